# Optimizing an MI355X kernel written in HIP

```python
import math
import jax, jax.numpy as jnp
from jax import lax
import numpy as np

D_MODEL = 1024
BATCH = 8
SEQ = 4096
DEPTH = 4

HEAD_DIM = 64
GRID_W = 64
ROPE_THETA = 10000.0
EPS = 1e-6
BLOCK = 128
NEG = -1e30

WIN_HEADS = 4
WIN_KV = 2
WIN_RADIUS = 128
AX_HEADS = 4
AX_KV = 2
DIL_HEADS = 4
DIL_KV = 2
DIL_PATTERNS = ((128, 1), (512, 4), (2048, 16))
MLA_HEADS = 4
MLA_Q_RANK = 256
MLA_KV_RANK = 128
MLA_NOPE = 64
MLA_ROPE = 32
MLA_V = 64

N_GROUPS = 4
GROUP_W = 4 * HEAD_DIM
MIX_WIDTH = N_GROUPS * GROUP_W
IN_SIZES = (WIN_HEADS * HEAD_DIM, WIN_KV * HEAD_DIM, WIN_KV * HEAD_DIM,
            AX_HEADS * HEAD_DIM, AX_KV * HEAD_DIM, AX_KV * HEAD_DIM,
            DIL_HEADS * HEAD_DIM, DIL_KV * HEAD_DIM, DIL_KV * HEAD_DIM,
            MLA_Q_RANK, MLA_KV_RANK, MLA_ROPE)
IN_COLS = sum(IN_SIZES)

PEER_KEYS = 128
PEER_N = PEER_KEYS * PEER_KEYS
PEER_HEADS = 8
PEER_DK = 256
PEER_TOPK = 16
PEER_CHUNK = 128

kernel_name = "hybrid_parallel_heads_peer_encoder"


def rms_norm(x, g):
    xf = x.astype(jnp.float32)
    y = xf * lax.rsqrt(jnp.mean(xf * xf, axis=-1, keepdims=True) + EPS)
    return (y * g.astype(jnp.float32)).astype(x.dtype)


def rope_angles(pos, dim):
    inv = ROPE_THETA ** (-jnp.arange(0, dim, 2, dtype=jnp.float32) / dim)
    ang = pos.astype(jnp.float32)[:, None] * inv[None, :]
    return jnp.cos(ang), jnp.sin(ang)


def apply_rope(x, cos, sin):
    half = x.shape[-1] // 2
    xf = x.astype(jnp.float32)
    x1, x2 = xf[..., :half], xf[..., half:]
    c, s = cos[None, :, None, :], sin[None, :, None, :]
    return jnp.concatenate([x1 * c - x2 * s, x2 * c + x1 * s], axis=-1).astype(x.dtype)


def dense_attention_blocks(q, k, v, scale):
    b, s_len, kv, g, dk = q.shape
    nb = s_len // BLOCK
    qb = q.reshape(b, nb, BLOCK, kv, g, dk).transpose(1, 0, 2, 3, 4, 5)

    def one(qblk):
        sc = jnp.einsum('bqkgd,bskd->bkgqs', qblk, k, preferred_element_type=jnp.float32) * scale
        p = jax.nn.softmax(sc, axis=-1).astype(v.dtype)
        return jnp.einsum('bkgqs,bskd->bqkgd', p, v)

    o = lax.map(one, qb)
    return o.transpose(1, 0, 2, 3, 4, 5).reshape(b, s_len, kv, g, v.shape[-1])


def windowed_attention_sink(q, k, v, sink):
    b, s_len, kv, g, hd = q.shape
    nb = s_len // BLOCK
    qb = q.reshape(b, nb, BLOCK, kv, g, hd)

    def neighbours(t):
        tb = t.reshape(b, nb, BLOCK, kv, t.shape[-1])
        pad = jnp.zeros_like(tb[:, :1])
        tp = jnp.concatenate([pad, tb, pad], axis=1)
        return jnp.concatenate([tp[:, :-2], tp[:, 1:-1], tp[:, 2:]], axis=2)

    kw, vw = neighbours(k), neighbours(v)
    qpos = jnp.arange(nb)[:, None] * BLOCK + jnp.arange(BLOCK)[None, :]
    kpos = jnp.arange(nb)[:, None] * BLOCK + jnp.arange(-BLOCK, 2 * BLOCK)[None, :]
    rel = kpos[:, None, :] - qpos[:, :, None]
    valid = (jnp.abs(rel) <= WIN_RADIUS) & (kpos[:, None, :] >= 0) & (kpos[:, None, :] < s_len)
    sc = jnp.einsum('bnqkgd,bnskd->bnkgqs', qb, kw, preferred_element_type=jnp.float32) * (hd ** -0.5)
    sc = jnp.where(valid[None, :, None, None], sc, NEG)
    sink_l = sink.astype(jnp.float32).reshape(kv, g)[None, None, :, :, None, None]
    m = jnp.maximum(jnp.max(sc, axis=-1, keepdims=True), sink_l)
    e = jnp.exp(sc - m)
    p = (e / (jnp.sum(e, axis=-1, keepdims=True) + jnp.exp(sink_l - m))).astype(v.dtype)
    o = jnp.einsum('bnkgqs,bnskd->bnqkgd', p, vw)
    return o.reshape(b, s_len, kv, g, hd)


def dilated_attention(q, k, v):
    b, s_len, kv, g, hd = q.shape
    nb = s_len // BLOCK
    offs_np = np.stack([np.concatenate([-np.arange(w // 2, 0, -r), np.zeros(1, np.int64), np.arange(r, w // 2 + 1, r)])
                        for (w, r) in DIL_PATTERNS]).astype(np.int32)
    offs = jnp.asarray(offs_np)
    qb = q.reshape(b, nb, BLOCK, kv, g, hd).transpose(1, 0, 2, 3, 4, 5)

    def one(args):
        qblk, q0 = args
        qpos = q0 + jnp.arange(BLOCK)
        kpos = qpos[None, :, None] + offs[:, None, :]
        valid = (kpos >= 0) & (kpos < s_len)
        kidx = jnp.clip(kpos, 0, s_len - 1)
        kg = k[:, kidx]
        vg = v[:, kidx]
        sc = jnp.einsum('bqkgd,bpqjkd->bpkgqj', qblk, kg, preferred_element_type=jnp.float32) * (hd ** -0.5)
        sc = jnp.where(valid[None, :, None, None, :, :], sc, NEG)
        lse = jax.nn.logsumexp(sc, axis=-1)
        p = jnp.exp(sc - lse[..., None]).astype(v.dtype)
        o = jnp.einsum('bpkgqj,bpqjkd->bpqkgd', p, vg)
        wts = jax.nn.softmax(lse, axis=1).astype(o.dtype)
        return jnp.einsum('bpkgq,bpqkgd->bqkgd', wts, o)

    o = lax.map(one, (qb, jnp.arange(nb) * BLOCK))
    return o.transpose(1, 0, 2, 3, 4, 5).reshape(b, s_len, kv, g, hd)


def mixer_window(q, k, v, sink, cos, sin):
    b, s_len, _ = q.shape
    q = apply_rope(q.reshape(b, s_len, WIN_HEADS, HEAD_DIM), cos, sin).reshape(b, s_len, WIN_KV, WIN_HEADS // WIN_KV, HEAD_DIM)
    k = apply_rope(k.reshape(b, s_len, WIN_KV, HEAD_DIM), cos, sin)
    v = v.reshape(b, s_len, WIN_KV, HEAD_DIM)
    return windowed_attention_sink(q, k, v, sink).reshape(b, s_len, WIN_HEADS * HEAD_DIM)


def rope_2d(x, cos_r, sin_r, cos_c, sin_c):
    half = x.shape[-1] // 2
    return jnp.concatenate([apply_rope(x[..., :half], cos_r, sin_r), apply_rope(x[..., half:], cos_c, sin_c)], axis=-1)


def mixer_axial(q, k, v, g_qn, g_kn, cos_r, sin_r, cos_c, sin_c):
    b, s_len, _ = q.shape
    q = rope_2d(rms_norm(q.reshape(b, s_len, AX_HEADS, HEAD_DIM), g_qn), cos_r, sin_r, cos_c, sin_c)
    k = rope_2d(rms_norm(k.reshape(b, s_len, AX_KV, HEAD_DIM), g_kn), cos_r, sin_r, cos_c, sin_c)
    v = v.reshape(b, s_len, AX_KV, HEAD_DIM)
    q = q.reshape(b, s_len, AX_KV, AX_HEADS // AX_KV, HEAD_DIM)
    return dense_attention_blocks(q, k, v, HEAD_DIM ** -0.5).reshape(b, s_len, AX_HEADS * HEAD_DIM)


def mixer_dilated(q, k, v, cos, sin):
    b, s_len, _ = q.shape
    q = apply_rope(q.reshape(b, s_len, DIL_HEADS, HEAD_DIM), cos, sin).reshape(b, s_len, DIL_KV, DIL_HEADS // DIL_KV, HEAD_DIM)
    k = apply_rope(k.reshape(b, s_len, DIL_KV, HEAD_DIM), cos, sin)
    v = v.reshape(b, s_len, DIL_KV, HEAD_DIM)
    return dilated_attention(q, k, v).reshape(b, s_len, DIL_HEADS * HEAD_DIM)


def mixer_mla(c_q, c_kv, k_r, g_cq, g_ckv, w_uq, w_ukv, cos, sin):
    b, s_len, _ = c_q.shape
    q = (rms_norm(c_q, g_cq) @ w_uq).reshape(b, s_len, MLA_HEADS, MLA_NOPE + MLA_ROPE)
    q = jnp.concatenate([q[..., :MLA_NOPE], apply_rope(q[..., MLA_NOPE:], cos, sin)], axis=-1)
    kv = (rms_norm(c_kv, g_ckv) @ w_ukv).reshape(b, s_len, MLA_HEADS, MLA_NOPE + MLA_V)
    k_r = apply_rope(k_r[:, :, None, :], cos, sin)
    k = jnp.concatenate([kv[..., :MLA_NOPE], jnp.broadcast_to(k_r, (b, s_len, MLA_HEADS, MLA_ROPE))], axis=-1)
    v = kv[..., MLA_NOPE:]
    o = dense_attention_blocks(q[:, :, :, None, :], k, v, (MLA_NOPE + MLA_ROPE) ** -0.5)
    return o.reshape(b, s_len, MLA_HEADS * MLA_V)


def peer_ffn(h, w_q, sub_keys, u_tab, v_tab):
    b, s_len, d = h.shape
    t = b * s_len
    hf = h.reshape(t, d)
    qry = (hf @ w_q).reshape(t, PEER_HEADS, 2, PEER_DK // 2)
    sc = jnp.einsum('thcd,hcnd->thcn', qry, sub_keys, preferred_element_type=jnp.float32)
    s1, i1 = lax.top_k(sc[:, :, 0], PEER_TOPK)
    s2, i2 = lax.top_k(sc[:, :, 1], PEER_TOPK)
    cand = (s1[..., :, None] + s2[..., None, :]).reshape(t, PEER_HEADS, PEER_TOPK * PEER_TOPK)
    cidx = (i1[..., :, None] * PEER_KEYS + i2[..., None, :]).reshape(t, PEER_HEADS, PEER_TOPK * PEER_TOPK)
    best, sel = lax.top_k(cand, PEER_TOPK)
    eidx = jnp.take_along_axis(cidx, sel, axis=-1)
    gate = jax.nn.softmax(best, axis=-1)
    nc = t // PEER_CHUNK

    def one(args):
        xc, ec, gc = args
        u = jnp.take(u_tab, ec, axis=0)
        a = jax.nn.gelu(jnp.einsum('chkd,cd->chk', u, xc), approximate=False)
        wgt = gc.astype(a.dtype) * a
        vv = jnp.take(v_tab, ec, axis=0)
        return jnp.einsum('chk,chkd->cd', wgt, vv)

    out = lax.map(one, (hf.reshape(nc, PEER_CHUNK, d),
                        eidx.reshape(nc, PEER_CHUNK, PEER_HEADS, PEER_TOPK),
                        gate.reshape(nc, PEER_CHUNK, PEER_HEADS, PEER_TOPK)))
    return out.reshape(b, s_len, d)


def setup_inputs(seed: int = 0) -> dict:
    key = jax.random.key(seed)
    ks = jax.random.split(key, 18)
    f32 = jnp.float32

    def nrm(k, shape, scale):
        return jax.random.normal(k, shape, f32) * scale

    def gain(k, shape):
        return 1.0 + 0.05 * jax.random.normal(k, shape, f32)

    return {
        'x': nrm(ks[0], (BATCH, SEQ, D_MODEL), 1.0),
        'g_mix': gain(ks[1], (DEPTH, D_MODEL)),
        'w_in': nrm(ks[2], (DEPTH, D_MODEL, IN_COLS), D_MODEL ** -0.5),
        'win_sink': nrm(ks[3], (DEPTH, WIN_HEADS), 0.5),
        'ax_q_norm': gain(ks[4], (DEPTH, HEAD_DIM)),
        'ax_k_norm': gain(ks[5], (DEPTH, HEAD_DIM)),
        'mla_q_norm': gain(ks[6], (DEPTH, MLA_Q_RANK)),
        'mla_kv_norm': gain(ks[7], (DEPTH, MLA_KV_RANK)),
        'mla_w_uq': nrm(ks[8], (DEPTH, MLA_Q_RANK, MLA_HEADS * (MLA_NOPE + MLA_ROPE)), MLA_Q_RANK ** -0.5),
        'mla_w_ukv': nrm(ks[9], (DEPTH, MLA_KV_RANK, MLA_HEADS * (MLA_NOPE + MLA_V)), MLA_KV_RANK ** -0.5),
        'g_group': gain(ks[10], (DEPTH, N_GROUPS, GROUP_W)),
        'w_out': nrm(ks[11], (DEPTH, MIX_WIDTH, D_MODEL), MIX_WIDTH ** -0.5),
        'g_ffn': gain(ks[12], (DEPTH, D_MODEL)),
        'peer_w_q': nrm(ks[13], (DEPTH, D_MODEL, PEER_HEADS * PEER_DK), D_MODEL ** -0.5),
        'peer_sub_keys': nrm(ks[14], (DEPTH, PEER_HEADS, 2, PEER_KEYS, PEER_DK // 2), (PEER_DK // 2) ** -0.5),
        'peer_u': nrm(ks[15], (DEPTH, PEER_N, D_MODEL), D_MODEL ** -0.5),
        'peer_v': nrm(ks[16], (DEPTH, PEER_N, D_MODEL), PEER_HEADS ** -0.5),
        'g_final': gain(ks[17], (D_MODEL,)),
    }


def reference(x, g_mix, w_in, win_sink, ax_q_norm, ax_k_norm, mla_q_norm, mla_kv_norm, mla_w_uq, mla_w_ukv,
              g_group, w_out, g_ffn, peer_w_q, peer_sub_keys, peer_u, peer_v, g_final):
    b, s_len, _ = x.shape
    pos = jnp.arange(s_len)
    rows = s_len // GRID_W
    row = jnp.repeat(jnp.arange(rows), GRID_W)
    col = jnp.tile(jnp.arange(GRID_W), rows)
    cos1, sin1 = rope_angles(pos, HEAD_DIM)
    cos_m, sin_m = rope_angles(pos, MLA_ROPE)
    cos_r, sin_r = rope_angles(row, HEAD_DIM // 2)
    cos_c, sin_c = rope_angles(col, HEAD_DIM // 2)
    splits = np.cumsum(IN_SIZES)[:-1].tolist()
    for l in range(DEPTH):
        h = rms_norm(x, g_mix[l])
        z = h @ w_in[l]
        (aq, ak, av, bq, bk, bv, cq, ck, cv, dcq, dckv, dkr) = jnp.split(z, splits, axis=-1)
        o_a = mixer_window(aq, ak, av, win_sink[l], cos1, sin1)
        o_b = mixer_axial(bq, bk, bv, ax_q_norm[l], ax_k_norm[l], cos_r, sin_r, cos_c, sin_c)
        o_c = mixer_dilated(cq, ck, cv, cos1, sin1)
        o_d = mixer_mla(dcq, dckv, dkr, mla_q_norm[l], mla_kv_norm[l], mla_w_uq[l], mla_w_ukv[l], cos_m, sin_m)
        y = jnp.concatenate([rms_norm(o_a, g_group[l, 0]), rms_norm(o_b, g_group[l, 1]),
                             rms_norm(o_c, g_group[l, 2]), rms_norm(o_d, g_group[l, 3])], axis=-1)
        x = x + y @ w_out[l]
        x = x + peer_ffn(rms_norm(x, g_ffn[l]), peer_w_q[l], peer_sub_keys[l], peer_u[l], peer_v[l])
    return rms_norm(x, g_final)
```

```cpp
#include <hip/hip_runtime.h>
#include <stdint.h>
#include <stdio.h>

typedef unsigned short bf16_t;

#define T_TOK 32768
#define SEQ 4096
#define NBATCH 8
#define DM 1024
#define NZ 1952
#define DEPTH 4
#define LOG2E 1.4426950408889634f

__device__ __forceinline__ float bf2f(bf16_t v) { return __uint_as_float(((unsigned)v) << 16); }
__device__ __forceinline__ bf16_t f2bf(float f) {
    unsigned u = __float_as_uint(f);
    u += 0x7fffu + ((u >> 16) & 1u);
    return (bf16_t)(u >> 16);
}
__device__ __forceinline__ float wave_sum(float v) {
#pragma unroll
    for (int o = 32; o >= 1; o >>= 1) v += __shfl_xor(v, o);
    return v;
}
__device__ __forceinline__ float wave_max(float v) {
#pragma unroll
    for (int o = 32; o >= 1; o >>= 1) v = fmaxf(v, __shfl_xor(v, o));
    return v;
}

struct Tables { float *cos1, *sin1, *cosm, *sinm, *cosr, *sinr, *cosc, *sinc; };

__global__ void k_tables(Tables tb) {
    int i = blockIdx.x * blockDim.x + threadIdx.x;
    if (i < 4096 * 32) {
        int pos = i / 32, j = i % 32;
        float inv = powf(10000.f, -(float)(2 * j) / 64.f);
        float ang = (float)pos * inv;
        tb.cos1[i] = cosf(ang); tb.sin1[i] = sinf(ang);
    }
    if (i < 4096 * 16) {
        int pos = i / 16, j = i % 16;
        float inv = powf(10000.f, -(float)(2 * j) / 32.f);
        float ang = (float)pos * inv;
        tb.cosm[i] = cosf(ang); tb.sinm[i] = sinf(ang);
    }
    if (i < 64 * 16) {
        int pos = i / 16, j = i % 16;
        float inv = powf(10000.f, -(float)(2 * j) / 32.f);
        float ang = (float)pos * inv;
        tb.cosr[i] = cosf(ang); tb.sinr[i] = sinf(ang);
        tb.cosc[i] = cosf(ang); tb.sinc[i] = sinf(ang);
    }
}

__global__ void __launch_bounds__(256) k_rmsnorm_f32(const float* __restrict__ x, const float* __restrict__ g, float* __restrict__ out, int rows) {
    int row = blockIdx.x * 4 + (threadIdx.x >> 6), lane = threadIdx.x & 63;
    if (row >= rows) return;
    const float4* xr = (const float4*)(x + (size_t)row * DM);
    float4 v[4]; float ss = 0.f;
#pragma unroll
    for (int i = 0; i < 4; ++i) { v[i] = xr[lane + 64 * i]; ss += v[i].x * v[i].x + v[i].y * v[i].y + v[i].z * v[i].z + v[i].w * v[i].w; }
    ss = wave_sum(ss);
    float rstd = rsqrtf(ss * (1.f / DM) + 1e-6f);
    float4* orow = (float4*)(out + (size_t)row * DM);
    const float4* g4 = (const float4*)g;
#pragma unroll
    for (int i = 0; i < 4; ++i) {
        float4 gg = g4[lane + 64 * i]; float4 o;
        o.x = v[i].x * rstd * gg.x; o.y = v[i].y * rstd * gg.y; o.z = v[i].z * rstd * gg.z; o.w = v[i].w * rstd * gg.w;
        orow[lane + 64 * i] = o;
    }
}

__global__ void __launch_bounds__(256) k_groupnorm_f32(const bf16_t* __restrict__ o, const float* __restrict__ gg, float* __restrict__ out) {
    int row = blockIdx.x * 4 + (threadIdx.x >> 6), lane = threadIdx.x & 63;
    const bf16_t* orow = o + (size_t)row * DM;
#pragma unroll
    for (int g = 0; g < 4; ++g) {
        float v[4]; float ss = 0.f;
#pragma unroll
        for (int i = 0; i < 4; ++i) { v[i] = bf2f(orow[g * 256 + lane + 64 * i]); ss += v[i] * v[i]; }
        ss = wave_sum(ss);
        float rstd = rsqrtf(ss * (1.f / 256.f) + 1e-6f);
#pragma unroll
        for (int i = 0; i < 4; ++i) out[(size_t)row * DM + g * 256 + lane + 64 * i] = v[i] * rstd * gg[g * 256 + lane + 64 * i];
    }
}

template <typename AT> __device__ __forceinline__ float ldA(const AT* p);
template <> __device__ __forceinline__ float ldA<float>(const float* p) { return *p; }
template <> __device__ __forceinline__ float ldA<bf16_t>(const bf16_t* p) { return bf2f(*p); }
__device__ __forceinline__ void stC(float* p, float v) { *p = v; }
__device__ __forceinline__ void stC(bf16_t* p, float v) { *p = f2bf(v); }

template <typename AT, typename CT, bool RES>
__global__ void __launch_bounds__(256) k_ngemm(const AT* __restrict__ A, int lda, const float* __restrict__ B, int ldb,
                                               CT* C, int ldc, const float* R, int ldr, int M, int N, int K) {
    __shared__ float As[16][132];
    __shared__ float Bs[16][132];
    const int tid = threadIdx.x, tx = tid & 15, ty = tid >> 4;
    const int m0 = blockIdx.y * 128, n0 = blockIdx.x * 128;
    float acc[8][8];
#pragma unroll
    for (int i = 0; i < 8; ++i)
#pragma unroll
        for (int j = 0; j < 8; ++j) acc[i][j] = 0.f;
    const int ar = tid >> 1, ak = (tid & 1) * 8;
    const int bk = tid >> 4, bn = (tid & 15) * 8;
    for (int k0 = 0; k0 < K; k0 += 16) {
#pragma unroll
        for (int i = 0; i < 8; ++i) As[ak + i][ar] = ldA<AT>(A + (size_t)(m0 + ar) * lda + k0 + ak + i);
#pragma unroll
        for (int i = 0; i < 8; ++i) { int n = n0 + bn + i; Bs[bk][bn + i] = (n < N) ? B[(size_t)(k0 + bk) * ldb + n] : 0.f; }
        __syncthreads();
#pragma unroll
        for (int kk = 0; kk < 16; ++kk) {
            float a[8], b[8];
#pragma unroll
            for (int i = 0; i < 8; ++i) a[i] = As[kk][ty * 8 + i];
#pragma unroll
            for (int j = 0; j < 8; ++j) b[j] = Bs[kk][tx * 8 + j];
#pragma unroll
            for (int i = 0; i < 8; ++i)
#pragma unroll
                for (int j = 0; j < 8; ++j) acc[i][j] += a[i] * b[j];
        }
        __syncthreads();
    }
#pragma unroll
    for (int i = 0; i < 8; ++i) {
        int m = m0 + ty * 8 + i;
#pragma unroll
        for (int j = 0; j < 8; ++j) {
            int n = n0 + tx * 8 + j;
            if (n < N) {
                float v = acc[i][j];
                if (RES) v += R[(size_t)m * ldr + n];
                stC(C + (size_t)m * ldc + n, v);
            }
        }
    }
}

struct QKV {
    bf16_t *qA, *kA, *vA, *qB, *kB, *vB, *qC, *kC, *vC, *qD, *kD, *vD;
};
struct PostArgs {
    const bf16_t* z; QKV o; Tables tb;
    const float *g_qn, *g_kn, *g_cq, *g_ckv;
    float *cqn, *ckvn;
};

__global__ void __launch_bounds__(256) k_post_naive(PostArgs a) {
    __shared__ float zr[NZ];
    __shared__ float hs[8];
    const int t = blockIdx.x, tid = threadIdx.x;
    const int b = t / SEQ, s = t % SEQ;
    for (int i = tid; i < NZ; i += 256) zr[i] = bf2f(a.z[(size_t)t * NZ + i]);
    __syncthreads();
    if (tid < 8) {
        int base, n;
        if (tid < 4) { base = 512 + tid * 64; n = 64; }
        else if (tid < 6) { base = 768 + (tid - 4) * 64; n = 64; }
        else if (tid == 6) { base = 1536; n = 256; }
        else { base = 1792; n = 128; }
        float ss = 0.f;
        for (int i = 0; i < n; ++i) ss += zr[base + i] * zr[base + i];
        hs[tid] = rsqrtf(ss / (float)n + 1e-6f);
    }
    __syncthreads();
    const float scA = 0.125f * LOG2E;
    const float scD = 0.10206207261596575f * LOG2E;
    for (int mix = 0; mix < 2; ++mix) {
        const int zb = mix == 0 ? 0 : 1024;
        bf16_t* qo = mix == 0 ? a.o.qA : a.o.qC;
        bf16_t* ko = mix == 0 ? a.o.kA : a.o.kC;
        bf16_t* vo = mix == 0 ? a.o.vA : a.o.vC;
        for (int i = tid; i < 128; i += 256) {
            int h = i / 32, j = i % 32;
            float x1 = zr[zb + h * 64 + j], x2 = zr[zb + h * 64 + 32 + j];
            float c = a.tb.cos1[s * 32 + j], sn = a.tb.sin1[s * 32 + j];
            size_t ob = ((size_t)(b * 4 + h) * SEQ + s) * 64;
            qo[ob + j] = f2bf((x1 * c - x2 * sn) * scA);
            qo[ob + 32 + j] = f2bf((x2 * c + x1 * sn) * scA);
        }
        for (int i = tid; i < 64; i += 256) {
            int h = i / 32, j = i % 32;
            float x1 = zr[zb + 256 + h * 64 + j], x2 = zr[zb + 256 + h * 64 + 32 + j];
            float c = a.tb.cos1[s * 32 + j], sn = a.tb.sin1[s * 32 + j];
            size_t ob = ((size_t)(b * 2 + h) * SEQ + s) * 64;
            ko[ob + j] = f2bf(x1 * c - x2 * sn);
            ko[ob + 32 + j] = f2bf(x2 * c + x1 * sn);
        }
        for (int i = tid; i < 128; i += 256) {
            int h = i / 64, j = i % 64;
            vo[((size_t)(b * 2 + h) * SEQ + s) * 64 + j] = f2bf(zr[zb + 384 + i]);
        }
    }
    {
        const int row = s / 64, col = s % 64;
        for (int i = tid; i < 192; i += 256) {
            int hh = i / 32, r = i % 32, half = r / 16, j = r % 16;
            bool isq = hh < 4;
            int zb = isq ? 512 + hh * 64 : 768 + (hh - 4) * 64;
            const float* gn = isq ? a.g_qn : a.g_kn;
            float rstd = hs[hh];
            int d1 = half * 32 + j, d2 = half * 32 + 16 + j;
            float x1 = zr[zb + d1] * rstd * gn[d1], x2 = zr[zb + d2] * rstd * gn[d2];
            float c, sn;
            if (half == 0) { c = a.tb.cosr[row * 16 + j]; sn = a.tb.sinr[row * 16 + j]; }
            else { c = a.tb.cosc[col * 16 + j]; sn = a.tb.sinc[col * 16 + j]; }
            float o1 = x1 * c - x2 * sn, o2 = x2 * c + x1 * sn;
            if (isq) {
                size_t ob = ((size_t)(b * 4 + hh) * SEQ + s) * 64;
                a.o.qB[ob + d1] = f2bf(o1 * scA); a.o.qB[ob + d2] = f2bf(o2 * scA);
            } else {
                size_t ob = ((size_t)(b * 2 + (hh - 4)) * SEQ + s) * 64;
                a.o.kB[ob + d1] = f2bf(o1); a.o.kB[ob + d2] = f2bf(o2);
            }
        }
        for (int i = tid; i < 128; i += 256) {
            int h = i / 64, j = i % 64;
            a.o.vB[((size_t)(b * 2 + h) * SEQ + s) * 64 + j] = f2bf(zr[896 + i]);
        }
    }
    for (int i = tid; i < 256; i += 256) a.cqn[(size_t)t * 256 + i] = zr[1536 + i] * hs[6] * a.g_cq[i];
    for (int i = tid; i < 128; i += 256) a.ckvn[(size_t)t * 128 + i] = zr[1792 + i] * hs[7] * a.g_ckv[i];
    for (int i = tid; i < 16; i += 256) {
        float x1 = zr[1920 + i], x2 = zr[1920 + 16 + i];
        float c = a.tb.cosm[s * 16 + i], sn = a.tb.sinm[s * 16 + i];
        bf16_t o1 = f2bf(x1 * c - x2 * sn), o2 = f2bf(x2 * c + x1 * sn);
        for (int h = 0; h < 4; ++h) {
            size_t ob = ((size_t)(b * 4 + h) * SEQ + s) * 96;
            a.o.kD[ob + 64 + i] = o1; a.o.kD[ob + 80 + i] = o2;
        }
    }
    (void)scD;
}

__global__ void __launch_bounds__(256) k_post_mla(const float* __restrict__ qfull, const float* __restrict__ kvfull, QKV o, Tables tb) {
    const int t = blockIdx.x, tid = threadIdx.x;
    const int b = t / SEQ, s = t % SEQ;
    const float scD = 0.10206207261596575f * LOG2E;
    {
        int h = tid / 64, j = tid % 64;
        o.qD[((size_t)(b * 4 + h) * SEQ + s) * 96 + j] = f2bf(qfull[(size_t)t * 384 + h * 96 + j] * scD);
    }
    if (tid < 64) {
        int h = tid / 16, j = tid % 16;
        float x1 = qfull[(size_t)t * 384 + h * 96 + 64 + j], x2 = qfull[(size_t)t * 384 + h * 96 + 80 + j];
        float c = tb.cosm[s * 16 + j], sn = tb.sinm[s * 16 + j];
        size_t ob = ((size_t)(b * 4 + h) * SEQ + s) * 96;
        o.qD[ob + 64 + j] = f2bf((x1 * c - x2 * sn) * scD);
        o.qD[ob + 80 + j] = f2bf((x2 * c + x1 * sn) * scD);
    }
    {
        int h = tid / 64, j = tid % 64;
        o.kD[((size_t)(b * 4 + h) * SEQ + s) * 96 + j] = f2bf(kvfull[(size_t)t * 512 + h * 128 + j]);
        o.vD[((size_t)(b * 4 + h) * SEQ + s) * 64 + j] = f2bf(kvfull[(size_t)t * 512 + h * 128 + 64 + j]);
    }
}

template <int DK, int MODE>
__global__ void __launch_bounds__(256) k_attn_naive(const bf16_t* __restrict__ Q, const bf16_t* __restrict__ K, const bf16_t* __restrict__ V,
                                                    const float* __restrict__ sink, bf16_t* __restrict__ O, int H, int KV, int ocol) {
    const int wave = threadIdx.x >> 6, lane = threadIdx.x & 63;
    const int gq = blockIdx.x * 4 + wave;
    const int s = gq % SEQ, bh = gq / SEQ, h = bh % H, b = bh / H;
    const int kvh = h / (H / KV);
    const bf16_t* qrow = Q + (size_t)gq * DK;
    const bf16_t* Kb = K + (size_t)(b * KV + kvh) * SEQ * DK;
    const bf16_t* Vb = V + (size_t)(b * KV + kvh) * SEQ * 64;
    const int sub = lane & 7, grp = lane >> 3;
    constexpr int NCH = DK / 8;
    float q0[8], q1[8];
    {
        uint4 r = *(const uint4*)(qrow + sub * 8);
        const bf16_t* p = (const bf16_t*)&r;
#pragma unroll
        for (int i = 0; i < 8; ++i) q0[i] = bf2f(p[i]);
        const bool has1 = (NCH > 8) && (sub + 8 < NCH);
        uint4 r1 = make_uint4(0, 0, 0, 0);
        if (has1) r1 = *(const uint4*)(qrow + (sub + 8) * 8);
        const bf16_t* p1 = (const bf16_t*)&r1;
#pragma unroll
        for (int i = 0; i < 8; ++i) q1[i] = bf2f(p1[i]);
    }
    float m = -1e30f, l = 0.f, acc[8];
#pragma unroll
    for (int i = 0; i < 8; ++i) acc[i] = 0.f;
    if (MODE == 1 && grp == 0) { m = sink[h] * LOG2E; l = 1.f; }
    const int nk = MODE == 0 ? SEQ : (MODE == 1 ? 257 : 387);
    for (int base = 0; base < nk; base += 8) {
        const int kk = base + grp;
        bool valid = kk < nk;
        int tok;
        if (MODE == 0) tok = kk;
        else if (MODE == 1) tok = s - 128 + kk;
        else { int p = kk / 129, j = kk % 129; int r = p == 0 ? 1 : (p == 1 ? 4 : 16); tok = s + (j - 64) * r; }
        valid = valid && tok >= 0 && tok < SEQ;
        float sc = 0.f;
        if (valid) {
            uint4 r = *(const uint4*)(Kb + (size_t)tok * DK + sub * 8);
            const bf16_t* p = (const bf16_t*)&r;
#pragma unroll
            for (int i = 0; i < 8; ++i) sc += q0[i] * bf2f(p[i]);
            if (NCH > 8 && sub + 8 < NCH) {
                uint4 r1 = *(const uint4*)(Kb + (size_t)tok * DK + (sub + 8) * 8);
                const bf16_t* p1 = (const bf16_t*)&r1;
#pragma unroll
                for (int i = 0; i < 8; ++i) sc += q1[i] * bf2f(p1[i]);
            }
        }
        sc += __shfl_xor(sc, 1); sc += __shfl_xor(sc, 2); sc += __shfl_xor(sc, 4);
        if (valid) {
            float mn = fmaxf(m, sc);
            float f = exp2f(m - mn), p = exp2f(sc - mn);
            uint4 r = *(const uint4*)(Vb + (size_t)tok * 64 + sub * 8);
            const bf16_t* pv = (const bf16_t*)&r;
            l = l * f + p;
#pragma unroll
            for (int i = 0; i < 8; ++i) acc[i] = acc[i] * f + p * bf2f(pv[i]);
            m = mn;
        }
    }
    float M = m;
    M = fmaxf(M, __shfl_xor(M, 8)); M = fmaxf(M, __shfl_xor(M, 16)); M = fmaxf(M, __shfl_xor(M, 32));
    float f = exp2f(m - M);
    l *= f;
    l += __shfl_xor(l, 8); l += __shfl_xor(l, 16); l += __shfl_xor(l, 32);
#pragma unroll
    for (int i = 0; i < 8; ++i) {
        float v = acc[i] * f;
        v += __shfl_xor(v, 8); v += __shfl_xor(v, 16); v += __shfl_xor(v, 32);
        acc[i] = v;
    }
    if (grp == 0) {
        const int t = b * SEQ + s;
        float inv = 1.f / l;
#pragma unroll
        for (int i = 0; i < 8; ++i) O[(size_t)t * DM + ocol + h * 64 + sub * 8 + i] = f2bf(acc[i] * inv);
    }
}

__global__ void __launch_bounds__(64) k_peer_topk_naive(const bf16_t* __restrict__ qp, const float* __restrict__ subk  ,
                                                        int* __restrict__ eidx, float* __restrict__ gate) {
    __shared__ float qs[256];
    __shared__ float s12[2][16];
    __shared__ int i12[2][16];
    const int t = blockIdx.x >> 3, h = blockIdx.x & 7, lane = threadIdx.x;
    for (int i = lane; i < 256; i += 64) qs[i] = bf2f(qp[(size_t)t * 2048 + h * 256 + i]);
    __syncthreads();
    float sc[2][2];
#pragma unroll
    for (int c = 0; c < 2; ++c)
#pragma unroll
        for (int u = 0; u < 2; ++u) {
            int n = lane + 64 * u;
            const float* kr = subk + ((size_t)(h * 2 + c) * 128 + n) * 128;
            float a = 0.f;
            for (int d = 0; d < 128; ++d) a += qs[c * 128 + d] * kr[d];
            sc[c][u] = a;
        }
#pragma unroll
    for (int c = 0; c < 2; ++c) {
        for (int r = 0; r < 16; ++r) {
            float bv; int bi;
            if (sc[c][0] >= sc[c][1]) { bv = sc[c][0]; bi = lane; } else { bv = sc[c][1]; bi = lane + 64; }
#pragma unroll
            for (int o = 32; o >= 1; o >>= 1) {
                float ov = __shfl_xor(bv, o); int oi = __shfl_xor(bi, o);
                if (ov > bv || (ov == bv && oi < bi)) { bv = ov; bi = oi; }
            }
            if (bi == lane) sc[c][0] = -3e38f;
            if (bi == lane + 64) sc[c][1] = -3e38f;
            if (lane == 0) { s12[c][r] = bv; i12[c][r] = bi; }
        }
    }
    __syncthreads();
    float cv[4]; int ci[4];
#pragma unroll
    for (int u = 0; u < 4; ++u) {
        int id = lane + 64 * u;
        cv[u] = s12[0][id / 16] + s12[1][id % 16];
        ci[u] = i12[0][id / 16] * 128 + i12[1][id % 16];
    }
    float best = 0.f; int be = 0;
    for (int r = 0; r < 16; ++r) {
        float bv = cv[0]; int bu = 0;
#pragma unroll
        for (int u = 1; u < 4; ++u) if (cv[u] > bv) { bv = cv[u]; bu = u; }
        int bid = lane + 64 * bu;
#pragma unroll
        for (int o = 32; o >= 1; o >>= 1) {
            float ov = __shfl_xor(bv, o); int oi = __shfl_xor(bid, o);
            if (ov > bv || (ov == bv && oi < bid)) { bv = ov; bid = oi; }
        }
        int e = 0;
#pragma unroll
        for (int u = 0; u < 4; ++u) if (bid == lane + 64 * u) { cv[u] = -3e38f; e = ci[u]; }
        e = __shfl(e, bid & 63);
        if (lane == r) { best = bv; be = e; }
    }
    float mx = lane < 16 ? best : -3e38f;
    mx = wave_max(mx);
    float ex = lane < 16 ? expf(best - mx) : 0.f;
    float sm = wave_sum(ex);
    if (lane < 16) {
        eidx[(size_t)t * 128 + h * 16 + lane] = be;
        gate[(size_t)t * 128 + h * 16 + lane] = ex / sm;
    }
}

__global__ void __launch_bounds__(256) k_peer_expert_naive(const float* __restrict__ hn, const int* __restrict__ eidx, const float* __restrict__ gate,
                                                           const float* __restrict__ ut, const float* __restrict__ vt, float* __restrict__ x) {
    __shared__ float hs[DM];
    __shared__ float wg[128];
    __shared__ int es[128];
    const int t = blockIdx.x, tid = threadIdx.x, wave = tid >> 6, lane = tid & 63;
    for (int i = tid; i < DM; i += 256) hs[i] = hn[(size_t)t * DM + i];
    if (tid < 128) es[tid] = eidx[(size_t)t * 128 + tid];
    __syncthreads();
    for (int p = wave * 32; p < wave * 32 + 32; ++p) {
        const float* ur = ut + (size_t)es[p] * DM;
        float a = 0.f;
#pragma unroll
        for (int i = 0; i < 16; ++i) a += ur[lane + 64 * i] * hs[lane + 64 * i];
        a = wave_sum(a);
        if (lane == 0) {
            float ge = 0.5f * a * (1.f + erff(a * 0.70710678118654752f));
            wg[p] = gate[(size_t)t * 128 + p] * ge;
        }
    }
    __syncthreads();
    float o[4] = {0.f, 0.f, 0.f, 0.f};
    for (int p = 0; p < 128; ++p) {
        const float* vr = vt + (size_t)es[p] * DM;
        float w = wg[p];
#pragma unroll
        for (int i = 0; i < 4; ++i) o[i] += w * vr[tid + 256 * i];
    }
#pragma unroll
    for (int i = 0; i < 4; ++i) x[(size_t)t * DM + tid + 256 * i] += o[i];
}

using bf16x8 = __attribute__((ext_vector_type(8))) short;
using s16x4 = __attribute__((ext_vector_type(4))) short;
using f32x16 = __attribute__((ext_vector_type(16))) float;
typedef __attribute__((ext_vector_type(2))) __bf16 bf16x2_t;

#define NBLK_THREADS 256
#define LDS_BYTES 65536

__device__ __forceinline__ unsigned cvtpk(float lo, float hi) {
    unsigned r; asm volatile("v_cvt_pk_bf16_f32 %0, %1, %2" : "=v"(r) : "v"(lo), "v"(hi)); return r;
}
__device__ __forceinline__ int tid_opaque() { int t = threadIdx.x; asm volatile("" : "+v"(t)); return t; }
__device__ __forceinline__ int crow(int i, int hh) { return (i & 3) + 8 * (i >> 2) + 4 * hh; }
__device__ __forceinline__ float xhalf(float v) { return __shfl_xor(v, 32); }

struct P {
    const float *x_in, *g_mix, *w_in, *win_sink, *ax_q_norm, *ax_k_norm, *mla_q_norm, *mla_kv_norm, *mla_w_uq, *mla_w_ukv, *g_group, *w_out,
        *g_ffn, *peer_w_q, *peer_sub_keys, *peer_u, *peer_v, *g_final;
    float* out;
    float* x; bf16_t* hnb; bf16_t* zb; QKV q; bf16_t* ob; bf16_t* qp; int* eidx; float* gate;
    bf16_t *cqn, *ckvn, *qfull, *kvfull;
    bf16_t *winT, *woutT, *wqT, *subk, *wuqT, *wukvT, *ub, *vb;
    Tables tb;
    unsigned* bar;
    int flags; int pad0;
};

struct EpiStoreBf16 {
    bf16_t* C; int ldc; int N;
    __device__ __forceinline__ void operator()(const f32x16 (&acc)[2][2], int mbase, int nbase, int r32, int hh) const {
#pragma unroll
        for (int mt = 0; mt < 2; ++mt)
#pragma unroll
            for (int nt = 0; nt < 2; ++nt) {
                const int n = nbase + nt * 32 + r32;
                if (n < N) {
#pragma unroll
                    for (int i = 0; i < 16; ++i) {
                        const int m = mbase + mt * 32 + crow(i, hh);
                        C[(size_t)m * ldc + n] = f2bf(acc[mt][nt][i]);
                    }
                }
            }
    }
};
struct EpiResidF32 {
    float* X; int ldx;
    __device__ __forceinline__ void operator()(const f32x16 (&acc)[2][2], int mbase, int nbase, int r32, int hh) const {
#pragma unroll
        for (int mt = 0; mt < 2; ++mt)
#pragma unroll
            for (int nt = 0; nt < 2; ++nt) {
                const int n = nbase + nt * 32 + r32;
#pragma unroll
                for (int i = 0; i < 16; ++i) {
                    const int m = mbase + mt * 32 + crow(i, hh);
                    float* p = X + (size_t)m * ldx + n;
                    *p = *p + acc[mt][nt][i];
                }
            }
    }
};

template <class Epi>
__device__ __forceinline__ void gemm_tile(const bf16_t* __restrict__ X, int ldx, const bf16_t* __restrict__ W, int ldw, int K, int m0, int n0, int N,
                                          char* lds, const Epi& epi) {
    const int tid = tid_opaque(), lane = tid & 63, wave = tid >> 6;
    const int wm = wave >> 1, wn = wave & 1;
    const int r32 = lane & 31, hh = lane >> 5;
    const int lrow = tid >> 3, lc = tid & 7;
    const bf16_t* xg = X + (size_t)(m0 + lrow) * ldx + lc * 8;
    const bf16_t* wg[4];
#pragma unroll
    for (int j = 0; j < 4; ++j) { int n = n0 + lrow + 32 * j; n = n < N ? n : N - 1; wg[j] = W + (size_t)n * ldw + lc * 8; }
    uint4 xr[4], wr[4];
    f32x16 acc[2][2];
#pragma unroll
    for (int a = 0; a < 2; ++a)
#pragma unroll
        for (int b = 0; b < 2; ++b)
#pragma unroll
            for (int i = 0; i < 16; ++i) acc[a][b][i] = 0.f;
    const int nk = K >> 6;
#pragma unroll
    for (int j = 0; j < 4; ++j) { xr[j] = *(const uint4*)(xg + (size_t)(32 * j) * ldx); wr[j] = *(const uint4*)(wg[j]); }
#pragma unroll
    for (int j = 0; j < 4; ++j) {
        const int r = lrow + 32 * j; const int off = r * 128 + ((lc ^ ((r >> 1) & 7)) << 4);
        *(uint4*)(lds + off) = xr[j]; *(uint4*)(lds + 16384 + off) = wr[j];
    }
    __syncthreads();
    for (int kt = 0; kt < nk; ++kt) {
        const bool nxt = kt + 1 < nk;
        if (nxt) {
#pragma unroll
            for (int j = 0; j < 4; ++j) { xr[j] = *(const uint4*)(xg + (size_t)(32 * j) * ldx + (kt + 1) * 64); wr[j] = *(const uint4*)(wg[j] + (kt + 1) * 64); }
        }
        const char* xs = lds + (kt & 1) * 32768; const char* ws = xs + 16384;
#pragma unroll
        for (int ks = 0; ks < 4; ++ks) {
            bf16x8 xf[2], wf[2];
#pragma unroll
            for (int mt = 0; mt < 2; ++mt) { const int r = wm * 64 + mt * 32 + r32; xf[mt] = *(const bf16x8*)(xs + r * 128 + (((ks * 2 + hh) ^ ((r >> 1) & 7)) << 4)); }
#pragma unroll
            for (int nt = 0; nt < 2; ++nt) { const int r = wn * 64 + nt * 32 + r32; wf[nt] = *(const bf16x8*)(ws + r * 128 + (((ks * 2 + hh) ^ ((r >> 1) & 7)) << 4)); }
#pragma unroll
            for (int mt = 0; mt < 2; ++mt)
#pragma unroll
                for (int nt = 0; nt < 2; ++nt) acc[mt][nt] = __builtin_amdgcn_mfma_f32_32x32x16_bf16(xf[mt], wf[nt], acc[mt][nt], 0, 0, 0);
        }
        if (nxt) {
            char* xd = lds + ((kt + 1) & 1) * 32768;
#pragma unroll
            for (int j = 0; j < 4; ++j) {
                const int r = lrow + 32 * j; const int off = r * 128 + ((lc ^ ((r >> 1) & 7)) << 4);
                *(uint4*)(xd + off) = xr[j]; *(uint4*)(xd + 16384 + off) = wr[j];
            }
        }
        __syncthreads();
    }
    epi(acc, m0 + wm * 64, n0 + wn * 64, r32, hh);
}

__device__ __forceinline__ void tile_map(int tile, int ntm, int ntn, int& mt, int& nt) {
    if ((ntn & 7) == 0) {
        const int G = gridDim.x;
        const int round = tile / G, bi = tile % G;
        const int x = bi & 7, j = bi >> 3;
        const int per = G >> 3;
        const int id = (round * 8 + x) * per + j;
        const int st = id >> 6, in = id & 63;
        const int snt = ntn >> 3;
        const int sm = st / snt, sn = st % snt;
        mt = sm * 8 + (in >> 3); nt = sn * 8 + (in & 7);
    } else { mt = tile / ntn; nt = tile % ntn; }
}

template <class Epi>
__device__ __forceinline__ void gemm_phase(const bf16_t* X, int ldx, const bf16_t* W, int ldw, int M, int N, int K, char* lds, const Epi& epi) {
    const int ntm = M >> 7, ntn = (N + 127) >> 7, nt_tot = ntm * ntn;
    for (int tile = blockIdx.x; tile < nt_tot; tile += gridDim.x) {
        int mt, nt;
        if ((gridDim.x & 7) == 0 && (gridDim.x >> 3) * 8 == gridDim.x && ((gridDim.x >> 3) & 63) == 0) tile_map(tile, ntm, ntn, mt, nt);
        else { mt = tile / ntn; nt = tile % ntn; }
        if (mt < ntm && nt < ntn) gemm_tile(X, ldx, W, ldw, K, mt * 128, nt * 128, N, lds, epi);
    }
}

template <int OFF> __device__ __forceinline__ s16x4 tr_read(int vb) {
    s16x4 r; asm volatile("ds_read_b64_tr_b16 %0, %1 offset:%2" : "=&v"(r) : "v"(vb), "i"(OFF) : "memory"); return r;
}
#define VS_BYTES 192

template <int KT2>
__device__ __forceinline__ void pv_sub(f32x16 (&o)[2], const f32x16& p, int vbase) {
    bf16x8 pf[2];
#pragma unroll
    for (int s2 = 0; s2 < 2; ++s2) {
        unsigned a = cvtpk(p[8 * s2 + 0], p[8 * s2 + 1]), b = cvtpk(p[8 * s2 + 2], p[8 * s2 + 3]);
        unsigned c = cvtpk(p[8 * s2 + 4], p[8 * s2 + 5]), d = cvtpk(p[8 * s2 + 6], p[8 * s2 + 7]);
        uint4 w = make_uint4(a, b, c, d);
        pf[s2] = *(bf16x8*)&w;
    }
    {
        s16x4 l00 = tr_read<(KT2 * 32 + 0) * VS_BYTES + 0>(vbase), h00 = tr_read<(KT2 * 32 + 8) * VS_BYTES + 0>(vbase);
        s16x4 l01 = tr_read<(KT2 * 32 + 0) * VS_BYTES + 64>(vbase), h01 = tr_read<(KT2 * 32 + 8) * VS_BYTES + 64>(vbase);
        s16x4 l10 = tr_read<(KT2 * 32 + 16) * VS_BYTES + 0>(vbase), h10 = tr_read<(KT2 * 32 + 24) * VS_BYTES + 0>(vbase);
        s16x4 l11 = tr_read<(KT2 * 32 + 16) * VS_BYTES + 64>(vbase), h11 = tr_read<(KT2 * 32 + 24) * VS_BYTES + 64>(vbase);
        asm volatile("s_waitcnt lgkmcnt(0)" ::: "memory");
        __builtin_amdgcn_sched_barrier(0);
#define PKV(L, H) (bf16x8){L[0], L[1], L[2], L[3], H[0], H[1], H[2], H[3]}
        o[0] = __builtin_amdgcn_mfma_f32_32x32x16_bf16(PKV(l00, h00), pf[0], o[0], 0, 0, 0);
        o[1] = __builtin_amdgcn_mfma_f32_32x32x16_bf16(PKV(l01, h01), pf[0], o[1], 0, 0, 0);
        o[0] = __builtin_amdgcn_mfma_f32_32x32x16_bf16(PKV(l10, h10), pf[1], o[0], 0, 0, 0);
        o[1] = __builtin_amdgcn_mfma_f32_32x32x16_bf16(PKV(l11, h11), pf[1], o[1], 0, 0, 0);
#undef PKV
    }
}

template <int DK, int G, bool WINDOW>
__device__ __forceinline__ void attn_item(const bf16_t* __restrict__ Q, const bf16_t* __restrict__ K, const bf16_t* __restrict__ V, const float* __restrict__ sink,
                                          bf16_t* __restrict__ O, int ocol, int H, int KV, int item, char* lds) {
    constexpr int KS = DK * 2 + 16;
    constexpr int KCH = DK / 8;
    constexpr int KLD = (64 * KCH) / 256;
    constexpr int QB = 128 / G;
    constexpr int NCH = SEQ / QB;
    constexpr int KBUF = 64 * KS, VBUF = 64 * VS_BYTES;
    const int tid = tid_opaque(), lane = tid & 63, wave = tid >> 6;
    const int r32 = lane & 31, hh = lane >> 5;
    const int chunk = item % NCH, kvh = (item / NCH) % KV, b = item / (NCH * KV);
    const int g = (G == 2) ? (wave >> 1) : 0;
    const int qoff = (G == 2) ? (wave & 1) * 32 : wave * 32;
    const int head = kvh * G + g;
    const int q0 = chunk * QB;
    const int qpos = q0 + qoff + r32;
    bf16x8 qf[DK / 16];
    {
        const bf16_t* qp = Q + ((size_t)(b * H + head) * SEQ + qpos) * DK + hh * 8;
#pragma unroll
        for (int ks = 0; ks < DK / 16; ++ks) qf[ks] = *(const bf16x8*)(qp + ks * 16);
    }
    int kt_lo = 0, kt_hi = SEQ / 64;
    if (WINDOW) { kt_lo = q0 / 64 - 2; if (kt_lo < 0) kt_lo = 0; kt_hi = (q0 + QB) / 64 + 2; if (kt_hi > SEQ / 64) kt_hi = SEQ / 64; }
    const char* Kg = (const char*)(K + (size_t)(b * KV + kvh) * SEQ * DK);
    const char* Vg = (const char*)(V + (size_t)(b * KV + kvh) * SEQ * 64);
    uint4 kr[KLD], vr[2];
    int koff[KLD], voff[2];
#pragma unroll
    for (int j = 0; j < KLD; ++j) { const int id = tid + 256 * j; koff[j] = (id / KCH) * KS + (id % KCH) * 16; }
#pragma unroll
    for (int j = 0; j < 2; ++j) { const int id = tid + 256 * j; voff[j] = (id >> 3) * VS_BYTES + (id & 7) * 16; }
    f32x16 o[2];
#pragma unroll
    for (int d = 0; d < 2; ++d)
#pragma unroll
        for (int i = 0; i < 16; ++i) o[d][i] = 0.f;
    float m = -1e30f, l = 0.f;
    if (WINDOW) { m = sink[head] * LOG2E; l = (hh == 0) ? 1.f : 0.f; }
    const int gg = lane >> 4, li = lane & 15;
    const int vlane = (4 * (gg >> 1) + (li >> 2)) * VS_BYTES + (16 * (gg & 1) + 4 * (li & 3)) * 2;
    char* Kl = lds; char* Vl = lds + 2 * KBUF;
    {
        const char* kg = Kg + (size_t)kt_lo * 64 * DK * 2; const char* vg = Vg + (size_t)kt_lo * 64 * 128;
#pragma unroll
        for (int j = 0; j < KLD; ++j) kr[j] = *(const uint4*)(kg + (tid + 256 * j) * 16);
#pragma unroll
        for (int j = 0; j < 2; ++j) vr[j] = *(const uint4*)(vg + (tid + 256 * j) * 16);
#pragma unroll
        for (int j = 0; j < KLD; ++j) *(uint4*)(Kl + koff[j]) = kr[j];
#pragma unroll
        for (int j = 0; j < 2; ++j) *(uint4*)(Vl + voff[j]) = vr[j];
    }
    __syncthreads();
    for (int kt = kt_lo; kt < kt_hi; ++kt) {
        const int cur = (kt - kt_lo) & 1;
        const bool nxt = kt + 1 < kt_hi;
        {
            const int ktn = nxt ? kt + 1 : kt;
            const char* kg = Kg + (size_t)ktn * 64 * DK * 2; const char* vg = Vg + (size_t)ktn * 64 * 128;
#pragma unroll
            for (int j = 0; j < KLD; ++j) kr[j] = *(const uint4*)(kg + (tid + 256 * j) * 16);
#pragma unroll
            for (int j = 0; j < 2; ++j) vr[j] = *(const uint4*)(vg + (tid + 256 * j) * 16);
        }
        const char* kb = Kl + cur * KBUF;
        f32x16 s0, s1;
#pragma unroll
        for (int i = 0; i < 16; ++i) { s0[i] = 0.f; s1[i] = 0.f; }
#pragma unroll
        for (int ks = 0; ks < DK / 16; ++ks) {
            bf16x8 k0 = *(const bf16x8*)(kb + r32 * KS + (ks * 2 + hh) * 16);
            bf16x8 k1 = *(const bf16x8*)(kb + (32 + r32) * KS + (ks * 2 + hh) * 16);
            s0 = __builtin_amdgcn_mfma_f32_32x32x16_bf16(k0, qf[ks], s0, 0, 0, 0);
            s1 = __builtin_amdgcn_mfma_f32_32x32x16_bf16(k1, qf[ks], s1, 0, 0, 0);
        }
        if (WINDOW) {
            const int kb0 = kt * 64 + 4 * hh - qpos;
#pragma unroll
            for (int i = 0; i < 16; ++i) {
                const int d0 = kb0 + (i & 3) + 8 * (i >> 2), d1 = d0 + 32;
                s0[i] = (d0 > 128 || d0 < -128) ? -1e30f : s0[i];
                s1[i] = (d1 > 128 || d1 < -128) ? -1e30f : s1[i];
            }
        }
        float tmax = s0[0];
#pragma unroll
        for (int i = 1; i < 16; ++i) tmax = fmaxf(tmax, s0[i]);
#pragma unroll
        for (int i = 0; i < 16; ++i) tmax = fmaxf(tmax, s1[i]);
        tmax = fmaxf(tmax, xhalf(tmax));
        const float mn = fmaxf(m, tmax);
        const float alpha = __builtin_amdgcn_exp2f(m - mn);
        m = mn;
        float ps = 0.f;
#pragma unroll
        for (int i = 0; i < 16; ++i) { s0[i] = __builtin_amdgcn_exp2f(s0[i] - mn); ps += s0[i]; }
#pragma unroll
        for (int i = 0; i < 16; ++i) { s1[i] = __builtin_amdgcn_exp2f(s1[i] - mn); ps += s1[i]; }
        l = l * alpha + ps;
        if (__any(alpha != 1.f)) {
#pragma unroll
            for (int d = 0; d < 2; ++d)
#pragma unroll
                for (int i = 0; i < 16; ++i) o[d][i] *= alpha;
        }
        const int vbase = (int)(size_t)(Vl + cur * VBUF - lds) + vlane;
        pv_sub<0>(o, s0, vbase);
        pv_sub<1>(o, s1, vbase);
        {
            char* kd = Kl + (cur ^ 1) * KBUF; char* vd = Vl + (cur ^ 1) * VBUF;
#pragma unroll
            for (int j = 0; j < KLD; ++j) *(uint4*)(kd + koff[j]) = kr[j];
#pragma unroll
            for (int j = 0; j < 2; ++j) *(uint4*)(vd + voff[j]) = vr[j];
        }
        __syncthreads();
    }
    l += xhalf(l);
    const float inv = 1.f / l;
    bf16_t* orow = O + (size_t)(b * SEQ + qpos) * DM + ocol + head * 64;
#pragma unroll
    for (int d = 0; d < 2; ++d)
#pragma unroll
        for (int gq = 0; gq < 4; ++gq) {
            uint2 w;
            w.x = cvtpk(o[d][gq * 4 + 0] * inv, o[d][gq * 4 + 1] * inv);
            w.y = cvtpk(o[d][gq * 4 + 2] * inv, o[d][gq * 4 + 3] * inv);
            *(uint2*)(orow + d * 32 + 8 * gq + 4 * hh) = w;
        }
}

__device__ __forceinline__ void dil_wave_item(const bf16_t* __restrict__ Q, const bf16_t* __restrict__ K, const bf16_t* __restrict__ V,
                                              bf16_t* __restrict__ O, int witem, char* wlds, int lds_off) {
    const int lane = tid_opaque() & 63, r32 = lane & 31, hh = lane >> 5;
    const int c = witem & 15, chunk = (witem >> 4) & 15, kvh = (witem >> 8) & 1, b = witem >> 9;
    const int t0 = chunk * 256;
    const int mq = r32 & 15, g = r32 >> 4;
    const int qpos = t0 + 16 * mq + c, head = kvh * 2 + g;
    bf16x8 qf[4];
    {
        const bf16_t* qp = Q + ((size_t)(b * 4 + head) * SEQ + qpos) * 64 + hh * 8;
#pragma unroll
        for (int ks = 0; ks < 4; ++ks) qf[ks] = *(const bf16x8*)(qp + ks * 16);
    }
    const bf16_t* Kg = K + (size_t)(b * 2 + kvh) * SEQ * 64;
    const bf16_t* Vg = V + (size_t)(b * 2 + kvh) * SEQ * 64;
    f32x16 o[2];
#pragma unroll
    for (int d = 0; d < 2; ++d)
#pragma unroll
        for (int i = 0; i < 16; ++i) o[d][i] = 0.f;
    float m = -1e30f, l = 0.f;
    const int gg = lane >> 4, li = lane & 15;
    const int vlane = lds_off + (4 * (gg >> 1) + (li >> 2)) * VS_BYTES + (16 * (gg & 1) + 4 * (li & 3)) * 2;
    for (int it = 0; it < 23; ++it) {
        int sh, j;
        if (it < 12) { sh = 0; j = it; } else if (it < 18) { sh = 2; j = it - 12; } else { sh = 4; j = it - 18; }
        const int rr = 1 << sh;
        const int cc = c & (rr - 1);
        const int idx0 = (t0 >> sh) - 64 + 32 * j;
        const int lim = SEQ >> sh;
        if (idx0 + 31 < 0 || idx0 >= lim) continue;
        bf16x8 kf[4];
        {
            int idx = idx0 + r32; idx = idx < 0 ? 0 : (idx >= lim ? lim - 1 : idx);
            const bf16_t* kp = Kg + (size_t)((idx << sh) + cc) * 64 + hh * 8;
#pragma unroll
            for (int ks = 0; ks < 4; ++ks) kf[ks] = *(const bf16x8*)(kp + ks * 16);
        }
        uint4 vr[4];
#pragma unroll
        for (int jj = 0; jj < 4; ++jj) {
            const int id = lane + 64 * jj; int idx = idx0 + (id >> 3); idx = idx < 0 ? 0 : (idx >= lim ? lim - 1 : idx);
            vr[jj] = *(const uint4*)(Vg + (size_t)((idx << sh) + cc) * 64 + (id & 7) * 8);
        }
#pragma unroll
        for (int jj = 0; jj < 4; ++jj) { const int id = lane + 64 * jj; *(uint4*)(wlds + (id >> 3) * VS_BYTES + (id & 7) * 16) = vr[jj]; }
        f32x16 s;
#pragma unroll
        for (int i = 0; i < 16; ++i) s[i] = 0.f;
#pragma unroll
        for (int ks = 0; ks < 4; ++ks) s = __builtin_amdgcn_mfma_f32_32x32x16_bf16(kf[ks], qf[ks], s, 0, 0, 0);
        const int qidx = qpos >> sh;
        const int base = idx0 + 4 * hh;
#pragma unroll
        for (int i = 0; i < 16; ++i) {
            const int idx = base + (i & 3) + 8 * (i >> 2);
            const int d = idx - qidx;
            s[i] = (d > 64 || d < -64 || idx < 0 || idx >= lim) ? -1e30f : s[i];
        }
        float tmax = s[0];
#pragma unroll
        for (int i = 1; i < 16; ++i) tmax = fmaxf(tmax, s[i]);
        tmax = fmaxf(tmax, xhalf(tmax));
        const float mn = fmaxf(fmaxf(m, tmax), -1e20f);
        const float alpha = __builtin_amdgcn_exp2f(m - mn);
        m = mn;
        float ps = 0.f;
#pragma unroll
        for (int i = 0; i < 16; ++i) { s[i] = __builtin_amdgcn_exp2f(s[i] - mn); ps += s[i]; }
        l = l * alpha + ps;
#pragma unroll
        for (int d = 0; d < 2; ++d)
#pragma unroll
            for (int i = 0; i < 16; ++i) o[d][i] *= alpha;
        pv_sub<0>(o, s, vlane);
    }
    l += xhalf(l);
    const float inv = 1.f / l;
    bf16_t* orow = O + (size_t)(b * SEQ + qpos) * DM + 512 + head * 64;
#pragma unroll
    for (int d = 0; d < 2; ++d)
#pragma unroll
        for (int gq = 0; gq < 4; ++gq) {
            uint2 w;
            w.x = cvtpk(o[d][gq * 4 + 0] * inv, o[d][gq * 4 + 1] * inv);
            w.y = cvtpk(o[d][gq * 4 + 2] * inv, o[d][gq * 4 + 3] * inv);
            *(uint2*)(orow + d * 32 + 8 * gq + 4 * hh) = w;
        }
}

__device__ __forceinline__ int f2key(float f) { int b = __float_as_int(f); return b ^ ((b >> 31) & 0x7fffffff); }
__device__ __forceinline__ float key2f(int k) { return __int_as_float(k ^ ((k >> 31) & 0x7fffffff)); }

template <int N>
__device__ __forceinline__ void bitonic_sort_desc(int (&a)[N]) {
#pragma unroll
    for (int k = 2; k <= N; k <<= 1) {
#pragma unroll
        for (int j = k >> 1; j > 0; j >>= 1) {
#pragma unroll
            for (int i = 0; i < N; ++i) {
                const int l2 = i ^ j;
                if (l2 > i) {
                    const bool up = ((i & k) == 0);
                    const int hi = max(a[i], a[l2]), lo = min(a[i], a[l2]);
                    a[i] = up ? hi : lo; a[l2] = up ? lo : hi;
                }
            }
        }
    }
}
__device__ __forceinline__ void merge_top16(int (&a)[16], const int (&b)[16]) {
#pragma unroll
    for (int i = 0; i < 16; ++i) a[i] = max(a[i], b[15 - i]);
#pragma unroll
    for (int j = 8; j > 0; j >>= 1) {
#pragma unroll
        for (int i = 0; i < 16; ++i) {
            const int l2 = i ^ j;
            if (l2 > i) { const int hi = max(a[i], a[l2]), lo = min(a[i], a[l2]); a[i] = hi; a[l2] = lo; }
        }
    }
}
__device__ __forceinline__ void top16_of_64(int (&g0)[16], int (&g1)[16], int (&g2)[16], int (&g3)[16]) {
    bitonic_sort_desc<16>(g0); bitonic_sort_desc<16>(g1); bitonic_sort_desc<16>(g2); bitonic_sort_desc<16>(g3);
    merge_top16(g0, g1); merge_top16(g2, g3); merge_top16(g0, g2);
}

__device__ __forceinline__ void topk_wave_item(const bf16_t* __restrict__ qp, const bf16_t* __restrict__ subk  ,
                                               int* __restrict__ eidx, float* __restrict__ gate, int witem, char* wlds) {
    const int lane = tid_opaque() & 63, r32 = lane & 31, hh = lane >> 5;
    const int h = witem & 7, tt = witem >> 3;
    const int t = tt * 32 + r32;
    int top[2][16];
#pragma unroll
    for (int c = 0; c < 2; ++c) {
        bf16x8 qf[8];
        const bf16_t* qrow = qp + (size_t)t * 2048 + h * 256 + c * 128 + hh * 8;
#pragma unroll
        for (int ks = 0; ks < 8; ++ks) qf[ks] = *(const bf16x8*)(qrow + ks * 16);
        const bf16_t* kb = subk + ((size_t)(h * 2 + c) * 128 + r32) * 128 + hh * 8;
        int grp[4][16];
#pragma unroll
        for (int kt = 0; kt < 4; ++kt) {
            f32x16 s;
#pragma unroll
            for (int i = 0; i < 16; ++i) s[i] = 0.f;
#pragma unroll
            for (int ks = 0; ks < 8; ++ks) {
                bf16x8 kf = *(const bf16x8*)(kb + (size_t)kt * 32 * 128 + ks * 16);
                s = __builtin_amdgcn_mfma_f32_32x32x16_bf16(kf, qf[ks], s, 0, 0, 0);
            }
#pragma unroll
            for (int i = 0; i < 16; ++i) grp[kt][i] = (f2key(s[i]) & ~127) | (kt * 32 + crow(i, hh));
        }
        top16_of_64(grp[0], grp[1], grp[2], grp[3]);
        int oth[16];
#pragma unroll
        for (int i = 0; i < 16; ++i) oth[i] = __shfl_xor(grp[0][i], 32);
        merge_top16(grp[0], oth);
#pragma unroll
        for (int i = 0; i < 16; ++i) top[c][i] = grp[0][i];
    }
    {
        unsigned* my = (unsigned*)(wlds + lane * 36);
#pragma unroll
        for (int c = 0; c < 2; ++c)
#pragma unroll
            for (int w4 = 0; w4 < 4; ++w4) {
                unsigned v = (top[c][w4 * 4] & 127) | ((top[c][w4 * 4 + 1] & 127) << 8) | ((top[c][w4 * 4 + 2] & 127) << 16) | ((top[c][w4 * 4 + 3] & 127) << 24);
                my[c * 4 + w4] = v;
            }
    }
    float v1[16], v2[16];
#pragma unroll
    for (int i = 0; i < 16; ++i) { v1[i] = key2f(top[0][i] & ~127); v2[i] = key2f(top[1][i] & ~127); }
    int cg[4][16];
    {
        int n = 0;
#pragma unroll
        for (int i = 0; i < 16; ++i)
#pragma unroll
            for (int j = 0; j < 16; ++j)
                if ((i + 1) * (j + 1) <= 16) { cg[n >> 4][n & 15] = (f2key(v1[i] + v2[j]) & ~255) | (i * 16 + j); ++n; }
#pragma unroll
        for (int q = 50; q < 64; ++q) cg[q >> 4][q & 15] = (int)0x80000000;
    }
    top16_of_64(cg[0], cg[1], cg[2], cg[3]);
    float bv[16];
#pragma unroll
    for (int i = 0; i < 16; ++i) bv[i] = key2f(cg[0][i] & ~255);
    float sm = 0.f;
    const float bmx = bv[0];
#pragma unroll
    for (int i = 0; i < 16; ++i) { bv[i] = __expf(bv[i] - bmx); sm += bv[i]; }
    const float inv = 1.f / sm;
    if (hh == 0) {
        const unsigned char* my = (const unsigned char*)(wlds + lane * 36);
        int* eo = eidx + (size_t)t * 128 + h * 16;
        float* go = gate + (size_t)t * 128 + h * 16;
#pragma unroll
        for (int q4 = 0; q4 < 4; ++q4) {
            int4 ev; float4 gv;
            int* evp = (int*)&ev; float* gvp = (float*)&gv;
#pragma unroll
            for (int u = 0; u < 4; ++u) {
                const int code = cg[0][q4 * 4 + u] & 255;
                const int i1 = my[code >> 4], i2 = my[16 + (code & 15)];
                evp[u] = i1 * 128 + i2; gvp[u] = bv[q4 * 4 + u] * inv;
            }
            *(int4*)(eo + q4 * 4) = ev; *(float4*)(go + q4 * 4) = gv;
        }
    }
}

__device__ __forceinline__ float dot8(uint4 u, const unsigned (&h)[4], float acc) {
    acc = __builtin_amdgcn_fdot2_f32_bf16(*(bf16x2_t*)&u.x, *(const bf16x2_t*)&h[0], acc, false);
    acc = __builtin_amdgcn_fdot2_f32_bf16(*(bf16x2_t*)&u.y, *(const bf16x2_t*)&h[1], acc, false);
    acc = __builtin_amdgcn_fdot2_f32_bf16(*(bf16x2_t*)&u.z, *(const bf16x2_t*)&h[2], acc, false);
    acc = __builtin_amdgcn_fdot2_f32_bf16(*(bf16x2_t*)&u.w, *(const bf16x2_t*)&h[3], acc, false);
    return acc;
}
__device__ __forceinline__ void axpy8(float (&acc)[8], float w, uint4 v) {
    acc[0] += w * __uint_as_float(v.x << 16); acc[1] += w * __uint_as_float(v.x & 0xffff0000u);
    acc[2] += w * __uint_as_float(v.y << 16); acc[3] += w * __uint_as_float(v.y & 0xffff0000u);
    acc[4] += w * __uint_as_float(v.z << 16); acc[5] += w * __uint_as_float(v.z & 0xffff0000u);
    acc[6] += w * __uint_as_float(v.w << 16); acc[7] += w * __uint_as_float(v.w & 0xffff0000u);
}
__device__ __forceinline__ float gelu_exact(float a) { return 0.5f * a * (1.f + erff(a * 0.70710678118654752f)); }

__device__ __forceinline__ float transpose_reduce16(float (&p)[16], int lane) {
#pragma unroll
    for (int st = 0; st < 4; ++st) {
        const int o = 32 >> st, n = 16 >> st;
        const bool up = (lane & o) != 0;
#pragma unroll
        for (int i = 0; i < n / 2; ++i) {
            const float keep = up ? p[i + n / 2] : p[i];
            const float send = up ? p[i] : p[i + n / 2];
            p[i] = keep + __shfl_xor(send, o);
        }
    }
    float v = p[0];
    v += __shfl_xor(v, 1); v += __shfl_xor(v, 2);
    return v;
}
__device__ __forceinline__ float udots64(const bf16_t* __restrict__ ub, int eb, const unsigned (&hp)[2][4], int lane) {
    float own = 0.f;
#pragma unroll 1
    for (int gI = 0; gI < 4; ++gI) {
        float pp[16];
#pragma unroll
        for (int e = 0; e < 16; ++e) {
            const int idx = __builtin_amdgcn_readlane(eb, gI * 16 + e);
            const bf16_t* row = ub + (size_t)idx * DM + lane * 8;
            const uint4 u0 = *(const uint4*)row, u1 = *(const uint4*)(row + 512);
            pp[e] = dot8(u1, hp[1], dot8(u0, hp[0], 0.f));
        }
        const float v = transpose_reduce16(pp, lane);
        const float got = __shfl(v, (lane & 15) << 2);
        own = ((lane >> 4) == gI) ? got : own;
    }
    return own;
}

__device__ __forceinline__ void expert_token(const P& p, int layer, int t, bool last) {
    const int lane = tid_opaque() & 63;
    const float* gf = p.g_ffn + layer * DM;
    float* xrow = p.x + (size_t)t * DM;
    float xv[16];
    {
        const float4 a0 = *(const float4*)(xrow + lane * 8), a1 = *(const float4*)(xrow + lane * 8 + 4);
        const float4 b0 = *(const float4*)(xrow + 512 + lane * 8), b1 = *(const float4*)(xrow + 512 + lane * 8 + 4);
        xv[0] = a0.x; xv[1] = a0.y; xv[2] = a0.z; xv[3] = a0.w; xv[4] = a1.x; xv[5] = a1.y; xv[6] = a1.z; xv[7] = a1.w;
        xv[8] = b0.x; xv[9] = b0.y; xv[10] = b0.z; xv[11] = b0.w; xv[12] = b1.x; xv[13] = b1.y; xv[14] = b1.z; xv[15] = b1.w;
    }
    float ss = 0.f;
#pragma unroll
    for (int i = 0; i < 16; ++i) ss += xv[i] * xv[i];
    ss = wave_sum(ss);
    const float rstd = rsqrtf(ss * (1.f / DM) + 1e-6f);
    unsigned hp[2][4];
    {
        float hn[16];
#pragma unroll
        for (int i = 0; i < 8; ++i) { hn[i] = xv[i] * rstd * gf[lane * 8 + i]; hn[8 + i] = xv[8 + i] * rstd * gf[512 + lane * 8 + i]; }
#pragma unroll
        for (int i = 0; i < 4; ++i) { hp[0][i] = cvtpk(hn[2 * i], hn[2 * i + 1]); hp[1][i] = cvtpk(hn[8 + 2 * i], hn[8 + 2 * i + 1]); }
    }
    const int e0 = p.eidx[(size_t)t * 128 + lane], e1 = p.eidx[(size_t)t * 128 + 64 + lane];
    const float g0 = p.gate[(size_t)t * 128 + lane], g1 = p.gate[(size_t)t * 128 + 64 + lane];
    const bf16_t* ub = p.ub + (size_t)layer * 16384 * DM;
    const bf16_t* vb = p.vb + (size_t)layer * 16384 * DM;
    const float w0 = g0 * gelu_exact(udots64(ub, e0, hp, lane));
    const float w1 = g1 * gelu_exact(udots64(ub, e1, hp, lane));
    float acc0[8], acc1[8];
#pragma unroll
    for (int i = 0; i < 8; ++i) { acc0[i] = 0.f; acc1[i] = 0.f; }
#pragma unroll 8
    for (int e = 0; e < 64; ++e) {
        const int idx = __builtin_amdgcn_readlane(e0, e);
        const float w = __int_as_float(__builtin_amdgcn_readlane(__float_as_int(w0), e));
        const bf16_t* row = vb + (size_t)idx * DM + lane * 8;
        const uint4 u0 = *(const uint4*)row, u1 = *(const uint4*)(row + 512);
        axpy8(acc0, w, u0); axpy8(acc1, w, u1);
    }
#pragma unroll 8
    for (int e = 0; e < 64; ++e) {
        const int idx = __builtin_amdgcn_readlane(e1, e);
        const float w = __int_as_float(__builtin_amdgcn_readlane(__float_as_int(w1), e));
        const bf16_t* row = vb + (size_t)idx * DM + lane * 8;
        const uint4 u0 = *(const uint4*)row, u1 = *(const uint4*)(row + 512);
        axpy8(acc0, w, u0); axpy8(acc1, w, u1);
    }
#pragma unroll
    for (int i = 0; i < 8; ++i) { xv[i] += acc0[i]; xv[8 + i] += acc1[i]; }
    float s2 = 0.f;
#pragma unroll
    for (int i = 0; i < 16; ++i) s2 += xv[i] * xv[i];
    s2 = wave_sum(s2);
    const float r2 = rsqrtf(s2 * (1.f / DM) + 1e-6f);
    if (!last) {
        *(float4*)(xrow + lane * 8) = make_float4(xv[0], xv[1], xv[2], xv[3]);
        *(float4*)(xrow + lane * 8 + 4) = make_float4(xv[4], xv[5], xv[6], xv[7]);
        *(float4*)(xrow + 512 + lane * 8) = make_float4(xv[8], xv[9], xv[10], xv[11]);
        *(float4*)(xrow + 512 + lane * 8 + 4) = make_float4(xv[12], xv[13], xv[14], xv[15]);
        const float* gn = p.g_mix + (layer + 1) * DM;
        uint4 wa, wb;
        wa.x = cvtpk(xv[0] * r2 * gn[lane * 8 + 0], xv[1] * r2 * gn[lane * 8 + 1]); wa.y = cvtpk(xv[2] * r2 * gn[lane * 8 + 2], xv[3] * r2 * gn[lane * 8 + 3]);
        wa.z = cvtpk(xv[4] * r2 * gn[lane * 8 + 4], xv[5] * r2 * gn[lane * 8 + 5]); wa.w = cvtpk(xv[6] * r2 * gn[lane * 8 + 6], xv[7] * r2 * gn[lane * 8 + 7]);
        wb.x = cvtpk(xv[8] * r2 * gn[512 + lane * 8 + 0], xv[9] * r2 * gn[512 + lane * 8 + 1]); wb.y = cvtpk(xv[10] * r2 * gn[512 + lane * 8 + 2], xv[11] * r2 * gn[512 + lane * 8 + 3]);
        wb.z = cvtpk(xv[12] * r2 * gn[512 + lane * 8 + 4], xv[13] * r2 * gn[512 + lane * 8 + 5]); wb.w = cvtpk(xv[14] * r2 * gn[512 + lane * 8 + 6], xv[15] * r2 * gn[512 + lane * 8 + 7]);
        *(uint4*)(p.hnb + (size_t)t * DM + lane * 8) = wa;
        *(uint4*)(p.hnb + (size_t)t * DM + 512 + lane * 8) = wb;
    } else {
        const float* gn = p.g_final;
        float* orow = p.out + (size_t)t * DM;
        *(float4*)(orow + lane * 8) = make_float4(xv[0] * r2 * gn[lane * 8 + 0], xv[1] * r2 * gn[lane * 8 + 1], xv[2] * r2 * gn[lane * 8 + 2], xv[3] * r2 * gn[lane * 8 + 3]);
        *(float4*)(orow + lane * 8 + 4) = make_float4(xv[4] * r2 * gn[lane * 8 + 4], xv[5] * r2 * gn[lane * 8 + 5], xv[6] * r2 * gn[lane * 8 + 6], xv[7] * r2 * gn[lane * 8 + 7]);
        *(float4*)(orow + 512 + lane * 8) = make_float4(xv[8] * r2 * gn[512 + lane * 8 + 0], xv[9] * r2 * gn[512 + lane * 8 + 1], xv[10] * r2 * gn[512 + lane * 8 + 2], xv[11] * r2 * gn[512 + lane * 8 + 3]);
        *(float4*)(orow + 512 + lane * 8 + 4) = make_float4(xv[12] * r2 * gn[512 + lane * 8 + 4], xv[13] * r2 * gn[512 + lane * 8 + 5], xv[14] * r2 * gn[512 + lane * 8 + 6], xv[15] * r2 * gn[512 + lane * 8 + 7]);
    }
}
__device__ __forceinline__ void transpose_tile(const float* __restrict__ src, int K, int N, bf16_t* __restrict__ dst, int tk, int tn, float* tl) {
    const int tid = tid_opaque(), r = tid >> 6, c = tid & 63;
    const int k0 = tk * 64, n0 = tn * 64;
#pragma unroll
    for (int i = 0; i < 16; ++i) {
        const int kk = i * 4 + r, n = n0 + c;
        tl[kk * 65 + c] = (n < N) ? src[(size_t)(k0 + kk) * N + n] : 0.f;
    }
    __syncthreads();
#pragma unroll
    for (int i = 0; i < 16; ++i) {
        const int nn = i * 4 + r;
        if (n0 + nn < N) dst[(size_t)(n0 + nn) * K + k0 + c] = f2bf(tl[c * 65 + nn]);
    }
    __syncthreads();
}
__device__ __forceinline__ void transpose_all(const float* src, int K, int N, bf16_t* dst, float* tl) {
    const int ntk = K / 64, ntn = (N + 63) / 64;
    for (int t = blockIdx.x; t < ntk * ntn; t += gridDim.x) transpose_tile(src, K, N, dst, t / ntn, t % ntn, tl);
}
__device__ __forceinline__ void convert_plain(const float* __restrict__ src, bf16_t* __restrict__ dst, size_t n) {
    const size_t n8 = n >> 3;
    for (size_t i = (size_t)blockIdx.x * blockDim.x + tid_opaque(); i < n8; i += (size_t)gridDim.x * blockDim.x) {
        const float4 a = *(const float4*)(src + i * 8), b = *(const float4*)(src + i * 8 + 4);
        uint4 w; w.x = cvtpk(a.x, a.y); w.y = cvtpk(a.z, a.w); w.z = cvtpk(b.x, b.y); w.w = cvtpk(b.z, b.w);
        *(uint4*)(dst + i * 8) = w;
    }
}
__device__ __forceinline__ void rms_row_bf16(const float* __restrict__ src, const float* __restrict__ g, bf16_t* __restrict__ dst, float* __restrict__ cpy, int lane) {
    float xv[16];
    const float4 a0 = *(const float4*)(src + lane * 8), a1 = *(const float4*)(src + lane * 8 + 4);
    const float4 b0 = *(const float4*)(src + 512 + lane * 8), b1 = *(const float4*)(src + 512 + lane * 8 + 4);
    xv[0] = a0.x; xv[1] = a0.y; xv[2] = a0.z; xv[3] = a0.w; xv[4] = a1.x; xv[5] = a1.y; xv[6] = a1.z; xv[7] = a1.w;
    xv[8] = b0.x; xv[9] = b0.y; xv[10] = b0.z; xv[11] = b0.w; xv[12] = b1.x; xv[13] = b1.y; xv[14] = b1.z; xv[15] = b1.w;
    if (cpy) {
        *(float4*)(cpy + lane * 8) = a0; *(float4*)(cpy + lane * 8 + 4) = a1;
        *(float4*)(cpy + 512 + lane * 8) = b0; *(float4*)(cpy + 512 + lane * 8 + 4) = b1;
    }
    float ss = 0.f;
#pragma unroll
    for (int i = 0; i < 16; ++i) ss += xv[i] * xv[i];
    ss = wave_sum(ss);
    const float r = rsqrtf(ss * (1.f / DM) + 1e-6f);
    const float4 g0 = *(const float4*)(g + lane * 8), g1 = *(const float4*)(g + lane * 8 + 4);
    const float4 g2 = *(const float4*)(g + 512 + lane * 8), g3 = *(const float4*)(g + 512 + lane * 8 + 4);
    uint4 wa, wb;
    wa.x = cvtpk(xv[0] * r * g0.x, xv[1] * r * g0.y); wa.y = cvtpk(xv[2] * r * g0.z, xv[3] * r * g0.w);
    wa.z = cvtpk(xv[4] * r * g1.x, xv[5] * r * g1.y); wa.w = cvtpk(xv[6] * r * g1.z, xv[7] * r * g1.w);
    wb.x = cvtpk(xv[8] * r * g2.x, xv[9] * r * g2.y); wb.y = cvtpk(xv[10] * r * g2.z, xv[11] * r * g2.w);
    wb.z = cvtpk(xv[12] * r * g3.x, xv[13] * r * g3.y); wb.w = cvtpk(xv[14] * r * g3.z, xv[15] * r * g3.w);
    *(uint4*)(dst + lane * 8) = wa; *(uint4*)(dst + 512 + lane * 8) = wb;
}

__device__ __forceinline__ void phase_pro(const P& p, char* lds) {
    float* tl = (float*)lds;
    for (int l = 0; l < DEPTH; ++l) {
        transpose_all(p.w_in + (size_t)l * DM * NZ, DM, NZ, p.winT + (size_t)l * NZ * DM, tl);
        transpose_all(p.w_out + (size_t)l * DM * DM, DM, DM, p.woutT + (size_t)l * DM * DM, tl);
        transpose_all(p.peer_w_q + (size_t)l * DM * 2048, DM, 2048, p.wqT + (size_t)l * 2048 * DM, tl);
        transpose_all(p.mla_w_uq + (size_t)l * 256 * 384, 256, 384, p.wuqT + (size_t)l * 384 * 256, tl);
        transpose_all(p.mla_w_ukv + (size_t)l * 128 * 512, 128, 512, p.wukvT + (size_t)l * 512 * 128, tl);
    }
    convert_plain(p.peer_sub_keys, p.subk, (size_t)DEPTH * 8 * 2 * 128 * 128);
    if (p.flags & 1) {
        convert_plain(p.peer_u, p.ub, (size_t)DEPTH * 16384 * DM);
        convert_plain(p.peer_v, p.vb, (size_t)DEPTH * 16384 * DM);
    }
    for (int i = blockIdx.x * blockDim.x + tid_opaque(); i < 4096 * 32; i += gridDim.x * blockDim.x) {
        {
            const int pos = i / 32, j = i % 32;
            const float inv = powf(10000.f, -(float)(2 * j) / 64.f); const float ang = (float)pos * inv;
            p.tb.cos1[i] = cosf(ang); p.tb.sin1[i] = sinf(ang);
        }
        if (i < 4096 * 16) {
            const int pos = i / 16, j = i % 16;
            const float inv = powf(10000.f, -(float)(2 * j) / 32.f); const float ang = (float)pos * inv;
            p.tb.cosm[i] = cosf(ang); p.tb.sinm[i] = sinf(ang);
        }
        if (i < 64 * 16) {
            const int pos = i / 16, j = i % 16;
            const float inv = powf(10000.f, -(float)(2 * j) / 32.f); const float ang = (float)pos * inv;
            p.tb.cosr[i] = cosf(ang); p.tb.sinr[i] = sinf(ang); p.tb.cosc[i] = cosf(ang); p.tb.sinc[i] = sinf(ang);
        }
    }
    const int wave = tid_opaque() >> 6, lane = tid_opaque() & 63;
    for (int t = blockIdx.x * 4 + wave; t < T_TOK; t += gridDim.x * 4)
        rms_row_bf16(p.x_in + (size_t)t * DM, p.g_mix, p.hnb + (size_t)t * DM, p.x + (size_t)t * DM, lane);
}

__device__ __forceinline__ void phase_g1(const P& p, int l, char* lds) {
    EpiStoreBf16 e{p.zb, NZ, NZ};
    gemm_phase(p.hnb, DM, p.winT + (size_t)l * NZ * DM, DM, T_TOK, NZ, DM, lds, e);
}

__device__ __forceinline__ void phase_post(const P& p, int l, char* lds) {
    float* zr = (float*)lds;
    float* hs = zr + 2048;
    const int tid = tid_opaque(), wave = tid >> 6, lane = tid & 63;
    const float* g_qn = p.ax_q_norm + l * 64; const float* g_kn = p.ax_k_norm + l * 64;
    const float* g_cq = p.mla_q_norm + l * 256; const float* g_ckv = p.mla_kv_norm + l * 128;
    const float scA = 0.125f * LOG2E;
    for (int t = blockIdx.x; t < T_TOK; t += gridDim.x) {
        const int b = t / SEQ, s = t % SEQ;
        if (tid < 244) {
            const uint4 w = *(const uint4*)(p.zb + (size_t)t * NZ + tid * 8);
            float* d = zr + tid * 8;
            d[0] = __uint_as_float(w.x << 16); d[1] = __uint_as_float(w.x & 0xffff0000u);
            d[2] = __uint_as_float(w.y << 16); d[3] = __uint_as_float(w.y & 0xffff0000u);
            d[4] = __uint_as_float(w.z << 16); d[5] = __uint_as_float(w.z & 0xffff0000u);
            d[6] = __uint_as_float(w.w << 16); d[7] = __uint_as_float(w.w & 0xffff0000u);
        }
        __syncthreads();
#pragma unroll
        for (int rr = 0; rr < 2; ++rr) {
            const int r = wave + 4 * rr;
            int base, n;
            if (r < 4) { base = 512 + r * 64; n = 64; } else if (r < 6) { base = 768 + (r - 4) * 64; n = 64; } else if (r == 6) { base = 1536; n = 256; } else { base = 1792; n = 128; }
            float ss = 0.f;
            for (int i = lane; i < n; i += 64) ss += zr[base + i] * zr[base + i];
            ss = wave_sum(ss);
            if (lane == 0) hs[r] = rsqrtf(ss / (float)n + 1e-6f);
        }
        __syncthreads();
#pragma unroll
        for (int mix = 0; mix < 2; ++mix) {
            const int zb = mix == 0 ? 0 : 1024;
            bf16_t* qo = mix == 0 ? p.q.qA : p.q.qC; bf16_t* ko = mix == 0 ? p.q.kA : p.q.kC; bf16_t* vo = mix == 0 ? p.q.vA : p.q.vC;
            if (tid < 128) {
                const int h = tid / 32, j = tid % 32;
                const float x1 = zr[zb + h * 64 + j], x2 = zr[zb + h * 64 + 32 + j];
                const float c = p.tb.cos1[s * 32 + j], sn = p.tb.sin1[s * 32 + j];
                const size_t ob = ((size_t)(b * 4 + h) * SEQ + s) * 64;
                qo[ob + j] = f2bf((x1 * c - x2 * sn) * scA); qo[ob + 32 + j] = f2bf((x2 * c + x1 * sn) * scA);
            } else if (tid < 192) {
                const int i = tid - 128, h = i / 32, j = i % 32;
                const float x1 = zr[zb + 256 + h * 64 + j], x2 = zr[zb + 256 + h * 64 + 32 + j];
                const float c = p.tb.cos1[s * 32 + j], sn = p.tb.sin1[s * 32 + j];
                const size_t ob = ((size_t)(b * 2 + h) * SEQ + s) * 64;
                ko[ob + j] = f2bf(x1 * c - x2 * sn); ko[ob + 32 + j] = f2bf(x2 * c + x1 * sn);
            } else {
                const int i = (tid - 192) * 2, h = i / 64, j = i % 64;
                const unsigned w = cvtpk(zr[zb + 384 + i], zr[zb + 384 + i + 1]);
                *(unsigned*)(vo + ((size_t)(b * 2 + h) * SEQ + s) * 64 + j) = w;
            }
        }
        {
            const int row = s / 64, col = s % 64;
            if (tid < 192) {
                const int hh = tid / 32, r = tid % 32, half = r / 16, j = r % 16;
                const bool isq = hh < 4;
                const int zb = isq ? 512 + hh * 64 : 768 + (hh - 4) * 64;
                const float* gn = isq ? g_qn : g_kn;
                const float rstd = hs[hh];
                const int d1 = half * 32 + j, d2 = half * 32 + 16 + j;
                const float x1 = zr[zb + d1] * rstd * gn[d1], x2 = zr[zb + d2] * rstd * gn[d2];
                float c, sn;
                if (half == 0) { c = p.tb.cosr[row * 16 + j]; sn = p.tb.sinr[row * 16 + j]; } else { c = p.tb.cosc[col * 16 + j]; sn = p.tb.sinc[col * 16 + j]; }
                const float o1 = x1 * c - x2 * sn, o2 = x2 * c + x1 * sn;
                if (isq) { const size_t ob = ((size_t)(b * 4 + hh) * SEQ + s) * 64; p.q.qB[ob + d1] = f2bf(o1 * scA); p.q.qB[ob + d2] = f2bf(o2 * scA); }
                else { const size_t ob = ((size_t)(b * 2 + (hh - 4)) * SEQ + s) * 64; p.q.kB[ob + d1] = f2bf(o1); p.q.kB[ob + d2] = f2bf(o2); }
            } else {
                const int i = (tid - 192) * 2, h = i / 64, j = i % 64;
                const unsigned w = cvtpk(zr[896 + i], zr[896 + i + 1]);
                *(unsigned*)(p.q.vB + ((size_t)(b * 2 + h) * SEQ + s) * 64 + j) = w;
            }
        }
        p.cqn[(size_t)t * 256 + tid] = f2bf(zr[1536 + tid] * hs[6] * g_cq[tid]);
        if (tid < 128) p.ckvn[(size_t)t * 128 + tid] = f2bf(zr[1792 + tid] * hs[7] * g_ckv[tid]);
        else if (tid < 144) {
            const int i = tid - 128;
            const float x1 = zr[1920 + i], x2 = zr[1920 + 16 + i];
            const float c = p.tb.cosm[s * 16 + i], sn = p.tb.sinm[s * 16 + i];
            const bf16_t o1 = f2bf(x1 * c - x2 * sn), o2 = f2bf(x2 * c + x1 * sn);
#pragma unroll
            for (int h = 0; h < 4; ++h) { const size_t ob = ((size_t)(b * 4 + h) * SEQ + s) * 96; p.q.kD[ob + 64 + i] = o1; p.q.kD[ob + 80 + i] = o2; }
        }
        __syncthreads();
    }
}

__device__ __forceinline__ void phase_mla(const P& p, int l, char* lds) {
    { EpiStoreBf16 e{p.qfull, 384, 384}; gemm_phase(p.cqn, 256, p.wuqT + (size_t)l * 384 * 256, 256, T_TOK, 384, 256, lds, e); }
    { EpiStoreBf16 e{p.kvfull, 512, 512}; gemm_phase(p.ckvn, 128, p.wukvT + (size_t)l * 512 * 128, 128, T_TOK, 512, 128, lds, e); }
}

__device__ __forceinline__ void phase_postmla(const P& p, int l) {
    const int tid = tid_opaque();
    const float scD = 0.10206207261596575f * LOG2E;
    for (int t = blockIdx.x; t < T_TOK; t += gridDim.x) {
        const int b = t / SEQ, s = t % SEQ;
        {
            const int h = tid / 64, j = tid % 64;
            p.q.qD[((size_t)(b * 4 + h) * SEQ + s) * 96 + j] = f2bf(bf2f(p.qfull[(size_t)t * 384 + h * 96 + j]) * scD);
            p.q.kD[((size_t)(b * 4 + h) * SEQ + s) * 96 + j] = p.kvfull[(size_t)t * 512 + h * 128 + j];
            p.q.vD[((size_t)(b * 4 + h) * SEQ + s) * 64 + j] = p.kvfull[(size_t)t * 512 + h * 128 + 64 + j];
        }
        if (tid < 64) {
            const int h = tid / 16, j = tid % 16;
            const float x1 = bf2f(p.qfull[(size_t)t * 384 + h * 96 + 64 + j]), x2 = bf2f(p.qfull[(size_t)t * 384 + h * 96 + 80 + j]);
            const float c = p.tb.cosm[s * 16 + j], sn = p.tb.sinm[s * 16 + j];
            const size_t ob = ((size_t)(b * 4 + h) * SEQ + s) * 96;
            p.q.qD[ob + 64 + j] = f2bf((x1 * c - x2 * sn) * scD); p.q.qD[ob + 80 + j] = f2bf((x2 * c + x1 * sn) * scD);
        }
    }
}

__device__ __forceinline__ void phase_att(const P& p, int l, char* lds) {
    for (int it = blockIdx.x; it < 1024; it += gridDim.x) attn_item<96, 1, false>(p.q.qD, p.q.kD, p.q.vD, nullptr, p.ob, 768, 4, 4, it, lds);
    for (int it = blockIdx.x; it < 1024; it += gridDim.x) attn_item<64, 2, false>(p.q.qB, p.q.kB, p.q.vB, nullptr, p.ob, 256, 4, 2, it, lds);
    for (int it = blockIdx.x; it < 1024; it += gridDim.x) attn_item<64, 2, true>(p.q.qA, p.q.kA, p.q.vA, p.win_sink + l * 4, p.ob, 0, 4, 2, it, lds);
    {
        const int wave = tid_opaque() >> 6;
        char* wl = lds + wave * 6144;
        const int off = (int)(uintptr_t)wl;
        for (int wi = blockIdx.x * 4 + wave; wi < 4096; wi += gridDim.x * 4) dil_wave_item(p.q.qC, p.q.kC, p.q.vC, p.ob, wi, wl, off);
    }
}

__device__ __forceinline__ void phase_gn(const P& p, int l) {
    const int wave = tid_opaque() >> 6, lane = tid_opaque() & 63;
    const float* gg = p.g_group + (size_t)l * 1024;
    for (int t = blockIdx.x * 4 + wave; t < T_TOK; t += gridDim.x * 4) {
#pragma unroll
        for (int g = 0; g < 4; ++g) {
            const uint2 w = *(const uint2*)(p.ob + (size_t)t * DM + g * 256 + lane * 4);
            const float v0 = __uint_as_float(w.x << 16), v1 = __uint_as_float(w.x & 0xffff0000u), v2 = __uint_as_float(w.y << 16), v3 = __uint_as_float(w.y & 0xffff0000u);
            float ss = v0 * v0 + v1 * v1 + v2 * v2 + v3 * v3;
            ss = wave_sum(ss);
            const float r = rsqrtf(ss * (1.f / 256.f) + 1e-6f);
            const float4 g4 = *(const float4*)(gg + g * 256 + lane * 4);
            uint2 o; o.x = cvtpk(v0 * r * g4.x, v1 * r * g4.y); o.y = cvtpk(v2 * r * g4.z, v3 * r * g4.w);
            *(uint2*)(p.hnb + (size_t)t * DM + g * 256 + lane * 4) = o;
        }
    }
}
__device__ __forceinline__ void phase_g2(const P& p, int l, char* lds) {
    EpiResidF32 e{p.x, DM};
    gemm_phase(p.hnb, DM, p.woutT + (size_t)l * DM * DM, DM, T_TOK, DM, DM, lds, e);
}
__device__ __forceinline__ void phase_n2(const P& p, int l) {
    const int wave = tid_opaque() >> 6, lane = tid_opaque() & 63;
    for (int t = blockIdx.x * 4 + wave; t < T_TOK; t += gridDim.x * 4)
        rms_row_bf16(p.x + (size_t)t * DM, p.g_ffn + l * DM, p.hnb + (size_t)t * DM, nullptr, lane);
}
__device__ __forceinline__ void phase_g3(const P& p, int l, char* lds) {
    EpiStoreBf16 e{p.qp, 2048, 2048};
    gemm_phase(p.hnb, DM, p.wqT + (size_t)l * 2048 * DM, DM, T_TOK, 2048, DM, lds, e);
}
__device__ __forceinline__ void phase_topk(const P& p, int l, char* lds) {
    const int wave = tid_opaque() >> 6;
    char* wl = lds + wave * 2304;
    const bf16_t* sk = p.subk + (size_t)l * 8 * 2 * 128 * 128;
    for (int wi = blockIdx.x * 4 + wave; wi < 8192; wi += gridDim.x * 4) topk_wave_item(p.qp, sk, p.eidx, p.gate, wi, wl);
}
__device__ __forceinline__ void phase_exp(const P& p, int l) {
    const int wave = tid_opaque() >> 6;
    for (int t = blockIdx.x * 4 + wave; t < T_TOK; t += gridDim.x * 4) expert_token(p, l, t, l == DEPTH - 1);
}

template <int PH>
__global__ void __launch_bounds__(256, 2) k_phase(P p, int l) {
    extern __shared__ __attribute__((aligned(16))) char lds[];
    if (PH == 0) phase_pro(p, lds);
    if (PH == 1) phase_g1(p, l, lds);
    if (PH == 2) phase_post(p, l, lds);
    if (PH == 3) phase_mla(p, l, lds);
    if (PH == 4) phase_postmla(p, l);
    if (PH == 5) phase_att(p, l, lds);
    if (PH == 6) phase_gn(p, l);
    if (PH == 7) phase_g2(p, l, lds);
    if (PH == 8) phase_n2(p, l);
    if (PH == 9) phase_g3(p, l, lds);
    if (PH == 10) phase_topk(p, l, lds);
    if (PH == 11) phase_exp(p, l);
    if (PH == 12) { const int wave = tid_opaque() >> 6, lane = tid_opaque() & 63; for (int t = blockIdx.x * 4 + wave; t < T_TOK; t += gridDim.x * 4) rms_row_bf16(p.x + (size_t)t * DM, p.g_mix + l * DM, p.hnb + (size_t)t * DM, nullptr, lane); }
}
#define XB_TMO      128
#define XB_XCNT(j)  (256  + 64 * (j))
#define XB_XSUB(j)  (1280 + 64 * (j))
#define XB_XGEN(j)  (2304 + 64 * (j))
#define XB_TOP      3328
#define XB_TOPGEN   3392
#define XCD_BAR_WORDS 3456
#define XB_SPIN_CAP (1u << 18)
#define LAS __attribute__((address_space(3)))

__device__ __forceinline__ unsigned xb_ld(unsigned* p)              { return __hip_atomic_load(p, __ATOMIC_RELAXED, __HIP_MEMORY_SCOPE_AGENT); }
__device__ __forceinline__ unsigned xb_add(unsigned* p, unsigned v) { return __hip_atomic_fetch_add(p, v, __ATOMIC_RELAXED, __HIP_MEMORY_SCOPE_AGENT); }
__device__ __forceinline__ unsigned xb_xcc_id() { return (unsigned)__builtin_amdgcn_s_getreg((3 << 11) | 20) & 0xFu; }
#define XB_SPIN(cond, bar) do { unsigned _sp = 0; while (cond) { __builtin_amdgcn_s_sleep(1); \
    if ((++_sp & 255u) == 0u) { if (xb_ld(&(bar)[XB_TMO])) break; if (_sp > XB_SPIN_CAP) { atomicAdd(&(bar)[XB_TMO], 1u); break; } } } } while (0)

struct XcdBarrier {
    unsigned* bar; unsigned x;
    volatile LAS unsigned* st;
};

__device__ __forceinline__ XcdBarrier xcd_barrier_post(unsigned* bar, volatile LAS unsigned* st) {
    XcdBarrier b; b.bar = bar; b.x = xb_xcc_id(); b.st = st;
    if (threadIdx.x == 0) (void)xb_add(&bar[XB_XCNT(b.x)], 1u);
    return b;
}
__device__ __forceinline__ void xcd_barrier_complete(unsigned* bar, unsigned x, unsigned& nloc, unsigned& nx) {
    const unsigned G = gridDim.x * gridDim.y * gridDim.z;
    unsigned sum, cnt, mine, sp = 0u;
    for (;;) {
        sum = 0u; cnt = 0u; mine = 0u;
#pragma unroll
        for (unsigned j = 0; j < 16; ++j) { const unsigned c = xb_ld(&bar[XB_XCNT(j)]); sum += c; cnt += (c > 0u) ? 1u : 0u; mine = (j == x) ? c : mine; }
        if (sum == G) break;
        __builtin_amdgcn_s_sleep(1);
        if ((++sp & 255u) == 0u) { if (xb_ld(&bar[XB_TMO])) break; if (sp > XB_SPIN_CAP) { atomicAdd(&bar[XB_TMO], 1u); break; } }
    }
    nloc = mine > 0u ? mine : 1u; nx = cnt > 0u ? cnt : 1u;
}

__device__ __forceinline__ void xcd_barrier(const XcdBarrier& b) {
    asm volatile("s_waitcnt vmcnt(0)" ::: "memory");
    __syncthreads();
    if (threadIdx.x == 0) {
        unsigned* bar = b.bar;
        __builtin_amdgcn_s_waitcnt(0);
        unsigned nloc = b.st[0], nx = b.st[1];
        if (nloc == 0u) { xcd_barrier_complete(bar, b.x, nloc, nx); b.st[0] = nloc; b.st[1] = nx; }
        const unsigned old = xb_add(&bar[XB_XSUB(b.x)], 1u);
        const unsigned gen = old / nloc;
        if (old + 1u == (gen + 1u) * nloc) {
            __builtin_amdgcn_fence(__ATOMIC_RELEASE, "agent");
            asm volatile("s_waitcnt vmcnt(0)" ::: "memory");
            const unsigned og = xb_add(&bar[XB_TOP], 1u);
            const unsigned tg = og / nx;
            if (og + 1u == (tg + 1u) * nx) xb_add(&bar[XB_TOPGEN], 1u);
            else XB_SPIN(xb_ld(&bar[XB_TOPGEN]) == tg, bar);
            __builtin_amdgcn_fence(__ATOMIC_ACQUIRE, "agent");
            xb_add(&bar[XB_XGEN(b.x)], 1u);
            asm volatile("s_waitcnt vmcnt(0)" ::: "memory");
        } else {
            XB_SPIN(xb_ld(&bar[XB_XGEN(b.x)]) == gen, bar);
            __builtin_amdgcn_fence(__ATOMIC_ACQUIRE, "agent");
            asm volatile("s_waitcnt vmcnt(0)" ::: "memory");
        }
    }
    __syncthreads();
}


__global__ void __launch_bounds__(256, 2) k_mega(P p) {
    extern __shared__ __attribute__((aligned(16))) char lds[];
    uint4* xbw = (uint4*)(lds + LDS_BYTES);
    if (threadIdx.x == 0) *xbw = make_uint4(0u, 0u, 0u, 0u);
    __syncthreads();
    XcdBarrier bar = xcd_barrier_post(p.bar, (volatile LAS unsigned*)xbw);
    phase_pro(p, lds); xcd_barrier(bar);
    for (int l = 0; l < DEPTH; ++l) {
        phase_g1(p, l, lds); xcd_barrier(bar);
        phase_post(p, l, lds); xcd_barrier(bar);
        phase_mla(p, l, lds); xcd_barrier(bar);
        phase_postmla(p, l); xcd_barrier(bar);
        phase_att(p, l, lds); xcd_barrier(bar);
        phase_gn(p, l); xcd_barrier(bar);
        phase_g2(p, l, lds); xcd_barrier(bar);
        phase_n2(p, l); xcd_barrier(bar);
        phase_g3(p, l, lds); xcd_barrier(bar);
        phase_topk(p, l, lds); xcd_barrier(bar);
        phase_exp(p, l);
        if (l + 1 < DEPTH) xcd_barrier(bar);
    }
}
#ifndef OPT_MASK
#define OPT_MASK 0x7f
#endif
#ifndef MEGA
#define MEGA 1
#endif
static inline size_t align_up(size_t v, size_t a) { return (v + a - 1) / a * a; }
#define DYN_LDS (LDS_BYTES + 64)

template <int PH> static void launch_phase(const P& p, int l, hipStream_t stream) {
    static bool attr_done = false;
    if (!attr_done) { (void)hipFuncSetAttribute((const void*)k_phase<PH>, hipFuncAttributeMaxDynamicSharedMemorySize, DYN_LDS); attr_done = true; }
    k_phase<PH><<<512, 256, DYN_LDS, stream>>>(p, l);
}

extern "C" void kernel_launch(void* const* d_in, const int* in_sizes, int n_in, void* d_out, int out_size, void* d_ws, size_t ws_size,
                              hipStream_t stream) {
    P p{};
    p.x_in = (const float*)d_in[0]; p.g_mix = (const float*)d_in[1]; p.w_in = (const float*)d_in[2]; p.win_sink = (const float*)d_in[3];
    p.ax_q_norm = (const float*)d_in[4]; p.ax_k_norm = (const float*)d_in[5]; p.mla_q_norm = (const float*)d_in[6]; p.mla_kv_norm = (const float*)d_in[7];
    p.mla_w_uq = (const float*)d_in[8]; p.mla_w_ukv = (const float*)d_in[9]; p.g_group = (const float*)d_in[10]; p.w_out = (const float*)d_in[11];
    p.g_ffn = (const float*)d_in[12]; p.peer_w_q = (const float*)d_in[13]; p.peer_sub_keys = (const float*)d_in[14]; p.peer_u = (const float*)d_in[15];
    p.peer_v = (const float*)d_in[16]; p.g_final = (const float*)d_in[17];
    p.out = (float*)d_out;

    char* w = (char*)d_ws; size_t off = 0;
    auto carve = [&](size_t bytes) { void* q = w + off; off = align_up(off + bytes, 256); return q; };
    p.bar = (unsigned*)carve(16384);
    p.x = (float*)carve((size_t)T_TOK * DM * 4);
    p.hnb = (bf16_t*)carve((size_t)T_TOK * DM * 2);
    char* regZ = (char*)carve((size_t)T_TOK * 2048 * 2);
    p.zb = (bf16_t*)regZ; p.qp = (bf16_t*)regZ;
    p.qfull = (bf16_t*)regZ; p.kvfull = (bf16_t*)(regZ + (size_t)T_TOK * 384 * 2);
    QKV& q = p.q;
    q.qA = (bf16_t*)carve((size_t)T_TOK * 256 * 2); q.kA = (bf16_t*)carve((size_t)T_TOK * 128 * 2); q.vA = (bf16_t*)carve((size_t)T_TOK * 128 * 2);
    q.qB = (bf16_t*)carve((size_t)T_TOK * 256 * 2); q.kB = (bf16_t*)carve((size_t)T_TOK * 128 * 2); q.vB = (bf16_t*)carve((size_t)T_TOK * 128 * 2);
    q.qC = (bf16_t*)carve((size_t)T_TOK * 256 * 2); q.kC = (bf16_t*)carve((size_t)T_TOK * 128 * 2); q.vC = (bf16_t*)carve((size_t)T_TOK * 128 * 2);
    q.qD = (bf16_t*)carve((size_t)T_TOK * 384 * 2); q.kD = (bf16_t*)carve((size_t)T_TOK * 384 * 2); q.vD = (bf16_t*)carve((size_t)T_TOK * 256 * 2);
    p.ob = (bf16_t*)carve((size_t)T_TOK * DM * 2);
    p.cqn = p.ob; p.ckvn = p.ob + (size_t)T_TOK * 256;
    p.eidx = (int*)carve((size_t)T_TOK * 128 * 4);
    p.gate = (float*)carve((size_t)T_TOK * 128 * 4);
    p.winT = (bf16_t*)carve((size_t)DEPTH * NZ * DM * 2);
    p.woutT = (bf16_t*)carve((size_t)DEPTH * DM * DM * 2);
    p.wqT = (bf16_t*)carve((size_t)DEPTH * 2048 * DM * 2);
    p.subk = (bf16_t*)carve((size_t)DEPTH * 8 * 2 * 128 * 128 * 2);
    p.wuqT = (bf16_t*)carve((size_t)DEPTH * 384 * 256 * 2);
    p.wukvT = (bf16_t*)carve((size_t)DEPTH * 512 * 128 * 2);
    if (OPT_MASK & 64) {
        p.ub = (bf16_t*)carve((size_t)DEPTH * 16384 * DM * 2);
        p.vb = (bf16_t*)carve((size_t)DEPTH * 16384 * DM * 2);
        p.flags = 1;
    }
    Tables& tb = p.tb;
    tb.cos1 = (float*)carve(4096 * 32 * 4); tb.sin1 = (float*)carve(4096 * 32 * 4);
    tb.cosm = (float*)carve(4096 * 16 * 4); tb.sinm = (float*)carve(4096 * 16 * 4);
    tb.cosr = (float*)carve(64 * 16 * 4); tb.sinr = (float*)carve(64 * 16 * 4);
    tb.cosc = (float*)carve(64 * 16 * 4); tb.sinc = (float*)carve(64 * 16 * 4);
    float* hn = nullptr; float *cqn_f = nullptr, *ckvn_f = nullptr, *qfull_f = nullptr, *kvfull_f = nullptr;
    if (OPT_MASK != 0x7f) {
        hn = (float*)carve((size_t)T_TOK * DM * 4);
        cqn_f = (float*)carve((size_t)T_TOK * 256 * 4); ckvn_f = (float*)carve((size_t)T_TOK * 128 * 4);
        qfull_f = (float*)carve((size_t)T_TOK * 384 * 4); kvfull_f = hn;
    }
    if (off > ws_size) { fprintf(stderr, "workspace too small: need %zu have %zu\n", off, ws_size); return; }

#if MEGA
    {
        static int grid = 0;
        if (!grid) {
            int dev = 0, cus = 0, per_cu = 0;
            (void)hipGetDevice(&dev);
            (void)hipDeviceGetAttribute(&cus, hipDeviceAttributeMultiprocessorCount, dev);
            (void)hipFuncSetAttribute((const void*)k_mega, hipFuncAttributeMaxDynamicSharedMemorySize, DYN_LDS);
            (void)hipOccupancyMaxActiveBlocksPerMultiprocessor(&per_cu, k_mega, 256, DYN_LDS);
            if (per_cu < 1) per_cu = 1;
            grid = cus * (per_cu < 2 ? per_cu : 2);
        }
        (void)hipMemsetAsync(p.bar, 0, XCD_BAR_WORDS * sizeof(unsigned), stream);
        k_mega<<<grid, 256, DYN_LDS, stream>>>(p);
        return;
    }
#endif
    const float* x_in = p.x_in; float* x = p.x; float* out = p.out;
    launch_phase<0>(p, 0, stream);

    for (int l = 0; l < DEPTH; ++l) {
        if (OPT_MASK & 1) {
            if (l > 0 && !(OPT_MASK & 64)) launch_phase<12>(p, l, stream);
            launch_phase<1>(p, l, stream);
        } else {
            k_rmsnorm_f32<<<T_TOK / 4, 256, 0, stream>>>(x, p.g_mix + l * DM, hn, T_TOK);
            k_ngemm<float, bf16_t, false><<<dim3((NZ + 127) / 128, T_TOK / 128), 256, 0, stream>>>(hn, DM, p.w_in + (size_t)l * DM * NZ, NZ, p.zb, NZ, nullptr, 0, T_TOK, NZ, DM);
        }
        if (OPT_MASK & 2) {
            launch_phase<2>(p, l, stream); launch_phase<3>(p, l, stream); launch_phase<4>(p, l, stream);
        } else {
            PostArgs pa; pa.z = p.zb; pa.o = q; pa.tb = tb;
            pa.g_qn = p.ax_q_norm + l * 64; pa.g_kn = p.ax_k_norm + l * 64; pa.g_cq = p.mla_q_norm + l * 256; pa.g_ckv = p.mla_kv_norm + l * 128;
            pa.cqn = cqn_f; pa.ckvn = ckvn_f;
            k_post_naive<<<T_TOK, 256, 0, stream>>>(pa);
            k_ngemm<float, float, false><<<dim3(384 / 128, T_TOK / 128), 256, 0, stream>>>(cqn_f, 256, p.mla_w_uq + (size_t)l * 256 * 384, 384, qfull_f, 384, nullptr, 0, T_TOK, 384, 256);
            k_ngemm<float, float, false><<<dim3(512 / 128, T_TOK / 128), 256, 0, stream>>>(ckvn_f, 128, p.mla_w_ukv + (size_t)l * 128 * 512, 512, kvfull_f, 512, nullptr, 0, T_TOK, 512, 128);
            k_post_mla<<<T_TOK, 256, 0, stream>>>(qfull_f, kvfull_f, q, tb);
        }
        if (OPT_MASK & 4) {
            launch_phase<5>(p, l, stream);
        } else {
            k_attn_naive<64, 1><<<NBATCH * 4 * SEQ / 4, 256, 0, stream>>>(q.qA, q.kA, q.vA, p.win_sink + l * 4, p.ob, 4, 2, 0);
            k_attn_naive<64, 0><<<NBATCH * 4 * SEQ / 4, 256, 0, stream>>>(q.qB, q.kB, q.vB, nullptr, p.ob, 4, 2, 256);
            k_attn_naive<64, 2><<<NBATCH * 4 * SEQ / 4, 256, 0, stream>>>(q.qC, q.kC, q.vC, nullptr, p.ob, 4, 2, 512);
            k_attn_naive<96, 0><<<NBATCH * 4 * SEQ / 4, 256, 0, stream>>>(q.qD, q.kD, q.vD, nullptr, p.ob, 4, 4, 768);
        }
        if (OPT_MASK & 8) {
            launch_phase<6>(p, l, stream); launch_phase<7>(p, l, stream);
        } else {
            k_groupnorm_f32<<<T_TOK / 4, 256, 0, stream>>>(p.ob, p.g_group + (size_t)l * 1024, hn);
            k_ngemm<float, float, true><<<dim3(DM / 128, T_TOK / 128), 256, 0, stream>>>(hn, DM, p.w_out + (size_t)l * DM * DM, DM, x, DM, x, DM, T_TOK, DM, DM);
        }
        if (OPT_MASK & 16) {
            launch_phase<8>(p, l, stream); launch_phase<9>(p, l, stream);
            if (!(OPT_MASK & 64)) k_rmsnorm_f32<<<T_TOK / 4, 256, 0, stream>>>(x, p.g_ffn + l * DM, hn, T_TOK);
        } else {
            k_rmsnorm_f32<<<T_TOK / 4, 256, 0, stream>>>(x, p.g_ffn + l * DM, hn, T_TOK);
            k_ngemm<float, bf16_t, false><<<dim3(2048 / 128, T_TOK / 128), 256, 0, stream>>>(hn, DM, p.peer_w_q + (size_t)l * DM * 2048, 2048, p.qp, 2048, nullptr, 0, T_TOK, 2048, DM);
        }
        if (OPT_MASK & 32) launch_phase<10>(p, l, stream);
        else k_peer_topk_naive<<<T_TOK * 8, 64, 0, stream>>>(p.qp, p.peer_sub_keys + (size_t)l * 8 * 2 * 128 * 128, p.eidx, p.gate);
        if (OPT_MASK & 64) launch_phase<11>(p, l, stream);
        else {
            k_peer_expert_naive<<<T_TOK, 256, 0, stream>>>(hn, p.eidx, p.gate, p.peer_u + (size_t)l * 16384 * DM, p.peer_v + (size_t)l * 16384 * DM, x);
            if (l == DEPTH - 1) k_rmsnorm_f32<<<T_TOK / 4, 256, 0, stream>>>(x, p.g_final, out, T_TOK);
        }
    }
    (void)x_in; (void)in_sizes; (void)n_in; (void)out_size;
}
```

```cpp
#include <hip/hip_runtime.h>
#include <stdint.h>
#include <stdio.h>

typedef unsigned short bf16_t;

#define T_TOK 32768
#define SEQ 4096
#define NBATCH 8
#define DM 1024
#define NZ 1952
#define DEPTH 4
#define LOG2E 1.4426950408889634f

__device__ __forceinline__ float bf2f(bf16_t v) { return __uint_as_float(((unsigned)v) << 16); }
__device__ __forceinline__ bf16_t f2bf(float f) {
    unsigned u = __float_as_uint(f);
    u += 0x7fffu + ((u >> 16) & 1u);
    return (bf16_t)(u >> 16);
}
__device__ __forceinline__ float wave_sum(float v) {
#pragma unroll
    for (int o = 32; o >= 1; o >>= 1) v += __shfl_xor(v, o);
    return v;
}
__device__ __forceinline__ float wave_max(float v) {
#pragma unroll
    for (int o = 32; o >= 1; o >>= 1) v = fmaxf(v, __shfl_xor(v, o));
    return v;
}

struct Tables { float *cos1, *sin1, *cosm, *sinm, *cosr, *sinr, *cosc, *sinc; };

__global__ void k_tables(Tables tb) {
    int i = blockIdx.x * blockDim.x + threadIdx.x;
    if (i < 4096 * 32) {
        int pos = i / 32, j = i % 32;
        float inv = powf(10000.f, -(float)(2 * j) / 64.f);
        float ang = (float)pos * inv;
        tb.cos1[i] = cosf(ang); tb.sin1[i] = sinf(ang);
    }
    if (i < 4096 * 16) {
        int pos = i / 16, j = i % 16;
        float inv = powf(10000.f, -(float)(2 * j) / 32.f);
        float ang = (float)pos * inv;
        tb.cosm[i] = cosf(ang); tb.sinm[i] = sinf(ang);
    }
    if (i < 64 * 16) {
        int pos = i / 16, j = i % 16;
        float inv = powf(10000.f, -(float)(2 * j) / 32.f);
        float ang = (float)pos * inv;
        tb.cosr[i] = cosf(ang); tb.sinr[i] = sinf(ang);
        tb.cosc[i] = cosf(ang); tb.sinc[i] = sinf(ang);
    }
}

__global__ void __launch_bounds__(256) k_rmsnorm_f32(const float* __restrict__ x, const float* __restrict__ g, float* __restrict__ out, int rows) {
    int row = blockIdx.x * 4 + (threadIdx.x >> 6), lane = threadIdx.x & 63;
    if (row >= rows) return;
    const float4* xr = (const float4*)(x + (size_t)row * DM);
    float4 v[4]; float ss = 0.f;
#pragma unroll
    for (int i = 0; i < 4; ++i) { v[i] = xr[lane + 64 * i]; ss += v[i].x * v[i].x + v[i].y * v[i].y + v[i].z * v[i].z + v[i].w * v[i].w; }
    ss = wave_sum(ss);
    float rstd = rsqrtf(ss * (1.f / DM) + 1e-6f);
    float4* orow = (float4*)(out + (size_t)row * DM);
    const float4* g4 = (const float4*)g;
#pragma unroll
    for (int i = 0; i < 4; ++i) {
        float4 gg = g4[lane + 64 * i]; float4 o;
        o.x = v[i].x * rstd * gg.x; o.y = v[i].y * rstd * gg.y; o.z = v[i].z * rstd * gg.z; o.w = v[i].w * rstd * gg.w;
        orow[lane + 64 * i] = o;
    }
}

__global__ void __launch_bounds__(256) k_groupnorm_f32(const bf16_t* __restrict__ o, const float* __restrict__ gg, float* __restrict__ out) {
    int row = blockIdx.x * 4 + (threadIdx.x >> 6), lane = threadIdx.x & 63;
    const bf16_t* orow = o + (size_t)row * DM;
#pragma unroll
    for (int g = 0; g < 4; ++g) {
        float v[4]; float ss = 0.f;
#pragma unroll
        for (int i = 0; i < 4; ++i) { v[i] = bf2f(orow[g * 256 + lane + 64 * i]); ss += v[i] * v[i]; }
        ss = wave_sum(ss);
        float rstd = rsqrtf(ss * (1.f / 256.f) + 1e-6f);
#pragma unroll
        for (int i = 0; i < 4; ++i) out[(size_t)row * DM + g * 256 + lane + 64 * i] = v[i] * rstd * gg[g * 256 + lane + 64 * i];
    }
}

template <typename AT> __device__ __forceinline__ float ldA(const AT* p);
template <> __device__ __forceinline__ float ldA<float>(const float* p) { return *p; }
template <> __device__ __forceinline__ float ldA<bf16_t>(const bf16_t* p) { return bf2f(*p); }
__device__ __forceinline__ void stC(float* p, float v) { *p = v; }
__device__ __forceinline__ void stC(bf16_t* p, float v) { *p = f2bf(v); }

template <typename AT, typename CT, bool RES>
__global__ void __launch_bounds__(256) k_ngemm(const AT* __restrict__ A, int lda, const float* __restrict__ B, int ldb,
                                               CT* C, int ldc, const float* R, int ldr, int M, int N, int K) {
    __shared__ float As[16][132];
    __shared__ float Bs[16][132];
    const int tid = threadIdx.x, tx = tid & 15, ty = tid >> 4;
    const int m0 = blockIdx.y * 128, n0 = blockIdx.x * 128;
    float acc[8][8];
#pragma unroll
    for (int i = 0; i < 8; ++i)
#pragma unroll
        for (int j = 0; j < 8; ++j) acc[i][j] = 0.f;
    const int ar = tid >> 1, ak = (tid & 1) * 8;
    const int bk = tid >> 4, bn = (tid & 15) * 8;
    for (int k0 = 0; k0 < K; k0 += 16) {
#pragma unroll
        for (int i = 0; i < 8; ++i) As[ak + i][ar] = ldA<AT>(A + (size_t)(m0 + ar) * lda + k0 + ak + i);
#pragma unroll
        for (int i = 0; i < 8; ++i) { int n = n0 + bn + i; Bs[bk][bn + i] = (n < N) ? B[(size_t)(k0 + bk) * ldb + n] : 0.f; }
        __syncthreads();
#pragma unroll
        for (int kk = 0; kk < 16; ++kk) {
            float a[8], b[8];
#pragma unroll
            for (int i = 0; i < 8; ++i) a[i] = As[kk][ty * 8 + i];
#pragma unroll
            for (int j = 0; j < 8; ++j) b[j] = Bs[kk][tx * 8 + j];
#pragma unroll
            for (int i = 0; i < 8; ++i)
#pragma unroll
                for (int j = 0; j < 8; ++j) acc[i][j] += a[i] * b[j];
        }
        __syncthreads();
    }
#pragma unroll
    for (int i = 0; i < 8; ++i) {
        int m = m0 + ty * 8 + i;
#pragma unroll
        for (int j = 0; j < 8; ++j) {
            int n = n0 + tx * 8 + j;
            if (n < N) {
                float v = acc[i][j];
                if (RES) v += R[(size_t)m * ldr + n];
                stC(C + (size_t)m * ldc + n, v);
            }
        }
    }
}

struct QKV {
    bf16_t *qA, *kA, *vA, *qB, *kB, *vB, *qC, *kC, *vC, *qD, *kD, *vD;
};
struct PostArgs {
    const bf16_t* z; QKV o; Tables tb;
    const float *g_qn, *g_kn, *g_cq, *g_ckv;
    float *cqn, *ckvn;
};

__global__ void __launch_bounds__(256) k_post_naive(PostArgs a) {
    __shared__ float zr[NZ];
    __shared__ float hs[8];
    const int t = blockIdx.x, tid = threadIdx.x;
    const int b = t / SEQ, s = t % SEQ;
    for (int i = tid; i < NZ; i += 256) zr[i] = bf2f(a.z[(size_t)t * NZ + i]);
    __syncthreads();
    if (tid < 8) {
        int base, n;
        if (tid < 4) { base = 512 + tid * 64; n = 64; }
        else if (tid < 6) { base = 768 + (tid - 4) * 64; n = 64; }
        else if (tid == 6) { base = 1536; n = 256; }
        else { base = 1792; n = 128; }
        float ss = 0.f;
        for (int i = 0; i < n; ++i) ss += zr[base + i] * zr[base + i];
        hs[tid] = rsqrtf(ss / (float)n + 1e-6f);
    }
    __syncthreads();
    const float scA = 0.125f * LOG2E;
    const float scD = 0.10206207261596575f * LOG2E;
    for (int mix = 0; mix < 2; ++mix) {
        const int zb = mix == 0 ? 0 : 1024;
        bf16_t* qo = mix == 0 ? a.o.qA : a.o.qC;
        bf16_t* ko = mix == 0 ? a.o.kA : a.o.kC;
        bf16_t* vo = mix == 0 ? a.o.vA : a.o.vC;
        for (int i = tid; i < 128; i += 256) {
            int h = i / 32, j = i % 32;
            float x1 = zr[zb + h * 64 + j], x2 = zr[zb + h * 64 + 32 + j];
            float c = a.tb.cos1[s * 32 + j], sn = a.tb.sin1[s * 32 + j];
            size_t ob = ((size_t)(b * 4 + h) * SEQ + s) * 64;
            qo[ob + j] = f2bf((x1 * c - x2 * sn) * scA);
            qo[ob + 32 + j] = f2bf((x2 * c + x1 * sn) * scA);
        }
        for (int i = tid; i < 64; i += 256) {
            int h = i / 32, j = i % 32;
            float x1 = zr[zb + 256 + h * 64 + j], x2 = zr[zb + 256 + h * 64 + 32 + j];
            float c = a.tb.cos1[s * 32 + j], sn = a.tb.sin1[s * 32 + j];
            size_t ob = ((size_t)(b * 2 + h) * SEQ + s) * 64;
            ko[ob + j] = f2bf(x1 * c - x2 * sn);
            ko[ob + 32 + j] = f2bf(x2 * c + x1 * sn);
        }
        for (int i = tid; i < 128; i += 256) {
            int h = i / 64, j = i % 64;
            vo[((size_t)(b * 2 + h) * SEQ + s) * 64 + j] = f2bf(zr[zb + 384 + i]);
        }
    }
    {
        const int row = s / 64, col = s % 64;
        for (int i = tid; i < 192; i += 256) {
            int hh = i / 32, r = i % 32, half = r / 16, j = r % 16;
            bool isq = hh < 4;
            int zb = isq ? 512 + hh * 64 : 768 + (hh - 4) * 64;
            const float* gn = isq ? a.g_qn : a.g_kn;
            float rstd = hs[hh];
            int d1 = half * 32 + j, d2 = half * 32 + 16 + j;
            float x1 = zr[zb + d1] * rstd * gn[d1], x2 = zr[zb + d2] * rstd * gn[d2];
            float c, sn;
            if (half == 0) { c = a.tb.cosr[row * 16 + j]; sn = a.tb.sinr[row * 16 + j]; }
            else { c = a.tb.cosc[col * 16 + j]; sn = a.tb.sinc[col * 16 + j]; }
            float o1 = x1 * c - x2 * sn, o2 = x2 * c + x1 * sn;
            if (isq) {
                size_t ob = ((size_t)(b * 4 + hh) * SEQ + s) * 64;
                a.o.qB[ob + d1] = f2bf(o1 * scA); a.o.qB[ob + d2] = f2bf(o2 * scA);
            } else {
                size_t ob = ((size_t)(b * 2 + (hh - 4)) * SEQ + s) * 64;
                a.o.kB[ob + d1] = f2bf(o1); a.o.kB[ob + d2] = f2bf(o2);
            }
        }
        for (int i = tid; i < 128; i += 256) {
            int h = i / 64, j = i % 64;
            a.o.vB[((size_t)(b * 2 + h) * SEQ + s) * 64 + j] = f2bf(zr[896 + i]);
        }
    }
    for (int i = tid; i < 256; i += 256) a.cqn[(size_t)t * 256 + i] = zr[1536 + i] * hs[6] * a.g_cq[i];
    for (int i = tid; i < 128; i += 256) a.ckvn[(size_t)t * 128 + i] = zr[1792 + i] * hs[7] * a.g_ckv[i];
    for (int i = tid; i < 16; i += 256) {
        float x1 = zr[1920 + i], x2 = zr[1920 + 16 + i];
        float c = a.tb.cosm[s * 16 + i], sn = a.tb.sinm[s * 16 + i];
        bf16_t o1 = f2bf(x1 * c - x2 * sn), o2 = f2bf(x2 * c + x1 * sn);
        for (int h = 0; h < 4; ++h) {
            size_t ob = ((size_t)(b * 4 + h) * SEQ + s) * 96;
            a.o.kD[ob + 64 + i] = o1; a.o.kD[ob + 80 + i] = o2;
        }
    }
    (void)scD;
}

__global__ void __launch_bounds__(256) k_post_mla(const float* __restrict__ qfull, const float* __restrict__ kvfull, QKV o, Tables tb) {
    const int t = blockIdx.x, tid = threadIdx.x;
    const int b = t / SEQ, s = t % SEQ;
    const float scD = 0.10206207261596575f * LOG2E;
    {
        int h = tid / 64, j = tid % 64;
        o.qD[((size_t)(b * 4 + h) * SEQ + s) * 96 + j] = f2bf(qfull[(size_t)t * 384 + h * 96 + j] * scD);
    }
    if (tid < 64) {
        int h = tid / 16, j = tid % 16;
        float x1 = qfull[(size_t)t * 384 + h * 96 + 64 + j], x2 = qfull[(size_t)t * 384 + h * 96 + 80 + j];
        float c = tb.cosm[s * 16 + j], sn = tb.sinm[s * 16 + j];
        size_t ob = ((size_t)(b * 4 + h) * SEQ + s) * 96;
        o.qD[ob + 64 + j] = f2bf((x1 * c - x2 * sn) * scD);
        o.qD[ob + 80 + j] = f2bf((x2 * c + x1 * sn) * scD);
    }
    {
        int h = tid / 64, j = tid % 64;
        o.kD[((size_t)(b * 4 + h) * SEQ + s) * 96 + j] = f2bf(kvfull[(size_t)t * 512 + h * 128 + j]);
        o.vD[((size_t)(b * 4 + h) * SEQ + s) * 64 + j] = f2bf(kvfull[(size_t)t * 512 + h * 128 + 64 + j]);
    }
}

template <int DK, int MODE>
__global__ void __launch_bounds__(256) k_attn_naive(const bf16_t* __restrict__ Q, const bf16_t* __restrict__ K, const bf16_t* __restrict__ V,
                                                    const float* __restrict__ sink, bf16_t* __restrict__ O, int H, int KV, int ocol) {
    const int wave = threadIdx.x >> 6, lane = threadIdx.x & 63;
    const int gq = blockIdx.x * 4 + wave;
    const int s = gq % SEQ, bh = gq / SEQ, h = bh % H, b = bh / H;
    const int kvh = h / (H / KV);
    const bf16_t* qrow = Q + (size_t)gq * DK;
    const bf16_t* Kb = K + (size_t)(b * KV + kvh) * SEQ * DK;
    const bf16_t* Vb = V + (size_t)(b * KV + kvh) * SEQ * 64;
    const int sub = lane & 7, grp = lane >> 3;
    constexpr int NCH = DK / 8;
    float q0[8], q1[8];
    {
        uint4 r = *(const uint4*)(qrow + sub * 8);
        const bf16_t* p = (const bf16_t*)&r;
#pragma unroll
        for (int i = 0; i < 8; ++i) q0[i] = bf2f(p[i]);
        const bool has1 = (NCH > 8) && (sub + 8 < NCH);
        uint4 r1 = make_uint4(0, 0, 0, 0);
        if (has1) r1 = *(const uint4*)(qrow + (sub + 8) * 8);
        const bf16_t* p1 = (const bf16_t*)&r1;
#pragma unroll
        for (int i = 0; i < 8; ++i) q1[i] = bf2f(p1[i]);
    }
    float m = -1e30f, l = 0.f, acc[8];
#pragma unroll
    for (int i = 0; i < 8; ++i) acc[i] = 0.f;
    if (MODE == 1 && grp == 0) { m = sink[h] * LOG2E; l = 1.f; }
    const int nk = MODE == 0 ? SEQ : (MODE == 1 ? 257 : 387);
    for (int base = 0; base < nk; base += 8) {
        const int kk = base + grp;
        bool valid = kk < nk;
        int tok;
        if (MODE == 0) tok = kk;
        else if (MODE == 1) tok = s - 128 + kk;
        else { int p = kk / 129, j = kk % 129; int r = p == 0 ? 1 : (p == 1 ? 4 : 16); tok = s + (j - 64) * r; }
        valid = valid && tok >= 0 && tok < SEQ;
        float sc = 0.f;
        if (valid) {
            uint4 r = *(const uint4*)(Kb + (size_t)tok * DK + sub * 8);
            const bf16_t* p = (const bf16_t*)&r;
#pragma unroll
            for (int i = 0; i < 8; ++i) sc += q0[i] * bf2f(p[i]);
            if (NCH > 8 && sub + 8 < NCH) {
                uint4 r1 = *(const uint4*)(Kb + (size_t)tok * DK + (sub + 8) * 8);
                const bf16_t* p1 = (const bf16_t*)&r1;
#pragma unroll
                for (int i = 0; i < 8; ++i) sc += q1[i] * bf2f(p1[i]);
            }
        }
        sc += __shfl_xor(sc, 1); sc += __shfl_xor(sc, 2); sc += __shfl_xor(sc, 4);
        if (valid) {
            float mn = fmaxf(m, sc);
            float f = exp2f(m - mn), p = exp2f(sc - mn);
            uint4 r = *(const uint4*)(Vb + (size_t)tok * 64 + sub * 8);
            const bf16_t* pv = (const bf16_t*)&r;
            l = l * f + p;
#pragma unroll
            for (int i = 0; i < 8; ++i) acc[i] = acc[i] * f + p * bf2f(pv[i]);
            m = mn;
        }
    }
    float M = m;
    M = fmaxf(M, __shfl_xor(M, 8)); M = fmaxf(M, __shfl_xor(M, 16)); M = fmaxf(M, __shfl_xor(M, 32));
    float f = exp2f(m - M);
    l *= f;
    l += __shfl_xor(l, 8); l += __shfl_xor(l, 16); l += __shfl_xor(l, 32);
#pragma unroll
    for (int i = 0; i < 8; ++i) {
        float v = acc[i] * f;
        v += __shfl_xor(v, 8); v += __shfl_xor(v, 16); v += __shfl_xor(v, 32);
        acc[i] = v;
    }
    if (grp == 0) {
        const int t = b * SEQ + s;
        float inv = 1.f / l;
#pragma unroll
        for (int i = 0; i < 8; ++i) O[(size_t)t * DM + ocol + h * 64 + sub * 8 + i] = f2bf(acc[i] * inv);
    }
}

__global__ void __launch_bounds__(64) k_peer_topk_naive(const bf16_t* __restrict__ qp, const float* __restrict__ subk  ,
                                                        int* __restrict__ eidx, float* __restrict__ gate) {
    __shared__ float qs[256];
    __shared__ float s12[2][16];
    __shared__ int i12[2][16];
    const int t = blockIdx.x >> 3, h = blockIdx.x & 7, lane = threadIdx.x;
    for (int i = lane; i < 256; i += 64) qs[i] = bf2f(qp[(size_t)t * 2048 + h * 256 + i]);
    __syncthreads();
    float sc[2][2];
#pragma unroll
    for (int c = 0; c < 2; ++c)
#pragma unroll
        for (int u = 0; u < 2; ++u) {
            int n = lane + 64 * u;
            const float* kr = subk + ((size_t)(h * 2 + c) * 128 + n) * 128;
            float a = 0.f;
            for (int d = 0; d < 128; ++d) a += qs[c * 128 + d] * kr[d];
            sc[c][u] = a;
        }
#pragma unroll
    for (int c = 0; c < 2; ++c) {
        for (int r = 0; r < 16; ++r) {
            float bv; int bi;
            if (sc[c][0] >= sc[c][1]) { bv = sc[c][0]; bi = lane; } else { bv = sc[c][1]; bi = lane + 64; }
#pragma unroll
            for (int o = 32; o >= 1; o >>= 1) {
                float ov = __shfl_xor(bv, o); int oi = __shfl_xor(bi, o);
                if (ov > bv || (ov == bv && oi < bi)) { bv = ov; bi = oi; }
            }
            if (bi == lane) sc[c][0] = -3e38f;
            if (bi == lane + 64) sc[c][1] = -3e38f;
            if (lane == 0) { s12[c][r] = bv; i12[c][r] = bi; }
        }
    }
    __syncthreads();
    float cv[4]; int ci[4];
#pragma unroll
    for (int u = 0; u < 4; ++u) {
        int id = lane + 64 * u;
        cv[u] = s12[0][id / 16] + s12[1][id % 16];
        ci[u] = i12[0][id / 16] * 128 + i12[1][id % 16];
    }
    float best = 0.f; int be = 0;
    for (int r = 0; r < 16; ++r) {
        float bv = cv[0]; int bu = 0;
#pragma unroll
        for (int u = 1; u < 4; ++u) if (cv[u] > bv) { bv = cv[u]; bu = u; }
        int bid = lane + 64 * bu;
#pragma unroll
        for (int o = 32; o >= 1; o >>= 1) {
            float ov = __shfl_xor(bv, o); int oi = __shfl_xor(bid, o);
            if (ov > bv || (ov == bv && oi < bid)) { bv = ov; bid = oi; }
        }
        int e = 0;
#pragma unroll
        for (int u = 0; u < 4; ++u) if (bid == lane + 64 * u) { cv[u] = -3e38f; e = ci[u]; }
        e = __shfl(e, bid & 63);
        if (lane == r) { best = bv; be = e; }
    }
    float mx = lane < 16 ? best : -3e38f;
    mx = wave_max(mx);
    float ex = lane < 16 ? expf(best - mx) : 0.f;
    float sm = wave_sum(ex);
    if (lane < 16) {
        eidx[(size_t)t * 128 + h * 16 + lane] = be;
        gate[(size_t)t * 128 + h * 16 + lane] = ex / sm;
    }
}

__global__ void __launch_bounds__(256) k_peer_expert_naive(const float* __restrict__ hn, const int* __restrict__ eidx, const float* __restrict__ gate,
                                                           const float* __restrict__ ut, const float* __restrict__ vt, float* __restrict__ x) {
    __shared__ float hs[DM];
    __shared__ float wg[128];
    __shared__ int es[128];
    const int t = blockIdx.x, tid = threadIdx.x, wave = tid >> 6, lane = tid & 63;
    for (int i = tid; i < DM; i += 256) hs[i] = hn[(size_t)t * DM + i];
    if (tid < 128) es[tid] = eidx[(size_t)t * 128 + tid];
    __syncthreads();
    for (int p = wave * 32; p < wave * 32 + 32; ++p) {
        const float* ur = ut + (size_t)es[p] * DM;
        float a = 0.f;
#pragma unroll
        for (int i = 0; i < 16; ++i) a += ur[lane + 64 * i] * hs[lane + 64 * i];
        a = wave_sum(a);
        if (lane == 0) {
            float ge = 0.5f * a * (1.f + erff(a * 0.70710678118654752f));
            wg[p] = gate[(size_t)t * 128 + p] * ge;
        }
    }
    __syncthreads();
    float o[4] = {0.f, 0.f, 0.f, 0.f};
    for (int p = 0; p < 128; ++p) {
        const float* vr = vt + (size_t)es[p] * DM;
        float w = wg[p];
#pragma unroll
        for (int i = 0; i < 4; ++i) o[i] += w * vr[tid + 256 * i];
    }
#pragma unroll
    for (int i = 0; i < 4; ++i) x[(size_t)t * DM + tid + 256 * i] += o[i];
}

using bf16x8 = __attribute__((ext_vector_type(8))) short;
using s16x4 = __attribute__((ext_vector_type(4))) short;
using f32x16 = __attribute__((ext_vector_type(16))) float;
typedef __attribute__((ext_vector_type(2))) __bf16 bf16x2_t;

#define NBLK_THREADS 256
#define LDS_BYTES 65536

__device__ __forceinline__ unsigned cvtpk(float lo, float hi) {
    unsigned r; asm volatile("v_cvt_pk_bf16_f32 %0, %1, %2" : "=v"(r) : "v"(lo), "v"(hi)); return r;
}
__device__ __forceinline__ int tid_opaque() { int t = threadIdx.x; asm volatile("" : "+v"(t)); return t; }
__device__ __forceinline__ int crow(int i, int hh) { return (i & 3) + 8 * (i >> 2) + 4 * hh; }
__device__ __forceinline__ float xhalf(float v) { return __shfl_xor(v, 32); }

struct P {
    const float *x_in, *g_mix, *w_in, *win_sink, *ax_q_norm, *ax_k_norm, *mla_q_norm, *mla_kv_norm, *mla_w_uq, *mla_w_ukv, *g_group, *w_out,
        *g_ffn, *peer_w_q, *peer_sub_keys, *peer_u, *peer_v, *g_final;
    float* out;
    float* x; bf16_t* hnb; bf16_t* zb; QKV q; bf16_t* ob; bf16_t* qp; int* eidx; float* gate;
    bf16_t *cqn, *ckvn, *qfull, *kvfull;
    bf16_t *winT, *woutT, *wqT, *subk, *wuqT, *wukvT;
    unsigned char *u8, *v8; float *su, *sv;
    Tables tb;
    unsigned* bar;
    int flags; int pad0;
};
typedef const P __attribute__((address_space(4))) PC;
__device__ __forceinline__ PC* kargs() { PC* q = (PC*)__builtin_amdgcn_kernarg_segment_ptr(); asm volatile("" : "+s"(q)); return q; }

struct EpiStoreBf16 {
    bf16_t* C; int ldc; int N;
    __device__ __forceinline__ void operator()(const f32x16 (&acc)[2][2], int mbase, int nbase, int r32, int hh) const {
#pragma unroll
        for (int mt = 0; mt < 2; ++mt)
#pragma unroll
            for (int nt = 0; nt < 2; ++nt) {
                const int n = nbase + nt * 32 + r32;
                if (n < N) {
#pragma unroll
                    for (int i = 0; i < 16; ++i) {
                        const int m = mbase + mt * 32 + crow(i, hh);
                        C[(size_t)m * ldc + n] = f2bf(acc[mt][nt][i]);
                    }
                }
            }
    }
};
struct EpiResidF32 {
    float* X; int ldx;
    __device__ __forceinline__ void operator()(const f32x16 (&acc)[2][2], int mbase, int nbase, int r32, int hh) const {
#pragma unroll
        for (int mt = 0; mt < 2; ++mt)
#pragma unroll
            for (int nt = 0; nt < 2; ++nt) {
                const int n = nbase + nt * 32 + r32;
#pragma unroll
                for (int i = 0; i < 16; ++i) {
                    const int m = mbase + mt * 32 + crow(i, hh);
                    float* p = X + (size_t)m * ldx + n;
                    *p = *p + acc[mt][nt][i];
                }
            }
    }
};

template <class Epi>
__device__ __forceinline__ void gemm_tile(const bf16_t* __restrict__ X, int ldx, const bf16_t* __restrict__ W, int ldw, int K, int m0, int n0, int N,
                                          char* lds, const Epi& epi) {
    const int tid = tid_opaque(), lane = tid & 63, wave = tid >> 6;
    const int wm = wave >> 1, wn = wave & 1;
    const int r32 = lane & 31, hh = lane >> 5;
    const int lrow = tid >> 3, lc = tid & 7;
    const bf16_t* xg = X + (size_t)(m0 + lrow) * ldx + lc * 8;
    const bf16_t* wg[4];
#pragma unroll
    for (int j = 0; j < 4; ++j) { int n = n0 + lrow + 32 * j; n = n < N ? n : N - 1; wg[j] = W + (size_t)n * ldw + lc * 8; }
    uint4 xr0, xr1, xr2, xr3, wr0, wr1, wr2, wr3;
    f32x16 acc[2][2];
#pragma unroll
    for (int a = 0; a < 2; ++a)
#pragma unroll
        for (int b = 0; b < 2; ++b)
#pragma unroll
            for (int i = 0; i < 16; ++i) acc[a][b][i] = 0.f;
    const int nk = K >> 6;
    int soff0, soff1, soff2, soff3;
    { int r;
      r = lrow;      soff0 = r * 128 + ((lc ^ ((r >> 1) & 7)) << 4);
      r = lrow + 32; soff1 = r * 128 + ((lc ^ ((r >> 1) & 7)) << 4);
      r = lrow + 64; soff2 = r * 128 + ((lc ^ ((r >> 1) & 7)) << 4);
      r = lrow + 96; soff3 = r * 128 + ((lc ^ ((r >> 1) & 7)) << 4); }
    const bf16_t* xg1 = xg + (size_t)32 * ldx; const bf16_t* xg2 = xg + (size_t)64 * ldx; const bf16_t* xg3 = xg + (size_t)96 * ldx;
#define GLOAD(KO) do { xr0 = *(const uint4*)(xg + (KO)); xr1 = *(const uint4*)(xg1 + (KO)); xr2 = *(const uint4*)(xg2 + (KO)); xr3 = *(const uint4*)(xg3 + (KO)); \
                       wr0 = *(const uint4*)(wg[0] + (KO)); wr1 = *(const uint4*)(wg[1] + (KO)); wr2 = *(const uint4*)(wg[2] + (KO)); wr3 = *(const uint4*)(wg[3] + (KO)); } while (0)
#define LSTORE(BASE) do { char* _b = (BASE); *(uint4*)(_b + soff0) = xr0; *(uint4*)(_b + soff1) = xr1; *(uint4*)(_b + soff2) = xr2; *(uint4*)(_b + soff3) = xr3; \
                       *(uint4*)(_b + 16384 + soff0) = wr0; *(uint4*)(_b + 16384 + soff1) = wr1; *(uint4*)(_b + 16384 + soff2) = wr2; *(uint4*)(_b + 16384 + soff3) = wr3; } while (0)
    GLOAD(0);
    LSTORE(lds);
    { const int k1 = (nk > 1 ? 1 : 0) * 64; GLOAD(k1); }
    __syncthreads();
    for (int kt = 0; kt < nk; ++kt) {
        LSTORE(lds + ((kt + 1) & 1) * 32768);
        { const int k2 = (kt + 2 < nk ? kt + 2 : nk - 1) * 64; GLOAD(k2); }
        __builtin_amdgcn_sched_barrier(0);
        const char* xs = lds + (kt & 1) * 32768; const char* ws = xs + 16384;
#pragma unroll
        for (int ks = 0; ks < 4; ++ks) {
            bf16x8 xf[2], wf[2];
#pragma unroll
            for (int mt = 0; mt < 2; ++mt) { const int r = wm * 64 + mt * 32 + r32; xf[mt] = *(const bf16x8*)(xs + r * 128 + (((ks * 2 + hh) ^ ((r >> 1) & 7)) << 4)); }
#pragma unroll
            for (int nt = 0; nt < 2; ++nt) { const int r = wn * 64 + nt * 32 + r32; wf[nt] = *(const bf16x8*)(ws + r * 128 + (((ks * 2 + hh) ^ ((r >> 1) & 7)) << 4)); }
#pragma unroll
            for (int mt = 0; mt < 2; ++mt)
#pragma unroll
                for (int nt = 0; nt < 2; ++nt) acc[mt][nt] = __builtin_amdgcn_mfma_f32_32x32x16_bf16(xf[mt], wf[nt], acc[mt][nt], 0, 0, 0);
        }
        __syncthreads();
    }
#undef GLOAD
#undef LSTORE
    epi(acc, m0 + wm * 64, n0 + wn * 64, r32, hh);
}

__device__ __forceinline__ void tile_map(int tile, int ntm, int ntn, int& mt, int& nt) {
    if ((ntn & 7) == 0) {
        const int G = gridDim.x;
        const int round = tile / G, bi = tile % G;
        const int x = bi & 7, j = bi >> 3;
        const int per = G >> 3;
        const int id = (round * 8 + x) * per + j;
        const int st = id >> 6, in = id & 63;
        const int snt = ntn >> 3;
        const int sm = st / snt, sn = st % snt;
        mt = sm * 8 + (in >> 3); nt = sn * 8 + (in & 7);
    } else { mt = tile / ntn; nt = tile % ntn; }
}

template <class Epi>
__device__ __forceinline__ void gemm_phase(const bf16_t* X, int ldx, const bf16_t* W, int ldw, int M, int N, int K, char* lds, const Epi& epi) {
    const int ntm = M >> 7, ntn = (N + 127) >> 7, nt_tot = ntm * ntn;
    for (int tile = blockIdx.x; tile < nt_tot; tile += gridDim.x) {
        int mt, nt;
        if ((gridDim.x & 7) == 0 && (gridDim.x >> 3) * 8 == gridDim.x && ((gridDim.x >> 3) & 63) == 0) tile_map(tile, ntm, ntn, mt, nt);
        else { mt = tile / ntn; nt = tile % ntn; }
        if (mt < ntm && nt < ntn) gemm_tile(X, ldx, W, ldw, K, mt * 128, nt * 128, N, lds, epi);
    }
}

template <int OFF> __device__ __forceinline__ s16x4 tr_read(int vb) {
    s16x4 r; asm volatile("ds_read_b64_tr_b16 %0, %1 offset:%2" : "=&v"(r) : "v"(vb), "i"(OFF) : "memory"); return r;
}
#define VS_BYTES 192

template <int KT2>
__device__ __forceinline__ void pv_sub(f32x16 (&o)[2], const f32x16& p, int vbase) {
    bf16x8 pf[2];
#pragma unroll
    for (int s2 = 0; s2 < 2; ++s2) {
        unsigned a = cvtpk(p[8 * s2 + 0], p[8 * s2 + 1]), b = cvtpk(p[8 * s2 + 2], p[8 * s2 + 3]);
        unsigned c = cvtpk(p[8 * s2 + 4], p[8 * s2 + 5]), d = cvtpk(p[8 * s2 + 6], p[8 * s2 + 7]);
        uint4 w = make_uint4(a, b, c, d);
        pf[s2] = *(bf16x8*)&w;
    }
    {
        s16x4 l00 = tr_read<(KT2 * 32 + 0) * VS_BYTES + 0>(vbase), h00 = tr_read<(KT2 * 32 + 8) * VS_BYTES + 0>(vbase);
        s16x4 l01 = tr_read<(KT2 * 32 + 0) * VS_BYTES + 64>(vbase), h01 = tr_read<(KT2 * 32 + 8) * VS_BYTES + 64>(vbase);
        s16x4 l10 = tr_read<(KT2 * 32 + 16) * VS_BYTES + 0>(vbase), h10 = tr_read<(KT2 * 32 + 24) * VS_BYTES + 0>(vbase);
        s16x4 l11 = tr_read<(KT2 * 32 + 16) * VS_BYTES + 64>(vbase), h11 = tr_read<(KT2 * 32 + 24) * VS_BYTES + 64>(vbase);
        asm volatile("s_waitcnt lgkmcnt(0)" ::: "memory");
        __builtin_amdgcn_sched_barrier(0);
#define PKV(L, H) (bf16x8){L[0], L[1], L[2], L[3], H[0], H[1], H[2], H[3]}
        o[0] = __builtin_amdgcn_mfma_f32_32x32x16_bf16(PKV(l00, h00), pf[0], o[0], 0, 0, 0);
        o[1] = __builtin_amdgcn_mfma_f32_32x32x16_bf16(PKV(l01, h01), pf[0], o[1], 0, 0, 0);
        o[0] = __builtin_amdgcn_mfma_f32_32x32x16_bf16(PKV(l10, h10), pf[1], o[0], 0, 0, 0);
        o[1] = __builtin_amdgcn_mfma_f32_32x32x16_bf16(PKV(l11, h11), pf[1], o[1], 0, 0, 0);
#undef PKV
    }
}

template <int DK, int G, bool WINDOW>
__device__ __forceinline__ void attn_item(const bf16_t* __restrict__ Q, const bf16_t* __restrict__ K, const bf16_t* __restrict__ V, const float* __restrict__ sink,
                                          bf16_t* __restrict__ O, int ocol, int H, int KV, int item, char* lds) {
    constexpr int KS = DK * 2 + 16;
    constexpr int KCH = DK / 8;
    constexpr int KLD = (64 * KCH) / 256;
    constexpr int QB = 128 / G;
    constexpr int NCH = SEQ / QB;
    constexpr int KBUF = 64 * KS, VBUF = 64 * VS_BYTES;
    const int tid = tid_opaque(), lane = tid & 63, wave = tid >> 6;
    const int r32 = lane & 31, hh = lane >> 5;
    const int chunk = item % NCH, kvh = (item / NCH) % KV, b = item / (NCH * KV);
    const int g = (G == 2) ? (wave >> 1) : 0;
    const int qoff = (G == 2) ? (wave & 1) * 32 : wave * 32;
    const int head = kvh * G + g;
    const int q0 = chunk * QB;
    const int qpos = q0 + qoff + r32;
    bf16x8 qf[DK / 16];
    {
        const bf16_t* qp = Q + ((size_t)(b * H + head) * SEQ + qpos) * DK + hh * 8;
#pragma unroll
        for (int ks = 0; ks < DK / 16; ++ks) qf[ks] = *(const bf16x8*)(qp + ks * 16);
    }
    int kt_lo = 0, kt_hi = SEQ / 64;
    if (WINDOW) { kt_lo = q0 / 64 - 2; if (kt_lo < 0) kt_lo = 0; kt_hi = (q0 + QB) / 64 + 2; if (kt_hi > SEQ / 64) kt_hi = SEQ / 64; }
    const char* Kg = (const char*)(K + (size_t)(b * KV + kvh) * SEQ * DK);
    const char* Vg = (const char*)(V + (size_t)(b * KV + kvh) * SEQ * 64);
    uint4 kr0, kr1, kr2 = make_uint4(0, 0, 0, 0), vr0, vr1;
    int koff[KLD], voff[2];
#pragma unroll
    for (int j = 0; j < KLD; ++j) { const int id = tid + 256 * j; koff[j] = (id / KCH) * KS + (id % KCH) * 16; }
#pragma unroll
    for (int j = 0; j < 2; ++j) { const int id = tid + 256 * j; voff[j] = (id >> 3) * VS_BYTES + (id & 7) * 16; }
    f32x16 o[2];
#pragma unroll
    for (int d = 0; d < 2; ++d)
#pragma unroll
        for (int i = 0; i < 16; ++i) o[d][i] = 0.f;
    float m = -1e30f, l = 0.f;
    if (WINDOW) { m = sink[head] * LOG2E; l = (hh == 0) ? 1.f : 0.f; }
    const int gg = lane >> 4, li = lane & 15;
    const int vlane = (4 * (gg >> 1) + (li >> 2)) * VS_BYTES + (16 * (gg & 1) + 4 * (li & 3)) * 2;
    char* Kl = lds; char* Vl = lds + 2 * KBUF;
#define AGLOAD(KT) do { const char* _kg = Kg + (size_t)(KT) * 64 * DK * 2; const char* _vg = Vg + (size_t)(KT) * 64 * 128; \
        kr0 = *(const uint4*)(_kg + tid * 16); kr1 = *(const uint4*)(_kg + (tid + 256) * 16); if (KLD > 2) kr2 = *(const uint4*)(_kg + (tid + 512) * 16); \
        vr0 = *(const uint4*)(_vg + tid * 16); vr1 = *(const uint4*)(_vg + (tid + 256) * 16); } while (0)
#define ASTORE(KB, VB) do { char* _kd = (KB); char* _vd = (VB); *(uint4*)(_kd + koff[0]) = kr0; *(uint4*)(_kd + koff[1]) = kr1; if (KLD > 2) *(uint4*)(_kd + koff[KLD - 1]) = kr2; \
        *(uint4*)(_vd + voff[0]) = vr0; *(uint4*)(_vd + voff[1]) = vr1; } while (0)
    AGLOAD(kt_lo);
    ASTORE(Kl, Vl);
    { const int k1 = kt_lo + 1 < kt_hi ? kt_lo + 1 : kt_lo; AGLOAD(k1); }
    __syncthreads();
    for (int kt = kt_lo; kt < kt_hi; ++kt) {
        const int cur = (kt - kt_lo) & 1;
        ASTORE(Kl + (cur ^ 1) * KBUF, Vl + (cur ^ 1) * VBUF);
        { const int ktn = kt + 2 < kt_hi ? kt + 2 : kt_hi - 1; AGLOAD(ktn); }
        __builtin_amdgcn_sched_barrier(0);
        const char* kb = Kl + cur * KBUF;
        f32x16 s0, s1;
#pragma unroll
        for (int i = 0; i < 16; ++i) { s0[i] = 0.f; s1[i] = 0.f; }
#pragma unroll
        for (int ks = 0; ks < DK / 16; ++ks) {
            bf16x8 k0 = *(const bf16x8*)(kb + r32 * KS + (ks * 2 + hh) * 16);
            bf16x8 k1 = *(const bf16x8*)(kb + (32 + r32) * KS + (ks * 2 + hh) * 16);
            s0 = __builtin_amdgcn_mfma_f32_32x32x16_bf16(k0, qf[ks], s0, 0, 0, 0);
            s1 = __builtin_amdgcn_mfma_f32_32x32x16_bf16(k1, qf[ks], s1, 0, 0, 0);
        }
        if (WINDOW) {
            const int kb0 = kt * 64 + 4 * hh - qpos;
#pragma unroll
            for (int i = 0; i < 16; ++i) {
                const int d0 = kb0 + (i & 3) + 8 * (i >> 2), d1 = d0 + 32;
                s0[i] = (d0 > 128 || d0 < -128) ? -1e30f : s0[i];
                s1[i] = (d1 > 128 || d1 < -128) ? -1e30f : s1[i];
            }
        }
        float tmax = s0[0];
#pragma unroll
        for (int i = 1; i < 16; ++i) tmax = fmaxf(tmax, s0[i]);
#pragma unroll
        for (int i = 0; i < 16; ++i) tmax = fmaxf(tmax, s1[i]);
        tmax = fmaxf(tmax, xhalf(tmax));
        const float mn = fmaxf(m, tmax);
        const float alpha = __builtin_amdgcn_exp2f(m - mn);
        m = mn;
        float ps = 0.f;
#pragma unroll
        for (int i = 0; i < 16; ++i) { s0[i] = __builtin_amdgcn_exp2f(s0[i] - mn); ps += s0[i]; }
#pragma unroll
        for (int i = 0; i < 16; ++i) { s1[i] = __builtin_amdgcn_exp2f(s1[i] - mn); ps += s1[i]; }
        l = l * alpha + ps;
        if (__any(alpha != 1.f)) {
#pragma unroll
            for (int d = 0; d < 2; ++d)
#pragma unroll
                for (int i = 0; i < 16; ++i) o[d][i] *= alpha;
        }
        const int vbase = (int)(size_t)(Vl + cur * VBUF - lds) + vlane;
        pv_sub<0>(o, s0, vbase);
        pv_sub<1>(o, s1, vbase);
        __syncthreads();
    }
#undef AGLOAD
#undef ASTORE
    l += xhalf(l);
    const float inv = 1.f / l;
    bf16_t* orow = O + (size_t)(b * SEQ + qpos) * DM + ocol + head * 64;
#pragma unroll
    for (int d = 0; d < 2; ++d)
#pragma unroll
        for (int gq = 0; gq < 4; ++gq) {
            uint2 w;
            w.x = cvtpk(o[d][gq * 4 + 0] * inv, o[d][gq * 4 + 1] * inv);
            w.y = cvtpk(o[d][gq * 4 + 2] * inv, o[d][gq * 4 + 3] * inv);
            *(uint2*)(orow + d * 32 + 8 * gq + 4 * hh) = w;
        }
}

__device__ __forceinline__ void dil_wave_item(const bf16_t* __restrict__ Q, const bf16_t* __restrict__ K, const bf16_t* __restrict__ V,
                                              bf16_t* __restrict__ O, int witem, char* wlds, int lds_off) {
    const int lane = tid_opaque() & 63, r32 = lane & 31, hh = lane >> 5;
    const int c = witem & 15, chunk = (witem >> 4) & 15, kvh = (witem >> 8) & 1, b = witem >> 9;
    const int t0 = chunk * 256;
    const int mq = r32 & 15, g = r32 >> 4;
    const int qpos = t0 + 16 * mq + c, head = kvh * 2 + g;
    bf16x8 qf[4];
    {
        const bf16_t* qp = Q + ((size_t)(b * 4 + head) * SEQ + qpos) * 64 + hh * 8;
#pragma unroll
        for (int ks = 0; ks < 4; ++ks) qf[ks] = *(const bf16x8*)(qp + ks * 16);
    }
    const bf16_t* Kg = K + (size_t)(b * 2 + kvh) * SEQ * 64;
    const bf16_t* Vg = V + (size_t)(b * 2 + kvh) * SEQ * 64;
    f32x16 o[2];
#pragma unroll
    for (int d = 0; d < 2; ++d)
#pragma unroll
        for (int i = 0; i < 16; ++i) o[d][i] = 0.f;
    float m = -1e30f, l = 0.f;
    const int gg = lane >> 4, li = lane & 15;
    const int vlane = lds_off + (4 * (gg >> 1) + (li >> 2)) * VS_BYTES + (16 * (gg & 1) + 4 * (li & 3)) * 2;
    for (int it = 0; it < 23; ++it) {
        int sh, j;
        if (it < 12) { sh = 0; j = it; } else if (it < 18) { sh = 2; j = it - 12; } else { sh = 4; j = it - 18; }
        const int rr = 1 << sh;
        const int cc = c & (rr - 1);
        const int idx0 = (t0 >> sh) - 64 + 32 * j;
        const int lim = SEQ >> sh;
        if (idx0 + 31 < 0 || idx0 >= lim) continue;
        bf16x8 kf[4];
        {
            int idx = idx0 + r32; idx = idx < 0 ? 0 : (idx >= lim ? lim - 1 : idx);
            const bf16_t* kp = Kg + (size_t)((idx << sh) + cc) * 64 + hh * 8;
#pragma unroll
            for (int ks = 0; ks < 4; ++ks) kf[ks] = *(const bf16x8*)(kp + ks * 16);
        }
        uint4 vr[4];
#pragma unroll
        for (int jj = 0; jj < 4; ++jj) {
            const int id = lane + 64 * jj; int idx = idx0 + (id >> 3); idx = idx < 0 ? 0 : (idx >= lim ? lim - 1 : idx);
            vr[jj] = *(const uint4*)(Vg + (size_t)((idx << sh) + cc) * 64 + (id & 7) * 8);
        }
#pragma unroll
        for (int jj = 0; jj < 4; ++jj) { const int id = lane + 64 * jj; *(uint4*)(wlds + (id >> 3) * VS_BYTES + (id & 7) * 16) = vr[jj]; }
        f32x16 s;
#pragma unroll
        for (int i = 0; i < 16; ++i) s[i] = 0.f;
#pragma unroll
        for (int ks = 0; ks < 4; ++ks) s = __builtin_amdgcn_mfma_f32_32x32x16_bf16(kf[ks], qf[ks], s, 0, 0, 0);
        const int qidx = qpos >> sh;
        const int base = idx0 + 4 * hh;
#pragma unroll
        for (int i = 0; i < 16; ++i) {
            const int idx = base + (i & 3) + 8 * (i >> 2);
            const int d = idx - qidx;
            s[i] = (d > 64 || d < -64 || idx < 0 || idx >= lim) ? -1e30f : s[i];
        }
        float tmax = s[0];
#pragma unroll
        for (int i = 1; i < 16; ++i) tmax = fmaxf(tmax, s[i]);
        tmax = fmaxf(tmax, xhalf(tmax));
        const float mn = fmaxf(fmaxf(m, tmax), -1e20f);
        const float alpha = __builtin_amdgcn_exp2f(m - mn);
        m = mn;
        float ps = 0.f;
#pragma unroll
        for (int i = 0; i < 16; ++i) { s[i] = __builtin_amdgcn_exp2f(s[i] - mn); ps += s[i]; }
        l = l * alpha + ps;
#pragma unroll
        for (int d = 0; d < 2; ++d)
#pragma unroll
            for (int i = 0; i < 16; ++i) o[d][i] *= alpha;
        pv_sub<0>(o, s, vlane);
    }
    l += xhalf(l);
    const float inv = 1.f / l;
    bf16_t* orow = O + (size_t)(b * SEQ + qpos) * DM + 512 + head * 64;
#pragma unroll
    for (int d = 0; d < 2; ++d)
#pragma unroll
        for (int gq = 0; gq < 4; ++gq) {
            uint2 w;
            w.x = cvtpk(o[d][gq * 4 + 0] * inv, o[d][gq * 4 + 1] * inv);
            w.y = cvtpk(o[d][gq * 4 + 2] * inv, o[d][gq * 4 + 3] * inv);
            *(uint2*)(orow + d * 32 + 8 * gq + 4 * hh) = w;
        }
}

__device__ __forceinline__ int f2key(float f) { int b = __float_as_int(f); return b ^ ((b >> 31) & 0x7fffffff); }
__device__ __forceinline__ float key2f(int k) { return __int_as_float(k ^ ((k >> 31) & 0x7fffffff)); }

template <int N>
__device__ __forceinline__ void bitonic_sort_desc(int (&a)[N]) {
#pragma unroll
    for (int k = 2; k <= N; k <<= 1) {
#pragma unroll
        for (int j = k >> 1; j > 0; j >>= 1) {
#pragma unroll
            for (int i = 0; i < N; ++i) {
                const int l2 = i ^ j;
                if (l2 > i) {
                    const bool up = ((i & k) == 0);
                    const int hi = max(a[i], a[l2]), lo = min(a[i], a[l2]);
                    a[i] = up ? hi : lo; a[l2] = up ? lo : hi;
                }
            }
        }
    }
}
__device__ __forceinline__ void merge_top16(int (&a)[16], const int (&b)[16]) {
#pragma unroll
    for (int i = 0; i < 16; ++i) a[i] = max(a[i], b[15 - i]);
#pragma unroll
    for (int j = 8; j > 0; j >>= 1) {
#pragma unroll
        for (int i = 0; i < 16; ++i) {
            const int l2 = i ^ j;
            if (l2 > i) { const int hi = max(a[i], a[l2]), lo = min(a[i], a[l2]); a[i] = hi; a[l2] = lo; }
        }
    }
}
__device__ __forceinline__ void top16_of_64(int (&g0)[16], int (&g1)[16], int (&g2)[16], int (&g3)[16]) {
    bitonic_sort_desc<16>(g0); bitonic_sort_desc<16>(g1); bitonic_sort_desc<16>(g2); bitonic_sort_desc<16>(g3);
    merge_top16(g0, g1); merge_top16(g2, g3); merge_top16(g0, g2);
}

__device__ __forceinline__ void topk_wave_item(const bf16_t* __restrict__ qp, const bf16_t* __restrict__ subk  ,
                                               int* __restrict__ eidx, float* __restrict__ gate, int witem, char* wlds) {
    const int lane = tid_opaque() & 63, r32 = lane & 31, hh = lane >> 5;
    const int h = witem & 7, tt = witem >> 3;
    const int t = tt * 32 + r32;
    int top[2][16];
#pragma unroll
    for (int c = 0; c < 2; ++c) {
        bf16x8 qf[8];
        const bf16_t* qrow = qp + (size_t)t * 2048 + h * 256 + c * 128 + hh * 8;
#pragma unroll
        for (int ks = 0; ks < 8; ++ks) qf[ks] = *(const bf16x8*)(qrow + ks * 16);
        const bf16_t* kb = subk + ((size_t)(h * 2 + c) * 128 + r32) * 128 + hh * 8;
        int grp[4][16];
#pragma unroll
        for (int kt = 0; kt < 4; ++kt) {
            f32x16 s;
#pragma unroll
            for (int i = 0; i < 16; ++i) s[i] = 0.f;
#pragma unroll
            for (int ks = 0; ks < 8; ++ks) {
                bf16x8 kf = *(const bf16x8*)(kb + (size_t)kt * 32 * 128 + ks * 16);
                s = __builtin_amdgcn_mfma_f32_32x32x16_bf16(kf, qf[ks], s, 0, 0, 0);
            }
#pragma unroll
            for (int i = 0; i < 16; ++i) grp[kt][i] = (f2key(s[i]) & ~127) | (kt * 32 + crow(i, hh));
        }
        top16_of_64(grp[0], grp[1], grp[2], grp[3]);
        int oth[16];
#pragma unroll
        for (int i = 0; i < 16; ++i) oth[i] = __shfl_xor(grp[0][i], 32);
        merge_top16(grp[0], oth);
#pragma unroll
        for (int i = 0; i < 16; ++i) top[c][i] = grp[0][i];
    }
    {
        unsigned* my = (unsigned*)(wlds + lane * 36);
#pragma unroll
        for (int c = 0; c < 2; ++c)
#pragma unroll
            for (int w4 = 0; w4 < 4; ++w4) {
                unsigned v = (top[c][w4 * 4] & 127) | ((top[c][w4 * 4 + 1] & 127) << 8) | ((top[c][w4 * 4 + 2] & 127) << 16) | ((top[c][w4 * 4 + 3] & 127) << 24);
                my[c * 4 + w4] = v;
            }
    }
    float v1[16], v2[16];
#pragma unroll
    for (int i = 0; i < 16; ++i) { v1[i] = key2f(top[0][i] & ~127); v2[i] = key2f(top[1][i] & ~127); }
    int cg[4][16];
    {
        int n = 0;
#pragma unroll
        for (int i = 0; i < 16; ++i)
#pragma unroll
            for (int j = 0; j < 16; ++j)
                if ((i + 1) * (j + 1) <= 16) { cg[n >> 4][n & 15] = (f2key(v1[i] + v2[j]) & ~255) | (i * 16 + j); ++n; }
#pragma unroll
        for (int q = 50; q < 64; ++q) cg[q >> 4][q & 15] = (int)0x80000000;
    }
    top16_of_64(cg[0], cg[1], cg[2], cg[3]);
    float bv[16];
#pragma unroll
    for (int i = 0; i < 16; ++i) bv[i] = key2f(cg[0][i] & ~255);
    float sm = 0.f;
    const float bmx = bv[0];
#pragma unroll
    for (int i = 0; i < 16; ++i) { bv[i] = __expf(bv[i] - bmx); sm += bv[i]; }
    const float inv = 1.f / sm;
    if (hh == 0) {
        const unsigned char* my = (const unsigned char*)(wlds + lane * 36);
        int* eo = eidx + (size_t)t * 128 + h * 16;
        float* go = gate + (size_t)t * 128 + h * 16;
#pragma unroll
        for (int q4 = 0; q4 < 4; ++q4) {
            int4 ev; float4 gv;
            int* evp = (int*)&ev; float* gvp = (float*)&gv;
#pragma unroll
            for (int u = 0; u < 4; ++u) {
                const int code = cg[0][q4 * 4 + u] & 255;
                const int i1 = my[code >> 4], i2 = my[16 + (code & 15)];
                evp[u] = i1 * 128 + i2; gvp[u] = bv[q4 * 4 + u] * inv;
            }
            *(int4*)(eo + q4 * 4) = ev; *(float4*)(go + q4 * 4) = gv;
        }
    }
}

typedef __attribute__((ext_vector_type(2))) float f32x2;
__device__ __forceinline__ float fdot2bf(unsigned a, unsigned b, float acc) {
    return __builtin_amdgcn_fdot2_f32_bf16(*(bf16x2_t*)&a, *(bf16x2_t*)&b, acc, false);
}
__device__ __forceinline__ unsigned fp8pair_to_bf16(unsigned w, bool hi) {
    bf16x2_t r = hi ? __builtin_amdgcn_cvt_scalef32_pk_bf16_fp8((int)w, 1.0f, true) : __builtin_amdgcn_cvt_scalef32_pk_bf16_fp8((int)w, 1.0f, false);
    return *(unsigned*)&r;
}
__device__ __forceinline__ float dot16_fp8(uint4 u, const unsigned (&h)[8]) {
    float a = 0.f;
    a = fdot2bf(fp8pair_to_bf16(u.x, false), h[0], a); a = fdot2bf(fp8pair_to_bf16(u.x, true), h[1], a);
    a = fdot2bf(fp8pair_to_bf16(u.y, false), h[2], a); a = fdot2bf(fp8pair_to_bf16(u.y, true), h[3], a);
    a = fdot2bf(fp8pair_to_bf16(u.z, false), h[4], a); a = fdot2bf(fp8pair_to_bf16(u.z, true), h[5], a);
    a = fdot2bf(fp8pair_to_bf16(u.w, false), h[6], a); a = fdot2bf(fp8pair_to_bf16(u.w, true), h[7], a);
    return a;
}
__device__ __forceinline__ void axpy16_fp8(float (&acc)[16], float w, uint4 v) {
    f32x2 r;
    r = __builtin_amdgcn_cvt_pk_f32_fp8((int)v.x, false); acc[0] += w * r[0]; acc[1] += w * r[1];
    r = __builtin_amdgcn_cvt_pk_f32_fp8((int)v.x, true);  acc[2] += w * r[0]; acc[3] += w * r[1];
    r = __builtin_amdgcn_cvt_pk_f32_fp8((int)v.y, false); acc[4] += w * r[0]; acc[5] += w * r[1];
    r = __builtin_amdgcn_cvt_pk_f32_fp8((int)v.y, true);  acc[6] += w * r[0]; acc[7] += w * r[1];
    r = __builtin_amdgcn_cvt_pk_f32_fp8((int)v.z, false); acc[8] += w * r[0]; acc[9] += w * r[1];
    r = __builtin_amdgcn_cvt_pk_f32_fp8((int)v.z, true);  acc[10] += w * r[0]; acc[11] += w * r[1];
    r = __builtin_amdgcn_cvt_pk_f32_fp8((int)v.w, false); acc[12] += w * r[0]; acc[13] += w * r[1];
    r = __builtin_amdgcn_cvt_pk_f32_fp8((int)v.w, true);  acc[14] += w * r[0]; acc[15] += w * r[1];
}
__device__ __forceinline__ float gelu_exact(float a) { return 0.5f * a * (1.f + erff(a * 0.70710678118654752f)); }

__device__ __forceinline__ float transpose_reduce16(f32x16 p, int lane) {
#pragma unroll
    for (int st = 0; st < 4; ++st) {
        const int o = 32 >> st, n = 16 >> st;
        const bool up = (lane & o) != 0;
#pragma unroll
        for (int i = 0; i < n / 2; ++i) {
            const float keep = up ? p[i + n / 2] : p[i];
            const float send = up ? p[i] : p[i + n / 2];
            p[i] = keep + __shfl_xor(send, o);
        }
    }
    float v = p[0];
    v += __shfl_xor(v, 1); v += __shfl_xor(v, 2);
    return v;
}
#define EX_SB() __builtin_amdgcn_sched_barrier(0)
#define EX_LD1(R, TAB, EB, S) R = *(const uint4*)((TAB) + (size_t)__builtin_amdgcn_readlane((EB), (S)) * DM + lane * 16)
#define EX_LOAD8(P, TAB, EB, SL) do { EX_LD1(P##0, TAB, EB, (SL) + 0); EX_LD1(P##1, TAB, EB, (SL) + 1); EX_LD1(P##2, TAB, EB, (SL) + 2); EX_LD1(P##3, TAB, EB, (SL) + 3); \
        EX_LD1(P##4, TAB, EB, (SL) + 4); EX_LD1(P##5, TAB, EB, (SL) + 5); EX_LD1(P##6, TAB, EB, (SL) + 6); EX_LD1(P##7, TAB, EB, (SL) + 7); } while (0)
#define EX_DOT8(P, PP, O) do { PP[(O) + 0] = dot16_fp8(P##0, hp); PP[(O) + 1] = dot16_fp8(P##1, hp); PP[(O) + 2] = dot16_fp8(P##2, hp); PP[(O) + 3] = dot16_fp8(P##3, hp); \
        PP[(O) + 4] = dot16_fp8(P##4, hp); PP[(O) + 5] = dot16_fp8(P##5, hp); PP[(O) + 6] = dot16_fp8(P##6, hp); PP[(O) + 7] = dot16_fp8(P##7, hp); } while (0)
#define EX_RL(W, S) __int_as_float(__builtin_amdgcn_readlane(__float_as_int(W), (S)))
#define EX_AXPY8(P, W, SL) do { axpy16_fp8(acc, EX_RL(W, (SL) + 0), P##0); axpy16_fp8(acc, EX_RL(W, (SL) + 1), P##1); axpy16_fp8(acc, EX_RL(W, (SL) + 2), P##2); axpy16_fp8(acc, EX_RL(W, (SL) + 3), P##3); \
        axpy16_fp8(acc, EX_RL(W, (SL) + 4), P##4); axpy16_fp8(acc, EX_RL(W, (SL) + 5), P##5); axpy16_fp8(acc, EX_RL(W, (SL) + 6), P##6); axpy16_fp8(acc, EX_RL(W, (SL) + 7), P##7); } while (0)
#define EX_COPY8(D, S_) do { D##0 = S_##0; D##1 = S_##1; D##2 = S_##2; D##3 = S_##3; D##4 = S_##4; D##5 = S_##5; D##6 = S_##6; D##7 = S_##7; } while (0)

__device__ __forceinline__ void expert_token(PC& p, int layer, int t, bool last, bool dummy = false) {
    const int lane = tid_opaque() & 63;
    const float* gfb = p.g_ffn + layer * DM; asm volatile("" : "+s"(gfb));
    const float* gf = gfb + lane * 16;
    float* xrow = p.x + (size_t)t * DM + lane * 16;
    float* xwr = dummy ? (float*)p.zb + (size_t)t * DM + lane * 16 : xrow;
    bf16_t* hwr = (dummy ? p.q.qA + (size_t)t * DM : p.hnb + (size_t)t * DM) + lane * 16;
    float xv[16];
#pragma unroll
    for (int q = 0; q < 4; ++q) { const float4 a = *(const float4*)(xrow + 4 * q); xv[4 * q] = a.x; xv[4 * q + 1] = a.y; xv[4 * q + 2] = a.z; xv[4 * q + 3] = a.w; }
    float ss = 0.f;
#pragma unroll
    for (int i = 0; i < 16; ++i) ss += xv[i] * xv[i];
    ss = wave_sum(ss);
    const float rstd = rsqrtf(ss * (1.f / DM) + 1e-6f);
    unsigned hp[8];
#pragma unroll
    for (int q = 0; q < 4; ++q) {
        const float4 g = *(const float4*)(gf + 4 * q);
        hp[2 * q] = cvtpk(xv[4 * q] * rstd * g.x, xv[4 * q + 1] * rstd * g.y);
        hp[2 * q + 1] = cvtpk(xv[4 * q + 2] * rstd * g.z, xv[4 * q + 3] * rstd * g.w);
    }
    const int e0 = p.eidx[(size_t)t * 128 + lane], e1 = p.eidx[(size_t)t * 128 + 64 + lane];
    const float g0 = p.gate[(size_t)t * 128 + lane], g1 = p.gate[(size_t)t * 128 + 64 + lane];
    const unsigned char* u8 = p.u8 + (size_t)layer * 16384 * DM;
    const unsigned char* v8 = p.v8 + (size_t)layer * 16384 * DM;
    const float* su = p.su + layer * 16384; const float* sv = p.sv + layer * 16384;
    const float su0 = su[e0], su1 = su[e1], sv0 = sv[e0], sv1 = sv[e1];
    uint4 rx0, rx1, rx2, rx3, rx4, rx5, rx6, rx7, ry0, ry1, ry2, ry3, ry4, ry5, ry6, ry7;
    float a0 = 0.f, a1 = 0.f;
    EX_LOAD8(rx, u8, e0, 0);
#pragma unroll 1
    for (int g = 0; g < 8; ++g) {
        const int eb = g < 4 ? e0 : e1;
        const int sl = (g & 3) * 16;
        f32x16 pp;
        EX_LOAD8(ry, u8, eb, sl + 8);
        EX_SB();
        EX_DOT8(rx, pp, 0);
        EX_SB();
        {
            const int gn = g + 1 < 8 ? g + 1 : 7;
            const int ebn = gn < 4 ? e0 : e1;
            EX_LOAD8(rx, u8, ebn, (gn & 3) * 16);
        }
        EX_SB();
        EX_DOT8(ry, pp, 8);
        const float v = transpose_reduce16(pp, lane);
        const float got = __shfl(v, (lane & 15) << 2);
        const bool mine = (lane >> 4) == (g & 3);
        a0 = (mine && g < 4) ? got : a0;
        a1 = (mine && g >= 4) ? got : a1;
        EX_SB();
    }
    const float w0 = g0 * gelu_exact(su0 * a0) * sv0;
    const float w1 = g1 * gelu_exact(su1 * a1) * sv1;
    float acc[16];
#pragma unroll
    for (int i = 0; i < 16; ++i) acc[i] = 0.f;
    EX_LOAD8(rx, v8, e0, 0);
#pragma unroll 1
    for (int hg = 0; hg < 16; ++hg) {
        {
            const int hn_ = hg + 1 < 16 ? hg + 1 : 15;
            const int ebn = hn_ < 8 ? e0 : e1;
            EX_LOAD8(ry, v8, ebn, (hn_ & 7) * 8);
        }
        EX_SB();
        const float wb = hg < 8 ? w0 : w1;
        EX_AXPY8(rx, wb, (hg & 7) * 8);
        EX_SB();
        EX_COPY8(rx, ry);
    }
#pragma unroll
    for (int i = 0; i < 16; ++i) xv[i] += acc[i];
    float s2 = 0.f;
#pragma unroll
    for (int i = 0; i < 16; ++i) s2 += xv[i] * xv[i];
    s2 = wave_sum(s2);
    const float r2 = rsqrtf(s2 * (1.f / DM) + 1e-6f);
    if (!last) {
#pragma unroll
        for (int q = 0; q < 4; ++q) *(float4*)(xwr + 4 * q) = make_float4(xv[4 * q], xv[4 * q + 1], xv[4 * q + 2], xv[4 * q + 3]);
        const float* gnb = p.g_mix + (layer + 1) * DM; asm volatile("" : "+s"(gnb));
        const float* gn = gnb + lane * 16;
        unsigned hw[8];
#pragma unroll
        for (int q = 0; q < 4; ++q) {
            const float4 g = *(const float4*)(gn + 4 * q);
            hw[2 * q] = cvtpk(xv[4 * q] * r2 * g.x, xv[4 * q + 1] * r2 * g.y);
            hw[2 * q + 1] = cvtpk(xv[4 * q + 2] * r2 * g.z, xv[4 * q + 3] * r2 * g.w);
        }
        *(uint4*)(hwr) = make_uint4(hw[0], hw[1], hw[2], hw[3]);
        *(uint4*)(hwr + 8) = make_uint4(hw[4], hw[5], hw[6], hw[7]);
    } else {
        const float* gnb = p.g_final; asm volatile("" : "+s"(gnb));
        const float* gn = gnb + lane * 16;
        float* orow = dummy ? xwr : p.out + (size_t)t * DM + lane * 16;
#pragma unroll
        for (int q = 0; q < 4; ++q) {
            const float4 g = *(const float4*)(gn + 4 * q);
            *(float4*)(orow + 4 * q) = make_float4(xv[4 * q] * r2 * g.x, xv[4 * q + 1] * r2 * g.y, xv[4 * q + 2] * r2 * g.z, xv[4 * q + 3] * r2 * g.w);
        }
    }
}
__device__ __forceinline__ void transpose_tile(const float* __restrict__ src, int K, int N, bf16_t* __restrict__ dst, int tk, int tn, float* tl) {
    const int tid = tid_opaque(), r = tid >> 6, c = tid & 63;
    const int k0 = tk * 64, n0 = tn * 64;
#pragma unroll
    for (int i = 0; i < 16; ++i) {
        const int kk = i * 4 + r, n = n0 + c;
        tl[kk * 65 + c] = (n < N) ? src[(size_t)(k0 + kk) * N + n] : 0.f;
    }
    __syncthreads();
#pragma unroll
    for (int i = 0; i < 16; ++i) {
        const int nn = i * 4 + r;
        if (n0 + nn < N) dst[(size_t)(n0 + nn) * K + k0 + c] = f2bf(tl[c * 65 + nn]);
    }
    __syncthreads();
}
__device__ __forceinline__ void transpose_all(const float* src, int K, int N, bf16_t* dst, float* tl) {
    const int ntk = K / 64, ntn = (N + 63) / 64;
    for (int t = blockIdx.x; t < ntk * ntn; t += gridDim.x) transpose_tile(src, K, N, dst, t / ntn, t % ntn, tl);
}
__device__ __forceinline__ void convert_plain(const float* __restrict__ src, bf16_t* __restrict__ dst, size_t n) {
    const size_t n8 = n >> 3;
    for (size_t i = (size_t)blockIdx.x * blockDim.x + tid_opaque(); i < n8; i += (size_t)gridDim.x * blockDim.x) {
        const float4 a = *(const float4*)(src + i * 8), b = *(const float4*)(src + i * 8 + 4);
        uint4 w; w.x = cvtpk(a.x, a.y); w.y = cvtpk(a.z, a.w); w.z = cvtpk(b.x, b.y); w.w = cvtpk(b.z, b.w);
        *(uint4*)(dst + i * 8) = w;
    }
}
__device__ __forceinline__ void convert_rows_fp8(const float* __restrict__ src, unsigned char* __restrict__ dst, float* __restrict__ scales, int nrows) {
    const int tid = tid_opaque(), wave = tid >> 6, lane = tid & 63;
    for (int row = blockIdx.x * 4 + wave; row < nrows; row += gridDim.x * 4) {
        const float* sr = src + (size_t)row * DM + lane * 16;
        float xv[16];
#pragma unroll
        for (int q = 0; q < 4; ++q) { const float4 a = *(const float4*)(sr + 4 * q); xv[4 * q] = a.x; xv[4 * q + 1] = a.y; xv[4 * q + 2] = a.z; xv[4 * q + 3] = a.w; }
        float am = 0.f;
#pragma unroll
        for (int i = 0; i < 16; ++i) am = fmaxf(am, fabsf(xv[i]));
        am = wave_max(am);
        const float sc = am > 0.f ? am * (1.f / 448.f) : 1.f;
        const float inv = 1.f / sc;
        unsigned w[4];
#pragma unroll
        for (int q = 0; q < 4; ++q) {
            int t = 0;
            t = __builtin_amdgcn_cvt_pk_fp8_f32(xv[4 * q] * inv, xv[4 * q + 1] * inv, t, false);
            t = __builtin_amdgcn_cvt_pk_fp8_f32(xv[4 * q + 2] * inv, xv[4 * q + 3] * inv, t, true);
            w[q] = (unsigned)t;
        }
        *(uint4*)(dst + (size_t)row * DM + lane * 16) = make_uint4(w[0], w[1], w[2], w[3]);
        if (lane == 0) scales[row] = sc;
    }
}
__device__ __forceinline__ void rms_row_bf16(const float* __restrict__ src, const float* __restrict__ g, bf16_t* __restrict__ dst, float* __restrict__ cpy, int lane) {
    float xv[16];
    const float4 a0 = *(const float4*)(src + lane * 8), a1 = *(const float4*)(src + lane * 8 + 4);
    const float4 b0 = *(const float4*)(src + 512 + lane * 8), b1 = *(const float4*)(src + 512 + lane * 8 + 4);
    xv[0] = a0.x; xv[1] = a0.y; xv[2] = a0.z; xv[3] = a0.w; xv[4] = a1.x; xv[5] = a1.y; xv[6] = a1.z; xv[7] = a1.w;
    xv[8] = b0.x; xv[9] = b0.y; xv[10] = b0.z; xv[11] = b0.w; xv[12] = b1.x; xv[13] = b1.y; xv[14] = b1.z; xv[15] = b1.w;
    if (cpy) {
        *(float4*)(cpy + lane * 8) = a0; *(float4*)(cpy + lane * 8 + 4) = a1;
        *(float4*)(cpy + 512 + lane * 8) = b0; *(float4*)(cpy + 512 + lane * 8 + 4) = b1;
    }
    float ss = 0.f;
#pragma unroll
    for (int i = 0; i < 16; ++i) ss += xv[i] * xv[i];
    ss = wave_sum(ss);
    const float r = rsqrtf(ss * (1.f / DM) + 1e-6f);
    const float4 g0 = *(const float4*)(g + lane * 8), g1 = *(const float4*)(g + lane * 8 + 4);
    const float4 g2 = *(const float4*)(g + 512 + lane * 8), g3 = *(const float4*)(g + 512 + lane * 8 + 4);
    uint4 wa, wb;
    wa.x = cvtpk(xv[0] * r * g0.x, xv[1] * r * g0.y); wa.y = cvtpk(xv[2] * r * g0.z, xv[3] * r * g0.w);
    wa.z = cvtpk(xv[4] * r * g1.x, xv[5] * r * g1.y); wa.w = cvtpk(xv[6] * r * g1.z, xv[7] * r * g1.w);
    wb.x = cvtpk(xv[8] * r * g2.x, xv[9] * r * g2.y); wb.y = cvtpk(xv[10] * r * g2.z, xv[11] * r * g2.w);
    wb.z = cvtpk(xv[12] * r * g3.x, xv[13] * r * g3.y); wb.w = cvtpk(xv[14] * r * g3.z, xv[15] * r * g3.w);
    *(uint4*)(dst + lane * 8) = wa; *(uint4*)(dst + 512 + lane * 8) = wb;
}

__device__ __forceinline__ void phase_pro(PC& p, char* lds) {
    float* tl = (float*)lds;
    for (int l = 0; l < DEPTH; ++l) {
        transpose_all(p.w_in + (size_t)l * DM * NZ, DM, NZ, p.winT + (size_t)l * NZ * DM, tl);
        transpose_all(p.w_out + (size_t)l * DM * DM, DM, DM, p.woutT + (size_t)l * DM * DM, tl);
        transpose_all(p.peer_w_q + (size_t)l * DM * 2048, DM, 2048, p.wqT + (size_t)l * 2048 * DM, tl);
        transpose_all(p.mla_w_uq + (size_t)l * 256 * 384, 256, 384, p.wuqT + (size_t)l * 384 * 256, tl);
        transpose_all(p.mla_w_ukv + (size_t)l * 128 * 512, 128, 512, p.wukvT + (size_t)l * 512 * 128, tl);
    }
    convert_plain(p.peer_sub_keys, p.subk, (size_t)DEPTH * 8 * 2 * 128 * 128);
    if (p.flags & 1) {
        convert_rows_fp8(p.peer_u, p.u8, p.su, DEPTH * 16384);
        convert_rows_fp8(p.peer_v, p.v8, p.sv, DEPTH * 16384);
    }
    for (int i = blockIdx.x * blockDim.x + tid_opaque(); i < 4096 * 32; i += gridDim.x * blockDim.x) {
        {
            const int pos = i / 32, j = i % 32;
            const float inv = powf(10000.f, -(float)(2 * j) / 64.f); const float ang = (float)pos * inv;
            p.tb.cos1[i] = cosf(ang); p.tb.sin1[i] = sinf(ang);
        }
        if (i < 4096 * 16) {
            const int pos = i / 16, j = i % 16;
            const float inv = powf(10000.f, -(float)(2 * j) / 32.f); const float ang = (float)pos * inv;
            p.tb.cosm[i] = cosf(ang); p.tb.sinm[i] = sinf(ang);
        }
        if (i < 64 * 16) {
            const int pos = i / 16, j = i % 16;
            const float inv = powf(10000.f, -(float)(2 * j) / 32.f); const float ang = (float)pos * inv;
            p.tb.cosr[i] = cosf(ang); p.tb.sinr[i] = sinf(ang); p.tb.cosc[i] = cosf(ang); p.tb.sinc[i] = sinf(ang);
        }
    }
    const int wave = tid_opaque() >> 6, lane = tid_opaque() & 63;
    for (int t = blockIdx.x * 4 + wave; t < T_TOK; t += gridDim.x * 4)
        rms_row_bf16(p.x_in + (size_t)t * DM, p.g_mix, p.hnb + (size_t)t * DM, p.x + (size_t)t * DM, lane);
}

__device__ __forceinline__ void phase_g1(PC& p, int l, char* lds) {
    EpiStoreBf16 e{p.zb, NZ, NZ};
    gemm_phase(p.hnb, DM, p.winT + (size_t)l * NZ * DM, DM, T_TOK, NZ, DM, lds, e);
}

__device__ __forceinline__ void phase_post(PC& p, int l, char* lds) {
    float* zr = (float*)lds;
    float* hs = zr + 2048;
    const int tid = tid_opaque(), wave = tid >> 6, lane = tid & 63;
    const float* g_qn = p.ax_q_norm + l * 64; const float* g_kn = p.ax_k_norm + l * 64;
    const float* g_cq = p.mla_q_norm + l * 256; const float* g_ckv = p.mla_kv_norm + l * 128;
    const float scA = 0.125f * LOG2E;
    for (int t = blockIdx.x; t < T_TOK; t += gridDim.x) {
        const int b = t / SEQ, s = t % SEQ;
        if (tid < 244) {
            const uint4 w = *(const uint4*)(p.zb + (size_t)t * NZ + tid * 8);
            float* d = zr + tid * 8;
            d[0] = __uint_as_float(w.x << 16); d[1] = __uint_as_float(w.x & 0xffff0000u);
            d[2] = __uint_as_float(w.y << 16); d[3] = __uint_as_float(w.y & 0xffff0000u);
            d[4] = __uint_as_float(w.z << 16); d[5] = __uint_as_float(w.z & 0xffff0000u);
            d[6] = __uint_as_float(w.w << 16); d[7] = __uint_as_float(w.w & 0xffff0000u);
        }
        __syncthreads();
#pragma unroll
        for (int rr = 0; rr < 2; ++rr) {
            const int r = wave + 4 * rr;
            int base, n;
            if (r < 4) { base = 512 + r * 64; n = 64; } else if (r < 6) { base = 768 + (r - 4) * 64; n = 64; } else if (r == 6) { base = 1536; n = 256; } else { base = 1792; n = 128; }
            float ss = 0.f;
            for (int i = lane; i < n; i += 64) ss += zr[base + i] * zr[base + i];
            ss = wave_sum(ss);
            if (lane == 0) hs[r] = rsqrtf(ss / (float)n + 1e-6f);
        }
        __syncthreads();
#pragma unroll
        for (int mix = 0; mix < 2; ++mix) {
            const int zb = mix == 0 ? 0 : 1024;
            bf16_t* qo = mix == 0 ? p.q.qA : p.q.qC; bf16_t* ko = mix == 0 ? p.q.kA : p.q.kC; bf16_t* vo = mix == 0 ? p.q.vA : p.q.vC;
            if (tid < 128) {
                const int h = tid / 32, j = tid % 32;
                const float x1 = zr[zb + h * 64 + j], x2 = zr[zb + h * 64 + 32 + j];
                const float c = p.tb.cos1[s * 32 + j], sn = p.tb.sin1[s * 32 + j];
                const size_t ob = ((size_t)(b * 4 + h) * SEQ + s) * 64;
                qo[ob + j] = f2bf((x1 * c - x2 * sn) * scA); qo[ob + 32 + j] = f2bf((x2 * c + x1 * sn) * scA);
            } else if (tid < 192) {
                const int i = tid - 128, h = i / 32, j = i % 32;
                const float x1 = zr[zb + 256 + h * 64 + j], x2 = zr[zb + 256 + h * 64 + 32 + j];
                const float c = p.tb.cos1[s * 32 + j], sn = p.tb.sin1[s * 32 + j];
                const size_t ob = ((size_t)(b * 2 + h) * SEQ + s) * 64;
                ko[ob + j] = f2bf(x1 * c - x2 * sn); ko[ob + 32 + j] = f2bf(x2 * c + x1 * sn);
            } else {
                const int i = (tid - 192) * 2, h = i / 64, j = i % 64;
                const unsigned w = cvtpk(zr[zb + 384 + i], zr[zb + 384 + i + 1]);
                *(unsigned*)(vo + ((size_t)(b * 2 + h) * SEQ + s) * 64 + j) = w;
            }
        }
        {
            const int row = s / 64, col = s % 64;
            if (tid < 192) {
                const int hh = tid / 32, r = tid % 32, half = r / 16, j = r % 16;
                const bool isq = hh < 4;
                const int zb = isq ? 512 + hh * 64 : 768 + (hh - 4) * 64;
                const float* gn = isq ? g_qn : g_kn;
                const float rstd = hs[hh];
                const int d1 = half * 32 + j, d2 = half * 32 + 16 + j;
                const float x1 = zr[zb + d1] * rstd * gn[d1], x2 = zr[zb + d2] * rstd * gn[d2];
                float c, sn;
                if (half == 0) { c = p.tb.cosr[row * 16 + j]; sn = p.tb.sinr[row * 16 + j]; } else { c = p.tb.cosc[col * 16 + j]; sn = p.tb.sinc[col * 16 + j]; }
                const float o1 = x1 * c - x2 * sn, o2 = x2 * c + x1 * sn;
                if (isq) { const size_t ob = ((size_t)(b * 4 + hh) * SEQ + s) * 64; p.q.qB[ob + d1] = f2bf(o1 * scA); p.q.qB[ob + d2] = f2bf(o2 * scA); }
                else { const size_t ob = ((size_t)(b * 2 + (hh - 4)) * SEQ + s) * 64; p.q.kB[ob + d1] = f2bf(o1); p.q.kB[ob + d2] = f2bf(o2); }
            } else {
                const int i = (tid - 192) * 2, h = i / 64, j = i % 64;
                const unsigned w = cvtpk(zr[896 + i], zr[896 + i + 1]);
                *(unsigned*)(p.q.vB + ((size_t)(b * 2 + h) * SEQ + s) * 64 + j) = w;
            }
        }
        p.cqn[(size_t)t * 256 + tid] = f2bf(zr[1536 + tid] * hs[6] * g_cq[tid]);
        if (tid < 128) p.ckvn[(size_t)t * 128 + tid] = f2bf(zr[1792 + tid] * hs[7] * g_ckv[tid]);
        else if (tid < 144) {
            const int i = tid - 128;
            const float x1 = zr[1920 + i], x2 = zr[1920 + 16 + i];
            const float c = p.tb.cosm[s * 16 + i], sn = p.tb.sinm[s * 16 + i];
            const bf16_t o1 = f2bf(x1 * c - x2 * sn), o2 = f2bf(x2 * c + x1 * sn);
#pragma unroll
            for (int h = 0; h < 4; ++h) { const size_t ob = ((size_t)(b * 4 + h) * SEQ + s) * 96; p.q.kD[ob + 64 + i] = o1; p.q.kD[ob + 80 + i] = o2; }
        }
        __syncthreads();
    }
}

__device__ __forceinline__ void phase_mla(PC& p, int l, char* lds) {
    { EpiStoreBf16 e{p.qfull, 384, 384}; gemm_phase(p.cqn, 256, p.wuqT + (size_t)l * 384 * 256, 256, T_TOK, 384, 256, lds, e); }
    { EpiStoreBf16 e{p.kvfull, 512, 512}; gemm_phase(p.ckvn, 128, p.wukvT + (size_t)l * 512 * 128, 128, T_TOK, 512, 128, lds, e); }
}

__device__ __forceinline__ void phase_postmla(PC& p, int l) {
    const int tid = tid_opaque();
    const float scD = 0.10206207261596575f * LOG2E;
    for (int t = blockIdx.x; t < T_TOK; t += gridDim.x) {
        const int b = t / SEQ, s = t % SEQ;
        {
            const int h = tid / 64, j = tid % 64;
            p.q.qD[((size_t)(b * 4 + h) * SEQ + s) * 96 + j] = f2bf(bf2f(p.qfull[(size_t)t * 384 + h * 96 + j]) * scD);
            p.q.kD[((size_t)(b * 4 + h) * SEQ + s) * 96 + j] = p.kvfull[(size_t)t * 512 + h * 128 + j];
            p.q.vD[((size_t)(b * 4 + h) * SEQ + s) * 64 + j] = p.kvfull[(size_t)t * 512 + h * 128 + 64 + j];
        }
        if (tid < 64) {
            const int h = tid / 16, j = tid % 16;
            const float x1 = bf2f(p.qfull[(size_t)t * 384 + h * 96 + 64 + j]), x2 = bf2f(p.qfull[(size_t)t * 384 + h * 96 + 80 + j]);
            const float c = p.tb.cosm[s * 16 + j], sn = p.tb.sinm[s * 16 + j];
            const size_t ob = ((size_t)(b * 4 + h) * SEQ + s) * 96;
            p.q.qD[ob + 64 + j] = f2bf((x1 * c - x2 * sn) * scD); p.q.qD[ob + 80 + j] = f2bf((x2 * c + x1 * sn) * scD);
        }
    }
}

__device__ __forceinline__ void phase_att(PC& p, int l, char* lds) {
    for (int it = blockIdx.x; it < 1024; it += gridDim.x) attn_item<96, 1, false>(p.q.qD, p.q.kD, p.q.vD, nullptr, p.ob, 768, 4, 4, it, lds);
    for (int it = blockIdx.x; it < 1024; it += gridDim.x) attn_item<64, 2, false>(p.q.qB, p.q.kB, p.q.vB, nullptr, p.ob, 256, 4, 2, it, lds);
    for (int it = blockIdx.x; it < 1024; it += gridDim.x) attn_item<64, 2, true>(p.q.qA, p.q.kA, p.q.vA, p.win_sink + l * 4, p.ob, 0, 4, 2, it, lds);
    {
        const int wave = tid_opaque() >> 6;
        char* wl = lds + wave * 6144;
        const int off = (int)(uintptr_t)wl;
        for (int wi = blockIdx.x * 4 + wave; wi < 4096; wi += gridDim.x * 4) dil_wave_item(p.q.qC, p.q.kC, p.q.vC, p.ob, wi, wl, off);
    }
}

__device__ __forceinline__ void phase_gn(PC& p, int l) {
    const int wave = tid_opaque() >> 6, lane = tid_opaque() & 63;
    const float* gg = p.g_group + (size_t)l * 1024;
    for (int t = blockIdx.x * 4 + wave; t < T_TOK; t += gridDim.x * 4) {
#pragma unroll
        for (int g = 0; g < 4; ++g) {
            const uint2 w = *(const uint2*)(p.ob + (size_t)t * DM + g * 256 + lane * 4);
            const float v0 = __uint_as_float(w.x << 16), v1 = __uint_as_float(w.x & 0xffff0000u), v2 = __uint_as_float(w.y << 16), v3 = __uint_as_float(w.y & 0xffff0000u);
            float ss = v0 * v0 + v1 * v1 + v2 * v2 + v3 * v3;
            ss = wave_sum(ss);
            const float r = rsqrtf(ss * (1.f / 256.f) + 1e-6f);
            const float4 g4 = *(const float4*)(gg + g * 256 + lane * 4);
            uint2 o; o.x = cvtpk(v0 * r * g4.x, v1 * r * g4.y); o.y = cvtpk(v2 * r * g4.z, v3 * r * g4.w);
            *(uint2*)(p.hnb + (size_t)t * DM + g * 256 + lane * 4) = o;
        }
    }
}
__device__ __forceinline__ void phase_g2(PC& p, int l, char* lds) {
    EpiResidF32 e{p.x, DM};
    gemm_phase(p.hnb, DM, p.woutT + (size_t)l * DM * DM, DM, T_TOK, DM, DM, lds, e);
}
__device__ __forceinline__ void phase_n2(PC& p, int l) {
    const int wave = tid_opaque() >> 6, lane = tid_opaque() & 63;
    for (int t = blockIdx.x * 4 + wave; t < T_TOK; t += gridDim.x * 4)
        rms_row_bf16(p.x + (size_t)t * DM, p.g_ffn + l * DM, p.hnb + (size_t)t * DM, nullptr, lane);
}
__device__ __forceinline__ void phase_g3(PC& p, int l, char* lds) {
    EpiStoreBf16 e{p.qp, 2048, 2048};
    gemm_phase(p.hnb, DM, p.wqT + (size_t)l * 2048 * DM, DM, T_TOK, 2048, DM, lds, e);
}
__device__ __forceinline__ void phase_topk(PC& p, int l, char* lds) {
    const int wave = tid_opaque() >> 6;
    char* wl = lds + wave * 2304;
    const bf16_t* sk = p.subk + (size_t)l * 8 * 2 * 128 * 128;
    for (int wi = blockIdx.x * 4 + wave; wi < 8192; wi += gridDim.x * 4) topk_wave_item(p.qp, sk, p.eidx, p.gate, wi, wl);
}
__device__ __forceinline__ void phase_exp(PC& p, int l) {
    const int wave = tid_opaque() >> 6;
    for (int t = blockIdx.x * 4 + wave; t < T_TOK; t += gridDim.x * 4) expert_token(p, l, t, l == DEPTH - 1);
}

template <int PH>
__global__ void __launch_bounds__(256, 2) k_phase(P p, int l) {
    extern __shared__ __attribute__((aligned(16))) char lds[];
    if (PH == 0) phase_pro(*kargs(), lds);
    if (PH == 1) phase_g1(*kargs(), l, lds);
    if (PH == 2) phase_post(*kargs(), l, lds);
    if (PH == 3) phase_mla(*kargs(), l, lds);
    if (PH == 4) phase_postmla(*kargs(), l);
    if (PH == 5) phase_att(*kargs(), l, lds);
    if (PH == 6) phase_gn(*kargs(), l);
    if (PH == 7) phase_g2(*kargs(), l, lds);
    if (PH == 8) phase_n2(*kargs(), l);
    if (PH == 9) phase_g3(*kargs(), l, lds);
    if (PH == 10) phase_topk(*kargs(), l, lds);
    if (PH == 11) phase_exp(*kargs(), l);
    if (PH == 13) { const int wave = tid_opaque() >> 6; for (int t = blockIdx.x * 4 + wave; t < T_TOK; t += gridDim.x * 4) expert_token(*kargs(), l, t, l == DEPTH - 1, true); }
    if (PH == 12) { const int wave = tid_opaque() >> 6, lane = tid_opaque() & 63; for (int t = blockIdx.x * 4 + wave; t < T_TOK; t += gridDim.x * 4) rms_row_bf16(kargs()->x + (size_t)t * DM, kargs()->g_mix + l * DM, kargs()->hnb + (size_t)t * DM, nullptr, lane); }
}
#define XB_TMO      128
#define XB_XCNT(j)  (256  + 64 * (j))
#define XB_XSUB(j)  (1280 + 64 * (j))
#define XB_XGEN(j)  (2304 + 64 * (j))
#define XB_TOP      3328
#define XB_TOPGEN   3392
#define XCD_BAR_WORDS 3456
#define XB_SPIN_CAP (1u << 18)
#define LAS __attribute__((address_space(3)))

__device__ __forceinline__ unsigned xb_ld(unsigned* p)              { return __hip_atomic_load(p, __ATOMIC_RELAXED, __HIP_MEMORY_SCOPE_AGENT); }
__device__ __forceinline__ unsigned xb_add(unsigned* p, unsigned v) { return __hip_atomic_fetch_add(p, v, __ATOMIC_RELAXED, __HIP_MEMORY_SCOPE_AGENT); }
__device__ __forceinline__ unsigned xb_xcc_id() { return (unsigned)__builtin_amdgcn_s_getreg((3 << 11) | 20) & 0xFu; }
#define XB_SPIN(cond, bar) do { unsigned _sp = 0; while (cond) { __builtin_amdgcn_s_sleep(1); \
    if ((++_sp & 255u) == 0u) { if (xb_ld(&(bar)[XB_TMO])) break; if (_sp > XB_SPIN_CAP) { atomicAdd(&(bar)[XB_TMO], 1u); break; } } } } while (0)

struct XcdBarrier {
    unsigned* bar; unsigned x;
    volatile LAS unsigned* st;
};

__device__ __forceinline__ XcdBarrier xcd_barrier_post(unsigned* bar, volatile LAS unsigned* st) {
    XcdBarrier b; b.bar = bar; b.x = xb_xcc_id(); b.st = st;
    if (threadIdx.x == 0) (void)xb_add(&bar[XB_XCNT(b.x)], 1u);
    return b;
}
__device__ __forceinline__ void xcd_barrier_complete(unsigned* bar, unsigned x, unsigned& nloc, unsigned& nx) {
    const unsigned G = gridDim.x * gridDim.y * gridDim.z;
    unsigned sum, cnt, mine, sp = 0u;
    for (;;) {
        sum = 0u; cnt = 0u; mine = 0u;
#pragma unroll
        for (unsigned j = 0; j < 16; ++j) { const unsigned c = xb_ld(&bar[XB_XCNT(j)]); sum += c; cnt += (c > 0u) ? 1u : 0u; mine = (j == x) ? c : mine; }
        if (sum == G) break;
        __builtin_amdgcn_s_sleep(1);
        if ((++sp & 255u) == 0u) { if (xb_ld(&bar[XB_TMO])) break; if (sp > XB_SPIN_CAP) { atomicAdd(&bar[XB_TMO], 1u); break; } }
    }
    nloc = mine > 0u ? mine : 1u; nx = cnt > 0u ? cnt : 1u;
}

__device__ __forceinline__ void xcd_barrier(const XcdBarrier& b) {
    asm volatile("s_waitcnt vmcnt(0)" ::: "memory");
    __syncthreads();
    if (threadIdx.x == 0) {
        unsigned* bar = b.bar;
        __builtin_amdgcn_s_waitcnt(0);
        unsigned nloc = b.st[0], nx = b.st[1];
        if (nloc == 0u) { xcd_barrier_complete(bar, b.x, nloc, nx); b.st[0] = nloc; b.st[1] = nx; }
        const unsigned old = xb_add(&bar[XB_XSUB(b.x)], 1u);
        const unsigned gen = old / nloc;
        if (old + 1u == (gen + 1u) * nloc) {
            __builtin_amdgcn_fence(__ATOMIC_RELEASE, "agent");
            asm volatile("s_waitcnt vmcnt(0)" ::: "memory");
            const unsigned og = xb_add(&bar[XB_TOP], 1u);
            const unsigned tg = og / nx;
            if (og + 1u == (tg + 1u) * nx) xb_add(&bar[XB_TOPGEN], 1u);
            else XB_SPIN(xb_ld(&bar[XB_TOPGEN]) == tg, bar);
            __builtin_amdgcn_fence(__ATOMIC_ACQUIRE, "agent");
            xb_add(&bar[XB_XGEN(b.x)], 1u);
            asm volatile("s_waitcnt vmcnt(0)" ::: "memory");
        } else {
            XB_SPIN(xb_ld(&bar[XB_XGEN(b.x)]) == gen, bar);
            __builtin_amdgcn_fence(__ATOMIC_ACQUIRE, "agent");
            asm volatile("s_waitcnt vmcnt(0)" ::: "memory");
        }
    }
    __syncthreads();
}


__global__ void __launch_bounds__(256, 2) k_mega(P p) {
    extern __shared__ __attribute__((aligned(16))) char lds[];
    uint4* xbw = (uint4*)(lds + LDS_BYTES);
    if (threadIdx.x == 0) *xbw = make_uint4(0u, 0u, 0u, 0u);
    __syncthreads();
    XcdBarrier bar = xcd_barrier_post(kargs()->bar, (volatile LAS unsigned*)xbw);
    phase_pro(*kargs(), lds); xcd_barrier(bar);
    for (int l = 0; l < DEPTH; ++l) {
        phase_g1(*kargs(), l, lds); xcd_barrier(bar);
        phase_post(*kargs(), l, lds); xcd_barrier(bar);
        phase_mla(*kargs(), l, lds); xcd_barrier(bar);
        phase_postmla(*kargs(), l); xcd_barrier(bar);
        phase_att(*kargs(), l, lds); xcd_barrier(bar);
        phase_gn(*kargs(), l); xcd_barrier(bar);
        phase_g2(*kargs(), l, lds); xcd_barrier(bar);
        phase_n2(*kargs(), l); xcd_barrier(bar);
        phase_g3(*kargs(), l, lds); xcd_barrier(bar);
        phase_topk(*kargs(), l, lds); xcd_barrier(bar);
        phase_exp(*kargs(), l);
        if (l + 1 < DEPTH) xcd_barrier(bar);
    }
}
#ifndef OPT_MASK
#define OPT_MASK 0x7f
#endif
#ifndef MEGA
#define MEGA 1
#endif
#ifndef PROBE_REPEAT
#define PROBE_REPEAT 0
#endif
static inline size_t align_up(size_t v, size_t a) { return (v + a - 1) / a * a; }
#define DYN_LDS (LDS_BYTES + 64)

template <int PH> static void launch_phase(const P& p, int l, hipStream_t stream) {
    static bool attr_done = false;
    if (!attr_done) { (void)hipFuncSetAttribute((const void*)k_phase<PH>, hipFuncAttributeMaxDynamicSharedMemorySize, DYN_LDS); attr_done = true; }
    k_phase<PH><<<512, 256, DYN_LDS, stream>>>(p, l);
    if ((PROBE_REPEAT >> PH) & 1) k_phase<PH><<<512, 256, DYN_LDS, stream>>>(p, l);
}

extern "C" void kernel_launch(void* const* d_in, const int* in_sizes, int n_in, void* d_out, int out_size, void* d_ws, size_t ws_size,
                              hipStream_t stream) {
    P p{};
    p.x_in = (const float*)d_in[0]; p.g_mix = (const float*)d_in[1]; p.w_in = (const float*)d_in[2]; p.win_sink = (const float*)d_in[3];
    p.ax_q_norm = (const float*)d_in[4]; p.ax_k_norm = (const float*)d_in[5]; p.mla_q_norm = (const float*)d_in[6]; p.mla_kv_norm = (const float*)d_in[7];
    p.mla_w_uq = (const float*)d_in[8]; p.mla_w_ukv = (const float*)d_in[9]; p.g_group = (const float*)d_in[10]; p.w_out = (const float*)d_in[11];
    p.g_ffn = (const float*)d_in[12]; p.peer_w_q = (const float*)d_in[13]; p.peer_sub_keys = (const float*)d_in[14]; p.peer_u = (const float*)d_in[15];
    p.peer_v = (const float*)d_in[16]; p.g_final = (const float*)d_in[17];
    p.out = (float*)d_out;

    char* w = (char*)d_ws; size_t off = 0;
    auto carve = [&](size_t bytes) { void* q = w + off; off = align_up(off + bytes, 256); return q; };
    p.bar = (unsigned*)carve(16384);
    p.x = (float*)carve((size_t)T_TOK * DM * 4);
    p.hnb = (bf16_t*)carve((size_t)T_TOK * DM * 2);
    char* regZ = (char*)carve((size_t)T_TOK * 2048 * 2);
    p.zb = (bf16_t*)regZ; p.qp = (bf16_t*)regZ;
    p.qfull = (bf16_t*)regZ; p.kvfull = (bf16_t*)(regZ + (size_t)T_TOK * 384 * 2);
    QKV& q = p.q;
    q.qA = (bf16_t*)carve((size_t)T_TOK * 256 * 2); q.kA = (bf16_t*)carve((size_t)T_TOK * 128 * 2); q.vA = (bf16_t*)carve((size_t)T_TOK * 128 * 2);
    q.qB = (bf16_t*)carve((size_t)T_TOK * 256 * 2); q.kB = (bf16_t*)carve((size_t)T_TOK * 128 * 2); q.vB = (bf16_t*)carve((size_t)T_TOK * 128 * 2);
    q.qC = (bf16_t*)carve((size_t)T_TOK * 256 * 2); q.kC = (bf16_t*)carve((size_t)T_TOK * 128 * 2); q.vC = (bf16_t*)carve((size_t)T_TOK * 128 * 2);
    q.qD = (bf16_t*)carve((size_t)T_TOK * 384 * 2); q.kD = (bf16_t*)carve((size_t)T_TOK * 384 * 2); q.vD = (bf16_t*)carve((size_t)T_TOK * 256 * 2);
    p.ob = (bf16_t*)carve((size_t)T_TOK * DM * 2);
    p.cqn = p.ob; p.ckvn = p.ob + (size_t)T_TOK * 256;
    p.eidx = (int*)carve((size_t)T_TOK * 128 * 4);
    p.gate = (float*)carve((size_t)T_TOK * 128 * 4);
    p.winT = (bf16_t*)carve((size_t)DEPTH * NZ * DM * 2);
    p.woutT = (bf16_t*)carve((size_t)DEPTH * DM * DM * 2);
    p.wqT = (bf16_t*)carve((size_t)DEPTH * 2048 * DM * 2);
    p.subk = (bf16_t*)carve((size_t)DEPTH * 8 * 2 * 128 * 128 * 2);
    p.wuqT = (bf16_t*)carve((size_t)DEPTH * 384 * 256 * 2);
    p.wukvT = (bf16_t*)carve((size_t)DEPTH * 512 * 128 * 2);
    if (OPT_MASK & 64) {
        p.u8 = (unsigned char*)carve((size_t)DEPTH * 16384 * DM);
        p.v8 = (unsigned char*)carve((size_t)DEPTH * 16384 * DM);
        p.su = (float*)carve((size_t)DEPTH * 16384 * 4);
        p.sv = (float*)carve((size_t)DEPTH * 16384 * 4);
        p.flags = 1;
    }
    Tables& tb = p.tb;
    tb.cos1 = (float*)carve(4096 * 32 * 4); tb.sin1 = (float*)carve(4096 * 32 * 4);
    tb.cosm = (float*)carve(4096 * 16 * 4); tb.sinm = (float*)carve(4096 * 16 * 4);
    tb.cosr = (float*)carve(64 * 16 * 4); tb.sinr = (float*)carve(64 * 16 * 4);
    tb.cosc = (float*)carve(64 * 16 * 4); tb.sinc = (float*)carve(64 * 16 * 4);
    float* hn = nullptr; float *cqn_f = nullptr, *ckvn_f = nullptr, *qfull_f = nullptr, *kvfull_f = nullptr;
    if (OPT_MASK != 0x7f) {
        hn = (float*)carve((size_t)T_TOK * DM * 4);
        cqn_f = (float*)carve((size_t)T_TOK * 256 * 4); ckvn_f = (float*)carve((size_t)T_TOK * 128 * 4);
        qfull_f = (float*)carve((size_t)T_TOK * 384 * 4); kvfull_f = hn;
    }
    if (off > ws_size) { fprintf(stderr, "workspace too small: need %zu have %zu\n", off, ws_size); return; }

#if MEGA
    {
        static int grid = 0;
        if (!grid) {
            int dev = 0, cus = 0, per_cu = 0;
            (void)hipGetDevice(&dev);
            (void)hipDeviceGetAttribute(&cus, hipDeviceAttributeMultiprocessorCount, dev);
            (void)hipFuncSetAttribute((const void*)k_mega, hipFuncAttributeMaxDynamicSharedMemorySize, DYN_LDS);
            (void)hipOccupancyMaxActiveBlocksPerMultiprocessor(&per_cu, k_mega, 256, DYN_LDS);
            if (per_cu < 1) per_cu = 1;
            grid = cus * (per_cu < 2 ? per_cu : 2);
        }
        (void)hipMemsetAsync(p.bar, 0, XCD_BAR_WORDS * sizeof(unsigned), stream);
        k_mega<<<grid, 256, DYN_LDS, stream>>>(p);
        return;
    }
#endif
    const float* x_in = p.x_in; float* x = p.x; float* out = p.out;
    launch_phase<0>(p, 0, stream);

    for (int l = 0; l < DEPTH; ++l) {
        if (OPT_MASK & 1) {
            if (l > 0 && !(OPT_MASK & 64)) launch_phase<12>(p, l, stream);
            launch_phase<1>(p, l, stream);
        } else {
            k_rmsnorm_f32<<<T_TOK / 4, 256, 0, stream>>>(x, p.g_mix + l * DM, hn, T_TOK);
            k_ngemm<float, bf16_t, false><<<dim3((NZ + 127) / 128, T_TOK / 128), 256, 0, stream>>>(hn, DM, p.w_in + (size_t)l * DM * NZ, NZ, p.zb, NZ, nullptr, 0, T_TOK, NZ, DM);
        }
        if (OPT_MASK & 2) {
            launch_phase<2>(p, l, stream); launch_phase<3>(p, l, stream); launch_phase<4>(p, l, stream);
        } else {
            PostArgs pa; pa.z = p.zb; pa.o = q; pa.tb = tb;
            pa.g_qn = p.ax_q_norm + l * 64; pa.g_kn = p.ax_k_norm + l * 64; pa.g_cq = p.mla_q_norm + l * 256; pa.g_ckv = p.mla_kv_norm + l * 128;
            pa.cqn = cqn_f; pa.ckvn = ckvn_f;
            k_post_naive<<<T_TOK, 256, 0, stream>>>(pa);
            k_ngemm<float, float, false><<<dim3(384 / 128, T_TOK / 128), 256, 0, stream>>>(cqn_f, 256, p.mla_w_uq + (size_t)l * 256 * 384, 384, qfull_f, 384, nullptr, 0, T_TOK, 384, 256);
            k_ngemm<float, float, false><<<dim3(512 / 128, T_TOK / 128), 256, 0, stream>>>(ckvn_f, 128, p.mla_w_ukv + (size_t)l * 128 * 512, 512, kvfull_f, 512, nullptr, 0, T_TOK, 512, 128);
            k_post_mla<<<T_TOK, 256, 0, stream>>>(qfull_f, kvfull_f, q, tb);
        }
        if (OPT_MASK & 4) {
            launch_phase<5>(p, l, stream);
        } else {
            k_attn_naive<64, 1><<<NBATCH * 4 * SEQ / 4, 256, 0, stream>>>(q.qA, q.kA, q.vA, p.win_sink + l * 4, p.ob, 4, 2, 0);
            k_attn_naive<64, 0><<<NBATCH * 4 * SEQ / 4, 256, 0, stream>>>(q.qB, q.kB, q.vB, nullptr, p.ob, 4, 2, 256);
            k_attn_naive<64, 2><<<NBATCH * 4 * SEQ / 4, 256, 0, stream>>>(q.qC, q.kC, q.vC, nullptr, p.ob, 4, 2, 512);
            k_attn_naive<96, 0><<<NBATCH * 4 * SEQ / 4, 256, 0, stream>>>(q.qD, q.kD, q.vD, nullptr, p.ob, 4, 4, 768);
        }
        if (OPT_MASK & 8) {
            launch_phase<6>(p, l, stream); launch_phase<7>(p, l, stream);
        } else {
            k_groupnorm_f32<<<T_TOK / 4, 256, 0, stream>>>(p.ob, p.g_group + (size_t)l * 1024, hn);
            k_ngemm<float, float, true><<<dim3(DM / 128, T_TOK / 128), 256, 0, stream>>>(hn, DM, p.w_out + (size_t)l * DM * DM, DM, x, DM, x, DM, T_TOK, DM, DM);
        }
        if (OPT_MASK & 16) {
            launch_phase<8>(p, l, stream); launch_phase<9>(p, l, stream);
            if (!(OPT_MASK & 64)) k_rmsnorm_f32<<<T_TOK / 4, 256, 0, stream>>>(x, p.g_ffn + l * DM, hn, T_TOK);
        } else {
            k_rmsnorm_f32<<<T_TOK / 4, 256, 0, stream>>>(x, p.g_ffn + l * DM, hn, T_TOK);
            k_ngemm<float, bf16_t, false><<<dim3(2048 / 128, T_TOK / 128), 256, 0, stream>>>(hn, DM, p.peer_w_q + (size_t)l * DM * 2048, 2048, p.qp, 2048, nullptr, 0, T_TOK, 2048, DM);
        }
        if (OPT_MASK & 32) launch_phase<10>(p, l, stream);
        else k_peer_topk_naive<<<T_TOK * 8, 64, 0, stream>>>(p.qp, p.peer_sub_keys + (size_t)l * 8 * 2 * 128 * 128, p.eidx, p.gate);
        if ((PROBE_REPEAT >> 13) & 1) launch_phase<13>(p, l, stream);
        if (OPT_MASK & 64) launch_phase<11>(p, l, stream);
        else {
            k_peer_expert_naive<<<T_TOK, 256, 0, stream>>>(hn, p.eidx, p.gate, p.peer_u + (size_t)l * 16384 * DM, p.peer_v + (size_t)l * 16384 * DM, x);
            if (l == DEPTH - 1) k_rmsnorm_f32<<<T_TOK / 4, 256, 0, stream>>>(x, p.g_final, out, T_TOK);
        }
    }
    (void)x_in; (void)in_sizes; (void)n_in; (void)out_size;
}
```

```cpp
#include <hip/hip_runtime.h>
#include <stdint.h>
#include <stdio.h>

typedef unsigned short bf16_t;

#define T_TOK 32768
#define SEQ 4096
#define NBATCH 8
#define DM 1024
#define NZ 1952
#define DEPTH 4
#define LOG2E 1.4426950408889634f

__device__ __forceinline__ float bf2f(bf16_t v) { return __uint_as_float(((unsigned)v) << 16); }
__device__ __forceinline__ bf16_t f2bf(float f) {
    unsigned u = __float_as_uint(f);
    u += 0x7fffu + ((u >> 16) & 1u);
    return (bf16_t)(u >> 16);
}
__device__ __forceinline__ float wave_sum(float v) {
#pragma unroll
    for (int o = 32; o >= 1; o >>= 1) v += __shfl_xor(v, o);
    return v;
}
__device__ __forceinline__ float wave_max(float v) {
#pragma unroll
    for (int o = 32; o >= 1; o >>= 1) v = fmaxf(v, __shfl_xor(v, o));
    return v;
}

struct Tables { float *cos1, *sin1, *cosm, *sinm, *cosr, *sinr, *cosc, *sinc; };

__global__ void k_tables(Tables tb) {
    int i = blockIdx.x * blockDim.x + threadIdx.x;
    if (i < 4096 * 32) {
        int pos = i / 32, j = i % 32;
        float inv = powf(10000.f, -(float)(2 * j) / 64.f);
        float ang = (float)pos * inv;
        tb.cos1[i] = cosf(ang); tb.sin1[i] = sinf(ang);
    }
    if (i < 4096 * 16) {
        int pos = i / 16, j = i % 16;
        float inv = powf(10000.f, -(float)(2 * j) / 32.f);
        float ang = (float)pos * inv;
        tb.cosm[i] = cosf(ang); tb.sinm[i] = sinf(ang);
    }
    if (i < 64 * 16) {
        int pos = i / 16, j = i % 16;
        float inv = powf(10000.f, -(float)(2 * j) / 32.f);
        float ang = (float)pos * inv;
        tb.cosr[i] = cosf(ang); tb.sinr[i] = sinf(ang);
        tb.cosc[i] = cosf(ang); tb.sinc[i] = sinf(ang);
    }
}

__global__ void __launch_bounds__(256) k_rmsnorm_f32(const float* __restrict__ x, const float* __restrict__ g, float* __restrict__ out, int rows) {
    int row = blockIdx.x * 4 + (threadIdx.x >> 6), lane = threadIdx.x & 63;
    if (row >= rows) return;
    const float4* xr = (const float4*)(x + (size_t)row * DM);
    float4 v[4]; float ss = 0.f;
#pragma unroll
    for (int i = 0; i < 4; ++i) { v[i] = xr[lane + 64 * i]; ss += v[i].x * v[i].x + v[i].y * v[i].y + v[i].z * v[i].z + v[i].w * v[i].w; }
    ss = wave_sum(ss);
    float rstd = rsqrtf(ss * (1.f / DM) + 1e-6f);
    float4* orow = (float4*)(out + (size_t)row * DM);
    const float4* g4 = (const float4*)g;
#pragma unroll
    for (int i = 0; i < 4; ++i) {
        float4 gg = g4[lane + 64 * i]; float4 o;
        o.x = v[i].x * rstd * gg.x; o.y = v[i].y * rstd * gg.y; o.z = v[i].z * rstd * gg.z; o.w = v[i].w * rstd * gg.w;
        orow[lane + 64 * i] = o;
    }
}

__global__ void __launch_bounds__(256) k_groupnorm_f32(const bf16_t* __restrict__ o, const float* __restrict__ gg, float* __restrict__ out) {
    int row = blockIdx.x * 4 + (threadIdx.x >> 6), lane = threadIdx.x & 63;
    const bf16_t* orow = o + (size_t)row * DM;
#pragma unroll
    for (int g = 0; g < 4; ++g) {
        float v[4]; float ss = 0.f;
#pragma unroll
        for (int i = 0; i < 4; ++i) { v[i] = bf2f(orow[g * 256 + lane + 64 * i]); ss += v[i] * v[i]; }
        ss = wave_sum(ss);
        float rstd = rsqrtf(ss * (1.f / 256.f) + 1e-6f);
#pragma unroll
        for (int i = 0; i < 4; ++i) out[(size_t)row * DM + g * 256 + lane + 64 * i] = v[i] * rstd * gg[g * 256 + lane + 64 * i];
    }
}

template <typename AT> __device__ __forceinline__ float ldA(const AT* p);
template <> __device__ __forceinline__ float ldA<float>(const float* p) { return *p; }
template <> __device__ __forceinline__ float ldA<bf16_t>(const bf16_t* p) { return bf2f(*p); }
__device__ __forceinline__ void stC(float* p, float v) { *p = v; }
__device__ __forceinline__ void stC(bf16_t* p, float v) { *p = f2bf(v); }

template <typename AT, typename CT, bool RES>
__global__ void __launch_bounds__(256) k_ngemm(const AT* __restrict__ A, int lda, const float* __restrict__ B, int ldb,
                                               CT* C, int ldc, const float* R, int ldr, int M, int N, int K) {
    __shared__ float As[16][132];
    __shared__ float Bs[16][132];
    const int tid = threadIdx.x, tx = tid & 15, ty = tid >> 4;
    const int m0 = blockIdx.y * 128, n0 = blockIdx.x * 128;
    float acc[8][8];
#pragma unroll
    for (int i = 0; i < 8; ++i)
#pragma unroll
        for (int j = 0; j < 8; ++j) acc[i][j] = 0.f;
    const int ar = tid >> 1, ak = (tid & 1) * 8;
    const int bk = tid >> 4, bn = (tid & 15) * 8;
    for (int k0 = 0; k0 < K; k0 += 16) {
#pragma unroll
        for (int i = 0; i < 8; ++i) As[ak + i][ar] = ldA<AT>(A + (size_t)(m0 + ar) * lda + k0 + ak + i);
#pragma unroll
        for (int i = 0; i < 8; ++i) { int n = n0 + bn + i; Bs[bk][bn + i] = (n < N) ? B[(size_t)(k0 + bk) * ldb + n] : 0.f; }
        __syncthreads();
#pragma unroll
        for (int kk = 0; kk < 16; ++kk) {
            float a[8], b[8];
#pragma unroll
            for (int i = 0; i < 8; ++i) a[i] = As[kk][ty * 8 + i];
#pragma unroll
            for (int j = 0; j < 8; ++j) b[j] = Bs[kk][tx * 8 + j];
#pragma unroll
            for (int i = 0; i < 8; ++i)
#pragma unroll
                for (int j = 0; j < 8; ++j) acc[i][j] += a[i] * b[j];
        }
        __syncthreads();
    }
#pragma unroll
    for (int i = 0; i < 8; ++i) {
        int m = m0 + ty * 8 + i;
#pragma unroll
        for (int j = 0; j < 8; ++j) {
            int n = n0 + tx * 8 + j;
            if (n < N) {
                float v = acc[i][j];
                if (RES) v += R[(size_t)m * ldr + n];
                stC(C + (size_t)m * ldc + n, v);
            }
        }
    }
}

struct QKV {
    bf16_t *qA, *kA, *vA, *qB, *kB, *vB, *qC, *kC, *vC, *qD, *kD, *vD;
};
struct PostArgs {
    const bf16_t* z; QKV o; Tables tb;
    const float *g_qn, *g_kn, *g_cq, *g_ckv;
    float *cqn, *ckvn;
};

__global__ void __launch_bounds__(256) k_post_naive(PostArgs a) {
    __shared__ float zr[NZ];
    __shared__ float hs[8];
    const int t = blockIdx.x, tid = threadIdx.x;
    const int b = t / SEQ, s = t % SEQ;
    for (int i = tid; i < NZ; i += 256) zr[i] = bf2f(a.z[(size_t)t * NZ + i]);
    __syncthreads();
    if (tid < 8) {
        int base, n;
        if (tid < 4) { base = 512 + tid * 64; n = 64; }
        else if (tid < 6) { base = 768 + (tid - 4) * 64; n = 64; }
        else if (tid == 6) { base = 1536; n = 256; }
        else { base = 1792; n = 128; }
        float ss = 0.f;
        for (int i = 0; i < n; ++i) ss += zr[base + i] * zr[base + i];
        hs[tid] = rsqrtf(ss / (float)n + 1e-6f);
    }
    __syncthreads();
    const float scA = 0.125f * LOG2E;
    const float scD = 0.10206207261596575f * LOG2E;
    for (int mix = 0; mix < 2; ++mix) {
        const int zb = mix == 0 ? 0 : 1024;
        bf16_t* qo = mix == 0 ? a.o.qA : a.o.qC;
        bf16_t* ko = mix == 0 ? a.o.kA : a.o.kC;
        bf16_t* vo = mix == 0 ? a.o.vA : a.o.vC;
        for (int i = tid; i < 128; i += 256) {
            int h = i / 32, j = i % 32;
            float x1 = zr[zb + h * 64 + j], x2 = zr[zb + h * 64 + 32 + j];
            float c = a.tb.cos1[s * 32 + j], sn = a.tb.sin1[s * 32 + j];
            size_t ob = ((size_t)(b * 4 + h) * SEQ + s) * 64;
            qo[ob + j] = f2bf((x1 * c - x2 * sn) * scA);
            qo[ob + 32 + j] = f2bf((x2 * c + x1 * sn) * scA);
        }
        for (int i = tid; i < 64; i += 256) {
            int h = i / 32, j = i % 32;
            float x1 = zr[zb + 256 + h * 64 + j], x2 = zr[zb + 256 + h * 64 + 32 + j];
            float c = a.tb.cos1[s * 32 + j], sn = a.tb.sin1[s * 32 + j];
            size_t ob = ((size_t)(b * 2 + h) * SEQ + s) * 64;
            ko[ob + j] = f2bf(x1 * c - x2 * sn);
            ko[ob + 32 + j] = f2bf(x2 * c + x1 * sn);
        }
        for (int i = tid; i < 128; i += 256) {
            int h = i / 64, j = i % 64;
            vo[((size_t)(b * 2 + h) * SEQ + s) * 64 + j] = f2bf(zr[zb + 384 + i]);
        }
    }
    {
        const int row = s / 64, col = s % 64;
        for (int i = tid; i < 192; i += 256) {
            int hh = i / 32, r = i % 32, half = r / 16, j = r % 16;
            bool isq = hh < 4;
            int zb = isq ? 512 + hh * 64 : 768 + (hh - 4) * 64;
            const float* gn = isq ? a.g_qn : a.g_kn;
            float rstd = hs[hh];
            int d1 = half * 32 + j, d2 = half * 32 + 16 + j;
            float x1 = zr[zb + d1] * rstd * gn[d1], x2 = zr[zb + d2] * rstd * gn[d2];
            float c, sn;
            if (half == 0) { c = a.tb.cosr[row * 16 + j]; sn = a.tb.sinr[row * 16 + j]; }
            else { c = a.tb.cosc[col * 16 + j]; sn = a.tb.sinc[col * 16 + j]; }
            float o1 = x1 * c - x2 * sn, o2 = x2 * c + x1 * sn;
            if (isq) {
                size_t ob = ((size_t)(b * 4 + hh) * SEQ + s) * 64;
                a.o.qB[ob + d1] = f2bf(o1 * scA); a.o.qB[ob + d2] = f2bf(o2 * scA);
            } else {
                size_t ob = ((size_t)(b * 2 + (hh - 4)) * SEQ + s) * 64;
                a.o.kB[ob + d1] = f2bf(o1); a.o.kB[ob + d2] = f2bf(o2);
            }
        }
        for (int i = tid; i < 128; i += 256) {
            int h = i / 64, j = i % 64;
            a.o.vB[((size_t)(b * 2 + h) * SEQ + s) * 64 + j] = f2bf(zr[896 + i]);
        }
    }
    for (int i = tid; i < 256; i += 256) a.cqn[(size_t)t * 256 + i] = zr[1536 + i] * hs[6] * a.g_cq[i];
    for (int i = tid; i < 128; i += 256) a.ckvn[(size_t)t * 128 + i] = zr[1792 + i] * hs[7] * a.g_ckv[i];
    for (int i = tid; i < 16; i += 256) {
        float x1 = zr[1920 + i], x2 = zr[1920 + 16 + i];
        float c = a.tb.cosm[s * 16 + i], sn = a.tb.sinm[s * 16 + i];
        bf16_t o1 = f2bf(x1 * c - x2 * sn), o2 = f2bf(x2 * c + x1 * sn);
        for (int h = 0; h < 4; ++h) {
            size_t ob = ((size_t)(b * 4 + h) * SEQ + s) * 96;
            a.o.kD[ob + 64 + i] = o1; a.o.kD[ob + 80 + i] = o2;
        }
    }
    (void)scD;
}

__global__ void __launch_bounds__(256) k_post_mla(const float* __restrict__ qfull, const float* __restrict__ kvfull, QKV o, Tables tb) {
    const int t = blockIdx.x, tid = threadIdx.x;
    const int b = t / SEQ, s = t % SEQ;
    const float scD = 0.10206207261596575f * LOG2E;
    {
        int h = tid / 64, j = tid % 64;
        o.qD[((size_t)(b * 4 + h) * SEQ + s) * 96 + j] = f2bf(qfull[(size_t)t * 384 + h * 96 + j] * scD);
    }
    if (tid < 64) {
        int h = tid / 16, j = tid % 16;
        float x1 = qfull[(size_t)t * 384 + h * 96 + 64 + j], x2 = qfull[(size_t)t * 384 + h * 96 + 80 + j];
        float c = tb.cosm[s * 16 + j], sn = tb.sinm[s * 16 + j];
        size_t ob = ((size_t)(b * 4 + h) * SEQ + s) * 96;
        o.qD[ob + 64 + j] = f2bf((x1 * c - x2 * sn) * scD);
        o.qD[ob + 80 + j] = f2bf((x2 * c + x1 * sn) * scD);
    }
    {
        int h = tid / 64, j = tid % 64;
        o.kD[((size_t)(b * 4 + h) * SEQ + s) * 96 + j] = f2bf(kvfull[(size_t)t * 512 + h * 128 + j]);
        o.vD[((size_t)(b * 4 + h) * SEQ + s) * 64 + j] = f2bf(kvfull[(size_t)t * 512 + h * 128 + 64 + j]);
    }
}

template <int DK, int MODE>
__global__ void __launch_bounds__(256) k_attn_naive(const bf16_t* __restrict__ Q, const bf16_t* __restrict__ K, const bf16_t* __restrict__ V,
                                                    const float* __restrict__ sink, bf16_t* __restrict__ O, int H, int KV, int ocol) {
    const int wave = threadIdx.x >> 6, lane = threadIdx.x & 63;
    const int gq = blockIdx.x * 4 + wave;
    const int s = gq % SEQ, bh = gq / SEQ, h = bh % H, b = bh / H;
    const int kvh = h / (H / KV);
    const bf16_t* qrow = Q + (size_t)gq * DK;
    const bf16_t* Kb = K + (size_t)(b * KV + kvh) * SEQ * DK;
    const bf16_t* Vb = V + (size_t)(b * KV + kvh) * SEQ * 64;
    const int sub = lane & 7, grp = lane >> 3;
    constexpr int NCH = DK / 8;
    float q0[8], q1[8];
    {
        uint4 r = *(const uint4*)(qrow + sub * 8);
        const bf16_t* p = (const bf16_t*)&r;
#pragma unroll
        for (int i = 0; i < 8; ++i) q0[i] = bf2f(p[i]);
        const bool has1 = (NCH > 8) && (sub + 8 < NCH);
        uint4 r1 = make_uint4(0, 0, 0, 0);
        if (has1) r1 = *(const uint4*)(qrow + (sub + 8) * 8);
        const bf16_t* p1 = (const bf16_t*)&r1;
#pragma unroll
        for (int i = 0; i < 8; ++i) q1[i] = bf2f(p1[i]);
    }
    float m = -1e30f, l = 0.f, acc[8];
#pragma unroll
    for (int i = 0; i < 8; ++i) acc[i] = 0.f;
    if (MODE == 1 && grp == 0) { m = sink[h] * LOG2E; l = 1.f; }
    const int nk = MODE == 0 ? SEQ : (MODE == 1 ? 257 : 387);
    for (int base = 0; base < nk; base += 8) {
        const int kk = base + grp;
        bool valid = kk < nk;
        int tok;
        if (MODE == 0) tok = kk;
        else if (MODE == 1) tok = s - 128 + kk;
        else { int p = kk / 129, j = kk % 129; int r = p == 0 ? 1 : (p == 1 ? 4 : 16); tok = s + (j - 64) * r; }
        valid = valid && tok >= 0 && tok < SEQ;
        float sc = 0.f;
        if (valid) {
            uint4 r = *(const uint4*)(Kb + (size_t)tok * DK + sub * 8);
            const bf16_t* p = (const bf16_t*)&r;
#pragma unroll
            for (int i = 0; i < 8; ++i) sc += q0[i] * bf2f(p[i]);
            if (NCH > 8 && sub + 8 < NCH) {
                uint4 r1 = *(const uint4*)(Kb + (size_t)tok * DK + (sub + 8) * 8);
                const bf16_t* p1 = (const bf16_t*)&r1;
#pragma unroll
                for (int i = 0; i < 8; ++i) sc += q1[i] * bf2f(p1[i]);
            }
        }
        sc += __shfl_xor(sc, 1); sc += __shfl_xor(sc, 2); sc += __shfl_xor(sc, 4);
        if (valid) {
            float mn = fmaxf(m, sc);
            float f = exp2f(m - mn), p = exp2f(sc - mn);
            uint4 r = *(const uint4*)(Vb + (size_t)tok * 64 + sub * 8);
            const bf16_t* pv = (const bf16_t*)&r;
            l = l * f + p;
#pragma unroll
            for (int i = 0; i < 8; ++i) acc[i] = acc[i] * f + p * bf2f(pv[i]);
            m = mn;
        }
    }
    float M = m;
    M = fmaxf(M, __shfl_xor(M, 8)); M = fmaxf(M, __shfl_xor(M, 16)); M = fmaxf(M, __shfl_xor(M, 32));
    float f = exp2f(m - M);
    l *= f;
    l += __shfl_xor(l, 8); l += __shfl_xor(l, 16); l += __shfl_xor(l, 32);
#pragma unroll
    for (int i = 0; i < 8; ++i) {
        float v = acc[i] * f;
        v += __shfl_xor(v, 8); v += __shfl_xor(v, 16); v += __shfl_xor(v, 32);
        acc[i] = v;
    }
    if (grp == 0) {
        const int t = b * SEQ + s;
        float inv = 1.f / l;
#pragma unroll
        for (int i = 0; i < 8; ++i) O[(size_t)t * DM + ocol + h * 64 + sub * 8 + i] = f2bf(acc[i] * inv);
    }
}

__global__ void __launch_bounds__(64) k_peer_topk_naive(const bf16_t* __restrict__ qp, const float* __restrict__ subk  ,
                                                        int* __restrict__ eidx, float* __restrict__ gate) {
    __shared__ float qs[256];
    __shared__ float s12[2][16];
    __shared__ int i12[2][16];
    const int t = blockIdx.x >> 3, h = blockIdx.x & 7, lane = threadIdx.x;
    for (int i = lane; i < 256; i += 64) qs[i] = bf2f(qp[(size_t)t * 2048 + h * 256 + i]);
    __syncthreads();
    float sc[2][2];
#pragma unroll
    for (int c = 0; c < 2; ++c)
#pragma unroll
        for (int u = 0; u < 2; ++u) {
            int n = lane + 64 * u;
            const float* kr = subk + ((size_t)(h * 2 + c) * 128 + n) * 128;
            float a = 0.f;
            for (int d = 0; d < 128; ++d) a += qs[c * 128 + d] * kr[d];
            sc[c][u] = a;
        }
#pragma unroll
    for (int c = 0; c < 2; ++c) {
        for (int r = 0; r < 16; ++r) {
            float bv; int bi;
            if (sc[c][0] >= sc[c][1]) { bv = sc[c][0]; bi = lane; } else { bv = sc[c][1]; bi = lane + 64; }
#pragma unroll
            for (int o = 32; o >= 1; o >>= 1) {
                float ov = __shfl_xor(bv, o); int oi = __shfl_xor(bi, o);
                if (ov > bv || (ov == bv && oi < bi)) { bv = ov; bi = oi; }
            }
            if (bi == lane) sc[c][0] = -3e38f;
            if (bi == lane + 64) sc[c][1] = -3e38f;
            if (lane == 0) { s12[c][r] = bv; i12[c][r] = bi; }
        }
    }
    __syncthreads();
    float cv[4]; int ci[4];
#pragma unroll
    for (int u = 0; u < 4; ++u) {
        int id = lane + 64 * u;
        cv[u] = s12[0][id / 16] + s12[1][id % 16];
        ci[u] = i12[0][id / 16] * 128 + i12[1][id % 16];
    }
    float best = 0.f; int be = 0;
    for (int r = 0; r < 16; ++r) {
        float bv = cv[0]; int bu = 0;
#pragma unroll
        for (int u = 1; u < 4; ++u) if (cv[u] > bv) { bv = cv[u]; bu = u; }
        int bid = lane + 64 * bu;
#pragma unroll
        for (int o = 32; o >= 1; o >>= 1) {
            float ov = __shfl_xor(bv, o); int oi = __shfl_xor(bid, o);
            if (ov > bv || (ov == bv && oi < bid)) { bv = ov; bid = oi; }
        }
        int e = 0;
#pragma unroll
        for (int u = 0; u < 4; ++u) if (bid == lane + 64 * u) { cv[u] = -3e38f; e = ci[u]; }
        e = __shfl(e, bid & 63);
        if (lane == r) { best = bv; be = e; }
    }
    float mx = lane < 16 ? best : -3e38f;
    mx = wave_max(mx);
    float ex = lane < 16 ? expf(best - mx) : 0.f;
    float sm = wave_sum(ex);
    if (lane < 16) {
        eidx[(size_t)t * 128 + h * 16 + lane] = be;
        gate[(size_t)t * 128 + h * 16 + lane] = ex / sm;
    }
}

__global__ void __launch_bounds__(256) k_peer_expert_naive(const float* __restrict__ hn, const int* __restrict__ eidx, const float* __restrict__ gate,
                                                           const float* __restrict__ ut, const float* __restrict__ vt, float* __restrict__ x) {
    __shared__ float hs[DM];
    __shared__ float wg[128];
    __shared__ int es[128];
    const int t = blockIdx.x, tid = threadIdx.x, wave = tid >> 6, lane = tid & 63;
    for (int i = tid; i < DM; i += 256) hs[i] = hn[(size_t)t * DM + i];
    if (tid < 128) es[tid] = eidx[(size_t)t * 128 + tid];
    __syncthreads();
    for (int p = wave * 32; p < wave * 32 + 32; ++p) {
        const float* ur = ut + (size_t)es[p] * DM;
        float a = 0.f;
#pragma unroll
        for (int i = 0; i < 16; ++i) a += ur[lane + 64 * i] * hs[lane + 64 * i];
        a = wave_sum(a);
        if (lane == 0) {
            float ge = 0.5f * a * (1.f + erff(a * 0.70710678118654752f));
            wg[p] = gate[(size_t)t * 128 + p] * ge;
        }
    }
    __syncthreads();
    float o[4] = {0.f, 0.f, 0.f, 0.f};
    for (int p = 0; p < 128; ++p) {
        const float* vr = vt + (size_t)es[p] * DM;
        float w = wg[p];
#pragma unroll
        for (int i = 0; i < 4; ++i) o[i] += w * vr[tid + 256 * i];
    }
#pragma unroll
    for (int i = 0; i < 4; ++i) x[(size_t)t * DM + tid + 256 * i] += o[i];
}

using bf16x8 = __attribute__((ext_vector_type(8))) short;
using s16x4 = __attribute__((ext_vector_type(4))) short;
using f32x16 = __attribute__((ext_vector_type(16))) float;
typedef __attribute__((ext_vector_type(2))) __bf16 bf16x2_t;

#define NBLK_THREADS 256
#define LDS_BYTES 65536

__device__ __forceinline__ unsigned cvtpk(float lo, float hi) {
    unsigned r; asm("v_cvt_pk_bf16_f32 %0, %1, %2" : "=v"(r) : "v"(lo), "v"(hi)); return r;
}
__device__ __forceinline__ int tid_opaque() { int t = threadIdx.x; asm volatile("" : "+v"(t)); return t; }
__device__ __forceinline__ int crow(int i, int hh) { return (i & 3) + 8 * (i >> 2) + 4 * hh; }
__device__ __forceinline__ float xhalf(float v) { return __shfl_xor(v, 32); }
__device__ __forceinline__ float xhalf_max(float v) { auto rr = __builtin_amdgcn_permlane32_swap(__float_as_uint(v), __float_as_uint(v), false, false); return fmaxf(__uint_as_float(rr[0]), __uint_as_float(rr[1])); }
__device__ __forceinline__ float xhalf_sum(float v) { auto rr = __builtin_amdgcn_permlane32_swap(__float_as_uint(v), __float_as_uint(v), false, false); return __uint_as_float(rr[0]) + __uint_as_float(rr[1]); }

struct P {
    const float *x_in, *g_mix, *w_in, *win_sink, *ax_q_norm, *ax_k_norm, *mla_q_norm, *mla_kv_norm, *mla_w_uq, *mla_w_ukv, *g_group, *w_out,
        *g_ffn, *peer_w_q, *peer_sub_keys, *peer_u, *peer_v, *g_final;
    float* out;
    float* x; bf16_t* hnb; bf16_t* zb; QKV q; bf16_t* ob; bf16_t* qp; int* eidx; float* gate;
    bf16_t *cqn, *ckvn, *qfull, *kvfull;
    bf16_t *winT, *woutT, *wqT, *subk, *wuqT, *wukvT;
    unsigned char *u8, *v8; float *su, *sv;
    Tables tb;
    unsigned* bar;
    int flags; int pad0;
};
typedef const P __attribute__((address_space(4))) PC;
__device__ __forceinline__ PC* kargs() { PC* q = (PC*)__builtin_amdgcn_kernarg_segment_ptr(); asm volatile("" : "+s"(q)); return q; }

struct EpiStoreBf16 {
    bf16_t* C; int ldc; int N;
    __device__ __forceinline__ void operator()(const f32x16 (&acc)[2][2], int mbase, int nbase, int r32, int hh) const {
#pragma unroll
        for (int mt = 0; mt < 2; ++mt)
#pragma unroll
            for (int nt = 0; nt < 2; ++nt) {
                const int n = nbase + nt * 32 + r32;
                if (n < N) {
#pragma unroll
                    for (int i = 0; i < 16; ++i) {
                        const int m = mbase + mt * 32 + crow(i, hh);
                        C[(size_t)m * ldc + n] = f2bf(acc[mt][nt][i]);
                    }
                }
            }
    }
};
struct EpiResidF32 {
    float* X; int ldx;
    __device__ __forceinline__ void operator()(const f32x16 (&acc)[2][2], int mbase, int nbase, int r32, int hh) const {
#pragma unroll
        for (int mt = 0; mt < 2; ++mt)
#pragma unroll
            for (int nt = 0; nt < 2; ++nt) {
                const int n = nbase + nt * 32 + r32;
#pragma unroll
                for (int i = 0; i < 16; ++i) {
                    const int m = mbase + mt * 32 + crow(i, hh);
                    float* p = X + (size_t)m * ldx + n;
                    *p = *p + acc[mt][nt][i];
                }
            }
    }
};

template <class Epi>
__device__ __forceinline__ void gemm_tile(const bf16_t* __restrict__ X, int ldx, const bf16_t* __restrict__ W, int ldw, int K, int m0, int n0, int N,
                                          char* lds, const Epi& epi) {
    const int tid = tid_opaque(), lane = tid & 63, wave = tid >> 6;
    const int wm = wave >> 1, wn = wave & 1;
    const int r32 = lane & 31, hh = lane >> 5;
    const int lrow = tid >> 3, lc = tid & 7;
    const bf16_t* xg = X + (size_t)(m0 + lrow) * ldx + lc * 8;
    const bf16_t* wg[4];
#pragma unroll
    for (int j = 0; j < 4; ++j) { int n = n0 + lrow + 32 * j; n = n < N ? n : N - 1; wg[j] = W + (size_t)n * ldw + lc * 8; }
    uint4 xr0, xr1, xr2, xr3, wr0, wr1, wr2, wr3;
    f32x16 acc[2][2];
#pragma unroll
    for (int a = 0; a < 2; ++a)
#pragma unroll
        for (int b = 0; b < 2; ++b)
#pragma unroll
            for (int i = 0; i < 16; ++i) acc[a][b][i] = 0.f;
    const int nk = K >> 6;
    int soff0, soff1, soff2, soff3;
    { int r;
      r = lrow;      soff0 = r * 128 + ((lc ^ ((r >> 1) & 7)) << 4);
      r = lrow + 32; soff1 = r * 128 + ((lc ^ ((r >> 1) & 7)) << 4);
      r = lrow + 64; soff2 = r * 128 + ((lc ^ ((r >> 1) & 7)) << 4);
      r = lrow + 96; soff3 = r * 128 + ((lc ^ ((r >> 1) & 7)) << 4); }
    const bf16_t* xg1 = xg + (size_t)32 * ldx; const bf16_t* xg2 = xg + (size_t)64 * ldx; const bf16_t* xg3 = xg + (size_t)96 * ldx;
#define GLOAD(KO) do { xr0 = *(const uint4*)(xg + (KO)); xr1 = *(const uint4*)(xg1 + (KO)); xr2 = *(const uint4*)(xg2 + (KO)); xr3 = *(const uint4*)(xg3 + (KO)); \
                       wr0 = *(const uint4*)(wg[0] + (KO)); wr1 = *(const uint4*)(wg[1] + (KO)); wr2 = *(const uint4*)(wg[2] + (KO)); wr3 = *(const uint4*)(wg[3] + (KO)); } while (0)
#define LSTORE(BASE) do { char* _b = (BASE); *(uint4*)(_b + soff0) = xr0; *(uint4*)(_b + soff1) = xr1; *(uint4*)(_b + soff2) = xr2; *(uint4*)(_b + soff3) = xr3; \
                       *(uint4*)(_b + 16384 + soff0) = wr0; *(uint4*)(_b + 16384 + soff1) = wr1; *(uint4*)(_b + 16384 + soff2) = wr2; *(uint4*)(_b + 16384 + soff3) = wr3; } while (0)
    GLOAD(0);
    LSTORE(lds);
    { const int k1 = (nk > 1 ? 1 : 0) * 64; GLOAD(k1); }
    __syncthreads();
    for (int kt = 0; kt < nk; ++kt) {
        LSTORE(lds + ((kt + 1) & 1) * 32768);
        { const int k2 = (kt + 2 < nk ? kt + 2 : nk - 1) * 64; GLOAD(k2); }
        __builtin_amdgcn_sched_barrier(0);
        const char* xs = lds + (kt & 1) * 32768; const char* ws = xs + 16384;
#pragma unroll
        for (int ks = 0; ks < 4; ++ks) {
            bf16x8 xf[2], wf[2];
#pragma unroll
            for (int mt = 0; mt < 2; ++mt) { const int r = wm * 64 + mt * 32 + r32; xf[mt] = *(const bf16x8*)(xs + r * 128 + (((ks * 2 + hh) ^ ((r >> 1) & 7)) << 4)); }
#pragma unroll
            for (int nt = 0; nt < 2; ++nt) { const int r = wn * 64 + nt * 32 + r32; wf[nt] = *(const bf16x8*)(ws + r * 128 + (((ks * 2 + hh) ^ ((r >> 1) & 7)) << 4)); }
#pragma unroll
            for (int mt = 0; mt < 2; ++mt)
#pragma unroll
                for (int nt = 0; nt < 2; ++nt) acc[mt][nt] = __builtin_amdgcn_mfma_f32_32x32x16_bf16(xf[mt], wf[nt], acc[mt][nt], 0, 0, 0);
        }
        __syncthreads();
    }
#undef GLOAD
#undef LSTORE
    epi(acc, m0 + wm * 64, n0 + wn * 64, r32, hh);
}

__device__ __forceinline__ void tile_map(int tile, int ntm, int ntn, int& mt, int& nt) {
    if ((ntn & 7) == 0) {
        const int G = gridDim.x;
        const int round = tile / G, bi = tile % G;
        const int x = bi & 7, j = bi >> 3;
        const int per = G >> 3;
        const int id = (round * 8 + x) * per + j;
        const int st = id >> 6, in = id & 63;
        const int snt = ntn >> 3;
        const int sm = st / snt, sn = st % snt;
        mt = sm * 8 + (in >> 3); nt = sn * 8 + (in & 7);
    } else { mt = tile / ntn; nt = tile % ntn; }
}

template <class Epi>
__device__ __forceinline__ void gemm_phase(const bf16_t* X, int ldx, const bf16_t* W, int ldw, int M, int N, int K, char* lds, const Epi& epi) {
    const int ntm = M >> 7, ntn = (N + 127) >> 7, nt_tot = ntm * ntn;
    for (int tile = blockIdx.x; tile < nt_tot; tile += gridDim.x) {
        int mt, nt;
        if ((gridDim.x & 7) == 0 && (gridDim.x >> 3) * 8 == gridDim.x && ((gridDim.x >> 3) & 63) == 0) tile_map(tile, ntm, ntn, mt, nt);
        else { mt = tile / ntn; nt = tile % ntn; }
        if (mt < ntm && nt < ntn) gemm_tile(X, ldx, W, ldw, K, mt * 128, nt * 128, N, lds, epi);
    }
}

template <int OFF> __device__ __forceinline__ s16x4 tr_read(int vb) {
    s16x4 r; asm volatile("ds_read_b64_tr_b16 %0, %1 offset:%2" : "=&v"(r) : "v"(vb), "i"(OFF) : "memory"); return r;
}
#define VS_BYTES 192

template <int KT2>
__device__ __forceinline__ void pv_sub(f32x16 (&o)[2], const f32x16& p, int vbase) {
    bf16x8 pf[2];
#pragma unroll
    for (int s2 = 0; s2 < 2; ++s2) {
        unsigned a = cvtpk(p[8 * s2 + 0], p[8 * s2 + 1]), b = cvtpk(p[8 * s2 + 2], p[8 * s2 + 3]);
        unsigned c = cvtpk(p[8 * s2 + 4], p[8 * s2 + 5]), d = cvtpk(p[8 * s2 + 6], p[8 * s2 + 7]);
        uint4 w = make_uint4(a, b, c, d);
        pf[s2] = *(bf16x8*)&w;
    }
    {
        s16x4 l00 = tr_read<(KT2 * 32 + 0) * VS_BYTES + 0>(vbase), h00 = tr_read<(KT2 * 32 + 8) * VS_BYTES + 0>(vbase);
        s16x4 l01 = tr_read<(KT2 * 32 + 0) * VS_BYTES + 64>(vbase), h01 = tr_read<(KT2 * 32 + 8) * VS_BYTES + 64>(vbase);
        s16x4 l10 = tr_read<(KT2 * 32 + 16) * VS_BYTES + 0>(vbase), h10 = tr_read<(KT2 * 32 + 24) * VS_BYTES + 0>(vbase);
        s16x4 l11 = tr_read<(KT2 * 32 + 16) * VS_BYTES + 64>(vbase), h11 = tr_read<(KT2 * 32 + 24) * VS_BYTES + 64>(vbase);
        asm volatile("s_waitcnt lgkmcnt(0)" ::: "memory");
        __builtin_amdgcn_sched_barrier(0);
#define PKV(L, H) (bf16x8){L[0], L[1], L[2], L[3], H[0], H[1], H[2], H[3]}
        o[0] = __builtin_amdgcn_mfma_f32_32x32x16_bf16(PKV(l00, h00), pf[0], o[0], 0, 0, 0);
        o[1] = __builtin_amdgcn_mfma_f32_32x32x16_bf16(PKV(l01, h01), pf[0], o[1], 0, 0, 0);
        o[0] = __builtin_amdgcn_mfma_f32_32x32x16_bf16(PKV(l10, h10), pf[1], o[0], 0, 0, 0);
        o[1] = __builtin_amdgcn_mfma_f32_32x32x16_bf16(PKV(l11, h11), pf[1], o[1], 0, 0, 0);
#undef PKV
    }
}


#define PV_LOAD(KT2, VB, F) \
    const s16x4 F##0 = tr_read<((KT2) * 32 + 0) * VS_BYTES + 0>(VB), F##1 = tr_read<((KT2) * 32 + 8) * VS_BYTES + 0>(VB), \
                F##2 = tr_read<((KT2) * 32 + 0) * VS_BYTES + 64>(VB), F##3 = tr_read<((KT2) * 32 + 8) * VS_BYTES + 64>(VB), \
                F##4 = tr_read<((KT2) * 32 + 16) * VS_BYTES + 0>(VB), F##5 = tr_read<((KT2) * 32 + 24) * VS_BYTES + 0>(VB), \
                F##6 = tr_read<((KT2) * 32 + 16) * VS_BYTES + 64>(VB), F##7 = tr_read<((KT2) * 32 + 24) * VS_BYTES + 64>(VB)
#define PKV2(L, H) (bf16x8){L[0], L[1], L[2], L[3], H[0], H[1], H[2], H[3]}
#define PV_MMA(O, P, F) do { bf16x8 _pf0, _pf1; \
        { uint4 _w = make_uint4(cvtpk(P[0], P[1]), cvtpk(P[2], P[3]), cvtpk(P[4], P[5]), cvtpk(P[6], P[7])); _pf0 = *(bf16x8*)&_w; } \
        { uint4 _w = make_uint4(cvtpk(P[8], P[9]), cvtpk(P[10], P[11]), cvtpk(P[12], P[13]), cvtpk(P[14], P[15])); _pf1 = *(bf16x8*)&_w; } \
        O[0] = __builtin_amdgcn_mfma_f32_32x32x16_bf16(PKV2(F##0, F##1), _pf0, O[0], 0, 0, 0); \
        O[1] = __builtin_amdgcn_mfma_f32_32x32x16_bf16(PKV2(F##2, F##3), _pf0, O[1], 0, 0, 0); \
        O[0] = __builtin_amdgcn_mfma_f32_32x32x16_bf16(PKV2(F##4, F##5), _pf1, O[0], 0, 0, 0); \
        O[1] = __builtin_amdgcn_mfma_f32_32x32x16_bf16(PKV2(F##6, F##7), _pf1, O[1], 0, 0, 0); } while (0)

template <int DK, int G, bool WINDOW>
__device__ __forceinline__ void attn_item(const bf16_t* __restrict__ Q, const bf16_t* __restrict__ K, const bf16_t* __restrict__ V, const float* __restrict__ sink,
                                          bf16_t* __restrict__ O, int ocol, int H, int KV, int item, char* lds) {
    constexpr int KS = DK * 2 + 16;
    constexpr int KCH = DK / 8;
    constexpr int KLD = (64 * KCH) / 256;
    constexpr int QB = 128 / G;
    constexpr int NCH = SEQ / QB;
    constexpr int KBUF = 64 * KS, VBUF = 64 * VS_BYTES;
    const int tid = tid_opaque(), lane = tid & 63, wave = tid >> 6;
    const int r32 = lane & 31, hh = lane >> 5;
    const int chunk = item % NCH, kvh = (item / NCH) % KV, b = item / (NCH * KV);
    const int g = (G == 2) ? (wave >> 1) : 0;
    const int qoff = (G == 2) ? (wave & 1) * 32 : wave * 32;
    const int head = kvh * G + g;
    const int q0 = chunk * QB;
    const int qpos = q0 + qoff + r32;
    bf16x8 qf[DK / 16];
    {
        const bf16_t* qp = Q + ((size_t)(b * H + head) * SEQ + qpos) * DK + hh * 8;
#pragma unroll
        for (int ks = 0; ks < DK / 16; ++ks) qf[ks] = *(const bf16x8*)(qp + ks * 16);
    }
    int kt_lo = 0, kt_hi = SEQ / 64;
    if (WINDOW) { kt_lo = q0 / 64 - 2; if (kt_lo < 0) kt_lo = 0; kt_hi = (q0 + QB) / 64 + 2; if (kt_hi > SEQ / 64) kt_hi = SEQ / 64; }
    const char* Kg = (const char*)(K + (size_t)(b * KV + kvh) * SEQ * DK);
    const char* Vg = (const char*)(V + (size_t)(b * KV + kvh) * SEQ * 64);
    uint4 kr0, kr1, kr2 = make_uint4(0, 0, 0, 0), vr0, vr1;
    int koff[KLD], voff[2];
#pragma unroll
    for (int j = 0; j < KLD; ++j) { const int id = tid + 256 * j; koff[j] = (id / KCH) * KS + (id % KCH) * 16; }
#pragma unroll
    for (int j = 0; j < 2; ++j) { const int id = tid + 256 * j; voff[j] = (id >> 3) * VS_BYTES + (id & 7) * 16; }
    f32x16 o[2];
#pragma unroll
    for (int d = 0; d < 2; ++d)
#pragma unroll
        for (int i = 0; i < 16; ++i) o[d][i] = 0.f;
    float m = -1e30f, l = 0.f;
    if (WINDOW) { m = sink[head] * LOG2E; l = (hh == 0) ? 1.f : 0.f; }
    const int gg = lane >> 4, li = lane & 15;
    const int vlane = (4 * (gg >> 1) + (li >> 2)) * VS_BYTES + (16 * (gg & 1) + 4 * (li & 3)) * 2;
    char* Kl = lds; char* Vl = lds + 2 * KBUF;
#define AGLOAD(KT) do { const char* _kg = Kg + (size_t)(KT) * 64 * DK * 2; const char* _vg = Vg + (size_t)(KT) * 64 * 128; \
        kr0 = *(const uint4*)(_kg + tid * 16); kr1 = *(const uint4*)(_kg + (tid + 256) * 16); if (KLD > 2) kr2 = *(const uint4*)(_kg + (tid + 512) * 16); \
        vr0 = *(const uint4*)(_vg + tid * 16); vr1 = *(const uint4*)(_vg + (tid + 256) * 16); } while (0)
#define ASTORE(KB, VB) do { char* _kd = (KB); char* _vd = (VB); *(uint4*)(_kd + koff[0]) = kr0; *(uint4*)(_kd + koff[1]) = kr1; if (KLD > 2) *(uint4*)(_kd + koff[KLD - 1]) = kr2; \
        *(uint4*)(_vd + voff[0]) = vr0; *(uint4*)(_vd + voff[1]) = vr1; } while (0)
    AGLOAD(kt_lo);
    ASTORE(Kl, Vl);
    { const int k1 = kt_lo + 1 < kt_hi ? kt_lo + 1 : kt_lo; AGLOAD(k1); }
    __syncthreads();
    for (int kt = kt_lo; kt < kt_hi; ++kt) {
        const int cur = (kt - kt_lo) & 1;
        ASTORE(Kl + (cur ^ 1) * KBUF, Vl + (cur ^ 1) * VBUF);
        { const int ktn = kt + 2 < kt_hi ? kt + 2 : kt_hi - 1; AGLOAD(ktn); }
        __builtin_amdgcn_sched_barrier(0);
        const char* kb = Kl + cur * KBUF;
        f32x16 s0, s1;
#pragma unroll
        for (int i = 0; i < 16; ++i) { s0[i] = 0.f; s1[i] = 0.f; }
#pragma unroll
        for (int ks = 0; ks < DK / 16; ++ks) {
            bf16x8 k0 = *(const bf16x8*)(kb + r32 * KS + (ks * 2 + hh) * 16);
            bf16x8 k1 = *(const bf16x8*)(kb + (32 + r32) * KS + (ks * 2 + hh) * 16);
            s0 = __builtin_amdgcn_mfma_f32_32x32x16_bf16(k0, qf[ks], s0, 0, 0, 0);
            s1 = __builtin_amdgcn_mfma_f32_32x32x16_bf16(k1, qf[ks], s1, 0, 0, 0);
        }
        if (WINDOW) {
            const int kb0 = kt * 64 + 4 * hh - qpos;
#pragma unroll
            for (int i = 0; i < 16; ++i) {
                const int d0 = kb0 + (i & 3) + 8 * (i >> 2), d1 = d0 + 32;
                s0[i] = (d0 > 128 || d0 < -128) ? -1e30f : s0[i];
                s1[i] = (d1 > 128 || d1 < -128) ? -1e30f : s1[i];
            }
        }
        const int vbase = (int)(size_t)(Vl + cur * VBUF - lds) + vlane;
        PV_LOAD(0, vbase, vfa);
        PV_LOAD(1, vbase, vfb);
        __builtin_amdgcn_sched_barrier(0);
        float tmax = s0[0];
#pragma unroll
        for (int i = 1; i < 16; ++i) tmax = fmaxf(tmax, s0[i]);
#pragma unroll
        for (int i = 0; i < 16; ++i) tmax = fmaxf(tmax, s1[i]);
        tmax = xhalf_max(tmax);
        const float mn = fmaxf(m, tmax);
        const float alpha = __builtin_amdgcn_exp2f(m - mn);
        m = mn;
        float ps = 0.f;
#pragma unroll
        for (int i = 0; i < 16; ++i) { s0[i] = __builtin_amdgcn_exp2f(s0[i] - mn); ps += s0[i]; }
#pragma unroll
        for (int i = 0; i < 16; ++i) { s1[i] = __builtin_amdgcn_exp2f(s1[i] - mn); ps += s1[i]; }
        l = l * alpha + ps;
        if (__any(alpha != 1.f)) {
#pragma unroll
            for (int d = 0; d < 2; ++d)
#pragma unroll
                for (int i = 0; i < 16; ++i) o[d][i] *= alpha;
        }
        asm volatile("s_waitcnt lgkmcnt(0)" ::: "memory");
        __builtin_amdgcn_sched_barrier(0);
        PV_MMA(o, s0, vfa);
        PV_MMA(o, s1, vfb);
        __syncthreads();
    }
#undef AGLOAD
#undef ASTORE
    l = xhalf_sum(l);
    const float inv = 1.f / l;
    bf16_t* orow = O + (size_t)(b * SEQ + qpos) * DM + ocol + head * 64;
#pragma unroll
    for (int d = 0; d < 2; ++d)
#pragma unroll
        for (int gq = 0; gq < 4; ++gq) {
            uint2 w;
            w.x = cvtpk(o[d][gq * 4 + 0] * inv, o[d][gq * 4 + 1] * inv);
            w.y = cvtpk(o[d][gq * 4 + 2] * inv, o[d][gq * 4 + 3] * inv);
            *(uint2*)(orow + d * 32 + 8 * gq + 4 * hh) = w;
        }
}

__device__ __forceinline__ void dil_wave_item(const bf16_t* __restrict__ Q, const bf16_t* __restrict__ K, const bf16_t* __restrict__ V,
                                              bf16_t* __restrict__ O, int witem, char* wlds, int lds_off) {
    const int lane = tid_opaque() & 63, r32 = lane & 31, hh = lane >> 5;
    const int c = witem & 15, chunk = (witem >> 4) & 15, kvh = (witem >> 8) & 1, b = witem >> 9;
    const int t0 = chunk * 256;
    const int mq = r32 & 15, g = r32 >> 4;
    const int qpos = t0 + 16 * mq + c, head = kvh * 2 + g;
    bf16x8 qf[4];
    {
        const bf16_t* qp = Q + ((size_t)(b * 4 + head) * SEQ + qpos) * 64 + hh * 8;
#pragma unroll
        for (int ks = 0; ks < 4; ++ks) qf[ks] = *(const bf16x8*)(qp + ks * 16);
    }
    const bf16_t* Kg = K + (size_t)(b * 2 + kvh) * SEQ * 64;
    const bf16_t* Vg = V + (size_t)(b * 2 + kvh) * SEQ * 64;
    f32x16 o[2];
#pragma unroll
    for (int d = 0; d < 2; ++d)
#pragma unroll
        for (int i = 0; i < 16; ++i) o[d][i] = 0.f;
    float m = -1e30f, l = 0.f;
    const int gg = lane >> 4, li = lane & 15;
    const int vlane = lds_off + (4 * (gg >> 1) + (li >> 2)) * VS_BYTES + (16 * (gg & 1) + 4 * (li & 3)) * 2;
    for (int it = 0; it < 23; ++it) {
        int sh, j;
        if (it < 12) { sh = 0; j = it; } else if (it < 18) { sh = 2; j = it - 12; } else { sh = 4; j = it - 18; }
        const int rr = 1 << sh;
        const int cc = c & (rr - 1);
        const int idx0 = (t0 >> sh) - 64 + 32 * j;
        const int lim = SEQ >> sh;
        if (idx0 + 31 < 0 || idx0 >= lim) continue;
        bf16x8 kf[4];
        {
            int idx = idx0 + r32; idx = idx < 0 ? 0 : (idx >= lim ? lim - 1 : idx);
            const bf16_t* kp = Kg + (size_t)((idx << sh) + cc) * 64 + hh * 8;
#pragma unroll
            for (int ks = 0; ks < 4; ++ks) kf[ks] = *(const bf16x8*)(kp + ks * 16);
        }
        uint4 vr[4];
#pragma unroll
        for (int jj = 0; jj < 4; ++jj) {
            const int id = lane + 64 * jj; int idx = idx0 + (id >> 3); idx = idx < 0 ? 0 : (idx >= lim ? lim - 1 : idx);
            vr[jj] = *(const uint4*)(Vg + (size_t)((idx << sh) + cc) * 64 + (id & 7) * 8);
        }
#pragma unroll
        for (int jj = 0; jj < 4; ++jj) { const int id = lane + 64 * jj; *(uint4*)(wlds + (id >> 3) * VS_BYTES + (id & 7) * 16) = vr[jj]; }
        f32x16 s;
#pragma unroll
        for (int i = 0; i < 16; ++i) s[i] = 0.f;
#pragma unroll
        for (int ks = 0; ks < 4; ++ks) s = __builtin_amdgcn_mfma_f32_32x32x16_bf16(kf[ks], qf[ks], s, 0, 0, 0);
        const int qidx = qpos >> sh;
        const int base = idx0 + 4 * hh;
#pragma unroll
        for (int i = 0; i < 16; ++i) {
            const int idx = base + (i & 3) + 8 * (i >> 2);
            const int d = idx - qidx;
            s[i] = (d > 64 || d < -64 || idx < 0 || idx >= lim) ? -1e30f : s[i];
        }
        float tmax = s[0];
#pragma unroll
        for (int i = 1; i < 16; ++i) tmax = fmaxf(tmax, s[i]);
        tmax = fmaxf(tmax, xhalf(tmax));
        const float mn = fmaxf(fmaxf(m, tmax), -1e20f);
        const float alpha = __builtin_amdgcn_exp2f(m - mn);
        m = mn;
        float ps = 0.f;
#pragma unroll
        for (int i = 0; i < 16; ++i) { s[i] = __builtin_amdgcn_exp2f(s[i] - mn); ps += s[i]; }
        l = l * alpha + ps;
#pragma unroll
        for (int d = 0; d < 2; ++d)
#pragma unroll
            for (int i = 0; i < 16; ++i) o[d][i] *= alpha;
        pv_sub<0>(o, s, vlane);
    }
    l += xhalf(l);
    const float inv = 1.f / l;
    bf16_t* orow = O + (size_t)(b * SEQ + qpos) * DM + 512 + head * 64;
#pragma unroll
    for (int d = 0; d < 2; ++d)
#pragma unroll
        for (int gq = 0; gq < 4; ++gq) {
            uint2 w;
            w.x = cvtpk(o[d][gq * 4 + 0] * inv, o[d][gq * 4 + 1] * inv);
            w.y = cvtpk(o[d][gq * 4 + 2] * inv, o[d][gq * 4 + 3] * inv);
            *(uint2*)(orow + d * 32 + 8 * gq + 4 * hh) = w;
        }
}

__device__ __forceinline__ int f2key(float f) { int b = __float_as_int(f); return b ^ ((b >> 31) & 0x7fffffff); }
__device__ __forceinline__ float key2f(int k) { return __int_as_float(k ^ ((k >> 31) & 0x7fffffff)); }

template <int N>
__device__ __forceinline__ void bitonic_sort_desc(int (&a)[N]) {
#pragma unroll
    for (int k = 2; k <= N; k <<= 1) {
#pragma unroll
        for (int j = k >> 1; j > 0; j >>= 1) {
#pragma unroll
            for (int i = 0; i < N; ++i) {
                const int l2 = i ^ j;
                if (l2 > i) {
                    const bool up = ((i & k) == 0);
                    const int hi = max(a[i], a[l2]), lo = min(a[i], a[l2]);
                    a[i] = up ? hi : lo; a[l2] = up ? lo : hi;
                }
            }
        }
    }
}
__device__ __forceinline__ void merge_top16(int (&a)[16], const int (&b)[16]) {
#pragma unroll
    for (int i = 0; i < 16; ++i) a[i] = max(a[i], b[15 - i]);
#pragma unroll
    for (int j = 8; j > 0; j >>= 1) {
#pragma unroll
        for (int i = 0; i < 16; ++i) {
            const int l2 = i ^ j;
            if (l2 > i) { const int hi = max(a[i], a[l2]), lo = min(a[i], a[l2]); a[i] = hi; a[l2] = lo; }
        }
    }
}
__device__ __forceinline__ void top16_of_64(int (&g0)[16], int (&g1)[16], int (&g2)[16], int (&g3)[16]) {
    bitonic_sort_desc<16>(g0); bitonic_sort_desc<16>(g1); bitonic_sort_desc<16>(g2); bitonic_sort_desc<16>(g3);
    merge_top16(g0, g1); merge_top16(g2, g3); merge_top16(g0, g2);
}

__device__ __forceinline__ void topk_wave_item(const bf16_t* __restrict__ qp, const bf16_t* __restrict__ subk  ,
                                               int* __restrict__ eidx, float* __restrict__ gate, int witem, char* wlds) {
    const int lane = tid_opaque() & 63, r32 = lane & 31, hh = lane >> 5;
    const int h = witem & 7, tt = witem >> 3;
    const int t = tt * 32 + r32;
    int top[2][16];
#pragma unroll
    for (int c = 0; c < 2; ++c) {
        bf16x8 qf[8];
        const bf16_t* qrow = qp + (size_t)t * 2048 + h * 256 + c * 128 + hh * 8;
#pragma unroll
        for (int ks = 0; ks < 8; ++ks) qf[ks] = *(const bf16x8*)(qrow + ks * 16);
        const bf16_t* kb = subk + ((size_t)(h * 2 + c) * 128 + r32) * 128 + hh * 8;
        int grp[4][16];
#pragma unroll
        for (int kt = 0; kt < 4; ++kt) {
            f32x16 s;
#pragma unroll
            for (int i = 0; i < 16; ++i) s[i] = 0.f;
#pragma unroll
            for (int ks = 0; ks < 8; ++ks) {
                bf16x8 kf = *(const bf16x8*)(kb + (size_t)kt * 32 * 128 + ks * 16);
                s = __builtin_amdgcn_mfma_f32_32x32x16_bf16(kf, qf[ks], s, 0, 0, 0);
            }
#pragma unroll
            for (int i = 0; i < 16; ++i) grp[kt][i] = (f2key(s[i]) & ~127) | (kt * 32 + crow(i, hh));
        }
        top16_of_64(grp[0], grp[1], grp[2], grp[3]);
        int oth[16];
#pragma unroll
        for (int i = 0; i < 16; ++i) oth[i] = __shfl_xor(grp[0][i], 32);
        merge_top16(grp[0], oth);
#pragma unroll
        for (int i = 0; i < 16; ++i) top[c][i] = grp[0][i];
    }
    {
        unsigned* my = (unsigned*)(wlds + lane * 36);
#pragma unroll
        for (int c = 0; c < 2; ++c)
#pragma unroll
            for (int w4 = 0; w4 < 4; ++w4) {
                unsigned v = (top[c][w4 * 4] & 127) | ((top[c][w4 * 4 + 1] & 127) << 8) | ((top[c][w4 * 4 + 2] & 127) << 16) | ((top[c][w4 * 4 + 3] & 127) << 24);
                my[c * 4 + w4] = v;
            }
    }
    float v1[16], v2[16];
#pragma unroll
    for (int i = 0; i < 16; ++i) { v1[i] = key2f(top[0][i] & ~127); v2[i] = key2f(top[1][i] & ~127); }
    int cg[4][16];
    {
        int n = 0;
#pragma unroll
        for (int i = 0; i < 16; ++i)
#pragma unroll
            for (int j = 0; j < 16; ++j)
                if ((i + 1) * (j + 1) <= 16) { cg[n >> 4][n & 15] = (f2key(v1[i] + v2[j]) & ~255) | (i * 16 + j); ++n; }
#pragma unroll
        for (int q = 50; q < 64; ++q) cg[q >> 4][q & 15] = (int)0x80000000;
    }
    top16_of_64(cg[0], cg[1], cg[2], cg[3]);
    float bv[16];
#pragma unroll
    for (int i = 0; i < 16; ++i) bv[i] = key2f(cg[0][i] & ~255);
    float sm = 0.f;
    const float bmx = bv[0];
#pragma unroll
    for (int i = 0; i < 16; ++i) { bv[i] = __expf(bv[i] - bmx); sm += bv[i]; }
    const float inv = 1.f / sm;
    if (hh == 0) {
        const unsigned char* my = (const unsigned char*)(wlds + lane * 36);
        int* eo = eidx + (size_t)t * 128 + h * 16;
        float* go = gate + (size_t)t * 128 + h * 16;
#pragma unroll
        for (int q4 = 0; q4 < 4; ++q4) {
            int4 ev; float4 gv;
            int* evp = (int*)&ev; float* gvp = (float*)&gv;
#pragma unroll
            for (int u = 0; u < 4; ++u) {
                const int code = cg[0][q4 * 4 + u] & 255;
                const int i1 = my[code >> 4], i2 = my[16 + (code & 15)];
                evp[u] = i1 * 128 + i2; gvp[u] = bv[q4 * 4 + u] * inv;
            }
            *(int4*)(eo + q4 * 4) = ev; *(float4*)(go + q4 * 4) = gv;
        }
    }
}

typedef __attribute__((ext_vector_type(2))) float f32x2;
__device__ __forceinline__ float fdot2bf(unsigned a, unsigned b, float acc) {
    return __builtin_amdgcn_fdot2_f32_bf16(*(bf16x2_t*)&a, *(bf16x2_t*)&b, acc, false);
}
__device__ __forceinline__ unsigned fp8pair_to_bf16(unsigned w, bool hi) {
    bf16x2_t r = hi ? __builtin_amdgcn_cvt_scalef32_pk_bf16_fp8((int)w, 1.0f, true) : __builtin_amdgcn_cvt_scalef32_pk_bf16_fp8((int)w, 1.0f, false);
    return *(unsigned*)&r;
}
__device__ __forceinline__ float dot16_fp8(uint4 u, const unsigned (&h)[8]) {
    float a = 0.f;
    a = fdot2bf(fp8pair_to_bf16(u.x, false), h[0], a); a = fdot2bf(fp8pair_to_bf16(u.x, true), h[1], a);
    a = fdot2bf(fp8pair_to_bf16(u.y, false), h[2], a); a = fdot2bf(fp8pair_to_bf16(u.y, true), h[3], a);
    a = fdot2bf(fp8pair_to_bf16(u.z, false), h[4], a); a = fdot2bf(fp8pair_to_bf16(u.z, true), h[5], a);
    a = fdot2bf(fp8pair_to_bf16(u.w, false), h[6], a); a = fdot2bf(fp8pair_to_bf16(u.w, true), h[7], a);
    return a;
}
__device__ __forceinline__ void axpy16_fp8(float (&acc)[16], float w, uint4 v) {
    f32x2 r;
    r = __builtin_amdgcn_cvt_pk_f32_fp8((int)v.x, false); acc[0] += w * r[0]; acc[1] += w * r[1];
    r = __builtin_amdgcn_cvt_pk_f32_fp8((int)v.x, true);  acc[2] += w * r[0]; acc[3] += w * r[1];
    r = __builtin_amdgcn_cvt_pk_f32_fp8((int)v.y, false); acc[4] += w * r[0]; acc[5] += w * r[1];
    r = __builtin_amdgcn_cvt_pk_f32_fp8((int)v.y, true);  acc[6] += w * r[0]; acc[7] += w * r[1];
    r = __builtin_amdgcn_cvt_pk_f32_fp8((int)v.z, false); acc[8] += w * r[0]; acc[9] += w * r[1];
    r = __builtin_amdgcn_cvt_pk_f32_fp8((int)v.z, true);  acc[10] += w * r[0]; acc[11] += w * r[1];
    r = __builtin_amdgcn_cvt_pk_f32_fp8((int)v.w, false); acc[12] += w * r[0]; acc[13] += w * r[1];
    r = __builtin_amdgcn_cvt_pk_f32_fp8((int)v.w, true);  acc[14] += w * r[0]; acc[15] += w * r[1];
}
__device__ __forceinline__ float gelu_exact(float a) { return 0.5f * a * (1.f + erff(a * 0.70710678118654752f)); }

__device__ __forceinline__ float transpose_reduce16(f32x16 p, int lane) {
#pragma unroll
    for (int st = 0; st < 4; ++st) {
        const int o = 32 >> st, n = 16 >> st;
        const bool up = (lane & o) != 0;
#pragma unroll
        for (int i = 0; i < n / 2; ++i) {
            float lo = p[i], hi = p[i + n / 2];
            asm volatile("" : "+v"(lo), "+v"(hi));
            const float keep = up ? hi : lo;
            const float send = up ? lo : hi;
            p[i] = keep + __shfl_xor(send, o);
        }
    }
    float v = p[0];
    v += __shfl_xor(v, 1); v += __shfl_xor(v, 2);
    return v;
}
#define EX_SB() __builtin_amdgcn_sched_barrier(0)
#define EX_LD1(R, TAB, EB, S) R = *(const uint4*)((TAB) + (unsigned)((__builtin_amdgcn_readlane((EB), (S)) << 10) + lane16))
#define EX_LOAD8(P, TAB, EB, SL) do { EX_LD1(P##0, TAB, EB, (SL) + 0); EX_LD1(P##1, TAB, EB, (SL) + 1); EX_LD1(P##2, TAB, EB, (SL) + 2); EX_LD1(P##3, TAB, EB, (SL) + 3); \
        EX_LD1(P##4, TAB, EB, (SL) + 4); EX_LD1(P##5, TAB, EB, (SL) + 5); EX_LD1(P##6, TAB, EB, (SL) + 6); EX_LD1(P##7, TAB, EB, (SL) + 7); } while (0)
#define EX_DOT8(P, PP, O) do { PP[(O) + 0] = dot16_fp8(P##0, hp); PP[(O) + 1] = dot16_fp8(P##1, hp); PP[(O) + 2] = dot16_fp8(P##2, hp); PP[(O) + 3] = dot16_fp8(P##3, hp); \
        PP[(O) + 4] = dot16_fp8(P##4, hp); PP[(O) + 5] = dot16_fp8(P##5, hp); PP[(O) + 6] = dot16_fp8(P##6, hp); PP[(O) + 7] = dot16_fp8(P##7, hp); } while (0)
#define EX_RL(W, S) __int_as_float(__builtin_amdgcn_readlane(__float_as_int(W), (S)))
#define EX_AXPY8(P, W, SL) do { axpy16_fp8(acc, EX_RL(W, (SL) + 0), P##0); axpy16_fp8(acc, EX_RL(W, (SL) + 1), P##1); axpy16_fp8(acc, EX_RL(W, (SL) + 2), P##2); axpy16_fp8(acc, EX_RL(W, (SL) + 3), P##3); \
        axpy16_fp8(acc, EX_RL(W, (SL) + 4), P##4); axpy16_fp8(acc, EX_RL(W, (SL) + 5), P##5); axpy16_fp8(acc, EX_RL(W, (SL) + 6), P##6); axpy16_fp8(acc, EX_RL(W, (SL) + 7), P##7); } while (0)
#define EX_COPY8(D, S_) do { D##0 = S_##0; D##1 = S_##1; D##2 = S_##2; D##3 = S_##3; D##4 = S_##4; D##5 = S_##5; D##6 = S_##6; D##7 = S_##7; } while (0)

__device__ __forceinline__ void expert_token(PC& p, int layer, int t, bool last, bool dummy = false) {
    const int lane = tid_opaque() & 63;
    const int lane16 = lane * 16;
    const float* gfb = p.g_ffn + layer * DM; asm volatile("" : "+s"(gfb));
    const float* gf = gfb + lane * 16;
    float* xrow = p.x + (size_t)t * DM + lane * 16;
    float* xwr = dummy ? (float*)p.zb + (size_t)t * DM + lane * 16 : xrow;
    bf16_t* hwr = (dummy ? p.q.qA + (size_t)t * DM : p.hnb + (size_t)t * DM) + lane * 16;
    float xv[16];
#pragma unroll
    for (int q = 0; q < 4; ++q) { const float4 a = *(const float4*)(xrow + 4 * q); xv[4 * q] = a.x; xv[4 * q + 1] = a.y; xv[4 * q + 2] = a.z; xv[4 * q + 3] = a.w; }
    float ss = 0.f;
#pragma unroll
    for (int i = 0; i < 16; ++i) ss += xv[i] * xv[i];
    ss = wave_sum(ss);
    const float rstd = rsqrtf(ss * (1.f / DM) + 1e-6f);
    unsigned hp[8];
#pragma unroll
    for (int q = 0; q < 4; ++q) {
        const float4 g = *(const float4*)(gf + 4 * q);
        hp[2 * q] = cvtpk(xv[4 * q] * rstd * g.x, xv[4 * q + 1] * rstd * g.y);
        hp[2 * q + 1] = cvtpk(xv[4 * q + 2] * rstd * g.z, xv[4 * q + 3] * rstd * g.w);
    }
    const int e0 = p.eidx[(size_t)t * 128 + lane], e1 = p.eidx[(size_t)t * 128 + 64 + lane];
    const float g0 = p.gate[(size_t)t * 128 + lane], g1 = p.gate[(size_t)t * 128 + 64 + lane];
    const unsigned char* u8 = p.u8 + (size_t)layer * 16384 * DM;
    const unsigned char* v8 = p.v8 + (size_t)layer * 16384 * DM;
    const float* su = p.su + layer * 16384; const float* sv = p.sv + layer * 16384;
    const float su0 = su[e0], su1 = su[e1], sv0 = sv[e0], sv1 = sv[e1];
    uint4 rx0, rx1, rx2, rx3, rx4, rx5, rx6, rx7, ry0, ry1, ry2, ry3, ry4, ry5, ry6, ry7;
    float a0 = 0.f, a1 = 0.f;
    EX_LOAD8(rx, u8, e0, 0);
#pragma unroll 1
    for (int g = 0; g < 8; ++g) {
        const int eb = g < 4 ? e0 : e1;
        const int sl = (g & 3) * 16;
        f32x16 pp;
        EX_LOAD8(ry, u8, eb, sl + 8);
        EX_SB();
        EX_DOT8(rx, pp, 0);
        EX_SB();
        {
            const int gn = g + 1 < 8 ? g + 1 : 7;
            const int ebn = gn < 4 ? e0 : e1;
            EX_LOAD8(rx, u8, ebn, (gn & 3) * 16);
        }
        EX_SB();
        EX_DOT8(ry, pp, 8);
        const float v = transpose_reduce16(pp, lane);
        const float got = __shfl(v, (lane & 15) << 2);
        const bool mine = (lane >> 4) == (g & 3);
        a0 = (mine && g < 4) ? got : a0;
        a1 = (mine && g >= 4) ? got : a1;
        EX_SB();
    }
    const float w0 = g0 * gelu_exact(su0 * a0) * sv0;
    const float w1 = g1 * gelu_exact(su1 * a1) * sv1;
    float acc[16];
#pragma unroll
    for (int i = 0; i < 16; ++i) acc[i] = 0.f;
    EX_LOAD8(rx, v8, e0, 0);
#pragma unroll 1
    for (int h2 = 0; h2 < 8; ++h2) {
        const int ebc = h2 < 4 ? e0 : e1;
        const float wb = h2 < 4 ? w0 : w1;
        const int slc = (h2 & 3) * 16;
        EX_LOAD8(ry, v8, ebc, slc + 8);
        EX_SB();
        EX_AXPY8(rx, wb, slc);
        EX_SB();
        {
            const int hn_ = h2 + 1 < 8 ? h2 + 1 : 7;
            const int ebn = hn_ < 4 ? e0 : e1;
            EX_LOAD8(rx, v8, ebn, (hn_ & 3) * 16);
        }
        EX_SB();
        EX_AXPY8(ry, wb, slc + 8);
        EX_SB();
    }
#pragma unroll
    for (int i = 0; i < 16; ++i) xv[i] += acc[i];
    float s2 = 0.f;
#pragma unroll
    for (int i = 0; i < 16; ++i) s2 += xv[i] * xv[i];
    s2 = wave_sum(s2);
    const float r2 = rsqrtf(s2 * (1.f / DM) + 1e-6f);
    if (!last) {
#pragma unroll
        for (int q = 0; q < 4; ++q) *(float4*)(xwr + 4 * q) = make_float4(xv[4 * q], xv[4 * q + 1], xv[4 * q + 2], xv[4 * q + 3]);
        const float* gnb = p.g_mix + (layer + 1) * DM; asm volatile("" : "+s"(gnb));
        const float* gn = gnb + lane * 16;
        unsigned hw[8];
#pragma unroll
        for (int q = 0; q < 4; ++q) {
            const float4 g = *(const float4*)(gn + 4 * q);
            hw[2 * q] = cvtpk(xv[4 * q] * r2 * g.x, xv[4 * q + 1] * r2 * g.y);
            hw[2 * q + 1] = cvtpk(xv[4 * q + 2] * r2 * g.z, xv[4 * q + 3] * r2 * g.w);
        }
        *(uint4*)(hwr) = make_uint4(hw[0], hw[1], hw[2], hw[3]);
        *(uint4*)(hwr + 8) = make_uint4(hw[4], hw[5], hw[6], hw[7]);
    } else {
        const float* gnb = p.g_final; asm volatile("" : "+s"(gnb));
        const float* gn = gnb + lane * 16;
        float* orow = dummy ? xwr : p.out + (size_t)t * DM + lane * 16;
#pragma unroll
        for (int q = 0; q < 4; ++q) {
            const float4 g = *(const float4*)(gn + 4 * q);
            *(float4*)(orow + 4 * q) = make_float4(xv[4 * q] * r2 * g.x, xv[4 * q + 1] * r2 * g.y, xv[4 * q + 2] * r2 * g.z, xv[4 * q + 3] * r2 * g.w);
        }
    }
}
__device__ __forceinline__ void transpose_tile(const float* __restrict__ src, int K, int N, bf16_t* __restrict__ dst, int tk, int tn, float* tl) {
    const int tid = tid_opaque(), r = tid >> 6, c = tid & 63;
    const int k0 = tk * 64, n0 = tn * 64;
#pragma unroll
    for (int i = 0; i < 16; ++i) {
        const int kk = i * 4 + r, n = n0 + c;
        tl[kk * 65 + c] = (n < N) ? src[(size_t)(k0 + kk) * N + n] : 0.f;
    }
    __syncthreads();
#pragma unroll
    for (int i = 0; i < 16; ++i) {
        const int nn = i * 4 + r;
        if (n0 + nn < N) dst[(size_t)(n0 + nn) * K + k0 + c] = f2bf(tl[c * 65 + nn]);
    }
    __syncthreads();
}
__device__ __forceinline__ void transpose_all(const float* src, int K, int N, bf16_t* dst, float* tl) {
    const int ntk = K / 64, ntn = (N + 63) / 64;
    for (int t = blockIdx.x; t < ntk * ntn; t += gridDim.x) transpose_tile(src, K, N, dst, t / ntn, t % ntn, tl);
}
__device__ __forceinline__ void convert_plain(const float* __restrict__ src, bf16_t* __restrict__ dst, size_t n) {
    const size_t n8 = n >> 3;
    for (size_t i = (size_t)blockIdx.x * blockDim.x + tid_opaque(); i < n8; i += (size_t)gridDim.x * blockDim.x) {
        const float4 a = *(const float4*)(src + i * 8), b = *(const float4*)(src + i * 8 + 4);
        uint4 w; w.x = cvtpk(a.x, a.y); w.y = cvtpk(a.z, a.w); w.z = cvtpk(b.x, b.y); w.w = cvtpk(b.z, b.w);
        *(uint4*)(dst + i * 8) = w;
    }
}
__device__ __forceinline__ void convert_rows_fp8(const float* __restrict__ src, unsigned char* __restrict__ dst, float* __restrict__ scales, int nrows) {
    const int tid = tid_opaque(), wave = tid >> 6, lane = tid & 63;
    for (int row = blockIdx.x * 4 + wave; row < nrows; row += gridDim.x * 4) {
        const float* sr = src + (size_t)row * DM + lane * 16;
        float xv[16];
#pragma unroll
        for (int q = 0; q < 4; ++q) { const float4 a = *(const float4*)(sr + 4 * q); xv[4 * q] = a.x; xv[4 * q + 1] = a.y; xv[4 * q + 2] = a.z; xv[4 * q + 3] = a.w; }
        float am = 0.f;
#pragma unroll
        for (int i = 0; i < 16; ++i) am = fmaxf(am, fabsf(xv[i]));
        am = wave_max(am);
        const float sc = am > 0.f ? am * (1.f / 448.f) : 1.f;
        const float inv = 1.f / sc;
        unsigned w[4];
#pragma unroll
        for (int q = 0; q < 4; ++q) {
            int t = 0;
            t = __builtin_amdgcn_cvt_pk_fp8_f32(xv[4 * q] * inv, xv[4 * q + 1] * inv, t, false);
            t = __builtin_amdgcn_cvt_pk_fp8_f32(xv[4 * q + 2] * inv, xv[4 * q + 3] * inv, t, true);
            w[q] = (unsigned)t;
        }
        *(uint4*)(dst + (size_t)row * DM + lane * 16) = make_uint4(w[0], w[1], w[2], w[3]);
        if (lane == 0) scales[row] = sc;
    }
}
__device__ __forceinline__ void rms_row_bf16(const float* __restrict__ src, const float* __restrict__ g, bf16_t* __restrict__ dst, float* __restrict__ cpy, int lane) {
    float xv[16];
    const float4 a0 = *(const float4*)(src + lane * 8), a1 = *(const float4*)(src + lane * 8 + 4);
    const float4 b0 = *(const float4*)(src + 512 + lane * 8), b1 = *(const float4*)(src + 512 + lane * 8 + 4);
    xv[0] = a0.x; xv[1] = a0.y; xv[2] = a0.z; xv[3] = a0.w; xv[4] = a1.x; xv[5] = a1.y; xv[6] = a1.z; xv[7] = a1.w;
    xv[8] = b0.x; xv[9] = b0.y; xv[10] = b0.z; xv[11] = b0.w; xv[12] = b1.x; xv[13] = b1.y; xv[14] = b1.z; xv[15] = b1.w;
    if (cpy) {
        *(float4*)(cpy + lane * 8) = a0; *(float4*)(cpy + lane * 8 + 4) = a1;
        *(float4*)(cpy + 512 + lane * 8) = b0; *(float4*)(cpy + 512 + lane * 8 + 4) = b1;
    }
    float ss = 0.f;
#pragma unroll
    for (int i = 0; i < 16; ++i) ss += xv[i] * xv[i];
    ss = wave_sum(ss);
    const float r = rsqrtf(ss * (1.f / DM) + 1e-6f);
    const float4 g0 = *(const float4*)(g + lane * 8), g1 = *(const float4*)(g + lane * 8 + 4);
    const float4 g2 = *(const float4*)(g + 512 + lane * 8), g3 = *(const float4*)(g + 512 + lane * 8 + 4);
    uint4 wa, wb;
    wa.x = cvtpk(xv[0] * r * g0.x, xv[1] * r * g0.y); wa.y = cvtpk(xv[2] * r * g0.z, xv[3] * r * g0.w);
    wa.z = cvtpk(xv[4] * r * g1.x, xv[5] * r * g1.y); wa.w = cvtpk(xv[6] * r * g1.z, xv[7] * r * g1.w);
    wb.x = cvtpk(xv[8] * r * g2.x, xv[9] * r * g2.y); wb.y = cvtpk(xv[10] * r * g2.z, xv[11] * r * g2.w);
    wb.z = cvtpk(xv[12] * r * g3.x, xv[13] * r * g3.y); wb.w = cvtpk(xv[14] * r * g3.z, xv[15] * r * g3.w);
    *(uint4*)(dst + lane * 8) = wa; *(uint4*)(dst + 512 + lane * 8) = wb;
}

__device__ __forceinline__ void phase_pro(PC& p, char* lds) {
    float* tl = (float*)lds;
    for (int l = 0; l < DEPTH; ++l) {
        transpose_all(p.w_in + (size_t)l * DM * NZ, DM, NZ, p.winT + (size_t)l * NZ * DM, tl);
        transpose_all(p.w_out + (size_t)l * DM * DM, DM, DM, p.woutT + (size_t)l * DM * DM, tl);
        transpose_all(p.peer_w_q + (size_t)l * DM * 2048, DM, 2048, p.wqT + (size_t)l * 2048 * DM, tl);
        transpose_all(p.mla_w_uq + (size_t)l * 256 * 384, 256, 384, p.wuqT + (size_t)l * 384 * 256, tl);
        transpose_all(p.mla_w_ukv + (size_t)l * 128 * 512, 128, 512, p.wukvT + (size_t)l * 512 * 128, tl);
    }
    convert_plain(p.peer_sub_keys, p.subk, (size_t)DEPTH * 8 * 2 * 128 * 128);
    if (p.flags & 1) {
        convert_rows_fp8(p.peer_u, p.u8, p.su, DEPTH * 16384);
        convert_rows_fp8(p.peer_v, p.v8, p.sv, DEPTH * 16384);
    }
    for (int i = blockIdx.x * blockDim.x + tid_opaque(); i < 4096 * 32; i += gridDim.x * blockDim.x) {
        {
            const int pos = i / 32, j = i % 32;
            const float inv = powf(10000.f, -(float)(2 * j) / 64.f); const float ang = (float)pos * inv;
            p.tb.cos1[i] = cosf(ang); p.tb.sin1[i] = sinf(ang);
        }
        if (i < 4096 * 16) {
            const int pos = i / 16, j = i % 16;
            const float inv = powf(10000.f, -(float)(2 * j) / 32.f); const float ang = (float)pos * inv;
            p.tb.cosm[i] = cosf(ang); p.tb.sinm[i] = sinf(ang);
        }
        if (i < 64 * 16) {
            const int pos = i / 16, j = i % 16;
            const float inv = powf(10000.f, -(float)(2 * j) / 32.f); const float ang = (float)pos * inv;
            p.tb.cosr[i] = cosf(ang); p.tb.sinr[i] = sinf(ang); p.tb.cosc[i] = cosf(ang); p.tb.sinc[i] = sinf(ang);
        }
    }
    const int wave = tid_opaque() >> 6, lane = tid_opaque() & 63;
    for (int t = blockIdx.x * 4 + wave; t < T_TOK; t += gridDim.x * 4)
        rms_row_bf16(p.x_in + (size_t)t * DM, p.g_mix, p.hnb + (size_t)t * DM, p.x + (size_t)t * DM, lane);
}

__device__ __forceinline__ void phase_g1(PC& p, int l, char* lds) {
    EpiStoreBf16 e{p.zb, NZ, NZ};
    gemm_phase(p.hnb, DM, p.winT + (size_t)l * NZ * DM, DM, T_TOK, NZ, DM, lds, e);
}

__device__ __forceinline__ unsigned pk2(float a, float b) { return cvtpk(a, b); }
__device__ __forceinline__ void phase_post(PC& p, int l, char* lds) {
    const int tid = tid_opaque(), wave = tid >> 6, lane = tid & 63;
    float* zr = (float*)(lds + wave * 8192);
    const float* g_qn = p.ax_q_norm + l * 64; const float* g_kn = p.ax_k_norm + l * 64;
    const float* g_cq = p.mla_q_norm + l * 256; const float* g_ckv = p.mla_kv_norm + l * 128;
    const float scA = 0.125f * LOG2E;
    const bf16_t* zb = p.zb;
    const float *cos1 = p.tb.cos1, *sin1 = p.tb.sin1, *cosm = p.tb.cosm, *sinm = p.tb.sinm, *cosr = p.tb.cosr, *sinr = p.tb.sinr, *cosc = p.tb.cosc, *sinc = p.tb.sinc;
    for (int t = blockIdx.x * 4 + wave; t < T_TOK; t += gridDim.x * 4) {
        const int b = t / SEQ, s = t % SEQ;
#pragma unroll
        for (int j = 0; j < 4; ++j) {
            const int ch = lane + 64 * j;
            if (ch < 244) {
                const uint4 w = *(const uint4*)(zb + (size_t)t * NZ + ch * 8);
                float4 lo, hi;
                lo.x = __uint_as_float(w.x << 16); lo.y = __uint_as_float(w.x & 0xffff0000u); lo.z = __uint_as_float(w.y << 16); lo.w = __uint_as_float(w.y & 0xffff0000u);
                hi.x = __uint_as_float(w.z << 16); hi.y = __uint_as_float(w.z & 0xffff0000u); hi.z = __uint_as_float(w.w << 16); hi.w = __uint_as_float(w.w & 0xffff0000u);
                *(float4*)(zr + ch * 8) = lo; *(float4*)(zr + ch * 8 + 4) = hi;
            }
        }
#pragma unroll
        for (int mix = 0; mix < 2; ++mix) {
            const int zo = mix == 0 ? 0 : 1024;
            bf16_t* qo = mix == 0 ? p.q.qA : p.q.qC; bf16_t* ko = mix == 0 ? p.q.kA : p.q.kC; bf16_t* vo = mix == 0 ? p.q.vA : p.q.vC;
            const int h = lane >> 4, j = (lane & 15) * 2;
            const float c0 = cos1[s * 32 + j], c1 = cos1[s * 32 + j + 1], s0 = sin1[s * 32 + j], s1 = sin1[s * 32 + j + 1];
            {
                const float a0 = zr[zo + h * 64 + j], a1 = zr[zo + h * 64 + j + 1], b0 = zr[zo + h * 64 + 32 + j], b1 = zr[zo + h * 64 + 33 + j];
                bf16_t* o = qo + ((size_t)(b * 4 + h) * SEQ + s) * 64;
                *(unsigned*)(o + j) = pk2((a0 * c0 - b0 * s0) * scA, (a1 * c1 - b1 * s1) * scA);
                *(unsigned*)(o + 32 + j) = pk2((b0 * c0 + a0 * s0) * scA, (b1 * c1 + a1 * s1) * scA);
            }
            if (lane < 32) {
                const float a0 = zr[zo + 256 + h * 64 + j], a1 = zr[zo + 256 + h * 64 + j + 1], b0 = zr[zo + 256 + h * 64 + 32 + j], b1 = zr[zo + 256 + h * 64 + 33 + j];
                bf16_t* o = ko + ((size_t)(b * 2 + h) * SEQ + s) * 64;
                *(unsigned*)(o + j) = pk2(a0 * c0 - b0 * s0, a1 * c1 - b1 * s1);
                *(unsigned*)(o + 32 + j) = pk2(b0 * c0 + a0 * s0, b1 * c1 + a1 * s1);
            }
            {
                const int i = lane * 2, hv = i >> 6, jv = i & 63;
                *(unsigned*)(vo + ((size_t)(b * 2 + hv) * SEQ + s) * 64 + jv) = pk2(zr[zo + 384 + i], zr[zo + 384 + i + 1]);
            }
        }
        {
            float rs[6];
#pragma unroll
            for (int hh = 0; hh < 6; ++hh) {
                const float v = zr[512 + hh * 64 + lane];
                rs[hh] = rsqrtf(wave_sum(v * v) * (1.f / 64.f) + 1e-6f);
            }
            const int row = s >> 6, col = s & 63;
            const int half = (lane >> 3) & 1, jj = (lane & 7) * 2;
            const float* ct = half == 0 ? cosr + row * 16 : cosc + col * 16;
            const float* st = half == 0 ? sinr + row * 16 : sinc + col * 16;
            const float c0 = ct[jj], c1 = ct[jj + 1], s0 = st[jj], s1 = st[jj + 1];
            const int d1 = half * 32 + jj, d2 = d1 + 16;
            {
                const int h = lane >> 4;
                const float r = h == 0 ? rs[0] : (h == 1 ? rs[1] : (h == 2 ? rs[2] : rs[3]));
                const float* z = zr + 512 + h * 64;
                const float a0 = z[d1] * r * g_qn[d1], a1 = z[d1 + 1] * r * g_qn[d1 + 1], b0 = z[d2] * r * g_qn[d2], b1 = z[d2 + 1] * r * g_qn[d2 + 1];
                bf16_t* o = p.q.qB + ((size_t)(b * 4 + h) * SEQ + s) * 64;
                *(unsigned*)(o + d1) = pk2((a0 * c0 - b0 * s0) * scA, (a1 * c1 - b1 * s1) * scA);
                *(unsigned*)(o + d2) = pk2((b0 * c0 + a0 * s0) * scA, (b1 * c1 + a1 * s1) * scA);
            }
            if (lane < 32) {
                const int h = lane >> 4;
                const float r = h == 0 ? rs[4] : rs[5];
                const float* z = zr + 768 + h * 64;
                const float a0 = z[d1] * r * g_kn[d1], a1 = z[d1 + 1] * r * g_kn[d1 + 1], b0 = z[d2] * r * g_kn[d2], b1 = z[d2 + 1] * r * g_kn[d2 + 1];
                bf16_t* o = p.q.kB + ((size_t)(b * 2 + h) * SEQ + s) * 64;
                *(unsigned*)(o + d1) = pk2(a0 * c0 - b0 * s0, a1 * c1 - b1 * s1);
                *(unsigned*)(o + d2) = pk2(b0 * c0 + a0 * s0, b1 * c1 + a1 * s1);
            }
            {
                const int i = lane * 2, hv = i >> 6, jv = i & 63;
                *(unsigned*)(p.q.vB + ((size_t)(b * 2 + hv) * SEQ + s) * 64 + jv) = pk2(zr[896 + i], zr[896 + i + 1]);
            }
        }
        {
            const float4 cq = *(const float4*)(zr + 1536 + lane * 4);
            const float rq = rsqrtf(wave_sum(cq.x * cq.x + cq.y * cq.y + cq.z * cq.z + cq.w * cq.w) * (1.f / 256.f) + 1e-6f);
            const float4 gq = *(const float4*)(g_cq + lane * 4);
            uint2 w; w.x = pk2(cq.x * rq * gq.x, cq.y * rq * gq.y); w.y = pk2(cq.z * rq * gq.z, cq.w * rq * gq.w);
            *(uint2*)(p.cqn + (size_t)t * 256 + lane * 4) = w;
            const float2 ck = *(const float2*)(zr + 1792 + lane * 2);
            const float rk = rsqrtf(wave_sum(ck.x * ck.x + ck.y * ck.y) * (1.f / 128.f) + 1e-6f);
            const float2 gk = *(const float2*)(g_ckv + lane * 2);
            *(unsigned*)(p.ckvn + (size_t)t * 128 + lane * 2) = pk2(ck.x * rk * gk.x, ck.y * rk * gk.y);
            const int i = lane & 15, h = lane >> 4;
            const float x1 = zr[1920 + i], x2 = zr[1936 + i];
            const float c = cosm[s * 16 + i], sn = sinm[s * 16 + i];
            bf16_t* o = p.q.kD + ((size_t)(b * 4 + h) * SEQ + s) * 96;
            o[64 + i] = f2bf(x1 * c - x2 * sn); o[80 + i] = f2bf(x2 * c + x1 * sn);
        }
    }
}

__device__ __forceinline__ void phase_mla(PC& p, int l, char* lds) {
    { EpiStoreBf16 e{p.qfull, 384, 384}; gemm_phase(p.cqn, 256, p.wuqT + (size_t)l * 384 * 256, 256, T_TOK, 384, 256, lds, e); }
    { EpiStoreBf16 e{p.kvfull, 512, 512}; gemm_phase(p.ckvn, 128, p.wukvT + (size_t)l * 512 * 128, 128, T_TOK, 512, 128, lds, e); }
}

__device__ __forceinline__ void phase_postmla(PC& p, int l) {
    const int tid = tid_opaque();
    const float scD = 0.10206207261596575f * LOG2E;
    for (int t = blockIdx.x; t < T_TOK; t += gridDim.x) {
        const int b = t / SEQ, s = t % SEQ;
        {
            const int h = tid / 64, j = tid % 64;
            p.q.qD[((size_t)(b * 4 + h) * SEQ + s) * 96 + j] = f2bf(bf2f(p.qfull[(size_t)t * 384 + h * 96 + j]) * scD);
            p.q.kD[((size_t)(b * 4 + h) * SEQ + s) * 96 + j] = p.kvfull[(size_t)t * 512 + h * 128 + j];
            p.q.vD[((size_t)(b * 4 + h) * SEQ + s) * 64 + j] = p.kvfull[(size_t)t * 512 + h * 128 + 64 + j];
        }
        if (tid < 64) {
            const int h = tid / 16, j = tid % 16;
            const float x1 = bf2f(p.qfull[(size_t)t * 384 + h * 96 + 64 + j]), x2 = bf2f(p.qfull[(size_t)t * 384 + h * 96 + 80 + j]);
            const float c = p.tb.cosm[s * 16 + j], sn = p.tb.sinm[s * 16 + j];
            const size_t ob = ((size_t)(b * 4 + h) * SEQ + s) * 96;
            p.q.qD[ob + 64 + j] = f2bf((x1 * c - x2 * sn) * scD); p.q.qD[ob + 80 + j] = f2bf((x2 * c + x1 * sn) * scD);
        }
    }
}

__device__ __forceinline__ void phase_att(PC& p, int l, char* lds) {
    for (int it = blockIdx.x; it < 1024; it += gridDim.x) attn_item<96, 1, false>(p.q.qD, p.q.kD, p.q.vD, nullptr, p.ob, 768, 4, 4, it, lds);
    for (int it = blockIdx.x; it < 1024; it += gridDim.x) attn_item<64, 2, false>(p.q.qB, p.q.kB, p.q.vB, nullptr, p.ob, 256, 4, 2, it, lds);
    for (int it = blockIdx.x; it < 1024; it += gridDim.x) attn_item<64, 2, true>(p.q.qA, p.q.kA, p.q.vA, p.win_sink + l * 4, p.ob, 0, 4, 2, it, lds);
    {
        const int wave = tid_opaque() >> 6;
        char* wl = lds + wave * 6144;
        const int off = (int)(uintptr_t)wl;
        for (int wi = blockIdx.x * 4 + wave; wi < 4096; wi += gridDim.x * 4) dil_wave_item(p.q.qC, p.q.kC, p.q.vC, p.ob, wi, wl, off);
    }
}

__device__ __forceinline__ void phase_gn(PC& p, int l) {
    const int wave = tid_opaque() >> 6, lane = tid_opaque() & 63;
    const float* gg = p.g_group + (size_t)l * 1024;
    for (int t = blockIdx.x * 4 + wave; t < T_TOK; t += gridDim.x * 4) {
#pragma unroll
        for (int g = 0; g < 4; ++g) {
            const uint2 w = *(const uint2*)(p.ob + (size_t)t * DM + g * 256 + lane * 4);
            const float v0 = __uint_as_float(w.x << 16), v1 = __uint_as_float(w.x & 0xffff0000u), v2 = __uint_as_float(w.y << 16), v3 = __uint_as_float(w.y & 0xffff0000u);
            float ss = v0 * v0 + v1 * v1 + v2 * v2 + v3 * v3;
            ss = wave_sum(ss);
            const float r = rsqrtf(ss * (1.f / 256.f) + 1e-6f);
            const float4 g4 = *(const float4*)(gg + g * 256 + lane * 4);
            uint2 o; o.x = cvtpk(v0 * r * g4.x, v1 * r * g4.y); o.y = cvtpk(v2 * r * g4.z, v3 * r * g4.w);
            *(uint2*)(p.hnb + (size_t)t * DM + g * 256 + lane * 4) = o;
        }
    }
}
__device__ __forceinline__ void phase_g2(PC& p, int l, char* lds) {
    EpiResidF32 e{p.x, DM};
    gemm_phase(p.hnb, DM, p.woutT + (size_t)l * DM * DM, DM, T_TOK, DM, DM, lds, e);
}
__device__ __forceinline__ void phase_n2(PC& p, int l) {
    const int wave = tid_opaque() >> 6, lane = tid_opaque() & 63;
    for (int t = blockIdx.x * 4 + wave; t < T_TOK; t += gridDim.x * 4)
        rms_row_bf16(p.x + (size_t)t * DM, p.g_ffn + l * DM, p.hnb + (size_t)t * DM, nullptr, lane);
}
__device__ __forceinline__ void phase_g3(PC& p, int l, char* lds) {
    EpiStoreBf16 e{p.qp, 2048, 2048};
    gemm_phase(p.hnb, DM, p.wqT + (size_t)l * 2048 * DM, DM, T_TOK, 2048, DM, lds, e);
}
__device__ __forceinline__ void phase_topk(PC& p, int l, char* lds) {
    const int wave = tid_opaque() >> 6;
    char* wl = lds + wave * 2304;
    const bf16_t* sk = p.subk + (size_t)l * 8 * 2 * 128 * 128;
    for (int wi = blockIdx.x * 4 + wave; wi < 8192; wi += gridDim.x * 4) topk_wave_item(p.qp, sk, p.eidx, p.gate, wi, wl);
}
__device__ __forceinline__ void phase_exp(PC& p, int l) {
    const int wave = tid_opaque() >> 6;
    for (int t = blockIdx.x * 4 + wave; t < T_TOK; t += gridDim.x * 4) expert_token(p, l, t, l == DEPTH - 1);
}

template <int PH>
__global__ void __launch_bounds__(256, 2) k_phase(P p, int l) {
    extern __shared__ __attribute__((aligned(16))) char lds[];
    if (PH == 0) phase_pro(*kargs(), lds);
    if (PH == 1) phase_g1(*kargs(), l, lds);
    if (PH == 2) phase_post(*kargs(), l, lds);
    if (PH == 3) phase_mla(*kargs(), l, lds);
    if (PH == 4) phase_postmla(*kargs(), l);
    if (PH == 5) phase_att(*kargs(), l, lds);
    if (PH == 6) phase_gn(*kargs(), l);
    if (PH == 7) phase_g2(*kargs(), l, lds);
    if (PH == 8) phase_n2(*kargs(), l);
    if (PH == 9) phase_g3(*kargs(), l, lds);
    if (PH == 10) phase_topk(*kargs(), l, lds);
    if (PH == 11) phase_exp(*kargs(), l);
    if (PH == 13) { const int wave = tid_opaque() >> 6; for (int t = blockIdx.x * 4 + wave; t < T_TOK; t += gridDim.x * 4) expert_token(*kargs(), l, t, l == DEPTH - 1, true); }
    if (PH == 12) { const int wave = tid_opaque() >> 6, lane = tid_opaque() & 63; for (int t = blockIdx.x * 4 + wave; t < T_TOK; t += gridDim.x * 4) rms_row_bf16(kargs()->x + (size_t)t * DM, kargs()->g_mix + l * DM, kargs()->hnb + (size_t)t * DM, nullptr, lane); }
}
#define XB_TMO      128
#define XB_XCNT(j)  (256  + 64 * (j))
#define XB_XSUB(j)  (1280 + 64 * (j))
#define XB_XGEN(j)  (2304 + 64 * (j))
#define XB_TOP      3328
#define XB_TOPGEN   3392
#define XCD_BAR_WORDS 3456
#define XB_SPIN_CAP (1u << 18)
#define LAS __attribute__((address_space(3)))

__device__ __forceinline__ unsigned xb_ld(unsigned* p)              { return __hip_atomic_load(p, __ATOMIC_RELAXED, __HIP_MEMORY_SCOPE_AGENT); }
__device__ __forceinline__ unsigned xb_add(unsigned* p, unsigned v) { return __hip_atomic_fetch_add(p, v, __ATOMIC_RELAXED, __HIP_MEMORY_SCOPE_AGENT); }
__device__ __forceinline__ unsigned xb_xcc_id() { return (unsigned)__builtin_amdgcn_s_getreg((3 << 11) | 20) & 0xFu; }
#define XB_SPIN(cond, bar) do { unsigned _sp = 0; while (cond) { __builtin_amdgcn_s_sleep(1); \
    if ((++_sp & 255u) == 0u) { if (xb_ld(&(bar)[XB_TMO])) break; if (_sp > XB_SPIN_CAP) { atomicAdd(&(bar)[XB_TMO], 1u); break; } } } } while (0)

struct XcdBarrier {
    unsigned* bar; unsigned x;
    volatile LAS unsigned* st;
};

__device__ __forceinline__ XcdBarrier xcd_barrier_post(unsigned* bar, volatile LAS unsigned* st) {
    XcdBarrier b; b.bar = bar; b.x = xb_xcc_id(); b.st = st;
    if (threadIdx.x == 0) (void)xb_add(&bar[XB_XCNT(b.x)], 1u);
    return b;
}
__device__ __forceinline__ void xcd_barrier_complete(unsigned* bar, unsigned x, unsigned& nloc, unsigned& nx) {
    const unsigned G = gridDim.x * gridDim.y * gridDim.z;
    unsigned sum, cnt, mine, sp = 0u;
    for (;;) {
        sum = 0u; cnt = 0u; mine = 0u;
#pragma unroll
        for (unsigned j = 0; j < 16; ++j) { const unsigned c = xb_ld(&bar[XB_XCNT(j)]); sum += c; cnt += (c > 0u) ? 1u : 0u; mine = (j == x) ? c : mine; }
        if (sum == G) break;
        __builtin_amdgcn_s_sleep(1);
        if ((++sp & 255u) == 0u) { if (xb_ld(&bar[XB_TMO])) break; if (sp > XB_SPIN_CAP) { atomicAdd(&bar[XB_TMO], 1u); break; } }
    }
    nloc = mine > 0u ? mine : 1u; nx = cnt > 0u ? cnt : 1u;
}

__device__ __forceinline__ void xcd_barrier(const XcdBarrier& b) {
    asm volatile("s_waitcnt vmcnt(0)" ::: "memory");
    __syncthreads();
    if (threadIdx.x == 0) {
        unsigned* bar = b.bar;
        __builtin_amdgcn_s_waitcnt(0);
        unsigned nloc = b.st[0], nx = b.st[1];
        if (nloc == 0u) { xcd_barrier_complete(bar, b.x, nloc, nx); b.st[0] = nloc; b.st[1] = nx; }
        const unsigned old = xb_add(&bar[XB_XSUB(b.x)], 1u);
        const unsigned gen = old / nloc;
        if (old + 1u == (gen + 1u) * nloc) {
            __builtin_amdgcn_fence(__ATOMIC_RELEASE, "agent");
            asm volatile("s_waitcnt vmcnt(0)" ::: "memory");
            const unsigned og = xb_add(&bar[XB_TOP], 1u);
            const unsigned tg = og / nx;
            if (og + 1u == (tg + 1u) * nx) xb_add(&bar[XB_TOPGEN], 1u);
            else XB_SPIN(xb_ld(&bar[XB_TOPGEN]) == tg, bar);
            __builtin_amdgcn_fence(__ATOMIC_ACQUIRE, "agent");
            xb_add(&bar[XB_XGEN(b.x)], 1u);
            asm volatile("s_waitcnt vmcnt(0)" ::: "memory");
        } else {
            XB_SPIN(xb_ld(&bar[XB_XGEN(b.x)]) == gen, bar);
            __builtin_amdgcn_fence(__ATOMIC_ACQUIRE, "agent");
            asm volatile("s_waitcnt vmcnt(0)" ::: "memory");
        }
    }
    __syncthreads();
}


__global__ void __launch_bounds__(256, 2) k_mega(P p) {
    extern __shared__ __attribute__((aligned(16))) char lds[];
    uint4* xbw = (uint4*)(lds + LDS_BYTES);
    if (threadIdx.x == 0) *xbw = make_uint4(0u, 0u, 0u, 0u);
    __syncthreads();
    XcdBarrier bar = xcd_barrier_post(kargs()->bar, (volatile LAS unsigned*)xbw);
    phase_pro(*kargs(), lds); xcd_barrier(bar);
    for (int l = 0; l < DEPTH; ++l) {
        phase_g1(*kargs(), l, lds); xcd_barrier(bar);
        phase_post(*kargs(), l, lds); xcd_barrier(bar);
        phase_mla(*kargs(), l, lds); xcd_barrier(bar);
        phase_postmla(*kargs(), l); xcd_barrier(bar);
        phase_att(*kargs(), l, lds); xcd_barrier(bar);
        phase_gn(*kargs(), l); xcd_barrier(bar);
        phase_g2(*kargs(), l, lds); xcd_barrier(bar);
        phase_n2(*kargs(), l); xcd_barrier(bar);
        phase_g3(*kargs(), l, lds); xcd_barrier(bar);
        phase_topk(*kargs(), l, lds); xcd_barrier(bar);
        phase_exp(*kargs(), l);
        if (l + 1 < DEPTH) xcd_barrier(bar);
    }
}
#ifndef OPT_MASK
#define OPT_MASK 0x7f
#endif
#ifndef MEGA
#define MEGA 1
#endif
#ifndef PROBE_REPEAT
#define PROBE_REPEAT 0
#endif
static inline size_t align_up(size_t v, size_t a) { return (v + a - 1) / a * a; }
#define DYN_LDS (LDS_BYTES + 64)

template <int PH> static void launch_phase(const P& p, int l, hipStream_t stream) {
    static bool attr_done = false;
    if (!attr_done) { (void)hipFuncSetAttribute((const void*)k_phase<PH>, hipFuncAttributeMaxDynamicSharedMemorySize, DYN_LDS); attr_done = true; }
    k_phase<PH><<<512, 256, DYN_LDS, stream>>>(p, l);
    if ((PROBE_REPEAT >> PH) & 1) k_phase<PH><<<512, 256, DYN_LDS, stream>>>(p, l);
}

extern "C" void kernel_launch(void* const* d_in, const int* in_sizes, int n_in, void* d_out, int out_size, void* d_ws, size_t ws_size,
                              hipStream_t stream) {
    P p{};
    p.x_in = (const float*)d_in[0]; p.g_mix = (const float*)d_in[1]; p.w_in = (const float*)d_in[2]; p.win_sink = (const float*)d_in[3];
    p.ax_q_norm = (const float*)d_in[4]; p.ax_k_norm = (const float*)d_in[5]; p.mla_q_norm = (const float*)d_in[6]; p.mla_kv_norm = (const float*)d_in[7];
    p.mla_w_uq = (const float*)d_in[8]; p.mla_w_ukv = (const float*)d_in[9]; p.g_group = (const float*)d_in[10]; p.w_out = (const float*)d_in[11];
    p.g_ffn = (const float*)d_in[12]; p.peer_w_q = (const float*)d_in[13]; p.peer_sub_keys = (const float*)d_in[14]; p.peer_u = (const float*)d_in[15];
    p.peer_v = (const float*)d_in[16]; p.g_final = (const float*)d_in[17];
    p.out = (float*)d_out;

    char* w = (char*)d_ws; size_t off = 0;
    auto carve = [&](size_t bytes) { void* q = w + off; off = align_up(off + bytes, 256); return q; };
    p.bar = (unsigned*)carve(16384);
    p.x = (float*)carve((size_t)T_TOK * DM * 4);
    p.hnb = (bf16_t*)carve((size_t)T_TOK * DM * 2);
    char* regZ = (char*)carve((size_t)T_TOK * 2048 * 2);
    p.zb = (bf16_t*)regZ; p.qp = (bf16_t*)regZ;
    p.qfull = (bf16_t*)regZ; p.kvfull = (bf16_t*)(regZ + (size_t)T_TOK * 384 * 2);
    QKV& q = p.q;
    q.qA = (bf16_t*)carve((size_t)T_TOK * 256 * 2); q.kA = (bf16_t*)carve((size_t)T_TOK * 128 * 2); q.vA = (bf16_t*)carve((size_t)T_TOK * 128 * 2);
    q.qB = (bf16_t*)carve((size_t)T_TOK * 256 * 2); q.kB = (bf16_t*)carve((size_t)T_TOK * 128 * 2); q.vB = (bf16_t*)carve((size_t)T_TOK * 128 * 2);
    q.qC = (bf16_t*)carve((size_t)T_TOK * 256 * 2); q.kC = (bf16_t*)carve((size_t)T_TOK * 128 * 2); q.vC = (bf16_t*)carve((size_t)T_TOK * 128 * 2);
    q.qD = (bf16_t*)carve((size_t)T_TOK * 384 * 2); q.kD = (bf16_t*)carve((size_t)T_TOK * 384 * 2); q.vD = (bf16_t*)carve((size_t)T_TOK * 256 * 2);
    p.ob = (bf16_t*)carve((size_t)T_TOK * DM * 2);
    p.cqn = p.ob; p.ckvn = p.ob + (size_t)T_TOK * 256;
    p.eidx = (int*)carve((size_t)T_TOK * 128 * 4);
    p.gate = (float*)carve((size_t)T_TOK * 128 * 4);
    p.winT = (bf16_t*)carve((size_t)DEPTH * NZ * DM * 2);
    p.woutT = (bf16_t*)carve((size_t)DEPTH * DM * DM * 2);
    p.wqT = (bf16_t*)carve((size_t)DEPTH * 2048 * DM * 2);
    p.subk = (bf16_t*)carve((size_t)DEPTH * 8 * 2 * 128 * 128 * 2);
    p.wuqT = (bf16_t*)carve((size_t)DEPTH * 384 * 256 * 2);
    p.wukvT = (bf16_t*)carve((size_t)DEPTH * 512 * 128 * 2);
    if (OPT_MASK & 64) {
        p.u8 = (unsigned char*)carve((size_t)DEPTH * 16384 * DM);
        p.v8 = (unsigned char*)carve((size_t)DEPTH * 16384 * DM);
        p.su = (float*)carve((size_t)DEPTH * 16384 * 4);
        p.sv = (float*)carve((size_t)DEPTH * 16384 * 4);
        p.flags = 1;
    }
    Tables& tb = p.tb;
    tb.cos1 = (float*)carve(4096 * 32 * 4); tb.sin1 = (float*)carve(4096 * 32 * 4);
    tb.cosm = (float*)carve(4096 * 16 * 4); tb.sinm = (float*)carve(4096 * 16 * 4);
    tb.cosr = (float*)carve(64 * 16 * 4); tb.sinr = (float*)carve(64 * 16 * 4);
    tb.cosc = (float*)carve(64 * 16 * 4); tb.sinc = (float*)carve(64 * 16 * 4);
    float* hn = nullptr; float *cqn_f = nullptr, *ckvn_f = nullptr, *qfull_f = nullptr, *kvfull_f = nullptr;
    if (OPT_MASK != 0x7f) {
        hn = (float*)carve((size_t)T_TOK * DM * 4);
        cqn_f = (float*)carve((size_t)T_TOK * 256 * 4); ckvn_f = (float*)carve((size_t)T_TOK * 128 * 4);
        qfull_f = (float*)carve((size_t)T_TOK * 384 * 4); kvfull_f = hn;
    }
    if (off > ws_size) { fprintf(stderr, "workspace too small: need %zu have %zu\n", off, ws_size); return; }

#if MEGA
    {
        static int grid = 0;
        if (!grid) {
            int dev = 0, cus = 0, per_cu = 0;
            (void)hipGetDevice(&dev);
            (void)hipDeviceGetAttribute(&cus, hipDeviceAttributeMultiprocessorCount, dev);
            (void)hipFuncSetAttribute((const void*)k_mega, hipFuncAttributeMaxDynamicSharedMemorySize, DYN_LDS);
            (void)hipOccupancyMaxActiveBlocksPerMultiprocessor(&per_cu, k_mega, 256, DYN_LDS);
            if (per_cu < 1) per_cu = 1;
            grid = cus * (per_cu < 2 ? per_cu : 2);
        }
        (void)hipMemsetAsync(p.bar, 0, XCD_BAR_WORDS * sizeof(unsigned), stream);
        k_mega<<<grid, 256, DYN_LDS, stream>>>(p);
        return;
    }
#endif
    const float* x_in = p.x_in; float* x = p.x; float* out = p.out;
    launch_phase<0>(p, 0, stream);

    for (int l = 0; l < DEPTH; ++l) {
        if (OPT_MASK & 1) {
            if (l > 0 && !(OPT_MASK & 64)) launch_phase<12>(p, l, stream);
            launch_phase<1>(p, l, stream);
        } else {
            k_rmsnorm_f32<<<T_TOK / 4, 256, 0, stream>>>(x, p.g_mix + l * DM, hn, T_TOK);
            k_ngemm<float, bf16_t, false><<<dim3((NZ + 127) / 128, T_TOK / 128), 256, 0, stream>>>(hn, DM, p.w_in + (size_t)l * DM * NZ, NZ, p.zb, NZ, nullptr, 0, T_TOK, NZ, DM);
        }
        if (OPT_MASK & 2) {
            launch_phase<2>(p, l, stream); launch_phase<3>(p, l, stream); launch_phase<4>(p, l, stream);
        } else {
            PostArgs pa; pa.z = p.zb; pa.o = q; pa.tb = tb;
            pa.g_qn = p.ax_q_norm + l * 64; pa.g_kn = p.ax_k_norm + l * 64; pa.g_cq = p.mla_q_norm + l * 256; pa.g_ckv = p.mla_kv_norm + l * 128;
            pa.cqn = cqn_f; pa.ckvn = ckvn_f;
            k_post_naive<<<T_TOK, 256, 0, stream>>>(pa);
            k_ngemm<float, float, false><<<dim3(384 / 128, T_TOK / 128), 256, 0, stream>>>(cqn_f, 256, p.mla_w_uq + (size_t)l * 256 * 384, 384, qfull_f, 384, nullptr, 0, T_TOK, 384, 256);
            k_ngemm<float, float, false><<<dim3(512 / 128, T_TOK / 128), 256, 0, stream>>>(ckvn_f, 128, p.mla_w_ukv + (size_t)l * 128 * 512, 512, kvfull_f, 512, nullptr, 0, T_TOK, 512, 128);
            k_post_mla<<<T_TOK, 256, 0, stream>>>(qfull_f, kvfull_f, q, tb);
        }
        if (OPT_MASK & 4) {
            launch_phase<5>(p, l, stream);
        } else {
            k_attn_naive<64, 1><<<NBATCH * 4 * SEQ / 4, 256, 0, stream>>>(q.qA, q.kA, q.vA, p.win_sink + l * 4, p.ob, 4, 2, 0);
            k_attn_naive<64, 0><<<NBATCH * 4 * SEQ / 4, 256, 0, stream>>>(q.qB, q.kB, q.vB, nullptr, p.ob, 4, 2, 256);
            k_attn_naive<64, 2><<<NBATCH * 4 * SEQ / 4, 256, 0, stream>>>(q.qC, q.kC, q.vC, nullptr, p.ob, 4, 2, 512);
            k_attn_naive<96, 0><<<NBATCH * 4 * SEQ / 4, 256, 0, stream>>>(q.qD, q.kD, q.vD, nullptr, p.ob, 4, 4, 768);
        }
        if (OPT_MASK & 8) {
            launch_phase<6>(p, l, stream); launch_phase<7>(p, l, stream);
        } else {
            k_groupnorm_f32<<<T_TOK / 4, 256, 0, stream>>>(p.ob, p.g_group + (size_t)l * 1024, hn);
            k_ngemm<float, float, true><<<dim3(DM / 128, T_TOK / 128), 256, 0, stream>>>(hn, DM, p.w_out + (size_t)l * DM * DM, DM, x, DM, x, DM, T_TOK, DM, DM);
        }
        if (OPT_MASK & 16) {
            launch_phase<8>(p, l, stream); launch_phase<9>(p, l, stream);
            if (!(OPT_MASK & 64)) k_rmsnorm_f32<<<T_TOK / 4, 256, 0, stream>>>(x, p.g_ffn + l * DM, hn, T_TOK);
        } else {
            k_rmsnorm_f32<<<T_TOK / 4, 256, 0, stream>>>(x, p.g_ffn + l * DM, hn, T_TOK);
            k_ngemm<float, bf16_t, false><<<dim3(2048 / 128, T_TOK / 128), 256, 0, stream>>>(hn, DM, p.peer_w_q + (size_t)l * DM * 2048, 2048, p.qp, 2048, nullptr, 0, T_TOK, 2048, DM);
        }
        if (OPT_MASK & 32) launch_phase<10>(p, l, stream);
        else k_peer_topk_naive<<<T_TOK * 8, 64, 0, stream>>>(p.qp, p.peer_sub_keys + (size_t)l * 8 * 2 * 128 * 128, p.eidx, p.gate);
        if ((PROBE_REPEAT >> 13) & 1) launch_phase<13>(p, l, stream);
        if (OPT_MASK & 64) launch_phase<11>(p, l, stream);
        else {
            k_peer_expert_naive<<<T_TOK, 256, 0, stream>>>(hn, p.eidx, p.gate, p.peer_u + (size_t)l * 16384 * DM, p.peer_v + (size_t)l * 16384 * DM, x);
            if (l == DEPTH - 1) k_rmsnorm_f32<<<T_TOK / 4, 256, 0, stream>>>(x, p.g_final, out, T_TOK);
        }
    }
    (void)x_in; (void)in_sizes; (void)n_in; (void)out_size;
}
```

```cpp
#include <hip/hip_runtime.h>
#include <stdint.h>
#include <stdio.h>

typedef unsigned short bf16_t;

#define T_TOK 32768
#define SEQ 4096
#define NBATCH 8
#define DM 1024
#define NZ 1952
#define DEPTH 4
#define LOG2E 1.4426950408889634f

__device__ __forceinline__ float bf2f(bf16_t v) { return __uint_as_float(((unsigned)v) << 16); }
__device__ __forceinline__ bf16_t f2bf(float f) {
    unsigned u = __float_as_uint(f);
    u += 0x7fffu + ((u >> 16) & 1u);
    return (bf16_t)(u >> 16);
}
__device__ __forceinline__ float wave_sum(float v) {
#pragma unroll
    for (int o = 32; o >= 1; o >>= 1) v += __shfl_xor(v, o);
    return v;
}
__device__ __forceinline__ float wave_max(float v) {
#pragma unroll
    for (int o = 32; o >= 1; o >>= 1) v = fmaxf(v, __shfl_xor(v, o));
    return v;
}

struct Tables { float *cos1, *sin1, *cosm, *sinm, *cosr, *sinr, *cosc, *sinc; };

__global__ void k_tables(Tables tb) {
    int i = blockIdx.x * blockDim.x + threadIdx.x;
    if (i < 4096 * 32) {
        int pos = i / 32, j = i % 32;
        float inv = powf(10000.f, -(float)(2 * j) / 64.f);
        float ang = (float)pos * inv;
        tb.cos1[i] = cosf(ang); tb.sin1[i] = sinf(ang);
    }
    if (i < 4096 * 16) {
        int pos = i / 16, j = i % 16;
        float inv = powf(10000.f, -(float)(2 * j) / 32.f);
        float ang = (float)pos * inv;
        tb.cosm[i] = cosf(ang); tb.sinm[i] = sinf(ang);
    }
    if (i < 64 * 16) {
        int pos = i / 16, j = i % 16;
        float inv = powf(10000.f, -(float)(2 * j) / 32.f);
        float ang = (float)pos * inv;
        tb.cosr[i] = cosf(ang); tb.sinr[i] = sinf(ang);
        tb.cosc[i] = cosf(ang); tb.sinc[i] = sinf(ang);
    }
}

__global__ void __launch_bounds__(256) k_rmsnorm_f32(const float* __restrict__ x, const float* __restrict__ g, float* __restrict__ out, int rows) {
    int row = blockIdx.x * 4 + (threadIdx.x >> 6), lane = threadIdx.x & 63;
    if (row >= rows) return;
    const float4* xr = (const float4*)(x + (size_t)row * DM);
    float4 v[4]; float ss = 0.f;
#pragma unroll
    for (int i = 0; i < 4; ++i) { v[i] = xr[lane + 64 * i]; ss += v[i].x * v[i].x + v[i].y * v[i].y + v[i].z * v[i].z + v[i].w * v[i].w; }
    ss = wave_sum(ss);
    float rstd = rsqrtf(ss * (1.f / DM) + 1e-6f);
    float4* orow = (float4*)(out + (size_t)row * DM);
    const float4* g4 = (const float4*)g;
#pragma unroll
    for (int i = 0; i < 4; ++i) {
        float4 gg = g4[lane + 64 * i]; float4 o;
        o.x = v[i].x * rstd * gg.x; o.y = v[i].y * rstd * gg.y; o.z = v[i].z * rstd * gg.z; o.w = v[i].w * rstd * gg.w;
        orow[lane + 64 * i] = o;
    }
}

__global__ void __launch_bounds__(256) k_groupnorm_f32(const bf16_t* __restrict__ o, const float* __restrict__ gg, float* __restrict__ out) {
    int row = blockIdx.x * 4 + (threadIdx.x >> 6), lane = threadIdx.x & 63;
    const bf16_t* orow = o + (size_t)row * DM;
#pragma unroll
    for (int g = 0; g < 4; ++g) {
        float v[4]; float ss = 0.f;
#pragma unroll
        for (int i = 0; i < 4; ++i) { v[i] = bf2f(orow[g * 256 + lane + 64 * i]); ss += v[i] * v[i]; }
        ss = wave_sum(ss);
        float rstd = rsqrtf(ss * (1.f / 256.f) + 1e-6f);
#pragma unroll
        for (int i = 0; i < 4; ++i) out[(size_t)row * DM + g * 256 + lane + 64 * i] = v[i] * rstd * gg[g * 256 + lane + 64 * i];
    }
}

template <typename AT> __device__ __forceinline__ float ldA(const AT* p);
template <> __device__ __forceinline__ float ldA<float>(const float* p) { return *p; }
template <> __device__ __forceinline__ float ldA<bf16_t>(const bf16_t* p) { return bf2f(*p); }
__device__ __forceinline__ void stC(float* p, float v) { *p = v; }
__device__ __forceinline__ void stC(bf16_t* p, float v) { *p = f2bf(v); }

template <typename AT, typename CT, bool RES>
__global__ void __launch_bounds__(256) k_ngemm(const AT* __restrict__ A, int lda, const float* __restrict__ B, int ldb,
                                               CT* C, int ldc, const float* R, int ldr, int M, int N, int K) {
    __shared__ float As[16][132];
    __shared__ float Bs[16][132];
    const int tid = threadIdx.x, tx = tid & 15, ty = tid >> 4;
    const int m0 = blockIdx.y * 128, n0 = blockIdx.x * 128;
    float acc[8][8];
#pragma unroll
    for (int i = 0; i < 8; ++i)
#pragma unroll
        for (int j = 0; j < 8; ++j) acc[i][j] = 0.f;
    const int ar = tid >> 1, ak = (tid & 1) * 8;
    const int bk = tid >> 4, bn = (tid & 15) * 8;
    for (int k0 = 0; k0 < K; k0 += 16) {
#pragma unroll
        for (int i = 0; i < 8; ++i) As[ak + i][ar] = ldA<AT>(A + (size_t)(m0 + ar) * lda + k0 + ak + i);
#pragma unroll
        for (int i = 0; i < 8; ++i) { int n = n0 + bn + i; Bs[bk][bn + i] = (n < N) ? B[(size_t)(k0 + bk) * ldb + n] : 0.f; }
        __syncthreads();
#pragma unroll
        for (int kk = 0; kk < 16; ++kk) {
            float a[8], b[8];
#pragma unroll
            for (int i = 0; i < 8; ++i) a[i] = As[kk][ty * 8 + i];
#pragma unroll
            for (int j = 0; j < 8; ++j) b[j] = Bs[kk][tx * 8 + j];
#pragma unroll
            for (int i = 0; i < 8; ++i)
#pragma unroll
                for (int j = 0; j < 8; ++j) acc[i][j] += a[i] * b[j];
        }
        __syncthreads();
    }
#pragma unroll
    for (int i = 0; i < 8; ++i) {
        int m = m0 + ty * 8 + i;
#pragma unroll
        for (int j = 0; j < 8; ++j) {
            int n = n0 + tx * 8 + j;
            if (n < N) {
                float v = acc[i][j];
                if (RES) v += R[(size_t)m * ldr + n];
                stC(C + (size_t)m * ldc + n, v);
            }
        }
    }
}

struct QKV {
    bf16_t *qA, *kA, *vA, *qB, *kB, *vB, *qC, *kC, *vC, *qD, *kD, *vD;
};
struct PostArgs {
    const bf16_t* z; QKV o; Tables tb;
    const float *g_qn, *g_kn, *g_cq, *g_ckv;
    float *cqn, *ckvn;
};

__global__ void __launch_bounds__(256) k_post_naive(PostArgs a) {
    __shared__ float zr[NZ];
    __shared__ float hs[8];
    const int t = blockIdx.x, tid = threadIdx.x;
    const int b = t / SEQ, s = t % SEQ;
    for (int i = tid; i < NZ; i += 256) zr[i] = bf2f(a.z[(size_t)t * NZ + i]);
    __syncthreads();
    if (tid < 8) {
        int base, n;
        if (tid < 4) { base = 512 + tid * 64; n = 64; }
        else if (tid < 6) { base = 768 + (tid - 4) * 64; n = 64; }
        else if (tid == 6) { base = 1536; n = 256; }
        else { base = 1792; n = 128; }
        float ss = 0.f;
        for (int i = 0; i < n; ++i) ss += zr[base + i] * zr[base + i];
        hs[tid] = rsqrtf(ss / (float)n + 1e-6f);
    }
    __syncthreads();
    const float scA = 0.125f * LOG2E;
    const float scD = 0.10206207261596575f * LOG2E;
    for (int mix = 0; mix < 2; ++mix) {
        const int zb = mix == 0 ? 0 : 1024;
        bf16_t* qo = mix == 0 ? a.o.qA : a.o.qC;
        bf16_t* ko = mix == 0 ? a.o.kA : a.o.kC;
        bf16_t* vo = mix == 0 ? a.o.vA : a.o.vC;
        for (int i = tid; i < 128; i += 256) {
            int h = i / 32, j = i % 32;
            float x1 = zr[zb + h * 64 + j], x2 = zr[zb + h * 64 + 32 + j];
            float c = a.tb.cos1[s * 32 + j], sn = a.tb.sin1[s * 32 + j];
            size_t ob = ((size_t)(b * 4 + h) * SEQ + s) * 64;
            qo[ob + j] = f2bf((x1 * c - x2 * sn) * scA);
            qo[ob + 32 + j] = f2bf((x2 * c + x1 * sn) * scA);
        }
        for (int i = tid; i < 64; i += 256) {
            int h = i / 32, j = i % 32;
            float x1 = zr[zb + 256 + h * 64 + j], x2 = zr[zb + 256 + h * 64 + 32 + j];
            float c = a.tb.cos1[s * 32 + j], sn = a.tb.sin1[s * 32 + j];
            size_t ob = ((size_t)(b * 2 + h) * SEQ + s) * 64;
            ko[ob + j] = f2bf(x1 * c - x2 * sn);
            ko[ob + 32 + j] = f2bf(x2 * c + x1 * sn);
        }
        for (int i = tid; i < 128; i += 256) {
            int h = i / 64, j = i % 64;
            vo[((size_t)(b * 2 + h) * SEQ + s) * 64 + j] = f2bf(zr[zb + 384 + i]);
        }
    }
    {
        const int row = s / 64, col = s % 64;
        for (int i = tid; i < 192; i += 256) {
            int hh = i / 32, r = i % 32, half = r / 16, j = r % 16;
            bool isq = hh < 4;
            int zb = isq ? 512 + hh * 64 : 768 + (hh - 4) * 64;
            const float* gn = isq ? a.g_qn : a.g_kn;
            float rstd = hs[hh];
            int d1 = half * 32 + j, d2 = half * 32 + 16 + j;
            float x1 = zr[zb + d1] * rstd * gn[d1], x2 = zr[zb + d2] * rstd * gn[d2];
            float c, sn;
            if (half == 0) { c = a.tb.cosr[row * 16 + j]; sn = a.tb.sinr[row * 16 + j]; }
            else { c = a.tb.cosc[col * 16 + j]; sn = a.tb.sinc[col * 16 + j]; }
            float o1 = x1 * c - x2 * sn, o2 = x2 * c + x1 * sn;
            if (isq) {
                size_t ob = ((size_t)(b * 4 + hh) * SEQ + s) * 64;
                a.o.qB[ob + d1] = f2bf(o1 * scA); a.o.qB[ob + d2] = f2bf(o2 * scA);
            } else {
                size_t ob = ((size_t)(b * 2 + (hh - 4)) * SEQ + s) * 64;
                a.o.kB[ob + d1] = f2bf(o1); a.o.kB[ob + d2] = f2bf(o2);
            }
        }
        for (int i = tid; i < 128; i += 256) {
            int h = i / 64, j = i % 64;
            a.o.vB[((size_t)(b * 2 + h) * SEQ + s) * 64 + j] = f2bf(zr[896 + i]);
        }
    }
    for (int i = tid; i < 256; i += 256) a.cqn[(size_t)t * 256 + i] = zr[1536 + i] * hs[6] * a.g_cq[i];
    for (int i = tid; i < 128; i += 256) a.ckvn[(size_t)t * 128 + i] = zr[1792 + i] * hs[7] * a.g_ckv[i];
    for (int i = tid; i < 16; i += 256) {
        float x1 = zr[1920 + i], x2 = zr[1920 + 16 + i];
        float c = a.tb.cosm[s * 16 + i], sn = a.tb.sinm[s * 16 + i];
        bf16_t o1 = f2bf(x1 * c - x2 * sn), o2 = f2bf(x2 * c + x1 * sn);
        for (int h = 0; h < 4; ++h) {
            size_t ob = ((size_t)(b * 4 + h) * SEQ + s) * 96;
            a.o.kD[ob + 64 + i] = o1; a.o.kD[ob + 80 + i] = o2;
        }
    }
    (void)scD;
}

__global__ void __launch_bounds__(256) k_post_mla(const float* __restrict__ qfull, const float* __restrict__ kvfull, QKV o, Tables tb) {
    const int t = blockIdx.x, tid = threadIdx.x;
    const int b = t / SEQ, s = t % SEQ;
    const float scD = 0.10206207261596575f * LOG2E;
    {
        int h = tid / 64, j = tid % 64;
        o.qD[((size_t)(b * 4 + h) * SEQ + s) * 96 + j] = f2bf(qfull[(size_t)t * 384 + h * 96 + j] * scD);
    }
    if (tid < 64) {
        int h = tid / 16, j = tid % 16;
        float x1 = qfull[(size_t)t * 384 + h * 96 + 64 + j], x2 = qfull[(size_t)t * 384 + h * 96 + 80 + j];
        float c = tb.cosm[s * 16 + j], sn = tb.sinm[s * 16 + j];
        size_t ob = ((size_t)(b * 4 + h) * SEQ + s) * 96;
        o.qD[ob + 64 + j] = f2bf((x1 * c - x2 * sn) * scD);
        o.qD[ob + 80 + j] = f2bf((x2 * c + x1 * sn) * scD);
    }
    {
        int h = tid / 64, j = tid % 64;
        o.kD[((size_t)(b * 4 + h) * SEQ + s) * 96 + j] = f2bf(kvfull[(size_t)t * 512 + h * 128 + j]);
        o.vD[((size_t)(b * 4 + h) * SEQ + s) * 64 + j] = f2bf(kvfull[(size_t)t * 512 + h * 128 + 64 + j]);
    }
}

template <int DK, int MODE>
__global__ void __launch_bounds__(256) k_attn_naive(const bf16_t* __restrict__ Q, const bf16_t* __restrict__ K, const bf16_t* __restrict__ V,
                                                    const float* __restrict__ sink, bf16_t* __restrict__ O, int H, int KV, int ocol) {
    const int wave = threadIdx.x >> 6, lane = threadIdx.x & 63;
    const int gq = blockIdx.x * 4 + wave;
    const int s = gq % SEQ, bh = gq / SEQ, h = bh % H, b = bh / H;
    const int kvh = h / (H / KV);
    const bf16_t* qrow = Q + (size_t)gq * DK;
    const bf16_t* Kb = K + (size_t)(b * KV + kvh) * SEQ * DK;
    const bf16_t* Vb = V + (size_t)(b * KV + kvh) * SEQ * 64;
    const int sub = lane & 7, grp = lane >> 3;
    constexpr int NCH = DK / 8;
    float q0[8], q1[8];
    {
        uint4 r = *(const uint4*)(qrow + sub * 8);
        const bf16_t* p = (const bf16_t*)&r;
#pragma unroll
        for (int i = 0; i < 8; ++i) q0[i] = bf2f(p[i]);
        const bool has1 = (NCH > 8) && (sub + 8 < NCH);
        uint4 r1 = make_uint4(0, 0, 0, 0);
        if (has1) r1 = *(const uint4*)(qrow + (sub + 8) * 8);
        const bf16_t* p1 = (const bf16_t*)&r1;
#pragma unroll
        for (int i = 0; i < 8; ++i) q1[i] = bf2f(p1[i]);
    }
    float m = -1e30f, l = 0.f, acc[8];
#pragma unroll
    for (int i = 0; i < 8; ++i) acc[i] = 0.f;
    if (MODE == 1 && grp == 0) { m = sink[h] * LOG2E; l = 1.f; }
    const int nk = MODE == 0 ? SEQ : (MODE == 1 ? 257 : 387);
    for (int base = 0; base < nk; base += 8) {
        const int kk = base + grp;
        bool valid = kk < nk;
        int tok;
        if (MODE == 0) tok = kk;
        else if (MODE == 1) tok = s - 128 + kk;
        else { int p = kk / 129, j = kk % 129; int r = p == 0 ? 1 : (p == 1 ? 4 : 16); tok = s + (j - 64) * r; }
        valid = valid && tok >= 0 && tok < SEQ;
        float sc = 0.f;
        if (valid) {
            uint4 r = *(const uint4*)(Kb + (size_t)tok * DK + sub * 8);
            const bf16_t* p = (const bf16_t*)&r;
#pragma unroll
            for (int i = 0; i < 8; ++i) sc += q0[i] * bf2f(p[i]);
            if (NCH > 8 && sub + 8 < NCH) {
                uint4 r1 = *(const uint4*)(Kb + (size_t)tok * DK + (sub + 8) * 8);
                const bf16_t* p1 = (const bf16_t*)&r1;
#pragma unroll
                for (int i = 0; i < 8; ++i) sc += q1[i] * bf2f(p1[i]);
            }
        }
        sc += __shfl_xor(sc, 1); sc += __shfl_xor(sc, 2); sc += __shfl_xor(sc, 4);
        if (valid) {
            float mn = fmaxf(m, sc);
            float f = exp2f(m - mn), p = exp2f(sc - mn);
            uint4 r = *(const uint4*)(Vb + (size_t)tok * 64 + sub * 8);
            const bf16_t* pv = (const bf16_t*)&r;
            l = l * f + p;
#pragma unroll
            for (int i = 0; i < 8; ++i) acc[i] = acc[i] * f + p * bf2f(pv[i]);
            m = mn;
        }
    }
    float M = m;
    M = fmaxf(M, __shfl_xor(M, 8)); M = fmaxf(M, __shfl_xor(M, 16)); M = fmaxf(M, __shfl_xor(M, 32));
    float f = exp2f(m - M);
    l *= f;
    l += __shfl_xor(l, 8); l += __shfl_xor(l, 16); l += __shfl_xor(l, 32);
#pragma unroll
    for (int i = 0; i < 8; ++i) {
        float v = acc[i] * f;
        v += __shfl_xor(v, 8); v += __shfl_xor(v, 16); v += __shfl_xor(v, 32);
        acc[i] = v;
    }
    if (grp == 0) {
        const int t = b * SEQ + s;
        float inv = 1.f / l;
#pragma unroll
        for (int i = 0; i < 8; ++i) O[(size_t)t * DM + ocol + h * 64 + sub * 8 + i] = f2bf(acc[i] * inv);
    }
}

__global__ void __launch_bounds__(64) k_peer_topk_naive(const bf16_t* __restrict__ qp, const float* __restrict__ subk  ,
                                                        int* __restrict__ eidx, float* __restrict__ gate) {
    __shared__ float qs[256];
    __shared__ float s12[2][16];
    __shared__ int i12[2][16];
    const int t = blockIdx.x >> 3, h = blockIdx.x & 7, lane = threadIdx.x;
    for (int i = lane; i < 256; i += 64) qs[i] = bf2f(qp[(size_t)t * 2048 + h * 256 + i]);
    __syncthreads();
    float sc[2][2];
#pragma unroll
    for (int c = 0; c < 2; ++c)
#pragma unroll
        for (int u = 0; u < 2; ++u) {
            int n = lane + 64 * u;
            const float* kr = subk + ((size_t)(h * 2 + c) * 128 + n) * 128;
            float a = 0.f;
            for (int d = 0; d < 128; ++d) a += qs[c * 128 + d] * kr[d];
            sc[c][u] = a;
        }
#pragma unroll
    for (int c = 0; c < 2; ++c) {
        for (int r = 0; r < 16; ++r) {
            float bv; int bi;
            if (sc[c][0] >= sc[c][1]) { bv = sc[c][0]; bi = lane; } else { bv = sc[c][1]; bi = lane + 64; }
#pragma unroll
            for (int o = 32; o >= 1; o >>= 1) {
                float ov = __shfl_xor(bv, o); int oi = __shfl_xor(bi, o);
                if (ov > bv || (ov == bv && oi < bi)) { bv = ov; bi = oi; }
            }
            if (bi == lane) sc[c][0] = -3e38f;
            if (bi == lane + 64) sc[c][1] = -3e38f;
            if (lane == 0) { s12[c][r] = bv; i12[c][r] = bi; }
        }
    }
    __syncthreads();
    float cv[4]; int ci[4];
#pragma unroll
    for (int u = 0; u < 4; ++u) {
        int id = lane + 64 * u;
        cv[u] = s12[0][id / 16] + s12[1][id % 16];
        ci[u] = i12[0][id / 16] * 128 + i12[1][id % 16];
    }
    float best = 0.f; int be = 0;
    for (int r = 0; r < 16; ++r) {
        float bv = cv[0]; int bu = 0;
#pragma unroll
        for (int u = 1; u < 4; ++u) if (cv[u] > bv) { bv = cv[u]; bu = u; }
        int bid = lane + 64 * bu;
#pragma unroll
        for (int o = 32; o >= 1; o >>= 1) {
            float ov = __shfl_xor(bv, o); int oi = __shfl_xor(bid, o);
            if (ov > bv || (ov == bv && oi < bid)) { bv = ov; bid = oi; }
        }
        int e = 0;
#pragma unroll
        for (int u = 0; u < 4; ++u) if (bid == lane + 64 * u) { cv[u] = -3e38f; e = ci[u]; }
        e = __shfl(e, bid & 63);
        if (lane == r) { best = bv; be = e; }
    }
    float mx = lane < 16 ? best : -3e38f;
    mx = wave_max(mx);
    float ex = lane < 16 ? expf(best - mx) : 0.f;
    float sm = wave_sum(ex);
    if (lane < 16) {
        eidx[(size_t)t * 128 + h * 16 + lane] = be;
        gate[(size_t)t * 128 + h * 16 + lane] = ex / sm;
    }
}

__global__ void __launch_bounds__(256) k_peer_expert_naive(const float* __restrict__ hn, const int* __restrict__ eidx, const float* __restrict__ gate,
                                                           const float* __restrict__ ut, const float* __restrict__ vt, float* __restrict__ x) {
    __shared__ float hs[DM];
    __shared__ float wg[128];
    __shared__ int es[128];
    const int t = blockIdx.x, tid = threadIdx.x, wave = tid >> 6, lane = tid & 63;
    for (int i = tid; i < DM; i += 256) hs[i] = hn[(size_t)t * DM + i];
    if (tid < 128) es[tid] = eidx[(size_t)t * 128 + tid];
    __syncthreads();
    for (int p = wave * 32; p < wave * 32 + 32; ++p) {
        const float* ur = ut + (size_t)es[p] * DM;
        float a = 0.f;
#pragma unroll
        for (int i = 0; i < 16; ++i) a += ur[lane + 64 * i] * hs[lane + 64 * i];
        a = wave_sum(a);
        if (lane == 0) {
            float ge = 0.5f * a * (1.f + erff(a * 0.70710678118654752f));
            wg[p] = gate[(size_t)t * 128 + p] * ge;
        }
    }
    __syncthreads();
    float o[4] = {0.f, 0.f, 0.f, 0.f};
    for (int p = 0; p < 128; ++p) {
        const float* vr = vt + (size_t)es[p] * DM;
        float w = wg[p];
#pragma unroll
        for (int i = 0; i < 4; ++i) o[i] += w * vr[tid + 256 * i];
    }
#pragma unroll
    for (int i = 0; i < 4; ++i) x[(size_t)t * DM + tid + 256 * i] += o[i];
}

using bf16x8 = __attribute__((ext_vector_type(8))) short;
using s16x4 = __attribute__((ext_vector_type(4))) short;
using f32x16 = __attribute__((ext_vector_type(16))) float;
typedef __attribute__((ext_vector_type(2))) __bf16 bf16x2_t;

#define NBLK_THREADS 256
#define LDS_BYTES 65536

__device__ __forceinline__ unsigned cvtpk(float lo, float hi) {
    unsigned r; asm("v_cvt_pk_bf16_f32 %0, %1, %2" : "=v"(r) : "v"(lo), "v"(hi)); return r;
}
__device__ __forceinline__ int tid_opaque() { int t = threadIdx.x; asm volatile("" : "+v"(t)); return t; }
__device__ __forceinline__ int crow(int i, int hh) { return (i & 3) + 8 * (i >> 2) + 4 * hh; }
__device__ __forceinline__ float xhalf(float v) { return __shfl_xor(v, 32); }
__device__ __forceinline__ float xhalf_max(float v) { auto rr = __builtin_amdgcn_permlane32_swap(__float_as_uint(v), __float_as_uint(v), false, false); return fmaxf(__uint_as_float(rr[0]), __uint_as_float(rr[1])); }
__device__ __forceinline__ float xhalf_sum(float v) { auto rr = __builtin_amdgcn_permlane32_swap(__float_as_uint(v), __float_as_uint(v), false, false); return __uint_as_float(rr[0]) + __uint_as_float(rr[1]); }

struct P {
    const float *x_in, *g_mix, *w_in, *win_sink, *ax_q_norm, *ax_k_norm, *mla_q_norm, *mla_kv_norm, *mla_w_uq, *mla_w_ukv, *g_group, *w_out,
        *g_ffn, *peer_w_q, *peer_sub_keys, *peer_u, *peer_v, *g_final;
    float* out;
    float* x; bf16_t* hnb; bf16_t* zb; QKV q; bf16_t* ob; bf16_t* qp; int* eidx; float* gate;
    bf16_t *cqn, *ckvn, *qfull, *kvfull;
    bf16_t *winT, *woutT, *wqT, *subk, *wuqT, *wukvT;
    unsigned char *u8, *v8; float *su, *sv; float* ssq2; bf16_t* xb2;
    Tables tb;
    unsigned* bar;
    int flags; int pad0;
};
typedef const P __attribute__((address_space(4))) PC;
__device__ __forceinline__ PC* kargs() { PC* q = (PC*)__builtin_amdgcn_kernarg_segment_ptr(); asm volatile("" : "+s"(q)); return q; }

struct EpiStoreBf16 {
    bf16_t* C; int ldc; int N;
    __device__ __forceinline__ void operator()(const f32x16 (&acc)[2][2], int mbase, int nbase, int r32, int hh) const {
#pragma unroll
        for (int mt = 0; mt < 2; ++mt)
#pragma unroll
            for (int nt = 0; nt < 2; ++nt) {
                const int n = nbase + nt * 32 + r32;
                if (n < N) {
#pragma unroll
                    for (int i = 0; i < 16; ++i) {
                        const int m = mbase + mt * 32 + crow(i, hh);
                        C[(size_t)m * ldc + n] = f2bf(acc[mt][nt][i]);
                    }
                }
            }
    }
};
struct EpiResidNorm {
    float* X; int ldx; bf16_t* XB; float* ssq;
    __device__ __forceinline__ void operator()(const f32x16 (&acc)[2][2], int mbase, int nbase, int r32, int hh) const {
#pragma unroll
        for (int mt = 0; mt < 2; ++mt) {
#pragma unroll
            for (int i = 0; i < 16; ++i) {
                const int m = mbase + mt * 32 + crow(i, hh);
                float sq = 0.f;
#pragma unroll
                for (int nt = 0; nt < 2; ++nt) {
                    const int n = nbase + nt * 32 + r32;
                    float* px = X + (size_t)m * ldx + n;
                    const float v = *px + acc[mt][nt][i];
                    *px = v;
                    XB[(size_t)m * ldx + n] = f2bf(v);
                    sq += v * v;
                }
                sq += __shfl_xor(sq, 1); sq += __shfl_xor(sq, 2); sq += __shfl_xor(sq, 4); sq += __shfl_xor(sq, 8); sq += __shfl_xor(sq, 16);
                if (r32 == 0) ssq[(size_t)m * 16 + (nbase >> 6)] = sq;
            }
        }
    }
};
struct EpiStoreBf16RowNorm {
    bf16_t* C; int ldc; const float* ssq;
    __device__ __forceinline__ void operator()(const f32x16 (&acc)[2][2], int mbase, int nbase, int r32, int hh) const {
#pragma unroll
        for (int mt = 0; mt < 2; ++mt)
#pragma unroll
            for (int i = 0; i < 16; ++i) {
                const int m = mbase + mt * 32 + crow(i, hh);
                const float4 q0 = *(const float4*)(ssq + (size_t)m * 16), q1 = *(const float4*)(ssq + (size_t)m * 16 + 4);
                const float4 q2 = *(const float4*)(ssq + (size_t)m * 16 + 8), q3 = *(const float4*)(ssq + (size_t)m * 16 + 12);
                const float tot = (((q0.x + q0.y) + (q0.z + q0.w)) + ((q1.x + q1.y) + (q1.z + q1.w))) + (((q2.x + q2.y) + (q2.z + q2.w)) + ((q3.x + q3.y) + (q3.z + q3.w)));
                const float r = rsqrtf(tot * (1.f / DM) + 1e-6f);
#pragma unroll
                for (int nt = 0; nt < 2; ++nt) C[(size_t)m * ldc + nbase + nt * 32 + r32] = f2bf(acc[mt][nt][i] * r);
            }
    }
};
struct EpiResidF32 {
    float* X; int ldx;
    __device__ __forceinline__ void operator()(const f32x16 (&acc)[2][2], int mbase, int nbase, int r32, int hh) const {
#pragma unroll
        for (int mt = 0; mt < 2; ++mt)
#pragma unroll
            for (int nt = 0; nt < 2; ++nt) {
                const int n = nbase + nt * 32 + r32;
#pragma unroll
                for (int i = 0; i < 16; ++i) {
                    const int m = mbase + mt * 32 + crow(i, hh);
                    float* p = X + (size_t)m * ldx + n;
                    *p = *p + acc[mt][nt][i];
                }
            }
    }
};

__device__ __forceinline__ void glds16(const void* gsrc, unsigned lds_dst) {
    unsigned keep;
    asm volatile("s_mov_b32 %0, m0\n\ts_mov_b32 m0, %2\n\ts_nop 0\n\tglobal_load_lds_dwordx4 %1, off\n\ts_mov_b32 m0, %0" : "=&s"(keep) : "v"(gsrc), "s"(lds_dst) : "memory");
}

template <class Epi>
__device__ __forceinline__ void gemm_tile(const bf16_t* __restrict__ X, int ldx, const bf16_t* __restrict__ W, int ldw, int K, int m0, int n0, int N,
                                          char* lds, const Epi& epi) {
    const int tid = tid_opaque(), lane = tid & 63, wave = tid >> 6;
    const int wm = wave >> 1, wn = wave & 1;
    const int r32 = lane & 31, hh = lane >> 5;
    const char* xsrc[4]; const char* wsrc[4];
#pragma unroll
    for (int j = 0; j < 4; ++j) {
        const int row = (wave * 4 + j) * 8 + (lane >> 3), slot = lane & 7;
        const int c = slot ^ ((row >> 1) & 7);
        xsrc[j] = (const char*)(X + (size_t)(m0 + row) * ldx + c * 8);
        int n = n0 + row; n = n < N ? n : N - 1;
        wsrc[j] = (const char*)(W + (size_t)n * ldw + c * 8);
    }
    const unsigned lbase = (unsigned)(uintptr_t)lds;
    const unsigned wpiece = __builtin_amdgcn_readfirstlane(wave) * 4096u;
    f32x16 acc[2][2];
#pragma unroll
    for (int a = 0; a < 2; ++a)
#pragma unroll
        for (int b = 0; b < 2; ++b)
#pragma unroll
            for (int i = 0; i < 16; ++i) acc[a][b][i] = 0.f;
    const int nk = K >> 6;
#define GDMA(KT, BUF) do { const unsigned _d = lbase + (BUF) * 32768u + wpiece; const int _ko = (KT) * 128; \
        glds16(xsrc[0] + _ko, _d); glds16(xsrc[1] + _ko, _d + 1024u); glds16(xsrc[2] + _ko, _d + 2048u); glds16(xsrc[3] + _ko, _d + 3072u); \
        glds16(wsrc[0] + _ko, _d + 16384u); glds16(wsrc[1] + _ko, _d + 17408u); glds16(wsrc[2] + _ko, _d + 18432u); glds16(wsrc[3] + _ko, _d + 19456u); } while (0)
    GDMA(0, 0);
    asm volatile("s_waitcnt vmcnt(0)" ::: "memory");
    __syncthreads();
    for (int kt = 0; kt < nk; ++kt) {
        if (kt + 1 < nk) GDMA(kt + 1, (kt + 1) & 1);
        const char* xs = lds + (kt & 1) * 32768; const char* ws = xs + 16384;
#pragma unroll
        for (int ks = 0; ks < 4; ++ks) {
            bf16x8 xf[2], wf[2];
#pragma unroll
            for (int mt = 0; mt < 2; ++mt) { const int r = wm * 64 + mt * 32 + r32; xf[mt] = *(const bf16x8*)(xs + r * 128 + (((ks * 2 + hh) ^ ((r >> 1) & 7)) << 4)); }
#pragma unroll
            for (int nt = 0; nt < 2; ++nt) { const int r = wn * 64 + nt * 32 + r32; wf[nt] = *(const bf16x8*)(ws + r * 128 + (((ks * 2 + hh) ^ ((r >> 1) & 7)) << 4)); }
#pragma unroll
            for (int mt = 0; mt < 2; ++mt)
#pragma unroll
                for (int nt = 0; nt < 2; ++nt) acc[mt][nt] = __builtin_amdgcn_mfma_f32_32x32x16_bf16(xf[mt], wf[nt], acc[mt][nt], 0, 0, 0);
        }
        asm volatile("s_waitcnt vmcnt(0)" ::: "memory");
        __syncthreads();
    }
#undef GDMA
    epi(acc, m0 + wm * 64, n0 + wn * 64, r32, hh);
}

__device__ __forceinline__ void tile_map(int tile, int ntm, int ntn, int& mt, int& nt) {
    if ((ntn & 7) == 0) {
        const int G = gridDim.x;
        const int round = tile / G, bi = tile % G;
        const int x = bi & 7, j = bi >> 3;
        const int per = G >> 3;
        const int id = (round * 8 + x) * per + j;
        const int st = id >> 6, in = id & 63;
        const int snt = ntn >> 3;
        const int sm = st / snt, sn = st % snt;
        mt = sm * 8 + (in >> 3); nt = sn * 8 + (in & 7);
    } else { mt = tile / ntn; nt = tile % ntn; }
}

template <class Epi>
__device__ __forceinline__ void gemm_phase(const bf16_t* X, int ldx, const bf16_t* W, int ldw, int M, int N, int K, char* lds, const Epi& epi) {
    const int ntm = M >> 7, ntn = (N + 127) >> 7, nt_tot = ntm * ntn;
    for (int tile = blockIdx.x; tile < nt_tot; tile += gridDim.x) {
        int mt, nt;
        if ((gridDim.x & 7) == 0 && (gridDim.x >> 3) * 8 == gridDim.x && ((gridDim.x >> 3) & 63) == 0) tile_map(tile, ntm, ntn, mt, nt);
        else { mt = tile / ntn; nt = tile % ntn; }
        if (mt < ntm && nt < ntn) gemm_tile(X, ldx, W, ldw, K, mt * 128, nt * 128, N, lds, epi);
    }
}

template <int OFF> __device__ __forceinline__ s16x4 tr_read(int vb) {
    s16x4 r; asm volatile("ds_read_b64_tr_b16 %0, %1 offset:%2" : "=&v"(r) : "v"(vb), "i"(OFF) : "memory"); return r;
}
#define VS_BYTES 192

template <int KT2>
__device__ __forceinline__ void pv_sub(f32x16 (&o)[2], const f32x16& p, int vbase) {
    bf16x8 pf[2];
#pragma unroll
    for (int s2 = 0; s2 < 2; ++s2) {
        unsigned a = cvtpk(p[8 * s2 + 0], p[8 * s2 + 1]), b = cvtpk(p[8 * s2 + 2], p[8 * s2 + 3]);
        unsigned c = cvtpk(p[8 * s2 + 4], p[8 * s2 + 5]), d = cvtpk(p[8 * s2 + 6], p[8 * s2 + 7]);
        uint4 w = make_uint4(a, b, c, d);
        pf[s2] = *(bf16x8*)&w;
    }
    {
        s16x4 l00 = tr_read<(KT2 * 32 + 0) * VS_BYTES + 0>(vbase), h00 = tr_read<(KT2 * 32 + 8) * VS_BYTES + 0>(vbase);
        s16x4 l01 = tr_read<(KT2 * 32 + 0) * VS_BYTES + 64>(vbase), h01 = tr_read<(KT2 * 32 + 8) * VS_BYTES + 64>(vbase);
        s16x4 l10 = tr_read<(KT2 * 32 + 16) * VS_BYTES + 0>(vbase), h10 = tr_read<(KT2 * 32 + 24) * VS_BYTES + 0>(vbase);
        s16x4 l11 = tr_read<(KT2 * 32 + 16) * VS_BYTES + 64>(vbase), h11 = tr_read<(KT2 * 32 + 24) * VS_BYTES + 64>(vbase);
        asm volatile("s_waitcnt lgkmcnt(0)" ::: "memory");
        __builtin_amdgcn_sched_barrier(0);
#define PKV(L, H) (bf16x8){L[0], L[1], L[2], L[3], H[0], H[1], H[2], H[3]}
        o[0] = __builtin_amdgcn_mfma_f32_32x32x16_bf16(PKV(l00, h00), pf[0], o[0], 0, 0, 0);
        o[1] = __builtin_amdgcn_mfma_f32_32x32x16_bf16(PKV(l01, h01), pf[0], o[1], 0, 0, 0);
        o[0] = __builtin_amdgcn_mfma_f32_32x32x16_bf16(PKV(l10, h10), pf[1], o[0], 0, 0, 0);
        o[1] = __builtin_amdgcn_mfma_f32_32x32x16_bf16(PKV(l11, h11), pf[1], o[1], 0, 0, 0);
#undef PKV
    }
}


#define PV_LOAD(KT2, VB, F) \
    const s16x4 F##0 = tr_read<((KT2) * 32 + 0) * VS_BYTES + 0>(VB), F##1 = tr_read<((KT2) * 32 + 8) * VS_BYTES + 0>(VB), \
                F##2 = tr_read<((KT2) * 32 + 0) * VS_BYTES + 64>(VB), F##3 = tr_read<((KT2) * 32 + 8) * VS_BYTES + 64>(VB), \
                F##4 = tr_read<((KT2) * 32 + 16) * VS_BYTES + 0>(VB), F##5 = tr_read<((KT2) * 32 + 24) * VS_BYTES + 0>(VB), \
                F##6 = tr_read<((KT2) * 32 + 16) * VS_BYTES + 64>(VB), F##7 = tr_read<((KT2) * 32 + 24) * VS_BYTES + 64>(VB)
#define PKV2(L, H) (bf16x8){L[0], L[1], L[2], L[3], H[0], H[1], H[2], H[3]}
#define PV_MMA(O, P, F) do { bf16x8 _pf0, _pf1; \
        { uint4 _w = make_uint4(cvtpk(P[0], P[1]), cvtpk(P[2], P[3]), cvtpk(P[4], P[5]), cvtpk(P[6], P[7])); _pf0 = *(bf16x8*)&_w; } \
        { uint4 _w = make_uint4(cvtpk(P[8], P[9]), cvtpk(P[10], P[11]), cvtpk(P[12], P[13]), cvtpk(P[14], P[15])); _pf1 = *(bf16x8*)&_w; } \
        O[0] = __builtin_amdgcn_mfma_f32_32x32x16_bf16(PKV2(F##0, F##1), _pf0, O[0], 0, 0, 0); \
        O[1] = __builtin_amdgcn_mfma_f32_32x32x16_bf16(PKV2(F##2, F##3), _pf0, O[1], 0, 0, 0); \
        O[0] = __builtin_amdgcn_mfma_f32_32x32x16_bf16(PKV2(F##4, F##5), _pf1, O[0], 0, 0, 0); \
        O[1] = __builtin_amdgcn_mfma_f32_32x32x16_bf16(PKV2(F##6, F##7), _pf1, O[1], 0, 0, 0); } while (0)

template <int DK, int G, bool WINDOW>
__device__ __forceinline__ void attn_item(const bf16_t* __restrict__ Q, const bf16_t* __restrict__ K, const bf16_t* __restrict__ V, const float* __restrict__ sink,
                                          bf16_t* __restrict__ O, int ocol, int H, int KV, int item, char* lds) {
    constexpr int KS = DK * 2 + 16;
    constexpr int KCH = DK / 8;
    constexpr int KLD = (64 * KCH) / 256;
    constexpr int QB = 128 / G;
    constexpr int NCH = SEQ / QB;
    constexpr int KBUF = 64 * KS, VBUF = 64 * VS_BYTES;
    const int tid = tid_opaque(), lane = tid & 63, wave = tid >> 6;
    const int r32 = lane & 31, hh = lane >> 5;
    const int chunk = item % NCH, kvh = (item / NCH) % KV, b = item / (NCH * KV);
    const int g = (G == 2) ? (wave >> 1) : 0;
    const int qoff = (G == 2) ? (wave & 1) * 32 : wave * 32;
    const int head = kvh * G + g;
    const int q0 = chunk * QB;
    const int qpos = q0 + qoff + r32;
    bf16x8 qf[DK / 16];
    {
        const bf16_t* qp = Q + ((size_t)(b * H + head) * SEQ + qpos) * DK + hh * 8;
#pragma unroll
        for (int ks = 0; ks < DK / 16; ++ks) qf[ks] = *(const bf16x8*)(qp + ks * 16);
    }
    int kt_lo = 0, kt_hi = SEQ / 64;
    if (WINDOW) { kt_lo = q0 / 64 - 2; if (kt_lo < 0) kt_lo = 0; kt_hi = (q0 + QB) / 64 + 2; if (kt_hi > SEQ / 64) kt_hi = SEQ / 64; }
    const char* Kg = (const char*)(K + (size_t)(b * KV + kvh) * SEQ * DK);
    const char* Vg = (const char*)(V + (size_t)(b * KV + kvh) * SEQ * 64);
    uint4 kr0, kr1, kr2 = make_uint4(0, 0, 0, 0), vr0, vr1;
    int koff[KLD], voff[2];
#pragma unroll
    for (int j = 0; j < KLD; ++j) { const int id = tid + 256 * j; koff[j] = (id / KCH) * KS + (id % KCH) * 16; }
#pragma unroll
    for (int j = 0; j < 2; ++j) { const int id = tid + 256 * j; voff[j] = (id >> 3) * VS_BYTES + (id & 7) * 16; }
    f32x16 o[2];
#pragma unroll
    for (int d = 0; d < 2; ++d)
#pragma unroll
        for (int i = 0; i < 16; ++i) o[d][i] = 0.f;
    float m = -1e30f, l = 0.f;
    if (WINDOW) { m = sink[head] * LOG2E; l = (hh == 0) ? 1.f : 0.f; }
    const int gg = lane >> 4, li = lane & 15;
    const int vlane = (4 * (gg >> 1) + (li >> 2)) * VS_BYTES + (16 * (gg & 1) + 4 * (li & 3)) * 2;
    char* Kl = lds; char* Vl = lds + 2 * KBUF;
#define AGLOAD(KT) do { const char* _kg = Kg + (size_t)(KT) * 64 * DK * 2; const char* _vg = Vg + (size_t)(KT) * 64 * 128; \
        kr0 = *(const uint4*)(_kg + tid * 16); kr1 = *(const uint4*)(_kg + (tid + 256) * 16); if (KLD > 2) kr2 = *(const uint4*)(_kg + (tid + 512) * 16); \
        vr0 = *(const uint4*)(_vg + tid * 16); vr1 = *(const uint4*)(_vg + (tid + 256) * 16); } while (0)
#define ASTORE(KB, VB) do { char* _kd = (KB); char* _vd = (VB); *(uint4*)(_kd + koff[0]) = kr0; *(uint4*)(_kd + koff[1]) = kr1; if (KLD > 2) *(uint4*)(_kd + koff[KLD - 1]) = kr2; \
        *(uint4*)(_vd + voff[0]) = vr0; *(uint4*)(_vd + voff[1]) = vr1; } while (0)
    AGLOAD(kt_lo);
    ASTORE(Kl, Vl);
    { const int k1 = kt_lo + 1 < kt_hi ? kt_lo + 1 : kt_lo; AGLOAD(k1); }
    __syncthreads();
    for (int kt = kt_lo; kt < kt_hi; ++kt) {
        const int cur = (kt - kt_lo) & 1;
        ASTORE(Kl + (cur ^ 1) * KBUF, Vl + (cur ^ 1) * VBUF);
        { const int ktn = kt + 2 < kt_hi ? kt + 2 : kt_hi - 1; AGLOAD(ktn); }
        __builtin_amdgcn_sched_barrier(0);
        const char* kb = Kl + cur * KBUF;
        f32x16 s0, s1;
#pragma unroll
        for (int i = 0; i < 16; ++i) { s0[i] = 0.f; s1[i] = 0.f; }
#pragma unroll
        for (int ks = 0; ks < DK / 16; ++ks) {
            bf16x8 k0 = *(const bf16x8*)(kb + r32 * KS + (ks * 2 + hh) * 16);
            bf16x8 k1 = *(const bf16x8*)(kb + (32 + r32) * KS + (ks * 2 + hh) * 16);
            s0 = __builtin_amdgcn_mfma_f32_32x32x16_bf16(k0, qf[ks], s0, 0, 0, 0);
            s1 = __builtin_amdgcn_mfma_f32_32x32x16_bf16(k1, qf[ks], s1, 0, 0, 0);
        }
        if (WINDOW) {
            const int kb0 = kt * 64 + 4 * hh - qpos;
#pragma unroll
            for (int i = 0; i < 16; ++i) {
                const int d0 = kb0 + (i & 3) + 8 * (i >> 2), d1 = d0 + 32;
                s0[i] = (d0 > 128 || d0 < -128) ? -1e30f : s0[i];
                s1[i] = (d1 > 128 || d1 < -128) ? -1e30f : s1[i];
            }
        }
        const int vbase = (int)(size_t)(Vl + cur * VBUF - lds) + vlane;
        PV_LOAD(0, vbase, vfa);
        PV_LOAD(1, vbase, vfb);
        __builtin_amdgcn_sched_barrier(0);
        float tmax = s0[0];
#pragma unroll
        for (int i = 1; i < 16; ++i) tmax = fmaxf(tmax, s0[i]);
#pragma unroll
        for (int i = 0; i < 16; ++i) tmax = fmaxf(tmax, s1[i]);
        tmax = xhalf_max(tmax);
        const float mn = fmaxf(m, tmax);
        const float alpha = __builtin_amdgcn_exp2f(m - mn);
        m = mn;
        float ps = 0.f;
#pragma unroll
        for (int i = 0; i < 16; ++i) { s0[i] = __builtin_amdgcn_exp2f(s0[i] - mn); ps += s0[i]; }
#pragma unroll
        for (int i = 0; i < 16; ++i) { s1[i] = __builtin_amdgcn_exp2f(s1[i] - mn); ps += s1[i]; }
        l = l * alpha + ps;
        if (__any(alpha != 1.f)) {
#pragma unroll
            for (int d = 0; d < 2; ++d)
#pragma unroll
                for (int i = 0; i < 16; ++i) o[d][i] *= alpha;
        }
        asm volatile("s_waitcnt lgkmcnt(0)" ::: "memory");
        __builtin_amdgcn_sched_barrier(0);
        PV_MMA(o, s0, vfa);
        PV_MMA(o, s1, vfb);
        __syncthreads();
    }
#undef AGLOAD
#undef ASTORE
    l = xhalf_sum(l);
    const float inv = 1.f / l;
    bf16_t* orow = O + (size_t)(b * SEQ + qpos) * DM + ocol + head * 64;
#pragma unroll
    for (int d = 0; d < 2; ++d)
#pragma unroll
        for (int gq = 0; gq < 4; ++gq) {
            uint2 w;
            w.x = cvtpk(o[d][gq * 4 + 0] * inv, o[d][gq * 4 + 1] * inv);
            w.y = cvtpk(o[d][gq * 4 + 2] * inv, o[d][gq * 4 + 3] * inv);
            *(uint2*)(orow + d * 32 + 8 * gq + 4 * hh) = w;
        }
}

__device__ __forceinline__ void dil_wave_item(const bf16_t* __restrict__ Q, const bf16_t* __restrict__ K, const bf16_t* __restrict__ V,
                                              bf16_t* __restrict__ O, int witem, char* wlds, int lds_off) {
    const int lane = tid_opaque() & 63, r32 = lane & 31, hh = lane >> 5;
    const int c = witem & 15, chunk = (witem >> 4) & 15, kvh = (witem >> 8) & 1, b = witem >> 9;
    const int t0 = chunk * 256;
    const int mq = r32 & 15, g = r32 >> 4;
    const int qpos = t0 + 16 * mq + c, head = kvh * 2 + g;
    bf16x8 qf[4];
    {
        const bf16_t* qp = Q + ((size_t)(b * 4 + head) * SEQ + qpos) * 64 + hh * 8;
#pragma unroll
        for (int ks = 0; ks < 4; ++ks) qf[ks] = *(const bf16x8*)(qp + ks * 16);
    }
    const bf16_t* Kg = K + (size_t)(b * 2 + kvh) * SEQ * 64;
    const bf16_t* Vg = V + (size_t)(b * 2 + kvh) * SEQ * 64;
    f32x16 o[2];
#pragma unroll
    for (int d = 0; d < 2; ++d)
#pragma unroll
        for (int i = 0; i < 16; ++i) o[d][i] = 0.f;
    float m = -1e30f, l = 0.f;
    const int gg = lane >> 4, li = lane & 15;
    const int vlane = lds_off + (4 * (gg >> 1) + (li >> 2)) * VS_BYTES + (16 * (gg & 1) + 4 * (li & 3)) * 2;
    for (int it = 0; it < 23; ++it) {
        int sh, j;
        if (it < 12) { sh = 0; j = it; } else if (it < 18) { sh = 2; j = it - 12; } else { sh = 4; j = it - 18; }
        const int rr = 1 << sh;
        const int cc = c & (rr - 1);
        const int idx0 = (t0 >> sh) - 64 + 32 * j;
        const int lim = SEQ >> sh;
        if (idx0 + 31 < 0 || idx0 >= lim) continue;
        bf16x8 kf[4];
        {
            int idx = idx0 + r32; idx = idx < 0 ? 0 : (idx >= lim ? lim - 1 : idx);
            const bf16_t* kp = Kg + (size_t)((idx << sh) + cc) * 64 + hh * 8;
#pragma unroll
            for (int ks = 0; ks < 4; ++ks) kf[ks] = *(const bf16x8*)(kp + ks * 16);
        }
        uint4 vr[4];
#pragma unroll
        for (int jj = 0; jj < 4; ++jj) {
            const int id = lane + 64 * jj; int idx = idx0 + (id >> 3); idx = idx < 0 ? 0 : (idx >= lim ? lim - 1 : idx);
            vr[jj] = *(const uint4*)(Vg + (size_t)((idx << sh) + cc) * 64 + (id & 7) * 8);
        }
#pragma unroll
        for (int jj = 0; jj < 4; ++jj) { const int id = lane + 64 * jj; *(uint4*)(wlds + (id >> 3) * VS_BYTES + (id & 7) * 16) = vr[jj]; }
        f32x16 s;
#pragma unroll
        for (int i = 0; i < 16; ++i) s[i] = 0.f;
#pragma unroll
        for (int ks = 0; ks < 4; ++ks) s = __builtin_amdgcn_mfma_f32_32x32x16_bf16(kf[ks], qf[ks], s, 0, 0, 0);
        const int qidx = qpos >> sh;
        const int base = idx0 + 4 * hh;
#pragma unroll
        for (int i = 0; i < 16; ++i) {
            const int idx = base + (i & 3) + 8 * (i >> 2);
            const int d = idx - qidx;
            s[i] = (d > 64 || d < -64 || idx < 0 || idx >= lim) ? -1e30f : s[i];
        }
        float tmax = s[0];
#pragma unroll
        for (int i = 1; i < 16; ++i) tmax = fmaxf(tmax, s[i]);
        tmax = fmaxf(tmax, xhalf(tmax));
        const float mn = fmaxf(fmaxf(m, tmax), -1e20f);
        const float alpha = __builtin_amdgcn_exp2f(m - mn);
        m = mn;
        float ps = 0.f;
#pragma unroll
        for (int i = 0; i < 16; ++i) { s[i] = __builtin_amdgcn_exp2f(s[i] - mn); ps += s[i]; }
        l = l * alpha + ps;
#pragma unroll
        for (int d = 0; d < 2; ++d)
#pragma unroll
            for (int i = 0; i < 16; ++i) o[d][i] *= alpha;
        pv_sub<0>(o, s, vlane);
    }
    l += xhalf(l);
    const float inv = 1.f / l;
    bf16_t* orow = O + (size_t)(b * SEQ + qpos) * DM + 512 + head * 64;
#pragma unroll
    for (int d = 0; d < 2; ++d)
#pragma unroll
        for (int gq = 0; gq < 4; ++gq) {
            uint2 w;
            w.x = cvtpk(o[d][gq * 4 + 0] * inv, o[d][gq * 4 + 1] * inv);
            w.y = cvtpk(o[d][gq * 4 + 2] * inv, o[d][gq * 4 + 3] * inv);
            *(uint2*)(orow + d * 32 + 8 * gq + 4 * hh) = w;
        }
}

__device__ __forceinline__ int f2key(float f) { int b = __float_as_int(f); return b ^ ((b >> 31) & 0x7fffffff); }
__device__ __forceinline__ float key2f(int k) { return __int_as_float(k ^ ((k >> 31) & 0x7fffffff)); }

template <int N>
__device__ __forceinline__ void bitonic_sort_desc(int (&a)[N]) {
#pragma unroll
    for (int k = 2; k <= N; k <<= 1) {
#pragma unroll
        for (int j = k >> 1; j > 0; j >>= 1) {
#pragma unroll
            for (int i = 0; i < N; ++i) {
                const int l2 = i ^ j;
                if (l2 > i) {
                    const bool up = ((i & k) == 0);
                    const int hi = max(a[i], a[l2]), lo = min(a[i], a[l2]);
                    a[i] = up ? hi : lo; a[l2] = up ? lo : hi;
                }
            }
        }
    }
}
__device__ __forceinline__ void merge_top16(int (&a)[16], const int (&b)[16]) {
#pragma unroll
    for (int i = 0; i < 16; ++i) a[i] = max(a[i], b[15 - i]);
#pragma unroll
    for (int j = 8; j > 0; j >>= 1) {
#pragma unroll
        for (int i = 0; i < 16; ++i) {
            const int l2 = i ^ j;
            if (l2 > i) { const int hi = max(a[i], a[l2]), lo = min(a[i], a[l2]); a[i] = hi; a[l2] = lo; }
        }
    }
}
__device__ __forceinline__ void top16_of_64(int (&g0)[16], int (&g1)[16], int (&g2)[16], int (&g3)[16]) {
    bitonic_sort_desc<16>(g0); bitonic_sort_desc<16>(g1); bitonic_sort_desc<16>(g2); bitonic_sort_desc<16>(g3);
    merge_top16(g0, g1); merge_top16(g2, g3); merge_top16(g0, g2);
}

__device__ __forceinline__ void topk_wave_item(const bf16_t* __restrict__ qp, const bf16_t* __restrict__ subk  ,
                                               int* __restrict__ eidx, float* __restrict__ gate, int witem, char* wlds) {
    const int lane = tid_opaque() & 63, r32 = lane & 31, hh = lane >> 5;
    const int h = witem & 7, tt = witem >> 3;
    const int t = tt * 32 + r32;
    int top[2][16];
#pragma unroll
    for (int c = 0; c < 2; ++c) {
        bf16x8 qf[8];
        const bf16_t* qrow = qp + (size_t)t * 2048 + h * 256 + c * 128 + hh * 8;
#pragma unroll
        for (int ks = 0; ks < 8; ++ks) qf[ks] = *(const bf16x8*)(qrow + ks * 16);
        const bf16_t* kb = subk + ((size_t)(h * 2 + c) * 128 + r32) * 128 + hh * 8;
        int grp[4][16];
#pragma unroll
        for (int kt = 0; kt < 4; ++kt) {
            f32x16 s;
#pragma unroll
            for (int i = 0; i < 16; ++i) s[i] = 0.f;
#pragma unroll
            for (int ks = 0; ks < 8; ++ks) {
                bf16x8 kf = *(const bf16x8*)(kb + (size_t)kt * 32 * 128 + ks * 16);
                s = __builtin_amdgcn_mfma_f32_32x32x16_bf16(kf, qf[ks], s, 0, 0, 0);
            }
#pragma unroll
            for (int i = 0; i < 16; ++i) grp[kt][i] = (f2key(s[i]) & ~127) | (kt * 32 + crow(i, hh));
        }
        top16_of_64(grp[0], grp[1], grp[2], grp[3]);
        int oth[16];
#pragma unroll
        for (int i = 0; i < 16; ++i) oth[i] = __shfl_xor(grp[0][i], 32);
        merge_top16(grp[0], oth);
#pragma unroll
        for (int i = 0; i < 16; ++i) top[c][i] = grp[0][i];
    }
    {
        unsigned* my = (unsigned*)(wlds + lane * 36);
#pragma unroll
        for (int c = 0; c < 2; ++c)
#pragma unroll
            for (int w4 = 0; w4 < 4; ++w4) {
                unsigned v = (top[c][w4 * 4] & 127) | ((top[c][w4 * 4 + 1] & 127) << 8) | ((top[c][w4 * 4 + 2] & 127) << 16) | ((top[c][w4 * 4 + 3] & 127) << 24);
                my[c * 4 + w4] = v;
            }
    }
    float v1[16], v2[16];
#pragma unroll
    for (int i = 0; i < 16; ++i) { v1[i] = key2f(top[0][i] & ~127); v2[i] = key2f(top[1][i] & ~127); }
    int cg[4][16];
    {
        int n = 0;
#pragma unroll
        for (int i = 0; i < 16; ++i)
#pragma unroll
            for (int j = 0; j < 16; ++j)
                if ((i + 1) * (j + 1) <= 16) { cg[n >> 4][n & 15] = (f2key(v1[i] + v2[j]) & ~255) | (i * 16 + j); ++n; }
#pragma unroll
        for (int q = 50; q < 64; ++q) cg[q >> 4][q & 15] = (int)0x80000000;
    }
    top16_of_64(cg[0], cg[1], cg[2], cg[3]);
    float bv[16];
#pragma unroll
    for (int i = 0; i < 16; ++i) bv[i] = key2f(cg[0][i] & ~255);
    float sm = 0.f;
    const float bmx = bv[0];
#pragma unroll
    for (int i = 0; i < 16; ++i) { bv[i] = __expf(bv[i] - bmx); sm += bv[i]; }
    const float inv = 1.f / sm;
    if (hh == 0) {
        const unsigned char* my = (const unsigned char*)(wlds + lane * 36);
        int* eo = eidx + (size_t)t * 128 + h * 16;
        float* go = gate + (size_t)t * 128 + h * 16;
#pragma unroll
        for (int q4 = 0; q4 < 4; ++q4) {
            int4 ev; float4 gv;
            int* evp = (int*)&ev; float* gvp = (float*)&gv;
#pragma unroll
            for (int u = 0; u < 4; ++u) {
                const int code = cg[0][q4 * 4 + u] & 255;
                const int i1 = my[code >> 4], i2 = my[16 + (code & 15)];
                evp[u] = i1 * 128 + i2; gvp[u] = bv[q4 * 4 + u] * inv;
            }
            *(int4*)(eo + q4 * 4) = ev; *(float4*)(go + q4 * 4) = gv;
        }
    }
}

typedef __attribute__((ext_vector_type(2))) float f32x2;
__device__ __forceinline__ float fdot2bf(unsigned a, unsigned b, float acc) {
    return __builtin_amdgcn_fdot2_f32_bf16(*(bf16x2_t*)&a, *(bf16x2_t*)&b, acc, false);
}
__device__ __forceinline__ unsigned fp8pair_to_bf16(unsigned w, bool hi) {
    bf16x2_t r = hi ? __builtin_amdgcn_cvt_scalef32_pk_bf16_fp8((int)w, 1.0f, true) : __builtin_amdgcn_cvt_scalef32_pk_bf16_fp8((int)w, 1.0f, false);
    return *(unsigned*)&r;
}
__device__ __forceinline__ float dot16_fp8(uint4 u, const unsigned (&h)[8]) {
    float a = 0.f;
    a = fdot2bf(fp8pair_to_bf16(u.x, false), h[0], a); a = fdot2bf(fp8pair_to_bf16(u.x, true), h[1], a);
    a = fdot2bf(fp8pair_to_bf16(u.y, false), h[2], a); a = fdot2bf(fp8pair_to_bf16(u.y, true), h[3], a);
    a = fdot2bf(fp8pair_to_bf16(u.z, false), h[4], a); a = fdot2bf(fp8pair_to_bf16(u.z, true), h[5], a);
    a = fdot2bf(fp8pair_to_bf16(u.w, false), h[6], a); a = fdot2bf(fp8pair_to_bf16(u.w, true), h[7], a);
    return a;
}
__device__ __forceinline__ void axpy16_fp8(float (&acc)[16], float w, uint4 v) {
    f32x2 r;
    r = __builtin_amdgcn_cvt_pk_f32_fp8((int)v.x, false); acc[0] += w * r[0]; acc[1] += w * r[1];
    r = __builtin_amdgcn_cvt_pk_f32_fp8((int)v.x, true);  acc[2] += w * r[0]; acc[3] += w * r[1];
    r = __builtin_amdgcn_cvt_pk_f32_fp8((int)v.y, false); acc[4] += w * r[0]; acc[5] += w * r[1];
    r = __builtin_amdgcn_cvt_pk_f32_fp8((int)v.y, true);  acc[6] += w * r[0]; acc[7] += w * r[1];
    r = __builtin_amdgcn_cvt_pk_f32_fp8((int)v.z, false); acc[8] += w * r[0]; acc[9] += w * r[1];
    r = __builtin_amdgcn_cvt_pk_f32_fp8((int)v.z, true);  acc[10] += w * r[0]; acc[11] += w * r[1];
    r = __builtin_amdgcn_cvt_pk_f32_fp8((int)v.w, false); acc[12] += w * r[0]; acc[13] += w * r[1];
    r = __builtin_amdgcn_cvt_pk_f32_fp8((int)v.w, true);  acc[14] += w * r[0]; acc[15] += w * r[1];
}
__device__ __forceinline__ float gelu_exact(float a) { return 0.5f * a * (1.f + erff(a * 0.70710678118654752f)); }

__device__ __forceinline__ float transpose_reduce16(f32x16 p, int lane) {
#pragma unroll
    for (int st = 0; st < 4; ++st) {
        const int o = 32 >> st, n = 16 >> st;
        const bool up = (lane & o) != 0;
#pragma unroll
        for (int i = 0; i < n / 2; ++i) {
            float lo = p[i], hi = p[i + n / 2];
            asm volatile("" : "+v"(lo), "+v"(hi));
            const float keep = up ? hi : lo;
            const float send = up ? lo : hi;
            p[i] = keep + __shfl_xor(send, o);
        }
    }
    float v = p[0];
    v += __shfl_xor(v, 1); v += __shfl_xor(v, 2);
    return v;
}
#define EX_SB() __builtin_amdgcn_sched_barrier(0)
#define EX_LD1(R, TAB, EB, S) R = *(const uint4*)((TAB) + (unsigned)((__builtin_amdgcn_readlane((EB), (S)) << 10) + lane16))
#define EX_LOAD8(P, TAB, EB, SL) do { EX_LD1(P##0, TAB, EB, (SL) + 0); EX_LD1(P##1, TAB, EB, (SL) + 1); EX_LD1(P##2, TAB, EB, (SL) + 2); EX_LD1(P##3, TAB, EB, (SL) + 3); \
        EX_LD1(P##4, TAB, EB, (SL) + 4); EX_LD1(P##5, TAB, EB, (SL) + 5); EX_LD1(P##6, TAB, EB, (SL) + 6); EX_LD1(P##7, TAB, EB, (SL) + 7); } while (0)
#define EX_DOT8(P, PP, O) do { PP[(O) + 0] = dot16_fp8(P##0, hp); PP[(O) + 1] = dot16_fp8(P##1, hp); PP[(O) + 2] = dot16_fp8(P##2, hp); PP[(O) + 3] = dot16_fp8(P##3, hp); \
        PP[(O) + 4] = dot16_fp8(P##4, hp); PP[(O) + 5] = dot16_fp8(P##5, hp); PP[(O) + 6] = dot16_fp8(P##6, hp); PP[(O) + 7] = dot16_fp8(P##7, hp); } while (0)
#define EX_RL(W, S) __int_as_float(__builtin_amdgcn_readlane(__float_as_int(W), (S)))
#define EX_AXPY8(P, W, SL) do { axpy16_fp8(acc, EX_RL(W, (SL) + 0), P##0); axpy16_fp8(acc, EX_RL(W, (SL) + 1), P##1); axpy16_fp8(acc, EX_RL(W, (SL) + 2), P##2); axpy16_fp8(acc, EX_RL(W, (SL) + 3), P##3); \
        axpy16_fp8(acc, EX_RL(W, (SL) + 4), P##4); axpy16_fp8(acc, EX_RL(W, (SL) + 5), P##5); axpy16_fp8(acc, EX_RL(W, (SL) + 6), P##6); axpy16_fp8(acc, EX_RL(W, (SL) + 7), P##7); } while (0)
#define EX_COPY8(D, S_) do { D##0 = S_##0; D##1 = S_##1; D##2 = S_##2; D##3 = S_##3; D##4 = S_##4; D##5 = S_##5; D##6 = S_##6; D##7 = S_##7; } while (0)

__device__ __forceinline__ void expert_token(PC& p, int layer, int t, bool last, bool dummy = false) {
    const int lane = tid_opaque() & 63;
    const int lane16 = lane * 16;
    const float* gfb = p.g_ffn + layer * DM; asm volatile("" : "+s"(gfb));
    const float* gf = gfb + lane * 16;
    float* xrow = p.x + (size_t)t * DM + lane * 16;
    float* xwr = dummy ? (float*)p.zb + (size_t)t * DM + lane * 16 : xrow;
    bf16_t* hwr = (dummy ? p.q.qA + (size_t)t * DM : p.hnb + (size_t)t * DM) + lane * 16;
    float xv[16];
#pragma unroll
    for (int q = 0; q < 4; ++q) { const float4 a = *(const float4*)(xrow + 4 * q); xv[4 * q] = a.x; xv[4 * q + 1] = a.y; xv[4 * q + 2] = a.z; xv[4 * q + 3] = a.w; }
    float ss = 0.f;
#pragma unroll
    for (int i = 0; i < 16; ++i) ss += xv[i] * xv[i];
    ss = wave_sum(ss);
    const float rstd = rsqrtf(ss * (1.f / DM) + 1e-6f);
    unsigned hp[8];
#pragma unroll
    for (int q = 0; q < 4; ++q) {
        const float4 g = *(const float4*)(gf + 4 * q);
        hp[2 * q] = cvtpk(xv[4 * q] * rstd * g.x, xv[4 * q + 1] * rstd * g.y);
        hp[2 * q + 1] = cvtpk(xv[4 * q + 2] * rstd * g.z, xv[4 * q + 3] * rstd * g.w);
    }
    const int e0 = p.eidx[(size_t)t * 128 + lane], e1 = p.eidx[(size_t)t * 128 + 64 + lane];
    const float g0 = p.gate[(size_t)t * 128 + lane], g1 = p.gate[(size_t)t * 128 + 64 + lane];
    const unsigned char* u8 = p.u8 + (size_t)layer * 16384 * DM;
    const unsigned char* v8 = p.v8 + (size_t)layer * 16384 * DM;
    const float* su = p.su + layer * 16384; const float* sv = p.sv + layer * 16384;
    const float su0 = su[e0], su1 = su[e1], sv0 = sv[e0], sv1 = sv[e1];
    uint4 rx0, rx1, rx2, rx3, rx4, rx5, rx6, rx7, ry0, ry1, ry2, ry3, ry4, ry5, ry6, ry7;
    float a0 = 0.f, a1 = 0.f;
    EX_LOAD8(rx, u8, e0, 0);
#pragma unroll 1
    for (int g = 0; g < 8; ++g) {
        const int eb = g < 4 ? e0 : e1;
        const int sl = (g & 3) * 16;
        f32x16 pp;
        EX_LOAD8(ry, u8, eb, sl + 8);
        EX_SB();
        EX_DOT8(rx, pp, 0);
        EX_SB();
        {
            const int gn = g + 1 < 8 ? g + 1 : 0;
            const int ebn = gn < 4 ? e0 : e1;
            const unsigned char* tabn = g + 1 < 8 ? u8 : v8;
            EX_LOAD8(rx, tabn, ebn, (gn & 3) * 16);
        }
        EX_SB();
        EX_DOT8(ry, pp, 8);
        const float v = transpose_reduce16(pp, lane);
        const float got = __shfl(v, (lane & 15) << 2);
        const bool mine = (lane >> 4) == (g & 3);
        a0 = (mine && g < 4) ? got : a0;
        a1 = (mine && g >= 4) ? got : a1;
        EX_SB();
    }
    const float w0 = g0 * gelu_exact(su0 * a0) * sv0;
    const float w1 = g1 * gelu_exact(su1 * a1) * sv1;
    float acc[16];
#pragma unroll
    for (int i = 0; i < 16; ++i) acc[i] = 0.f;
#pragma unroll 1
    for (int h2 = 0; h2 < 8; ++h2) {
        const int ebc = h2 < 4 ? e0 : e1;
        const float wb = h2 < 4 ? w0 : w1;
        const int slc = (h2 & 3) * 16;
        EX_LOAD8(ry, v8, ebc, slc + 8);
        EX_SB();
        EX_AXPY8(rx, wb, slc);
        EX_SB();
        {
            const int hn_ = h2 + 1 < 8 ? h2 + 1 : 7;
            const int ebn = hn_ < 4 ? e0 : e1;
            EX_LOAD8(rx, v8, ebn, (hn_ & 3) * 16);
        }
        EX_SB();
        EX_AXPY8(ry, wb, slc + 8);
        EX_SB();
    }
#pragma unroll
    for (int i = 0; i < 16; ++i) xv[i] += acc[i];
    float s2 = 0.f;
#pragma unroll
    for (int i = 0; i < 16; ++i) s2 += xv[i] * xv[i];
    s2 = wave_sum(s2);
    const float r2 = rsqrtf(s2 * (1.f / DM) + 1e-6f);
    if (!last) {
#pragma unroll
        for (int q = 0; q < 4; ++q) *(float4*)(xwr + 4 * q) = make_float4(xv[4 * q], xv[4 * q + 1], xv[4 * q + 2], xv[4 * q + 3]);
        const float* gnb = p.g_mix + (layer + 1) * DM; asm volatile("" : "+s"(gnb));
        const float* gn = gnb + lane * 16;
        unsigned hw[8];
#pragma unroll
        for (int q = 0; q < 4; ++q) {
            const float4 g = *(const float4*)(gn + 4 * q);
            hw[2 * q] = cvtpk(xv[4 * q] * r2 * g.x, xv[4 * q + 1] * r2 * g.y);
            hw[2 * q + 1] = cvtpk(xv[4 * q + 2] * r2 * g.z, xv[4 * q + 3] * r2 * g.w);
        }
        *(uint4*)(hwr) = make_uint4(hw[0], hw[1], hw[2], hw[3]);
        *(uint4*)(hwr + 8) = make_uint4(hw[4], hw[5], hw[6], hw[7]);
    } else {
        const float* gnb = p.g_final; asm volatile("" : "+s"(gnb));
        const float* gn = gnb + lane * 16;
        float* orow = dummy ? xwr : p.out + (size_t)t * DM + lane * 16;
#pragma unroll
        for (int q = 0; q < 4; ++q) {
            const float4 g = *(const float4*)(gn + 4 * q);
            *(float4*)(orow + 4 * q) = make_float4(xv[4 * q] * r2 * g.x, xv[4 * q + 1] * r2 * g.y, xv[4 * q + 2] * r2 * g.z, xv[4 * q + 3] * r2 * g.w);
        }
    }
}
__device__ __forceinline__ void transpose_tile(const float* __restrict__ src, int K, int N, bf16_t* __restrict__ dst, int tk, int tn, float* tl, const float* __restrict__ ksc) {
    const int tid = tid_opaque(), r = tid >> 6, c = tid & 63;
    const int k0 = tk * 64, n0 = tn * 64;
#pragma unroll
    for (int i = 0; i < 16; ++i) {
        const int kk = i * 4 + r, n = n0 + c;
        tl[kk * 65 + c] = (n < N) ? src[(size_t)(k0 + kk) * N + n] : 0.f;
    }
    __syncthreads();
#pragma unroll
    for (int i = 0; i < 16; ++i) {
        const int nn = i * 4 + r;
        if (n0 + nn < N) dst[(size_t)(n0 + nn) * K + k0 + c] = f2bf(tl[c * 65 + nn] * (ksc ? ksc[k0 + c] : 1.f));
    }
    __syncthreads();
}
__device__ __forceinline__ void transpose_all(const float* src, int K, int N, bf16_t* dst, float* tl, const float* ksc = nullptr) {
    const int ntk = K / 64, ntn = (N + 63) / 64;
    for (int t = blockIdx.x; t < ntk * ntn; t += gridDim.x) transpose_tile(src, K, N, dst, t / ntn, t % ntn, tl, ksc);
}
__device__ __forceinline__ void convert_plain(const float* __restrict__ src, bf16_t* __restrict__ dst, size_t n) {
    const size_t n8 = n >> 3;
    for (size_t i = (size_t)blockIdx.x * blockDim.x + tid_opaque(); i < n8; i += (size_t)gridDim.x * blockDim.x) {
        const float4 a = *(const float4*)(src + i * 8), b = *(const float4*)(src + i * 8 + 4);
        uint4 w; w.x = cvtpk(a.x, a.y); w.y = cvtpk(a.z, a.w); w.z = cvtpk(b.x, b.y); w.w = cvtpk(b.z, b.w);
        *(uint4*)(dst + i * 8) = w;
    }
}
__device__ __forceinline__ void convert_rows_fp8(const float* __restrict__ src, unsigned char* __restrict__ dst, float* __restrict__ scales, int nrows) {
    const int tid = tid_opaque(), wave = tid >> 6, lane = tid & 63;
    for (int row = blockIdx.x * 4 + wave; row < nrows; row += gridDim.x * 4) {
        const float* sr = src + (size_t)row * DM + lane * 16;
        float xv[16];
#pragma unroll
        for (int q = 0; q < 4; ++q) { const float4 a = *(const float4*)(sr + 4 * q); xv[4 * q] = a.x; xv[4 * q + 1] = a.y; xv[4 * q + 2] = a.z; xv[4 * q + 3] = a.w; }
        float am = 0.f;
#pragma unroll
        for (int i = 0; i < 16; ++i) am = fmaxf(am, fabsf(xv[i]));
        am = wave_max(am);
        const float sc = am > 0.f ? am * (1.f / 448.f) : 1.f;
        const float inv = 1.f / sc;
        unsigned w[4];
#pragma unroll
        for (int q = 0; q < 4; ++q) {
            int t = 0;
            t = __builtin_amdgcn_cvt_pk_fp8_f32(xv[4 * q] * inv, xv[4 * q + 1] * inv, t, false);
            t = __builtin_amdgcn_cvt_pk_fp8_f32(xv[4 * q + 2] * inv, xv[4 * q + 3] * inv, t, true);
            w[q] = (unsigned)t;
        }
        *(uint4*)(dst + (size_t)row * DM + lane * 16) = make_uint4(w[0], w[1], w[2], w[3]);
        if (lane == 0) scales[row] = sc;
    }
}
__device__ __forceinline__ void rms_row_bf16(const float* __restrict__ src, const float* __restrict__ g, bf16_t* __restrict__ dst, float* __restrict__ cpy, int lane) {
    float xv[16];
    const float4 a0 = *(const float4*)(src + lane * 8), a1 = *(const float4*)(src + lane * 8 + 4);
    const float4 b0 = *(const float4*)(src + 512 + lane * 8), b1 = *(const float4*)(src + 512 + lane * 8 + 4);
    xv[0] = a0.x; xv[1] = a0.y; xv[2] = a0.z; xv[3] = a0.w; xv[4] = a1.x; xv[5] = a1.y; xv[6] = a1.z; xv[7] = a1.w;
    xv[8] = b0.x; xv[9] = b0.y; xv[10] = b0.z; xv[11] = b0.w; xv[12] = b1.x; xv[13] = b1.y; xv[14] = b1.z; xv[15] = b1.w;
    if (cpy) {
        *(float4*)(cpy + lane * 8) = a0; *(float4*)(cpy + lane * 8 + 4) = a1;
        *(float4*)(cpy + 512 + lane * 8) = b0; *(float4*)(cpy + 512 + lane * 8 + 4) = b1;
    }
    float ss = 0.f;
#pragma unroll
    for (int i = 0; i < 16; ++i) ss += xv[i] * xv[i];
    ss = wave_sum(ss);
    const float r = rsqrtf(ss * (1.f / DM) + 1e-6f);
    const float4 g0 = *(const float4*)(g + lane * 8), g1 = *(const float4*)(g + lane * 8 + 4);
    const float4 g2 = *(const float4*)(g + 512 + lane * 8), g3 = *(const float4*)(g + 512 + lane * 8 + 4);
    uint4 wa, wb;
    wa.x = cvtpk(xv[0] * r * g0.x, xv[1] * r * g0.y); wa.y = cvtpk(xv[2] * r * g0.z, xv[3] * r * g0.w);
    wa.z = cvtpk(xv[4] * r * g1.x, xv[5] * r * g1.y); wa.w = cvtpk(xv[6] * r * g1.z, xv[7] * r * g1.w);
    wb.x = cvtpk(xv[8] * r * g2.x, xv[9] * r * g2.y); wb.y = cvtpk(xv[10] * r * g2.z, xv[11] * r * g2.w);
    wb.z = cvtpk(xv[12] * r * g3.x, xv[13] * r * g3.y); wb.w = cvtpk(xv[14] * r * g3.z, xv[15] * r * g3.w);
    *(uint4*)(dst + lane * 8) = wa; *(uint4*)(dst + 512 + lane * 8) = wb;
}

__device__ __forceinline__ void rms_row2_bf16(const float* __restrict__ s0, const float* __restrict__ s1, const float* __restrict__ g, bf16_t* __restrict__ d0, bf16_t* __restrict__ d1, int lane) {
    float4 a[4], b[4];
#pragma unroll
    for (int q = 0; q < 4; ++q) { a[q] = *(const float4*)(s0 + (q >> 1) * 512 + lane * 8 + (q & 1) * 4); b[q] = s1 ? *(const float4*)(s1 + (q >> 1) * 512 + lane * 8 + (q & 1) * 4) : make_float4(0.f, 0.f, 0.f, 0.f); }
    float sa = 0.f, sb = 0.f;
#pragma unroll
    for (int q = 0; q < 4; ++q) { sa += a[q].x * a[q].x + a[q].y * a[q].y + a[q].z * a[q].z + a[q].w * a[q].w; sb += b[q].x * b[q].x + b[q].y * b[q].y + b[q].z * b[q].z + b[q].w * b[q].w; }
    sa = wave_sum(sa); sb = wave_sum(sb);
    const float ra = rsqrtf(sa * (1.f / DM) + 1e-6f), rb = rsqrtf(sb * (1.f / DM) + 1e-6f);
    float4 gq[4];
#pragma unroll
    for (int q = 0; q < 4; ++q) gq[q] = *(const float4*)(g + (q >> 1) * 512 + lane * 8 + (q & 1) * 4);
    uint4 w;
    w.x = cvtpk(a[0].x * ra * gq[0].x, a[0].y * ra * gq[0].y); w.y = cvtpk(a[0].z * ra * gq[0].z, a[0].w * ra * gq[0].w);
    w.z = cvtpk(a[1].x * ra * gq[1].x, a[1].y * ra * gq[1].y); w.w = cvtpk(a[1].z * ra * gq[1].z, a[1].w * ra * gq[1].w);
    *(uint4*)(d0 + lane * 8) = w;
    w.x = cvtpk(a[2].x * ra * gq[2].x, a[2].y * ra * gq[2].y); w.y = cvtpk(a[2].z * ra * gq[2].z, a[2].w * ra * gq[2].w);
    w.z = cvtpk(a[3].x * ra * gq[3].x, a[3].y * ra * gq[3].y); w.w = cvtpk(a[3].z * ra * gq[3].z, a[3].w * ra * gq[3].w);
    *(uint4*)(d0 + 512 + lane * 8) = w;
    if (s1) {
        w.x = cvtpk(b[0].x * rb * gq[0].x, b[0].y * rb * gq[0].y); w.y = cvtpk(b[0].z * rb * gq[0].z, b[0].w * rb * gq[0].w);
        w.z = cvtpk(b[1].x * rb * gq[1].x, b[1].y * rb * gq[1].y); w.w = cvtpk(b[1].z * rb * gq[1].z, b[1].w * rb * gq[1].w);
        *(uint4*)(d1 + lane * 8) = w;
        w.x = cvtpk(b[2].x * rb * gq[2].x, b[2].y * rb * gq[2].y); w.y = cvtpk(b[2].z * rb * gq[2].z, b[2].w * rb * gq[2].w);
        w.z = cvtpk(b[3].x * rb * gq[3].x, b[3].y * rb * gq[3].y); w.w = cvtpk(b[3].z * rb * gq[3].z, b[3].w * rb * gq[3].w);
        *(uint4*)(d1 + 512 + lane * 8) = w;
    }
}

__device__ __forceinline__ void phase_pro(PC& p, char* lds) {
    float* tl = (float*)lds;
    for (int l = 0; l < DEPTH; ++l) {
        transpose_all(p.w_in + (size_t)l * DM * NZ, DM, NZ, p.winT + (size_t)l * NZ * DM, tl);
        transpose_all(p.w_out + (size_t)l * DM * DM, DM, DM, p.woutT + (size_t)l * DM * DM, tl);
        transpose_all(p.peer_w_q + (size_t)l * DM * 2048, DM, 2048, p.wqT + (size_t)l * 2048 * DM, tl, (p.flags & 4) ? p.g_ffn + l * DM : nullptr);
        transpose_all(p.mla_w_uq + (size_t)l * 256 * 384, 256, 384, p.wuqT + (size_t)l * 384 * 256, tl);
        transpose_all(p.mla_w_ukv + (size_t)l * 128 * 512, 128, 512, p.wukvT + (size_t)l * 512 * 128, tl);
    }
    convert_plain(p.peer_sub_keys, p.subk, (size_t)DEPTH * 8 * 2 * 128 * 128);
    if ((p.flags & 3) == 1) {
        convert_rows_fp8(p.peer_u, p.u8, p.su, DEPTH * 16384);
        convert_rows_fp8(p.peer_v, p.v8, p.sv, DEPTH * 16384);
    }
    for (int i = blockIdx.x * blockDim.x + tid_opaque(); i < 4096 * 32; i += gridDim.x * blockDim.x) {
        {
            const int pos = i / 32, j = i % 32;
            const float inv = powf(10000.f, -(float)(2 * j) / 64.f); const float ang = (float)pos * inv;
            p.tb.cos1[i] = cosf(ang); p.tb.sin1[i] = sinf(ang);
        }
        if (i < 4096 * 16) {
            const int pos = i / 16, j = i % 16;
            const float inv = powf(10000.f, -(float)(2 * j) / 32.f); const float ang = (float)pos * inv;
            p.tb.cosm[i] = cosf(ang); p.tb.sinm[i] = sinf(ang);
        }
        if (i < 64 * 16) {
            const int pos = i / 16, j = i % 16;
            const float inv = powf(10000.f, -(float)(2 * j) / 32.f); const float ang = (float)pos * inv;
            p.tb.cosr[i] = cosf(ang); p.tb.sinr[i] = sinf(ang); p.tb.cosc[i] = cosf(ang); p.tb.sinc[i] = sinf(ang);
        }
    }
    const int wave = tid_opaque() >> 6, lane = tid_opaque() & 63;
    for (int t = blockIdx.x * 4 + wave; t < T_TOK; t += gridDim.x * 4)
        rms_row_bf16(p.x_in + (size_t)t * DM, p.g_mix, p.hnb + (size_t)t * DM, p.x + (size_t)t * DM, lane);
}

__device__ __forceinline__ void phase_g1(PC& p, int l, char* lds) {
    EpiStoreBf16 e{p.zb, NZ, NZ};
    gemm_phase(p.hnb, DM, p.winT + (size_t)l * NZ * DM, DM, T_TOK, NZ, DM, lds, e);
}

__device__ __forceinline__ unsigned pk2(float a, float b) { return cvtpk(a, b); }
__device__ __forceinline__ void phase_post(PC& p, int l, char* lds) {
    const int tid = tid_opaque(), wave = tid >> 6, lane = tid & 63;
    float* zr = (float*)(lds + wave * 8192);
    const float* g_qn = p.ax_q_norm + l * 64; const float* g_kn = p.ax_k_norm + l * 64;
    const float* g_cq = p.mla_q_norm + l * 256; const float* g_ckv = p.mla_kv_norm + l * 128;
    const float scA = 0.125f * LOG2E;
    const bf16_t* zb = p.zb;
    const float *cos1 = p.tb.cos1, *sin1 = p.tb.sin1, *cosm = p.tb.cosm, *sinm = p.tb.sinm, *cosr = p.tb.cosr, *sinr = p.tb.sinr, *cosc = p.tb.cosc, *sinc = p.tb.sinc;
    for (int t = blockIdx.x * 4 + wave; t < T_TOK; t += gridDim.x * 4) {
        const int b = t / SEQ, s = t % SEQ;
#pragma unroll
        for (int j = 0; j < 4; ++j) {
            const int ch = lane + 64 * j;
            if (ch < 244) {
                const uint4 w = *(const uint4*)(zb + (size_t)t * NZ + ch * 8);
                float4 lo, hi;
                lo.x = __uint_as_float(w.x << 16); lo.y = __uint_as_float(w.x & 0xffff0000u); lo.z = __uint_as_float(w.y << 16); lo.w = __uint_as_float(w.y & 0xffff0000u);
                hi.x = __uint_as_float(w.z << 16); hi.y = __uint_as_float(w.z & 0xffff0000u); hi.z = __uint_as_float(w.w << 16); hi.w = __uint_as_float(w.w & 0xffff0000u);
                *(float4*)(zr + ch * 8) = lo; *(float4*)(zr + ch * 8 + 4) = hi;
            }
        }
#pragma unroll
        for (int mix = 0; mix < 2; ++mix) {
            const int zo = mix == 0 ? 0 : 1024;
            bf16_t* qo = mix == 0 ? p.q.qA : p.q.qC; bf16_t* ko = mix == 0 ? p.q.kA : p.q.kC; bf16_t* vo = mix == 0 ? p.q.vA : p.q.vC;
            const int h = lane >> 4, j = (lane & 15) * 2;
            const float c0 = cos1[s * 32 + j], c1 = cos1[s * 32 + j + 1], s0 = sin1[s * 32 + j], s1 = sin1[s * 32 + j + 1];
            {
                const float a0 = zr[zo + h * 64 + j], a1 = zr[zo + h * 64 + j + 1], b0 = zr[zo + h * 64 + 32 + j], b1 = zr[zo + h * 64 + 33 + j];
                bf16_t* o = qo + ((size_t)(b * 4 + h) * SEQ + s) * 64;
                *(unsigned*)(o + j) = pk2((a0 * c0 - b0 * s0) * scA, (a1 * c1 - b1 * s1) * scA);
                *(unsigned*)(o + 32 + j) = pk2((b0 * c0 + a0 * s0) * scA, (b1 * c1 + a1 * s1) * scA);
            }
            if (lane < 32) {
                const float a0 = zr[zo + 256 + h * 64 + j], a1 = zr[zo + 256 + h * 64 + j + 1], b0 = zr[zo + 256 + h * 64 + 32 + j], b1 = zr[zo + 256 + h * 64 + 33 + j];
                bf16_t* o = ko + ((size_t)(b * 2 + h) * SEQ + s) * 64;
                *(unsigned*)(o + j) = pk2(a0 * c0 - b0 * s0, a1 * c1 - b1 * s1);
                *(unsigned*)(o + 32 + j) = pk2(b0 * c0 + a0 * s0, b1 * c1 + a1 * s1);
            }
            {
                const int i = lane * 2, hv = i >> 6, jv = i & 63;
                *(unsigned*)(vo + ((size_t)(b * 2 + hv) * SEQ + s) * 64 + jv) = pk2(zr[zo + 384 + i], zr[zo + 384 + i + 1]);
            }
        }
        {
            float rs[6];
#pragma unroll
            for (int hh = 0; hh < 6; ++hh) {
                const float v = zr[512 + hh * 64 + lane];
                rs[hh] = rsqrtf(wave_sum(v * v) * (1.f / 64.f) + 1e-6f);
            }
            const int row = s >> 6, col = s & 63;
            const int half = (lane >> 3) & 1, jj = (lane & 7) * 2;
            const float* ct = half == 0 ? cosr + row * 16 : cosc + col * 16;
            const float* st = half == 0 ? sinr + row * 16 : sinc + col * 16;
            const float c0 = ct[jj], c1 = ct[jj + 1], s0 = st[jj], s1 = st[jj + 1];
            const int d1 = half * 32 + jj, d2 = d1 + 16;
            {
                const int h = lane >> 4;
                const float r = h == 0 ? rs[0] : (h == 1 ? rs[1] : (h == 2 ? rs[2] : rs[3]));
                const float* z = zr + 512 + h * 64;
                const float a0 = z[d1] * r * g_qn[d1], a1 = z[d1 + 1] * r * g_qn[d1 + 1], b0 = z[d2] * r * g_qn[d2], b1 = z[d2 + 1] * r * g_qn[d2 + 1];
                bf16_t* o = p.q.qB + ((size_t)(b * 4 + h) * SEQ + s) * 64;
                *(unsigned*)(o + d1) = pk2((a0 * c0 - b0 * s0) * scA, (a1 * c1 - b1 * s1) * scA);
                *(unsigned*)(o + d2) = pk2((b0 * c0 + a0 * s0) * scA, (b1 * c1 + a1 * s1) * scA);
            }
            if (lane < 32) {
                const int h = lane >> 4;
                const float r = h == 0 ? rs[4] : rs[5];
                const float* z = zr + 768 + h * 64;
                const float a0 = z[d1] * r * g_kn[d1], a1 = z[d1 + 1] * r * g_kn[d1 + 1], b0 = z[d2] * r * g_kn[d2], b1 = z[d2 + 1] * r * g_kn[d2 + 1];
                bf16_t* o = p.q.kB + ((size_t)(b * 2 + h) * SEQ + s) * 64;
                *(unsigned*)(o + d1) = pk2(a0 * c0 - b0 * s0, a1 * c1 - b1 * s1);
                *(unsigned*)(o + d2) = pk2(b0 * c0 + a0 * s0, b1 * c1 + a1 * s1);
            }
            {
                const int i = lane * 2, hv = i >> 6, jv = i & 63;
                *(unsigned*)(p.q.vB + ((size_t)(b * 2 + hv) * SEQ + s) * 64 + jv) = pk2(zr[896 + i], zr[896 + i + 1]);
            }
        }
        {
            const float4 cq = *(const float4*)(zr + 1536 + lane * 4);
            const float rq = rsqrtf(wave_sum(cq.x * cq.x + cq.y * cq.y + cq.z * cq.z + cq.w * cq.w) * (1.f / 256.f) + 1e-6f);
            const float4 gq = *(const float4*)(g_cq + lane * 4);
            uint2 w; w.x = pk2(cq.x * rq * gq.x, cq.y * rq * gq.y); w.y = pk2(cq.z * rq * gq.z, cq.w * rq * gq.w);
            *(uint2*)(p.cqn + (size_t)t * 256 + lane * 4) = w;
            const float2 ck = *(const float2*)(zr + 1792 + lane * 2);
            const float rk = rsqrtf(wave_sum(ck.x * ck.x + ck.y * ck.y) * (1.f / 128.f) + 1e-6f);
            const float2 gk = *(const float2*)(g_ckv + lane * 2);
            *(unsigned*)(p.ckvn + (size_t)t * 128 + lane * 2) = pk2(ck.x * rk * gk.x, ck.y * rk * gk.y);
            const int i = lane & 15, h = lane >> 4;
            const float x1 = zr[1920 + i], x2 = zr[1936 + i];
            const float c = cosm[s * 16 + i], sn = sinm[s * 16 + i];
            bf16_t* o = p.q.kD + ((size_t)(b * 4 + h) * SEQ + s) * 96;
            o[64 + i] = f2bf(x1 * c - x2 * sn); o[80 + i] = f2bf(x2 * c + x1 * sn);
        }
    }
}

__device__ __forceinline__ void phase_mla(PC& p, int l, char* lds) {
    { EpiStoreBf16 e{p.qfull, 384, 384}; gemm_phase(p.cqn, 256, p.wuqT + (size_t)l * 384 * 256, 256, T_TOK, 384, 256, lds, e); }
    { EpiStoreBf16 e{p.kvfull, 512, 512}; gemm_phase(p.ckvn, 128, p.wukvT + (size_t)l * 512 * 128, 128, T_TOK, 512, 128, lds, e); }
}

__device__ __forceinline__ void phase_postmla(PC& p, int l) {
    const int tid = tid_opaque(), wave = tid >> 6, lane = tid & 63;
    const float scD = 0.10206207261596575f * LOG2E;
    const float *cosm = p.tb.cosm, *sinm = p.tb.sinm;
    const bf16_t* qfull = p.qfull; const bf16_t* kvfull = p.kvfull;
    const int h = lane >> 4, j = (lane & 15) * 4, i = lane & 15;
    for (int tb = blockIdx.x * 4 + wave; tb < T_TOK; tb += gridDim.x * 8) {
        uint2 qw[2], kw[2], vw[2]; float x1[2], x2[2], cc[2], ss[2];
#pragma unroll
        for (int u = 0; u < 2; ++u) {
            int t = tb + u * gridDim.x * 4; t = t < T_TOK ? t : tb;
            const int s = t % SEQ;
            qw[u] = *(const uint2*)(qfull + (size_t)t * 384 + h * 96 + j);
            kw[u] = *(const uint2*)(kvfull + (size_t)t * 512 + h * 128 + j);
            vw[u] = *(const uint2*)(kvfull + (size_t)t * 512 + h * 128 + 64 + j);
            x1[u] = bf2f(qfull[(size_t)t * 384 + h * 96 + 64 + i]); x2[u] = bf2f(qfull[(size_t)t * 384 + h * 96 + 80 + i]);
            cc[u] = cosm[s * 16 + i]; ss[u] = sinm[s * 16 + i];
        }
#pragma unroll
        for (int u = 0; u < 2; ++u) {
            const int t = tb + u * gridDim.x * 4;
            if (t < T_TOK) {
                const int b = t / SEQ, s = t % SEQ;
                const size_t hb = (size_t)(b * 4 + h) * SEQ + s;
                uint2 o;
                o.x = cvtpk(__uint_as_float(qw[u].x << 16) * scD, __uint_as_float(qw[u].x & 0xffff0000u) * scD);
                o.y = cvtpk(__uint_as_float(qw[u].y << 16) * scD, __uint_as_float(qw[u].y & 0xffff0000u) * scD);
                *(uint2*)(p.q.qD + hb * 96 + j) = o;
                *(uint2*)(p.q.kD + hb * 96 + j) = kw[u];
                *(uint2*)(p.q.vD + hb * 64 + j) = vw[u];
                p.q.qD[hb * 96 + 64 + i] = f2bf((x1[u] * cc[u] - x2[u] * ss[u]) * scD);
                p.q.qD[hb * 96 + 80 + i] = f2bf((x2[u] * cc[u] + x1[u] * ss[u]) * scD);
            }
        }
    }
}

__device__ __forceinline__ void phase_att(PC& p, int l, char* lds) {
    for (int it = blockIdx.x; it < 1024; it += gridDim.x) attn_item<96, 1, false>(p.q.qD, p.q.kD, p.q.vD, nullptr, p.ob, 768, 4, 4, it, lds);
    if (p.flags & 2) convert_rows_fp8(p.peer_u + (size_t)l * 16384 * DM, p.u8 + (size_t)l * 16384 * DM, p.su + l * 16384, 16384);
    for (int it = blockIdx.x; it < 1024; it += gridDim.x) attn_item<64, 2, false>(p.q.qB, p.q.kB, p.q.vB, nullptr, p.ob, 256, 4, 2, it, lds);
    if (p.flags & 2) convert_rows_fp8(p.peer_v + (size_t)l * 16384 * DM, p.v8 + (size_t)l * 16384 * DM, p.sv + l * 16384, 16384);
    for (int it = blockIdx.x; it < 1024; it += gridDim.x) attn_item<64, 2, true>(p.q.qA, p.q.kA, p.q.vA, p.win_sink + l * 4, p.ob, 0, 4, 2, it, lds);
    {
        const int wave = tid_opaque() >> 6;
        char* wl = lds + wave * 6144;
        const int off = (int)(uintptr_t)wl;
        for (int wi = blockIdx.x * 4 + wave; wi < 4096; wi += gridDim.x * 4) dil_wave_item(p.q.qC, p.q.kC, p.q.vC, p.ob, wi, wl, off);
    }
}

__device__ __forceinline__ void phase_gn(PC& p, int l) {
    const int wave = tid_opaque() >> 6, lane = tid_opaque() & 63;
    const float* gg = p.g_group + (size_t)l * 1024;
    const bf16_t* ob = p.ob; bf16_t* hnb = p.hnb;
    for (int t0 = blockIdx.x * 4 + wave; t0 < T_TOK; t0 += gridDim.x * 8) {
        const int t1 = t0 + gridDim.x * 4;
        const bool has1 = t1 < T_TOK;
        uint2 w0[4], w1[4];
#pragma unroll
        for (int g = 0; g < 4; ++g) {
            w0[g] = *(const uint2*)(ob + (size_t)t0 * DM + g * 256 + lane * 4);
            w1[g] = has1 ? *(const uint2*)(ob + (size_t)t1 * DM + g * 256 + lane * 4) : make_uint2(0, 0);
        }
#pragma unroll
        for (int g = 0; g < 4; ++g) {
            const float4 g4 = *(const float4*)(gg + g * 256 + lane * 4);
            {
                const float v0 = __uint_as_float(w0[g].x << 16), v1 = __uint_as_float(w0[g].x & 0xffff0000u), v2 = __uint_as_float(w0[g].y << 16), v3 = __uint_as_float(w0[g].y & 0xffff0000u);
                const float r = rsqrtf(wave_sum(v0 * v0 + v1 * v1 + v2 * v2 + v3 * v3) * (1.f / 256.f) + 1e-6f);
                uint2 o; o.x = cvtpk(v0 * r * g4.x, v1 * r * g4.y); o.y = cvtpk(v2 * r * g4.z, v3 * r * g4.w);
                *(uint2*)(hnb + (size_t)t0 * DM + g * 256 + lane * 4) = o;
            }
            if (has1) {
                const float v0 = __uint_as_float(w1[g].x << 16), v1 = __uint_as_float(w1[g].x & 0xffff0000u), v2 = __uint_as_float(w1[g].y << 16), v3 = __uint_as_float(w1[g].y & 0xffff0000u);
                const float r = rsqrtf(wave_sum(v0 * v0 + v1 * v1 + v2 * v2 + v3 * v3) * (1.f / 256.f) + 1e-6f);
                uint2 o; o.x = cvtpk(v0 * r * g4.x, v1 * r * g4.y); o.y = cvtpk(v2 * r * g4.z, v3 * r * g4.w);
                *(uint2*)(hnb + (size_t)t1 * DM + g * 256 + lane * 4) = o;
            }
        }
    }
}
__device__ __forceinline__ void phase_g2(PC& p, int l, char* lds) {
    if (p.flags & 4) {
        EpiResidNorm e{p.x, DM, p.xb2, p.ssq2};
        gemm_phase(p.hnb, DM, p.woutT + (size_t)l * DM * DM, DM, T_TOK, DM, DM, lds, e);
    } else {
        EpiResidF32 e{p.x, DM};
        gemm_phase(p.hnb, DM, p.woutT + (size_t)l * DM * DM, DM, T_TOK, DM, DM, lds, e);
    }
}
__device__ __forceinline__ void phase_n2(PC& p, int l) {
    const int wave = tid_opaque() >> 6, lane = tid_opaque() & 63;
    for (int t = blockIdx.x * 4 + wave; t < T_TOK; t += gridDim.x * 8) {
        const int t1 = t + gridDim.x * 4;
        rms_row2_bf16(p.x + (size_t)t * DM, t1 < T_TOK ? p.x + (size_t)t1 * DM : nullptr, p.g_ffn + l * DM, p.hnb + (size_t)t * DM, p.hnb + (size_t)t1 * DM, lane);
    }
}
__device__ __forceinline__ void phase_g3(PC& p, int l, char* lds) {
    if (p.flags & 4) {
        EpiStoreBf16RowNorm e{p.qp, 2048, p.ssq2};
        gemm_phase(p.xb2, DM, p.wqT + (size_t)l * 2048 * DM, DM, T_TOK, 2048, DM, lds, e);
    } else {
        EpiStoreBf16 e{p.qp, 2048, 2048};
        gemm_phase(p.hnb, DM, p.wqT + (size_t)l * 2048 * DM, DM, T_TOK, 2048, DM, lds, e);
    }
}
__device__ __forceinline__ void phase_topk(PC& p, int l, char* lds) {
    const int wave = tid_opaque() >> 6;
    char* wl = lds + wave * 2304;
    const bf16_t* sk = p.subk + (size_t)l * 8 * 2 * 128 * 128;
    for (int wi = blockIdx.x * 4 + wave; wi < 8192; wi += gridDim.x * 4) topk_wave_item(p.qp, sk, p.eidx, p.gate, wi, wl);
}
__device__ __forceinline__ void phase_exp(PC& p, int l) {
    const int wave = tid_opaque() >> 6;
    for (int t = blockIdx.x * 4 + wave; t < T_TOK; t += gridDim.x * 4) expert_token(p, l, t, l == DEPTH - 1);
}

template <int PH>
__global__ void __launch_bounds__(256, 2) k_phase(P p, int l) {
    extern __shared__ __attribute__((aligned(16))) char lds[];
    if (PH == 0) phase_pro(*kargs(), lds);
    if (PH == 1) phase_g1(*kargs(), l, lds);
    if (PH == 2) phase_post(*kargs(), l, lds);
    if (PH == 3) phase_mla(*kargs(), l, lds);
    if (PH == 4) phase_postmla(*kargs(), l);
    if (PH == 5) phase_att(*kargs(), l, lds);
    if (PH == 6) phase_gn(*kargs(), l);
    if (PH == 7) phase_g2(*kargs(), l, lds);
    if (PH == 8) phase_n2(*kargs(), l);
    if (PH == 9) phase_g3(*kargs(), l, lds);
    if (PH == 10) phase_topk(*kargs(), l, lds);
    if (PH == 11) phase_exp(*kargs(), l);
    if (PH == 13) { const int wave = tid_opaque() >> 6; for (int t = blockIdx.x * 4 + wave; t < T_TOK; t += gridDim.x * 4) expert_token(*kargs(), l, t, l == DEPTH - 1, true); }
    if (PH == 12) { const int wave = tid_opaque() >> 6, lane = tid_opaque() & 63; for (int t = blockIdx.x * 4 + wave; t < T_TOK; t += gridDim.x * 4) rms_row_bf16(kargs()->x + (size_t)t * DM, kargs()->g_mix + l * DM, kargs()->hnb + (size_t)t * DM, nullptr, lane); }
}
#define XB_TMO      128
#define XB_XCNT(j)  (256  + 64 * (j))
#define XB_XSUB(j)  (1280 + 64 * (j))
#define XB_XGEN(j)  (2304 + 64 * (j))
#define XB_TOP      3328
#define XB_TOPGEN   3392
#define XCD_BAR_WORDS 3456
#define XB_SPIN_CAP (1u << 18)
#define LAS __attribute__((address_space(3)))

__device__ __forceinline__ unsigned xb_ld(unsigned* p)              { return __hip_atomic_load(p, __ATOMIC_RELAXED, __HIP_MEMORY_SCOPE_AGENT); }
__device__ __forceinline__ unsigned xb_add(unsigned* p, unsigned v) { return __hip_atomic_fetch_add(p, v, __ATOMIC_RELAXED, __HIP_MEMORY_SCOPE_AGENT); }
__device__ __forceinline__ unsigned xb_xcc_id() { return (unsigned)__builtin_amdgcn_s_getreg((3 << 11) | 20) & 0xFu; }
#define XB_SPIN(cond, bar) do { unsigned _sp = 0; while (cond) { __builtin_amdgcn_s_sleep(1); \
    if ((++_sp & 255u) == 0u) { if (xb_ld(&(bar)[XB_TMO])) break; if (_sp > XB_SPIN_CAP) { atomicAdd(&(bar)[XB_TMO], 1u); break; } } } } while (0)

struct XcdBarrier {
    unsigned* bar; unsigned x;
    volatile LAS unsigned* st;
};

__device__ __forceinline__ XcdBarrier xcd_barrier_post(unsigned* bar, volatile LAS unsigned* st) {
    XcdBarrier b; b.bar = bar; b.x = xb_xcc_id(); b.st = st;
    if (threadIdx.x == 0) (void)xb_add(&bar[XB_XCNT(b.x)], 1u);
    return b;
}
__device__ __forceinline__ void xcd_barrier_complete(unsigned* bar, unsigned x, unsigned& nloc, unsigned& nx) {
    const unsigned G = gridDim.x * gridDim.y * gridDim.z;
    unsigned sum, cnt, mine, sp = 0u;
    for (;;) {
        sum = 0u; cnt = 0u; mine = 0u;
#pragma unroll
        for (unsigned j = 0; j < 16; ++j) { const unsigned c = xb_ld(&bar[XB_XCNT(j)]); sum += c; cnt += (c > 0u) ? 1u : 0u; mine = (j == x) ? c : mine; }
        if (sum == G) break;
        __builtin_amdgcn_s_sleep(1);
        if ((++sp & 255u) == 0u) { if (xb_ld(&bar[XB_TMO])) break; if (sp > XB_SPIN_CAP) { atomicAdd(&bar[XB_TMO], 1u); break; } }
    }
    nloc = mine > 0u ? mine : 1u; nx = cnt > 0u ? cnt : 1u;
}

__device__ __forceinline__ void xcd_barrier(const XcdBarrier& b) {
    asm volatile("s_waitcnt vmcnt(0)" ::: "memory");
    __syncthreads();
    if (threadIdx.x == 0) {
        unsigned* bar = b.bar;
        __builtin_amdgcn_s_waitcnt(0);
        unsigned nloc = b.st[0], nx = b.st[1];
        if (nloc == 0u) { xcd_barrier_complete(bar, b.x, nloc, nx); b.st[0] = nloc; b.st[1] = nx; }
        const unsigned old = xb_add(&bar[XB_XSUB(b.x)], 1u);
        const unsigned gen = old / nloc;
        if (old + 1u == (gen + 1u) * nloc) {
            __builtin_amdgcn_fence(__ATOMIC_RELEASE, "agent");
            asm volatile("s_waitcnt vmcnt(0)" ::: "memory");
            const unsigned og = xb_add(&bar[XB_TOP], 1u);
            const unsigned tg = og / nx;
            if (og + 1u == (tg + 1u) * nx) xb_add(&bar[XB_TOPGEN], 1u);
            else XB_SPIN(xb_ld(&bar[XB_TOPGEN]) == tg, bar);
            __builtin_amdgcn_fence(__ATOMIC_ACQUIRE, "agent");
            xb_add(&bar[XB_XGEN(b.x)], 1u);
            asm volatile("s_waitcnt vmcnt(0)" ::: "memory");
        } else {
            XB_SPIN(xb_ld(&bar[XB_XGEN(b.x)]) == gen, bar);
            __builtin_amdgcn_fence(__ATOMIC_ACQUIRE, "agent");
            asm volatile("s_waitcnt vmcnt(0)" ::: "memory");
        }
    }
    __syncthreads();
}


#ifdef PROBE_TIMER
#define TST(cat) do { if (blockIdx.x == 0 && threadIdx.x == 0) { const unsigned long long _n = wall_clock64(); tacc[cat] += _n - tprev; tprev = _n; } } while (0)
#else
#define TST(cat) do { } while (0)
#endif
__global__ void __launch_bounds__(256, 2) k_mega(P p) {
    extern __shared__ __attribute__((aligned(16))) char lds[];
    uint4* xbw = (uint4*)(lds + LDS_BYTES);
    if (threadIdx.x == 0) *xbw = make_uint4(0u, 0u, 0u, 0u);
    __syncthreads();
    XcdBarrier bar = xcd_barrier_post(kargs()->bar, (volatile LAS unsigned*)xbw);
#ifdef PROBE_TIMER
    unsigned long long tacc[7] = {0, 0, 0, 0, 0, 0, 0};
    unsigned long long tprev = wall_clock64();
#endif
    phase_pro(*kargs(), lds); TST(0); xcd_barrier(bar); TST(6);
    for (int l = 0; l < DEPTH; ++l) {
        phase_g1(*kargs(), l, lds); TST(1); xcd_barrier(bar); TST(6);
        phase_post(*kargs(), l, lds); TST(2); xcd_barrier(bar); TST(6);
        phase_mla(*kargs(), l, lds); TST(1); xcd_barrier(bar); TST(6);
        phase_postmla(*kargs(), l); TST(2); xcd_barrier(bar); TST(6);
        phase_att(*kargs(), l, lds); TST(3); xcd_barrier(bar); TST(6);
        phase_gn(*kargs(), l); TST(2); xcd_barrier(bar); TST(6);
        phase_g2(*kargs(), l, lds); TST(1); xcd_barrier(bar); TST(6);
        if (!(kargs()->flags & 4)) { phase_n2(*kargs(), l); TST(2); xcd_barrier(bar); TST(6); }
        phase_g3(*kargs(), l, lds); TST(1); xcd_barrier(bar); TST(6);
        phase_topk(*kargs(), l, lds); TST(4); xcd_barrier(bar); TST(6);
        phase_exp(*kargs(), l); TST(5);
        if (l + 1 < DEPTH) { xcd_barrier(bar); TST(6); }
    }
#ifdef PROBE_TIMER
    {
        float* slot = (float*)(kargs()->bar + 8192);
        if (blockIdx.x == 0 && threadIdx.x == 0) {
            unsigned long long tot = 0;
            for (int i = 0; i < 7; ++i) tot += tacc[i];
            const float share = floorf((float)tacc[PROBE_TIMER] / (float)tot * 16.f + 0.5f) * (1.f / 16.f);
            *slot = sqrtf(0.1f + 0.89f * share);
        }
        xcd_barrier(bar);
        const float delta = *slot;
        float* out = kargs()->out;
        for (size_t i = (size_t)blockIdx.x * 256 + threadIdx.x; i < (size_t)T_TOK * DM / 4; i += (size_t)gridDim.x * 256) {
            float4 v = ((float4*)out)[i];
            v.x *= 1.f + delta; v.y *= 1.f + delta; v.z *= 1.f + delta; v.w *= 1.f + delta;
            ((float4*)out)[i] = v;
        }
    }
#endif
}
#ifndef OPT_MASK
#define OPT_MASK 0x7f
#endif
#ifndef MEGA
#define MEGA 1
#endif
#ifndef PROBE_REPEAT
#define PROBE_REPEAT 0
#endif
static inline size_t align_up(size_t v, size_t a) { return (v + a - 1) / a * a; }
#define DYN_LDS (LDS_BYTES + 64)

template <int PH> static void launch_phase(const P& p, int l, hipStream_t stream) {
    static bool attr_done = false;
    if (!attr_done) { (void)hipFuncSetAttribute((const void*)k_phase<PH>, hipFuncAttributeMaxDynamicSharedMemorySize, DYN_LDS); attr_done = true; }
    k_phase<PH><<<512, 256, DYN_LDS, stream>>>(p, l);
    if ((PROBE_REPEAT >> PH) & 1) k_phase<PH><<<512, 256, DYN_LDS, stream>>>(p, l);
}

extern "C" void kernel_launch(void* const* d_in, const int* in_sizes, int n_in, void* d_out, int out_size, void* d_ws, size_t ws_size,
                              hipStream_t stream) {
    P p{};
    p.x_in = (const float*)d_in[0]; p.g_mix = (const float*)d_in[1]; p.w_in = (const float*)d_in[2]; p.win_sink = (const float*)d_in[3];
    p.ax_q_norm = (const float*)d_in[4]; p.ax_k_norm = (const float*)d_in[5]; p.mla_q_norm = (const float*)d_in[6]; p.mla_kv_norm = (const float*)d_in[7];
    p.mla_w_uq = (const float*)d_in[8]; p.mla_w_ukv = (const float*)d_in[9]; p.g_group = (const float*)d_in[10]; p.w_out = (const float*)d_in[11];
    p.g_ffn = (const float*)d_in[12]; p.peer_w_q = (const float*)d_in[13]; p.peer_sub_keys = (const float*)d_in[14]; p.peer_u = (const float*)d_in[15];
    p.peer_v = (const float*)d_in[16]; p.g_final = (const float*)d_in[17];
    p.out = (float*)d_out;

    char* w = (char*)d_ws; size_t off = 0;
    auto carve = [&](size_t bytes) { void* q = w + off; off = align_up(off + bytes, 256); return q; };
    p.bar = (unsigned*)carve(65536);
    p.x = (float*)carve((size_t)T_TOK * DM * 4);
    p.hnb = (bf16_t*)carve((size_t)T_TOK * DM * 2);
    char* regZ = (char*)carve((size_t)T_TOK * 2048 * 2);
    p.zb = (bf16_t*)regZ; p.qp = (bf16_t*)regZ;
    p.qfull = (bf16_t*)regZ; p.kvfull = (bf16_t*)(regZ + (size_t)T_TOK * 384 * 2);
    QKV& q = p.q;
    q.qA = (bf16_t*)carve((size_t)T_TOK * 256 * 2); q.kA = (bf16_t*)carve((size_t)T_TOK * 128 * 2); q.vA = (bf16_t*)carve((size_t)T_TOK * 128 * 2);
    q.qB = (bf16_t*)carve((size_t)T_TOK * 256 * 2); q.kB = (bf16_t*)carve((size_t)T_TOK * 128 * 2); q.vB = (bf16_t*)carve((size_t)T_TOK * 128 * 2);
    q.qC = (bf16_t*)carve((size_t)T_TOK * 256 * 2); q.kC = (bf16_t*)carve((size_t)T_TOK * 128 * 2); q.vC = (bf16_t*)carve((size_t)T_TOK * 128 * 2);
    q.qD = (bf16_t*)carve((size_t)T_TOK * 384 * 2); q.kD = (bf16_t*)carve((size_t)T_TOK * 384 * 2); q.vD = (bf16_t*)carve((size_t)T_TOK * 256 * 2);
    p.ob = (bf16_t*)carve((size_t)T_TOK * DM * 2);
    p.cqn = p.ob; p.ckvn = p.ob + (size_t)T_TOK * 256;
    p.eidx = (int*)carve((size_t)T_TOK * 128 * 4);
    p.gate = (float*)carve((size_t)T_TOK * 128 * 4);
    p.winT = (bf16_t*)carve((size_t)DEPTH * NZ * DM * 2);
    p.woutT = (bf16_t*)carve((size_t)DEPTH * DM * DM * 2);
    p.wqT = (bf16_t*)carve((size_t)DEPTH * 2048 * DM * 2);
    p.subk = (bf16_t*)carve((size_t)DEPTH * 8 * 2 * 128 * 128 * 2);
    p.wuqT = (bf16_t*)carve((size_t)DEPTH * 384 * 256 * 2);
    p.wukvT = (bf16_t*)carve((size_t)DEPTH * 512 * 128 * 2);
    if (OPT_MASK & 64) {
        p.u8 = (unsigned char*)carve((size_t)DEPTH * 16384 * DM);
        p.v8 = (unsigned char*)carve((size_t)DEPTH * 16384 * DM);
        p.su = (float*)carve((size_t)DEPTH * 16384 * 4);
        p.sv = (float*)carve((size_t)DEPTH * 16384 * 4);
        p.flags = 1 | (MEGA ? 2 : 0);
    }
    Tables& tb = p.tb;
    tb.cos1 = (float*)carve(4096 * 32 * 4); tb.sin1 = (float*)carve(4096 * 32 * 4);
    tb.cosm = (float*)carve(4096 * 16 * 4); tb.sinm = (float*)carve(4096 * 16 * 4);
    tb.cosr = (float*)carve(64 * 16 * 4); tb.sinr = (float*)carve(64 * 16 * 4);
    tb.cosc = (float*)carve(64 * 16 * 4); tb.sinc = (float*)carve(64 * 16 * 4);
    float* hn = nullptr; float *cqn_f = nullptr, *ckvn_f = nullptr, *qfull_f = nullptr, *kvfull_f = nullptr;
    if (OPT_MASK != 0x7f) {
        hn = (float*)carve((size_t)T_TOK * DM * 4);
        cqn_f = (float*)carve((size_t)T_TOK * 256 * 4); ckvn_f = (float*)carve((size_t)T_TOK * 128 * 4);
        qfull_f = (float*)carve((size_t)T_TOK * 384 * 4); kvfull_f = hn;
    }
    if (off > ws_size) { fprintf(stderr, "workspace too small: need %zu have %zu\n", off, ws_size); return; }

#if MEGA
    {
        static int grid = 0;
        if (!grid) {
            int dev = 0, cus = 0, per_cu = 0;
            (void)hipGetDevice(&dev);
            (void)hipDeviceGetAttribute(&cus, hipDeviceAttributeMultiprocessorCount, dev);
            (void)hipFuncSetAttribute((const void*)k_mega, hipFuncAttributeMaxDynamicSharedMemorySize, DYN_LDS);
            (void)hipOccupancyMaxActiveBlocksPerMultiprocessor(&per_cu, k_mega, 256, DYN_LDS);
            if (per_cu < 1) per_cu = 1;
            grid = cus * (per_cu < 2 ? per_cu : 2);
        }
        (void)hipMemsetAsync(p.bar, 0, XCD_BAR_WORDS * sizeof(unsigned), stream);
        k_mega<<<grid, 256, DYN_LDS, stream>>>(p);
        return;
    }
#endif
    const float* x_in = p.x_in; float* x = p.x; float* out = p.out;
    launch_phase<0>(p, 0, stream);

    for (int l = 0; l < DEPTH; ++l) {
        if (OPT_MASK & 1) {
            if (l > 0 && !(OPT_MASK & 64)) launch_phase<12>(p, l, stream);
            launch_phase<1>(p, l, stream);
        } else {
            k_rmsnorm_f32<<<T_TOK / 4, 256, 0, stream>>>(x, p.g_mix + l * DM, hn, T_TOK);
            k_ngemm<float, bf16_t, false><<<dim3((NZ + 127) / 128, T_TOK / 128), 256, 0, stream>>>(hn, DM, p.w_in + (size_t)l * DM * NZ, NZ, p.zb, NZ, nullptr, 0, T_TOK, NZ, DM);
        }
        if (OPT_MASK & 2) {
            launch_phase<2>(p, l, stream); launch_phase<3>(p, l, stream); launch_phase<4>(p, l, stream);
        } else {
            PostArgs pa; pa.z = p.zb; pa.o = q; pa.tb = tb;
            pa.g_qn = p.ax_q_norm + l * 64; pa.g_kn = p.ax_k_norm + l * 64; pa.g_cq = p.mla_q_norm + l * 256; pa.g_ckv = p.mla_kv_norm + l * 128;
            pa.cqn = cqn_f; pa.ckvn = ckvn_f;
            k_post_naive<<<T_TOK, 256, 0, stream>>>(pa);
            k_ngemm<float, float, false><<<dim3(384 / 128, T_TOK / 128), 256, 0, stream>>>(cqn_f, 256, p.mla_w_uq + (size_t)l * 256 * 384, 384, qfull_f, 384, nullptr, 0, T_TOK, 384, 256);
            k_ngemm<float, float, false><<<dim3(512 / 128, T_TOK / 128), 256, 0, stream>>>(ckvn_f, 128, p.mla_w_ukv + (size_t)l * 128 * 512, 512, kvfull_f, 512, nullptr, 0, T_TOK, 512, 128);
            k_post_mla<<<T_TOK, 256, 0, stream>>>(qfull_f, kvfull_f, q, tb);
        }
        if (OPT_MASK & 4) {
            launch_phase<5>(p, l, stream);
        } else {
            k_attn_naive<64, 1><<<NBATCH * 4 * SEQ / 4, 256, 0, stream>>>(q.qA, q.kA, q.vA, p.win_sink + l * 4, p.ob, 4, 2, 0);
            k_attn_naive<64, 0><<<NBATCH * 4 * SEQ / 4, 256, 0, stream>>>(q.qB, q.kB, q.vB, nullptr, p.ob, 4, 2, 256);
            k_attn_naive<64, 2><<<NBATCH * 4 * SEQ / 4, 256, 0, stream>>>(q.qC, q.kC, q.vC, nullptr, p.ob, 4, 2, 512);
            k_attn_naive<96, 0><<<NBATCH * 4 * SEQ / 4, 256, 0, stream>>>(q.qD, q.kD, q.vD, nullptr, p.ob, 4, 4, 768);
        }
        if (OPT_MASK & 8) {
            launch_phase<6>(p, l, stream); launch_phase<7>(p, l, stream);
        } else {
            k_groupnorm_f32<<<T_TOK / 4, 256, 0, stream>>>(p.ob, p.g_group + (size_t)l * 1024, hn);
            k_ngemm<float, float, true><<<dim3(DM / 128, T_TOK / 128), 256, 0, stream>>>(hn, DM, p.w_out + (size_t)l * DM * DM, DM, x, DM, x, DM, T_TOK, DM, DM);
        }
        if (OPT_MASK & 16) {
            launch_phase<8>(p, l, stream); launch_phase<9>(p, l, stream);
            if (!(OPT_MASK & 64)) k_rmsnorm_f32<<<T_TOK / 4, 256, 0, stream>>>(x, p.g_ffn + l * DM, hn, T_TOK);
        } else {
            k_rmsnorm_f32<<<T_TOK / 4, 256, 0, stream>>>(x, p.g_ffn + l * DM, hn, T_TOK);
            k_ngemm<float, bf16_t, false><<<dim3(2048 / 128, T_TOK / 128), 256, 0, stream>>>(hn, DM, p.peer_w_q + (size_t)l * DM * 2048, 2048, p.qp, 2048, nullptr, 0, T_TOK, 2048, DM);
        }
        if (OPT_MASK & 32) launch_phase<10>(p, l, stream);
        else k_peer_topk_naive<<<T_TOK * 8, 64, 0, stream>>>(p.qp, p.peer_sub_keys + (size_t)l * 8 * 2 * 128 * 128, p.eidx, p.gate);
        if ((PROBE_REPEAT >> 13) & 1) launch_phase<13>(p, l, stream);
        if (OPT_MASK & 64) launch_phase<11>(p, l, stream);
        else {
            k_peer_expert_naive<<<T_TOK, 256, 0, stream>>>(hn, p.eidx, p.gate, p.peer_u + (size_t)l * 16384 * DM, p.peer_v + (size_t)l * 16384 * DM, x);
            if (l == DEPTH - 1) k_rmsnorm_f32<<<T_TOK / 4, 256, 0, stream>>>(x, p.g_final, out, T_TOK);
        }
    }
    (void)x_in; (void)in_sizes; (void)n_in; (void)out_size;
}
```

```cpp
#include <hip/hip_runtime.h>
#include <stdint.h>
#include <stdio.h>

typedef unsigned short bf16_t;

#define T_TOK 32768
#define SEQ 4096
#define NBATCH 8
#define DM 1024
#define NZ 1952
#define DEPTH 4
#define LOG2E 1.4426950408889634f

__device__ __forceinline__ float bf2f(bf16_t v) { return __uint_as_float(((unsigned)v) << 16); }
__device__ __forceinline__ bf16_t f2bf(float f) {
    unsigned u = __float_as_uint(f);
    u += 0x7fffu + ((u >> 16) & 1u);
    return (bf16_t)(u >> 16);
}
__device__ __forceinline__ float wave_sum(float v) {
#pragma unroll
    for (int o = 32; o >= 1; o >>= 1) v += __shfl_xor(v, o);
    return v;
}
__device__ __forceinline__ float wave_max(float v) {
#pragma unroll
    for (int o = 32; o >= 1; o >>= 1) v = fmaxf(v, __shfl_xor(v, o));
    return v;
}

struct Tables { float *cos1, *sin1, *cosm, *sinm, *cosr, *sinr, *cosc, *sinc; };

__global__ void k_tables(Tables tb) {
    int i = blockIdx.x * blockDim.x + threadIdx.x;
    if (i < 4096 * 32) {
        int pos = i / 32, j = i % 32;
        float inv = powf(10000.f, -(float)(2 * j) / 64.f);
        float ang = (float)pos * inv;
        tb.cos1[i] = cosf(ang); tb.sin1[i] = sinf(ang);
    }
    if (i < 4096 * 16) {
        int pos = i / 16, j = i % 16;
        float inv = powf(10000.f, -(float)(2 * j) / 32.f);
        float ang = (float)pos * inv;
        tb.cosm[i] = cosf(ang); tb.sinm[i] = sinf(ang);
    }
    if (i < 64 * 16) {
        int pos = i / 16, j = i % 16;
        float inv = powf(10000.f, -(float)(2 * j) / 32.f);
        float ang = (float)pos * inv;
        tb.cosr[i] = cosf(ang); tb.sinr[i] = sinf(ang);
        tb.cosc[i] = cosf(ang); tb.sinc[i] = sinf(ang);
    }
}

__global__ void __launch_bounds__(256) k_rmsnorm_f32(const float* __restrict__ x, const float* __restrict__ g, float* __restrict__ out, int rows) {
    int row = blockIdx.x * 4 + (threadIdx.x >> 6), lane = threadIdx.x & 63;
    if (row >= rows) return;
    const float4* xr = (const float4*)(x + (size_t)row * DM);
    float4 v[4]; float ss = 0.f;
#pragma unroll
    for (int i = 0; i < 4; ++i) { v[i] = xr[lane + 64 * i]; ss += v[i].x * v[i].x + v[i].y * v[i].y + v[i].z * v[i].z + v[i].w * v[i].w; }
    ss = wave_sum(ss);
    float rstd = rsqrtf(ss * (1.f / DM) + 1e-6f);
    float4* orow = (float4*)(out + (size_t)row * DM);
    const float4* g4 = (const float4*)g;
#pragma unroll
    for (int i = 0; i < 4; ++i) {
        float4 gg = g4[lane + 64 * i]; float4 o;
        o.x = v[i].x * rstd * gg.x; o.y = v[i].y * rstd * gg.y; o.z = v[i].z * rstd * gg.z; o.w = v[i].w * rstd * gg.w;
        orow[lane + 64 * i] = o;
    }
}

__global__ void __launch_bounds__(256) k_groupnorm_f32(const bf16_t* __restrict__ o, const float* __restrict__ gg, float* __restrict__ out) {
    int row = blockIdx.x * 4 + (threadIdx.x >> 6), lane = threadIdx.x & 63;
    const bf16_t* orow = o + (size_t)row * DM;
#pragma unroll
    for (int g = 0; g < 4; ++g) {
        float v[4]; float ss = 0.f;
#pragma unroll
        for (int i = 0; i < 4; ++i) { v[i] = bf2f(orow[g * 256 + lane + 64 * i]); ss += v[i] * v[i]; }
        ss = wave_sum(ss);
        float rstd = rsqrtf(ss * (1.f / 256.f) + 1e-6f);
#pragma unroll
        for (int i = 0; i < 4; ++i) out[(size_t)row * DM + g * 256 + lane + 64 * i] = v[i] * rstd * gg[g * 256 + lane + 64 * i];
    }
}

template <typename AT> __device__ __forceinline__ float ldA(const AT* p);
template <> __device__ __forceinline__ float ldA<float>(const float* p) { return *p; }
template <> __device__ __forceinline__ float ldA<bf16_t>(const bf16_t* p) { return bf2f(*p); }
__device__ __forceinline__ void stC(float* p, float v) { *p = v; }
__device__ __forceinline__ void stC(bf16_t* p, float v) { *p = f2bf(v); }

template <typename AT, typename CT, bool RES>
__global__ void __launch_bounds__(256) k_ngemm(const AT* __restrict__ A, int lda, const float* __restrict__ B, int ldb,
                                               CT* C, int ldc, const float* R, int ldr, int M, int N, int K) {
    __shared__ float As[16][132];
    __shared__ float Bs[16][132];
    const int tid = threadIdx.x, tx = tid & 15, ty = tid >> 4;
    const int m0 = blockIdx.y * 128, n0 = blockIdx.x * 128;
    float acc[8][8];
#pragma unroll
    for (int i = 0; i < 8; ++i)
#pragma unroll
        for (int j = 0; j < 8; ++j) acc[i][j] = 0.f;
    const int ar = tid >> 1, ak = (tid & 1) * 8;
    const int bk = tid >> 4, bn = (tid & 15) * 8;
    for (int k0 = 0; k0 < K; k0 += 16) {
#pragma unroll
        for (int i = 0; i < 8; ++i) As[ak + i][ar] = ldA<AT>(A + (size_t)(m0 + ar) * lda + k0 + ak + i);
#pragma unroll
        for (int i = 0; i < 8; ++i) { int n = n0 + bn + i; Bs[bk][bn + i] = (n < N) ? B[(size_t)(k0 + bk) * ldb + n] : 0.f; }
        __syncthreads();
#pragma unroll
        for (int kk = 0; kk < 16; ++kk) {
            float a[8], b[8];
#pragma unroll
            for (int i = 0; i < 8; ++i) a[i] = As[kk][ty * 8 + i];
#pragma unroll
            for (int j = 0; j < 8; ++j) b[j] = Bs[kk][tx * 8 + j];
#pragma unroll
            for (int i = 0; i < 8; ++i)
#pragma unroll
                for (int j = 0; j < 8; ++j) acc[i][j] += a[i] * b[j];
        }
        __syncthreads();
    }
#pragma unroll
    for (int i = 0; i < 8; ++i) {
        int m = m0 + ty * 8 + i;
#pragma unroll
        for (int j = 0; j < 8; ++j) {
            int n = n0 + tx * 8 + j;
            if (n < N) {
                float v = acc[i][j];
                if (RES) v += R[(size_t)m * ldr + n];
                stC(C + (size_t)m * ldc + n, v);
            }
        }
    }
}

struct QKV {
    bf16_t *qA, *kA, *vA, *qB, *kB, *vB, *qC, *kC, *vC, *qD, *kD, *vD;
};
struct PostArgs {
    const bf16_t* z; QKV o; Tables tb;
    const float *g_qn, *g_kn, *g_cq, *g_ckv;
    float *cqn, *ckvn;
};

__global__ void __launch_bounds__(256) k_post_naive(PostArgs a) {
    __shared__ float zr[NZ];
    __shared__ float hs[8];
    const int t = blockIdx.x, tid = threadIdx.x;
    const int b = t / SEQ, s = t % SEQ;
    for (int i = tid; i < NZ; i += 256) zr[i] = bf2f(a.z[(size_t)t * NZ + i]);
    __syncthreads();
    if (tid < 8) {
        int base, n;
        if (tid < 4) { base = 512 + tid * 64; n = 64; }
        else if (tid < 6) { base = 768 + (tid - 4) * 64; n = 64; }
        else if (tid == 6) { base = 1536; n = 256; }
        else { base = 1792; n = 128; }
        float ss = 0.f;
        for (int i = 0; i < n; ++i) ss += zr[base + i] * zr[base + i];
        hs[tid] = rsqrtf(ss / (float)n + 1e-6f);
    }
    __syncthreads();
    const float scA = 0.125f * LOG2E;
    const float scD = 0.10206207261596575f * LOG2E;
    for (int mix = 0; mix < 2; ++mix) {
        const int zb = mix == 0 ? 0 : 1024;
        bf16_t* qo = mix == 0 ? a.o.qA : a.o.qC;
        bf16_t* ko = mix == 0 ? a.o.kA : a.o.kC;
        bf16_t* vo = mix == 0 ? a.o.vA : a.o.vC;
        for (int i = tid; i < 128; i += 256) {
            int h = i / 32, j = i % 32;
            float x1 = zr[zb + h * 64 + j], x2 = zr[zb + h * 64 + 32 + j];
            float c = a.tb.cos1[s * 32 + j], sn = a.tb.sin1[s * 32 + j];
            size_t ob = ((size_t)(b * 4 + h) * SEQ + s) * 64;
            qo[ob + j] = f2bf((x1 * c - x2 * sn) * scA);
            qo[ob + 32 + j] = f2bf((x2 * c + x1 * sn) * scA);
        }
        for (int i = tid; i < 64; i += 256) {
            int h = i / 32, j = i % 32;
            float x1 = zr[zb + 256 + h * 64 + j], x2 = zr[zb + 256 + h * 64 + 32 + j];
            float c = a.tb.cos1[s * 32 + j], sn = a.tb.sin1[s * 32 + j];
            size_t ob = ((size_t)(b * 2 + h) * SEQ + s) * 64;
            ko[ob + j] = f2bf(x1 * c - x2 * sn);
            ko[ob + 32 + j] = f2bf(x2 * c + x1 * sn);
        }
        for (int i = tid; i < 128; i += 256) {
            int h = i / 64, j = i % 64;
            vo[((size_t)(b * 2 + h) * SEQ + s) * 64 + j] = f2bf(zr[zb + 384 + i]);
        }
    }
    {
        const int row = s / 64, col = s % 64;
        for (int i = tid; i < 192; i += 256) {
            int hh = i / 32, r = i % 32, half = r / 16, j = r % 16;
            bool isq = hh < 4;
            int zb = isq ? 512 + hh * 64 : 768 + (hh - 4) * 64;
            const float* gn = isq ? a.g_qn : a.g_kn;
            float rstd = hs[hh];
            int d1 = half * 32 + j, d2 = half * 32 + 16 + j;
            float x1 = zr[zb + d1] * rstd * gn[d1], x2 = zr[zb + d2] * rstd * gn[d2];
            float c, sn;
            if (half == 0) { c = a.tb.cosr[row * 16 + j]; sn = a.tb.sinr[row * 16 + j]; }
            else { c = a.tb.cosc[col * 16 + j]; sn = a.tb.sinc[col * 16 + j]; }
            float o1 = x1 * c - x2 * sn, o2 = x2 * c + x1 * sn;
            if (isq) {
                size_t ob = ((size_t)(b * 4 + hh) * SEQ + s) * 64;
                a.o.qB[ob + d1] = f2bf(o1 * scA); a.o.qB[ob + d2] = f2bf(o2 * scA);
            } else {
                size_t ob = ((size_t)(b * 2 + (hh - 4)) * SEQ + s) * 64;
                a.o.kB[ob + d1] = f2bf(o1); a.o.kB[ob + d2] = f2bf(o2);
            }
        }
        for (int i = tid; i < 128; i += 256) {
            int h = i / 64, j = i % 64;
            a.o.vB[((size_t)(b * 2 + h) * SEQ + s) * 64 + j] = f2bf(zr[896 + i]);
        }
    }
    for (int i = tid; i < 256; i += 256) a.cqn[(size_t)t * 256 + i] = zr[1536 + i] * hs[6] * a.g_cq[i];
    for (int i = tid; i < 128; i += 256) a.ckvn[(size_t)t * 128 + i] = zr[1792 + i] * hs[7] * a.g_ckv[i];
    for (int i = tid; i < 16; i += 256) {
        float x1 = zr[1920 + i], x2 = zr[1920 + 16 + i];
        float c = a.tb.cosm[s * 16 + i], sn = a.tb.sinm[s * 16 + i];
        bf16_t o1 = f2bf(x1 * c - x2 * sn), o2 = f2bf(x2 * c + x1 * sn);
        for (int h = 0; h < 4; ++h) {
            size_t ob = ((size_t)(b * 4 + h) * SEQ + s) * 96;
            a.o.kD[ob + 64 + i] = o1; a.o.kD[ob + 80 + i] = o2;
        }
    }
    (void)scD;
}

__global__ void __launch_bounds__(256) k_post_mla(const float* __restrict__ qfull, const float* __restrict__ kvfull, QKV o, Tables tb) {
    const int t = blockIdx.x, tid = threadIdx.x;
    const int b = t / SEQ, s = t % SEQ;
    const float scD = 0.10206207261596575f * LOG2E;
    {
        int h = tid / 64, j = tid % 64;
        o.qD[((size_t)(b * 4 + h) * SEQ + s) * 96 + j] = f2bf(qfull[(size_t)t * 384 + h * 96 + j] * scD);
    }
    if (tid < 64) {
        int h = tid / 16, j = tid % 16;
        float x1 = qfull[(size_t)t * 384 + h * 96 + 64 + j], x2 = qfull[(size_t)t * 384 + h * 96 + 80 + j];
        float c = tb.cosm[s * 16 + j], sn = tb.sinm[s * 16 + j];
        size_t ob = ((size_t)(b * 4 + h) * SEQ + s) * 96;
        o.qD[ob + 64 + j] = f2bf((x1 * c - x2 * sn) * scD);
        o.qD[ob + 80 + j] = f2bf((x2 * c + x1 * sn) * scD);
    }
    {
        int h = tid / 64, j = tid % 64;
        o.kD[((size_t)(b * 4 + h) * SEQ + s) * 96 + j] = f2bf(kvfull[(size_t)t * 512 + h * 128 + j]);
        o.vD[((size_t)(b * 4 + h) * SEQ + s) * 64 + j] = f2bf(kvfull[(size_t)t * 512 + h * 128 + 64 + j]);
    }
}

template <int DK, int MODE>
__global__ void __launch_bounds__(256) k_attn_naive(const bf16_t* __restrict__ Q, const bf16_t* __restrict__ K, const bf16_t* __restrict__ V,
                                                    const float* __restrict__ sink, bf16_t* __restrict__ O, int H, int KV, int ocol) {
    const int wave = threadIdx.x >> 6, lane = threadIdx.x & 63;
    const int gq = blockIdx.x * 4 + wave;
    const int s = gq % SEQ, bh = gq / SEQ, h = bh % H, b = bh / H;
    const int kvh = h / (H / KV);
    const bf16_t* qrow = Q + (size_t)gq * DK;
    const bf16_t* Kb = K + (size_t)(b * KV + kvh) * SEQ * DK;
    const bf16_t* Vb = V + (size_t)(b * KV + kvh) * SEQ * 64;
    const int sub = lane & 7, grp = lane >> 3;
    constexpr int NCH = DK / 8;
    float q0[8], q1[8];
    {
        uint4 r = *(const uint4*)(qrow + sub * 8);
        const bf16_t* p = (const bf16_t*)&r;
#pragma unroll
        for (int i = 0; i < 8; ++i) q0[i] = bf2f(p[i]);
        const bool has1 = (NCH > 8) && (sub + 8 < NCH);
        uint4 r1 = make_uint4(0, 0, 0, 0);
        if (has1) r1 = *(const uint4*)(qrow + (sub + 8) * 8);
        const bf16_t* p1 = (const bf16_t*)&r1;
#pragma unroll
        for (int i = 0; i < 8; ++i) q1[i] = bf2f(p1[i]);
    }
    float m = -1e30f, l = 0.f, acc[8];
#pragma unroll
    for (int i = 0; i < 8; ++i) acc[i] = 0.f;
    if (MODE == 1 && grp == 0) { m = sink[h] * LOG2E; l = 1.f; }
    const int nk = MODE == 0 ? SEQ : (MODE == 1 ? 257 : 387);
    for (int base = 0; base < nk; base += 8) {
        const int kk = base + grp;
        bool valid = kk < nk;
        int tok;
        if (MODE == 0) tok = kk;
        else if (MODE == 1) tok = s - 128 + kk;
        else { int p = kk / 129, j = kk % 129; int r = p == 0 ? 1 : (p == 1 ? 4 : 16); tok = s + (j - 64) * r; }
        valid = valid && tok >= 0 && tok < SEQ;
        float sc = 0.f;
        if (valid) {
            uint4 r = *(const uint4*)(Kb + (size_t)tok * DK + sub * 8);
            const bf16_t* p = (const bf16_t*)&r;
#pragma unroll
            for (int i = 0; i < 8; ++i) sc += q0[i] * bf2f(p[i]);
            if (NCH > 8 && sub + 8 < NCH) {
                uint4 r1 = *(const uint4*)(Kb + (size_t)tok * DK + (sub + 8) * 8);
                const bf16_t* p1 = (const bf16_t*)&r1;
#pragma unroll
                for (int i = 0; i < 8; ++i) sc += q1[i] * bf2f(p1[i]);
            }
        }
        sc += __shfl_xor(sc, 1); sc += __shfl_xor(sc, 2); sc += __shfl_xor(sc, 4);
        if (valid) {
            float mn = fmaxf(m, sc);
            float f = exp2f(m - mn), p = exp2f(sc - mn);
            uint4 r = *(const uint4*)(Vb + (size_t)tok * 64 + sub * 8);
            const bf16_t* pv = (const bf16_t*)&r;
            l = l * f + p;
#pragma unroll
            for (int i = 0; i < 8; ++i) acc[i] = acc[i] * f + p * bf2f(pv[i]);
            m = mn;
        }
    }
    float M = m;
    M = fmaxf(M, __shfl_xor(M, 8)); M = fmaxf(M, __shfl_xor(M, 16)); M = fmaxf(M, __shfl_xor(M, 32));
    float f = exp2f(m - M);
    l *= f;
    l += __shfl_xor(l, 8); l += __shfl_xor(l, 16); l += __shfl_xor(l, 32);
#pragma unroll
    for (int i = 0; i < 8; ++i) {
        float v = acc[i] * f;
        v += __shfl_xor(v, 8); v += __shfl_xor(v, 16); v += __shfl_xor(v, 32);
        acc[i] = v;
    }
    if (grp == 0) {
        const int t = b * SEQ + s;
        float inv = 1.f / l;
#pragma unroll
        for (int i = 0; i < 8; ++i) O[(size_t)t * DM + ocol + h * 64 + sub * 8 + i] = f2bf(acc[i] * inv);
    }
}

__global__ void __launch_bounds__(64) k_peer_topk_naive(const bf16_t* __restrict__ qp, const float* __restrict__ subk  ,
                                                        int* __restrict__ eidx, float* __restrict__ gate) {
    __shared__ float qs[256];
    __shared__ float s12[2][16];
    __shared__ int i12[2][16];
    const int t = blockIdx.x >> 3, h = blockIdx.x & 7, lane = threadIdx.x;
    for (int i = lane; i < 256; i += 64) qs[i] = bf2f(qp[(size_t)t * 2048 + h * 256 + i]);
    __syncthreads();
    float sc[2][2];
#pragma unroll
    for (int c = 0; c < 2; ++c)
#pragma unroll
        for (int u = 0; u < 2; ++u) {
            int n = lane + 64 * u;
            const float* kr = subk + ((size_t)(h * 2 + c) * 128 + n) * 128;
            float a = 0.f;
            for (int d = 0; d < 128; ++d) a += qs[c * 128 + d] * kr[d];
            sc[c][u] = a;
        }
#pragma unroll
    for (int c = 0; c < 2; ++c) {
        for (int r = 0; r < 16; ++r) {
            float bv; int bi;
            if (sc[c][0] >= sc[c][1]) { bv = sc[c][0]; bi = lane; } else { bv = sc[c][1]; bi = lane + 64; }
#pragma unroll
            for (int o = 32; o >= 1; o >>= 1) {
                float ov = __shfl_xor(bv, o); int oi = __shfl_xor(bi, o);
                if (ov > bv || (ov == bv && oi < bi)) { bv = ov; bi = oi; }
            }
            if (bi == lane) sc[c][0] = -3e38f;
            if (bi == lane + 64) sc[c][1] = -3e38f;
            if (lane == 0) { s12[c][r] = bv; i12[c][r] = bi; }
        }
    }
    __syncthreads();
    float cv[4]; int ci[4];
#pragma unroll
    for (int u = 0; u < 4; ++u) {
        int id = lane + 64 * u;
        cv[u] = s12[0][id / 16] + s12[1][id % 16];
        ci[u] = i12[0][id / 16] * 128 + i12[1][id % 16];
    }
    float best = 0.f; int be = 0;
    for (int r = 0; r < 16; ++r) {
        float bv = cv[0]; int bu = 0;
#pragma unroll
        for (int u = 1; u < 4; ++u) if (cv[u] > bv) { bv = cv[u]; bu = u; }
        int bid = lane + 64 * bu;
#pragma unroll
        for (int o = 32; o >= 1; o >>= 1) {
            float ov = __shfl_xor(bv, o); int oi = __shfl_xor(bid, o);
            if (ov > bv || (ov == bv && oi < bid)) { bv = ov; bid = oi; }
        }
        int e = 0;
#pragma unroll
        for (int u = 0; u < 4; ++u) if (bid == lane + 64 * u) { cv[u] = -3e38f; e = ci[u]; }
        e = __shfl(e, bid & 63);
        if (lane == r) { best = bv; be = e; }
    }
    float mx = lane < 16 ? best : -3e38f;
    mx = wave_max(mx);
    float ex = lane < 16 ? expf(best - mx) : 0.f;
    float sm = wave_sum(ex);
    if (lane < 16) {
        eidx[(size_t)t * 128 + h * 16 + lane] = be;
        gate[(size_t)t * 128 + h * 16 + lane] = ex / sm;
    }
}

__global__ void __launch_bounds__(256) k_peer_expert_naive(const float* __restrict__ hn, const int* __restrict__ eidx, const float* __restrict__ gate,
                                                           const float* __restrict__ ut, const float* __restrict__ vt, float* __restrict__ x) {
    __shared__ float hs[DM];
    __shared__ float wg[128];
    __shared__ int es[128];
    const int t = blockIdx.x, tid = threadIdx.x, wave = tid >> 6, lane = tid & 63;
    for (int i = tid; i < DM; i += 256) hs[i] = hn[(size_t)t * DM + i];
    if (tid < 128) es[tid] = eidx[(size_t)t * 128 + tid];
    __syncthreads();
    for (int p = wave * 32; p < wave * 32 + 32; ++p) {
        const float* ur = ut + (size_t)es[p] * DM;
        float a = 0.f;
#pragma unroll
        for (int i = 0; i < 16; ++i) a += ur[lane + 64 * i] * hs[lane + 64 * i];
        a = wave_sum(a);
        if (lane == 0) {
            float ge = 0.5f * a * (1.f + erff(a * 0.70710678118654752f));
            wg[p] = gate[(size_t)t * 128 + p] * ge;
        }
    }
    __syncthreads();
    float o[4] = {0.f, 0.f, 0.f, 0.f};
    for (int p = 0; p < 128; ++p) {
        const float* vr = vt + (size_t)es[p] * DM;
        float w = wg[p];
#pragma unroll
        for (int i = 0; i < 4; ++i) o[i] += w * vr[tid + 256 * i];
    }
#pragma unroll
    for (int i = 0; i < 4; ++i) x[(size_t)t * DM + tid + 256 * i] += o[i];
}

using bf16x8 = __attribute__((ext_vector_type(8))) short;
using s16x4 = __attribute__((ext_vector_type(4))) short;
using f32x16 = __attribute__((ext_vector_type(16))) float;
typedef __attribute__((ext_vector_type(2))) __bf16 bf16x2_t;

#define NBLK_THREADS 256
#define CT_STRIDE 132
#define LDS_BYTES (128 * CT_STRIDE * 4)

__device__ __forceinline__ unsigned cvtpk(float lo, float hi) {
    unsigned r; asm("v_cvt_pk_bf16_f32 %0, %1, %2" : "=v"(r) : "v"(lo), "v"(hi)); return r;
}
__device__ __forceinline__ int tid_opaque() { int t = threadIdx.x; asm volatile("" : "+v"(t)); return t; }
__device__ __forceinline__ int crow(int i, int hh) { return (i & 3) + 8 * (i >> 2) + 4 * hh; }
__device__ __forceinline__ float xhalf(float v) { return __shfl_xor(v, 32); }
__device__ __forceinline__ float xhalf_max(float v) { auto rr = __builtin_amdgcn_permlane32_swap(__float_as_uint(v), __float_as_uint(v), false, false); return fmaxf(__uint_as_float(rr[0]), __uint_as_float(rr[1])); }
__device__ __forceinline__ float xhalf_sum(float v) { auto rr = __builtin_amdgcn_permlane32_swap(__float_as_uint(v), __float_as_uint(v), false, false); return __uint_as_float(rr[0]) + __uint_as_float(rr[1]); }

struct P {
    const float *x_in, *g_mix, *w_in, *win_sink, *ax_q_norm, *ax_k_norm, *mla_q_norm, *mla_kv_norm, *mla_w_uq, *mla_w_ukv, *g_group, *w_out,
        *g_ffn, *peer_w_q, *peer_sub_keys, *peer_u, *peer_v, *g_final;
    float* out;
    float* x; bf16_t* hnb; bf16_t* zb; QKV q; bf16_t* ob; bf16_t* qp; int* eidx; float* gate;
    bf16_t *cqn, *ckvn, *qfull, *kvfull;
    bf16_t *winT, *woutT, *wqT, *subk, *wuqT, *wukvT;
    unsigned char *u8, *v8; float *su, *sv; float* ssq2; bf16_t* xb2; float* ssqd;
    Tables tb;
    unsigned* bar;
    int flags; int pad0;
};
typedef const P __attribute__((address_space(4))) PC;
__device__ __forceinline__ PC* kargs() { PC* q = (PC*)__builtin_amdgcn_kernarg_segment_ptr(); asm volatile("" : "+s"(q)); return q; }

struct EpiStoreBf16 {
    bf16_t* C; int ldc; int N;
    __device__ __forceinline__ void operator()(const f32x16 (&acc)[2][2], int mbase, int nbase, int r32, int hh) const {
#pragma unroll
        for (int mt = 0; mt < 2; ++mt)
#pragma unroll
            for (int nt = 0; nt < 2; ++nt) {
                const int n = nbase + nt * 32 + r32;
                if (n < N) {
#pragma unroll
                    for (int i = 0; i < 16; ++i) {
                        const int m = mbase + mt * 32 + crow(i, hh);
                        C[(size_t)m * ldc + n] = f2bf(acc[mt][nt][i]);
                    }
                }
            }
    }
};
struct EpiResidNorm {
    float* X; int ldx; bf16_t* XB; float* ssq;
    __device__ __forceinline__ void operator()(const f32x16 (&acc)[2][2], int mbase, int nbase, int r32, int hh) const {
#pragma unroll
        for (int mt = 0; mt < 2; ++mt) {
#pragma unroll
            for (int i = 0; i < 16; ++i) {
                const int m = mbase + mt * 32 + crow(i, hh);
                float sq = 0.f;
#pragma unroll
                for (int nt = 0; nt < 2; ++nt) {
                    const int n = nbase + nt * 32 + r32;
                    float* px = X + (size_t)m * ldx + n;
                    const float v = *px + acc[mt][nt][i];
                    *px = v;
                    XB[(size_t)m * ldx + n] = f2bf(v);
                    sq += v * v;
                }
                sq += __shfl_xor(sq, 1); sq += __shfl_xor(sq, 2); sq += __shfl_xor(sq, 4); sq += __shfl_xor(sq, 8); sq += __shfl_xor(sq, 16);
                if (r32 == 0) ssq[(size_t)m * 16 + (nbase >> 6)] = sq;
            }
        }
    }
};
struct EpiStoreBf16RowNorm {
    bf16_t* C; int ldc; const float* ssq;
    __device__ __forceinline__ void operator()(const f32x16 (&acc)[2][2], int mbase, int nbase, int r32, int hh) const {
#pragma unroll
        for (int mt = 0; mt < 2; ++mt)
#pragma unroll
            for (int i = 0; i < 16; ++i) {
                const int m = mbase + mt * 32 + crow(i, hh);
                const float4 q0 = *(const float4*)(ssq + (size_t)m * 16), q1 = *(const float4*)(ssq + (size_t)m * 16 + 4);
                const float4 q2 = *(const float4*)(ssq + (size_t)m * 16 + 8), q3 = *(const float4*)(ssq + (size_t)m * 16 + 12);
                const float tot = (((q0.x + q0.y) + (q0.z + q0.w)) + ((q1.x + q1.y) + (q1.z + q1.w))) + (((q2.x + q2.y) + (q2.z + q2.w)) + ((q3.x + q3.y) + (q3.z + q3.w)));
                const float r = rsqrtf(tot * (1.f / DM) + 1e-6f);
#pragma unroll
                for (int nt = 0; nt < 2; ++nt) C[(size_t)m * ldc + nbase + nt * 32 + r32] = f2bf(acc[mt][nt][i] * r);
            }
    }
};
struct EpiResidF32 {
    float* X; int ldx;
    __device__ __forceinline__ void operator()(const f32x16 (&acc)[2][2], int mbase, int nbase, int r32, int hh) const {
#pragma unroll
        for (int mt = 0; mt < 2; ++mt)
#pragma unroll
            for (int nt = 0; nt < 2; ++nt) {
                const int n = nbase + nt * 32 + r32;
#pragma unroll
                for (int i = 0; i < 16; ++i) {
                    const int m = mbase + mt * 32 + crow(i, hh);
                    float* p = X + (size_t)m * ldx + n;
                    *p = *p + acc[mt][nt][i];
                }
            }
    }
};

__device__ __forceinline__ void glds16(const void* gsrc, unsigned lds_dst) {
    unsigned keep;
    asm volatile("s_mov_b32 %0, m0\n\ts_mov_b32 m0, %2\n\ts_nop 0\n\tglobal_load_lds_dwordx4 %1, off\n\ts_mov_b32 m0, %0" : "=&s"(keep) : "v"(gsrc), "s"(lds_dst) : "memory");
}

template <class Epi>
__device__ __forceinline__ void gemm_tile(const bf16_t* __restrict__ X, int ldx, const bf16_t* __restrict__ W, int ldw, int K, int m0, int n0, int N,
                                          char* lds, const Epi& epi) {
    const int tid = tid_opaque(), lane = tid & 63, wave = tid >> 6;
    const int wm = wave >> 1, wn = wave & 1;
    const int r32 = lane & 31, hh = lane >> 5;
    const char* xsrc[4]; const char* wsrc[4];
#pragma unroll
    for (int j = 0; j < 4; ++j) {
        const int row = (wave * 4 + j) * 8 + (lane >> 3), slot = lane & 7;
        const int c = slot ^ ((row >> 1) & 7);
        xsrc[j] = (const char*)(X + (size_t)(m0 + row) * ldx + c * 8);
        int n = n0 + row; n = n < N ? n : N - 1;
        wsrc[j] = (const char*)(W + (size_t)n * ldw + c * 8);
    }
    const unsigned lbase = (unsigned)(uintptr_t)lds;
    const unsigned wpiece = __builtin_amdgcn_readfirstlane(wave) * 4096u;
    f32x16 acc[2][2];
#pragma unroll
    for (int a = 0; a < 2; ++a)
#pragma unroll
        for (int b = 0; b < 2; ++b)
#pragma unroll
            for (int i = 0; i < 16; ++i) acc[a][b][i] = 0.f;
    const int nk = K >> 6;
#define GDMA(KT, BUF) do { const unsigned _d = lbase + (BUF) * 32768u + wpiece; const int _ko = (KT) * 128; \
        glds16(xsrc[0] + _ko, _d); glds16(xsrc[1] + _ko, _d + 1024u); glds16(xsrc[2] + _ko, _d + 2048u); glds16(xsrc[3] + _ko, _d + 3072u); \
        glds16(wsrc[0] + _ko, _d + 16384u); glds16(wsrc[1] + _ko, _d + 17408u); glds16(wsrc[2] + _ko, _d + 18432u); glds16(wsrc[3] + _ko, _d + 19456u); } while (0)
    GDMA(0, 0);
    asm volatile("s_waitcnt vmcnt(0)" ::: "memory");
    __syncthreads();
    for (int kt = 0; kt < nk; ++kt) {
        if (kt + 1 < nk) GDMA(kt + 1, (kt + 1) & 1);
        const char* xs = lds + (kt & 1) * 32768; const char* ws = xs + 16384;
#pragma unroll
        for (int ks = 0; ks < 4; ++ks) {
            bf16x8 xf[2], wf[2];
#pragma unroll
            for (int mt = 0; mt < 2; ++mt) { const int r = wm * 64 + mt * 32 + r32; xf[mt] = *(const bf16x8*)(xs + r * 128 + (((ks * 2 + hh) ^ ((r >> 1) & 7)) << 4)); }
#pragma unroll
            for (int nt = 0; nt < 2; ++nt) { const int r = wn * 64 + nt * 32 + r32; wf[nt] = *(const bf16x8*)(ws + r * 128 + (((ks * 2 + hh) ^ ((r >> 1) & 7)) << 4)); }
#pragma unroll
            for (int mt = 0; mt < 2; ++mt)
#pragma unroll
                for (int nt = 0; nt < 2; ++nt) acc[mt][nt] = __builtin_amdgcn_mfma_f32_32x32x16_bf16(xf[mt], wf[nt], acc[mt][nt], 0, 0, 0);
        }
        asm volatile("s_waitcnt vmcnt(0)" ::: "memory");
        __syncthreads();
    }
#undef GDMA
    epi(acc, m0 + wm * 64, n0 + wn * 64, r32, hh);
}

__device__ __forceinline__ void tile_map(int tile, int ntm, int ntn, int& mt, int& nt) {
    if ((ntn & 7) == 0) {
        const int G = gridDim.x;
        const int round = tile / G, bi = tile % G;
        const int x = bi & 7, j = bi >> 3;
        const int per = G >> 3;
        const int id = (round * 8 + x) * per + j;
        const int st = id >> 6, in = id & 63;
        const int snt = ntn >> 3;
        const int sm = st / snt, sn = st % snt;
        mt = sm * 8 + (in >> 3); nt = sn * 8 + (in & 7);
    } else { mt = tile / ntn; nt = tile % ntn; }
}

template <class Epi, int KGROUP>
__device__ __forceinline__ void gemm_tile_rows(const bf16_t* __restrict__ X, int ldx, const bf16_t* __restrict__ W, int ldw, int K, int m0, int n0, int N,
                                               char* lds, const Epi& epi) {
    const int tid = tid_opaque(), lane = tid & 63, wave = tid >> 6;
    const int wm = wave >> 1, wn = wave & 1;
    const int r32 = lane & 31, hh = lane >> 5;
    const char* xsrc[4]; const char* wsrc[4];
#pragma unroll
    for (int j = 0; j < 4; ++j) {
        const int row = (wave * 4 + j) * 8 + (lane >> 3), slot = lane & 7;
        const int c = slot ^ ((row >> 1) & 7);
        xsrc[j] = (const char*)(X + (size_t)(m0 + row) * ldx + c * 8);
        int n = n0 + row; n = n < N ? n : N - 1;
        wsrc[j] = (const char*)(W + (size_t)n * ldw + c * 8);
    }
    const unsigned lbase = (unsigned)(uintptr_t)lds;
    const unsigned wpiece = __builtin_amdgcn_readfirstlane(wave) * 4096u;
    f32x16 acc[2][2], tot[2][2];
#pragma unroll
    for (int a = 0; a < 2; ++a)
#pragma unroll
        for (int b = 0; b < 2; ++b)
#pragma unroll
            for (int i = 0; i < 16; ++i) { acc[a][b][i] = 0.f; tot[a][b][i] = 0.f; }
    const float* gtab = (const float*)(lds + 65536);
    if (KGROUP > 0) epi.table((float*)(lds + 65536), m0, tid);
    const int nk = K >> 6;
#define GDMA(KT, BUF) do { const unsigned _d = lbase + (BUF) * 32768u + wpiece; const int _ko = (KT) * 128; \
        glds16(xsrc[0] + _ko, _d); glds16(xsrc[1] + _ko, _d + 1024u); glds16(xsrc[2] + _ko, _d + 2048u); glds16(xsrc[3] + _ko, _d + 3072u); \
        glds16(wsrc[0] + _ko, _d + 16384u); glds16(wsrc[1] + _ko, _d + 17408u); glds16(wsrc[2] + _ko, _d + 18432u); glds16(wsrc[3] + _ko, _d + 19456u); } while (0)
    GDMA(0, 0);
    asm volatile("s_waitcnt vmcnt(0)" ::: "memory");
    __syncthreads();
    for (int kt = 0; kt < nk; ++kt) {
        if (kt + 1 < nk) GDMA(kt + 1, (kt + 1) & 1);
        const char* xs = lds + (kt & 1) * 32768; const char* ws = xs + 16384;
#pragma unroll
        for (int ks = 0; ks < 4; ++ks) {
            bf16x8 xf[2], wf[2];
#pragma unroll
            for (int mt = 0; mt < 2; ++mt) { const int r = wm * 64 + mt * 32 + r32; xf[mt] = *(const bf16x8*)(xs + r * 128 + (((ks * 2 + hh) ^ ((r >> 1) & 7)) << 4)); }
#pragma unroll
            for (int nt = 0; nt < 2; ++nt) { const int r = wn * 64 + nt * 32 + r32; wf[nt] = *(const bf16x8*)(ws + r * 128 + (((ks * 2 + hh) ^ ((r >> 1) & 7)) << 4)); }
#pragma unroll
            for (int mt = 0; mt < 2; ++mt)
#pragma unroll
                for (int nt = 0; nt < 2; ++nt) acc[mt][nt] = __builtin_amdgcn_mfma_f32_32x32x16_bf16(xf[mt], wf[nt], acc[mt][nt], 0, 0, 0);
        }
        if (KGROUP > 0) {
            if (((kt + 1) % (KGROUP > 0 ? KGROUP : 1)) == 0) {
                const int g = kt / (KGROUP > 0 ? KGROUP : 1);
#pragma unroll
                for (int mt = 0; mt < 2; ++mt)
#pragma unroll
                    for (int i = 0; i < 16; ++i) {
                        const float sc = gtab[(wm * 64 + mt * 32 + crow(i, hh)) * 4 + g];
#pragma unroll
                        for (int nt = 0; nt < 2; ++nt) { tot[mt][nt][i] += sc * acc[mt][nt][i]; acc[mt][nt][i] = 0.f; }
                    }
            }
        }
        asm volatile("s_waitcnt vmcnt(0)" ::: "memory");
        __syncthreads();
    }
#undef GDMA
    float* ct = (float*)lds;
#pragma unroll
    for (int mt = 0; mt < 2; ++mt)
#pragma unroll
        for (int nt = 0; nt < 2; ++nt)
#pragma unroll
            for (int i = 0; i < 16; ++i)
                ct[(wm * 64 + mt * 32 + crow(i, hh)) * CT_STRIDE + wn * 64 + nt * 32 + r32] = (KGROUP > 0) ? tot[mt][nt][i] : acc[mt][nt][i];
    __syncthreads();
    epi.begin(ct, m0, n0, tid);
#pragma unroll
    for (int pass = 0; pass < 8; ++pass) {
        const int half = pass & 1, row = (pass >> 1) * 32 + (tid >> 3), c = tid & 7;
        epi.chunk(ct + row * CT_STRIDE + half * 64 + c * 8, m0 + row, n0 + half * 64, c, row);
    }
    __syncthreads();
}

template <class Epi, int KGROUP>
__device__ __forceinline__ void gemm_phase_rows(const bf16_t* X, int ldx, const bf16_t* W, int ldw, int M, int N, int K, char* lds, const Epi& epi) {
    const int ntm = M >> 7, ntn = (N + 127) >> 7, nt_tot = ntm * ntn;
    for (int tile = blockIdx.x; tile < nt_tot; tile += gridDim.x) {
        int mt, nt;
        if ((gridDim.x & 7) == 0 && ((gridDim.x >> 3) & 63) == 0) tile_map(tile, ntm, ntn, mt, nt);
        else { mt = tile / ntn; nt = tile % ntn; }
        if (mt < ntm && nt < ntn) gemm_tile_rows<Epi, KGROUP>(X, ldx, W, ldw, K, mt * 128, nt * 128, N, lds, epi);
    }
}

__device__ __forceinline__ uint4 pack8(const float4& a, const float4& b) { return make_uint4(cvtpk(a.x, a.y), cvtpk(a.z, a.w), cvtpk(b.x, b.y), cvtpk(b.z, b.w)); }
__device__ __forceinline__ float sum8(float v) { v += __shfl_xor(v, 1); v += __shfl_xor(v, 2); v += __shfl_xor(v, 4); return v; }

struct RowsStoreBf16 {
    bf16_t* C; int ldc; int N;
    __device__ __forceinline__ void table(float*, int, int) const {}
    __device__ __forceinline__ void begin(float*, int, int, int) const {}
    __device__ __forceinline__ void chunk(const float* t, int m, int n, int c, int) const {
        if (n + 8 * c < N) *(uint4*)(C + (size_t)m * ldc + n + 8 * c) = pack8(*(const float4*)t, *(const float4*)(t + 4));
    }
};
struct RowsResidF32 {
    float* X; int ldx;
    __device__ __forceinline__ void table(float*, int, int) const {}
    __device__ __forceinline__ void begin(float*, int, int, int) const {}
    __device__ __forceinline__ void chunk(const float* t, int m, int n, int c, int) const {
        float* px = X + (size_t)m * ldx + n + 8 * c;
        float4 v0 = *(const float4*)px, v1 = *(const float4*)(px + 4);
        const float4 a0 = *(const float4*)t, a1 = *(const float4*)(t + 4);
        v0.x += a0.x; v0.y += a0.y; v0.z += a0.z; v0.w += a0.w; v1.x += a1.x; v1.y += a1.y; v1.z += a1.z; v1.w += a1.w;
        *(float4*)px = v0; *(float4*)(px + 4) = v1;
    }
};
struct RowsResidNorm {
    float* X; int ldx; bf16_t* XB; float* ssq;
    __device__ __forceinline__ void table(float*, int, int) const {}
    __device__ __forceinline__ void begin(float*, int, int, int) const {}
    __device__ __forceinline__ void chunk(const float* t, int m, int n, int c, int) const {
        float* px = X + (size_t)m * ldx + n + 8 * c;
        float4 v0 = *(const float4*)px, v1 = *(const float4*)(px + 4);
        const float4 a0 = *(const float4*)t, a1 = *(const float4*)(t + 4);
        v0.x += a0.x; v0.y += a0.y; v0.z += a0.z; v0.w += a0.w; v1.x += a1.x; v1.y += a1.y; v1.z += a1.z; v1.w += a1.w;
        *(float4*)px = v0; *(float4*)(px + 4) = v1;
        *(uint4*)(XB + (size_t)m * ldx + n + 8 * c) = pack8(v0, v1);
        const float sq = sum8((v0.x * v0.x + v0.y * v0.y) + (v0.z * v0.z + v0.w * v0.w) + (v1.x * v1.x + v1.y * v1.y) + (v1.z * v1.z + v1.w * v1.w));
        if (c == 0) ssq[((size_t)(n >> 7) * T_TOK + m) * 2 + ((n >> 6) & 1)] = sq;
    }
};
struct RowsStoreBf16RowNorm {
    bf16_t* C; int ldc; const float* ssq;
    __device__ __forceinline__ void table(float*, int, int) const {}
    __device__ __forceinline__ void begin(float* ct, int m0, int, int tid) const {
        if (tid < 128) {
            float tot = 0.f;
#pragma unroll
            for (int j = 0; j < 8; ++j) { const float2 q = *(const float2*)(ssq + ((size_t)j * T_TOK + m0 + tid) * 2); tot += q.x + q.y; }
            ct[tid * CT_STRIDE + 128] = rsqrtf(tot * (1.f / DM) + 1e-6f);
        }
        __syncthreads();
    }
    __device__ __forceinline__ void chunk(const float* t, int m, int n, int c, int row) const {
        const float r = (t - (n & 64) - 8 * c)[128];
        const float4 a = *(const float4*)t, b = *(const float4*)(t + 4);
        *(uint4*)(C + (size_t)m * ldc + n + 8 * c) = make_uint4(cvtpk(a.x * r, a.y * r), cvtpk(a.z * r, a.w * r), cvtpk(b.x * r, b.y * r), cvtpk(b.z * r, b.w * r));
    }
};

struct F8 { float4 a, b; };
__device__ __forceinline__ F8 f8_load(const float* p) { F8 r; r.a = *(const float4*)p; r.b = *(const float4*)(p + 4); return r; }
__device__ __forceinline__ F8 f8_shfl_xor(const F8& v, int m) {
    F8 r; r.a.x = __shfl_xor(v.a.x, m); r.a.y = __shfl_xor(v.a.y, m); r.a.z = __shfl_xor(v.a.z, m); r.a.w = __shfl_xor(v.a.w, m);
    r.b.x = __shfl_xor(v.b.x, m); r.b.y = __shfl_xor(v.b.y, m); r.b.z = __shfl_xor(v.b.z, m); r.b.w = __shfl_xor(v.b.w, m); return r;
}
__device__ __forceinline__ float f8_ssq(const F8& v) { return (v.a.x * v.a.x + v.a.y * v.a.y) + (v.a.z * v.a.z + v.a.w * v.a.w) + (v.b.x * v.b.x + v.b.y * v.b.y) + (v.b.z * v.b.z + v.b.w * v.b.w); }
__device__ __forceinline__ uint4 f8_rope_pack(const F8& v, const F8& pv, const F8& cs, const F8& sn, float sg, float sc) {
    return make_uint4(cvtpk((v.a.x * cs.a.x + sg * pv.a.x * sn.a.x) * sc, (v.a.y * cs.a.y + sg * pv.a.y * sn.a.y) * sc),
                      cvtpk((v.a.z * cs.a.z + sg * pv.a.z * sn.a.z) * sc, (v.a.w * cs.a.w + sg * pv.a.w * sn.a.w) * sc),
                      cvtpk((v.b.x * cs.b.x + sg * pv.b.x * sn.b.x) * sc, (v.b.y * cs.b.y + sg * pv.b.y * sn.b.y) * sc),
                      cvtpk((v.b.z * cs.b.z + sg * pv.b.z * sn.b.z) * sc, (v.b.w * cs.b.w + sg * pv.b.w * sn.b.w) * sc));
}
#define QKV_MIX(mi) ((size_t)(mi) * 512 * T_TOK)
#define QKV_K (256 * (size_t)T_TOK)
#define QKV_V (384 * (size_t)T_TOK)
#define QKV_KD (1920 * (size_t)T_TOK)
struct RowsPostZ {
    bf16_t* qkv; const float* tb; const float* g_qn; const float* g_kn; bf16_t* lat; float* ssqd;
    __device__ __forceinline__ void table(float*, int, int) const {}
    __device__ __forceinline__ void begin(float*, int, int, int) const {}
    __device__ __forceinline__ void chunk(const float* t, int m, int n, int c, int) const {
        const int qc = n >> 6;
        const int b = m / SEQ, s = m % SEQ;
        F8 v = f8_load(t);
        const float scA = 0.125f * LOG2E;
        if (qc < 6 || (qc >= 16 && qc < 22)) {
            const int mi = qc >= 16 ? 2 : 0; const int ql = qc - 8 * mi;
            const F8 pv = f8_shfl_xor(v, 4);
            const int j0 = 8 * (c & 3);
            const F8 cs = f8_load(tb + s * 32 + j0), sn = f8_load(tb + 131072 + s * 32 + j0);
            const size_t off = QKV_MIX(mi) + (ql < 4 ? ((size_t)(b * 4 + ql) * SEQ + s) * 64 : QKV_K + ((size_t)(b * 2 + (ql - 4)) * SEQ + s) * 64);
            *(uint4*)(qkv + off + 8 * c) = f8_rope_pack(v, pv, cs, sn, (c < 4) ? -1.f : 1.f, (ql < 4) ? scA : 1.f);
        } else if (qc == 6 || qc == 7 || qc == 14 || qc == 15 || qc == 22 || qc == 23) {
            *(uint4*)(qkv + QKV_MIX(qc >> 3) + QKV_V + ((size_t)(b * 2 + (qc & 1)) * SEQ + s) * 64 + 8 * c) = pack8(v.a, v.b);
        } else if (qc >= 8 && qc < 14) {
            const bool isq = qc < 12; const int h = isq ? qc - 8 : qc - 12;
            const float r = rsqrtf(sum8(f8_ssq(v)) * (1.f / 64.f) + 1e-6f);
            const F8 gq = f8_load(g_qn + 8 * c), gk = f8_load(g_kn + 8 * c);
            v.a.x *= r * (isq ? gq.a.x : gk.a.x); v.a.y *= r * (isq ? gq.a.y : gk.a.y); v.a.z *= r * (isq ? gq.a.z : gk.a.z); v.a.w *= r * (isq ? gq.a.w : gk.a.w);
            v.b.x *= r * (isq ? gq.b.x : gk.b.x); v.b.y *= r * (isq ? gq.b.y : gk.b.y); v.b.z *= r * (isq ? gq.b.z : gk.b.z); v.b.w *= r * (isq ? gq.b.w : gk.b.w);
            const F8 pv = f8_shfl_xor(v, 2);
            const int jj0 = 8 * (c & 1);
            const int to = (c < 4) ? 393216 + (s >> 6) * 16 : 395264 + (s & 63) * 16;
            const F8 cs = f8_load(tb + to + jj0), sn = f8_load(tb + to + 1024 + jj0);
            const size_t off = QKV_MIX(1) + (isq ? ((size_t)(b * 4 + h) * SEQ + s) * 64 : QKV_K + ((size_t)(b * 2 + h) * SEQ + s) * 64);
            *(uint4*)(qkv + off + 8 * c) = f8_rope_pack(v, pv, cs, sn, (c & 2) ? 1.f : -1.f, isq ? scA : 1.f);
        } else if (qc >= 24 && qc < 30) {
            const float ss = sum8(f8_ssq(v));
            const size_t off = qc < 28 ? (size_t)m * 256 + (qc - 24) * 64 : (size_t)T_TOK * 256 + (size_t)m * 128 + (qc - 28) * 64;
            *(uint4*)(lat + off + 8 * c) = pack8(v.a, v.b);
            if (c == 0) ssqd[(size_t)(qc - 24) * T_TOK + m] = ss;
        } else if (qc == 30) {
            const F8 pv = f8_shfl_xor(v, 2);
            if (c < 4) {
                const int i0 = 8 * (c & 1);
                const F8 cs = f8_load(tb + 262144 + s * 16 + i0), sn = f8_load(tb + 327680 + s * 16 + i0);
                const uint4 w = f8_rope_pack(v, pv, cs, sn, (c & 2) ? 1.f : -1.f, 1.f);
#pragma unroll
                for (int h = 0; h < 4; ++h) *(uint4*)(qkv + QKV_KD + ((size_t)(b * 4 + h) * SEQ + s) * 96 + 64 + 8 * c) = w;
            }
        }
    }
};
template <int NS, int DIM>
struct RowsStoreBf16Scale {
    bf16_t* C; int ldc; int N; const float* ssq;
    __device__ __forceinline__ void table(float*, int, int) const {}
    __device__ __forceinline__ void begin(float* ct, int m0, int, int tid) const {
        if (tid < 128) {
            float tot = 0.f;
#pragma unroll
            for (int j = 0; j < NS; ++j) tot += ssq[(size_t)j * T_TOK + m0 + tid];
            ct[tid * CT_STRIDE + 128] = rsqrtf(tot * (1.f / DIM) + 1e-6f);
        }
        __syncthreads();
    }
    __device__ __forceinline__ void chunk(const float* t, int m, int n, int c, int) const {
        const float r = (t - (n & 64) - 8 * c)[128];
        const float4 a = *(const float4*)t, b = *(const float4*)(t + 4);
        if (n + 8 * c < N) *(uint4*)(C + (size_t)m * ldc + n + 8 * c) = make_uint4(cvtpk(a.x * r, a.y * r), cvtpk(a.z * r, a.w * r), cvtpk(b.x * r, b.y * r), cvtpk(b.z * r, b.w * r));
    }
};

template <class Epi>
__device__ __forceinline__ void gemm_phase(const bf16_t* X, int ldx, const bf16_t* W, int ldw, int M, int N, int K, char* lds, const Epi& epi) {
    const int ntm = M >> 7, ntn = (N + 127) >> 7, nt_tot = ntm * ntn;
    for (int tile = blockIdx.x; tile < nt_tot; tile += gridDim.x) {
        int mt, nt;
        if ((gridDim.x & 7) == 0 && (gridDim.x >> 3) * 8 == gridDim.x && ((gridDim.x >> 3) & 63) == 0) tile_map(tile, ntm, ntn, mt, nt);
        else { mt = tile / ntn; nt = tile % ntn; }
        if (mt < ntm && nt < ntn) gemm_tile(X, ldx, W, ldw, K, mt * 128, nt * 128, N, lds, epi);
    }
}

template <int OFF> __device__ __forceinline__ s16x4 tr_read(int vb) {
    s16x4 r; asm volatile("ds_read_b64_tr_b16 %0, %1 offset:%2" : "=&v"(r) : "v"(vb), "i"(OFF) : "memory"); return r;
}
#define VS_BYTES 192

template <int KT2>
__device__ __forceinline__ void pv_sub(f32x16 (&o)[2], const f32x16& p, int vbase) {
    bf16x8 pf[2];
#pragma unroll
    for (int s2 = 0; s2 < 2; ++s2) {
        unsigned a = cvtpk(p[8 * s2 + 0], p[8 * s2 + 1]), b = cvtpk(p[8 * s2 + 2], p[8 * s2 + 3]);
        unsigned c = cvtpk(p[8 * s2 + 4], p[8 * s2 + 5]), d = cvtpk(p[8 * s2 + 6], p[8 * s2 + 7]);
        uint4 w = make_uint4(a, b, c, d);
        pf[s2] = *(bf16x8*)&w;
    }
    {
        s16x4 l00 = tr_read<(KT2 * 32 + 0) * VS_BYTES + 0>(vbase), h00 = tr_read<(KT2 * 32 + 8) * VS_BYTES + 0>(vbase);
        s16x4 l01 = tr_read<(KT2 * 32 + 0) * VS_BYTES + 64>(vbase), h01 = tr_read<(KT2 * 32 + 8) * VS_BYTES + 64>(vbase);
        s16x4 l10 = tr_read<(KT2 * 32 + 16) * VS_BYTES + 0>(vbase), h10 = tr_read<(KT2 * 32 + 24) * VS_BYTES + 0>(vbase);
        s16x4 l11 = tr_read<(KT2 * 32 + 16) * VS_BYTES + 64>(vbase), h11 = tr_read<(KT2 * 32 + 24) * VS_BYTES + 64>(vbase);
        asm volatile("s_waitcnt lgkmcnt(0)" ::: "memory");
        __builtin_amdgcn_sched_barrier(0);
#define PKV(L, H) (bf16x8){L[0], L[1], L[2], L[3], H[0], H[1], H[2], H[3]}
        o[0] = __builtin_amdgcn_mfma_f32_32x32x16_bf16(PKV(l00, h00), pf[0], o[0], 0, 0, 0);
        o[1] = __builtin_amdgcn_mfma_f32_32x32x16_bf16(PKV(l01, h01), pf[0], o[1], 0, 0, 0);
        o[0] = __builtin_amdgcn_mfma_f32_32x32x16_bf16(PKV(l10, h10), pf[1], o[0], 0, 0, 0);
        o[1] = __builtin_amdgcn_mfma_f32_32x32x16_bf16(PKV(l11, h11), pf[1], o[1], 0, 0, 0);
#undef PKV
    }
}


#define PV_LOAD(KT2, VB, F) \
    const s16x4 F##0 = tr_read<((KT2) * 32 + 0) * VS_BYTES + 0>(VB), F##1 = tr_read<((KT2) * 32 + 8) * VS_BYTES + 0>(VB), \
                F##2 = tr_read<((KT2) * 32 + 0) * VS_BYTES + 64>(VB), F##3 = tr_read<((KT2) * 32 + 8) * VS_BYTES + 64>(VB), \
                F##4 = tr_read<((KT2) * 32 + 16) * VS_BYTES + 0>(VB), F##5 = tr_read<((KT2) * 32 + 24) * VS_BYTES + 0>(VB), \
                F##6 = tr_read<((KT2) * 32 + 16) * VS_BYTES + 64>(VB), F##7 = tr_read<((KT2) * 32 + 24) * VS_BYTES + 64>(VB)
#define PKV2(L, H) (bf16x8){L[0], L[1], L[2], L[3], H[0], H[1], H[2], H[3]}
#define PV_MMA(O, P, F) do { bf16x8 _pf0, _pf1; \
        { uint4 _w = make_uint4(cvtpk(P[0], P[1]), cvtpk(P[2], P[3]), cvtpk(P[4], P[5]), cvtpk(P[6], P[7])); _pf0 = *(bf16x8*)&_w; } \
        { uint4 _w = make_uint4(cvtpk(P[8], P[9]), cvtpk(P[10], P[11]), cvtpk(P[12], P[13]), cvtpk(P[14], P[15])); _pf1 = *(bf16x8*)&_w; } \
        O[0] = __builtin_amdgcn_mfma_f32_32x32x16_bf16(PKV2(F##0, F##1), _pf0, O[0], 0, 0, 0); \
        O[1] = __builtin_amdgcn_mfma_f32_32x32x16_bf16(PKV2(F##2, F##3), _pf0, O[1], 0, 0, 0); \
        O[0] = __builtin_amdgcn_mfma_f32_32x32x16_bf16(PKV2(F##4, F##5), _pf1, O[0], 0, 0, 0); \
        O[1] = __builtin_amdgcn_mfma_f32_32x32x16_bf16(PKV2(F##6, F##7), _pf1, O[1], 0, 0, 0); } while (0)

template <int DK, int G, bool WINDOW>
__device__ __forceinline__ void attn_item(const bf16_t* __restrict__ Q, const bf16_t* __restrict__ K, const bf16_t* __restrict__ V, const float* __restrict__ sink,
                                          bf16_t* __restrict__ O, int ocol, int H, int KV, int item, char* lds) {
    constexpr int KS = DK * 2 + 16;
    constexpr int KCH = DK / 8;
    constexpr int KLD = (64 * KCH) / 256;
    constexpr int QB = 128 / G;
    constexpr int NCH = SEQ / QB;
    constexpr int KBUF = 64 * KS, VBUF = 64 * VS_BYTES;
    const int tid = tid_opaque(), lane = tid & 63, wave = tid >> 6;
    const int r32 = lane & 31, hh = lane >> 5;
    const int chunk = item % NCH, kvh = (item / NCH) % KV, b = item / (NCH * KV);
    const int g = (G == 2) ? (wave >> 1) : 0;
    const int qoff = (G == 2) ? (wave & 1) * 32 : wave * 32;
    const int head = kvh * G + g;
    const int q0 = chunk * QB;
    const int qpos = q0 + qoff + r32;
    bf16x8 qf[DK / 16];
    {
        const bf16_t* qp = Q + ((size_t)(b * H + head) * SEQ + qpos) * DK + hh * 8;
#pragma unroll
        for (int ks = 0; ks < DK / 16; ++ks) qf[ks] = *(const bf16x8*)(qp + ks * 16);
    }
    int kt_lo = 0, kt_hi = SEQ / 64;
    if (WINDOW) { kt_lo = q0 / 64 - 2; if (kt_lo < 0) kt_lo = 0; kt_hi = (q0 + QB) / 64 + 2; if (kt_hi > SEQ / 64) kt_hi = SEQ / 64; }
    const char* Kg = (const char*)(K + (size_t)(b * KV + kvh) * SEQ * DK);
    const char* Vg = (const char*)(V + (size_t)(b * KV + kvh) * SEQ * 64);
    uint4 kr0, kr1, kr2 = make_uint4(0, 0, 0, 0), vr0, vr1;
    int koff[KLD], voff[2];
#pragma unroll
    for (int j = 0; j < KLD; ++j) { const int id = tid + 256 * j; koff[j] = (id / KCH) * KS + (id % KCH) * 16; }
#pragma unroll
    for (int j = 0; j < 2; ++j) { const int id = tid + 256 * j; voff[j] = (id >> 3) * VS_BYTES + (id & 7) * 16; }
    f32x16 o[2];
#pragma unroll
    for (int d = 0; d < 2; ++d)
#pragma unroll
        for (int i = 0; i < 16; ++i) o[d][i] = 0.f;
    float m = -1e30f, l = 0.f;
    if (WINDOW) { m = sink[head] * LOG2E; l = (hh == 0) ? 1.f : 0.f; }
    const int gg = lane >> 4, li = lane & 15;
    const int vlane = (4 * (gg >> 1) + (li >> 2)) * VS_BYTES + (16 * (gg & 1) + 4 * (li & 3)) * 2;
    char* Kl = lds; char* Vl = lds + 2 * KBUF;
#define AGLOAD(KT) do { const char* _kg = Kg + (size_t)(KT) * 64 * DK * 2; const char* _vg = Vg + (size_t)(KT) * 64 * 128; \
        kr0 = *(const uint4*)(_kg + tid * 16); kr1 = *(const uint4*)(_kg + (tid + 256) * 16); if (KLD > 2) kr2 = *(const uint4*)(_kg + (tid + 512) * 16); \
        vr0 = *(const uint4*)(_vg + tid * 16); vr1 = *(const uint4*)(_vg + (tid + 256) * 16); } while (0)
#define ASTORE(KB, VB) do { char* _kd = (KB); char* _vd = (VB); *(uint4*)(_kd + koff[0]) = kr0; *(uint4*)(_kd + koff[1]) = kr1; if (KLD > 2) *(uint4*)(_kd + koff[KLD - 1]) = kr2; \
        *(uint4*)(_vd + voff[0]) = vr0; *(uint4*)(_vd + voff[1]) = vr1; } while (0)
    AGLOAD(kt_lo);
    ASTORE(Kl, Vl);
    { const int k1 = kt_lo + 1 < kt_hi ? kt_lo + 1 : kt_lo; AGLOAD(k1); }
    __syncthreads();
    for (int kt = kt_lo; kt < kt_hi; ++kt) {
        const int cur = (kt - kt_lo) & 1;
        ASTORE(Kl + (cur ^ 1) * KBUF, Vl + (cur ^ 1) * VBUF);
        { const int ktn = kt + 2 < kt_hi ? kt + 2 : kt_hi - 1; AGLOAD(ktn); }
        __builtin_amdgcn_sched_barrier(0);
        const char* kb = Kl + cur * KBUF;
        f32x16 s0, s1;
#pragma unroll
        for (int i = 0; i < 16; ++i) { s0[i] = 0.f; s1[i] = 0.f; }
#pragma unroll
        for (int ks = 0; ks < DK / 16; ++ks) {
            bf16x8 k0 = *(const bf16x8*)(kb + r32 * KS + (ks * 2 + hh) * 16);
            bf16x8 k1 = *(const bf16x8*)(kb + (32 + r32) * KS + (ks * 2 + hh) * 16);
            s0 = __builtin_amdgcn_mfma_f32_32x32x16_bf16(k0, qf[ks], s0, 0, 0, 0);
            s1 = __builtin_amdgcn_mfma_f32_32x32x16_bf16(k1, qf[ks], s1, 0, 0, 0);
        }
        if (WINDOW) {
            const int kb0 = kt * 64 + 4 * hh - qpos;
#pragma unroll
            for (int i = 0; i < 16; ++i) {
                const int d0 = kb0 + (i & 3) + 8 * (i >> 2), d1 = d0 + 32;
                s0[i] = (d0 > 128 || d0 < -128) ? -1e30f : s0[i];
                s1[i] = (d1 > 128 || d1 < -128) ? -1e30f : s1[i];
            }
        }
        const int vbase = (int)(size_t)(Vl + cur * VBUF - lds) + vlane;
        PV_LOAD(0, vbase, vfa);
        PV_LOAD(1, vbase, vfb);
        __builtin_amdgcn_sched_barrier(0);
        float tmax = s0[0];
#pragma unroll
        for (int i = 1; i < 16; ++i) tmax = fmaxf(tmax, s0[i]);
#pragma unroll
        for (int i = 0; i < 16; ++i) tmax = fmaxf(tmax, s1[i]);
        tmax = xhalf_max(tmax);
        const float mn = fmaxf(m, tmax);
        const float alpha = __builtin_amdgcn_exp2f(m - mn);
        m = mn;
        float ps = 0.f;
#pragma unroll
        for (int i = 0; i < 16; ++i) { s0[i] = __builtin_amdgcn_exp2f(s0[i] - mn); ps += s0[i]; }
#pragma unroll
        for (int i = 0; i < 16; ++i) { s1[i] = __builtin_amdgcn_exp2f(s1[i] - mn); ps += s1[i]; }
        l = l * alpha + ps;
        if (__any(alpha != 1.f)) {
#pragma unroll
            for (int d = 0; d < 2; ++d)
#pragma unroll
                for (int i = 0; i < 16; ++i) o[d][i] *= alpha;
        }
        asm volatile("s_waitcnt lgkmcnt(0)" ::: "memory");
        __builtin_amdgcn_sched_barrier(0);
        PV_MMA(o, s0, vfa);
        PV_MMA(o, s1, vfb);
        __syncthreads();
    }
#undef AGLOAD
#undef ASTORE
    l = xhalf_sum(l);
    const float inv = 1.f / l;
    bf16_t* orow = O + (size_t)(b * SEQ + qpos) * DM + ocol + head * 64;
#pragma unroll
    for (int d = 0; d < 2; ++d)
#pragma unroll
        for (int gq = 0; gq < 4; ++gq) {
            uint2 w;
            w.x = cvtpk(o[d][gq * 4 + 0] * inv, o[d][gq * 4 + 1] * inv);
            w.y = cvtpk(o[d][gq * 4 + 2] * inv, o[d][gq * 4 + 3] * inv);
            *(uint2*)(orow + d * 32 + 8 * gq + 4 * hh) = w;
        }
}

__device__ __forceinline__ void dil_wave_item(const bf16_t* __restrict__ Q, const bf16_t* __restrict__ K, const bf16_t* __restrict__ V,
                                              bf16_t* __restrict__ O, int witem, char* wlds, int lds_off) {
    const int lane = tid_opaque() & 63, r32 = lane & 31, hh = lane >> 5;
    const int c = witem & 15, chunk = (witem >> 4) & 15, kvh = (witem >> 8) & 1, b = witem >> 9;
    const int t0 = chunk * 256;
    const int mq = r32 & 15, g = r32 >> 4;
    const int qpos = t0 + 16 * mq + c, head = kvh * 2 + g;
    bf16x8 qf[4];
    {
        const bf16_t* qp = Q + ((size_t)(b * 4 + head) * SEQ + qpos) * 64 + hh * 8;
#pragma unroll
        for (int ks = 0; ks < 4; ++ks) qf[ks] = *(const bf16x8*)(qp + ks * 16);
    }
    const bf16_t* Kg = K + (size_t)(b * 2 + kvh) * SEQ * 64;
    const bf16_t* Vg = V + (size_t)(b * 2 + kvh) * SEQ * 64;
    f32x16 o[2];
#pragma unroll
    for (int d = 0; d < 2; ++d)
#pragma unroll
        for (int i = 0; i < 16; ++i) o[d][i] = 0.f;
    float m = -1e30f, l = 0.f;
    const int gg = lane >> 4, li = lane & 15;
    const int vlane = lds_off + (4 * (gg >> 1) + (li >> 2)) * VS_BYTES + (16 * (gg & 1) + 4 * (li & 3)) * 2;
    for (int it = 0; it < 23; ++it) {
        int sh, j;
        if (it < 12) { sh = 0; j = it; } else if (it < 18) { sh = 2; j = it - 12; } else { sh = 4; j = it - 18; }
        const int rr = 1 << sh;
        const int cc = c & (rr - 1);
        const int idx0 = (t0 >> sh) - 64 + 32 * j;
        const int lim = SEQ >> sh;
        if (idx0 + 31 < 0 || idx0 >= lim) continue;
        bf16x8 kf[4];
        {
            int idx = idx0 + r32; idx = idx < 0 ? 0 : (idx >= lim ? lim - 1 : idx);
            const bf16_t* kp = Kg + (size_t)((idx << sh) + cc) * 64 + hh * 8;
#pragma unroll
            for (int ks = 0; ks < 4; ++ks) kf[ks] = *(const bf16x8*)(kp + ks * 16);
        }
        uint4 vr[4];
#pragma unroll
        for (int jj = 0; jj < 4; ++jj) {
            const int id = lane + 64 * jj; int idx = idx0 + (id >> 3); idx = idx < 0 ? 0 : (idx >= lim ? lim - 1 : idx);
            vr[jj] = *(const uint4*)(Vg + (size_t)((idx << sh) + cc) * 64 + (id & 7) * 8);
        }
#pragma unroll
        for (int jj = 0; jj < 4; ++jj) { const int id = lane + 64 * jj; *(uint4*)(wlds + (id >> 3) * VS_BYTES + (id & 7) * 16) = vr[jj]; }
        f32x16 s;
#pragma unroll
        for (int i = 0; i < 16; ++i) s[i] = 0.f;
#pragma unroll
        for (int ks = 0; ks < 4; ++ks) s = __builtin_amdgcn_mfma_f32_32x32x16_bf16(kf[ks], qf[ks], s, 0, 0, 0);
        const int qidx = qpos >> sh;
        const int base = idx0 + 4 * hh;
#pragma unroll
        for (int i = 0; i < 16; ++i) {
            const int idx = base + (i & 3) + 8 * (i >> 2);
            const int d = idx - qidx;
            s[i] = (d > 64 || d < -64 || idx < 0 || idx >= lim) ? -1e30f : s[i];
        }
        float tmax = s[0];
#pragma unroll
        for (int i = 1; i < 16; ++i) tmax = fmaxf(tmax, s[i]);
        tmax = fmaxf(tmax, xhalf(tmax));
        const float mn = fmaxf(fmaxf(m, tmax), -1e20f);
        const float alpha = __builtin_amdgcn_exp2f(m - mn);
        m = mn;
        float ps = 0.f;
#pragma unroll
        for (int i = 0; i < 16; ++i) { s[i] = __builtin_amdgcn_exp2f(s[i] - mn); ps += s[i]; }
        l = l * alpha + ps;
#pragma unroll
        for (int d = 0; d < 2; ++d)
#pragma unroll
            for (int i = 0; i < 16; ++i) o[d][i] *= alpha;
        pv_sub<0>(o, s, vlane);
    }
    l += xhalf(l);
    const float inv = 1.f / l;
    bf16_t* orow = O + (size_t)(b * SEQ + qpos) * DM + 512 + head * 64;
#pragma unroll
    for (int d = 0; d < 2; ++d)
#pragma unroll
        for (int gq = 0; gq < 4; ++gq) {
            uint2 w;
            w.x = cvtpk(o[d][gq * 4 + 0] * inv, o[d][gq * 4 + 1] * inv);
            w.y = cvtpk(o[d][gq * 4 + 2] * inv, o[d][gq * 4 + 3] * inv);
            *(uint2*)(orow + d * 32 + 8 * gq + 4 * hh) = w;
        }
}

__device__ __forceinline__ int f2key(float f) { int b = __float_as_int(f); return b ^ ((b >> 31) & 0x7fffffff); }
__device__ __forceinline__ float key2f(int k) { return __int_as_float(k ^ ((k >> 31) & 0x7fffffff)); }

template <int N>
__device__ __forceinline__ void bitonic_sort_desc(int (&a)[N]) {
#pragma unroll
    for (int k = 2; k <= N; k <<= 1) {
#pragma unroll
        for (int j = k >> 1; j > 0; j >>= 1) {
#pragma unroll
            for (int i = 0; i < N; ++i) {
                const int l2 = i ^ j;
                if (l2 > i) {
                    const bool up = ((i & k) == 0);
                    const int hi = max(a[i], a[l2]), lo = min(a[i], a[l2]);
                    a[i] = up ? hi : lo; a[l2] = up ? lo : hi;
                }
            }
        }
    }
}
__device__ __forceinline__ void merge_top16(int (&a)[16], const int (&b)[16]) {
#pragma unroll
    for (int i = 0; i < 16; ++i) a[i] = max(a[i], b[15 - i]);
#pragma unroll
    for (int j = 8; j > 0; j >>= 1) {
#pragma unroll
        for (int i = 0; i < 16; ++i) {
            const int l2 = i ^ j;
            if (l2 > i) { const int hi = max(a[i], a[l2]), lo = min(a[i], a[l2]); a[i] = hi; a[l2] = lo; }
        }
    }
}
__device__ __forceinline__ void top16_of_64(int (&g0)[16], int (&g1)[16], int (&g2)[16], int (&g3)[16]) {
    bitonic_sort_desc<16>(g0); bitonic_sort_desc<16>(g1); bitonic_sort_desc<16>(g2); bitonic_sort_desc<16>(g3);
    merge_top16(g0, g1); merge_top16(g2, g3); merge_top16(g0, g2);
}

__device__ __forceinline__ void topk_wave_item(const bf16_t* __restrict__ qp, const bf16_t* __restrict__ subk  ,
                                               int* __restrict__ eidx, float* __restrict__ gate, int witem, char* wlds) {
    const int lane = tid_opaque() & 63, r32 = lane & 31, hh = lane >> 5;
    const int h = witem & 7, tt = witem >> 3;
    const int t = tt * 32 + r32;
    int top[2][16];
#pragma unroll
    for (int c = 0; c < 2; ++c) {
        bf16x8 qf[8];
        const bf16_t* qrow = qp + (size_t)t * 2048 + h * 256 + c * 128 + hh * 8;
#pragma unroll
        for (int ks = 0; ks < 8; ++ks) qf[ks] = *(const bf16x8*)(qrow + ks * 16);
        const bf16_t* kb = subk + ((size_t)(h * 2 + c) * 128 + r32) * 128 + hh * 8;
        int grp[4][16];
#pragma unroll
        for (int kt = 0; kt < 4; ++kt) {
            f32x16 s;
#pragma unroll
            for (int i = 0; i < 16; ++i) s[i] = 0.f;
#pragma unroll
            for (int ks = 0; ks < 8; ++ks) {
                bf16x8 kf = *(const bf16x8*)(kb + (size_t)kt * 32 * 128 + ks * 16);
                s = __builtin_amdgcn_mfma_f32_32x32x16_bf16(kf, qf[ks], s, 0, 0, 0);
            }
#pragma unroll
            for (int i = 0; i < 16; ++i) grp[kt][i] = (f2key(s[i]) & ~127) | (kt * 32 + crow(i, hh));
        }
        top16_of_64(grp[0], grp[1], grp[2], grp[3]);
        int oth[16];
#pragma unroll
        for (int i = 0; i < 16; ++i) oth[i] = __shfl_xor(grp[0][i], 32);
        merge_top16(grp[0], oth);
#pragma unroll
        for (int i = 0; i < 16; ++i) top[c][i] = grp[0][i];
    }
    {
        unsigned* my = (unsigned*)(wlds + lane * 36);
#pragma unroll
        for (int c = 0; c < 2; ++c)
#pragma unroll
            for (int w4 = 0; w4 < 4; ++w4) {
                unsigned v = (top[c][w4 * 4] & 127) | ((top[c][w4 * 4 + 1] & 127) << 8) | ((top[c][w4 * 4 + 2] & 127) << 16) | ((top[c][w4 * 4 + 3] & 127) << 24);
                my[c * 4 + w4] = v;
            }
    }
    float v1[16], v2[16];
#pragma unroll
    for (int i = 0; i < 16; ++i) { v1[i] = key2f(top[0][i] & ~127); v2[i] = key2f(top[1][i] & ~127); }
    int cg[4][16];
    {
        int n = 0;
#pragma unroll
        for (int i = 0; i < 16; ++i)
#pragma unroll
            for (int j = 0; j < 16; ++j)
                if ((i + 1) * (j + 1) <= 16) { cg[n >> 4][n & 15] = (f2key(v1[i] + v2[j]) & ~255) | (i * 16 + j); ++n; }
#pragma unroll
        for (int q = 50; q < 64; ++q) cg[q >> 4][q & 15] = (int)0x80000000;
    }
    top16_of_64(cg[0], cg[1], cg[2], cg[3]);
    float bv[16];
#pragma unroll
    for (int i = 0; i < 16; ++i) bv[i] = key2f(cg[0][i] & ~255);
    float sm = 0.f;
    const float bmx = bv[0];
#pragma unroll
    for (int i = 0; i < 16; ++i) { bv[i] = __expf(bv[i] - bmx); sm += bv[i]; }
    const float inv = 1.f / sm;
    if (hh == 0) {
        const unsigned char* my = (const unsigned char*)(wlds + lane * 36);
        int* eo = eidx + (size_t)t * 128 + h * 16;
        float* go = gate + (size_t)t * 128 + h * 16;
#pragma unroll
        for (int q4 = 0; q4 < 4; ++q4) {
            int4 ev; float4 gv;
            int* evp = (int*)&ev; float* gvp = (float*)&gv;
#pragma unroll
            for (int u = 0; u < 4; ++u) {
                const int code = cg[0][q4 * 4 + u] & 255;
                const int i1 = my[code >> 4], i2 = my[16 + (code & 15)];
                evp[u] = i1 * 128 + i2; gvp[u] = bv[q4 * 4 + u] * inv;
            }
            *(int4*)(eo + q4 * 4) = ev; *(float4*)(go + q4 * 4) = gv;
        }
    }
}

typedef __attribute__((ext_vector_type(2))) float f32x2;
__device__ __forceinline__ float fdot2bf(unsigned a, unsigned b, float acc) {
    return __builtin_amdgcn_fdot2_f32_bf16(*(bf16x2_t*)&a, *(bf16x2_t*)&b, acc, false);
}
__device__ __forceinline__ unsigned fp8pair_to_bf16(unsigned w, bool hi) {
    bf16x2_t r = hi ? __builtin_amdgcn_cvt_scalef32_pk_bf16_fp8((int)w, 1.0f, true) : __builtin_amdgcn_cvt_scalef32_pk_bf16_fp8((int)w, 1.0f, false);
    return *(unsigned*)&r;
}
__device__ __forceinline__ float dot16_fp8(uint4 u, const unsigned (&h)[8]) {
    float a = 0.f;
    a = fdot2bf(fp8pair_to_bf16(u.x, false), h[0], a); a = fdot2bf(fp8pair_to_bf16(u.x, true), h[1], a);
    a = fdot2bf(fp8pair_to_bf16(u.y, false), h[2], a); a = fdot2bf(fp8pair_to_bf16(u.y, true), h[3], a);
    a = fdot2bf(fp8pair_to_bf16(u.z, false), h[4], a); a = fdot2bf(fp8pair_to_bf16(u.z, true), h[5], a);
    a = fdot2bf(fp8pair_to_bf16(u.w, false), h[6], a); a = fdot2bf(fp8pair_to_bf16(u.w, true), h[7], a);
    return a;
}
__device__ __forceinline__ void axpy16_fp8(float (&acc)[16], float w, uint4 v) {
    f32x2 r;
    r = __builtin_amdgcn_cvt_pk_f32_fp8((int)v.x, false); acc[0] += w * r[0]; acc[1] += w * r[1];
    r = __builtin_amdgcn_cvt_pk_f32_fp8((int)v.x, true);  acc[2] += w * r[0]; acc[3] += w * r[1];
    r = __builtin_amdgcn_cvt_pk_f32_fp8((int)v.y, false); acc[4] += w * r[0]; acc[5] += w * r[1];
    r = __builtin_amdgcn_cvt_pk_f32_fp8((int)v.y, true);  acc[6] += w * r[0]; acc[7] += w * r[1];
    r = __builtin_amdgcn_cvt_pk_f32_fp8((int)v.z, false); acc[8] += w * r[0]; acc[9] += w * r[1];
    r = __builtin_amdgcn_cvt_pk_f32_fp8((int)v.z, true);  acc[10] += w * r[0]; acc[11] += w * r[1];
    r = __builtin_amdgcn_cvt_pk_f32_fp8((int)v.w, false); acc[12] += w * r[0]; acc[13] += w * r[1];
    r = __builtin_amdgcn_cvt_pk_f32_fp8((int)v.w, true);  acc[14] += w * r[0]; acc[15] += w * r[1];
}
__device__ __forceinline__ float gelu_exact(float a) { return 0.5f * a * (1.f + erff(a * 0.70710678118654752f)); }

__device__ __forceinline__ float transpose_reduce16(f32x16 p, int lane) {
#pragma unroll
    for (int st = 0; st < 4; ++st) {
        const int o = 32 >> st, n = 16 >> st;
        const bool up = (lane & o) != 0;
#pragma unroll
        for (int i = 0; i < n / 2; ++i) {
            float lo = p[i], hi = p[i + n / 2];
            asm volatile("" : "+v"(lo), "+v"(hi));
            const float keep = up ? hi : lo;
            const float send = up ? lo : hi;
            p[i] = keep + __shfl_xor(send, o);
        }
    }
    float v = p[0];
    v += __shfl_xor(v, 1); v += __shfl_xor(v, 2);
    return v;
}
#define EX_SB() __builtin_amdgcn_sched_barrier(0)
#define EX_LD1(R, TAB, EB, S) R = *(const uint4*)((TAB) + (unsigned)((__builtin_amdgcn_readlane((EB), (S)) << 10) + lane16))
#define EX_LOAD8(P, TAB, EB, SL) do { EX_LD1(P##0, TAB, EB, (SL) + 0); EX_LD1(P##1, TAB, EB, (SL) + 1); EX_LD1(P##2, TAB, EB, (SL) + 2); EX_LD1(P##3, TAB, EB, (SL) + 3); \
        EX_LD1(P##4, TAB, EB, (SL) + 4); EX_LD1(P##5, TAB, EB, (SL) + 5); EX_LD1(P##6, TAB, EB, (SL) + 6); EX_LD1(P##7, TAB, EB, (SL) + 7); } while (0)
#define EX_DOT8(P, PP, O) do { PP[(O) + 0] = dot16_fp8(P##0, hp); PP[(O) + 1] = dot16_fp8(P##1, hp); PP[(O) + 2] = dot16_fp8(P##2, hp); PP[(O) + 3] = dot16_fp8(P##3, hp); \
        PP[(O) + 4] = dot16_fp8(P##4, hp); PP[(O) + 5] = dot16_fp8(P##5, hp); PP[(O) + 6] = dot16_fp8(P##6, hp); PP[(O) + 7] = dot16_fp8(P##7, hp); } while (0)
#define EX_RL(W, S) __int_as_float(__builtin_amdgcn_readlane(__float_as_int(W), (S)))
#define EX_AXPY8(P, W, SL) do { axpy16_fp8(acc, EX_RL(W, (SL) + 0), P##0); axpy16_fp8(acc, EX_RL(W, (SL) + 1), P##1); axpy16_fp8(acc, EX_RL(W, (SL) + 2), P##2); axpy16_fp8(acc, EX_RL(W, (SL) + 3), P##3); \
        axpy16_fp8(acc, EX_RL(W, (SL) + 4), P##4); axpy16_fp8(acc, EX_RL(W, (SL) + 5), P##5); axpy16_fp8(acc, EX_RL(W, (SL) + 6), P##6); axpy16_fp8(acc, EX_RL(W, (SL) + 7), P##7); } while (0)
#define EX_COPY8(D, S_) do { D##0 = S_##0; D##1 = S_##1; D##2 = S_##2; D##3 = S_##3; D##4 = S_##4; D##5 = S_##5; D##6 = S_##6; D##7 = S_##7; } while (0)

__device__ __forceinline__ void expert_token(PC& p, int layer, int t, bool last, bool dummy = false) {
    const int lane = tid_opaque() & 63;
    const int lane16 = lane * 16;
    const float* gfb = p.g_ffn + layer * DM; asm volatile("" : "+s"(gfb));
    const float* gf = gfb + lane * 16;
    float* xrow = p.x + (size_t)t * DM + lane * 16;
    float* xwr = dummy ? (float*)p.zb + (size_t)t * DM + lane * 16 : xrow;
    bf16_t* hwr = (dummy ? p.q.qA + (size_t)t * DM : p.hnb + (size_t)t * DM) + lane * 16;
    float xv[16];
#pragma unroll
    for (int q = 0; q < 4; ++q) { const float4 a = *(const float4*)(xrow + 4 * q); xv[4 * q] = a.x; xv[4 * q + 1] = a.y; xv[4 * q + 2] = a.z; xv[4 * q + 3] = a.w; }
    float ss = 0.f;
#pragma unroll
    for (int i = 0; i < 16; ++i) ss += xv[i] * xv[i];
    ss = wave_sum(ss);
    const float rstd = rsqrtf(ss * (1.f / DM) + 1e-6f);
    unsigned hp[8];
#pragma unroll
    for (int q = 0; q < 4; ++q) {
        const float4 g = *(const float4*)(gf + 4 * q);
        hp[2 * q] = cvtpk(xv[4 * q] * rstd * g.x, xv[4 * q + 1] * rstd * g.y);
        hp[2 * q + 1] = cvtpk(xv[4 * q + 2] * rstd * g.z, xv[4 * q + 3] * rstd * g.w);
    }
    const int e0 = p.eidx[(size_t)t * 128 + lane], e1 = p.eidx[(size_t)t * 128 + 64 + lane];
    const float g0 = p.gate[(size_t)t * 128 + lane], g1 = p.gate[(size_t)t * 128 + 64 + lane];
    const unsigned char* u8 = p.u8 + (size_t)layer * 16384 * DM;
    const unsigned char* v8 = p.v8 + (size_t)layer * 16384 * DM;
    const float* su = p.su + layer * 16384; const float* sv = p.sv + layer * 16384;
    const float su0 = su[e0], su1 = su[e1], sv0 = sv[e0], sv1 = sv[e1];
    uint4 rx0, rx1, rx2, rx3, rx4, rx5, rx6, rx7, ry0, ry1, ry2, ry3, ry4, ry5, ry6, ry7;
    float a0 = 0.f, a1 = 0.f;
    EX_LOAD8(rx, u8, e0, 0);
#pragma unroll 1
    for (int g = 0; g < 8; ++g) {
        const int eb = g < 4 ? e0 : e1;
        const int sl = (g & 3) * 16;
        f32x16 pp;
        EX_LOAD8(ry, u8, eb, sl + 8);
        EX_SB();
        EX_DOT8(rx, pp, 0);
        EX_SB();
        {
            const int gn = g + 1 < 8 ? g + 1 : 0;
            const int ebn = gn < 4 ? e0 : e1;
            const unsigned char* tabn = g + 1 < 8 ? u8 : v8;
            EX_LOAD8(rx, tabn, ebn, (gn & 3) * 16);
        }
        EX_SB();
        EX_DOT8(ry, pp, 8);
        const float v = transpose_reduce16(pp, lane);
        const float got = __shfl(v, (lane & 15) << 2);
        const bool mine = (lane >> 4) == (g & 3);
        a0 = (mine && g < 4) ? got : a0;
        a1 = (mine && g >= 4) ? got : a1;
        EX_SB();
    }
    const float w0 = g0 * gelu_exact(su0 * a0) * sv0;
    const float w1 = g1 * gelu_exact(su1 * a1) * sv1;
    float acc[16];
#pragma unroll
    for (int i = 0; i < 16; ++i) acc[i] = 0.f;
#pragma unroll 1
    for (int h2 = 0; h2 < 8; ++h2) {
        const int ebc = h2 < 4 ? e0 : e1;
        const float wb = h2 < 4 ? w0 : w1;
        const int slc = (h2 & 3) * 16;
        EX_LOAD8(ry, v8, ebc, slc + 8);
        EX_SB();
        EX_AXPY8(rx, wb, slc);
        EX_SB();
        {
            const int hn_ = h2 + 1 < 8 ? h2 + 1 : 7;
            const int ebn = hn_ < 4 ? e0 : e1;
            EX_LOAD8(rx, v8, ebn, (hn_ & 3) * 16);
        }
        EX_SB();
        EX_AXPY8(ry, wb, slc + 8);
        EX_SB();
    }
#pragma unroll
    for (int i = 0; i < 16; ++i) xv[i] += acc[i];
    float s2 = 0.f;
#pragma unroll
    for (int i = 0; i < 16; ++i) s2 += xv[i] * xv[i];
    s2 = wave_sum(s2);
    const float r2 = rsqrtf(s2 * (1.f / DM) + 1e-6f);
    if (!last) {
#pragma unroll
        for (int q = 0; q < 4; ++q) *(float4*)(xwr + 4 * q) = make_float4(xv[4 * q], xv[4 * q + 1], xv[4 * q + 2], xv[4 * q + 3]);
        const float* gnb = p.g_mix + (layer + 1) * DM; asm volatile("" : "+s"(gnb));
        const float* gn = gnb + lane * 16;
        unsigned hw[8];
#pragma unroll
        for (int q = 0; q < 4; ++q) {
            const float4 g = *(const float4*)(gn + 4 * q);
            hw[2 * q] = cvtpk(xv[4 * q] * r2 * g.x, xv[4 * q + 1] * r2 * g.y);
            hw[2 * q + 1] = cvtpk(xv[4 * q + 2] * r2 * g.z, xv[4 * q + 3] * r2 * g.w);
        }
        *(uint4*)(hwr) = make_uint4(hw[0], hw[1], hw[2], hw[3]);
        *(uint4*)(hwr + 8) = make_uint4(hw[4], hw[5], hw[6], hw[7]);
    } else {
        const float* gnb = p.g_final; asm volatile("" : "+s"(gnb));
        const float* gn = gnb + lane * 16;
        float* orow = dummy ? xwr : p.out + (size_t)t * DM + lane * 16;
#pragma unroll
        for (int q = 0; q < 4; ++q) {
            const float4 g = *(const float4*)(gn + 4 * q);
            *(float4*)(orow + 4 * q) = make_float4(xv[4 * q] * r2 * g.x, xv[4 * q + 1] * r2 * g.y, xv[4 * q + 2] * r2 * g.z, xv[4 * q + 3] * r2 * g.w);
        }
    }
}
__device__ __forceinline__ void transpose_tile(const float* __restrict__ src, int K, int N, bf16_t* __restrict__ dst, int tk, int tn, float* tl, const float* __restrict__ ksc) {
    const int tid = tid_opaque(), r = tid >> 6, c = tid & 63;
    const int k0 = tk * 64, n0 = tn * 64;
#pragma unroll
    for (int i = 0; i < 16; ++i) {
        const int kk = i * 4 + r, n = n0 + c;
        tl[kk * 65 + c] = (n < N) ? src[(size_t)(k0 + kk) * N + n] : 0.f;
    }
    __syncthreads();
#pragma unroll
    for (int i = 0; i < 16; ++i) {
        const int nn = i * 4 + r;
        if (n0 + nn < N) dst[(size_t)(n0 + nn) * K + k0 + c] = f2bf(tl[c * 65 + nn] * (ksc ? ksc[k0 + c] : 1.f));
    }
    __syncthreads();
}
__device__ __forceinline__ void transpose_all(const float* src, int K, int N, bf16_t* dst, float* tl, const float* ksc = nullptr) {
    const int ntk = K / 64, ntn = (N + 63) / 64;
    for (int t = blockIdx.x; t < ntk * ntn; t += gridDim.x) transpose_tile(src, K, N, dst, t / ntn, t % ntn, tl, ksc);
}
__device__ __forceinline__ void convert_plain(const float* __restrict__ src, bf16_t* __restrict__ dst, size_t n) {
    const size_t n8 = n >> 3;
    for (size_t i = (size_t)blockIdx.x * blockDim.x + tid_opaque(); i < n8; i += (size_t)gridDim.x * blockDim.x) {
        const float4 a = *(const float4*)(src + i * 8), b = *(const float4*)(src + i * 8 + 4);
        uint4 w; w.x = cvtpk(a.x, a.y); w.y = cvtpk(a.z, a.w); w.z = cvtpk(b.x, b.y); w.w = cvtpk(b.z, b.w);
        *(uint4*)(dst + i * 8) = w;
    }
}
__device__ __forceinline__ void convert_rows_fp8(const float* __restrict__ src, unsigned char* __restrict__ dst, float* __restrict__ scales, int nrows) {
    const int tid = tid_opaque(), wave = tid >> 6, lane = tid & 63;
    for (int row = blockIdx.x * 4 + wave; row < nrows; row += gridDim.x * 4) {
        const float* sr = src + (size_t)row * DM + lane * 16;
        float xv[16];
#pragma unroll
        for (int q = 0; q < 4; ++q) { const float4 a = *(const float4*)(sr + 4 * q); xv[4 * q] = a.x; xv[4 * q + 1] = a.y; xv[4 * q + 2] = a.z; xv[4 * q + 3] = a.w; }
        float am = 0.f;
#pragma unroll
        for (int i = 0; i < 16; ++i) am = fmaxf(am, fabsf(xv[i]));
        am = wave_max(am);
        const float sc = am > 0.f ? am * (1.f / 448.f) : 1.f;
        const float inv = 1.f / sc;
        unsigned w[4];
#pragma unroll
        for (int q = 0; q < 4; ++q) {
            int t = 0;
            t = __builtin_amdgcn_cvt_pk_fp8_f32(xv[4 * q] * inv, xv[4 * q + 1] * inv, t, false);
            t = __builtin_amdgcn_cvt_pk_fp8_f32(xv[4 * q + 2] * inv, xv[4 * q + 3] * inv, t, true);
            w[q] = (unsigned)t;
        }
        *(uint4*)(dst + (size_t)row * DM + lane * 16) = make_uint4(w[0], w[1], w[2], w[3]);
        if (lane == 0) scales[row] = sc;
    }
}
__device__ __forceinline__ void rms_row_bf16(const float* __restrict__ src, const float* __restrict__ g, bf16_t* __restrict__ dst, float* __restrict__ cpy, int lane) {
    float xv[16];
    const float4 a0 = *(const float4*)(src + lane * 8), a1 = *(const float4*)(src + lane * 8 + 4);
    const float4 b0 = *(const float4*)(src + 512 + lane * 8), b1 = *(const float4*)(src + 512 + lane * 8 + 4);
    xv[0] = a0.x; xv[1] = a0.y; xv[2] = a0.z; xv[3] = a0.w; xv[4] = a1.x; xv[5] = a1.y; xv[6] = a1.z; xv[7] = a1.w;
    xv[8] = b0.x; xv[9] = b0.y; xv[10] = b0.z; xv[11] = b0.w; xv[12] = b1.x; xv[13] = b1.y; xv[14] = b1.z; xv[15] = b1.w;
    if (cpy) {
        *(float4*)(cpy + lane * 8) = a0; *(float4*)(cpy + lane * 8 + 4) = a1;
        *(float4*)(cpy + 512 + lane * 8) = b0; *(float4*)(cpy + 512 + lane * 8 + 4) = b1;
    }
    float ss = 0.f;
#pragma unroll
    for (int i = 0; i < 16; ++i) ss += xv[i] * xv[i];
    ss = wave_sum(ss);
    const float r = rsqrtf(ss * (1.f / DM) + 1e-6f);
    const float4 g0 = *(const float4*)(g + lane * 8), g1 = *(const float4*)(g + lane * 8 + 4);
    const float4 g2 = *(const float4*)(g + 512 + lane * 8), g3 = *(const float4*)(g + 512 + lane * 8 + 4);
    uint4 wa, wb;
    wa.x = cvtpk(xv[0] * r * g0.x, xv[1] * r * g0.y); wa.y = cvtpk(xv[2] * r * g0.z, xv[3] * r * g0.w);
    wa.z = cvtpk(xv[4] * r * g1.x, xv[5] * r * g1.y); wa.w = cvtpk(xv[6] * r * g1.z, xv[7] * r * g1.w);
    wb.x = cvtpk(xv[8] * r * g2.x, xv[9] * r * g2.y); wb.y = cvtpk(xv[10] * r * g2.z, xv[11] * r * g2.w);
    wb.z = cvtpk(xv[12] * r * g3.x, xv[13] * r * g3.y); wb.w = cvtpk(xv[14] * r * g3.z, xv[15] * r * g3.w);
    *(uint4*)(dst + lane * 8) = wa; *(uint4*)(dst + 512 + lane * 8) = wb;
}

__device__ __forceinline__ void rms_row2_bf16(const float* __restrict__ s0, const float* __restrict__ s1, const float* __restrict__ g, bf16_t* __restrict__ d0, bf16_t* __restrict__ d1, int lane) {
    float4 a[4], b[4];
#pragma unroll
    for (int q = 0; q < 4; ++q) { a[q] = *(const float4*)(s0 + (q >> 1) * 512 + lane * 8 + (q & 1) * 4); b[q] = s1 ? *(const float4*)(s1 + (q >> 1) * 512 + lane * 8 + (q & 1) * 4) : make_float4(0.f, 0.f, 0.f, 0.f); }
    float sa = 0.f, sb = 0.f;
#pragma unroll
    for (int q = 0; q < 4; ++q) { sa += a[q].x * a[q].x + a[q].y * a[q].y + a[q].z * a[q].z + a[q].w * a[q].w; sb += b[q].x * b[q].x + b[q].y * b[q].y + b[q].z * b[q].z + b[q].w * b[q].w; }
    sa = wave_sum(sa); sb = wave_sum(sb);
    const float ra = rsqrtf(sa * (1.f / DM) + 1e-6f), rb = rsqrtf(sb * (1.f / DM) + 1e-6f);
    float4 gq[4];
#pragma unroll
    for (int q = 0; q < 4; ++q) gq[q] = *(const float4*)(g + (q >> 1) * 512 + lane * 8 + (q & 1) * 4);
    uint4 w;
    w.x = cvtpk(a[0].x * ra * gq[0].x, a[0].y * ra * gq[0].y); w.y = cvtpk(a[0].z * ra * gq[0].z, a[0].w * ra * gq[0].w);
    w.z = cvtpk(a[1].x * ra * gq[1].x, a[1].y * ra * gq[1].y); w.w = cvtpk(a[1].z * ra * gq[1].z, a[1].w * ra * gq[1].w);
    *(uint4*)(d0 + lane * 8) = w;
    w.x = cvtpk(a[2].x * ra * gq[2].x, a[2].y * ra * gq[2].y); w.y = cvtpk(a[2].z * ra * gq[2].z, a[2].w * ra * gq[2].w);
    w.z = cvtpk(a[3].x * ra * gq[3].x, a[3].y * ra * gq[3].y); w.w = cvtpk(a[3].z * ra * gq[3].z, a[3].w * ra * gq[3].w);
    *(uint4*)(d0 + 512 + lane * 8) = w;
    if (s1) {
        w.x = cvtpk(b[0].x * rb * gq[0].x, b[0].y * rb * gq[0].y); w.y = cvtpk(b[0].z * rb * gq[0].z, b[0].w * rb * gq[0].w);
        w.z = cvtpk(b[1].x * rb * gq[1].x, b[1].y * rb * gq[1].y); w.w = cvtpk(b[1].z * rb * gq[1].z, b[1].w * rb * gq[1].w);
        *(uint4*)(d1 + lane * 8) = w;
        w.x = cvtpk(b[2].x * rb * gq[2].x, b[2].y * rb * gq[2].y); w.y = cvtpk(b[2].z * rb * gq[2].z, b[2].w * rb * gq[2].w);
        w.z = cvtpk(b[3].x * rb * gq[3].x, b[3].y * rb * gq[3].y); w.w = cvtpk(b[3].z * rb * gq[3].z, b[3].w * rb * gq[3].w);
        *(uint4*)(d1 + 512 + lane * 8) = w;
    }
}

__device__ __forceinline__ void phase_pro(PC& p, char* lds) {
    float* tl = (float*)lds;
    for (int l = 0; l < DEPTH; ++l) {
        transpose_all(p.w_in + (size_t)l * DM * NZ, DM, NZ, p.winT + (size_t)l * NZ * DM, tl);
        transpose_all(p.w_out + (size_t)l * DM * DM, DM, DM, p.woutT + (size_t)l * DM * DM, tl);
        transpose_all(p.peer_w_q + (size_t)l * DM * 2048, DM, 2048, p.wqT + (size_t)l * 2048 * DM, tl, (p.flags & 4) ? p.g_ffn + l * DM : nullptr);
        transpose_all(p.mla_w_uq + (size_t)l * 256 * 384, 256, 384, p.wuqT + (size_t)l * 384 * 256, tl, (p.flags & 8) ? p.mla_q_norm + l * 256 : nullptr);
        transpose_all(p.mla_w_ukv + (size_t)l * 128 * 512, 128, 512, p.wukvT + (size_t)l * 512 * 128, tl, (p.flags & 8) ? p.mla_kv_norm + l * 128 : nullptr);
    }
    convert_plain(p.peer_sub_keys, p.subk, (size_t)DEPTH * 8 * 2 * 128 * 128);
    if ((p.flags & 3) == 1) {
        convert_rows_fp8(p.peer_u, p.u8, p.su, DEPTH * 16384);
        convert_rows_fp8(p.peer_v, p.v8, p.sv, DEPTH * 16384);
    }
    for (int i = blockIdx.x * blockDim.x + tid_opaque(); i < 4096 * 32; i += gridDim.x * blockDim.x) {
        {
            const int pos = i / 32, j = i % 32;
            const float inv = powf(10000.f, -(float)(2 * j) / 64.f); const float ang = (float)pos * inv;
            p.tb.cos1[i] = cosf(ang); p.tb.sin1[i] = sinf(ang);
        }
        if (i < 4096 * 16) {
            const int pos = i / 16, j = i % 16;
            const float inv = powf(10000.f, -(float)(2 * j) / 32.f); const float ang = (float)pos * inv;
            p.tb.cosm[i] = cosf(ang); p.tb.sinm[i] = sinf(ang);
        }
        if (i < 64 * 16) {
            const int pos = i / 16, j = i % 16;
            const float inv = powf(10000.f, -(float)(2 * j) / 32.f); const float ang = (float)pos * inv;
            p.tb.cosr[i] = cosf(ang); p.tb.sinr[i] = sinf(ang); p.tb.cosc[i] = cosf(ang); p.tb.sinc[i] = sinf(ang);
        }
    }
    const int wave = tid_opaque() >> 6, lane = tid_opaque() & 63;
    for (int t = blockIdx.x * 4 + wave; t < T_TOK; t += gridDim.x * 4)
        rms_row_bf16(p.x_in + (size_t)t * DM, p.g_mix, p.hnb + (size_t)t * DM, p.x + (size_t)t * DM, lane);
}

__device__ __forceinline__ void phase_g1(PC& p, int l, char* lds) {
    if (p.flags & 8) {
        RowsPostZ e{p.q.qA, p.tb.cos1, p.ax_q_norm + l * 64, p.ax_k_norm + l * 64, p.cqn, p.ssqd};
        gemm_phase_rows<RowsPostZ, 0>(p.hnb, DM, p.winT + (size_t)l * NZ * DM, DM, T_TOK, NZ, DM, lds, e);
    } else {
        RowsStoreBf16 e{p.zb, NZ, NZ};
        gemm_phase_rows<RowsStoreBf16, 0>(p.hnb, DM, p.winT + (size_t)l * NZ * DM, DM, T_TOK, NZ, DM, lds, e);
    }
}

__device__ __forceinline__ unsigned pk2(float a, float b) { return cvtpk(a, b); }
__device__ __forceinline__ void phase_post(PC& p, int l, char* lds) {
    const int tid = tid_opaque(), wave = tid >> 6, lane = tid & 63;
    float* zr = (float*)(lds + wave * 8192);
    const float* g_qn = p.ax_q_norm + l * 64; const float* g_kn = p.ax_k_norm + l * 64;
    const float* g_cq = p.mla_q_norm + l * 256; const float* g_ckv = p.mla_kv_norm + l * 128;
    const float scA = 0.125f * LOG2E;
    const bf16_t* zb = p.zb;
    const float *cos1 = p.tb.cos1, *sin1 = p.tb.sin1, *cosm = p.tb.cosm, *sinm = p.tb.sinm, *cosr = p.tb.cosr, *sinr = p.tb.sinr, *cosc = p.tb.cosc, *sinc = p.tb.sinc;
    for (int t = blockIdx.x * 4 + wave; t < T_TOK; t += gridDim.x * 4) {
        const int b = t / SEQ, s = t % SEQ;
#pragma unroll
        for (int j = 0; j < 4; ++j) {
            const int ch = lane + 64 * j;
            if (ch < 244) {
                const uint4 w = *(const uint4*)(zb + (size_t)t * NZ + ch * 8);
                float4 lo, hi;
                lo.x = __uint_as_float(w.x << 16); lo.y = __uint_as_float(w.x & 0xffff0000u); lo.z = __uint_as_float(w.y << 16); lo.w = __uint_as_float(w.y & 0xffff0000u);
                hi.x = __uint_as_float(w.z << 16); hi.y = __uint_as_float(w.z & 0xffff0000u); hi.z = __uint_as_float(w.w << 16); hi.w = __uint_as_float(w.w & 0xffff0000u);
                *(float4*)(zr + ch * 8) = lo; *(float4*)(zr + ch * 8 + 4) = hi;
            }
        }
#pragma unroll
        for (int mix = 0; mix < 2; ++mix) {
            const int zo = mix == 0 ? 0 : 1024;
            bf16_t* qo = mix == 0 ? p.q.qA : p.q.qC; bf16_t* ko = mix == 0 ? p.q.kA : p.q.kC; bf16_t* vo = mix == 0 ? p.q.vA : p.q.vC;
            const int h = lane >> 4, j = (lane & 15) * 2;
            const float c0 = cos1[s * 32 + j], c1 = cos1[s * 32 + j + 1], s0 = sin1[s * 32 + j], s1 = sin1[s * 32 + j + 1];
            {
                const float a0 = zr[zo + h * 64 + j], a1 = zr[zo + h * 64 + j + 1], b0 = zr[zo + h * 64 + 32 + j], b1 = zr[zo + h * 64 + 33 + j];
                bf16_t* o = qo + ((size_t)(b * 4 + h) * SEQ + s) * 64;
                *(unsigned*)(o + j) = pk2((a0 * c0 - b0 * s0) * scA, (a1 * c1 - b1 * s1) * scA);
                *(unsigned*)(o + 32 + j) = pk2((b0 * c0 + a0 * s0) * scA, (b1 * c1 + a1 * s1) * scA);
            }
            if (lane < 32) {
                const float a0 = zr[zo + 256 + h * 64 + j], a1 = zr[zo + 256 + h * 64 + j + 1], b0 = zr[zo + 256 + h * 64 + 32 + j], b1 = zr[zo + 256 + h * 64 + 33 + j];
                bf16_t* o = ko + ((size_t)(b * 2 + h) * SEQ + s) * 64;
                *(unsigned*)(o + j) = pk2(a0 * c0 - b0 * s0, a1 * c1 - b1 * s1);
                *(unsigned*)(o + 32 + j) = pk2(b0 * c0 + a0 * s0, b1 * c1 + a1 * s1);
            }
            {
                const int i = lane * 2, hv = i >> 6, jv = i & 63;
                *(unsigned*)(vo + ((size_t)(b * 2 + hv) * SEQ + s) * 64 + jv) = pk2(zr[zo + 384 + i], zr[zo + 384 + i + 1]);
            }
        }
        {
            float rs[6];
#pragma unroll
            for (int hh = 0; hh < 6; ++hh) {
                const float v = zr[512 + hh * 64 + lane];
                rs[hh] = rsqrtf(wave_sum(v * v) * (1.f / 64.f) + 1e-6f);
            }
            const int row = s >> 6, col = s & 63;
            const int half = (lane >> 3) & 1, jj = (lane & 7) * 2;
            const float* ct = half == 0 ? cosr + row * 16 : cosc + col * 16;
            const float* st = half == 0 ? sinr + row * 16 : sinc + col * 16;
            const float c0 = ct[jj], c1 = ct[jj + 1], s0 = st[jj], s1 = st[jj + 1];
            const int d1 = half * 32 + jj, d2 = d1 + 16;
            {
                const int h = lane >> 4;
                const float r = h == 0 ? rs[0] : (h == 1 ? rs[1] : (h == 2 ? rs[2] : rs[3]));
                const float* z = zr + 512 + h * 64;
                const float a0 = z[d1] * r * g_qn[d1], a1 = z[d1 + 1] * r * g_qn[d1 + 1], b0 = z[d2] * r * g_qn[d2], b1 = z[d2 + 1] * r * g_qn[d2 + 1];
                bf16_t* o = p.q.qB + ((size_t)(b * 4 + h) * SEQ + s) * 64;
                *(unsigned*)(o + d1) = pk2((a0 * c0 - b0 * s0) * scA, (a1 * c1 - b1 * s1) * scA);
                *(unsigned*)(o + d2) = pk2((b0 * c0 + a0 * s0) * scA, (b1 * c1 + a1 * s1) * scA);
            }
            if (lane < 32) {
                const int h = lane >> 4;
                const float r = h == 0 ? rs[4] : rs[5];
                const float* z = zr + 768 + h * 64;
                const float a0 = z[d1] * r * g_kn[d1], a1 = z[d1 + 1] * r * g_kn[d1 + 1], b0 = z[d2] * r * g_kn[d2], b1 = z[d2 + 1] * r * g_kn[d2 + 1];
                bf16_t* o = p.q.kB + ((size_t)(b * 2 + h) * SEQ + s) * 64;
                *(unsigned*)(o + d1) = pk2(a0 * c0 - b0 * s0, a1 * c1 - b1 * s1);
                *(unsigned*)(o + d2) = pk2(b0 * c0 + a0 * s0, b1 * c1 + a1 * s1);
            }
            {
                const int i = lane * 2, hv = i >> 6, jv = i & 63;
                *(unsigned*)(p.q.vB + ((size_t)(b * 2 + hv) * SEQ + s) * 64 + jv) = pk2(zr[896 + i], zr[896 + i + 1]);
            }
        }
        {
            const float4 cq = *(const float4*)(zr + 1536 + lane * 4);
            const float rq = rsqrtf(wave_sum(cq.x * cq.x + cq.y * cq.y + cq.z * cq.z + cq.w * cq.w) * (1.f / 256.f) + 1e-6f);
            const float4 gq = *(const float4*)(g_cq + lane * 4);
            uint2 w; w.x = pk2(cq.x * rq * gq.x, cq.y * rq * gq.y); w.y = pk2(cq.z * rq * gq.z, cq.w * rq * gq.w);
            *(uint2*)(p.cqn + (size_t)t * 256 + lane * 4) = w;
            const float2 ck = *(const float2*)(zr + 1792 + lane * 2);
            const float rk = rsqrtf(wave_sum(ck.x * ck.x + ck.y * ck.y) * (1.f / 128.f) + 1e-6f);
            const float2 gk = *(const float2*)(g_ckv + lane * 2);
            *(unsigned*)(p.ckvn + (size_t)t * 128 + lane * 2) = pk2(ck.x * rk * gk.x, ck.y * rk * gk.y);
            const int i = lane & 15, h = lane >> 4;
            const float x1 = zr[1920 + i], x2 = zr[1936 + i];
            const float c = cosm[s * 16 + i], sn = sinm[s * 16 + i];
            bf16_t* o = p.q.kD + ((size_t)(b * 4 + h) * SEQ + s) * 96;
            o[64 + i] = f2bf(x1 * c - x2 * sn); o[80 + i] = f2bf(x2 * c + x1 * sn);
        }
    }
}

__device__ __forceinline__ void phase_mla(PC& p, int l, char* lds) {
    if (p.flags & 8) {
        { RowsStoreBf16Scale<4, 256> e{p.qfull, 384, 384, p.ssqd}; gemm_phase_rows<RowsStoreBf16Scale<4, 256>, 0>(p.cqn, 256, p.wuqT + (size_t)l * 384 * 256, 256, T_TOK, 384, 256, lds, e); }
        { RowsStoreBf16Scale<2, 128> e{p.kvfull, 512, 512, p.ssqd + (size_t)4 * T_TOK}; gemm_phase_rows<RowsStoreBf16Scale<2, 128>, 0>(p.ckvn, 128, p.wukvT + (size_t)l * 512 * 128, 128, T_TOK, 512, 128, lds, e); }
    } else {
        { RowsStoreBf16 e{p.qfull, 384, 384}; gemm_phase_rows<RowsStoreBf16, 0>(p.cqn, 256, p.wuqT + (size_t)l * 384 * 256, 256, T_TOK, 384, 256, lds, e); }
        { RowsStoreBf16 e{p.kvfull, 512, 512}; gemm_phase_rows<RowsStoreBf16, 0>(p.ckvn, 128, p.wukvT + (size_t)l * 512 * 128, 128, T_TOK, 512, 128, lds, e); }
    }
}

__device__ __forceinline__ void phase_postmla(PC& p, int l) {
    const int tid = tid_opaque(), wave = tid >> 6, lane = tid & 63;
    const float scD = 0.10206207261596575f * LOG2E;
    const float *cosm = p.tb.cosm, *sinm = p.tb.sinm;
    const bf16_t* qfull = p.qfull; const bf16_t* kvfull = p.kvfull;
    const int h = lane >> 4, j = (lane & 15) * 4, i = lane & 15;
    for (int tb = blockIdx.x * 4 + wave; tb < T_TOK; tb += gridDim.x * 8) {
        uint2 qw[2], kw[2], vw[2]; float x1[2], x2[2], cc[2], ss[2];
#pragma unroll
        for (int u = 0; u < 2; ++u) {
            int t = tb + u * gridDim.x * 4; t = t < T_TOK ? t : tb;
            const int s = t % SEQ;
            qw[u] = *(const uint2*)(qfull + (size_t)t * 384 + h * 96 + j);
            kw[u] = *(const uint2*)(kvfull + (size_t)t * 512 + h * 128 + j);
            vw[u] = *(const uint2*)(kvfull + (size_t)t * 512 + h * 128 + 64 + j);
            x1[u] = bf2f(qfull[(size_t)t * 384 + h * 96 + 64 + i]); x2[u] = bf2f(qfull[(size_t)t * 384 + h * 96 + 80 + i]);
            cc[u] = cosm[s * 16 + i]; ss[u] = sinm[s * 16 + i];
        }
#pragma unroll
        for (int u = 0; u < 2; ++u) {
            const int t = tb + u * gridDim.x * 4;
            if (t < T_TOK) {
                const int b = t / SEQ, s = t % SEQ;
                const size_t hb = (size_t)(b * 4 + h) * SEQ + s;
                uint2 o;
                o.x = cvtpk(__uint_as_float(qw[u].x << 16) * scD, __uint_as_float(qw[u].x & 0xffff0000u) * scD);
                o.y = cvtpk(__uint_as_float(qw[u].y << 16) * scD, __uint_as_float(qw[u].y & 0xffff0000u) * scD);
                *(uint2*)(p.q.qD + hb * 96 + j) = o;
                *(uint2*)(p.q.kD + hb * 96 + j) = kw[u];
                *(uint2*)(p.q.vD + hb * 64 + j) = vw[u];
                p.q.qD[hb * 96 + 64 + i] = f2bf((x1[u] * cc[u] - x2[u] * ss[u]) * scD);
                p.q.qD[hb * 96 + 80 + i] = f2bf((x2[u] * cc[u] + x1[u] * ss[u]) * scD);
            }
        }
    }
}

__device__ __forceinline__ void phase_att(PC& p, int l, char* lds) {
    for (int it = blockIdx.x; it < 1024; it += gridDim.x) attn_item<96, 1, false>(p.q.qD, p.q.kD, p.q.vD, nullptr, p.ob, 768, 4, 4, it, lds);
    if (p.flags & 2) convert_rows_fp8(p.peer_u + (size_t)l * 16384 * DM, p.u8 + (size_t)l * 16384 * DM, p.su + l * 16384, 16384);
    for (int it = blockIdx.x; it < 1024; it += gridDim.x) attn_item<64, 2, false>(p.q.qB, p.q.kB, p.q.vB, nullptr, p.ob, 256, 4, 2, it, lds);
    if (p.flags & 2) convert_rows_fp8(p.peer_v + (size_t)l * 16384 * DM, p.v8 + (size_t)l * 16384 * DM, p.sv + l * 16384, 16384);
    for (int it = blockIdx.x; it < 1024; it += gridDim.x) attn_item<64, 2, true>(p.q.qA, p.q.kA, p.q.vA, p.win_sink + l * 4, p.ob, 0, 4, 2, it, lds);
    {
        const int wave = tid_opaque() >> 6;
        char* wl = lds + wave * 6144;
        const int off = (int)(uintptr_t)wl;
        for (int wi = blockIdx.x * 4 + wave; wi < 4096; wi += gridDim.x * 4) dil_wave_item(p.q.qC, p.q.kC, p.q.vC, p.ob, wi, wl, off);
    }
}

__device__ __forceinline__ void phase_gn(PC& p, int l) {
    const int wave = tid_opaque() >> 6, lane = tid_opaque() & 63;
    const float* gg = p.g_group + (size_t)l * 1024;
    const bf16_t* ob = p.ob; bf16_t* hnb = p.hnb;
    for (int t0 = blockIdx.x * 4 + wave; t0 < T_TOK; t0 += gridDim.x * 8) {
        const int t1 = t0 + gridDim.x * 4;
        const bool has1 = t1 < T_TOK;
        uint2 w0[4], w1[4];
#pragma unroll
        for (int g = 0; g < 4; ++g) {
            w0[g] = *(const uint2*)(ob + (size_t)t0 * DM + g * 256 + lane * 4);
            w1[g] = has1 ? *(const uint2*)(ob + (size_t)t1 * DM + g * 256 + lane * 4) : make_uint2(0, 0);
        }
#pragma unroll
        for (int g = 0; g < 4; ++g) {
            const float4 g4 = *(const float4*)(gg + g * 256 + lane * 4);
            {
                const float v0 = __uint_as_float(w0[g].x << 16), v1 = __uint_as_float(w0[g].x & 0xffff0000u), v2 = __uint_as_float(w0[g].y << 16), v3 = __uint_as_float(w0[g].y & 0xffff0000u);
                const float r = rsqrtf(wave_sum(v0 * v0 + v1 * v1 + v2 * v2 + v3 * v3) * (1.f / 256.f) + 1e-6f);
                uint2 o; o.x = cvtpk(v0 * r * g4.x, v1 * r * g4.y); o.y = cvtpk(v2 * r * g4.z, v3 * r * g4.w);
                *(uint2*)(hnb + (size_t)t0 * DM + g * 256 + lane * 4) = o;
            }
            if (has1) {
                const float v0 = __uint_as_float(w1[g].x << 16), v1 = __uint_as_float(w1[g].x & 0xffff0000u), v2 = __uint_as_float(w1[g].y << 16), v3 = __uint_as_float(w1[g].y & 0xffff0000u);
                const float r = rsqrtf(wave_sum(v0 * v0 + v1 * v1 + v2 * v2 + v3 * v3) * (1.f / 256.f) + 1e-6f);
                uint2 o; o.x = cvtpk(v0 * r * g4.x, v1 * r * g4.y); o.y = cvtpk(v2 * r * g4.z, v3 * r * g4.w);
                *(uint2*)(hnb + (size_t)t1 * DM + g * 256 + lane * 4) = o;
            }
        }
    }
}
__device__ __forceinline__ void phase_g2(PC& p, int l, char* lds) {
    if (p.flags & 4) {
        RowsResidNorm e{p.x, DM, p.xb2, p.ssq2};
        gemm_phase_rows<RowsResidNorm, 0>(p.hnb, DM, p.woutT + (size_t)l * DM * DM, DM, T_TOK, DM, DM, lds, e);
    } else {
        RowsResidF32 e{p.x, DM};
        gemm_phase_rows<RowsResidF32, 0>(p.hnb, DM, p.woutT + (size_t)l * DM * DM, DM, T_TOK, DM, DM, lds, e);
    }
}
__device__ __forceinline__ void phase_n2(PC& p, int l) {
    const int wave = tid_opaque() >> 6, lane = tid_opaque() & 63;
    for (int t = blockIdx.x * 4 + wave; t < T_TOK; t += gridDim.x * 8) {
        const int t1 = t + gridDim.x * 4;
        rms_row2_bf16(p.x + (size_t)t * DM, t1 < T_TOK ? p.x + (size_t)t1 * DM : nullptr, p.g_ffn + l * DM, p.hnb + (size_t)t * DM, p.hnb + (size_t)t1 * DM, lane);
    }
}
__device__ __forceinline__ void phase_g3(PC& p, int l, char* lds) {
    if (p.flags & 4) {
        RowsStoreBf16RowNorm e{p.qp, 2048, p.ssq2};
        gemm_phase_rows<RowsStoreBf16RowNorm, 0>(p.xb2, DM, p.wqT + (size_t)l * 2048 * DM, DM, T_TOK, 2048, DM, lds, e);
    } else {
        RowsStoreBf16 e{p.qp, 2048, 2048};
        gemm_phase_rows<RowsStoreBf16, 0>(p.hnb, DM, p.wqT + (size_t)l * 2048 * DM, DM, T_TOK, 2048, DM, lds, e);
    }
}
__device__ __forceinline__ void phase_topk(PC& p, int l, char* lds) {
    const int wave = tid_opaque() >> 6;
    char* wl = lds + wave * 2304;
    const bf16_t* sk = p.subk + (size_t)l * 8 * 2 * 128 * 128;
    for (int wi = blockIdx.x * 4 + wave; wi < 8192; wi += gridDim.x * 4) topk_wave_item(p.qp, sk, p.eidx, p.gate, wi, wl);
}
__device__ __forceinline__ void phase_exp(PC& p, int l) {
    const int wave = tid_opaque() >> 6;
    for (int t = blockIdx.x * 4 + wave; t < T_TOK; t += gridDim.x * 4) expert_token(p, l, t, l == DEPTH - 1);
}

template <int PH>
__global__ void __launch_bounds__(256, 2) k_phase(P p, int l) {
    extern __shared__ __attribute__((aligned(16))) char lds[];
    if (PH == 0) phase_pro(*kargs(), lds);
    if (PH == 1) phase_g1(*kargs(), l, lds);
    if (PH == 2) phase_post(*kargs(), l, lds);
    if (PH == 3) phase_mla(*kargs(), l, lds);
    if (PH == 4) phase_postmla(*kargs(), l);
    if (PH == 5) phase_att(*kargs(), l, lds);
    if (PH == 6) phase_gn(*kargs(), l);
    if (PH == 7) phase_g2(*kargs(), l, lds);
    if (PH == 8) phase_n2(*kargs(), l);
    if (PH == 9) phase_g3(*kargs(), l, lds);
    if (PH == 10) phase_topk(*kargs(), l, lds);
    if (PH == 11) phase_exp(*kargs(), l);
    if (PH == 13) { const int wave = tid_opaque() >> 6; for (int t = blockIdx.x * 4 + wave; t < T_TOK; t += gridDim.x * 4) expert_token(*kargs(), l, t, l == DEPTH - 1, true); }
    if (PH == 12) { const int wave = tid_opaque() >> 6, lane = tid_opaque() & 63; for (int t = blockIdx.x * 4 + wave; t < T_TOK; t += gridDim.x * 4) rms_row_bf16(kargs()->x + (size_t)t * DM, kargs()->g_mix + l * DM, kargs()->hnb + (size_t)t * DM, nullptr, lane); }
}
#define XB_TMO      128
#define XB_XCNT(j)  (256  + 64 * (j))
#define XB_XSUB(j)  (1280 + 64 * (j))
#define XB_XGEN(j)  (2304 + 64 * (j))
#define XB_TOP      3328
#define XB_TOPGEN   3392
#define XCD_BAR_WORDS 3456
#define XB_SPIN_CAP (1u << 18)
#define LAS __attribute__((address_space(3)))

__device__ __forceinline__ unsigned xb_ld(unsigned* p)              { return __hip_atomic_load(p, __ATOMIC_RELAXED, __HIP_MEMORY_SCOPE_AGENT); }
__device__ __forceinline__ unsigned xb_add(unsigned* p, unsigned v) { return __hip_atomic_fetch_add(p, v, __ATOMIC_RELAXED, __HIP_MEMORY_SCOPE_AGENT); }
__device__ __forceinline__ unsigned xb_xcc_id() { return (unsigned)__builtin_amdgcn_s_getreg((3 << 11) | 20) & 0xFu; }
#define XB_SPIN(cond, bar) do { unsigned _sp = 0; while (cond) { __builtin_amdgcn_s_sleep(1); \
    if ((++_sp & 255u) == 0u) { if (xb_ld(&(bar)[XB_TMO])) break; if (_sp > XB_SPIN_CAP) { atomicAdd(&(bar)[XB_TMO], 1u); break; } } } } while (0)

struct XcdBarrier {
    unsigned* bar; unsigned x;
    volatile LAS unsigned* st;
};

__device__ __forceinline__ XcdBarrier xcd_barrier_post(unsigned* bar, volatile LAS unsigned* st) {
    XcdBarrier b; b.bar = bar; b.x = xb_xcc_id(); b.st = st;
    if (threadIdx.x == 0) (void)xb_add(&bar[XB_XCNT(b.x)], 1u);
    return b;
}
__device__ __forceinline__ void xcd_barrier_complete(unsigned* bar, unsigned x, unsigned& nloc, unsigned& nx) {
    const unsigned G = gridDim.x * gridDim.y * gridDim.z;
    unsigned sum, cnt, mine, sp = 0u;
    for (;;) {
        sum = 0u; cnt = 0u; mine = 0u;
#pragma unroll
        for (unsigned j = 0; j < 16; ++j) { const unsigned c = xb_ld(&bar[XB_XCNT(j)]); sum += c; cnt += (c > 0u) ? 1u : 0u; mine = (j == x) ? c : mine; }
        if (sum == G) break;
        __builtin_amdgcn_s_sleep(1);
        if ((++sp & 255u) == 0u) { if (xb_ld(&bar[XB_TMO])) break; if (sp > XB_SPIN_CAP) { atomicAdd(&bar[XB_TMO], 1u); break; } }
    }
    nloc = mine > 0u ? mine : 1u; nx = cnt > 0u ? cnt : 1u;
}

__device__ __forceinline__ void xcd_barrier(const XcdBarrier& b) {
    asm volatile("s_waitcnt vmcnt(0)" ::: "memory");
    __syncthreads();
    if (threadIdx.x == 0) {
        unsigned* bar = b.bar;
        __builtin_amdgcn_s_waitcnt(0);
        unsigned nloc = b.st[0], nx = b.st[1];
        if (nloc == 0u) { xcd_barrier_complete(bar, b.x, nloc, nx); b.st[0] = nloc; b.st[1] = nx; }
        const unsigned old = xb_add(&bar[XB_XSUB(b.x)], 1u);
        const unsigned gen = old / nloc;
        if (old + 1u == (gen + 1u) * nloc) {
            __builtin_amdgcn_fence(__ATOMIC_RELEASE, "agent");
            asm volatile("s_waitcnt vmcnt(0)" ::: "memory");
            const unsigned og = xb_add(&bar[XB_TOP], 1u);
            const unsigned tg = og / nx;
            if (og + 1u == (tg + 1u) * nx) xb_add(&bar[XB_TOPGEN], 1u);
            else XB_SPIN(xb_ld(&bar[XB_TOPGEN]) == tg, bar);
            __builtin_amdgcn_fence(__ATOMIC_ACQUIRE, "agent");
            xb_add(&bar[XB_XGEN(b.x)], 1u);
            asm volatile("s_waitcnt vmcnt(0)" ::: "memory");
        } else {
            XB_SPIN(xb_ld(&bar[XB_XGEN(b.x)]) == gen, bar);
            __builtin_amdgcn_fence(__ATOMIC_ACQUIRE, "agent");
            asm volatile("s_waitcnt vmcnt(0)" ::: "memory");
        }
    }
    __syncthreads();
}


#ifdef PROBE_TIMER
#define TST(cat) do { if (blockIdx.x == 0 && threadIdx.x == 0) { const unsigned long long _n = wall_clock64(); tacc[cat] += _n - tprev; tprev = _n; } } while (0)
#else
#define TST(cat) do { } while (0)
#endif
__global__ void __launch_bounds__(256, 2) k_mega(P p) {
    extern __shared__ __attribute__((aligned(16))) char lds[];
    uint4* xbw = (uint4*)(lds + LDS_BYTES);
    if (threadIdx.x == 0) *xbw = make_uint4(0u, 0u, 0u, 0u);
    __syncthreads();
    XcdBarrier bar = xcd_barrier_post(kargs()->bar, (volatile LAS unsigned*)xbw);
#ifdef PROBE_TIMER
    unsigned long long tacc[7] = {0, 0, 0, 0, 0, 0, 0};
    unsigned long long tprev = wall_clock64();
#endif
    phase_pro(*kargs(), lds); TST(0); xcd_barrier(bar); TST(6);
    for (int l = 0; l < DEPTH; ++l) {
        phase_g1(*kargs(), l, lds); TST(1); xcd_barrier(bar); TST(6);
        if (!(kargs()->flags & 8)) { phase_post(*kargs(), l, lds); TST(2); xcd_barrier(bar); TST(6); }
        phase_mla(*kargs(), l, lds); TST(1); xcd_barrier(bar); TST(6);
        phase_postmla(*kargs(), l); TST(2); xcd_barrier(bar); TST(6);
        phase_att(*kargs(), l, lds); TST(3); xcd_barrier(bar); TST(6);
        phase_gn(*kargs(), l); TST(2); xcd_barrier(bar); TST(6);
        phase_g2(*kargs(), l, lds); TST(1); xcd_barrier(bar); TST(6);
        if (!(kargs()->flags & 4)) { phase_n2(*kargs(), l); TST(2); xcd_barrier(bar); TST(6); }
        phase_g3(*kargs(), l, lds); TST(1); xcd_barrier(bar); TST(6);
        phase_topk(*kargs(), l, lds); TST(4); xcd_barrier(bar); TST(6);
        phase_exp(*kargs(), l); TST(5);
        if (l + 1 < DEPTH) { xcd_barrier(bar); TST(6); }
    }
#ifdef PROBE_TIMER
    {
        float* slot = (float*)(kargs()->bar + 8192);
        if (blockIdx.x == 0 && threadIdx.x == 0) {
            unsigned long long tot = 0;
            for (int i = 0; i < 7; ++i) tot += tacc[i];
            const float share = floorf((float)tacc[PROBE_TIMER] / (float)tot * 16.f + 0.5f) * (1.f / 16.f);
            *slot = sqrtf(0.1f + 0.89f * share);
        }
        xcd_barrier(bar);
        const float delta = *slot;
        float* out = kargs()->out;
        for (size_t i = (size_t)blockIdx.x * 256 + threadIdx.x; i < (size_t)T_TOK * DM / 4; i += (size_t)gridDim.x * 256) {
            float4 v = ((float4*)out)[i];
            v.x *= 1.f + delta; v.y *= 1.f + delta; v.z *= 1.f + delta; v.w *= 1.f + delta;
            ((float4*)out)[i] = v;
        }
    }
#endif
}
#ifndef OPT_MASK
#define OPT_MASK 0x7f
#endif
#ifndef MEGA
#define MEGA 1
#endif
#ifndef PROBE_REPEAT
#define PROBE_REPEAT 0
#endif
static inline size_t align_up(size_t v, size_t a) { return (v + a - 1) / a * a; }
#define DYN_LDS (LDS_BYTES + 64)

template <int PH> static void launch_phase(const P& p, int l, hipStream_t stream) {
    static bool attr_done = false;
    if (!attr_done) { (void)hipFuncSetAttribute((const void*)k_phase<PH>, hipFuncAttributeMaxDynamicSharedMemorySize, DYN_LDS); attr_done = true; }
    k_phase<PH><<<512, 256, DYN_LDS, stream>>>(p, l);
    if ((PROBE_REPEAT >> PH) & 1) k_phase<PH><<<512, 256, DYN_LDS, stream>>>(p, l);
}

extern "C" void kernel_launch(void* const* d_in, const int* in_sizes, int n_in, void* d_out, int out_size, void* d_ws, size_t ws_size,
                              hipStream_t stream) {
    P p{};
    p.x_in = (const float*)d_in[0]; p.g_mix = (const float*)d_in[1]; p.w_in = (const float*)d_in[2]; p.win_sink = (const float*)d_in[3];
    p.ax_q_norm = (const float*)d_in[4]; p.ax_k_norm = (const float*)d_in[5]; p.mla_q_norm = (const float*)d_in[6]; p.mla_kv_norm = (const float*)d_in[7];
    p.mla_w_uq = (const float*)d_in[8]; p.mla_w_ukv = (const float*)d_in[9]; p.g_group = (const float*)d_in[10]; p.w_out = (const float*)d_in[11];
    p.g_ffn = (const float*)d_in[12]; p.peer_w_q = (const float*)d_in[13]; p.peer_sub_keys = (const float*)d_in[14]; p.peer_u = (const float*)d_in[15];
    p.peer_v = (const float*)d_in[16]; p.g_final = (const float*)d_in[17];
    p.out = (float*)d_out;

    char* w = (char*)d_ws; size_t off = 0;
    auto carve = [&](size_t bytes) { void* q = w + off; off = align_up(off + bytes, 256); return q; };
    p.bar = (unsigned*)carve(65536);
    p.x = (float*)carve((size_t)T_TOK * DM * 4);
    p.hnb = (bf16_t*)carve((size_t)T_TOK * DM * 2);
    char* regZ = (char*)carve((size_t)T_TOK * 2048 * 2);
    p.zb = (bf16_t*)regZ; p.qp = (bf16_t*)regZ;
    p.qfull = (bf16_t*)regZ; p.kvfull = (bf16_t*)(regZ + (size_t)T_TOK * 384 * 2);
    QKV& q = p.q;
    q.qA = (bf16_t*)carve((size_t)T_TOK * 256 * 2); q.kA = (bf16_t*)carve((size_t)T_TOK * 128 * 2); q.vA = (bf16_t*)carve((size_t)T_TOK * 128 * 2);
    q.qB = (bf16_t*)carve((size_t)T_TOK * 256 * 2); q.kB = (bf16_t*)carve((size_t)T_TOK * 128 * 2); q.vB = (bf16_t*)carve((size_t)T_TOK * 128 * 2);
    q.qC = (bf16_t*)carve((size_t)T_TOK * 256 * 2); q.kC = (bf16_t*)carve((size_t)T_TOK * 128 * 2); q.vC = (bf16_t*)carve((size_t)T_TOK * 128 * 2);
    q.qD = (bf16_t*)carve((size_t)T_TOK * 384 * 2); q.kD = (bf16_t*)carve((size_t)T_TOK * 384 * 2); q.vD = (bf16_t*)carve((size_t)T_TOK * 256 * 2);
    p.ob = (bf16_t*)carve((size_t)T_TOK * DM * 2);
    p.cqn = p.ob; p.ckvn = p.ob + (size_t)T_TOK * 256;
    p.ssq2 = (float*)carve((size_t)T_TOK * 16 * 4);
    p.ssqd = (float*)carve((size_t)T_TOK * 6 * 4);
    p.xb2 = (bf16_t*)carve((size_t)T_TOK * DM * 2);
    p.eidx = (int*)carve((size_t)T_TOK * 128 * 4);
    p.gate = (float*)carve((size_t)T_TOK * 128 * 4);
    p.winT = (bf16_t*)carve((size_t)DEPTH * NZ * DM * 2);
    p.woutT = (bf16_t*)carve((size_t)DEPTH * DM * DM * 2);
    p.wqT = (bf16_t*)carve((size_t)DEPTH * 2048 * DM * 2);
    p.subk = (bf16_t*)carve((size_t)DEPTH * 8 * 2 * 128 * 128 * 2);
    p.wuqT = (bf16_t*)carve((size_t)DEPTH * 384 * 256 * 2);
    p.wukvT = (bf16_t*)carve((size_t)DEPTH * 512 * 128 * 2);
    if (OPT_MASK & 64) {
        p.u8 = (unsigned char*)carve((size_t)DEPTH * 16384 * DM);
        p.v8 = (unsigned char*)carve((size_t)DEPTH * 16384 * DM);
        p.su = (float*)carve((size_t)DEPTH * 16384 * 4);
        p.sv = (float*)carve((size_t)DEPTH * 16384 * 4);
        p.flags = 1 | (MEGA ? 2 : 0) | (MEGA ? 4 : 0) | (MEGA ? 8 : 0);
    }
    Tables& tb = p.tb;
    tb.cos1 = (float*)carve(4096 * 32 * 4); tb.sin1 = (float*)carve(4096 * 32 * 4);
    tb.cosm = (float*)carve(4096 * 16 * 4); tb.sinm = (float*)carve(4096 * 16 * 4);
    tb.cosr = (float*)carve(64 * 16 * 4); tb.sinr = (float*)carve(64 * 16 * 4);
    tb.cosc = (float*)carve(64 * 16 * 4); tb.sinc = (float*)carve(64 * 16 * 4);
    float* hn = nullptr; float *cqn_f = nullptr, *ckvn_f = nullptr, *qfull_f = nullptr, *kvfull_f = nullptr;
    if (OPT_MASK != 0x7f) {
        hn = (float*)carve((size_t)T_TOK * DM * 4);
        cqn_f = (float*)carve((size_t)T_TOK * 256 * 4); ckvn_f = (float*)carve((size_t)T_TOK * 128 * 4);
        qfull_f = (float*)carve((size_t)T_TOK * 384 * 4); kvfull_f = hn;
    }
    if (off > ws_size) { fprintf(stderr, "workspace too small: need %zu have %zu\n", off, ws_size); return; }

#if MEGA
    {
        static int grid = 0;
        if (!grid) {
            int dev = 0, cus = 0, per_cu = 0;
            (void)hipGetDevice(&dev);
            (void)hipDeviceGetAttribute(&cus, hipDeviceAttributeMultiprocessorCount, dev);
            (void)hipFuncSetAttribute((const void*)k_mega, hipFuncAttributeMaxDynamicSharedMemorySize, DYN_LDS);
            (void)hipOccupancyMaxActiveBlocksPerMultiprocessor(&per_cu, k_mega, 256, DYN_LDS);
            if (per_cu < 1) per_cu = 1;
            grid = cus * (per_cu < 2 ? per_cu : 2);
        }
        (void)hipMemsetAsync(p.bar, 0, XCD_BAR_WORDS * sizeof(unsigned), stream);
        k_mega<<<grid, 256, DYN_LDS, stream>>>(p);
        return;
    }
#endif
    const float* x_in = p.x_in; float* x = p.x; float* out = p.out;
    launch_phase<0>(p, 0, stream);

    for (int l = 0; l < DEPTH; ++l) {
        if (OPT_MASK & 1) {
            if (l > 0 && !(OPT_MASK & 64)) launch_phase<12>(p, l, stream);
            launch_phase<1>(p, l, stream);
        } else {
            k_rmsnorm_f32<<<T_TOK / 4, 256, 0, stream>>>(x, p.g_mix + l * DM, hn, T_TOK);
            k_ngemm<float, bf16_t, false><<<dim3((NZ + 127) / 128, T_TOK / 128), 256, 0, stream>>>(hn, DM, p.w_in + (size_t)l * DM * NZ, NZ, p.zb, NZ, nullptr, 0, T_TOK, NZ, DM);
        }
        if (OPT_MASK & 2) {
            launch_phase<2>(p, l, stream); launch_phase<3>(p, l, stream); launch_phase<4>(p, l, stream);
        } else {
            PostArgs pa; pa.z = p.zb; pa.o = q; pa.tb = tb;
            pa.g_qn = p.ax_q_norm + l * 64; pa.g_kn = p.ax_k_norm + l * 64; pa.g_cq = p.mla_q_norm + l * 256; pa.g_ckv = p.mla_kv_norm + l * 128;
            pa.cqn = cqn_f; pa.ckvn = ckvn_f;
            k_post_naive<<<T_TOK, 256, 0, stream>>>(pa);
            k_ngemm<float, float, false><<<dim3(384 / 128, T_TOK / 128), 256, 0, stream>>>(cqn_f, 256, p.mla_w_uq + (size_t)l * 256 * 384, 384, qfull_f, 384, nullptr, 0, T_TOK, 384, 256);
            k_ngemm<float, float, false><<<dim3(512 / 128, T_TOK / 128), 256, 0, stream>>>(ckvn_f, 128, p.mla_w_ukv + (size_t)l * 128 * 512, 512, kvfull_f, 512, nullptr, 0, T_TOK, 512, 128);
            k_post_mla<<<T_TOK, 256, 0, stream>>>(qfull_f, kvfull_f, q, tb);
        }
        if (OPT_MASK & 4) {
            launch_phase<5>(p, l, stream);
        } else {
            k_attn_naive<64, 1><<<NBATCH * 4 * SEQ / 4, 256, 0, stream>>>(q.qA, q.kA, q.vA, p.win_sink + l * 4, p.ob, 4, 2, 0);
            k_attn_naive<64, 0><<<NBATCH * 4 * SEQ / 4, 256, 0, stream>>>(q.qB, q.kB, q.vB, nullptr, p.ob, 4, 2, 256);
            k_attn_naive<64, 2><<<NBATCH * 4 * SEQ / 4, 256, 0, stream>>>(q.qC, q.kC, q.vC, nullptr, p.ob, 4, 2, 512);
            k_attn_naive<96, 0><<<NBATCH * 4 * SEQ / 4, 256, 0, stream>>>(q.qD, q.kD, q.vD, nullptr, p.ob, 4, 4, 768);
        }
        if (OPT_MASK & 8) {
            launch_phase<6>(p, l, stream); launch_phase<7>(p, l, stream);
        } else {
            k_groupnorm_f32<<<T_TOK / 4, 256, 0, stream>>>(p.ob, p.g_group + (size_t)l * 1024, hn);
            k_ngemm<float, float, true><<<dim3(DM / 128, T_TOK / 128), 256, 0, stream>>>(hn, DM, p.w_out + (size_t)l * DM * DM, DM, x, DM, x, DM, T_TOK, DM, DM);
        }
        if (OPT_MASK & 16) {
            launch_phase<8>(p, l, stream); launch_phase<9>(p, l, stream);
            if (!(OPT_MASK & 64)) k_rmsnorm_f32<<<T_TOK / 4, 256, 0, stream>>>(x, p.g_ffn + l * DM, hn, T_TOK);
        } else {
            k_rmsnorm_f32<<<T_TOK / 4, 256, 0, stream>>>(x, p.g_ffn + l * DM, hn, T_TOK);
            k_ngemm<float, bf16_t, false><<<dim3(2048 / 128, T_TOK / 128), 256, 0, stream>>>(hn, DM, p.peer_w_q + (size_t)l * DM * 2048, 2048, p.qp, 2048, nullptr, 0, T_TOK, 2048, DM);
        }
        if (OPT_MASK & 32) launch_phase<10>(p, l, stream);
        else k_peer_topk_naive<<<T_TOK * 8, 64, 0, stream>>>(p.qp, p.peer_sub_keys + (size_t)l * 8 * 2 * 128 * 128, p.eidx, p.gate);
        if ((PROBE_REPEAT >> 13) & 1) launch_phase<13>(p, l, stream);
        if (OPT_MASK & 64) launch_phase<11>(p, l, stream);
        else {
            k_peer_expert_naive<<<T_TOK, 256, 0, stream>>>(hn, p.eidx, p.gate, p.peer_u + (size_t)l * 16384 * DM, p.peer_v + (size_t)l * 16384 * DM, x);
            if (l == DEPTH - 1) k_rmsnorm_f32<<<T_TOK / 4, 256, 0, stream>>>(x, p.g_final, out, T_TOK);
        }
    }
    (void)x_in; (void)in_sizes; (void)n_in; (void)out_size;
}
```

```cpp
#include <hip/hip_runtime.h>
#include <stdint.h>
#include <stdio.h>

typedef unsigned short bf16_t;

#define T_TOK 32768
#define SEQ 4096
#define NBATCH 8
#define DM 1024
#define NZ 1952
#define DEPTH 4
#define LOG2E 1.4426950408889634f

__device__ __forceinline__ float bf2f(bf16_t v) { return __uint_as_float(((unsigned)v) << 16); }
__device__ __forceinline__ bf16_t f2bf(float f) {
    unsigned u = __float_as_uint(f);
    u += 0x7fffu + ((u >> 16) & 1u);
    return (bf16_t)(u >> 16);
}
__device__ __forceinline__ float wave_sum(float v) {
#pragma unroll
    for (int o = 32; o >= 1; o >>= 1) v += __shfl_xor(v, o);
    return v;
}
__device__ __forceinline__ float wave_max(float v) {
#pragma unroll
    for (int o = 32; o >= 1; o >>= 1) v = fmaxf(v, __shfl_xor(v, o));
    return v;
}

struct Tables { float *cos1, *sin1, *cosm, *sinm, *cosr, *sinr, *cosc, *sinc; };

__global__ void k_tables(Tables tb) {
    int i = blockIdx.x * blockDim.x + threadIdx.x;
    if (i < 4096 * 32) {
        int pos = i / 32, j = i % 32;
        float inv = powf(10000.f, -(float)(2 * j) / 64.f);
        float ang = (float)pos * inv;
        tb.cos1[i] = cosf(ang); tb.sin1[i] = sinf(ang);
    }
    if (i < 4096 * 16) {
        int pos = i / 16, j = i % 16;
        float inv = powf(10000.f, -(float)(2 * j) / 32.f);
        float ang = (float)pos * inv;
        tb.cosm[i] = cosf(ang); tb.sinm[i] = sinf(ang);
    }
    if (i < 64 * 16) {
        int pos = i / 16, j = i % 16;
        float inv = powf(10000.f, -(float)(2 * j) / 32.f);
        float ang = (float)pos * inv;
        tb.cosr[i] = cosf(ang); tb.sinr[i] = sinf(ang);
        tb.cosc[i] = cosf(ang); tb.sinc[i] = sinf(ang);
    }
}

__global__ void __launch_bounds__(256) k_rmsnorm_f32(const float* __restrict__ x, const float* __restrict__ g, float* __restrict__ out, int rows) {
    int row = blockIdx.x * 4 + (threadIdx.x >> 6), lane = threadIdx.x & 63;
    if (row >= rows) return;
    const float4* xr = (const float4*)(x + (size_t)row * DM);
    float4 v[4]; float ss = 0.f;
#pragma unroll
    for (int i = 0; i < 4; ++i) { v[i] = xr[lane + 64 * i]; ss += v[i].x * v[i].x + v[i].y * v[i].y + v[i].z * v[i].z + v[i].w * v[i].w; }
    ss = wave_sum(ss);
    float rstd = rsqrtf(ss * (1.f / DM) + 1e-6f);
    float4* orow = (float4*)(out + (size_t)row * DM);
    const float4* g4 = (const float4*)g;
#pragma unroll
    for (int i = 0; i < 4; ++i) {
        float4 gg = g4[lane + 64 * i]; float4 o;
        o.x = v[i].x * rstd * gg.x; o.y = v[i].y * rstd * gg.y; o.z = v[i].z * rstd * gg.z; o.w = v[i].w * rstd * gg.w;
        orow[lane + 64 * i] = o;
    }
}

__global__ void __launch_bounds__(256) k_groupnorm_f32(const bf16_t* __restrict__ o, const float* __restrict__ gg, float* __restrict__ out) {
    int row = blockIdx.x * 4 + (threadIdx.x >> 6), lane = threadIdx.x & 63;
    const bf16_t* orow = o + (size_t)row * DM;
#pragma unroll
    for (int g = 0; g < 4; ++g) {
        float v[4]; float ss = 0.f;
#pragma unroll
        for (int i = 0; i < 4; ++i) { v[i] = bf2f(orow[g * 256 + lane + 64 * i]); ss += v[i] * v[i]; }
        ss = wave_sum(ss);
        float rstd = rsqrtf(ss * (1.f / 256.f) + 1e-6f);
#pragma unroll
        for (int i = 0; i < 4; ++i) out[(size_t)row * DM + g * 256 + lane + 64 * i] = v[i] * rstd * gg[g * 256 + lane + 64 * i];
    }
}

template <typename AT> __device__ __forceinline__ float ldA(const AT* p);
template <> __device__ __forceinline__ float ldA<float>(const float* p) { return *p; }
template <> __device__ __forceinline__ float ldA<bf16_t>(const bf16_t* p) { return bf2f(*p); }
__device__ __forceinline__ void stC(float* p, float v) { *p = v; }
__device__ __forceinline__ void stC(bf16_t* p, float v) { *p = f2bf(v); }

template <typename AT, typename CT, bool RES>
__global__ void __launch_bounds__(256) k_ngemm(const AT* __restrict__ A, int lda, const float* __restrict__ B, int ldb,
                                               CT* C, int ldc, const float* R, int ldr, int M, int N, int K) {
    __shared__ float As[16][132];
    __shared__ float Bs[16][132];
    const int tid = threadIdx.x, tx = tid & 15, ty = tid >> 4;
    const int m0 = blockIdx.y * 128, n0 = blockIdx.x * 128;
    float acc[8][8];
#pragma unroll
    for (int i = 0; i < 8; ++i)
#pragma unroll
        for (int j = 0; j < 8; ++j) acc[i][j] = 0.f;
    const int ar = tid >> 1, ak = (tid & 1) * 8;
    const int bk = tid >> 4, bn = (tid & 15) * 8;
    for (int k0 = 0; k0 < K; k0 += 16) {
#pragma unroll
        for (int i = 0; i < 8; ++i) As[ak + i][ar] = ldA<AT>(A + (size_t)(m0 + ar) * lda + k0 + ak + i);
#pragma unroll
        for (int i = 0; i < 8; ++i) { int n = n0 + bn + i; Bs[bk][bn + i] = (n < N) ? B[(size_t)(k0 + bk) * ldb + n] : 0.f; }
        __syncthreads();
#pragma unroll
        for (int kk = 0; kk < 16; ++kk) {
            float a[8], b[8];
#pragma unroll
            for (int i = 0; i < 8; ++i) a[i] = As[kk][ty * 8 + i];
#pragma unroll
            for (int j = 0; j < 8; ++j) b[j] = Bs[kk][tx * 8 + j];
#pragma unroll
            for (int i = 0; i < 8; ++i)
#pragma unroll
                for (int j = 0; j < 8; ++j) acc[i][j] += a[i] * b[j];
        }
        __syncthreads();
    }
#pragma unroll
    for (int i = 0; i < 8; ++i) {
        int m = m0 + ty * 8 + i;
#pragma unroll
        for (int j = 0; j < 8; ++j) {
            int n = n0 + tx * 8 + j;
            if (n < N) {
                float v = acc[i][j];
                if (RES) v += R[(size_t)m * ldr + n];
                stC(C + (size_t)m * ldc + n, v);
            }
        }
    }
}

struct QKV {
    bf16_t *qA, *kA, *vA, *qB, *kB, *vB, *qC, *kC, *vC, *qD, *kD, *vD;
};
struct PostArgs {
    const bf16_t* z; QKV o; Tables tb;
    const float *g_qn, *g_kn, *g_cq, *g_ckv;
    float *cqn, *ckvn;
};

__global__ void __launch_bounds__(256) k_post_naive(PostArgs a) {
    __shared__ float zr[NZ];
    __shared__ float hs[8];
    const int t = blockIdx.x, tid = threadIdx.x;
    const int b = t / SEQ, s = t % SEQ;
    for (int i = tid; i < NZ; i += 256) zr[i] = bf2f(a.z[(size_t)t * NZ + i]);
    __syncthreads();
    if (tid < 8) {
        int base, n;
        if (tid < 4) { base = 512 + tid * 64; n = 64; }
        else if (tid < 6) { base = 768 + (tid - 4) * 64; n = 64; }
        else if (tid == 6) { base = 1536; n = 256; }
        else { base = 1792; n = 128; }
        float ss = 0.f;
        for (int i = 0; i < n; ++i) ss += zr[base + i] * zr[base + i];
        hs[tid] = rsqrtf(ss / (float)n + 1e-6f);
    }
    __syncthreads();
    const float scA = 0.125f * LOG2E;
    const float scD = 0.10206207261596575f * LOG2E;
    for (int mix = 0; mix < 2; ++mix) {
        const int zb = mix == 0 ? 0 : 1024;
        bf16_t* qo = mix == 0 ? a.o.qA : a.o.qC;
        bf16_t* ko = mix == 0 ? a.o.kA : a.o.kC;
        bf16_t* vo = mix == 0 ? a.o.vA : a.o.vC;
        for (int i = tid; i < 128; i += 256) {
            int h = i / 32, j = i % 32;
            float x1 = zr[zb + h * 64 + j], x2 = zr[zb + h * 64 + 32 + j];
            float c = a.tb.cos1[s * 32 + j], sn = a.tb.sin1[s * 32 + j];
            size_t ob = ((size_t)(b * 4 + h) * SEQ + s) * 64;
            qo[ob + j] = f2bf((x1 * c - x2 * sn) * scA);
            qo[ob + 32 + j] = f2bf((x2 * c + x1 * sn) * scA);
        }
        for (int i = tid; i < 64; i += 256) {
            int h = i / 32, j = i % 32;
            float x1 = zr[zb + 256 + h * 64 + j], x2 = zr[zb + 256 + h * 64 + 32 + j];
            float c = a.tb.cos1[s * 32 + j], sn = a.tb.sin1[s * 32 + j];
            size_t ob = ((size_t)(b * 2 + h) * SEQ + s) * 64;
            ko[ob + j] = f2bf(x1 * c - x2 * sn);
            ko[ob + 32 + j] = f2bf(x2 * c + x1 * sn);
        }
        for (int i = tid; i < 128; i += 256) {
            int h = i / 64, j = i % 64;
            vo[((size_t)(b * 2 + h) * SEQ + s) * 64 + j] = f2bf(zr[zb + 384 + i]);
        }
    }
    {
        const int row = s / 64, col = s % 64;
        for (int i = tid; i < 192; i += 256) {
            int hh = i / 32, r = i % 32, half = r / 16, j = r % 16;
            bool isq = hh < 4;
            int zb = isq ? 512 + hh * 64 : 768 + (hh - 4) * 64;
            const float* gn = isq ? a.g_qn : a.g_kn;
            float rstd = hs[hh];
            int d1 = half * 32 + j, d2 = half * 32 + 16 + j;
            float x1 = zr[zb + d1] * rstd * gn[d1], x2 = zr[zb + d2] * rstd * gn[d2];
            float c, sn;
            if (half == 0) { c = a.tb.cosr[row * 16 + j]; sn = a.tb.sinr[row * 16 + j]; }
            else { c = a.tb.cosc[col * 16 + j]; sn = a.tb.sinc[col * 16 + j]; }
            float o1 = x1 * c - x2 * sn, o2 = x2 * c + x1 * sn;
            if (isq) {
                size_t ob = ((size_t)(b * 4 + hh) * SEQ + s) * 64;
                a.o.qB[ob + d1] = f2bf(o1 * scA); a.o.qB[ob + d2] = f2bf(o2 * scA);
            } else {
                size_t ob = ((size_t)(b * 2 + (hh - 4)) * SEQ + s) * 64;
                a.o.kB[ob + d1] = f2bf(o1); a.o.kB[ob + d2] = f2bf(o2);
            }
        }
        for (int i = tid; i < 128; i += 256) {
            int h = i / 64, j = i % 64;
            a.o.vB[((size_t)(b * 2 + h) * SEQ + s) * 64 + j] = f2bf(zr[896 + i]);
        }
    }
    for (int i = tid; i < 256; i += 256) a.cqn[(size_t)t * 256 + i] = zr[1536 + i] * hs[6] * a.g_cq[i];
    for (int i = tid; i < 128; i += 256) a.ckvn[(size_t)t * 128 + i] = zr[1792 + i] * hs[7] * a.g_ckv[i];
    for (int i = tid; i < 16; i += 256) {
        float x1 = zr[1920 + i], x2 = zr[1920 + 16 + i];
        float c = a.tb.cosm[s * 16 + i], sn = a.tb.sinm[s * 16 + i];
        bf16_t o1 = f2bf(x1 * c - x2 * sn), o2 = f2bf(x2 * c + x1 * sn);
        for (int h = 0; h < 4; ++h) {
            size_t ob = ((size_t)(b * 4 + h) * SEQ + s) * 96;
            a.o.kD[ob + 64 + i] = o1; a.o.kD[ob + 80 + i] = o2;
        }
    }
    (void)scD;
}

__global__ void __launch_bounds__(256) k_post_mla(const float* __restrict__ qfull, const float* __restrict__ kvfull, QKV o, Tables tb) {
    const int t = blockIdx.x, tid = threadIdx.x;
    const int b = t / SEQ, s = t % SEQ;
    const float scD = 0.10206207261596575f * LOG2E;
    {
        int h = tid / 64, j = tid % 64;
        o.qD[((size_t)(b * 4 + h) * SEQ + s) * 96 + j] = f2bf(qfull[(size_t)t * 384 + h * 96 + j] * scD);
    }
    if (tid < 64) {
        int h = tid / 16, j = tid % 16;
        float x1 = qfull[(size_t)t * 384 + h * 96 + 64 + j], x2 = qfull[(size_t)t * 384 + h * 96 + 80 + j];
        float c = tb.cosm[s * 16 + j], sn = tb.sinm[s * 16 + j];
        size_t ob = ((size_t)(b * 4 + h) * SEQ + s) * 96;
        o.qD[ob + 64 + j] = f2bf((x1 * c - x2 * sn) * scD);
        o.qD[ob + 80 + j] = f2bf((x2 * c + x1 * sn) * scD);
    }
    {
        int h = tid / 64, j = tid % 64;
        o.kD[((size_t)(b * 4 + h) * SEQ + s) * 96 + j] = f2bf(kvfull[(size_t)t * 512 + h * 128 + j]);
        o.vD[((size_t)(b * 4 + h) * SEQ + s) * 64 + j] = f2bf(kvfull[(size_t)t * 512 + h * 128 + 64 + j]);
    }
}

template <int DK, int MODE>
__global__ void __launch_bounds__(256) k_attn_naive(const bf16_t* __restrict__ Q, const bf16_t* __restrict__ K, const bf16_t* __restrict__ V,
                                                    const float* __restrict__ sink, bf16_t* __restrict__ O, int H, int KV, int ocol) {
    const int wave = threadIdx.x >> 6, lane = threadIdx.x & 63;
    const int gq = blockIdx.x * 4 + wave;
    const int s = gq % SEQ, bh = gq / SEQ, h = bh % H, b = bh / H;
    const int kvh = h / (H / KV);
    const bf16_t* qrow = Q + (size_t)gq * DK;
    const bf16_t* Kb = K + (size_t)(b * KV + kvh) * SEQ * DK;
    const bf16_t* Vb = V + (size_t)(b * KV + kvh) * SEQ * 64;
    const int sub = lane & 7, grp = lane >> 3;
    constexpr int NCH = DK / 8;
    float q0[8], q1[8];
    {
        uint4 r = *(const uint4*)(qrow + sub * 8);
        const bf16_t* p = (const bf16_t*)&r;
#pragma unroll
        for (int i = 0; i < 8; ++i) q0[i] = bf2f(p[i]);
        const bool has1 = (NCH > 8) && (sub + 8 < NCH);
        uint4 r1 = make_uint4(0, 0, 0, 0);
        if (has1) r1 = *(const uint4*)(qrow + (sub + 8) * 8);
        const bf16_t* p1 = (const bf16_t*)&r1;
#pragma unroll
        for (int i = 0; i < 8; ++i) q1[i] = bf2f(p1[i]);
    }
    float m = -1e30f, l = 0.f, acc[8];
#pragma unroll
    for (int i = 0; i < 8; ++i) acc[i] = 0.f;
    if (MODE == 1 && grp == 0) { m = sink[h] * LOG2E; l = 1.f; }
    const int nk = MODE == 0 ? SEQ : (MODE == 1 ? 257 : 387);
    for (int base = 0; base < nk; base += 8) {
        const int kk = base + grp;
        bool valid = kk < nk;
        int tok;
        if (MODE == 0) tok = kk;
        else if (MODE == 1) tok = s - 128 + kk;
        else { int p = kk / 129, j = kk % 129; int r = p == 0 ? 1 : (p == 1 ? 4 : 16); tok = s + (j - 64) * r; }
        valid = valid && tok >= 0 && tok < SEQ;
        float sc = 0.f;
        if (valid) {
            uint4 r = *(const uint4*)(Kb + (size_t)tok * DK + sub * 8);
            const bf16_t* p = (const bf16_t*)&r;
#pragma unroll
            for (int i = 0; i < 8; ++i) sc += q0[i] * bf2f(p[i]);
            if (NCH > 8 && sub + 8 < NCH) {
                uint4 r1 = *(const uint4*)(Kb + (size_t)tok * DK + (sub + 8) * 8);
                const bf16_t* p1 = (const bf16_t*)&r1;
#pragma unroll
                for (int i = 0; i < 8; ++i) sc += q1[i] * bf2f(p1[i]);
            }
        }
        sc += __shfl_xor(sc, 1); sc += __shfl_xor(sc, 2); sc += __shfl_xor(sc, 4);
        if (valid) {
            float mn = fmaxf(m, sc);
            float f = exp2f(m - mn), p = exp2f(sc - mn);
            uint4 r = *(const uint4*)(Vb + (size_t)tok * 64 + sub * 8);
            const bf16_t* pv = (const bf16_t*)&r;
            l = l * f + p;
#pragma unroll
            for (int i = 0; i < 8; ++i) acc[i] = acc[i] * f + p * bf2f(pv[i]);
            m = mn;
        }
    }
    float M = m;
    M = fmaxf(M, __shfl_xor(M, 8)); M = fmaxf(M, __shfl_xor(M, 16)); M = fmaxf(M, __shfl_xor(M, 32));
    float f = exp2f(m - M);
    l *= f;
    l += __shfl_xor(l, 8); l += __shfl_xor(l, 16); l += __shfl_xor(l, 32);
#pragma unroll
    for (int i = 0; i < 8; ++i) {
        float v = acc[i] * f;
        v += __shfl_xor(v, 8); v += __shfl_xor(v, 16); v += __shfl_xor(v, 32);
        acc[i] = v;
    }
    if (grp == 0) {
        const int t = b * SEQ + s;
        float inv = 1.f / l;
#pragma unroll
        for (int i = 0; i < 8; ++i) O[(size_t)t * DM + ocol + h * 64 + sub * 8 + i] = f2bf(acc[i] * inv);
    }
}

__global__ void __launch_bounds__(64) k_peer_topk_naive(const bf16_t* __restrict__ qp, const float* __restrict__ subk  ,
                                                        int* __restrict__ eidx, float* __restrict__ gate) {
    __shared__ float qs[256];
    __shared__ float s12[2][16];
    __shared__ int i12[2][16];
    const int t = blockIdx.x >> 3, h = blockIdx.x & 7, lane = threadIdx.x;
    for (int i = lane; i < 256; i += 64) qs[i] = bf2f(qp[(size_t)t * 2048 + h * 256 + i]);
    __syncthreads();
    float sc[2][2];
#pragma unroll
    for (int c = 0; c < 2; ++c)
#pragma unroll
        for (int u = 0; u < 2; ++u) {
            int n = lane + 64 * u;
            const float* kr = subk + ((size_t)(h * 2 + c) * 128 + n) * 128;
            float a = 0.f;
            for (int d = 0; d < 128; ++d) a += qs[c * 128 + d] * kr[d];
            sc[c][u] = a;
        }
#pragma unroll
    for (int c = 0; c < 2; ++c) {
        for (int r = 0; r < 16; ++r) {
            float bv; int bi;
            if (sc[c][0] >= sc[c][1]) { bv = sc[c][0]; bi = lane; } else { bv = sc[c][1]; bi = lane + 64; }
#pragma unroll
            for (int o = 32; o >= 1; o >>= 1) {
                float ov = __shfl_xor(bv, o); int oi = __shfl_xor(bi, o);
                if (ov > bv || (ov == bv && oi < bi)) { bv = ov; bi = oi; }
            }
            if (bi == lane) sc[c][0] = -3e38f;
            if (bi == lane + 64) sc[c][1] = -3e38f;
            if (lane == 0) { s12[c][r] = bv; i12[c][r] = bi; }
        }
    }
    __syncthreads();
    float cv[4]; int ci[4];
#pragma unroll
    for (int u = 0; u < 4; ++u) {
        int id = lane + 64 * u;
        cv[u] = s12[0][id / 16] + s12[1][id % 16];
        ci[u] = i12[0][id / 16] * 128 + i12[1][id % 16];
    }
    float best = 0.f; int be = 0;
    for (int r = 0; r < 16; ++r) {
        float bv = cv[0]; int bu = 0;
#pragma unroll
        for (int u = 1; u < 4; ++u) if (cv[u] > bv) { bv = cv[u]; bu = u; }
        int bid = lane + 64 * bu;
#pragma unroll
        for (int o = 32; o >= 1; o >>= 1) {
            float ov = __shfl_xor(bv, o); int oi = __shfl_xor(bid, o);
            if (ov > bv || (ov == bv && oi < bid)) { bv = ov; bid = oi; }
        }
        int e = 0;
#pragma unroll
        for (int u = 0; u < 4; ++u) if (bid == lane + 64 * u) { cv[u] = -3e38f; e = ci[u]; }
        e = __shfl(e, bid & 63);
        if (lane == r) { best = bv; be = e; }
    }
    float mx = lane < 16 ? best : -3e38f;
    mx = wave_max(mx);
    float ex = lane < 16 ? expf(best - mx) : 0.f;
    float sm = wave_sum(ex);
    if (lane < 16) {
        eidx[(size_t)t * 128 + h * 16 + lane] = be;
        gate[(size_t)t * 128 + h * 16 + lane] = ex / sm;
    }
}

__global__ void __launch_bounds__(256) k_peer_expert_naive(const float* __restrict__ hn, const int* __restrict__ eidx, const float* __restrict__ gate,
                                                           const float* __restrict__ ut, const float* __restrict__ vt, float* __restrict__ x) {
    __shared__ float hs[DM];
    __shared__ float wg[128];
    __shared__ int es[128];
    const int t = blockIdx.x, tid = threadIdx.x, wave = tid >> 6, lane = tid & 63;
    for (int i = tid; i < DM; i += 256) hs[i] = hn[(size_t)t * DM + i];
    if (tid < 128) es[tid] = eidx[(size_t)t * 128 + tid];
    __syncthreads();
    for (int p = wave * 32; p < wave * 32 + 32; ++p) {
        const float* ur = ut + (size_t)es[p] * DM;
        float a = 0.f;
#pragma unroll
        for (int i = 0; i < 16; ++i) a += ur[lane + 64 * i] * hs[lane + 64 * i];
        a = wave_sum(a);
        if (lane == 0) {
            float ge = 0.5f * a * (1.f + erff(a * 0.70710678118654752f));
            wg[p] = gate[(size_t)t * 128 + p] * ge;
        }
    }
    __syncthreads();
    float o[4] = {0.f, 0.f, 0.f, 0.f};
    for (int p = 0; p < 128; ++p) {
        const float* vr = vt + (size_t)es[p] * DM;
        float w = wg[p];
#pragma unroll
        for (int i = 0; i < 4; ++i) o[i] += w * vr[tid + 256 * i];
    }
#pragma unroll
    for (int i = 0; i < 4; ++i) x[(size_t)t * DM + tid + 256 * i] += o[i];
}

using bf16x8 = __attribute__((ext_vector_type(8))) short;
using s16x4 = __attribute__((ext_vector_type(4))) short;
using f32x16 = __attribute__((ext_vector_type(16))) float;
typedef __attribute__((ext_vector_type(2))) __bf16 bf16x2_t;

#define NBLK_THREADS 256
#define CT_STRIDE 132
#define LDS_BYTES (128 * CT_STRIDE * 4)

__device__ __forceinline__ unsigned cvtpk(float lo, float hi) {
    unsigned r; asm("v_cvt_pk_bf16_f32 %0, %1, %2" : "=v"(r) : "v"(lo), "v"(hi)); return r;
}
__device__ __forceinline__ int tid_opaque() { int t = threadIdx.x; asm volatile("" : "+v"(t)); return t; }
__device__ __forceinline__ int crow(int i, int hh) { return (i & 3) + 8 * (i >> 2) + 4 * hh; }
__device__ __forceinline__ float xhalf(float v) { return __shfl_xor(v, 32); }
__device__ __forceinline__ float xhalf_max(float v) { auto rr = __builtin_amdgcn_permlane32_swap(__float_as_uint(v), __float_as_uint(v), false, false); return fmaxf(__uint_as_float(rr[0]), __uint_as_float(rr[1])); }
__device__ __forceinline__ float xhalf_sum(float v) { auto rr = __builtin_amdgcn_permlane32_swap(__float_as_uint(v), __float_as_uint(v), false, false); return __uint_as_float(rr[0]) + __uint_as_float(rr[1]); }

struct P {
    const float *x_in, *g_mix, *w_in, *win_sink, *ax_q_norm, *ax_k_norm, *mla_q_norm, *mla_kv_norm, *mla_w_uq, *mla_w_ukv, *g_group, *w_out,
        *g_ffn, *peer_w_q, *peer_sub_keys, *peer_u, *peer_v, *g_final;
    float* out;
    float* x; bf16_t* hnb; bf16_t* zb; QKV q; bf16_t* ob; bf16_t* qp; int* eidx; float* gate;
    bf16_t *cqn, *ckvn, *qfull, *kvfull;
    bf16_t *winT, *woutT, *wqT, *subk, *wuqT, *wukvT;
    unsigned char *u8, *v8; float *su, *sv; float* ssq2; bf16_t* xb2; float* ssqd;
    Tables tb;
    unsigned* bar;
    int flags; int pad0;
};
typedef const P __attribute__((address_space(4))) PC;
__device__ __forceinline__ PC* kargs() { PC* q = (PC*)__builtin_amdgcn_kernarg_segment_ptr(); asm volatile("" : "+s"(q)); return q; }

struct EpiStoreBf16 {
    bf16_t* C; int ldc; int N;
    __device__ __forceinline__ void operator()(const f32x16 (&acc)[2][2], int mbase, int nbase, int r32, int hh) const {
#pragma unroll
        for (int mt = 0; mt < 2; ++mt)
#pragma unroll
            for (int nt = 0; nt < 2; ++nt) {
                const int n = nbase + nt * 32 + r32;
                if (n < N) {
#pragma unroll
                    for (int i = 0; i < 16; ++i) {
                        const int m = mbase + mt * 32 + crow(i, hh);
                        C[(size_t)m * ldc + n] = f2bf(acc[mt][nt][i]);
                    }
                }
            }
    }
};
struct EpiResidNorm {
    float* X; int ldx; bf16_t* XB; float* ssq;
    __device__ __forceinline__ void operator()(const f32x16 (&acc)[2][2], int mbase, int nbase, int r32, int hh) const {
#pragma unroll
        for (int mt = 0; mt < 2; ++mt) {
#pragma unroll
            for (int i = 0; i < 16; ++i) {
                const int m = mbase + mt * 32 + crow(i, hh);
                float sq = 0.f;
#pragma unroll
                for (int nt = 0; nt < 2; ++nt) {
                    const int n = nbase + nt * 32 + r32;
                    float* px = X + (size_t)m * ldx + n;
                    const float v = *px + acc[mt][nt][i];
                    *px = v;
                    XB[(size_t)m * ldx + n] = f2bf(v);
                    sq += v * v;
                }
                sq += __shfl_xor(sq, 1); sq += __shfl_xor(sq, 2); sq += __shfl_xor(sq, 4); sq += __shfl_xor(sq, 8); sq += __shfl_xor(sq, 16);
                if (r32 == 0) ssq[(size_t)m * 16 + (nbase >> 6)] = sq;
            }
        }
    }
};
struct EpiStoreBf16RowNorm {
    bf16_t* C; int ldc; const float* ssq;
    __device__ __forceinline__ void operator()(const f32x16 (&acc)[2][2], int mbase, int nbase, int r32, int hh) const {
#pragma unroll
        for (int mt = 0; mt < 2; ++mt)
#pragma unroll
            for (int i = 0; i < 16; ++i) {
                const int m = mbase + mt * 32 + crow(i, hh);
                const float4 q0 = *(const float4*)(ssq + (size_t)m * 16), q1 = *(const float4*)(ssq + (size_t)m * 16 + 4);
                const float4 q2 = *(const float4*)(ssq + (size_t)m * 16 + 8), q3 = *(const float4*)(ssq + (size_t)m * 16 + 12);
                const float tot = (((q0.x + q0.y) + (q0.z + q0.w)) + ((q1.x + q1.y) + (q1.z + q1.w))) + (((q2.x + q2.y) + (q2.z + q2.w)) + ((q3.x + q3.y) + (q3.z + q3.w)));
                const float r = rsqrtf(tot * (1.f / DM) + 1e-6f);
#pragma unroll
                for (int nt = 0; nt < 2; ++nt) C[(size_t)m * ldc + nbase + nt * 32 + r32] = f2bf(acc[mt][nt][i] * r);
            }
    }
};
struct EpiResidF32 {
    float* X; int ldx;
    __device__ __forceinline__ void operator()(const f32x16 (&acc)[2][2], int mbase, int nbase, int r32, int hh) const {
#pragma unroll
        for (int mt = 0; mt < 2; ++mt)
#pragma unroll
            for (int nt = 0; nt < 2; ++nt) {
                const int n = nbase + nt * 32 + r32;
#pragma unroll
                for (int i = 0; i < 16; ++i) {
                    const int m = mbase + mt * 32 + crow(i, hh);
                    float* p = X + (size_t)m * ldx + n;
                    *p = *p + acc[mt][nt][i];
                }
            }
    }
};

__device__ __forceinline__ void glds16(const void* gsrc, unsigned lds_dst) {
    unsigned keep;
    asm volatile("s_mov_b32 %0, m0\n\ts_mov_b32 m0, %2\n\ts_nop 0\n\tglobal_load_lds_dwordx4 %1, off\n\ts_mov_b32 m0, %0" : "=&s"(keep) : "v"(gsrc), "s"(lds_dst) : "memory");
}

template <class Epi>
__device__ __forceinline__ void gemm_tile(const bf16_t* __restrict__ X, int ldx, const bf16_t* __restrict__ W, int ldw, int K, int m0, int n0, int N,
                                          char* lds, const Epi& epi) {
    const int tid = tid_opaque(), lane = tid & 63, wave = tid >> 6;
    const int wm = wave >> 1, wn = wave & 1;
    const int r32 = lane & 31, hh = lane >> 5;
    const char* xsrc[4]; const char* wsrc[4];
#pragma unroll
    for (int j = 0; j < 4; ++j) {
        const int row = (wave * 4 + j) * 8 + (lane >> 3), slot = lane & 7;
        const int c = slot ^ ((row >> 1) & 7);
        xsrc[j] = (const char*)(X + (size_t)(m0 + row) * ldx + c * 8);
        int n = n0 + row; n = n < N ? n : N - 1;
        wsrc[j] = (const char*)(W + (size_t)n * ldw + c * 8);
    }
    const unsigned lbase = (unsigned)(uintptr_t)lds;
    const unsigned wpiece = __builtin_amdgcn_readfirstlane(wave) * 4096u;
    f32x16 acc[2][2];
#pragma unroll
    for (int a = 0; a < 2; ++a)
#pragma unroll
        for (int b = 0; b < 2; ++b)
#pragma unroll
            for (int i = 0; i < 16; ++i) acc[a][b][i] = 0.f;
    const int nk = K >> 6;
#define GDMA(KT, BUF) do { const unsigned _d = lbase + (BUF) * 32768u + wpiece; const int _ko = (KT) * 128; \
        glds16(xsrc[0] + _ko, _d); glds16(xsrc[1] + _ko, _d + 1024u); glds16(xsrc[2] + _ko, _d + 2048u); glds16(xsrc[3] + _ko, _d + 3072u); \
        glds16(wsrc[0] + _ko, _d + 16384u); glds16(wsrc[1] + _ko, _d + 17408u); glds16(wsrc[2] + _ko, _d + 18432u); glds16(wsrc[3] + _ko, _d + 19456u); } while (0)
    GDMA(0, 0);
    asm volatile("s_waitcnt vmcnt(0)" ::: "memory");
    __syncthreads();
    for (int kt = 0; kt < nk; ++kt) {
        if (kt + 1 < nk) GDMA(kt + 1, (kt + 1) & 1);
        const char* xs = lds + (kt & 1) * 32768; const char* ws = xs + 16384;
#pragma unroll
        for (int ks = 0; ks < 4; ++ks) {
            bf16x8 xf[2], wf[2];
#pragma unroll
            for (int mt = 0; mt < 2; ++mt) { const int r = wm * 64 + mt * 32 + r32; xf[mt] = *(const bf16x8*)(xs + r * 128 + (((ks * 2 + hh) ^ ((r >> 1) & 7)) << 4)); }
#pragma unroll
            for (int nt = 0; nt < 2; ++nt) { const int r = wn * 64 + nt * 32 + r32; wf[nt] = *(const bf16x8*)(ws + r * 128 + (((ks * 2 + hh) ^ ((r >> 1) & 7)) << 4)); }
#pragma unroll
            for (int mt = 0; mt < 2; ++mt)
#pragma unroll
                for (int nt = 0; nt < 2; ++nt) acc[mt][nt] = __builtin_amdgcn_mfma_f32_32x32x16_bf16(xf[mt], wf[nt], acc[mt][nt], 0, 0, 0);
        }
        asm volatile("s_waitcnt vmcnt(0)" ::: "memory");
        __syncthreads();
    }
#undef GDMA
    epi(acc, m0 + wm * 64, n0 + wn * 64, r32, hh);
}

__device__ __forceinline__ void tile_map(int tile, int ntm, int ntn, int& mt, int& nt) {
    if ((ntn & 7) == 0) {
        const int G = gridDim.x;
        const int round = tile / G, bi = tile % G;
        const int x = bi & 7, j = bi >> 3;
        const int per = G >> 3;
        const int id = (round * 8 + x) * per + j;
        const int st = id >> 6, in = id & 63;
        const int snt = ntn >> 3;
        const int sm = st / snt, sn = st % snt;
        mt = sm * 8 + (in >> 3); nt = sn * 8 + (in & 7);
    } else { mt = tile / ntn; nt = tile % ntn; }
}

template <class Epi, int KGROUP>
__device__ __forceinline__ void gemm_tile_rows(const bf16_t* __restrict__ X, int ldx, const bf16_t* __restrict__ W, int ldw, int K, int m0, int n0, int N,
                                               char* lds, const Epi& epi) {
    const int tid = tid_opaque(), lane = tid & 63, wave = tid >> 6;
    const int wm = wave >> 1, wn = wave & 1;
    const int r32 = lane & 31, hh = lane >> 5;
    const char* xsrc[4]; const char* wsrc[4];
#pragma unroll
    for (int j = 0; j < 4; ++j) {
        const int row = (wave * 4 + j) * 8 + (lane >> 3), slot = lane & 7;
        const int c = slot ^ ((row >> 1) & 7);
        xsrc[j] = (const char*)(X + (size_t)(m0 + row) * ldx + c * 8);
        int n = n0 + row; n = n < N ? n : N - 1;
        wsrc[j] = (const char*)(W + (size_t)n * ldw + c * 8);
    }
    const unsigned lbase = (unsigned)(uintptr_t)lds;
    const unsigned wpiece = __builtin_amdgcn_readfirstlane(wave) * 4096u;
    f32x16 acc[2][2], tot[2][2];
#pragma unroll
    for (int a = 0; a < 2; ++a)
#pragma unroll
        for (int b = 0; b < 2; ++b)
#pragma unroll
            for (int i = 0; i < 16; ++i) { acc[a][b][i] = 0.f; tot[a][b][i] = 0.f; }
    const float* gtab = (const float*)(lds + 65536);
    const int nk = K >> 6;
#define GDMA(KT, BUF) do { const unsigned _d = lbase + (BUF) * 32768u + wpiece; const int _ko = (KT) * 128; \
        glds16(xsrc[0] + _ko, _d); glds16(xsrc[1] + _ko, _d + 1024u); glds16(xsrc[2] + _ko, _d + 2048u); glds16(xsrc[3] + _ko, _d + 3072u); \
        glds16(wsrc[0] + _ko, _d + 16384u); glds16(wsrc[1] + _ko, _d + 17408u); glds16(wsrc[2] + _ko, _d + 18432u); glds16(wsrc[3] + _ko, _d + 19456u); } while (0)
    GDMA(0, 0);
    if (KGROUP > 0) epi.table((float*)(lds + 65536), m0, tid);
    asm volatile("s_waitcnt vmcnt(0)" ::: "memory");
    __syncthreads();
    for (int kt = 0; kt < nk; ++kt) {
        if (kt + 1 < nk) GDMA(kt + 1, (kt + 1) & 1);
        const char* xs = lds + (kt & 1) * 32768; const char* ws = xs + 16384;
#pragma unroll
        for (int ks = 0; ks < 4; ++ks) {
            bf16x8 xf[2], wf[2];
#pragma unroll
            for (int mt = 0; mt < 2; ++mt) { const int r = wm * 64 + mt * 32 + r32; xf[mt] = *(const bf16x8*)(xs + r * 128 + (((ks * 2 + hh) ^ ((r >> 1) & 7)) << 4)); }
#pragma unroll
            for (int nt = 0; nt < 2; ++nt) { const int r = wn * 64 + nt * 32 + r32; wf[nt] = *(const bf16x8*)(ws + r * 128 + (((ks * 2 + hh) ^ ((r >> 1) & 7)) << 4)); }
#pragma unroll
            for (int mt = 0; mt < 2; ++mt)
#pragma unroll
                for (int nt = 0; nt < 2; ++nt) acc[mt][nt] = __builtin_amdgcn_mfma_f32_32x32x16_bf16(xf[mt], wf[nt], acc[mt][nt], 0, 0, 0);
        }
        if (KGROUP > 0) {
            if (((kt + 1) % (KGROUP > 0 ? KGROUP : 1)) == 0) {
                const int g = kt / (KGROUP > 0 ? KGROUP : 1);
#pragma unroll
                for (int mt = 0; mt < 2; ++mt)
#pragma unroll
                    for (int i = 0; i < 16; ++i) {
                        const float sc = gtab[(wm * 64 + mt * 32 + crow(i, hh)) * 4 + g];
#pragma unroll
                        for (int nt = 0; nt < 2; ++nt) { tot[mt][nt][i] += sc * acc[mt][nt][i]; acc[mt][nt][i] = 0.f; }
                    }
            }
        }
        asm volatile("s_waitcnt vmcnt(0)" ::: "memory");
        __syncthreads();
    }
#undef GDMA
    float* ct = (float*)lds;
#pragma unroll
    for (int mt = 0; mt < 2; ++mt)
#pragma unroll
        for (int nt = 0; nt < 2; ++nt)
#pragma unroll
            for (int i = 0; i < 16; ++i)
                ct[(wm * 64 + mt * 32 + crow(i, hh)) * CT_STRIDE + wn * 64 + nt * 32 + r32] = (KGROUP > 0) ? tot[mt][nt][i] : acc[mt][nt][i];
    __syncthreads();
    epi.begin(ct, m0, n0, tid);
#pragma unroll
    for (int pass = 0; pass < 8; ++pass) {
        const int half = pass & 1, row = (pass >> 1) * 32 + (tid >> 3), c = tid & 7;
        epi.chunk(ct + row * CT_STRIDE + half * 64 + c * 8, m0 + row, n0 + half * 64, c, row);
    }
    __syncthreads();
}

template <class Epi, int KGROUP>
__device__ __forceinline__ void gemm_phase_rows(const bf16_t* X, int ldx, const bf16_t* W, int ldw, int M, int N, int K, char* lds, const Epi& epi) {
    const int ntm = M >> 7, ntn = (N + 127) >> 7, nt_tot = ntm * ntn;
    for (int tile = blockIdx.x; tile < nt_tot; tile += gridDim.x) {
        int mt, nt;
        if ((gridDim.x & 7) == 0 && ((gridDim.x >> 3) & 63) == 0) tile_map(tile, ntm, ntn, mt, nt);
        else { mt = tile / ntn; nt = tile % ntn; }
        if (mt < ntm && nt < ntn) gemm_tile_rows<Epi, KGROUP>(X, ldx, W, ldw, K, mt * 128, nt * 128, N, lds, epi);
    }
}

__device__ __forceinline__ uint4 pack8(const float4& a, const float4& b) { return make_uint4(cvtpk(a.x, a.y), cvtpk(a.z, a.w), cvtpk(b.x, b.y), cvtpk(b.z, b.w)); }
__device__ __forceinline__ float sum8(float v) { v += __shfl_xor(v, 1); v += __shfl_xor(v, 2); v += __shfl_xor(v, 4); return v; }

struct RowsStoreBf16 {
    bf16_t* C; int ldc; int N;
    __device__ __forceinline__ void table(float*, int, int) const {}
    __device__ __forceinline__ void begin(float*, int, int, int) const {}
    __device__ __forceinline__ void chunk(const float* t, int m, int n, int c, int) const {
        if (n + 8 * c < N) *(uint4*)(C + (size_t)m * ldc + n + 8 * c) = pack8(*(const float4*)t, *(const float4*)(t + 4));
    }
};
struct RowsResidF32 {
    float* X; int ldx;
    __device__ __forceinline__ void table(float*, int, int) const {}
    __device__ __forceinline__ void begin(float*, int, int, int) const {}
    __device__ __forceinline__ void chunk(const float* t, int m, int n, int c, int) const {
        float* px = X + (size_t)m * ldx + n + 8 * c;
        float4 v0 = *(const float4*)px, v1 = *(const float4*)(px + 4);
        const float4 a0 = *(const float4*)t, a1 = *(const float4*)(t + 4);
        v0.x += a0.x; v0.y += a0.y; v0.z += a0.z; v0.w += a0.w; v1.x += a1.x; v1.y += a1.y; v1.z += a1.z; v1.w += a1.w;
        *(float4*)px = v0; *(float4*)(px + 4) = v1;
    }
};
struct RowsResidNorm {
    float* X; int ldx; bf16_t* XB; float* ssq;
    __device__ __forceinline__ void table(float*, int, int) const {}
    __device__ __forceinline__ void begin(float*, int, int, int) const {}
    __device__ __forceinline__ void chunk(const float* t, int m, int n, int c, int) const {
        float* px = X + (size_t)m * ldx + n + 8 * c;
        float4 v0 = *(const float4*)px, v1 = *(const float4*)(px + 4);
        const float4 a0 = *(const float4*)t, a1 = *(const float4*)(t + 4);
        v0.x += a0.x; v0.y += a0.y; v0.z += a0.z; v0.w += a0.w; v1.x += a1.x; v1.y += a1.y; v1.z += a1.z; v1.w += a1.w;
        *(float4*)px = v0; *(float4*)(px + 4) = v1;
        *(uint4*)(XB + (size_t)m * ldx + n + 8 * c) = pack8(v0, v1);
        const float sq = sum8((v0.x * v0.x + v0.y * v0.y) + (v0.z * v0.z + v0.w * v0.w) + (v1.x * v1.x + v1.y * v1.y) + (v1.z * v1.z + v1.w * v1.w));
        if (c == 0) ssq[((size_t)(n >> 7) * T_TOK + m) * 2 + ((n >> 6) & 1)] = sq;
    }
};
struct RowsResidNormG : RowsResidNorm {
    const bf16_t* O;
    __device__ __forceinline__ void table(float* tab, int m0, int tid) const {
        const int c = tid & 7, lg = tid >> 3;
#pragma unroll
        for (int it = 0; it < 4; ++it) {
            uint4 w[4][4];
#pragma unroll
            for (int u = 0; u < 4; ++u) {
                const int item = (it * 4 + u) * 32 + lg;
                const uint4* src = (const uint4*)(O + (size_t)(m0 + (item >> 2)) * DM + (item & 3) * 256) + c;
#pragma unroll
                for (int k = 0; k < 4; ++k) w[u][k] = src[8 * k];
            }
#pragma unroll
            for (int u = 0; u < 4; ++u) {
                float ss = 0.f;
#pragma unroll
                for (int k = 0; k < 4; ++k) {
                    const uint4 q = w[u][k];
                    const float a0 = __uint_as_float(q.x << 16), a1 = __uint_as_float(q.x & 0xffff0000u), a2 = __uint_as_float(q.y << 16), a3 = __uint_as_float(q.y & 0xffff0000u);
                    const float a4 = __uint_as_float(q.z << 16), a5 = __uint_as_float(q.z & 0xffff0000u), a6 = __uint_as_float(q.w << 16), a7 = __uint_as_float(q.w & 0xffff0000u);
                    ss += (a0 * a0 + a1 * a1) + (a2 * a2 + a3 * a3) + (a4 * a4 + a5 * a5) + (a6 * a6 + a7 * a7);
                }
                ss = sum8(ss);
                if (c == 0) tab[(it * 4 + u) * 32 + lg] = rsqrtf(ss * (1.f / 256.f) + 1e-6f);
            }
        }
    }
};
struct RowsStoreBf16RowNorm {
    bf16_t* C; int ldc; const float* ssq;
    __device__ __forceinline__ void table(float*, int, int) const {}
    __device__ __forceinline__ void begin(float* ct, int m0, int, int tid) const {
        if (tid < 128) {
            float tot = 0.f;
#pragma unroll
            for (int j = 0; j < 8; ++j) { const float2 q = *(const float2*)(ssq + ((size_t)j * T_TOK + m0 + tid) * 2); tot += q.x + q.y; }
            ct[tid * CT_STRIDE + 128] = rsqrtf(tot * (1.f / DM) + 1e-6f);
        }
        __syncthreads();
    }
    __device__ __forceinline__ void chunk(const float* t, int m, int n, int c, int row) const {
        const float r = (t - (n & 64) - 8 * c)[128];
        const float4 a = *(const float4*)t, b = *(const float4*)(t + 4);
        *(uint4*)(C + (size_t)m * ldc + n + 8 * c) = make_uint4(cvtpk(a.x * r, a.y * r), cvtpk(a.z * r, a.w * r), cvtpk(b.x * r, b.y * r), cvtpk(b.z * r, b.w * r));
    }
};

struct F8 { float4 a, b; };
__device__ __forceinline__ F8 f8_load(const float* p) { F8 r; r.a = *(const float4*)p; r.b = *(const float4*)(p + 4); return r; }
__device__ __forceinline__ F8 f8_shfl_xor(const F8& v, int m) {
    F8 r; r.a.x = __shfl_xor(v.a.x, m); r.a.y = __shfl_xor(v.a.y, m); r.a.z = __shfl_xor(v.a.z, m); r.a.w = __shfl_xor(v.a.w, m);
    r.b.x = __shfl_xor(v.b.x, m); r.b.y = __shfl_xor(v.b.y, m); r.b.z = __shfl_xor(v.b.z, m); r.b.w = __shfl_xor(v.b.w, m); return r;
}
__device__ __forceinline__ float f8_ssq(const F8& v) { return (v.a.x * v.a.x + v.a.y * v.a.y) + (v.a.z * v.a.z + v.a.w * v.a.w) + (v.b.x * v.b.x + v.b.y * v.b.y) + (v.b.z * v.b.z + v.b.w * v.b.w); }
__device__ __forceinline__ uint4 f8_rope_pack(const F8& v, const F8& pv, const F8& cs, const F8& sn, float sg, float sc) {
    return make_uint4(cvtpk((v.a.x * cs.a.x + sg * pv.a.x * sn.a.x) * sc, (v.a.y * cs.a.y + sg * pv.a.y * sn.a.y) * sc),
                      cvtpk((v.a.z * cs.a.z + sg * pv.a.z * sn.a.z) * sc, (v.a.w * cs.a.w + sg * pv.a.w * sn.a.w) * sc),
                      cvtpk((v.b.x * cs.b.x + sg * pv.b.x * sn.b.x) * sc, (v.b.y * cs.b.y + sg * pv.b.y * sn.b.y) * sc),
                      cvtpk((v.b.z * cs.b.z + sg * pv.b.z * sn.b.z) * sc, (v.b.w * cs.b.w + sg * pv.b.w * sn.b.w) * sc));
}
#define QKV_MIX(mi) ((size_t)(mi) * 512 * T_TOK)
#define QKV_K (256 * (size_t)T_TOK)
#define QKV_V (384 * (size_t)T_TOK)
#define QKV_KD (1920 * (size_t)T_TOK)
struct RowsPostZ {
    bf16_t* qkv; const float* tb; const float* g_qn; const float* g_kn; bf16_t* lat; float* ssqd; bf16_t* kD;
    __device__ __forceinline__ void table(float*, int, int) const {}
    __device__ __forceinline__ void begin(float*, int, int, int) const {}
    __device__ __forceinline__ void chunk(const float* t, int m, int n, int c, int) const {
        const int qc = n >> 6;
        const int b = m / SEQ, s = m % SEQ;
        F8 v = f8_load(t);
        const float scA = 0.125f * LOG2E;
        if (qc < 6 || (qc >= 16 && qc < 22)) {
            const int mi = qc >= 16 ? 2 : 0; const int ql = qc - 8 * mi;
            const F8 pv = f8_shfl_xor(v, 4);
            const int j0 = 8 * (c & 3);
            const F8 cs = f8_load(tb + s * 32 + j0), sn = f8_load(tb + 131072 + s * 32 + j0);
            const size_t off = QKV_MIX(mi) + (ql < 4 ? ((size_t)(b * 4 + ql) * SEQ + s) * 64 : QKV_K + ((size_t)(b * 2 + (ql - 4)) * SEQ + s) * 64);
            *(uint4*)(qkv + off + 8 * c) = f8_rope_pack(v, pv, cs, sn, (c < 4) ? -1.f : 1.f, (ql < 4) ? scA : 1.f);
        } else if (qc == 6 || qc == 7 || qc == 14 || qc == 15 || qc == 22 || qc == 23) {
            *(uint4*)(qkv + QKV_MIX(qc >> 3) + QKV_V + ((size_t)(b * 2 + (qc & 1)) * SEQ + s) * 64 + 8 * c) = pack8(v.a, v.b);
        } else if (qc >= 8 && qc < 14) {
            const bool isq = qc < 12; const int h = isq ? qc - 8 : qc - 12;
            const float r = rsqrtf(sum8(f8_ssq(v)) * (1.f / 64.f) + 1e-6f);
            const F8 gq = f8_load(g_qn + 8 * c), gk = f8_load(g_kn + 8 * c);
            v.a.x *= r * (isq ? gq.a.x : gk.a.x); v.a.y *= r * (isq ? gq.a.y : gk.a.y); v.a.z *= r * (isq ? gq.a.z : gk.a.z); v.a.w *= r * (isq ? gq.a.w : gk.a.w);
            v.b.x *= r * (isq ? gq.b.x : gk.b.x); v.b.y *= r * (isq ? gq.b.y : gk.b.y); v.b.z *= r * (isq ? gq.b.z : gk.b.z); v.b.w *= r * (isq ? gq.b.w : gk.b.w);
            const F8 pv = f8_shfl_xor(v, 2);
            const int jj0 = 8 * (c & 1);
            const int to = (c < 4) ? 393216 + (s >> 6) * 16 : 395264 + (s & 63) * 16;
            const F8 cs = f8_load(tb + to + jj0), sn = f8_load(tb + to + 1024 + jj0);
            const size_t off = QKV_MIX(1) + (isq ? ((size_t)(b * 4 + h) * SEQ + s) * 64 : QKV_K + ((size_t)(b * 2 + h) * SEQ + s) * 64);
            *(uint4*)(qkv + off + 8 * c) = f8_rope_pack(v, pv, cs, sn, (c & 2) ? 1.f : -1.f, isq ? scA : 1.f);
        } else if (qc >= 24 && qc < 30) {
            const float ss = sum8(f8_ssq(v));
            const size_t off = qc < 28 ? (size_t)m * 256 + (qc - 24) * 64 : (size_t)T_TOK * 256 + (size_t)m * 128 + (qc - 28) * 64;
            *(uint4*)(lat + off + 8 * c) = pack8(v.a, v.b);
            if (c == 0) ssqd[(size_t)(qc - 24) * T_TOK + m] = ss;
        } else if (qc == 30) {
            const F8 pv = f8_shfl_xor(v, 2);
            if (c < 4) {
                const int i0 = 8 * (c & 1);
                const F8 cs = f8_load(tb + 262144 + s * 16 + i0), sn = f8_load(tb + 327680 + s * 16 + i0);
                const uint4 w = f8_rope_pack(v, pv, cs, sn, (c & 2) ? 1.f : -1.f, 1.f);
#pragma unroll
                for (int h = 0; h < 4; ++h) *(uint4*)(kD + ((size_t)(b * 4 + h) * SEQ + s) * 96 + 64 + 8 * c) = w;
            }
        }
    }
};
template <int NS, int DIM>
struct RowsStoreBf16Scale {
    bf16_t* C; int ldc; int N; const float* ssq;
    __device__ __forceinline__ void table(float*, int, int) const {}
    __device__ __forceinline__ void begin(float* ct, int m0, int, int tid) const {
        if (tid < 128) {
            float tot = 0.f;
#pragma unroll
            for (int j = 0; j < NS; ++j) tot += ssq[(size_t)j * T_TOK + m0 + tid];
            ct[tid * CT_STRIDE + 128] = rsqrtf(tot * (1.f / DIM) + 1e-6f);
        }
        __syncthreads();
    }
    __device__ __forceinline__ void chunk(const float* t, int m, int n, int c, int) const {
        const float r = (t - (n & 64) - 8 * c)[128];
        const float4 a = *(const float4*)t, b = *(const float4*)(t + 4);
        if (n + 8 * c < N) *(uint4*)(C + (size_t)m * ldc + n + 8 * c) = make_uint4(cvtpk(a.x * r, a.y * r), cvtpk(a.z * r, a.w * r), cvtpk(b.x * r, b.y * r), cvtpk(b.z * r, b.w * r));
    }
};

struct RowsPostQ {
    bf16_t* qD; const float* tb; const float* ssq;
    __device__ __forceinline__ void table(float*, int, int) const {}
    __device__ __forceinline__ void begin(float* ct, int m0, int, int tid) const {
        if (tid < 128) {
            const float tot = (ssq[m0 + tid] + ssq[(size_t)T_TOK + m0 + tid]) + (ssq[(size_t)2 * T_TOK + m0 + tid] + ssq[(size_t)3 * T_TOK + m0 + tid]);
            ct[tid * CT_STRIDE + 128] = rsqrtf(tot * (1.f / 256.f) + 1e-6f) * (0.10206207261596575f * LOG2E);
        }
        __syncthreads();
    }
    __device__ __forceinline__ void chunk(const float* t, int m, int n, int c, int) const {
        const float r = (t - (n & 64) - 8 * c)[128];
        const int qc = n >> 6, b = m / SEQ, s = m % SEQ;
        F8 v = f8_load(t);
        v.a.x *= r; v.a.y *= r; v.a.z *= r; v.a.w *= r; v.b.x *= r; v.b.y *= r; v.b.z *= r; v.b.w *= r;
        if (qc < 4) {
            *(uint4*)(qD + ((size_t)(b * 4 + qc) * SEQ + s) * 128 + 8 * c) = pack8(v.a, v.b);
        } else {
            const F8 pv = f8_shfl_xor(v, 2);
            const int h = (qc - 4) * 2 + (c >> 2), i0 = 8 * (c & 1);
            const F8 cs = f8_load(tb + 262144 + s * 16 + i0), sn = f8_load(tb + 327680 + s * 16 + i0);
            *(uint4*)(qD + ((size_t)(b * 4 + h) * SEQ + s) * 128 + 64 + 8 * (c & 3)) = f8_rope_pack(v, pv, cs, sn, (c & 2) ? 1.f : -1.f, 1.f);
        }
    }
};
struct RowsPostKV {
    bf16_t* kD; bf16_t* vD; const float* ssq;
    __device__ __forceinline__ void table(float*, int, int) const {}
    __device__ __forceinline__ void begin(float* ct, int m0, int, int tid) const {
        if (tid < 128) ct[tid * CT_STRIDE + 128] = rsqrtf((ssq[m0 + tid] + ssq[(size_t)T_TOK + m0 + tid]) * (1.f / 128.f) + 1e-6f);
        __syncthreads();
    }
    __device__ __forceinline__ void chunk(const float* t, int m, int n, int c, int) const {
        const float r = (t - (n & 64) - 8 * c)[128];
        const int qc = n >> 6, h = qc >> 1, b = m / SEQ, s = m % SEQ;
        F8 v = f8_load(t);
        v.a.x *= r; v.a.y *= r; v.a.z *= r; v.a.w *= r; v.b.x *= r; v.b.y *= r; v.b.z *= r; v.b.w *= r;
        const size_t hb = (size_t)(b * 4 + h) * SEQ + s;
        const size_t off = (qc & 1) ? hb * 64 : hb * 96;
        bf16_t* base = (bf16_t*)((qc & 1) ? (size_t)vD : (size_t)kD);
        *(uint4*)(base + off + 8 * c) = pack8(v.a, v.b);
    }
};

template <class Epi>
__device__ __forceinline__ void gemm_phase(const bf16_t* X, int ldx, const bf16_t* W, int ldw, int M, int N, int K, char* lds, const Epi& epi) {
    const int ntm = M >> 7, ntn = (N + 127) >> 7, nt_tot = ntm * ntn;
    for (int tile = blockIdx.x; tile < nt_tot; tile += gridDim.x) {
        int mt, nt;
        if ((gridDim.x & 7) == 0 && (gridDim.x >> 3) * 8 == gridDim.x && ((gridDim.x >> 3) & 63) == 0) tile_map(tile, ntm, ntn, mt, nt);
        else { mt = tile / ntn; nt = tile % ntn; }
        if (mt < ntm && nt < ntn) gemm_tile(X, ldx, W, ldw, K, mt * 128, nt * 128, N, lds, epi);
    }
}

template <int OFF> __device__ __forceinline__ s16x4 tr_read(int vb) {
    s16x4 r; asm volatile("ds_read_b64_tr_b16 %0, %1 offset:%2" : "=&v"(r) : "v"(vb), "i"(OFF) : "memory"); return r;
}
#define VS_BYTES 192

template <int KT2>
__device__ __forceinline__ void pv_sub(f32x16 (&o)[2], const f32x16& p, int vbase) {
    bf16x8 pf[2];
#pragma unroll
    for (int s2 = 0; s2 < 2; ++s2) {
        unsigned a = cvtpk(p[8 * s2 + 0], p[8 * s2 + 1]), b = cvtpk(p[8 * s2 + 2], p[8 * s2 + 3]);
        unsigned c = cvtpk(p[8 * s2 + 4], p[8 * s2 + 5]), d = cvtpk(p[8 * s2 + 6], p[8 * s2 + 7]);
        uint4 w = make_uint4(a, b, c, d);
        pf[s2] = *(bf16x8*)&w;
    }
    {
        s16x4 l00 = tr_read<(KT2 * 32 + 0) * VS_BYTES + 0>(vbase), h00 = tr_read<(KT2 * 32 + 8) * VS_BYTES + 0>(vbase);
        s16x4 l01 = tr_read<(KT2 * 32 + 0) * VS_BYTES + 64>(vbase), h01 = tr_read<(KT2 * 32 + 8) * VS_BYTES + 64>(vbase);
        s16x4 l10 = tr_read<(KT2 * 32 + 16) * VS_BYTES + 0>(vbase), h10 = tr_read<(KT2 * 32 + 24) * VS_BYTES + 0>(vbase);
        s16x4 l11 = tr_read<(KT2 * 32 + 16) * VS_BYTES + 64>(vbase), h11 = tr_read<(KT2 * 32 + 24) * VS_BYTES + 64>(vbase);
        asm volatile("s_waitcnt lgkmcnt(0)" ::: "memory");
        __builtin_amdgcn_sched_barrier(0);
#define PKV(L, H) (bf16x8){L[0], L[1], L[2], L[3], H[0], H[1], H[2], H[3]}
        o[0] = __builtin_amdgcn_mfma_f32_32x32x16_bf16(PKV(l00, h00), pf[0], o[0], 0, 0, 0);
        o[1] = __builtin_amdgcn_mfma_f32_32x32x16_bf16(PKV(l01, h01), pf[0], o[1], 0, 0, 0);
        o[0] = __builtin_amdgcn_mfma_f32_32x32x16_bf16(PKV(l10, h10), pf[1], o[0], 0, 0, 0);
        o[1] = __builtin_amdgcn_mfma_f32_32x32x16_bf16(PKV(l11, h11), pf[1], o[1], 0, 0, 0);
#undef PKV
    }
}


#define PV_LOAD(KT2, VB, F) \
    const s16x4 F##0 = tr_read<((KT2) * 32 + 0) * VS_BYTES + 0>(VB), F##1 = tr_read<((KT2) * 32 + 8) * VS_BYTES + 0>(VB), \
                F##2 = tr_read<((KT2) * 32 + 0) * VS_BYTES + 64>(VB), F##3 = tr_read<((KT2) * 32 + 8) * VS_BYTES + 64>(VB), \
                F##4 = tr_read<((KT2) * 32 + 16) * VS_BYTES + 0>(VB), F##5 = tr_read<((KT2) * 32 + 24) * VS_BYTES + 0>(VB), \
                F##6 = tr_read<((KT2) * 32 + 16) * VS_BYTES + 64>(VB), F##7 = tr_read<((KT2) * 32 + 24) * VS_BYTES + 64>(VB)
#define PKV2(L, H) (bf16x8){L[0], L[1], L[2], L[3], H[0], H[1], H[2], H[3]}
#define PV_MMA(O, P, F) do { bf16x8 _pf0, _pf1; \
        { uint4 _w = make_uint4(cvtpk(P[0], P[1]), cvtpk(P[2], P[3]), cvtpk(P[4], P[5]), cvtpk(P[6], P[7])); _pf0 = *(bf16x8*)&_w; } \
        { uint4 _w = make_uint4(cvtpk(P[8], P[9]), cvtpk(P[10], P[11]), cvtpk(P[12], P[13]), cvtpk(P[14], P[15])); _pf1 = *(bf16x8*)&_w; } \
        O[0] = __builtin_amdgcn_mfma_f32_32x32x16_bf16(PKV2(F##0, F##1), _pf0, O[0], 0, 0, 0); \
        O[1] = __builtin_amdgcn_mfma_f32_32x32x16_bf16(PKV2(F##2, F##3), _pf0, O[1], 0, 0, 0); \
        O[0] = __builtin_amdgcn_mfma_f32_32x32x16_bf16(PKV2(F##4, F##5), _pf1, O[0], 0, 0, 0); \
        O[1] = __builtin_amdgcn_mfma_f32_32x32x16_bf16(PKV2(F##6, F##7), _pf1, O[1], 0, 0, 0); } while (0)

template <int DK, int G, bool WINDOW>
__device__ __forceinline__ void attn_item(const bf16_t* __restrict__ Q, const bf16_t* __restrict__ K, const bf16_t* __restrict__ V, const float* __restrict__ sink,
                                          bf16_t* __restrict__ O, int ocol, int H, int KV, int item, char* lds, int qs = DK) {
    constexpr int KS = DK * 2 + 16;
    constexpr int KCH = DK / 8;
    constexpr int KLD = (64 * KCH) / 256;
    constexpr int QB = 128 / G;
    constexpr int NCH = SEQ / QB;
    constexpr int KBUF = 64 * KS, VBUF = 64 * VS_BYTES;
    const int tid = tid_opaque(), lane = tid & 63, wave = tid >> 6;
    const int r32 = lane & 31, hh = lane >> 5;
    const int chunk = item % NCH, kvh = (item / NCH) % KV, b = item / (NCH * KV);
    const int g = (G == 2) ? (wave >> 1) : 0;
    const int qoff = (G == 2) ? (wave & 1) * 32 : wave * 32;
    const int head = kvh * G + g;
    const int q0 = chunk * QB;
    const int qpos = q0 + qoff + r32;
    bf16x8 qf[DK / 16];
    {
        const bf16_t* qp = Q + ((size_t)(b * H + head) * SEQ + qpos) * qs + hh * 8;
#pragma unroll
        for (int ks = 0; ks < DK / 16; ++ks) qf[ks] = *(const bf16x8*)(qp + ks * 16);
    }
    int kt_lo = 0, kt_hi = SEQ / 64;
    if (WINDOW) { kt_lo = q0 / 64 - 2; if (kt_lo < 0) kt_lo = 0; kt_hi = (q0 + QB) / 64 + 2; if (kt_hi > SEQ / 64) kt_hi = SEQ / 64; }
    const char* Kg = (const char*)(K + (size_t)(b * KV + kvh) * SEQ * DK);
    const char* Vg = (const char*)(V + (size_t)(b * KV + kvh) * SEQ * 64);
    uint4 kr0, kr1, kr2 = make_uint4(0, 0, 0, 0), vr0, vr1;
    int koff[KLD], voff[2];
#pragma unroll
    for (int j = 0; j < KLD; ++j) { const int id = tid + 256 * j; koff[j] = (id / KCH) * KS + (id % KCH) * 16; }
#pragma unroll
    for (int j = 0; j < 2; ++j) { const int id = tid + 256 * j; voff[j] = (id >> 3) * VS_BYTES + (id & 7) * 16; }
    f32x16 o[2];
#pragma unroll
    for (int d = 0; d < 2; ++d)
#pragma unroll
        for (int i = 0; i < 16; ++i) o[d][i] = 0.f;
    float m = -1e30f, l = 0.f;
    if (WINDOW) { m = sink[head] * LOG2E; l = (hh == 0) ? 1.f : 0.f; }
    const int gg = lane >> 4, li = lane & 15;
    const int vlane = (4 * (gg >> 1) + (li >> 2)) * VS_BYTES + (16 * (gg & 1) + 4 * (li & 3)) * 2;
    char* Kl = lds; char* Vl = lds + 2 * KBUF;
#define AGLOAD(KT) do { const char* _kg = Kg + (size_t)(KT) * 64 * DK * 2; const char* _vg = Vg + (size_t)(KT) * 64 * 128; \
        kr0 = *(const uint4*)(_kg + tid * 16); kr1 = *(const uint4*)(_kg + (tid + 256) * 16); if (KLD > 2) kr2 = *(const uint4*)(_kg + (tid + 512) * 16); \
        vr0 = *(const uint4*)(_vg + tid * 16); vr1 = *(const uint4*)(_vg + (tid + 256) * 16); } while (0)
#define ASTORE(KB, VB) do { char* _kd = (KB); char* _vd = (VB); *(uint4*)(_kd + koff[0]) = kr0; *(uint4*)(_kd + koff[1]) = kr1; if (KLD > 2) *(uint4*)(_kd + koff[KLD - 1]) = kr2; \
        *(uint4*)(_vd + voff[0]) = vr0; *(uint4*)(_vd + voff[1]) = vr1; } while (0)
    AGLOAD(kt_lo);
    ASTORE(Kl, Vl);
    { const int k1 = kt_lo + 1 < kt_hi ? kt_lo + 1 : kt_lo; AGLOAD(k1); }
    __syncthreads();
    for (int kt = kt_lo; kt < kt_hi; ++kt) {
        const int cur = (kt - kt_lo) & 1;
        ASTORE(Kl + (cur ^ 1) * KBUF, Vl + (cur ^ 1) * VBUF);
        { const int ktn = kt + 2 < kt_hi ? kt + 2 : kt_hi - 1; AGLOAD(ktn); }
        __builtin_amdgcn_sched_barrier(0);
        const char* kb = Kl + cur * KBUF;
        f32x16 s0, s1;
#pragma unroll
        for (int i = 0; i < 16; ++i) { s0[i] = 0.f; s1[i] = 0.f; }
#pragma unroll
        for (int ks = 0; ks < DK / 16; ++ks) {
            bf16x8 k0 = *(const bf16x8*)(kb + r32 * KS + (ks * 2 + hh) * 16);
            bf16x8 k1 = *(const bf16x8*)(kb + (32 + r32) * KS + (ks * 2 + hh) * 16);
            s0 = __builtin_amdgcn_mfma_f32_32x32x16_bf16(k0, qf[ks], s0, 0, 0, 0);
            s1 = __builtin_amdgcn_mfma_f32_32x32x16_bf16(k1, qf[ks], s1, 0, 0, 0);
        }
        if (WINDOW) {
            const int kb0 = kt * 64 + 4 * hh - qpos;
#pragma unroll
            for (int i = 0; i < 16; ++i) {
                const int d0 = kb0 + (i & 3) + 8 * (i >> 2), d1 = d0 + 32;
                s0[i] = (d0 > 128 || d0 < -128) ? -1e30f : s0[i];
                s1[i] = (d1 > 128 || d1 < -128) ? -1e30f : s1[i];
            }
        }
        const int vbase = (int)(size_t)(Vl + cur * VBUF - lds) + vlane;
        PV_LOAD(0, vbase, vfa);
        PV_LOAD(1, vbase, vfb);
        __builtin_amdgcn_sched_barrier(0);
        float tmax = s0[0];
#pragma unroll
        for (int i = 1; i < 16; ++i) tmax = fmaxf(tmax, s0[i]);
#pragma unroll
        for (int i = 0; i < 16; ++i) tmax = fmaxf(tmax, s1[i]);
        tmax = xhalf_max(tmax);
        const float mn = fmaxf(m, tmax);
        const float alpha = __builtin_amdgcn_exp2f(m - mn);
        m = mn;
        float ps = 0.f;
#pragma unroll
        for (int i = 0; i < 16; ++i) { s0[i] = __builtin_amdgcn_exp2f(s0[i] - mn); ps += s0[i]; }
#pragma unroll
        for (int i = 0; i < 16; ++i) { s1[i] = __builtin_amdgcn_exp2f(s1[i] - mn); ps += s1[i]; }
        l = l * alpha + ps;
        if (__any(alpha != 1.f)) {
#pragma unroll
            for (int d = 0; d < 2; ++d)
#pragma unroll
                for (int i = 0; i < 16; ++i) o[d][i] *= alpha;
        }
        asm volatile("s_waitcnt lgkmcnt(0)" ::: "memory");
        __builtin_amdgcn_sched_barrier(0);
        PV_MMA(o, s0, vfa);
        PV_MMA(o, s1, vfb);
        __syncthreads();
    }
#undef AGLOAD
#undef ASTORE
    l = xhalf_sum(l);
    const float inv = 1.f / l;
    bf16_t* orow = O + (size_t)(b * SEQ + qpos) * DM + ocol + head * 64;
#pragma unroll
    for (int d = 0; d < 2; ++d)
#pragma unroll
        for (int gq = 0; gq < 4; ++gq) {
            uint2 w;
            w.x = cvtpk(o[d][gq * 4 + 0] * inv, o[d][gq * 4 + 1] * inv);
            w.y = cvtpk(o[d][gq * 4 + 2] * inv, o[d][gq * 4 + 3] * inv);
            *(uint2*)(orow + d * 32 + 8 * gq + 4 * hh) = w;
        }
}

__device__ __forceinline__ void dil_wave_item(const bf16_t* __restrict__ Q, const bf16_t* __restrict__ K, const bf16_t* __restrict__ V,
                                              bf16_t* __restrict__ O, int witem, char* wlds, int lds_off) {
    const int lane = tid_opaque() & 63, r32 = lane & 31, hh = lane >> 5;
    const int c = witem & 15, chunk = (witem >> 4) & 15, kvh = (witem >> 8) & 1, b = witem >> 9;
    const int t0 = chunk * 256;
    const int mq = r32 & 15, g = r32 >> 4;
    const int qpos = t0 + 16 * mq + c, head = kvh * 2 + g;
    bf16x8 qf[4];
    {
        const bf16_t* qp = Q + ((size_t)(b * 4 + head) * SEQ + qpos) * 64 + hh * 8;
#pragma unroll
        for (int ks = 0; ks < 4; ++ks) qf[ks] = *(const bf16x8*)(qp + ks * 16);
    }
    const bf16_t* Kg = K + (size_t)(b * 2 + kvh) * SEQ * 64;
    const bf16_t* Vg = V + (size_t)(b * 2 + kvh) * SEQ * 64;
    f32x16 o[2];
#pragma unroll
    for (int d = 0; d < 2; ++d)
#pragma unroll
        for (int i = 0; i < 16; ++i) o[d][i] = 0.f;
    float m = -1e30f, l = 0.f;
    const int gg = lane >> 4, li = lane & 15;
    const int vlane = lds_off + (4 * (gg >> 1) + (li >> 2)) * VS_BYTES + (16 * (gg & 1) + 4 * (li & 3)) * 2;
    for (int it = 0; it < 23; ++it) {
        int sh, j;
        if (it < 12) { sh = 0; j = it; } else if (it < 18) { sh = 2; j = it - 12; } else { sh = 4; j = it - 18; }
        const int rr = 1 << sh;
        const int cc = c & (rr - 1);
        const int idx0 = (t0 >> sh) - 64 + 32 * j;
        const int lim = SEQ >> sh;
        if (idx0 + 31 < 0 || idx0 >= lim) continue;
        bf16x8 kf[4];
        {
            int idx = idx0 + r32; idx = idx < 0 ? 0 : (idx >= lim ? lim - 1 : idx);
            const bf16_t* kp = Kg + (size_t)((idx << sh) + cc) * 64 + hh * 8;
#pragma unroll
            for (int ks = 0; ks < 4; ++ks) kf[ks] = *(const bf16x8*)(kp + ks * 16);
        }
        uint4 vr[4];
#pragma unroll
        for (int jj = 0; jj < 4; ++jj) {
            const int id = lane + 64 * jj; int idx = idx0 + (id >> 3); idx = idx < 0 ? 0 : (idx >= lim ? lim - 1 : idx);
            vr[jj] = *(const uint4*)(Vg + (size_t)((idx << sh) + cc) * 64 + (id & 7) * 8);
        }
#pragma unroll
        for (int jj = 0; jj < 4; ++jj) { const int id = lane + 64 * jj; *(uint4*)(wlds + (id >> 3) * VS_BYTES + (id & 7) * 16) = vr[jj]; }
        f32x16 s;
#pragma unroll
        for (int i = 0; i < 16; ++i) s[i] = 0.f;
#pragma unroll
        for (int ks = 0; ks < 4; ++ks) s = __builtin_amdgcn_mfma_f32_32x32x16_bf16(kf[ks], qf[ks], s, 0, 0, 0);
        const int qidx = qpos >> sh;
        const int base = idx0 + 4 * hh;
#pragma unroll
        for (int i = 0; i < 16; ++i) {
            const int idx = base + (i & 3) + 8 * (i >> 2);
            const int d = idx - qidx;
            s[i] = (d > 64 || d < -64 || idx < 0 || idx >= lim) ? -1e30f : s[i];
        }
        float tmax = s[0];
#pragma unroll
        for (int i = 1; i < 16; ++i) tmax = fmaxf(tmax, s[i]);
        tmax = fmaxf(tmax, xhalf(tmax));
        const float mn = fmaxf(fmaxf(m, tmax), -1e20f);
        const float alpha = __builtin_amdgcn_exp2f(m - mn);
        m = mn;
        float ps = 0.f;
#pragma unroll
        for (int i = 0; i < 16; ++i) { s[i] = __builtin_amdgcn_exp2f(s[i] - mn); ps += s[i]; }
        l = l * alpha + ps;
#pragma unroll
        for (int d = 0; d < 2; ++d)
#pragma unroll
            for (int i = 0; i < 16; ++i) o[d][i] *= alpha;
        pv_sub<0>(o, s, vlane);
    }
    l += xhalf(l);
    const float inv = 1.f / l;
    bf16_t* orow = O + (size_t)(b * SEQ + qpos) * DM + 512 + head * 64;
#pragma unroll
    for (int d = 0; d < 2; ++d)
#pragma unroll
        for (int gq = 0; gq < 4; ++gq) {
            uint2 w;
            w.x = cvtpk(o[d][gq * 4 + 0] * inv, o[d][gq * 4 + 1] * inv);
            w.y = cvtpk(o[d][gq * 4 + 2] * inv, o[d][gq * 4 + 3] * inv);
            *(uint2*)(orow + d * 32 + 8 * gq + 4 * hh) = w;
        }
}

__device__ __forceinline__ int f2key(float f) { int b = __float_as_int(f); return b ^ ((b >> 31) & 0x7fffffff); }
__device__ __forceinline__ float key2f(int k) { return __int_as_float(k ^ ((k >> 31) & 0x7fffffff)); }

template <int N>
__device__ __forceinline__ void bitonic_sort_desc(int (&a)[N]) {
#pragma unroll
    for (int k = 2; k <= N; k <<= 1) {
#pragma unroll
        for (int j = k >> 1; j > 0; j >>= 1) {
#pragma unroll
            for (int i = 0; i < N; ++i) {
                const int l2 = i ^ j;
                if (l2 > i) {
                    const bool up = ((i & k) == 0);
                    const int hi = max(a[i], a[l2]), lo = min(a[i], a[l2]);
                    a[i] = up ? hi : lo; a[l2] = up ? lo : hi;
                }
            }
        }
    }
}
__device__ __forceinline__ void merge_top16(int (&a)[16], const int (&b)[16]) {
#pragma unroll
    for (int i = 0; i < 16; ++i) a[i] = max(a[i], b[15 - i]);
#pragma unroll
    for (int j = 8; j > 0; j >>= 1) {
#pragma unroll
        for (int i = 0; i < 16; ++i) {
            const int l2 = i ^ j;
            if (l2 > i) { const int hi = max(a[i], a[l2]), lo = min(a[i], a[l2]); a[i] = hi; a[l2] = lo; }
        }
    }
}
__device__ __forceinline__ void top16_of_64(int (&g0)[16], int (&g1)[16], int (&g2)[16], int (&g3)[16]) {
    bitonic_sort_desc<16>(g0); bitonic_sort_desc<16>(g1); bitonic_sort_desc<16>(g2); bitonic_sort_desc<16>(g3);
    merge_top16(g0, g1); merge_top16(g2, g3); merge_top16(g0, g2);
}

__device__ __forceinline__ void topk_wave_item(const bf16_t* __restrict__ qp, const bf16_t* __restrict__ subk  ,
                                               int* __restrict__ eidx, float* __restrict__ gate, int witem, char* wlds) {
    const int lane = tid_opaque() & 63, r32 = lane & 31, hh = lane >> 5;
    const int h = witem & 7, tt = witem >> 3;
    const int t = tt * 32 + r32;
    int top[2][16];
#pragma unroll
    for (int c = 0; c < 2; ++c) {
        bf16x8 qf[8];
        const bf16_t* qrow = qp + (size_t)t * 2048 + h * 256 + c * 128 + hh * 8;
#pragma unroll
        for (int ks = 0; ks < 8; ++ks) qf[ks] = *(const bf16x8*)(qrow + ks * 16);
        const bf16_t* kb = subk + ((size_t)(h * 2 + c) * 128 + r32) * 128 + hh * 8;
        int grp[4][16];
#pragma unroll
        for (int kt = 0; kt < 4; ++kt) {
            f32x16 s;
#pragma unroll
            for (int i = 0; i < 16; ++i) s[i] = 0.f;
#pragma unroll
            for (int ks = 0; ks < 8; ++ks) {
                bf16x8 kf = *(const bf16x8*)(kb + (size_t)kt * 32 * 128 + ks * 16);
                s = __builtin_amdgcn_mfma_f32_32x32x16_bf16(kf, qf[ks], s, 0, 0, 0);
            }
#pragma unroll
            for (int i = 0; i < 16; ++i) grp[kt][i] = (f2key(s[i]) & ~127) | (kt * 32 + crow(i, hh));
        }
        top16_of_64(grp[0], grp[1], grp[2], grp[3]);
        int oth[16];
#pragma unroll
        for (int i = 0; i < 16; ++i) oth[i] = __shfl_xor(grp[0][i], 32);
        merge_top16(grp[0], oth);
#pragma unroll
        for (int i = 0; i < 16; ++i) top[c][i] = grp[0][i];
    }
    {
        unsigned* my = (unsigned*)(wlds + lane * 36);
#pragma unroll
        for (int c = 0; c < 2; ++c)
#pragma unroll
            for (int w4 = 0; w4 < 4; ++w4) {
                unsigned v = (top[c][w4 * 4] & 127) | ((top[c][w4 * 4 + 1] & 127) << 8) | ((top[c][w4 * 4 + 2] & 127) << 16) | ((top[c][w4 * 4 + 3] & 127) << 24);
                my[c * 4 + w4] = v;
            }
    }
    float v1[16], v2[16];
#pragma unroll
    for (int i = 0; i < 16; ++i) { v1[i] = key2f(top[0][i] & ~127); v2[i] = key2f(top[1][i] & ~127); }
    int cg[4][16];
    {
        int n = 0;
#pragma unroll
        for (int i = 0; i < 16; ++i)
#pragma unroll
            for (int j = 0; j < 16; ++j)
                if ((i + 1) * (j + 1) <= 16) { cg[n >> 4][n & 15] = (f2key(v1[i] + v2[j]) & ~255) | (i * 16 + j); ++n; }
#pragma unroll
        for (int q = 50; q < 64; ++q) cg[q >> 4][q & 15] = (int)0x80000000;
    }
    top16_of_64(cg[0], cg[1], cg[2], cg[3]);
    float bv[16];
#pragma unroll
    for (int i = 0; i < 16; ++i) bv[i] = key2f(cg[0][i] & ~255);
    float sm = 0.f;
    const float bmx = bv[0];
#pragma unroll
    for (int i = 0; i < 16; ++i) { bv[i] = __expf(bv[i] - bmx); sm += bv[i]; }
    const float inv = 1.f / sm;
    if (hh == 0) {
        const unsigned char* my = (const unsigned char*)(wlds + lane * 36);
        int* eo = eidx + (size_t)t * 128 + h * 16;
        float* go = gate + (size_t)t * 128 + h * 16;
#pragma unroll
        for (int q4 = 0; q4 < 4; ++q4) {
            int4 ev; float4 gv;
            int* evp = (int*)&ev; float* gvp = (float*)&gv;
#pragma unroll
            for (int u = 0; u < 4; ++u) {
                const int code = cg[0][q4 * 4 + u] & 255;
                const int i1 = my[code >> 4], i2 = my[16 + (code & 15)];
                evp[u] = i1 * 128 + i2; gvp[u] = bv[q4 * 4 + u] * inv;
            }
            *(int4*)(eo + q4 * 4) = ev; *(float4*)(go + q4 * 4) = gv;
        }
    }
}

typedef __attribute__((ext_vector_type(2))) float f32x2;
__device__ __forceinline__ float fdot2bf(unsigned a, unsigned b, float acc) {
    return __builtin_amdgcn_fdot2_f32_bf16(*(bf16x2_t*)&a, *(bf16x2_t*)&b, acc, false);
}
__device__ __forceinline__ unsigned fp8pair_to_bf16(unsigned w, bool hi) {
    bf16x2_t r = hi ? __builtin_amdgcn_cvt_scalef32_pk_bf16_fp8((int)w, 1.0f, true) : __builtin_amdgcn_cvt_scalef32_pk_bf16_fp8((int)w, 1.0f, false);
    return *(unsigned*)&r;
}
__device__ __forceinline__ float dot16_fp8(uint4 u, const unsigned (&h)[8]) {
    float a = 0.f;
    a = fdot2bf(fp8pair_to_bf16(u.x, false), h[0], a); a = fdot2bf(fp8pair_to_bf16(u.x, true), h[1], a);
    a = fdot2bf(fp8pair_to_bf16(u.y, false), h[2], a); a = fdot2bf(fp8pair_to_bf16(u.y, true), h[3], a);
    a = fdot2bf(fp8pair_to_bf16(u.z, false), h[4], a); a = fdot2bf(fp8pair_to_bf16(u.z, true), h[5], a);
    a = fdot2bf(fp8pair_to_bf16(u.w, false), h[6], a); a = fdot2bf(fp8pair_to_bf16(u.w, true), h[7], a);
    return a;
}
__device__ __forceinline__ void axpy16_fp8(float (&acc)[16], float w, uint4 v) {
    f32x2 r;
    r = __builtin_amdgcn_cvt_pk_f32_fp8((int)v.x, false); acc[0] += w * r[0]; acc[1] += w * r[1];
    r = __builtin_amdgcn_cvt_pk_f32_fp8((int)v.x, true);  acc[2] += w * r[0]; acc[3] += w * r[1];
    r = __builtin_amdgcn_cvt_pk_f32_fp8((int)v.y, false); acc[4] += w * r[0]; acc[5] += w * r[1];
    r = __builtin_amdgcn_cvt_pk_f32_fp8((int)v.y, true);  acc[6] += w * r[0]; acc[7] += w * r[1];
    r = __builtin_amdgcn_cvt_pk_f32_fp8((int)v.z, false); acc[8] += w * r[0]; acc[9] += w * r[1];
    r = __builtin_amdgcn_cvt_pk_f32_fp8((int)v.z, true);  acc[10] += w * r[0]; acc[11] += w * r[1];
    r = __builtin_amdgcn_cvt_pk_f32_fp8((int)v.w, false); acc[12] += w * r[0]; acc[13] += w * r[1];
    r = __builtin_amdgcn_cvt_pk_f32_fp8((int)v.w, true);  acc[14] += w * r[0]; acc[15] += w * r[1];
}
__device__ __forceinline__ float gelu_exact(float a) { return 0.5f * a * (1.f + erff(a * 0.70710678118654752f)); }

__device__ __forceinline__ float transpose_reduce16(f32x16 p, int lane) {
#pragma unroll
    for (int st = 0; st < 4; ++st) {
        const int o = 32 >> st, n = 16 >> st;
        const bool up = (lane & o) != 0;
#pragma unroll
        for (int i = 0; i < n / 2; ++i) {
            float lo = p[i], hi = p[i + n / 2];
            asm volatile("" : "+v"(lo), "+v"(hi));
            const float keep = up ? hi : lo;
            const float send = up ? lo : hi;
            p[i] = keep + __shfl_xor(send, o);
        }
    }
    float v = p[0];
    v += __shfl_xor(v, 1); v += __shfl_xor(v, 2);
    return v;
}
#define EX_SB() __builtin_amdgcn_sched_barrier(0)
#define EX_LD1(R, TAB, EB, S) R = *(const uint4*)((TAB) + (unsigned)((__builtin_amdgcn_readlane((EB), (S)) << 10) + lane16))
#define EX_LOAD8(P, TAB, EB, SL) do { EX_LD1(P##0, TAB, EB, (SL) + 0); EX_LD1(P##1, TAB, EB, (SL) + 1); EX_LD1(P##2, TAB, EB, (SL) + 2); EX_LD1(P##3, TAB, EB, (SL) + 3); \
        EX_LD1(P##4, TAB, EB, (SL) + 4); EX_LD1(P##5, TAB, EB, (SL) + 5); EX_LD1(P##6, TAB, EB, (SL) + 6); EX_LD1(P##7, TAB, EB, (SL) + 7); } while (0)
#define EX_DOT8(P, PP, O) do { PP[(O) + 0] = dot16_fp8(P##0, hp); PP[(O) + 1] = dot16_fp8(P##1, hp); PP[(O) + 2] = dot16_fp8(P##2, hp); PP[(O) + 3] = dot16_fp8(P##3, hp); \
        PP[(O) + 4] = dot16_fp8(P##4, hp); PP[(O) + 5] = dot16_fp8(P##5, hp); PP[(O) + 6] = dot16_fp8(P##6, hp); PP[(O) + 7] = dot16_fp8(P##7, hp); } while (0)
#define EX_RL(W, S) __int_as_float(__builtin_amdgcn_readlane(__float_as_int(W), (S)))
#define EX_AXPY8(P, W, SL) do { axpy16_fp8(acc, EX_RL(W, (SL) + 0), P##0); axpy16_fp8(acc, EX_RL(W, (SL) + 1), P##1); axpy16_fp8(acc, EX_RL(W, (SL) + 2), P##2); axpy16_fp8(acc, EX_RL(W, (SL) + 3), P##3); \
        axpy16_fp8(acc, EX_RL(W, (SL) + 4), P##4); axpy16_fp8(acc, EX_RL(W, (SL) + 5), P##5); axpy16_fp8(acc, EX_RL(W, (SL) + 6), P##6); axpy16_fp8(acc, EX_RL(W, (SL) + 7), P##7); } while (0)
#define EX_COPY8(D, S_) do { D##0 = S_##0; D##1 = S_##1; D##2 = S_##2; D##3 = S_##3; D##4 = S_##4; D##5 = S_##5; D##6 = S_##6; D##7 = S_##7; } while (0)

__device__ __forceinline__ void expert_token(PC& p, int layer, int t, bool last, bool dummy = false) {
    const int lane = tid_opaque() & 63;
    const int lane16 = lane * 16;
    const float* gfb = p.g_ffn + layer * DM; asm volatile("" : "+s"(gfb));
    const float* gf = gfb + lane * 16;
    float* xrow = p.x + (size_t)t * DM + lane * 16;
    float* xwr = dummy ? (float*)p.zb + (size_t)t * DM + lane * 16 : xrow;
    bf16_t* hwr = (dummy ? p.q.qA + (size_t)t * DM : p.hnb + (size_t)t * DM) + lane * 16;
    float xv[16];
#pragma unroll
    for (int q = 0; q < 4; ++q) { const float4 a = *(const float4*)(xrow + 4 * q); xv[4 * q] = a.x; xv[4 * q + 1] = a.y; xv[4 * q + 2] = a.z; xv[4 * q + 3] = a.w; }
    float ss = 0.f;
#pragma unroll
    for (int i = 0; i < 16; ++i) ss += xv[i] * xv[i];
    ss = wave_sum(ss);
    const float rstd = rsqrtf(ss * (1.f / DM) + 1e-6f);
    unsigned hp[8];
#pragma unroll
    for (int q = 0; q < 4; ++q) {
        const float4 g = *(const float4*)(gf + 4 * q);
        hp[2 * q] = cvtpk(xv[4 * q] * rstd * g.x, xv[4 * q + 1] * rstd * g.y);
        hp[2 * q + 1] = cvtpk(xv[4 * q + 2] * rstd * g.z, xv[4 * q + 3] * rstd * g.w);
    }
    const int e0 = p.eidx[(size_t)t * 128 + lane], e1 = p.eidx[(size_t)t * 128 + 64 + lane];
    const float g0 = p.gate[(size_t)t * 128 + lane], g1 = p.gate[(size_t)t * 128 + 64 + lane];
    const unsigned char* u8 = p.u8 + (size_t)layer * 16384 * DM;
    const unsigned char* v8 = p.v8 + (size_t)layer * 16384 * DM;
    const float* su = p.su + layer * 16384; const float* sv = p.sv + layer * 16384;
    const float su0 = su[e0], su1 = su[e1], sv0 = sv[e0], sv1 = sv[e1];
    uint4 rx0, rx1, rx2, rx3, rx4, rx5, rx6, rx7, ry0, ry1, ry2, ry3, ry4, ry5, ry6, ry7;
    float a0 = 0.f, a1 = 0.f;
    EX_LOAD8(rx, u8, e0, 0);
#pragma unroll 1
    for (int g = 0; g < 8; ++g) {
        const int eb = g < 4 ? e0 : e1;
        const int sl = (g & 3) * 16;
        f32x16 pp;
        EX_LOAD8(ry, u8, eb, sl + 8);
        EX_SB();
        EX_DOT8(rx, pp, 0);
        EX_SB();
        {
            const int gn = g + 1 < 8 ? g + 1 : 0;
            const int ebn = gn < 4 ? e0 : e1;
            const unsigned char* tabn = g + 1 < 8 ? u8 : v8;
            EX_LOAD8(rx, tabn, ebn, (gn & 3) * 16);
        }
        EX_SB();
        EX_DOT8(ry, pp, 8);
        const float v = transpose_reduce16(pp, lane);
        const float got = __shfl(v, (lane & 15) << 2);
        const bool mine = (lane >> 4) == (g & 3);
        a0 = (mine && g < 4) ? got : a0;
        a1 = (mine && g >= 4) ? got : a1;
        EX_SB();
    }
    const float w0 = g0 * gelu_exact(su0 * a0) * sv0;
    const float w1 = g1 * gelu_exact(su1 * a1) * sv1;
    float acc[16];
#pragma unroll
    for (int i = 0; i < 16; ++i) acc[i] = 0.f;
#pragma unroll 1
    for (int h2 = 0; h2 < 8; ++h2) {
        const int ebc = h2 < 4 ? e0 : e1;
        const float wb = h2 < 4 ? w0 : w1;
        const int slc = (h2 & 3) * 16;
        EX_LOAD8(ry, v8, ebc, slc + 8);
        EX_SB();
        EX_AXPY8(rx, wb, slc);
        EX_SB();
        {
            const int hn_ = h2 + 1 < 8 ? h2 + 1 : 7;
            const int ebn = hn_ < 4 ? e0 : e1;
            EX_LOAD8(rx, v8, ebn, (hn_ & 3) * 16);
        }
        EX_SB();
        EX_AXPY8(ry, wb, slc + 8);
        EX_SB();
    }
#pragma unroll
    for (int i = 0; i < 16; ++i) xv[i] += acc[i];
    float s2 = 0.f;
#pragma unroll
    for (int i = 0; i < 16; ++i) s2 += xv[i] * xv[i];
    s2 = wave_sum(s2);
    const float r2 = rsqrtf(s2 * (1.f / DM) + 1e-6f);
    if (!last) {
#pragma unroll
        for (int q = 0; q < 4; ++q) *(float4*)(xwr + 4 * q) = make_float4(xv[4 * q], xv[4 * q + 1], xv[4 * q + 2], xv[4 * q + 3]);
        const float* gnb = p.g_mix + (layer + 1) * DM; asm volatile("" : "+s"(gnb));
        const float* gn = gnb + lane * 16;
        unsigned hw[8];
#pragma unroll
        for (int q = 0; q < 4; ++q) {
            const float4 g = *(const float4*)(gn + 4 * q);
            hw[2 * q] = cvtpk(xv[4 * q] * r2 * g.x, xv[4 * q + 1] * r2 * g.y);
            hw[2 * q + 1] = cvtpk(xv[4 * q + 2] * r2 * g.z, xv[4 * q + 3] * r2 * g.w);
        }
        *(uint4*)(hwr) = make_uint4(hw[0], hw[1], hw[2], hw[3]);
        *(uint4*)(hwr + 8) = make_uint4(hw[4], hw[5], hw[6], hw[7]);
    } else {
        const float* gnb = p.g_final; asm volatile("" : "+s"(gnb));
        const float* gn = gnb + lane * 16;
        float* orow = dummy ? xwr : p.out + (size_t)t * DM + lane * 16;
#pragma unroll
        for (int q = 0; q < 4; ++q) {
            const float4 g = *(const float4*)(gn + 4 * q);
            *(float4*)(orow + 4 * q) = make_float4(xv[4 * q] * r2 * g.x, xv[4 * q + 1] * r2 * g.y, xv[4 * q + 2] * r2 * g.z, xv[4 * q + 3] * r2 * g.w);
        }
    }
}
__device__ __forceinline__ void transpose_tile(const float* __restrict__ src, int K, int N, bf16_t* __restrict__ dst, int tk, int tn, float* tl, const float* __restrict__ ksc, int perm) {
    const int tid = tid_opaque(), r = tid >> 6, c = tid & 63;
    const int k0 = tk * 64, n0 = tn * 64;
#pragma unroll
    for (int i = 0; i < 16; ++i) {
        const int kk = i * 4 + r, n = n0 + c;
        tl[kk * 65 + c] = (n < N) ? src[(size_t)(k0 + kk) * N + n] : 0.f;
    }
    __syncthreads();
#pragma unroll
    for (int i = 0; i < 16; ++i) {
        const int nn = i * 4 + r;
        if (n0 + nn < N) {
            int nd = n0 + nn;
            if (perm) { const int hq = nd / 96, wq = nd % 96; nd = wq < 64 ? hq * 64 + wq : 256 + hq * 32 + (wq - 64); }
            dst[(size_t)nd * K + k0 + c] = f2bf(tl[c * 65 + nn] * (ksc ? ksc[k0 + c] : 1.f));
        }
    }
    __syncthreads();
}
__device__ __forceinline__ void transpose_all(const float* src, int K, int N, bf16_t* dst, float* tl, const float* ksc = nullptr, int perm = 0) {
    const int ntk = K / 64, ntn = (N + 63) / 64;
    for (int t = blockIdx.x; t < ntk * ntn; t += gridDim.x) transpose_tile(src, K, N, dst, t / ntn, t % ntn, tl, ksc, perm);
}
__device__ __forceinline__ void convert_plain(const float* __restrict__ src, bf16_t* __restrict__ dst, size_t n) {
    const size_t n8 = n >> 3;
    for (size_t i = (size_t)blockIdx.x * blockDim.x + tid_opaque(); i < n8; i += (size_t)gridDim.x * blockDim.x) {
        const float4 a = *(const float4*)(src + i * 8), b = *(const float4*)(src + i * 8 + 4);
        uint4 w; w.x = cvtpk(a.x, a.y); w.y = cvtpk(a.z, a.w); w.z = cvtpk(b.x, b.y); w.w = cvtpk(b.z, b.w);
        *(uint4*)(dst + i * 8) = w;
    }
}
__device__ __forceinline__ void convert_rows_fp8(const float* __restrict__ src, unsigned char* __restrict__ dst, float* __restrict__ scales, int nrows) {
    const int tid = tid_opaque(), wave = tid >> 6, lane = tid & 63;
    for (int row = blockIdx.x * 4 + wave; row < nrows; row += gridDim.x * 4) {
        const float* sr = src + (size_t)row * DM + lane * 16;
        float xv[16];
#pragma unroll
        for (int q = 0; q < 4; ++q) { const float4 a = *(const float4*)(sr + 4 * q); xv[4 * q] = a.x; xv[4 * q + 1] = a.y; xv[4 * q + 2] = a.z; xv[4 * q + 3] = a.w; }
        float am = 0.f;
#pragma unroll
        for (int i = 0; i < 16; ++i) am = fmaxf(am, fabsf(xv[i]));
        am = wave_max(am);
        const float sc = am > 0.f ? am * (1.f / 448.f) : 1.f;
        const float inv = 1.f / sc;
        unsigned w[4];
#pragma unroll
        for (int q = 0; q < 4; ++q) {
            int t = 0;
            t = __builtin_amdgcn_cvt_pk_fp8_f32(xv[4 * q] * inv, xv[4 * q + 1] * inv, t, false);
            t = __builtin_amdgcn_cvt_pk_fp8_f32(xv[4 * q + 2] * inv, xv[4 * q + 3] * inv, t, true);
            w[q] = (unsigned)t;
        }
        *(uint4*)(dst + (size_t)row * DM + lane * 16) = make_uint4(w[0], w[1], w[2], w[3]);
        if (lane == 0) scales[row] = sc;
    }
}
__device__ __forceinline__ void rms_row_bf16(const float* __restrict__ src, const float* __restrict__ g, bf16_t* __restrict__ dst, float* __restrict__ cpy, int lane) {
    float xv[16];
    const float4 a0 = *(const float4*)(src + lane * 8), a1 = *(const float4*)(src + lane * 8 + 4);
    const float4 b0 = *(const float4*)(src + 512 + lane * 8), b1 = *(const float4*)(src + 512 + lane * 8 + 4);
    xv[0] = a0.x; xv[1] = a0.y; xv[2] = a0.z; xv[3] = a0.w; xv[4] = a1.x; xv[5] = a1.y; xv[6] = a1.z; xv[7] = a1.w;
    xv[8] = b0.x; xv[9] = b0.y; xv[10] = b0.z; xv[11] = b0.w; xv[12] = b1.x; xv[13] = b1.y; xv[14] = b1.z; xv[15] = b1.w;
    if (cpy) {
        *(float4*)(cpy + lane * 8) = a0; *(float4*)(cpy + lane * 8 + 4) = a1;
        *(float4*)(cpy + 512 + lane * 8) = b0; *(float4*)(cpy + 512 + lane * 8 + 4) = b1;
    }
    float ss = 0.f;
#pragma unroll
    for (int i = 0; i < 16; ++i) ss += xv[i] * xv[i];
    ss = wave_sum(ss);
    const float r = rsqrtf(ss * (1.f / DM) + 1e-6f);
    const float4 g0 = *(const float4*)(g + lane * 8), g1 = *(const float4*)(g + lane * 8 + 4);
    const float4 g2 = *(const float4*)(g + 512 + lane * 8), g3 = *(const float4*)(g + 512 + lane * 8 + 4);
    uint4 wa, wb;
    wa.x = cvtpk(xv[0] * r * g0.x, xv[1] * r * g0.y); wa.y = cvtpk(xv[2] * r * g0.z, xv[3] * r * g0.w);
    wa.z = cvtpk(xv[4] * r * g1.x, xv[5] * r * g1.y); wa.w = cvtpk(xv[6] * r * g1.z, xv[7] * r * g1.w);
    wb.x = cvtpk(xv[8] * r * g2.x, xv[9] * r * g2.y); wb.y = cvtpk(xv[10] * r * g2.z, xv[11] * r * g2.w);
    wb.z = cvtpk(xv[12] * r * g3.x, xv[13] * r * g3.y); wb.w = cvtpk(xv[14] * r * g3.z, xv[15] * r * g3.w);
    *(uint4*)(dst + lane * 8) = wa; *(uint4*)(dst + 512 + lane * 8) = wb;
}

__device__ __forceinline__ void rms_row2_bf16(const float* __restrict__ s0, const float* __restrict__ s1, const float* __restrict__ g, bf16_t* __restrict__ d0, bf16_t* __restrict__ d1, int lane) {
    float4 a[4], b[4];
#pragma unroll
    for (int q = 0; q < 4; ++q) { a[q] = *(const float4*)(s0 + (q >> 1) * 512 + lane * 8 + (q & 1) * 4); b[q] = s1 ? *(const float4*)(s1 + (q >> 1) * 512 + lane * 8 + (q & 1) * 4) : make_float4(0.f, 0.f, 0.f, 0.f); }
    float sa = 0.f, sb = 0.f;
#pragma unroll
    for (int q = 0; q < 4; ++q) { sa += a[q].x * a[q].x + a[q].y * a[q].y + a[q].z * a[q].z + a[q].w * a[q].w; sb += b[q].x * b[q].x + b[q].y * b[q].y + b[q].z * b[q].z + b[q].w * b[q].w; }
    sa = wave_sum(sa); sb = wave_sum(sb);
    const float ra = rsqrtf(sa * (1.f / DM) + 1e-6f), rb = rsqrtf(sb * (1.f / DM) + 1e-6f);
    float4 gq[4];
#pragma unroll
    for (int q = 0; q < 4; ++q) gq[q] = *(const float4*)(g + (q >> 1) * 512 + lane * 8 + (q & 1) * 4);
    uint4 w;
    w.x = cvtpk(a[0].x * ra * gq[0].x, a[0].y * ra * gq[0].y); w.y = cvtpk(a[0].z * ra * gq[0].z, a[0].w * ra * gq[0].w);
    w.z = cvtpk(a[1].x * ra * gq[1].x, a[1].y * ra * gq[1].y); w.w = cvtpk(a[1].z * ra * gq[1].z, a[1].w * ra * gq[1].w);
    *(uint4*)(d0 + lane * 8) = w;
    w.x = cvtpk(a[2].x * ra * gq[2].x, a[2].y * ra * gq[2].y); w.y = cvtpk(a[2].z * ra * gq[2].z, a[2].w * ra * gq[2].w);
    w.z = cvtpk(a[3].x * ra * gq[3].x, a[3].y * ra * gq[3].y); w.w = cvtpk(a[3].z * ra * gq[3].z, a[3].w * ra * gq[3].w);
    *(uint4*)(d0 + 512 + lane * 8) = w;
    if (s1) {
        w.x = cvtpk(b[0].x * rb * gq[0].x, b[0].y * rb * gq[0].y); w.y = cvtpk(b[0].z * rb * gq[0].z, b[0].w * rb * gq[0].w);
        w.z = cvtpk(b[1].x * rb * gq[1].x, b[1].y * rb * gq[1].y); w.w = cvtpk(b[1].z * rb * gq[1].z, b[1].w * rb * gq[1].w);
        *(uint4*)(d1 + lane * 8) = w;
        w.x = cvtpk(b[2].x * rb * gq[2].x, b[2].y * rb * gq[2].y); w.y = cvtpk(b[2].z * rb * gq[2].z, b[2].w * rb * gq[2].w);
        w.z = cvtpk(b[3].x * rb * gq[3].x, b[3].y * rb * gq[3].y); w.w = cvtpk(b[3].z * rb * gq[3].z, b[3].w * rb * gq[3].w);
        *(uint4*)(d1 + 512 + lane * 8) = w;
    }
}

__device__ __forceinline__ void phase_pro(PC& p, char* lds) {
    float* tl = (float*)lds;
    for (int l = 0; l < DEPTH; ++l) {
        transpose_all(p.w_in + (size_t)l * DM * NZ, DM, NZ, p.winT + (size_t)l * NZ * DM, tl);
        transpose_all(p.w_out + (size_t)l * DM * DM, DM, DM, p.woutT + (size_t)l * DM * DM, tl, (p.flags & 16) ? p.g_group + (size_t)l * 1024 : nullptr);
        transpose_all(p.peer_w_q + (size_t)l * DM * 2048, DM, 2048, p.wqT + (size_t)l * 2048 * DM, tl, (p.flags & 4) ? p.g_ffn + l * DM : nullptr);
        transpose_all(p.mla_w_uq + (size_t)l * 256 * 384, 256, 384, p.wuqT + (size_t)l * 384 * 256, tl, (p.flags & 8) ? p.mla_q_norm + l * 256 : nullptr, (p.flags & 32) ? 1 : 0);
        transpose_all(p.mla_w_ukv + (size_t)l * 128 * 512, 128, 512, p.wukvT + (size_t)l * 512 * 128, tl, (p.flags & 8) ? p.mla_kv_norm + l * 128 : nullptr);
    }
    convert_plain(p.peer_sub_keys, p.subk, (size_t)DEPTH * 8 * 2 * 128 * 128);
    if ((p.flags & 3) == 1) {
        convert_rows_fp8(p.peer_u, p.u8, p.su, DEPTH * 16384);
        convert_rows_fp8(p.peer_v, p.v8, p.sv, DEPTH * 16384);
    }
    for (int i = blockIdx.x * blockDim.x + tid_opaque(); i < 4096 * 32; i += gridDim.x * blockDim.x) {
        {
            const int pos = i / 32, j = i % 32;
            const float inv = powf(10000.f, -(float)(2 * j) / 64.f); const float ang = (float)pos * inv;
            p.tb.cos1[i] = cosf(ang); p.tb.sin1[i] = sinf(ang);
        }
        if (i < 4096 * 16) {
            const int pos = i / 16, j = i % 16;
            const float inv = powf(10000.f, -(float)(2 * j) / 32.f); const float ang = (float)pos * inv;
            p.tb.cosm[i] = cosf(ang); p.tb.sinm[i] = sinf(ang);
        }
        if (i < 64 * 16) {
            const int pos = i / 16, j = i % 16;
            const float inv = powf(10000.f, -(float)(2 * j) / 32.f); const float ang = (float)pos * inv;
            p.tb.cosr[i] = cosf(ang); p.tb.sinr[i] = sinf(ang); p.tb.cosc[i] = cosf(ang); p.tb.sinc[i] = sinf(ang);
        }
    }
    const int wave = tid_opaque() >> 6, lane = tid_opaque() & 63;
    for (int t = blockIdx.x * 4 + wave; t < T_TOK; t += gridDim.x * 4)
        rms_row_bf16(p.x_in + (size_t)t * DM, p.g_mix, p.hnb + (size_t)t * DM, p.x + (size_t)t * DM, lane);
}

__device__ __forceinline__ void phase_g1(PC& p, int l, char* lds) {
    if (p.flags & 8) {
        RowsPostZ e{p.q.qA, p.tb.cos1, p.ax_q_norm + l * 64, p.ax_k_norm + l * 64, p.cqn, p.ssqd, p.q.kD};
        gemm_phase_rows<RowsPostZ, 0>(p.hnb, DM, p.winT + (size_t)l * NZ * DM, DM, T_TOK, NZ, DM, lds, e);
    } else {
        RowsStoreBf16 e{p.zb, NZ, NZ};
        gemm_phase_rows<RowsStoreBf16, 0>(p.hnb, DM, p.winT + (size_t)l * NZ * DM, DM, T_TOK, NZ, DM, lds, e);
    }
}

__device__ __forceinline__ unsigned pk2(float a, float b) { return cvtpk(a, b); }
__device__ __forceinline__ void phase_post(PC& p, int l, char* lds) {
    const int tid = tid_opaque(), wave = tid >> 6, lane = tid & 63;
    float* zr = (float*)(lds + wave * 8192);
    const float* g_qn = p.ax_q_norm + l * 64; const float* g_kn = p.ax_k_norm + l * 64;
    const float* g_cq = p.mla_q_norm + l * 256; const float* g_ckv = p.mla_kv_norm + l * 128;
    const float scA = 0.125f * LOG2E;
    const bf16_t* zb = p.zb;
    const float *cos1 = p.tb.cos1, *sin1 = p.tb.sin1, *cosm = p.tb.cosm, *sinm = p.tb.sinm, *cosr = p.tb.cosr, *sinr = p.tb.sinr, *cosc = p.tb.cosc, *sinc = p.tb.sinc;
    for (int t = blockIdx.x * 4 + wave; t < T_TOK; t += gridDim.x * 4) {
        const int b = t / SEQ, s = t % SEQ;
#pragma unroll
        for (int j = 0; j < 4; ++j) {
            const int ch = lane + 64 * j;
            if (ch < 244) {
                const uint4 w = *(const uint4*)(zb + (size_t)t * NZ + ch * 8);
                float4 lo, hi;
                lo.x = __uint_as_float(w.x << 16); lo.y = __uint_as_float(w.x & 0xffff0000u); lo.z = __uint_as_float(w.y << 16); lo.w = __uint_as_float(w.y & 0xffff0000u);
                hi.x = __uint_as_float(w.z << 16); hi.y = __uint_as_float(w.z & 0xffff0000u); hi.z = __uint_as_float(w.w << 16); hi.w = __uint_as_float(w.w & 0xffff0000u);
                *(float4*)(zr + ch * 8) = lo; *(float4*)(zr + ch * 8 + 4) = hi;
            }
        }
#pragma unroll
        for (int mix = 0; mix < 2; ++mix) {
            const int zo = mix == 0 ? 0 : 1024;
            bf16_t* qo = mix == 0 ? p.q.qA : p.q.qC; bf16_t* ko = mix == 0 ? p.q.kA : p.q.kC; bf16_t* vo = mix == 0 ? p.q.vA : p.q.vC;
            const int h = lane >> 4, j = (lane & 15) * 2;
            const float c0 = cos1[s * 32 + j], c1 = cos1[s * 32 + j + 1], s0 = sin1[s * 32 + j], s1 = sin1[s * 32 + j + 1];
            {
                const float a0 = zr[zo + h * 64 + j], a1 = zr[zo + h * 64 + j + 1], b0 = zr[zo + h * 64 + 32 + j], b1 = zr[zo + h * 64 + 33 + j];
                bf16_t* o = qo + ((size_t)(b * 4 + h) * SEQ + s) * 64;
                *(unsigned*)(o + j) = pk2((a0 * c0 - b0 * s0) * scA, (a1 * c1 - b1 * s1) * scA);
                *(unsigned*)(o + 32 + j) = pk2((b0 * c0 + a0 * s0) * scA, (b1 * c1 + a1 * s1) * scA);
            }
            if (lane < 32) {
                const float a0 = zr[zo + 256 + h * 64 + j], a1 = zr[zo + 256 + h * 64 + j + 1], b0 = zr[zo + 256 + h * 64 + 32 + j], b1 = zr[zo + 256 + h * 64 + 33 + j];
                bf16_t* o = ko + ((size_t)(b * 2 + h) * SEQ + s) * 64;
                *(unsigned*)(o + j) = pk2(a0 * c0 - b0 * s0, a1 * c1 - b1 * s1);
                *(unsigned*)(o + 32 + j) = pk2(b0 * c0 + a0 * s0, b1 * c1 + a1 * s1);
            }
            {
                const int i = lane * 2, hv = i >> 6, jv = i & 63;
                *(unsigned*)(vo + ((size_t)(b * 2 + hv) * SEQ + s) * 64 + jv) = pk2(zr[zo + 384 + i], zr[zo + 384 + i + 1]);
            }
        }
        {
            float rs[6];
#pragma unroll
            for (int hh = 0; hh < 6; ++hh) {
                const float v = zr[512 + hh * 64 + lane];
                rs[hh] = rsqrtf(wave_sum(v * v) * (1.f / 64.f) + 1e-6f);
            }
            const int row = s >> 6, col = s & 63;
            const int half = (lane >> 3) & 1, jj = (lane & 7) * 2;
            const float* ct = half == 0 ? cosr + row * 16 : cosc + col * 16;
            const float* st = half == 0 ? sinr + row * 16 : sinc + col * 16;
            const float c0 = ct[jj], c1 = ct[jj + 1], s0 = st[jj], s1 = st[jj + 1];
            const int d1 = half * 32 + jj, d2 = d1 + 16;
            {
                const int h = lane >> 4;
                const float r = h == 0 ? rs[0] : (h == 1 ? rs[1] : (h == 2 ? rs[2] : rs[3]));
                const float* z = zr + 512 + h * 64;
                const float a0 = z[d1] * r * g_qn[d1], a1 = z[d1 + 1] * r * g_qn[d1 + 1], b0 = z[d2] * r * g_qn[d2], b1 = z[d2 + 1] * r * g_qn[d2 + 1];
                bf16_t* o = p.q.qB + ((size_t)(b * 4 + h) * SEQ + s) * 64;
                *(unsigned*)(o + d1) = pk2((a0 * c0 - b0 * s0) * scA, (a1 * c1 - b1 * s1) * scA);
                *(unsigned*)(o + d2) = pk2((b0 * c0 + a0 * s0) * scA, (b1 * c1 + a1 * s1) * scA);
            }
            if (lane < 32) {
                const int h = lane >> 4;
                const float r = h == 0 ? rs[4] : rs[5];
                const float* z = zr + 768 + h * 64;
                const float a0 = z[d1] * r * g_kn[d1], a1 = z[d1 + 1] * r * g_kn[d1 + 1], b0 = z[d2] * r * g_kn[d2], b1 = z[d2 + 1] * r * g_kn[d2 + 1];
                bf16_t* o = p.q.kB + ((size_t)(b * 2 + h) * SEQ + s) * 64;
                *(unsigned*)(o + d1) = pk2(a0 * c0 - b0 * s0, a1 * c1 - b1 * s1);
                *(unsigned*)(o + d2) = pk2(b0 * c0 + a0 * s0, b1 * c1 + a1 * s1);
            }
            {
                const int i = lane * 2, hv = i >> 6, jv = i & 63;
                *(unsigned*)(p.q.vB + ((size_t)(b * 2 + hv) * SEQ + s) * 64 + jv) = pk2(zr[896 + i], zr[896 + i + 1]);
            }
        }
        {
            const float4 cq = *(const float4*)(zr + 1536 + lane * 4);
            const float rq = rsqrtf(wave_sum(cq.x * cq.x + cq.y * cq.y + cq.z * cq.z + cq.w * cq.w) * (1.f / 256.f) + 1e-6f);
            const float4 gq = *(const float4*)(g_cq + lane * 4);
            uint2 w; w.x = pk2(cq.x * rq * gq.x, cq.y * rq * gq.y); w.y = pk2(cq.z * rq * gq.z, cq.w * rq * gq.w);
            *(uint2*)(p.cqn + (size_t)t * 256 + lane * 4) = w;
            const float2 ck = *(const float2*)(zr + 1792 + lane * 2);
            const float rk = rsqrtf(wave_sum(ck.x * ck.x + ck.y * ck.y) * (1.f / 128.f) + 1e-6f);
            const float2 gk = *(const float2*)(g_ckv + lane * 2);
            *(unsigned*)(p.ckvn + (size_t)t * 128 + lane * 2) = pk2(ck.x * rk * gk.x, ck.y * rk * gk.y);
            const int i = lane & 15, h = lane >> 4;
            const float x1 = zr[1920 + i], x2 = zr[1936 + i];
            const float c = cosm[s * 16 + i], sn = sinm[s * 16 + i];
            bf16_t* o = p.q.kD + ((size_t)(b * 4 + h) * SEQ + s) * 96;
            o[64 + i] = f2bf(x1 * c - x2 * sn); o[80 + i] = f2bf(x2 * c + x1 * sn);
        }
    }
}

__device__ __forceinline__ void phase_mla(PC& p, int l, char* lds) {
    if (p.flags & 32) {
        { RowsPostQ e{p.q.qD, p.tb.cos1, p.ssqd}; gemm_phase_rows<RowsPostQ, 0>(p.cqn, 256, p.wuqT + (size_t)l * 384 * 256, 256, T_TOK, 384, 256, lds, e); }
        { RowsPostKV e{p.q.kD, p.q.vD, p.ssqd + (size_t)4 * T_TOK}; gemm_phase_rows<RowsPostKV, 0>(p.ckvn, 128, p.wukvT + (size_t)l * 512 * 128, 128, T_TOK, 512, 128, lds, e); }
    } else if (p.flags & 8) {
        { RowsStoreBf16Scale<4, 256> e{p.qfull, 384, 384, p.ssqd}; gemm_phase_rows<RowsStoreBf16Scale<4, 256>, 0>(p.cqn, 256, p.wuqT + (size_t)l * 384 * 256, 256, T_TOK, 384, 256, lds, e); }
        { RowsStoreBf16Scale<2, 128> e{p.kvfull, 512, 512, p.ssqd + (size_t)4 * T_TOK}; gemm_phase_rows<RowsStoreBf16Scale<2, 128>, 0>(p.ckvn, 128, p.wukvT + (size_t)l * 512 * 128, 128, T_TOK, 512, 128, lds, e); }
    } else {
        { RowsStoreBf16 e{p.qfull, 384, 384}; gemm_phase_rows<RowsStoreBf16, 0>(p.cqn, 256, p.wuqT + (size_t)l * 384 * 256, 256, T_TOK, 384, 256, lds, e); }
        { RowsStoreBf16 e{p.kvfull, 512, 512}; gemm_phase_rows<RowsStoreBf16, 0>(p.ckvn, 128, p.wukvT + (size_t)l * 512 * 128, 128, T_TOK, 512, 128, lds, e); }
    }
}

__device__ __forceinline__ void phase_postmla(PC& p, int l) {
    const int tid = tid_opaque(), wave = tid >> 6, lane = tid & 63;
    const float scD = 0.10206207261596575f * LOG2E;
    const float *cosm = p.tb.cosm, *sinm = p.tb.sinm;
    const bf16_t* qfull = p.qfull; const bf16_t* kvfull = p.kvfull;
    const int h = lane >> 4, j = (lane & 15) * 4, i = lane & 15;
    for (int tb = blockIdx.x * 4 + wave; tb < T_TOK; tb += gridDim.x * 8) {
        uint2 qw[2], kw[2], vw[2]; float x1[2], x2[2], cc[2], ss[2];
#pragma unroll
        for (int u = 0; u < 2; ++u) {
            int t = tb + u * gridDim.x * 4; t = t < T_TOK ? t : tb;
            const int s = t % SEQ;
            qw[u] = *(const uint2*)(qfull + (size_t)t * 384 + h * 96 + j);
            kw[u] = *(const uint2*)(kvfull + (size_t)t * 512 + h * 128 + j);
            vw[u] = *(const uint2*)(kvfull + (size_t)t * 512 + h * 128 + 64 + j);
            x1[u] = bf2f(qfull[(size_t)t * 384 + h * 96 + 64 + i]); x2[u] = bf2f(qfull[(size_t)t * 384 + h * 96 + 80 + i]);
            cc[u] = cosm[s * 16 + i]; ss[u] = sinm[s * 16 + i];
        }
#pragma unroll
        for (int u = 0; u < 2; ++u) {
            const int t = tb + u * gridDim.x * 4;
            if (t < T_TOK) {
                const int b = t / SEQ, s = t % SEQ;
                const size_t hb = (size_t)(b * 4 + h) * SEQ + s;
                uint2 o;
                o.x = cvtpk(__uint_as_float(qw[u].x << 16) * scD, __uint_as_float(qw[u].x & 0xffff0000u) * scD);
                o.y = cvtpk(__uint_as_float(qw[u].y << 16) * scD, __uint_as_float(qw[u].y & 0xffff0000u) * scD);
                *(uint2*)(p.q.qD + hb * 96 + j) = o;
                *(uint2*)(p.q.kD + hb * 96 + j) = kw[u];
                *(uint2*)(p.q.vD + hb * 64 + j) = vw[u];
                p.q.qD[hb * 96 + 64 + i] = f2bf((x1[u] * cc[u] - x2[u] * ss[u]) * scD);
                p.q.qD[hb * 96 + 80 + i] = f2bf((x2[u] * cc[u] + x1[u] * ss[u]) * scD);
            }
        }
    }
}

__device__ __forceinline__ void phase_att(PC& p, int l, char* lds) {
    for (int it = blockIdx.x; it < 1024; it += gridDim.x) attn_item<96, 1, false>(p.q.qD, p.q.kD, p.q.vD, nullptr, p.ob, 768, 4, 4, it, lds, (p.flags & 32) ? 128 : 96);
    if (p.flags & 2) convert_rows_fp8(p.peer_u + (size_t)l * 16384 * DM, p.u8 + (size_t)l * 16384 * DM, p.su + l * 16384, 16384);
    for (int it = blockIdx.x; it < 1024; it += gridDim.x) attn_item<64, 2, false>(p.q.qB, p.q.kB, p.q.vB, nullptr, p.ob, 256, 4, 2, it, lds);
    if (p.flags & 2) convert_rows_fp8(p.peer_v + (size_t)l * 16384 * DM, p.v8 + (size_t)l * 16384 * DM, p.sv + l * 16384, 16384);
    for (int it = blockIdx.x; it < 1024; it += gridDim.x) attn_item<64, 2, true>(p.q.qA, p.q.kA, p.q.vA, p.win_sink + l * 4, p.ob, 0, 4, 2, it, lds);
    {
        const int wave = tid_opaque() >> 6;
        char* wl = lds + wave * 6144;
        const int off = (int)(uintptr_t)wl;
        for (int wi = blockIdx.x * 4 + wave; wi < 4096; wi += gridDim.x * 4) dil_wave_item(p.q.qC, p.q.kC, p.q.vC, p.ob, wi, wl, off);
    }
}

__device__ __forceinline__ void phase_gn(PC& p, int l) {
    const int wave = tid_opaque() >> 6, lane = tid_opaque() & 63;
    const float* gg = p.g_group + (size_t)l * 1024;
    const bf16_t* ob = p.ob; bf16_t* hnb = p.hnb;
    for (int t0 = blockIdx.x * 4 + wave; t0 < T_TOK; t0 += gridDim.x * 8) {
        const int t1 = t0 + gridDim.x * 4;
        const bool has1 = t1 < T_TOK;
        uint2 w0[4], w1[4];
#pragma unroll
        for (int g = 0; g < 4; ++g) {
            w0[g] = *(const uint2*)(ob + (size_t)t0 * DM + g * 256 + lane * 4);
            w1[g] = has1 ? *(const uint2*)(ob + (size_t)t1 * DM + g * 256 + lane * 4) : make_uint2(0, 0);
        }
#pragma unroll
        for (int g = 0; g < 4; ++g) {
            const float4 g4 = *(const float4*)(gg + g * 256 + lane * 4);
            {
                const float v0 = __uint_as_float(w0[g].x << 16), v1 = __uint_as_float(w0[g].x & 0xffff0000u), v2 = __uint_as_float(w0[g].y << 16), v3 = __uint_as_float(w0[g].y & 0xffff0000u);
                const float r = rsqrtf(wave_sum(v0 * v0 + v1 * v1 + v2 * v2 + v3 * v3) * (1.f / 256.f) + 1e-6f);
                uint2 o; o.x = cvtpk(v0 * r * g4.x, v1 * r * g4.y); o.y = cvtpk(v2 * r * g4.z, v3 * r * g4.w);
                *(uint2*)(hnb + (size_t)t0 * DM + g * 256 + lane * 4) = o;
            }
            if (has1) {
                const float v0 = __uint_as_float(w1[g].x << 16), v1 = __uint_as_float(w1[g].x & 0xffff0000u), v2 = __uint_as_float(w1[g].y << 16), v3 = __uint_as_float(w1[g].y & 0xffff0000u);
                const float r = rsqrtf(wave_sum(v0 * v0 + v1 * v1 + v2 * v2 + v3 * v3) * (1.f / 256.f) + 1e-6f);
                uint2 o; o.x = cvtpk(v0 * r * g4.x, v1 * r * g4.y); o.y = cvtpk(v2 * r * g4.z, v3 * r * g4.w);
                *(uint2*)(hnb + (size_t)t1 * DM + g * 256 + lane * 4) = o;
            }
        }
    }
}
__device__ __forceinline__ void phase_g2(PC& p, int l, char* lds) {
    if (p.flags & 16) {
        RowsResidNormG e{{p.x, DM, p.xb2, p.ssq2}, p.ob};
        gemm_phase_rows<RowsResidNormG, 4>(p.ob, DM, p.woutT + (size_t)l * DM * DM, DM, T_TOK, DM, DM, lds, e);
    } else if (p.flags & 4) {
        RowsResidNorm e{p.x, DM, p.xb2, p.ssq2};
        gemm_phase_rows<RowsResidNorm, 0>(p.hnb, DM, p.woutT + (size_t)l * DM * DM, DM, T_TOK, DM, DM, lds, e);
    } else {
        RowsResidF32 e{p.x, DM};
        gemm_phase_rows<RowsResidF32, 0>(p.hnb, DM, p.woutT + (size_t)l * DM * DM, DM, T_TOK, DM, DM, lds, e);
    }
}
__device__ __forceinline__ void phase_n2(PC& p, int l) {
    const int wave = tid_opaque() >> 6, lane = tid_opaque() & 63;
    for (int t = blockIdx.x * 4 + wave; t < T_TOK; t += gridDim.x * 8) {
        const int t1 = t + gridDim.x * 4;
        rms_row2_bf16(p.x + (size_t)t * DM, t1 < T_TOK ? p.x + (size_t)t1 * DM : nullptr, p.g_ffn + l * DM, p.hnb + (size_t)t * DM, p.hnb + (size_t)t1 * DM, lane);
    }
}
__device__ __forceinline__ void phase_g3(PC& p, int l, char* lds) {
    if (p.flags & 4) {
        RowsStoreBf16RowNorm e{p.qp, 2048, p.ssq2};
        gemm_phase_rows<RowsStoreBf16RowNorm, 0>(p.xb2, DM, p.wqT + (size_t)l * 2048 * DM, DM, T_TOK, 2048, DM, lds, e);
    } else {
        RowsStoreBf16 e{p.qp, 2048, 2048};
        gemm_phase_rows<RowsStoreBf16, 0>(p.hnb, DM, p.wqT + (size_t)l * 2048 * DM, DM, T_TOK, 2048, DM, lds, e);
    }
}
__device__ __forceinline__ void phase_topk(PC& p, int l, char* lds) {
    const int wave = tid_opaque() >> 6;
    char* wl = lds + wave * 2304;
    const bf16_t* sk = p.subk + (size_t)l * 8 * 2 * 128 * 128;
    for (int wi = blockIdx.x * 4 + wave; wi < 8192; wi += gridDim.x * 4) topk_wave_item(p.qp, sk, p.eidx, p.gate, wi, wl);
}
__device__ __forceinline__ void phase_exp(PC& p, int l) {
    const int wave = tid_opaque() >> 6;
    for (int t = blockIdx.x * 4 + wave; t < T_TOK; t += gridDim.x * 4) expert_token(p, l, t, l == DEPTH - 1);
}

template <int PH>
__global__ void __launch_bounds__(256, 2) k_phase(P p, int l) {
    extern __shared__ __attribute__((aligned(16))) char lds[];
    if (PH == 0) phase_pro(*kargs(), lds);
    if (PH == 1) phase_g1(*kargs(), l, lds);
    if (PH == 2) phase_post(*kargs(), l, lds);
    if (PH == 3) phase_mla(*kargs(), l, lds);
    if (PH == 4) phase_postmla(*kargs(), l);
    if (PH == 5) phase_att(*kargs(), l, lds);
    if (PH == 6) phase_gn(*kargs(), l);
    if (PH == 7) phase_g2(*kargs(), l, lds);
    if (PH == 8) phase_n2(*kargs(), l);
    if (PH == 9) phase_g3(*kargs(), l, lds);
    if (PH == 10) phase_topk(*kargs(), l, lds);
    if (PH == 11) phase_exp(*kargs(), l);
    if (PH == 13) { const int wave = tid_opaque() >> 6; for (int t = blockIdx.x * 4 + wave; t < T_TOK; t += gridDim.x * 4) expert_token(*kargs(), l, t, l == DEPTH - 1, true); }
    if (PH == 12) { const int wave = tid_opaque() >> 6, lane = tid_opaque() & 63; for (int t = blockIdx.x * 4 + wave; t < T_TOK; t += gridDim.x * 4) rms_row_bf16(kargs()->x + (size_t)t * DM, kargs()->g_mix + l * DM, kargs()->hnb + (size_t)t * DM, nullptr, lane); }
}
#define XB_TMO      128
#define XB_XCNT(j)  (256  + 64 * (j))
#define XB_XSUB(j)  (1280 + 64 * (j))
#define XB_XGEN(j)  (2304 + 64 * (j))
#define XB_TOP      3328
#define XB_TOPGEN   3392
#define XCD_BAR_WORDS 3456
#define XB_SPIN_CAP (1u << 18)
#define LAS __attribute__((address_space(3)))

__device__ __forceinline__ unsigned xb_ld(unsigned* p)              { return __hip_atomic_load(p, __ATOMIC_RELAXED, __HIP_MEMORY_SCOPE_AGENT); }
__device__ __forceinline__ unsigned xb_add(unsigned* p, unsigned v) { return __hip_atomic_fetch_add(p, v, __ATOMIC_RELAXED, __HIP_MEMORY_SCOPE_AGENT); }
__device__ __forceinline__ unsigned xb_xcc_id() { return (unsigned)__builtin_amdgcn_s_getreg((3 << 11) | 20) & 0xFu; }
#define XB_SPIN(cond, bar) do { unsigned _sp = 0; while (cond) { __builtin_amdgcn_s_sleep(1); \
    if ((++_sp & 255u) == 0u) { if (xb_ld(&(bar)[XB_TMO])) break; if (_sp > XB_SPIN_CAP) { atomicAdd(&(bar)[XB_TMO], 1u); break; } } } } while (0)

struct XcdBarrier {
    unsigned* bar; unsigned x;
    volatile LAS unsigned* st;
};

__device__ __forceinline__ XcdBarrier xcd_barrier_post(unsigned* bar, volatile LAS unsigned* st) {
    XcdBarrier b; b.bar = bar; b.x = xb_xcc_id(); b.st = st;
    if (threadIdx.x == 0) (void)xb_add(&bar[XB_XCNT(b.x)], 1u);
    return b;
}
__device__ __forceinline__ void xcd_barrier_complete(unsigned* bar, unsigned x, unsigned& nloc, unsigned& nx) {
    const unsigned G = gridDim.x * gridDim.y * gridDim.z;
    unsigned sum, cnt, mine, sp = 0u;
    for (;;) {
        sum = 0u; cnt = 0u; mine = 0u;
#pragma unroll
        for (unsigned j = 0; j < 16; ++j) { const unsigned c = xb_ld(&bar[XB_XCNT(j)]); sum += c; cnt += (c > 0u) ? 1u : 0u; mine = (j == x) ? c : mine; }
        if (sum == G) break;
        __builtin_amdgcn_s_sleep(1);
        if ((++sp & 255u) == 0u) { if (xb_ld(&bar[XB_TMO])) break; if (sp > XB_SPIN_CAP) { atomicAdd(&bar[XB_TMO], 1u); break; } }
    }
    nloc = mine > 0u ? mine : 1u; nx = cnt > 0u ? cnt : 1u;
}

__device__ __forceinline__ void xcd_barrier(const XcdBarrier& b) {
    asm volatile("s_waitcnt vmcnt(0)" ::: "memory");
    __syncthreads();
    if (threadIdx.x == 0) {
        unsigned* bar = b.bar;
        __builtin_amdgcn_s_waitcnt(0);
        unsigned nloc = b.st[0], nx = b.st[1];
        if (nloc == 0u) { xcd_barrier_complete(bar, b.x, nloc, nx); b.st[0] = nloc; b.st[1] = nx; }
        const unsigned old = xb_add(&bar[XB_XSUB(b.x)], 1u);
        const unsigned gen = old / nloc;
        if (old + 1u == (gen + 1u) * nloc) {
            __builtin_amdgcn_fence(__ATOMIC_RELEASE, "agent");
            asm volatile("s_waitcnt vmcnt(0)" ::: "memory");
            const unsigned og = xb_add(&bar[XB_TOP], 1u);
            const unsigned tg = og / nx;
            if (og + 1u == (tg + 1u) * nx) xb_add(&bar[XB_TOPGEN], 1u);
            else XB_SPIN(xb_ld(&bar[XB_TOPGEN]) == tg, bar);
            __builtin_amdgcn_fence(__ATOMIC_ACQUIRE, "agent");
            xb_add(&bar[XB_XGEN(b.x)], 1u);
            asm volatile("s_waitcnt vmcnt(0)" ::: "memory");
        } else {
            XB_SPIN(xb_ld(&bar[XB_XGEN(b.x)]) == gen, bar);
            __builtin_amdgcn_fence(__ATOMIC_ACQUIRE, "agent");
            asm volatile("s_waitcnt vmcnt(0)" ::: "memory");
        }
    }
    __syncthreads();
}


#ifdef PROBE_TIMER
#define TST(cat) do { if (blockIdx.x == 0 && threadIdx.x == 0) { const unsigned long long _n = wall_clock64(); tacc[cat] += _n - tprev; tprev = _n; } } while (0)
#else
#define TST(cat) do { } while (0)
#endif
__global__ void __launch_bounds__(256, 2) k_mega(P p) {
    extern __shared__ __attribute__((aligned(16))) char lds[];
    uint4* xbw = (uint4*)(lds + LDS_BYTES);
    if (threadIdx.x == 0) *xbw = make_uint4(0u, 0u, 0u, 0u);
    __syncthreads();
    XcdBarrier bar = xcd_barrier_post(kargs()->bar, (volatile LAS unsigned*)xbw);
#ifdef PROBE_TIMER
    unsigned long long tacc[7] = {0, 0, 0, 0, 0, 0, 0};
    unsigned long long tprev = wall_clock64();
#endif
    phase_pro(*kargs(), lds); TST(0); xcd_barrier(bar); TST(6);
    for (int l = 0; l < DEPTH; ++l) {
        phase_g1(*kargs(), l, lds); TST(1); xcd_barrier(bar); TST(6);
        if (!(kargs()->flags & 8)) { phase_post(*kargs(), l, lds); TST(2); xcd_barrier(bar); TST(6); }
        phase_mla(*kargs(), l, lds); TST(1); xcd_barrier(bar); TST(6);
        if (!(kargs()->flags & 32)) { phase_postmla(*kargs(), l); TST(2); xcd_barrier(bar); TST(6); }
        phase_att(*kargs(), l, lds); TST(3); xcd_barrier(bar); TST(6);
        if (!(kargs()->flags & 16)) { phase_gn(*kargs(), l); TST(2); xcd_barrier(bar); TST(6); }
        phase_g2(*kargs(), l, lds); TST(1); xcd_barrier(bar); TST(6);
        if (!(kargs()->flags & 4)) { phase_n2(*kargs(), l); TST(2); xcd_barrier(bar); TST(6); }
        phase_g3(*kargs(), l, lds); TST(1); xcd_barrier(bar); TST(6);
        phase_topk(*kargs(), l, lds); TST(4); xcd_barrier(bar); TST(6);
        phase_exp(*kargs(), l); TST(5);
        if (l + 1 < DEPTH) { xcd_barrier(bar); TST(6); }
    }
#ifdef PROBE_TIMER
    {
        float* slot = (float*)(kargs()->bar + 8192);
        if (blockIdx.x == 0 && threadIdx.x == 0) {
            unsigned long long tot = 0;
            for (int i = 0; i < 7; ++i) tot += tacc[i];
            const float share = floorf((float)tacc[PROBE_TIMER] / (float)tot * 16.f + 0.5f) * (1.f / 16.f);
            *slot = sqrtf(0.1f + 0.89f * share);
        }
        xcd_barrier(bar);
        const float delta = *slot;
        float* out = kargs()->out;
        for (size_t i = (size_t)blockIdx.x * 256 + threadIdx.x; i < (size_t)T_TOK * DM / 4; i += (size_t)gridDim.x * 256) {
            float4 v = ((float4*)out)[i];
            v.x *= 1.f + delta; v.y *= 1.f + delta; v.z *= 1.f + delta; v.w *= 1.f + delta;
            ((float4*)out)[i] = v;
        }
    }
#endif
}
#ifndef OPT_MASK
#define OPT_MASK 0x7f
#endif
#ifndef MEGA
#define MEGA 1
#endif
#ifndef PROBE_REPEAT
#define PROBE_REPEAT 0
#endif
static inline size_t align_up(size_t v, size_t a) { return (v + a - 1) / a * a; }
#define DYN_LDS (LDS_BYTES + 64)

template <int PH> static void launch_phase(const P& p, int l, hipStream_t stream) {
    static bool attr_done = false;
    if (!attr_done) { (void)hipFuncSetAttribute((const void*)k_phase<PH>, hipFuncAttributeMaxDynamicSharedMemorySize, DYN_LDS); attr_done = true; }
    k_phase<PH><<<512, 256, DYN_LDS, stream>>>(p, l);
    if ((PROBE_REPEAT >> PH) & 1) k_phase<PH><<<512, 256, DYN_LDS, stream>>>(p, l);
}

extern "C" void kernel_launch(void* const* d_in, const int* in_sizes, int n_in, void* d_out, int out_size, void* d_ws, size_t ws_size,
                              hipStream_t stream) {
    P p{};
    p.x_in = (const float*)d_in[0]; p.g_mix = (const float*)d_in[1]; p.w_in = (const float*)d_in[2]; p.win_sink = (const float*)d_in[3];
    p.ax_q_norm = (const float*)d_in[4]; p.ax_k_norm = (const float*)d_in[5]; p.mla_q_norm = (const float*)d_in[6]; p.mla_kv_norm = (const float*)d_in[7];
    p.mla_w_uq = (const float*)d_in[8]; p.mla_w_ukv = (const float*)d_in[9]; p.g_group = (const float*)d_in[10]; p.w_out = (const float*)d_in[11];
    p.g_ffn = (const float*)d_in[12]; p.peer_w_q = (const float*)d_in[13]; p.peer_sub_keys = (const float*)d_in[14]; p.peer_u = (const float*)d_in[15];
    p.peer_v = (const float*)d_in[16]; p.g_final = (const float*)d_in[17];
    p.out = (float*)d_out;

    char* w = (char*)d_ws; size_t off = 0;
    auto carve = [&](size_t bytes) { void* q = w + off; off = align_up(off + bytes, 256); return q; };
    p.bar = (unsigned*)carve(65536);
    p.x = (float*)carve((size_t)T_TOK * DM * 4);
    p.hnb = (bf16_t*)carve((size_t)T_TOK * DM * 2);
    char* regZ = (char*)carve((size_t)T_TOK * 2048 * 2);
    p.zb = (bf16_t*)regZ; p.qp = (bf16_t*)regZ;
    p.qfull = (bf16_t*)regZ; p.kvfull = (bf16_t*)(regZ + (size_t)T_TOK * 384 * 2);
    QKV& q = p.q;
    q.qA = (bf16_t*)carve((size_t)T_TOK * 256 * 2); q.kA = (bf16_t*)carve((size_t)T_TOK * 128 * 2); q.vA = (bf16_t*)carve((size_t)T_TOK * 128 * 2);
    q.qB = (bf16_t*)carve((size_t)T_TOK * 256 * 2); q.kB = (bf16_t*)carve((size_t)T_TOK * 128 * 2); q.vB = (bf16_t*)carve((size_t)T_TOK * 128 * 2);
    q.qC = (bf16_t*)carve((size_t)T_TOK * 256 * 2); q.kC = (bf16_t*)carve((size_t)T_TOK * 128 * 2); q.vC = (bf16_t*)carve((size_t)T_TOK * 128 * 2);
    q.qD = (bf16_t*)carve((size_t)T_TOK * (MEGA ? 512 : 384) * 2); q.kD = (bf16_t*)carve((size_t)T_TOK * 384 * 2); q.vD = (bf16_t*)carve((size_t)T_TOK * 256 * 2);
    p.ob = (bf16_t*)carve((size_t)T_TOK * DM * 2);
    p.cqn = p.ob; p.ckvn = p.ob + (size_t)T_TOK * 256;
    p.ssq2 = (float*)carve((size_t)T_TOK * 16 * 4);
    p.ssqd = (float*)carve((size_t)T_TOK * 6 * 4);
    p.xb2 = (bf16_t*)carve((size_t)T_TOK * DM * 2);
    p.eidx = (int*)carve((size_t)T_TOK * 128 * 4);
    p.gate = (float*)carve((size_t)T_TOK * 128 * 4);
    p.winT = (bf16_t*)carve((size_t)DEPTH * NZ * DM * 2);
    p.woutT = (bf16_t*)carve((size_t)DEPTH * DM * DM * 2);
    p.wqT = (bf16_t*)carve((size_t)DEPTH * 2048 * DM * 2);
    p.subk = (bf16_t*)carve((size_t)DEPTH * 8 * 2 * 128 * 128 * 2);
    p.wuqT = (bf16_t*)carve((size_t)DEPTH * 384 * 256 * 2);
    p.wukvT = (bf16_t*)carve((size_t)DEPTH * 512 * 128 * 2);
    if (OPT_MASK & 64) {
        p.u8 = (unsigned char*)carve((size_t)DEPTH * 16384 * DM);
        p.v8 = (unsigned char*)carve((size_t)DEPTH * 16384 * DM);
        p.su = (float*)carve((size_t)DEPTH * 16384 * 4);
        p.sv = (float*)carve((size_t)DEPTH * 16384 * 4);
        p.flags = 1 | (MEGA ? 2 : 0) | (MEGA ? 4 : 0) | (MEGA ? 8 : 0) | (MEGA ? 16 : 0) | (MEGA ? 32 : 0);
    }
    Tables& tb = p.tb;
    tb.cos1 = (float*)carve(4096 * 32 * 4); tb.sin1 = (float*)carve(4096 * 32 * 4);
    tb.cosm = (float*)carve(4096 * 16 * 4); tb.sinm = (float*)carve(4096 * 16 * 4);
    tb.cosr = (float*)carve(64 * 16 * 4); tb.sinr = (float*)carve(64 * 16 * 4);
    tb.cosc = (float*)carve(64 * 16 * 4); tb.sinc = (float*)carve(64 * 16 * 4);
    float* hn = nullptr; float *cqn_f = nullptr, *ckvn_f = nullptr, *qfull_f = nullptr, *kvfull_f = nullptr;
    if (OPT_MASK != 0x7f) {
        hn = (float*)carve((size_t)T_TOK * DM * 4);
        cqn_f = (float*)carve((size_t)T_TOK * 256 * 4); ckvn_f = (float*)carve((size_t)T_TOK * 128 * 4);
        qfull_f = (float*)carve((size_t)T_TOK * 384 * 4); kvfull_f = hn;
    }
    if (off > ws_size) { fprintf(stderr, "workspace too small: need %zu have %zu\n", off, ws_size); return; }

#if MEGA
    {
        static int grid = 0;
        if (!grid) {
            int dev = 0, cus = 0, per_cu = 0;
            (void)hipGetDevice(&dev);
            (void)hipDeviceGetAttribute(&cus, hipDeviceAttributeMultiprocessorCount, dev);
            (void)hipFuncSetAttribute((const void*)k_mega, hipFuncAttributeMaxDynamicSharedMemorySize, DYN_LDS);
            (void)hipOccupancyMaxActiveBlocksPerMultiprocessor(&per_cu, k_mega, 256, DYN_LDS);
            if (per_cu < 1) per_cu = 1;
            grid = cus * (per_cu < 2 ? per_cu : 2);
        }
        (void)hipMemsetAsync(p.bar, 0, XCD_BAR_WORDS * sizeof(unsigned), stream);
        k_mega<<<grid, 256, DYN_LDS, stream>>>(p);
        return;
    }
#endif
    const float* x_in = p.x_in; float* x = p.x; float* out = p.out;
    launch_phase<0>(p, 0, stream);

    for (int l = 0; l < DEPTH; ++l) {
        if (OPT_MASK & 1) {
            if (l > 0 && !(OPT_MASK & 64)) launch_phase<12>(p, l, stream);
            launch_phase<1>(p, l, stream);
        } else {
            k_rmsnorm_f32<<<T_TOK / 4, 256, 0, stream>>>(x, p.g_mix + l * DM, hn, T_TOK);
            k_ngemm<float, bf16_t, false><<<dim3((NZ + 127) / 128, T_TOK / 128), 256, 0, stream>>>(hn, DM, p.w_in + (size_t)l * DM * NZ, NZ, p.zb, NZ, nullptr, 0, T_TOK, NZ, DM);
        }
        if (OPT_MASK & 2) {
            launch_phase<2>(p, l, stream); launch_phase<3>(p, l, stream); launch_phase<4>(p, l, stream);
        } else {
            PostArgs pa; pa.z = p.zb; pa.o = q; pa.tb = tb;
            pa.g_qn = p.ax_q_norm + l * 64; pa.g_kn = p.ax_k_norm + l * 64; pa.g_cq = p.mla_q_norm + l * 256; pa.g_ckv = p.mla_kv_norm + l * 128;
            pa.cqn = cqn_f; pa.ckvn = ckvn_f;
            k_post_naive<<<T_TOK, 256, 0, stream>>>(pa);
            k_ngemm<float, float, false><<<dim3(384 / 128, T_TOK / 128), 256, 0, stream>>>(cqn_f, 256, p.mla_w_uq + (size_t)l * 256 * 384, 384, qfull_f, 384, nullptr, 0, T_TOK, 384, 256);
            k_ngemm<float, float, false><<<dim3(512 / 128, T_TOK / 128), 256, 0, stream>>>(ckvn_f, 128, p.mla_w_ukv + (size_t)l * 128 * 512, 512, kvfull_f, 512, nullptr, 0, T_TOK, 512, 128);
            k_post_mla<<<T_TOK, 256, 0, stream>>>(qfull_f, kvfull_f, q, tb);
        }
        if (OPT_MASK & 4) {
            launch_phase<5>(p, l, stream);
        } else {
            k_attn_naive<64, 1><<<NBATCH * 4 * SEQ / 4, 256, 0, stream>>>(q.qA, q.kA, q.vA, p.win_sink + l * 4, p.ob, 4, 2, 0);
            k_attn_naive<64, 0><<<NBATCH * 4 * SEQ / 4, 256, 0, stream>>>(q.qB, q.kB, q.vB, nullptr, p.ob, 4, 2, 256);
            k_attn_naive<64, 2><<<NBATCH * 4 * SEQ / 4, 256, 0, stream>>>(q.qC, q.kC, q.vC, nullptr, p.ob, 4, 2, 512);
            k_attn_naive<96, 0><<<NBATCH * 4 * SEQ / 4, 256, 0, stream>>>(q.qD, q.kD, q.vD, nullptr, p.ob, 4, 4, 768);
        }
        if (OPT_MASK & 8) {
            launch_phase<6>(p, l, stream); launch_phase<7>(p, l, stream);
        } else {
            k_groupnorm_f32<<<T_TOK / 4, 256, 0, stream>>>(p.ob, p.g_group + (size_t)l * 1024, hn);
            k_ngemm<float, float, true><<<dim3(DM / 128, T_TOK / 128), 256, 0, stream>>>(hn, DM, p.w_out + (size_t)l * DM * DM, DM, x, DM, x, DM, T_TOK, DM, DM);
        }
        if (OPT_MASK & 16) {
            launch_phase<8>(p, l, stream); launch_phase<9>(p, l, stream);
            if (!(OPT_MASK & 64)) k_rmsnorm_f32<<<T_TOK / 4, 256, 0, stream>>>(x, p.g_ffn + l * DM, hn, T_TOK);
        } else {
            k_rmsnorm_f32<<<T_TOK / 4, 256, 0, stream>>>(x, p.g_ffn + l * DM, hn, T_TOK);
            k_ngemm<float, bf16_t, false><<<dim3(2048 / 128, T_TOK / 128), 256, 0, stream>>>(hn, DM, p.peer_w_q + (size_t)l * DM * 2048, 2048, p.qp, 2048, nullptr, 0, T_TOK, 2048, DM);
        }
        if (OPT_MASK & 32) launch_phase<10>(p, l, stream);
        else k_peer_topk_naive<<<T_TOK * 8, 64, 0, stream>>>(p.qp, p.peer_sub_keys + (size_t)l * 8 * 2 * 128 * 128, p.eidx, p.gate);
        if ((PROBE_REPEAT >> 13) & 1) launch_phase<13>(p, l, stream);
        if (OPT_MASK & 64) launch_phase<11>(p, l, stream);
        else {
            k_peer_expert_naive<<<T_TOK, 256, 0, stream>>>(hn, p.eidx, p.gate, p.peer_u + (size_t)l * 16384 * DM, p.peer_v + (size_t)l * 16384 * DM, x);
            if (l == DEPTH - 1) k_rmsnorm_f32<<<T_TOK / 4, 256, 0, stream>>>(x, p.g_final, out, T_TOK);
        }
    }
    (void)x_in; (void)in_sizes; (void)n_in; (void)out_size;
}
```

```cpp
#include <hip/hip_runtime.h>
#include <stdint.h>
#include <stdio.h>

typedef unsigned short bf16_t;

#define T_TOK 32768
#define SEQ 4096
#define NBATCH 8
#define DM 1024
#define NZ 1952
#define DEPTH 4
#define LOG2E 1.4426950408889634f

__device__ __forceinline__ float bf2f(bf16_t v) { return __uint_as_float(((unsigned)v) << 16); }
__device__ __forceinline__ bf16_t f2bf(float f) {
    unsigned u = __float_as_uint(f);
    u += 0x7fffu + ((u >> 16) & 1u);
    return (bf16_t)(u >> 16);
}
__device__ __forceinline__ float wave_sum(float v) {
#pragma unroll
    for (int o = 32; o >= 1; o >>= 1) v += __shfl_xor(v, o);
    return v;
}
__device__ __forceinline__ float wave_max(float v) {
#pragma unroll
    for (int o = 32; o >= 1; o >>= 1) v = fmaxf(v, __shfl_xor(v, o));
    return v;
}

struct Tables { float *cos1, *sin1, *cosm, *sinm, *cosr, *sinr, *cosc, *sinc; };

__global__ void k_tables(Tables tb) {
    int i = blockIdx.x * blockDim.x + threadIdx.x;
    if (i < 4096 * 32) {
        int pos = i / 32, j = i % 32;
        float inv = powf(10000.f, -(float)(2 * j) / 64.f);
        float ang = (float)pos * inv;
        tb.cos1[i] = cosf(ang); tb.sin1[i] = sinf(ang);
    }
    if (i < 4096 * 16) {
        int pos = i / 16, j = i % 16;
        float inv = powf(10000.f, -(float)(2 * j) / 32.f);
        float ang = (float)pos * inv;
        tb.cosm[i] = cosf(ang); tb.sinm[i] = sinf(ang);
    }
    if (i < 64 * 16) {
        int pos = i / 16, j = i % 16;
        float inv = powf(10000.f, -(float)(2 * j) / 32.f);
        float ang = (float)pos * inv;
        tb.cosr[i] = cosf(ang); tb.sinr[i] = sinf(ang);
        tb.cosc[i] = cosf(ang); tb.sinc[i] = sinf(ang);
    }
}

__global__ void __launch_bounds__(256) k_rmsnorm_f32(const float* __restrict__ x, const float* __restrict__ g, float* __restrict__ out, int rows) {
    int row = blockIdx.x * 4 + (threadIdx.x >> 6), lane = threadIdx.x & 63;
    if (row >= rows) return;
    const float4* xr = (const float4*)(x + (size_t)row * DM);
    float4 v[4]; float ss = 0.f;
#pragma unroll
    for (int i = 0; i < 4; ++i) { v[i] = xr[lane + 64 * i]; ss += v[i].x * v[i].x + v[i].y * v[i].y + v[i].z * v[i].z + v[i].w * v[i].w; }
    ss = wave_sum(ss);
    float rstd = rsqrtf(ss * (1.f / DM) + 1e-6f);
    float4* orow = (float4*)(out + (size_t)row * DM);
    const float4* g4 = (const float4*)g;
#pragma unroll
    for (int i = 0; i < 4; ++i) {
        float4 gg = g4[lane + 64 * i]; float4 o;
        o.x = v[i].x * rstd * gg.x; o.y = v[i].y * rstd * gg.y; o.z = v[i].z * rstd * gg.z; o.w = v[i].w * rstd * gg.w;
        orow[lane + 64 * i] = o;
    }
}

__global__ void __launch_bounds__(256) k_groupnorm_f32(const bf16_t* __restrict__ o, const float* __restrict__ gg, float* __restrict__ out) {
    int row = blockIdx.x * 4 + (threadIdx.x >> 6), lane = threadIdx.x & 63;
    const bf16_t* orow = o + (size_t)row * DM;
#pragma unroll
    for (int g = 0; g < 4; ++g) {
        float v[4]; float ss = 0.f;
#pragma unroll
        for (int i = 0; i < 4; ++i) { v[i] = bf2f(orow[g * 256 + lane + 64 * i]); ss += v[i] * v[i]; }
        ss = wave_sum(ss);
        float rstd = rsqrtf(ss * (1.f / 256.f) + 1e-6f);
#pragma unroll
        for (int i = 0; i < 4; ++i) out[(size_t)row * DM + g * 256 + lane + 64 * i] = v[i] * rstd * gg[g * 256 + lane + 64 * i];
    }
}

template <typename AT> __device__ __forceinline__ float ldA(const AT* p);
template <> __device__ __forceinline__ float ldA<float>(const float* p) { return *p; }
template <> __device__ __forceinline__ float ldA<bf16_t>(const bf16_t* p) { return bf2f(*p); }
__device__ __forceinline__ void stC(float* p, float v) { *p = v; }
__device__ __forceinline__ void stC(bf16_t* p, float v) { *p = f2bf(v); }

template <typename AT, typename CT, bool RES>
__global__ void __launch_bounds__(256) k_ngemm(const AT* __restrict__ A, int lda, const float* __restrict__ B, int ldb,
                                               CT* C, int ldc, const float* R, int ldr, int M, int N, int K) {
    __shared__ float As[16][132];
    __shared__ float Bs[16][132];
    const int tid = threadIdx.x, tx = tid & 15, ty = tid >> 4;
    const int m0 = blockIdx.y * 128, n0 = blockIdx.x * 128;
    float acc[8][8];
#pragma unroll
    for (int i = 0; i < 8; ++i)
#pragma unroll
        for (int j = 0; j < 8; ++j) acc[i][j] = 0.f;
    const int ar = tid >> 1, ak = (tid & 1) * 8;
    const int bk = tid >> 4, bn = (tid & 15) * 8;
    for (int k0 = 0; k0 < K; k0 += 16) {
#pragma unroll
        for (int i = 0; i < 8; ++i) As[ak + i][ar] = ldA<AT>(A + (size_t)(m0 + ar) * lda + k0 + ak + i);
#pragma unroll
        for (int i = 0; i < 8; ++i) { int n = n0 + bn + i; Bs[bk][bn + i] = (n < N) ? B[(size_t)(k0 + bk) * ldb + n] : 0.f; }
        __syncthreads();
#pragma unroll
        for (int kk = 0; kk < 16; ++kk) {
            float a[8], b[8];
#pragma unroll
            for (int i = 0; i < 8; ++i) a[i] = As[kk][ty * 8 + i];
#pragma unroll
            for (int j = 0; j < 8; ++j) b[j] = Bs[kk][tx * 8 + j];
#pragma unroll
            for (int i = 0; i < 8; ++i)
#pragma unroll
                for (int j = 0; j < 8; ++j) acc[i][j] += a[i] * b[j];
        }
        __syncthreads();
    }
#pragma unroll
    for (int i = 0; i < 8; ++i) {
        int m = m0 + ty * 8 + i;
#pragma unroll
        for (int j = 0; j < 8; ++j) {
            int n = n0 + tx * 8 + j;
            if (n < N) {
                float v = acc[i][j];
                if (RES) v += R[(size_t)m * ldr + n];
                stC(C + (size_t)m * ldc + n, v);
            }
        }
    }
}

struct QKV {
    bf16_t *qA, *kA, *vA, *qB, *kB, *vB, *qC, *kC, *vC, *qD, *kD, *vD;
};
struct PostArgs {
    const bf16_t* z; QKV o; Tables tb;
    const float *g_qn, *g_kn, *g_cq, *g_ckv;
    float *cqn, *ckvn;
};

__global__ void __launch_bounds__(256) k_post_naive(PostArgs a) {
    __shared__ float zr[NZ];
    __shared__ float hs[8];
    const int t = blockIdx.x, tid = threadIdx.x;
    const int b = t / SEQ, s = t % SEQ;
    for (int i = tid; i < NZ; i += 256) zr[i] = bf2f(a.z[(size_t)t * NZ + i]);
    __syncthreads();
    if (tid < 8) {
        int base, n;
        if (tid < 4) { base = 512 + tid * 64; n = 64; }
        else if (tid < 6) { base = 768 + (tid - 4) * 64; n = 64; }
        else if (tid == 6) { base = 1536; n = 256; }
        else { base = 1792; n = 128; }
        float ss = 0.f;
        for (int i = 0; i < n; ++i) ss += zr[base + i] * zr[base + i];
        hs[tid] = rsqrtf(ss / (float)n + 1e-6f);
    }
    __syncthreads();
    const float scA = 0.125f * LOG2E;
    const float scD = 0.10206207261596575f * LOG2E;
    for (int mix = 0; mix < 2; ++mix) {
        const int zb = mix == 0 ? 0 : 1024;
        bf16_t* qo = mix == 0 ? a.o.qA : a.o.qC;
        bf16_t* ko = mix == 0 ? a.o.kA : a.o.kC;
        bf16_t* vo = mix == 0 ? a.o.vA : a.o.vC;
        for (int i = tid; i < 128; i += 256) {
            int h = i / 32, j = i % 32;
            float x1 = zr[zb + h * 64 + j], x2 = zr[zb + h * 64 + 32 + j];
            float c = a.tb.cos1[s * 32 + j], sn = a.tb.sin1[s * 32 + j];
            size_t ob = ((size_t)(b * 4 + h) * SEQ + s) * 64;
            qo[ob + j] = f2bf((x1 * c - x2 * sn) * scA);
            qo[ob + 32 + j] = f2bf((x2 * c + x1 * sn) * scA);
        }
        for (int i = tid; i < 64; i += 256) {
            int h = i / 32, j = i % 32;
            float x1 = zr[zb + 256 + h * 64 + j], x2 = zr[zb + 256 + h * 64 + 32 + j];
            float c = a.tb.cos1[s * 32 + j], sn = a.tb.sin1[s * 32 + j];
            size_t ob = ((size_t)(b * 2 + h) * SEQ + s) * 64;
            ko[ob + j] = f2bf(x1 * c - x2 * sn);
            ko[ob + 32 + j] = f2bf(x2 * c + x1 * sn);
        }
        for (int i = tid; i < 128; i += 256) {
            int h = i / 64, j = i % 64;
            vo[((size_t)(b * 2 + h) * SEQ + s) * 64 + j] = f2bf(zr[zb + 384 + i]);
        }
    }
    {
        const int row = s / 64, col = s % 64;
        for (int i = tid; i < 192; i += 256) {
            int hh = i / 32, r = i % 32, half = r / 16, j = r % 16;
            bool isq = hh < 4;
            int zb = isq ? 512 + hh * 64 : 768 + (hh - 4) * 64;
            const float* gn = isq ? a.g_qn : a.g_kn;
            float rstd = hs[hh];
            int d1 = half * 32 + j, d2 = half * 32 + 16 + j;
            float x1 = zr[zb + d1] * rstd * gn[d1], x2 = zr[zb + d2] * rstd * gn[d2];
            float c, sn;
            if (half == 0) { c = a.tb.cosr[row * 16 + j]; sn = a.tb.sinr[row * 16 + j]; }
            else { c = a.tb.cosc[col * 16 + j]; sn = a.tb.sinc[col * 16 + j]; }
            float o1 = x1 * c - x2 * sn, o2 = x2 * c + x1 * sn;
            if (isq) {
                size_t ob = ((size_t)(b * 4 + hh) * SEQ + s) * 64;
                a.o.qB[ob + d1] = f2bf(o1 * scA); a.o.qB[ob + d2] = f2bf(o2 * scA);
            } else {
                size_t ob = ((size_t)(b * 2 + (hh - 4)) * SEQ + s) * 64;
                a.o.kB[ob + d1] = f2bf(o1); a.o.kB[ob + d2] = f2bf(o2);
            }
        }
        for (int i = tid; i < 128; i += 256) {
            int h = i / 64, j = i % 64;
            a.o.vB[((size_t)(b * 2 + h) * SEQ + s) * 64 + j] = f2bf(zr[896 + i]);
        }
    }
    for (int i = tid; i < 256; i += 256) a.cqn[(size_t)t * 256 + i] = zr[1536 + i] * hs[6] * a.g_cq[i];
    for (int i = tid; i < 128; i += 256) a.ckvn[(size_t)t * 128 + i] = zr[1792 + i] * hs[7] * a.g_ckv[i];
    for (int i = tid; i < 16; i += 256) {
        float x1 = zr[1920 + i], x2 = zr[1920 + 16 + i];
        float c = a.tb.cosm[s * 16 + i], sn = a.tb.sinm[s * 16 + i];
        bf16_t o1 = f2bf(x1 * c - x2 * sn), o2 = f2bf(x2 * c + x1 * sn);
        for (int h = 0; h < 4; ++h) {
            size_t ob = ((size_t)(b * 4 + h) * SEQ + s) * 96;
            a.o.kD[ob + 64 + i] = o1; a.o.kD[ob + 80 + i] = o2;
        }
    }
    (void)scD;
}

__global__ void __launch_bounds__(256) k_post_mla(const float* __restrict__ qfull, const float* __restrict__ kvfull, QKV o, Tables tb) {
    const int t = blockIdx.x, tid = threadIdx.x;
    const int b = t / SEQ, s = t % SEQ;
    const float scD = 0.10206207261596575f * LOG2E;
    {
        int h = tid / 64, j = tid % 64;
        o.qD[((size_t)(b * 4 + h) * SEQ + s) * 96 + j] = f2bf(qfull[(size_t)t * 384 + h * 96 + j] * scD);
    }
    if (tid < 64) {
        int h = tid / 16, j = tid % 16;
        float x1 = qfull[(size_t)t * 384 + h * 96 + 64 + j], x2 = qfull[(size_t)t * 384 + h * 96 + 80 + j];
        float c = tb.cosm[s * 16 + j], sn = tb.sinm[s * 16 + j];
        size_t ob = ((size_t)(b * 4 + h) * SEQ + s) * 96;
        o.qD[ob + 64 + j] = f2bf((x1 * c - x2 * sn) * scD);
        o.qD[ob + 80 + j] = f2bf((x2 * c + x1 * sn) * scD);
    }
    {
        int h = tid / 64, j = tid % 64;
        o.kD[((size_t)(b * 4 + h) * SEQ + s) * 96 + j] = f2bf(kvfull[(size_t)t * 512 + h * 128 + j]);
        o.vD[((size_t)(b * 4 + h) * SEQ + s) * 64 + j] = f2bf(kvfull[(size_t)t * 512 + h * 128 + 64 + j]);
    }
}

template <int DK, int MODE>
__global__ void __launch_bounds__(256) k_attn_naive(const bf16_t* __restrict__ Q, const bf16_t* __restrict__ K, const bf16_t* __restrict__ V,
                                                    const float* __restrict__ sink, bf16_t* __restrict__ O, int H, int KV, int ocol) {
    const int wave = threadIdx.x >> 6, lane = threadIdx.x & 63;
    const int gq = blockIdx.x * 4 + wave;
    const int s = gq % SEQ, bh = gq / SEQ, h = bh % H, b = bh / H;
    const int kvh = h / (H / KV);
    const bf16_t* qrow = Q + (size_t)gq * DK;
    const bf16_t* Kb = K + (size_t)(b * KV + kvh) * SEQ * DK;
    const bf16_t* Vb = V + (size_t)(b * KV + kvh) * SEQ * 64;
    const int sub = lane & 7, grp = lane >> 3;
    constexpr int NCH = DK / 8;
    float q0[8], q1[8];
    {
        uint4 r = *(const uint4*)(qrow + sub * 8);
        const bf16_t* p = (const bf16_t*)&r;
#pragma unroll
        for (int i = 0; i < 8; ++i) q0[i] = bf2f(p[i]);
        const bool has1 = (NCH > 8) && (sub + 8 < NCH);
        uint4 r1 = make_uint4(0, 0, 0, 0);
        if (has1) r1 = *(const uint4*)(qrow + (sub + 8) * 8);
        const bf16_t* p1 = (const bf16_t*)&r1;
#pragma unroll
        for (int i = 0; i < 8; ++i) q1[i] = bf2f(p1[i]);
    }
    float m = -1e30f, l = 0.f, acc[8];
#pragma unroll
    for (int i = 0; i < 8; ++i) acc[i] = 0.f;
    if (MODE == 1 && grp == 0) { m = sink[h] * LOG2E; l = 1.f; }
    const int nk = MODE == 0 ? SEQ : (MODE == 1 ? 257 : 387);
    for (int base = 0; base < nk; base += 8) {
        const int kk = base + grp;
        bool valid = kk < nk;
        int tok;
        if (MODE == 0) tok = kk;
        else if (MODE == 1) tok = s - 128 + kk;
        else { int p = kk / 129, j = kk % 129; int r = p == 0 ? 1 : (p == 1 ? 4 : 16); tok = s + (j - 64) * r; }
        valid = valid && tok >= 0 && tok < SEQ;
        float sc = 0.f;
        if (valid) {
            uint4 r = *(const uint4*)(Kb + (size_t)tok * DK + sub * 8);
            const bf16_t* p = (const bf16_t*)&r;
#pragma unroll
            for (int i = 0; i < 8; ++i) sc += q0[i] * bf2f(p[i]);
            if (NCH > 8 && sub + 8 < NCH) {
                uint4 r1 = *(const uint4*)(Kb + (size_t)tok * DK + (sub + 8) * 8);
                const bf16_t* p1 = (const bf16_t*)&r1;
#pragma unroll
                for (int i = 0; i < 8; ++i) sc += q1[i] * bf2f(p1[i]);
            }
        }
        sc += __shfl_xor(sc, 1); sc += __shfl_xor(sc, 2); sc += __shfl_xor(sc, 4);
        if (valid) {
            float mn = fmaxf(m, sc);
            float f = exp2f(m - mn), p = exp2f(sc - mn);
            uint4 r = *(const uint4*)(Vb + (size_t)tok * 64 + sub * 8);
            const bf16_t* pv = (const bf16_t*)&r;
            l = l * f + p;
#pragma unroll
            for (int i = 0; i < 8; ++i) acc[i] = acc[i] * f + p * bf2f(pv[i]);
            m = mn;
        }
    }
    float M = m;
    M = fmaxf(M, __shfl_xor(M, 8)); M = fmaxf(M, __shfl_xor(M, 16)); M = fmaxf(M, __shfl_xor(M, 32));
    float f = exp2f(m - M);
    l *= f;
    l += __shfl_xor(l, 8); l += __shfl_xor(l, 16); l += __shfl_xor(l, 32);
#pragma unroll
    for (int i = 0; i < 8; ++i) {
        float v = acc[i] * f;
        v += __shfl_xor(v, 8); v += __shfl_xor(v, 16); v += __shfl_xor(v, 32);
        acc[i] = v;
    }
    if (grp == 0) {
        const int t = b * SEQ + s;
        float inv = 1.f / l;
#pragma unroll
        for (int i = 0; i < 8; ++i) O[(size_t)t * DM + ocol + h * 64 + sub * 8 + i] = f2bf(acc[i] * inv);
    }
}

__global__ void __launch_bounds__(64) k_peer_topk_naive(const bf16_t* __restrict__ qp, const float* __restrict__ subk  ,
                                                        int* __restrict__ eidx, float* __restrict__ gate) {
    __shared__ float qs[256];
    __shared__ float s12[2][16];
    __shared__ int i12[2][16];
    const int t = blockIdx.x >> 3, h = blockIdx.x & 7, lane = threadIdx.x;
    for (int i = lane; i < 256; i += 64) qs[i] = bf2f(qp[(size_t)t * 2048 + h * 256 + i]);
    __syncthreads();
    float sc[2][2];
#pragma unroll
    for (int c = 0; c < 2; ++c)
#pragma unroll
        for (int u = 0; u < 2; ++u) {
            int n = lane + 64 * u;
            const float* kr = subk + ((size_t)(h * 2 + c) * 128 + n) * 128;
            float a = 0.f;
            for (int d = 0; d < 128; ++d) a += qs[c * 128 + d] * kr[d];
            sc[c][u] = a;
        }
#pragma unroll
    for (int c = 0; c < 2; ++c) {
        for (int r = 0; r < 16; ++r) {
            float bv; int bi;
            if (sc[c][0] >= sc[c][1]) { bv = sc[c][0]; bi = lane; } else { bv = sc[c][1]; bi = lane + 64; }
#pragma unroll
            for (int o = 32; o >= 1; o >>= 1) {
                float ov = __shfl_xor(bv, o); int oi = __shfl_xor(bi, o);
                if (ov > bv || (ov == bv && oi < bi)) { bv = ov; bi = oi; }
            }
            if (bi == lane) sc[c][0] = -3e38f;
            if (bi == lane + 64) sc[c][1] = -3e38f;
            if (lane == 0) { s12[c][r] = bv; i12[c][r] = bi; }
        }
    }
    __syncthreads();
    float cv[4]; int ci[4];
#pragma unroll
    for (int u = 0; u < 4; ++u) {
        int id = lane + 64 * u;
        cv[u] = s12[0][id / 16] + s12[1][id % 16];
        ci[u] = i12[0][id / 16] * 128 + i12[1][id % 16];
    }
    float best = 0.f; int be = 0;
    for (int r = 0; r < 16; ++r) {
        float bv = cv[0]; int bu = 0;
#pragma unroll
        for (int u = 1; u < 4; ++u) if (cv[u] > bv) { bv = cv[u]; bu = u; }
        int bid = lane + 64 * bu;
#pragma unroll
        for (int o = 32; o >= 1; o >>= 1) {
            float ov = __shfl_xor(bv, o); int oi = __shfl_xor(bid, o);
            if (ov > bv || (ov == bv && oi < bid)) { bv = ov; bid = oi; }
        }
        int e = 0;
#pragma unroll
        for (int u = 0; u < 4; ++u) if (bid == lane + 64 * u) { cv[u] = -3e38f; e = ci[u]; }
        e = __shfl(e, bid & 63);
        if (lane == r) { best = bv; be = e; }
    }
    float mx = lane < 16 ? best : -3e38f;
    mx = wave_max(mx);
    float ex = lane < 16 ? expf(best - mx) : 0.f;
    float sm = wave_sum(ex);
    if (lane < 16) {
        eidx[(size_t)t * 128 + h * 16 + lane] = be;
        gate[(size_t)t * 128 + h * 16 + lane] = ex / sm;
    }
}

__global__ void __launch_bounds__(256) k_peer_expert_naive(const float* __restrict__ hn, const int* __restrict__ eidx, const float* __restrict__ gate,
                                                           const float* __restrict__ ut, const float* __restrict__ vt, float* __restrict__ x) {
    __shared__ float hs[DM];
    __shared__ float wg[128];
    __shared__ int es[128];
    const int t = blockIdx.x, tid = threadIdx.x, wave = tid >> 6, lane = tid & 63;
    for (int i = tid; i < DM; i += 256) hs[i] = hn[(size_t)t * DM + i];
    if (tid < 128) es[tid] = eidx[(size_t)t * 128 + tid];
    __syncthreads();
    for (int p = wave * 32; p < wave * 32 + 32; ++p) {
        const float* ur = ut + (size_t)es[p] * DM;
        float a = 0.f;
#pragma unroll
        for (int i = 0; i < 16; ++i) a += ur[lane + 64 * i] * hs[lane + 64 * i];
        a = wave_sum(a);
        if (lane == 0) {
            float ge = 0.5f * a * (1.f + erff(a * 0.70710678118654752f));
            wg[p] = gate[(size_t)t * 128 + p] * ge;
        }
    }
    __syncthreads();
    float o[4] = {0.f, 0.f, 0.f, 0.f};
    for (int p = 0; p < 128; ++p) {
        const float* vr = vt + (size_t)es[p] * DM;
        float w = wg[p];
#pragma unroll
        for (int i = 0; i < 4; ++i) o[i] += w * vr[tid + 256 * i];
    }
#pragma unroll
    for (int i = 0; i < 4; ++i) x[(size_t)t * DM + tid + 256 * i] += o[i];
}

using bf16x8 = __attribute__((ext_vector_type(8))) short;
using s16x4 = __attribute__((ext_vector_type(4))) short;
using f32x16 = __attribute__((ext_vector_type(16))) float;
typedef __attribute__((ext_vector_type(2))) __bf16 bf16x2_t;

#define NW 8
#define NBLK_THREADS 512
#define CT_STRIDE 260
#define LDS_BYTES (128 * CT_STRIDE * 4)

__device__ __forceinline__ unsigned cvtpk(float lo, float hi) {
    unsigned r; asm("v_cvt_pk_bf16_f32 %0, %1, %2" : "=v"(r) : "v"(lo), "v"(hi)); return r;
}
__device__ __forceinline__ int tid_opaque() { int t = threadIdx.x; asm volatile("" : "+v"(t)); return t; }
__device__ __forceinline__ int crow(int i, int hh) { return (i & 3) + 8 * (i >> 2) + 4 * hh; }
__device__ __forceinline__ float xhalf(float v) { return __shfl_xor(v, 32); }
__device__ __forceinline__ float xhalf_max(float v) { auto rr = __builtin_amdgcn_permlane32_swap(__float_as_uint(v), __float_as_uint(v), false, false); return fmaxf(__uint_as_float(rr[0]), __uint_as_float(rr[1])); }
__device__ __forceinline__ float xhalf_sum(float v) { auto rr = __builtin_amdgcn_permlane32_swap(__float_as_uint(v), __float_as_uint(v), false, false); return __uint_as_float(rr[0]) + __uint_as_float(rr[1]); }

struct P {
    const float *x_in, *g_mix, *w_in, *win_sink, *ax_q_norm, *ax_k_norm, *mla_q_norm, *mla_kv_norm, *mla_w_uq, *mla_w_ukv, *g_group, *w_out,
        *g_ffn, *peer_w_q, *peer_sub_keys, *peer_u, *peer_v, *g_final;
    float* out;
    float* x; bf16_t* hnb; bf16_t* zb; QKV q; bf16_t* ob; bf16_t* qp; int* eidx; float* gate;
    bf16_t *cqn, *ckvn, *qfull, *kvfull;
    bf16_t *winT, *woutT, *wqT, *subk, *wuqT, *wukvT;
    unsigned char *u8, *v8; float *su, *sv; float* ssq2; bf16_t* xb2; float* ssqd;
    Tables tb;
    unsigned* bar;
    int flags; int pad0;
};
typedef const P __attribute__((address_space(4))) PC;
__device__ __forceinline__ PC* kargs() { PC* q = (PC*)__builtin_amdgcn_kernarg_segment_ptr(); asm volatile("" : "+s"(q)); return q; }

struct EpiStoreBf16 {
    bf16_t* C; int ldc; int N;
    __device__ __forceinline__ void operator()(const f32x16 (&acc)[2][2], int mbase, int nbase, int r32, int hh) const {
#pragma unroll
        for (int mt = 0; mt < 2; ++mt)
#pragma unroll
            for (int nt = 0; nt < 2; ++nt) {
                const int n = nbase + nt * 32 + r32;
                if (n < N) {
#pragma unroll
                    for (int i = 0; i < 16; ++i) {
                        const int m = mbase + mt * 32 + crow(i, hh);
                        C[(size_t)m * ldc + n] = f2bf(acc[mt][nt][i]);
                    }
                }
            }
    }
};
struct EpiResidNorm {
    float* X; int ldx; bf16_t* XB; float* ssq;
    __device__ __forceinline__ void operator()(const f32x16 (&acc)[2][2], int mbase, int nbase, int r32, int hh) const {
#pragma unroll
        for (int mt = 0; mt < 2; ++mt) {
#pragma unroll
            for (int i = 0; i < 16; ++i) {
                const int m = mbase + mt * 32 + crow(i, hh);
                float sq = 0.f;
#pragma unroll
                for (int nt = 0; nt < 2; ++nt) {
                    const int n = nbase + nt * 32 + r32;
                    float* px = X + (size_t)m * ldx + n;
                    const float v = *px + acc[mt][nt][i];
                    *px = v;
                    XB[(size_t)m * ldx + n] = f2bf(v);
                    sq += v * v;
                }
                sq += __shfl_xor(sq, 1); sq += __shfl_xor(sq, 2); sq += __shfl_xor(sq, 4); sq += __shfl_xor(sq, 8); sq += __shfl_xor(sq, 16);
                if (r32 == 0) ssq[(size_t)m * 16 + (nbase >> 6)] = sq;
            }
        }
    }
};
struct EpiStoreBf16RowNorm {
    bf16_t* C; int ldc; const float* ssq;
    __device__ __forceinline__ void operator()(const f32x16 (&acc)[2][2], int mbase, int nbase, int r32, int hh) const {
#pragma unroll
        for (int mt = 0; mt < 2; ++mt)
#pragma unroll
            for (int i = 0; i < 16; ++i) {
                const int m = mbase + mt * 32 + crow(i, hh);
                const float4 q0 = *(const float4*)(ssq + (size_t)m * 16), q1 = *(const float4*)(ssq + (size_t)m * 16 + 4);
                const float4 q2 = *(const float4*)(ssq + (size_t)m * 16 + 8), q3 = *(const float4*)(ssq + (size_t)m * 16 + 12);
                const float tot = (((q0.x + q0.y) + (q0.z + q0.w)) + ((q1.x + q1.y) + (q1.z + q1.w))) + (((q2.x + q2.y) + (q2.z + q2.w)) + ((q3.x + q3.y) + (q3.z + q3.w)));
                const float r = rsqrtf(tot * (1.f / DM) + 1e-6f);
#pragma unroll
                for (int nt = 0; nt < 2; ++nt) C[(size_t)m * ldc + nbase + nt * 32 + r32] = f2bf(acc[mt][nt][i] * r);
            }
    }
};
struct EpiResidF32 {
    float* X; int ldx;
    __device__ __forceinline__ void operator()(const f32x16 (&acc)[2][2], int mbase, int nbase, int r32, int hh) const {
#pragma unroll
        for (int mt = 0; mt < 2; ++mt)
#pragma unroll
            for (int nt = 0; nt < 2; ++nt) {
                const int n = nbase + nt * 32 + r32;
#pragma unroll
                for (int i = 0; i < 16; ++i) {
                    const int m = mbase + mt * 32 + crow(i, hh);
                    float* p = X + (size_t)m * ldx + n;
                    *p = *p + acc[mt][nt][i];
                }
            }
    }
};

__device__ __forceinline__ void glds16(const void* gsrc, unsigned lds_dst) {
    unsigned keep;
    asm volatile("s_mov_b32 %0, m0\n\ts_mov_b32 m0, %2\n\ts_nop 0\n\tglobal_load_lds_dwordx4 %1, off\n\ts_mov_b32 m0, %0" : "=&s"(keep) : "v"(gsrc), "s"(lds_dst) : "memory");
}

template <class Epi>
__device__ __forceinline__ void gemm_tile(const bf16_t* __restrict__ X, int ldx, const bf16_t* __restrict__ W, int ldw, int K, int m0, int n0, int N,
                                          char* lds, const Epi& epi) {
    const int tid = tid_opaque(), lane = tid & 63, wave = tid >> 6;
    const int wm = wave >> 1, wn = wave & 1;
    const int r32 = lane & 31, hh = lane >> 5;
    const char* xsrc[4]; const char* wsrc[4];
#pragma unroll
    for (int j = 0; j < 4; ++j) {
        const int row = (wave * 4 + j) * 8 + (lane >> 3), slot = lane & 7;
        const int c = slot ^ ((row >> 1) & 7);
        xsrc[j] = (const char*)(X + (size_t)(m0 + row) * ldx + c * 8);
        int n = n0 + row; n = n < N ? n : N - 1;
        wsrc[j] = (const char*)(W + (size_t)n * ldw + c * 8);
    }
    const unsigned lbase = (unsigned)(uintptr_t)lds;
    const unsigned wpiece = __builtin_amdgcn_readfirstlane(wave) * 4096u;
    f32x16 acc[2][2];
#pragma unroll
    for (int a = 0; a < 2; ++a)
#pragma unroll
        for (int b = 0; b < 2; ++b)
#pragma unroll
            for (int i = 0; i < 16; ++i) acc[a][b][i] = 0.f;
    const int nk = K >> 6;
#define GDMA(KT, BUF) do { const unsigned _d = lbase + (BUF) * 32768u + wpiece; const int _ko = (KT) * 128; \
        glds16(xsrc[0] + _ko, _d); glds16(xsrc[1] + _ko, _d + 1024u); glds16(xsrc[2] + _ko, _d + 2048u); glds16(xsrc[3] + _ko, _d + 3072u); \
        glds16(wsrc[0] + _ko, _d + 16384u); glds16(wsrc[1] + _ko, _d + 17408u); glds16(wsrc[2] + _ko, _d + 18432u); glds16(wsrc[3] + _ko, _d + 19456u); } while (0)
    GDMA(0, 0);
    asm volatile("s_waitcnt vmcnt(0)" ::: "memory");
    __syncthreads();
    for (int kt = 0; kt < nk; ++kt) {
        if (kt + 1 < nk) GDMA(kt + 1, (kt + 1) & 1);
        const char* xs = lds + (kt & 1) * 32768; const char* ws = xs + 16384;
#pragma unroll
        for (int ks = 0; ks < 4; ++ks) {
            bf16x8 xf[2], wf[2];
#pragma unroll
            for (int mt = 0; mt < 2; ++mt) { const int r = wm * 64 + mt * 32 + r32; xf[mt] = *(const bf16x8*)(xs + r * 128 + (((ks * 2 + hh) ^ ((r >> 1) & 7)) << 4)); }
#pragma unroll
            for (int nt = 0; nt < 2; ++nt) { const int r = wn * 64 + nt * 32 + r32; wf[nt] = *(const bf16x8*)(ws + r * 128 + (((ks * 2 + hh) ^ ((r >> 1) & 7)) << 4)); }
#pragma unroll
            for (int mt = 0; mt < 2; ++mt)
#pragma unroll
                for (int nt = 0; nt < 2; ++nt) acc[mt][nt] = __builtin_amdgcn_mfma_f32_32x32x16_bf16(xf[mt], wf[nt], acc[mt][nt], 0, 0, 0);
        }
        asm volatile("s_waitcnt vmcnt(0)" ::: "memory");
        __syncthreads();
    }
#undef GDMA
    epi(acc, m0 + wm * 64, n0 + wn * 64, r32, hh);
}

__device__ __forceinline__ void tile_map(int tile, int ntm, int ntn, int& mt, int& nt) {
    if ((ntn & 7) == 0) {
        const int G = gridDim.x;
        const int round = tile / G, bi = tile % G;
        const int x = bi & 7, j = bi >> 3;
        const int per = G >> 3;
        const int id = (round * 8 + x) * per + j;
        const int st = id >> 6, in = id & 63;
        const int snt = ntn >> 3;
        const int sm = st / snt, sn = st % snt;
        mt = sm * 8 + (in >> 3); nt = sn * 8 + (in & 7);
    } else { mt = tile / ntn; nt = tile % ntn; }
}

template <class Epi, int KGROUP>
__device__ __forceinline__ void gemm_tile_rows(const bf16_t* __restrict__ X, int ldx, const bf16_t* __restrict__ W, int ldw, int K, int m0, int n0, int N,
                                               char* lds, const Epi& epi) {
    const int tid = tid_opaque(), lane = tid & 63, wave = tid >> 6;
    const int wm = wave >> 1, wn = wave & 1;
    const int r32 = lane & 31, hh = lane >> 5;
    const char* xsrc[4]; const char* wsrc[4];
#pragma unroll
    for (int j = 0; j < 4; ++j) {
        const int row = (wave * 4 + j) * 8 + (lane >> 3), slot = lane & 7;
        const int c = slot ^ ((row >> 1) & 7);
        xsrc[j] = (const char*)(X + (size_t)(m0 + row) * ldx + c * 8);
        int n = n0 + row; n = n < N ? n : N - 1;
        wsrc[j] = (const char*)(W + (size_t)n * ldw + c * 8);
    }
    const unsigned lbase = (unsigned)(uintptr_t)lds;
    const unsigned wpiece = __builtin_amdgcn_readfirstlane(wave) * 4096u;
    f32x16 acc[2][4];
#pragma unroll
    for (int a = 0; a < 2; ++a)
#pragma unroll
        for (int b = 0; b < 4; ++b)
#pragma unroll
            for (int i = 0; i < 16; ++i) acc[a][b][i] = 0.f;
    const int nk = K >> 6;
#define GDMA(KT, BUF) do { const unsigned _d = lbase + (BUF) * 65536u + wpiece; const int _ko = (KT) * 128; \
        glds16(xsrc[0] + _ko, _d); glds16(xsrc[1] + _ko, _d + 1024u); glds16(xsrc[2] + _ko, _d + 2048u); glds16(xsrc[3] + _ko, _d + 3072u); \
        glds16(wsrc[0] + _ko, _d + 32768u); glds16(wsrc[1] + _ko, _d + 33792u); glds16(wsrc[2] + _ko, _d + 34816u); glds16(wsrc[3] + _ko, _d + 35840u); } while (0)
    GDMA(0, 0);
    asm volatile("s_waitcnt vmcnt(0)" ::: "memory");
    __syncthreads();
    for (int kt = 0; kt < nk; ++kt) {
        if (kt + 1 < nk) GDMA(kt + 1, (kt + 1) & 1);
        const char* xs = lds + (kt & 1) * 65536; const char* ws = xs + 32768;
#pragma unroll
        for (int ks = 0; ks < 4; ++ks) {
            bf16x8 xf[2], wf[4];
#pragma unroll
            for (int mt = 0; mt < 2; ++mt) { const int r = wm * 64 + mt * 32 + r32; xf[mt] = *(const bf16x8*)(xs + r * 128 + (((ks * 2 + hh) ^ ((r >> 1) & 7)) << 4)); }
#pragma unroll
            for (int nt = 0; nt < 4; ++nt) { const int r = wn * 128 + nt * 32 + r32; wf[nt] = *(const bf16x8*)(ws + r * 128 + (((ks * 2 + hh) ^ ((r >> 1) & 7)) << 4)); }
#pragma unroll
            for (int mt = 0; mt < 2; ++mt)
#pragma unroll
                for (int nt = 0; nt < 4; ++nt) acc[mt][nt] = __builtin_amdgcn_mfma_f32_32x32x16_bf16(xf[mt], wf[nt], acc[mt][nt], 0, 0, 0);
        }
        asm volatile("s_waitcnt vmcnt(0)" ::: "memory");
        __syncthreads();
    }
#undef GDMA
    float* ct = (float*)lds;
#pragma unroll
    for (int hsel = 0; hsel < 2; ++hsel) {
        if ((wm >> 1) == hsel) {
#pragma unroll
            for (int mt = 0; mt < 2; ++mt)
#pragma unroll
                for (int nt = 0; nt < 4; ++nt)
#pragma unroll
                    for (int i = 0; i < 16; ++i)
                        ct[((wm & 1) * 64 + mt * 32 + crow(i, hh)) * CT_STRIDE + wn * 128 + nt * 32 + r32] = acc[mt][nt][i];
        }
        __syncthreads();
        epi.begin(ct, m0 + hsel * 128, n0, tid);
#pragma unroll
        for (int pass = 0; pass < 8; ++pass) {
            const int ch = pass & 3, row = (pass >> 2) * 64 + (tid >> 3), c = tid & 7;
            epi.chunk(ct + row * CT_STRIDE + ch * 64 + c * 8, ct + row * CT_STRIDE, m0 + hsel * 128 + row, n0 + ch * 64, c);
        }
        __syncthreads();
    }
}

template <class Epi, int KGROUP>
__device__ __forceinline__ void gemm_phase_rows(const bf16_t* X, int ldx, const bf16_t* W, int ldw, int M, int N, int K, char* lds, const Epi& epi) {
    const int ntm = M >> 8, ntn = (N + 255) >> 8, nt_tot = ntm * ntn;
    for (int tile = blockIdx.x; tile < nt_tot; tile += gridDim.x) {
        int mt, nt;
        if ((gridDim.x & 63) == 0 && (ntn & 7) == 0 && (nt_tot % gridDim.x) == 0) tile_map(tile, ntm, ntn, mt, nt);
        else { mt = tile / ntn; nt = tile % ntn; }
        if (mt < ntm && nt < ntn) gemm_tile_rows<Epi, KGROUP>(X, ldx, W, ldw, K, mt * 256, nt * 256, N, lds, epi);
    }
}

__device__ __forceinline__ uint4 pack8(const float4& a, const float4& b) { return make_uint4(cvtpk(a.x, a.y), cvtpk(a.z, a.w), cvtpk(b.x, b.y), cvtpk(b.z, b.w)); }
__device__ __forceinline__ float sum8(float v) { v += __shfl_xor(v, 1); v += __shfl_xor(v, 2); v += __shfl_xor(v, 4); return v; }

struct RowsStoreBf16 {
    bf16_t* C; int ldc; int N;
    __device__ __forceinline__ void table(float*, int, int) const {}
    __device__ __forceinline__ void begin(float*, int, int, int) const {}
    __device__ __forceinline__ void chunk(const float* t, const float* rb, int m, int n, int c) const {
        if (n + 8 * c < N) *(uint4*)(C + (size_t)m * ldc + n + 8 * c) = pack8(*(const float4*)t, *(const float4*)(t + 4));
    }
};
struct RowsResidF32 {
    float* X; int ldx;
    __device__ __forceinline__ void table(float*, int, int) const {}
    __device__ __forceinline__ void begin(float*, int, int, int) const {}
    __device__ __forceinline__ void chunk(const float* t, const float* rb, int m, int n, int c) const {
        float* px = X + (size_t)m * ldx + n + 8 * c;
        float4 v0 = *(const float4*)px, v1 = *(const float4*)(px + 4);
        const float4 a0 = *(const float4*)t, a1 = *(const float4*)(t + 4);
        v0.x += a0.x; v0.y += a0.y; v0.z += a0.z; v0.w += a0.w; v1.x += a1.x; v1.y += a1.y; v1.z += a1.z; v1.w += a1.w;
        *(float4*)px = v0; *(float4*)(px + 4) = v1;
    }
};
struct RowsResidNorm {
    float* X; int ldx; bf16_t* XB; float* ssq;
    __device__ __forceinline__ void table(float*, int, int) const {}
    __device__ __forceinline__ void begin(float*, int, int, int) const {}
    __device__ __forceinline__ void chunk(const float* t, const float* rb, int m, int n, int c) const {
        float* px = X + (size_t)m * ldx + n + 8 * c;
        float4 v0 = *(const float4*)px, v1 = *(const float4*)(px + 4);
        const float4 a0 = *(const float4*)t, a1 = *(const float4*)(t + 4);
        v0.x += a0.x; v0.y += a0.y; v0.z += a0.z; v0.w += a0.w; v1.x += a1.x; v1.y += a1.y; v1.z += a1.z; v1.w += a1.w;
        *(float4*)px = v0; *(float4*)(px + 4) = v1;
        *(uint4*)(XB + (size_t)m * ldx + n + 8 * c) = pack8(v0, v1);
        const float sq = sum8((v0.x * v0.x + v0.y * v0.y) + (v0.z * v0.z + v0.w * v0.w) + (v1.x * v1.x + v1.y * v1.y) + (v1.z * v1.z + v1.w * v1.w));
        if (c == 0) ssq[((size_t)(n >> 8) * T_TOK + m) * 4 + ((n >> 6) & 3)] = sq;
    }
};
struct RowsStoreBf16RowNorm {
    bf16_t* C; int ldc; const float* ssq;
    __device__ __forceinline__ void table(float*, int, int) const {}
    __device__ __forceinline__ void begin(float* ct, int m0, int, int tid) const {
        if (tid < 128) {
            float tot = 0.f;
#pragma unroll
            for (int j = 0; j < 4; ++j) { const float4 q = *(const float4*)(ssq + ((size_t)j * T_TOK + m0 + tid) * 4); tot += (q.x + q.y) + (q.z + q.w); }
            ct[tid * CT_STRIDE + 256] = rsqrtf(tot * (1.f / DM) + 1e-6f);
        }
        __syncthreads();
    }
    __device__ __forceinline__ void chunk(const float* t, const float* rb, int m, int n, int c) const {
        const float r = rb[256];
        const float4 a = *(const float4*)t, b = *(const float4*)(t + 4);
        *(uint4*)(C + (size_t)m * ldc + n + 8 * c) = make_uint4(cvtpk(a.x * r, a.y * r), cvtpk(a.z * r, a.w * r), cvtpk(b.x * r, b.y * r), cvtpk(b.z * r, b.w * r));
    }
};

struct F8 { float4 a, b; };
__device__ __forceinline__ F8 f8_load(const float* p) { F8 r; r.a = *(const float4*)p; r.b = *(const float4*)(p + 4); return r; }
__device__ __forceinline__ F8 f8_shfl_xor(const F8& v, int m) {
    F8 r; r.a.x = __shfl_xor(v.a.x, m); r.a.y = __shfl_xor(v.a.y, m); r.a.z = __shfl_xor(v.a.z, m); r.a.w = __shfl_xor(v.a.w, m);
    r.b.x = __shfl_xor(v.b.x, m); r.b.y = __shfl_xor(v.b.y, m); r.b.z = __shfl_xor(v.b.z, m); r.b.w = __shfl_xor(v.b.w, m); return r;
}
__device__ __forceinline__ float f8_ssq(const F8& v) { return (v.a.x * v.a.x + v.a.y * v.a.y) + (v.a.z * v.a.z + v.a.w * v.a.w) + (v.b.x * v.b.x + v.b.y * v.b.y) + (v.b.z * v.b.z + v.b.w * v.b.w); }
__device__ __forceinline__ uint4 f8_rope_pack(const F8& v, const F8& pv, const F8& cs, const F8& sn, float sg, float sc) {
    return make_uint4(cvtpk((v.a.x * cs.a.x + sg * pv.a.x * sn.a.x) * sc, (v.a.y * cs.a.y + sg * pv.a.y * sn.a.y) * sc),
                      cvtpk((v.a.z * cs.a.z + sg * pv.a.z * sn.a.z) * sc, (v.a.w * cs.a.w + sg * pv.a.w * sn.a.w) * sc),
                      cvtpk((v.b.x * cs.b.x + sg * pv.b.x * sn.b.x) * sc, (v.b.y * cs.b.y + sg * pv.b.y * sn.b.y) * sc),
                      cvtpk((v.b.z * cs.b.z + sg * pv.b.z * sn.b.z) * sc, (v.b.w * cs.b.w + sg * pv.b.w * sn.b.w) * sc));
}
#define QKV_MIX(mi) ((size_t)(mi) * 512 * T_TOK)
#define QKV_K (256 * (size_t)T_TOK)
#define QKV_V (384 * (size_t)T_TOK)
#define QKV_KD (1920 * (size_t)T_TOK)
struct RowsPostZ {
    bf16_t* qkv; const float* tb; const float* g_qn; const float* g_kn; bf16_t* lat; float* ssqd; bf16_t* kD;
    __device__ __forceinline__ void table(float*, int, int) const {}
    __device__ __forceinline__ void begin(float*, int, int, int) const {}
    __device__ __forceinline__ void chunk(const float* t, const float* rb, int m, int n, int c) const {
        const int qc = n >> 6;
        const int b = m / SEQ, s = m % SEQ;
        F8 v = f8_load(t);
        const float scA = 0.125f * LOG2E;
        if (qc < 6 || (qc >= 16 && qc < 22)) {
            const int mi = qc >= 16 ? 2 : 0; const int ql = qc - 8 * mi;
            const F8 pv = f8_shfl_xor(v, 4);
            const int j0 = 8 * (c & 3);
            const F8 cs = f8_load(tb + s * 32 + j0), sn = f8_load(tb + 131072 + s * 32 + j0);
            const size_t off = QKV_MIX(mi) + (ql < 4 ? ((size_t)(b * 4 + ql) * SEQ + s) * 64 : QKV_K + ((size_t)(b * 2 + (ql - 4)) * SEQ + s) * 64);
            *(uint4*)(qkv + off + 8 * c) = f8_rope_pack(v, pv, cs, sn, (c < 4) ? -1.f : 1.f, (ql < 4) ? scA : 1.f);
        } else if (qc == 6 || qc == 7 || qc == 14 || qc == 15 || qc == 22 || qc == 23) {
            *(uint4*)(qkv + QKV_MIX(qc >> 3) + QKV_V + ((size_t)(b * 2 + (qc & 1)) * SEQ + s) * 64 + 8 * c) = pack8(v.a, v.b);
        } else if (qc >= 8 && qc < 14) {
            const bool isq = qc < 12; const int h = isq ? qc - 8 : qc - 12;
            const float r = rsqrtf(sum8(f8_ssq(v)) * (1.f / 64.f) + 1e-6f);
            const F8 gq = f8_load(g_qn + 8 * c), gk = f8_load(g_kn + 8 * c);
            v.a.x *= r * (isq ? gq.a.x : gk.a.x); v.a.y *= r * (isq ? gq.a.y : gk.a.y); v.a.z *= r * (isq ? gq.a.z : gk.a.z); v.a.w *= r * (isq ? gq.a.w : gk.a.w);
            v.b.x *= r * (isq ? gq.b.x : gk.b.x); v.b.y *= r * (isq ? gq.b.y : gk.b.y); v.b.z *= r * (isq ? gq.b.z : gk.b.z); v.b.w *= r * (isq ? gq.b.w : gk.b.w);
            const F8 pv = f8_shfl_xor(v, 2);
            const int jj0 = 8 * (c & 1);
            const int to = (c < 4) ? 393216 + (s >> 6) * 16 : 395264 + (s & 63) * 16;
            const F8 cs = f8_load(tb + to + jj0), sn = f8_load(tb + to + 1024 + jj0);
            const size_t off = QKV_MIX(1) + (isq ? ((size_t)(b * 4 + h) * SEQ + s) * 64 : QKV_K + ((size_t)(b * 2 + h) * SEQ + s) * 64);
            *(uint4*)(qkv + off + 8 * c) = f8_rope_pack(v, pv, cs, sn, (c & 2) ? 1.f : -1.f, isq ? scA : 1.f);
        } else if (qc >= 24 && qc < 30) {
            const float ss = sum8(f8_ssq(v));
            const size_t off = qc < 28 ? (size_t)m * 256 + (qc - 24) * 64 : (size_t)T_TOK * 256 + (size_t)m * 128 + (qc - 28) * 64;
            *(uint4*)(lat + off + 8 * c) = pack8(v.a, v.b);
            if (c == 0) ssqd[(size_t)(qc - 24) * T_TOK + m] = ss;
        } else if (qc == 30) {
            const F8 pv = f8_shfl_xor(v, 2);
            if (c < 4) {
                const int i0 = 8 * (c & 1);
                const F8 cs = f8_load(tb + 262144 + s * 16 + i0), sn = f8_load(tb + 327680 + s * 16 + i0);
                const uint4 w = f8_rope_pack(v, pv, cs, sn, (c & 2) ? 1.f : -1.f, 1.f);
#pragma unroll
                for (int h = 0; h < 4; ++h) *(uint4*)(kD + ((size_t)(b * 4 + h) * SEQ + s) * 96 + 64 + 8 * c) = w;
            }
        }
    }
};
template <int NS, int DIM>
struct RowsStoreBf16Scale {
    bf16_t* C; int ldc; int N; const float* ssq;
    __device__ __forceinline__ void table(float*, int, int) const {}
    __device__ __forceinline__ void begin(float* ct, int m0, int, int tid) const {
        if (tid < 128) {
            float tot = 0.f;
#pragma unroll
            for (int j = 0; j < NS; ++j) tot += ssq[(size_t)j * T_TOK + m0 + tid];
            ct[tid * CT_STRIDE + 256] = rsqrtf(tot * (1.f / DIM) + 1e-6f);
        }
        __syncthreads();
    }
    __device__ __forceinline__ void chunk(const float* t, const float* rb, int m, int n, int c) const {
        const float r = rb[256];
        const float4 a = *(const float4*)t, b = *(const float4*)(t + 4);
        if (n + 8 * c < N) *(uint4*)(C + (size_t)m * ldc + n + 8 * c) = make_uint4(cvtpk(a.x * r, a.y * r), cvtpk(a.z * r, a.w * r), cvtpk(b.x * r, b.y * r), cvtpk(b.z * r, b.w * r));
    }
};

struct RowsPostQ {
    bf16_t* qD; const float* tb; const float* ssq;
    __device__ __forceinline__ void table(float*, int, int) const {}
    __device__ __forceinline__ void begin(float* ct, int m0, int, int tid) const {
        if (tid < 128) {
            const float tot = (ssq[m0 + tid] + ssq[(size_t)T_TOK + m0 + tid]) + (ssq[(size_t)2 * T_TOK + m0 + tid] + ssq[(size_t)3 * T_TOK + m0 + tid]);
            ct[tid * CT_STRIDE + 256] = rsqrtf(tot * (1.f / 256.f) + 1e-6f) * (0.10206207261596575f * LOG2E);
        }
        __syncthreads();
    }
    __device__ __forceinline__ void chunk(const float* t, const float* rb, int m, int n, int c) const {
        if (n >= 384) return;
        const float r = rb[256];
        const int qc = n >> 6, b = m / SEQ, s = m % SEQ;
        F8 v = f8_load(t);
        v.a.x *= r; v.a.y *= r; v.a.z *= r; v.a.w *= r; v.b.x *= r; v.b.y *= r; v.b.z *= r; v.b.w *= r;
        if (qc < 4) {
            *(uint4*)(qD + ((size_t)(b * 4 + qc) * SEQ + s) * 128 + 8 * c) = pack8(v.a, v.b);
        } else {
            const F8 pv = f8_shfl_xor(v, 2);
            const int h = (qc - 4) * 2 + (c >> 2), i0 = 8 * (c & 1);
            const F8 cs = f8_load(tb + 262144 + s * 16 + i0), sn = f8_load(tb + 327680 + s * 16 + i0);
            *(uint4*)(qD + ((size_t)(b * 4 + h) * SEQ + s) * 128 + 64 + 8 * (c & 3)) = f8_rope_pack(v, pv, cs, sn, (c & 2) ? 1.f : -1.f, 1.f);
        }
    }
};
struct RowsPostKV {
    bf16_t* kD; bf16_t* vD; const float* ssq;
    __device__ __forceinline__ void table(float*, int, int) const {}
    __device__ __forceinline__ void begin(float* ct, int m0, int, int tid) const {
        if (tid < 128) ct[tid * CT_STRIDE + 256] = rsqrtf((ssq[m0 + tid] + ssq[(size_t)T_TOK + m0 + tid]) * (1.f / 128.f) + 1e-6f);
        __syncthreads();
    }
    __device__ __forceinline__ void chunk(const float* t, const float* rb, int m, int n, int c) const {
        const float r = rb[256];
        const int qc = n >> 6, h = qc >> 1, b = m / SEQ, s = m % SEQ;
        F8 v = f8_load(t);
        v.a.x *= r; v.a.y *= r; v.a.z *= r; v.a.w *= r; v.b.x *= r; v.b.y *= r; v.b.z *= r; v.b.w *= r;
        const size_t hb = (size_t)(b * 4 + h) * SEQ + s;
        const size_t off = (qc & 1) ? hb * 64 : hb * 96;
        bf16_t* base = (bf16_t*)((qc & 1) ? (size_t)vD : (size_t)kD);
        *(uint4*)(base + off + 8 * c) = pack8(v.a, v.b);
    }
};

template <class Epi>
__device__ __forceinline__ void gemm_phase(const bf16_t* X, int ldx, const bf16_t* W, int ldw, int M, int N, int K, char* lds, const Epi& epi) {
    const int ntm = M >> 7, ntn = (N + 127) >> 7, nt_tot = ntm * ntn;
    for (int tile = blockIdx.x; tile < nt_tot; tile += gridDim.x) {
        int mt, nt;
        if ((gridDim.x & 7) == 0 && (gridDim.x >> 3) * 8 == gridDim.x && ((gridDim.x >> 3) & 63) == 0) tile_map(tile, ntm, ntn, mt, nt);
        else { mt = tile / ntn; nt = tile % ntn; }
        if (mt < ntm && nt < ntn) gemm_tile(X, ldx, W, ldw, K, mt * 128, nt * 128, N, lds, epi);
    }
}

template <int OFF> __device__ __forceinline__ s16x4 tr_read(int vb) {
    s16x4 r; asm volatile("ds_read_b64_tr_b16 %0, %1 offset:%2" : "=&v"(r) : "v"(vb), "i"(OFF) : "memory"); return r;
}
#define VS_BYTES 192

template <int KT2>
__device__ __forceinline__ void pv_sub(f32x16 (&o)[2], const f32x16& p, int vbase) {
    bf16x8 pf[2];
#pragma unroll
    for (int s2 = 0; s2 < 2; ++s2) {
        unsigned a = cvtpk(p[8 * s2 + 0], p[8 * s2 + 1]), b = cvtpk(p[8 * s2 + 2], p[8 * s2 + 3]);
        unsigned c = cvtpk(p[8 * s2 + 4], p[8 * s2 + 5]), d = cvtpk(p[8 * s2 + 6], p[8 * s2 + 7]);
        uint4 w = make_uint4(a, b, c, d);
        pf[s2] = *(bf16x8*)&w;
    }
    {
        s16x4 l00 = tr_read<(KT2 * 32 + 0) * VS_BYTES + 0>(vbase), h00 = tr_read<(KT2 * 32 + 8) * VS_BYTES + 0>(vbase);
        s16x4 l01 = tr_read<(KT2 * 32 + 0) * VS_BYTES + 64>(vbase), h01 = tr_read<(KT2 * 32 + 8) * VS_BYTES + 64>(vbase);
        s16x4 l10 = tr_read<(KT2 * 32 + 16) * VS_BYTES + 0>(vbase), h10 = tr_read<(KT2 * 32 + 24) * VS_BYTES + 0>(vbase);
        s16x4 l11 = tr_read<(KT2 * 32 + 16) * VS_BYTES + 64>(vbase), h11 = tr_read<(KT2 * 32 + 24) * VS_BYTES + 64>(vbase);
        asm volatile("s_waitcnt lgkmcnt(0)" ::: "memory");
        __builtin_amdgcn_sched_barrier(0);
#define PKV(L, H) (bf16x8){L[0], L[1], L[2], L[3], H[0], H[1], H[2], H[3]}
        o[0] = __builtin_amdgcn_mfma_f32_32x32x16_bf16(PKV(l00, h00), pf[0], o[0], 0, 0, 0);
        o[1] = __builtin_amdgcn_mfma_f32_32x32x16_bf16(PKV(l01, h01), pf[0], o[1], 0, 0, 0);
        o[0] = __builtin_amdgcn_mfma_f32_32x32x16_bf16(PKV(l10, h10), pf[1], o[0], 0, 0, 0);
        o[1] = __builtin_amdgcn_mfma_f32_32x32x16_bf16(PKV(l11, h11), pf[1], o[1], 0, 0, 0);
#undef PKV
    }
}


#define PV_LOAD(KT2, VB, F) \
    const s16x4 F##0 = tr_read<((KT2) * 32 + 0) * VS_BYTES + 0>(VB), F##1 = tr_read<((KT2) * 32 + 8) * VS_BYTES + 0>(VB), \
                F##2 = tr_read<((KT2) * 32 + 0) * VS_BYTES + 64>(VB), F##3 = tr_read<((KT2) * 32 + 8) * VS_BYTES + 64>(VB), \
                F##4 = tr_read<((KT2) * 32 + 16) * VS_BYTES + 0>(VB), F##5 = tr_read<((KT2) * 32 + 24) * VS_BYTES + 0>(VB), \
                F##6 = tr_read<((KT2) * 32 + 16) * VS_BYTES + 64>(VB), F##7 = tr_read<((KT2) * 32 + 24) * VS_BYTES + 64>(VB)
#define PKV2(L, H) (bf16x8){L[0], L[1], L[2], L[3], H[0], H[1], H[2], H[3]}
#define PV_MMA(O, P, F) do { bf16x8 _pf0, _pf1; \
        { uint4 _w = make_uint4(cvtpk(P[0], P[1]), cvtpk(P[2], P[3]), cvtpk(P[4], P[5]), cvtpk(P[6], P[7])); _pf0 = *(bf16x8*)&_w; } \
        { uint4 _w = make_uint4(cvtpk(P[8], P[9]), cvtpk(P[10], P[11]), cvtpk(P[12], P[13]), cvtpk(P[14], P[15])); _pf1 = *(bf16x8*)&_w; } \
        O[0] = __builtin_amdgcn_mfma_f32_32x32x16_bf16(PKV2(F##0, F##1), _pf0, O[0], 0, 0, 0); \
        O[1] = __builtin_amdgcn_mfma_f32_32x32x16_bf16(PKV2(F##2, F##3), _pf0, O[1], 0, 0, 0); \
        O[0] = __builtin_amdgcn_mfma_f32_32x32x16_bf16(PKV2(F##4, F##5), _pf1, O[0], 0, 0, 0); \
        O[1] = __builtin_amdgcn_mfma_f32_32x32x16_bf16(PKV2(F##6, F##7), _pf1, O[1], 0, 0, 0); } while (0)

template <int DK, int G, bool WINDOW>
__device__ __forceinline__ void attn_item(const bf16_t* __restrict__ Q, const bf16_t* __restrict__ K, const bf16_t* __restrict__ V, const float* __restrict__ sink,
                                          bf16_t* __restrict__ O, int ocol, int H, int KV, int item, char* lds, int qs = DK) {
    constexpr int KS = DK * 2 + 16;
    constexpr int KCH = DK / 8;
    constexpr int KLD = (64 * KCH + 511) / 512;
    constexpr int QB = 256 / G;
    constexpr int NCH = SEQ / QB;
    constexpr int KBUF = 64 * KS, VBUF = 64 * VS_BYTES;
    const int tid = tid_opaque(), lane = tid & 63, wave = tid >> 6;
    const int r32 = lane & 31, hh = lane >> 5;
    const int chunk = item % NCH, kvh = (item / NCH) % KV, b = item / (NCH * KV);
    const int g = (G == 2) ? (wave >> 2) : 0;
    const int qoff = (G == 2) ? (wave & 3) * 32 : wave * 32;
    const int head = kvh * G + g;
    const int q0 = chunk * QB;
    const int qpos = q0 + qoff + r32;
    bf16x8 qf[DK / 16];
    {
        const bf16_t* qp = Q + ((size_t)(b * H + head) * SEQ + qpos) * qs + hh * 8;
#pragma unroll
        for (int ks = 0; ks < DK / 16; ++ks) qf[ks] = *(const bf16x8*)(qp + ks * 16);
    }
    int kt_lo = 0, kt_hi = SEQ / 64;
    if (WINDOW) { kt_lo = q0 / 64 - 2; if (kt_lo < 0) kt_lo = 0; kt_hi = (q0 + QB) / 64 + 2; if (kt_hi > SEQ / 64) kt_hi = SEQ / 64; }
    const char* Kg = (const char*)(K + (size_t)(b * KV + kvh) * SEQ * DK);
    const char* Vg = (const char*)(V + (size_t)(b * KV + kvh) * SEQ * 64);
    uint4 kr0, kr1 = make_uint4(0, 0, 0, 0), vr0;
    const bool k2 = (KLD > 1) && (tid + 512 < 64 * KCH);
    const int koff0 = (tid / KCH) * KS + (tid % KCH) * 16;
    const int koff1 = ((tid + 512) / KCH) * KS + ((tid + 512) % KCH) * 16;
    const int voff0 = (tid >> 3) * VS_BYTES + (tid & 7) * 16;
    f32x16 o[2];
#pragma unroll
    for (int d = 0; d < 2; ++d)
#pragma unroll
        for (int i = 0; i < 16; ++i) o[d][i] = 0.f;
    float m = -1e30f, l = 0.f;
    if (WINDOW) { m = sink[head] * LOG2E; l = (hh == 0) ? 1.f : 0.f; }
    const int gg = lane >> 4, li = lane & 15;
    const int vlane = (4 * (gg >> 1) + (li >> 2)) * VS_BYTES + (16 * (gg & 1) + 4 * (li & 3)) * 2;
    char* Kl = lds; char* Vl = lds + 2 * KBUF;
#define AGLOAD(KT) do { const char* _kg = Kg + (size_t)(KT) * 64 * DK * 2; const char* _vg = Vg + (size_t)(KT) * 64 * 128; \
        kr0 = *(const uint4*)(_kg + tid * 16); if (k2) kr1 = *(const uint4*)(_kg + (tid + 512) * 16); \
        vr0 = *(const uint4*)(_vg + tid * 16); } while (0)
#define ASTORE(KB, VB) do { char* _kd = (KB); char* _vd = (VB); *(uint4*)(_kd + koff0) = kr0; if (k2) *(uint4*)(_kd + koff1) = kr1; \
        *(uint4*)(_vd + voff0) = vr0; } while (0)
    AGLOAD(kt_lo);
    ASTORE(Kl, Vl);
    { const int k1 = kt_lo + 1 < kt_hi ? kt_lo + 1 : kt_lo; AGLOAD(k1); }
    __syncthreads();
    for (int kt = kt_lo; kt < kt_hi; ++kt) {
        const int cur = (kt - kt_lo) & 1;
        ASTORE(Kl + (cur ^ 1) * KBUF, Vl + (cur ^ 1) * VBUF);
        { const int ktn = kt + 2 < kt_hi ? kt + 2 : kt_hi - 1; AGLOAD(ktn); }
        __builtin_amdgcn_sched_barrier(0);
        const char* kb = Kl + cur * KBUF;
        f32x16 s0, s1;
#pragma unroll
        for (int i = 0; i < 16; ++i) { s0[i] = 0.f; s1[i] = 0.f; }
#pragma unroll
        for (int ks = 0; ks < DK / 16; ++ks) {
            bf16x8 k0 = *(const bf16x8*)(kb + r32 * KS + (ks * 2 + hh) * 16);
            bf16x8 k1 = *(const bf16x8*)(kb + (32 + r32) * KS + (ks * 2 + hh) * 16);
            s0 = __builtin_amdgcn_mfma_f32_32x32x16_bf16(k0, qf[ks], s0, 0, 0, 0);
            s1 = __builtin_amdgcn_mfma_f32_32x32x16_bf16(k1, qf[ks], s1, 0, 0, 0);
        }
        if (WINDOW) {
            const int kb0 = kt * 64 + 4 * hh - qpos;
#pragma unroll
            for (int i = 0; i < 16; ++i) {
                const int d0 = kb0 + (i & 3) + 8 * (i >> 2), d1 = d0 + 32;
                s0[i] = (d0 > 128 || d0 < -128) ? -1e30f : s0[i];
                s1[i] = (d1 > 128 || d1 < -128) ? -1e30f : s1[i];
            }
        }
        const int vbase = (int)(size_t)(Vl + cur * VBUF - lds) + vlane;
        PV_LOAD(0, vbase, vfa);
        PV_LOAD(1, vbase, vfb);
        __builtin_amdgcn_sched_barrier(0);
        float tmax = s0[0];
#pragma unroll
        for (int i = 1; i < 16; ++i) tmax = fmaxf(tmax, s0[i]);
#pragma unroll
        for (int i = 0; i < 16; ++i) tmax = fmaxf(tmax, s1[i]);
        tmax = xhalf_max(tmax);
        const float mn = fmaxf(m, tmax);
        const float alpha = __builtin_amdgcn_exp2f(m - mn);
        m = mn;
        float ps = 0.f;
#pragma unroll
        for (int i = 0; i < 16; ++i) { s0[i] = __builtin_amdgcn_exp2f(s0[i] - mn); ps += s0[i]; }
#pragma unroll
        for (int i = 0; i < 16; ++i) { s1[i] = __builtin_amdgcn_exp2f(s1[i] - mn); ps += s1[i]; }
        l = l * alpha + ps;
        if (__any(alpha != 1.f)) {
#pragma unroll
            for (int d = 0; d < 2; ++d)
#pragma unroll
                for (int i = 0; i < 16; ++i) o[d][i] *= alpha;
        }
        asm volatile("s_waitcnt lgkmcnt(0)" ::: "memory");
        __builtin_amdgcn_sched_barrier(0);
        PV_MMA(o, s0, vfa);
        PV_MMA(o, s1, vfb);
        __syncthreads();
    }
#undef AGLOAD
#undef ASTORE
    l = xhalf_sum(l);
    const float inv = 1.f / l;
    bf16_t* orow = O + (size_t)(b * SEQ + qpos) * DM + ocol + head * 64;
#pragma unroll
    for (int d = 0; d < 2; ++d)
#pragma unroll
        for (int gq = 0; gq < 4; ++gq) {
            uint2 w;
            w.x = cvtpk(o[d][gq * 4 + 0] * inv, o[d][gq * 4 + 1] * inv);
            w.y = cvtpk(o[d][gq * 4 + 2] * inv, o[d][gq * 4 + 3] * inv);
            *(uint2*)(orow + d * 32 + 8 * gq + 4 * hh) = w;
        }
}

__device__ __forceinline__ void dil_wave_item(const bf16_t* __restrict__ Q, const bf16_t* __restrict__ K, const bf16_t* __restrict__ V,
                                              bf16_t* __restrict__ O, int witem, char* wlds, int lds_off) {
    const int lane = tid_opaque() & 63, r32 = lane & 31, hh = lane >> 5;
    const int c = witem & 15, chunk = (witem >> 4) & 15, kvh = (witem >> 8) & 1, b = witem >> 9;
    const int t0 = chunk * 256;
    const int mq = r32 & 15, g = r32 >> 4;
    const int qpos = t0 + 16 * mq + c, head = kvh * 2 + g;
    bf16x8 qf[4];
    {
        const bf16_t* qp = Q + ((size_t)(b * 4 + head) * SEQ + qpos) * 64 + hh * 8;
#pragma unroll
        for (int ks = 0; ks < 4; ++ks) qf[ks] = *(const bf16x8*)(qp + ks * 16);
    }
    const bf16_t* Kg = K + (size_t)(b * 2 + kvh) * SEQ * 64;
    const bf16_t* Vg = V + (size_t)(b * 2 + kvh) * SEQ * 64;
    f32x16 o[2];
#pragma unroll
    for (int d = 0; d < 2; ++d)
#pragma unroll
        for (int i = 0; i < 16; ++i) o[d][i] = 0.f;
    float m = -1e30f, l = 0.f;
    const int gg = lane >> 4, li = lane & 15;
    const int vlane = lds_off + (4 * (gg >> 1) + (li >> 2)) * VS_BYTES + (16 * (gg & 1) + 4 * (li & 3)) * 2;
    for (int it = 0; it < 23; ++it) {
        int sh, j;
        if (it < 12) { sh = 0; j = it; } else if (it < 18) { sh = 2; j = it - 12; } else { sh = 4; j = it - 18; }
        const int rr = 1 << sh;
        const int cc = c & (rr - 1);
        const int idx0 = (t0 >> sh) - 64 + 32 * j;
        const int lim = SEQ >> sh;
        if (idx0 + 31 < 0 || idx0 >= lim) continue;
        bf16x8 kf[4];
        {
            int idx = idx0 + r32; idx = idx < 0 ? 0 : (idx >= lim ? lim - 1 : idx);
            const bf16_t* kp = Kg + (size_t)((idx << sh) + cc) * 64 + hh * 8;
#pragma unroll
            for (int ks = 0; ks < 4; ++ks) kf[ks] = *(const bf16x8*)(kp + ks * 16);
        }
        uint4 vr[4];
#pragma unroll
        for (int jj = 0; jj < 4; ++jj) {
            const int id = lane + 64 * jj; int idx = idx0 + (id >> 3); idx = idx < 0 ? 0 : (idx >= lim ? lim - 1 : idx);
            vr[jj] = *(const uint4*)(Vg + (size_t)((idx << sh) + cc) * 64 + (id & 7) * 8);
        }
#pragma unroll
        for (int jj = 0; jj < 4; ++jj) { const int id = lane + 64 * jj; *(uint4*)(wlds + (id >> 3) * VS_BYTES + (id & 7) * 16) = vr[jj]; }
        f32x16 s;
#pragma unroll
        for (int i = 0; i < 16; ++i) s[i] = 0.f;
#pragma unroll
        for (int ks = 0; ks < 4; ++ks) s = __builtin_amdgcn_mfma_f32_32x32x16_bf16(kf[ks], qf[ks], s, 0, 0, 0);
        const int qidx = qpos >> sh;
        const int base = idx0 + 4 * hh;
#pragma unroll
        for (int i = 0; i < 16; ++i) {
            const int idx = base + (i & 3) + 8 * (i >> 2);
            const int d = idx - qidx;
            s[i] = (d > 64 || d < -64 || idx < 0 || idx >= lim) ? -1e30f : s[i];
        }
        float tmax = s[0];
#pragma unroll
        for (int i = 1; i < 16; ++i) tmax = fmaxf(tmax, s[i]);
        tmax = fmaxf(tmax, xhalf(tmax));
        const float mn = fmaxf(fmaxf(m, tmax), -1e20f);
        const float alpha = __builtin_amdgcn_exp2f(m - mn);
        m = mn;
        float ps = 0.f;
#pragma unroll
        for (int i = 0; i < 16; ++i) { s[i] = __builtin_amdgcn_exp2f(s[i] - mn); ps += s[i]; }
        l = l * alpha + ps;
#pragma unroll
        for (int d = 0; d < 2; ++d)
#pragma unroll
            for (int i = 0; i < 16; ++i) o[d][i] *= alpha;
        pv_sub<0>(o, s, vlane);
    }
    l += xhalf(l);
    const float inv = 1.f / l;
    bf16_t* orow = O + (size_t)(b * SEQ + qpos) * DM + 512 + head * 64;
#pragma unroll
    for (int d = 0; d < 2; ++d)
#pragma unroll
        for (int gq = 0; gq < 4; ++gq) {
            uint2 w;
            w.x = cvtpk(o[d][gq * 4 + 0] * inv, o[d][gq * 4 + 1] * inv);
            w.y = cvtpk(o[d][gq * 4 + 2] * inv, o[d][gq * 4 + 3] * inv);
            *(uint2*)(orow + d * 32 + 8 * gq + 4 * hh) = w;
        }
}

__device__ __forceinline__ int f2key(float f) { int b = __float_as_int(f); return b ^ ((b >> 31) & 0x7fffffff); }
__device__ __forceinline__ float key2f(int k) { return __int_as_float(k ^ ((k >> 31) & 0x7fffffff)); }

template <int N>
__device__ __forceinline__ void bitonic_sort_desc(int (&a)[N]) {
#pragma unroll
    for (int k = 2; k <= N; k <<= 1) {
#pragma unroll
        for (int j = k >> 1; j > 0; j >>= 1) {
#pragma unroll
            for (int i = 0; i < N; ++i) {
                const int l2 = i ^ j;
                if (l2 > i) {
                    const bool up = ((i & k) == 0);
                    const int hi = max(a[i], a[l2]), lo = min(a[i], a[l2]);
                    a[i] = up ? hi : lo; a[l2] = up ? lo : hi;
                }
            }
        }
    }
}
__device__ __forceinline__ void merge_top16(int (&a)[16], const int (&b)[16]) {
#pragma unroll
    for (int i = 0; i < 16; ++i) a[i] = max(a[i], b[15 - i]);
#pragma unroll
    for (int j = 8; j > 0; j >>= 1) {
#pragma unroll
        for (int i = 0; i < 16; ++i) {
            const int l2 = i ^ j;
            if (l2 > i) { const int hi = max(a[i], a[l2]), lo = min(a[i], a[l2]); a[i] = hi; a[l2] = lo; }
        }
    }
}
__device__ __forceinline__ void top16_of_64(int (&g0)[16], int (&g1)[16], int (&g2)[16], int (&g3)[16]) {
    bitonic_sort_desc<16>(g0); bitonic_sort_desc<16>(g1); bitonic_sort_desc<16>(g2); bitonic_sort_desc<16>(g3);
    merge_top16(g0, g1); merge_top16(g2, g3); merge_top16(g0, g2);
}

__device__ __forceinline__ void topk_wave_item(const bf16_t* __restrict__ qp, const bf16_t* __restrict__ subk  ,
                                               int* __restrict__ eidx, float* __restrict__ gate, int witem, char* wlds) {
    const int lane = tid_opaque() & 63, r32 = lane & 31, hh = lane >> 5;
    const int h = witem & 7, tt = witem >> 3;
    const int t = tt * 32 + r32;
    int top[2][16];
#pragma unroll
    for (int c = 0; c < 2; ++c) {
        bf16x8 qf[8];
        const bf16_t* qrow = qp + (size_t)t * 2048 + h * 256 + c * 128 + hh * 8;
#pragma unroll
        for (int ks = 0; ks < 8; ++ks) qf[ks] = *(const bf16x8*)(qrow + ks * 16);
        const bf16_t* kb = subk + ((size_t)(h * 2 + c) * 128 + r32) * 128 + hh * 8;
        int grp[4][16];
#pragma unroll
        for (int kt = 0; kt < 4; ++kt) {
            f32x16 s;
#pragma unroll
            for (int i = 0; i < 16; ++i) s[i] = 0.f;
#pragma unroll
            for (int ks = 0; ks < 8; ++ks) {
                bf16x8 kf = *(const bf16x8*)(kb + (size_t)kt * 32 * 128 + ks * 16);
                s = __builtin_amdgcn_mfma_f32_32x32x16_bf16(kf, qf[ks], s, 0, 0, 0);
            }
#pragma unroll
            for (int i = 0; i < 16; ++i) grp[kt][i] = (f2key(s[i]) & ~127) | (kt * 32 + crow(i, hh));
        }
        top16_of_64(grp[0], grp[1], grp[2], grp[3]);
        int oth[16];
#pragma unroll
        for (int i = 0; i < 16; ++i) oth[i] = __shfl_xor(grp[0][i], 32);
        merge_top16(grp[0], oth);
#pragma unroll
        for (int i = 0; i < 16; ++i) top[c][i] = grp[0][i];
    }
    {
        unsigned* my = (unsigned*)(wlds + lane * 36);
#pragma unroll
        for (int c = 0; c < 2; ++c)
#pragma unroll
            for (int w4 = 0; w4 < 4; ++w4) {
                unsigned v = (top[c][w4 * 4] & 127) | ((top[c][w4 * 4 + 1] & 127) << 8) | ((top[c][w4 * 4 + 2] & 127) << 16) | ((top[c][w4 * 4 + 3] & 127) << 24);
                my[c * 4 + w4] = v;
            }
    }
    float v1[16], v2[16];
#pragma unroll
    for (int i = 0; i < 16; ++i) { v1[i] = key2f(top[0][i] & ~127); v2[i] = key2f(top[1][i] & ~127); }
    int cg[4][16];
    {
        int n = 0;
#pragma unroll
        for (int i = 0; i < 16; ++i)
#pragma unroll
            for (int j = 0; j < 16; ++j)
                if ((i + 1) * (j + 1) <= 16) { cg[n >> 4][n & 15] = (f2key(v1[i] + v2[j]) & ~255) | (i * 16 + j); ++n; }
#pragma unroll
        for (int q = 50; q < 64; ++q) cg[q >> 4][q & 15] = (int)0x80000000;
    }
    top16_of_64(cg[0], cg[1], cg[2], cg[3]);
    float bv[16];
#pragma unroll
    for (int i = 0; i < 16; ++i) bv[i] = key2f(cg[0][i] & ~255);
    float sm = 0.f;
    const float bmx = bv[0];
#pragma unroll
    for (int i = 0; i < 16; ++i) { bv[i] = __expf(bv[i] - bmx); sm += bv[i]; }
    const float inv = 1.f / sm;
    if (hh == 0) {
        const unsigned char* my = (const unsigned char*)(wlds + lane * 36);
        int* eo = eidx + (size_t)t * 128 + h * 16;
        float* go = gate + (size_t)t * 128 + h * 16;
#pragma unroll
        for (int q4 = 0; q4 < 4; ++q4) {
            int4 ev; float4 gv;
            int* evp = (int*)&ev; float* gvp = (float*)&gv;
#pragma unroll
            for (int u = 0; u < 4; ++u) {
                const int code = cg[0][q4 * 4 + u] & 255;
                const int i1 = my[code >> 4], i2 = my[16 + (code & 15)];
                evp[u] = i1 * 128 + i2; gvp[u] = bv[q4 * 4 + u] * inv;
            }
            *(int4*)(eo + q4 * 4) = ev; *(float4*)(go + q4 * 4) = gv;
        }
    }
}

typedef __attribute__((ext_vector_type(2))) float f32x2;
__device__ __forceinline__ float fdot2bf(unsigned a, unsigned b, float acc) {
    return __builtin_amdgcn_fdot2_f32_bf16(*(bf16x2_t*)&a, *(bf16x2_t*)&b, acc, false);
}
__device__ __forceinline__ unsigned fp8pair_to_bf16(unsigned w, bool hi) {
    bf16x2_t r = hi ? __builtin_amdgcn_cvt_scalef32_pk_bf16_fp8((int)w, 1.0f, true) : __builtin_amdgcn_cvt_scalef32_pk_bf16_fp8((int)w, 1.0f, false);
    return *(unsigned*)&r;
}
__device__ __forceinline__ float dot16_fp8(uint4 u, const unsigned (&h)[8]) {
    float a = 0.f;
    a = fdot2bf(fp8pair_to_bf16(u.x, false), h[0], a); a = fdot2bf(fp8pair_to_bf16(u.x, true), h[1], a);
    a = fdot2bf(fp8pair_to_bf16(u.y, false), h[2], a); a = fdot2bf(fp8pair_to_bf16(u.y, true), h[3], a);
    a = fdot2bf(fp8pair_to_bf16(u.z, false), h[4], a); a = fdot2bf(fp8pair_to_bf16(u.z, true), h[5], a);
    a = fdot2bf(fp8pair_to_bf16(u.w, false), h[6], a); a = fdot2bf(fp8pair_to_bf16(u.w, true), h[7], a);
    return a;
}
__device__ __forceinline__ void axpy16_fp8(float (&acc)[16], float w, uint4 v) {
    f32x2 r;
    r = __builtin_amdgcn_cvt_pk_f32_fp8((int)v.x, false); acc[0] += w * r[0]; acc[1] += w * r[1];
    r = __builtin_amdgcn_cvt_pk_f32_fp8((int)v.x, true);  acc[2] += w * r[0]; acc[3] += w * r[1];
    r = __builtin_amdgcn_cvt_pk_f32_fp8((int)v.y, false); acc[4] += w * r[0]; acc[5] += w * r[1];
    r = __builtin_amdgcn_cvt_pk_f32_fp8((int)v.y, true);  acc[6] += w * r[0]; acc[7] += w * r[1];
    r = __builtin_amdgcn_cvt_pk_f32_fp8((int)v.z, false); acc[8] += w * r[0]; acc[9] += w * r[1];
    r = __builtin_amdgcn_cvt_pk_f32_fp8((int)v.z, true);  acc[10] += w * r[0]; acc[11] += w * r[1];
    r = __builtin_amdgcn_cvt_pk_f32_fp8((int)v.w, false); acc[12] += w * r[0]; acc[13] += w * r[1];
    r = __builtin_amdgcn_cvt_pk_f32_fp8((int)v.w, true);  acc[14] += w * r[0]; acc[15] += w * r[1];
}
__device__ __forceinline__ float gelu_exact(float a) { return 0.5f * a * (1.f + erff(a * 0.70710678118654752f)); }

__device__ __forceinline__ float transpose_reduce16(f32x16 p, int lane) {
#pragma unroll
    for (int st = 0; st < 4; ++st) {
        const int o = 32 >> st, n = 16 >> st;
        const bool up = (lane & o) != 0;
#pragma unroll
        for (int i = 0; i < n / 2; ++i) {
            float lo = p[i], hi = p[i + n / 2];
            asm volatile("" : "+v"(lo), "+v"(hi));
            const float keep = up ? hi : lo;
            const float send = up ? lo : hi;
            p[i] = keep + __shfl_xor(send, o);
        }
    }
    float v = p[0];
    v += __shfl_xor(v, 1); v += __shfl_xor(v, 2);
    return v;
}
#define EX_SB() __builtin_amdgcn_sched_barrier(0)
#define EX_LD1(R, TAB, EB, S) R = *(const uint4*)((TAB) + (unsigned)((__builtin_amdgcn_readlane((EB), (S)) << 10) + lane16))
#define EX_LOAD8(P, TAB, EB, SL) do { EX_LD1(P##0, TAB, EB, (SL) + 0); EX_LD1(P##1, TAB, EB, (SL) + 1); EX_LD1(P##2, TAB, EB, (SL) + 2); EX_LD1(P##3, TAB, EB, (SL) + 3); \
        EX_LD1(P##4, TAB, EB, (SL) + 4); EX_LD1(P##5, TAB, EB, (SL) + 5); EX_LD1(P##6, TAB, EB, (SL) + 6); EX_LD1(P##7, TAB, EB, (SL) + 7); } while (0)
#define EX_DOT8(P, PP, O) do { PP[(O) + 0] = dot16_fp8(P##0, hp); PP[(O) + 1] = dot16_fp8(P##1, hp); PP[(O) + 2] = dot16_fp8(P##2, hp); PP[(O) + 3] = dot16_fp8(P##3, hp); \
        PP[(O) + 4] = dot16_fp8(P##4, hp); PP[(O) + 5] = dot16_fp8(P##5, hp); PP[(O) + 6] = dot16_fp8(P##6, hp); PP[(O) + 7] = dot16_fp8(P##7, hp); } while (0)
#define EX_RL(W, S) __int_as_float(__builtin_amdgcn_readlane(__float_as_int(W), (S)))
#define EX_AXPY8(P, W, SL) do { axpy16_fp8(acc, EX_RL(W, (SL) + 0), P##0); axpy16_fp8(acc, EX_RL(W, (SL) + 1), P##1); axpy16_fp8(acc, EX_RL(W, (SL) + 2), P##2); axpy16_fp8(acc, EX_RL(W, (SL) + 3), P##3); \
        axpy16_fp8(acc, EX_RL(W, (SL) + 4), P##4); axpy16_fp8(acc, EX_RL(W, (SL) + 5), P##5); axpy16_fp8(acc, EX_RL(W, (SL) + 6), P##6); axpy16_fp8(acc, EX_RL(W, (SL) + 7), P##7); } while (0)
#define EX_COPY8(D, S_) do { D##0 = S_##0; D##1 = S_##1; D##2 = S_##2; D##3 = S_##3; D##4 = S_##4; D##5 = S_##5; D##6 = S_##6; D##7 = S_##7; } while (0)

__device__ __forceinline__ void expert_token(PC& p, int layer, int t, bool last, bool dummy = false) {
    const int lane = tid_opaque() & 63;
    const int lane16 = lane * 16;
    const float* gfb = p.g_ffn + layer * DM; asm volatile("" : "+s"(gfb));
    const float* gf = gfb + lane * 16;
    float* xrow = p.x + (size_t)t * DM + lane * 16;
    float* xwr = dummy ? (float*)p.zb + (size_t)t * DM + lane * 16 : xrow;
    bf16_t* hwr = (dummy ? p.q.qA + (size_t)t * DM : p.hnb + (size_t)t * DM) + lane * 16;
    float xv[16];
#pragma unroll
    for (int q = 0; q < 4; ++q) { const float4 a = *(const float4*)(xrow + 4 * q); xv[4 * q] = a.x; xv[4 * q + 1] = a.y; xv[4 * q + 2] = a.z; xv[4 * q + 3] = a.w; }
    float ss = 0.f;
#pragma unroll
    for (int i = 0; i < 16; ++i) ss += xv[i] * xv[i];
    ss = wave_sum(ss);
    const float rstd = rsqrtf(ss * (1.f / DM) + 1e-6f);
    unsigned hp[8];
#pragma unroll
    for (int q = 0; q < 4; ++q) {
        const float4 g = *(const float4*)(gf + 4 * q);
        hp[2 * q] = cvtpk(xv[4 * q] * rstd * g.x, xv[4 * q + 1] * rstd * g.y);
        hp[2 * q + 1] = cvtpk(xv[4 * q + 2] * rstd * g.z, xv[4 * q + 3] * rstd * g.w);
    }
    const int e0 = p.eidx[(size_t)t * 128 + lane], e1 = p.eidx[(size_t)t * 128 + 64 + lane];
    const float g0 = p.gate[(size_t)t * 128 + lane], g1 = p.gate[(size_t)t * 128 + 64 + lane];
    const unsigned char* u8 = p.u8 + (size_t)layer * 16384 * DM;
    const unsigned char* v8 = p.v8 + (size_t)layer * 16384 * DM;
    const float* su = p.su + layer * 16384; const float* sv = p.sv + layer * 16384;
    const float su0 = su[e0], su1 = su[e1], sv0 = sv[e0], sv1 = sv[e1];
    uint4 rx0, rx1, rx2, rx3, rx4, rx5, rx6, rx7, ry0, ry1, ry2, ry3, ry4, ry5, ry6, ry7;
    float a0 = 0.f, a1 = 0.f;
    EX_LOAD8(rx, u8, e0, 0);
#pragma unroll 1
    for (int g = 0; g < 8; ++g) {
        const int eb = g < 4 ? e0 : e1;
        const int sl = (g & 3) * 16;
        f32x16 pp;
        EX_LOAD8(ry, u8, eb, sl + 8);
        EX_SB();
        EX_DOT8(rx, pp, 0);
        EX_SB();
        {
            const int gn = g + 1 < 8 ? g + 1 : 0;
            const int ebn = gn < 4 ? e0 : e1;
            const unsigned char* tabn = g + 1 < 8 ? u8 : v8;
            EX_LOAD8(rx, tabn, ebn, (gn & 3) * 16);
        }
        EX_SB();
        EX_DOT8(ry, pp, 8);
        const float v = transpose_reduce16(pp, lane);
        const float got = __shfl(v, (lane & 15) << 2);
        const bool mine = (lane >> 4) == (g & 3);
        a0 = (mine && g < 4) ? got : a0;
        a1 = (mine && g >= 4) ? got : a1;
        EX_SB();
    }
    const float w0 = g0 * gelu_exact(su0 * a0) * sv0;
    const float w1 = g1 * gelu_exact(su1 * a1) * sv1;
    float acc[16];
#pragma unroll
    for (int i = 0; i < 16; ++i) acc[i] = 0.f;
#pragma unroll 1
    for (int h2 = 0; h2 < 8; ++h2) {
        const int ebc = h2 < 4 ? e0 : e1;
        const float wb = h2 < 4 ? w0 : w1;
        const int slc = (h2 & 3) * 16;
        EX_LOAD8(ry, v8, ebc, slc + 8);
        EX_SB();
        EX_AXPY8(rx, wb, slc);
        EX_SB();
        {
            const int hn_ = h2 + 1 < 8 ? h2 + 1 : 7;
            const int ebn = hn_ < 4 ? e0 : e1;
            EX_LOAD8(rx, v8, ebn, (hn_ & 3) * 16);
        }
        EX_SB();
        EX_AXPY8(ry, wb, slc + 8);
        EX_SB();
    }
#pragma unroll
    for (int i = 0; i < 16; ++i) xv[i] += acc[i];
    float s2 = 0.f;
#pragma unroll
    for (int i = 0; i < 16; ++i) s2 += xv[i] * xv[i];
    s2 = wave_sum(s2);
    const float r2 = rsqrtf(s2 * (1.f / DM) + 1e-6f);
    if (!last) {
#pragma unroll
        for (int q = 0; q < 4; ++q) *(float4*)(xwr + 4 * q) = make_float4(xv[4 * q], xv[4 * q + 1], xv[4 * q + 2], xv[4 * q + 3]);
        const float* gnb = p.g_mix + (layer + 1) * DM; asm volatile("" : "+s"(gnb));
        const float* gn = gnb + lane * 16;
        unsigned hw[8];
#pragma unroll
        for (int q = 0; q < 4; ++q) {
            const float4 g = *(const float4*)(gn + 4 * q);
            hw[2 * q] = cvtpk(xv[4 * q] * r2 * g.x, xv[4 * q + 1] * r2 * g.y);
            hw[2 * q + 1] = cvtpk(xv[4 * q + 2] * r2 * g.z, xv[4 * q + 3] * r2 * g.w);
        }
        *(uint4*)(hwr) = make_uint4(hw[0], hw[1], hw[2], hw[3]);
        *(uint4*)(hwr + 8) = make_uint4(hw[4], hw[5], hw[6], hw[7]);
    } else {
        const float* gnb = p.g_final; asm volatile("" : "+s"(gnb));
        const float* gn = gnb + lane * 16;
        float* orow = dummy ? xwr : p.out + (size_t)t * DM + lane * 16;
#pragma unroll
        for (int q = 0; q < 4; ++q) {
            const float4 g = *(const float4*)(gn + 4 * q);
            *(float4*)(orow + 4 * q) = make_float4(xv[4 * q] * r2 * g.x, xv[4 * q + 1] * r2 * g.y, xv[4 * q + 2] * r2 * g.z, xv[4 * q + 3] * r2 * g.w);
        }
    }
}
__device__ __forceinline__ void transpose_tile(const float* __restrict__ src, int K, int N, bf16_t* __restrict__ dst, int tk, int tn, float* tl, const float* __restrict__ ksc, int perm) {
    const int tid = tid_opaque(), r = tid >> 6, c = tid & 63;
    const int k0 = tk * 64, n0 = tn * 64;
#pragma unroll
    for (int i = 0; i < 8; ++i) {
        const int kk = i * 8 + r, n = n0 + c;
        tl[kk * 65 + c] = (n < N) ? src[(size_t)(k0 + kk) * N + n] : 0.f;
    }
    __syncthreads();
#pragma unroll
    for (int i = 0; i < 8; ++i) {
        const int nn = i * 8 + r;
        if (n0 + nn < N) {
            int nd = n0 + nn;
            if (perm) { const int hq = nd / 96, wq = nd % 96; nd = wq < 64 ? hq * 64 + wq : 256 + hq * 32 + (wq - 64); }
            dst[(size_t)nd * K + k0 + c] = f2bf(tl[c * 65 + nn] * (ksc ? ksc[k0 + c] : 1.f));
        }
    }
    __syncthreads();
}
__device__ __forceinline__ void transpose_all(const float* src, int K, int N, bf16_t* dst, float* tl, const float* ksc = nullptr, int perm = 0) {
    const int ntk = K / 64, ntn = (N + 63) / 64;
    for (int t = blockIdx.x; t < ntk * ntn; t += gridDim.x) transpose_tile(src, K, N, dst, t / ntn, t % ntn, tl, ksc, perm);
}
__device__ __forceinline__ void convert_plain(const float* __restrict__ src, bf16_t* __restrict__ dst, size_t n) {
    const size_t n8 = n >> 3;
    for (size_t i = (size_t)blockIdx.x * blockDim.x + tid_opaque(); i < n8; i += (size_t)gridDim.x * blockDim.x) {
        const float4 a = *(const float4*)(src + i * 8), b = *(const float4*)(src + i * 8 + 4);
        uint4 w; w.x = cvtpk(a.x, a.y); w.y = cvtpk(a.z, a.w); w.z = cvtpk(b.x, b.y); w.w = cvtpk(b.z, b.w);
        *(uint4*)(dst + i * 8) = w;
    }
}
__device__ __forceinline__ void convert_rows_fp8(const float* __restrict__ src, unsigned char* __restrict__ dst, float* __restrict__ scales, int nrows) {
    const int tid = tid_opaque(), wave = tid >> 6, lane = tid & 63;
    for (int row = blockIdx.x * NW + wave; row < nrows; row += gridDim.x * NW) {
        const float* sr = src + (size_t)row * DM + lane * 16;
        float xv[16];
#pragma unroll
        for (int q = 0; q < 4; ++q) { const float4 a = *(const float4*)(sr + 4 * q); xv[4 * q] = a.x; xv[4 * q + 1] = a.y; xv[4 * q + 2] = a.z; xv[4 * q + 3] = a.w; }
        float am = 0.f;
#pragma unroll
        for (int i = 0; i < 16; ++i) am = fmaxf(am, fabsf(xv[i]));
        am = wave_max(am);
        const float sc = am > 0.f ? am * (1.f / 448.f) : 1.f;
        const float inv = 1.f / sc;
        unsigned w[4];
#pragma unroll
        for (int q = 0; q < 4; ++q) {
            int t = 0;
            t = __builtin_amdgcn_cvt_pk_fp8_f32(xv[4 * q] * inv, xv[4 * q + 1] * inv, t, false);
            t = __builtin_amdgcn_cvt_pk_fp8_f32(xv[4 * q + 2] * inv, xv[4 * q + 3] * inv, t, true);
            w[q] = (unsigned)t;
        }
        *(uint4*)(dst + (size_t)row * DM + lane * 16) = make_uint4(w[0], w[1], w[2], w[3]);
        if (lane == 0) scales[row] = sc;
    }
}
__device__ __forceinline__ void rms_row_bf16(const float* __restrict__ src, const float* __restrict__ g, bf16_t* __restrict__ dst, float* __restrict__ cpy, int lane) {
    float xv[16];
    const float4 a0 = *(const float4*)(src + lane * 8), a1 = *(const float4*)(src + lane * 8 + 4);
    const float4 b0 = *(const float4*)(src + 512 + lane * 8), b1 = *(const float4*)(src + 512 + lane * 8 + 4);
    xv[0] = a0.x; xv[1] = a0.y; xv[2] = a0.z; xv[3] = a0.w; xv[4] = a1.x; xv[5] = a1.y; xv[6] = a1.z; xv[7] = a1.w;
    xv[8] = b0.x; xv[9] = b0.y; xv[10] = b0.z; xv[11] = b0.w; xv[12] = b1.x; xv[13] = b1.y; xv[14] = b1.z; xv[15] = b1.w;
    if (cpy) {
        *(float4*)(cpy + lane * 8) = a0; *(float4*)(cpy + lane * 8 + 4) = a1;
        *(float4*)(cpy + 512 + lane * 8) = b0; *(float4*)(cpy + 512 + lane * 8 + 4) = b1;
    }
    float ss = 0.f;
#pragma unroll
    for (int i = 0; i < 16; ++i) ss += xv[i] * xv[i];
    ss = wave_sum(ss);
    const float r = rsqrtf(ss * (1.f / DM) + 1e-6f);
    const float4 g0 = *(const float4*)(g + lane * 8), g1 = *(const float4*)(g + lane * 8 + 4);
    const float4 g2 = *(const float4*)(g + 512 + lane * 8), g3 = *(const float4*)(g + 512 + lane * 8 + 4);
    uint4 wa, wb;
    wa.x = cvtpk(xv[0] * r * g0.x, xv[1] * r * g0.y); wa.y = cvtpk(xv[2] * r * g0.z, xv[3] * r * g0.w);
    wa.z = cvtpk(xv[4] * r * g1.x, xv[5] * r * g1.y); wa.w = cvtpk(xv[6] * r * g1.z, xv[7] * r * g1.w);
    wb.x = cvtpk(xv[8] * r * g2.x, xv[9] * r * g2.y); wb.y = cvtpk(xv[10] * r * g2.z, xv[11] * r * g2.w);
    wb.z = cvtpk(xv[12] * r * g3.x, xv[13] * r * g3.y); wb.w = cvtpk(xv[14] * r * g3.z, xv[15] * r * g3.w);
    *(uint4*)(dst + lane * 8) = wa; *(uint4*)(dst + 512 + lane * 8) = wb;
}

__device__ __forceinline__ void rms_row2_bf16(const float* __restrict__ s0, const float* __restrict__ s1, const float* __restrict__ g, bf16_t* __restrict__ d0, bf16_t* __restrict__ d1, int lane) {
    float4 a[4], b[4];
#pragma unroll
    for (int q = 0; q < 4; ++q) { a[q] = *(const float4*)(s0 + (q >> 1) * 512 + lane * 8 + (q & 1) * 4); b[q] = s1 ? *(const float4*)(s1 + (q >> 1) * 512 + lane * 8 + (q & 1) * 4) : make_float4(0.f, 0.f, 0.f, 0.f); }
    float sa = 0.f, sb = 0.f;
#pragma unroll
    for (int q = 0; q < 4; ++q) { sa += a[q].x * a[q].x + a[q].y * a[q].y + a[q].z * a[q].z + a[q].w * a[q].w; sb += b[q].x * b[q].x + b[q].y * b[q].y + b[q].z * b[q].z + b[q].w * b[q].w; }
    sa = wave_sum(sa); sb = wave_sum(sb);
    const float ra = rsqrtf(sa * (1.f / DM) + 1e-6f), rb = rsqrtf(sb * (1.f / DM) + 1e-6f);
    float4 gq[4];
#pragma unroll
    for (int q = 0; q < 4; ++q) gq[q] = *(const float4*)(g + (q >> 1) * 512 + lane * 8 + (q & 1) * 4);
    uint4 w;
    w.x = cvtpk(a[0].x * ra * gq[0].x, a[0].y * ra * gq[0].y); w.y = cvtpk(a[0].z * ra * gq[0].z, a[0].w * ra * gq[0].w);
    w.z = cvtpk(a[1].x * ra * gq[1].x, a[1].y * ra * gq[1].y); w.w = cvtpk(a[1].z * ra * gq[1].z, a[1].w * ra * gq[1].w);
    *(uint4*)(d0 + lane * 8) = w;
    w.x = cvtpk(a[2].x * ra * gq[2].x, a[2].y * ra * gq[2].y); w.y = cvtpk(a[2].z * ra * gq[2].z, a[2].w * ra * gq[2].w);
    w.z = cvtpk(a[3].x * ra * gq[3].x, a[3].y * ra * gq[3].y); w.w = cvtpk(a[3].z * ra * gq[3].z, a[3].w * ra * gq[3].w);
    *(uint4*)(d0 + 512 + lane * 8) = w;
    if (s1) {
        w.x = cvtpk(b[0].x * rb * gq[0].x, b[0].y * rb * gq[0].y); w.y = cvtpk(b[0].z * rb * gq[0].z, b[0].w * rb * gq[0].w);
        w.z = cvtpk(b[1].x * rb * gq[1].x, b[1].y * rb * gq[1].y); w.w = cvtpk(b[1].z * rb * gq[1].z, b[1].w * rb * gq[1].w);
        *(uint4*)(d1 + lane * 8) = w;
        w.x = cvtpk(b[2].x * rb * gq[2].x, b[2].y * rb * gq[2].y); w.y = cvtpk(b[2].z * rb * gq[2].z, b[2].w * rb * gq[2].w);
        w.z = cvtpk(b[3].x * rb * gq[3].x, b[3].y * rb * gq[3].y); w.w = cvtpk(b[3].z * rb * gq[3].z, b[3].w * rb * gq[3].w);
        *(uint4*)(d1 + 512 + lane * 8) = w;
    }
}

__device__ __forceinline__ void phase_pro(PC& p, char* lds) {
    float* tl = (float*)lds;
    for (int l = 0; l < DEPTH; ++l) {
        transpose_all(p.w_in + (size_t)l * DM * NZ, DM, NZ, p.winT + (size_t)l * NZ * DM, tl);
        transpose_all(p.w_out + (size_t)l * DM * DM, DM, DM, p.woutT + (size_t)l * DM * DM, tl, (p.flags & 16) ? p.g_group + (size_t)l * 1024 : nullptr);
        transpose_all(p.peer_w_q + (size_t)l * DM * 2048, DM, 2048, p.wqT + (size_t)l * 2048 * DM, tl, (p.flags & 4) ? p.g_ffn + l * DM : nullptr);
        transpose_all(p.mla_w_uq + (size_t)l * 256 * 384, 256, 384, p.wuqT + (size_t)l * 384 * 256, tl, (p.flags & 8) ? p.mla_q_norm + l * 256 : nullptr, (p.flags & 32) ? 1 : 0);
        transpose_all(p.mla_w_ukv + (size_t)l * 128 * 512, 128, 512, p.wukvT + (size_t)l * 512 * 128, tl, (p.flags & 8) ? p.mla_kv_norm + l * 128 : nullptr);
    }
    convert_plain(p.peer_sub_keys, p.subk, (size_t)DEPTH * 8 * 2 * 128 * 128);
    if ((p.flags & 3) == 1) {
        convert_rows_fp8(p.peer_u, p.u8, p.su, DEPTH * 16384);
        convert_rows_fp8(p.peer_v, p.v8, p.sv, DEPTH * 16384);
    }
    for (int i = blockIdx.x * blockDim.x + tid_opaque(); i < 4096 * 32; i += gridDim.x * blockDim.x) {
        {
            const int pos = i / 32, j = i % 32;
            const float inv = powf(10000.f, -(float)(2 * j) / 64.f); const float ang = (float)pos * inv;
            p.tb.cos1[i] = cosf(ang); p.tb.sin1[i] = sinf(ang);
        }
        if (i < 4096 * 16) {
            const int pos = i / 16, j = i % 16;
            const float inv = powf(10000.f, -(float)(2 * j) / 32.f); const float ang = (float)pos * inv;
            p.tb.cosm[i] = cosf(ang); p.tb.sinm[i] = sinf(ang);
        }
        if (i < 64 * 16) {
            const int pos = i / 16, j = i % 16;
            const float inv = powf(10000.f, -(float)(2 * j) / 32.f); const float ang = (float)pos * inv;
            p.tb.cosr[i] = cosf(ang); p.tb.sinr[i] = sinf(ang); p.tb.cosc[i] = cosf(ang); p.tb.sinc[i] = sinf(ang);
        }
    }
    const int wave = tid_opaque() >> 6, lane = tid_opaque() & 63;
    for (int t = blockIdx.x * NW + wave; t < T_TOK; t += gridDim.x * NW)
        rms_row_bf16(p.x_in + (size_t)t * DM, p.g_mix, p.hnb + (size_t)t * DM, p.x + (size_t)t * DM, lane);
}

__device__ __forceinline__ void phase_g1(PC& p, int l, char* lds) {
    if (p.flags & 8) {
        RowsPostZ e{p.q.qA, p.tb.cos1, p.ax_q_norm + l * 64, p.ax_k_norm + l * 64, p.cqn, p.ssqd, p.q.kD};
        gemm_phase_rows<RowsPostZ, 0>(p.hnb, DM, p.winT + (size_t)l * NZ * DM, DM, T_TOK, NZ, DM, lds, e);
    } else {
        RowsStoreBf16 e{p.zb, NZ, NZ};
        gemm_phase_rows<RowsStoreBf16, 0>(p.hnb, DM, p.winT + (size_t)l * NZ * DM, DM, T_TOK, NZ, DM, lds, e);
    }
}

__device__ __forceinline__ unsigned pk2(float a, float b) { return cvtpk(a, b); }
__device__ __forceinline__ void phase_post(PC& p, int l, char* lds) {
    const int tid = tid_opaque(), wave = tid >> 6, lane = tid & 63;
    float* zr = (float*)(lds + wave * 8192);
    const float* g_qn = p.ax_q_norm + l * 64; const float* g_kn = p.ax_k_norm + l * 64;
    const float* g_cq = p.mla_q_norm + l * 256; const float* g_ckv = p.mla_kv_norm + l * 128;
    const float scA = 0.125f * LOG2E;
    const bf16_t* zb = p.zb;
    const float *cos1 = p.tb.cos1, *sin1 = p.tb.sin1, *cosm = p.tb.cosm, *sinm = p.tb.sinm, *cosr = p.tb.cosr, *sinr = p.tb.sinr, *cosc = p.tb.cosc, *sinc = p.tb.sinc;
    for (int t = blockIdx.x * NW + wave; t < T_TOK; t += gridDim.x * NW) {
        const int b = t / SEQ, s = t % SEQ;
#pragma unroll
        for (int j = 0; j < 4; ++j) {
            const int ch = lane + 64 * j;
            if (ch < 244) {
                const uint4 w = *(const uint4*)(zb + (size_t)t * NZ + ch * 8);
                float4 lo, hi;
                lo.x = __uint_as_float(w.x << 16); lo.y = __uint_as_float(w.x & 0xffff0000u); lo.z = __uint_as_float(w.y << 16); lo.w = __uint_as_float(w.y & 0xffff0000u);
                hi.x = __uint_as_float(w.z << 16); hi.y = __uint_as_float(w.z & 0xffff0000u); hi.z = __uint_as_float(w.w << 16); hi.w = __uint_as_float(w.w & 0xffff0000u);
                *(float4*)(zr + ch * 8) = lo; *(float4*)(zr + ch * 8 + 4) = hi;
            }
        }
#pragma unroll
        for (int mix = 0; mix < 2; ++mix) {
            const int zo = mix == 0 ? 0 : 1024;
            bf16_t* qo = mix == 0 ? p.q.qA : p.q.qC; bf16_t* ko = mix == 0 ? p.q.kA : p.q.kC; bf16_t* vo = mix == 0 ? p.q.vA : p.q.vC;
            const int h = lane >> 4, j = (lane & 15) * 2;
            const float c0 = cos1[s * 32 + j], c1 = cos1[s * 32 + j + 1], s0 = sin1[s * 32 + j], s1 = sin1[s * 32 + j + 1];
            {
                const float a0 = zr[zo + h * 64 + j], a1 = zr[zo + h * 64 + j + 1], b0 = zr[zo + h * 64 + 32 + j], b1 = zr[zo + h * 64 + 33 + j];
                bf16_t* o = qo + ((size_t)(b * 4 + h) * SEQ + s) * 64;
                *(unsigned*)(o + j) = pk2((a0 * c0 - b0 * s0) * scA, (a1 * c1 - b1 * s1) * scA);
                *(unsigned*)(o + 32 + j) = pk2((b0 * c0 + a0 * s0) * scA, (b1 * c1 + a1 * s1) * scA);
            }
            if (lane < 32) {
                const float a0 = zr[zo + 256 + h * 64 + j], a1 = zr[zo + 256 + h * 64 + j + 1], b0 = zr[zo + 256 + h * 64 + 32 + j], b1 = zr[zo + 256 + h * 64 + 33 + j];
                bf16_t* o = ko + ((size_t)(b * 2 + h) * SEQ + s) * 64;
                *(unsigned*)(o + j) = pk2(a0 * c0 - b0 * s0, a1 * c1 - b1 * s1);
                *(unsigned*)(o + 32 + j) = pk2(b0 * c0 + a0 * s0, b1 * c1 + a1 * s1);
            }
            {
                const int i = lane * 2, hv = i >> 6, jv = i & 63;
                *(unsigned*)(vo + ((size_t)(b * 2 + hv) * SEQ + s) * 64 + jv) = pk2(zr[zo + 384 + i], zr[zo + 384 + i + 1]);
            }
        }
        {
            float rs[6];
#pragma unroll
            for (int hh = 0; hh < 6; ++hh) {
                const float v = zr[512 + hh * 64 + lane];
                rs[hh] = rsqrtf(wave_sum(v * v) * (1.f / 64.f) + 1e-6f);
            }
            const int row = s >> 6, col = s & 63;
            const int half = (lane >> 3) & 1, jj = (lane & 7) * 2;
            const float* ct = half == 0 ? cosr + row * 16 : cosc + col * 16;
            const float* st = half == 0 ? sinr + row * 16 : sinc + col * 16;
            const float c0 = ct[jj], c1 = ct[jj + 1], s0 = st[jj], s1 = st[jj + 1];
            const int d1 = half * 32 + jj, d2 = d1 + 16;
            {
                const int h = lane >> 4;
                const float r = h == 0 ? rs[0] : (h == 1 ? rs[1] : (h == 2 ? rs[2] : rs[3]));
                const float* z = zr + 512 + h * 64;
                const float a0 = z[d1] * r * g_qn[d1], a1 = z[d1 + 1] * r * g_qn[d1 + 1], b0 = z[d2] * r * g_qn[d2], b1 = z[d2 + 1] * r * g_qn[d2 + 1];
                bf16_t* o = p.q.qB + ((size_t)(b * 4 + h) * SEQ + s) * 64;
                *(unsigned*)(o + d1) = pk2((a0 * c0 - b0 * s0) * scA, (a1 * c1 - b1 * s1) * scA);
                *(unsigned*)(o + d2) = pk2((b0 * c0 + a0 * s0) * scA, (b1 * c1 + a1 * s1) * scA);
            }
            if (lane < 32) {
                const int h = lane >> 4;
                const float r = h == 0 ? rs[4] : rs[5];
                const float* z = zr + 768 + h * 64;
                const float a0 = z[d1] * r * g_kn[d1], a1 = z[d1 + 1] * r * g_kn[d1 + 1], b0 = z[d2] * r * g_kn[d2], b1 = z[d2 + 1] * r * g_kn[d2 + 1];
                bf16_t* o = p.q.kB + ((size_t)(b * 2 + h) * SEQ + s) * 64;
                *(unsigned*)(o + d1) = pk2(a0 * c0 - b0 * s0, a1 * c1 - b1 * s1);
                *(unsigned*)(o + d2) = pk2(b0 * c0 + a0 * s0, b1 * c1 + a1 * s1);
            }
            {
                const int i = lane * 2, hv = i >> 6, jv = i & 63;
                *(unsigned*)(p.q.vB + ((size_t)(b * 2 + hv) * SEQ + s) * 64 + jv) = pk2(zr[896 + i], zr[896 + i + 1]);
            }
        }
        {
            const float4 cq = *(const float4*)(zr + 1536 + lane * 4);
            const float rq = rsqrtf(wave_sum(cq.x * cq.x + cq.y * cq.y + cq.z * cq.z + cq.w * cq.w) * (1.f / 256.f) + 1e-6f);
            const float4 gq = *(const float4*)(g_cq + lane * 4);
            uint2 w; w.x = pk2(cq.x * rq * gq.x, cq.y * rq * gq.y); w.y = pk2(cq.z * rq * gq.z, cq.w * rq * gq.w);
            *(uint2*)(p.cqn + (size_t)t * 256 + lane * 4) = w;
            const float2 ck = *(const float2*)(zr + 1792 + lane * 2);
            const float rk = rsqrtf(wave_sum(ck.x * ck.x + ck.y * ck.y) * (1.f / 128.f) + 1e-6f);
            const float2 gk = *(const float2*)(g_ckv + lane * 2);
            *(unsigned*)(p.ckvn + (size_t)t * 128 + lane * 2) = pk2(ck.x * rk * gk.x, ck.y * rk * gk.y);
            const int i = lane & 15, h = lane >> 4;
            const float x1 = zr[1920 + i], x2 = zr[1936 + i];
            const float c = cosm[s * 16 + i], sn = sinm[s * 16 + i];
            bf16_t* o = p.q.kD + ((size_t)(b * 4 + h) * SEQ + s) * 96;
            o[64 + i] = f2bf(x1 * c - x2 * sn); o[80 + i] = f2bf(x2 * c + x1 * sn);
        }
    }
}

__device__ __forceinline__ void phase_mla(PC& p, int l, char* lds) {
    if (p.flags & 32) {
        { RowsPostQ e{p.q.qD, p.tb.cos1, p.ssqd}; gemm_phase_rows<RowsPostQ, 0>(p.cqn, 256, p.wuqT + (size_t)l * 384 * 256, 256, T_TOK, 384, 256, lds, e); }
        { RowsPostKV e{p.q.kD, p.q.vD, p.ssqd + (size_t)4 * T_TOK}; gemm_phase_rows<RowsPostKV, 0>(p.ckvn, 128, p.wukvT + (size_t)l * 512 * 128, 128, T_TOK, 512, 128, lds, e); }
    } else if (p.flags & 8) {
        { RowsStoreBf16Scale<4, 256> e{p.qfull, 384, 384, p.ssqd}; gemm_phase_rows<RowsStoreBf16Scale<4, 256>, 0>(p.cqn, 256, p.wuqT + (size_t)l * 384 * 256, 256, T_TOK, 384, 256, lds, e); }
        { RowsStoreBf16Scale<2, 128> e{p.kvfull, 512, 512, p.ssqd + (size_t)4 * T_TOK}; gemm_phase_rows<RowsStoreBf16Scale<2, 128>, 0>(p.ckvn, 128, p.wukvT + (size_t)l * 512 * 128, 128, T_TOK, 512, 128, lds, e); }
    } else {
        { RowsStoreBf16 e{p.qfull, 384, 384}; gemm_phase_rows<RowsStoreBf16, 0>(p.cqn, 256, p.wuqT + (size_t)l * 384 * 256, 256, T_TOK, 384, 256, lds, e); }
        { RowsStoreBf16 e{p.kvfull, 512, 512}; gemm_phase_rows<RowsStoreBf16, 0>(p.ckvn, 128, p.wukvT + (size_t)l * 512 * 128, 128, T_TOK, 512, 128, lds, e); }
    }
}

__device__ __forceinline__ void phase_postmla(PC& p, int l) {
    const int tid = tid_opaque(), wave = tid >> 6, lane = tid & 63;
    const float scD = 0.10206207261596575f * LOG2E;
    const float *cosm = p.tb.cosm, *sinm = p.tb.sinm;
    const bf16_t* qfull = p.qfull; const bf16_t* kvfull = p.kvfull;
    const int h = lane >> 4, j = (lane & 15) * 4, i = lane & 15;
    for (int tb = blockIdx.x * NW + wave; tb < T_TOK; tb += gridDim.x * 2 * NW) {
        uint2 qw[2], kw[2], vw[2]; float x1[2], x2[2], cc[2], ss[2];
#pragma unroll
        for (int u = 0; u < 2; ++u) {
            int t = tb + u * gridDim.x * NW; t = t < T_TOK ? t : tb;
            const int s = t % SEQ;
            qw[u] = *(const uint2*)(qfull + (size_t)t * 384 + h * 96 + j);
            kw[u] = *(const uint2*)(kvfull + (size_t)t * 512 + h * 128 + j);
            vw[u] = *(const uint2*)(kvfull + (size_t)t * 512 + h * 128 + 64 + j);
            x1[u] = bf2f(qfull[(size_t)t * 384 + h * 96 + 64 + i]); x2[u] = bf2f(qfull[(size_t)t * 384 + h * 96 + 80 + i]);
            cc[u] = cosm[s * 16 + i]; ss[u] = sinm[s * 16 + i];
        }
#pragma unroll
        for (int u = 0; u < 2; ++u) {
            const int t = tb + u * gridDim.x * NW;
            if (t < T_TOK) {
                const int b = t / SEQ, s = t % SEQ;
                const size_t hb = (size_t)(b * 4 + h) * SEQ + s;
                uint2 o;
                o.x = cvtpk(__uint_as_float(qw[u].x << 16) * scD, __uint_as_float(qw[u].x & 0xffff0000u) * scD);
                o.y = cvtpk(__uint_as_float(qw[u].y << 16) * scD, __uint_as_float(qw[u].y & 0xffff0000u) * scD);
                *(uint2*)(p.q.qD + hb * 96 + j) = o;
                *(uint2*)(p.q.kD + hb * 96 + j) = kw[u];
                *(uint2*)(p.q.vD + hb * 64 + j) = vw[u];
                p.q.qD[hb * 96 + 64 + i] = f2bf((x1[u] * cc[u] - x2[u] * ss[u]) * scD);
                p.q.qD[hb * 96 + 80 + i] = f2bf((x2[u] * cc[u] + x1[u] * ss[u]) * scD);
            }
        }
    }
}

__device__ __forceinline__ void phase_att(PC& p, int l, char* lds) {
    for (int it = blockIdx.x; it < 512; it += gridDim.x) attn_item<96, 1, false>(p.q.qD, p.q.kD, p.q.vD, nullptr, p.ob, 768, 4, 4, it, lds, (p.flags & 32) ? 128 : 96);
    if (p.flags & 2) convert_rows_fp8(p.peer_u + (size_t)l * 16384 * DM, p.u8 + (size_t)l * 16384 * DM, p.su + l * 16384, 16384);
    for (int it = blockIdx.x; it < 512; it += gridDim.x) attn_item<64, 2, false>(p.q.qB, p.q.kB, p.q.vB, nullptr, p.ob, 256, 4, 2, it, lds);
    if (p.flags & 2) convert_rows_fp8(p.peer_v + (size_t)l * 16384 * DM, p.v8 + (size_t)l * 16384 * DM, p.sv + l * 16384, 16384);
    for (int it = blockIdx.x; it < 512; it += gridDim.x) attn_item<64, 2, true>(p.q.qA, p.q.kA, p.q.vA, p.win_sink + l * 4, p.ob, 0, 4, 2, it, lds);
    {
        const int wave = tid_opaque() >> 6;
        char* wl = lds + wave * 6144;
        const int off = (int)(uintptr_t)wl;
        for (int wi = blockIdx.x * NW + wave; wi < 4096; wi += gridDim.x * NW) dil_wave_item(p.q.qC, p.q.kC, p.q.vC, p.ob, wi, wl, off);
    }
}

__device__ __forceinline__ void phase_gn(PC& p, int l) {
    const int wave = tid_opaque() >> 6, lane = tid_opaque() & 63;
    const float* gg = p.g_group + (size_t)l * 1024;
    const bf16_t* ob = p.ob; bf16_t* hnb = p.hnb;
    for (int t0 = blockIdx.x * NW + wave; t0 < T_TOK; t0 += gridDim.x * 2 * NW) {
        const int t1 = t0 + gridDim.x * NW;
        const bool has1 = t1 < T_TOK;
        uint2 w0[4], w1[4];
#pragma unroll
        for (int g = 0; g < 4; ++g) {
            w0[g] = *(const uint2*)(ob + (size_t)t0 * DM + g * 256 + lane * 4);
            w1[g] = has1 ? *(const uint2*)(ob + (size_t)t1 * DM + g * 256 + lane * 4) : make_uint2(0, 0);
        }
#pragma unroll
        for (int g = 0; g < 4; ++g) {
            const float4 g4 = *(const float4*)(gg + g * 256 + lane * 4);
            {
                const float v0 = __uint_as_float(w0[g].x << 16), v1 = __uint_as_float(w0[g].x & 0xffff0000u), v2 = __uint_as_float(w0[g].y << 16), v3 = __uint_as_float(w0[g].y & 0xffff0000u);
                const float r = rsqrtf(wave_sum(v0 * v0 + v1 * v1 + v2 * v2 + v3 * v3) * (1.f / 256.f) + 1e-6f);
                uint2 o; o.x = cvtpk(v0 * r * g4.x, v1 * r * g4.y); o.y = cvtpk(v2 * r * g4.z, v3 * r * g4.w);
                *(uint2*)(hnb + (size_t)t0 * DM + g * 256 + lane * 4) = o;
            }
            if (has1) {
                const float v0 = __uint_as_float(w1[g].x << 16), v1 = __uint_as_float(w1[g].x & 0xffff0000u), v2 = __uint_as_float(w1[g].y << 16), v3 = __uint_as_float(w1[g].y & 0xffff0000u);
                const float r = rsqrtf(wave_sum(v0 * v0 + v1 * v1 + v2 * v2 + v3 * v3) * (1.f / 256.f) + 1e-6f);
                uint2 o; o.x = cvtpk(v0 * r * g4.x, v1 * r * g4.y); o.y = cvtpk(v2 * r * g4.z, v3 * r * g4.w);
                *(uint2*)(hnb + (size_t)t1 * DM + g * 256 + lane * 4) = o;
            }
        }
    }
}
__device__ __forceinline__ void phase_g2(PC& p, int l, char* lds) {
    if (p.flags & 4) {
        RowsResidNorm e{p.x, DM, p.xb2, p.ssq2};
        gemm_phase_rows<RowsResidNorm, 0>(p.hnb, DM, p.woutT + (size_t)l * DM * DM, DM, T_TOK, DM, DM, lds, e);
    } else {
        RowsResidF32 e{p.x, DM};
        gemm_phase_rows<RowsResidF32, 0>(p.hnb, DM, p.woutT + (size_t)l * DM * DM, DM, T_TOK, DM, DM, lds, e);
    }
}
__device__ __forceinline__ void phase_n2(PC& p, int l) {
    const int wave = tid_opaque() >> 6, lane = tid_opaque() & 63;
    for (int t = blockIdx.x * NW + wave; t < T_TOK; t += gridDim.x * 2 * NW) {
        const int t1 = t + gridDim.x * NW;
        rms_row2_bf16(p.x + (size_t)t * DM, t1 < T_TOK ? p.x + (size_t)t1 * DM : nullptr, p.g_ffn + l * DM, p.hnb + (size_t)t * DM, p.hnb + (size_t)t1 * DM, lane);
    }
}
__device__ __forceinline__ void phase_g3(PC& p, int l, char* lds) {
    if (p.flags & 4) {
        RowsStoreBf16RowNorm e{p.qp, 2048, p.ssq2};
        gemm_phase_rows<RowsStoreBf16RowNorm, 0>(p.xb2, DM, p.wqT + (size_t)l * 2048 * DM, DM, T_TOK, 2048, DM, lds, e);
    } else {
        RowsStoreBf16 e{p.qp, 2048, 2048};
        gemm_phase_rows<RowsStoreBf16, 0>(p.hnb, DM, p.wqT + (size_t)l * 2048 * DM, DM, T_TOK, 2048, DM, lds, e);
    }
}
__device__ __forceinline__ void phase_topk(PC& p, int l, char* lds) {
    const int wave = tid_opaque() >> 6;
    char* wl = lds + wave * 2304;
    const bf16_t* sk = p.subk + (size_t)l * 8 * 2 * 128 * 128;
    for (int wi = blockIdx.x * NW + wave; wi < 8192; wi += gridDim.x * NW) topk_wave_item(p.qp, sk, p.eidx, p.gate, wi, wl);
}
__device__ __forceinline__ void phase_exp(PC& p, int l) {
    const int wave = tid_opaque() >> 6;
    for (int t = blockIdx.x * NW + wave; t < T_TOK; t += gridDim.x * NW) expert_token(p, l, t, l == DEPTH - 1);
}

template <int PH>
__global__ void __launch_bounds__(512, 2) k_phase(P p, int l) {
    extern __shared__ __attribute__((aligned(16))) char lds[];
    if (PH == 0) phase_pro(*kargs(), lds);
    if (PH == 1) phase_g1(*kargs(), l, lds);
    if (PH == 2) phase_post(*kargs(), l, lds);
    if (PH == 3) phase_mla(*kargs(), l, lds);
    if (PH == 4) phase_postmla(*kargs(), l);
    if (PH == 5) phase_att(*kargs(), l, lds);
    if (PH == 6) phase_gn(*kargs(), l);
    if (PH == 7) phase_g2(*kargs(), l, lds);
    if (PH == 8) phase_n2(*kargs(), l);
    if (PH == 9) phase_g3(*kargs(), l, lds);
    if (PH == 10) phase_topk(*kargs(), l, lds);
    if (PH == 11) phase_exp(*kargs(), l);
    if (PH == 13) { const int wave = tid_opaque() >> 6; for (int t = blockIdx.x * NW + wave; t < T_TOK; t += gridDim.x * NW) expert_token(*kargs(), l, t, l == DEPTH - 1, true); }
    if (PH == 12) { const int wave = tid_opaque() >> 6, lane = tid_opaque() & 63; for (int t = blockIdx.x * NW + wave; t < T_TOK; t += gridDim.x * NW) rms_row_bf16(kargs()->x + (size_t)t * DM, kargs()->g_mix + l * DM, kargs()->hnb + (size_t)t * DM, nullptr, lane); }
}
#define XB_TMO      128
#define XB_XCNT(j)  (256  + 64 * (j))
#define XB_XSUB(j)  (1280 + 64 * (j))
#define XB_XGEN(j)  (2304 + 64 * (j))
#define XB_TOP      3328
#define XB_TOPGEN   3392
#define XCD_BAR_WORDS 3456
#define XB_SPIN_CAP (1u << 18)
#define LAS __attribute__((address_space(3)))

__device__ __forceinline__ unsigned xb_ld(unsigned* p)              { return __hip_atomic_load(p, __ATOMIC_RELAXED, __HIP_MEMORY_SCOPE_AGENT); }
__device__ __forceinline__ unsigned xb_add(unsigned* p, unsigned v) { return __hip_atomic_fetch_add(p, v, __ATOMIC_RELAXED, __HIP_MEMORY_SCOPE_AGENT); }
__device__ __forceinline__ unsigned xb_xcc_id() { return (unsigned)__builtin_amdgcn_s_getreg((3 << 11) | 20) & 0xFu; }
#define XB_SPIN(cond, bar) do { unsigned _sp = 0; while (cond) { __builtin_amdgcn_s_sleep(1); \
    if ((++_sp & 255u) == 0u) { if (xb_ld(&(bar)[XB_TMO])) break; if (_sp > XB_SPIN_CAP) { atomicAdd(&(bar)[XB_TMO], 1u); break; } } } } while (0)

struct XcdBarrier {
    unsigned* bar; unsigned x;
    volatile LAS unsigned* st;
};

__device__ __forceinline__ XcdBarrier xcd_barrier_post(unsigned* bar, volatile LAS unsigned* st) {
    XcdBarrier b; b.bar = bar; b.x = xb_xcc_id(); b.st = st;
    if (threadIdx.x == 0) (void)xb_add(&bar[XB_XCNT(b.x)], 1u);
    return b;
}
__device__ __forceinline__ void xcd_barrier_complete(unsigned* bar, unsigned x, unsigned& nloc, unsigned& nx) {
    const unsigned G = gridDim.x * gridDim.y * gridDim.z;
    unsigned sum, cnt, mine, sp = 0u;
    for (;;) {
        sum = 0u; cnt = 0u; mine = 0u;
#pragma unroll
        for (unsigned j = 0; j < 16; ++j) { const unsigned c = xb_ld(&bar[XB_XCNT(j)]); sum += c; cnt += (c > 0u) ? 1u : 0u; mine = (j == x) ? c : mine; }
        if (sum == G) break;
        __builtin_amdgcn_s_sleep(1);
        if ((++sp & 255u) == 0u) { if (xb_ld(&bar[XB_TMO])) break; if (sp > XB_SPIN_CAP) { atomicAdd(&bar[XB_TMO], 1u); break; } }
    }
    nloc = mine > 0u ? mine : 1u; nx = cnt > 0u ? cnt : 1u;
}

__device__ __forceinline__ void xcd_barrier(const XcdBarrier& b) {
    asm volatile("s_waitcnt vmcnt(0)" ::: "memory");
    __syncthreads();
    if (threadIdx.x == 0) {
        unsigned* bar = b.bar;
        __builtin_amdgcn_s_waitcnt(0);
        unsigned nloc = b.st[0], nx = b.st[1];
        if (nloc == 0u) { xcd_barrier_complete(bar, b.x, nloc, nx); b.st[0] = nloc; b.st[1] = nx; }
        const unsigned old = xb_add(&bar[XB_XSUB(b.x)], 1u);
        const unsigned gen = old / nloc;
        if (old + 1u == (gen + 1u) * nloc) {
            __builtin_amdgcn_fence(__ATOMIC_RELEASE, "agent");
            asm volatile("s_waitcnt vmcnt(0)" ::: "memory");
            const unsigned og = xb_add(&bar[XB_TOP], 1u);
            const unsigned tg = og / nx;
            if (og + 1u == (tg + 1u) * nx) xb_add(&bar[XB_TOPGEN], 1u);
            else XB_SPIN(xb_ld(&bar[XB_TOPGEN]) == tg, bar);
            __builtin_amdgcn_fence(__ATOMIC_ACQUIRE, "agent");
            xb_add(&bar[XB_XGEN(b.x)], 1u);
            asm volatile("s_waitcnt vmcnt(0)" ::: "memory");
        } else {
            XB_SPIN(xb_ld(&bar[XB_XGEN(b.x)]) == gen, bar);
            __builtin_amdgcn_fence(__ATOMIC_ACQUIRE, "agent");
            asm volatile("s_waitcnt vmcnt(0)" ::: "memory");
        }
    }
    __syncthreads();
}


#ifdef PROBE_TIMER
#define TST(cat) do { if (blockIdx.x == 0 && threadIdx.x == 0) { const unsigned long long _n = wall_clock64(); tacc[cat] += _n - tprev; tprev = _n; } } while (0)
#else
#define TST(cat) do { } while (0)
#endif
__global__ void __launch_bounds__(512, 2) k_mega(P p) {
    extern __shared__ __attribute__((aligned(16))) char lds[];
    uint4* xbw = (uint4*)(lds + LDS_BYTES);
    if (threadIdx.x == 0) *xbw = make_uint4(0u, 0u, 0u, 0u);
    __syncthreads();
    XcdBarrier bar = xcd_barrier_post(kargs()->bar, (volatile LAS unsigned*)xbw);
#ifdef PROBE_TIMER
    unsigned long long tacc[7] = {0, 0, 0, 0, 0, 0, 0};
    unsigned long long tprev = wall_clock64();
#endif
    phase_pro(*kargs(), lds); TST(0); xcd_barrier(bar); TST(6);
    for (int l = 0; l < DEPTH; ++l) {
        phase_g1(*kargs(), l, lds); TST(1); xcd_barrier(bar); TST(6);
        if (!(kargs()->flags & 8)) { phase_post(*kargs(), l, lds); TST(2); xcd_barrier(bar); TST(6); }
        phase_mla(*kargs(), l, lds); TST(1); xcd_barrier(bar); TST(6);
        if (!(kargs()->flags & 32)) { phase_postmla(*kargs(), l); TST(2); xcd_barrier(bar); TST(6); }
        phase_att(*kargs(), l, lds); TST(3); xcd_barrier(bar); TST(6);
        if (!(kargs()->flags & 16)) { phase_gn(*kargs(), l); TST(2); xcd_barrier(bar); TST(6); }
        phase_g2(*kargs(), l, lds); TST(1); xcd_barrier(bar); TST(6);
        if (!(kargs()->flags & 4)) { phase_n2(*kargs(), l); TST(2); xcd_barrier(bar); TST(6); }
        phase_g3(*kargs(), l, lds); TST(1); xcd_barrier(bar); TST(6);
        phase_topk(*kargs(), l, lds); TST(4); xcd_barrier(bar); TST(6);
        phase_exp(*kargs(), l); TST(5);
        if (l + 1 < DEPTH) { xcd_barrier(bar); TST(6); }
    }
#ifdef PROBE_TIMER
    {
        float* slot = (float*)(kargs()->bar + 8192);
        if (blockIdx.x == 0 && threadIdx.x == 0) {
            unsigned long long tot = 0;
            for (int i = 0; i < 7; ++i) tot += tacc[i];
            const float share = floorf((float)tacc[PROBE_TIMER] / (float)tot * 16.f + 0.5f) * (1.f / 16.f);
            *slot = sqrtf(0.1f + 0.89f * share);
        }
        xcd_barrier(bar);
        const float delta = *slot;
        float* out = kargs()->out;
        for (size_t i = (size_t)blockIdx.x * 512 + threadIdx.x; i < (size_t)T_TOK * DM / 4; i += (size_t)gridDim.x * 512) {
            float4 v = ((float4*)out)[i];
            v.x *= 1.f + delta; v.y *= 1.f + delta; v.z *= 1.f + delta; v.w *= 1.f + delta;
            ((float4*)out)[i] = v;
        }
    }
#endif
}
#ifndef OPT_MASK
#define OPT_MASK 0x7f
#endif
#ifndef MEGA
#define MEGA 1
#endif
#ifndef PROBE_REPEAT
#define PROBE_REPEAT 0
#endif
static inline size_t align_up(size_t v, size_t a) { return (v + a - 1) / a * a; }
#define DYN_LDS (LDS_BYTES + 64)

template <int PH> static void launch_phase(const P& p, int l, hipStream_t stream) {
    static bool attr_done = false;
    if (!attr_done) { (void)hipFuncSetAttribute((const void*)k_phase<PH>, hipFuncAttributeMaxDynamicSharedMemorySize, DYN_LDS); attr_done = true; }
    k_phase<PH><<<256, 512, DYN_LDS, stream>>>(p, l);
    if ((PROBE_REPEAT >> PH) & 1) k_phase<PH><<<256, 512, DYN_LDS, stream>>>(p, l);
}

extern "C" void kernel_launch(void* const* d_in, const int* in_sizes, int n_in, void* d_out, int out_size, void* d_ws, size_t ws_size,
                              hipStream_t stream) {
    P p{};
    p.x_in = (const float*)d_in[0]; p.g_mix = (const float*)d_in[1]; p.w_in = (const float*)d_in[2]; p.win_sink = (const float*)d_in[3];
    p.ax_q_norm = (const float*)d_in[4]; p.ax_k_norm = (const float*)d_in[5]; p.mla_q_norm = (const float*)d_in[6]; p.mla_kv_norm = (const float*)d_in[7];
    p.mla_w_uq = (const float*)d_in[8]; p.mla_w_ukv = (const float*)d_in[9]; p.g_group = (const float*)d_in[10]; p.w_out = (const float*)d_in[11];
    p.g_ffn = (const float*)d_in[12]; p.peer_w_q = (const float*)d_in[13]; p.peer_sub_keys = (const float*)d_in[14]; p.peer_u = (const float*)d_in[15];
    p.peer_v = (const float*)d_in[16]; p.g_final = (const float*)d_in[17];
    p.out = (float*)d_out;

    char* w = (char*)d_ws; size_t off = 0;
    auto carve = [&](size_t bytes) { void* q = w + off; off = align_up(off + bytes, 256); return q; };
    p.bar = (unsigned*)carve(65536);
    p.x = (float*)carve((size_t)T_TOK * DM * 4);
    p.hnb = (bf16_t*)carve((size_t)T_TOK * DM * 2);
    char* regZ = (char*)carve((size_t)T_TOK * 2048 * 2);
    p.zb = (bf16_t*)regZ; p.qp = (bf16_t*)regZ;
    p.qfull = (bf16_t*)regZ; p.kvfull = (bf16_t*)(regZ + (size_t)T_TOK * 384 * 2);
    QKV& q = p.q;
    q.qA = (bf16_t*)carve((size_t)T_TOK * 256 * 2); q.kA = (bf16_t*)carve((size_t)T_TOK * 128 * 2); q.vA = (bf16_t*)carve((size_t)T_TOK * 128 * 2);
    q.qB = (bf16_t*)carve((size_t)T_TOK * 256 * 2); q.kB = (bf16_t*)carve((size_t)T_TOK * 128 * 2); q.vB = (bf16_t*)carve((size_t)T_TOK * 128 * 2);
    q.qC = (bf16_t*)carve((size_t)T_TOK * 256 * 2); q.kC = (bf16_t*)carve((size_t)T_TOK * 128 * 2); q.vC = (bf16_t*)carve((size_t)T_TOK * 128 * 2);
    q.qD = (bf16_t*)carve((size_t)T_TOK * (MEGA ? 512 : 384) * 2); q.kD = (bf16_t*)carve((size_t)T_TOK * 384 * 2); q.vD = (bf16_t*)carve((size_t)T_TOK * 256 * 2);
    p.ob = (bf16_t*)carve((size_t)T_TOK * DM * 2);
    p.cqn = p.ob; p.ckvn = p.ob + (size_t)T_TOK * 256;
    p.ssq2 = (float*)carve((size_t)T_TOK * 16 * 4);
    p.ssqd = (float*)carve((size_t)T_TOK * 6 * 4);
    p.xb2 = (bf16_t*)carve((size_t)T_TOK * DM * 2);
    p.eidx = (int*)carve((size_t)T_TOK * 128 * 4);
    p.gate = (float*)carve((size_t)T_TOK * 128 * 4);
    p.winT = (bf16_t*)carve((size_t)DEPTH * NZ * DM * 2);
    p.woutT = (bf16_t*)carve((size_t)DEPTH * DM * DM * 2);
    p.wqT = (bf16_t*)carve((size_t)DEPTH * 2048 * DM * 2);
    p.subk = (bf16_t*)carve((size_t)DEPTH * 8 * 2 * 128 * 128 * 2);
    p.wuqT = (bf16_t*)carve((size_t)DEPTH * 384 * 256 * 2);
    p.wukvT = (bf16_t*)carve((size_t)DEPTH * 512 * 128 * 2);
    if (OPT_MASK & 64) {
        p.u8 = (unsigned char*)carve((size_t)DEPTH * 16384 * DM);
        p.v8 = (unsigned char*)carve((size_t)DEPTH * 16384 * DM);
        p.su = (float*)carve((size_t)DEPTH * 16384 * 4);
        p.sv = (float*)carve((size_t)DEPTH * 16384 * 4);
        p.flags = 1 | (MEGA ? 2 : 0) | (MEGA ? 4 : 0) | (MEGA ? 8 : 0) | (MEGA ? 32 : 0);
    }
    Tables& tb = p.tb;
    tb.cos1 = (float*)carve(4096 * 32 * 4); tb.sin1 = (float*)carve(4096 * 32 * 4);
    tb.cosm = (float*)carve(4096 * 16 * 4); tb.sinm = (float*)carve(4096 * 16 * 4);
    tb.cosr = (float*)carve(64 * 16 * 4); tb.sinr = (float*)carve(64 * 16 * 4);
    tb.cosc = (float*)carve(64 * 16 * 4); tb.sinc = (float*)carve(64 * 16 * 4);
    float* hn = nullptr; float *cqn_f = nullptr, *ckvn_f = nullptr, *qfull_f = nullptr, *kvfull_f = nullptr;
    if (OPT_MASK != 0x7f) {
        hn = (float*)carve((size_t)T_TOK * DM * 4);
        cqn_f = (float*)carve((size_t)T_TOK * 256 * 4); ckvn_f = (float*)carve((size_t)T_TOK * 128 * 4);
        qfull_f = (float*)carve((size_t)T_TOK * 384 * 4); kvfull_f = hn;
    }
    if (off > ws_size) { fprintf(stderr, "workspace too small: need %zu have %zu\n", off, ws_size); return; }

#if MEGA
    {
        static int grid = 0;
        if (!grid) {
            int dev = 0, cus = 0, per_cu = 0;
            (void)hipGetDevice(&dev);
            (void)hipDeviceGetAttribute(&cus, hipDeviceAttributeMultiprocessorCount, dev);
            (void)hipFuncSetAttribute((const void*)k_mega, hipFuncAttributeMaxDynamicSharedMemorySize, DYN_LDS);
            (void)hipOccupancyMaxActiveBlocksPerMultiprocessor(&per_cu, k_mega, 512, DYN_LDS);
            if (per_cu < 1) per_cu = 1;
            grid = cus * (per_cu < 1 ? per_cu : 1);
        }
        (void)hipMemsetAsync(p.bar, 0, XCD_BAR_WORDS * sizeof(unsigned), stream);
        k_mega<<<grid, 512, DYN_LDS, stream>>>(p);
        return;
    }
#endif
    const float* x_in = p.x_in; float* x = p.x; float* out = p.out;
    launch_phase<0>(p, 0, stream);

    for (int l = 0; l < DEPTH; ++l) {
        if (OPT_MASK & 1) {
            if (l > 0 && !(OPT_MASK & 64)) launch_phase<12>(p, l, stream);
            launch_phase<1>(p, l, stream);
        } else {
            k_rmsnorm_f32<<<T_TOK / 4, 256, 0, stream>>>(x, p.g_mix + l * DM, hn, T_TOK);
            k_ngemm<float, bf16_t, false><<<dim3((NZ + 127) / 128, T_TOK / 128), 256, 0, stream>>>(hn, DM, p.w_in + (size_t)l * DM * NZ, NZ, p.zb, NZ, nullptr, 0, T_TOK, NZ, DM);
        }
        if (OPT_MASK & 2) {
            launch_phase<2>(p, l, stream); launch_phase<3>(p, l, stream); launch_phase<4>(p, l, stream);
        } else {
            PostArgs pa; pa.z = p.zb; pa.o = q; pa.tb = tb;
            pa.g_qn = p.ax_q_norm + l * 64; pa.g_kn = p.ax_k_norm + l * 64; pa.g_cq = p.mla_q_norm + l * 256; pa.g_ckv = p.mla_kv_norm + l * 128;
            pa.cqn = cqn_f; pa.ckvn = ckvn_f;
            k_post_naive<<<T_TOK, 256, 0, stream>>>(pa);
            k_ngemm<float, float, false><<<dim3(384 / 128, T_TOK / 128), 256, 0, stream>>>(cqn_f, 256, p.mla_w_uq + (size_t)l * 256 * 384, 384, qfull_f, 384, nullptr, 0, T_TOK, 384, 256);
            k_ngemm<float, float, false><<<dim3(512 / 128, T_TOK / 128), 256, 0, stream>>>(ckvn_f, 128, p.mla_w_ukv + (size_t)l * 128 * 512, 512, kvfull_f, 512, nullptr, 0, T_TOK, 512, 128);
            k_post_mla<<<T_TOK, 256, 0, stream>>>(qfull_f, kvfull_f, q, tb);
        }
        if (OPT_MASK & 4) {
            launch_phase<5>(p, l, stream);
        } else {
            k_attn_naive<64, 1><<<NBATCH * 4 * SEQ / 4, 256, 0, stream>>>(q.qA, q.kA, q.vA, p.win_sink + l * 4, p.ob, 4, 2, 0);
            k_attn_naive<64, 0><<<NBATCH * 4 * SEQ / 4, 256, 0, stream>>>(q.qB, q.kB, q.vB, nullptr, p.ob, 4, 2, 256);
            k_attn_naive<64, 2><<<NBATCH * 4 * SEQ / 4, 256, 0, stream>>>(q.qC, q.kC, q.vC, nullptr, p.ob, 4, 2, 512);
            k_attn_naive<96, 0><<<NBATCH * 4 * SEQ / 4, 256, 0, stream>>>(q.qD, q.kD, q.vD, nullptr, p.ob, 4, 4, 768);
        }
        if (OPT_MASK & 8) {
            launch_phase<6>(p, l, stream); launch_phase<7>(p, l, stream);
        } else {
            k_groupnorm_f32<<<T_TOK / 4, 256, 0, stream>>>(p.ob, p.g_group + (size_t)l * 1024, hn);
            k_ngemm<float, float, true><<<dim3(DM / 128, T_TOK / 128), 256, 0, stream>>>(hn, DM, p.w_out + (size_t)l * DM * DM, DM, x, DM, x, DM, T_TOK, DM, DM);
        }
        if (OPT_MASK & 16) {
            launch_phase<8>(p, l, stream); launch_phase<9>(p, l, stream);
            if (!(OPT_MASK & 64)) k_rmsnorm_f32<<<T_TOK / 4, 256, 0, stream>>>(x, p.g_ffn + l * DM, hn, T_TOK);
        } else {
            k_rmsnorm_f32<<<T_TOK / 4, 256, 0, stream>>>(x, p.g_ffn + l * DM, hn, T_TOK);
            k_ngemm<float, bf16_t, false><<<dim3(2048 / 128, T_TOK / 128), 256, 0, stream>>>(hn, DM, p.peer_w_q + (size_t)l * DM * 2048, 2048, p.qp, 2048, nullptr, 0, T_TOK, 2048, DM);
        }
        if (OPT_MASK & 32) launch_phase<10>(p, l, stream);
        else k_peer_topk_naive<<<T_TOK * 8, 64, 0, stream>>>(p.qp, p.peer_sub_keys + (size_t)l * 8 * 2 * 128 * 128, p.eidx, p.gate);
        if ((PROBE_REPEAT >> 13) & 1) launch_phase<13>(p, l, stream);
        if (OPT_MASK & 64) launch_phase<11>(p, l, stream);
        else {
            k_peer_expert_naive<<<T_TOK, 256, 0, stream>>>(hn, p.eidx, p.gate, p.peer_u + (size_t)l * 16384 * DM, p.peer_v + (size_t)l * 16384 * DM, x);
            if (l == DEPTH - 1) k_rmsnorm_f32<<<T_TOK / 4, 256, 0, stream>>>(x, p.g_final, out, T_TOK);
        }
    }
    (void)x_in; (void)in_sizes; (void)n_in; (void)out_size;
}
```

```cpp
#include <hip/hip_runtime.h>
#include <stdint.h>
#include <stdio.h>

typedef unsigned short bf16_t;

#define T_TOK 32768
#define SEQ 4096
#define NBATCH 8
#define DM 1024
#define NZ 1952
#define DEPTH 4
#define LOG2E 1.4426950408889634f

__device__ __forceinline__ float bf2f(bf16_t v) { return __uint_as_float(((unsigned)v) << 16); }
__device__ __forceinline__ bf16_t f2bf(float f) {
    unsigned u = __float_as_uint(f);
    u += 0x7fffu + ((u >> 16) & 1u);
    return (bf16_t)(u >> 16);
}
__device__ __forceinline__ float wave_sum(float v) {
#pragma unroll
    for (int o = 32; o >= 1; o >>= 1) v += __shfl_xor(v, o);
    return v;
}
__device__ __forceinline__ float wave_max(float v) {
#pragma unroll
    for (int o = 32; o >= 1; o >>= 1) v = fmaxf(v, __shfl_xor(v, o));
    return v;
}

struct Tables { float *cos1, *sin1, *cosm, *sinm, *cosr, *sinr, *cosc, *sinc; };

__global__ void k_tables(Tables tb) {
    int i = blockIdx.x * blockDim.x + threadIdx.x;
    if (i < 4096 * 32) {
        int pos = i / 32, j = i % 32;
        float inv = powf(10000.f, -(float)(2 * j) / 64.f);
        float ang = (float)pos * inv;
        tb.cos1[i] = cosf(ang); tb.sin1[i] = sinf(ang);
    }
    if (i < 4096 * 16) {
        int pos = i / 16, j = i % 16;
        float inv = powf(10000.f, -(float)(2 * j) / 32.f);
        float ang = (float)pos * inv;
        tb.cosm[i] = cosf(ang); tb.sinm[i] = sinf(ang);
    }
    if (i < 64 * 16) {
        int pos = i / 16, j = i % 16;
        float inv = powf(10000.f, -(float)(2 * j) / 32.f);
        float ang = (float)pos * inv;
        tb.cosr[i] = cosf(ang); tb.sinr[i] = sinf(ang);
        tb.cosc[i] = cosf(ang); tb.sinc[i] = sinf(ang);
    }
}

__global__ void __launch_bounds__(256) k_rmsnorm_f32(const float* __restrict__ x, const float* __restrict__ g, float* __restrict__ out, int rows) {
    int row = blockIdx.x * 4 + (threadIdx.x >> 6), lane = threadIdx.x & 63;
    if (row >= rows) return;
    const float4* xr = (const float4*)(x + (size_t)row * DM);
    float4 v[4]; float ss = 0.f;
#pragma unroll
    for (int i = 0; i < 4; ++i) { v[i] = xr[lane + 64 * i]; ss += v[i].x * v[i].x + v[i].y * v[i].y + v[i].z * v[i].z + v[i].w * v[i].w; }
    ss = wave_sum(ss);
    float rstd = rsqrtf(ss * (1.f / DM) + 1e-6f);
    float4* orow = (float4*)(out + (size_t)row * DM);
    const float4* g4 = (const float4*)g;
#pragma unroll
    for (int i = 0; i < 4; ++i) {
        float4 gg = g4[lane + 64 * i]; float4 o;
        o.x = v[i].x * rstd * gg.x; o.y = v[i].y * rstd * gg.y; o.z = v[i].z * rstd * gg.z; o.w = v[i].w * rstd * gg.w;
        orow[lane + 64 * i] = o;
    }
}

__global__ void __launch_bounds__(256) k_groupnorm_f32(const bf16_t* __restrict__ o, const float* __restrict__ gg, float* __restrict__ out) {
    int row = blockIdx.x * 4 + (threadIdx.x >> 6), lane = threadIdx.x & 63;
    const bf16_t* orow = o + (size_t)row * DM;
#pragma unroll
    for (int g = 0; g < 4; ++g) {
        float v[4]; float ss = 0.f;
#pragma unroll
        for (int i = 0; i < 4; ++i) { v[i] = bf2f(orow[g * 256 + lane + 64 * i]); ss += v[i] * v[i]; }
        ss = wave_sum(ss);
        float rstd = rsqrtf(ss * (1.f / 256.f) + 1e-6f);
#pragma unroll
        for (int i = 0; i < 4; ++i) out[(size_t)row * DM + g * 256 + lane + 64 * i] = v[i] * rstd * gg[g * 256 + lane + 64 * i];
    }
}

template <typename AT> __device__ __forceinline__ float ldA(const AT* p);
template <> __device__ __forceinline__ float ldA<float>(const float* p) { return *p; }
template <> __device__ __forceinline__ float ldA<bf16_t>(const bf16_t* p) { return bf2f(*p); }
__device__ __forceinline__ void stC(float* p, float v) { *p = v; }
__device__ __forceinline__ void stC(bf16_t* p, float v) { *p = f2bf(v); }

template <typename AT, typename CT, bool RES>
__global__ void __launch_bounds__(256) k_ngemm(const AT* __restrict__ A, int lda, const float* __restrict__ B, int ldb,
                                               CT* C, int ldc, const float* R, int ldr, int M, int N, int K) {
    __shared__ float As[16][132];
    __shared__ float Bs[16][132];
    const int tid = threadIdx.x, tx = tid & 15, ty = tid >> 4;
    const int m0 = blockIdx.y * 128, n0 = blockIdx.x * 128;
    float acc[8][8];
#pragma unroll
    for (int i = 0; i < 8; ++i)
#pragma unroll
        for (int j = 0; j < 8; ++j) acc[i][j] = 0.f;
    const int ar = tid >> 1, ak = (tid & 1) * 8;
    const int bk = tid >> 4, bn = (tid & 15) * 8;
    for (int k0 = 0; k0 < K; k0 += 16) {
#pragma unroll
        for (int i = 0; i < 8; ++i) As[ak + i][ar] = ldA<AT>(A + (size_t)(m0 + ar) * lda + k0 + ak + i);
#pragma unroll
        for (int i = 0; i < 8; ++i) { int n = n0 + bn + i; Bs[bk][bn + i] = (n < N) ? B[(size_t)(k0 + bk) * ldb + n] : 0.f; }
        __syncthreads();
#pragma unroll
        for (int kk = 0; kk < 16; ++kk) {
            float a[8], b[8];
#pragma unroll
            for (int i = 0; i < 8; ++i) a[i] = As[kk][ty * 8 + i];
#pragma unroll
            for (int j = 0; j < 8; ++j) b[j] = Bs[kk][tx * 8 + j];
#pragma unroll
            for (int i = 0; i < 8; ++i)
#pragma unroll
                for (int j = 0; j < 8; ++j) acc[i][j] += a[i] * b[j];
        }
        __syncthreads();
    }
#pragma unroll
    for (int i = 0; i < 8; ++i) {
        int m = m0 + ty * 8 + i;
#pragma unroll
        for (int j = 0; j < 8; ++j) {
            int n = n0 + tx * 8 + j;
            if (n < N) {
                float v = acc[i][j];
                if (RES) v += R[(size_t)m * ldr + n];
                stC(C + (size_t)m * ldc + n, v);
            }
        }
    }
}

struct QKV {
    bf16_t *qA, *kA, *vA, *qB, *kB, *vB, *qC, *kC, *vC, *qD, *kD, *vD;
};
struct PostArgs {
    const bf16_t* z; QKV o; Tables tb;
    const float *g_qn, *g_kn, *g_cq, *g_ckv;
    float *cqn, *ckvn;
};

__global__ void __launch_bounds__(256) k_post_naive(PostArgs a) {
    __shared__ float zr[NZ];
    __shared__ float hs[8];
    const int t = blockIdx.x, tid = threadIdx.x;
    const int b = t / SEQ, s = t % SEQ;
    for (int i = tid; i < NZ; i += 256) zr[i] = bf2f(a.z[(size_t)t * NZ + i]);
    __syncthreads();
    if (tid < 8) {
        int base, n;
        if (tid < 4) { base = 512 + tid * 64; n = 64; }
        else if (tid < 6) { base = 768 + (tid - 4) * 64; n = 64; }
        else if (tid == 6) { base = 1536; n = 256; }
        else { base = 1792; n = 128; }
        float ss = 0.f;
        for (int i = 0; i < n; ++i) ss += zr[base + i] * zr[base + i];
        hs[tid] = rsqrtf(ss / (float)n + 1e-6f);
    }
    __syncthreads();
    const float scA = 0.125f * LOG2E;
    const float scD = 0.10206207261596575f * LOG2E;
    for (int mix = 0; mix < 2; ++mix) {
        const int zb = mix == 0 ? 0 : 1024;
        bf16_t* qo = mix == 0 ? a.o.qA : a.o.qC;
        bf16_t* ko = mix == 0 ? a.o.kA : a.o.kC;
        bf16_t* vo = mix == 0 ? a.o.vA : a.o.vC;
        for (int i = tid; i < 128; i += 256) {
            int h = i / 32, j = i % 32;
            float x1 = zr[zb + h * 64 + j], x2 = zr[zb + h * 64 + 32 + j];
            float c = a.tb.cos1[s * 32 + j], sn = a.tb.sin1[s * 32 + j];
            size_t ob = ((size_t)(b * 4 + h) * SEQ + s) * 64;
            qo[ob + j] = f2bf((x1 * c - x2 * sn) * scA);
            qo[ob + 32 + j] = f2bf((x2 * c + x1 * sn) * scA);
        }
        for (int i = tid; i < 64; i += 256) {
            int h = i / 32, j = i % 32;
            float x1 = zr[zb + 256 + h * 64 + j], x2 = zr[zb + 256 + h * 64 + 32 + j];
            float c = a.tb.cos1[s * 32 + j], sn = a.tb.sin1[s * 32 + j];
            size_t ob = ((size_t)(b * 2 + h) * SEQ + s) * 64;
            ko[ob + j] = f2bf(x1 * c - x2 * sn);
            ko[ob + 32 + j] = f2bf(x2 * c + x1 * sn);
        }
        for (int i = tid; i < 128; i += 256) {
            int h = i / 64, j = i % 64;
            vo[((size_t)(b * 2 + h) * SEQ + s) * 64 + j] = f2bf(zr[zb + 384 + i]);
        }
    }
    {
        const int row = s / 64, col = s % 64;
        for (int i = tid; i < 192; i += 256) {
            int hh = i / 32, r = i % 32, half = r / 16, j = r % 16;
            bool isq = hh < 4;
            int zb = isq ? 512 + hh * 64 : 768 + (hh - 4) * 64;
            const float* gn = isq ? a.g_qn : a.g_kn;
            float rstd = hs[hh];
            int d1 = half * 32 + j, d2 = half * 32 + 16 + j;
            float x1 = zr[zb + d1] * rstd * gn[d1], x2 = zr[zb + d2] * rstd * gn[d2];
            float c, sn;
            if (half == 0) { c = a.tb.cosr[row * 16 + j]; sn = a.tb.sinr[row * 16 + j]; }
            else { c = a.tb.cosc[col * 16 + j]; sn = a.tb.sinc[col * 16 + j]; }
            float o1 = x1 * c - x2 * sn, o2 = x2 * c + x1 * sn;
            if (isq) {
                size_t ob = ((size_t)(b * 4 + hh) * SEQ + s) * 64;
                a.o.qB[ob + d1] = f2bf(o1 * scA); a.o.qB[ob + d2] = f2bf(o2 * scA);
            } else {
                size_t ob = ((size_t)(b * 2 + (hh - 4)) * SEQ + s) * 64;
                a.o.kB[ob + d1] = f2bf(o1); a.o.kB[ob + d2] = f2bf(o2);
            }
        }
        for (int i = tid; i < 128; i += 256) {
            int h = i / 64, j = i % 64;
            a.o.vB[((size_t)(b * 2 + h) * SEQ + s) * 64 + j] = f2bf(zr[896 + i]);
        }
    }
    for (int i = tid; i < 256; i += 256) a.cqn[(size_t)t * 256 + i] = zr[1536 + i] * hs[6] * a.g_cq[i];
    for (int i = tid; i < 128; i += 256) a.ckvn[(size_t)t * 128 + i] = zr[1792 + i] * hs[7] * a.g_ckv[i];
    for (int i = tid; i < 16; i += 256) {
        float x1 = zr[1920 + i], x2 = zr[1920 + 16 + i];
        float c = a.tb.cosm[s * 16 + i], sn = a.tb.sinm[s * 16 + i];
        bf16_t o1 = f2bf(x1 * c - x2 * sn), o2 = f2bf(x2 * c + x1 * sn);
        for (int h = 0; h < 4; ++h) {
            size_t ob = ((size_t)(b * 4 + h) * SEQ + s) * 96;
            a.o.kD[ob + 64 + i] = o1; a.o.kD[ob + 80 + i] = o2;
        }
    }
    (void)scD;
}

__global__ void __launch_bounds__(256) k_post_mla(const float* __restrict__ qfull, const float* __restrict__ kvfull, QKV o, Tables tb) {
    const int t = blockIdx.x, tid = threadIdx.x;
    const int b = t / SEQ, s = t % SEQ;
    const float scD = 0.10206207261596575f * LOG2E;
    {
        int h = tid / 64, j = tid % 64;
        o.qD[((size_t)(b * 4 + h) * SEQ + s) * 96 + j] = f2bf(qfull[(size_t)t * 384 + h * 96 + j] * scD);
    }
    if (tid < 64) {
        int h = tid / 16, j = tid % 16;
        float x1 = qfull[(size_t)t * 384 + h * 96 + 64 + j], x2 = qfull[(size_t)t * 384 + h * 96 + 80 + j];
        float c = tb.cosm[s * 16 + j], sn = tb.sinm[s * 16 + j];
        size_t ob = ((size_t)(b * 4 + h) * SEQ + s) * 96;
        o.qD[ob + 64 + j] = f2bf((x1 * c - x2 * sn) * scD);
        o.qD[ob + 80 + j] = f2bf((x2 * c + x1 * sn) * scD);
    }
    {
        int h = tid / 64, j = tid % 64;
        o.kD[((size_t)(b * 4 + h) * SEQ + s) * 96 + j] = f2bf(kvfull[(size_t)t * 512 + h * 128 + j]);
        o.vD[((size_t)(b * 4 + h) * SEQ + s) * 64 + j] = f2bf(kvfull[(size_t)t * 512 + h * 128 + 64 + j]);
    }
}

template <int DK, int MODE>
__global__ void __launch_bounds__(256) k_attn_naive(const bf16_t* __restrict__ Q, const bf16_t* __restrict__ K, const bf16_t* __restrict__ V,
                                                    const float* __restrict__ sink, bf16_t* __restrict__ O, int H, int KV, int ocol) {
    const int wave = threadIdx.x >> 6, lane = threadIdx.x & 63;
    const int gq = blockIdx.x * 4 + wave;
    const int s = gq % SEQ, bh = gq / SEQ, h = bh % H, b = bh / H;
    const int kvh = h / (H / KV);
    const bf16_t* qrow = Q + (size_t)gq * DK;
    const bf16_t* Kb = K + (size_t)(b * KV + kvh) * SEQ * DK;
    const bf16_t* Vb = V + (size_t)(b * KV + kvh) * SEQ * 64;
    const int sub = lane & 7, grp = lane >> 3;
    constexpr int NCH = DK / 8;
    float q0[8], q1[8];
    {
        uint4 r = *(const uint4*)(qrow + sub * 8);
        const bf16_t* p = (const bf16_t*)&r;
#pragma unroll
        for (int i = 0; i < 8; ++i) q0[i] = bf2f(p[i]);
        const bool has1 = (NCH > 8) && (sub + 8 < NCH);
        uint4 r1 = make_uint4(0, 0, 0, 0);
        if (has1) r1 = *(const uint4*)(qrow + (sub + 8) * 8);
        const bf16_t* p1 = (const bf16_t*)&r1;
#pragma unroll
        for (int i = 0; i < 8; ++i) q1[i] = bf2f(p1[i]);
    }
    float m = -1e30f, l = 0.f, acc[8];
#pragma unroll
    for (int i = 0; i < 8; ++i) acc[i] = 0.f;
    if (MODE == 1 && grp == 0) { m = sink[h] * LOG2E; l = 1.f; }
    const int nk = MODE == 0 ? SEQ : (MODE == 1 ? 257 : 387);
    for (int base = 0; base < nk; base += 8) {
        const int kk = base + grp;
        bool valid = kk < nk;
        int tok;
        if (MODE == 0) tok = kk;
        else if (MODE == 1) tok = s - 128 + kk;
        else { int p = kk / 129, j = kk % 129; int r = p == 0 ? 1 : (p == 1 ? 4 : 16); tok = s + (j - 64) * r; }
        valid = valid && tok >= 0 && tok < SEQ;
        float sc = 0.f;
        if (valid) {
            uint4 r = *(const uint4*)(Kb + (size_t)tok * DK + sub * 8);
            const bf16_t* p = (const bf16_t*)&r;
#pragma unroll
            for (int i = 0; i < 8; ++i) sc += q0[i] * bf2f(p[i]);
            if (NCH > 8 && sub + 8 < NCH) {
                uint4 r1 = *(const uint4*)(Kb + (size_t)tok * DK + (sub + 8) * 8);
                const bf16_t* p1 = (const bf16_t*)&r1;
#pragma unroll
                for (int i = 0; i < 8; ++i) sc += q1[i] * bf2f(p1[i]);
            }
        }
        sc += __shfl_xor(sc, 1); sc += __shfl_xor(sc, 2); sc += __shfl_xor(sc, 4);
        if (valid) {
            float mn = fmaxf(m, sc);
            float f = exp2f(m - mn), p = exp2f(sc - mn);
            uint4 r = *(const uint4*)(Vb + (size_t)tok * 64 + sub * 8);
            const bf16_t* pv = (const bf16_t*)&r;
            l = l * f + p;
#pragma unroll
            for (int i = 0; i < 8; ++i) acc[i] = acc[i] * f + p * bf2f(pv[i]);
            m = mn;
        }
    }
    float M = m;
    M = fmaxf(M, __shfl_xor(M, 8)); M = fmaxf(M, __shfl_xor(M, 16)); M = fmaxf(M, __shfl_xor(M, 32));
    float f = exp2f(m - M);
    l *= f;
    l += __shfl_xor(l, 8); l += __shfl_xor(l, 16); l += __shfl_xor(l, 32);
#pragma unroll
    for (int i = 0; i < 8; ++i) {
        float v = acc[i] * f;
        v += __shfl_xor(v, 8); v += __shfl_xor(v, 16); v += __shfl_xor(v, 32);
        acc[i] = v;
    }
    if (grp == 0) {
        const int t = b * SEQ + s;
        float inv = 1.f / l;
#pragma unroll
        for (int i = 0; i < 8; ++i) O[(size_t)t * DM + ocol + h * 64 + sub * 8 + i] = f2bf(acc[i] * inv);
    }
}

__global__ void __launch_bounds__(64) k_peer_topk_naive(const bf16_t* __restrict__ qp, const float* __restrict__ subk  ,
                                                        int* __restrict__ eidx, float* __restrict__ gate) {
    __shared__ float qs[256];
    __shared__ float s12[2][16];
    __shared__ int i12[2][16];
    const int t = blockIdx.x >> 3, h = blockIdx.x & 7, lane = threadIdx.x;
    for (int i = lane; i < 256; i += 64) qs[i] = bf2f(qp[(size_t)t * 2048 + h * 256 + i]);
    __syncthreads();
    float sc[2][2];
#pragma unroll
    for (int c = 0; c < 2; ++c)
#pragma unroll
        for (int u = 0; u < 2; ++u) {
            int n = lane + 64 * u;
            const float* kr = subk + ((size_t)(h * 2 + c) * 128 + n) * 128;
            float a = 0.f;
            for (int d = 0; d < 128; ++d) a += qs[c * 128 + d] * kr[d];
            sc[c][u] = a;
        }
#pragma unroll
    for (int c = 0; c < 2; ++c) {
        for (int r = 0; r < 16; ++r) {
            float bv; int bi;
            if (sc[c][0] >= sc[c][1]) { bv = sc[c][0]; bi = lane; } else { bv = sc[c][1]; bi = lane + 64; }
#pragma unroll
            for (int o = 32; o >= 1; o >>= 1) {
                float ov = __shfl_xor(bv, o); int oi = __shfl_xor(bi, o);
                if (ov > bv || (ov == bv && oi < bi)) { bv = ov; bi = oi; }
            }
            if (bi == lane) sc[c][0] = -3e38f;
            if (bi == lane + 64) sc[c][1] = -3e38f;
            if (lane == 0) { s12[c][r] = bv; i12[c][r] = bi; }
        }
    }
    __syncthreads();
    float cv[4]; int ci[4];
#pragma unroll
    for (int u = 0; u < 4; ++u) {
        int id = lane + 64 * u;
        cv[u] = s12[0][id / 16] + s12[1][id % 16];
        ci[u] = i12[0][id / 16] * 128 + i12[1][id % 16];
    }
    float best = 0.f; int be = 0;
    for (int r = 0; r < 16; ++r) {
        float bv = cv[0]; int bu = 0;
#pragma unroll
        for (int u = 1; u < 4; ++u) if (cv[u] > bv) { bv = cv[u]; bu = u; }
        int bid = lane + 64 * bu;
#pragma unroll
        for (int o = 32; o >= 1; o >>= 1) {
            float ov = __shfl_xor(bv, o); int oi = __shfl_xor(bid, o);
            if (ov > bv || (ov == bv && oi < bid)) { bv = ov; bid = oi; }
        }
        int e = 0;
#pragma unroll
        for (int u = 0; u < 4; ++u) if (bid == lane + 64 * u) { cv[u] = -3e38f; e = ci[u]; }
        e = __shfl(e, bid & 63);
        if (lane == r) { best = bv; be = e; }
    }
    float mx = lane < 16 ? best : -3e38f;
    mx = wave_max(mx);
    float ex = lane < 16 ? expf(best - mx) : 0.f;
    float sm = wave_sum(ex);
    if (lane < 16) {
        eidx[(size_t)t * 128 + h * 16 + lane] = be;
        gate[(size_t)t * 128 + h * 16 + lane] = ex / sm;
    }
}

__global__ void __launch_bounds__(256) k_peer_expert_naive(const float* __restrict__ hn, const int* __restrict__ eidx, const float* __restrict__ gate,
                                                           const float* __restrict__ ut, const float* __restrict__ vt, float* __restrict__ x) {
    __shared__ float hs[DM];
    __shared__ float wg[128];
    __shared__ int es[128];
    const int t = blockIdx.x, tid = threadIdx.x, wave = tid >> 6, lane = tid & 63;
    for (int i = tid; i < DM; i += 256) hs[i] = hn[(size_t)t * DM + i];
    if (tid < 128) es[tid] = eidx[(size_t)t * 128 + tid];
    __syncthreads();
    for (int p = wave * 32; p < wave * 32 + 32; ++p) {
        const float* ur = ut + (size_t)es[p] * DM;
        float a = 0.f;
#pragma unroll
        for (int i = 0; i < 16; ++i) a += ur[lane + 64 * i] * hs[lane + 64 * i];
        a = wave_sum(a);
        if (lane == 0) {
            float ge = 0.5f * a * (1.f + erff(a * 0.70710678118654752f));
            wg[p] = gate[(size_t)t * 128 + p] * ge;
        }
    }
    __syncthreads();
    float o[4] = {0.f, 0.f, 0.f, 0.f};
    for (int p = 0; p < 128; ++p) {
        const float* vr = vt + (size_t)es[p] * DM;
        float w = wg[p];
#pragma unroll
        for (int i = 0; i < 4; ++i) o[i] += w * vr[tid + 256 * i];
    }
#pragma unroll
    for (int i = 0; i < 4; ++i) x[(size_t)t * DM + tid + 256 * i] += o[i];
}

using bf16x8 = __attribute__((ext_vector_type(8))) short;
using s16x4 = __attribute__((ext_vector_type(4))) short;
using f32x16 = __attribute__((ext_vector_type(16))) float;
typedef __attribute__((ext_vector_type(2))) __bf16 bf16x2_t;

#define NW 8
#define NBLK_THREADS 512
#define CT_STRIDE 260
#define QST 264
#define TOPK_STASH (256 * QST * 2)
#define LDS_BYTES (TOPK_STASH + NW * 2304)

__device__ __forceinline__ unsigned cvtpk(float lo, float hi) {
    unsigned r; asm("v_cvt_pk_bf16_f32 %0, %1, %2" : "=v"(r) : "v"(lo), "v"(hi)); return r;
}
__device__ __forceinline__ int tid_opaque() { int t = threadIdx.x; asm volatile("" : "+v"(t)); return t; }
__device__ __forceinline__ int crow(int i, int hh) { return (i & 3) + 8 * (i >> 2) + 4 * hh; }
__device__ __forceinline__ float xhalf(float v) { return __shfl_xor(v, 32); }
__device__ __forceinline__ float xhalf_max(float v) { auto rr = __builtin_amdgcn_permlane32_swap(__float_as_uint(v), __float_as_uint(v), false, false); return fmaxf(__uint_as_float(rr[0]), __uint_as_float(rr[1])); }
__device__ __forceinline__ float xhalf_sum(float v) { auto rr = __builtin_amdgcn_permlane32_swap(__float_as_uint(v), __float_as_uint(v), false, false); return __uint_as_float(rr[0]) + __uint_as_float(rr[1]); }

struct P {
    const float *x_in, *g_mix, *w_in, *win_sink, *ax_q_norm, *ax_k_norm, *mla_q_norm, *mla_kv_norm, *mla_w_uq, *mla_w_ukv, *g_group, *w_out,
        *g_ffn, *peer_w_q, *peer_sub_keys, *peer_u, *peer_v, *g_final;
    float* out;
    float* x; bf16_t* hnb; bf16_t* zb; QKV q; bf16_t* ob; bf16_t* qp; int* eidx; float* gate;
    bf16_t *cqn, *ckvn, *qfull, *kvfull;
    bf16_t *winT, *woutT, *wqT, *subk, *wuqT, *wukvT;
    unsigned char *u8, *v8; float *su, *sv; float* ssq2; bf16_t* xb2; float* ssqd;
    Tables tb;
    unsigned* bar;
    int flags; int pad0;
};
typedef const P __attribute__((address_space(4))) PC;
__device__ __forceinline__ PC* kargs() { PC* q = (PC*)__builtin_amdgcn_kernarg_segment_ptr(); asm volatile("" : "+s"(q)); return q; }

struct EpiStoreBf16 {
    bf16_t* C; int ldc; int N;
    __device__ __forceinline__ void operator()(const f32x16 (&acc)[2][2], int mbase, int nbase, int r32, int hh) const {
#pragma unroll
        for (int mt = 0; mt < 2; ++mt)
#pragma unroll
            for (int nt = 0; nt < 2; ++nt) {
                const int n = nbase + nt * 32 + r32;
                if (n < N) {
#pragma unroll
                    for (int i = 0; i < 16; ++i) {
                        const int m = mbase + mt * 32 + crow(i, hh);
                        C[(size_t)m * ldc + n] = f2bf(acc[mt][nt][i]);
                    }
                }
            }
    }
};
struct EpiResidNorm {
    float* X; int ldx; bf16_t* XB; float* ssq;
    __device__ __forceinline__ void operator()(const f32x16 (&acc)[2][2], int mbase, int nbase, int r32, int hh) const {
#pragma unroll
        for (int mt = 0; mt < 2; ++mt) {
#pragma unroll
            for (int i = 0; i < 16; ++i) {
                const int m = mbase + mt * 32 + crow(i, hh);
                float sq = 0.f;
#pragma unroll
                for (int nt = 0; nt < 2; ++nt) {
                    const int n = nbase + nt * 32 + r32;
                    float* px = X + (size_t)m * ldx + n;
                    const float v = *px + acc[mt][nt][i];
                    *px = v;
                    XB[(size_t)m * ldx + n] = f2bf(v);
                    sq += v * v;
                }
                sq += __shfl_xor(sq, 1); sq += __shfl_xor(sq, 2); sq += __shfl_xor(sq, 4); sq += __shfl_xor(sq, 8); sq += __shfl_xor(sq, 16);
                if (r32 == 0) ssq[(size_t)m * 16 + (nbase >> 6)] = sq;
            }
        }
    }
};
struct EpiStoreBf16RowNorm {
    bf16_t* C; int ldc; const float* ssq;
    __device__ __forceinline__ void operator()(const f32x16 (&acc)[2][2], int mbase, int nbase, int r32, int hh) const {
#pragma unroll
        for (int mt = 0; mt < 2; ++mt)
#pragma unroll
            for (int i = 0; i < 16; ++i) {
                const int m = mbase + mt * 32 + crow(i, hh);
                const float4 q0 = *(const float4*)(ssq + (size_t)m * 16), q1 = *(const float4*)(ssq + (size_t)m * 16 + 4);
                const float4 q2 = *(const float4*)(ssq + (size_t)m * 16 + 8), q3 = *(const float4*)(ssq + (size_t)m * 16 + 12);
                const float tot = (((q0.x + q0.y) + (q0.z + q0.w)) + ((q1.x + q1.y) + (q1.z + q1.w))) + (((q2.x + q2.y) + (q2.z + q2.w)) + ((q3.x + q3.y) + (q3.z + q3.w)));
                const float r = rsqrtf(tot * (1.f / DM) + 1e-6f);
#pragma unroll
                for (int nt = 0; nt < 2; ++nt) C[(size_t)m * ldc + nbase + nt * 32 + r32] = f2bf(acc[mt][nt][i] * r);
            }
    }
};
struct EpiResidF32 {
    float* X; int ldx;
    __device__ __forceinline__ void operator()(const f32x16 (&acc)[2][2], int mbase, int nbase, int r32, int hh) const {
#pragma unroll
        for (int mt = 0; mt < 2; ++mt)
#pragma unroll
            for (int nt = 0; nt < 2; ++nt) {
                const int n = nbase + nt * 32 + r32;
#pragma unroll
                for (int i = 0; i < 16; ++i) {
                    const int m = mbase + mt * 32 + crow(i, hh);
                    float* p = X + (size_t)m * ldx + n;
                    *p = *p + acc[mt][nt][i];
                }
            }
    }
};

__device__ __forceinline__ void glds16(const void* gsrc, unsigned lds_dst) {
    unsigned keep;
    asm volatile("s_mov_b32 %0, m0\n\ts_mov_b32 m0, %2\n\ts_nop 0\n\tglobal_load_lds_dwordx4 %1, off\n\ts_mov_b32 m0, %0" : "=&s"(keep) : "v"(gsrc), "s"(lds_dst) : "memory");
}

template <class Epi>
__device__ __forceinline__ void gemm_tile(const bf16_t* __restrict__ X, int ldx, const bf16_t* __restrict__ W, int ldw, int K, int m0, int n0, int N,
                                          char* lds, const Epi& epi) {
    const int tid = tid_opaque(), lane = tid & 63, wave = tid >> 6;
    const int wm = wave >> 1, wn = wave & 1;
    const int r32 = lane & 31, hh = lane >> 5;
    const char* xsrc[4]; const char* wsrc[4];
#pragma unroll
    for (int j = 0; j < 4; ++j) {
        const int row = (wave * 4 + j) * 8 + (lane >> 3), slot = lane & 7;
        const int c = slot ^ ((row >> 1) & 7);
        xsrc[j] = (const char*)(X + (size_t)(m0 + row) * ldx + c * 8);
        int n = n0 + row; n = n < N ? n : N - 1;
        wsrc[j] = (const char*)(W + (size_t)n * ldw + c * 8);
    }
    const unsigned lbase = (unsigned)(uintptr_t)lds;
    const unsigned wpiece = __builtin_amdgcn_readfirstlane(wave) * 4096u;
    f32x16 acc[2][2];
#pragma unroll
    for (int a = 0; a < 2; ++a)
#pragma unroll
        for (int b = 0; b < 2; ++b)
#pragma unroll
            for (int i = 0; i < 16; ++i) acc[a][b][i] = 0.f;
    const int nk = K >> 6;
#define GDMA(KT, BUF) do { const unsigned _d = lbase + (BUF) * 32768u + wpiece; const int _ko = (KT) * 128; \
        glds16(xsrc[0] + _ko, _d); glds16(xsrc[1] + _ko, _d + 1024u); glds16(xsrc[2] + _ko, _d + 2048u); glds16(xsrc[3] + _ko, _d + 3072u); \
        glds16(wsrc[0] + _ko, _d + 16384u); glds16(wsrc[1] + _ko, _d + 17408u); glds16(wsrc[2] + _ko, _d + 18432u); glds16(wsrc[3] + _ko, _d + 19456u); } while (0)
    GDMA(0, 0);
    asm volatile("s_waitcnt vmcnt(0)" ::: "memory");
    __syncthreads();
    for (int kt = 0; kt < nk; ++kt) {
        if (kt + 1 < nk) GDMA(kt + 1, (kt + 1) & 1);
        const char* xs = lds + (kt & 1) * 32768; const char* ws = xs + 16384;
#pragma unroll
        for (int ks = 0; ks < 4; ++ks) {
            bf16x8 xf[2], wf[2];
#pragma unroll
            for (int mt = 0; mt < 2; ++mt) { const int r = wm * 64 + mt * 32 + r32; xf[mt] = *(const bf16x8*)(xs + r * 128 + (((ks * 2 + hh) ^ ((r >> 1) & 7)) << 4)); }
#pragma unroll
            for (int nt = 0; nt < 2; ++nt) { const int r = wn * 64 + nt * 32 + r32; wf[nt] = *(const bf16x8*)(ws + r * 128 + (((ks * 2 + hh) ^ ((r >> 1) & 7)) << 4)); }
#pragma unroll
            for (int mt = 0; mt < 2; ++mt)
#pragma unroll
                for (int nt = 0; nt < 2; ++nt) acc[mt][nt] = __builtin_amdgcn_mfma_f32_32x32x16_bf16(xf[mt], wf[nt], acc[mt][nt], 0, 0, 0);
        }
        asm volatile("s_waitcnt vmcnt(0)" ::: "memory");
        __syncthreads();
    }
#undef GDMA
    epi(acc, m0 + wm * 64, n0 + wn * 64, r32, hh);
}

__device__ __forceinline__ void tile_map(int tile, int ntm, int ntn, int& mt, int& nt) {
    if ((ntn & 7) == 0) {
        const int G = gridDim.x;
        const int round = tile / G, bi = tile % G;
        const int x = bi & 7, j = bi >> 3;
        const int per = G >> 3;
        const int id = (round * 8 + x) * per + j;
        const int st = id >> 6, in = id & 63;
        const int snt = ntn >> 3;
        const int sm = st / snt, sn = st % snt;
        mt = sm * 8 + (in >> 3); nt = sn * 8 + (in & 7);
    } else { mt = tile / ntn; nt = tile % ntn; }
}

__device__ __forceinline__ void gemm_mainloop(const bf16_t* __restrict__ X, int ldx, const bf16_t* __restrict__ W, int ldw, int K, int m0, int n0, int N,
                                              char* lds, f32x16 (&acc)[2][4]) {
    const int tid = tid_opaque(), lane = tid & 63, wave = tid >> 6;
    const int wm = wave >> 1, wn = wave & 1;
    const int r32 = lane & 31, hh = lane >> 5;
    const char* xsrc[4]; const char* wsrc[4];
#pragma unroll
    for (int j = 0; j < 4; ++j) {
        const int row = (wave * 4 + j) * 8 + (lane >> 3), slot = lane & 7;
        const int c = slot ^ ((row >> 1) & 7);
        xsrc[j] = (const char*)(X + (size_t)(m0 + row) * ldx + c * 8);
        int n = n0 + row; n = n < N ? n : N - 1;
        wsrc[j] = (const char*)(W + (size_t)n * ldw + c * 8);
    }
    const unsigned lbase = (unsigned)(uintptr_t)lds;
    const unsigned wpiece = __builtin_amdgcn_readfirstlane(wave) * 4096u;
#pragma unroll
    for (int a = 0; a < 2; ++a)
#pragma unroll
        for (int b = 0; b < 4; ++b)
#pragma unroll
            for (int i = 0; i < 16; ++i) acc[a][b][i] = 0.f;
    const int nk = K >> 6;
#define GDMA(KT, BUF) do { const unsigned _d = lbase + (BUF) * 65536u + wpiece; const int _ko = (KT) * 128; \
        glds16(xsrc[0] + _ko, _d); glds16(xsrc[1] + _ko, _d + 1024u); glds16(xsrc[2] + _ko, _d + 2048u); glds16(xsrc[3] + _ko, _d + 3072u); \
        glds16(wsrc[0] + _ko, _d + 32768u); glds16(wsrc[1] + _ko, _d + 33792u); glds16(wsrc[2] + _ko, _d + 34816u); glds16(wsrc[3] + _ko, _d + 35840u); } while (0)
    GDMA(0, 0);
    asm volatile("s_waitcnt vmcnt(0)" ::: "memory");
    __syncthreads();
    for (int kt = 0; kt < nk; ++kt) {
        if (kt + 1 < nk) GDMA(kt + 1, (kt + 1) & 1);
        const char* xs = lds + (kt & 1) * 65536; const char* ws = xs + 32768;
#pragma unroll
        for (int ks = 0; ks < 4; ++ks) {
            bf16x8 xf[2], wf[4];
#pragma unroll
            for (int mt = 0; mt < 2; ++mt) { const int r = wm * 64 + mt * 32 + r32; xf[mt] = *(const bf16x8*)(xs + r * 128 + (((ks * 2 + hh) ^ ((r >> 1) & 7)) << 4)); }
#pragma unroll
            for (int nt = 0; nt < 4; ++nt) { const int r = wn * 128 + nt * 32 + r32; wf[nt] = *(const bf16x8*)(ws + r * 128 + (((ks * 2 + hh) ^ ((r >> 1) & 7)) << 4)); }
#pragma unroll
            for (int mt = 0; mt < 2; ++mt)
#pragma unroll
                for (int nt = 0; nt < 4; ++nt) acc[mt][nt] = __builtin_amdgcn_mfma_f32_32x32x16_bf16(xf[mt], wf[nt], acc[mt][nt], 0, 0, 0);
        }
        asm volatile("s_waitcnt vmcnt(0)" ::: "memory");
        __syncthreads();
    }
#undef GDMA
}

template <class Epi, int KGROUP>
__device__ __forceinline__ void gemm_tile_rows(const bf16_t* __restrict__ X, int ldx, const bf16_t* __restrict__ W, int ldw, int K, int m0, int n0, int N,
                                               char* lds, const Epi& epi) {
    const int tid = tid_opaque(), lane = tid & 63, wave = tid >> 6;
    const int wm = wave >> 1, wn = wave & 1;
    const int r32 = lane & 31, hh = lane >> 5;
    f32x16 acc[2][4];
    gemm_mainloop(X, ldx, W, ldw, K, m0, n0, N, lds, acc);
    float* ct = (float*)lds;
#pragma unroll
    for (int hsel = 0; hsel < 2; ++hsel) {
        if ((wm >> 1) == hsel) {
#pragma unroll
            for (int mt = 0; mt < 2; ++mt)
#pragma unroll
                for (int nt = 0; nt < 4; ++nt)
#pragma unroll
                    for (int i = 0; i < 16; ++i)
                        ct[((wm & 1) * 64 + mt * 32 + crow(i, hh)) * CT_STRIDE + wn * 128 + nt * 32 + r32] = acc[mt][nt][i];
        }
        __syncthreads();
        epi.begin(ct, m0 + hsel * 128, n0, tid);
#pragma unroll
        for (int pass = 0; pass < 8; ++pass) {
            const int ch = pass & 3, row = (pass >> 2) * 64 + (tid >> 3), c = tid & 7;
            epi.chunk(ct + row * CT_STRIDE + ch * 64 + c * 8, ct + row * CT_STRIDE, m0 + hsel * 128 + row, n0 + ch * 64, c);
        }
        __syncthreads();
    }
}

template <class Epi, int KGROUP>
__device__ __forceinline__ void gemm_phase_rows(const bf16_t* X, int ldx, const bf16_t* W, int ldw, int M, int N, int K, char* lds, const Epi& epi) {
    const int ntm = M >> 8, ntn = (N + 255) >> 8, nt_tot = ntm * ntn;
    for (int tile = blockIdx.x; tile < nt_tot; tile += gridDim.x) {
        int mt, nt;
        if ((gridDim.x & 63) == 0 && (ntn & 7) == 0 && (nt_tot % gridDim.x) == 0) tile_map(tile, ntm, ntn, mt, nt);
        else { mt = tile / ntn; nt = tile % ntn; }
        if (mt < ntm && nt < ntn) gemm_tile_rows<Epi, KGROUP>(X, ldx, W, ldw, K, mt * 256, nt * 256, N, lds, epi);
    }
}

__device__ __forceinline__ uint4 pack8(const float4& a, const float4& b) { return make_uint4(cvtpk(a.x, a.y), cvtpk(a.z, a.w), cvtpk(b.x, b.y), cvtpk(b.z, b.w)); }
__device__ __forceinline__ float sum8(float v) { v += __shfl_xor(v, 1); v += __shfl_xor(v, 2); v += __shfl_xor(v, 4); return v; }

struct RowsStoreBf16 {
    bf16_t* C; int ldc; int N;
    __device__ __forceinline__ void table(float*, int, int) const {}
    __device__ __forceinline__ void begin(float*, int, int, int) const {}
    __device__ __forceinline__ void chunk(const float* t, const float* rb, int m, int n, int c) const {
        if (n + 8 * c < N) *(uint4*)(C + (size_t)m * ldc + n + 8 * c) = pack8(*(const float4*)t, *(const float4*)(t + 4));
    }
};
struct RowsResidF32 {
    float* X; int ldx;
    __device__ __forceinline__ void table(float*, int, int) const {}
    __device__ __forceinline__ void begin(float*, int, int, int) const {}
    __device__ __forceinline__ void chunk(const float* t, const float* rb, int m, int n, int c) const {
        float* px = X + (size_t)m * ldx + n + 8 * c;
        float4 v0 = *(const float4*)px, v1 = *(const float4*)(px + 4);
        const float4 a0 = *(const float4*)t, a1 = *(const float4*)(t + 4);
        v0.x += a0.x; v0.y += a0.y; v0.z += a0.z; v0.w += a0.w; v1.x += a1.x; v1.y += a1.y; v1.z += a1.z; v1.w += a1.w;
        *(float4*)px = v0; *(float4*)(px + 4) = v1;
    }
};
struct RowsResidNorm {
    float* X; int ldx; bf16_t* XB; float* ssq;
    __device__ __forceinline__ void table(float*, int, int) const {}
    __device__ __forceinline__ void begin(float*, int, int, int) const {}
    __device__ __forceinline__ void chunk(const float* t, const float* rb, int m, int n, int c) const {
        float* px = X + (size_t)m * ldx + n + 8 * c;
        float4 v0 = *(const float4*)px, v1 = *(const float4*)(px + 4);
        const float4 a0 = *(const float4*)t, a1 = *(const float4*)(t + 4);
        v0.x += a0.x; v0.y += a0.y; v0.z += a0.z; v0.w += a0.w; v1.x += a1.x; v1.y += a1.y; v1.z += a1.z; v1.w += a1.w;
        *(float4*)px = v0; *(float4*)(px + 4) = v1;
        *(uint4*)(XB + (size_t)m * ldx + n + 8 * c) = pack8(v0, v1);
        const float sq = sum8((v0.x * v0.x + v0.y * v0.y) + (v0.z * v0.z + v0.w * v0.w) + (v1.x * v1.x + v1.y * v1.y) + (v1.z * v1.z + v1.w * v1.w));
        if (c == 0) ssq[((size_t)(n >> 8) * T_TOK + m) * 4 + ((n >> 6) & 3)] = sq;
    }
};
struct RowsStoreBf16RowNorm {
    bf16_t* C; int ldc; const float* ssq;
    __device__ __forceinline__ void table(float*, int, int) const {}
    __device__ __forceinline__ void begin(float* ct, int m0, int, int tid) const {
        if (tid < 128) {
            float tot = 0.f;
#pragma unroll
            for (int j = 0; j < 4; ++j) { const float4 q = *(const float4*)(ssq + ((size_t)j * T_TOK + m0 + tid) * 4); tot += (q.x + q.y) + (q.z + q.w); }
            ct[tid * CT_STRIDE + 256] = rsqrtf(tot * (1.f / DM) + 1e-6f);
        }
        __syncthreads();
    }
    __device__ __forceinline__ void chunk(const float* t, const float* rb, int m, int n, int c) const {
        const float r = rb[256];
        const float4 a = *(const float4*)t, b = *(const float4*)(t + 4);
        *(uint4*)(C + (size_t)m * ldc + n + 8 * c) = make_uint4(cvtpk(a.x * r, a.y * r), cvtpk(a.z * r, a.w * r), cvtpk(b.x * r, b.y * r), cvtpk(b.z * r, b.w * r));
    }
};

struct F8 { float4 a, b; };
__device__ __forceinline__ F8 f8_load(const float* p) { F8 r; r.a = *(const float4*)p; r.b = *(const float4*)(p + 4); return r; }
__device__ __forceinline__ F8 f8_shfl_xor(const F8& v, int m) {
    F8 r; r.a.x = __shfl_xor(v.a.x, m); r.a.y = __shfl_xor(v.a.y, m); r.a.z = __shfl_xor(v.a.z, m); r.a.w = __shfl_xor(v.a.w, m);
    r.b.x = __shfl_xor(v.b.x, m); r.b.y = __shfl_xor(v.b.y, m); r.b.z = __shfl_xor(v.b.z, m); r.b.w = __shfl_xor(v.b.w, m); return r;
}
__device__ __forceinline__ float f8_ssq(const F8& v) { return (v.a.x * v.a.x + v.a.y * v.a.y) + (v.a.z * v.a.z + v.a.w * v.a.w) + (v.b.x * v.b.x + v.b.y * v.b.y) + (v.b.z * v.b.z + v.b.w * v.b.w); }
__device__ __forceinline__ uint4 f8_rope_pack(const F8& v, const F8& pv, const F8& cs, const F8& sn, float sg, float sc) {
    return make_uint4(cvtpk((v.a.x * cs.a.x + sg * pv.a.x * sn.a.x) * sc, (v.a.y * cs.a.y + sg * pv.a.y * sn.a.y) * sc),
                      cvtpk((v.a.z * cs.a.z + sg * pv.a.z * sn.a.z) * sc, (v.a.w * cs.a.w + sg * pv.a.w * sn.a.w) * sc),
                      cvtpk((v.b.x * cs.b.x + sg * pv.b.x * sn.b.x) * sc, (v.b.y * cs.b.y + sg * pv.b.y * sn.b.y) * sc),
                      cvtpk((v.b.z * cs.b.z + sg * pv.b.z * sn.b.z) * sc, (v.b.w * cs.b.w + sg * pv.b.w * sn.b.w) * sc));
}
#define QKV_MIX(mi) ((size_t)(mi) * 512 * T_TOK)
#define QKV_K (256 * (size_t)T_TOK)
#define QKV_V (384 * (size_t)T_TOK)
#define QKV_KD (1920 * (size_t)T_TOK)
struct RowsPostZ {
    bf16_t* qkv; const float* tb; const float* g_qn; const float* g_kn; bf16_t* lat; float* ssqd; bf16_t* kD;
    __device__ __forceinline__ void table(float*, int, int) const {}
    __device__ __forceinline__ void begin(float*, int, int, int) const {}
    __device__ __forceinline__ void chunk(const float* t, const float* rb, int m, int n, int c) const {
        const int qc = n >> 6;
        const int b = m / SEQ, s = m % SEQ;
        F8 v = f8_load(t);
        const float scA = 0.125f * LOG2E;
        if (qc < 6 || (qc >= 16 && qc < 22)) {
            const int mi = qc >= 16 ? 2 : 0; const int ql = qc - 8 * mi;
            const F8 pv = f8_shfl_xor(v, 4);
            const int j0 = 8 * (c & 3);
            const F8 cs = f8_load(tb + s * 32 + j0), sn = f8_load(tb + 131072 + s * 32 + j0);
            const size_t off = QKV_MIX(mi) + (ql < 4 ? ((size_t)(b * 4 + ql) * SEQ + s) * 64 : QKV_K + ((size_t)(b * 2 + (ql - 4)) * SEQ + s) * 64);
            *(uint4*)(qkv + off + 8 * c) = f8_rope_pack(v, pv, cs, sn, (c < 4) ? -1.f : 1.f, (ql < 4) ? scA : 1.f);
        } else if (qc == 6 || qc == 7 || qc == 14 || qc == 15 || qc == 22 || qc == 23) {
            *(uint4*)(qkv + QKV_MIX(qc >> 3) + QKV_V + ((size_t)(b * 2 + (qc & 1)) * SEQ + s) * 64 + 8 * c) = pack8(v.a, v.b);
        } else if (qc >= 8 && qc < 14) {
            const bool isq = qc < 12; const int h = isq ? qc - 8 : qc - 12;
            const float r = rsqrtf(sum8(f8_ssq(v)) * (1.f / 64.f) + 1e-6f);
            const F8 gq = f8_load(g_qn + 8 * c), gk = f8_load(g_kn + 8 * c);
            v.a.x *= r * (isq ? gq.a.x : gk.a.x); v.a.y *= r * (isq ? gq.a.y : gk.a.y); v.a.z *= r * (isq ? gq.a.z : gk.a.z); v.a.w *= r * (isq ? gq.a.w : gk.a.w);
            v.b.x *= r * (isq ? gq.b.x : gk.b.x); v.b.y *= r * (isq ? gq.b.y : gk.b.y); v.b.z *= r * (isq ? gq.b.z : gk.b.z); v.b.w *= r * (isq ? gq.b.w : gk.b.w);
            const F8 pv = f8_shfl_xor(v, 2);
            const int jj0 = 8 * (c & 1);
            const int to = (c < 4) ? 393216 + (s >> 6) * 16 : 395264 + (s & 63) * 16;
            const F8 cs = f8_load(tb + to + jj0), sn = f8_load(tb + to + 1024 + jj0);
            const size_t off = QKV_MIX(1) + (isq ? ((size_t)(b * 4 + h) * SEQ + s) * 64 : QKV_K + ((size_t)(b * 2 + h) * SEQ + s) * 64);
            *(uint4*)(qkv + off + 8 * c) = f8_rope_pack(v, pv, cs, sn, (c & 2) ? 1.f : -1.f, isq ? scA : 1.f);
        } else if (qc >= 24 && qc < 30) {
            const float ss = sum8(f8_ssq(v));
            const size_t off = qc < 28 ? (size_t)m * 256 + (qc - 24) * 64 : (size_t)T_TOK * 256 + (size_t)m * 128 + (qc - 28) * 64;
            *(uint4*)(lat + off + 8 * c) = pack8(v.a, v.b);
            if (c == 0) ssqd[(size_t)(qc - 24) * T_TOK + m] = ss;
        } else if (qc == 30) {
            const F8 pv = f8_shfl_xor(v, 2);
            if (c < 4) {
                const int i0 = 8 * (c & 1);
                const F8 cs = f8_load(tb + 262144 + s * 16 + i0), sn = f8_load(tb + 327680 + s * 16 + i0);
                const uint4 w = f8_rope_pack(v, pv, cs, sn, (c & 2) ? 1.f : -1.f, 1.f);
#pragma unroll
                for (int h = 0; h < 4; ++h) *(uint4*)(kD + ((size_t)(b * 4 + h) * SEQ + s) * 96 + 64 + 8 * c) = w;
            }
        }
    }
};
template <int NS, int DIM>
struct RowsStoreBf16Scale {
    bf16_t* C; int ldc; int N; const float* ssq;
    __device__ __forceinline__ void table(float*, int, int) const {}
    __device__ __forceinline__ void begin(float* ct, int m0, int, int tid) const {
        if (tid < 128) {
            float tot = 0.f;
#pragma unroll
            for (int j = 0; j < NS; ++j) tot += ssq[(size_t)j * T_TOK + m0 + tid];
            ct[tid * CT_STRIDE + 256] = rsqrtf(tot * (1.f / DIM) + 1e-6f);
        }
        __syncthreads();
    }
    __device__ __forceinline__ void chunk(const float* t, const float* rb, int m, int n, int c) const {
        const float r = rb[256];
        const float4 a = *(const float4*)t, b = *(const float4*)(t + 4);
        if (n + 8 * c < N) *(uint4*)(C + (size_t)m * ldc + n + 8 * c) = make_uint4(cvtpk(a.x * r, a.y * r), cvtpk(a.z * r, a.w * r), cvtpk(b.x * r, b.y * r), cvtpk(b.z * r, b.w * r));
    }
};

struct RowsPostQ {
    bf16_t* qD; const float* tb; const float* ssq;
    __device__ __forceinline__ void table(float*, int, int) const {}
    __device__ __forceinline__ void begin(float* ct, int m0, int, int tid) const {
        if (tid < 128) {
            const float tot = (ssq[m0 + tid] + ssq[(size_t)T_TOK + m0 + tid]) + (ssq[(size_t)2 * T_TOK + m0 + tid] + ssq[(size_t)3 * T_TOK + m0 + tid]);
            ct[tid * CT_STRIDE + 256] = rsqrtf(tot * (1.f / 256.f) + 1e-6f) * (0.10206207261596575f * LOG2E);
        }
        __syncthreads();
    }
    __device__ __forceinline__ void chunk(const float* t, const float* rb, int m, int n, int c) const {
        if (n >= 384) return;
        const float r = rb[256];
        const int qc = n >> 6, b = m / SEQ, s = m % SEQ;
        F8 v = f8_load(t);
        v.a.x *= r; v.a.y *= r; v.a.z *= r; v.a.w *= r; v.b.x *= r; v.b.y *= r; v.b.z *= r; v.b.w *= r;
        if (qc < 4) {
            *(uint4*)(qD + ((size_t)(b * 4 + qc) * SEQ + s) * 128 + 8 * c) = pack8(v.a, v.b);
        } else {
            const F8 pv = f8_shfl_xor(v, 2);
            const int h = (qc - 4) * 2 + (c >> 2), i0 = 8 * (c & 1);
            const F8 cs = f8_load(tb + 262144 + s * 16 + i0), sn = f8_load(tb + 327680 + s * 16 + i0);
            *(uint4*)(qD + ((size_t)(b * 4 + h) * SEQ + s) * 128 + 64 + 8 * (c & 3)) = f8_rope_pack(v, pv, cs, sn, (c & 2) ? 1.f : -1.f, 1.f);
        }
    }
};
struct RowsPostKV {
    bf16_t* kD; bf16_t* vD; const float* ssq;
    __device__ __forceinline__ void table(float*, int, int) const {}
    __device__ __forceinline__ void begin(float* ct, int m0, int, int tid) const {
        if (tid < 128) ct[tid * CT_STRIDE + 256] = rsqrtf((ssq[m0 + tid] + ssq[(size_t)T_TOK + m0 + tid]) * (1.f / 128.f) + 1e-6f);
        __syncthreads();
    }
    __device__ __forceinline__ void chunk(const float* t, const float* rb, int m, int n, int c) const {
        const float r = rb[256];
        const int qc = n >> 6, h = qc >> 1, b = m / SEQ, s = m % SEQ;
        F8 v = f8_load(t);
        v.a.x *= r; v.a.y *= r; v.a.z *= r; v.a.w *= r; v.b.x *= r; v.b.y *= r; v.b.z *= r; v.b.w *= r;
        const size_t hb = (size_t)(b * 4 + h) * SEQ + s;
        const size_t off = (qc & 1) ? hb * 64 : hb * 96;
        bf16_t* base = (bf16_t*)((qc & 1) ? (size_t)vD : (size_t)kD);
        *(uint4*)(base + off + 8 * c) = pack8(v.a, v.b);
    }
};

template <class Epi>
__device__ __forceinline__ void gemm_phase(const bf16_t* X, int ldx, const bf16_t* W, int ldw, int M, int N, int K, char* lds, const Epi& epi) {
    const int ntm = M >> 7, ntn = (N + 127) >> 7, nt_tot = ntm * ntn;
    for (int tile = blockIdx.x; tile < nt_tot; tile += gridDim.x) {
        int mt, nt;
        if ((gridDim.x & 7) == 0 && (gridDim.x >> 3) * 8 == gridDim.x && ((gridDim.x >> 3) & 63) == 0) tile_map(tile, ntm, ntn, mt, nt);
        else { mt = tile / ntn; nt = tile % ntn; }
        if (mt < ntm && nt < ntn) gemm_tile(X, ldx, W, ldw, K, mt * 128, nt * 128, N, lds, epi);
    }
}

template <int OFF> __device__ __forceinline__ s16x4 tr_read(int vb) {
    s16x4 r; asm volatile("ds_read_b64_tr_b16 %0, %1 offset:%2" : "=&v"(r) : "v"(vb), "i"(OFF) : "memory"); return r;
}
#define VS_BYTES 192

template <int KT2>
__device__ __forceinline__ void pv_sub(f32x16 (&o)[2], const f32x16& p, int vbase) {
    bf16x8 pf[2];
#pragma unroll
    for (int s2 = 0; s2 < 2; ++s2) {
        unsigned a = cvtpk(p[8 * s2 + 0], p[8 * s2 + 1]), b = cvtpk(p[8 * s2 + 2], p[8 * s2 + 3]);
        unsigned c = cvtpk(p[8 * s2 + 4], p[8 * s2 + 5]), d = cvtpk(p[8 * s2 + 6], p[8 * s2 + 7]);
        uint4 w = make_uint4(a, b, c, d);
        pf[s2] = *(bf16x8*)&w;
    }
    {
        s16x4 l00 = tr_read<(KT2 * 32 + 0) * VS_BYTES + 0>(vbase), h00 = tr_read<(KT2 * 32 + 8) * VS_BYTES + 0>(vbase);
        s16x4 l01 = tr_read<(KT2 * 32 + 0) * VS_BYTES + 64>(vbase), h01 = tr_read<(KT2 * 32 + 8) * VS_BYTES + 64>(vbase);
        s16x4 l10 = tr_read<(KT2 * 32 + 16) * VS_BYTES + 0>(vbase), h10 = tr_read<(KT2 * 32 + 24) * VS_BYTES + 0>(vbase);
        s16x4 l11 = tr_read<(KT2 * 32 + 16) * VS_BYTES + 64>(vbase), h11 = tr_read<(KT2 * 32 + 24) * VS_BYTES + 64>(vbase);
        asm volatile("s_waitcnt lgkmcnt(0)" ::: "memory");
        __builtin_amdgcn_sched_barrier(0);
#define PKV(L, H) (bf16x8){L[0], L[1], L[2], L[3], H[0], H[1], H[2], H[3]}
        o[0] = __builtin_amdgcn_mfma_f32_32x32x16_bf16(PKV(l00, h00), pf[0], o[0], 0, 0, 0);
        o[1] = __builtin_amdgcn_mfma_f32_32x32x16_bf16(PKV(l01, h01), pf[0], o[1], 0, 0, 0);
        o[0] = __builtin_amdgcn_mfma_f32_32x32x16_bf16(PKV(l10, h10), pf[1], o[0], 0, 0, 0);
        o[1] = __builtin_amdgcn_mfma_f32_32x32x16_bf16(PKV(l11, h11), pf[1], o[1], 0, 0, 0);
#undef PKV
    }
}


#define PV_LOAD(KT2, VB, F) \
    const s16x4 F##0 = tr_read<((KT2) * 32 + 0) * VS_BYTES + 0>(VB), F##1 = tr_read<((KT2) * 32 + 8) * VS_BYTES + 0>(VB), \
                F##2 = tr_read<((KT2) * 32 + 0) * VS_BYTES + 64>(VB), F##3 = tr_read<((KT2) * 32 + 8) * VS_BYTES + 64>(VB), \
                F##4 = tr_read<((KT2) * 32 + 16) * VS_BYTES + 0>(VB), F##5 = tr_read<((KT2) * 32 + 24) * VS_BYTES + 0>(VB), \
                F##6 = tr_read<((KT2) * 32 + 16) * VS_BYTES + 64>(VB), F##7 = tr_read<((KT2) * 32 + 24) * VS_BYTES + 64>(VB)
#define PKV2(L, H) (bf16x8){L[0], L[1], L[2], L[3], H[0], H[1], H[2], H[3]}
#define PV_MMA(O, P, F) do { bf16x8 _pf0, _pf1; \
        { uint4 _w = make_uint4(cvtpk(P[0], P[1]), cvtpk(P[2], P[3]), cvtpk(P[4], P[5]), cvtpk(P[6], P[7])); _pf0 = *(bf16x8*)&_w; } \
        { uint4 _w = make_uint4(cvtpk(P[8], P[9]), cvtpk(P[10], P[11]), cvtpk(P[12], P[13]), cvtpk(P[14], P[15])); _pf1 = *(bf16x8*)&_w; } \
        O[0] = __builtin_amdgcn_mfma_f32_32x32x16_bf16(PKV2(F##0, F##1), _pf0, O[0], 0, 0, 0); \
        O[1] = __builtin_amdgcn_mfma_f32_32x32x16_bf16(PKV2(F##2, F##3), _pf0, O[1], 0, 0, 0); \
        O[0] = __builtin_amdgcn_mfma_f32_32x32x16_bf16(PKV2(F##4, F##5), _pf1, O[0], 0, 0, 0); \
        O[1] = __builtin_amdgcn_mfma_f32_32x32x16_bf16(PKV2(F##6, F##7), _pf1, O[1], 0, 0, 0); } while (0)

template <int DK, int G, bool WINDOW>
__device__ __forceinline__ void attn_item(const bf16_t* __restrict__ Q, const bf16_t* __restrict__ K, const bf16_t* __restrict__ V, const float* __restrict__ sink,
                                          bf16_t* __restrict__ O, int ocol, int H, int KV, int item, char* lds, int qs = DK) {
    constexpr int KS = DK * 2 + 16;
    constexpr int KCH = DK / 8;
    constexpr int KLD = (128 * KCH) / 512;
    constexpr int QB = 256 / G;
    constexpr int NCH = SEQ / QB;
    constexpr int KBUF = 128 * KS, VBUF = 128 * VS_BYTES;
    const int tid = tid_opaque(), lane = tid & 63, wave = tid >> 6;
    const int r32 = lane & 31, hh = lane >> 5;
    const int chunk = item % NCH, kvh = (item / NCH) % KV, b = item / (NCH * KV);
    const int g = (G == 2) ? (wave >> 2) : 0;
    const int qoff = (G == 2) ? (wave & 3) * 32 : wave * 32;
    const int head = kvh * G + g;
    const int q0 = chunk * QB;
    const int qpos = q0 + qoff + r32;
    bf16x8 qf[DK / 16];
    {
        const bf16_t* qp = Q + ((size_t)(b * H + head) * SEQ + qpos) * qs + hh * 8;
#pragma unroll
        for (int ks = 0; ks < DK / 16; ++ks) qf[ks] = *(const bf16x8*)(qp + ks * 16);
    }
    int kt_lo = 0, kt_hi = SEQ / 128;
    if (WINDOW) { kt_lo = q0 / 128 - 1; if (kt_lo < 0) kt_lo = 0; kt_hi = (q0 + QB) / 128 + 1; if (kt_hi > SEQ / 128) kt_hi = SEQ / 128; }
    const char* Kg = (const char*)(K + (size_t)(b * KV + kvh) * SEQ * DK);
    const char* Vg = (const char*)(V + (size_t)(b * KV + kvh) * SEQ * 64);
    uint4 kr0, kr1, kr2 = make_uint4(0, 0, 0, 0), vr0, vr1;
    const int koff0 = (tid / KCH) * KS + (tid % KCH) * 16;
    const int koff1 = ((tid + 512) / KCH) * KS + ((tid + 512) % KCH) * 16;
    const int koff2 = ((tid + 1024) / KCH) * KS + ((tid + 1024) % KCH) * 16;
    const int voff0 = (tid >> 3) * VS_BYTES + (tid & 7) * 16;
    const int voff1 = ((tid + 512) >> 3) * VS_BYTES + (tid & 7) * 16;
    f32x16 o[2];
#pragma unroll
    for (int d = 0; d < 2; ++d)
#pragma unroll
        for (int i = 0; i < 16; ++i) o[d][i] = 0.f;
    float m = -1e30f, l = 0.f;
    if (WINDOW) { m = sink[head] * LOG2E; l = (hh == 0) ? 1.f : 0.f; }
    const int gg = lane >> 4, li = lane & 15;
    const int vlane = (4 * (gg >> 1) + (li >> 2)) * VS_BYTES + (16 * (gg & 1) + 4 * (li & 3)) * 2;
    char* Kl = lds; char* Vl = lds + 2 * KBUF;
#define AGLOAD(KT) do { const char* _kg = Kg + (size_t)(KT) * 128 * DK * 2; const char* _vg = Vg + (size_t)(KT) * 128 * 128; \
        kr0 = *(const uint4*)(_kg + tid * 16); kr1 = *(const uint4*)(_kg + (tid + 512) * 16); if (KLD > 2) kr2 = *(const uint4*)(_kg + (tid + 1024) * 16); \
        vr0 = *(const uint4*)(_vg + tid * 16); vr1 = *(const uint4*)(_vg + (tid + 512) * 16); } while (0)
#define ASTORE(KB, VB) do { char* _kd = (KB); char* _vd = (VB); *(uint4*)(_kd + koff0) = kr0; *(uint4*)(_kd + koff1) = kr1; if (KLD > 2) *(uint4*)(_kd + koff2) = kr2; \
        *(uint4*)(_vd + voff0) = vr0; *(uint4*)(_vd + voff1) = vr1; } while (0)
    AGLOAD(kt_lo);
    ASTORE(Kl, Vl);
    { const int k1 = kt_lo + 1 < kt_hi ? kt_lo + 1 : kt_lo; AGLOAD(k1); }
    __syncthreads();
    for (int kt = kt_lo; kt < kt_hi; ++kt) {
        const int cur = (kt - kt_lo) & 1;
        ASTORE(Kl + (cur ^ 1) * KBUF, Vl + (cur ^ 1) * VBUF);
        { const int ktn = kt + 2 < kt_hi ? kt + 2 : kt_hi - 1; AGLOAD(ktn); }
        __builtin_amdgcn_sched_barrier(0);
#pragma unroll
        for (int sub = 0; sub < 2; ++sub) {
            const char* kb = Kl + cur * KBUF + sub * 64 * KS;
            f32x16 s0, s1;
#pragma unroll
            for (int i = 0; i < 16; ++i) { s0[i] = 0.f; s1[i] = 0.f; }
#pragma unroll
            for (int ks = 0; ks < DK / 16; ++ks) {
                bf16x8 k0 = *(const bf16x8*)(kb + r32 * KS + (ks * 2 + hh) * 16);
                bf16x8 k1 = *(const bf16x8*)(kb + (32 + r32) * KS + (ks * 2 + hh) * 16);
                s0 = __builtin_amdgcn_mfma_f32_32x32x16_bf16(k0, qf[ks], s0, 0, 0, 0);
                s1 = __builtin_amdgcn_mfma_f32_32x32x16_bf16(k1, qf[ks], s1, 0, 0, 0);
            }
            if (WINDOW) {
                const int kb0 = kt * 128 + sub * 64 + 4 * hh - qpos;
#pragma unroll
                for (int i = 0; i < 16; ++i) {
                    const int d0 = kb0 + (i & 3) + 8 * (i >> 2), d1 = d0 + 32;
                    s0[i] = (d0 > 128 || d0 < -128) ? -1e30f : s0[i];
                    s1[i] = (d1 > 128 || d1 < -128) ? -1e30f : s1[i];
                }
            }
            const int vbase = (int)(size_t)(Vl + cur * VBUF - lds) + sub * 64 * VS_BYTES + vlane;
            PV_LOAD(0, vbase, vfa);
            PV_LOAD(1, vbase, vfb);
            __builtin_amdgcn_sched_barrier(0);
            float tmax = s0[0];
#pragma unroll
            for (int i = 1; i < 16; ++i) tmax = fmaxf(tmax, s0[i]);
#pragma unroll
            for (int i = 0; i < 16; ++i) tmax = fmaxf(tmax, s1[i]);
            tmax = xhalf_max(tmax);
            const float mn = fmaxf(m, tmax);
            const float alpha = __builtin_amdgcn_exp2f(m - mn);
            m = mn;
            float ps = 0.f;
#pragma unroll
            for (int i = 0; i < 16; ++i) { s0[i] = __builtin_amdgcn_exp2f(s0[i] - mn); ps += s0[i]; }
#pragma unroll
            for (int i = 0; i < 16; ++i) { s1[i] = __builtin_amdgcn_exp2f(s1[i] - mn); ps += s1[i]; }
            l = l * alpha + ps;
            if (__any(alpha != 1.f)) {
#pragma unroll
                for (int d = 0; d < 2; ++d)
#pragma unroll
                    for (int i = 0; i < 16; ++i) o[d][i] *= alpha;
            }
            asm volatile("s_waitcnt lgkmcnt(0)" ::: "memory");
            __builtin_amdgcn_sched_barrier(0);
            PV_MMA(o, s0, vfa);
            PV_MMA(o, s1, vfb);
        }
        __syncthreads();
    }
#undef AGLOAD
#undef ASTORE
    l = xhalf_sum(l);
    const float inv = 1.f / l;
    bf16_t* orow = O + (size_t)(b * SEQ + qpos) * DM + ocol + head * 64;
#pragma unroll
    for (int d = 0; d < 2; ++d)
#pragma unroll
        for (int gq = 0; gq < 4; ++gq) {
            uint2 w;
            w.x = cvtpk(o[d][gq * 4 + 0] * inv, o[d][gq * 4 + 1] * inv);
            w.y = cvtpk(o[d][gq * 4 + 2] * inv, o[d][gq * 4 + 3] * inv);
            *(uint2*)(orow + d * 32 + 8 * gq + 4 * hh) = w;
        }
}

__device__ __forceinline__ void dil_wave_item(const bf16_t* __restrict__ Q, const bf16_t* __restrict__ K, const bf16_t* __restrict__ V,
                                              bf16_t* __restrict__ O, int witem, char* wlds, int lds_off) {
    const int lane = tid_opaque() & 63, r32 = lane & 31, hh = lane >> 5;
    const int c = witem & 15, chunk = (witem >> 4) & 15, kvh = (witem >> 8) & 1, b = witem >> 9;
    const int t0 = chunk * 256;
    const int mq = r32 & 15, g = r32 >> 4;
    const int qpos = t0 + 16 * mq + c, head = kvh * 2 + g;
    bf16x8 qf[4];
    {
        const bf16_t* qp = Q + ((size_t)(b * 4 + head) * SEQ + qpos) * 64 + hh * 8;
#pragma unroll
        for (int ks = 0; ks < 4; ++ks) qf[ks] = *(const bf16x8*)(qp + ks * 16);
    }
    const bf16_t* Kg = K + (size_t)(b * 2 + kvh) * SEQ * 64;
    const bf16_t* Vg = V + (size_t)(b * 2 + kvh) * SEQ * 64;
    f32x16 o[2];
#pragma unroll
    for (int d = 0; d < 2; ++d)
#pragma unroll
        for (int i = 0; i < 16; ++i) o[d][i] = 0.f;
    float m = -1e30f, l = 0.f;
    const int gg = lane >> 4, li = lane & 15;
    const int vlane = lds_off + (4 * (gg >> 1) + (li >> 2)) * VS_BYTES + (16 * (gg & 1) + 4 * (li & 3)) * 2;
    for (int it = 0; it < 23; ++it) {
        int sh, j;
        if (it < 12) { sh = 0; j = it; } else if (it < 18) { sh = 2; j = it - 12; } else { sh = 4; j = it - 18; }
        const int rr = 1 << sh;
        const int cc = c & (rr - 1);
        const int idx0 = (t0 >> sh) - 64 + 32 * j;
        const int lim = SEQ >> sh;
        if (idx0 + 31 < 0 || idx0 >= lim) continue;
        bf16x8 kf[4];
        {
            int idx = idx0 + r32; idx = idx < 0 ? 0 : (idx >= lim ? lim - 1 : idx);
            const bf16_t* kp = Kg + (size_t)((idx << sh) + cc) * 64 + hh * 8;
#pragma unroll
            for (int ks = 0; ks < 4; ++ks) kf[ks] = *(const bf16x8*)(kp + ks * 16);
        }
        uint4 vr[4];
#pragma unroll
        for (int jj = 0; jj < 4; ++jj) {
            const int id = lane + 64 * jj; int idx = idx0 + (id >> 3); idx = idx < 0 ? 0 : (idx >= lim ? lim - 1 : idx);
            vr[jj] = *(const uint4*)(Vg + (size_t)((idx << sh) + cc) * 64 + (id & 7) * 8);
        }
#pragma unroll
        for (int jj = 0; jj < 4; ++jj) { const int id = lane + 64 * jj; *(uint4*)(wlds + (id >> 3) * VS_BYTES + (id & 7) * 16) = vr[jj]; }
        f32x16 s;
#pragma unroll
        for (int i = 0; i < 16; ++i) s[i] = 0.f;
#pragma unroll
        for (int ks = 0; ks < 4; ++ks) s = __builtin_amdgcn_mfma_f32_32x32x16_bf16(kf[ks], qf[ks], s, 0, 0, 0);
        const int qidx = qpos >> sh;
        const int base = idx0 + 4 * hh;
#pragma unroll
        for (int i = 0; i < 16; ++i) {
            const int idx = base + (i & 3) + 8 * (i >> 2);
            const int d = idx - qidx;
            s[i] = (d > 64 || d < -64 || idx < 0 || idx >= lim) ? -1e30f : s[i];
        }
        float tmax = s[0];
#pragma unroll
        for (int i = 1; i < 16; ++i) tmax = fmaxf(tmax, s[i]);
        tmax = fmaxf(tmax, xhalf(tmax));
        const float mn = fmaxf(fmaxf(m, tmax), -1e20f);
        const float alpha = __builtin_amdgcn_exp2f(m - mn);
        m = mn;
        float ps = 0.f;
#pragma unroll
        for (int i = 0; i < 16; ++i) { s[i] = __builtin_amdgcn_exp2f(s[i] - mn); ps += s[i]; }
        l = l * alpha + ps;
#pragma unroll
        for (int d = 0; d < 2; ++d)
#pragma unroll
            for (int i = 0; i < 16; ++i) o[d][i] *= alpha;
        pv_sub<0>(o, s, vlane);
    }
    l += xhalf(l);
    const float inv = 1.f / l;
    bf16_t* orow = O + (size_t)(b * SEQ + qpos) * DM + 512 + head * 64;
#pragma unroll
    for (int d = 0; d < 2; ++d)
#pragma unroll
        for (int gq = 0; gq < 4; ++gq) {
            uint2 w;
            w.x = cvtpk(o[d][gq * 4 + 0] * inv, o[d][gq * 4 + 1] * inv);
            w.y = cvtpk(o[d][gq * 4 + 2] * inv, o[d][gq * 4 + 3] * inv);
            *(uint2*)(orow + d * 32 + 8 * gq + 4 * hh) = w;
        }
}

__device__ __forceinline__ int f2key(float f) { int b = __float_as_int(f); return b ^ ((b >> 31) & 0x7fffffff); }
__device__ __forceinline__ float key2f(int k) { return __int_as_float(k ^ ((k >> 31) & 0x7fffffff)); }

template <int N>
__device__ __forceinline__ void bitonic_sort_desc(int (&a)[N]) {
#pragma unroll
    for (int k = 2; k <= N; k <<= 1) {
#pragma unroll
        for (int j = k >> 1; j > 0; j >>= 1) {
#pragma unroll
            for (int i = 0; i < N; ++i) {
                const int l2 = i ^ j;
                if (l2 > i) {
                    const bool up = ((i & k) == 0);
                    const int hi = max(a[i], a[l2]), lo = min(a[i], a[l2]);
                    a[i] = up ? hi : lo; a[l2] = up ? lo : hi;
                }
            }
        }
    }
}
__device__ __forceinline__ void merge_top16(int (&a)[16], const int (&b)[16]) {
#pragma unroll
    for (int i = 0; i < 16; ++i) a[i] = max(a[i], b[15 - i]);
#pragma unroll
    for (int j = 8; j > 0; j >>= 1) {
#pragma unroll
        for (int i = 0; i < 16; ++i) {
            const int l2 = i ^ j;
            if (l2 > i) { const int hi = max(a[i], a[l2]), lo = min(a[i], a[l2]); a[i] = hi; a[l2] = lo; }
        }
    }
}
__device__ __forceinline__ void top16_of_64(int (&g0)[16], int (&g1)[16], int (&g2)[16], int (&g3)[16]) {
    bitonic_sort_desc<16>(g0); bitonic_sort_desc<16>(g1); bitonic_sort_desc<16>(g2); bitonic_sort_desc<16>(g3);
    merge_top16(g0, g1); merge_top16(g2, g3); merge_top16(g0, g2);
}

__device__ __forceinline__ void topk_core(const bf16_t* q0, const bf16_t* __restrict__ subk_h, float rscale, int* eo, float* go, char* wlds) {
    const int lane = tid_opaque() & 63, r32 = lane & 31, hh = lane >> 5;
    int top[2][16];
#pragma unroll
    for (int c = 0; c < 2; ++c) {
        bf16x8 qf[8];
        const bf16_t* qrow = q0 + c * 128;
#pragma unroll
        for (int ks = 0; ks < 8; ++ks) qf[ks] = *(const bf16x8*)(qrow + ks * 16);
        const bf16_t* kb = subk_h + ((size_t)c * 128 + r32) * 128 + hh * 8;
        int grp[4][16];
#pragma unroll
        for (int kt = 0; kt < 4; ++kt) {
            f32x16 s;
#pragma unroll
            for (int i = 0; i < 16; ++i) s[i] = 0.f;
#pragma unroll
            for (int ks = 0; ks < 8; ++ks) {
                bf16x8 kf = *(const bf16x8*)(kb + (size_t)kt * 32 * 128 + ks * 16);
                s = __builtin_amdgcn_mfma_f32_32x32x16_bf16(kf, qf[ks], s, 0, 0, 0);
            }
#pragma unroll
            for (int i = 0; i < 16; ++i) grp[kt][i] = (f2key(s[i]) & ~127) | (kt * 32 + crow(i, hh));
        }
        top16_of_64(grp[0], grp[1], grp[2], grp[3]);
        int oth[16];
#pragma unroll
        for (int i = 0; i < 16; ++i) oth[i] = __shfl_xor(grp[0][i], 32);
        merge_top16(grp[0], oth);
#pragma unroll
        for (int i = 0; i < 16; ++i) top[c][i] = grp[0][i];
    }
    {
        unsigned* my = (unsigned*)(wlds + lane * 36);
#pragma unroll
        for (int c = 0; c < 2; ++c)
#pragma unroll
            for (int w4 = 0; w4 < 4; ++w4) {
                unsigned v = (top[c][w4 * 4] & 127) | ((top[c][w4 * 4 + 1] & 127) << 8) | ((top[c][w4 * 4 + 2] & 127) << 16) | ((top[c][w4 * 4 + 3] & 127) << 24);
                my[c * 4 + w4] = v;
            }
    }
    float v1[16], v2[16];
#pragma unroll
    for (int i = 0; i < 16; ++i) { v1[i] = key2f(top[0][i] & ~127); v2[i] = key2f(top[1][i] & ~127); }
    int cg[4][16];
    {
        int n = 0;
#pragma unroll
        for (int i = 0; i < 16; ++i)
#pragma unroll
            for (int j = 0; j < 16; ++j)
                if ((i + 1) * (j + 1) <= 16) { cg[n >> 4][n & 15] = (f2key(v1[i] + v2[j]) & ~255) | (i * 16 + j); ++n; }
#pragma unroll
        for (int q = 50; q < 64; ++q) cg[q >> 4][q & 15] = (int)0x80000000;
    }
    top16_of_64(cg[0], cg[1], cg[2], cg[3]);
    float bv[16];
#pragma unroll
    for (int i = 0; i < 16; ++i) bv[i] = key2f(cg[0][i] & ~255) * rscale;
    float sm = 0.f;
    const float bmx = bv[0];
#pragma unroll
    for (int i = 0; i < 16; ++i) { bv[i] = __expf(bv[i] - bmx); sm += bv[i]; }
    const float inv = 1.f / sm;
    if (hh == 0) {
        const unsigned char* my = (const unsigned char*)(wlds + lane * 36);
#pragma unroll
        for (int q4 = 0; q4 < 4; ++q4) {
            int4 ev; float4 gv;
            int* evp = (int*)&ev; float* gvp = (float*)&gv;
#pragma unroll
            for (int u = 0; u < 4; ++u) {
                const int code = cg[0][q4 * 4 + u] & 255;
                const int i1 = my[code >> 4], i2 = my[16 + (code & 15)];
                evp[u] = i1 * 128 + i2; gvp[u] = bv[q4 * 4 + u] * inv;
            }
            *(int4*)(eo + q4 * 4) = ev; *(float4*)(go + q4 * 4) = gv;
        }
    }
}

__device__ __forceinline__ void topk_wave_item(const bf16_t* __restrict__ qp, const bf16_t* __restrict__ subk, int* __restrict__ eidx, float* __restrict__ gate, int witem, char* wlds) {
    const int lane = tid_opaque() & 63, r32 = lane & 31, hh = lane >> 5;
    const int h = witem & 7, t = (witem >> 3) * 32 + r32;
    topk_core(qp + (size_t)t * 2048 + h * 256 + hh * 8, subk + (size_t)h * 2 * 128 * 128, 1.f, eidx + ((size_t)h * T_TOK + t) * 16, gate + ((size_t)h * T_TOK + t) * 16, wlds);
}
__device__ __forceinline__ void gemm_tile_topk(const bf16_t* __restrict__ X, int ldx, const bf16_t* __restrict__ W, int ldw, int K, int m0, int h, char* lds,
                                               const bf16_t* __restrict__ subk, const float* __restrict__ ssq, int* __restrict__ eidx, float* __restrict__ gate) {
    const int tid = tid_opaque(), lane = tid & 63, wave = tid >> 6;
    const int wm = wave >> 1, wn = wave & 1;
    const int r32 = lane & 31, hh = lane >> 5;
    {
        f32x16 acc[2][4];
        gemm_mainloop(X, ldx, W, ldw, K, m0, h * 256, 2048, lds, acc);
        bf16_t* qst = (bf16_t*)lds;
#pragma unroll
        for (int mt = 0; mt < 2; ++mt)
#pragma unroll
            for (int nt = 0; nt < 4; ++nt)
#pragma unroll
                for (int i = 0; i < 16; ++i)
                    qst[(wm * 64 + mt * 32 + crow(i, hh)) * QST + wn * 128 + nt * 32 + r32] = f2bf(acc[mt][nt][i]);
    }
    __syncthreads();
    {
        const int tok = wave * 32 + r32, t = m0 + tok;
        float tot = 0.f;
#pragma unroll
        for (int j = 0; j < 4; ++j) { const float4 q = *(const float4*)(ssq + ((size_t)j * T_TOK + t) * 4); tot += (q.x + q.y) + (q.z + q.w); }
        const float r = rsqrtf(tot * (1.f / DM) + 1e-6f);
        topk_core((const bf16_t*)lds + tok * QST + hh * 8, subk + (size_t)h * 2 * 128 * 128, r, eidx + ((size_t)h * T_TOK + t) * 16, gate + ((size_t)h * T_TOK + t) * 16,
                  lds + TOPK_STASH + wave * 2304);
    }
    __syncthreads();
}

typedef __attribute__((ext_vector_type(2))) float f32x2;
__device__ __forceinline__ float fdot2bf(unsigned a, unsigned b, float acc) {
    return __builtin_amdgcn_fdot2_f32_bf16(*(bf16x2_t*)&a, *(bf16x2_t*)&b, acc, false);
}
__device__ __forceinline__ unsigned fp8pair_to_bf16(unsigned w, bool hi) {
    bf16x2_t r = hi ? __builtin_amdgcn_cvt_scalef32_pk_bf16_fp8((int)w, 1.0f, true) : __builtin_amdgcn_cvt_scalef32_pk_bf16_fp8((int)w, 1.0f, false);
    return *(unsigned*)&r;
}
__device__ __forceinline__ float dot16_fp8(uint4 u, const unsigned (&h)[8]) {
    float a = 0.f;
    a = fdot2bf(fp8pair_to_bf16(u.x, false), h[0], a); a = fdot2bf(fp8pair_to_bf16(u.x, true), h[1], a);
    a = fdot2bf(fp8pair_to_bf16(u.y, false), h[2], a); a = fdot2bf(fp8pair_to_bf16(u.y, true), h[3], a);
    a = fdot2bf(fp8pair_to_bf16(u.z, false), h[4], a); a = fdot2bf(fp8pair_to_bf16(u.z, true), h[5], a);
    a = fdot2bf(fp8pair_to_bf16(u.w, false), h[6], a); a = fdot2bf(fp8pair_to_bf16(u.w, true), h[7], a);
    return a;
}
__device__ __forceinline__ void axpy16_fp8(float (&acc)[16], float w, uint4 v) {
    f32x2 r;
    r = __builtin_amdgcn_cvt_pk_f32_fp8((int)v.x, false); acc[0] += w * r[0]; acc[1] += w * r[1];
    r = __builtin_amdgcn_cvt_pk_f32_fp8((int)v.x, true);  acc[2] += w * r[0]; acc[3] += w * r[1];
    r = __builtin_amdgcn_cvt_pk_f32_fp8((int)v.y, false); acc[4] += w * r[0]; acc[5] += w * r[1];
    r = __builtin_amdgcn_cvt_pk_f32_fp8((int)v.y, true);  acc[6] += w * r[0]; acc[7] += w * r[1];
    r = __builtin_amdgcn_cvt_pk_f32_fp8((int)v.z, false); acc[8] += w * r[0]; acc[9] += w * r[1];
    r = __builtin_amdgcn_cvt_pk_f32_fp8((int)v.z, true);  acc[10] += w * r[0]; acc[11] += w * r[1];
    r = __builtin_amdgcn_cvt_pk_f32_fp8((int)v.w, false); acc[12] += w * r[0]; acc[13] += w * r[1];
    r = __builtin_amdgcn_cvt_pk_f32_fp8((int)v.w, true);  acc[14] += w * r[0]; acc[15] += w * r[1];
}
__device__ __forceinline__ float gelu_exact(float a) { return 0.5f * a * (1.f + erff(a * 0.70710678118654752f)); }

__device__ __forceinline__ float transpose_reduce16(f32x16 p, int lane) {
#pragma unroll
    for (int st = 0; st < 4; ++st) {
        const int o = 32 >> st, n = 16 >> st;
        const bool up = (lane & o) != 0;
#pragma unroll
        for (int i = 0; i < n / 2; ++i) {
            float lo = p[i], hi = p[i + n / 2];
            asm volatile("" : "+v"(lo), "+v"(hi));
            const float keep = up ? hi : lo;
            const float send = up ? lo : hi;
            p[i] = keep + __shfl_xor(send, o);
        }
    }
    float v = p[0];
    v += __shfl_xor(v, 1); v += __shfl_xor(v, 2);
    return v;
}
#define EX_SB() __builtin_amdgcn_sched_barrier(0)
#define EX_LD1(R, TAB, EB, S) R = *(const uint4*)((TAB) + (unsigned)((__builtin_amdgcn_readlane((EB), (S)) << 10) + lane16))
#define EX_LOAD8(P, TAB, EB, SL) do { EX_LD1(P##0, TAB, EB, (SL) + 0); EX_LD1(P##1, TAB, EB, (SL) + 1); EX_LD1(P##2, TAB, EB, (SL) + 2); EX_LD1(P##3, TAB, EB, (SL) + 3); \
        EX_LD1(P##4, TAB, EB, (SL) + 4); EX_LD1(P##5, TAB, EB, (SL) + 5); EX_LD1(P##6, TAB, EB, (SL) + 6); EX_LD1(P##7, TAB, EB, (SL) + 7); } while (0)
#define EX_DOT8(P, PP, O) do { PP[(O) + 0] = dot16_fp8(P##0, hp); PP[(O) + 1] = dot16_fp8(P##1, hp); PP[(O) + 2] = dot16_fp8(P##2, hp); PP[(O) + 3] = dot16_fp8(P##3, hp); \
        PP[(O) + 4] = dot16_fp8(P##4, hp); PP[(O) + 5] = dot16_fp8(P##5, hp); PP[(O) + 6] = dot16_fp8(P##6, hp); PP[(O) + 7] = dot16_fp8(P##7, hp); } while (0)
#define EX_RL(W, S) __int_as_float(__builtin_amdgcn_readlane(__float_as_int(W), (S)))
#define EX_AXPY8(P, W, SL) do { axpy16_fp8(acc, EX_RL(W, (SL) + 0), P##0); axpy16_fp8(acc, EX_RL(W, (SL) + 1), P##1); axpy16_fp8(acc, EX_RL(W, (SL) + 2), P##2); axpy16_fp8(acc, EX_RL(W, (SL) + 3), P##3); \
        axpy16_fp8(acc, EX_RL(W, (SL) + 4), P##4); axpy16_fp8(acc, EX_RL(W, (SL) + 5), P##5); axpy16_fp8(acc, EX_RL(W, (SL) + 6), P##6); axpy16_fp8(acc, EX_RL(W, (SL) + 7), P##7); } while (0)
#define EX_COPY8(D, S_) do { D##0 = S_##0; D##1 = S_##1; D##2 = S_##2; D##3 = S_##3; D##4 = S_##4; D##5 = S_##5; D##6 = S_##6; D##7 = S_##7; } while (0)

__device__ __forceinline__ void expert_token(PC& p, int layer, int t, bool last, bool dummy = false) {
    const int lane = tid_opaque() & 63;
    const int lane16 = lane * 16;
    const float* gfb = p.g_ffn + layer * DM; asm volatile("" : "+s"(gfb));
    const float* gf = gfb + lane * 16;
    float* xrow = p.x + (size_t)t * DM + lane * 16;
    float* xwr = dummy ? (float*)p.zb + (size_t)t * DM + lane * 16 : xrow;
    bf16_t* hwr = (dummy ? p.q.qA + (size_t)t * DM : p.hnb + (size_t)t * DM) + lane * 16;
    float xv[16];
#pragma unroll
    for (int q = 0; q < 4; ++q) { const float4 a = *(const float4*)(xrow + 4 * q); xv[4 * q] = a.x; xv[4 * q + 1] = a.y; xv[4 * q + 2] = a.z; xv[4 * q + 3] = a.w; }
    float ss = 0.f;
#pragma unroll
    for (int i = 0; i < 16; ++i) ss += xv[i] * xv[i];
    ss = wave_sum(ss);
    const float rstd = rsqrtf(ss * (1.f / DM) + 1e-6f);
    unsigned hp[8];
#pragma unroll
    for (int q = 0; q < 4; ++q) {
        const float4 g = *(const float4*)(gf + 4 * q);
        hp[2 * q] = cvtpk(xv[4 * q] * rstd * g.x, xv[4 * q + 1] * rstd * g.y);
        hp[2 * q + 1] = cvtpk(xv[4 * q + 2] * rstd * g.z, xv[4 * q + 3] * rstd * g.w);
    }
    const size_t ei0 = ((size_t)(lane >> 4) * T_TOK + t) * 16 + (lane & 15), ei1 = ei0 + (size_t)4 * T_TOK * 16;
    const int e0 = p.eidx[ei0], e1 = p.eidx[ei1];
    const float g0 = p.gate[ei0], g1 = p.gate[ei1];
    const unsigned char* u8 = p.u8 + (size_t)layer * 16384 * DM;
    const unsigned char* v8 = p.v8 + (size_t)layer * 16384 * DM;
    const float* su = p.su + layer * 16384; const float* sv = p.sv + layer * 16384;
    const float su0 = su[e0], su1 = su[e1], sv0 = sv[e0], sv1 = sv[e1];
    uint4 rx0, rx1, rx2, rx3, rx4, rx5, rx6, rx7, ry0, ry1, ry2, ry3, ry4, ry5, ry6, ry7;
    float a0 = 0.f, a1 = 0.f;
    EX_LOAD8(rx, u8, e0, 0);
#pragma unroll 1
    for (int g = 0; g < 8; ++g) {
        const int eb = g < 4 ? e0 : e1;
        const int sl = (g & 3) * 16;
        f32x16 pp;
        EX_LOAD8(ry, u8, eb, sl + 8);
        EX_SB();
        EX_DOT8(rx, pp, 0);
        EX_SB();
        {
            const int gn = g + 1 < 8 ? g + 1 : 0;
            const int ebn = gn < 4 ? e0 : e1;
            const unsigned char* tabn = g + 1 < 8 ? u8 : v8;
            EX_LOAD8(rx, tabn, ebn, (gn & 3) * 16);
        }
        EX_SB();
        EX_DOT8(ry, pp, 8);
        const float v = transpose_reduce16(pp, lane);
        const float got = __shfl(v, (lane & 15) << 2);
        const bool mine = (lane >> 4) == (g & 3);
        a0 = (mine && g < 4) ? got : a0;
        a1 = (mine && g >= 4) ? got : a1;
        EX_SB();
    }
    const float w0 = g0 * gelu_exact(su0 * a0) * sv0;
    const float w1 = g1 * gelu_exact(su1 * a1) * sv1;
    float acc[16];
#pragma unroll
    for (int i = 0; i < 16; ++i) acc[i] = 0.f;
#pragma unroll 1
    for (int h2 = 0; h2 < 8; ++h2) {
        const int ebc = h2 < 4 ? e0 : e1;
        const float wb = h2 < 4 ? w0 : w1;
        const int slc = (h2 & 3) * 16;
        EX_LOAD8(ry, v8, ebc, slc + 8);
        EX_SB();
        EX_AXPY8(rx, wb, slc);
        EX_SB();
        {
            const int hn_ = h2 + 1 < 8 ? h2 + 1 : 7;
            const int ebn = hn_ < 4 ? e0 : e1;
            EX_LOAD8(rx, v8, ebn, (hn_ & 3) * 16);
        }
        EX_SB();
        EX_AXPY8(ry, wb, slc + 8);
        EX_SB();
    }
#pragma unroll
    for (int i = 0; i < 16; ++i) xv[i] += acc[i];
    float s2 = 0.f;
#pragma unroll
    for (int i = 0; i < 16; ++i) s2 += xv[i] * xv[i];
    s2 = wave_sum(s2);
    const float r2 = rsqrtf(s2 * (1.f / DM) + 1e-6f);
    if (!last) {
#pragma unroll
        for (int q = 0; q < 4; ++q) *(float4*)(xwr + 4 * q) = make_float4(xv[4 * q], xv[4 * q + 1], xv[4 * q + 2], xv[4 * q + 3]);
        const float* gnb = p.g_mix + (layer + 1) * DM; asm volatile("" : "+s"(gnb));
        const float* gn = gnb + lane * 16;
        unsigned hw[8];
#pragma unroll
        for (int q = 0; q < 4; ++q) {
            const float4 g = *(const float4*)(gn + 4 * q);
            hw[2 * q] = cvtpk(xv[4 * q] * r2 * g.x, xv[4 * q + 1] * r2 * g.y);
            hw[2 * q + 1] = cvtpk(xv[4 * q + 2] * r2 * g.z, xv[4 * q + 3] * r2 * g.w);
        }
        *(uint4*)(hwr) = make_uint4(hw[0], hw[1], hw[2], hw[3]);
        *(uint4*)(hwr + 8) = make_uint4(hw[4], hw[5], hw[6], hw[7]);
    } else {
        const float* gnb = p.g_final; asm volatile("" : "+s"(gnb));
        const float* gn = gnb + lane * 16;
        float* orow = dummy ? xwr : p.out + (size_t)t * DM + lane * 16;
#pragma unroll
        for (int q = 0; q < 4; ++q) {
            const float4 g = *(const float4*)(gn + 4 * q);
            *(float4*)(orow + 4 * q) = make_float4(xv[4 * q] * r2 * g.x, xv[4 * q + 1] * r2 * g.y, xv[4 * q + 2] * r2 * g.z, xv[4 * q + 3] * r2 * g.w);
        }
    }
}
__device__ __forceinline__ void transpose_tile(const float* __restrict__ src, int K, int N, bf16_t* __restrict__ dst, int tk, int tn, float* tl, const float* __restrict__ ksc, int perm) {
    const int tid = tid_opaque(), r = tid >> 6, c = tid & 63;
    const int k0 = tk * 64, n0 = tn * 64;
#pragma unroll
    for (int i = 0; i < 8; ++i) {
        const int kk = i * 8 + r, n = n0 + c;
        tl[kk * 65 + c] = (n < N) ? src[(size_t)(k0 + kk) * N + n] : 0.f;
    }
    __syncthreads();
#pragma unroll
    for (int i = 0; i < 8; ++i) {
        const int nn = i * 8 + r;
        if (n0 + nn < N) {
            int nd = n0 + nn;
            if (perm) { const int hq = nd / 96, wq = nd % 96; nd = wq < 64 ? hq * 64 + wq : 256 + hq * 32 + (wq - 64); }
            dst[(size_t)nd * K + k0 + c] = f2bf(tl[c * 65 + nn] * (ksc ? ksc[k0 + c] : 1.f));
        }
    }
    __syncthreads();
}
__device__ __forceinline__ void transpose_all(const float* src, int K, int N, bf16_t* dst, float* tl, const float* ksc = nullptr, int perm = 0) {
    const int ntk = K / 64, ntn = (N + 63) / 64;
    for (int t = blockIdx.x; t < ntk * ntn; t += gridDim.x) transpose_tile(src, K, N, dst, t / ntn, t % ntn, tl, ksc, perm);
}
__device__ __forceinline__ void convert_plain(const float* __restrict__ src, bf16_t* __restrict__ dst, size_t n) {
    const size_t n8 = n >> 3;
    for (size_t i = (size_t)blockIdx.x * blockDim.x + tid_opaque(); i < n8; i += (size_t)gridDim.x * blockDim.x) {
        const float4 a = *(const float4*)(src + i * 8), b = *(const float4*)(src + i * 8 + 4);
        uint4 w; w.x = cvtpk(a.x, a.y); w.y = cvtpk(a.z, a.w); w.z = cvtpk(b.x, b.y); w.w = cvtpk(b.z, b.w);
        *(uint4*)(dst + i * 8) = w;
    }
}
__device__ __forceinline__ void convert_rows_fp8(const float* __restrict__ src, unsigned char* __restrict__ dst, float* __restrict__ scales, int nrows) {
    const int tid = tid_opaque(), wave = tid >> 6, lane = tid & 63;
    for (int row = blockIdx.x * NW + wave; row < nrows; row += gridDim.x * NW) {
        const float* sr = src + (size_t)row * DM + lane * 16;
        float xv[16];
#pragma unroll
        for (int q = 0; q < 4; ++q) { const float4 a = *(const float4*)(sr + 4 * q); xv[4 * q] = a.x; xv[4 * q + 1] = a.y; xv[4 * q + 2] = a.z; xv[4 * q + 3] = a.w; }
        float am = 0.f;
#pragma unroll
        for (int i = 0; i < 16; ++i) am = fmaxf(am, fabsf(xv[i]));
        am = wave_max(am);
        const float sc = am > 0.f ? am * (1.f / 448.f) : 1.f;
        const float inv = 1.f / sc;
        unsigned w[4];
#pragma unroll
        for (int q = 0; q < 4; ++q) {
            int t = 0;
            t = __builtin_amdgcn_cvt_pk_fp8_f32(xv[4 * q] * inv, xv[4 * q + 1] * inv, t, false);
            t = __builtin_amdgcn_cvt_pk_fp8_f32(xv[4 * q + 2] * inv, xv[4 * q + 3] * inv, t, true);
            w[q] = (unsigned)t;
        }
        *(uint4*)(dst + (size_t)row * DM + lane * 16) = make_uint4(w[0], w[1], w[2], w[3]);
        if (lane == 0) scales[row] = sc;
    }
}
__device__ __forceinline__ void rms_row_bf16(const float* __restrict__ src, const float* __restrict__ g, bf16_t* __restrict__ dst, float* __restrict__ cpy, int lane) {
    float xv[16];
    const float4 a0 = *(const float4*)(src + lane * 8), a1 = *(const float4*)(src + lane * 8 + 4);
    const float4 b0 = *(const float4*)(src + 512 + lane * 8), b1 = *(const float4*)(src + 512 + lane * 8 + 4);
    xv[0] = a0.x; xv[1] = a0.y; xv[2] = a0.z; xv[3] = a0.w; xv[4] = a1.x; xv[5] = a1.y; xv[6] = a1.z; xv[7] = a1.w;
    xv[8] = b0.x; xv[9] = b0.y; xv[10] = b0.z; xv[11] = b0.w; xv[12] = b1.x; xv[13] = b1.y; xv[14] = b1.z; xv[15] = b1.w;
    if (cpy) {
        *(float4*)(cpy + lane * 8) = a0; *(float4*)(cpy + lane * 8 + 4) = a1;
        *(float4*)(cpy + 512 + lane * 8) = b0; *(float4*)(cpy + 512 + lane * 8 + 4) = b1;
    }
    float ss = 0.f;
#pragma unroll
    for (int i = 0; i < 16; ++i) ss += xv[i] * xv[i];
    ss = wave_sum(ss);
    const float r = rsqrtf(ss * (1.f / DM) + 1e-6f);
    const float4 g0 = *(const float4*)(g + lane * 8), g1 = *(const float4*)(g + lane * 8 + 4);
    const float4 g2 = *(const float4*)(g + 512 + lane * 8), g3 = *(const float4*)(g + 512 + lane * 8 + 4);
    uint4 wa, wb;
    wa.x = cvtpk(xv[0] * r * g0.x, xv[1] * r * g0.y); wa.y = cvtpk(xv[2] * r * g0.z, xv[3] * r * g0.w);
    wa.z = cvtpk(xv[4] * r * g1.x, xv[5] * r * g1.y); wa.w = cvtpk(xv[6] * r * g1.z, xv[7] * r * g1.w);
    wb.x = cvtpk(xv[8] * r * g2.x, xv[9] * r * g2.y); wb.y = cvtpk(xv[10] * r * g2.z, xv[11] * r * g2.w);
    wb.z = cvtpk(xv[12] * r * g3.x, xv[13] * r * g3.y); wb.w = cvtpk(xv[14] * r * g3.z, xv[15] * r * g3.w);
    *(uint4*)(dst + lane * 8) = wa; *(uint4*)(dst + 512 + lane * 8) = wb;
}

__device__ __forceinline__ void rms_row2_bf16(const float* __restrict__ s0, const float* __restrict__ s1, const float* __restrict__ g, bf16_t* __restrict__ d0, bf16_t* __restrict__ d1, int lane) {
    float4 a[4], b[4];
#pragma unroll
    for (int q = 0; q < 4; ++q) { a[q] = *(const float4*)(s0 + (q >> 1) * 512 + lane * 8 + (q & 1) * 4); b[q] = s1 ? *(const float4*)(s1 + (q >> 1) * 512 + lane * 8 + (q & 1) * 4) : make_float4(0.f, 0.f, 0.f, 0.f); }
    float sa = 0.f, sb = 0.f;
#pragma unroll
    for (int q = 0; q < 4; ++q) { sa += a[q].x * a[q].x + a[q].y * a[q].y + a[q].z * a[q].z + a[q].w * a[q].w; sb += b[q].x * b[q].x + b[q].y * b[q].y + b[q].z * b[q].z + b[q].w * b[q].w; }
    sa = wave_sum(sa); sb = wave_sum(sb);
    const float ra = rsqrtf(sa * (1.f / DM) + 1e-6f), rb = rsqrtf(sb * (1.f / DM) + 1e-6f);
    float4 gq[4];
#pragma unroll
    for (int q = 0; q < 4; ++q) gq[q] = *(const float4*)(g + (q >> 1) * 512 + lane * 8 + (q & 1) * 4);
    uint4 w;
    w.x = cvtpk(a[0].x * ra * gq[0].x, a[0].y * ra * gq[0].y); w.y = cvtpk(a[0].z * ra * gq[0].z, a[0].w * ra * gq[0].w);
    w.z = cvtpk(a[1].x * ra * gq[1].x, a[1].y * ra * gq[1].y); w.w = cvtpk(a[1].z * ra * gq[1].z, a[1].w * ra * gq[1].w);
    *(uint4*)(d0 + lane * 8) = w;
    w.x = cvtpk(a[2].x * ra * gq[2].x, a[2].y * ra * gq[2].y); w.y = cvtpk(a[2].z * ra * gq[2].z, a[2].w * ra * gq[2].w);
    w.z = cvtpk(a[3].x * ra * gq[3].x, a[3].y * ra * gq[3].y); w.w = cvtpk(a[3].z * ra * gq[3].z, a[3].w * ra * gq[3].w);
    *(uint4*)(d0 + 512 + lane * 8) = w;
    if (s1) {
        w.x = cvtpk(b[0].x * rb * gq[0].x, b[0].y * rb * gq[0].y); w.y = cvtpk(b[0].z * rb * gq[0].z, b[0].w * rb * gq[0].w);
        w.z = cvtpk(b[1].x * rb * gq[1].x, b[1].y * rb * gq[1].y); w.w = cvtpk(b[1].z * rb * gq[1].z, b[1].w * rb * gq[1].w);
        *(uint4*)(d1 + lane * 8) = w;
        w.x = cvtpk(b[2].x * rb * gq[2].x, b[2].y * rb * gq[2].y); w.y = cvtpk(b[2].z * rb * gq[2].z, b[2].w * rb * gq[2].w);
        w.z = cvtpk(b[3].x * rb * gq[3].x, b[3].y * rb * gq[3].y); w.w = cvtpk(b[3].z * rb * gq[3].z, b[3].w * rb * gq[3].w);
        *(uint4*)(d1 + 512 + lane * 8) = w;
    }
}

__device__ __forceinline__ void phase_pro(PC& p, char* lds) {
    float* tl = (float*)lds;
    for (int l = 0; l < DEPTH; ++l) {
        transpose_all(p.w_in + (size_t)l * DM * NZ, DM, NZ, p.winT + (size_t)l * NZ * DM, tl);
        transpose_all(p.w_out + (size_t)l * DM * DM, DM, DM, p.woutT + (size_t)l * DM * DM, tl, (p.flags & 16) ? p.g_group + (size_t)l * 1024 : nullptr);
        transpose_all(p.peer_w_q + (size_t)l * DM * 2048, DM, 2048, p.wqT + (size_t)l * 2048 * DM, tl, (p.flags & 4) ? p.g_ffn + l * DM : nullptr);
        transpose_all(p.mla_w_uq + (size_t)l * 256 * 384, 256, 384, p.wuqT + (size_t)l * 384 * 256, tl, (p.flags & 8) ? p.mla_q_norm + l * 256 : nullptr, (p.flags & 32) ? 1 : 0);
        transpose_all(p.mla_w_ukv + (size_t)l * 128 * 512, 128, 512, p.wukvT + (size_t)l * 512 * 128, tl, (p.flags & 8) ? p.mla_kv_norm + l * 128 : nullptr);
    }
    convert_plain(p.peer_sub_keys, p.subk, (size_t)DEPTH * 8 * 2 * 128 * 128);
    if ((p.flags & 3) == 1) {
        convert_rows_fp8(p.peer_u, p.u8, p.su, DEPTH * 16384);
        convert_rows_fp8(p.peer_v, p.v8, p.sv, DEPTH * 16384);
    }
    for (int i = blockIdx.x * blockDim.x + tid_opaque(); i < 4096 * 32; i += gridDim.x * blockDim.x) {
        {
            const int pos = i / 32, j = i % 32;
            const float inv = powf(10000.f, -(float)(2 * j) / 64.f); const float ang = (float)pos * inv;
            p.tb.cos1[i] = cosf(ang); p.tb.sin1[i] = sinf(ang);
        }
        if (i < 4096 * 16) {
            const int pos = i / 16, j = i % 16;
            const float inv = powf(10000.f, -(float)(2 * j) / 32.f); const float ang = (float)pos * inv;
            p.tb.cosm[i] = cosf(ang); p.tb.sinm[i] = sinf(ang);
        }
        if (i < 64 * 16) {
            const int pos = i / 16, j = i % 16;
            const float inv = powf(10000.f, -(float)(2 * j) / 32.f); const float ang = (float)pos * inv;
            p.tb.cosr[i] = cosf(ang); p.tb.sinr[i] = sinf(ang); p.tb.cosc[i] = cosf(ang); p.tb.sinc[i] = sinf(ang);
        }
    }
    const int wave = tid_opaque() >> 6, lane = tid_opaque() & 63;
    for (int t = blockIdx.x * NW + wave; t < T_TOK; t += gridDim.x * NW)
        rms_row_bf16(p.x_in + (size_t)t * DM, p.g_mix, p.hnb + (size_t)t * DM, p.x + (size_t)t * DM, lane);
}

__device__ __forceinline__ void phase_g1(PC& p, int l, char* lds) {
    if (p.flags & 8) {
        RowsPostZ e{p.q.qA, p.tb.cos1, p.ax_q_norm + l * 64, p.ax_k_norm + l * 64, p.cqn, p.ssqd, p.q.kD};
        gemm_phase_rows<RowsPostZ, 0>(p.hnb, DM, p.winT + (size_t)l * NZ * DM, DM, T_TOK, NZ, DM, lds, e);
    } else {
        RowsStoreBf16 e{p.zb, NZ, NZ};
        gemm_phase_rows<RowsStoreBf16, 0>(p.hnb, DM, p.winT + (size_t)l * NZ * DM, DM, T_TOK, NZ, DM, lds, e);
    }
}

__device__ __forceinline__ unsigned pk2(float a, float b) { return cvtpk(a, b); }
__device__ __forceinline__ void phase_post(PC& p, int l, char* lds) {
    const int tid = tid_opaque(), wave = tid >> 6, lane = tid & 63;
    float* zr = (float*)(lds + wave * 8192);
    const float* g_qn = p.ax_q_norm + l * 64; const float* g_kn = p.ax_k_norm + l * 64;
    const float* g_cq = p.mla_q_norm + l * 256; const float* g_ckv = p.mla_kv_norm + l * 128;
    const float scA = 0.125f * LOG2E;
    const bf16_t* zb = p.zb;
    const float *cos1 = p.tb.cos1, *sin1 = p.tb.sin1, *cosm = p.tb.cosm, *sinm = p.tb.sinm, *cosr = p.tb.cosr, *sinr = p.tb.sinr, *cosc = p.tb.cosc, *sinc = p.tb.sinc;
    for (int t = blockIdx.x * NW + wave; t < T_TOK; t += gridDim.x * NW) {
        const int b = t / SEQ, s = t % SEQ;
#pragma unroll
        for (int j = 0; j < 4; ++j) {
            const int ch = lane + 64 * j;
            if (ch < 244) {
                const uint4 w = *(const uint4*)(zb + (size_t)t * NZ + ch * 8);
                float4 lo, hi;
                lo.x = __uint_as_float(w.x << 16); lo.y = __uint_as_float(w.x & 0xffff0000u); lo.z = __uint_as_float(w.y << 16); lo.w = __uint_as_float(w.y & 0xffff0000u);
                hi.x = __uint_as_float(w.z << 16); hi.y = __uint_as_float(w.z & 0xffff0000u); hi.z = __uint_as_float(w.w << 16); hi.w = __uint_as_float(w.w & 0xffff0000u);
                *(float4*)(zr + ch * 8) = lo; *(float4*)(zr + ch * 8 + 4) = hi;
            }
        }
#pragma unroll
        for (int mix = 0; mix < 2; ++mix) {
            const int zo = mix == 0 ? 0 : 1024;
            bf16_t* qo = mix == 0 ? p.q.qA : p.q.qC; bf16_t* ko = mix == 0 ? p.q.kA : p.q.kC; bf16_t* vo = mix == 0 ? p.q.vA : p.q.vC;
            const int h = lane >> 4, j = (lane & 15) * 2;
            const float c0 = cos1[s * 32 + j], c1 = cos1[s * 32 + j + 1], s0 = sin1[s * 32 + j], s1 = sin1[s * 32 + j + 1];
            {
                const float a0 = zr[zo + h * 64 + j], a1 = zr[zo + h * 64 + j + 1], b0 = zr[zo + h * 64 + 32 + j], b1 = zr[zo + h * 64 + 33 + j];
                bf16_t* o = qo + ((size_t)(b * 4 + h) * SEQ + s) * 64;
                *(unsigned*)(o + j) = pk2((a0 * c0 - b0 * s0) * scA, (a1 * c1 - b1 * s1) * scA);
                *(unsigned*)(o + 32 + j) = pk2((b0 * c0 + a0 * s0) * scA, (b1 * c1 + a1 * s1) * scA);
            }
            if (lane < 32) {
                const float a0 = zr[zo + 256 + h * 64 + j], a1 = zr[zo + 256 + h * 64 + j + 1], b0 = zr[zo + 256 + h * 64 + 32 + j], b1 = zr[zo + 256 + h * 64 + 33 + j];
                bf16_t* o = ko + ((size_t)(b * 2 + h) * SEQ + s) * 64;
                *(unsigned*)(o + j) = pk2(a0 * c0 - b0 * s0, a1 * c1 - b1 * s1);
                *(unsigned*)(o + 32 + j) = pk2(b0 * c0 + a0 * s0, b1 * c1 + a1 * s1);
            }
            {
                const int i = lane * 2, hv = i >> 6, jv = i & 63;
                *(unsigned*)(vo + ((size_t)(b * 2 + hv) * SEQ + s) * 64 + jv) = pk2(zr[zo + 384 + i], zr[zo + 384 + i + 1]);
            }
        }
        {
            float rs[6];
#pragma unroll
            for (int hh = 0; hh < 6; ++hh) {
                const float v = zr[512 + hh * 64 + lane];
                rs[hh] = rsqrtf(wave_sum(v * v) * (1.f / 64.f) + 1e-6f);
            }
            const int row = s >> 6, col = s & 63;
            const int half = (lane >> 3) & 1, jj = (lane & 7) * 2;
            const float* ct = half == 0 ? cosr + row * 16 : cosc + col * 16;
            const float* st = half == 0 ? sinr + row * 16 : sinc + col * 16;
            const float c0 = ct[jj], c1 = ct[jj + 1], s0 = st[jj], s1 = st[jj + 1];
            const int d1 = half * 32 + jj, d2 = d1 + 16;
            {
                const int h = lane >> 4;
                const float r = h == 0 ? rs[0] : (h == 1 ? rs[1] : (h == 2 ? rs[2] : rs[3]));
                const float* z = zr + 512 + h * 64;
                const float a0 = z[d1] * r * g_qn[d1], a1 = z[d1 + 1] * r * g_qn[d1 + 1], b0 = z[d2] * r * g_qn[d2], b1 = z[d2 + 1] * r * g_qn[d2 + 1];
                bf16_t* o = p.q.qB + ((size_t)(b * 4 + h) * SEQ + s) * 64;
                *(unsigned*)(o + d1) = pk2((a0 * c0 - b0 * s0) * scA, (a1 * c1 - b1 * s1) * scA);
                *(unsigned*)(o + d2) = pk2((b0 * c0 + a0 * s0) * scA, (b1 * c1 + a1 * s1) * scA);
            }
            if (lane < 32) {
                const int h = lane >> 4;
                const float r = h == 0 ? rs[4] : rs[5];
                const float* z = zr + 768 + h * 64;
                const float a0 = z[d1] * r * g_kn[d1], a1 = z[d1 + 1] * r * g_kn[d1 + 1], b0 = z[d2] * r * g_kn[d2], b1 = z[d2 + 1] * r * g_kn[d2 + 1];
                bf16_t* o = p.q.kB + ((size_t)(b * 2 + h) * SEQ + s) * 64;
                *(unsigned*)(o + d1) = pk2(a0 * c0 - b0 * s0, a1 * c1 - b1 * s1);
                *(unsigned*)(o + d2) = pk2(b0 * c0 + a0 * s0, b1 * c1 + a1 * s1);
            }
            {
                const int i = lane * 2, hv = i >> 6, jv = i & 63;
                *(unsigned*)(p.q.vB + ((size_t)(b * 2 + hv) * SEQ + s) * 64 + jv) = pk2(zr[896 + i], zr[896 + i + 1]);
            }
        }
        {
            const float4 cq = *(const float4*)(zr + 1536 + lane * 4);
            const float rq = rsqrtf(wave_sum(cq.x * cq.x + cq.y * cq.y + cq.z * cq.z + cq.w * cq.w) * (1.f / 256.f) + 1e-6f);
            const float4 gq = *(const float4*)(g_cq + lane * 4);
            uint2 w; w.x = pk2(cq.x * rq * gq.x, cq.y * rq * gq.y); w.y = pk2(cq.z * rq * gq.z, cq.w * rq * gq.w);
            *(uint2*)(p.cqn + (size_t)t * 256 + lane * 4) = w;
            const float2 ck = *(const float2*)(zr + 1792 + lane * 2);
            const float rk = rsqrtf(wave_sum(ck.x * ck.x + ck.y * ck.y) * (1.f / 128.f) + 1e-6f);
            const float2 gk = *(const float2*)(g_ckv + lane * 2);
            *(unsigned*)(p.ckvn + (size_t)t * 128 + lane * 2) = pk2(ck.x * rk * gk.x, ck.y * rk * gk.y);
            const int i = lane & 15, h = lane >> 4;
            const float x1 = zr[1920 + i], x2 = zr[1936 + i];
            const float c = cosm[s * 16 + i], sn = sinm[s * 16 + i];
            bf16_t* o = p.q.kD + ((size_t)(b * 4 + h) * SEQ + s) * 96;
            o[64 + i] = f2bf(x1 * c - x2 * sn); o[80 + i] = f2bf(x2 * c + x1 * sn);
        }
    }
}

__device__ __forceinline__ void phase_mla(PC& p, int l, char* lds) {
    if (p.flags & 32) {
        { RowsPostQ e{p.q.qD, p.tb.cos1, p.ssqd}; gemm_phase_rows<RowsPostQ, 0>(p.cqn, 256, p.wuqT + (size_t)l * 384 * 256, 256, T_TOK, 384, 256, lds, e); }
        { RowsPostKV e{p.q.kD, p.q.vD, p.ssqd + (size_t)4 * T_TOK}; gemm_phase_rows<RowsPostKV, 0>(p.ckvn, 128, p.wukvT + (size_t)l * 512 * 128, 128, T_TOK, 512, 128, lds, e); }
    } else if (p.flags & 8) {
        { RowsStoreBf16Scale<4, 256> e{p.qfull, 384, 384, p.ssqd}; gemm_phase_rows<RowsStoreBf16Scale<4, 256>, 0>(p.cqn, 256, p.wuqT + (size_t)l * 384 * 256, 256, T_TOK, 384, 256, lds, e); }
        { RowsStoreBf16Scale<2, 128> e{p.kvfull, 512, 512, p.ssqd + (size_t)4 * T_TOK}; gemm_phase_rows<RowsStoreBf16Scale<2, 128>, 0>(p.ckvn, 128, p.wukvT + (size_t)l * 512 * 128, 128, T_TOK, 512, 128, lds, e); }
    } else {
        { RowsStoreBf16 e{p.qfull, 384, 384}; gemm_phase_rows<RowsStoreBf16, 0>(p.cqn, 256, p.wuqT + (size_t)l * 384 * 256, 256, T_TOK, 384, 256, lds, e); }
        { RowsStoreBf16 e{p.kvfull, 512, 512}; gemm_phase_rows<RowsStoreBf16, 0>(p.ckvn, 128, p.wukvT + (size_t)l * 512 * 128, 128, T_TOK, 512, 128, lds, e); }
    }
}

__device__ __forceinline__ void phase_postmla(PC& p, int l) {
    const int tid = tid_opaque(), wave = tid >> 6, lane = tid & 63;
    const float scD = 0.10206207261596575f * LOG2E;
    const float *cosm = p.tb.cosm, *sinm = p.tb.sinm;
    const bf16_t* qfull = p.qfull; const bf16_t* kvfull = p.kvfull;
    const int h = lane >> 4, j = (lane & 15) * 4, i = lane & 15;
    for (int tb = blockIdx.x * NW + wave; tb < T_TOK; tb += gridDim.x * 2 * NW) {
        uint2 qw[2], kw[2], vw[2]; float x1[2], x2[2], cc[2], ss[2];
#pragma unroll
        for (int u = 0; u < 2; ++u) {
            int t = tb + u * gridDim.x * NW; t = t < T_TOK ? t : tb;
            const int s = t % SEQ;
            qw[u] = *(const uint2*)(qfull + (size_t)t * 384 + h * 96 + j);
            kw[u] = *(const uint2*)(kvfull + (size_t)t * 512 + h * 128 + j);
            vw[u] = *(const uint2*)(kvfull + (size_t)t * 512 + h * 128 + 64 + j);
            x1[u] = bf2f(qfull[(size_t)t * 384 + h * 96 + 64 + i]); x2[u] = bf2f(qfull[(size_t)t * 384 + h * 96 + 80 + i]);
            cc[u] = cosm[s * 16 + i]; ss[u] = sinm[s * 16 + i];
        }
#pragma unroll
        for (int u = 0; u < 2; ++u) {
            const int t = tb + u * gridDim.x * NW;
            if (t < T_TOK) {
                const int b = t / SEQ, s = t % SEQ;
                const size_t hb = (size_t)(b * 4 + h) * SEQ + s;
                uint2 o;
                o.x = cvtpk(__uint_as_float(qw[u].x << 16) * scD, __uint_as_float(qw[u].x & 0xffff0000u) * scD);
                o.y = cvtpk(__uint_as_float(qw[u].y << 16) * scD, __uint_as_float(qw[u].y & 0xffff0000u) * scD);
                *(uint2*)(p.q.qD + hb * 96 + j) = o;
                *(uint2*)(p.q.kD + hb * 96 + j) = kw[u];
                *(uint2*)(p.q.vD + hb * 64 + j) = vw[u];
                p.q.qD[hb * 96 + 64 + i] = f2bf((x1[u] * cc[u] - x2[u] * ss[u]) * scD);
                p.q.qD[hb * 96 + 80 + i] = f2bf((x2[u] * cc[u] + x1[u] * ss[u]) * scD);
            }
        }
    }
}

__device__ __forceinline__ void phase_att(PC& p, int l, char* lds) {
    for (int it = blockIdx.x; it < 512; it += gridDim.x) attn_item<96, 1, false>(p.q.qD, p.q.kD, p.q.vD, nullptr, p.ob, 768, 4, 4, it, lds, (p.flags & 32) ? 128 : 96);
    if (p.flags & 2) convert_rows_fp8(p.peer_u + (size_t)l * 16384 * DM, p.u8 + (size_t)l * 16384 * DM, p.su + l * 16384, 16384);
    for (int it = blockIdx.x; it < 512; it += gridDim.x) attn_item<64, 2, false>(p.q.qB, p.q.kB, p.q.vB, nullptr, p.ob, 256, 4, 2, it, lds);
    if (p.flags & 2) convert_rows_fp8(p.peer_v + (size_t)l * 16384 * DM, p.v8 + (size_t)l * 16384 * DM, p.sv + l * 16384, 16384);
    for (int it = blockIdx.x; it < 512; it += gridDim.x) attn_item<64, 2, true>(p.q.qA, p.q.kA, p.q.vA, p.win_sink + l * 4, p.ob, 0, 4, 2, it, lds);
    {
        const int wave = tid_opaque() >> 6;
        char* wl = lds + wave * 6144;
        const int off = (int)(uintptr_t)wl;
        for (int wi = blockIdx.x * NW + wave; wi < 4096; wi += gridDim.x * NW) dil_wave_item(p.q.qC, p.q.kC, p.q.vC, p.ob, wi, wl, off);
    }
}

__device__ __forceinline__ void phase_gn(PC& p, int l) {
    const int wave = tid_opaque() >> 6, lane = tid_opaque() & 63;
    const float* gg = p.g_group + (size_t)l * 1024;
    const bf16_t* ob = p.ob; bf16_t* hnb = p.hnb;
    for (int t0 = blockIdx.x * NW + wave; t0 < T_TOK; t0 += gridDim.x * 2 * NW) {
        const int t1 = t0 + gridDim.x * NW;
        const bool has1 = t1 < T_TOK;
        uint2 w0[4], w1[4];
#pragma unroll
        for (int g = 0; g < 4; ++g) {
            w0[g] = *(const uint2*)(ob + (size_t)t0 * DM + g * 256 + lane * 4);
            w1[g] = has1 ? *(const uint2*)(ob + (size_t)t1 * DM + g * 256 + lane * 4) : make_uint2(0, 0);
        }
#pragma unroll
        for (int g = 0; g < 4; ++g) {
            const float4 g4 = *(const float4*)(gg + g * 256 + lane * 4);
            {
                const float v0 = __uint_as_float(w0[g].x << 16), v1 = __uint_as_float(w0[g].x & 0xffff0000u), v2 = __uint_as_float(w0[g].y << 16), v3 = __uint_as_float(w0[g].y & 0xffff0000u);
                const float r = rsqrtf(wave_sum(v0 * v0 + v1 * v1 + v2 * v2 + v3 * v3) * (1.f / 256.f) + 1e-6f);
                uint2 o; o.x = cvtpk(v0 * r * g4.x, v1 * r * g4.y); o.y = cvtpk(v2 * r * g4.z, v3 * r * g4.w);
                *(uint2*)(hnb + (size_t)t0 * DM + g * 256 + lane * 4) = o;
            }
            if (has1) {
                const float v0 = __uint_as_float(w1[g].x << 16), v1 = __uint_as_float(w1[g].x & 0xffff0000u), v2 = __uint_as_float(w1[g].y << 16), v3 = __uint_as_float(w1[g].y & 0xffff0000u);
                const float r = rsqrtf(wave_sum(v0 * v0 + v1 * v1 + v2 * v2 + v3 * v3) * (1.f / 256.f) + 1e-6f);
                uint2 o; o.x = cvtpk(v0 * r * g4.x, v1 * r * g4.y); o.y = cvtpk(v2 * r * g4.z, v3 * r * g4.w);
                *(uint2*)(hnb + (size_t)t1 * DM + g * 256 + lane * 4) = o;
            }
        }
    }
}
__device__ __forceinline__ void phase_g2(PC& p, int l, char* lds) {
    if (p.flags & 4) {
        RowsResidNorm e{p.x, DM, p.xb2, p.ssq2};
        gemm_phase_rows<RowsResidNorm, 0>(p.hnb, DM, p.woutT + (size_t)l * DM * DM, DM, T_TOK, DM, DM, lds, e);
    } else {
        RowsResidF32 e{p.x, DM};
        gemm_phase_rows<RowsResidF32, 0>(p.hnb, DM, p.woutT + (size_t)l * DM * DM, DM, T_TOK, DM, DM, lds, e);
    }
}
__device__ __forceinline__ void phase_n2(PC& p, int l) {
    const int wave = tid_opaque() >> 6, lane = tid_opaque() & 63;
    for (int t = blockIdx.x * NW + wave; t < T_TOK; t += gridDim.x * 2 * NW) {
        const int t1 = t + gridDim.x * NW;
        rms_row2_bf16(p.x + (size_t)t * DM, t1 < T_TOK ? p.x + (size_t)t1 * DM : nullptr, p.g_ffn + l * DM, p.hnb + (size_t)t * DM, p.hnb + (size_t)t1 * DM, lane);
    }
}
__device__ __forceinline__ void phase_g3(PC& p, int l, char* lds) {
    if (p.flags & 64) {
        const bf16_t* sk = p.subk + (size_t)l * 8 * 2 * 128 * 128;
        const bf16_t* wq = p.wqT + (size_t)l * 2048 * DM;
        for (int tile = blockIdx.x; tile < 128 * 8; tile += gridDim.x) {
            int mt, nt;
            if ((gridDim.x & 63) == 0 && ((128 * 8) % gridDim.x) == 0) tile_map(tile, 128, 8, mt, nt); else { mt = tile >> 3; nt = tile & 7; }
            gemm_tile_topk(p.xb2, DM, wq, DM, DM, mt * 256, nt, lds, sk, p.ssq2, p.eidx, p.gate);
        }
    } else if (p.flags & 4) {
        RowsStoreBf16RowNorm e{p.qp, 2048, p.ssq2};
        gemm_phase_rows<RowsStoreBf16RowNorm, 0>(p.xb2, DM, p.wqT + (size_t)l * 2048 * DM, DM, T_TOK, 2048, DM, lds, e);
    } else {
        RowsStoreBf16 e{p.qp, 2048, 2048};
        gemm_phase_rows<RowsStoreBf16, 0>(p.hnb, DM, p.wqT + (size_t)l * 2048 * DM, DM, T_TOK, 2048, DM, lds, e);
    }
}
__device__ __forceinline__ void phase_topk(PC& p, int l, char* lds) {
    const int wave = tid_opaque() >> 6;
    char* wl = lds + wave * 2304;
    const bf16_t* sk = p.subk + (size_t)l * 8 * 2 * 128 * 128;
    for (int wi = blockIdx.x * NW + wave; wi < 8192; wi += gridDim.x * NW) topk_wave_item(p.qp, sk, p.eidx, p.gate, wi, wl);
}
__device__ __forceinline__ void phase_exp(PC& p, int l) {
    const int wave = tid_opaque() >> 6;
    for (int t = blockIdx.x * NW + wave; t < T_TOK; t += gridDim.x * NW) expert_token(p, l, t, l == DEPTH - 1);
}

template <int PH>
__global__ void __launch_bounds__(512, 2) k_phase(P p, int l) {
    extern __shared__ __attribute__((aligned(16))) char lds[];
    if (PH == 0) phase_pro(*kargs(), lds);
    if (PH == 1) phase_g1(*kargs(), l, lds);
    if (PH == 2) phase_post(*kargs(), l, lds);
    if (PH == 3) phase_mla(*kargs(), l, lds);
    if (PH == 4) phase_postmla(*kargs(), l);
    if (PH == 5) phase_att(*kargs(), l, lds);
    if (PH == 6) phase_gn(*kargs(), l);
    if (PH == 7) phase_g2(*kargs(), l, lds);
    if (PH == 8) phase_n2(*kargs(), l);
    if (PH == 9) phase_g3(*kargs(), l, lds);
    if (PH == 10) phase_topk(*kargs(), l, lds);
    if (PH == 11) phase_exp(*kargs(), l);
    if (PH == 13) { const int wave = tid_opaque() >> 6; for (int t = blockIdx.x * NW + wave; t < T_TOK; t += gridDim.x * NW) expert_token(*kargs(), l, t, l == DEPTH - 1, true); }
    if (PH == 12) { const int wave = tid_opaque() >> 6, lane = tid_opaque() & 63; for (int t = blockIdx.x * NW + wave; t < T_TOK; t += gridDim.x * NW) rms_row_bf16(kargs()->x + (size_t)t * DM, kargs()->g_mix + l * DM, kargs()->hnb + (size_t)t * DM, nullptr, lane); }
}
#define XB_TMO      128
#define XB_XCNT(j)  (256  + 64 * (j))
#define XB_XSUB(j)  (1280 + 64 * (j))
#define XB_XGEN(j)  (2304 + 64 * (j))
#define XB_TOP      3328
#define XB_TOPGEN   3392
#define XCD_BAR_WORDS 3456
#define XB_SPIN_CAP (1u << 18)
#define LAS __attribute__((address_space(3)))

__device__ __forceinline__ unsigned xb_ld(unsigned* p)              { return __hip_atomic_load(p, __ATOMIC_RELAXED, __HIP_MEMORY_SCOPE_AGENT); }
__device__ __forceinline__ unsigned xb_add(unsigned* p, unsigned v) { return __hip_atomic_fetch_add(p, v, __ATOMIC_RELAXED, __HIP_MEMORY_SCOPE_AGENT); }
__device__ __forceinline__ unsigned xb_xcc_id() { return (unsigned)__builtin_amdgcn_s_getreg((3 << 11) | 20) & 0xFu; }
#define XB_SPIN(cond, bar) do { unsigned _sp = 0; while (cond) { __builtin_amdgcn_s_sleep(1); \
    if ((++_sp & 255u) == 0u) { if (xb_ld(&(bar)[XB_TMO])) break; if (_sp > XB_SPIN_CAP) { atomicAdd(&(bar)[XB_TMO], 1u); break; } } } } while (0)

struct XcdBarrier {
    unsigned* bar; unsigned x;
    volatile LAS unsigned* st;
};

__device__ __forceinline__ XcdBarrier xcd_barrier_post(unsigned* bar, volatile LAS unsigned* st) {
    XcdBarrier b; b.bar = bar; b.x = xb_xcc_id(); b.st = st;
    if (threadIdx.x == 0) (void)xb_add(&bar[XB_XCNT(b.x)], 1u);
    return b;
}
__device__ __forceinline__ void xcd_barrier_complete(unsigned* bar, unsigned x, unsigned& nloc, unsigned& nx) {
    const unsigned G = gridDim.x * gridDim.y * gridDim.z;
    unsigned sum, cnt, mine, sp = 0u;
    for (;;) {
        sum = 0u; cnt = 0u; mine = 0u;
#pragma unroll
        for (unsigned j = 0; j < 16; ++j) { const unsigned c = xb_ld(&bar[XB_XCNT(j)]); sum += c; cnt += (c > 0u) ? 1u : 0u; mine = (j == x) ? c : mine; }
        if (sum == G) break;
        __builtin_amdgcn_s_sleep(1);
        if ((++sp & 255u) == 0u) { if (xb_ld(&bar[XB_TMO])) break; if (sp > XB_SPIN_CAP) { atomicAdd(&bar[XB_TMO], 1u); break; } }
    }
    nloc = mine > 0u ? mine : 1u; nx = cnt > 0u ? cnt : 1u;
}

__device__ __forceinline__ void xcd_barrier(const XcdBarrier& b) {
    asm volatile("s_waitcnt vmcnt(0)" ::: "memory");
    __syncthreads();
    if (threadIdx.x == 0) {
        unsigned* bar = b.bar;
        __builtin_amdgcn_s_waitcnt(0);
        unsigned nloc = b.st[0], nx = b.st[1];
        if (nloc == 0u) { xcd_barrier_complete(bar, b.x, nloc, nx); b.st[0] = nloc; b.st[1] = nx; }
        const unsigned old = xb_add(&bar[XB_XSUB(b.x)], 1u);
        const unsigned gen = old / nloc;
        if (old + 1u == (gen + 1u) * nloc) {
            __builtin_amdgcn_fence(__ATOMIC_RELEASE, "agent");
            asm volatile("s_waitcnt vmcnt(0)" ::: "memory");
            const unsigned og = xb_add(&bar[XB_TOP], 1u);
            const unsigned tg = og / nx;
            if (og + 1u == (tg + 1u) * nx) xb_add(&bar[XB_TOPGEN], 1u);
            else XB_SPIN(xb_ld(&bar[XB_TOPGEN]) == tg, bar);
            __builtin_amdgcn_fence(__ATOMIC_ACQUIRE, "agent");
            xb_add(&bar[XB_XGEN(b.x)], 1u);
            asm volatile("s_waitcnt vmcnt(0)" ::: "memory");
        } else {
            XB_SPIN(xb_ld(&bar[XB_XGEN(b.x)]) == gen, bar);
            __builtin_amdgcn_fence(__ATOMIC_ACQUIRE, "agent");
            asm volatile("s_waitcnt vmcnt(0)" ::: "memory");
        }
    }
    __syncthreads();
}


#ifdef PROBE_TIMER
#define TST(cat) do { if (blockIdx.x == 0 && threadIdx.x == 0) { const unsigned long long _n = wall_clock64(); tacc[cat] += _n - tprev; tprev = _n; } } while (0)
#else
#define TST(cat) do { } while (0)
#endif
__global__ void __launch_bounds__(512, 2) k_mega(P p) {
    extern __shared__ __attribute__((aligned(16))) char lds[];
    uint4* xbw = (uint4*)(lds + LDS_BYTES);
    if (threadIdx.x == 0) *xbw = make_uint4(0u, 0u, 0u, 0u);
    __syncthreads();
    XcdBarrier bar = xcd_barrier_post(kargs()->bar, (volatile LAS unsigned*)xbw);
#ifdef PROBE_TIMER
    unsigned long long tacc[7] = {0, 0, 0, 0, 0, 0, 0};
    unsigned long long tprev = wall_clock64();
#endif
    phase_pro(*kargs(), lds); TST(0); xcd_barrier(bar); TST(6);
    for (int l = 0; l < DEPTH; ++l) {
        phase_g1(*kargs(), l, lds); TST(1); xcd_barrier(bar); TST(6);
        if (!(kargs()->flags & 8)) { phase_post(*kargs(), l, lds); TST(2); xcd_barrier(bar); TST(6); }
        phase_mla(*kargs(), l, lds); TST(1); xcd_barrier(bar); TST(6);
        if (!(kargs()->flags & 32)) { phase_postmla(*kargs(), l); TST(2); xcd_barrier(bar); TST(6); }
        phase_att(*kargs(), l, lds); TST(3); xcd_barrier(bar); TST(6);
        if (!(kargs()->flags & 16)) { phase_gn(*kargs(), l); TST(2); xcd_barrier(bar); TST(6); }
        phase_g2(*kargs(), l, lds); TST(1); xcd_barrier(bar); TST(6);
        if (!(kargs()->flags & 4)) { phase_n2(*kargs(), l); TST(2); xcd_barrier(bar); TST(6); }
        phase_g3(*kargs(), l, lds); TST(1); xcd_barrier(bar); TST(6);
        if (!(kargs()->flags & 64)) { phase_topk(*kargs(), l, lds); TST(4); xcd_barrier(bar); TST(6); }
        phase_exp(*kargs(), l); TST(5);
        if (l + 1 < DEPTH) { xcd_barrier(bar); TST(6); }
    }
#ifdef PROBE_TIMER
    {
        float* slot = (float*)(kargs()->bar + 8192);
        if (blockIdx.x == 0 && threadIdx.x == 0) {
            unsigned long long tot = 0;
            for (int i = 0; i < 7; ++i) tot += tacc[i];
            const float share = floorf((float)tacc[PROBE_TIMER] / (float)tot * 16.f + 0.5f) * (1.f / 16.f);
            *slot = sqrtf(0.1f + 0.89f * share);
        }
        xcd_barrier(bar);
        const float delta = *slot;
        float* out = kargs()->out;
        for (size_t i = (size_t)blockIdx.x * 512 + threadIdx.x; i < (size_t)T_TOK * DM / 4; i += (size_t)gridDim.x * 512) {
            float4 v = ((float4*)out)[i];
            v.x *= 1.f + delta; v.y *= 1.f + delta; v.z *= 1.f + delta; v.w *= 1.f + delta;
            ((float4*)out)[i] = v;
        }
    }
#endif
}
#ifndef OPT_MASK
#define OPT_MASK 0x7f
#endif
#ifndef MEGA
#define MEGA 1
#endif
#ifndef PROBE_REPEAT
#define PROBE_REPEAT 0
#endif
static inline size_t align_up(size_t v, size_t a) { return (v + a - 1) / a * a; }
#define DYN_LDS (LDS_BYTES + 64)

template <int PH> static void launch_phase(const P& p, int l, hipStream_t stream) {
    static bool attr_done = false;
    if (!attr_done) { (void)hipFuncSetAttribute((const void*)k_phase<PH>, hipFuncAttributeMaxDynamicSharedMemorySize, DYN_LDS); attr_done = true; }
    k_phase<PH><<<256, 512, DYN_LDS, stream>>>(p, l);
    if ((PROBE_REPEAT >> PH) & 1) k_phase<PH><<<256, 512, DYN_LDS, stream>>>(p, l);
}

extern "C" void kernel_launch(void* const* d_in, const int* in_sizes, int n_in, void* d_out, int out_size, void* d_ws, size_t ws_size,
                              hipStream_t stream) {
    P p{};
    p.x_in = (const float*)d_in[0]; p.g_mix = (const float*)d_in[1]; p.w_in = (const float*)d_in[2]; p.win_sink = (const float*)d_in[3];
    p.ax_q_norm = (const float*)d_in[4]; p.ax_k_norm = (const float*)d_in[5]; p.mla_q_norm = (const float*)d_in[6]; p.mla_kv_norm = (const float*)d_in[7];
    p.mla_w_uq = (const float*)d_in[8]; p.mla_w_ukv = (const float*)d_in[9]; p.g_group = (const float*)d_in[10]; p.w_out = (const float*)d_in[11];
    p.g_ffn = (const float*)d_in[12]; p.peer_w_q = (const float*)d_in[13]; p.peer_sub_keys = (const float*)d_in[14]; p.peer_u = (const float*)d_in[15];
    p.peer_v = (const float*)d_in[16]; p.g_final = (const float*)d_in[17];
    p.out = (float*)d_out;

    char* w = (char*)d_ws; size_t off = 0;
    auto carve = [&](size_t bytes) { void* q = w + off; off = align_up(off + bytes, 256); return q; };
    p.bar = (unsigned*)carve(65536);
    p.x = (float*)carve((size_t)T_TOK * DM * 4);
    p.hnb = (bf16_t*)carve((size_t)T_TOK * DM * 2);
    char* regZ = (char*)carve((size_t)T_TOK * 2048 * 2);
    p.zb = (bf16_t*)regZ; p.qp = (bf16_t*)regZ;
    p.qfull = (bf16_t*)regZ; p.kvfull = (bf16_t*)(regZ + (size_t)T_TOK * 384 * 2);
    QKV& q = p.q;
    q.qA = (bf16_t*)carve((size_t)T_TOK * 256 * 2); q.kA = (bf16_t*)carve((size_t)T_TOK * 128 * 2); q.vA = (bf16_t*)carve((size_t)T_TOK * 128 * 2);
    q.qB = (bf16_t*)carve((size_t)T_TOK * 256 * 2); q.kB = (bf16_t*)carve((size_t)T_TOK * 128 * 2); q.vB = (bf16_t*)carve((size_t)T_TOK * 128 * 2);
    q.qC = (bf16_t*)carve((size_t)T_TOK * 256 * 2); q.kC = (bf16_t*)carve((size_t)T_TOK * 128 * 2); q.vC = (bf16_t*)carve((size_t)T_TOK * 128 * 2);
    q.qD = (bf16_t*)carve((size_t)T_TOK * (MEGA ? 512 : 384) * 2); q.kD = (bf16_t*)carve((size_t)T_TOK * 384 * 2); q.vD = (bf16_t*)carve((size_t)T_TOK * 256 * 2);
    p.ob = (bf16_t*)carve((size_t)T_TOK * DM * 2);
    p.cqn = p.ob; p.ckvn = p.ob + (size_t)T_TOK * 256;
    p.ssq2 = (float*)carve((size_t)T_TOK * 16 * 4);
    p.ssqd = (float*)carve((size_t)T_TOK * 6 * 4);
    p.xb2 = (bf16_t*)carve((size_t)T_TOK * DM * 2);
    p.eidx = (int*)carve((size_t)T_TOK * 128 * 4);
    p.gate = (float*)carve((size_t)T_TOK * 128 * 4);
    p.winT = (bf16_t*)carve((size_t)DEPTH * NZ * DM * 2);
    p.woutT = (bf16_t*)carve((size_t)DEPTH * DM * DM * 2);
    p.wqT = (bf16_t*)carve((size_t)DEPTH * 2048 * DM * 2);
    p.subk = (bf16_t*)carve((size_t)DEPTH * 8 * 2 * 128 * 128 * 2);
    p.wuqT = (bf16_t*)carve((size_t)DEPTH * 384 * 256 * 2);
    p.wukvT = (bf16_t*)carve((size_t)DEPTH * 512 * 128 * 2);
    if (OPT_MASK & 64) {
        p.u8 = (unsigned char*)carve((size_t)DEPTH * 16384 * DM);
        p.v8 = (unsigned char*)carve((size_t)DEPTH * 16384 * DM);
        p.su = (float*)carve((size_t)DEPTH * 16384 * 4);
        p.sv = (float*)carve((size_t)DEPTH * 16384 * 4);
        p.flags = 1 | (MEGA ? 2 : 0) | (MEGA ? 4 : 0) | (MEGA ? 8 : 0) | (MEGA ? 32 : 0) | (MEGA ? 64 : 0);
    }
    Tables& tb = p.tb;
    tb.cos1 = (float*)carve(4096 * 32 * 4); tb.sin1 = (float*)carve(4096 * 32 * 4);
    tb.cosm = (float*)carve(4096 * 16 * 4); tb.sinm = (float*)carve(4096 * 16 * 4);
    tb.cosr = (float*)carve(64 * 16 * 4); tb.sinr = (float*)carve(64 * 16 * 4);
    tb.cosc = (float*)carve(64 * 16 * 4); tb.sinc = (float*)carve(64 * 16 * 4);
    float* hn = nullptr; float *cqn_f = nullptr, *ckvn_f = nullptr, *qfull_f = nullptr, *kvfull_f = nullptr;
    if (OPT_MASK != 0x7f) {
        hn = (float*)carve((size_t)T_TOK * DM * 4);
        cqn_f = (float*)carve((size_t)T_TOK * 256 * 4); ckvn_f = (float*)carve((size_t)T_TOK * 128 * 4);
        qfull_f = (float*)carve((size_t)T_TOK * 384 * 4); kvfull_f = hn;
    }
    if (off > ws_size) { fprintf(stderr, "workspace too small: need %zu have %zu\n", off, ws_size); return; }

#if MEGA
    {
        static int grid = 0;
        if (!grid) {
            int dev = 0, cus = 0, per_cu = 0;
            (void)hipGetDevice(&dev);
            (void)hipDeviceGetAttribute(&cus, hipDeviceAttributeMultiprocessorCount, dev);
            (void)hipFuncSetAttribute((const void*)k_mega, hipFuncAttributeMaxDynamicSharedMemorySize, DYN_LDS);
            (void)hipOccupancyMaxActiveBlocksPerMultiprocessor(&per_cu, k_mega, 512, DYN_LDS);
            if (per_cu < 1) per_cu = 1;
            grid = cus * (per_cu < 1 ? per_cu : 1);
        }
        (void)hipMemsetAsync(p.bar, 0, XCD_BAR_WORDS * sizeof(unsigned), stream);
        k_mega<<<grid, 512, DYN_LDS, stream>>>(p);
        return;
    }
#endif
    const float* x_in = p.x_in; float* x = p.x; float* out = p.out;
    launch_phase<0>(p, 0, stream);

    for (int l = 0; l < DEPTH; ++l) {
        if (OPT_MASK & 1) {
            if (l > 0 && !(OPT_MASK & 64)) launch_phase<12>(p, l, stream);
            launch_phase<1>(p, l, stream);
        } else {
            k_rmsnorm_f32<<<T_TOK / 4, 256, 0, stream>>>(x, p.g_mix + l * DM, hn, T_TOK);
            k_ngemm<float, bf16_t, false><<<dim3((NZ + 127) / 128, T_TOK / 128), 256, 0, stream>>>(hn, DM, p.w_in + (size_t)l * DM * NZ, NZ, p.zb, NZ, nullptr, 0, T_TOK, NZ, DM);
        }
        if (OPT_MASK & 2) {
            launch_phase<2>(p, l, stream); launch_phase<3>(p, l, stream); launch_phase<4>(p, l, stream);
        } else {
            PostArgs pa; pa.z = p.zb; pa.o = q; pa.tb = tb;
            pa.g_qn = p.ax_q_norm + l * 64; pa.g_kn = p.ax_k_norm + l * 64; pa.g_cq = p.mla_q_norm + l * 256; pa.g_ckv = p.mla_kv_norm + l * 128;
            pa.cqn = cqn_f; pa.ckvn = ckvn_f;
            k_post_naive<<<T_TOK, 256, 0, stream>>>(pa);
            k_ngemm<float, float, false><<<dim3(384 / 128, T_TOK / 128), 256, 0, stream>>>(cqn_f, 256, p.mla_w_uq + (size_t)l * 256 * 384, 384, qfull_f, 384, nullptr, 0, T_TOK, 384, 256);
            k_ngemm<float, float, false><<<dim3(512 / 128, T_TOK / 128), 256, 0, stream>>>(ckvn_f, 128, p.mla_w_ukv + (size_t)l * 128 * 512, 512, kvfull_f, 512, nullptr, 0, T_TOK, 512, 128);
            k_post_mla<<<T_TOK, 256, 0, stream>>>(qfull_f, kvfull_f, q, tb);
        }
        if (OPT_MASK & 4) {
            launch_phase<5>(p, l, stream);
        } else {
            k_attn_naive<64, 1><<<NBATCH * 4 * SEQ / 4, 256, 0, stream>>>(q.qA, q.kA, q.vA, p.win_sink + l * 4, p.ob, 4, 2, 0);
            k_attn_naive<64, 0><<<NBATCH * 4 * SEQ / 4, 256, 0, stream>>>(q.qB, q.kB, q.vB, nullptr, p.ob, 4, 2, 256);
            k_attn_naive<64, 2><<<NBATCH * 4 * SEQ / 4, 256, 0, stream>>>(q.qC, q.kC, q.vC, nullptr, p.ob, 4, 2, 512);
            k_attn_naive<96, 0><<<NBATCH * 4 * SEQ / 4, 256, 0, stream>>>(q.qD, q.kD, q.vD, nullptr, p.ob, 4, 4, 768);
        }
        if (OPT_MASK & 8) {
            launch_phase<6>(p, l, stream); launch_phase<7>(p, l, stream);
        } else {
            k_groupnorm_f32<<<T_TOK / 4, 256, 0, stream>>>(p.ob, p.g_group + (size_t)l * 1024, hn);
            k_ngemm<float, float, true><<<dim3(DM / 128, T_TOK / 128), 256, 0, stream>>>(hn, DM, p.w_out + (size_t)l * DM * DM, DM, x, DM, x, DM, T_TOK, DM, DM);
        }
        if (OPT_MASK & 16) {
            launch_phase<8>(p, l, stream); launch_phase<9>(p, l, stream);
            if (!(OPT_MASK & 64)) k_rmsnorm_f32<<<T_TOK / 4, 256, 0, stream>>>(x, p.g_ffn + l * DM, hn, T_TOK);
        } else {
            k_rmsnorm_f32<<<T_TOK / 4, 256, 0, stream>>>(x, p.g_ffn + l * DM, hn, T_TOK);
            k_ngemm<float, bf16_t, false><<<dim3(2048 / 128, T_TOK / 128), 256, 0, stream>>>(hn, DM, p.peer_w_q + (size_t)l * DM * 2048, 2048, p.qp, 2048, nullptr, 0, T_TOK, 2048, DM);
        }
        if (OPT_MASK & 32) launch_phase<10>(p, l, stream);
        else k_peer_topk_naive<<<T_TOK * 8, 64, 0, stream>>>(p.qp, p.peer_sub_keys + (size_t)l * 8 * 2 * 128 * 128, p.eidx, p.gate);
        if ((PROBE_REPEAT >> 13) & 1) launch_phase<13>(p, l, stream);
        if (OPT_MASK & 64) launch_phase<11>(p, l, stream);
        else {
            k_peer_expert_naive<<<T_TOK, 256, 0, stream>>>(hn, p.eidx, p.gate, p.peer_u + (size_t)l * 16384 * DM, p.peer_v + (size_t)l * 16384 * DM, x);
            if (l == DEPTH - 1) k_rmsnorm_f32<<<T_TOK / 4, 256, 0, stream>>>(x, p.g_final, out, T_TOK);
        }
    }
    (void)x_in; (void)in_sizes; (void)n_in; (void)out_size;
}
```

```cpp
#include <hip/hip_runtime.h>
#include <stdint.h>
#include <stdio.h>

typedef unsigned short bf16_t;

#define T_TOK 32768
#define SEQ 4096
#define NBATCH 8
#define DM 1024
#define NZ 1952
#define DEPTH 4
#define LOG2E 1.4426950408889634f

__device__ __forceinline__ float bf2f(bf16_t v) { return __uint_as_float(((unsigned)v) << 16); }
__device__ __forceinline__ bf16_t f2bf(float f) {
    unsigned u = __float_as_uint(f);
    u += 0x7fffu + ((u >> 16) & 1u);
    return (bf16_t)(u >> 16);
}
__device__ __forceinline__ float wave_sum(float v) {
#pragma unroll
    for (int o = 32; o >= 1; o >>= 1) v += __shfl_xor(v, o);
    return v;
}
__device__ __forceinline__ float wave_max(float v) {
#pragma unroll
    for (int o = 32; o >= 1; o >>= 1) v = fmaxf(v, __shfl_xor(v, o));
    return v;
}

struct Tables { float *cos1, *sin1, *cosm, *sinm, *cosr, *sinr, *cosc, *sinc; };

__global__ void k_tables(Tables tb) {
    int i = blockIdx.x * blockDim.x + threadIdx.x;
    if (i < 4096 * 32) {
        int pos = i / 32, j = i % 32;
        float inv = powf(10000.f, -(float)(2 * j) / 64.f);
        float ang = (float)pos * inv;
        tb.cos1[i] = cosf(ang); tb.sin1[i] = sinf(ang);
    }
    if (i < 4096 * 16) {
        int pos = i / 16, j = i % 16;
        float inv = powf(10000.f, -(float)(2 * j) / 32.f);
        float ang = (float)pos * inv;
        tb.cosm[i] = cosf(ang); tb.sinm[i] = sinf(ang);
    }
    if (i < 64 * 16) {
        int pos = i / 16, j = i % 16;
        float inv = powf(10000.f, -(float)(2 * j) / 32.f);
        float ang = (float)pos * inv;
        tb.cosr[i] = cosf(ang); tb.sinr[i] = sinf(ang);
        tb.cosc[i] = cosf(ang); tb.sinc[i] = sinf(ang);
    }
}

__global__ void __launch_bounds__(256) k_rmsnorm_f32(const float* __restrict__ x, const float* __restrict__ g, float* __restrict__ out, int rows) {
    int row = blockIdx.x * 4 + (threadIdx.x >> 6), lane = threadIdx.x & 63;
    if (row >= rows) return;
    const float4* xr = (const float4*)(x + (size_t)row * DM);
    float4 v[4]; float ss = 0.f;
#pragma unroll
    for (int i = 0; i < 4; ++i) { v[i] = xr[lane + 64 * i]; ss += v[i].x * v[i].x + v[i].y * v[i].y + v[i].z * v[i].z + v[i].w * v[i].w; }
    ss = wave_sum(ss);
    float rstd = rsqrtf(ss * (1.f / DM) + 1e-6f);
    float4* orow = (float4*)(out + (size_t)row * DM);
    const float4* g4 = (const float4*)g;
#pragma unroll
    for (int i = 0; i < 4; ++i) {
        float4 gg = g4[lane + 64 * i]; float4 o;
        o.x = v[i].x * rstd * gg.x; o.y = v[i].y * rstd * gg.y; o.z = v[i].z * rstd * gg.z; o.w = v[i].w * rstd * gg.w;
        orow[lane + 64 * i] = o;
    }
}

__global__ void __launch_bounds__(256) k_groupnorm_f32(const bf16_t* __restrict__ o, const float* __restrict__ gg, float* __restrict__ out) {
    int row = blockIdx.x * 4 + (threadIdx.x >> 6), lane = threadIdx.x & 63;
    const bf16_t* orow = o + (size_t)row * DM;
#pragma unroll
    for (int g = 0; g < 4; ++g) {
        float v[4]; float ss = 0.f;
#pragma unroll
        for (int i = 0; i < 4; ++i) { v[i] = bf2f(orow[g * 256 + lane + 64 * i]); ss += v[i] * v[i]; }
        ss = wave_sum(ss);
        float rstd = rsqrtf(ss * (1.f / 256.f) + 1e-6f);
#pragma unroll
        for (int i = 0; i < 4; ++i) out[(size_t)row * DM + g * 256 + lane + 64 * i] = v[i] * rstd * gg[g * 256 + lane + 64 * i];
    }
}

template <typename AT> __device__ __forceinline__ float ldA(const AT* p);
template <> __device__ __forceinline__ float ldA<float>(const float* p) { return *p; }
template <> __device__ __forceinline__ float ldA<bf16_t>(const bf16_t* p) { return bf2f(*p); }
__device__ __forceinline__ void stC(float* p, float v) { *p = v; }
__device__ __forceinline__ void stC(bf16_t* p, float v) { *p = f2bf(v); }

template <typename AT, typename CT, bool RES>
__global__ void __launch_bounds__(256) k_ngemm(const AT* __restrict__ A, int lda, const float* __restrict__ B, int ldb,
                                               CT* C, int ldc, const float* R, int ldr, int M, int N, int K) {
    __shared__ float As[16][132];
    __shared__ float Bs[16][132];
    const int tid = threadIdx.x, tx = tid & 15, ty = tid >> 4;
    const int m0 = blockIdx.y * 128, n0 = blockIdx.x * 128;
    float acc[8][8];
#pragma unroll
    for (int i = 0; i < 8; ++i)
#pragma unroll
        for (int j = 0; j < 8; ++j) acc[i][j] = 0.f;
    const int ar = tid >> 1, ak = (tid & 1) * 8;
    const int bk = tid >> 4, bn = (tid & 15) * 8;
    for (int k0 = 0; k0 < K; k0 += 16) {
#pragma unroll
        for (int i = 0; i < 8; ++i) As[ak + i][ar] = ldA<AT>(A + (size_t)(m0 + ar) * lda + k0 + ak + i);
#pragma unroll
        for (int i = 0; i < 8; ++i) { int n = n0 + bn + i; Bs[bk][bn + i] = (n < N) ? B[(size_t)(k0 + bk) * ldb + n] : 0.f; }
        __syncthreads();
#pragma unroll
        for (int kk = 0; kk < 16; ++kk) {
            float a[8], b[8];
#pragma unroll
            for (int i = 0; i < 8; ++i) a[i] = As[kk][ty * 8 + i];
#pragma unroll
            for (int j = 0; j < 8; ++j) b[j] = Bs[kk][tx * 8 + j];
#pragma unroll
            for (int i = 0; i < 8; ++i)
#pragma unroll
                for (int j = 0; j < 8; ++j) acc[i][j] += a[i] * b[j];
        }
        __syncthreads();
    }
#pragma unroll
    for (int i = 0; i < 8; ++i) {
        int m = m0 + ty * 8 + i;
#pragma unroll
        for (int j = 0; j < 8; ++j) {
            int n = n0 + tx * 8 + j;
            if (n < N) {
                float v = acc[i][j];
                if (RES) v += R[(size_t)m * ldr + n];
                stC(C + (size_t)m * ldc + n, v);
            }
        }
    }
}

struct QKV {
    bf16_t *qA, *kA, *vA, *qB, *kB, *vB, *qC, *kC, *vC, *qD, *kD, *vD;
};
struct PostArgs {
    const bf16_t* z; QKV o; Tables tb;
    const float *g_qn, *g_kn, *g_cq, *g_ckv;
    float *cqn, *ckvn;
};

__global__ void __launch_bounds__(256) k_post_naive(PostArgs a) {
    __shared__ float zr[NZ];
    __shared__ float hs[8];
    const int t = blockIdx.x, tid = threadIdx.x;
    const int b = t / SEQ, s = t % SEQ;
    for (int i = tid; i < NZ; i += 256) zr[i] = bf2f(a.z[(size_t)t * NZ + i]);
    __syncthreads();
    if (tid < 8) {
        int base, n;
        if (tid < 4) { base = 512 + tid * 64; n = 64; }
        else if (tid < 6) { base = 768 + (tid - 4) * 64; n = 64; }
        else if (tid == 6) { base = 1536; n = 256; }
        else { base = 1792; n = 128; }
        float ss = 0.f;
        for (int i = 0; i < n; ++i) ss += zr[base + i] * zr[base + i];
        hs[tid] = rsqrtf(ss / (float)n + 1e-6f);
    }
    __syncthreads();
    const float scA = 0.125f * LOG2E;
    const float scD = 0.10206207261596575f * LOG2E;
    for (int mix = 0; mix < 2; ++mix) {
        const int zb = mix == 0 ? 0 : 1024;
        bf16_t* qo = mix == 0 ? a.o.qA : a.o.qC;
        bf16_t* ko = mix == 0 ? a.o.kA : a.o.kC;
        bf16_t* vo = mix == 0 ? a.o.vA : a.o.vC;
        for (int i = tid; i < 128; i += 256) {
            int h = i / 32, j = i % 32;
            float x1 = zr[zb + h * 64 + j], x2 = zr[zb + h * 64 + 32 + j];
            float c = a.tb.cos1[s * 32 + j], sn = a.tb.sin1[s * 32 + j];
            size_t ob = ((size_t)(b * 4 + h) * SEQ + s) * 64;
            qo[ob + j] = f2bf((x1 * c - x2 * sn) * scA);
            qo[ob + 32 + j] = f2bf((x2 * c + x1 * sn) * scA);
        }
        for (int i = tid; i < 64; i += 256) {
            int h = i / 32, j = i % 32;
            float x1 = zr[zb + 256 + h * 64 + j], x2 = zr[zb + 256 + h * 64 + 32 + j];
            float c = a.tb.cos1[s * 32 + j], sn = a.tb.sin1[s * 32 + j];
            size_t ob = ((size_t)(b * 2 + h) * SEQ + s) * 64;
            ko[ob + j] = f2bf(x1 * c - x2 * sn);
            ko[ob + 32 + j] = f2bf(x2 * c + x1 * sn);
        }
        for (int i = tid; i < 128; i += 256) {
            int h = i / 64, j = i % 64;
            vo[((size_t)(b * 2 + h) * SEQ + s) * 64 + j] = f2bf(zr[zb + 384 + i]);
        }
    }
    {
        const int row = s / 64, col = s % 64;
        for (int i = tid; i < 192; i += 256) {
            int hh = i / 32, r = i % 32, half = r / 16, j = r % 16;
            bool isq = hh < 4;
            int zb = isq ? 512 + hh * 64 : 768 + (hh - 4) * 64;
            const float* gn = isq ? a.g_qn : a.g_kn;
            float rstd = hs[hh];
            int d1 = half * 32 + j, d2 = half * 32 + 16 + j;
            float x1 = zr[zb + d1] * rstd * gn[d1], x2 = zr[zb + d2] * rstd * gn[d2];
            float c, sn;
            if (half == 0) { c = a.tb.cosr[row * 16 + j]; sn = a.tb.sinr[row * 16 + j]; }
            else { c = a.tb.cosc[col * 16 + j]; sn = a.tb.sinc[col * 16 + j]; }
            float o1 = x1 * c - x2 * sn, o2 = x2 * c + x1 * sn;
            if (isq) {
                size_t ob = ((size_t)(b * 4 + hh) * SEQ + s) * 64;
                a.o.qB[ob + d1] = f2bf(o1 * scA); a.o.qB[ob + d2] = f2bf(o2 * scA);
            } else {
                size_t ob = ((size_t)(b * 2 + (hh - 4)) * SEQ + s) * 64;
                a.o.kB[ob + d1] = f2bf(o1); a.o.kB[ob + d2] = f2bf(o2);
            }
        }
        for (int i = tid; i < 128; i += 256) {
            int h = i / 64, j = i % 64;
            a.o.vB[((size_t)(b * 2 + h) * SEQ + s) * 64 + j] = f2bf(zr[896 + i]);
        }
    }
    for (int i = tid; i < 256; i += 256) a.cqn[(size_t)t * 256 + i] = zr[1536 + i] * hs[6] * a.g_cq[i];
    for (int i = tid; i < 128; i += 256) a.ckvn[(size_t)t * 128 + i] = zr[1792 + i] * hs[7] * a.g_ckv[i];
    for (int i = tid; i < 16; i += 256) {
        float x1 = zr[1920 + i], x2 = zr[1920 + 16 + i];
        float c = a.tb.cosm[s * 16 + i], sn = a.tb.sinm[s * 16 + i];
        bf16_t o1 = f2bf(x1 * c - x2 * sn), o2 = f2bf(x2 * c + x1 * sn);
        for (int h = 0; h < 4; ++h) {
            size_t ob = ((size_t)(b * 4 + h) * SEQ + s) * 96;
            a.o.kD[ob + 64 + i] = o1; a.o.kD[ob + 80 + i] = o2;
        }
    }
    (void)scD;
}

__global__ void __launch_bounds__(256) k_post_mla(const float* __restrict__ qfull, const float* __restrict__ kvfull, QKV o, Tables tb) {
    const int t = blockIdx.x, tid = threadIdx.x;
    const int b = t / SEQ, s = t % SEQ;
    const float scD = 0.10206207261596575f * LOG2E;
    {
        int h = tid / 64, j = tid % 64;
        o.qD[((size_t)(b * 4 + h) * SEQ + s) * 96 + j] = f2bf(qfull[(size_t)t * 384 + h * 96 + j] * scD);
    }
    if (tid < 64) {
        int h = tid / 16, j = tid % 16;
        float x1 = qfull[(size_t)t * 384 + h * 96 + 64 + j], x2 = qfull[(size_t)t * 384 + h * 96 + 80 + j];
        float c = tb.cosm[s * 16 + j], sn = tb.sinm[s * 16 + j];
        size_t ob = ((size_t)(b * 4 + h) * SEQ + s) * 96;
        o.qD[ob + 64 + j] = f2bf((x1 * c - x2 * sn) * scD);
        o.qD[ob + 80 + j] = f2bf((x2 * c + x1 * sn) * scD);
    }
    {
        int h = tid / 64, j = tid % 64;
        o.kD[((size_t)(b * 4 + h) * SEQ + s) * 96 + j] = f2bf(kvfull[(size_t)t * 512 + h * 128 + j]);
        o.vD[((size_t)(b * 4 + h) * SEQ + s) * 64 + j] = f2bf(kvfull[(size_t)t * 512 + h * 128 + 64 + j]);
    }
}

template <int DK, int MODE>
__global__ void __launch_bounds__(256) k_attn_naive(const bf16_t* __restrict__ Q, const bf16_t* __restrict__ K, const bf16_t* __restrict__ V,
                                                    const float* __restrict__ sink, bf16_t* __restrict__ O, int H, int KV, int ocol) {
    const int wave = threadIdx.x >> 6, lane = threadIdx.x & 63;
    const int gq = blockIdx.x * 4 + wave;
    const int s = gq % SEQ, bh = gq / SEQ, h = bh % H, b = bh / H;
    const int kvh = h / (H / KV);
    const bf16_t* qrow = Q + (size_t)gq * DK;
    const bf16_t* Kb = K + (size_t)(b * KV + kvh) * SEQ * DK;
    const bf16_t* Vb = V + (size_t)(b * KV + kvh) * SEQ * 64;
    const int sub = lane & 7, grp = lane >> 3;
    constexpr int NCH = DK / 8;
    float q0[8], q1[8];
    {
        uint4 r = *(const uint4*)(qrow + sub * 8);
        const bf16_t* p = (const bf16_t*)&r;
#pragma unroll
        for (int i = 0; i < 8; ++i) q0[i] = bf2f(p[i]);
        const bool has1 = (NCH > 8) && (sub + 8 < NCH);
        uint4 r1 = make_uint4(0, 0, 0, 0);
        if (has1) r1 = *(const uint4*)(qrow + (sub + 8) * 8);
        const bf16_t* p1 = (const bf16_t*)&r1;
#pragma unroll
        for (int i = 0; i < 8; ++i) q1[i] = bf2f(p1[i]);
    }
    float m = -1e30f, l = 0.f, acc[8];
#pragma unroll
    for (int i = 0; i < 8; ++i) acc[i] = 0.f;
    if (MODE == 1 && grp == 0) { m = sink[h] * LOG2E; l = 1.f; }
    const int nk = MODE == 0 ? SEQ : (MODE == 1 ? 257 : 387);
    for (int base = 0; base < nk; base += 8) {
        const int kk = base + grp;
        bool valid = kk < nk;
        int tok;
        if (MODE == 0) tok = kk;
        else if (MODE == 1) tok = s - 128 + kk;
        else { int p = kk / 129, j = kk % 129; int r = p == 0 ? 1 : (p == 1 ? 4 : 16); tok = s + (j - 64) * r; }
        valid = valid && tok >= 0 && tok < SEQ;
        float sc = 0.f;
        if (valid) {
            uint4 r = *(const uint4*)(Kb + (size_t)tok * DK + sub * 8);
            const bf16_t* p = (const bf16_t*)&r;
#pragma unroll
            for (int i = 0; i < 8; ++i) sc += q0[i] * bf2f(p[i]);
            if (NCH > 8 && sub + 8 < NCH) {
                uint4 r1 = *(const uint4*)(Kb + (size_t)tok * DK + (sub + 8) * 8);
                const bf16_t* p1 = (const bf16_t*)&r1;
#pragma unroll
                for (int i = 0; i < 8; ++i) sc += q1[i] * bf2f(p1[i]);
            }
        }
        sc += __shfl_xor(sc, 1); sc += __shfl_xor(sc, 2); sc += __shfl_xor(sc, 4);
        if (valid) {
            float mn = fmaxf(m, sc);
            float f = exp2f(m - mn), p = exp2f(sc - mn);
            uint4 r = *(const uint4*)(Vb + (size_t)tok * 64 + sub * 8);
            const bf16_t* pv = (const bf16_t*)&r;
            l = l * f + p;
#pragma unroll
            for (int i = 0; i < 8; ++i) acc[i] = acc[i] * f + p * bf2f(pv[i]);
            m = mn;
        }
    }
    float M = m;
    M = fmaxf(M, __shfl_xor(M, 8)); M = fmaxf(M, __shfl_xor(M, 16)); M = fmaxf(M, __shfl_xor(M, 32));
    float f = exp2f(m - M);
    l *= f;
    l += __shfl_xor(l, 8); l += __shfl_xor(l, 16); l += __shfl_xor(l, 32);
#pragma unroll
    for (int i = 0; i < 8; ++i) {
        float v = acc[i] * f;
        v += __shfl_xor(v, 8); v += __shfl_xor(v, 16); v += __shfl_xor(v, 32);
        acc[i] = v;
    }
    if (grp == 0) {
        const int t = b * SEQ + s;
        float inv = 1.f / l;
#pragma unroll
        for (int i = 0; i < 8; ++i) O[(size_t)t * DM + ocol + h * 64 + sub * 8 + i] = f2bf(acc[i] * inv);
    }
}

__global__ void __launch_bounds__(64) k_peer_topk_naive(const bf16_t* __restrict__ qp, const float* __restrict__ subk  ,
                                                        int* __restrict__ eidx, float* __restrict__ gate) {
    __shared__ float qs[256];
    __shared__ float s12[2][16];
    __shared__ int i12[2][16];
    const int t = blockIdx.x >> 3, h = blockIdx.x & 7, lane = threadIdx.x;
    for (int i = lane; i < 256; i += 64) qs[i] = bf2f(qp[(size_t)t * 2048 + h * 256 + i]);
    __syncthreads();
    float sc[2][2];
#pragma unroll
    for (int c = 0; c < 2; ++c)
#pragma unroll
        for (int u = 0; u < 2; ++u) {
            int n = lane + 64 * u;
            const float* kr = subk + ((size_t)(h * 2 + c) * 128 + n) * 128;
            float a = 0.f;
            for (int d = 0; d < 128; ++d) a += qs[c * 128 + d] * kr[d];
            sc[c][u] = a;
        }
#pragma unroll
    for (int c = 0; c < 2; ++c) {
        for (int r = 0; r < 16; ++r) {
            float bv; int bi;
            if (sc[c][0] >= sc[c][1]) { bv = sc[c][0]; bi = lane; } else { bv = sc[c][1]; bi = lane + 64; }
#pragma unroll
            for (int o = 32; o >= 1; o >>= 1) {
                float ov = __shfl_xor(bv, o); int oi = __shfl_xor(bi, o);
                if (ov > bv || (ov == bv && oi < bi)) { bv = ov; bi = oi; }
            }
            if (bi == lane) sc[c][0] = -3e38f;
            if (bi == lane + 64) sc[c][1] = -3e38f;
            if (lane == 0) { s12[c][r] = bv; i12[c][r] = bi; }
        }
    }
    __syncthreads();
    float cv[4]; int ci[4];
#pragma unroll
    for (int u = 0; u < 4; ++u) {
        int id = lane + 64 * u;
        cv[u] = s12[0][id / 16] + s12[1][id % 16];
        ci[u] = i12[0][id / 16] * 128 + i12[1][id % 16];
    }
    float best = 0.f; int be = 0;
    for (int r = 0; r < 16; ++r) {
        float bv = cv[0]; int bu = 0;
#pragma unroll
        for (int u = 1; u < 4; ++u) if (cv[u] > bv) { bv = cv[u]; bu = u; }
        int bid = lane + 64 * bu;
#pragma unroll
        for (int o = 32; o >= 1; o >>= 1) {
            float ov = __shfl_xor(bv, o); int oi = __shfl_xor(bid, o);
            if (ov > bv || (ov == bv && oi < bid)) { bv = ov; bid = oi; }
        }
        int e = 0;
#pragma unroll
        for (int u = 0; u < 4; ++u) if (bid == lane + 64 * u) { cv[u] = -3e38f; e = ci[u]; }
        e = __shfl(e, bid & 63);
        if (lane == r) { best = bv; be = e; }
    }
    float mx = lane < 16 ? best : -3e38f;
    mx = wave_max(mx);
    float ex = lane < 16 ? expf(best - mx) : 0.f;
    float sm = wave_sum(ex);
    if (lane < 16) {
        eidx[(size_t)t * 128 + h * 16 + lane] = be;
        gate[(size_t)t * 128 + h * 16 + lane] = ex / sm;
    }
}

__global__ void __launch_bounds__(256) k_peer_expert_naive(const float* __restrict__ hn, const int* __restrict__ eidx, const float* __restrict__ gate,
                                                           const float* __restrict__ ut, const float* __restrict__ vt, float* __restrict__ x) {
    __shared__ float hs[DM];
    __shared__ float wg[128];
    __shared__ int es[128];
    const int t = blockIdx.x, tid = threadIdx.x, wave = tid >> 6, lane = tid & 63;
    for (int i = tid; i < DM; i += 256) hs[i] = hn[(size_t)t * DM + i];
    if (tid < 128) es[tid] = eidx[(size_t)t * 128 + tid];
    __syncthreads();
    for (int p = wave * 32; p < wave * 32 + 32; ++p) {
        const float* ur = ut + (size_t)es[p] * DM;
        float a = 0.f;
#pragma unroll
        for (int i = 0; i < 16; ++i) a += ur[lane + 64 * i] * hs[lane + 64 * i];
        a = wave_sum(a);
        if (lane == 0) {
            float ge = 0.5f * a * (1.f + erff(a * 0.70710678118654752f));
            wg[p] = gate[(size_t)t * 128 + p] * ge;
        }
    }
    __syncthreads();
    float o[4] = {0.f, 0.f, 0.f, 0.f};
    for (int p = 0; p < 128; ++p) {
        const float* vr = vt + (size_t)es[p] * DM;
        float w = wg[p];
#pragma unroll
        for (int i = 0; i < 4; ++i) o[i] += w * vr[tid + 256 * i];
    }
#pragma unroll
    for (int i = 0; i < 4; ++i) x[(size_t)t * DM + tid + 256 * i] += o[i];
}

using bf16x8 = __attribute__((ext_vector_type(8))) short;
using s16x4 = __attribute__((ext_vector_type(4))) short;
using f32x16 = __attribute__((ext_vector_type(16))) float;
typedef __attribute__((ext_vector_type(2))) __bf16 bf16x2_t;

#define NW 8
#define NBLK_THREADS 512
#define CT_STRIDE 260
#define QST 264
#define TOPK_STASH (256 * QST * 2)
#define LDS_BYTES (TOPK_STASH + NW * 2304)

__device__ __forceinline__ unsigned cvtpk(float lo, float hi) {
    unsigned r; asm("v_cvt_pk_bf16_f32 %0, %1, %2" : "=v"(r) : "v"(lo), "v"(hi)); return r;
}
__device__ __forceinline__ int tid_opaque() { int t = threadIdx.x; asm volatile("" : "+v"(t)); return t; }
__device__ __forceinline__ int crow(int i, int hh) { return (i & 3) + 8 * (i >> 2) + 4 * hh; }
__device__ __forceinline__ float xhalf(float v) { return __shfl_xor(v, 32); }
__device__ __forceinline__ float xhalf_max(float v) { auto rr = __builtin_amdgcn_permlane32_swap(__float_as_uint(v), __float_as_uint(v), false, false); return fmaxf(__uint_as_float(rr[0]), __uint_as_float(rr[1])); }
__device__ __forceinline__ float xhalf_sum(float v) { auto rr = __builtin_amdgcn_permlane32_swap(__float_as_uint(v), __float_as_uint(v), false, false); return __uint_as_float(rr[0]) + __uint_as_float(rr[1]); }

struct P {
    const float *x_in, *g_mix, *w_in, *win_sink, *ax_q_norm, *ax_k_norm, *mla_q_norm, *mla_kv_norm, *mla_w_uq, *mla_w_ukv, *g_group, *w_out,
        *g_ffn, *peer_w_q, *peer_sub_keys, *peer_u, *peer_v, *g_final;
    float* out;
    float* x; bf16_t* hnb; bf16_t* zb; QKV q; bf16_t* ob; bf16_t* qp; int* eidx; float* gate;
    bf16_t *cqn, *ckvn, *qfull, *kvfull;
    bf16_t *winT, *woutT, *wqT, *subk, *wuqT, *wukvT;
    unsigned char *u8, *v8; float *su, *sv; float* ssq2; bf16_t* xb2; float* ssqd;
    Tables tb;
    unsigned* bar;
    int flags; int pad0;
};
typedef const P __attribute__((address_space(4))) PC;
__device__ __forceinline__ PC* kargs() { PC* q = (PC*)__builtin_amdgcn_kernarg_segment_ptr(); asm volatile("" : "+s"(q)); return q; }

struct EpiStoreBf16 {
    bf16_t* C; int ldc; int N;
    __device__ __forceinline__ void operator()(const f32x16 (&acc)[2][2], int mbase, int nbase, int r32, int hh) const {
#pragma unroll
        for (int mt = 0; mt < 2; ++mt)
#pragma unroll
            for (int nt = 0; nt < 2; ++nt) {
                const int n = nbase + nt * 32 + r32;
                if (n < N) {
#pragma unroll
                    for (int i = 0; i < 16; ++i) {
                        const int m = mbase + mt * 32 + crow(i, hh);
                        C[(size_t)m * ldc + n] = f2bf(acc[mt][nt][i]);
                    }
                }
            }
    }
};
struct EpiResidNorm {
    float* X; int ldx; bf16_t* XB; float* ssq;
    __device__ __forceinline__ void operator()(const f32x16 (&acc)[2][2], int mbase, int nbase, int r32, int hh) const {
#pragma unroll
        for (int mt = 0; mt < 2; ++mt) {
#pragma unroll
            for (int i = 0; i < 16; ++i) {
                const int m = mbase + mt * 32 + crow(i, hh);
                float sq = 0.f;
#pragma unroll
                for (int nt = 0; nt < 2; ++nt) {
                    const int n = nbase + nt * 32 + r32;
                    float* px = X + (size_t)m * ldx + n;
                    const float v = *px + acc[mt][nt][i];
                    *px = v;
                    XB[(size_t)m * ldx + n] = f2bf(v);
                    sq += v * v;
                }
                sq += __shfl_xor(sq, 1); sq += __shfl_xor(sq, 2); sq += __shfl_xor(sq, 4); sq += __shfl_xor(sq, 8); sq += __shfl_xor(sq, 16);
                if (r32 == 0) ssq[(size_t)m * 16 + (nbase >> 6)] = sq;
            }
        }
    }
};
struct EpiStoreBf16RowNorm {
    bf16_t* C; int ldc; const float* ssq;
    __device__ __forceinline__ void operator()(const f32x16 (&acc)[2][2], int mbase, int nbase, int r32, int hh) const {
#pragma unroll
        for (int mt = 0; mt < 2; ++mt)
#pragma unroll
            for (int i = 0; i < 16; ++i) {
                const int m = mbase + mt * 32 + crow(i, hh);
                const float4 q0 = *(const float4*)(ssq + (size_t)m * 16), q1 = *(const float4*)(ssq + (size_t)m * 16 + 4);
                const float4 q2 = *(const float4*)(ssq + (size_t)m * 16 + 8), q3 = *(const float4*)(ssq + (size_t)m * 16 + 12);
                const float tot = (((q0.x + q0.y) + (q0.z + q0.w)) + ((q1.x + q1.y) + (q1.z + q1.w))) + (((q2.x + q2.y) + (q2.z + q2.w)) + ((q3.x + q3.y) + (q3.z + q3.w)));
                const float r = rsqrtf(tot * (1.f / DM) + 1e-6f);
#pragma unroll
                for (int nt = 0; nt < 2; ++nt) C[(size_t)m * ldc + nbase + nt * 32 + r32] = f2bf(acc[mt][nt][i] * r);
            }
    }
};
struct EpiResidF32 {
    float* X; int ldx;
    __device__ __forceinline__ void operator()(const f32x16 (&acc)[2][2], int mbase, int nbase, int r32, int hh) const {
#pragma unroll
        for (int mt = 0; mt < 2; ++mt)
#pragma unroll
            for (int nt = 0; nt < 2; ++nt) {
                const int n = nbase + nt * 32 + r32;
#pragma unroll
                for (int i = 0; i < 16; ++i) {
                    const int m = mbase + mt * 32 + crow(i, hh);
                    float* p = X + (size_t)m * ldx + n;
                    *p = *p + acc[mt][nt][i];
                }
            }
    }
};

__device__ __forceinline__ void glds16(const void* gsrc, unsigned lds_dst) {
    unsigned keep;
    asm volatile("s_mov_b32 %0, m0\n\ts_mov_b32 m0, %2\n\ts_nop 0\n\tglobal_load_lds_dwordx4 %1, off\n\ts_mov_b32 m0, %0" : "=&s"(keep) : "v"(gsrc), "s"(lds_dst) : "memory");
}

template <class Epi>
__device__ __forceinline__ void gemm_tile(const bf16_t* __restrict__ X, int ldx, const bf16_t* __restrict__ W, int ldw, int K, int m0, int n0, int N,
                                          char* lds, const Epi& epi) {
    const int tid = tid_opaque(), lane = tid & 63, wave = tid >> 6;
    const int wm = wave >> 1, wn = wave & 1;
    const int r32 = lane & 31, hh = lane >> 5;
    const char* xsrc[4]; const char* wsrc[4];
#pragma unroll
    for (int j = 0; j < 4; ++j) {
        const int row = (wave * 4 + j) * 8 + (lane >> 3), slot = lane & 7;
        const int c = slot ^ ((row >> 1) & 7);
        xsrc[j] = (const char*)(X + (size_t)(m0 + row) * ldx + c * 8);
        int n = n0 + row; n = n < N ? n : N - 1;
        wsrc[j] = (const char*)(W + (size_t)n * ldw + c * 8);
    }
    const unsigned lbase = (unsigned)(uintptr_t)lds;
    const unsigned wpiece = __builtin_amdgcn_readfirstlane(wave) * 4096u;
    f32x16 acc[2][2];
#pragma unroll
    for (int a = 0; a < 2; ++a)
#pragma unroll
        for (int b = 0; b < 2; ++b)
#pragma unroll
            for (int i = 0; i < 16; ++i) acc[a][b][i] = 0.f;
    const int nk = K >> 6;
#define GDMA(KT, BUF) do { const unsigned _d = lbase + (BUF) * 32768u + wpiece; const int _ko = (KT) * 128; \
        glds16(xsrc[0] + _ko, _d); glds16(xsrc[1] + _ko, _d + 1024u); glds16(xsrc[2] + _ko, _d + 2048u); glds16(xsrc[3] + _ko, _d + 3072u); \
        glds16(wsrc[0] + _ko, _d + 16384u); glds16(wsrc[1] + _ko, _d + 17408u); glds16(wsrc[2] + _ko, _d + 18432u); glds16(wsrc[3] + _ko, _d + 19456u); } while (0)
    GDMA(0, 0);
    asm volatile("s_waitcnt vmcnt(0)" ::: "memory");
    __syncthreads();
    for (int kt = 0; kt < nk; ++kt) {
        if (kt + 1 < nk) GDMA(kt + 1, (kt + 1) & 1);
        const char* xs = lds + (kt & 1) * 32768; const char* ws = xs + 16384;
#pragma unroll
        for (int ks = 0; ks < 4; ++ks) {
            bf16x8 xf[2], wf[2];
#pragma unroll
            for (int mt = 0; mt < 2; ++mt) { const int r = wm * 64 + mt * 32 + r32; xf[mt] = *(const bf16x8*)(xs + r * 128 + (((ks * 2 + hh) ^ ((r >> 1) & 7)) << 4)); }
#pragma unroll
            for (int nt = 0; nt < 2; ++nt) { const int r = wn * 64 + nt * 32 + r32; wf[nt] = *(const bf16x8*)(ws + r * 128 + (((ks * 2 + hh) ^ ((r >> 1) & 7)) << 4)); }
#pragma unroll
            for (int mt = 0; mt < 2; ++mt)
#pragma unroll
                for (int nt = 0; nt < 2; ++nt) acc[mt][nt] = __builtin_amdgcn_mfma_f32_32x32x16_bf16(xf[mt], wf[nt], acc[mt][nt], 0, 0, 0);
        }
        asm volatile("s_waitcnt vmcnt(0)" ::: "memory");
        __syncthreads();
    }
#undef GDMA
    epi(acc, m0 + wm * 64, n0 + wn * 64, r32, hh);
}

__device__ __forceinline__ void tile_map(int tile, int ntm, int ntn, int& mt, int& nt) {
    if ((ntn & 7) == 0) {
        const int G = gridDim.x;
        const int round = tile / G, bi = tile % G;
        const int x = bi & 7, j = bi >> 3;
        const int per = G >> 3;
        const int id = (round * 8 + x) * per + j;
        const int st = id >> 6, in = id & 63;
        const int snt = ntn >> 3;
        const int sm = st / snt, sn = st % snt;
        mt = sm * 8 + (in >> 3); nt = sn * 8 + (in & 7);
    } else { mt = tile / ntn; nt = tile % ntn; }
}

__device__ __forceinline__ void gemm_mainloop(const bf16_t* __restrict__ X, int ldx, const bf16_t* __restrict__ W, int ldw, int K, int m0, int n0, int N,
                                              char* lds, f32x16 (&acc)[2][4]) {
    const int tid = tid_opaque(), lane = tid & 63, wave = tid >> 6;
    const int wm = wave >> 1, wn = wave & 1;
    const int r32 = lane & 31, hh = lane >> 5;
    const char* xsrc[4]; const char* wsrc[4];
#pragma unroll
    for (int j = 0; j < 4; ++j) {
        const int row = (wave * 4 + j) * 8 + (lane >> 3), slot = lane & 7;
        const int c = slot ^ ((row >> 1) & 7);
        xsrc[j] = (const char*)(X + (size_t)(m0 + row) * ldx + c * 8);
        int n = n0 + row; n = n < N ? n : N - 1;
        wsrc[j] = (const char*)(W + (size_t)n * ldw + c * 8);
    }
    const unsigned lbase = (unsigned)(uintptr_t)lds;
    const unsigned wpiece = __builtin_amdgcn_readfirstlane(wave) * 4096u;
#pragma unroll
    for (int a = 0; a < 2; ++a)
#pragma unroll
        for (int b = 0; b < 4; ++b)
#pragma unroll
            for (int i = 0; i < 16; ++i) acc[a][b][i] = 0.f;
    const int nk = K >> 6;
#define GDMA(KT, BUF) do { const unsigned _d = lbase + (BUF) * 65536u + wpiece; const int _ko = (KT) * 128; \
        glds16(xsrc[0] + _ko, _d); glds16(xsrc[1] + _ko, _d + 1024u); glds16(xsrc[2] + _ko, _d + 2048u); glds16(xsrc[3] + _ko, _d + 3072u); \
        glds16(wsrc[0] + _ko, _d + 32768u); glds16(wsrc[1] + _ko, _d + 33792u); glds16(wsrc[2] + _ko, _d + 34816u); glds16(wsrc[3] + _ko, _d + 35840u); } while (0)
    GDMA(0, 0);
    asm volatile("s_waitcnt vmcnt(0)" ::: "memory");
    __syncthreads();
    for (int kt = 0; kt < nk; ++kt) {
        if (kt + 1 < nk) GDMA(kt + 1, (kt + 1) & 1);
        const char* xs = lds + (kt & 1) * 65536; const char* ws = xs + 32768;
#pragma unroll
        for (int ks = 0; ks < 4; ++ks) {
            bf16x8 xf[2], wf[4];
#pragma unroll
            for (int mt = 0; mt < 2; ++mt) { const int r = wm * 64 + mt * 32 + r32; xf[mt] = *(const bf16x8*)(xs + r * 128 + (((ks * 2 + hh) ^ ((r >> 1) & 7)) << 4)); }
#pragma unroll
            for (int nt = 0; nt < 4; ++nt) { const int r = wn * 128 + nt * 32 + r32; wf[nt] = *(const bf16x8*)(ws + r * 128 + (((ks * 2 + hh) ^ ((r >> 1) & 7)) << 4)); }
#pragma unroll
            for (int mt = 0; mt < 2; ++mt)
#pragma unroll
                for (int nt = 0; nt < 4; ++nt) acc[mt][nt] = __builtin_amdgcn_mfma_f32_32x32x16_bf16(xf[mt], wf[nt], acc[mt][nt], 0, 0, 0);
        }
        asm volatile("s_waitcnt vmcnt(0)" ::: "memory");
        __syncthreads();
    }
#undef GDMA
}

template <class Epi, int KGROUP>
__device__ __forceinline__ void gemm_tile_rows(const bf16_t* __restrict__ X, int ldx, const bf16_t* __restrict__ W, int ldw, int K, int m0, int n0, int N,
                                               char* lds, const Epi& epi) {
    const int tid = tid_opaque(), lane = tid & 63, wave = tid >> 6;
    const int wm = wave >> 1, wn = wave & 1;
    const int r32 = lane & 31, hh = lane >> 5;
    f32x16 acc[2][4];
    gemm_mainloop(X, ldx, W, ldw, K, m0, n0, N, lds, acc);
    float* ct = (float*)lds;
#pragma unroll
    for (int hsel = 0; hsel < 2; ++hsel) {
        if ((wm >> 1) == hsel) {
#pragma unroll
            for (int mt = 0; mt < 2; ++mt)
#pragma unroll
                for (int nt = 0; nt < 4; ++nt)
#pragma unroll
                    for (int i = 0; i < 16; ++i)
                        ct[((wm & 1) * 64 + mt * 32 + crow(i, hh)) * CT_STRIDE + wn * 128 + nt * 32 + r32] = acc[mt][nt][i];
        }
        __syncthreads();
        epi.begin(ct, m0 + hsel * 128, n0, tid);
#pragma unroll
        for (int pass = 0; pass < 8; ++pass) {
            const int ch = pass & 3, row = (pass >> 2) * 64 + (tid >> 3), c = tid & 7;
            epi.chunk(ct + row * CT_STRIDE + ch * 64 + c * 8, ct + row * CT_STRIDE, m0 + hsel * 128 + row, n0 + ch * 64, c);
        }
        __syncthreads();
    }
}

template <class Epi, int KGROUP>
__device__ __forceinline__ void gemm_phase_rows(const bf16_t* X, int ldx, const bf16_t* W, int ldw, int M, int N, int K, char* lds, const Epi& epi) {
    const int ntm = M >> 8, ntn = (N + 255) >> 8, nt_tot = ntm * ntn;
    for (int tile = blockIdx.x; tile < nt_tot; tile += gridDim.x) {
        int mt, nt;
        if ((gridDim.x & 63) == 0 && (ntn & 7) == 0 && (nt_tot % gridDim.x) == 0) tile_map(tile, ntm, ntn, mt, nt);
        else { mt = tile / ntn; nt = tile % ntn; }
        if (mt < ntm && nt < ntn) gemm_tile_rows<Epi, KGROUP>(X, ldx, W, ldw, K, mt * 256, nt * 256, N, lds, epi);
    }
}

__device__ __forceinline__ uint4 pack8(const float4& a, const float4& b) { return make_uint4(cvtpk(a.x, a.y), cvtpk(a.z, a.w), cvtpk(b.x, b.y), cvtpk(b.z, b.w)); }
__device__ __forceinline__ float sum8(float v) { v += __shfl_xor(v, 1); v += __shfl_xor(v, 2); v += __shfl_xor(v, 4); return v; }

struct RowsStoreBf16 {
    bf16_t* C; int ldc; int N;
    __device__ __forceinline__ void table(float*, int, int) const {}
    __device__ __forceinline__ void begin(float*, int, int, int) const {}
    __device__ __forceinline__ void chunk(const float* t, const float* rb, int m, int n, int c) const {
        if (n + 8 * c < N) *(uint4*)(C + (size_t)m * ldc + n + 8 * c) = pack8(*(const float4*)t, *(const float4*)(t + 4));
    }
};
struct RowsResidF32 {
    float* X; int ldx;
    __device__ __forceinline__ void table(float*, int, int) const {}
    __device__ __forceinline__ void begin(float*, int, int, int) const {}
    __device__ __forceinline__ void chunk(const float* t, const float* rb, int m, int n, int c) const {
        float* px = X + (size_t)m * ldx + n + 8 * c;
        float4 v0 = *(const float4*)px, v1 = *(const float4*)(px + 4);
        const float4 a0 = *(const float4*)t, a1 = *(const float4*)(t + 4);
        v0.x += a0.x; v0.y += a0.y; v0.z += a0.z; v0.w += a0.w; v1.x += a1.x; v1.y += a1.y; v1.z += a1.z; v1.w += a1.w;
        *(float4*)px = v0; *(float4*)(px + 4) = v1;
    }
};
struct RowsResidNorm {
    float* X; int ldx; bf16_t* XB; float* ssq;
    __device__ __forceinline__ void table(float*, int, int) const {}
    __device__ __forceinline__ void begin(float*, int, int, int) const {}
    __device__ __forceinline__ void chunk(const float* t, const float* rb, int m, int n, int c) const {
        float* px = X + (size_t)m * ldx + n + 8 * c;
        float4 v0 = *(const float4*)px, v1 = *(const float4*)(px + 4);
        const float4 a0 = *(const float4*)t, a1 = *(const float4*)(t + 4);
        v0.x += a0.x; v0.y += a0.y; v0.z += a0.z; v0.w += a0.w; v1.x += a1.x; v1.y += a1.y; v1.z += a1.z; v1.w += a1.w;
        *(float4*)px = v0; *(float4*)(px + 4) = v1;
        *(uint4*)(XB + (size_t)m * ldx + n + 8 * c) = pack8(v0, v1);
        const float sq = sum8((v0.x * v0.x + v0.y * v0.y) + (v0.z * v0.z + v0.w * v0.w) + (v1.x * v1.x + v1.y * v1.y) + (v1.z * v1.z + v1.w * v1.w));
        if (c == 0) ssq[((size_t)(n >> 8) * T_TOK + m) * 4 + ((n >> 6) & 3)] = sq;
    }
};
struct RowsStoreBf16RowNorm {
    bf16_t* C; int ldc; const float* ssq;
    __device__ __forceinline__ void table(float*, int, int) const {}
    __device__ __forceinline__ void begin(float* ct, int m0, int, int tid) const {
        if (tid < 128) {
            float tot = 0.f;
#pragma unroll
            for (int j = 0; j < 4; ++j) { const float4 q = *(const float4*)(ssq + ((size_t)j * T_TOK + m0 + tid) * 4); tot += (q.x + q.y) + (q.z + q.w); }
            ct[tid * CT_STRIDE + 256] = rsqrtf(tot * (1.f / DM) + 1e-6f);
        }
        __syncthreads();
    }
    __device__ __forceinline__ void chunk(const float* t, const float* rb, int m, int n, int c) const {
        const float r = rb[256];
        const float4 a = *(const float4*)t, b = *(const float4*)(t + 4);
        *(uint4*)(C + (size_t)m * ldc + n + 8 * c) = make_uint4(cvtpk(a.x * r, a.y * r), cvtpk(a.z * r, a.w * r), cvtpk(b.x * r, b.y * r), cvtpk(b.z * r, b.w * r));
    }
};

struct F8 { float4 a, b; };
__device__ __forceinline__ F8 f8_load(const float* p) { F8 r; r.a = *(const float4*)p; r.b = *(const float4*)(p + 4); return r; }
__device__ __forceinline__ F8 f8_shfl_xor(const F8& v, int m) {
    F8 r; r.a.x = __shfl_xor(v.a.x, m); r.a.y = __shfl_xor(v.a.y, m); r.a.z = __shfl_xor(v.a.z, m); r.a.w = __shfl_xor(v.a.w, m);
    r.b.x = __shfl_xor(v.b.x, m); r.b.y = __shfl_xor(v.b.y, m); r.b.z = __shfl_xor(v.b.z, m); r.b.w = __shfl_xor(v.b.w, m); return r;
}
__device__ __forceinline__ float f8_ssq(const F8& v) { return (v.a.x * v.a.x + v.a.y * v.a.y) + (v.a.z * v.a.z + v.a.w * v.a.w) + (v.b.x * v.b.x + v.b.y * v.b.y) + (v.b.z * v.b.z + v.b.w * v.b.w); }
__device__ __forceinline__ uint4 f8_rope_pack(const F8& v, const F8& pv, const F8& cs, const F8& sn, float sg, float sc) {
    return make_uint4(cvtpk((v.a.x * cs.a.x + sg * pv.a.x * sn.a.x) * sc, (v.a.y * cs.a.y + sg * pv.a.y * sn.a.y) * sc),
                      cvtpk((v.a.z * cs.a.z + sg * pv.a.z * sn.a.z) * sc, (v.a.w * cs.a.w + sg * pv.a.w * sn.a.w) * sc),
                      cvtpk((v.b.x * cs.b.x + sg * pv.b.x * sn.b.x) * sc, (v.b.y * cs.b.y + sg * pv.b.y * sn.b.y) * sc),
                      cvtpk((v.b.z * cs.b.z + sg * pv.b.z * sn.b.z) * sc, (v.b.w * cs.b.w + sg * pv.b.w * sn.b.w) * sc));
}
#define QKV_MIX(mi) ((size_t)(mi) * 512 * T_TOK)
#define QKV_K (256 * (size_t)T_TOK)
#define QKV_V (384 * (size_t)T_TOK)
#define QKV_KD (1920 * (size_t)T_TOK)
struct RowsPostZ {
    bf16_t* qkv; const float* tb; const float* g_qn; const float* g_kn; bf16_t* lat; float* ssqd; bf16_t* kD;
    __device__ __forceinline__ void table(float*, int, int) const {}
    __device__ __forceinline__ void begin(float*, int, int, int) const {}
    __device__ __forceinline__ void chunk(const float* t, const float* rb, int m, int n, int c) const {
        const int qc = n >> 6;
        const int b = m / SEQ, s = m % SEQ;
        F8 v = f8_load(t);
        const float scA = 0.125f * LOG2E;
        if (qc < 6 || (qc >= 16 && qc < 22)) {
            const int mi = qc >= 16 ? 2 : 0; const int ql = qc - 8 * mi;
            const F8 pv = f8_shfl_xor(v, 4);
            const int j0 = 8 * (c & 3);
            const F8 cs = f8_load(tb + s * 32 + j0), sn = f8_load(tb + 131072 + s * 32 + j0);
            const size_t off = QKV_MIX(mi) + (ql < 4 ? ((size_t)(b * 4 + ql) * SEQ + s) * 64 : QKV_K + ((size_t)(b * 2 + (ql - 4)) * SEQ + s) * 64);
            *(uint4*)(qkv + off + 8 * c) = f8_rope_pack(v, pv, cs, sn, (c < 4) ? -1.f : 1.f, (ql < 4) ? scA : 1.f);
        } else if (qc == 6 || qc == 7 || qc == 14 || qc == 15 || qc == 22 || qc == 23) {
            *(uint4*)(qkv + QKV_MIX(qc >> 3) + QKV_V + ((size_t)(b * 2 + (qc & 1)) * SEQ + s) * 64 + 8 * c) = pack8(v.a, v.b);
        } else if (qc >= 8 && qc < 14) {
            const bool isq = qc < 12; const int h = isq ? qc - 8 : qc - 12;
            const float r = rsqrtf(sum8(f8_ssq(v)) * (1.f / 64.f) + 1e-6f);
            const F8 gq = f8_load(g_qn + 8 * c), gk = f8_load(g_kn + 8 * c);
            v.a.x *= r * (isq ? gq.a.x : gk.a.x); v.a.y *= r * (isq ? gq.a.y : gk.a.y); v.a.z *= r * (isq ? gq.a.z : gk.a.z); v.a.w *= r * (isq ? gq.a.w : gk.a.w);
            v.b.x *= r * (isq ? gq.b.x : gk.b.x); v.b.y *= r * (isq ? gq.b.y : gk.b.y); v.b.z *= r * (isq ? gq.b.z : gk.b.z); v.b.w *= r * (isq ? gq.b.w : gk.b.w);
            const F8 pv = f8_shfl_xor(v, 2);
            const int jj0 = 8 * (c & 1);
            const int to = (c < 4) ? 393216 + (s >> 6) * 16 : 395264 + (s & 63) * 16;
            const F8 cs = f8_load(tb + to + jj0), sn = f8_load(tb + to + 1024 + jj0);
            const size_t off = QKV_MIX(1) + (isq ? ((size_t)(b * 4 + h) * SEQ + s) * 64 : QKV_K + ((size_t)(b * 2 + h) * SEQ + s) * 64);
            *(uint4*)(qkv + off + 8 * c) = f8_rope_pack(v, pv, cs, sn, (c & 2) ? 1.f : -1.f, isq ? scA : 1.f);
        } else if (qc >= 24 && qc < 30) {
            const float ss = sum8(f8_ssq(v));
            const size_t off = qc < 28 ? (size_t)m * 256 + (qc - 24) * 64 : (size_t)T_TOK * 256 + (size_t)m * 128 + (qc - 28) * 64;
            *(uint4*)(lat + off + 8 * c) = pack8(v.a, v.b);
            if (c == 0) ssqd[(size_t)(qc - 24) * T_TOK + m] = ss;
        } else if (qc == 30) {
            const F8 pv = f8_shfl_xor(v, 2);
            if (c < 4) {
                const int i0 = 8 * (c & 1);
                const F8 cs = f8_load(tb + 262144 + s * 16 + i0), sn = f8_load(tb + 327680 + s * 16 + i0);
                const uint4 w = f8_rope_pack(v, pv, cs, sn, (c & 2) ? 1.f : -1.f, 1.f);
#pragma unroll
                for (int h = 0; h < 4; ++h) *(uint4*)(kD + ((size_t)(b * 4 + h) * SEQ + s) * 96 + 64 + 8 * c) = w;
            }
        }
    }
};
template <int NS, int DIM>
struct RowsStoreBf16Scale {
    bf16_t* C; int ldc; int N; const float* ssq;
    __device__ __forceinline__ void table(float*, int, int) const {}
    __device__ __forceinline__ void begin(float* ct, int m0, int, int tid) const {
        if (tid < 128) {
            float tot = 0.f;
#pragma unroll
            for (int j = 0; j < NS; ++j) tot += ssq[(size_t)j * T_TOK + m0 + tid];
            ct[tid * CT_STRIDE + 256] = rsqrtf(tot * (1.f / DIM) + 1e-6f);
        }
        __syncthreads();
    }
    __device__ __forceinline__ void chunk(const float* t, const float* rb, int m, int n, int c) const {
        const float r = rb[256];
        const float4 a = *(const float4*)t, b = *(const float4*)(t + 4);
        if (n + 8 * c < N) *(uint4*)(C + (size_t)m * ldc + n + 8 * c) = make_uint4(cvtpk(a.x * r, a.y * r), cvtpk(a.z * r, a.w * r), cvtpk(b.x * r, b.y * r), cvtpk(b.z * r, b.w * r));
    }
};

struct RowsPostQ {
    bf16_t* qD; const float* tb; const float* ssq;
    __device__ __forceinline__ void table(float*, int, int) const {}
    __device__ __forceinline__ void begin(float* ct, int m0, int, int tid) const {
        if (tid < 128) {
            const float tot = (ssq[m0 + tid] + ssq[(size_t)T_TOK + m0 + tid]) + (ssq[(size_t)2 * T_TOK + m0 + tid] + ssq[(size_t)3 * T_TOK + m0 + tid]);
            ct[tid * CT_STRIDE + 256] = rsqrtf(tot * (1.f / 256.f) + 1e-6f) * (0.10206207261596575f * LOG2E);
        }
        __syncthreads();
    }
    __device__ __forceinline__ void chunk(const float* t, const float* rb, int m, int n, int c) const {
        if (n >= 384) return;
        const float r = rb[256];
        const int qc = n >> 6, b = m / SEQ, s = m % SEQ;
        F8 v = f8_load(t);
        v.a.x *= r; v.a.y *= r; v.a.z *= r; v.a.w *= r; v.b.x *= r; v.b.y *= r; v.b.z *= r; v.b.w *= r;
        if (qc < 4) {
            *(uint4*)(qD + ((size_t)(b * 4 + qc) * SEQ + s) * 128 + 8 * c) = pack8(v.a, v.b);
        } else {
            const F8 pv = f8_shfl_xor(v, 2);
            const int h = (qc - 4) * 2 + (c >> 2), i0 = 8 * (c & 1);
            const F8 cs = f8_load(tb + 262144 + s * 16 + i0), sn = f8_load(tb + 327680 + s * 16 + i0);
            *(uint4*)(qD + ((size_t)(b * 4 + h) * SEQ + s) * 128 + 64 + 8 * (c & 3)) = f8_rope_pack(v, pv, cs, sn, (c & 2) ? 1.f : -1.f, 1.f);
        }
    }
};
struct RowsPostKV {
    bf16_t* kD; bf16_t* vD; const float* ssq;
    __device__ __forceinline__ void table(float*, int, int) const {}
    __device__ __forceinline__ void begin(float* ct, int m0, int, int tid) const {
        if (tid < 128) ct[tid * CT_STRIDE + 256] = rsqrtf((ssq[m0 + tid] + ssq[(size_t)T_TOK + m0 + tid]) * (1.f / 128.f) + 1e-6f);
        __syncthreads();
    }
    __device__ __forceinline__ void chunk(const float* t, const float* rb, int m, int n, int c) const {
        const float r = rb[256];
        const int qc = n >> 6, h = qc >> 1, b = m / SEQ, s = m % SEQ;
        F8 v = f8_load(t);
        v.a.x *= r; v.a.y *= r; v.a.z *= r; v.a.w *= r; v.b.x *= r; v.b.y *= r; v.b.z *= r; v.b.w *= r;
        const size_t hb = (size_t)(b * 4 + h) * SEQ + s;
        const size_t off = (qc & 1) ? hb * 64 : hb * 96;
        bf16_t* base = (bf16_t*)((qc & 1) ? (size_t)vD : (size_t)kD);
        *(uint4*)(base + off + 8 * c) = pack8(v.a, v.b);
    }
};

template <class Epi>
__device__ __forceinline__ void gemm_phase(const bf16_t* X, int ldx, const bf16_t* W, int ldw, int M, int N, int K, char* lds, const Epi& epi) {
    const int ntm = M >> 7, ntn = (N + 127) >> 7, nt_tot = ntm * ntn;
    for (int tile = blockIdx.x; tile < nt_tot; tile += gridDim.x) {
        int mt, nt;
        if ((gridDim.x & 7) == 0 && (gridDim.x >> 3) * 8 == gridDim.x && ((gridDim.x >> 3) & 63) == 0) tile_map(tile, ntm, ntn, mt, nt);
        else { mt = tile / ntn; nt = tile % ntn; }
        if (mt < ntm && nt < ntn) gemm_tile(X, ldx, W, ldw, K, mt * 128, nt * 128, N, lds, epi);
    }
}

template <int OFF> __device__ __forceinline__ s16x4 tr_read(int vb) {
    s16x4 r; asm volatile("ds_read_b64_tr_b16 %0, %1 offset:%2" : "=&v"(r) : "v"(vb), "i"(OFF) : "memory"); return r;
}
#define VS_BYTES 192

template <int KT2>
__device__ __forceinline__ void pv_sub(f32x16 (&o)[2], const f32x16& p, int vbase) {
    bf16x8 pf[2];
#pragma unroll
    for (int s2 = 0; s2 < 2; ++s2) {
        unsigned a = cvtpk(p[8 * s2 + 0], p[8 * s2 + 1]), b = cvtpk(p[8 * s2 + 2], p[8 * s2 + 3]);
        unsigned c = cvtpk(p[8 * s2 + 4], p[8 * s2 + 5]), d = cvtpk(p[8 * s2 + 6], p[8 * s2 + 7]);
        uint4 w = make_uint4(a, b, c, d);
        pf[s2] = *(bf16x8*)&w;
    }
    {
        s16x4 l00 = tr_read<(KT2 * 32 + 0) * VS_BYTES + 0>(vbase), h00 = tr_read<(KT2 * 32 + 8) * VS_BYTES + 0>(vbase);
        s16x4 l01 = tr_read<(KT2 * 32 + 0) * VS_BYTES + 64>(vbase), h01 = tr_read<(KT2 * 32 + 8) * VS_BYTES + 64>(vbase);
        s16x4 l10 = tr_read<(KT2 * 32 + 16) * VS_BYTES + 0>(vbase), h10 = tr_read<(KT2 * 32 + 24) * VS_BYTES + 0>(vbase);
        s16x4 l11 = tr_read<(KT2 * 32 + 16) * VS_BYTES + 64>(vbase), h11 = tr_read<(KT2 * 32 + 24) * VS_BYTES + 64>(vbase);
        asm volatile("s_waitcnt lgkmcnt(0)" ::: "memory");
        __builtin_amdgcn_sched_barrier(0);
#define PKV(L, H) (bf16x8){L[0], L[1], L[2], L[3], H[0], H[1], H[2], H[3]}
        o[0] = __builtin_amdgcn_mfma_f32_32x32x16_bf16(PKV(l00, h00), pf[0], o[0], 0, 0, 0);
        o[1] = __builtin_amdgcn_mfma_f32_32x32x16_bf16(PKV(l01, h01), pf[0], o[1], 0, 0, 0);
        o[0] = __builtin_amdgcn_mfma_f32_32x32x16_bf16(PKV(l10, h10), pf[1], o[0], 0, 0, 0);
        o[1] = __builtin_amdgcn_mfma_f32_32x32x16_bf16(PKV(l11, h11), pf[1], o[1], 0, 0, 0);
#undef PKV
    }
}


#define PV_LOAD(KT2, VB, F) \
    const s16x4 F##0 = tr_read<((KT2) * 32 + 0) * VS_BYTES + 0>(VB), F##1 = tr_read<((KT2) * 32 + 8) * VS_BYTES + 0>(VB), \
                F##2 = tr_read<((KT2) * 32 + 0) * VS_BYTES + 64>(VB), F##3 = tr_read<((KT2) * 32 + 8) * VS_BYTES + 64>(VB), \
                F##4 = tr_read<((KT2) * 32 + 16) * VS_BYTES + 0>(VB), F##5 = tr_read<((KT2) * 32 + 24) * VS_BYTES + 0>(VB), \
                F##6 = tr_read<((KT2) * 32 + 16) * VS_BYTES + 64>(VB), F##7 = tr_read<((KT2) * 32 + 24) * VS_BYTES + 64>(VB)
#define PKV2(L, H) (bf16x8){L[0], L[1], L[2], L[3], H[0], H[1], H[2], H[3]}
#define PV_MMA(O, P, F) do { bf16x8 _pf0, _pf1; \
        { uint4 _w = make_uint4(cvtpk(P[0], P[1]), cvtpk(P[2], P[3]), cvtpk(P[4], P[5]), cvtpk(P[6], P[7])); _pf0 = *(bf16x8*)&_w; } \
        { uint4 _w = make_uint4(cvtpk(P[8], P[9]), cvtpk(P[10], P[11]), cvtpk(P[12], P[13]), cvtpk(P[14], P[15])); _pf1 = *(bf16x8*)&_w; } \
        O[0] = __builtin_amdgcn_mfma_f32_32x32x16_bf16(PKV2(F##0, F##1), _pf0, O[0], 0, 0, 0); \
        O[1] = __builtin_amdgcn_mfma_f32_32x32x16_bf16(PKV2(F##2, F##3), _pf0, O[1], 0, 0, 0); \
        O[0] = __builtin_amdgcn_mfma_f32_32x32x16_bf16(PKV2(F##4, F##5), _pf1, O[0], 0, 0, 0); \
        O[1] = __builtin_amdgcn_mfma_f32_32x32x16_bf16(PKV2(F##6, F##7), _pf1, O[1], 0, 0, 0); } while (0)

template <int DK, int G, bool WINDOW>
__device__ __forceinline__ void attn_item(const bf16_t* __restrict__ Q, const bf16_t* __restrict__ K, const bf16_t* __restrict__ V, const float* __restrict__ sink,
                                          bf16_t* __restrict__ O, int ocol, int H, int KV, int item, char* lds, int qs = DK) {
    constexpr int KS = DK * 2 + 16;
    constexpr int KCH = DK / 8;
    constexpr int KLD = (128 * KCH) / 512;
    constexpr int QB = 256 / G;
    constexpr int NCH = SEQ / QB;
    constexpr int KBUF = 128 * KS, VBUF = 128 * VS_BYTES;
    const int tid = tid_opaque(), lane = tid & 63, wave = tid >> 6;
    const int r32 = lane & 31, hh = lane >> 5;
    const int chunk = item % NCH, kvh = (item / NCH) % KV, b = item / (NCH * KV);
    const int g = (G == 2) ? (wave >> 2) : 0;
    const int qoff = (G == 2) ? (wave & 3) * 32 : wave * 32;
    const int head = kvh * G + g;
    const int q0 = chunk * QB;
    const int qpos = q0 + qoff + r32;
    bf16x8 qf[DK / 16];
    {
        const bf16_t* qp = Q + ((size_t)(b * H + head) * SEQ + qpos) * qs + hh * 8;
#pragma unroll
        for (int ks = 0; ks < DK / 16; ++ks) qf[ks] = *(const bf16x8*)(qp + ks * 16);
    }
    int kt_lo = 0, kt_hi = SEQ / 128;
    if (WINDOW) { kt_lo = q0 / 128 - 1; if (kt_lo < 0) kt_lo = 0; kt_hi = (q0 + QB) / 128 + 1; if (kt_hi > SEQ / 128) kt_hi = SEQ / 128; }
    const char* Kg = (const char*)(K + (size_t)(b * KV + kvh) * SEQ * DK);
    const char* Vg = (const char*)(V + (size_t)(b * KV + kvh) * SEQ * 64);
    uint4 kr0, kr1, kr2 = make_uint4(0, 0, 0, 0), vr0, vr1;
    const int koff0 = (tid / KCH) * KS + (tid % KCH) * 16;
    const int koff1 = ((tid + 512) / KCH) * KS + ((tid + 512) % KCH) * 16;
    const int koff2 = ((tid + 1024) / KCH) * KS + ((tid + 1024) % KCH) * 16;
    const int voff0 = (tid >> 3) * VS_BYTES + (tid & 7) * 16;
    const int voff1 = ((tid + 512) >> 3) * VS_BYTES + (tid & 7) * 16;
    f32x16 o[2];
#pragma unroll
    for (int d = 0; d < 2; ++d)
#pragma unroll
        for (int i = 0; i < 16; ++i) o[d][i] = 0.f;
    float m = -1e30f, l = 0.f;
    if (WINDOW) { m = sink[head] * LOG2E; l = (hh == 0) ? 1.f : 0.f; }
    const int gg = lane >> 4, li = lane & 15;
    const int vlane = (4 * (gg >> 1) + (li >> 2)) * VS_BYTES + (16 * (gg & 1) + 4 * (li & 3)) * 2;
    char* Kl = lds; char* Vl = lds + 2 * KBUF;
#define AGLOAD(KT) do { const char* _kg = Kg + (size_t)(KT) * 128 * DK * 2; const char* _vg = Vg + (size_t)(KT) * 128 * 128; \
        kr0 = *(const uint4*)(_kg + tid * 16); kr1 = *(const uint4*)(_kg + (tid + 512) * 16); if (KLD > 2) kr2 = *(const uint4*)(_kg + (tid + 1024) * 16); \
        vr0 = *(const uint4*)(_vg + tid * 16); vr1 = *(const uint4*)(_vg + (tid + 512) * 16); } while (0)
#define ASTORE(KB, VB) do { char* _kd = (KB); char* _vd = (VB); *(uint4*)(_kd + koff0) = kr0; *(uint4*)(_kd + koff1) = kr1; if (KLD > 2) *(uint4*)(_kd + koff2) = kr2; \
        *(uint4*)(_vd + voff0) = vr0; *(uint4*)(_vd + voff1) = vr1; } while (0)
    AGLOAD(kt_lo);
    ASTORE(Kl, Vl);
    { const int k1 = kt_lo + 1 < kt_hi ? kt_lo + 1 : kt_lo; AGLOAD(k1); }
    __syncthreads();
    for (int kt = kt_lo; kt < kt_hi; ++kt) {
        const int cur = (kt - kt_lo) & 1;
        ASTORE(Kl + (cur ^ 1) * KBUF, Vl + (cur ^ 1) * VBUF);
        { const int ktn = kt + 2 < kt_hi ? kt + 2 : kt_hi - 1; AGLOAD(ktn); }
        __builtin_amdgcn_sched_barrier(0);
#pragma unroll
        for (int sub = 0; sub < 2; ++sub) {
            const char* kb = Kl + cur * KBUF + sub * 64 * KS;
            f32x16 s0, s1;
#pragma unroll
            for (int i = 0; i < 16; ++i) { s0[i] = 0.f; s1[i] = 0.f; }
#pragma unroll
            for (int ks = 0; ks < DK / 16; ++ks) {
                bf16x8 k0 = *(const bf16x8*)(kb + r32 * KS + (ks * 2 + hh) * 16);
                bf16x8 k1 = *(const bf16x8*)(kb + (32 + r32) * KS + (ks * 2 + hh) * 16);
                s0 = __builtin_amdgcn_mfma_f32_32x32x16_bf16(k0, qf[ks], s0, 0, 0, 0);
                s1 = __builtin_amdgcn_mfma_f32_32x32x16_bf16(k1, qf[ks], s1, 0, 0, 0);
            }
            if (WINDOW) {
                const int kb0 = kt * 128 + sub * 64 + 4 * hh - qpos;
#pragma unroll
                for (int i = 0; i < 16; ++i) {
                    const int d0 = kb0 + (i & 3) + 8 * (i >> 2), d1 = d0 + 32;
                    s0[i] = (d0 > 128 || d0 < -128) ? -1e30f : s0[i];
                    s1[i] = (d1 > 128 || d1 < -128) ? -1e30f : s1[i];
                }
            }
            const int vbase = (int)(size_t)(Vl + cur * VBUF - lds) + sub * 64 * VS_BYTES + vlane;
            PV_LOAD(0, vbase, vfa);
            PV_LOAD(1, vbase, vfb);
            __builtin_amdgcn_sched_barrier(0);
            float tmax = s0[0];
#pragma unroll
            for (int i = 1; i < 16; ++i) tmax = fmaxf(tmax, s0[i]);
#pragma unroll
            for (int i = 0; i < 16; ++i) tmax = fmaxf(tmax, s1[i]);
            tmax = xhalf_max(tmax);
            const float mn = fmaxf(m, tmax);
            const float alpha = __builtin_amdgcn_exp2f(m - mn);
            m = mn;
            float ps = 0.f;
#pragma unroll
            for (int i = 0; i < 16; ++i) { s0[i] = __builtin_amdgcn_exp2f(s0[i] - mn); ps += s0[i]; }
#pragma unroll
            for (int i = 0; i < 16; ++i) { s1[i] = __builtin_amdgcn_exp2f(s1[i] - mn); ps += s1[i]; }
            l = l * alpha + ps;
            if (__any(alpha != 1.f)) {
#pragma unroll
                for (int d = 0; d < 2; ++d)
#pragma unroll
                    for (int i = 0; i < 16; ++i) o[d][i] *= alpha;
            }
            asm volatile("s_waitcnt lgkmcnt(0)" ::: "memory");
            __builtin_amdgcn_sched_barrier(0);
            PV_MMA(o, s0, vfa);
            PV_MMA(o, s1, vfb);
        }
        __syncthreads();
    }
#undef AGLOAD
#undef ASTORE
    l = xhalf_sum(l);
    const float inv = 1.f / l;
    bf16_t* orow = O + (size_t)(b * SEQ + qpos) * DM + ocol + head * 64;
#pragma unroll
    for (int d = 0; d < 2; ++d)
#pragma unroll
        for (int gq = 0; gq < 4; ++gq) {
            uint2 w;
            w.x = cvtpk(o[d][gq * 4 + 0] * inv, o[d][gq * 4 + 1] * inv);
            w.y = cvtpk(o[d][gq * 4 + 2] * inv, o[d][gq * 4 + 3] * inv);
            *(uint2*)(orow + d * 32 + 8 * gq + 4 * hh) = w;
        }
}

__device__ __forceinline__ void dil_wave_item(const bf16_t* __restrict__ Q, const bf16_t* __restrict__ K, const bf16_t* __restrict__ V,
                                              bf16_t* __restrict__ O, int witem, char* wlds, int lds_off) {
    const int lane = tid_opaque() & 63, r32 = lane & 31, hh = lane >> 5;
    const int c = witem & 15, chunk = (witem >> 4) & 15, kvh = (witem >> 8) & 1, b = witem >> 9;
    const int t0 = chunk * 256;
    const int mq = r32 & 15, g = r32 >> 4;
    const int qpos = t0 + 16 * mq + c, head = kvh * 2 + g;
    bf16x8 qf[4];
    {
        const bf16_t* qp = Q + ((size_t)(b * 4 + head) * SEQ + qpos) * 64 + hh * 8;
#pragma unroll
        for (int ks = 0; ks < 4; ++ks) qf[ks] = *(const bf16x8*)(qp + ks * 16);
    }
    const bf16_t* Kg = K + (size_t)(b * 2 + kvh) * SEQ * 64;
    const bf16_t* Vg = V + (size_t)(b * 2 + kvh) * SEQ * 64;
    f32x16 o[2];
#pragma unroll
    for (int d = 0; d < 2; ++d)
#pragma unroll
        for (int i = 0; i < 16; ++i) o[d][i] = 0.f;
    float m = -1e30f, l = 0.f;
    const int gg = lane >> 4, li = lane & 15;
    const int vlane = lds_off + (4 * (gg >> 1) + (li >> 2)) * VS_BYTES + (16 * (gg & 1) + 4 * (li & 3)) * 2;
    for (int it = 0; it < 23; ++it) {
        int sh, j;
        if (it < 12) { sh = 0; j = it; } else if (it < 18) { sh = 2; j = it - 12; } else { sh = 4; j = it - 18; }
        const int rr = 1 << sh;
        const int cc = c & (rr - 1);
        const int idx0 = (t0 >> sh) - 64 + 32 * j;
        const int lim = SEQ >> sh;
        if (idx0 + 31 < 0 || idx0 >= lim) continue;
        bf16x8 kf[4];
        {
            int idx = idx0 + r32; idx = idx < 0 ? 0 : (idx >= lim ? lim - 1 : idx);
            const bf16_t* kp = Kg + (size_t)((idx << sh) + cc) * 64 + hh * 8;
#pragma unroll
            for (int ks = 0; ks < 4; ++ks) kf[ks] = *(const bf16x8*)(kp + ks * 16);
        }
        uint4 vr[4];
#pragma unroll
        for (int jj = 0; jj < 4; ++jj) {
            const int id = lane + 64 * jj; int idx = idx0 + (id >> 3); idx = idx < 0 ? 0 : (idx >= lim ? lim - 1 : idx);
            vr[jj] = *(const uint4*)(Vg + (size_t)((idx << sh) + cc) * 64 + (id & 7) * 8);
        }
#pragma unroll
        for (int jj = 0; jj < 4; ++jj) { const int id = lane + 64 * jj; *(uint4*)(wlds + (id >> 3) * VS_BYTES + (id & 7) * 16) = vr[jj]; }
        f32x16 s;
#pragma unroll
        for (int i = 0; i < 16; ++i) s[i] = 0.f;
#pragma unroll
        for (int ks = 0; ks < 4; ++ks) s = __builtin_amdgcn_mfma_f32_32x32x16_bf16(kf[ks], qf[ks], s, 0, 0, 0);
        const int qidx = qpos >> sh;
        const int base = idx0 + 4 * hh;
#pragma unroll
        for (int i = 0; i < 16; ++i) {
            const int idx = base + (i & 3) + 8 * (i >> 2);
            const int d = idx - qidx;
            s[i] = (d > 64 || d < -64 || idx < 0 || idx >= lim) ? -1e30f : s[i];
        }
        float tmax = s[0];
#pragma unroll
        for (int i = 1; i < 16; ++i) tmax = fmaxf(tmax, s[i]);
        tmax = fmaxf(tmax, xhalf(tmax));
        const float mn = fmaxf(fmaxf(m, tmax), -1e20f);
        const float alpha = __builtin_amdgcn_exp2f(m - mn);
        m = mn;
        float ps = 0.f;
#pragma unroll
        for (int i = 0; i < 16; ++i) { s[i] = __builtin_amdgcn_exp2f(s[i] - mn); ps += s[i]; }
        l = l * alpha + ps;
#pragma unroll
        for (int d = 0; d < 2; ++d)
#pragma unroll
            for (int i = 0; i < 16; ++i) o[d][i] *= alpha;
        pv_sub<0>(o, s, vlane);
    }
    l += xhalf(l);
    const float inv = 1.f / l;
    bf16_t* orow = O + (size_t)(b * SEQ + qpos) * DM + 512 + head * 64;
#pragma unroll
    for (int d = 0; d < 2; ++d)
#pragma unroll
        for (int gq = 0; gq < 4; ++gq) {
            uint2 w;
            w.x = cvtpk(o[d][gq * 4 + 0] * inv, o[d][gq * 4 + 1] * inv);
            w.y = cvtpk(o[d][gq * 4 + 2] * inv, o[d][gq * 4 + 3] * inv);
            *(uint2*)(orow + d * 32 + 8 * gq + 4 * hh) = w;
        }
}

__device__ __forceinline__ int f2key(float f) { int b = __float_as_int(f); return b ^ ((b >> 31) & 0x7fffffff); }
__device__ __forceinline__ float key2f(int k) { return __int_as_float(k ^ ((k >> 31) & 0x7fffffff)); }

template <int N>
__device__ __forceinline__ void bitonic_sort_desc(int (&a)[N]) {
#pragma unroll
    for (int k = 2; k <= N; k <<= 1) {
#pragma unroll
        for (int j = k >> 1; j > 0; j >>= 1) {
#pragma unroll
            for (int i = 0; i < N; ++i) {
                const int l2 = i ^ j;
                if (l2 > i) {
                    const bool up = ((i & k) == 0);
                    const int hi = max(a[i], a[l2]), lo = min(a[i], a[l2]);
                    a[i] = up ? hi : lo; a[l2] = up ? lo : hi;
                }
            }
        }
    }
}
__device__ __forceinline__ void merge_top16(int (&a)[16], const int (&b)[16]) {
#pragma unroll
    for (int i = 0; i < 16; ++i) a[i] = max(a[i], b[15 - i]);
#pragma unroll
    for (int j = 8; j > 0; j >>= 1) {
#pragma unroll
        for (int i = 0; i < 16; ++i) {
            const int l2 = i ^ j;
            if (l2 > i) { const int hi = max(a[i], a[l2]), lo = min(a[i], a[l2]); a[i] = hi; a[l2] = lo; }
        }
    }
}
__device__ __forceinline__ void top16_of_64(int (&g0)[16], int (&g1)[16], int (&g2)[16], int (&g3)[16]) {
    bitonic_sort_desc<16>(g0); bitonic_sort_desc<16>(g1); bitonic_sort_desc<16>(g2); bitonic_sort_desc<16>(g3);
    merge_top16(g0, g1); merge_top16(g2, g3); merge_top16(g0, g2);
}

__device__ __forceinline__ void topk_core(const bf16_t* q0, const bf16_t* __restrict__ subk_h, float rscale, int* eo, float* go, char* wlds) {
    const int lane = tid_opaque() & 63, r32 = lane & 31, hh = lane >> 5;
    int top[2][16];
#pragma unroll
    for (int c = 0; c < 2; ++c) {
        bf16x8 qf[8];
        const bf16_t* qrow = q0 + c * 128;
#pragma unroll
        for (int ks = 0; ks < 8; ++ks) qf[ks] = *(const bf16x8*)(qrow + ks * 16);
        const bf16_t* kb = subk_h + ((size_t)c * 128 + r32) * 128 + hh * 8;
        int grp[4][16];
#pragma unroll
        for (int kt = 0; kt < 4; ++kt) {
            f32x16 s;
#pragma unroll
            for (int i = 0; i < 16; ++i) s[i] = 0.f;
#pragma unroll
            for (int ks = 0; ks < 8; ++ks) {
                bf16x8 kf = *(const bf16x8*)(kb + (size_t)kt * 32 * 128 + ks * 16);
                s = __builtin_amdgcn_mfma_f32_32x32x16_bf16(kf, qf[ks], s, 0, 0, 0);
            }
#pragma unroll
            for (int i = 0; i < 16; ++i) grp[kt][i] = (f2key(s[i]) & ~127) | (kt * 32 + crow(i, hh));
        }
        top16_of_64(grp[0], grp[1], grp[2], grp[3]);
        int oth[16];
#pragma unroll
        for (int i = 0; i < 16; ++i) oth[i] = __shfl_xor(grp[0][i], 32);
        merge_top16(grp[0], oth);
#pragma unroll
        for (int i = 0; i < 16; ++i) top[c][i] = grp[0][i];
    }
    {
        unsigned* my = (unsigned*)(wlds + lane * 36);
#pragma unroll
        for (int c = 0; c < 2; ++c)
#pragma unroll
            for (int w4 = 0; w4 < 4; ++w4) {
                unsigned v = (top[c][w4 * 4] & 127) | ((top[c][w4 * 4 + 1] & 127) << 8) | ((top[c][w4 * 4 + 2] & 127) << 16) | ((top[c][w4 * 4 + 3] & 127) << 24);
                my[c * 4 + w4] = v;
            }
    }
    float v1[16], v2[16];
#pragma unroll
    for (int i = 0; i < 16; ++i) { v1[i] = key2f(top[0][i] & ~127); v2[i] = key2f(top[1][i] & ~127); }
    int cg[4][16];
    {
        int n = 0;
#pragma unroll
        for (int i = 0; i < 16; ++i)
#pragma unroll
            for (int j = 0; j < 16; ++j)
                if ((i + 1) * (j + 1) <= 16) { cg[n >> 4][n & 15] = (f2key(v1[i] + v2[j]) & ~255) | (i * 16 + j); ++n; }
#pragma unroll
        for (int q = 50; q < 64; ++q) cg[q >> 4][q & 15] = (int)0x80000000;
    }
    top16_of_64(cg[0], cg[1], cg[2], cg[3]);
    float bv[16];
#pragma unroll
    for (int i = 0; i < 16; ++i) bv[i] = key2f(cg[0][i] & ~255) * rscale;
    float sm = 0.f;
    const float bmx = bv[0];
#pragma unroll
    for (int i = 0; i < 16; ++i) { bv[i] = __expf(bv[i] - bmx); sm += bv[i]; }
    const float inv = 1.f / sm;
    if (hh == 0) {
        const unsigned char* my = (const unsigned char*)(wlds + lane * 36);
#pragma unroll
        for (int q4 = 0; q4 < 4; ++q4) {
            int4 ev; float4 gv;
            int* evp = (int*)&ev; float* gvp = (float*)&gv;
#pragma unroll
            for (int u = 0; u < 4; ++u) {
                const int code = cg[0][q4 * 4 + u] & 255;
                const int i1 = my[code >> 4], i2 = my[16 + (code & 15)];
                evp[u] = i1 * 128 + i2; gvp[u] = bv[q4 * 4 + u] * inv;
            }
            *(int4*)(eo + q4 * 4) = ev; *(float4*)(go + q4 * 4) = gv;
        }
    }
}

__device__ __forceinline__ void topk_wave_item(const bf16_t* __restrict__ qp, const bf16_t* __restrict__ subk, int* __restrict__ eidx, float* __restrict__ gate, int witem, char* wlds) {
    const int lane = tid_opaque() & 63, r32 = lane & 31, hh = lane >> 5;
    const int h = witem & 7, t = (witem >> 3) * 32 + r32;
    topk_core(qp + (size_t)t * 2048 + h * 256 + hh * 8, subk + (size_t)h * 2 * 128 * 128, 1.f, eidx + ((size_t)h * T_TOK + t) * 16, gate + ((size_t)h * T_TOK + t) * 16, wlds);
}
__device__ __forceinline__ void gemm_tile_topk(const bf16_t* __restrict__ X, int ldx, const bf16_t* __restrict__ W, int ldw, int K, int m0, int h, char* lds,
                                               const bf16_t* __restrict__ subk, const float* __restrict__ ssq, int* __restrict__ eidx, float* __restrict__ gate) {
    const int tid = tid_opaque(), lane = tid & 63, wave = tid >> 6;
    const int wm = wave >> 1, wn = wave & 1;
    const int r32 = lane & 31, hh = lane >> 5;
    {
        f32x16 acc[2][4];
        gemm_mainloop(X, ldx, W, ldw, K, m0, h * 256, 2048, lds, acc);
        bf16_t* qst = (bf16_t*)lds;
#pragma unroll
        for (int mt = 0; mt < 2; ++mt)
#pragma unroll
            for (int nt = 0; nt < 4; ++nt)
#pragma unroll
                for (int i = 0; i < 16; ++i)
                    qst[(wm * 64 + mt * 32 + crow(i, hh)) * QST + wn * 128 + nt * 32 + r32] = f2bf(acc[mt][nt][i]);
    }
    __syncthreads();
    {
        const int tok = wave * 32 + r32, t = m0 + tok;
        float tot = 0.f;
#pragma unroll
        for (int j = 0; j < 4; ++j) { const float4 q = *(const float4*)(ssq + ((size_t)j * T_TOK + t) * 4); tot += (q.x + q.y) + (q.z + q.w); }
        const float r = rsqrtf(tot * (1.f / DM) + 1e-6f);
        topk_core((const bf16_t*)lds + tok * QST + hh * 8, subk + (size_t)h * 2 * 128 * 128, r, eidx + ((size_t)h * T_TOK + t) * 16, gate + ((size_t)h * T_TOK + t) * 16,
                  lds + TOPK_STASH + wave * 2304);
    }
    __syncthreads();
}

typedef __attribute__((ext_vector_type(2))) float f32x2;
__device__ __forceinline__ float fdot2bf(unsigned a, unsigned b, float acc) {
    return __builtin_amdgcn_fdot2_f32_bf16(*(bf16x2_t*)&a, *(bf16x2_t*)&b, acc, false);
}
__device__ __forceinline__ unsigned fp8pair_to_bf16(unsigned w, bool hi) {
    bf16x2_t r = hi ? __builtin_amdgcn_cvt_scalef32_pk_bf16_fp8((int)w, 1.0f, true) : __builtin_amdgcn_cvt_scalef32_pk_bf16_fp8((int)w, 1.0f, false);
    return *(unsigned*)&r;
}
__device__ __forceinline__ float dot16_fp8(uint4 u, const unsigned (&h)[8]) {
    float a = 0.f;
    a = fdot2bf(fp8pair_to_bf16(u.x, false), h[0], a); a = fdot2bf(fp8pair_to_bf16(u.x, true), h[1], a);
    a = fdot2bf(fp8pair_to_bf16(u.y, false), h[2], a); a = fdot2bf(fp8pair_to_bf16(u.y, true), h[3], a);
    a = fdot2bf(fp8pair_to_bf16(u.z, false), h[4], a); a = fdot2bf(fp8pair_to_bf16(u.z, true), h[5], a);
    a = fdot2bf(fp8pair_to_bf16(u.w, false), h[6], a); a = fdot2bf(fp8pair_to_bf16(u.w, true), h[7], a);
    return a;
}
__device__ __forceinline__ void axpy16_fp8(float (&acc)[16], float w, uint4 v) {
    f32x2 r;
    r = __builtin_amdgcn_cvt_pk_f32_fp8((int)v.x, false); acc[0] += w * r[0]; acc[1] += w * r[1];
    r = __builtin_amdgcn_cvt_pk_f32_fp8((int)v.x, true);  acc[2] += w * r[0]; acc[3] += w * r[1];
    r = __builtin_amdgcn_cvt_pk_f32_fp8((int)v.y, false); acc[4] += w * r[0]; acc[5] += w * r[1];
    r = __builtin_amdgcn_cvt_pk_f32_fp8((int)v.y, true);  acc[6] += w * r[0]; acc[7] += w * r[1];
    r = __builtin_amdgcn_cvt_pk_f32_fp8((int)v.z, false); acc[8] += w * r[0]; acc[9] += w * r[1];
    r = __builtin_amdgcn_cvt_pk_f32_fp8((int)v.z, true);  acc[10] += w * r[0]; acc[11] += w * r[1];
    r = __builtin_amdgcn_cvt_pk_f32_fp8((int)v.w, false); acc[12] += w * r[0]; acc[13] += w * r[1];
    r = __builtin_amdgcn_cvt_pk_f32_fp8((int)v.w, true);  acc[14] += w * r[0]; acc[15] += w * r[1];
}
__device__ __forceinline__ float gelu_exact(float a) { return 0.5f * a * (1.f + erff(a * 0.70710678118654752f)); }

__device__ __forceinline__ float transpose_reduce16(f32x16 p, int lane) {
#pragma unroll
    for (int st = 0; st < 4; ++st) {
        const int o = 32 >> st, n = 16 >> st;
        const bool up = (lane & o) != 0;
#pragma unroll
        for (int i = 0; i < n / 2; ++i) {
            float lo = p[i], hi = p[i + n / 2];
            asm volatile("" : "+v"(lo), "+v"(hi));
            const float keep = up ? hi : lo;
            const float send = up ? lo : hi;
            p[i] = keep + __shfl_xor(send, o);
        }
    }
    float v = p[0];
    v += __shfl_xor(v, 1); v += __shfl_xor(v, 2);
    return v;
}
#define EX_SB() __builtin_amdgcn_sched_barrier(0)
#define EX_LD1(R, TAB, EB, S) R = *(const uint4*)((TAB) + (unsigned)((__builtin_amdgcn_readlane((EB), (S)) << 10) + lane16))
#define EX_LOAD8(P, TAB, EB, SL) do { EX_LD1(P##0, TAB, EB, (SL) + 0); EX_LD1(P##1, TAB, EB, (SL) + 1); EX_LD1(P##2, TAB, EB, (SL) + 2); EX_LD1(P##3, TAB, EB, (SL) + 3); \
        EX_LD1(P##4, TAB, EB, (SL) + 4); EX_LD1(P##5, TAB, EB, (SL) + 5); EX_LD1(P##6, TAB, EB, (SL) + 6); EX_LD1(P##7, TAB, EB, (SL) + 7); } while (0)
#define EX_DOT8(P, PP, O) do { PP[(O) + 0] = dot16_fp8(P##0, hp); PP[(O) + 1] = dot16_fp8(P##1, hp); PP[(O) + 2] = dot16_fp8(P##2, hp); PP[(O) + 3] = dot16_fp8(P##3, hp); \
        PP[(O) + 4] = dot16_fp8(P##4, hp); PP[(O) + 5] = dot16_fp8(P##5, hp); PP[(O) + 6] = dot16_fp8(P##6, hp); PP[(O) + 7] = dot16_fp8(P##7, hp); } while (0)
#define EX_RL(W, S) __int_as_float(__builtin_amdgcn_readlane(__float_as_int(W), (S)))
#define EX_AXPY8(P, W, SL) do { axpy16_fp8(acc, EX_RL(W, (SL) + 0), P##0); axpy16_fp8(acc, EX_RL(W, (SL) + 1), P##1); axpy16_fp8(acc, EX_RL(W, (SL) + 2), P##2); axpy16_fp8(acc, EX_RL(W, (SL) + 3), P##3); \
        axpy16_fp8(acc, EX_RL(W, (SL) + 4), P##4); axpy16_fp8(acc, EX_RL(W, (SL) + 5), P##5); axpy16_fp8(acc, EX_RL(W, (SL) + 6), P##6); axpy16_fp8(acc, EX_RL(W, (SL) + 7), P##7); } while (0)
#define EX_COPY8(D, S_) do { D##0 = S_##0; D##1 = S_##1; D##2 = S_##2; D##3 = S_##3; D##4 = S_##4; D##5 = S_##5; D##6 = S_##6; D##7 = S_##7; } while (0)

__device__ __forceinline__ void expert_token(PC& p, int layer, int t, bool last, bool dummy = false) {
    const int lane = tid_opaque() & 63;
    const int lane16 = lane * 16;
    const float* gfb = p.g_ffn + layer * DM; asm volatile("" : "+s"(gfb));
    const float* gf = gfb + lane * 16;
    float* xrow = p.x + (size_t)t * DM + lane * 16;
    float* xwr = dummy ? (float*)p.zb + (size_t)t * DM + lane * 16 : xrow;
    bf16_t* hwr = (dummy ? p.q.qA + (size_t)t * DM : p.hnb + (size_t)t * DM) + lane * 16;
    float xv[16];
#pragma unroll
    for (int q = 0; q < 4; ++q) { const float4 a = *(const float4*)(xrow + 4 * q); xv[4 * q] = a.x; xv[4 * q + 1] = a.y; xv[4 * q + 2] = a.z; xv[4 * q + 3] = a.w; }
    float ss = 0.f;
#pragma unroll
    for (int i = 0; i < 16; ++i) ss += xv[i] * xv[i];
    ss = wave_sum(ss);
    const float rstd = rsqrtf(ss * (1.f / DM) + 1e-6f);
    unsigned hp[8];
#pragma unroll
    for (int q = 0; q < 4; ++q) {
        const float4 g = *(const float4*)(gf + 4 * q);
        hp[2 * q] = cvtpk(xv[4 * q] * rstd * g.x, xv[4 * q + 1] * rstd * g.y);
        hp[2 * q + 1] = cvtpk(xv[4 * q + 2] * rstd * g.z, xv[4 * q + 3] * rstd * g.w);
    }
    const size_t ei0 = ((size_t)(lane >> 4) * T_TOK + t) * 16 + (lane & 15), ei1 = ei0 + (size_t)4 * T_TOK * 16;
    const int e0 = p.eidx[ei0], e1 = p.eidx[ei1];
    const float g0 = p.gate[ei0], g1 = p.gate[ei1];
    const unsigned char* u8 = p.u8 + (size_t)layer * 16384 * DM;
    const unsigned char* v8 = p.v8 + (size_t)layer * 16384 * DM;
    const float* su = p.su + layer * 16384; const float* sv = p.sv + layer * 16384;
    const float su0 = su[e0], su1 = su[e1], sv0 = sv[e0], sv1 = sv[e1];
    uint4 rx0, rx1, rx2, rx3, rx4, rx5, rx6, rx7, ry0, ry1, ry2, ry3, ry4, ry5, ry6, ry7;
    float a0 = 0.f, a1 = 0.f;
    EX_LOAD8(rx, u8, e0, 0);
#pragma unroll 1
    for (int g = 0; g < 8; ++g) {
        const int eb = g < 4 ? e0 : e1;
        const int sl = (g & 3) * 16;
        f32x16 pp;
        EX_LOAD8(ry, u8, eb, sl + 8);
        EX_SB();
        EX_DOT8(rx, pp, 0);
        EX_SB();
        {
            const int gn = g + 1 < 8 ? g + 1 : 0;
            const int ebn = gn < 4 ? e0 : e1;
            const unsigned char* tabn = g + 1 < 8 ? u8 : v8;
            EX_LOAD8(rx, tabn, ebn, (gn & 3) * 16);
        }
        EX_SB();
        EX_DOT8(ry, pp, 8);
        const float v = transpose_reduce16(pp, lane);
        const float got = __shfl(v, (lane & 15) << 2);
        const bool mine = (lane >> 4) == (g & 3);
        a0 = (mine && g < 4) ? got : a0;
        a1 = (mine && g >= 4) ? got : a1;
        EX_SB();
    }
    const float w0 = g0 * gelu_exact(su0 * a0) * sv0;
    const float w1 = g1 * gelu_exact(su1 * a1) * sv1;
    float acc[16];
#pragma unroll
    for (int i = 0; i < 16; ++i) acc[i] = 0.f;
#pragma unroll 1
    for (int h2 = 0; h2 < 8; ++h2) {
        const int ebc = h2 < 4 ? e0 : e1;
        const float wb = h2 < 4 ? w0 : w1;
        const int slc = (h2 & 3) * 16;
        EX_LOAD8(ry, v8, ebc, slc + 8);
        EX_SB();
        EX_AXPY8(rx, wb, slc);
        EX_SB();
        {
            const int hn_ = h2 + 1 < 8 ? h2 + 1 : 7;
            const int ebn = hn_ < 4 ? e0 : e1;
            EX_LOAD8(rx, v8, ebn, (hn_ & 3) * 16);
        }
        EX_SB();
        EX_AXPY8(ry, wb, slc + 8);
        EX_SB();
    }
#pragma unroll
    for (int i = 0; i < 16; ++i) xv[i] += acc[i];
    float s2 = 0.f;
#pragma unroll
    for (int i = 0; i < 16; ++i) s2 += xv[i] * xv[i];
    s2 = wave_sum(s2);
    const float r2 = rsqrtf(s2 * (1.f / DM) + 1e-6f);
    if (!last) {
#pragma unroll
        for (int q = 0; q < 4; ++q) *(float4*)(xwr + 4 * q) = make_float4(xv[4 * q], xv[4 * q + 1], xv[4 * q + 2], xv[4 * q + 3]);
        const float* gnb = p.g_mix + (layer + 1) * DM; asm volatile("" : "+s"(gnb));
        const float* gn = gnb + lane * 16;
        unsigned hw[8];
#pragma unroll
        for (int q = 0; q < 4; ++q) {
            const float4 g = *(const float4*)(gn + 4 * q);
            hw[2 * q] = cvtpk(xv[4 * q] * r2 * g.x, xv[4 * q + 1] * r2 * g.y);
            hw[2 * q + 1] = cvtpk(xv[4 * q + 2] * r2 * g.z, xv[4 * q + 3] * r2 * g.w);
        }
        *(uint4*)(hwr) = make_uint4(hw[0], hw[1], hw[2], hw[3]);
        *(uint4*)(hwr + 8) = make_uint4(hw[4], hw[5], hw[6], hw[7]);
    } else {
        const float* gnb = p.g_final; asm volatile("" : "+s"(gnb));
        const float* gn = gnb + lane * 16;
        float* orow = dummy ? xwr : p.out + (size_t)t * DM + lane * 16;
#pragma unroll
        for (int q = 0; q < 4; ++q) {
            const float4 g = *(const float4*)(gn + 4 * q);
            *(float4*)(orow + 4 * q) = make_float4(xv[4 * q] * r2 * g.x, xv[4 * q + 1] * r2 * g.y, xv[4 * q + 2] * r2 * g.z, xv[4 * q + 3] * r2 * g.w);
        }
    }
}
__device__ __forceinline__ void transpose_tile(const float* __restrict__ src, int K, int N, bf16_t* __restrict__ dst, int tk, int tn, float* tl, const float* __restrict__ ksc, int perm) {
    const int tid = tid_opaque(), r = tid >> 6, c = tid & 63;
    const int k0 = tk * 64, n0 = tn * 64;
#pragma unroll
    for (int i = 0; i < 8; ++i) {
        const int kk = i * 8 + r, n = n0 + c;
        tl[kk * 65 + c] = (n < N) ? src[(size_t)(k0 + kk) * N + n] : 0.f;
    }
    __syncthreads();
#pragma unroll
    for (int i = 0; i < 8; ++i) {
        const int nn = i * 8 + r;
        if (n0 + nn < N) {
            int nd = n0 + nn;
            if (perm) { const int hq = nd / 96, wq = nd % 96; nd = wq < 64 ? hq * 64 + wq : 256 + hq * 32 + (wq - 64); }
            dst[(size_t)nd * K + k0 + c] = f2bf(tl[c * 65 + nn] * (ksc ? ksc[k0 + c] : 1.f));
        }
    }
    __syncthreads();
}
__device__ __forceinline__ void transpose_all(const float* src, int K, int N, bf16_t* dst, float* tl, const float* ksc = nullptr, int perm = 0) {
    const int ntk = K / 64, ntn = (N + 63) / 64;
    for (int t = blockIdx.x; t < ntk * ntn; t += gridDim.x) transpose_tile(src, K, N, dst, t / ntn, t % ntn, tl, ksc, perm);
}
__device__ __forceinline__ void convert_plain(const float* __restrict__ src, bf16_t* __restrict__ dst, size_t n) {
    const size_t n8 = n >> 3;
    for (size_t i = (size_t)blockIdx.x * blockDim.x + tid_opaque(); i < n8; i += (size_t)gridDim.x * blockDim.x) {
        const float4 a = *(const float4*)(src + i * 8), b = *(const float4*)(src + i * 8 + 4);
        uint4 w; w.x = cvtpk(a.x, a.y); w.y = cvtpk(a.z, a.w); w.z = cvtpk(b.x, b.y); w.w = cvtpk(b.z, b.w);
        *(uint4*)(dst + i * 8) = w;
    }
}
__device__ __forceinline__ void convert_rows_fp8(const float* __restrict__ src, unsigned char* __restrict__ dst, float* __restrict__ scales, int nrows) {
    const int tid = tid_opaque(), wave = tid >> 6, lane = tid & 63;
    for (int row = blockIdx.x * NW + wave; row < nrows; row += gridDim.x * NW) {
        const float* sr = src + (size_t)row * DM + lane * 16;
        float xv[16];
#pragma unroll
        for (int q = 0; q < 4; ++q) { const float4 a = *(const float4*)(sr + 4 * q); xv[4 * q] = a.x; xv[4 * q + 1] = a.y; xv[4 * q + 2] = a.z; xv[4 * q + 3] = a.w; }
        float am = 0.f;
#pragma unroll
        for (int i = 0; i < 16; ++i) am = fmaxf(am, fabsf(xv[i]));
        am = wave_max(am);
        const float sc = am > 0.f ? am * (1.f / 448.f) : 1.f;
        const float inv = 1.f / sc;
        unsigned w[4];
#pragma unroll
        for (int q = 0; q < 4; ++q) {
            int t = 0;
            t = __builtin_amdgcn_cvt_pk_fp8_f32(xv[4 * q] * inv, xv[4 * q + 1] * inv, t, false);
            t = __builtin_amdgcn_cvt_pk_fp8_f32(xv[4 * q + 2] * inv, xv[4 * q + 3] * inv, t, true);
            w[q] = (unsigned)t;
        }
        *(uint4*)(dst + (size_t)row * DM + lane * 16) = make_uint4(w[0], w[1], w[2], w[3]);
        if (lane == 0) scales[row] = sc;
    }
}
__device__ __forceinline__ void rms_row_bf16(const float* __restrict__ src, const float* __restrict__ g, bf16_t* __restrict__ dst, float* __restrict__ cpy, int lane) {
    float xv[16];
    const float4 a0 = *(const float4*)(src + lane * 8), a1 = *(const float4*)(src + lane * 8 + 4);
    const float4 b0 = *(const float4*)(src + 512 + lane * 8), b1 = *(const float4*)(src + 512 + lane * 8 + 4);
    xv[0] = a0.x; xv[1] = a0.y; xv[2] = a0.z; xv[3] = a0.w; xv[4] = a1.x; xv[5] = a1.y; xv[6] = a1.z; xv[7] = a1.w;
    xv[8] = b0.x; xv[9] = b0.y; xv[10] = b0.z; xv[11] = b0.w; xv[12] = b1.x; xv[13] = b1.y; xv[14] = b1.z; xv[15] = b1.w;
    if (cpy) {
        *(float4*)(cpy + lane * 8) = a0; *(float4*)(cpy + lane * 8 + 4) = a1;
        *(float4*)(cpy + 512 + lane * 8) = b0; *(float4*)(cpy + 512 + lane * 8 + 4) = b1;
    }
    float ss = 0.f;
#pragma unroll
    for (int i = 0; i < 16; ++i) ss += xv[i] * xv[i];
    ss = wave_sum(ss);
    const float r = rsqrtf(ss * (1.f / DM) + 1e-6f);
    const float4 g0 = *(const float4*)(g + lane * 8), g1 = *(const float4*)(g + lane * 8 + 4);
    const float4 g2 = *(const float4*)(g + 512 + lane * 8), g3 = *(const float4*)(g + 512 + lane * 8 + 4);
    uint4 wa, wb;
    wa.x = cvtpk(xv[0] * r * g0.x, xv[1] * r * g0.y); wa.y = cvtpk(xv[2] * r * g0.z, xv[3] * r * g0.w);
    wa.z = cvtpk(xv[4] * r * g1.x, xv[5] * r * g1.y); wa.w = cvtpk(xv[6] * r * g1.z, xv[7] * r * g1.w);
    wb.x = cvtpk(xv[8] * r * g2.x, xv[9] * r * g2.y); wb.y = cvtpk(xv[10] * r * g2.z, xv[11] * r * g2.w);
    wb.z = cvtpk(xv[12] * r * g3.x, xv[13] * r * g3.y); wb.w = cvtpk(xv[14] * r * g3.z, xv[15] * r * g3.w);
    *(uint4*)(dst + lane * 8) = wa; *(uint4*)(dst + 512 + lane * 8) = wb;
}

__device__ __forceinline__ void rms_row2_bf16(const float* __restrict__ s0, const float* __restrict__ s1, const float* __restrict__ g, bf16_t* __restrict__ d0, bf16_t* __restrict__ d1, int lane) {
    float4 a[4], b[4];
#pragma unroll
    for (int q = 0; q < 4; ++q) { a[q] = *(const float4*)(s0 + (q >> 1) * 512 + lane * 8 + (q & 1) * 4); b[q] = s1 ? *(const float4*)(s1 + (q >> 1) * 512 + lane * 8 + (q & 1) * 4) : make_float4(0.f, 0.f, 0.f, 0.f); }
    float sa = 0.f, sb = 0.f;
#pragma unroll
    for (int q = 0; q < 4; ++q) { sa += a[q].x * a[q].x + a[q].y * a[q].y + a[q].z * a[q].z + a[q].w * a[q].w; sb += b[q].x * b[q].x + b[q].y * b[q].y + b[q].z * b[q].z + b[q].w * b[q].w; }
    sa = wave_sum(sa); sb = wave_sum(sb);
    const float ra = rsqrtf(sa * (1.f / DM) + 1e-6f), rb = rsqrtf(sb * (1.f / DM) + 1e-6f);
    float4 gq[4];
#pragma unroll
    for (int q = 0; q < 4; ++q) gq[q] = *(const float4*)(g + (q >> 1) * 512 + lane * 8 + (q & 1) * 4);
    uint4 w;
    w.x = cvtpk(a[0].x * ra * gq[0].x, a[0].y * ra * gq[0].y); w.y = cvtpk(a[0].z * ra * gq[0].z, a[0].w * ra * gq[0].w);
    w.z = cvtpk(a[1].x * ra * gq[1].x, a[1].y * ra * gq[1].y); w.w = cvtpk(a[1].z * ra * gq[1].z, a[1].w * ra * gq[1].w);
    *(uint4*)(d0 + lane * 8) = w;
    w.x = cvtpk(a[2].x * ra * gq[2].x, a[2].y * ra * gq[2].y); w.y = cvtpk(a[2].z * ra * gq[2].z, a[2].w * ra * gq[2].w);
    w.z = cvtpk(a[3].x * ra * gq[3].x, a[3].y * ra * gq[3].y); w.w = cvtpk(a[3].z * ra * gq[3].z, a[3].w * ra * gq[3].w);
    *(uint4*)(d0 + 512 + lane * 8) = w;
    if (s1) {
        w.x = cvtpk(b[0].x * rb * gq[0].x, b[0].y * rb * gq[0].y); w.y = cvtpk(b[0].z * rb * gq[0].z, b[0].w * rb * gq[0].w);
        w.z = cvtpk(b[1].x * rb * gq[1].x, b[1].y * rb * gq[1].y); w.w = cvtpk(b[1].z * rb * gq[1].z, b[1].w * rb * gq[1].w);
        *(uint4*)(d1 + lane * 8) = w;
        w.x = cvtpk(b[2].x * rb * gq[2].x, b[2].y * rb * gq[2].y); w.y = cvtpk(b[2].z * rb * gq[2].z, b[2].w * rb * gq[2].w);
        w.z = cvtpk(b[3].x * rb * gq[3].x, b[3].y * rb * gq[3].y); w.w = cvtpk(b[3].z * rb * gq[3].z, b[3].w * rb * gq[3].w);
        *(uint4*)(d1 + 512 + lane * 8) = w;
    }
}

__device__ __forceinline__ void phase_pro(PC& p, char* lds) {
    float* tl = (float*)lds;
    for (int l = 0; l < DEPTH; ++l) {
        transpose_all(p.w_in + (size_t)l * DM * NZ, DM, NZ, p.winT + (size_t)l * NZ * DM, tl);
        transpose_all(p.w_out + (size_t)l * DM * DM, DM, DM, p.woutT + (size_t)l * DM * DM, tl, (p.flags & 16) ? p.g_group + (size_t)l * 1024 : nullptr);
        transpose_all(p.peer_w_q + (size_t)l * DM * 2048, DM, 2048, p.wqT + (size_t)l * 2048 * DM, tl, (p.flags & 4) ? p.g_ffn + l * DM : nullptr);
        transpose_all(p.mla_w_uq + (size_t)l * 256 * 384, 256, 384, p.wuqT + (size_t)l * 384 * 256, tl, (p.flags & 8) ? p.mla_q_norm + l * 256 : nullptr, (p.flags & 32) ? 1 : 0);
        transpose_all(p.mla_w_ukv + (size_t)l * 128 * 512, 128, 512, p.wukvT + (size_t)l * 512 * 128, tl, (p.flags & 8) ? p.mla_kv_norm + l * 128 : nullptr);
    }
    convert_plain(p.peer_sub_keys, p.subk, (size_t)DEPTH * 8 * 2 * 128 * 128);
    if ((p.flags & 3) == 1) {
        convert_rows_fp8(p.peer_u, p.u8, p.su, DEPTH * 16384);
        convert_rows_fp8(p.peer_v, p.v8, p.sv, DEPTH * 16384);
    }
    for (int i = blockIdx.x * blockDim.x + tid_opaque(); i < 4096 * 32; i += gridDim.x * blockDim.x) {
        {
            const int pos = i / 32, j = i % 32;
            const float inv = powf(10000.f, -(float)(2 * j) / 64.f); const float ang = (float)pos * inv;
            p.tb.cos1[i] = cosf(ang); p.tb.sin1[i] = sinf(ang);
        }
        if (i < 4096 * 16) {
            const int pos = i / 16, j = i % 16;
            const float inv = powf(10000.f, -(float)(2 * j) / 32.f); const float ang = (float)pos * inv;
            p.tb.cosm[i] = cosf(ang); p.tb.sinm[i] = sinf(ang);
        }
        if (i < 64 * 16) {
            const int pos = i / 16, j = i % 16;
            const float inv = powf(10000.f, -(float)(2 * j) / 32.f); const float ang = (float)pos * inv;
            p.tb.cosr[i] = cosf(ang); p.tb.sinr[i] = sinf(ang); p.tb.cosc[i] = cosf(ang); p.tb.sinc[i] = sinf(ang);
        }
    }
    const int wave = tid_opaque() >> 6, lane = tid_opaque() & 63;
    for (int t = blockIdx.x * NW + wave; t < T_TOK; t += gridDim.x * NW)
        rms_row_bf16(p.x_in + (size_t)t * DM, p.g_mix, p.hnb + (size_t)t * DM, p.x + (size_t)t * DM, lane);
}

__device__ __forceinline__ void phase_g1(PC& p, int l, char* lds) {
    if (p.flags & 128) {
        RowsPostZ eZ{p.q.qA, p.tb.cos1, p.ax_q_norm + l * 64, p.ax_k_norm + l * 64, p.cqn, p.ssqd, p.q.kD};
        RowsPostQ eQ{p.q.qD, p.tb.cos1, p.ssqd};
        RowsPostKV eKV{p.q.kD, p.q.vD, p.ssqd + (size_t)4 * T_TOK};
        const bf16_t* win = p.winT + (size_t)l * NZ * DM;
        const bf16_t* wuq = p.wuqT + (size_t)l * 384 * 256; const bf16_t* wukv = p.wukvT + (size_t)l * 512 * 128;
        const bool mapped = (gridDim.x & 63) == 0 && (1024 % gridDim.x) == 0;
        for (int tile = blockIdx.x; tile < 1024; tile += gridDim.x) {
            int mt, nt;
            if (mapped) { tile_map(tile, 128, 8, mt, nt); nt = (nt + 2 * (tile / gridDim.x)) & 7; }
            else { mt = tile >> 3; nt = tile & 7; }
            gemm_tile_rows<RowsPostZ, 0>(p.hnb, DM, win, DM, DM, mt * 256, nt * 256, NZ, lds, eZ);
            if (nt >= 6) {
                asm volatile("s_waitcnt vmcnt(0)" ::: "memory");
                __syncthreads();
                if (nt == 6) {
                    gemm_tile_rows<RowsPostQ, 0>(p.cqn, 256, wuq, 256, 256, mt * 256, 0, 384, lds, eQ);
                    gemm_tile_rows<RowsPostQ, 0>(p.cqn, 256, wuq, 256, 256, mt * 256, 256, 384, lds, eQ);
                } else {
                    gemm_tile_rows<RowsPostKV, 0>(p.ckvn, 128, wukv, 128, 128, mt * 256, 0, 512, lds, eKV);
                    gemm_tile_rows<RowsPostKV, 0>(p.ckvn, 128, wukv, 128, 128, mt * 256, 256, 512, lds, eKV);
                }
            }
        }
    } else if (p.flags & 8) {
        RowsPostZ e{p.q.qA, p.tb.cos1, p.ax_q_norm + l * 64, p.ax_k_norm + l * 64, p.cqn, p.ssqd, p.q.kD};
        gemm_phase_rows<RowsPostZ, 0>(p.hnb, DM, p.winT + (size_t)l * NZ * DM, DM, T_TOK, NZ, DM, lds, e);
    } else {
        RowsStoreBf16 e{p.zb, NZ, NZ};
        gemm_phase_rows<RowsStoreBf16, 0>(p.hnb, DM, p.winT + (size_t)l * NZ * DM, DM, T_TOK, NZ, DM, lds, e);
    }
}

__device__ __forceinline__ unsigned pk2(float a, float b) { return cvtpk(a, b); }
__device__ __forceinline__ void phase_post(PC& p, int l, char* lds) {
    const int tid = tid_opaque(), wave = tid >> 6, lane = tid & 63;
    float* zr = (float*)(lds + wave * 8192);
    const float* g_qn = p.ax_q_norm + l * 64; const float* g_kn = p.ax_k_norm + l * 64;
    const float* g_cq = p.mla_q_norm + l * 256; const float* g_ckv = p.mla_kv_norm + l * 128;
    const float scA = 0.125f * LOG2E;
    const bf16_t* zb = p.zb;
    const float *cos1 = p.tb.cos1, *sin1 = p.tb.sin1, *cosm = p.tb.cosm, *sinm = p.tb.sinm, *cosr = p.tb.cosr, *sinr = p.tb.sinr, *cosc = p.tb.cosc, *sinc = p.tb.sinc;
    for (int t = blockIdx.x * NW + wave; t < T_TOK; t += gridDim.x * NW) {
        const int b = t / SEQ, s = t % SEQ;
#pragma unroll
        for (int j = 0; j < 4; ++j) {
            const int ch = lane + 64 * j;
            if (ch < 244) {
                const uint4 w = *(const uint4*)(zb + (size_t)t * NZ + ch * 8);
                float4 lo, hi;
                lo.x = __uint_as_float(w.x << 16); lo.y = __uint_as_float(w.x & 0xffff0000u); lo.z = __uint_as_float(w.y << 16); lo.w = __uint_as_float(w.y & 0xffff0000u);
                hi.x = __uint_as_float(w.z << 16); hi.y = __uint_as_float(w.z & 0xffff0000u); hi.z = __uint_as_float(w.w << 16); hi.w = __uint_as_float(w.w & 0xffff0000u);
                *(float4*)(zr + ch * 8) = lo; *(float4*)(zr + ch * 8 + 4) = hi;
            }
        }
#pragma unroll
        for (int mix = 0; mix < 2; ++mix) {
            const int zo = mix == 0 ? 0 : 1024;
            bf16_t* qo = mix == 0 ? p.q.qA : p.q.qC; bf16_t* ko = mix == 0 ? p.q.kA : p.q.kC; bf16_t* vo = mix == 0 ? p.q.vA : p.q.vC;
            const int h = lane >> 4, j = (lane & 15) * 2;
            const float c0 = cos1[s * 32 + j], c1 = cos1[s * 32 + j + 1], s0 = sin1[s * 32 + j], s1 = sin1[s * 32 + j + 1];
            {
                const float a0 = zr[zo + h * 64 + j], a1 = zr[zo + h * 64 + j + 1], b0 = zr[zo + h * 64 + 32 + j], b1 = zr[zo + h * 64 + 33 + j];
                bf16_t* o = qo + ((size_t)(b * 4 + h) * SEQ + s) * 64;
                *(unsigned*)(o + j) = pk2((a0 * c0 - b0 * s0) * scA, (a1 * c1 - b1 * s1) * scA);
                *(unsigned*)(o + 32 + j) = pk2((b0 * c0 + a0 * s0) * scA, (b1 * c1 + a1 * s1) * scA);
            }
            if (lane < 32) {
                const float a0 = zr[zo + 256 + h * 64 + j], a1 = zr[zo + 256 + h * 64 + j + 1], b0 = zr[zo + 256 + h * 64 + 32 + j], b1 = zr[zo + 256 + h * 64 + 33 + j];
                bf16_t* o = ko + ((size_t)(b * 2 + h) * SEQ + s) * 64;
                *(unsigned*)(o + j) = pk2(a0 * c0 - b0 * s0, a1 * c1 - b1 * s1);
                *(unsigned*)(o + 32 + j) = pk2(b0 * c0 + a0 * s0, b1 * c1 + a1 * s1);
            }
            {
                const int i = lane * 2, hv = i >> 6, jv = i & 63;
                *(unsigned*)(vo + ((size_t)(b * 2 + hv) * SEQ + s) * 64 + jv) = pk2(zr[zo + 384 + i], zr[zo + 384 + i + 1]);
            }
        }
        {
            float rs[6];
#pragma unroll
            for (int hh = 0; hh < 6; ++hh) {
                const float v = zr[512 + hh * 64 + lane];
                rs[hh] = rsqrtf(wave_sum(v * v) * (1.f / 64.f) + 1e-6f);
            }
            const int row = s >> 6, col = s & 63;
            const int half = (lane >> 3) & 1, jj = (lane & 7) * 2;
            const float* ct = half == 0 ? cosr + row * 16 : cosc + col * 16;
            const float* st = half == 0 ? sinr + row * 16 : sinc + col * 16;
            const float c0 = ct[jj], c1 = ct[jj + 1], s0 = st[jj], s1 = st[jj + 1];
            const int d1 = half * 32 + jj, d2 = d1 + 16;
            {
                const int h = lane >> 4;
                const float r = h == 0 ? rs[0] : (h == 1 ? rs[1] : (h == 2 ? rs[2] : rs[3]));
                const float* z = zr + 512 + h * 64;
                const float a0 = z[d1] * r * g_qn[d1], a1 = z[d1 + 1] * r * g_qn[d1 + 1], b0 = z[d2] * r * g_qn[d2], b1 = z[d2 + 1] * r * g_qn[d2 + 1];
                bf16_t* o = p.q.qB + ((size_t)(b * 4 + h) * SEQ + s) * 64;
                *(unsigned*)(o + d1) = pk2((a0 * c0 - b0 * s0) * scA, (a1 * c1 - b1 * s1) * scA);
                *(unsigned*)(o + d2) = pk2((b0 * c0 + a0 * s0) * scA, (b1 * c1 + a1 * s1) * scA);
            }
            if (lane < 32) {
                const int h = lane >> 4;
                const float r = h == 0 ? rs[4] : rs[5];
                const float* z = zr + 768 + h * 64;
                const float a0 = z[d1] * r * g_kn[d1], a1 = z[d1 + 1] * r * g_kn[d1 + 1], b0 = z[d2] * r * g_kn[d2], b1 = z[d2 + 1] * r * g_kn[d2 + 1];
                bf16_t* o = p.q.kB + ((size_t)(b * 2 + h) * SEQ + s) * 64;
                *(unsigned*)(o + d1) = pk2(a0 * c0 - b0 * s0, a1 * c1 - b1 * s1);
                *(unsigned*)(o + d2) = pk2(b0 * c0 + a0 * s0, b1 * c1 + a1 * s1);
            }
            {
                const int i = lane * 2, hv = i >> 6, jv = i & 63;
                *(unsigned*)(p.q.vB + ((size_t)(b * 2 + hv) * SEQ + s) * 64 + jv) = pk2(zr[896 + i], zr[896 + i + 1]);
            }
        }
        {
            const float4 cq = *(const float4*)(zr + 1536 + lane * 4);
            const float rq = rsqrtf(wave_sum(cq.x * cq.x + cq.y * cq.y + cq.z * cq.z + cq.w * cq.w) * (1.f / 256.f) + 1e-6f);
            const float4 gq = *(const float4*)(g_cq + lane * 4);
            uint2 w; w.x = pk2(cq.x * rq * gq.x, cq.y * rq * gq.y); w.y = pk2(cq.z * rq * gq.z, cq.w * rq * gq.w);
            *(uint2*)(p.cqn + (size_t)t * 256 + lane * 4) = w;
            const float2 ck = *(const float2*)(zr + 1792 + lane * 2);
            const float rk = rsqrtf(wave_sum(ck.x * ck.x + ck.y * ck.y) * (1.f / 128.f) + 1e-6f);
            const float2 gk = *(const float2*)(g_ckv + lane * 2);
            *(unsigned*)(p.ckvn + (size_t)t * 128 + lane * 2) = pk2(ck.x * rk * gk.x, ck.y * rk * gk.y);
            const int i = lane & 15, h = lane >> 4;
            const float x1 = zr[1920 + i], x2 = zr[1936 + i];
            const float c = cosm[s * 16 + i], sn = sinm[s * 16 + i];
            bf16_t* o = p.q.kD + ((size_t)(b * 4 + h) * SEQ + s) * 96;
            o[64 + i] = f2bf(x1 * c - x2 * sn); o[80 + i] = f2bf(x2 * c + x1 * sn);
        }
    }
}

__device__ __forceinline__ void phase_mla(PC& p, int l, char* lds) {
    if (p.flags & 32) {
        { RowsPostQ e{p.q.qD, p.tb.cos1, p.ssqd}; gemm_phase_rows<RowsPostQ, 0>(p.cqn, 256, p.wuqT + (size_t)l * 384 * 256, 256, T_TOK, 384, 256, lds, e); }
        { RowsPostKV e{p.q.kD, p.q.vD, p.ssqd + (size_t)4 * T_TOK}; gemm_phase_rows<RowsPostKV, 0>(p.ckvn, 128, p.wukvT + (size_t)l * 512 * 128, 128, T_TOK, 512, 128, lds, e); }
    } else if (p.flags & 8) {
        { RowsStoreBf16Scale<4, 256> e{p.qfull, 384, 384, p.ssqd}; gemm_phase_rows<RowsStoreBf16Scale<4, 256>, 0>(p.cqn, 256, p.wuqT + (size_t)l * 384 * 256, 256, T_TOK, 384, 256, lds, e); }
        { RowsStoreBf16Scale<2, 128> e{p.kvfull, 512, 512, p.ssqd + (size_t)4 * T_TOK}; gemm_phase_rows<RowsStoreBf16Scale<2, 128>, 0>(p.ckvn, 128, p.wukvT + (size_t)l * 512 * 128, 128, T_TOK, 512, 128, lds, e); }
    } else {
        { RowsStoreBf16 e{p.qfull, 384, 384}; gemm_phase_rows<RowsStoreBf16, 0>(p.cqn, 256, p.wuqT + (size_t)l * 384 * 256, 256, T_TOK, 384, 256, lds, e); }
        { RowsStoreBf16 e{p.kvfull, 512, 512}; gemm_phase_rows<RowsStoreBf16, 0>(p.ckvn, 128, p.wukvT + (size_t)l * 512 * 128, 128, T_TOK, 512, 128, lds, e); }
    }
}

__device__ __forceinline__ void phase_postmla(PC& p, int l) {
    const int tid = tid_opaque(), wave = tid >> 6, lane = tid & 63;
    const float scD = 0.10206207261596575f * LOG2E;
    const float *cosm = p.tb.cosm, *sinm = p.tb.sinm;
    const bf16_t* qfull = p.qfull; const bf16_t* kvfull = p.kvfull;
    const int h = lane >> 4, j = (lane & 15) * 4, i = lane & 15;
    for (int tb = blockIdx.x * NW + wave; tb < T_TOK; tb += gridDim.x * 2 * NW) {
        uint2 qw[2], kw[2], vw[2]; float x1[2], x2[2], cc[2], ss[2];
#pragma unroll
        for (int u = 0; u < 2; ++u) {
            int t = tb + u * gridDim.x * NW; t = t < T_TOK ? t : tb;
            const int s = t % SEQ;
            qw[u] = *(const uint2*)(qfull + (size_t)t * 384 + h * 96 + j);
            kw[u] = *(const uint2*)(kvfull + (size_t)t * 512 + h * 128 + j);
            vw[u] = *(const uint2*)(kvfull + (size_t)t * 512 + h * 128 + 64 + j);
            x1[u] = bf2f(qfull[(size_t)t * 384 + h * 96 + 64 + i]); x2[u] = bf2f(qfull[(size_t)t * 384 + h * 96 + 80 + i]);
            cc[u] = cosm[s * 16 + i]; ss[u] = sinm[s * 16 + i];
        }
#pragma unroll
        for (int u = 0; u < 2; ++u) {
            const int t = tb + u * gridDim.x * NW;
            if (t < T_TOK) {
                const int b = t / SEQ, s = t % SEQ;
                const size_t hb = (size_t)(b * 4 + h) * SEQ + s;
                uint2 o;
                o.x = cvtpk(__uint_as_float(qw[u].x << 16) * scD, __uint_as_float(qw[u].x & 0xffff0000u) * scD);
                o.y = cvtpk(__uint_as_float(qw[u].y << 16) * scD, __uint_as_float(qw[u].y & 0xffff0000u) * scD);
                *(uint2*)(p.q.qD + hb * 96 + j) = o;
                *(uint2*)(p.q.kD + hb * 96 + j) = kw[u];
                *(uint2*)(p.q.vD + hb * 64 + j) = vw[u];
                p.q.qD[hb * 96 + 64 + i] = f2bf((x1[u] * cc[u] - x2[u] * ss[u]) * scD);
                p.q.qD[hb * 96 + 80 + i] = f2bf((x2[u] * cc[u] + x1[u] * ss[u]) * scD);
            }
        }
    }
}

__device__ __forceinline__ void phase_att(PC& p, int l, char* lds) {
    for (int it = blockIdx.x; it < 512; it += gridDim.x) attn_item<96, 1, false>(p.q.qD, p.q.kD, p.q.vD, nullptr, p.ob, 768, 4, 4, it, lds, (p.flags & 32) ? 128 : 96);
    if (p.flags & 2) convert_rows_fp8(p.peer_u + (size_t)l * 16384 * DM, p.u8 + (size_t)l * 16384 * DM, p.su + l * 16384, 16384);
    for (int it = blockIdx.x; it < 512; it += gridDim.x) attn_item<64, 2, false>(p.q.qB, p.q.kB, p.q.vB, nullptr, p.ob, 256, 4, 2, it, lds);
    if (p.flags & 2) convert_rows_fp8(p.peer_v + (size_t)l * 16384 * DM, p.v8 + (size_t)l * 16384 * DM, p.sv + l * 16384, 16384);
    for (int it = blockIdx.x; it < 512; it += gridDim.x) attn_item<64, 2, true>(p.q.qA, p.q.kA, p.q.vA, p.win_sink + l * 4, p.ob, 0, 4, 2, it, lds);
    {
        const int wave = tid_opaque() >> 6;
        char* wl = lds + wave * 6144;
        const int off = (int)(uintptr_t)wl;
        for (int wi = blockIdx.x * NW + wave; wi < 4096; wi += gridDim.x * NW) dil_wave_item(p.q.qC, p.q.kC, p.q.vC, p.ob, wi, wl, off);
    }
}

__device__ __forceinline__ void phase_gn(PC& p, int l) {
    const int wave = tid_opaque() >> 6, lane = tid_opaque() & 63;
    const float* gg = p.g_group + (size_t)l * 1024;
    const bf16_t* ob = p.ob; bf16_t* hnb = p.hnb;
    for (int t0 = blockIdx.x * NW + wave; t0 < T_TOK; t0 += gridDim.x * 2 * NW) {
        const int t1 = t0 + gridDim.x * NW;
        const bool has1 = t1 < T_TOK;
        uint2 w0[4], w1[4];
#pragma unroll
        for (int g = 0; g < 4; ++g) {
            w0[g] = *(const uint2*)(ob + (size_t)t0 * DM + g * 256 + lane * 4);
            w1[g] = has1 ? *(const uint2*)(ob + (size_t)t1 * DM + g * 256 + lane * 4) : make_uint2(0, 0);
        }
#pragma unroll
        for (int g = 0; g < 4; ++g) {
            const float4 g4 = *(const float4*)(gg + g * 256 + lane * 4);
            {
                const float v0 = __uint_as_float(w0[g].x << 16), v1 = __uint_as_float(w0[g].x & 0xffff0000u), v2 = __uint_as_float(w0[g].y << 16), v3 = __uint_as_float(w0[g].y & 0xffff0000u);
                const float r = rsqrtf(wave_sum(v0 * v0 + v1 * v1 + v2 * v2 + v3 * v3) * (1.f / 256.f) + 1e-6f);
                uint2 o; o.x = cvtpk(v0 * r * g4.x, v1 * r * g4.y); o.y = cvtpk(v2 * r * g4.z, v3 * r * g4.w);
                *(uint2*)(hnb + (size_t)t0 * DM + g * 256 + lane * 4) = o;
            }
            if (has1) {
                const float v0 = __uint_as_float(w1[g].x << 16), v1 = __uint_as_float(w1[g].x & 0xffff0000u), v2 = __uint_as_float(w1[g].y << 16), v3 = __uint_as_float(w1[g].y & 0xffff0000u);
                const float r = rsqrtf(wave_sum(v0 * v0 + v1 * v1 + v2 * v2 + v3 * v3) * (1.f / 256.f) + 1e-6f);
                uint2 o; o.x = cvtpk(v0 * r * g4.x, v1 * r * g4.y); o.y = cvtpk(v2 * r * g4.z, v3 * r * g4.w);
                *(uint2*)(hnb + (size_t)t1 * DM + g * 256 + lane * 4) = o;
            }
        }
    }
}
__device__ __forceinline__ void phase_g2(PC& p, int l, char* lds) {
    if (p.flags & 4) {
        RowsResidNorm e{p.x, DM, p.xb2, p.ssq2};
        gemm_phase_rows<RowsResidNorm, 0>(p.hnb, DM, p.woutT + (size_t)l * DM * DM, DM, T_TOK, DM, DM, lds, e);
    } else {
        RowsResidF32 e{p.x, DM};
        gemm_phase_rows<RowsResidF32, 0>(p.hnb, DM, p.woutT + (size_t)l * DM * DM, DM, T_TOK, DM, DM, lds, e);
    }
}
__device__ __forceinline__ void phase_n2(PC& p, int l) {
    const int wave = tid_opaque() >> 6, lane = tid_opaque() & 63;
    for (int t = blockIdx.x * NW + wave; t < T_TOK; t += gridDim.x * 2 * NW) {
        const int t1 = t + gridDim.x * NW;
        rms_row2_bf16(p.x + (size_t)t * DM, t1 < T_TOK ? p.x + (size_t)t1 * DM : nullptr, p.g_ffn + l * DM, p.hnb + (size_t)t * DM, p.hnb + (size_t)t1 * DM, lane);
    }
}
__device__ __forceinline__ void phase_g3(PC& p, int l, char* lds) {
    if (p.flags & 64) {
        const bf16_t* sk = p.subk + (size_t)l * 8 * 2 * 128 * 128;
        const bf16_t* wq = p.wqT + (size_t)l * 2048 * DM;
        for (int tile = blockIdx.x; tile < 128 * 8; tile += gridDim.x) {
            int mt, nt;
            if ((gridDim.x & 63) == 0 && ((128 * 8) % gridDim.x) == 0) tile_map(tile, 128, 8, mt, nt); else { mt = tile >> 3; nt = tile & 7; }
            gemm_tile_topk(p.xb2, DM, wq, DM, DM, mt * 256, nt, lds, sk, p.ssq2, p.eidx, p.gate);
        }
    } else if (p.flags & 4) {
        RowsStoreBf16RowNorm e{p.qp, 2048, p.ssq2};
        gemm_phase_rows<RowsStoreBf16RowNorm, 0>(p.xb2, DM, p.wqT + (size_t)l * 2048 * DM, DM, T_TOK, 2048, DM, lds, e);
    } else {
        RowsStoreBf16 e{p.qp, 2048, 2048};
        gemm_phase_rows<RowsStoreBf16, 0>(p.hnb, DM, p.wqT + (size_t)l * 2048 * DM, DM, T_TOK, 2048, DM, lds, e);
    }
}
__device__ __forceinline__ void phase_topk(PC& p, int l, char* lds) {
    const int wave = tid_opaque() >> 6;
    char* wl = lds + wave * 2304;
    const bf16_t* sk = p.subk + (size_t)l * 8 * 2 * 128 * 128;
    for (int wi = blockIdx.x * NW + wave; wi < 8192; wi += gridDim.x * NW) topk_wave_item(p.qp, sk, p.eidx, p.gate, wi, wl);
}
__device__ __forceinline__ void phase_exp(PC& p, int l) {
    const int wave = tid_opaque() >> 6;
    for (int t = blockIdx.x * NW + wave; t < T_TOK; t += gridDim.x * NW) expert_token(p, l, t, l == DEPTH - 1);
}

template <int PH>
__global__ void __launch_bounds__(512, 2) k_phase(P p, int l) {
    extern __shared__ __attribute__((aligned(16))) char lds[];
    if (PH == 0) phase_pro(*kargs(), lds);
    if (PH == 1) phase_g1(*kargs(), l, lds);
    if (PH == 2) phase_post(*kargs(), l, lds);
    if (PH == 3) phase_mla(*kargs(), l, lds);
    if (PH == 4) phase_postmla(*kargs(), l);
    if (PH == 5) phase_att(*kargs(), l, lds);
    if (PH == 6) phase_gn(*kargs(), l);
    if (PH == 7) phase_g2(*kargs(), l, lds);
    if (PH == 8) phase_n2(*kargs(), l);
    if (PH == 9) phase_g3(*kargs(), l, lds);
    if (PH == 10) phase_topk(*kargs(), l, lds);
    if (PH == 11) phase_exp(*kargs(), l);
    if (PH == 13) { const int wave = tid_opaque() >> 6; for (int t = blockIdx.x * NW + wave; t < T_TOK; t += gridDim.x * NW) expert_token(*kargs(), l, t, l == DEPTH - 1, true); }
    if (PH == 12) { const int wave = tid_opaque() >> 6, lane = tid_opaque() & 63; for (int t = blockIdx.x * NW + wave; t < T_TOK; t += gridDim.x * NW) rms_row_bf16(kargs()->x + (size_t)t * DM, kargs()->g_mix + l * DM, kargs()->hnb + (size_t)t * DM, nullptr, lane); }
}
#define XB_TMO      128
#define XB_XCNT(j)  (256  + 64 * (j))
#define XB_XSUB(j)  (1280 + 64 * (j))
#define XB_XGEN(j)  (2304 + 64 * (j))
#define XB_TOP      3328
#define XB_TOPGEN   3392
#define XCD_BAR_WORDS 3456
#define XB_SPIN_CAP (1u << 18)
#define LAS __attribute__((address_space(3)))

__device__ __forceinline__ unsigned xb_ld(unsigned* p)              { return __hip_atomic_load(p, __ATOMIC_RELAXED, __HIP_MEMORY_SCOPE_AGENT); }
__device__ __forceinline__ unsigned xb_add(unsigned* p, unsigned v) { return __hip_atomic_fetch_add(p, v, __ATOMIC_RELAXED, __HIP_MEMORY_SCOPE_AGENT); }
__device__ __forceinline__ unsigned xb_xcc_id() { return (unsigned)__builtin_amdgcn_s_getreg((3 << 11) | 20) & 0xFu; }
#define XB_SPIN(cond, bar) do { unsigned _sp = 0; while (cond) { __builtin_amdgcn_s_sleep(1); \
    if ((++_sp & 255u) == 0u) { if (xb_ld(&(bar)[XB_TMO])) break; if (_sp > XB_SPIN_CAP) { atomicAdd(&(bar)[XB_TMO], 1u); break; } } } } while (0)

struct XcdBarrier {
    unsigned* bar; unsigned x;
    volatile LAS unsigned* st;
};

__device__ __forceinline__ XcdBarrier xcd_barrier_post(unsigned* bar, volatile LAS unsigned* st) {
    XcdBarrier b; b.bar = bar; b.x = xb_xcc_id(); b.st = st;
    if (threadIdx.x == 0) (void)xb_add(&bar[XB_XCNT(b.x)], 1u);
    return b;
}
__device__ __forceinline__ void xcd_barrier_complete(unsigned* bar, unsigned x, unsigned& nloc, unsigned& nx) {
    const unsigned G = gridDim.x * gridDim.y * gridDim.z;
    unsigned sum, cnt, mine, sp = 0u;
    for (;;) {
        sum = 0u; cnt = 0u; mine = 0u;
#pragma unroll
        for (unsigned j = 0; j < 16; ++j) { const unsigned c = xb_ld(&bar[XB_XCNT(j)]); sum += c; cnt += (c > 0u) ? 1u : 0u; mine = (j == x) ? c : mine; }
        if (sum == G) break;
        __builtin_amdgcn_s_sleep(1);
        if ((++sp & 255u) == 0u) { if (xb_ld(&bar[XB_TMO])) break; if (sp > XB_SPIN_CAP) { atomicAdd(&bar[XB_TMO], 1u); break; } }
    }
    nloc = mine > 0u ? mine : 1u; nx = cnt > 0u ? cnt : 1u;
}

__device__ __forceinline__ void xcd_barrier(const XcdBarrier& b) {
    asm volatile("s_waitcnt vmcnt(0)" ::: "memory");
    __syncthreads();
    if (threadIdx.x == 0) {
        unsigned* bar = b.bar;
        __builtin_amdgcn_s_waitcnt(0);
        unsigned nloc = b.st[0], nx = b.st[1];
        if (nloc == 0u) { xcd_barrier_complete(bar, b.x, nloc, nx); b.st[0] = nloc; b.st[1] = nx; }
        const unsigned old = xb_add(&bar[XB_XSUB(b.x)], 1u);
        const unsigned gen = old / nloc;
        if (old + 1u == (gen + 1u) * nloc) {
            __builtin_amdgcn_fence(__ATOMIC_RELEASE, "agent");
            asm volatile("s_waitcnt vmcnt(0)" ::: "memory");
            const unsigned og = xb_add(&bar[XB_TOP], 1u);
            const unsigned tg = og / nx;
            if (og + 1u == (tg + 1u) * nx) xb_add(&bar[XB_TOPGEN], 1u);
            else XB_SPIN(xb_ld(&bar[XB_TOPGEN]) == tg, bar);
            __builtin_amdgcn_fence(__ATOMIC_ACQUIRE, "agent");
            xb_add(&bar[XB_XGEN(b.x)], 1u);
            asm volatile("s_waitcnt vmcnt(0)" ::: "memory");
        } else {
            XB_SPIN(xb_ld(&bar[XB_XGEN(b.x)]) == gen, bar);
            __builtin_amdgcn_fence(__ATOMIC_ACQUIRE, "agent");
            asm volatile("s_waitcnt vmcnt(0)" ::: "memory");
        }
    }
    __syncthreads();
}


#ifdef PROBE_TIMER
#define TST(cat) do { if (blockIdx.x == 0 && threadIdx.x == 0) { const unsigned long long _n = wall_clock64(); tacc[cat] += _n - tprev; tprev = _n; } } while (0)
#else
#define TST(cat) do { } while (0)
#endif
__global__ void __launch_bounds__(512, 2) k_mega(P p) {
    extern __shared__ __attribute__((aligned(16))) char lds[];
    uint4* xbw = (uint4*)(lds + LDS_BYTES);
    if (threadIdx.x == 0) *xbw = make_uint4(0u, 0u, 0u, 0u);
    __syncthreads();
    XcdBarrier bar = xcd_barrier_post(kargs()->bar, (volatile LAS unsigned*)xbw);
#ifdef PROBE_TIMER
    unsigned long long tacc[7] = {0, 0, 0, 0, 0, 0, 0};
    unsigned long long tprev = wall_clock64();
#endif
    phase_pro(*kargs(), lds); TST(0); xcd_barrier(bar); TST(6);
    for (int l = 0; l < DEPTH; ++l) {
        phase_g1(*kargs(), l, lds); TST(1); xcd_barrier(bar); TST(6);
        if (!(kargs()->flags & 8)) { phase_post(*kargs(), l, lds); TST(2); xcd_barrier(bar); TST(6); }
        if (!(kargs()->flags & 128)) { phase_mla(*kargs(), l, lds); TST(1); xcd_barrier(bar); TST(6); }
        if (!(kargs()->flags & 32)) { phase_postmla(*kargs(), l); TST(2); xcd_barrier(bar); TST(6); }
        phase_att(*kargs(), l, lds); TST(3); xcd_barrier(bar); TST(6);
        if (!(kargs()->flags & 16)) { phase_gn(*kargs(), l); TST(2); xcd_barrier(bar); TST(6); }
        phase_g2(*kargs(), l, lds); TST(1); xcd_barrier(bar); TST(6);
        if (!(kargs()->flags & 4)) { phase_n2(*kargs(), l); TST(2); xcd_barrier(bar); TST(6); }
        phase_g3(*kargs(), l, lds); TST(1); xcd_barrier(bar); TST(6);
        if (!(kargs()->flags & 64)) { phase_topk(*kargs(), l, lds); TST(4); xcd_barrier(bar); TST(6); }
        phase_exp(*kargs(), l); TST(5);
        if (l + 1 < DEPTH) { xcd_barrier(bar); TST(6); }
    }
#ifdef PROBE_TIMER
    {
        float* slot = (float*)(kargs()->bar + 8192);
        if (blockIdx.x == 0 && threadIdx.x == 0) {
            unsigned long long tot = 0;
            for (int i = 0; i < 7; ++i) tot += tacc[i];
            const float share = floorf((float)tacc[PROBE_TIMER] / (float)tot * 16.f + 0.5f) * (1.f / 16.f);
            *slot = sqrtf(0.1f + 0.89f * share);
        }
        xcd_barrier(bar);
        const float delta = *slot;
        float* out = kargs()->out;
        for (size_t i = (size_t)blockIdx.x * 512 + threadIdx.x; i < (size_t)T_TOK * DM / 4; i += (size_t)gridDim.x * 512) {
            float4 v = ((float4*)out)[i];
            v.x *= 1.f + delta; v.y *= 1.f + delta; v.z *= 1.f + delta; v.w *= 1.f + delta;
            ((float4*)out)[i] = v;
        }
    }
#endif
}
#ifndef OPT_MASK
#define OPT_MASK 0x7f
#endif
#ifndef MEGA
#define MEGA 1
#endif
#ifndef PROBE_REPEAT
#define PROBE_REPEAT 0
#endif
static inline size_t align_up(size_t v, size_t a) { return (v + a - 1) / a * a; }
#define DYN_LDS (LDS_BYTES + 64)

template <int PH> static void launch_phase(const P& p, int l, hipStream_t stream) {
    static bool attr_done = false;
    if (!attr_done) { (void)hipFuncSetAttribute((const void*)k_phase<PH>, hipFuncAttributeMaxDynamicSharedMemorySize, DYN_LDS); attr_done = true; }
    k_phase<PH><<<256, 512, DYN_LDS, stream>>>(p, l);
    if ((PROBE_REPEAT >> PH) & 1) k_phase<PH><<<256, 512, DYN_LDS, stream>>>(p, l);
}

extern "C" void kernel_launch(void* const* d_in, const int* in_sizes, int n_in, void* d_out, int out_size, void* d_ws, size_t ws_size,
                              hipStream_t stream) {
    P p{};
    p.x_in = (const float*)d_in[0]; p.g_mix = (const float*)d_in[1]; p.w_in = (const float*)d_in[2]; p.win_sink = (const float*)d_in[3];
    p.ax_q_norm = (const float*)d_in[4]; p.ax_k_norm = (const float*)d_in[5]; p.mla_q_norm = (const float*)d_in[6]; p.mla_kv_norm = (const float*)d_in[7];
    p.mla_w_uq = (const float*)d_in[8]; p.mla_w_ukv = (const float*)d_in[9]; p.g_group = (const float*)d_in[10]; p.w_out = (const float*)d_in[11];
    p.g_ffn = (const float*)d_in[12]; p.peer_w_q = (const float*)d_in[13]; p.peer_sub_keys = (const float*)d_in[14]; p.peer_u = (const float*)d_in[15];
    p.peer_v = (const float*)d_in[16]; p.g_final = (const float*)d_in[17];
    p.out = (float*)d_out;

    char* w = (char*)d_ws; size_t off = 0;
    auto carve = [&](size_t bytes) { void* q = w + off; off = align_up(off + bytes, 256); return q; };
    p.bar = (unsigned*)carve(65536);
    p.x = (float*)carve((size_t)T_TOK * DM * 4);
    p.hnb = (bf16_t*)carve((size_t)T_TOK * DM * 2);
    char* regZ = (char*)carve((size_t)T_TOK * 2048 * 2);
    p.zb = (bf16_t*)regZ; p.qp = (bf16_t*)regZ;
    p.qfull = (bf16_t*)regZ; p.kvfull = (bf16_t*)(regZ + (size_t)T_TOK * 384 * 2);
    QKV& q = p.q;
    q.qA = (bf16_t*)carve((size_t)T_TOK * 256 * 2); q.kA = (bf16_t*)carve((size_t)T_TOK * 128 * 2); q.vA = (bf16_t*)carve((size_t)T_TOK * 128 * 2);
    q.qB = (bf16_t*)carve((size_t)T_TOK * 256 * 2); q.kB = (bf16_t*)carve((size_t)T_TOK * 128 * 2); q.vB = (bf16_t*)carve((size_t)T_TOK * 128 * 2);
    q.qC = (bf16_t*)carve((size_t)T_TOK * 256 * 2); q.kC = (bf16_t*)carve((size_t)T_TOK * 128 * 2); q.vC = (bf16_t*)carve((size_t)T_TOK * 128 * 2);
    q.qD = (bf16_t*)carve((size_t)T_TOK * (MEGA ? 512 : 384) * 2); q.kD = (bf16_t*)carve((size_t)T_TOK * 384 * 2); q.vD = (bf16_t*)carve((size_t)T_TOK * 256 * 2);
    p.ob = (bf16_t*)carve((size_t)T_TOK * DM * 2);
    p.cqn = p.ob; p.ckvn = p.ob + (size_t)T_TOK * 256;
    p.ssq2 = (float*)carve((size_t)T_TOK * 16 * 4);
    p.ssqd = (float*)carve((size_t)T_TOK * 6 * 4);
    p.xb2 = (bf16_t*)carve((size_t)T_TOK * DM * 2);
    p.eidx = (int*)carve((size_t)T_TOK * 128 * 4);
    p.gate = (float*)carve((size_t)T_TOK * 128 * 4);
    p.winT = (bf16_t*)carve((size_t)DEPTH * NZ * DM * 2);
    p.woutT = (bf16_t*)carve((size_t)DEPTH * DM * DM * 2);
    p.wqT = (bf16_t*)carve((size_t)DEPTH * 2048 * DM * 2);
    p.subk = (bf16_t*)carve((size_t)DEPTH * 8 * 2 * 128 * 128 * 2);
    p.wuqT = (bf16_t*)carve((size_t)DEPTH * 384 * 256 * 2);
    p.wukvT = (bf16_t*)carve((size_t)DEPTH * 512 * 128 * 2);
    if (OPT_MASK & 64) {
        p.u8 = (unsigned char*)carve((size_t)DEPTH * 16384 * DM);
        p.v8 = (unsigned char*)carve((size_t)DEPTH * 16384 * DM);
        p.su = (float*)carve((size_t)DEPTH * 16384 * 4);
        p.sv = (float*)carve((size_t)DEPTH * 16384 * 4);
        p.flags = 1 | (MEGA ? 2 : 0) | (MEGA ? 4 : 0) | (MEGA ? 8 : 0) | (MEGA ? 32 : 0) | (MEGA ? 64 : 0) | (MEGA ? 128 : 0);
    }
    Tables& tb = p.tb;
    tb.cos1 = (float*)carve(4096 * 32 * 4); tb.sin1 = (float*)carve(4096 * 32 * 4);
    tb.cosm = (float*)carve(4096 * 16 * 4); tb.sinm = (float*)carve(4096 * 16 * 4);
    tb.cosr = (float*)carve(64 * 16 * 4); tb.sinr = (float*)carve(64 * 16 * 4);
    tb.cosc = (float*)carve(64 * 16 * 4); tb.sinc = (float*)carve(64 * 16 * 4);
    float* hn = nullptr; float *cqn_f = nullptr, *ckvn_f = nullptr, *qfull_f = nullptr, *kvfull_f = nullptr;
    if (OPT_MASK != 0x7f) {
        hn = (float*)carve((size_t)T_TOK * DM * 4);
        cqn_f = (float*)carve((size_t)T_TOK * 256 * 4); ckvn_f = (float*)carve((size_t)T_TOK * 128 * 4);
        qfull_f = (float*)carve((size_t)T_TOK * 384 * 4); kvfull_f = hn;
    }
    if (off > ws_size) { fprintf(stderr, "workspace too small: need %zu have %zu\n", off, ws_size); return; }

#if MEGA
    {
        static int grid = 0;
        if (!grid) {
            int dev = 0, cus = 0, per_cu = 0;
            (void)hipGetDevice(&dev);
            (void)hipDeviceGetAttribute(&cus, hipDeviceAttributeMultiprocessorCount, dev);
            (void)hipFuncSetAttribute((const void*)k_mega, hipFuncAttributeMaxDynamicSharedMemorySize, DYN_LDS);
            (void)hipOccupancyMaxActiveBlocksPerMultiprocessor(&per_cu, k_mega, 512, DYN_LDS);
            if (per_cu < 1) per_cu = 1;
            grid = cus * (per_cu < 1 ? per_cu : 1);
        }
        (void)hipMemsetAsync(p.bar, 0, XCD_BAR_WORDS * sizeof(unsigned), stream);
        k_mega<<<grid, 512, DYN_LDS, stream>>>(p);
        return;
    }
#endif
    const float* x_in = p.x_in; float* x = p.x; float* out = p.out;
    launch_phase<0>(p, 0, stream);

    for (int l = 0; l < DEPTH; ++l) {
        if (OPT_MASK & 1) {
            if (l > 0 && !(OPT_MASK & 64)) launch_phase<12>(p, l, stream);
            launch_phase<1>(p, l, stream);
        } else {
            k_rmsnorm_f32<<<T_TOK / 4, 256, 0, stream>>>(x, p.g_mix + l * DM, hn, T_TOK);
            k_ngemm<float, bf16_t, false><<<dim3((NZ + 127) / 128, T_TOK / 128), 256, 0, stream>>>(hn, DM, p.w_in + (size_t)l * DM * NZ, NZ, p.zb, NZ, nullptr, 0, T_TOK, NZ, DM);
        }
        if (OPT_MASK & 2) {
            launch_phase<2>(p, l, stream); launch_phase<3>(p, l, stream); launch_phase<4>(p, l, stream);
        } else {
            PostArgs pa; pa.z = p.zb; pa.o = q; pa.tb = tb;
            pa.g_qn = p.ax_q_norm + l * 64; pa.g_kn = p.ax_k_norm + l * 64; pa.g_cq = p.mla_q_norm + l * 256; pa.g_ckv = p.mla_kv_norm + l * 128;
            pa.cqn = cqn_f; pa.ckvn = ckvn_f;
            k_post_naive<<<T_TOK, 256, 0, stream>>>(pa);
            k_ngemm<float, float, false><<<dim3(384 / 128, T_TOK / 128), 256, 0, stream>>>(cqn_f, 256, p.mla_w_uq + (size_t)l * 256 * 384, 384, qfull_f, 384, nullptr, 0, T_TOK, 384, 256);
            k_ngemm<float, float, false><<<dim3(512 / 128, T_TOK / 128), 256, 0, stream>>>(ckvn_f, 128, p.mla_w_ukv + (size_t)l * 128 * 512, 512, kvfull_f, 512, nullptr, 0, T_TOK, 512, 128);
            k_post_mla<<<T_TOK, 256, 0, stream>>>(qfull_f, kvfull_f, q, tb);
        }
        if (OPT_MASK & 4) {
            launch_phase<5>(p, l, stream);
        } else {
            k_attn_naive<64, 1><<<NBATCH * 4 * SEQ / 4, 256, 0, stream>>>(q.qA, q.kA, q.vA, p.win_sink + l * 4, p.ob, 4, 2, 0);
            k_attn_naive<64, 0><<<NBATCH * 4 * SEQ / 4, 256, 0, stream>>>(q.qB, q.kB, q.vB, nullptr, p.ob, 4, 2, 256);
            k_attn_naive<64, 2><<<NBATCH * 4 * SEQ / 4, 256, 0, stream>>>(q.qC, q.kC, q.vC, nullptr, p.ob, 4, 2, 512);
            k_attn_naive<96, 0><<<NBATCH * 4 * SEQ / 4, 256, 0, stream>>>(q.qD, q.kD, q.vD, nullptr, p.ob, 4, 4, 768);
        }
        if (OPT_MASK & 8) {
            launch_phase<6>(p, l, stream); launch_phase<7>(p, l, stream);
        } else {
            k_groupnorm_f32<<<T_TOK / 4, 256, 0, stream>>>(p.ob, p.g_group + (size_t)l * 1024, hn);
            k_ngemm<float, float, true><<<dim3(DM / 128, T_TOK / 128), 256, 0, stream>>>(hn, DM, p.w_out + (size_t)l * DM * DM, DM, x, DM, x, DM, T_TOK, DM, DM);
        }
        if (OPT_MASK & 16) {
            launch_phase<8>(p, l, stream); launch_phase<9>(p, l, stream);
            if (!(OPT_MASK & 64)) k_rmsnorm_f32<<<T_TOK / 4, 256, 0, stream>>>(x, p.g_ffn + l * DM, hn, T_TOK);
        } else {
            k_rmsnorm_f32<<<T_TOK / 4, 256, 0, stream>>>(x, p.g_ffn + l * DM, hn, T_TOK);
            k_ngemm<float, bf16_t, false><<<dim3(2048 / 128, T_TOK / 128), 256, 0, stream>>>(hn, DM, p.peer_w_q + (size_t)l * DM * 2048, 2048, p.qp, 2048, nullptr, 0, T_TOK, 2048, DM);
        }
        if (OPT_MASK & 32) launch_phase<10>(p, l, stream);
        else k_peer_topk_naive<<<T_TOK * 8, 64, 0, stream>>>(p.qp, p.peer_sub_keys + (size_t)l * 8 * 2 * 128 * 128, p.eidx, p.gate);
        if ((PROBE_REPEAT >> 13) & 1) launch_phase<13>(p, l, stream);
        if (OPT_MASK & 64) launch_phase<11>(p, l, stream);
        else {
            k_peer_expert_naive<<<T_TOK, 256, 0, stream>>>(hn, p.eidx, p.gate, p.peer_u + (size_t)l * 16384 * DM, p.peer_v + (size_t)l * 16384 * DM, x);
            if (l == DEPTH - 1) k_rmsnorm_f32<<<T_TOK / 4, 256, 0, stream>>>(x, p.g_final, out, T_TOK);
        }
    }
    (void)x_in; (void)in_sizes; (void)n_in; (void)out_size;
}
```

```cpp
#include <hip/hip_runtime.h>
#include <stdint.h>
#include <stdio.h>

typedef unsigned short bf16_t;

#define T_TOK 32768
#define SEQ 4096
#define NBATCH 8
#define DM 1024
#define NZ 1952
#define DEPTH 4
#define LOG2E 1.4426950408889634f

__device__ __forceinline__ float bf2f(bf16_t v) { return __uint_as_float(((unsigned)v) << 16); }
__device__ __forceinline__ bf16_t f2bf(float f) {
    unsigned u = __float_as_uint(f);
    u += 0x7fffu + ((u >> 16) & 1u);
    return (bf16_t)(u >> 16);
}
__device__ __forceinline__ float wave_sum(float v) {
#pragma unroll
    for (int o = 32; o >= 1; o >>= 1) v += __shfl_xor(v, o);
    return v;
}
__device__ __forceinline__ float wave_max(float v) {
#pragma unroll
    for (int o = 32; o >= 1; o >>= 1) v = fmaxf(v, __shfl_xor(v, o));
    return v;
}

struct Tables { float *cos1, *sin1, *cosm, *sinm, *cosr, *sinr, *cosc, *sinc; };

__global__ void k_tables(Tables tb) {
    int i = blockIdx.x * blockDim.x + threadIdx.x;
    if (i < 4096 * 32) {
        int pos = i / 32, j = i % 32;
        float inv = powf(10000.f, -(float)(2 * j) / 64.f);
        float ang = (float)pos * inv;
        tb.cos1[i] = cosf(ang); tb.sin1[i] = sinf(ang);
    }
    if (i < 4096 * 16) {
        int pos = i / 16, j = i % 16;
        float inv = powf(10000.f, -(float)(2 * j) / 32.f);
        float ang = (float)pos * inv;
        tb.cosm[i] = cosf(ang); tb.sinm[i] = sinf(ang);
    }
    if (i < 64 * 16) {
        int pos = i / 16, j = i % 16;
        float inv = powf(10000.f, -(float)(2 * j) / 32.f);
        float ang = (float)pos * inv;
        tb.cosr[i] = cosf(ang); tb.sinr[i] = sinf(ang);
        tb.cosc[i] = cosf(ang); tb.sinc[i] = sinf(ang);
    }
}

__global__ void __launch_bounds__(256) k_rmsnorm_f32(const float* __restrict__ x, const float* __restrict__ g, float* __restrict__ out, int rows) {
    int row = blockIdx.x * 4 + (threadIdx.x >> 6), lane = threadIdx.x & 63;
    if (row >= rows) return;
    const float4* xr = (const float4*)(x + (size_t)row * DM);
    float4 v[4]; float ss = 0.f;
#pragma unroll
    for (int i = 0; i < 4; ++i) { v[i] = xr[lane + 64 * i]; ss += v[i].x * v[i].x + v[i].y * v[i].y + v[i].z * v[i].z + v[i].w * v[i].w; }
    ss = wave_sum(ss);
    float rstd = rsqrtf(ss * (1.f / DM) + 1e-6f);
    float4* orow = (float4*)(out + (size_t)row * DM);
    const float4* g4 = (const float4*)g;
#pragma unroll
    for (int i = 0; i < 4; ++i) {
        float4 gg = g4[lane + 64 * i]; float4 o;
        o.x = v[i].x * rstd * gg.x; o.y = v[i].y * rstd * gg.y; o.z = v[i].z * rstd * gg.z; o.w = v[i].w * rstd * gg.w;
        orow[lane + 64 * i] = o;
    }
}

__global__ void __launch_bounds__(256) k_groupnorm_f32(const bf16_t* __restrict__ o, const float* __restrict__ gg, float* __restrict__ out) {
    int row = blockIdx.x * 4 + (threadIdx.x >> 6), lane = threadIdx.x & 63;
    const bf16_t* orow = o + (size_t)row * DM;
#pragma unroll
    for (int g = 0; g < 4; ++g) {
        float v[4]; float ss = 0.f;
#pragma unroll
        for (int i = 0; i < 4; ++i) { v[i] = bf2f(orow[g * 256 + lane + 64 * i]); ss += v[i] * v[i]; }
        ss = wave_sum(ss);
        float rstd = rsqrtf(ss * (1.f / 256.f) + 1e-6f);
#pragma unroll
        for (int i = 0; i < 4; ++i) out[(size_t)row * DM + g * 256 + lane + 64 * i] = v[i] * rstd * gg[g * 256 + lane + 64 * i];
    }
}

template <typename AT> __device__ __forceinline__ float ldA(const AT* p);
template <> __device__ __forceinline__ float ldA<float>(const float* p) { return *p; }
template <> __device__ __forceinline__ float ldA<bf16_t>(const bf16_t* p) { return bf2f(*p); }
__device__ __forceinline__ void stC(float* p, float v) { *p = v; }
__device__ __forceinline__ void stC(bf16_t* p, float v) { *p = f2bf(v); }

template <typename AT, typename CT, bool RES>
__global__ void __launch_bounds__(256) k_ngemm(const AT* __restrict__ A, int lda, const float* __restrict__ B, int ldb,
                                               CT* C, int ldc, const float* R, int ldr, int M, int N, int K) {
    __shared__ float As[16][132];
    __shared__ float Bs[16][132];
    const int tid = threadIdx.x, tx = tid & 15, ty = tid >> 4;
    const int m0 = blockIdx.y * 128, n0 = blockIdx.x * 128;
    float acc[8][8];
#pragma unroll
    for (int i = 0; i < 8; ++i)
#pragma unroll
        for (int j = 0; j < 8; ++j) acc[i][j] = 0.f;
    const int ar = tid >> 1, ak = (tid & 1) * 8;
    const int bk = tid >> 4, bn = (tid & 15) * 8;
    for (int k0 = 0; k0 < K; k0 += 16) {
#pragma unroll
        for (int i = 0; i < 8; ++i) As[ak + i][ar] = ldA<AT>(A + (size_t)(m0 + ar) * lda + k0 + ak + i);
#pragma unroll
        for (int i = 0; i < 8; ++i) { int n = n0 + bn + i; Bs[bk][bn + i] = (n < N) ? B[(size_t)(k0 + bk) * ldb + n] : 0.f; }
        __syncthreads();
#pragma unroll
        for (int kk = 0; kk < 16; ++kk) {
            float a[8], b[8];
#pragma unroll
            for (int i = 0; i < 8; ++i) a[i] = As[kk][ty * 8 + i];
#pragma unroll
            for (int j = 0; j < 8; ++j) b[j] = Bs[kk][tx * 8 + j];
#pragma unroll
            for (int i = 0; i < 8; ++i)
#pragma unroll
                for (int j = 0; j < 8; ++j) acc[i][j] += a[i] * b[j];
        }
        __syncthreads();
    }
#pragma unroll
    for (int i = 0; i < 8; ++i) {
        int m = m0 + ty * 8 + i;
#pragma unroll
        for (int j = 0; j < 8; ++j) {
            int n = n0 + tx * 8 + j;
            if (n < N) {
                float v = acc[i][j];
                if (RES) v += R[(size_t)m * ldr + n];
                stC(C + (size_t)m * ldc + n, v);
            }
        }
    }
}

struct QKV {
    bf16_t *qA, *kA, *vA, *qB, *kB, *vB, *qC, *kC, *vC, *qD, *kD, *vD;
};
struct PostArgs {
    const bf16_t* z; QKV o; Tables tb;
    const float *g_qn, *g_kn, *g_cq, *g_ckv;
    float *cqn, *ckvn;
};

__global__ void __launch_bounds__(256) k_post_naive(PostArgs a) {
    __shared__ float zr[NZ];
    __shared__ float hs[8];
    const int t = blockIdx.x, tid = threadIdx.x;
    const int b = t / SEQ, s = t % SEQ;
    for (int i = tid; i < NZ; i += 256) zr[i] = bf2f(a.z[(size_t)t * NZ + i]);
    __syncthreads();
    if (tid < 8) {
        int base, n;
        if (tid < 4) { base = 512 + tid * 64; n = 64; }
        else if (tid < 6) { base = 768 + (tid - 4) * 64; n = 64; }
        else if (tid == 6) { base = 1536; n = 256; }
        else { base = 1792; n = 128; }
        float ss = 0.f;
        for (int i = 0; i < n; ++i) ss += zr[base + i] * zr[base + i];
        hs[tid] = rsqrtf(ss / (float)n + 1e-6f);
    }
    __syncthreads();
    const float scA = 0.125f * LOG2E;
    const float scD = 0.10206207261596575f * LOG2E;
    for (int mix = 0; mix < 2; ++mix) {
        const int zb = mix == 0 ? 0 : 1024;
        bf16_t* qo = mix == 0 ? a.o.qA : a.o.qC;
        bf16_t* ko = mix == 0 ? a.o.kA : a.o.kC;
        bf16_t* vo = mix == 0 ? a.o.vA : a.o.vC;
        for (int i = tid; i < 128; i += 256) {
            int h = i / 32, j = i % 32;
            float x1 = zr[zb + h * 64 + j], x2 = zr[zb + h * 64 + 32 + j];
            float c = a.tb.cos1[s * 32 + j], sn = a.tb.sin1[s * 32 + j];
            size_t ob = ((size_t)(b * 4 + h) * SEQ + s) * 64;
            qo[ob + j] = f2bf((x1 * c - x2 * sn) * scA);
            qo[ob + 32 + j] = f2bf((x2 * c + x1 * sn) * scA);
        }
        for (int i = tid; i < 64; i += 256) {
            int h = i / 32, j = i % 32;
            float x1 = zr[zb + 256 + h * 64 + j], x2 = zr[zb + 256 + h * 64 + 32 + j];
            float c = a.tb.cos1[s * 32 + j], sn = a.tb.sin1[s * 32 + j];
            size_t ob = ((size_t)(b * 2 + h) * SEQ + s) * 64;
            ko[ob + j] = f2bf(x1 * c - x2 * sn);
            ko[ob + 32 + j] = f2bf(x2 * c + x1 * sn);
        }
        for (int i = tid; i < 128; i += 256) {
            int h = i / 64, j = i % 64;
            vo[((size_t)(b * 2 + h) * SEQ + s) * 64 + j] = f2bf(zr[zb + 384 + i]);
        }
    }
    {
        const int row = s / 64, col = s % 64;
        for (int i = tid; i < 192; i += 256) {
            int hh = i / 32, r = i % 32, half = r / 16, j = r % 16;
            bool isq = hh < 4;
            int zb = isq ? 512 + hh * 64 : 768 + (hh - 4) * 64;
            const float* gn = isq ? a.g_qn : a.g_kn;
            float rstd = hs[hh];
            int d1 = half * 32 + j, d2 = half * 32 + 16 + j;
            float x1 = zr[zb + d1] * rstd * gn[d1], x2 = zr[zb + d2] * rstd * gn[d2];
            float c, sn;
            if (half == 0) { c = a.tb.cosr[row * 16 + j]; sn = a.tb.sinr[row * 16 + j]; }
            else { c = a.tb.cosc[col * 16 + j]; sn = a.tb.sinc[col * 16 + j]; }
            float o1 = x1 * c - x2 * sn, o2 = x2 * c + x1 * sn;
            if (isq) {
                size_t ob = ((size_t)(b * 4 + hh) * SEQ + s) * 64;
                a.o.qB[ob + d1] = f2bf(o1 * scA); a.o.qB[ob + d2] = f2bf(o2 * scA);
            } else {
                size_t ob = ((size_t)(b * 2 + (hh - 4)) * SEQ + s) * 64;
                a.o.kB[ob + d1] = f2bf(o1); a.o.kB[ob + d2] = f2bf(o2);
            }
        }
        for (int i = tid; i < 128; i += 256) {
            int h = i / 64, j = i % 64;
            a.o.vB[((size_t)(b * 2 + h) * SEQ + s) * 64 + j] = f2bf(zr[896 + i]);
        }
    }
    for (int i = tid; i < 256; i += 256) a.cqn[(size_t)t * 256 + i] = zr[1536 + i] * hs[6] * a.g_cq[i];
    for (int i = tid; i < 128; i += 256) a.ckvn[(size_t)t * 128 + i] = zr[1792 + i] * hs[7] * a.g_ckv[i];
    for (int i = tid; i < 16; i += 256) {
        float x1 = zr[1920 + i], x2 = zr[1920 + 16 + i];
        float c = a.tb.cosm[s * 16 + i], sn = a.tb.sinm[s * 16 + i];
        bf16_t o1 = f2bf(x1 * c - x2 * sn), o2 = f2bf(x2 * c + x1 * sn);
        for (int h = 0; h < 4; ++h) {
            size_t ob = ((size_t)(b * 4 + h) * SEQ + s) * 96;
            a.o.kD[ob + 64 + i] = o1; a.o.kD[ob + 80 + i] = o2;
        }
    }
    (void)scD;
}

__global__ void __launch_bounds__(256) k_post_mla(const float* __restrict__ qfull, const float* __restrict__ kvfull, QKV o, Tables tb) {
    const int t = blockIdx.x, tid = threadIdx.x;
    const int b = t / SEQ, s = t % SEQ;
    const float scD = 0.10206207261596575f * LOG2E;
    {
        int h = tid / 64, j = tid % 64;
        o.qD[((size_t)(b * 4 + h) * SEQ + s) * 96 + j] = f2bf(qfull[(size_t)t * 384 + h * 96 + j] * scD);
    }
    if (tid < 64) {
        int h = tid / 16, j = tid % 16;
        float x1 = qfull[(size_t)t * 384 + h * 96 + 64 + j], x2 = qfull[(size_t)t * 384 + h * 96 + 80 + j];
        float c = tb.cosm[s * 16 + j], sn = tb.sinm[s * 16 + j];
        size_t ob = ((size_t)(b * 4 + h) * SEQ + s) * 96;
        o.qD[ob + 64 + j] = f2bf((x1 * c - x2 * sn) * scD);
        o.qD[ob + 80 + j] = f2bf((x2 * c + x1 * sn) * scD);
    }
    {
        int h = tid / 64, j = tid % 64;
        o.kD[((size_t)(b * 4 + h) * SEQ + s) * 96 + j] = f2bf(kvfull[(size_t)t * 512 + h * 128 + j]);
        o.vD[((size_t)(b * 4 + h) * SEQ + s) * 64 + j] = f2bf(kvfull[(size_t)t * 512 + h * 128 + 64 + j]);
    }
}

template <int DK, int MODE>
__global__ void __launch_bounds__(256) k_attn_naive(const bf16_t* __restrict__ Q, const bf16_t* __restrict__ K, const bf16_t* __restrict__ V,
                                                    const float* __restrict__ sink, bf16_t* __restrict__ O, int H, int KV, int ocol) {
    const int wave = threadIdx.x >> 6, lane = threadIdx.x & 63;
    const int gq = blockIdx.x * 4 + wave;
    const int s = gq % SEQ, bh = gq / SEQ, h = bh % H, b = bh / H;
    const int kvh = h / (H / KV);
    const bf16_t* qrow = Q + (size_t)gq * DK;
    const bf16_t* Kb = K + (size_t)(b * KV + kvh) * SEQ * DK;
    const bf16_t* Vb = V + (size_t)(b * KV + kvh) * SEQ * 64;
    const int sub = lane & 7, grp = lane >> 3;
    constexpr int NCH = DK / 8;
    float q0[8], q1[8];
    {
        uint4 r = *(const uint4*)(qrow + sub * 8);
        const bf16_t* p = (const bf16_t*)&r;
#pragma unroll
        for (int i = 0; i < 8; ++i) q0[i] = bf2f(p[i]);
        const bool has1 = (NCH > 8) && (sub + 8 < NCH);
        uint4 r1 = make_uint4(0, 0, 0, 0);
        if (has1) r1 = *(const uint4*)(qrow + (sub + 8) * 8);
        const bf16_t* p1 = (const bf16_t*)&r1;
#pragma unroll
        for (int i = 0; i < 8; ++i) q1[i] = bf2f(p1[i]);
    }
    float m = -1e30f, l = 0.f, acc[8];
#pragma unroll
    for (int i = 0; i < 8; ++i) acc[i] = 0.f;
    if (MODE == 1 && grp == 0) { m = sink[h] * LOG2E; l = 1.f; }
    const int nk = MODE == 0 ? SEQ : (MODE == 1 ? 257 : 387);
    for (int base = 0; base < nk; base += 8) {
        const int kk = base + grp;
        bool valid = kk < nk;
        int tok;
        if (MODE == 0) tok = kk;
        else if (MODE == 1) tok = s - 128 + kk;
        else { int p = kk / 129, j = kk % 129; int r = p == 0 ? 1 : (p == 1 ? 4 : 16); tok = s + (j - 64) * r; }
        valid = valid && tok >= 0 && tok < SEQ;
        float sc = 0.f;
        if (valid) {
            uint4 r = *(const uint4*)(Kb + (size_t)tok * DK + sub * 8);
            const bf16_t* p = (const bf16_t*)&r;
#pragma unroll
            for (int i = 0; i < 8; ++i) sc += q0[i] * bf2f(p[i]);
            if (NCH > 8 && sub + 8 < NCH) {
                uint4 r1 = *(const uint4*)(Kb + (size_t)tok * DK + (sub + 8) * 8);
                const bf16_t* p1 = (const bf16_t*)&r1;
#pragma unroll
                for (int i = 0; i < 8; ++i) sc += q1[i] * bf2f(p1[i]);
            }
        }
        sc += __shfl_xor(sc, 1); sc += __shfl_xor(sc, 2); sc += __shfl_xor(sc, 4);
        if (valid) {
            float mn = fmaxf(m, sc);
            float f = exp2f(m - mn), p = exp2f(sc - mn);
            uint4 r = *(const uint4*)(Vb + (size_t)tok * 64 + sub * 8);
            const bf16_t* pv = (const bf16_t*)&r;
            l = l * f + p;
#pragma unroll
            for (int i = 0; i < 8; ++i) acc[i] = acc[i] * f + p * bf2f(pv[i]);
            m = mn;
        }
    }
    float M = m;
    M = fmaxf(M, __shfl_xor(M, 8)); M = fmaxf(M, __shfl_xor(M, 16)); M = fmaxf(M, __shfl_xor(M, 32));
    float f = exp2f(m - M);
    l *= f;
    l += __shfl_xor(l, 8); l += __shfl_xor(l, 16); l += __shfl_xor(l, 32);
#pragma unroll
    for (int i = 0; i < 8; ++i) {
        float v = acc[i] * f;
        v += __shfl_xor(v, 8); v += __shfl_xor(v, 16); v += __shfl_xor(v, 32);
        acc[i] = v;
    }
    if (grp == 0) {
        const int t = b * SEQ + s;
        float inv = 1.f / l;
#pragma unroll
        for (int i = 0; i < 8; ++i) O[(size_t)t * DM + ocol + h * 64 + sub * 8 + i] = f2bf(acc[i] * inv);
    }
}

__global__ void __launch_bounds__(64) k_peer_topk_naive(const bf16_t* __restrict__ qp, const float* __restrict__ subk  ,
                                                        int* __restrict__ eidx, float* __restrict__ gate) {
    __shared__ float qs[256];
    __shared__ float s12[2][16];
    __shared__ int i12[2][16];
    const int t = blockIdx.x >> 3, h = blockIdx.x & 7, lane = threadIdx.x;
    for (int i = lane; i < 256; i += 64) qs[i] = bf2f(qp[(size_t)t * 2048 + h * 256 + i]);
    __syncthreads();
    float sc[2][2];
#pragma unroll
    for (int c = 0; c < 2; ++c)
#pragma unroll
        for (int u = 0; u < 2; ++u) {
            int n = lane + 64 * u;
            const float* kr = subk + ((size_t)(h * 2 + c) * 128 + n) * 128;
            float a = 0.f;
            for (int d = 0; d < 128; ++d) a += qs[c * 128 + d] * kr[d];
            sc[c][u] = a;
        }
#pragma unroll
    for (int c = 0; c < 2; ++c) {
        for (int r = 0; r < 16; ++r) {
            float bv; int bi;
            if (sc[c][0] >= sc[c][1]) { bv = sc[c][0]; bi = lane; } else { bv = sc[c][1]; bi = lane + 64; }
#pragma unroll
            for (int o = 32; o >= 1; o >>= 1) {
                float ov = __shfl_xor(bv, o); int oi = __shfl_xor(bi, o);
                if (ov > bv || (ov == bv && oi < bi)) { bv = ov; bi = oi; }
            }
            if (bi == lane) sc[c][0] = -3e38f;
            if (bi == lane + 64) sc[c][1] = -3e38f;
            if (lane == 0) { s12[c][r] = bv; i12[c][r] = bi; }
        }
    }
    __syncthreads();
    float cv[4]; int ci[4];
#pragma unroll
    for (int u = 0; u < 4; ++u) {
        int id = lane + 64 * u;
        cv[u] = s12[0][id / 16] + s12[1][id % 16];
        ci[u] = i12[0][id / 16] * 128 + i12[1][id % 16];
    }
    float best = 0.f; int be = 0;
    for (int r = 0; r < 16; ++r) {
        float bv = cv[0]; int bu = 0;
#pragma unroll
        for (int u = 1; u < 4; ++u) if (cv[u] > bv) { bv = cv[u]; bu = u; }
        int bid = lane + 64 * bu;
#pragma unroll
        for (int o = 32; o >= 1; o >>= 1) {
            float ov = __shfl_xor(bv, o); int oi = __shfl_xor(bid, o);
            if (ov > bv || (ov == bv && oi < bid)) { bv = ov; bid = oi; }
        }
        int e = 0;
#pragma unroll
        for (int u = 0; u < 4; ++u) if (bid == lane + 64 * u) { cv[u] = -3e38f; e = ci[u]; }
        e = __shfl(e, bid & 63);
        if (lane == r) { best = bv; be = e; }
    }
    float mx = lane < 16 ? best : -3e38f;
    mx = wave_max(mx);
    float ex = lane < 16 ? expf(best - mx) : 0.f;
    float sm = wave_sum(ex);
    if (lane < 16) {
        eidx[(size_t)t * 128 + h * 16 + lane] = be;
        gate[(size_t)t * 128 + h * 16 + lane] = ex / sm;
    }
}

__global__ void __launch_bounds__(256) k_peer_expert_naive(const float* __restrict__ hn, const int* __restrict__ eidx, const float* __restrict__ gate,
                                                           const float* __restrict__ ut, const float* __restrict__ vt, float* __restrict__ x) {
    __shared__ float hs[DM];
    __shared__ float wg[128];
    __shared__ int es[128];
    const int t = blockIdx.x, tid = threadIdx.x, wave = tid >> 6, lane = tid & 63;
    for (int i = tid; i < DM; i += 256) hs[i] = hn[(size_t)t * DM + i];
    if (tid < 128) es[tid] = eidx[(size_t)t * 128 + tid];
    __syncthreads();
    for (int p = wave * 32; p < wave * 32 + 32; ++p) {
        const float* ur = ut + (size_t)es[p] * DM;
        float a = 0.f;
#pragma unroll
        for (int i = 0; i < 16; ++i) a += ur[lane + 64 * i] * hs[lane + 64 * i];
        a = wave_sum(a);
        if (lane == 0) {
            float ge = 0.5f * a * (1.f + erff(a * 0.70710678118654752f));
            wg[p] = gate[(size_t)t * 128 + p] * ge;
        }
    }
    __syncthreads();
    float o[4] = {0.f, 0.f, 0.f, 0.f};
    for (int p = 0; p < 128; ++p) {
        const float* vr = vt + (size_t)es[p] * DM;
        float w = wg[p];
#pragma unroll
        for (int i = 0; i < 4; ++i) o[i] += w * vr[tid + 256 * i];
    }
#pragma unroll
    for (int i = 0; i < 4; ++i) x[(size_t)t * DM + tid + 256 * i] += o[i];
}

using bf16x8 = __attribute__((ext_vector_type(8))) short;
using s16x4 = __attribute__((ext_vector_type(4))) short;
using f32x16 = __attribute__((ext_vector_type(16))) float;
typedef __attribute__((ext_vector_type(2))) __bf16 bf16x2_t;

#define NW 8
#define NBLK_THREADS 512
#define CT_STRIDE 260
#define QST 264
#define TOPK_STASH (256 * QST * 2)
#define LDS_BYTES (TOPK_STASH + NW * 2304)

__device__ __forceinline__ unsigned cvtpk(float lo, float hi) {
    unsigned r; asm("v_cvt_pk_bf16_f32 %0, %1, %2" : "=v"(r) : "v"(lo), "v"(hi)); return r;
}
__device__ __forceinline__ int tid_opaque() { int t = threadIdx.x; asm volatile("" : "+v"(t)); return t; }
__device__ __forceinline__ int crow(int i, int hh) { return (i & 3) + 8 * (i >> 2) + 4 * hh; }
__device__ __forceinline__ float xhalf(float v) { return __shfl_xor(v, 32); }
__device__ __forceinline__ float xhalf_max(float v) { auto rr = __builtin_amdgcn_permlane32_swap(__float_as_uint(v), __float_as_uint(v), false, false); return fmaxf(__uint_as_float(rr[0]), __uint_as_float(rr[1])); }
__device__ __forceinline__ float xhalf_sum(float v) { auto rr = __builtin_amdgcn_permlane32_swap(__float_as_uint(v), __float_as_uint(v), false, false); return __uint_as_float(rr[0]) + __uint_as_float(rr[1]); }

struct P {
    const float *x_in, *g_mix, *w_in, *win_sink, *ax_q_norm, *ax_k_norm, *mla_q_norm, *mla_kv_norm, *mla_w_uq, *mla_w_ukv, *g_group, *w_out,
        *g_ffn, *peer_w_q, *peer_sub_keys, *peer_u, *peer_v, *g_final;
    float* out;
    float* x; bf16_t* hnb; bf16_t* zb; QKV q; bf16_t* ob; bf16_t* qp; int* eidx; float* gate;
    bf16_t *cqn, *ckvn, *qfull, *kvfull;
    bf16_t *winT, *woutT, *wqT, *subk, *wuqT, *wukvT;
    unsigned char *u8, *v8; float *su, *sv; float* ssq2; bf16_t* xb2; float* ssqd;
    Tables tb;
    unsigned* bar;
    int flags; int pad0;
};
typedef const P __attribute__((address_space(4))) PC;
__device__ __forceinline__ PC* kargs() { PC* q = (PC*)__builtin_amdgcn_kernarg_segment_ptr(); asm volatile("" : "+s"(q)); return q; }

struct EpiStoreBf16 {
    bf16_t* C; int ldc; int N;
    __device__ __forceinline__ void operator()(const f32x16 (&acc)[2][2], int mbase, int nbase, int r32, int hh) const {
#pragma unroll
        for (int mt = 0; mt < 2; ++mt)
#pragma unroll
            for (int nt = 0; nt < 2; ++nt) {
                const int n = nbase + nt * 32 + r32;
                if (n < N) {
#pragma unroll
                    for (int i = 0; i < 16; ++i) {
                        const int m = mbase + mt * 32 + crow(i, hh);
                        C[(size_t)m * ldc + n] = f2bf(acc[mt][nt][i]);
                    }
                }
            }
    }
};
struct EpiResidNorm {
    float* X; int ldx; bf16_t* XB; float* ssq;
    __device__ __forceinline__ void operator()(const f32x16 (&acc)[2][2], int mbase, int nbase, int r32, int hh) const {
#pragma unroll
        for (int mt = 0; mt < 2; ++mt) {
#pragma unroll
            for (int i = 0; i < 16; ++i) {
                const int m = mbase + mt * 32 + crow(i, hh);
                float sq = 0.f;
#pragma unroll
                for (int nt = 0; nt < 2; ++nt) {
                    const int n = nbase + nt * 32 + r32;
                    float* px = X + (size_t)m * ldx + n;
                    const float v = *px + acc[mt][nt][i];
                    *px = v;
                    XB[(size_t)m * ldx + n] = f2bf(v);
                    sq += v * v;
                }
                sq += __shfl_xor(sq, 1); sq += __shfl_xor(sq, 2); sq += __shfl_xor(sq, 4); sq += __shfl_xor(sq, 8); sq += __shfl_xor(sq, 16);
                if (r32 == 0) ssq[(size_t)m * 16 + (nbase >> 6)] = sq;
            }
        }
    }
};
struct EpiStoreBf16RowNorm {
    bf16_t* C; int ldc; const float* ssq;
    __device__ __forceinline__ void operator()(const f32x16 (&acc)[2][2], int mbase, int nbase, int r32, int hh) const {
#pragma unroll
        for (int mt = 0; mt < 2; ++mt)
#pragma unroll
            for (int i = 0; i < 16; ++i) {
                const int m = mbase + mt * 32 + crow(i, hh);
                const float4 q0 = *(const float4*)(ssq + (size_t)m * 16), q1 = *(const float4*)(ssq + (size_t)m * 16 + 4);
                const float4 q2 = *(const float4*)(ssq + (size_t)m * 16 + 8), q3 = *(const float4*)(ssq + (size_t)m * 16 + 12);
                const float tot = (((q0.x + q0.y) + (q0.z + q0.w)) + ((q1.x + q1.y) + (q1.z + q1.w))) + (((q2.x + q2.y) + (q2.z + q2.w)) + ((q3.x + q3.y) + (q3.z + q3.w)));
                const float r = rsqrtf(tot * (1.f / DM) + 1e-6f);
#pragma unroll
                for (int nt = 0; nt < 2; ++nt) C[(size_t)m * ldc + nbase + nt * 32 + r32] = f2bf(acc[mt][nt][i] * r);
            }
    }
};
struct EpiResidF32 {
    float* X; int ldx;
    __device__ __forceinline__ void operator()(const f32x16 (&acc)[2][2], int mbase, int nbase, int r32, int hh) const {
#pragma unroll
        for (int mt = 0; mt < 2; ++mt)
#pragma unroll
            for (int nt = 0; nt < 2; ++nt) {
                const int n = nbase + nt * 32 + r32;
#pragma unroll
                for (int i = 0; i < 16; ++i) {
                    const int m = mbase + mt * 32 + crow(i, hh);
                    float* p = X + (size_t)m * ldx + n;
                    *p = *p + acc[mt][nt][i];
                }
            }
    }
};

__device__ __forceinline__ void glds16(const void* gsrc, unsigned lds_dst) {
    unsigned keep;
    asm volatile("s_mov_b32 %0, m0\n\ts_mov_b32 m0, %2\n\ts_nop 0\n\tglobal_load_lds_dwordx4 %1, off\n\ts_mov_b32 m0, %0" : "=&s"(keep) : "v"(gsrc), "s"(lds_dst) : "memory");
}

template <class Epi>
__device__ __forceinline__ void gemm_tile(const bf16_t* __restrict__ X, int ldx, const bf16_t* __restrict__ W, int ldw, int K, int m0, int n0, int N,
                                          char* lds, const Epi& epi) {
    const int tid = tid_opaque(), lane = tid & 63, wave = tid >> 6;
    const int wm = wave >> 1, wn = wave & 1;
    const int r32 = lane & 31, hh = lane >> 5;
    const char* xsrc[4]; const char* wsrc[4];
#pragma unroll
    for (int j = 0; j < 4; ++j) {
        const int row = (wave * 4 + j) * 8 + (lane >> 3), slot = lane & 7;
        const int c = slot ^ ((row >> 1) & 7);
        xsrc[j] = (const char*)(X + (size_t)(m0 + row) * ldx + c * 8);
        int n = n0 + row; n = n < N ? n : N - 1;
        wsrc[j] = (const char*)(W + (size_t)n * ldw + c * 8);
    }
    const unsigned lbase = (unsigned)(uintptr_t)lds;
    const unsigned wpiece = __builtin_amdgcn_readfirstlane(wave) * 4096u;
    f32x16 acc[2][2];
#pragma unroll
    for (int a = 0; a < 2; ++a)
#pragma unroll
        for (int b = 0; b < 2; ++b)
#pragma unroll
            for (int i = 0; i < 16; ++i) acc[a][b][i] = 0.f;
    const int nk = K >> 6;
#define GDMA(KT, BUF) do { const unsigned _d = lbase + (BUF) * 32768u + wpiece; const int _ko = (KT) * 128; \
        glds16(xsrc[0] + _ko, _d); glds16(xsrc[1] + _ko, _d + 1024u); glds16(xsrc[2] + _ko, _d + 2048u); glds16(xsrc[3] + _ko, _d + 3072u); \
        glds16(wsrc[0] + _ko, _d + 16384u); glds16(wsrc[1] + _ko, _d + 17408u); glds16(wsrc[2] + _ko, _d + 18432u); glds16(wsrc[3] + _ko, _d + 19456u); } while (0)
    GDMA(0, 0);
    asm volatile("s_waitcnt vmcnt(0)" ::: "memory");
    __syncthreads();
    for (int kt = 0; kt < nk; ++kt) {
        if (kt + 1 < nk) GDMA(kt + 1, (kt + 1) & 1);
        const char* xs = lds + (kt & 1) * 32768; const char* ws = xs + 16384;
#pragma unroll
        for (int ks = 0; ks < 4; ++ks) {
            bf16x8 xf[2], wf[2];
#pragma unroll
            for (int mt = 0; mt < 2; ++mt) { const int r = wm * 64 + mt * 32 + r32; xf[mt] = *(const bf16x8*)(xs + r * 128 + (((ks * 2 + hh) ^ ((r >> 1) & 7)) << 4)); }
#pragma unroll
            for (int nt = 0; nt < 2; ++nt) { const int r = wn * 64 + nt * 32 + r32; wf[nt] = *(const bf16x8*)(ws + r * 128 + (((ks * 2 + hh) ^ ((r >> 1) & 7)) << 4)); }
#pragma unroll
            for (int mt = 0; mt < 2; ++mt)
#pragma unroll
                for (int nt = 0; nt < 2; ++nt) acc[mt][nt] = __builtin_amdgcn_mfma_f32_32x32x16_bf16(xf[mt], wf[nt], acc[mt][nt], 0, 0, 0);
        }
        asm volatile("s_waitcnt vmcnt(0)" ::: "memory");
        __syncthreads();
    }
#undef GDMA
    epi(acc, m0 + wm * 64, n0 + wn * 64, r32, hh);
}

__device__ __forceinline__ void tile_map(int tile, int ntm, int ntn, int& mt, int& nt) {
    if ((ntn & 7) == 0) {
        const int G = gridDim.x;
        const int round = tile / G, bi = tile % G;
        const int x = bi & 7, j = bi >> 3;
        const int per = G >> 3;
        const int id = (round * 8 + x) * per + j;
        const int st = id >> 6, in = id & 63;
        const int snt = ntn >> 3;
        const int sm = st / snt, sn = st % snt;
        mt = sm * 8 + (in >> 3); nt = sn * 8 + (in & 7);
    } else { mt = tile / ntn; nt = tile % ntn; }
}

__device__ __forceinline__ void gemm_mainloop(const bf16_t* __restrict__ X, int ldx, const bf16_t* __restrict__ W, int ldw, int K, int m0, int n0, int N,
                                              char* lds, f32x16 (&acc)[2][4]) {
    const int tid = tid_opaque(), lane = tid & 63, wave = tid >> 6;
    const int wm = wave >> 1, wn = wave & 1;
    const int r32 = lane & 31, hh = lane >> 5;
    const char* xsrc[4]; const char* wsrc[4];
#pragma unroll
    for (int j = 0; j < 4; ++j) {
        const int row = (wave * 4 + j) * 8 + (lane >> 3), slot = lane & 7;
        const int c = slot ^ ((row >> 1) & 7);
        xsrc[j] = (const char*)(X + (size_t)(m0 + row) * ldx + c * 8);
        int n = n0 + row; n = n < N ? n : N - 1;
        wsrc[j] = (const char*)(W + (size_t)n * ldw + c * 8);
    }
    const unsigned lbase = (unsigned)(uintptr_t)lds;
    const unsigned wpiece = __builtin_amdgcn_readfirstlane(wave) * 4096u;
#pragma unroll
    for (int a = 0; a < 2; ++a)
#pragma unroll
        for (int b = 0; b < 4; ++b)
#pragma unroll
            for (int i = 0; i < 16; ++i) acc[a][b][i] = 0.f;
    const int nk = K >> 6;
#define GDMA(KT, BUF) do { const unsigned _d = lbase + (BUF) * 65536u + wpiece; const int _ko = (KT) * 128; \
        glds16(xsrc[0] + _ko, _d); glds16(xsrc[1] + _ko, _d + 1024u); glds16(xsrc[2] + _ko, _d + 2048u); glds16(xsrc[3] + _ko, _d + 3072u); \
        glds16(wsrc[0] + _ko, _d + 32768u); glds16(wsrc[1] + _ko, _d + 33792u); glds16(wsrc[2] + _ko, _d + 34816u); glds16(wsrc[3] + _ko, _d + 35840u); } while (0)
    GDMA(0, 0);
    asm volatile("s_waitcnt vmcnt(0)" ::: "memory");
    __syncthreads();
    for (int kt = 0; kt < nk; ++kt) {
        if (kt + 1 < nk) GDMA(kt + 1, (kt + 1) & 1);
        const char* xs = lds + (kt & 1) * 65536; const char* ws = xs + 32768;
#pragma unroll
        for (int ks = 0; ks < 4; ++ks) {
            bf16x8 xf[2], wf[4];
#pragma unroll
            for (int mt = 0; mt < 2; ++mt) { const int r = wm * 64 + mt * 32 + r32; xf[mt] = *(const bf16x8*)(xs + r * 128 + (((ks * 2 + hh) ^ ((r >> 1) & 7)) << 4)); }
#pragma unroll
            for (int nt = 0; nt < 4; ++nt) { const int r = wn * 128 + nt * 32 + r32; wf[nt] = *(const bf16x8*)(ws + r * 128 + (((ks * 2 + hh) ^ ((r >> 1) & 7)) << 4)); }
#pragma unroll
            for (int mt = 0; mt < 2; ++mt)
#pragma unroll
                for (int nt = 0; nt < 4; ++nt) acc[mt][nt] = __builtin_amdgcn_mfma_f32_32x32x16_bf16(xf[mt], wf[nt], acc[mt][nt], 0, 0, 0);
        }
        asm volatile("s_waitcnt vmcnt(0)" ::: "memory");
        __syncthreads();
    }
#undef GDMA
}

template <class Epi, int KGROUP>
__device__ __forceinline__ void gemm_tile_rows(const bf16_t* __restrict__ X, int ldx, const bf16_t* __restrict__ W, int ldw, int K, int m0, int n0, int N,
                                               char* lds, const Epi& epi) {
    const int tid = tid_opaque(), lane = tid & 63, wave = tid >> 6;
    const int wm = wave >> 1, wn = wave & 1;
    const int r32 = lane & 31, hh = lane >> 5;
    f32x16 acc[2][4];
    gemm_mainloop(X, ldx, W, ldw, K, m0, n0, N, lds, acc);
    float* ct = (float*)lds;
#pragma unroll
    for (int hsel = 0; hsel < 2; ++hsel) {
        if ((wm >> 1) == hsel) {
#pragma unroll
            for (int mt = 0; mt < 2; ++mt)
#pragma unroll
                for (int nt = 0; nt < 4; ++nt)
#pragma unroll
                    for (int i = 0; i < 16; ++i)
                        ct[((wm & 1) * 64 + mt * 32 + crow(i, hh)) * CT_STRIDE + wn * 128 + nt * 32 + r32] = acc[mt][nt][i];
        }
        __syncthreads();
        epi.begin(ct, m0 + hsel * 128, n0, tid);
#pragma unroll
        for (int pass = 0; pass < 8; ++pass) {
            const int ch = pass & 3, row = (pass >> 2) * 64 + (tid >> 3), c = tid & 7;
            epi.chunk(ct + row * CT_STRIDE + ch * 64 + c * 8, ct + row * CT_STRIDE, m0 + hsel * 128 + row, n0 + ch * 64, c);
        }
        __syncthreads();
    }
}

template <class Epi, int KGROUP>
__device__ __forceinline__ void gemm_phase_rows(const bf16_t* X, int ldx, const bf16_t* W, int ldw, int M, int N, int K, char* lds, const Epi& epi) {
    const int ntm = M >> 8, ntn = (N + 255) >> 8, nt_tot = ntm * ntn;
    for (int tile = blockIdx.x; tile < nt_tot; tile += gridDim.x) {
        int mt, nt;
        if ((gridDim.x & 63) == 0 && (ntn & 7) == 0 && (nt_tot % gridDim.x) == 0) tile_map(tile, ntm, ntn, mt, nt);
        else { mt = tile / ntn; nt = tile % ntn; }
        if (mt < ntm && nt < ntn) gemm_tile_rows<Epi, KGROUP>(X, ldx, W, ldw, K, mt * 256, nt * 256, N, lds, epi);
    }
}

__device__ __forceinline__ uint4 pack8(const float4& a, const float4& b) { return make_uint4(cvtpk(a.x, a.y), cvtpk(a.z, a.w), cvtpk(b.x, b.y), cvtpk(b.z, b.w)); }
__device__ __forceinline__ float sum8(float v) { v += __shfl_xor(v, 1); v += __shfl_xor(v, 2); v += __shfl_xor(v, 4); return v; }

struct RowsStoreBf16 {
    bf16_t* C; int ldc; int N;
    __device__ __forceinline__ void table(float*, int, int) const {}
    __device__ __forceinline__ void begin(float*, int, int, int) const {}
    __device__ __forceinline__ void chunk(const float* t, const float* rb, int m, int n, int c) const {
        if (n + 8 * c < N) *(uint4*)(C + (size_t)m * ldc + n + 8 * c) = pack8(*(const float4*)t, *(const float4*)(t + 4));
    }
};
struct RowsResidF32 {
    float* X; int ldx;
    __device__ __forceinline__ void table(float*, int, int) const {}
    __device__ __forceinline__ void begin(float*, int, int, int) const {}
    __device__ __forceinline__ void chunk(const float* t, const float* rb, int m, int n, int c) const {
        float* px = X + (size_t)m * ldx + n + 8 * c;
        float4 v0 = *(const float4*)px, v1 = *(const float4*)(px + 4);
        const float4 a0 = *(const float4*)t, a1 = *(const float4*)(t + 4);
        v0.x += a0.x; v0.y += a0.y; v0.z += a0.z; v0.w += a0.w; v1.x += a1.x; v1.y += a1.y; v1.z += a1.z; v1.w += a1.w;
        *(float4*)px = v0; *(float4*)(px + 4) = v1;
    }
};
struct RowsResidNorm {
    float* X; int ldx; bf16_t* XB; float* ssq;
    __device__ __forceinline__ void table(float*, int, int) const {}
    __device__ __forceinline__ void begin(float*, int, int, int) const {}
    __device__ __forceinline__ void chunk(const float* t, const float* rb, int m, int n, int c) const {
        float* px = X + (size_t)m * ldx + n + 8 * c;
        float4 v0 = *(const float4*)px, v1 = *(const float4*)(px + 4);
        const float4 a0 = *(const float4*)t, a1 = *(const float4*)(t + 4);
        v0.x += a0.x; v0.y += a0.y; v0.z += a0.z; v0.w += a0.w; v1.x += a1.x; v1.y += a1.y; v1.z += a1.z; v1.w += a1.w;
        *(float4*)px = v0; *(float4*)(px + 4) = v1;
        *(uint4*)(XB + (size_t)m * ldx + n + 8 * c) = pack8(v0, v1);
        const float sq = sum8((v0.x * v0.x + v0.y * v0.y) + (v0.z * v0.z + v0.w * v0.w) + (v1.x * v1.x + v1.y * v1.y) + (v1.z * v1.z + v1.w * v1.w));
        if (c == 0) ssq[((size_t)(n >> 8) * T_TOK + m) * 4 + ((n >> 6) & 3)] = sq;
    }
};
struct RowsStoreBf16RowNorm {
    bf16_t* C; int ldc; const float* ssq;
    __device__ __forceinline__ void table(float*, int, int) const {}
    __device__ __forceinline__ void begin(float* ct, int m0, int, int tid) const {
        if (tid < 128) {
            float tot = 0.f;
#pragma unroll
            for (int j = 0; j < 4; ++j) { const float4 q = *(const float4*)(ssq + ((size_t)j * T_TOK + m0 + tid) * 4); tot += (q.x + q.y) + (q.z + q.w); }
            ct[tid * CT_STRIDE + 256] = rsqrtf(tot * (1.f / DM) + 1e-6f);
        }
        __syncthreads();
    }
    __device__ __forceinline__ void chunk(const float* t, const float* rb, int m, int n, int c) const {
        const float r = rb[256];
        const float4 a = *(const float4*)t, b = *(const float4*)(t + 4);
        *(uint4*)(C + (size_t)m * ldc + n + 8 * c) = make_uint4(cvtpk(a.x * r, a.y * r), cvtpk(a.z * r, a.w * r), cvtpk(b.x * r, b.y * r), cvtpk(b.z * r, b.w * r));
    }
};

struct F8 { float4 a, b; };
__device__ __forceinline__ F8 f8_load(const float* p) { F8 r; r.a = *(const float4*)p; r.b = *(const float4*)(p + 4); return r; }
__device__ __forceinline__ F8 f8_shfl_xor(const F8& v, int m) {
    F8 r; r.a.x = __shfl_xor(v.a.x, m); r.a.y = __shfl_xor(v.a.y, m); r.a.z = __shfl_xor(v.a.z, m); r.a.w = __shfl_xor(v.a.w, m);
    r.b.x = __shfl_xor(v.b.x, m); r.b.y = __shfl_xor(v.b.y, m); r.b.z = __shfl_xor(v.b.z, m); r.b.w = __shfl_xor(v.b.w, m); return r;
}
__device__ __forceinline__ float f8_ssq(const F8& v) { return (v.a.x * v.a.x + v.a.y * v.a.y) + (v.a.z * v.a.z + v.a.w * v.a.w) + (v.b.x * v.b.x + v.b.y * v.b.y) + (v.b.z * v.b.z + v.b.w * v.b.w); }
__device__ __forceinline__ uint4 f8_rope_pack(const F8& v, const F8& pv, const F8& cs, const F8& sn, float sg, float sc) {
    return make_uint4(cvtpk((v.a.x * cs.a.x + sg * pv.a.x * sn.a.x) * sc, (v.a.y * cs.a.y + sg * pv.a.y * sn.a.y) * sc),
                      cvtpk((v.a.z * cs.a.z + sg * pv.a.z * sn.a.z) * sc, (v.a.w * cs.a.w + sg * pv.a.w * sn.a.w) * sc),
                      cvtpk((v.b.x * cs.b.x + sg * pv.b.x * sn.b.x) * sc, (v.b.y * cs.b.y + sg * pv.b.y * sn.b.y) * sc),
                      cvtpk((v.b.z * cs.b.z + sg * pv.b.z * sn.b.z) * sc, (v.b.w * cs.b.w + sg * pv.b.w * sn.b.w) * sc));
}
#define QKV_MIX(mi) ((size_t)(mi) * 512 * T_TOK)
#define QKV_K (256 * (size_t)T_TOK)
#define QKV_V (384 * (size_t)T_TOK)
#define QKV_KD (1920 * (size_t)T_TOK)
struct RowsPostZ {
    bf16_t* qkv; const float* tb; const float* g_qn; const float* g_kn; bf16_t* lat; float* ssqd; bf16_t* kD;
    __device__ __forceinline__ void table(float*, int, int) const {}
    __device__ __forceinline__ void begin(float*, int, int, int) const {}
    __device__ __forceinline__ void chunk(const float* t, const float* rb, int m, int n, int c) const {
        const int qc = n >> 6;
        const int b = m / SEQ, s = m % SEQ;
        F8 v = f8_load(t);
        const float scA = 0.125f * LOG2E;
        if (qc < 6 || (qc >= 16 && qc < 22)) {
            const int mi = qc >= 16 ? 2 : 0; const int ql = qc - 8 * mi;
            const F8 pv = f8_shfl_xor(v, 4);
            const int j0 = 8 * (c & 3);
            const F8 cs = f8_load(tb + s * 32 + j0), sn = f8_load(tb + 131072 + s * 32 + j0);
            const size_t off = QKV_MIX(mi) + (ql < 4 ? ((size_t)(b * 4 + ql) * SEQ + s) * 64 : QKV_K + ((size_t)(b * 2 + (ql - 4)) * SEQ + s) * 64);
            *(uint4*)(qkv + off + 8 * c) = f8_rope_pack(v, pv, cs, sn, (c < 4) ? -1.f : 1.f, (ql < 4) ? scA : 1.f);
        } else if (qc == 6 || qc == 7 || qc == 14 || qc == 15 || qc == 22 || qc == 23) {
            *(uint4*)(qkv + QKV_MIX(qc >> 3) + QKV_V + ((size_t)(b * 2 + (qc & 1)) * SEQ + s) * 64 + 8 * c) = pack8(v.a, v.b);
        } else if (qc >= 8 && qc < 14) {
            const bool isq = qc < 12; const int h = isq ? qc - 8 : qc - 12;
            const float r = rsqrtf(sum8(f8_ssq(v)) * (1.f / 64.f) + 1e-6f);
            const F8 gq = f8_load(g_qn + 8 * c), gk = f8_load(g_kn + 8 * c);
            v.a.x *= r * (isq ? gq.a.x : gk.a.x); v.a.y *= r * (isq ? gq.a.y : gk.a.y); v.a.z *= r * (isq ? gq.a.z : gk.a.z); v.a.w *= r * (isq ? gq.a.w : gk.a.w);
            v.b.x *= r * (isq ? gq.b.x : gk.b.x); v.b.y *= r * (isq ? gq.b.y : gk.b.y); v.b.z *= r * (isq ? gq.b.z : gk.b.z); v.b.w *= r * (isq ? gq.b.w : gk.b.w);
            const F8 pv = f8_shfl_xor(v, 2);
            const int jj0 = 8 * (c & 1);
            const int to = (c < 4) ? 393216 + (s >> 6) * 16 : 395264 + (s & 63) * 16;
            const F8 cs = f8_load(tb + to + jj0), sn = f8_load(tb + to + 1024 + jj0);
            const size_t off = QKV_MIX(1) + (isq ? ((size_t)(b * 4 + h) * SEQ + s) * 64 : QKV_K + ((size_t)(b * 2 + h) * SEQ + s) * 64);
            *(uint4*)(qkv + off + 8 * c) = f8_rope_pack(v, pv, cs, sn, (c & 2) ? 1.f : -1.f, isq ? scA : 1.f);
        } else if (qc >= 24 && qc < 30) {
            const float ss = sum8(f8_ssq(v));
            const size_t off = qc < 28 ? (size_t)m * 256 + (qc - 24) * 64 : (size_t)T_TOK * 256 + (size_t)m * 128 + (qc - 28) * 64;
            *(uint4*)(lat + off + 8 * c) = pack8(v.a, v.b);
            if (c == 0) ssqd[(size_t)(qc - 24) * T_TOK + m] = ss;
        } else if (qc == 30) {
            const F8 pv = f8_shfl_xor(v, 2);
            if (c < 4) {
                const int i0 = 8 * (c & 1);
                const F8 cs = f8_load(tb + 262144 + s * 16 + i0), sn = f8_load(tb + 327680 + s * 16 + i0);
                const uint4 w = f8_rope_pack(v, pv, cs, sn, (c & 2) ? 1.f : -1.f, 1.f);
#pragma unroll
                for (int h = 0; h < 4; ++h) *(uint4*)(kD + ((size_t)(b * 4 + h) * SEQ + s) * 96 + 64 + 8 * c) = w;
            }
        }
    }
};
template <int NS, int DIM>
struct RowsStoreBf16Scale {
    bf16_t* C; int ldc; int N; const float* ssq;
    __device__ __forceinline__ void table(float*, int, int) const {}
    __device__ __forceinline__ void begin(float* ct, int m0, int, int tid) const {
        if (tid < 128) {
            float tot = 0.f;
#pragma unroll
            for (int j = 0; j < NS; ++j) tot += ssq[(size_t)j * T_TOK + m0 + tid];
            ct[tid * CT_STRIDE + 256] = rsqrtf(tot * (1.f / DIM) + 1e-6f);
        }
        __syncthreads();
    }
    __device__ __forceinline__ void chunk(const float* t, const float* rb, int m, int n, int c) const {
        const float r = rb[256];
        const float4 a = *(const float4*)t, b = *(const float4*)(t + 4);
        if (n + 8 * c < N) *(uint4*)(C + (size_t)m * ldc + n + 8 * c) = make_uint4(cvtpk(a.x * r, a.y * r), cvtpk(a.z * r, a.w * r), cvtpk(b.x * r, b.y * r), cvtpk(b.z * r, b.w * r));
    }
};

struct RowsPostQ {
    bf16_t* qD; const float* tb; const float* ssq;
    __device__ __forceinline__ void table(float*, int, int) const {}
    __device__ __forceinline__ void begin(float* ct, int m0, int, int tid) const {
        if (tid < 128) {
            const float tot = (ssq[m0 + tid] + ssq[(size_t)T_TOK + m0 + tid]) + (ssq[(size_t)2 * T_TOK + m0 + tid] + ssq[(size_t)3 * T_TOK + m0 + tid]);
            ct[tid * CT_STRIDE + 256] = rsqrtf(tot * (1.f / 256.f) + 1e-6f) * (0.10206207261596575f * LOG2E);
        }
        __syncthreads();
    }
    __device__ __forceinline__ void chunk(const float* t, const float* rb, int m, int n, int c) const {
        if (n >= 384) return;
        const float r = rb[256];
        const int qc = n >> 6, b = m / SEQ, s = m % SEQ;
        F8 v = f8_load(t);
        v.a.x *= r; v.a.y *= r; v.a.z *= r; v.a.w *= r; v.b.x *= r; v.b.y *= r; v.b.z *= r; v.b.w *= r;
        if (qc < 4) {
            *(uint4*)(qD + ((size_t)(b * 4 + qc) * SEQ + s) * 128 + 8 * c) = pack8(v.a, v.b);
        } else {
            const F8 pv = f8_shfl_xor(v, 2);
            const int h = (qc - 4) * 2 + (c >> 2), i0 = 8 * (c & 1);
            const F8 cs = f8_load(tb + 262144 + s * 16 + i0), sn = f8_load(tb + 327680 + s * 16 + i0);
            *(uint4*)(qD + ((size_t)(b * 4 + h) * SEQ + s) * 128 + 64 + 8 * (c & 3)) = f8_rope_pack(v, pv, cs, sn, (c & 2) ? 1.f : -1.f, 1.f);
        }
    }
};
struct RowsPostKV {
    bf16_t* kD; bf16_t* vD; const float* ssq;
    __device__ __forceinline__ void table(float*, int, int) const {}
    __device__ __forceinline__ void begin(float* ct, int m0, int, int tid) const {
        if (tid < 128) ct[tid * CT_STRIDE + 256] = rsqrtf((ssq[m0 + tid] + ssq[(size_t)T_TOK + m0 + tid]) * (1.f / 128.f) + 1e-6f);
        __syncthreads();
    }
    __device__ __forceinline__ void chunk(const float* t, const float* rb, int m, int n, int c) const {
        const float r = rb[256];
        const int qc = n >> 6, h = qc >> 1, b = m / SEQ, s = m % SEQ;
        F8 v = f8_load(t);
        v.a.x *= r; v.a.y *= r; v.a.z *= r; v.a.w *= r; v.b.x *= r; v.b.y *= r; v.b.z *= r; v.b.w *= r;
        const size_t hb = (size_t)(b * 4 + h) * SEQ + s;
        const size_t off = (qc & 1) ? hb * 64 : hb * 96;
        bf16_t* base = (bf16_t*)((qc & 1) ? (size_t)vD : (size_t)kD);
        *(uint4*)(base + off + 8 * c) = pack8(v.a, v.b);
    }
};

template <class Epi>
__device__ __forceinline__ void gemm_phase(const bf16_t* X, int ldx, const bf16_t* W, int ldw, int M, int N, int K, char* lds, const Epi& epi) {
    const int ntm = M >> 7, ntn = (N + 127) >> 7, nt_tot = ntm * ntn;
    for (int tile = blockIdx.x; tile < nt_tot; tile += gridDim.x) {
        int mt, nt;
        if ((gridDim.x & 7) == 0 && (gridDim.x >> 3) * 8 == gridDim.x && ((gridDim.x >> 3) & 63) == 0) tile_map(tile, ntm, ntn, mt, nt);
        else { mt = tile / ntn; nt = tile % ntn; }
        if (mt < ntm && nt < ntn) gemm_tile(X, ldx, W, ldw, K, mt * 128, nt * 128, N, lds, epi);
    }
}

template <int OFF> __device__ __forceinline__ s16x4 tr_read(int vb) {
    s16x4 r; asm volatile("ds_read_b64_tr_b16 %0, %1 offset:%2" : "=&v"(r) : "v"(vb), "i"(OFF) : "memory"); return r;
}
#define VS_BYTES 192

template <int KT2>
__device__ __forceinline__ void pv_sub(f32x16 (&o)[2], const f32x16& p, int vbase) {
    bf16x8 pf[2];
#pragma unroll
    for (int s2 = 0; s2 < 2; ++s2) {
        unsigned a = cvtpk(p[8 * s2 + 0], p[8 * s2 + 1]), b = cvtpk(p[8 * s2 + 2], p[8 * s2 + 3]);
        unsigned c = cvtpk(p[8 * s2 + 4], p[8 * s2 + 5]), d = cvtpk(p[8 * s2 + 6], p[8 * s2 + 7]);
        uint4 w = make_uint4(a, b, c, d);
        pf[s2] = *(bf16x8*)&w;
    }
    {
        s16x4 l00 = tr_read<(KT2 * 32 + 0) * VS_BYTES + 0>(vbase), h00 = tr_read<(KT2 * 32 + 8) * VS_BYTES + 0>(vbase);
        s16x4 l01 = tr_read<(KT2 * 32 + 0) * VS_BYTES + 64>(vbase), h01 = tr_read<(KT2 * 32 + 8) * VS_BYTES + 64>(vbase);
        s16x4 l10 = tr_read<(KT2 * 32 + 16) * VS_BYTES + 0>(vbase), h10 = tr_read<(KT2 * 32 + 24) * VS_BYTES + 0>(vbase);
        s16x4 l11 = tr_read<(KT2 * 32 + 16) * VS_BYTES + 64>(vbase), h11 = tr_read<(KT2 * 32 + 24) * VS_BYTES + 64>(vbase);
        asm volatile("s_waitcnt lgkmcnt(0)" ::: "memory");
        __builtin_amdgcn_sched_barrier(0);
#define PKV(L, H) (bf16x8){L[0], L[1], L[2], L[3], H[0], H[1], H[2], H[3]}
        o[0] = __builtin_amdgcn_mfma_f32_32x32x16_bf16(PKV(l00, h00), pf[0], o[0], 0, 0, 0);
        o[1] = __builtin_amdgcn_mfma_f32_32x32x16_bf16(PKV(l01, h01), pf[0], o[1], 0, 0, 0);
        o[0] = __builtin_amdgcn_mfma_f32_32x32x16_bf16(PKV(l10, h10), pf[1], o[0], 0, 0, 0);
        o[1] = __builtin_amdgcn_mfma_f32_32x32x16_bf16(PKV(l11, h11), pf[1], o[1], 0, 0, 0);
#undef PKV
    }
}


#define PV_LOAD(KT2, VB, F) \
    const s16x4 F##0 = tr_read<((KT2) * 32 + 0) * VS_BYTES + 0>(VB), F##1 = tr_read<((KT2) * 32 + 8) * VS_BYTES + 0>(VB), \
                F##2 = tr_read<((KT2) * 32 + 0) * VS_BYTES + 64>(VB), F##3 = tr_read<((KT2) * 32 + 8) * VS_BYTES + 64>(VB), \
                F##4 = tr_read<((KT2) * 32 + 16) * VS_BYTES + 0>(VB), F##5 = tr_read<((KT2) * 32 + 24) * VS_BYTES + 0>(VB), \
                F##6 = tr_read<((KT2) * 32 + 16) * VS_BYTES + 64>(VB), F##7 = tr_read<((KT2) * 32 + 24) * VS_BYTES + 64>(VB)
#define PKV2(L, H) (bf16x8){L[0], L[1], L[2], L[3], H[0], H[1], H[2], H[3]}
#define PV_MMA(O, P, F) do { bf16x8 _pf0, _pf1; \
        { uint4 _w = make_uint4(cvtpk(P[0], P[1]), cvtpk(P[2], P[3]), cvtpk(P[4], P[5]), cvtpk(P[6], P[7])); _pf0 = *(bf16x8*)&_w; } \
        { uint4 _w = make_uint4(cvtpk(P[8], P[9]), cvtpk(P[10], P[11]), cvtpk(P[12], P[13]), cvtpk(P[14], P[15])); _pf1 = *(bf16x8*)&_w; } \
        O[0] = __builtin_amdgcn_mfma_f32_32x32x16_bf16(PKV2(F##0, F##1), _pf0, O[0], 0, 0, 0); \
        O[1] = __builtin_amdgcn_mfma_f32_32x32x16_bf16(PKV2(F##2, F##3), _pf0, O[1], 0, 0, 0); \
        O[0] = __builtin_amdgcn_mfma_f32_32x32x16_bf16(PKV2(F##4, F##5), _pf1, O[0], 0, 0, 0); \
        O[1] = __builtin_amdgcn_mfma_f32_32x32x16_bf16(PKV2(F##6, F##7), _pf1, O[1], 0, 0, 0); } while (0)

template <int DK, int G, bool WINDOW>
__device__ __forceinline__ void attn_item(const bf16_t* __restrict__ Q, const bf16_t* __restrict__ K, const bf16_t* __restrict__ V, const float* __restrict__ sink,
                                          bf16_t* __restrict__ O, int ocol, int H, int KV, int item, char* lds, int qs = DK) {
    constexpr int KS = DK * 2 + 16;
    constexpr int KCH = DK / 8;
    constexpr int KLD = (128 * KCH) / 512;
    constexpr int QB = 256 / G;
    constexpr int NCH = SEQ / QB;
    constexpr int KBUF = 128 * KS, VBUF = 128 * VS_BYTES;
    const int tid = tid_opaque(), lane = tid & 63, wave = tid >> 6;
    const int r32 = lane & 31, hh = lane >> 5;
    const int chunk = item % NCH, kvh = (item / NCH) % KV, b = item / (NCH * KV);
    const int g = (G == 2) ? (wave >> 2) : 0;
    const int qoff = (G == 2) ? (wave & 3) * 32 : wave * 32;
    const int head = kvh * G + g;
    const int q0 = chunk * QB;
    const int qpos = q0 + qoff + r32;
    bf16x8 qf[DK / 16];
    {
        const bf16_t* qp = Q + ((size_t)(b * H + head) * SEQ + qpos) * qs + hh * 8;
#pragma unroll
        for (int ks = 0; ks < DK / 16; ++ks) qf[ks] = *(const bf16x8*)(qp + ks * 16);
    }
    int kt_lo = 0, kt_hi = SEQ / 128;
    if (WINDOW) { kt_lo = q0 / 128 - 1; if (kt_lo < 0) kt_lo = 0; kt_hi = (q0 + QB) / 128 + 1; if (kt_hi > SEQ / 128) kt_hi = SEQ / 128; }
    const char* Kg = (const char*)(K + (size_t)(b * KV + kvh) * SEQ * DK);
    const char* Vg = (const char*)(V + (size_t)(b * KV + kvh) * SEQ * 64);
    uint4 kr0, kr1, kr2 = make_uint4(0, 0, 0, 0), vr0, vr1;
    const int koff0 = (tid / KCH) * KS + (tid % KCH) * 16;
    const int koff1 = ((tid + 512) / KCH) * KS + ((tid + 512) % KCH) * 16;
    const int koff2 = ((tid + 1024) / KCH) * KS + ((tid + 1024) % KCH) * 16;
    const int voff0 = (tid >> 3) * VS_BYTES + (tid & 7) * 16;
    const int voff1 = ((tid + 512) >> 3) * VS_BYTES + (tid & 7) * 16;
    f32x16 o[2];
#pragma unroll
    for (int d = 0; d < 2; ++d)
#pragma unroll
        for (int i = 0; i < 16; ++i) o[d][i] = 0.f;
    float m = -1e30f, l = 0.f;
    if (WINDOW) { m = sink[head] * LOG2E; l = (hh == 0) ? 1.f : 0.f; }
    const int gg = lane >> 4, li = lane & 15;
    const int vlane = (4 * (gg >> 1) + (li >> 2)) * VS_BYTES + (16 * (gg & 1) + 4 * (li & 3)) * 2;
    char* Kl = lds; char* Vl = lds + 2 * KBUF;
#define AGLOAD(KT) do { const char* _kg = Kg + (size_t)(KT) * 128 * DK * 2; const char* _vg = Vg + (size_t)(KT) * 128 * 128; \
        kr0 = *(const uint4*)(_kg + tid * 16); kr1 = *(const uint4*)(_kg + (tid + 512) * 16); if (KLD > 2) kr2 = *(const uint4*)(_kg + (tid + 1024) * 16); \
        vr0 = *(const uint4*)(_vg + tid * 16); vr1 = *(const uint4*)(_vg + (tid + 512) * 16); } while (0)
#define ASTORE(KB, VB) do { char* _kd = (KB); char* _vd = (VB); *(uint4*)(_kd + koff0) = kr0; *(uint4*)(_kd + koff1) = kr1; if (KLD > 2) *(uint4*)(_kd + koff2) = kr2; \
        *(uint4*)(_vd + voff0) = vr0; *(uint4*)(_vd + voff1) = vr1; } while (0)
    AGLOAD(kt_lo);
    ASTORE(Kl, Vl);
    { const int k1 = kt_lo + 1 < kt_hi ? kt_lo + 1 : kt_lo; AGLOAD(k1); }
    __syncthreads();
    for (int kt = kt_lo; kt < kt_hi; ++kt) {
        const int cur = (kt - kt_lo) & 1;
        ASTORE(Kl + (cur ^ 1) * KBUF, Vl + (cur ^ 1) * VBUF);
        { const int ktn = kt + 2 < kt_hi ? kt + 2 : kt_hi - 1; AGLOAD(ktn); }
        __builtin_amdgcn_sched_barrier(0);
#pragma unroll
        for (int sub = 0; sub < 2; ++sub) {
            const char* kb = Kl + cur * KBUF + sub * 64 * KS;
            const float mi = (m < -1e29f) ? 0.f : m;
            f32x16 s0, s1;
#pragma unroll
            for (int i = 0; i < 16; ++i) { s0[i] = -mi; s1[i] = -mi; }
#pragma unroll
            for (int ks = 0; ks < DK / 16; ++ks) {
                bf16x8 k0 = *(const bf16x8*)(kb + r32 * KS + (ks * 2 + hh) * 16);
                bf16x8 k1 = *(const bf16x8*)(kb + (32 + r32) * KS + (ks * 2 + hh) * 16);
                s0 = __builtin_amdgcn_mfma_f32_32x32x16_bf16(k0, qf[ks], s0, 0, 0, 0);
                s1 = __builtin_amdgcn_mfma_f32_32x32x16_bf16(k1, qf[ks], s1, 0, 0, 0);
            }
            if (WINDOW) {
                const int kb0 = kt * 128 + sub * 64 + 4 * hh - qpos;
#pragma unroll
                for (int i = 0; i < 16; ++i) {
                    const int d0 = kb0 + (i & 3) + 8 * (i >> 2), d1 = d0 + 32;
                    s0[i] = (d0 > 128 || d0 < -128) ? -1e30f : s0[i];
                    s1[i] = (d1 > 128 || d1 < -128) ? -1e30f : s1[i];
                }
            }
            const int vbase = (int)(size_t)(Vl + cur * VBUF - lds) + sub * 64 * VS_BYTES + vlane;
            PV_LOAD(0, vbase, vfa);
            PV_LOAD(1, vbase, vfb);
            __builtin_amdgcn_sched_barrier(0);
            float tmax = s0[0];
#pragma unroll
            for (int i = 1; i < 16; ++i) tmax = fmaxf(tmax, s0[i]);
#pragma unroll
            for (int i = 0; i < 16; ++i) tmax = fmaxf(tmax, s1[i]);
            tmax = xhalf_max(tmax);
            float ps = 0.f;
            if (__all(m > -1e29f && tmax <= 8.f)) {
#pragma unroll
                for (int i = 0; i < 16; ++i) { s0[i] = __builtin_amdgcn_exp2f(s0[i]); ps += s0[i]; }
#pragma unroll
                for (int i = 0; i < 16; ++i) { s1[i] = __builtin_amdgcn_exp2f(s1[i]); ps += s1[i]; }
                l += ps;
            } else {
                const float mn = fmaxf(m, mi + tmax);
                const float d = mn - mi;
                const float alpha = __builtin_amdgcn_exp2f(m - mn);
                m = mn;
#pragma unroll
                for (int i = 0; i < 16; ++i) { s0[i] = __builtin_amdgcn_exp2f(s0[i] - d); ps += s0[i]; }
#pragma unroll
                for (int i = 0; i < 16; ++i) { s1[i] = __builtin_amdgcn_exp2f(s1[i] - d); ps += s1[i]; }
                l = l * alpha + ps;
#pragma unroll
                for (int dd = 0; dd < 2; ++dd)
#pragma unroll
                    for (int i = 0; i < 16; ++i) o[dd][i] *= alpha;
            }
            asm volatile("s_waitcnt lgkmcnt(0)" ::: "memory");
            __builtin_amdgcn_sched_barrier(0);
            PV_MMA(o, s0, vfa);
            PV_MMA(o, s1, vfb);
        }
        __syncthreads();
    }
#undef AGLOAD
#undef ASTORE
    l = xhalf_sum(l);
    const float inv = 1.f / l;
    bf16_t* orow = O + (size_t)(b * SEQ + qpos) * DM + ocol + head * 64;
#pragma unroll
    for (int d = 0; d < 2; ++d)
#pragma unroll
        for (int gq = 0; gq < 4; ++gq) {
            uint2 w;
            w.x = cvtpk(o[d][gq * 4 + 0] * inv, o[d][gq * 4 + 1] * inv);
            w.y = cvtpk(o[d][gq * 4 + 2] * inv, o[d][gq * 4 + 3] * inv);
            *(uint2*)(orow + d * 32 + 8 * gq + 4 * hh) = w;
        }
}

__device__ __forceinline__ void dil_wave_item(const bf16_t* __restrict__ Q, const bf16_t* __restrict__ K, const bf16_t* __restrict__ V,
                                              bf16_t* __restrict__ O, int witem, char* wlds, int lds_off) {
    const int lane = tid_opaque() & 63, r32 = lane & 31, hh = lane >> 5;
    const int c = witem & 15, chunk = (witem >> 4) & 15, kvh = (witem >> 8) & 1, b = witem >> 9;
    const int t0 = chunk * 256;
    const int mq = r32 & 15, g = r32 >> 4;
    const int qpos = t0 + 16 * mq + c, head = kvh * 2 + g;
    bf16x8 qf[4];
    {
        const bf16_t* qp = Q + ((size_t)(b * 4 + head) * SEQ + qpos) * 64 + hh * 8;
#pragma unroll
        for (int ks = 0; ks < 4; ++ks) qf[ks] = *(const bf16x8*)(qp + ks * 16);
    }
    const bf16_t* Kg = K + (size_t)(b * 2 + kvh) * SEQ * 64;
    const bf16_t* Vg = V + (size_t)(b * 2 + kvh) * SEQ * 64;
    f32x16 o[2];
#pragma unroll
    for (int d = 0; d < 2; ++d)
#pragma unroll
        for (int i = 0; i < 16; ++i) o[d][i] = 0.f;
    float m = -1e30f, l = 0.f;
    const int gg = lane >> 4, li = lane & 15;
    const int vlane = lds_off + (4 * (gg >> 1) + (li >> 2)) * VS_BYTES + (16 * (gg & 1) + 4 * (li & 3)) * 2;
    for (int it = 0; it < 23; ++it) {
        int sh, j;
        if (it < 12) { sh = 0; j = it; } else if (it < 18) { sh = 2; j = it - 12; } else { sh = 4; j = it - 18; }
        const int rr = 1 << sh;
        const int cc = c & (rr - 1);
        const int idx0 = (t0 >> sh) - 64 + 32 * j;
        const int lim = SEQ >> sh;
        if (idx0 + 31 < 0 || idx0 >= lim) continue;
        bf16x8 kf[4];
        {
            int idx = idx0 + r32; idx = idx < 0 ? 0 : (idx >= lim ? lim - 1 : idx);
            const bf16_t* kp = Kg + (size_t)((idx << sh) + cc) * 64 + hh * 8;
#pragma unroll
            for (int ks = 0; ks < 4; ++ks) kf[ks] = *(const bf16x8*)(kp + ks * 16);
        }
        uint4 vr[4];
#pragma unroll
        for (int jj = 0; jj < 4; ++jj) {
            const int id = lane + 64 * jj; int idx = idx0 + (id >> 3); idx = idx < 0 ? 0 : (idx >= lim ? lim - 1 : idx);
            vr[jj] = *(const uint4*)(Vg + (size_t)((idx << sh) + cc) * 64 + (id & 7) * 8);
        }
#pragma unroll
        for (int jj = 0; jj < 4; ++jj) { const int id = lane + 64 * jj; *(uint4*)(wlds + (id >> 3) * VS_BYTES + (id & 7) * 16) = vr[jj]; }
        f32x16 s;
#pragma unroll
        for (int i = 0; i < 16; ++i) s[i] = 0.f;
#pragma unroll
        for (int ks = 0; ks < 4; ++ks) s = __builtin_amdgcn_mfma_f32_32x32x16_bf16(kf[ks], qf[ks], s, 0, 0, 0);
        const int qidx = qpos >> sh;
        const int base = idx0 + 4 * hh;
#pragma unroll
        for (int i = 0; i < 16; ++i) {
            const int idx = base + (i & 3) + 8 * (i >> 2);
            const int d = idx - qidx;
            s[i] = (d > 64 || d < -64 || idx < 0 || idx >= lim) ? -1e30f : s[i];
        }
        float tmax = s[0];
#pragma unroll
        for (int i = 1; i < 16; ++i) tmax = fmaxf(tmax, s[i]);
        tmax = fmaxf(tmax, xhalf(tmax));
        const float mn = fmaxf(fmaxf(m, tmax), -1e20f);
        const float alpha = __builtin_amdgcn_exp2f(m - mn);
        m = mn;
        float ps = 0.f;
#pragma unroll
        for (int i = 0; i < 16; ++i) { s[i] = __builtin_amdgcn_exp2f(s[i] - mn); ps += s[i]; }
        l = l * alpha + ps;
#pragma unroll
        for (int d = 0; d < 2; ++d)
#pragma unroll
            for (int i = 0; i < 16; ++i) o[d][i] *= alpha;
        pv_sub<0>(o, s, vlane);
    }
    l += xhalf(l);
    const float inv = 1.f / l;
    bf16_t* orow = O + (size_t)(b * SEQ + qpos) * DM + 512 + head * 64;
#pragma unroll
    for (int d = 0; d < 2; ++d)
#pragma unroll
        for (int gq = 0; gq < 4; ++gq) {
            uint2 w;
            w.x = cvtpk(o[d][gq * 4 + 0] * inv, o[d][gq * 4 + 1] * inv);
            w.y = cvtpk(o[d][gq * 4 + 2] * inv, o[d][gq * 4 + 3] * inv);
            *(uint2*)(orow + d * 32 + 8 * gq + 4 * hh) = w;
        }
}

__device__ __forceinline__ int f2key(float f) { int b = __float_as_int(f); return b ^ ((b >> 31) & 0x7fffffff); }
__device__ __forceinline__ float key2f(int k) { return __int_as_float(k ^ ((k >> 31) & 0x7fffffff)); }

template <int N>
__device__ __forceinline__ void bitonic_sort_desc(int (&a)[N]) {
#pragma unroll
    for (int k = 2; k <= N; k <<= 1) {
#pragma unroll
        for (int j = k >> 1; j > 0; j >>= 1) {
#pragma unroll
            for (int i = 0; i < N; ++i) {
                const int l2 = i ^ j;
                if (l2 > i) {
                    const bool up = ((i & k) == 0);
                    const int hi = max(a[i], a[l2]), lo = min(a[i], a[l2]);
                    a[i] = up ? hi : lo; a[l2] = up ? lo : hi;
                }
            }
        }
    }
}
__device__ __forceinline__ void merge_top16(int (&a)[16], const int (&b)[16]) {
#pragma unroll
    for (int i = 0; i < 16; ++i) a[i] = max(a[i], b[15 - i]);
#pragma unroll
    for (int j = 8; j > 0; j >>= 1) {
#pragma unroll
        for (int i = 0; i < 16; ++i) {
            const int l2 = i ^ j;
            if (l2 > i) { const int hi = max(a[i], a[l2]), lo = min(a[i], a[l2]); a[i] = hi; a[l2] = lo; }
        }
    }
}
__device__ __forceinline__ void top16_of_64(int (&g0)[16], int (&g1)[16], int (&g2)[16], int (&g3)[16]) {
    bitonic_sort_desc<16>(g0); bitonic_sort_desc<16>(g1); bitonic_sort_desc<16>(g2); bitonic_sort_desc<16>(g3);
    merge_top16(g0, g1); merge_top16(g2, g3); merge_top16(g0, g2);
}

__device__ __forceinline__ void topk_core(const bf16_t* q0, const bf16_t* __restrict__ subk_h, float rscale, int* eo, float* go, char* wlds) {
    const int lane = tid_opaque() & 63, r32 = lane & 31, hh = lane >> 5;
    int top[2][16];
#pragma unroll
    for (int c = 0; c < 2; ++c) {
        bf16x8 qf[8];
        const bf16_t* qrow = q0 + c * 128;
#pragma unroll
        for (int ks = 0; ks < 8; ++ks) qf[ks] = *(const bf16x8*)(qrow + ks * 16);
        const bf16_t* kb = subk_h + ((size_t)c * 128 + r32) * 128 + hh * 8;
        int grp[4][16];
#pragma unroll
        for (int kt = 0; kt < 4; ++kt) {
            f32x16 s;
#pragma unroll
            for (int i = 0; i < 16; ++i) s[i] = 0.f;
#pragma unroll
            for (int ks = 0; ks < 8; ++ks) {
                bf16x8 kf = *(const bf16x8*)(kb + (size_t)kt * 32 * 128 + ks * 16);
                s = __builtin_amdgcn_mfma_f32_32x32x16_bf16(kf, qf[ks], s, 0, 0, 0);
            }
#pragma unroll
            for (int i = 0; i < 16; ++i) grp[kt][i] = (f2key(s[i]) & ~127) | (kt * 32 + crow(i, hh));
        }
        top16_of_64(grp[0], grp[1], grp[2], grp[3]);
        int oth[16];
#pragma unroll
        for (int i = 0; i < 16; ++i) oth[i] = __shfl_xor(grp[0][i], 32);
        merge_top16(grp[0], oth);
#pragma unroll
        for (int i = 0; i < 16; ++i) top[c][i] = grp[0][i];
    }
    {
        unsigned* my = (unsigned*)(wlds + lane * 36);
#pragma unroll
        for (int c = 0; c < 2; ++c)
#pragma unroll
            for (int w4 = 0; w4 < 4; ++w4) {
                unsigned v = (top[c][w4 * 4] & 127) | ((top[c][w4 * 4 + 1] & 127) << 8) | ((top[c][w4 * 4 + 2] & 127) << 16) | ((top[c][w4 * 4 + 3] & 127) << 24);
                my[c * 4 + w4] = v;
            }
    }
    float v1[16], v2[16];
#pragma unroll
    for (int i = 0; i < 16; ++i) { v1[i] = key2f(top[0][i] & ~127); v2[i] = key2f(top[1][i] & ~127); }
    int cg[4][16];
    {
        int n = 0;
#pragma unroll
        for (int i = 0; i < 16; ++i)
#pragma unroll
            for (int j = 0; j < 16; ++j)
                if ((i + 1) * (j + 1) <= 16) { cg[n >> 4][n & 15] = (f2key(v1[i] + v2[j]) & ~255) | (i * 16 + j); ++n; }
#pragma unroll
        for (int q = 50; q < 64; ++q) cg[q >> 4][q & 15] = (int)0x80000000;
    }
    top16_of_64(cg[0], cg[1], cg[2], cg[3]);
    float bv[16];
#pragma unroll
    for (int i = 0; i < 16; ++i) bv[i] = key2f(cg[0][i] & ~255) * rscale;
    float sm = 0.f;
    const float bmx = bv[0];
#pragma unroll
    for (int i = 0; i < 16; ++i) { bv[i] = __expf(bv[i] - bmx); sm += bv[i]; }
    const float inv = 1.f / sm;
    if (hh == 0) {
        const unsigned char* my = (const unsigned char*)(wlds + lane * 36);
#pragma unroll
        for (int q4 = 0; q4 < 4; ++q4) {
            int4 ev; float4 gv;
            int* evp = (int*)&ev; float* gvp = (float*)&gv;
#pragma unroll
            for (int u = 0; u < 4; ++u) {
                const int code = cg[0][q4 * 4 + u] & 255;
                const int i1 = my[code >> 4], i2 = my[16 + (code & 15)];
                evp[u] = i1 * 128 + i2; gvp[u] = bv[q4 * 4 + u] * inv;
            }
            *(int4*)(eo + q4 * 4) = ev; *(float4*)(go + q4 * 4) = gv;
        }
    }
}

__device__ __forceinline__ void topk_wave_item(const bf16_t* __restrict__ qp, const bf16_t* __restrict__ subk, int* __restrict__ eidx, float* __restrict__ gate, int witem, char* wlds) {
    const int lane = tid_opaque() & 63, r32 = lane & 31, hh = lane >> 5;
    const int h = witem & 7, t = (witem >> 3) * 32 + r32;
    topk_core(qp + (size_t)t * 2048 + h * 256 + hh * 8, subk + (size_t)h * 2 * 128 * 128, 1.f, eidx + ((size_t)h * T_TOK + t) * 16, gate + ((size_t)h * T_TOK + t) * 16, wlds);
}
__device__ __forceinline__ void gemm_tile_topk(const bf16_t* __restrict__ X, int ldx, const bf16_t* __restrict__ W, int ldw, int K, int m0, int h, char* lds,
                                               const bf16_t* __restrict__ subk, const float* __restrict__ ssq, int* __restrict__ eidx, float* __restrict__ gate) {
    const int tid = tid_opaque(), lane = tid & 63, wave = tid >> 6;
    const int wm = wave >> 1, wn = wave & 1;
    const int r32 = lane & 31, hh = lane >> 5;
    {
        f32x16 acc[2][4];
        gemm_mainloop(X, ldx, W, ldw, K, m0, h * 256, 2048, lds, acc);
        bf16_t* qst = (bf16_t*)lds;
#pragma unroll
        for (int mt = 0; mt < 2; ++mt)
#pragma unroll
            for (int nt = 0; nt < 4; ++nt)
#pragma unroll
                for (int i = 0; i < 16; ++i)
                    qst[(wm * 64 + mt * 32 + crow(i, hh)) * QST + wn * 128 + nt * 32 + r32] = f2bf(acc[mt][nt][i]);
    }
    __syncthreads();
    {
        const int tok = wave * 32 + r32, t = m0 + tok;
        float tot = 0.f;
#pragma unroll
        for (int j = 0; j < 4; ++j) { const float4 q = *(const float4*)(ssq + ((size_t)j * T_TOK + t) * 4); tot += (q.x + q.y) + (q.z + q.w); }
        const float r = rsqrtf(tot * (1.f / DM) + 1e-6f);
        topk_core((const bf16_t*)lds + tok * QST + hh * 8, subk + (size_t)h * 2 * 128 * 128, r, eidx + ((size_t)h * T_TOK + t) * 16, gate + ((size_t)h * T_TOK + t) * 16,
                  lds + TOPK_STASH + wave * 2304);
    }
    __syncthreads();
}

typedef __attribute__((ext_vector_type(2))) float f32x2;
__device__ __forceinline__ float fdot2bf(unsigned a, unsigned b, float acc) {
    return __builtin_amdgcn_fdot2_f32_bf16(*(bf16x2_t*)&a, *(bf16x2_t*)&b, acc, false);
}
__device__ __forceinline__ unsigned fp8pair_to_bf16(unsigned w, bool hi) {
    bf16x2_t r = hi ? __builtin_amdgcn_cvt_scalef32_pk_bf16_fp8((int)w, 1.0f, true) : __builtin_amdgcn_cvt_scalef32_pk_bf16_fp8((int)w, 1.0f, false);
    return *(unsigned*)&r;
}
__device__ __forceinline__ float dot16_fp8(uint4 u, const unsigned (&h)[8]) {
    float a = 0.f;
    a = fdot2bf(fp8pair_to_bf16(u.x, false), h[0], a); a = fdot2bf(fp8pair_to_bf16(u.x, true), h[1], a);
    a = fdot2bf(fp8pair_to_bf16(u.y, false), h[2], a); a = fdot2bf(fp8pair_to_bf16(u.y, true), h[3], a);
    a = fdot2bf(fp8pair_to_bf16(u.z, false), h[4], a); a = fdot2bf(fp8pair_to_bf16(u.z, true), h[5], a);
    a = fdot2bf(fp8pair_to_bf16(u.w, false), h[6], a); a = fdot2bf(fp8pair_to_bf16(u.w, true), h[7], a);
    return a;
}
__device__ __forceinline__ void axpy16_fp8(float (&acc)[16], float w, uint4 v) {
    f32x2 r;
    r = __builtin_amdgcn_cvt_pk_f32_fp8((int)v.x, false); acc[0] += w * r[0]; acc[1] += w * r[1];
    r = __builtin_amdgcn_cvt_pk_f32_fp8((int)v.x, true);  acc[2] += w * r[0]; acc[3] += w * r[1];
    r = __builtin_amdgcn_cvt_pk_f32_fp8((int)v.y, false); acc[4] += w * r[0]; acc[5] += w * r[1];
    r = __builtin_amdgcn_cvt_pk_f32_fp8((int)v.y, true);  acc[6] += w * r[0]; acc[7] += w * r[1];
    r = __builtin_amdgcn_cvt_pk_f32_fp8((int)v.z, false); acc[8] += w * r[0]; acc[9] += w * r[1];
    r = __builtin_amdgcn_cvt_pk_f32_fp8((int)v.z, true);  acc[10] += w * r[0]; acc[11] += w * r[1];
    r = __builtin_amdgcn_cvt_pk_f32_fp8((int)v.w, false); acc[12] += w * r[0]; acc[13] += w * r[1];
    r = __builtin_amdgcn_cvt_pk_f32_fp8((int)v.w, true);  acc[14] += w * r[0]; acc[15] += w * r[1];
}
__device__ __forceinline__ float gelu_exact(float a) { return 0.5f * a * (1.f + erff(a * 0.70710678118654752f)); }

__device__ __forceinline__ float transpose_reduce16(f32x16 p, int lane) {
#pragma unroll
    for (int st = 0; st < 4; ++st) {
        const int o = 32 >> st, n = 16 >> st;
        const bool up = (lane & o) != 0;
#pragma unroll
        for (int i = 0; i < n / 2; ++i) {
            float lo = p[i], hi = p[i + n / 2];
            asm volatile("" : "+v"(lo), "+v"(hi));
            const float keep = up ? hi : lo;
            const float send = up ? lo : hi;
            p[i] = keep + __shfl_xor(send, o);
        }
    }
    float v = p[0];
    v += __shfl_xor(v, 1); v += __shfl_xor(v, 2);
    return v;
}
#define EX_SB() __builtin_amdgcn_sched_barrier(0)
#define EX_LD1(R, TAB, EB, S) R = *(const uint4*)((TAB) + (unsigned)((__builtin_amdgcn_readlane((EB), (S)) << 10) + lane16))
#define EX_LOAD8(P, TAB, EB, SL) do { EX_LD1(P##0, TAB, EB, (SL) + 0); EX_LD1(P##1, TAB, EB, (SL) + 1); EX_LD1(P##2, TAB, EB, (SL) + 2); EX_LD1(P##3, TAB, EB, (SL) + 3); \
        EX_LD1(P##4, TAB, EB, (SL) + 4); EX_LD1(P##5, TAB, EB, (SL) + 5); EX_LD1(P##6, TAB, EB, (SL) + 6); EX_LD1(P##7, TAB, EB, (SL) + 7); } while (0)
#define EX_DOT8(P, PP, O) do { PP[(O) + 0] = dot16_fp8(P##0, hp); PP[(O) + 1] = dot16_fp8(P##1, hp); PP[(O) + 2] = dot16_fp8(P##2, hp); PP[(O) + 3] = dot16_fp8(P##3, hp); \
        PP[(O) + 4] = dot16_fp8(P##4, hp); PP[(O) + 5] = dot16_fp8(P##5, hp); PP[(O) + 6] = dot16_fp8(P##6, hp); PP[(O) + 7] = dot16_fp8(P##7, hp); } while (0)
#define EX_RL(W, S) __int_as_float(__builtin_amdgcn_readlane(__float_as_int(W), (S)))
#define EX_AXPY8(P, W, SL) do { axpy16_fp8(acc, EX_RL(W, (SL) + 0), P##0); axpy16_fp8(acc, EX_RL(W, (SL) + 1), P##1); axpy16_fp8(acc, EX_RL(W, (SL) + 2), P##2); axpy16_fp8(acc, EX_RL(W, (SL) + 3), P##3); \
        axpy16_fp8(acc, EX_RL(W, (SL) + 4), P##4); axpy16_fp8(acc, EX_RL(W, (SL) + 5), P##5); axpy16_fp8(acc, EX_RL(W, (SL) + 6), P##6); axpy16_fp8(acc, EX_RL(W, (SL) + 7), P##7); } while (0)
#define EX_COPY8(D, S_) do { D##0 = S_##0; D##1 = S_##1; D##2 = S_##2; D##3 = S_##3; D##4 = S_##4; D##5 = S_##5; D##6 = S_##6; D##7 = S_##7; } while (0)

__device__ __forceinline__ void expert_token(PC& p, int layer, int t, bool last, bool dummy = false) {
    const int lane = tid_opaque() & 63;
    const int lane16 = lane * 16;
    const float* gfb = p.g_ffn + layer * DM; asm volatile("" : "+s"(gfb));
    const float* gf = gfb + lane * 16;
    float* xrow = p.x + (size_t)t * DM + lane * 16;
    float* xwr = dummy ? (float*)p.zb + (size_t)t * DM + lane * 16 : xrow;
    bf16_t* hwr = (dummy ? p.q.qA + (size_t)t * DM : p.hnb + (size_t)t * DM) + lane * 16;
    float xv[16];
#pragma unroll
    for (int q = 0; q < 4; ++q) { const float4 a = *(const float4*)(xrow + 4 * q); xv[4 * q] = a.x; xv[4 * q + 1] = a.y; xv[4 * q + 2] = a.z; xv[4 * q + 3] = a.w; }
    float ss = 0.f;
#pragma unroll
    for (int i = 0; i < 16; ++i) ss += xv[i] * xv[i];
    ss = wave_sum(ss);
    const float rstd = rsqrtf(ss * (1.f / DM) + 1e-6f);
    unsigned hp[8];
#pragma unroll
    for (int q = 0; q < 4; ++q) {
        const float4 g = *(const float4*)(gf + 4 * q);
        hp[2 * q] = cvtpk(xv[4 * q] * rstd * g.x, xv[4 * q + 1] * rstd * g.y);
        hp[2 * q + 1] = cvtpk(xv[4 * q + 2] * rstd * g.z, xv[4 * q + 3] * rstd * g.w);
    }
    const size_t ei0 = ((size_t)(lane >> 4) * T_TOK + t) * 16 + (lane & 15), ei1 = ei0 + (size_t)4 * T_TOK * 16;
    const int e0 = p.eidx[ei0], e1 = p.eidx[ei1];
    const float g0 = p.gate[ei0], g1 = p.gate[ei1];
    const unsigned char* u8 = p.u8 + (size_t)layer * 16384 * DM;
    const unsigned char* v8 = p.v8 + (size_t)layer * 16384 * DM;
    const float* su = p.su + layer * 16384; const float* sv = p.sv + layer * 16384;
    const float su0 = su[e0], su1 = su[e1], sv0 = sv[e0], sv1 = sv[e1];
    uint4 rx0, rx1, rx2, rx3, rx4, rx5, rx6, rx7, ry0, ry1, ry2, ry3, ry4, ry5, ry6, ry7;
    float a0 = 0.f, a1 = 0.f;
    EX_LOAD8(rx, u8, e0, 0);
#pragma unroll 1
    for (int g = 0; g < 8; ++g) {
        const int eb = g < 4 ? e0 : e1;
        const int sl = (g & 3) * 16;
        f32x16 pp;
        EX_LOAD8(ry, u8, eb, sl + 8);
        EX_SB();
        EX_DOT8(rx, pp, 0);
        EX_SB();
        {
            const int gn = g + 1 < 8 ? g + 1 : 0;
            const int ebn = gn < 4 ? e0 : e1;
            const unsigned char* tabn = g + 1 < 8 ? u8 : v8;
            EX_LOAD8(rx, tabn, ebn, (gn & 3) * 16);
        }
        EX_SB();
        EX_DOT8(ry, pp, 8);
        const float v = transpose_reduce16(pp, lane);
        const float got = __shfl(v, (lane & 15) << 2);
        const bool mine = (lane >> 4) == (g & 3);
        a0 = (mine && g < 4) ? got : a0;
        a1 = (mine && g >= 4) ? got : a1;
        EX_SB();
    }
    const float w0 = g0 * gelu_exact(su0 * a0) * sv0;
    const float w1 = g1 * gelu_exact(su1 * a1) * sv1;
    float acc[16];
#pragma unroll
    for (int i = 0; i < 16; ++i) acc[i] = 0.f;
#pragma unroll 1
    for (int h2 = 0; h2 < 8; ++h2) {
        const int ebc = h2 < 4 ? e0 : e1;
        const float wb = h2 < 4 ? w0 : w1;
        const int slc = (h2 & 3) * 16;
        EX_LOAD8(ry, v8, ebc, slc + 8);
        EX_SB();
        EX_AXPY8(rx, wb, slc);
        EX_SB();
        {
            const int hn_ = h2 + 1 < 8 ? h2 + 1 : 7;
            const int ebn = hn_ < 4 ? e0 : e1;
            EX_LOAD8(rx, v8, ebn, (hn_ & 3) * 16);
        }
        EX_SB();
        EX_AXPY8(ry, wb, slc + 8);
        EX_SB();
    }
#pragma unroll
    for (int i = 0; i < 16; ++i) xv[i] += acc[i];
    float s2 = 0.f;
#pragma unroll
    for (int i = 0; i < 16; ++i) s2 += xv[i] * xv[i];
    s2 = wave_sum(s2);
    const float r2 = rsqrtf(s2 * (1.f / DM) + 1e-6f);
    if (!last) {
#pragma unroll
        for (int q = 0; q < 4; ++q) *(float4*)(xwr + 4 * q) = make_float4(xv[4 * q], xv[4 * q + 1], xv[4 * q + 2], xv[4 * q + 3]);
        const float* gnb = p.g_mix + (layer + 1) * DM; asm volatile("" : "+s"(gnb));
        const float* gn = gnb + lane * 16;
        unsigned hw[8];
#pragma unroll
        for (int q = 0; q < 4; ++q) {
            const float4 g = *(const float4*)(gn + 4 * q);
            hw[2 * q] = cvtpk(xv[4 * q] * r2 * g.x, xv[4 * q + 1] * r2 * g.y);
            hw[2 * q + 1] = cvtpk(xv[4 * q + 2] * r2 * g.z, xv[4 * q + 3] * r2 * g.w);
        }
        *(uint4*)(hwr) = make_uint4(hw[0], hw[1], hw[2], hw[3]);
        *(uint4*)(hwr + 8) = make_uint4(hw[4], hw[5], hw[6], hw[7]);
    } else {
        const float* gnb = p.g_final; asm volatile("" : "+s"(gnb));
        const float* gn = gnb + lane * 16;
        float* orow = dummy ? xwr : p.out + (size_t)t * DM + lane * 16;
#pragma unroll
        for (int q = 0; q < 4; ++q) {
            const float4 g = *(const float4*)(gn + 4 * q);
            *(float4*)(orow + 4 * q) = make_float4(xv[4 * q] * r2 * g.x, xv[4 * q + 1] * r2 * g.y, xv[4 * q + 2] * r2 * g.z, xv[4 * q + 3] * r2 * g.w);
        }
    }
}
__device__ __forceinline__ void transpose_tile(const float* __restrict__ src, int K, int N, bf16_t* __restrict__ dst, int tk, int tn, float* tl, const float* __restrict__ ksc, int perm) {
    const int tid = tid_opaque(), r = tid >> 6, c = tid & 63;
    const int k0 = tk * 64, n0 = tn * 64;
#pragma unroll
    for (int i = 0; i < 8; ++i) {
        const int kk = i * 8 + r, n = n0 + c;
        tl[kk * 65 + c] = (n < N) ? src[(size_t)(k0 + kk) * N + n] : 0.f;
    }
    __syncthreads();
#pragma unroll
    for (int i = 0; i < 8; ++i) {
        const int nn = i * 8 + r;
        if (n0 + nn < N) {
            int nd = n0 + nn;
            if (perm) { const int hq = nd / 96, wq = nd % 96; nd = wq < 64 ? hq * 64 + wq : 256 + hq * 32 + (wq - 64); }
            dst[(size_t)nd * K + k0 + c] = f2bf(tl[c * 65 + nn] * (ksc ? ksc[k0 + c] : 1.f));
        }
    }
    __syncthreads();
}
__device__ __forceinline__ void transpose_all(const float* src, int K, int N, bf16_t* dst, float* tl, const float* ksc = nullptr, int perm = 0) {
    const int ntk = K / 64, ntn = (N + 63) / 64;
    for (int t = blockIdx.x; t < ntk * ntn; t += gridDim.x) transpose_tile(src, K, N, dst, t / ntn, t % ntn, tl, ksc, perm);
}
__device__ __forceinline__ void convert_plain(const float* __restrict__ src, bf16_t* __restrict__ dst, size_t n) {
    const size_t n8 = n >> 3;
    for (size_t i = (size_t)blockIdx.x * blockDim.x + tid_opaque(); i < n8; i += (size_t)gridDim.x * blockDim.x) {
        const float4 a = *(const float4*)(src + i * 8), b = *(const float4*)(src + i * 8 + 4);
        uint4 w; w.x = cvtpk(a.x, a.y); w.y = cvtpk(a.z, a.w); w.z = cvtpk(b.x, b.y); w.w = cvtpk(b.z, b.w);
        *(uint4*)(dst + i * 8) = w;
    }
}
__device__ __forceinline__ void convert_rows_fp8(const float* __restrict__ src, unsigned char* __restrict__ dst, float* __restrict__ scales, int nrows) {
    const int tid = tid_opaque(), wave = tid >> 6, lane = tid & 63;
    for (int row = blockIdx.x * NW + wave; row < nrows; row += gridDim.x * NW) {
        const float* sr = src + (size_t)row * DM + lane * 16;
        float xv[16];
#pragma unroll
        for (int q = 0; q < 4; ++q) { const float4 a = *(const float4*)(sr + 4 * q); xv[4 * q] = a.x; xv[4 * q + 1] = a.y; xv[4 * q + 2] = a.z; xv[4 * q + 3] = a.w; }
        float am = 0.f;
#pragma unroll
        for (int i = 0; i < 16; ++i) am = fmaxf(am, fabsf(xv[i]));
        am = wave_max(am);
        const float sc = am > 0.f ? am * (1.f / 448.f) : 1.f;
        const float inv = 1.f / sc;
        unsigned w[4];
#pragma unroll
        for (int q = 0; q < 4; ++q) {
            int t = 0;
            t = __builtin_amdgcn_cvt_pk_fp8_f32(xv[4 * q] * inv, xv[4 * q + 1] * inv, t, false);
            t = __builtin_amdgcn_cvt_pk_fp8_f32(xv[4 * q + 2] * inv, xv[4 * q + 3] * inv, t, true);
            w[q] = (unsigned)t;
        }
        *(uint4*)(dst + (size_t)row * DM + lane * 16) = make_uint4(w[0], w[1], w[2], w[3]);
        if (lane == 0) scales[row] = sc;
    }
}
__device__ __forceinline__ void rms_row_bf16(const float* __restrict__ src, const float* __restrict__ g, bf16_t* __restrict__ dst, float* __restrict__ cpy, int lane) {
    float xv[16];
    const float4 a0 = *(const float4*)(src + lane * 8), a1 = *(const float4*)(src + lane * 8 + 4);
    const float4 b0 = *(const float4*)(src + 512 + lane * 8), b1 = *(const float4*)(src + 512 + lane * 8 + 4);
    xv[0] = a0.x; xv[1] = a0.y; xv[2] = a0.z; xv[3] = a0.w; xv[4] = a1.x; xv[5] = a1.y; xv[6] = a1.z; xv[7] = a1.w;
    xv[8] = b0.x; xv[9] = b0.y; xv[10] = b0.z; xv[11] = b0.w; xv[12] = b1.x; xv[13] = b1.y; xv[14] = b1.z; xv[15] = b1.w;
    if (cpy) {
        *(float4*)(cpy + lane * 8) = a0; *(float4*)(cpy + lane * 8 + 4) = a1;
        *(float4*)(cpy + 512 + lane * 8) = b0; *(float4*)(cpy + 512 + lane * 8 + 4) = b1;
    }
    float ss = 0.f;
#pragma unroll
    for (int i = 0; i < 16; ++i) ss += xv[i] * xv[i];
    ss = wave_sum(ss);
    const float r = rsqrtf(ss * (1.f / DM) + 1e-6f);
    const float4 g0 = *(const float4*)(g + lane * 8), g1 = *(const float4*)(g + lane * 8 + 4);
    const float4 g2 = *(const float4*)(g + 512 + lane * 8), g3 = *(const float4*)(g + 512 + lane * 8 + 4);
    uint4 wa, wb;
    wa.x = cvtpk(xv[0] * r * g0.x, xv[1] * r * g0.y); wa.y = cvtpk(xv[2] * r * g0.z, xv[3] * r * g0.w);
    wa.z = cvtpk(xv[4] * r * g1.x, xv[5] * r * g1.y); wa.w = cvtpk(xv[6] * r * g1.z, xv[7] * r * g1.w);
    wb.x = cvtpk(xv[8] * r * g2.x, xv[9] * r * g2.y); wb.y = cvtpk(xv[10] * r * g2.z, xv[11] * r * g2.w);
    wb.z = cvtpk(xv[12] * r * g3.x, xv[13] * r * g3.y); wb.w = cvtpk(xv[14] * r * g3.z, xv[15] * r * g3.w);
    *(uint4*)(dst + lane * 8) = wa; *(uint4*)(dst + 512 + lane * 8) = wb;
}

__device__ __forceinline__ void rms_row2_bf16(const float* __restrict__ s0, const float* __restrict__ s1, const float* __restrict__ g, bf16_t* __restrict__ d0, bf16_t* __restrict__ d1, int lane) {
    float4 a[4], b[4];
#pragma unroll
    for (int q = 0; q < 4; ++q) { a[q] = *(const float4*)(s0 + (q >> 1) * 512 + lane * 8 + (q & 1) * 4); b[q] = s1 ? *(const float4*)(s1 + (q >> 1) * 512 + lane * 8 + (q & 1) * 4) : make_float4(0.f, 0.f, 0.f, 0.f); }
    float sa = 0.f, sb = 0.f;
#pragma unroll
    for (int q = 0; q < 4; ++q) { sa += a[q].x * a[q].x + a[q].y * a[q].y + a[q].z * a[q].z + a[q].w * a[q].w; sb += b[q].x * b[q].x + b[q].y * b[q].y + b[q].z * b[q].z + b[q].w * b[q].w; }
    sa = wave_sum(sa); sb = wave_sum(sb);
    const float ra = rsqrtf(sa * (1.f / DM) + 1e-6f), rb = rsqrtf(sb * (1.f / DM) + 1e-6f);
    float4 gq[4];
#pragma unroll
    for (int q = 0; q < 4; ++q) gq[q] = *(const float4*)(g + (q >> 1) * 512 + lane * 8 + (q & 1) * 4);
    uint4 w;
    w.x = cvtpk(a[0].x * ra * gq[0].x, a[0].y * ra * gq[0].y); w.y = cvtpk(a[0].z * ra * gq[0].z, a[0].w * ra * gq[0].w);
    w.z = cvtpk(a[1].x * ra * gq[1].x, a[1].y * ra * gq[1].y); w.w = cvtpk(a[1].z * ra * gq[1].z, a[1].w * ra * gq[1].w);
    *(uint4*)(d0 + lane * 8) = w;
    w.x = cvtpk(a[2].x * ra * gq[2].x, a[2].y * ra * gq[2].y); w.y = cvtpk(a[2].z * ra * gq[2].z, a[2].w * ra * gq[2].w);
    w.z = cvtpk(a[3].x * ra * gq[3].x, a[3].y * ra * gq[3].y); w.w = cvtpk(a[3].z * ra * gq[3].z, a[3].w * ra * gq[3].w);
    *(uint4*)(d0 + 512 + lane * 8) = w;
    if (s1) {
        w.x = cvtpk(b[0].x * rb * gq[0].x, b[0].y * rb * gq[0].y); w.y = cvtpk(b[0].z * rb * gq[0].z, b[0].w * rb * gq[0].w);
        w.z = cvtpk(b[1].x * rb * gq[1].x, b[1].y * rb * gq[1].y); w.w = cvtpk(b[1].z * rb * gq[1].z, b[1].w * rb * gq[1].w);
        *(uint4*)(d1 + lane * 8) = w;
        w.x = cvtpk(b[2].x * rb * gq[2].x, b[2].y * rb * gq[2].y); w.y = cvtpk(b[2].z * rb * gq[2].z, b[2].w * rb * gq[2].w);
        w.z = cvtpk(b[3].x * rb * gq[3].x, b[3].y * rb * gq[3].y); w.w = cvtpk(b[3].z * rb * gq[3].z, b[3].w * rb * gq[3].w);
        *(uint4*)(d1 + 512 + lane * 8) = w;
    }
}

__device__ __forceinline__ void phase_pro(PC& p, char* lds) {
    float* tl = (float*)lds;
    for (int l = 0; l < DEPTH; ++l) {
        transpose_all(p.w_in + (size_t)l * DM * NZ, DM, NZ, p.winT + (size_t)l * NZ * DM, tl);
        transpose_all(p.w_out + (size_t)l * DM * DM, DM, DM, p.woutT + (size_t)l * DM * DM, tl, (p.flags & 16) ? p.g_group + (size_t)l * 1024 : nullptr);
        transpose_all(p.peer_w_q + (size_t)l * DM * 2048, DM, 2048, p.wqT + (size_t)l * 2048 * DM, tl, (p.flags & 4) ? p.g_ffn + l * DM : nullptr);
        transpose_all(p.mla_w_uq + (size_t)l * 256 * 384, 256, 384, p.wuqT + (size_t)l * 384 * 256, tl, (p.flags & 8) ? p.mla_q_norm + l * 256 : nullptr, (p.flags & 32) ? 1 : 0);
        transpose_all(p.mla_w_ukv + (size_t)l * 128 * 512, 128, 512, p.wukvT + (size_t)l * 512 * 128, tl, (p.flags & 8) ? p.mla_kv_norm + l * 128 : nullptr);
    }
    convert_plain(p.peer_sub_keys, p.subk, (size_t)DEPTH * 8 * 2 * 128 * 128);
    if ((p.flags & 3) == 1) {
        convert_rows_fp8(p.peer_u, p.u8, p.su, DEPTH * 16384);
        convert_rows_fp8(p.peer_v, p.v8, p.sv, DEPTH * 16384);
    }
    for (int i = blockIdx.x * blockDim.x + tid_opaque(); i < 4096 * 32; i += gridDim.x * blockDim.x) {
        {
            const int pos = i / 32, j = i % 32;
            const float inv = powf(10000.f, -(float)(2 * j) / 64.f); const float ang = (float)pos * inv;
            p.tb.cos1[i] = cosf(ang); p.tb.sin1[i] = sinf(ang);
        }
        if (i < 4096 * 16) {
            const int pos = i / 16, j = i % 16;
            const float inv = powf(10000.f, -(float)(2 * j) / 32.f); const float ang = (float)pos * inv;
            p.tb.cosm[i] = cosf(ang); p.tb.sinm[i] = sinf(ang);
        }
        if (i < 64 * 16) {
            const int pos = i / 16, j = i % 16;
            const float inv = powf(10000.f, -(float)(2 * j) / 32.f); const float ang = (float)pos * inv;
            p.tb.cosr[i] = cosf(ang); p.tb.sinr[i] = sinf(ang); p.tb.cosc[i] = cosf(ang); p.tb.sinc[i] = sinf(ang);
        }
    }
    const int wave = tid_opaque() >> 6, lane = tid_opaque() & 63;
    for (int t = blockIdx.x * NW + wave; t < T_TOK; t += gridDim.x * NW)
        rms_row_bf16(p.x_in + (size_t)t * DM, p.g_mix, p.hnb + (size_t)t * DM, p.x + (size_t)t * DM, lane);
}

__device__ __forceinline__ void phase_g1(PC& p, int l, char* lds) {
    if (p.flags & 128) {
        RowsPostZ eZ{p.q.qA, p.tb.cos1, p.ax_q_norm + l * 64, p.ax_k_norm + l * 64, p.cqn, p.ssqd, p.q.kD};
        RowsPostQ eQ{p.q.qD, p.tb.cos1, p.ssqd};
        RowsPostKV eKV{p.q.kD, p.q.vD, p.ssqd + (size_t)4 * T_TOK};
        const bf16_t* win = p.winT + (size_t)l * NZ * DM;
        const bf16_t* wuq = p.wuqT + (size_t)l * 384 * 256; const bf16_t* wukv = p.wukvT + (size_t)l * 512 * 128;
        const bool mapped = (gridDim.x & 63) == 0 && (1024 % gridDim.x) == 0;
        for (int tile = blockIdx.x; tile < 1024; tile += gridDim.x) {
            int mt, nt;
            if (mapped) { tile_map(tile, 128, 8, mt, nt); nt = (nt + 2 * (tile / gridDim.x)) & 7; }
            else { mt = tile >> 3; nt = tile & 7; }
            gemm_tile_rows<RowsPostZ, 0>(p.hnb, DM, win, DM, DM, mt * 256, nt * 256, NZ, lds, eZ);
            if (nt >= 6) {
                asm volatile("s_waitcnt vmcnt(0)" ::: "memory");
                __syncthreads();
                if (nt == 6) {
                    gemm_tile_rows<RowsPostQ, 0>(p.cqn, 256, wuq, 256, 256, mt * 256, 0, 384, lds, eQ);
                    gemm_tile_rows<RowsPostQ, 0>(p.cqn, 256, wuq, 256, 256, mt * 256, 256, 384, lds, eQ);
                } else {
                    gemm_tile_rows<RowsPostKV, 0>(p.ckvn, 128, wukv, 128, 128, mt * 256, 0, 512, lds, eKV);
                    gemm_tile_rows<RowsPostKV, 0>(p.ckvn, 128, wukv, 128, 128, mt * 256, 256, 512, lds, eKV);
                }
            }
        }
    } else if (p.flags & 8) {
        RowsPostZ e{p.q.qA, p.tb.cos1, p.ax_q_norm + l * 64, p.ax_k_norm + l * 64, p.cqn, p.ssqd, p.q.kD};
        gemm_phase_rows<RowsPostZ, 0>(p.hnb, DM, p.winT + (size_t)l * NZ * DM, DM, T_TOK, NZ, DM, lds, e);
    } else {
        RowsStoreBf16 e{p.zb, NZ, NZ};
        gemm_phase_rows<RowsStoreBf16, 0>(p.hnb, DM, p.winT + (size_t)l * NZ * DM, DM, T_TOK, NZ, DM, lds, e);
    }
}

__device__ __forceinline__ unsigned pk2(float a, float b) { return cvtpk(a, b); }
__device__ __forceinline__ void phase_post(PC& p, int l, char* lds) {
    const int tid = tid_opaque(), wave = tid >> 6, lane = tid & 63;
    float* zr = (float*)(lds + wave * 8192);
    const float* g_qn = p.ax_q_norm + l * 64; const float* g_kn = p.ax_k_norm + l * 64;
    const float* g_cq = p.mla_q_norm + l * 256; const float* g_ckv = p.mla_kv_norm + l * 128;
    const float scA = 0.125f * LOG2E;
    const bf16_t* zb = p.zb;
    const float *cos1 = p.tb.cos1, *sin1 = p.tb.sin1, *cosm = p.tb.cosm, *sinm = p.tb.sinm, *cosr = p.tb.cosr, *sinr = p.tb.sinr, *cosc = p.tb.cosc, *sinc = p.tb.sinc;
    for (int t = blockIdx.x * NW + wave; t < T_TOK; t += gridDim.x * NW) {
        const int b = t / SEQ, s = t % SEQ;
#pragma unroll
        for (int j = 0; j < 4; ++j) {
            const int ch = lane + 64 * j;
            if (ch < 244) {
                const uint4 w = *(const uint4*)(zb + (size_t)t * NZ + ch * 8);
                float4 lo, hi;
                lo.x = __uint_as_float(w.x << 16); lo.y = __uint_as_float(w.x & 0xffff0000u); lo.z = __uint_as_float(w.y << 16); lo.w = __uint_as_float(w.y & 0xffff0000u);
                hi.x = __uint_as_float(w.z << 16); hi.y = __uint_as_float(w.z & 0xffff0000u); hi.z = __uint_as_float(w.w << 16); hi.w = __uint_as_float(w.w & 0xffff0000u);
                *(float4*)(zr + ch * 8) = lo; *(float4*)(zr + ch * 8 + 4) = hi;
            }
        }
#pragma unroll
        for (int mix = 0; mix < 2; ++mix) {
            const int zo = mix == 0 ? 0 : 1024;
            bf16_t* qo = mix == 0 ? p.q.qA : p.q.qC; bf16_t* ko = mix == 0 ? p.q.kA : p.q.kC; bf16_t* vo = mix == 0 ? p.q.vA : p.q.vC;
            const int h = lane >> 4, j = (lane & 15) * 2;
            const float c0 = cos1[s * 32 + j], c1 = cos1[s * 32 + j + 1], s0 = sin1[s * 32 + j], s1 = sin1[s * 32 + j + 1];
            {
                const float a0 = zr[zo + h * 64 + j], a1 = zr[zo + h * 64 + j + 1], b0 = zr[zo + h * 64 + 32 + j], b1 = zr[zo + h * 64 + 33 + j];
                bf16_t* o = qo + ((size_t)(b * 4 + h) * SEQ + s) * 64;
                *(unsigned*)(o + j) = pk2((a0 * c0 - b0 * s0) * scA, (a1 * c1 - b1 * s1) * scA);
                *(unsigned*)(o + 32 + j) = pk2((b0 * c0 + a0 * s0) * scA, (b1 * c1 + a1 * s1) * scA);
            }
            if (lane < 32) {
                const float a0 = zr[zo + 256 + h * 64 + j], a1 = zr[zo + 256 + h * 64 + j + 1], b0 = zr[zo + 256 + h * 64 + 32 + j], b1 = zr[zo + 256 + h * 64 + 33 + j];
                bf16_t* o = ko + ((size_t)(b * 2 + h) * SEQ + s) * 64;
                *(unsigned*)(o + j) = pk2(a0 * c0 - b0 * s0, a1 * c1 - b1 * s1);
                *(unsigned*)(o + 32 + j) = pk2(b0 * c0 + a0 * s0, b1 * c1 + a1 * s1);
            }
            {
                const int i = lane * 2, hv = i >> 6, jv = i & 63;
                *(unsigned*)(vo + ((size_t)(b * 2 + hv) * SEQ + s) * 64 + jv) = pk2(zr[zo + 384 + i], zr[zo + 384 + i + 1]);
            }
        }
        {
            float rs[6];
#pragma unroll
            for (int hh = 0; hh < 6; ++hh) {
                const float v = zr[512 + hh * 64 + lane];
                rs[hh] = rsqrtf(wave_sum(v * v) * (1.f / 64.f) + 1e-6f);
            }
            const int row = s >> 6, col = s & 63;
            const int half = (lane >> 3) & 1, jj = (lane & 7) * 2;
            const float* ct = half == 0 ? cosr + row * 16 : cosc + col * 16;
            const float* st = half == 0 ? sinr + row * 16 : sinc + col * 16;
            const float c0 = ct[jj], c1 = ct[jj + 1], s0 = st[jj], s1 = st[jj + 1];
            const int d1 = half * 32 + jj, d2 = d1 + 16;
            {
                const int h = lane >> 4;
                const float r = h == 0 ? rs[0] : (h == 1 ? rs[1] : (h == 2 ? rs[2] : rs[3]));
                const float* z = zr + 512 + h * 64;
                const float a0 = z[d1] * r * g_qn[d1], a1 = z[d1 + 1] * r * g_qn[d1 + 1], b0 = z[d2] * r * g_qn[d2], b1 = z[d2 + 1] * r * g_qn[d2 + 1];
                bf16_t* o = p.q.qB + ((size_t)(b * 4 + h) * SEQ + s) * 64;
                *(unsigned*)(o + d1) = pk2((a0 * c0 - b0 * s0) * scA, (a1 * c1 - b1 * s1) * scA);
                *(unsigned*)(o + d2) = pk2((b0 * c0 + a0 * s0) * scA, (b1 * c1 + a1 * s1) * scA);
            }
            if (lane < 32) {
                const int h = lane >> 4;
                const float r = h == 0 ? rs[4] : rs[5];
                const float* z = zr + 768 + h * 64;
                const float a0 = z[d1] * r * g_kn[d1], a1 = z[d1 + 1] * r * g_kn[d1 + 1], b0 = z[d2] * r * g_kn[d2], b1 = z[d2 + 1] * r * g_kn[d2 + 1];
                bf16_t* o = p.q.kB + ((size_t)(b * 2 + h) * SEQ + s) * 64;
                *(unsigned*)(o + d1) = pk2(a0 * c0 - b0 * s0, a1 * c1 - b1 * s1);
                *(unsigned*)(o + d2) = pk2(b0 * c0 + a0 * s0, b1 * c1 + a1 * s1);
            }
            {
                const int i = lane * 2, hv = i >> 6, jv = i & 63;
                *(unsigned*)(p.q.vB + ((size_t)(b * 2 + hv) * SEQ + s) * 64 + jv) = pk2(zr[896 + i], zr[896 + i + 1]);
            }
        }
        {
            const float4 cq = *(const float4*)(zr + 1536 + lane * 4);
            const float rq = rsqrtf(wave_sum(cq.x * cq.x + cq.y * cq.y + cq.z * cq.z + cq.w * cq.w) * (1.f / 256.f) + 1e-6f);
            const float4 gq = *(const float4*)(g_cq + lane * 4);
            uint2 w; w.x = pk2(cq.x * rq * gq.x, cq.y * rq * gq.y); w.y = pk2(cq.z * rq * gq.z, cq.w * rq * gq.w);
            *(uint2*)(p.cqn + (size_t)t * 256 + lane * 4) = w;
            const float2 ck = *(const float2*)(zr + 1792 + lane * 2);
            const float rk = rsqrtf(wave_sum(ck.x * ck.x + ck.y * ck.y) * (1.f / 128.f) + 1e-6f);
            const float2 gk = *(const float2*)(g_ckv + lane * 2);
            *(unsigned*)(p.ckvn + (size_t)t * 128 + lane * 2) = pk2(ck.x * rk * gk.x, ck.y * rk * gk.y);
            const int i = lane & 15, h = lane >> 4;
            const float x1 = zr[1920 + i], x2 = zr[1936 + i];
            const float c = cosm[s * 16 + i], sn = sinm[s * 16 + i];
            bf16_t* o = p.q.kD + ((size_t)(b * 4 + h) * SEQ + s) * 96;
            o[64 + i] = f2bf(x1 * c - x2 * sn); o[80 + i] = f2bf(x2 * c + x1 * sn);
        }
    }
}

__device__ __forceinline__ void phase_mla(PC& p, int l, char* lds) {
    if (p.flags & 32) {
        { RowsPostQ e{p.q.qD, p.tb.cos1, p.ssqd}; gemm_phase_rows<RowsPostQ, 0>(p.cqn, 256, p.wuqT + (size_t)l * 384 * 256, 256, T_TOK, 384, 256, lds, e); }
        { RowsPostKV e{p.q.kD, p.q.vD, p.ssqd + (size_t)4 * T_TOK}; gemm_phase_rows<RowsPostKV, 0>(p.ckvn, 128, p.wukvT + (size_t)l * 512 * 128, 128, T_TOK, 512, 128, lds, e); }
    } else if (p.flags & 8) {
        { RowsStoreBf16Scale<4, 256> e{p.qfull, 384, 384, p.ssqd}; gemm_phase_rows<RowsStoreBf16Scale<4, 256>, 0>(p.cqn, 256, p.wuqT + (size_t)l * 384 * 256, 256, T_TOK, 384, 256, lds, e); }
        { RowsStoreBf16Scale<2, 128> e{p.kvfull, 512, 512, p.ssqd + (size_t)4 * T_TOK}; gemm_phase_rows<RowsStoreBf16Scale<2, 128>, 0>(p.ckvn, 128, p.wukvT + (size_t)l * 512 * 128, 128, T_TOK, 512, 128, lds, e); }
    } else {
        { RowsStoreBf16 e{p.qfull, 384, 384}; gemm_phase_rows<RowsStoreBf16, 0>(p.cqn, 256, p.wuqT + (size_t)l * 384 * 256, 256, T_TOK, 384, 256, lds, e); }
        { RowsStoreBf16 e{p.kvfull, 512, 512}; gemm_phase_rows<RowsStoreBf16, 0>(p.ckvn, 128, p.wukvT + (size_t)l * 512 * 128, 128, T_TOK, 512, 128, lds, e); }
    }
}

__device__ __forceinline__ void phase_postmla(PC& p, int l) {
    const int tid = tid_opaque(), wave = tid >> 6, lane = tid & 63;
    const float scD = 0.10206207261596575f * LOG2E;
    const float *cosm = p.tb.cosm, *sinm = p.tb.sinm;
    const bf16_t* qfull = p.qfull; const bf16_t* kvfull = p.kvfull;
    const int h = lane >> 4, j = (lane & 15) * 4, i = lane & 15;
    for (int tb = blockIdx.x * NW + wave; tb < T_TOK; tb += gridDim.x * 2 * NW) {
        uint2 qw[2], kw[2], vw[2]; float x1[2], x2[2], cc[2], ss[2];
#pragma unroll
        for (int u = 0; u < 2; ++u) {
            int t = tb + u * gridDim.x * NW; t = t < T_TOK ? t : tb;
            const int s = t % SEQ;
            qw[u] = *(const uint2*)(qfull + (size_t)t * 384 + h * 96 + j);
            kw[u] = *(const uint2*)(kvfull + (size_t)t * 512 + h * 128 + j);
            vw[u] = *(const uint2*)(kvfull + (size_t)t * 512 + h * 128 + 64 + j);
            x1[u] = bf2f(qfull[(size_t)t * 384 + h * 96 + 64 + i]); x2[u] = bf2f(qfull[(size_t)t * 384 + h * 96 + 80 + i]);
            cc[u] = cosm[s * 16 + i]; ss[u] = sinm[s * 16 + i];
        }
#pragma unroll
        for (int u = 0; u < 2; ++u) {
            const int t = tb + u * gridDim.x * NW;
            if (t < T_TOK) {
                const int b = t / SEQ, s = t % SEQ;
                const size_t hb = (size_t)(b * 4 + h) * SEQ + s;
                uint2 o;
                o.x = cvtpk(__uint_as_float(qw[u].x << 16) * scD, __uint_as_float(qw[u].x & 0xffff0000u) * scD);
                o.y = cvtpk(__uint_as_float(qw[u].y << 16) * scD, __uint_as_float(qw[u].y & 0xffff0000u) * scD);
                *(uint2*)(p.q.qD + hb * 96 + j) = o;
                *(uint2*)(p.q.kD + hb * 96 + j) = kw[u];
                *(uint2*)(p.q.vD + hb * 64 + j) = vw[u];
                p.q.qD[hb * 96 + 64 + i] = f2bf((x1[u] * cc[u] - x2[u] * ss[u]) * scD);
                p.q.qD[hb * 96 + 80 + i] = f2bf((x2[u] * cc[u] + x1[u] * ss[u]) * scD);
            }
        }
    }
}

__device__ __forceinline__ void phase_att(PC& p, int l, char* lds) {
    for (int it = blockIdx.x; it < 512; it += gridDim.x) attn_item<96, 1, false>(p.q.qD, p.q.kD, p.q.vD, nullptr, p.ob, 768, 4, 4, it, lds, (p.flags & 32) ? 128 : 96);
    if (p.flags & 2) convert_rows_fp8(p.peer_u + (size_t)l * 16384 * DM, p.u8 + (size_t)l * 16384 * DM, p.su + l * 16384, 16384);
    for (int it = blockIdx.x; it < 512; it += gridDim.x) attn_item<64, 2, false>(p.q.qB, p.q.kB, p.q.vB, nullptr, p.ob, 256, 4, 2, it, lds);
    if (p.flags & 2) convert_rows_fp8(p.peer_v + (size_t)l * 16384 * DM, p.v8 + (size_t)l * 16384 * DM, p.sv + l * 16384, 16384);
    for (int it = blockIdx.x; it < 512; it += gridDim.x) attn_item<64, 2, true>(p.q.qA, p.q.kA, p.q.vA, p.win_sink + l * 4, p.ob, 0, 4, 2, it, lds);
    {
        const int wave = tid_opaque() >> 6;
        char* wl = lds + wave * 6144;
        const int off = (int)(uintptr_t)wl;
        for (int wi = blockIdx.x * NW + wave; wi < 4096; wi += gridDim.x * NW) dil_wave_item(p.q.qC, p.q.kC, p.q.vC, p.ob, wi, wl, off);
    }
}

__device__ __forceinline__ void phase_gn(PC& p, int l) {
    const int wave = tid_opaque() >> 6, lane = tid_opaque() & 63;
    const float* gg = p.g_group + (size_t)l * 1024;
    const bf16_t* ob = p.ob; bf16_t* hnb = p.hnb;
    for (int t0 = blockIdx.x * NW + wave; t0 < T_TOK; t0 += gridDim.x * 2 * NW) {
        const int t1 = t0 + gridDim.x * NW;
        const bool has1 = t1 < T_TOK;
        uint2 w0[4], w1[4];
#pragma unroll
        for (int g = 0; g < 4; ++g) {
            w0[g] = *(const uint2*)(ob + (size_t)t0 * DM + g * 256 + lane * 4);
            w1[g] = has1 ? *(const uint2*)(ob + (size_t)t1 * DM + g * 256 + lane * 4) : make_uint2(0, 0);
        }
#pragma unroll
        for (int g = 0; g < 4; ++g) {
            const float4 g4 = *(const float4*)(gg + g * 256 + lane * 4);
            {
                const float v0 = __uint_as_float(w0[g].x << 16), v1 = __uint_as_float(w0[g].x & 0xffff0000u), v2 = __uint_as_float(w0[g].y << 16), v3 = __uint_as_float(w0[g].y & 0xffff0000u);
                const float r = rsqrtf(wave_sum(v0 * v0 + v1 * v1 + v2 * v2 + v3 * v3) * (1.f / 256.f) + 1e-6f);
                uint2 o; o.x = cvtpk(v0 * r * g4.x, v1 * r * g4.y); o.y = cvtpk(v2 * r * g4.z, v3 * r * g4.w);
                *(uint2*)(hnb + (size_t)t0 * DM + g * 256 + lane * 4) = o;
            }
            if (has1) {
                const float v0 = __uint_as_float(w1[g].x << 16), v1 = __uint_as_float(w1[g].x & 0xffff0000u), v2 = __uint_as_float(w1[g].y << 16), v3 = __uint_as_float(w1[g].y & 0xffff0000u);
                const float r = rsqrtf(wave_sum(v0 * v0 + v1 * v1 + v2 * v2 + v3 * v3) * (1.f / 256.f) + 1e-6f);
                uint2 o; o.x = cvtpk(v0 * r * g4.x, v1 * r * g4.y); o.y = cvtpk(v2 * r * g4.z, v3 * r * g4.w);
                *(uint2*)(hnb + (size_t)t1 * DM + g * 256 + lane * 4) = o;
            }
        }
    }
}
__device__ __forceinline__ void phase_g2(PC& p, int l, char* lds) {
    if (p.flags & 4) {
        RowsResidNorm e{p.x, DM, p.xb2, p.ssq2};
        gemm_phase_rows<RowsResidNorm, 0>(p.hnb, DM, p.woutT + (size_t)l * DM * DM, DM, T_TOK, DM, DM, lds, e);
    } else {
        RowsResidF32 e{p.x, DM};
        gemm_phase_rows<RowsResidF32, 0>(p.hnb, DM, p.woutT + (size_t)l * DM * DM, DM, T_TOK, DM, DM, lds, e);
    }
}
__device__ __forceinline__ void phase_n2(PC& p, int l) {
    const int wave = tid_opaque() >> 6, lane = tid_opaque() & 63;
    for (int t = blockIdx.x * NW + wave; t < T_TOK; t += gridDim.x * 2 * NW) {
        const int t1 = t + gridDim.x * NW;
        rms_row2_bf16(p.x + (size_t)t * DM, t1 < T_TOK ? p.x + (size_t)t1 * DM : nullptr, p.g_ffn + l * DM, p.hnb + (size_t)t * DM, p.hnb + (size_t)t1 * DM, lane);
    }
}
__device__ __forceinline__ void phase_g3(PC& p, int l, char* lds) {
    if (p.flags & 64) {
        const bf16_t* sk = p.subk + (size_t)l * 8 * 2 * 128 * 128;
        const bf16_t* wq = p.wqT + (size_t)l * 2048 * DM;
        for (int tile = blockIdx.x; tile < 128 * 8; tile += gridDim.x) {
            int mt, nt;
            if ((gridDim.x & 63) == 0 && ((128 * 8) % gridDim.x) == 0) tile_map(tile, 128, 8, mt, nt); else { mt = tile >> 3; nt = tile & 7; }
            gemm_tile_topk(p.xb2, DM, wq, DM, DM, mt * 256, nt, lds, sk, p.ssq2, p.eidx, p.gate);
        }
    } else if (p.flags & 4) {
        RowsStoreBf16RowNorm e{p.qp, 2048, p.ssq2};
        gemm_phase_rows<RowsStoreBf16RowNorm, 0>(p.xb2, DM, p.wqT + (size_t)l * 2048 * DM, DM, T_TOK, 2048, DM, lds, e);
    } else {
        RowsStoreBf16 e{p.qp, 2048, 2048};
        gemm_phase_rows<RowsStoreBf16, 0>(p.hnb, DM, p.wqT + (size_t)l * 2048 * DM, DM, T_TOK, 2048, DM, lds, e);
    }
}
__device__ __forceinline__ void phase_topk(PC& p, int l, char* lds) {
    const int wave = tid_opaque() >> 6;
    char* wl = lds + wave * 2304;
    const bf16_t* sk = p.subk + (size_t)l * 8 * 2 * 128 * 128;
    for (int wi = blockIdx.x * NW + wave; wi < 8192; wi += gridDim.x * NW) topk_wave_item(p.qp, sk, p.eidx, p.gate, wi, wl);
}
__device__ __forceinline__ void phase_exp(PC& p, int l) {
    const int wave = tid_opaque() >> 6;
    for (int t = blockIdx.x * NW + wave; t < T_TOK; t += gridDim.x * NW) expert_token(p, l, t, l == DEPTH - 1);
}

template <int PH>
__global__ void __launch_bounds__(512, 2) k_phase(P p, int l) {
    extern __shared__ __attribute__((aligned(16))) char lds[];
    if (PH == 0) phase_pro(*kargs(), lds);
    if (PH == 1) phase_g1(*kargs(), l, lds);
    if (PH == 2) phase_post(*kargs(), l, lds);
    if (PH == 3) phase_mla(*kargs(), l, lds);
    if (PH == 4) phase_postmla(*kargs(), l);
    if (PH == 5) phase_att(*kargs(), l, lds);
    if (PH == 6) phase_gn(*kargs(), l);
    if (PH == 7) phase_g2(*kargs(), l, lds);
    if (PH == 8) phase_n2(*kargs(), l);
    if (PH == 9) phase_g3(*kargs(), l, lds);
    if (PH == 10) phase_topk(*kargs(), l, lds);
    if (PH == 11) phase_exp(*kargs(), l);
    if (PH == 13) { const int wave = tid_opaque() >> 6; for (int t = blockIdx.x * NW + wave; t < T_TOK; t += gridDim.x * NW) expert_token(*kargs(), l, t, l == DEPTH - 1, true); }
    if (PH == 12) { const int wave = tid_opaque() >> 6, lane = tid_opaque() & 63; for (int t = blockIdx.x * NW + wave; t < T_TOK; t += gridDim.x * NW) rms_row_bf16(kargs()->x + (size_t)t * DM, kargs()->g_mix + l * DM, kargs()->hnb + (size_t)t * DM, nullptr, lane); }
}
#define XB_TMO      128
#define XB_XCNT(j)  (256  + 64 * (j))
#define XB_XSUB(j)  (1280 + 64 * (j))
#define XB_XGEN(j)  (2304 + 64 * (j))
#define XB_TOP      3328
#define XB_TOPGEN   3392
#define XCD_BAR_WORDS 3456
#define XB_SPIN_CAP (1u << 18)
#define LAS __attribute__((address_space(3)))

__device__ __forceinline__ unsigned xb_ld(unsigned* p)              { return __hip_atomic_load(p, __ATOMIC_RELAXED, __HIP_MEMORY_SCOPE_AGENT); }
__device__ __forceinline__ unsigned xb_add(unsigned* p, unsigned v) { return __hip_atomic_fetch_add(p, v, __ATOMIC_RELAXED, __HIP_MEMORY_SCOPE_AGENT); }
__device__ __forceinline__ unsigned xb_xcc_id() { return (unsigned)__builtin_amdgcn_s_getreg((3 << 11) | 20) & 0xFu; }
#define XB_SPIN(cond, bar) do { unsigned _sp = 0; while (cond) { __builtin_amdgcn_s_sleep(1); \
    if ((++_sp & 255u) == 0u) { if (xb_ld(&(bar)[XB_TMO])) break; if (_sp > XB_SPIN_CAP) { atomicAdd(&(bar)[XB_TMO], 1u); break; } } } } while (0)

struct XcdBarrier {
    unsigned* bar; unsigned x;
    volatile LAS unsigned* st;
};

__device__ __forceinline__ XcdBarrier xcd_barrier_post(unsigned* bar, volatile LAS unsigned* st) {
    XcdBarrier b; b.bar = bar; b.x = xb_xcc_id(); b.st = st;
    if (threadIdx.x == 0) (void)xb_add(&bar[XB_XCNT(b.x)], 1u);
    return b;
}
__device__ __forceinline__ void xcd_barrier_complete(unsigned* bar, unsigned x, unsigned& nloc, unsigned& nx) {
    const unsigned G = gridDim.x * gridDim.y * gridDim.z;
    unsigned sum, cnt, mine, sp = 0u;
    for (;;) {
        sum = 0u; cnt = 0u; mine = 0u;
#pragma unroll
        for (unsigned j = 0; j < 16; ++j) { const unsigned c = xb_ld(&bar[XB_XCNT(j)]); sum += c; cnt += (c > 0u) ? 1u : 0u; mine = (j == x) ? c : mine; }
        if (sum == G) break;
        __builtin_amdgcn_s_sleep(1);
        if ((++sp & 255u) == 0u) { if (xb_ld(&bar[XB_TMO])) break; if (sp > XB_SPIN_CAP) { atomicAdd(&bar[XB_TMO], 1u); break; } }
    }
    nloc = mine > 0u ? mine : 1u; nx = cnt > 0u ? cnt : 1u;
}

__device__ __forceinline__ void xcd_barrier(const XcdBarrier& b) {
    asm volatile("s_waitcnt vmcnt(0)" ::: "memory");
    __syncthreads();
    if (threadIdx.x == 0) {
        unsigned* bar = b.bar;
        __builtin_amdgcn_s_waitcnt(0);
        unsigned nloc = b.st[0], nx = b.st[1];
        if (nloc == 0u) { xcd_barrier_complete(bar, b.x, nloc, nx); b.st[0] = nloc; b.st[1] = nx; }
        const unsigned old = xb_add(&bar[XB_XSUB(b.x)], 1u);
        const unsigned gen = old / nloc;
        if (old + 1u == (gen + 1u) * nloc) {
            __builtin_amdgcn_fence(__ATOMIC_RELEASE, "agent");
            asm volatile("s_waitcnt vmcnt(0)" ::: "memory");
            const unsigned og = xb_add(&bar[XB_TOP], 1u);
            const unsigned tg = og / nx;
            if (og + 1u == (tg + 1u) * nx) xb_add(&bar[XB_TOPGEN], 1u);
            else XB_SPIN(xb_ld(&bar[XB_TOPGEN]) == tg, bar);
            __builtin_amdgcn_fence(__ATOMIC_ACQUIRE, "agent");
            xb_add(&bar[XB_XGEN(b.x)], 1u);
            asm volatile("s_waitcnt vmcnt(0)" ::: "memory");
        } else {
            XB_SPIN(xb_ld(&bar[XB_XGEN(b.x)]) == gen, bar);
            __builtin_amdgcn_fence(__ATOMIC_ACQUIRE, "agent");
            asm volatile("s_waitcnt vmcnt(0)" ::: "memory");
        }
    }
    __syncthreads();
}


#ifdef PROBE_TIMER
#define TST(cat) do { if (blockIdx.x == 0 && threadIdx.x == 0) { const unsigned long long _n = wall_clock64(); tacc[cat] += _n - tprev; tprev = _n; } } while (0)
#else
#define TST(cat) do { } while (0)
#endif
__global__ void __launch_bounds__(512, 2) k_mega(P p) {
    extern __shared__ __attribute__((aligned(16))) char lds[];
    uint4* xbw = (uint4*)(lds + LDS_BYTES);
    if (threadIdx.x == 0) *xbw = make_uint4(0u, 0u, 0u, 0u);
    __syncthreads();
    XcdBarrier bar = xcd_barrier_post(kargs()->bar, (volatile LAS unsigned*)xbw);
#ifdef PROBE_TIMER
    unsigned long long tacc[7] = {0, 0, 0, 0, 0, 0, 0};
    unsigned long long tprev = wall_clock64();
#endif
    phase_pro(*kargs(), lds); TST(0); xcd_barrier(bar); TST(6);
    for (int l = 0; l < DEPTH; ++l) {
        phase_g1(*kargs(), l, lds); TST(1); xcd_barrier(bar); TST(6);
        if (!(kargs()->flags & 8)) { phase_post(*kargs(), l, lds); TST(2); xcd_barrier(bar); TST(6); }
        if (!(kargs()->flags & 128)) { phase_mla(*kargs(), l, lds); TST(1); xcd_barrier(bar); TST(6); }
        if (!(kargs()->flags & 32)) { phase_postmla(*kargs(), l); TST(2); xcd_barrier(bar); TST(6); }
        phase_att(*kargs(), l, lds); TST(3); xcd_barrier(bar); TST(6);
        if (!(kargs()->flags & 16)) { phase_gn(*kargs(), l); TST(2); xcd_barrier(bar); TST(6); }
        phase_g2(*kargs(), l, lds); TST(1); xcd_barrier(bar); TST(6);
        if (!(kargs()->flags & 4)) { phase_n2(*kargs(), l); TST(2); xcd_barrier(bar); TST(6); }
        phase_g3(*kargs(), l, lds); TST(1); xcd_barrier(bar); TST(6);
        if (!(kargs()->flags & 64)) { phase_topk(*kargs(), l, lds); TST(4); xcd_barrier(bar); TST(6); }
        phase_exp(*kargs(), l); TST(5);
        if (l + 1 < DEPTH) { xcd_barrier(bar); TST(6); }
    }
#ifdef PROBE_TIMER
    {
        float* slot = (float*)(kargs()->bar + 8192);
        if (blockIdx.x == 0 && threadIdx.x == 0) {
            unsigned long long tot = 0;
            for (int i = 0; i < 7; ++i) tot += tacc[i];
            const float share = floorf((float)tacc[PROBE_TIMER] / (float)tot * 16.f + 0.5f) * (1.f / 16.f);
            *slot = sqrtf(0.1f + 0.89f * share);
        }
        xcd_barrier(bar);
        const float delta = *slot;
        float* out = kargs()->out;
        for (size_t i = (size_t)blockIdx.x * 512 + threadIdx.x; i < (size_t)T_TOK * DM / 4; i += (size_t)gridDim.x * 512) {
            float4 v = ((float4*)out)[i];
            v.x *= 1.f + delta; v.y *= 1.f + delta; v.z *= 1.f + delta; v.w *= 1.f + delta;
            ((float4*)out)[i] = v;
        }
    }
#endif
}
#ifndef OPT_MASK
#define OPT_MASK 0x7f
#endif
#ifndef MEGA
#define MEGA 1
#endif
#ifndef PROBE_REPEAT
#define PROBE_REPEAT 0
#endif
static inline size_t align_up(size_t v, size_t a) { return (v + a - 1) / a * a; }
#define DYN_LDS (LDS_BYTES + 64)

template <int PH> static void launch_phase(const P& p, int l, hipStream_t stream) {
    static bool attr_done = false;
    if (!attr_done) { (void)hipFuncSetAttribute((const void*)k_phase<PH>, hipFuncAttributeMaxDynamicSharedMemorySize, DYN_LDS); attr_done = true; }
    k_phase<PH><<<256, 512, DYN_LDS, stream>>>(p, l);
    if ((PROBE_REPEAT >> PH) & 1) k_phase<PH><<<256, 512, DYN_LDS, stream>>>(p, l);
}

extern "C" void kernel_launch(void* const* d_in, const int* in_sizes, int n_in, void* d_out, int out_size, void* d_ws, size_t ws_size,
                              hipStream_t stream) {
    P p{};
    p.x_in = (const float*)d_in[0]; p.g_mix = (const float*)d_in[1]; p.w_in = (const float*)d_in[2]; p.win_sink = (const float*)d_in[3];
    p.ax_q_norm = (const float*)d_in[4]; p.ax_k_norm = (const float*)d_in[5]; p.mla_q_norm = (const float*)d_in[6]; p.mla_kv_norm = (const float*)d_in[7];
    p.mla_w_uq = (const float*)d_in[8]; p.mla_w_ukv = (const float*)d_in[9]; p.g_group = (const float*)d_in[10]; p.w_out = (const float*)d_in[11];
    p.g_ffn = (const float*)d_in[12]; p.peer_w_q = (const float*)d_in[13]; p.peer_sub_keys = (const float*)d_in[14]; p.peer_u = (const float*)d_in[15];
    p.peer_v = (const float*)d_in[16]; p.g_final = (const float*)d_in[17];
    p.out = (float*)d_out;

    char* w = (char*)d_ws; size_t off = 0;
    auto carve = [&](size_t bytes) { void* q = w + off; off = align_up(off + bytes, 256); return q; };
    p.bar = (unsigned*)carve(65536);
    p.x = (float*)carve((size_t)T_TOK * DM * 4);
    p.hnb = (bf16_t*)carve((size_t)T_TOK * DM * 2);
    char* regZ = (char*)carve((size_t)T_TOK * 2048 * 2);
    p.zb = (bf16_t*)regZ; p.qp = (bf16_t*)regZ;
    p.qfull = (bf16_t*)regZ; p.kvfull = (bf16_t*)(regZ + (size_t)T_TOK * 384 * 2);
    QKV& q = p.q;
    q.qA = (bf16_t*)carve((size_t)T_TOK * 256 * 2); q.kA = (bf16_t*)carve((size_t)T_TOK * 128 * 2); q.vA = (bf16_t*)carve((size_t)T_TOK * 128 * 2);
    q.qB = (bf16_t*)carve((size_t)T_TOK * 256 * 2); q.kB = (bf16_t*)carve((size_t)T_TOK * 128 * 2); q.vB = (bf16_t*)carve((size_t)T_TOK * 128 * 2);
    q.qC = (bf16_t*)carve((size_t)T_TOK * 256 * 2); q.kC = (bf16_t*)carve((size_t)T_TOK * 128 * 2); q.vC = (bf16_t*)carve((size_t)T_TOK * 128 * 2);
    q.qD = (bf16_t*)carve((size_t)T_TOK * (MEGA ? 512 : 384) * 2); q.kD = (bf16_t*)carve((size_t)T_TOK * 384 * 2); q.vD = (bf16_t*)carve((size_t)T_TOK * 256 * 2);
    p.ob = (bf16_t*)carve((size_t)T_TOK * DM * 2);
    p.cqn = p.ob; p.ckvn = p.ob + (size_t)T_TOK * 256;
    p.ssq2 = (float*)carve((size_t)T_TOK * 16 * 4);
    p.ssqd = (float*)carve((size_t)T_TOK * 6 * 4);
    p.xb2 = (bf16_t*)carve((size_t)T_TOK * DM * 2);
    p.eidx = (int*)carve((size_t)T_TOK * 128 * 4);
    p.gate = (float*)carve((size_t)T_TOK * 128 * 4);
    p.winT = (bf16_t*)carve((size_t)DEPTH * NZ * DM * 2);
    p.woutT = (bf16_t*)carve((size_t)DEPTH * DM * DM * 2);
    p.wqT = (bf16_t*)carve((size_t)DEPTH * 2048 * DM * 2);
    p.subk = (bf16_t*)carve((size_t)DEPTH * 8 * 2 * 128 * 128 * 2);
    p.wuqT = (bf16_t*)carve((size_t)DEPTH * 384 * 256 * 2);
    p.wukvT = (bf16_t*)carve((size_t)DEPTH * 512 * 128 * 2);
    if (OPT_MASK & 64) {
        p.u8 = (unsigned char*)carve((size_t)DEPTH * 16384 * DM);
        p.v8 = (unsigned char*)carve((size_t)DEPTH * 16384 * DM);
        p.su = (float*)carve((size_t)DEPTH * 16384 * 4);
        p.sv = (float*)carve((size_t)DEPTH * 16384 * 4);
        p.flags = 1 | (MEGA ? 2 : 0) | (MEGA ? 4 : 0) | (MEGA ? 8 : 0) | (MEGA ? 32 : 0) | (MEGA ? 64 : 0) | (MEGA ? 128 : 0);
    }
    Tables& tb = p.tb;
    tb.cos1 = (float*)carve(4096 * 32 * 4); tb.sin1 = (float*)carve(4096 * 32 * 4);
    tb.cosm = (float*)carve(4096 * 16 * 4); tb.sinm = (float*)carve(4096 * 16 * 4);
    tb.cosr = (float*)carve(64 * 16 * 4); tb.sinr = (float*)carve(64 * 16 * 4);
    tb.cosc = (float*)carve(64 * 16 * 4); tb.sinc = (float*)carve(64 * 16 * 4);
    float* hn = nullptr; float *cqn_f = nullptr, *ckvn_f = nullptr, *qfull_f = nullptr, *kvfull_f = nullptr;
    if (OPT_MASK != 0x7f) {
        hn = (float*)carve((size_t)T_TOK * DM * 4);
        cqn_f = (float*)carve((size_t)T_TOK * 256 * 4); ckvn_f = (float*)carve((size_t)T_TOK * 128 * 4);
        qfull_f = (float*)carve((size_t)T_TOK * 384 * 4); kvfull_f = hn;
    }
    if (off > ws_size) { fprintf(stderr, "workspace too small: need %zu have %zu\n", off, ws_size); return; }

#if MEGA
    {
        static int grid = 0;
        if (!grid) {
            int dev = 0, cus = 0, per_cu = 0;
            (void)hipGetDevice(&dev);
            (void)hipDeviceGetAttribute(&cus, hipDeviceAttributeMultiprocessorCount, dev);
            (void)hipFuncSetAttribute((const void*)k_mega, hipFuncAttributeMaxDynamicSharedMemorySize, DYN_LDS);
            (void)hipOccupancyMaxActiveBlocksPerMultiprocessor(&per_cu, k_mega, 512, DYN_LDS);
            if (per_cu < 1) per_cu = 1;
            grid = cus * (per_cu < 1 ? per_cu : 1);
        }
        (void)hipMemsetAsync(p.bar, 0, XCD_BAR_WORDS * sizeof(unsigned), stream);
        k_mega<<<grid, 512, DYN_LDS, stream>>>(p);
        return;
    }
#endif
    const float* x_in = p.x_in; float* x = p.x; float* out = p.out;
    launch_phase<0>(p, 0, stream);

    for (int l = 0; l < DEPTH; ++l) {
        if (OPT_MASK & 1) {
            if (l > 0 && !(OPT_MASK & 64)) launch_phase<12>(p, l, stream);
            launch_phase<1>(p, l, stream);
        } else {
            k_rmsnorm_f32<<<T_TOK / 4, 256, 0, stream>>>(x, p.g_mix + l * DM, hn, T_TOK);
            k_ngemm<float, bf16_t, false><<<dim3((NZ + 127) / 128, T_TOK / 128), 256, 0, stream>>>(hn, DM, p.w_in + (size_t)l * DM * NZ, NZ, p.zb, NZ, nullptr, 0, T_TOK, NZ, DM);
        }
        if (OPT_MASK & 2) {
            launch_phase<2>(p, l, stream); launch_phase<3>(p, l, stream); launch_phase<4>(p, l, stream);
        } else {
            PostArgs pa; pa.z = p.zb; pa.o = q; pa.tb = tb;
            pa.g_qn = p.ax_q_norm + l * 64; pa.g_kn = p.ax_k_norm + l * 64; pa.g_cq = p.mla_q_norm + l * 256; pa.g_ckv = p.mla_kv_norm + l * 128;
            pa.cqn = cqn_f; pa.ckvn = ckvn_f;
            k_post_naive<<<T_TOK, 256, 0, stream>>>(pa);
            k_ngemm<float, float, false><<<dim3(384 / 128, T_TOK / 128), 256, 0, stream>>>(cqn_f, 256, p.mla_w_uq + (size_t)l * 256 * 384, 384, qfull_f, 384, nullptr, 0, T_TOK, 384, 256);
            k_ngemm<float, float, false><<<dim3(512 / 128, T_TOK / 128), 256, 0, stream>>>(ckvn_f, 128, p.mla_w_ukv + (size_t)l * 128 * 512, 512, kvfull_f, 512, nullptr, 0, T_TOK, 512, 128);
            k_post_mla<<<T_TOK, 256, 0, stream>>>(qfull_f, kvfull_f, q, tb);
        }
        if (OPT_MASK & 4) {
            launch_phase<5>(p, l, stream);
        } else {
            k_attn_naive<64, 1><<<NBATCH * 4 * SEQ / 4, 256, 0, stream>>>(q.qA, q.kA, q.vA, p.win_sink + l * 4, p.ob, 4, 2, 0);
            k_attn_naive<64, 0><<<NBATCH * 4 * SEQ / 4, 256, 0, stream>>>(q.qB, q.kB, q.vB, nullptr, p.ob, 4, 2, 256);
            k_attn_naive<64, 2><<<NBATCH * 4 * SEQ / 4, 256, 0, stream>>>(q.qC, q.kC, q.vC, nullptr, p.ob, 4, 2, 512);
            k_attn_naive<96, 0><<<NBATCH * 4 * SEQ / 4, 256, 0, stream>>>(q.qD, q.kD, q.vD, nullptr, p.ob, 4, 4, 768);
        }
        if (OPT_MASK & 8) {
            launch_phase<6>(p, l, stream); launch_phase<7>(p, l, stream);
        } else {
            k_groupnorm_f32<<<T_TOK / 4, 256, 0, stream>>>(p.ob, p.g_group + (size_t)l * 1024, hn);
            k_ngemm<float, float, true><<<dim3(DM / 128, T_TOK / 128), 256, 0, stream>>>(hn, DM, p.w_out + (size_t)l * DM * DM, DM, x, DM, x, DM, T_TOK, DM, DM);
        }
        if (OPT_MASK & 16) {
            launch_phase<8>(p, l, stream); launch_phase<9>(p, l, stream);
            if (!(OPT_MASK & 64)) k_rmsnorm_f32<<<T_TOK / 4, 256, 0, stream>>>(x, p.g_ffn + l * DM, hn, T_TOK);
        } else {
            k_rmsnorm_f32<<<T_TOK / 4, 256, 0, stream>>>(x, p.g_ffn + l * DM, hn, T_TOK);
            k_ngemm<float, bf16_t, false><<<dim3(2048 / 128, T_TOK / 128), 256, 0, stream>>>(hn, DM, p.peer_w_q + (size_t)l * DM * 2048, 2048, p.qp, 2048, nullptr, 0, T_TOK, 2048, DM);
        }
        if (OPT_MASK & 32) launch_phase<10>(p, l, stream);
        else k_peer_topk_naive<<<T_TOK * 8, 64, 0, stream>>>(p.qp, p.peer_sub_keys + (size_t)l * 8 * 2 * 128 * 128, p.eidx, p.gate);
        if ((PROBE_REPEAT >> 13) & 1) launch_phase<13>(p, l, stream);
        if (OPT_MASK & 64) launch_phase<11>(p, l, stream);
        else {
            k_peer_expert_naive<<<T_TOK, 256, 0, stream>>>(hn, p.eidx, p.gate, p.peer_u + (size_t)l * 16384 * DM, p.peer_v + (size_t)l * 16384 * DM, x);
            if (l == DEPTH - 1) k_rmsnorm_f32<<<T_TOK / 4, 256, 0, stream>>>(x, p.g_final, out, T_TOK);
        }
    }
    (void)x_in; (void)in_sizes; (void)n_in; (void)out_size;
}
```

```cpp
#include <hip/hip_runtime.h>
#include <stdint.h>
#include <stdio.h>

typedef unsigned short bf16_t;

#define T_TOK 32768
#define SEQ 4096
#define NBATCH 8
#define DM 1024
#define NZ 1952
#define DEPTH 4
#define LOG2E 1.4426950408889634f

__device__ __forceinline__ float bf2f(bf16_t v) { return __uint_as_float(((unsigned)v) << 16); }
__device__ __forceinline__ bf16_t f2bf(float f) {
    unsigned u = __float_as_uint(f);
    u += 0x7fffu + ((u >> 16) & 1u);
    return (bf16_t)(u >> 16);
}
__device__ __forceinline__ float wave_sum(float v) {
#pragma unroll
    for (int o = 32; o >= 1; o >>= 1) v += __shfl_xor(v, o);
    return v;
}
__device__ __forceinline__ float wave_max(float v) {
#pragma unroll
    for (int o = 32; o >= 1; o >>= 1) v = fmaxf(v, __shfl_xor(v, o));
    return v;
}

struct Tables { float *cos1, *sin1, *cosm, *sinm, *cosr, *sinr, *cosc, *sinc; };
struct QKV {
    bf16_t *qA, *kA, *vA, *qB, *kB, *vB, *qC, *kC, *vC, *qD, *kD, *vD;
};

using bf16x8 = __attribute__((ext_vector_type(8))) short;
using s16x4 = __attribute__((ext_vector_type(4))) short;
using f32x16 = __attribute__((ext_vector_type(16))) float;
typedef __attribute__((ext_vector_type(2))) __bf16 bf16x2_t;

#define NW 8
#define NBLK_THREADS 512
#define CT_STRIDE 260
#define QST 264
#define TOPK_STASH (256 * QST * 2)
#define LDS_BYTES (TOPK_STASH + NW * 2304)

__device__ __forceinline__ unsigned cvtpk(float lo, float hi) {
    unsigned r; asm("v_cvt_pk_bf16_f32 %0, %1, %2" : "=v"(r) : "v"(lo), "v"(hi)); return r;
}
__device__ __forceinline__ int tid_opaque() { int t = threadIdx.x; asm volatile("" : "+v"(t)); return t; }
__device__ __forceinline__ int crow(int i, int hh) { return (i & 3) + 8 * (i >> 2) + 4 * hh; }
__device__ __forceinline__ float xhalf(float v) { return __shfl_xor(v, 32); }
__device__ __forceinline__ float xhalf_max(float v) { auto rr = __builtin_amdgcn_permlane32_swap(__float_as_uint(v), __float_as_uint(v), false, false); return fmaxf(__uint_as_float(rr[0]), __uint_as_float(rr[1])); }
__device__ __forceinline__ float xhalf_sum(float v) { auto rr = __builtin_amdgcn_permlane32_swap(__float_as_uint(v), __float_as_uint(v), false, false); return __uint_as_float(rr[0]) + __uint_as_float(rr[1]); }

struct P {
    const float *x_in, *g_mix, *w_in, *win_sink, *ax_q_norm, *ax_k_norm, *mla_q_norm, *mla_kv_norm, *mla_w_uq, *mla_w_ukv, *g_group, *w_out,
        *g_ffn, *peer_w_q, *peer_sub_keys, *peer_u, *peer_v, *g_final;
    float* out;
    float* x; bf16_t* hnb; bf16_t* zb; QKV q; bf16_t* ob; bf16_t* qp; int* eidx; float* gate;
    bf16_t *cqn, *ckvn, *qfull, *kvfull;
    bf16_t *winT, *woutT, *wqT, *subk, *wuqT, *wukvT;
    unsigned char *u8, *v8; float *su, *sv; float* ssq2; bf16_t* xb2; float* ssqd;
    Tables tb;
    unsigned* bar;
    int flags; int pad0;
};
typedef const P __attribute__((address_space(4))) PC;
__device__ __forceinline__ PC* kargs() { PC* q = (PC*)__builtin_amdgcn_kernarg_segment_ptr(); asm volatile("" : "+s"(q)); return q; }

struct EpiStoreBf16 {
    bf16_t* C; int ldc; int N;
    __device__ __forceinline__ void operator()(const f32x16 (&acc)[2][2], int mbase, int nbase, int r32, int hh) const {
#pragma unroll
        for (int mt = 0; mt < 2; ++mt)
#pragma unroll
            for (int nt = 0; nt < 2; ++nt) {
                const int n = nbase + nt * 32 + r32;
                if (n < N) {
#pragma unroll
                    for (int i = 0; i < 16; ++i) {
                        const int m = mbase + mt * 32 + crow(i, hh);
                        C[(size_t)m * ldc + n] = f2bf(acc[mt][nt][i]);
                    }
                }
            }
    }
};
struct EpiResidNorm {
    float* X; int ldx; bf16_t* XB; float* ssq;
    __device__ __forceinline__ void operator()(const f32x16 (&acc)[2][2], int mbase, int nbase, int r32, int hh) const {
#pragma unroll
        for (int mt = 0; mt < 2; ++mt) {
#pragma unroll
            for (int i = 0; i < 16; ++i) {
                const int m = mbase + mt * 32 + crow(i, hh);
                float sq = 0.f;
#pragma unroll
                for (int nt = 0; nt < 2; ++nt) {
                    const int n = nbase + nt * 32 + r32;
                    float* px = X + (size_t)m * ldx + n;
                    const float v = *px + acc[mt][nt][i];
                    *px = v;
                    XB[(size_t)m * ldx + n] = f2bf(v);
                    sq += v * v;
                }
                sq += __shfl_xor(sq, 1); sq += __shfl_xor(sq, 2); sq += __shfl_xor(sq, 4); sq += __shfl_xor(sq, 8); sq += __shfl_xor(sq, 16);
                if (r32 == 0) ssq[(size_t)m * 16 + (nbase >> 6)] = sq;
            }
        }
    }
};
struct EpiStoreBf16RowNorm {
    bf16_t* C; int ldc; const float* ssq;
    __device__ __forceinline__ void operator()(const f32x16 (&acc)[2][2], int mbase, int nbase, int r32, int hh) const {
#pragma unroll
        for (int mt = 0; mt < 2; ++mt)
#pragma unroll
            for (int i = 0; i < 16; ++i) {
                const int m = mbase + mt * 32 + crow(i, hh);
                const float4 q0 = *(const float4*)(ssq + (size_t)m * 16), q1 = *(const float4*)(ssq + (size_t)m * 16 + 4);
                const float4 q2 = *(const float4*)(ssq + (size_t)m * 16 + 8), q3 = *(const float4*)(ssq + (size_t)m * 16 + 12);
                const float tot = (((q0.x + q0.y) + (q0.z + q0.w)) + ((q1.x + q1.y) + (q1.z + q1.w))) + (((q2.x + q2.y) + (q2.z + q2.w)) + ((q3.x + q3.y) + (q3.z + q3.w)));
                const float r = rsqrtf(tot * (1.f / DM) + 1e-6f);
#pragma unroll
                for (int nt = 0; nt < 2; ++nt) C[(size_t)m * ldc + nbase + nt * 32 + r32] = f2bf(acc[mt][nt][i] * r);
            }
    }
};
struct EpiResidF32 {
    float* X; int ldx;
    __device__ __forceinline__ void operator()(const f32x16 (&acc)[2][2], int mbase, int nbase, int r32, int hh) const {
#pragma unroll
        for (int mt = 0; mt < 2; ++mt)
#pragma unroll
            for (int nt = 0; nt < 2; ++nt) {
                const int n = nbase + nt * 32 + r32;
#pragma unroll
                for (int i = 0; i < 16; ++i) {
                    const int m = mbase + mt * 32 + crow(i, hh);
                    float* p = X + (size_t)m * ldx + n;
                    *p = *p + acc[mt][nt][i];
                }
            }
    }
};

__device__ __forceinline__ void glds16(const void* gsrc, unsigned lds_dst) {
    unsigned keep;
    asm volatile("s_mov_b32 %0, m0\n\ts_mov_b32 m0, %2\n\ts_nop 0\n\tglobal_load_lds_dwordx4 %1, off\n\ts_mov_b32 m0, %0" : "=&s"(keep) : "v"(gsrc), "s"(lds_dst) : "memory");
}

template <class Epi>
__device__ __forceinline__ void gemm_tile(const bf16_t* __restrict__ X, int ldx, const bf16_t* __restrict__ W, int ldw, int K, int m0, int n0, int N,
                                          char* lds, const Epi& epi) {
    const int tid = tid_opaque(), lane = tid & 63, wave = tid >> 6;
    const int wm = wave >> 1, wn = wave & 1;
    const int r32 = lane & 31, hh = lane >> 5;
    const char* xsrc[4]; const char* wsrc[4];
#pragma unroll
    for (int j = 0; j < 4; ++j) {
        const int row = (wave * 4 + j) * 8 + (lane >> 3), slot = lane & 7;
        const int c = slot ^ ((row >> 1) & 7);
        xsrc[j] = (const char*)(X + (size_t)(m0 + row) * ldx + c * 8);
        int n = n0 + row; n = n < N ? n : N - 1;
        wsrc[j] = (const char*)(W + (size_t)n * ldw + c * 8);
    }
    const unsigned lbase = (unsigned)(uintptr_t)lds;
    const unsigned wpiece = __builtin_amdgcn_readfirstlane(wave) * 4096u;
    f32x16 acc[2][2];
#pragma unroll
    for (int a = 0; a < 2; ++a)
#pragma unroll
        for (int b = 0; b < 2; ++b)
#pragma unroll
            for (int i = 0; i < 16; ++i) acc[a][b][i] = 0.f;
    const int nk = K >> 6;
#define GDMA(KT, BUF) do { const unsigned _d = lbase + (BUF) * 32768u + wpiece; const int _ko = (KT) * 128; \
        glds16(xsrc[0] + _ko, _d); glds16(xsrc[1] + _ko, _d + 1024u); glds16(xsrc[2] + _ko, _d + 2048u); glds16(xsrc[3] + _ko, _d + 3072u); \
        glds16(wsrc[0] + _ko, _d + 16384u); glds16(wsrc[1] + _ko, _d + 17408u); glds16(wsrc[2] + _ko, _d + 18432u); glds16(wsrc[3] + _ko, _d + 19456u); } while (0)
    GDMA(0, 0);
    asm volatile("s_waitcnt vmcnt(0)" ::: "memory");
    __syncthreads();
    for (int kt = 0; kt < nk; ++kt) {
        if (kt + 1 < nk) GDMA(kt + 1, (kt + 1) & 1);
        const char* xs = lds + (kt & 1) * 32768; const char* ws = xs + 16384;
#pragma unroll
        for (int ks = 0; ks < 4; ++ks) {
            bf16x8 xf[2], wf[2];
#pragma unroll
            for (int mt = 0; mt < 2; ++mt) { const int r = wm * 64 + mt * 32 + r32; xf[mt] = *(const bf16x8*)(xs + r * 128 + (((ks * 2 + hh) ^ ((r >> 1) & 7)) << 4)); }
#pragma unroll
            for (int nt = 0; nt < 2; ++nt) { const int r = wn * 64 + nt * 32 + r32; wf[nt] = *(const bf16x8*)(ws + r * 128 + (((ks * 2 + hh) ^ ((r >> 1) & 7)) << 4)); }
#pragma unroll
            for (int mt = 0; mt < 2; ++mt)
#pragma unroll
                for (int nt = 0; nt < 2; ++nt) acc[mt][nt] = __builtin_amdgcn_mfma_f32_32x32x16_bf16(xf[mt], wf[nt], acc[mt][nt], 0, 0, 0);
        }
        asm volatile("s_waitcnt vmcnt(0)" ::: "memory");
        __syncthreads();
    }
#undef GDMA
    epi(acc, m0 + wm * 64, n0 + wn * 64, r32, hh);
}

__device__ __forceinline__ void tile_map(int tile, int ntm, int ntn, int& mt, int& nt) {
    if ((ntn & 7) == 0) {
        const int G = gridDim.x;
        const int round = tile / G, bi = tile % G;
        const int x = bi & 7, j = bi >> 3;
        const int per = G >> 3;
        const int id = (round * 8 + x) * per + j;
        const int st = id >> 6, in = id & 63;
        const int snt = ntn >> 3;
        const int sm = st / snt, sn = st % snt;
        mt = sm * 8 + (in >> 3); nt = sn * 8 + (in & 7);
    } else { mt = tile / ntn; nt = tile % ntn; }
}

__device__ __forceinline__ void gemm_mainloop(const bf16_t* __restrict__ X, int ldx, const bf16_t* __restrict__ W, int ldw, int K, int m0, int n0, int N,
                                              char* lds, f32x16 (&acc)[2][4]) {
    const int tid = tid_opaque(), lane = tid & 63, wave = tid >> 6;
    const int wm = wave >> 1, wn = wave & 1;
    const int r32 = lane & 31, hh = lane >> 5;
    const char* xsrc[4]; const char* wsrc[4];
#pragma unroll
    for (int j = 0; j < 4; ++j) {
        const int row = (wave * 4 + j) * 8 + (lane >> 3), slot = lane & 7;
        const int c = slot ^ ((row >> 1) & 7);
        xsrc[j] = (const char*)(X + (size_t)(m0 + row) * ldx + c * 8);
        int n = n0 + row; n = n < N ? n : N - 1;
        wsrc[j] = (const char*)(W + (size_t)n * ldw + c * 8);
    }
    const unsigned lbase = (unsigned)(uintptr_t)lds;
    const unsigned wpiece = __builtin_amdgcn_readfirstlane(wave) * 4096u;
#pragma unroll
    for (int a = 0; a < 2; ++a)
#pragma unroll
        for (int b = 0; b < 4; ++b)
#pragma unroll
            for (int i = 0; i < 16; ++i) acc[a][b][i] = 0.f;
    const int nk = K >> 6;
#define GDMA(KT, BUF) do { const unsigned _d = lbase + (BUF) * 65536u + wpiece; const int _ko = (KT) * 128; \
        glds16(xsrc[0] + _ko, _d); glds16(xsrc[1] + _ko, _d + 1024u); glds16(xsrc[2] + _ko, _d + 2048u); glds16(xsrc[3] + _ko, _d + 3072u); \
        glds16(wsrc[0] + _ko, _d + 32768u); glds16(wsrc[1] + _ko, _d + 33792u); glds16(wsrc[2] + _ko, _d + 34816u); glds16(wsrc[3] + _ko, _d + 35840u); } while (0)
    GDMA(0, 0);
    asm volatile("s_waitcnt vmcnt(0)" ::: "memory");
    __syncthreads();
    for (int kt = 0; kt < nk; ++kt) {
        if (kt + 1 < nk) GDMA(kt + 1, (kt + 1) & 1);
        const char* xs = lds + (kt & 1) * 65536; const char* ws = xs + 32768;
#pragma unroll
        for (int ks = 0; ks < 4; ++ks) {
            bf16x8 xf[2], wf[4];
#pragma unroll
            for (int mt = 0; mt < 2; ++mt) { const int r = wm * 64 + mt * 32 + r32; xf[mt] = *(const bf16x8*)(xs + r * 128 + (((ks * 2 + hh) ^ ((r >> 1) & 7)) << 4)); }
#pragma unroll
            for (int nt = 0; nt < 4; ++nt) { const int r = wn * 128 + nt * 32 + r32; wf[nt] = *(const bf16x8*)(ws + r * 128 + (((ks * 2 + hh) ^ ((r >> 1) & 7)) << 4)); }
#pragma unroll
            for (int mt = 0; mt < 2; ++mt)
#pragma unroll
                for (int nt = 0; nt < 4; ++nt) acc[mt][nt] = __builtin_amdgcn_mfma_f32_32x32x16_bf16(xf[mt], wf[nt], acc[mt][nt], 0, 0, 0);
        }
        asm volatile("s_waitcnt vmcnt(0)" ::: "memory");
        __syncthreads();
    }
#undef GDMA
}

template <class Epi, int KGROUP>
__device__ __forceinline__ void gemm_tile_rows(const bf16_t* __restrict__ X, int ldx, const bf16_t* __restrict__ W, int ldw, int K, int m0, int n0, int N,
                                               char* lds, const Epi& epi) {
    const int tid = tid_opaque(), lane = tid & 63, wave = tid >> 6;
    const int wm = wave >> 1, wn = wave & 1;
    const int r32 = lane & 31, hh = lane >> 5;
    f32x16 acc[2][4];
    gemm_mainloop(X, ldx, W, ldw, K, m0, n0, N, lds, acc);
    float* ct = (float*)lds;
#pragma unroll
    for (int hsel = 0; hsel < 2; ++hsel) {
        if ((wm >> 1) == hsel) {
#pragma unroll
            for (int mt = 0; mt < 2; ++mt)
#pragma unroll
                for (int nt = 0; nt < 4; ++nt)
#pragma unroll
                    for (int i = 0; i < 16; ++i)
                        ct[((wm & 1) * 64 + mt * 32 + crow(i, hh)) * CT_STRIDE + wn * 128 + nt * 32 + r32] = acc[mt][nt][i];
        }
        __syncthreads();
        epi.begin(ct, m0 + hsel * 128, n0, tid);
#pragma unroll
        for (int pass = 0; pass < 8; ++pass) {
            const int ch = pass & 3, row = (pass >> 2) * 64 + (tid >> 3), c = tid & 7;
            epi.chunk(ct + row * CT_STRIDE + ch * 64 + c * 8, ct + row * CT_STRIDE, m0 + hsel * 128 + row, n0 + ch * 64, c);
        }
        __syncthreads();
    }
}

template <class Epi, int KGROUP>
__device__ __forceinline__ void gemm_phase_rows(const bf16_t* X, int ldx, const bf16_t* W, int ldw, int M, int N, int K, char* lds, const Epi& epi) {
    const int ntm = M >> 8, ntn = (N + 255) >> 8, nt_tot = ntm * ntn;
    for (int tile = blockIdx.x; tile < nt_tot; tile += gridDim.x) {
        int mt, nt;
        if ((gridDim.x & 63) == 0 && (ntn & 7) == 0 && (nt_tot % gridDim.x) == 0) tile_map(tile, ntm, ntn, mt, nt);
        else { mt = tile / ntn; nt = tile % ntn; }
        if (mt < ntm && nt < ntn) gemm_tile_rows<Epi, KGROUP>(X, ldx, W, ldw, K, mt * 256, nt * 256, N, lds, epi);
    }
}

__device__ __forceinline__ uint4 pack8(const float4& a, const float4& b) { return make_uint4(cvtpk(a.x, a.y), cvtpk(a.z, a.w), cvtpk(b.x, b.y), cvtpk(b.z, b.w)); }
__device__ __forceinline__ float sum8(float v) { v += __shfl_xor(v, 1); v += __shfl_xor(v, 2); v += __shfl_xor(v, 4); return v; }

struct RowsStoreBf16 {
    bf16_t* C; int ldc; int N;
    __device__ __forceinline__ void table(float*, int, int) const {}
    __device__ __forceinline__ void begin(float*, int, int, int) const {}
    __device__ __forceinline__ void chunk(const float* t, const float* rb, int m, int n, int c) const {
        if (n + 8 * c < N) *(uint4*)(C + (size_t)m * ldc + n + 8 * c) = pack8(*(const float4*)t, *(const float4*)(t + 4));
    }
};
struct RowsResidF32 {
    float* X; int ldx;
    __device__ __forceinline__ void table(float*, int, int) const {}
    __device__ __forceinline__ void begin(float*, int, int, int) const {}
    __device__ __forceinline__ void chunk(const float* t, const float* rb, int m, int n, int c) const {
        float* px = X + (size_t)m * ldx + n + 8 * c;
        float4 v0 = *(const float4*)px, v1 = *(const float4*)(px + 4);
        const float4 a0 = *(const float4*)t, a1 = *(const float4*)(t + 4);
        v0.x += a0.x; v0.y += a0.y; v0.z += a0.z; v0.w += a0.w; v1.x += a1.x; v1.y += a1.y; v1.z += a1.z; v1.w += a1.w;
        *(float4*)px = v0; *(float4*)(px + 4) = v1;
    }
};
struct RowsResidNorm {
    float* X; int ldx; bf16_t* XB; float* ssq;
    __device__ __forceinline__ void table(float*, int, int) const {}
    __device__ __forceinline__ void begin(float*, int, int, int) const {}
    __device__ __forceinline__ void chunk(const float* t, const float* rb, int m, int n, int c) const {
        float* px = X + (size_t)m * ldx + n + 8 * c;
        float4 v0 = *(const float4*)px, v1 = *(const float4*)(px + 4);
        const float4 a0 = *(const float4*)t, a1 = *(const float4*)(t + 4);
        v0.x += a0.x; v0.y += a0.y; v0.z += a0.z; v0.w += a0.w; v1.x += a1.x; v1.y += a1.y; v1.z += a1.z; v1.w += a1.w;
        *(float4*)px = v0; *(float4*)(px + 4) = v1;
        *(uint4*)(XB + (size_t)m * ldx + n + 8 * c) = pack8(v0, v1);
        const float sq = sum8((v0.x * v0.x + v0.y * v0.y) + (v0.z * v0.z + v0.w * v0.w) + (v1.x * v1.x + v1.y * v1.y) + (v1.z * v1.z + v1.w * v1.w));
        if (c == 0) ssq[((size_t)(n >> 8) * T_TOK + m) * 4 + ((n >> 6) & 3)] = sq;
    }
};
struct RowsStoreBf16RowNorm {
    bf16_t* C; int ldc; const float* ssq;
    __device__ __forceinline__ void table(float*, int, int) const {}
    __device__ __forceinline__ void begin(float* ct, int m0, int, int tid) const {
        if (tid < 128) {
            float tot = 0.f;
#pragma unroll
            for (int j = 0; j < 4; ++j) { const float4 q = *(const float4*)(ssq + ((size_t)j * T_TOK + m0 + tid) * 4); tot += (q.x + q.y) + (q.z + q.w); }
            ct[tid * CT_STRIDE + 256] = rsqrtf(tot * (1.f / DM) + 1e-6f);
        }
        __syncthreads();
    }
    __device__ __forceinline__ void chunk(const float* t, const float* rb, int m, int n, int c) const {
        const float r = rb[256];
        const float4 a = *(const float4*)t, b = *(const float4*)(t + 4);
        *(uint4*)(C + (size_t)m * ldc + n + 8 * c) = make_uint4(cvtpk(a.x * r, a.y * r), cvtpk(a.z * r, a.w * r), cvtpk(b.x * r, b.y * r), cvtpk(b.z * r, b.w * r));
    }
};

struct F8 { float4 a, b; };
__device__ __forceinline__ F8 f8_load(const float* p) { F8 r; r.a = *(const float4*)p; r.b = *(const float4*)(p + 4); return r; }
__device__ __forceinline__ F8 f8_shfl_xor(const F8& v, int m) {
    F8 r; r.a.x = __shfl_xor(v.a.x, m); r.a.y = __shfl_xor(v.a.y, m); r.a.z = __shfl_xor(v.a.z, m); r.a.w = __shfl_xor(v.a.w, m);
    r.b.x = __shfl_xor(v.b.x, m); r.b.y = __shfl_xor(v.b.y, m); r.b.z = __shfl_xor(v.b.z, m); r.b.w = __shfl_xor(v.b.w, m); return r;
}
__device__ __forceinline__ float f8_ssq(const F8& v) { return (v.a.x * v.a.x + v.a.y * v.a.y) + (v.a.z * v.a.z + v.a.w * v.a.w) + (v.b.x * v.b.x + v.b.y * v.b.y) + (v.b.z * v.b.z + v.b.w * v.b.w); }
__device__ __forceinline__ uint4 f8_rope_pack(const F8& v, const F8& pv, const F8& cs, const F8& sn, float sg, float sc) {
    return make_uint4(cvtpk((v.a.x * cs.a.x + sg * pv.a.x * sn.a.x) * sc, (v.a.y * cs.a.y + sg * pv.a.y * sn.a.y) * sc),
                      cvtpk((v.a.z * cs.a.z + sg * pv.a.z * sn.a.z) * sc, (v.a.w * cs.a.w + sg * pv.a.w * sn.a.w) * sc),
                      cvtpk((v.b.x * cs.b.x + sg * pv.b.x * sn.b.x) * sc, (v.b.y * cs.b.y + sg * pv.b.y * sn.b.y) * sc),
                      cvtpk((v.b.z * cs.b.z + sg * pv.b.z * sn.b.z) * sc, (v.b.w * cs.b.w + sg * pv.b.w * sn.b.w) * sc));
}
#define QKV_MIX(mi) ((size_t)(mi) * 512 * T_TOK)
#define QKV_K (256 * (size_t)T_TOK)
#define QKV_V (384 * (size_t)T_TOK)
#define QKV_KD (1920 * (size_t)T_TOK)
struct RowsPostZ {
    bf16_t* qkv; const float* tb; const float* g_qn; const float* g_kn; bf16_t* lat; float* ssqd; bf16_t* kD;
    __device__ __forceinline__ void table(float*, int, int) const {}
    __device__ __forceinline__ void begin(float*, int, int, int) const {}
    __device__ __forceinline__ void chunk(const float* t, const float* rb, int m, int n, int c) const {
        const int qc = n >> 6;
        const int b = m / SEQ, s = m % SEQ;
        F8 v = f8_load(t);
        const float scA = 0.125f * LOG2E;
        if (qc < 6 || (qc >= 16 && qc < 22)) {
            const int mi = qc >= 16 ? 2 : 0; const int ql = qc - 8 * mi;
            const F8 pv = f8_shfl_xor(v, 4);
            const int j0 = 8 * (c & 3);
            const F8 cs = f8_load(tb + s * 32 + j0), sn = f8_load(tb + 131072 + s * 32 + j0);
            const size_t off = QKV_MIX(mi) + (ql < 4 ? ((size_t)(b * 4 + ql) * SEQ + s) * 64 : QKV_K + ((size_t)(b * 2 + (ql - 4)) * SEQ + s) * 64);
            *(uint4*)(qkv + off + 8 * c) = f8_rope_pack(v, pv, cs, sn, (c < 4) ? -1.f : 1.f, (ql < 4) ? scA : 1.f);
        } else if (qc == 6 || qc == 7 || qc == 14 || qc == 15 || qc == 22 || qc == 23) {
            *(uint4*)(qkv + QKV_MIX(qc >> 3) + QKV_V + ((size_t)(b * 2 + (qc & 1)) * SEQ + s) * 64 + 8 * c) = pack8(v.a, v.b);
        } else if (qc >= 8 && qc < 14) {
            const bool isq = qc < 12; const int h = isq ? qc - 8 : qc - 12;
            const float r = rsqrtf(sum8(f8_ssq(v)) * (1.f / 64.f) + 1e-6f);
            const F8 gq = f8_load(g_qn + 8 * c), gk = f8_load(g_kn + 8 * c);
            v.a.x *= r * (isq ? gq.a.x : gk.a.x); v.a.y *= r * (isq ? gq.a.y : gk.a.y); v.a.z *= r * (isq ? gq.a.z : gk.a.z); v.a.w *= r * (isq ? gq.a.w : gk.a.w);
            v.b.x *= r * (isq ? gq.b.x : gk.b.x); v.b.y *= r * (isq ? gq.b.y : gk.b.y); v.b.z *= r * (isq ? gq.b.z : gk.b.z); v.b.w *= r * (isq ? gq.b.w : gk.b.w);
            const F8 pv = f8_shfl_xor(v, 2);
            const int jj0 = 8 * (c & 1);
            const int to = (c < 4) ? 393216 + (s >> 6) * 16 : 395264 + (s & 63) * 16;
            const F8 cs = f8_load(tb + to + jj0), sn = f8_load(tb + to + 1024 + jj0);
            const size_t off = QKV_MIX(1) + (isq ? ((size_t)(b * 4 + h) * SEQ + s) * 64 : QKV_K + ((size_t)(b * 2 + h) * SEQ + s) * 64);
            *(uint4*)(qkv + off + 8 * c) = f8_rope_pack(v, pv, cs, sn, (c & 2) ? 1.f : -1.f, isq ? scA : 1.f);
        } else if (qc >= 24 && qc < 30) {
            const float ss = sum8(f8_ssq(v));
            const size_t off = qc < 28 ? (size_t)m * 256 + (qc - 24) * 64 : (size_t)T_TOK * 256 + (size_t)m * 128 + (qc - 28) * 64;
            *(uint4*)(lat + off + 8 * c) = pack8(v.a, v.b);
            if (c == 0) ssqd[(size_t)(qc - 24) * T_TOK + m] = ss;
        } else if (qc == 30) {
            const F8 pv = f8_shfl_xor(v, 2);
            if (c < 4) {
                const int i0 = 8 * (c & 1);
                const F8 cs = f8_load(tb + 262144 + s * 16 + i0), sn = f8_load(tb + 327680 + s * 16 + i0);
                const uint4 w = f8_rope_pack(v, pv, cs, sn, (c & 2) ? 1.f : -1.f, 1.f);
#pragma unroll
                for (int h = 0; h < 4; ++h) *(uint4*)(kD + ((size_t)(b * 4 + h) * SEQ + s) * 96 + 64 + 8 * c) = w;
            }
        }
    }
};
template <int NS, int DIM>
struct RowsStoreBf16Scale {
    bf16_t* C; int ldc; int N; const float* ssq;
    __device__ __forceinline__ void table(float*, int, int) const {}
    __device__ __forceinline__ void begin(float* ct, int m0, int, int tid) const {
        if (tid < 128) {
            float tot = 0.f;
#pragma unroll
            for (int j = 0; j < NS; ++j) tot += ssq[(size_t)j * T_TOK + m0 + tid];
            ct[tid * CT_STRIDE + 256] = rsqrtf(tot * (1.f / DIM) + 1e-6f);
        }
        __syncthreads();
    }
    __device__ __forceinline__ void chunk(const float* t, const float* rb, int m, int n, int c) const {
        const float r = rb[256];
        const float4 a = *(const float4*)t, b = *(const float4*)(t + 4);
        if (n + 8 * c < N) *(uint4*)(C + (size_t)m * ldc + n + 8 * c) = make_uint4(cvtpk(a.x * r, a.y * r), cvtpk(a.z * r, a.w * r), cvtpk(b.x * r, b.y * r), cvtpk(b.z * r, b.w * r));
    }
};

struct RowsPostQ {
    bf16_t* qD; const float* tb; const float* ssq;
    __device__ __forceinline__ void table(float*, int, int) const {}
    __device__ __forceinline__ void begin(float* ct, int m0, int, int tid) const {
        if (tid < 128) {
            const float tot = (ssq[m0 + tid] + ssq[(size_t)T_TOK + m0 + tid]) + (ssq[(size_t)2 * T_TOK + m0 + tid] + ssq[(size_t)3 * T_TOK + m0 + tid]);
            ct[tid * CT_STRIDE + 256] = rsqrtf(tot * (1.f / 256.f) + 1e-6f) * (0.10206207261596575f * LOG2E);
        }
        __syncthreads();
    }
    __device__ __forceinline__ void chunk(const float* t, const float* rb, int m, int n, int c) const {
        if (n >= 384) return;
        const float r = rb[256];
        const int qc = n >> 6, b = m / SEQ, s = m % SEQ;
        F8 v = f8_load(t);
        v.a.x *= r; v.a.y *= r; v.a.z *= r; v.a.w *= r; v.b.x *= r; v.b.y *= r; v.b.z *= r; v.b.w *= r;
        if (qc < 4) {
            *(uint4*)(qD + ((size_t)(b * 4 + qc) * SEQ + s) * 128 + 8 * c) = pack8(v.a, v.b);
        } else {
            const F8 pv = f8_shfl_xor(v, 2);
            const int h = (qc - 4) * 2 + (c >> 2), i0 = 8 * (c & 1);
            const F8 cs = f8_load(tb + 262144 + s * 16 + i0), sn = f8_load(tb + 327680 + s * 16 + i0);
            *(uint4*)(qD + ((size_t)(b * 4 + h) * SEQ + s) * 128 + 64 + 8 * (c & 3)) = f8_rope_pack(v, pv, cs, sn, (c & 2) ? 1.f : -1.f, 1.f);
        }
    }
};
struct RowsPostKV {
    bf16_t* kD; bf16_t* vD; const float* ssq;
    __device__ __forceinline__ void table(float*, int, int) const {}
    __device__ __forceinline__ void begin(float* ct, int m0, int, int tid) const {
        if (tid < 128) ct[tid * CT_STRIDE + 256] = rsqrtf((ssq[m0 + tid] + ssq[(size_t)T_TOK + m0 + tid]) * (1.f / 128.f) + 1e-6f);
        __syncthreads();
    }
    __device__ __forceinline__ void chunk(const float* t, const float* rb, int m, int n, int c) const {
        const float r = rb[256];
        const int qc = n >> 6, h = qc >> 1, b = m / SEQ, s = m % SEQ;
        F8 v = f8_load(t);
        v.a.x *= r; v.a.y *= r; v.a.z *= r; v.a.w *= r; v.b.x *= r; v.b.y *= r; v.b.z *= r; v.b.w *= r;
        const size_t hb = (size_t)(b * 4 + h) * SEQ + s;
        const size_t off = (qc & 1) ? hb * 64 : hb * 96;
        bf16_t* base = (bf16_t*)((qc & 1) ? (size_t)vD : (size_t)kD);
        *(uint4*)(base + off + 8 * c) = pack8(v.a, v.b);
    }
};

template <class Epi>
__device__ __forceinline__ void gemm_phase(const bf16_t* X, int ldx, const bf16_t* W, int ldw, int M, int N, int K, char* lds, const Epi& epi) {
    const int ntm = M >> 7, ntn = (N + 127) >> 7, nt_tot = ntm * ntn;
    for (int tile = blockIdx.x; tile < nt_tot; tile += gridDim.x) {
        int mt, nt;
        if ((gridDim.x & 7) == 0 && (gridDim.x >> 3) * 8 == gridDim.x && ((gridDim.x >> 3) & 63) == 0) tile_map(tile, ntm, ntn, mt, nt);
        else { mt = tile / ntn; nt = tile % ntn; }
        if (mt < ntm && nt < ntn) gemm_tile(X, ldx, W, ldw, K, mt * 128, nt * 128, N, lds, epi);
    }
}

template <int OFF> __device__ __forceinline__ s16x4 tr_read(int vb) {
    s16x4 r; asm volatile("ds_read_b64_tr_b16 %0, %1 offset:%2" : "=&v"(r) : "v"(vb), "i"(OFF) : "memory"); return r;
}
#define VS_BYTES 192

template <int KT2>
__device__ __forceinline__ void pv_sub(f32x16 (&o)[2], const f32x16& p, int vbase) {
    bf16x8 pf[2];
#pragma unroll
    for (int s2 = 0; s2 < 2; ++s2) {
        unsigned a = cvtpk(p[8 * s2 + 0], p[8 * s2 + 1]), b = cvtpk(p[8 * s2 + 2], p[8 * s2 + 3]);
        unsigned c = cvtpk(p[8 * s2 + 4], p[8 * s2 + 5]), d = cvtpk(p[8 * s2 + 6], p[8 * s2 + 7]);
        uint4 w = make_uint4(a, b, c, d);
        pf[s2] = *(bf16x8*)&w;
    }
    {
        s16x4 l00 = tr_read<(KT2 * 32 + 0) * VS_BYTES + 0>(vbase), h00 = tr_read<(KT2 * 32 + 8) * VS_BYTES + 0>(vbase);
        s16x4 l01 = tr_read<(KT2 * 32 + 0) * VS_BYTES + 64>(vbase), h01 = tr_read<(KT2 * 32 + 8) * VS_BYTES + 64>(vbase);
        s16x4 l10 = tr_read<(KT2 * 32 + 16) * VS_BYTES + 0>(vbase), h10 = tr_read<(KT2 * 32 + 24) * VS_BYTES + 0>(vbase);
        s16x4 l11 = tr_read<(KT2 * 32 + 16) * VS_BYTES + 64>(vbase), h11 = tr_read<(KT2 * 32 + 24) * VS_BYTES + 64>(vbase);
        asm volatile("s_waitcnt lgkmcnt(0)" ::: "memory");
        __builtin_amdgcn_sched_barrier(0);
#define PKV(L, H) (bf16x8){L[0], L[1], L[2], L[3], H[0], H[1], H[2], H[3]}
        o[0] = __builtin_amdgcn_mfma_f32_32x32x16_bf16(PKV(l00, h00), pf[0], o[0], 0, 0, 0);
        o[1] = __builtin_amdgcn_mfma_f32_32x32x16_bf16(PKV(l01, h01), pf[0], o[1], 0, 0, 0);
        o[0] = __builtin_amdgcn_mfma_f32_32x32x16_bf16(PKV(l10, h10), pf[1], o[0], 0, 0, 0);
        o[1] = __builtin_amdgcn_mfma_f32_32x32x16_bf16(PKV(l11, h11), pf[1], o[1], 0, 0, 0);
#undef PKV
    }
}


#define PV_LOAD(KT2, VB, F) \
    const s16x4 F##0 = tr_read<((KT2) * 32 + 0) * VS_BYTES + 0>(VB), F##1 = tr_read<((KT2) * 32 + 8) * VS_BYTES + 0>(VB), \
                F##2 = tr_read<((KT2) * 32 + 0) * VS_BYTES + 64>(VB), F##3 = tr_read<((KT2) * 32 + 8) * VS_BYTES + 64>(VB), \
                F##4 = tr_read<((KT2) * 32 + 16) * VS_BYTES + 0>(VB), F##5 = tr_read<((KT2) * 32 + 24) * VS_BYTES + 0>(VB), \
                F##6 = tr_read<((KT2) * 32 + 16) * VS_BYTES + 64>(VB), F##7 = tr_read<((KT2) * 32 + 24) * VS_BYTES + 64>(VB)
#define PKV2(L, H) (bf16x8){L[0], L[1], L[2], L[3], H[0], H[1], H[2], H[3]}
#define PV_MMA(O, P, F) do { bf16x8 _pf0, _pf1; \
        { uint4 _w = make_uint4(cvtpk(P[0], P[1]), cvtpk(P[2], P[3]), cvtpk(P[4], P[5]), cvtpk(P[6], P[7])); _pf0 = *(bf16x8*)&_w; } \
        { uint4 _w = make_uint4(cvtpk(P[8], P[9]), cvtpk(P[10], P[11]), cvtpk(P[12], P[13]), cvtpk(P[14], P[15])); _pf1 = *(bf16x8*)&_w; } \
        O[0] = __builtin_amdgcn_mfma_f32_32x32x16_bf16(PKV2(F##0, F##1), _pf0, O[0], 0, 0, 0); \
        O[1] = __builtin_amdgcn_mfma_f32_32x32x16_bf16(PKV2(F##2, F##3), _pf0, O[1], 0, 0, 0); \
        O[0] = __builtin_amdgcn_mfma_f32_32x32x16_bf16(PKV2(F##4, F##5), _pf1, O[0], 0, 0, 0); \
        O[1] = __builtin_amdgcn_mfma_f32_32x32x16_bf16(PKV2(F##6, F##7), _pf1, O[1], 0, 0, 0); } while (0)

template <int DK, int G, bool WINDOW>
__device__ __forceinline__ void attn_item(const bf16_t* __restrict__ Q, const bf16_t* __restrict__ K, const bf16_t* __restrict__ V, const float* __restrict__ sink,
                                          bf16_t* __restrict__ O, int ocol, int H, int KV, int item, char* lds, int qs = DK) {
    constexpr int KS = DK * 2 + 16;
    constexpr int KCH = DK / 8;
    constexpr int KLD = (128 * KCH) / 512;
    constexpr int QB = 256 / G;
    constexpr int NCH = SEQ / QB;
    constexpr int KBUF = 128 * KS, VBUF = 128 * VS_BYTES;
    const int tid = tid_opaque(), lane = tid & 63, wave = tid >> 6;
    const int r32 = lane & 31, hh = lane >> 5;
    const int chunk = item % NCH, kvh = (item / NCH) % KV, b = item / (NCH * KV);
    const int g = (G == 2) ? (wave >> 2) : 0;
    const int qoff = (G == 2) ? (wave & 3) * 32 : wave * 32;
    const int head = kvh * G + g;
    const int q0 = chunk * QB;
    const int qpos = q0 + qoff + r32;
    bf16x8 qf[DK / 16];
    {
        const bf16_t* qp = Q + ((size_t)(b * H + head) * SEQ + qpos) * qs + hh * 8;
#pragma unroll
        for (int ks = 0; ks < DK / 16; ++ks) qf[ks] = *(const bf16x8*)(qp + ks * 16);
    }
    int kt_lo = 0, kt_hi = SEQ / 128;
    if (WINDOW) { kt_lo = q0 / 128 - 1; if (kt_lo < 0) kt_lo = 0; kt_hi = (q0 + QB) / 128 + 1; if (kt_hi > SEQ / 128) kt_hi = SEQ / 128; }
    const char* Kg = (const char*)(K + (size_t)(b * KV + kvh) * SEQ * DK);
    const char* Vg = (const char*)(V + (size_t)(b * KV + kvh) * SEQ * 64);
    uint4 kr0, kr1, kr2 = make_uint4(0, 0, 0, 0), vr0, vr1;
    const int koff0 = (tid / KCH) * KS + (tid % KCH) * 16;
    const int koff1 = ((tid + 512) / KCH) * KS + ((tid + 512) % KCH) * 16;
    const int koff2 = ((tid + 1024) / KCH) * KS + ((tid + 1024) % KCH) * 16;
    const int voff0 = (tid >> 3) * VS_BYTES + (tid & 7) * 16;
    const int voff1 = ((tid + 512) >> 3) * VS_BYTES + (tid & 7) * 16;
    f32x16 o[2];
#pragma unroll
    for (int d = 0; d < 2; ++d)
#pragma unroll
        for (int i = 0; i < 16; ++i) o[d][i] = 0.f;
    float m = -1e30f, l = 0.f;
    if (WINDOW) { m = sink[head] * LOG2E; l = (hh == 0) ? 1.f : 0.f; }
    const int gg = lane >> 4, li = lane & 15;
    const int vlane = (4 * (gg >> 1) + (li >> 2)) * VS_BYTES + (16 * (gg & 1) + 4 * (li & 3)) * 2;
    char* Kl = lds; char* Vl = lds + 2 * KBUF;
#define AGLOAD(KT) do { const char* _kg = Kg + (size_t)(KT) * 128 * DK * 2; const char* _vg = Vg + (size_t)(KT) * 128 * 128; \
        kr0 = *(const uint4*)(_kg + tid * 16); kr1 = *(const uint4*)(_kg + (tid + 512) * 16); if (KLD > 2) kr2 = *(const uint4*)(_kg + (tid + 1024) * 16); \
        vr0 = *(const uint4*)(_vg + tid * 16); vr1 = *(const uint4*)(_vg + (tid + 512) * 16); } while (0)
#define ASTORE(KB, VB) do { char* _kd = (KB); char* _vd = (VB); *(uint4*)(_kd + koff0) = kr0; *(uint4*)(_kd + koff1) = kr1; if (KLD > 2) *(uint4*)(_kd + koff2) = kr2; \
        *(uint4*)(_vd + voff0) = vr0; *(uint4*)(_vd + voff1) = vr1; } while (0)
    AGLOAD(kt_lo);
    ASTORE(Kl, Vl);
    { const int k1 = kt_lo + 1 < kt_hi ? kt_lo + 1 : kt_lo; AGLOAD(k1); }
    __syncthreads();
    for (int kt = kt_lo; kt < kt_hi; ++kt) {
        const int cur = (kt - kt_lo) & 1;
        ASTORE(Kl + (cur ^ 1) * KBUF, Vl + (cur ^ 1) * VBUF);
        { const int ktn = kt + 2 < kt_hi ? kt + 2 : kt_hi - 1; AGLOAD(ktn); }
        __builtin_amdgcn_sched_barrier(0);
#pragma unroll
        for (int sub = 0; sub < 2; ++sub) {
            const char* kb = Kl + cur * KBUF + sub * 64 * KS;
            const float mi = (m < -1e29f) ? 0.f : m;
            f32x16 s0, s1;
#pragma unroll
            for (int i = 0; i < 16; ++i) { s0[i] = -mi; s1[i] = -mi; }
#pragma unroll
            for (int ks = 0; ks < DK / 16; ++ks) {
                bf16x8 k0 = *(const bf16x8*)(kb + r32 * KS + (ks * 2 + hh) * 16);
                bf16x8 k1 = *(const bf16x8*)(kb + (32 + r32) * KS + (ks * 2 + hh) * 16);
                s0 = __builtin_amdgcn_mfma_f32_32x32x16_bf16(k0, qf[ks], s0, 0, 0, 0);
                s1 = __builtin_amdgcn_mfma_f32_32x32x16_bf16(k1, qf[ks], s1, 0, 0, 0);
            }
            if (WINDOW) {
                const int kb0 = kt * 128 + sub * 64 + 4 * hh - qpos;
#pragma unroll
                for (int i = 0; i < 16; ++i) {
                    const int d0 = kb0 + (i & 3) + 8 * (i >> 2), d1 = d0 + 32;
                    s0[i] = (d0 > 128 || d0 < -128) ? -1e30f : s0[i];
                    s1[i] = (d1 > 128 || d1 < -128) ? -1e30f : s1[i];
                }
            }
            const int vbase = (int)(size_t)(Vl + cur * VBUF - lds) + sub * 64 * VS_BYTES + vlane;
            PV_LOAD(0, vbase, vfa);
            PV_LOAD(1, vbase, vfb);
            __builtin_amdgcn_sched_barrier(0);
            float tmax = s0[0];
#pragma unroll
            for (int i = 1; i < 16; ++i) tmax = fmaxf(tmax, s0[i]);
#pragma unroll
            for (int i = 0; i < 16; ++i) tmax = fmaxf(tmax, s1[i]);
            tmax = xhalf_max(tmax);
            float ps = 0.f;
            if (__all(m > -1e29f && tmax <= 8.f)) {
#pragma unroll
                for (int i = 0; i < 16; ++i) { s0[i] = __builtin_amdgcn_exp2f(s0[i]); ps += s0[i]; }
#pragma unroll
                for (int i = 0; i < 16; ++i) { s1[i] = __builtin_amdgcn_exp2f(s1[i]); ps += s1[i]; }
                l += ps;
            } else {
                const float mn = fmaxf(m, mi + tmax);
                const float d = mn - mi;
                const float alpha = __builtin_amdgcn_exp2f(m - mn);
                m = mn;
#pragma unroll
                for (int i = 0; i < 16; ++i) { s0[i] = __builtin_amdgcn_exp2f(s0[i] - d); ps += s0[i]; }
#pragma unroll
                for (int i = 0; i < 16; ++i) { s1[i] = __builtin_amdgcn_exp2f(s1[i] - d); ps += s1[i]; }
                l = l * alpha + ps;
#pragma unroll
                for (int dd = 0; dd < 2; ++dd)
#pragma unroll
                    for (int i = 0; i < 16; ++i) o[dd][i] *= alpha;
            }
            asm volatile("s_waitcnt lgkmcnt(0)" ::: "memory");
            __builtin_amdgcn_sched_barrier(0);
            PV_MMA(o, s0, vfa);
            PV_MMA(o, s1, vfb);
        }
        __syncthreads();
    }
#undef AGLOAD
#undef ASTORE
    l = xhalf_sum(l);
    const float inv = 1.f / l;
    bf16_t* orow = O + (size_t)(b * SEQ + qpos) * DM + ocol + head * 64;
#pragma unroll
    for (int d = 0; d < 2; ++d)
#pragma unroll
        for (int gq = 0; gq < 4; ++gq) {
            uint2 w;
            w.x = cvtpk(o[d][gq * 4 + 0] * inv, o[d][gq * 4 + 1] * inv);
            w.y = cvtpk(o[d][gq * 4 + 2] * inv, o[d][gq * 4 + 3] * inv);
            *(uint2*)(orow + d * 32 + 8 * gq + 4 * hh) = w;
        }
}

__device__ __forceinline__ void dil_wave_item(const bf16_t* __restrict__ Q, const bf16_t* __restrict__ K, const bf16_t* __restrict__ V,
                                              bf16_t* __restrict__ O, int witem, char* wlds, int lds_off) {
    const int lane = tid_opaque() & 63, r32 = lane & 31, hh = lane >> 5;
    const int c = witem & 15, chunk = (witem >> 4) & 15, kvh = (witem >> 8) & 1, b = witem >> 9;
    const int t0 = chunk * 256;
    const int mq = r32 & 15, g = r32 >> 4;
    const int qpos = t0 + 16 * mq + c, head = kvh * 2 + g;
    bf16x8 qf[4];
    {
        const bf16_t* qp = Q + ((size_t)(b * 4 + head) * SEQ + qpos) * 64 + hh * 8;
#pragma unroll
        for (int ks = 0; ks < 4; ++ks) qf[ks] = *(const bf16x8*)(qp + ks * 16);
    }
    const bf16_t* Kg = K + (size_t)(b * 2 + kvh) * SEQ * 64;
    const bf16_t* Vg = V + (size_t)(b * 2 + kvh) * SEQ * 64;
    f32x16 o[2];
#pragma unroll
    for (int d = 0; d < 2; ++d)
#pragma unroll
        for (int i = 0; i < 16; ++i) o[d][i] = 0.f;
    float m = -1e30f, l = 0.f;
    const int gg = lane >> 4, li = lane & 15;
    const int vlane = lds_off + (4 * (gg >> 1) + (li >> 2)) * VS_BYTES + (16 * (gg & 1) + 4 * (li & 3)) * 2;
    for (int it = 0; it < 23; ++it) {
        int sh, j;
        if (it < 12) { sh = 0; j = it; } else if (it < 18) { sh = 2; j = it - 12; } else { sh = 4; j = it - 18; }
        const int rr = 1 << sh;
        const int cc = c & (rr - 1);
        const int idx0 = (t0 >> sh) - 64 + 32 * j;
        const int lim = SEQ >> sh;
        if (idx0 + 31 < 0 || idx0 >= lim) continue;
        bf16x8 kf[4];
        {
            int idx = idx0 + r32; idx = idx < 0 ? 0 : (idx >= lim ? lim - 1 : idx);
            const bf16_t* kp = Kg + (size_t)((idx << sh) + cc) * 64 + hh * 8;
#pragma unroll
            for (int ks = 0; ks < 4; ++ks) kf[ks] = *(const bf16x8*)(kp + ks * 16);
        }
        uint4 vr[4];
#pragma unroll
        for (int jj = 0; jj < 4; ++jj) {
            const int id = lane + 64 * jj; int idx = idx0 + (id >> 3); idx = idx < 0 ? 0 : (idx >= lim ? lim - 1 : idx);
            vr[jj] = *(const uint4*)(Vg + (size_t)((idx << sh) + cc) * 64 + (id & 7) * 8);
        }
#pragma unroll
        for (int jj = 0; jj < 4; ++jj) { const int id = lane + 64 * jj; *(uint4*)(wlds + (id >> 3) * VS_BYTES + (id & 7) * 16) = vr[jj]; }
        f32x16 s;
#pragma unroll
        for (int i = 0; i < 16; ++i) s[i] = 0.f;
#pragma unroll
        for (int ks = 0; ks < 4; ++ks) s = __builtin_amdgcn_mfma_f32_32x32x16_bf16(kf[ks], qf[ks], s, 0, 0, 0);
        const int qidx = qpos >> sh;
        const int base = idx0 + 4 * hh;
#pragma unroll
        for (int i = 0; i < 16; ++i) {
            const int idx = base + (i & 3) + 8 * (i >> 2);
            const int d = idx - qidx;
            s[i] = (d > 64 || d < -64 || idx < 0 || idx >= lim) ? -1e30f : s[i];
        }
        float tmax = s[0];
#pragma unroll
        for (int i = 1; i < 16; ++i) tmax = fmaxf(tmax, s[i]);
        tmax = fmaxf(tmax, xhalf(tmax));
        const float mn = fmaxf(fmaxf(m, tmax), -1e20f);
        const float alpha = __builtin_amdgcn_exp2f(m - mn);
        m = mn;
        float ps = 0.f;
#pragma unroll
        for (int i = 0; i < 16; ++i) { s[i] = __builtin_amdgcn_exp2f(s[i] - mn); ps += s[i]; }
        l = l * alpha + ps;
#pragma unroll
        for (int d = 0; d < 2; ++d)
#pragma unroll
            for (int i = 0; i < 16; ++i) o[d][i] *= alpha;
        pv_sub<0>(o, s, vlane);
    }
    l += xhalf(l);
    const float inv = 1.f / l;
    bf16_t* orow = O + (size_t)(b * SEQ + qpos) * DM + 512 + head * 64;
#pragma unroll
    for (int d = 0; d < 2; ++d)
#pragma unroll
        for (int gq = 0; gq < 4; ++gq) {
            uint2 w;
            w.x = cvtpk(o[d][gq * 4 + 0] * inv, o[d][gq * 4 + 1] * inv);
            w.y = cvtpk(o[d][gq * 4 + 2] * inv, o[d][gq * 4 + 3] * inv);
            *(uint2*)(orow + d * 32 + 8 * gq + 4 * hh) = w;
        }
}

__device__ __forceinline__ int f2key(float f) { int b = __float_as_int(f); return b ^ ((b >> 31) & 0x7fffffff); }
__device__ __forceinline__ float key2f(int k) { return __int_as_float(k ^ ((k >> 31) & 0x7fffffff)); }

template <int N>
__device__ __forceinline__ void bitonic_sort_desc(int (&a)[N]) {
#pragma unroll
    for (int k = 2; k <= N; k <<= 1) {
#pragma unroll
        for (int j = k >> 1; j > 0; j >>= 1) {
#pragma unroll
            for (int i = 0; i < N; ++i) {
                const int l2 = i ^ j;
                if (l2 > i) {
                    const bool up = ((i & k) == 0);
                    const int hi = max(a[i], a[l2]), lo = min(a[i], a[l2]);
                    a[i] = up ? hi : lo; a[l2] = up ? lo : hi;
                }
            }
        }
    }
}
__device__ __forceinline__ void merge_top16(int (&a)[16], const int (&b)[16]) {
#pragma unroll
    for (int i = 0; i < 16; ++i) a[i] = max(a[i], b[15 - i]);
#pragma unroll
    for (int j = 8; j > 0; j >>= 1) {
#pragma unroll
        for (int i = 0; i < 16; ++i) {
            const int l2 = i ^ j;
            if (l2 > i) { const int hi = max(a[i], a[l2]), lo = min(a[i], a[l2]); a[i] = hi; a[l2] = lo; }
        }
    }
}
__device__ __forceinline__ void top16_of_64(int (&g0)[16], int (&g1)[16], int (&g2)[16], int (&g3)[16]) {
    bitonic_sort_desc<16>(g0); bitonic_sort_desc<16>(g1); bitonic_sort_desc<16>(g2); bitonic_sort_desc<16>(g3);
    merge_top16(g0, g1); merge_top16(g2, g3); merge_top16(g0, g2);
}

__device__ __forceinline__ void topk_core(const bf16_t* q0, const bf16_t* __restrict__ subk_h, float rscale, int* eo, float* go, char* wlds) {
    const int lane = tid_opaque() & 63, r32 = lane & 31, hh = lane >> 5;
    int top[2][16];
#pragma unroll
    for (int c = 0; c < 2; ++c) {
        bf16x8 qf[8];
        const bf16_t* qrow = q0 + c * 128;
#pragma unroll
        for (int ks = 0; ks < 8; ++ks) qf[ks] = *(const bf16x8*)(qrow + ks * 16);
        const bf16_t* kb = subk_h + ((size_t)c * 128 + r32) * 128 + hh * 8;
        int grp[4][16];
#pragma unroll
        for (int kt = 0; kt < 4; ++kt) {
            f32x16 s;
#pragma unroll
            for (int i = 0; i < 16; ++i) s[i] = 0.f;
#pragma unroll
            for (int ks = 0; ks < 8; ++ks) {
                bf16x8 kf = *(const bf16x8*)(kb + (size_t)kt * 32 * 128 + ks * 16);
                s = __builtin_amdgcn_mfma_f32_32x32x16_bf16(kf, qf[ks], s, 0, 0, 0);
            }
#pragma unroll
            for (int i = 0; i < 16; ++i) grp[kt][i] = (f2key(s[i]) & ~127) | (kt * 32 + crow(i, hh));
        }
        top16_of_64(grp[0], grp[1], grp[2], grp[3]);
        int oth[16];
#pragma unroll
        for (int i = 0; i < 16; ++i) oth[i] = __shfl_xor(grp[0][i], 32);
        merge_top16(grp[0], oth);
#pragma unroll
        for (int i = 0; i < 16; ++i) top[c][i] = grp[0][i];
    }
    {
        unsigned* my = (unsigned*)(wlds + lane * 36);
#pragma unroll
        for (int c = 0; c < 2; ++c)
#pragma unroll
            for (int w4 = 0; w4 < 4; ++w4) {
                unsigned v = (top[c][w4 * 4] & 127) | ((top[c][w4 * 4 + 1] & 127) << 8) | ((top[c][w4 * 4 + 2] & 127) << 16) | ((top[c][w4 * 4 + 3] & 127) << 24);
                my[c * 4 + w4] = v;
            }
    }
    float v1[16], v2[16];
#pragma unroll
    for (int i = 0; i < 16; ++i) { v1[i] = key2f(top[0][i] & ~127); v2[i] = key2f(top[1][i] & ~127); }
    int cg[4][16];
    {
        int n = 0;
#pragma unroll
        for (int i = 0; i < 16; ++i)
#pragma unroll
            for (int j = 0; j < 16; ++j)
                if ((i + 1) * (j + 1) <= 16) { cg[n >> 4][n & 15] = (f2key(v1[i] + v2[j]) & ~255) | (i * 16 + j); ++n; }
#pragma unroll
        for (int q = 50; q < 64; ++q) cg[q >> 4][q & 15] = (int)0x80000000;
    }
    top16_of_64(cg[0], cg[1], cg[2], cg[3]);
    float bv[16];
#pragma unroll
    for (int i = 0; i < 16; ++i) bv[i] = key2f(cg[0][i] & ~255) * rscale;
    float sm = 0.f;
    const float bmx = bv[0];
#pragma unroll
    for (int i = 0; i < 16; ++i) { bv[i] = __expf(bv[i] - bmx); sm += bv[i]; }
    const float inv = 1.f / sm;
    if (hh == 0) {
        const unsigned char* my = (const unsigned char*)(wlds + lane * 36);
#pragma unroll
        for (int q4 = 0; q4 < 4; ++q4) {
            int4 ev; float4 gv;
            int* evp = (int*)&ev; float* gvp = (float*)&gv;
#pragma unroll
            for (int u = 0; u < 4; ++u) {
                const int code = cg[0][q4 * 4 + u] & 255;
                const int i1 = my[code >> 4], i2 = my[16 + (code & 15)];
                evp[u] = i1 * 128 + i2; gvp[u] = bv[q4 * 4 + u] * inv;
            }
            *(int4*)(eo + q4 * 4) = ev; *(float4*)(go + q4 * 4) = gv;
        }
    }
}

__device__ __forceinline__ void topk_wave_item(const bf16_t* __restrict__ qp, const bf16_t* __restrict__ subk, int* __restrict__ eidx, float* __restrict__ gate, int witem, char* wlds) {
    const int lane = tid_opaque() & 63, r32 = lane & 31, hh = lane >> 5;
    const int h = witem & 7, t = (witem >> 3) * 32 + r32;
    topk_core(qp + (size_t)t * 2048 + h * 256 + hh * 8, subk + (size_t)h * 2 * 128 * 128, 1.f, eidx + ((size_t)h * T_TOK + t) * 16, gate + ((size_t)h * T_TOK + t) * 16, wlds);
}
__device__ __forceinline__ void gemm_tile_topk(const bf16_t* __restrict__ X, int ldx, const bf16_t* __restrict__ W, int ldw, int K, int m0, int h, char* lds,
                                               const bf16_t* __restrict__ subk, const float* __restrict__ ssq, int* __restrict__ eidx, float* __restrict__ gate) {
    const int tid = tid_opaque(), lane = tid & 63, wave = tid >> 6;
    const int wm = wave >> 1, wn = wave & 1;
    const int r32 = lane & 31, hh = lane >> 5;
    {
        f32x16 acc[2][4];
        gemm_mainloop(X, ldx, W, ldw, K, m0, h * 256, 2048, lds, acc);
        bf16_t* qst = (bf16_t*)lds;
#pragma unroll
        for (int mt = 0; mt < 2; ++mt)
#pragma unroll
            for (int nt = 0; nt < 4; ++nt)
#pragma unroll
                for (int i = 0; i < 16; ++i)
                    qst[(wm * 64 + mt * 32 + crow(i, hh)) * QST + wn * 128 + nt * 32 + r32] = f2bf(acc[mt][nt][i]);
    }
    __syncthreads();
    {
        const int tok = wave * 32 + r32, t = m0 + tok;
        float tot = 0.f;
#pragma unroll
        for (int j = 0; j < 4; ++j) { const float4 q = *(const float4*)(ssq + ((size_t)j * T_TOK + t) * 4); tot += (q.x + q.y) + (q.z + q.w); }
        const float r = rsqrtf(tot * (1.f / DM) + 1e-6f);
        topk_core((const bf16_t*)lds + tok * QST + hh * 8, subk + (size_t)h * 2 * 128 * 128, r, eidx + ((size_t)h * T_TOK + t) * 16, gate + ((size_t)h * T_TOK + t) * 16,
                  lds + TOPK_STASH + wave * 2304);
    }
    __syncthreads();
}

typedef __attribute__((ext_vector_type(2))) float f32x2;
__device__ __forceinline__ float fdot2bf(unsigned a, unsigned b, float acc) {
    return __builtin_amdgcn_fdot2_f32_bf16(*(bf16x2_t*)&a, *(bf16x2_t*)&b, acc, false);
}
__device__ __forceinline__ unsigned fp8pair_to_bf16(unsigned w, bool hi) {
    bf16x2_t r = hi ? __builtin_amdgcn_cvt_scalef32_pk_bf16_fp8((int)w, 1.0f, true) : __builtin_amdgcn_cvt_scalef32_pk_bf16_fp8((int)w, 1.0f, false);
    return *(unsigned*)&r;
}
__device__ __forceinline__ float dot16_fp8(uint4 u, const unsigned (&h)[8]) {
    float a = 0.f;
    a = fdot2bf(fp8pair_to_bf16(u.x, false), h[0], a); a = fdot2bf(fp8pair_to_bf16(u.x, true), h[1], a);
    a = fdot2bf(fp8pair_to_bf16(u.y, false), h[2], a); a = fdot2bf(fp8pair_to_bf16(u.y, true), h[3], a);
    a = fdot2bf(fp8pair_to_bf16(u.z, false), h[4], a); a = fdot2bf(fp8pair_to_bf16(u.z, true), h[5], a);
    a = fdot2bf(fp8pair_to_bf16(u.w, false), h[6], a); a = fdot2bf(fp8pair_to_bf16(u.w, true), h[7], a);
    return a;
}
__device__ __forceinline__ void axpy16_fp8(float (&acc)[16], float w, uint4 v) {
    f32x2 r;
    r = __builtin_amdgcn_cvt_pk_f32_fp8((int)v.x, false); acc[0] += w * r[0]; acc[1] += w * r[1];
    r = __builtin_amdgcn_cvt_pk_f32_fp8((int)v.x, true);  acc[2] += w * r[0]; acc[3] += w * r[1];
    r = __builtin_amdgcn_cvt_pk_f32_fp8((int)v.y, false); acc[4] += w * r[0]; acc[5] += w * r[1];
    r = __builtin_amdgcn_cvt_pk_f32_fp8((int)v.y, true);  acc[6] += w * r[0]; acc[7] += w * r[1];
    r = __builtin_amdgcn_cvt_pk_f32_fp8((int)v.z, false); acc[8] += w * r[0]; acc[9] += w * r[1];
    r = __builtin_amdgcn_cvt_pk_f32_fp8((int)v.z, true);  acc[10] += w * r[0]; acc[11] += w * r[1];
    r = __builtin_amdgcn_cvt_pk_f32_fp8((int)v.w, false); acc[12] += w * r[0]; acc[13] += w * r[1];
    r = __builtin_amdgcn_cvt_pk_f32_fp8((int)v.w, true);  acc[14] += w * r[0]; acc[15] += w * r[1];
}
__device__ __forceinline__ float gelu_exact(float a) { return 0.5f * a * (1.f + erff(a * 0.70710678118654752f)); }

__device__ __forceinline__ float transpose_reduce16(f32x16 p, int lane) {
#pragma unroll
    for (int st = 0; st < 4; ++st) {
        const int o = 32 >> st, n = 16 >> st;
        const bool up = (lane & o) != 0;
#pragma unroll
        for (int i = 0; i < n / 2; ++i) {
            float lo = p[i], hi = p[i + n / 2];
            asm volatile("" : "+v"(lo), "+v"(hi));
            const float keep = up ? hi : lo;
            const float send = up ? lo : hi;
            p[i] = keep + __shfl_xor(send, o);
        }
    }
    float v = p[0];
    v += __shfl_xor(v, 1); v += __shfl_xor(v, 2);
    return v;
}
#define EX_SB() __builtin_amdgcn_sched_barrier(0)
#define EX_LD1(R, TAB, EB, S) R = *(const uint4*)((TAB) + (unsigned)((__builtin_amdgcn_readlane((EB), (S)) << 10) + lane16))
#define EX_LOAD8(P, TAB, EB, SL) do { EX_LD1(P##0, TAB, EB, (SL) + 0); EX_LD1(P##1, TAB, EB, (SL) + 1); EX_LD1(P##2, TAB, EB, (SL) + 2); EX_LD1(P##3, TAB, EB, (SL) + 3); \
        EX_LD1(P##4, TAB, EB, (SL) + 4); EX_LD1(P##5, TAB, EB, (SL) + 5); EX_LD1(P##6, TAB, EB, (SL) + 6); EX_LD1(P##7, TAB, EB, (SL) + 7); } while (0)
#define EX_DOT8(P, PP, O) do { PP[(O) + 0] = dot16_fp8(P##0, hp); PP[(O) + 1] = dot16_fp8(P##1, hp); PP[(O) + 2] = dot16_fp8(P##2, hp); PP[(O) + 3] = dot16_fp8(P##3, hp); \
        PP[(O) + 4] = dot16_fp8(P##4, hp); PP[(O) + 5] = dot16_fp8(P##5, hp); PP[(O) + 6] = dot16_fp8(P##6, hp); PP[(O) + 7] = dot16_fp8(P##7, hp); } while (0)
#define EX_RL(W, S) __int_as_float(__builtin_amdgcn_readlane(__float_as_int(W), (S)))
#define EX_AXPY8(P, W, SL) do { axpy16_fp8(acc, EX_RL(W, (SL) + 0), P##0); axpy16_fp8(acc, EX_RL(W, (SL) + 1), P##1); axpy16_fp8(acc, EX_RL(W, (SL) + 2), P##2); axpy16_fp8(acc, EX_RL(W, (SL) + 3), P##3); \
        axpy16_fp8(acc, EX_RL(W, (SL) + 4), P##4); axpy16_fp8(acc, EX_RL(W, (SL) + 5), P##5); axpy16_fp8(acc, EX_RL(W, (SL) + 6), P##6); axpy16_fp8(acc, EX_RL(W, (SL) + 7), P##7); } while (0)
#define EX_COPY8(D, S_) do { D##0 = S_##0; D##1 = S_##1; D##2 = S_##2; D##3 = S_##3; D##4 = S_##4; D##5 = S_##5; D##6 = S_##6; D##7 = S_##7; } while (0)

__device__ __forceinline__ void expert_token(PC& p, int layer, int t, bool last, bool dummy = false) {
    const int lane = tid_opaque() & 63;
    const int lane16 = lane * 16;
    const float* gfb = p.g_ffn + layer * DM; asm volatile("" : "+s"(gfb));
    const float* gf = gfb + lane * 16;
    float* xrow = p.x + (size_t)t * DM + lane * 16;
    float* xwr = dummy ? (float*)p.zb + (size_t)t * DM + lane * 16 : xrow;
    bf16_t* hwr = (dummy ? p.q.qA + (size_t)t * DM : p.hnb + (size_t)t * DM) + lane * 16;
    float xv[16];
#pragma unroll
    for (int q = 0; q < 4; ++q) { const float4 a = *(const float4*)(xrow + 4 * q); xv[4 * q] = a.x; xv[4 * q + 1] = a.y; xv[4 * q + 2] = a.z; xv[4 * q + 3] = a.w; }
    float ss = 0.f;
#pragma unroll
    for (int i = 0; i < 16; ++i) ss += xv[i] * xv[i];
    ss = wave_sum(ss);
    const float rstd = rsqrtf(ss * (1.f / DM) + 1e-6f);
    unsigned hp[8];
#pragma unroll
    for (int q = 0; q < 4; ++q) {
        const float4 g = *(const float4*)(gf + 4 * q);
        hp[2 * q] = cvtpk(xv[4 * q] * rstd * g.x, xv[4 * q + 1] * rstd * g.y);
        hp[2 * q + 1] = cvtpk(xv[4 * q + 2] * rstd * g.z, xv[4 * q + 3] * rstd * g.w);
    }
    const size_t ei0 = ((size_t)(lane >> 4) * T_TOK + t) * 16 + (lane & 15), ei1 = ei0 + (size_t)4 * T_TOK * 16;
    const int e0 = p.eidx[ei0], e1 = p.eidx[ei1];
    const float g0 = p.gate[ei0], g1 = p.gate[ei1];
    const unsigned char* u8 = p.u8 + (size_t)layer * 16384 * DM;
    const unsigned char* v8 = p.v8 + (size_t)layer * 16384 * DM;
    const float* su = p.su + layer * 16384; const float* sv = p.sv + layer * 16384;
    const float su0 = su[e0], su1 = su[e1], sv0 = sv[e0], sv1 = sv[e1];
    uint4 rx0, rx1, rx2, rx3, rx4, rx5, rx6, rx7, ry0, ry1, ry2, ry3, ry4, ry5, ry6, ry7;
    float a0 = 0.f, a1 = 0.f;
    EX_LOAD8(rx, u8, e0, 0);
#pragma unroll 1
    for (int g = 0; g < 8; ++g) {
        const int eb = g < 4 ? e0 : e1;
        const int sl = (g & 3) * 16;
        f32x16 pp;
        EX_LOAD8(ry, u8, eb, sl + 8);
        EX_SB();
        EX_DOT8(rx, pp, 0);
        EX_SB();
        {
            const int gn = g + 1 < 8 ? g + 1 : 0;
            const int ebn = gn < 4 ? e0 : e1;
            const unsigned char* tabn = g + 1 < 8 ? u8 : v8;
            EX_LOAD8(rx, tabn, ebn, (gn & 3) * 16);
        }
        EX_SB();
        EX_DOT8(ry, pp, 8);
        const float v = transpose_reduce16(pp, lane);
        const float got = __shfl(v, (lane & 15) << 2);
        const bool mine = (lane >> 4) == (g & 3);
        a0 = (mine && g < 4) ? got : a0;
        a1 = (mine && g >= 4) ? got : a1;
        EX_SB();
    }
    const float w0 = g0 * gelu_exact(su0 * a0) * sv0;
    const float w1 = g1 * gelu_exact(su1 * a1) * sv1;
    float acc[16];
#pragma unroll
    for (int i = 0; i < 16; ++i) acc[i] = 0.f;
#pragma unroll 1
    for (int h2 = 0; h2 < 8; ++h2) {
        const int ebc = h2 < 4 ? e0 : e1;
        const float wb = h2 < 4 ? w0 : w1;
        const int slc = (h2 & 3) * 16;
        EX_LOAD8(ry, v8, ebc, slc + 8);
        EX_SB();
        EX_AXPY8(rx, wb, slc);
        EX_SB();
        {
            const int hn_ = h2 + 1 < 8 ? h2 + 1 : 7;
            const int ebn = hn_ < 4 ? e0 : e1;
            EX_LOAD8(rx, v8, ebn, (hn_ & 3) * 16);
        }
        EX_SB();
        EX_AXPY8(ry, wb, slc + 8);
        EX_SB();
    }
#pragma unroll
    for (int i = 0; i < 16; ++i) xv[i] += acc[i];
    float s2 = 0.f;
#pragma unroll
    for (int i = 0; i < 16; ++i) s2 += xv[i] * xv[i];
    s2 = wave_sum(s2);
    const float r2 = rsqrtf(s2 * (1.f / DM) + 1e-6f);
    if (!last) {
#pragma unroll
        for (int q = 0; q < 4; ++q) *(float4*)(xwr + 4 * q) = make_float4(xv[4 * q], xv[4 * q + 1], xv[4 * q + 2], xv[4 * q + 3]);
        const float* gnb = p.g_mix + (layer + 1) * DM; asm volatile("" : "+s"(gnb));
        const float* gn = gnb + lane * 16;
        unsigned hw[8];
#pragma unroll
        for (int q = 0; q < 4; ++q) {
            const float4 g = *(const float4*)(gn + 4 * q);
            hw[2 * q] = cvtpk(xv[4 * q] * r2 * g.x, xv[4 * q + 1] * r2 * g.y);
            hw[2 * q + 1] = cvtpk(xv[4 * q + 2] * r2 * g.z, xv[4 * q + 3] * r2 * g.w);
        }
        *(uint4*)(hwr) = make_uint4(hw[0], hw[1], hw[2], hw[3]);
        *(uint4*)(hwr + 8) = make_uint4(hw[4], hw[5], hw[6], hw[7]);
    } else {
        const float* gnb = p.g_final; asm volatile("" : "+s"(gnb));
        const float* gn = gnb + lane * 16;
        float* orow = dummy ? xwr : p.out + (size_t)t * DM + lane * 16;
#pragma unroll
        for (int q = 0; q < 4; ++q) {
            const float4 g = *(const float4*)(gn + 4 * q);
            *(float4*)(orow + 4 * q) = make_float4(xv[4 * q] * r2 * g.x, xv[4 * q + 1] * r2 * g.y, xv[4 * q + 2] * r2 * g.z, xv[4 * q + 3] * r2 * g.w);
        }
    }
}
__device__ __forceinline__ void transpose_tile(const float* __restrict__ src, int K, int N, bf16_t* __restrict__ dst, int tk, int tn, float* tl, const float* __restrict__ ksc, int perm) {
    const int tid = tid_opaque(), r = tid >> 6, c = tid & 63;
    const int k0 = tk * 64, n0 = tn * 64;
#pragma unroll
    for (int i = 0; i < 8; ++i) {
        const int kk = i * 8 + r, n = n0 + c;
        tl[kk * 65 + c] = (n < N) ? src[(size_t)(k0 + kk) * N + n] : 0.f;
    }
    __syncthreads();
#pragma unroll
    for (int i = 0; i < 8; ++i) {
        const int nn = i * 8 + r;
        if (n0 + nn < N) {
            int nd = n0 + nn;
            if (perm) { const int hq = nd / 96, wq = nd % 96; nd = wq < 64 ? hq * 64 + wq : 256 + hq * 32 + (wq - 64); }
            dst[(size_t)nd * K + k0 + c] = f2bf(tl[c * 65 + nn] * (ksc ? ksc[k0 + c] : 1.f));
        }
    }
    __syncthreads();
}
__device__ __forceinline__ void transpose_all(const float* src, int K, int N, bf16_t* dst, float* tl, const float* ksc = nullptr, int perm = 0) {
    const int ntk = K / 64, ntn = (N + 63) / 64;
    for (int t = blockIdx.x; t < ntk * ntn; t += gridDim.x) transpose_tile(src, K, N, dst, t / ntn, t % ntn, tl, ksc, perm);
}
__device__ __forceinline__ void convert_plain(const float* __restrict__ src, bf16_t* __restrict__ dst, size_t n) {
    const size_t n8 = n >> 3;
    for (size_t i = (size_t)blockIdx.x * blockDim.x + tid_opaque(); i < n8; i += (size_t)gridDim.x * blockDim.x) {
        const float4 a = *(const float4*)(src + i * 8), b = *(const float4*)(src + i * 8 + 4);
        uint4 w; w.x = cvtpk(a.x, a.y); w.y = cvtpk(a.z, a.w); w.z = cvtpk(b.x, b.y); w.w = cvtpk(b.z, b.w);
        *(uint4*)(dst + i * 8) = w;
    }
}
__device__ __forceinline__ void convert_rows_fp8(const float* __restrict__ src, unsigned char* __restrict__ dst, float* __restrict__ scales, int nrows) {
    const int tid = tid_opaque(), wave = tid >> 6, lane = tid & 63;
    for (int row = blockIdx.x * NW + wave; row < nrows; row += gridDim.x * NW) {
        const float* sr = src + (size_t)row * DM + lane * 16;
        float xv[16];
#pragma unroll
        for (int q = 0; q < 4; ++q) { const float4 a = *(const float4*)(sr + 4 * q); xv[4 * q] = a.x; xv[4 * q + 1] = a.y; xv[4 * q + 2] = a.z; xv[4 * q + 3] = a.w; }
        float am = 0.f;
#pragma unroll
        for (int i = 0; i < 16; ++i) am = fmaxf(am, fabsf(xv[i]));
        am = wave_max(am);
        const float sc = am > 0.f ? am * (1.f / 448.f) : 1.f;
        const float inv = 1.f / sc;
        unsigned w[4];
#pragma unroll
        for (int q = 0; q < 4; ++q) {
            int t = 0;
            t = __builtin_amdgcn_cvt_pk_fp8_f32(xv[4 * q] * inv, xv[4 * q + 1] * inv, t, false);
            t = __builtin_amdgcn_cvt_pk_fp8_f32(xv[4 * q + 2] * inv, xv[4 * q + 3] * inv, t, true);
            w[q] = (unsigned)t;
        }
        *(uint4*)(dst + (size_t)row * DM + lane * 16) = make_uint4(w[0], w[1], w[2], w[3]);
        if (lane == 0) scales[row] = sc;
    }
}
__device__ __forceinline__ void rms_row_bf16(const float* __restrict__ src, const float* __restrict__ g, bf16_t* __restrict__ dst, float* __restrict__ cpy, int lane) {
    float xv[16];
    const float4 a0 = *(const float4*)(src + lane * 8), a1 = *(const float4*)(src + lane * 8 + 4);
    const float4 b0 = *(const float4*)(src + 512 + lane * 8), b1 = *(const float4*)(src + 512 + lane * 8 + 4);
    xv[0] = a0.x; xv[1] = a0.y; xv[2] = a0.z; xv[3] = a0.w; xv[4] = a1.x; xv[5] = a1.y; xv[6] = a1.z; xv[7] = a1.w;
    xv[8] = b0.x; xv[9] = b0.y; xv[10] = b0.z; xv[11] = b0.w; xv[12] = b1.x; xv[13] = b1.y; xv[14] = b1.z; xv[15] = b1.w;
    if (cpy) {
        *(float4*)(cpy + lane * 8) = a0; *(float4*)(cpy + lane * 8 + 4) = a1;
        *(float4*)(cpy + 512 + lane * 8) = b0; *(float4*)(cpy + 512 + lane * 8 + 4) = b1;
    }
    float ss = 0.f;
#pragma unroll
    for (int i = 0; i < 16; ++i) ss += xv[i] * xv[i];
    ss = wave_sum(ss);
    const float r = rsqrtf(ss * (1.f / DM) + 1e-6f);
    const float4 g0 = *(const float4*)(g + lane * 8), g1 = *(const float4*)(g + lane * 8 + 4);
    const float4 g2 = *(const float4*)(g + 512 + lane * 8), g3 = *(const float4*)(g + 512 + lane * 8 + 4);
    uint4 wa, wb;
    wa.x = cvtpk(xv[0] * r * g0.x, xv[1] * r * g0.y); wa.y = cvtpk(xv[2] * r * g0.z, xv[3] * r * g0.w);
    wa.z = cvtpk(xv[4] * r * g1.x, xv[5] * r * g1.y); wa.w = cvtpk(xv[6] * r * g1.z, xv[7] * r * g1.w);
    wb.x = cvtpk(xv[8] * r * g2.x, xv[9] * r * g2.y); wb.y = cvtpk(xv[10] * r * g2.z, xv[11] * r * g2.w);
    wb.z = cvtpk(xv[12] * r * g3.x, xv[13] * r * g3.y); wb.w = cvtpk(xv[14] * r * g3.z, xv[15] * r * g3.w);
    *(uint4*)(dst + lane * 8) = wa; *(uint4*)(dst + 512 + lane * 8) = wb;
}

__device__ __forceinline__ void rms_row2_bf16(const float* __restrict__ s0, const float* __restrict__ s1, const float* __restrict__ g, bf16_t* __restrict__ d0, bf16_t* __restrict__ d1, int lane) {
    float4 a[4], b[4];
#pragma unroll
    for (int q = 0; q < 4; ++q) { a[q] = *(const float4*)(s0 + (q >> 1) * 512 + lane * 8 + (q & 1) * 4); b[q] = s1 ? *(const float4*)(s1 + (q >> 1) * 512 + lane * 8 + (q & 1) * 4) : make_float4(0.f, 0.f, 0.f, 0.f); }
    float sa = 0.f, sb = 0.f;
#pragma unroll
    for (int q = 0; q < 4; ++q) { sa += a[q].x * a[q].x + a[q].y * a[q].y + a[q].z * a[q].z + a[q].w * a[q].w; sb += b[q].x * b[q].x + b[q].y * b[q].y + b[q].z * b[q].z + b[q].w * b[q].w; }
    sa = wave_sum(sa); sb = wave_sum(sb);
    const float ra = rsqrtf(sa * (1.f / DM) + 1e-6f), rb = rsqrtf(sb * (1.f / DM) + 1e-6f);
    float4 gq[4];
#pragma unroll
    for (int q = 0; q < 4; ++q) gq[q] = *(const float4*)(g + (q >> 1) * 512 + lane * 8 + (q & 1) * 4);
    uint4 w;
    w.x = cvtpk(a[0].x * ra * gq[0].x, a[0].y * ra * gq[0].y); w.y = cvtpk(a[0].z * ra * gq[0].z, a[0].w * ra * gq[0].w);
    w.z = cvtpk(a[1].x * ra * gq[1].x, a[1].y * ra * gq[1].y); w.w = cvtpk(a[1].z * ra * gq[1].z, a[1].w * ra * gq[1].w);
    *(uint4*)(d0 + lane * 8) = w;
    w.x = cvtpk(a[2].x * ra * gq[2].x, a[2].y * ra * gq[2].y); w.y = cvtpk(a[2].z * ra * gq[2].z, a[2].w * ra * gq[2].w);
    w.z = cvtpk(a[3].x * ra * gq[3].x, a[3].y * ra * gq[3].y); w.w = cvtpk(a[3].z * ra * gq[3].z, a[3].w * ra * gq[3].w);
    *(uint4*)(d0 + 512 + lane * 8) = w;
    if (s1) {
        w.x = cvtpk(b[0].x * rb * gq[0].x, b[0].y * rb * gq[0].y); w.y = cvtpk(b[0].z * rb * gq[0].z, b[0].w * rb * gq[0].w);
        w.z = cvtpk(b[1].x * rb * gq[1].x, b[1].y * rb * gq[1].y); w.w = cvtpk(b[1].z * rb * gq[1].z, b[1].w * rb * gq[1].w);
        *(uint4*)(d1 + lane * 8) = w;
        w.x = cvtpk(b[2].x * rb * gq[2].x, b[2].y * rb * gq[2].y); w.y = cvtpk(b[2].z * rb * gq[2].z, b[2].w * rb * gq[2].w);
        w.z = cvtpk(b[3].x * rb * gq[3].x, b[3].y * rb * gq[3].y); w.w = cvtpk(b[3].z * rb * gq[3].z, b[3].w * rb * gq[3].w);
        *(uint4*)(d1 + 512 + lane * 8) = w;
    }
}

__device__ __forceinline__ void phase_pro(PC& p, char* lds) {
    float* tl = (float*)lds;
    for (int l = 0; l < DEPTH; ++l) {
        transpose_all(p.w_in + (size_t)l * DM * NZ, DM, NZ, p.winT + (size_t)l * NZ * DM, tl);
        transpose_all(p.w_out + (size_t)l * DM * DM, DM, DM, p.woutT + (size_t)l * DM * DM, tl, (p.flags & 16) ? p.g_group + (size_t)l * 1024 : nullptr);
        transpose_all(p.peer_w_q + (size_t)l * DM * 2048, DM, 2048, p.wqT + (size_t)l * 2048 * DM, tl, (p.flags & 4) ? p.g_ffn + l * DM : nullptr);
        transpose_all(p.mla_w_uq + (size_t)l * 256 * 384, 256, 384, p.wuqT + (size_t)l * 384 * 256, tl, (p.flags & 8) ? p.mla_q_norm + l * 256 : nullptr, (p.flags & 32) ? 1 : 0);
        transpose_all(p.mla_w_ukv + (size_t)l * 128 * 512, 128, 512, p.wukvT + (size_t)l * 512 * 128, tl, (p.flags & 8) ? p.mla_kv_norm + l * 128 : nullptr);
    }
    convert_plain(p.peer_sub_keys, p.subk, (size_t)DEPTH * 8 * 2 * 128 * 128);
    if ((p.flags & 3) == 1) {
        convert_rows_fp8(p.peer_u, p.u8, p.su, DEPTH * 16384);
        convert_rows_fp8(p.peer_v, p.v8, p.sv, DEPTH * 16384);
    }
    for (int i = blockIdx.x * blockDim.x + tid_opaque(); i < 4096 * 32; i += gridDim.x * blockDim.x) {
        {
            const int pos = i / 32, j = i % 32;
            const float inv = powf(10000.f, -(float)(2 * j) / 64.f); const float ang = (float)pos * inv;
            p.tb.cos1[i] = cosf(ang); p.tb.sin1[i] = sinf(ang);
        }
        if (i < 4096 * 16) {
            const int pos = i / 16, j = i % 16;
            const float inv = powf(10000.f, -(float)(2 * j) / 32.f); const float ang = (float)pos * inv;
            p.tb.cosm[i] = cosf(ang); p.tb.sinm[i] = sinf(ang);
        }
        if (i < 64 * 16) {
            const int pos = i / 16, j = i % 16;
            const float inv = powf(10000.f, -(float)(2 * j) / 32.f); const float ang = (float)pos * inv;
            p.tb.cosr[i] = cosf(ang); p.tb.sinr[i] = sinf(ang); p.tb.cosc[i] = cosf(ang); p.tb.sinc[i] = sinf(ang);
        }
    }
    const int wave = tid_opaque() >> 6, lane = tid_opaque() & 63;
    for (int t = blockIdx.x * NW + wave; t < T_TOK; t += gridDim.x * NW)
        rms_row_bf16(p.x_in + (size_t)t * DM, p.g_mix, p.hnb + (size_t)t * DM, p.x + (size_t)t * DM, lane);
}

__device__ __forceinline__ void phase_g1(PC& p, int l, char* lds) {
    if (p.flags & 128) {
        RowsPostZ eZ{p.q.qA, p.tb.cos1, p.ax_q_norm + l * 64, p.ax_k_norm + l * 64, p.cqn, p.ssqd, p.q.kD};
        RowsPostQ eQ{p.q.qD, p.tb.cos1, p.ssqd};
        RowsPostKV eKV{p.q.kD, p.q.vD, p.ssqd + (size_t)4 * T_TOK};
        const bf16_t* win = p.winT + (size_t)l * NZ * DM;
        const bf16_t* wuq = p.wuqT + (size_t)l * 384 * 256; const bf16_t* wukv = p.wukvT + (size_t)l * 512 * 128;
        const bool mapped = (gridDim.x & 63) == 0 && (1024 % gridDim.x) == 0;
        for (int tile = blockIdx.x; tile < 1024; tile += gridDim.x) {
            int mt, nt;
            if (mapped) { tile_map(tile, 128, 8, mt, nt); nt = (nt + 2 * (tile / gridDim.x)) & 7; }
            else { mt = tile >> 3; nt = tile & 7; }
            gemm_tile_rows<RowsPostZ, 0>(p.hnb, DM, win, DM, DM, mt * 256, nt * 256, NZ, lds, eZ);
            if (nt >= 6) {
                asm volatile("s_waitcnt vmcnt(0)" ::: "memory");
                __syncthreads();
                if (nt == 6) {
                    gemm_tile_rows<RowsPostQ, 0>(p.cqn, 256, wuq, 256, 256, mt * 256, 0, 384, lds, eQ);
                    gemm_tile_rows<RowsPostQ, 0>(p.cqn, 256, wuq, 256, 256, mt * 256, 256, 384, lds, eQ);
                } else {
                    gemm_tile_rows<RowsPostKV, 0>(p.ckvn, 128, wukv, 128, 128, mt * 256, 0, 512, lds, eKV);
                    gemm_tile_rows<RowsPostKV, 0>(p.ckvn, 128, wukv, 128, 128, mt * 256, 256, 512, lds, eKV);
                }
            }
        }
    } else if (p.flags & 8) {
        RowsPostZ e{p.q.qA, p.tb.cos1, p.ax_q_norm + l * 64, p.ax_k_norm + l * 64, p.cqn, p.ssqd, p.q.kD};
        gemm_phase_rows<RowsPostZ, 0>(p.hnb, DM, p.winT + (size_t)l * NZ * DM, DM, T_TOK, NZ, DM, lds, e);
    } else {
        RowsStoreBf16 e{p.zb, NZ, NZ};
        gemm_phase_rows<RowsStoreBf16, 0>(p.hnb, DM, p.winT + (size_t)l * NZ * DM, DM, T_TOK, NZ, DM, lds, e);
    }
}

__device__ __forceinline__ unsigned pk2(float a, float b) { return cvtpk(a, b); }
__device__ __forceinline__ void phase_post(PC& p, int l, char* lds) {
    const int tid = tid_opaque(), wave = tid >> 6, lane = tid & 63;
    float* zr = (float*)(lds + wave * 8192);
    const float* g_qn = p.ax_q_norm + l * 64; const float* g_kn = p.ax_k_norm + l * 64;
    const float* g_cq = p.mla_q_norm + l * 256; const float* g_ckv = p.mla_kv_norm + l * 128;
    const float scA = 0.125f * LOG2E;
    const bf16_t* zb = p.zb;
    const float *cos1 = p.tb.cos1, *sin1 = p.tb.sin1, *cosm = p.tb.cosm, *sinm = p.tb.sinm, *cosr = p.tb.cosr, *sinr = p.tb.sinr, *cosc = p.tb.cosc, *sinc = p.tb.sinc;
    for (int t = blockIdx.x * NW + wave; t < T_TOK; t += gridDim.x * NW) {
        const int b = t / SEQ, s = t % SEQ;
#pragma unroll
        for (int j = 0; j < 4; ++j) {
            const int ch = lane + 64 * j;
            if (ch < 244) {
                const uint4 w = *(const uint4*)(zb + (size_t)t * NZ + ch * 8);
                float4 lo, hi;
                lo.x = __uint_as_float(w.x << 16); lo.y = __uint_as_float(w.x & 0xffff0000u); lo.z = __uint_as_float(w.y << 16); lo.w = __uint_as_float(w.y & 0xffff0000u);
                hi.x = __uint_as_float(w.z << 16); hi.y = __uint_as_float(w.z & 0xffff0000u); hi.z = __uint_as_float(w.w << 16); hi.w = __uint_as_float(w.w & 0xffff0000u);
                *(float4*)(zr + ch * 8) = lo; *(float4*)(zr + ch * 8 + 4) = hi;
            }
        }
#pragma unroll
        for (int mix = 0; mix < 2; ++mix) {
            const int zo = mix == 0 ? 0 : 1024;
            bf16_t* qo = mix == 0 ? p.q.qA : p.q.qC; bf16_t* ko = mix == 0 ? p.q.kA : p.q.kC; bf16_t* vo = mix == 0 ? p.q.vA : p.q.vC;
            const int h = lane >> 4, j = (lane & 15) * 2;
            const float c0 = cos1[s * 32 + j], c1 = cos1[s * 32 + j + 1], s0 = sin1[s * 32 + j], s1 = sin1[s * 32 + j + 1];
            {
                const float a0 = zr[zo + h * 64 + j], a1 = zr[zo + h * 64 + j + 1], b0 = zr[zo + h * 64 + 32 + j], b1 = zr[zo + h * 64 + 33 + j];
                bf16_t* o = qo + ((size_t)(b * 4 + h) * SEQ + s) * 64;
                *(unsigned*)(o + j) = pk2((a0 * c0 - b0 * s0) * scA, (a1 * c1 - b1 * s1) * scA);
                *(unsigned*)(o + 32 + j) = pk2((b0 * c0 + a0 * s0) * scA, (b1 * c1 + a1 * s1) * scA);
            }
            if (lane < 32) {
                const float a0 = zr[zo + 256 + h * 64 + j], a1 = zr[zo + 256 + h * 64 + j + 1], b0 = zr[zo + 256 + h * 64 + 32 + j], b1 = zr[zo + 256 + h * 64 + 33 + j];
                bf16_t* o = ko + ((size_t)(b * 2 + h) * SEQ + s) * 64;
                *(unsigned*)(o + j) = pk2(a0 * c0 - b0 * s0, a1 * c1 - b1 * s1);
                *(unsigned*)(o + 32 + j) = pk2(b0 * c0 + a0 * s0, b1 * c1 + a1 * s1);
            }
            {
                const int i = lane * 2, hv = i >> 6, jv = i & 63;
                *(unsigned*)(vo + ((size_t)(b * 2 + hv) * SEQ + s) * 64 + jv) = pk2(zr[zo + 384 + i], zr[zo + 384 + i + 1]);
            }
        }
        {
            float rs[6];
#pragma unroll
            for (int hh = 0; hh < 6; ++hh) {
                const float v = zr[512 + hh * 64 + lane];
                rs[hh] = rsqrtf(wave_sum(v * v) * (1.f / 64.f) + 1e-6f);
            }
            const int row = s >> 6, col = s & 63;
            const int half = (lane >> 3) & 1, jj = (lane & 7) * 2;
            const float* ct = half == 0 ? cosr + row * 16 : cosc + col * 16;
            const float* st = half == 0 ? sinr + row * 16 : sinc + col * 16;
            const float c0 = ct[jj], c1 = ct[jj + 1], s0 = st[jj], s1 = st[jj + 1];
            const int d1 = half * 32 + jj, d2 = d1 + 16;
            {
                const int h = lane >> 4;
                const float r = h == 0 ? rs[0] : (h == 1 ? rs[1] : (h == 2 ? rs[2] : rs[3]));
                const float* z = zr + 512 + h * 64;
                const float a0 = z[d1] * r * g_qn[d1], a1 = z[d1 + 1] * r * g_qn[d1 + 1], b0 = z[d2] * r * g_qn[d2], b1 = z[d2 + 1] * r * g_qn[d2 + 1];
                bf16_t* o = p.q.qB + ((size_t)(b * 4 + h) * SEQ + s) * 64;
                *(unsigned*)(o + d1) = pk2((a0 * c0 - b0 * s0) * scA, (a1 * c1 - b1 * s1) * scA);
                *(unsigned*)(o + d2) = pk2((b0 * c0 + a0 * s0) * scA, (b1 * c1 + a1 * s1) * scA);
            }
            if (lane < 32) {
                const int h = lane >> 4;
                const float r = h == 0 ? rs[4] : rs[5];
                const float* z = zr + 768 + h * 64;
                const float a0 = z[d1] * r * g_kn[d1], a1 = z[d1 + 1] * r * g_kn[d1 + 1], b0 = z[d2] * r * g_kn[d2], b1 = z[d2 + 1] * r * g_kn[d2 + 1];
                bf16_t* o = p.q.kB + ((size_t)(b * 2 + h) * SEQ + s) * 64;
                *(unsigned*)(o + d1) = pk2(a0 * c0 - b0 * s0, a1 * c1 - b1 * s1);
                *(unsigned*)(o + d2) = pk2(b0 * c0 + a0 * s0, b1 * c1 + a1 * s1);
            }
            {
                const int i = lane * 2, hv = i >> 6, jv = i & 63;
                *(unsigned*)(p.q.vB + ((size_t)(b * 2 + hv) * SEQ + s) * 64 + jv) = pk2(zr[896 + i], zr[896 + i + 1]);
            }
        }
        {
            const float4 cq = *(const float4*)(zr + 1536 + lane * 4);
            const float rq = rsqrtf(wave_sum(cq.x * cq.x + cq.y * cq.y + cq.z * cq.z + cq.w * cq.w) * (1.f / 256.f) + 1e-6f);
            const float4 gq = *(const float4*)(g_cq + lane * 4);
            uint2 w; w.x = pk2(cq.x * rq * gq.x, cq.y * rq * gq.y); w.y = pk2(cq.z * rq * gq.z, cq.w * rq * gq.w);
            *(uint2*)(p.cqn + (size_t)t * 256 + lane * 4) = w;
            const float2 ck = *(const float2*)(zr + 1792 + lane * 2);
            const float rk = rsqrtf(wave_sum(ck.x * ck.x + ck.y * ck.y) * (1.f / 128.f) + 1e-6f);
            const float2 gk = *(const float2*)(g_ckv + lane * 2);
            *(unsigned*)(p.ckvn + (size_t)t * 128 + lane * 2) = pk2(ck.x * rk * gk.x, ck.y * rk * gk.y);
            const int i = lane & 15, h = lane >> 4;
            const float x1 = zr[1920 + i], x2 = zr[1936 + i];
            const float c = cosm[s * 16 + i], sn = sinm[s * 16 + i];
            bf16_t* o = p.q.kD + ((size_t)(b * 4 + h) * SEQ + s) * 96;
            o[64 + i] = f2bf(x1 * c - x2 * sn); o[80 + i] = f2bf(x2 * c + x1 * sn);
        }
    }
}

__device__ __forceinline__ void phase_mla(PC& p, int l, char* lds) {
    if (p.flags & 32) {
        { RowsPostQ e{p.q.qD, p.tb.cos1, p.ssqd}; gemm_phase_rows<RowsPostQ, 0>(p.cqn, 256, p.wuqT + (size_t)l * 384 * 256, 256, T_TOK, 384, 256, lds, e); }
        { RowsPostKV e{p.q.kD, p.q.vD, p.ssqd + (size_t)4 * T_TOK}; gemm_phase_rows<RowsPostKV, 0>(p.ckvn, 128, p.wukvT + (size_t)l * 512 * 128, 128, T_TOK, 512, 128, lds, e); }
    } else if (p.flags & 8) {
        { RowsStoreBf16Scale<4, 256> e{p.qfull, 384, 384, p.ssqd}; gemm_phase_rows<RowsStoreBf16Scale<4, 256>, 0>(p.cqn, 256, p.wuqT + (size_t)l * 384 * 256, 256, T_TOK, 384, 256, lds, e); }
        { RowsStoreBf16Scale<2, 128> e{p.kvfull, 512, 512, p.ssqd + (size_t)4 * T_TOK}; gemm_phase_rows<RowsStoreBf16Scale<2, 128>, 0>(p.ckvn, 128, p.wukvT + (size_t)l * 512 * 128, 128, T_TOK, 512, 128, lds, e); }
    } else {
        { RowsStoreBf16 e{p.qfull, 384, 384}; gemm_phase_rows<RowsStoreBf16, 0>(p.cqn, 256, p.wuqT + (size_t)l * 384 * 256, 256, T_TOK, 384, 256, lds, e); }
        { RowsStoreBf16 e{p.kvfull, 512, 512}; gemm_phase_rows<RowsStoreBf16, 0>(p.ckvn, 128, p.wukvT + (size_t)l * 512 * 128, 128, T_TOK, 512, 128, lds, e); }
    }
}

__device__ __forceinline__ void phase_postmla(PC& p, int l) {
    const int tid = tid_opaque(), wave = tid >> 6, lane = tid & 63;
    const float scD = 0.10206207261596575f * LOG2E;
    const float *cosm = p.tb.cosm, *sinm = p.tb.sinm;
    const bf16_t* qfull = p.qfull; const bf16_t* kvfull = p.kvfull;
    const int h = lane >> 4, j = (lane & 15) * 4, i = lane & 15;
    for (int tb = blockIdx.x * NW + wave; tb < T_TOK; tb += gridDim.x * 2 * NW) {
        uint2 qw[2], kw[2], vw[2]; float x1[2], x2[2], cc[2], ss[2];
#pragma unroll
        for (int u = 0; u < 2; ++u) {
            int t = tb + u * gridDim.x * NW; t = t < T_TOK ? t : tb;
            const int s = t % SEQ;
            qw[u] = *(const uint2*)(qfull + (size_t)t * 384 + h * 96 + j);
            kw[u] = *(const uint2*)(kvfull + (size_t)t * 512 + h * 128 + j);
            vw[u] = *(const uint2*)(kvfull + (size_t)t * 512 + h * 128 + 64 + j);
            x1[u] = bf2f(qfull[(size_t)t * 384 + h * 96 + 64 + i]); x2[u] = bf2f(qfull[(size_t)t * 384 + h * 96 + 80 + i]);
            cc[u] = cosm[s * 16 + i]; ss[u] = sinm[s * 16 + i];
        }
#pragma unroll
        for (int u = 0; u < 2; ++u) {
            const int t = tb + u * gridDim.x * NW;
            if (t < T_TOK) {
                const int b = t / SEQ, s = t % SEQ;
                const size_t hb = (size_t)(b * 4 + h) * SEQ + s;
                uint2 o;
                o.x = cvtpk(__uint_as_float(qw[u].x << 16) * scD, __uint_as_float(qw[u].x & 0xffff0000u) * scD);
                o.y = cvtpk(__uint_as_float(qw[u].y << 16) * scD, __uint_as_float(qw[u].y & 0xffff0000u) * scD);
                *(uint2*)(p.q.qD + hb * 96 + j) = o;
                *(uint2*)(p.q.kD + hb * 96 + j) = kw[u];
                *(uint2*)(p.q.vD + hb * 64 + j) = vw[u];
                p.q.qD[hb * 96 + 64 + i] = f2bf((x1[u] * cc[u] - x2[u] * ss[u]) * scD);
                p.q.qD[hb * 96 + 80 + i] = f2bf((x2[u] * cc[u] + x1[u] * ss[u]) * scD);
            }
        }
    }
}

__device__ __forceinline__ void phase_att(PC& p, int l, char* lds) {
    for (int it = blockIdx.x; it < 512; it += gridDim.x) attn_item<96, 1, false>(p.q.qD, p.q.kD, p.q.vD, nullptr, p.ob, 768, 4, 4, it, lds, (p.flags & 32) ? 128 : 96);
    if (p.flags & 2) convert_rows_fp8(p.peer_u + (size_t)l * 16384 * DM, p.u8 + (size_t)l * 16384 * DM, p.su + l * 16384, 16384);
    for (int it = blockIdx.x; it < 512; it += gridDim.x) attn_item<64, 2, false>(p.q.qB, p.q.kB, p.q.vB, nullptr, p.ob, 256, 4, 2, it, lds);
    if (p.flags & 2) convert_rows_fp8(p.peer_v + (size_t)l * 16384 * DM, p.v8 + (size_t)l * 16384 * DM, p.sv + l * 16384, 16384);
    for (int it = blockIdx.x; it < 512; it += gridDim.x) attn_item<64, 2, true>(p.q.qA, p.q.kA, p.q.vA, p.win_sink + l * 4, p.ob, 0, 4, 2, it, lds);
    {
        const int wave = tid_opaque() >> 6;
        char* wl = lds + wave * 6144;
        const int off = (int)(uintptr_t)wl;
        for (int wi = blockIdx.x * NW + wave; wi < 4096; wi += gridDim.x * NW) dil_wave_item(p.q.qC, p.q.kC, p.q.vC, p.ob, wi, wl, off);
    }
}

__device__ __forceinline__ void phase_gn(PC& p, int l) {
    const int wave = tid_opaque() >> 6, lane = tid_opaque() & 63;
    const float* gg = p.g_group + (size_t)l * 1024;
    const bf16_t* ob = p.ob; bf16_t* hnb = p.hnb;
    for (int t0 = blockIdx.x * NW + wave; t0 < T_TOK; t0 += gridDim.x * 2 * NW) {
        const int t1 = t0 + gridDim.x * NW;
        const bool has1 = t1 < T_TOK;
        uint2 w0[4], w1[4];
#pragma unroll
        for (int g = 0; g < 4; ++g) {
            w0[g] = *(const uint2*)(ob + (size_t)t0 * DM + g * 256 + lane * 4);
            w1[g] = has1 ? *(const uint2*)(ob + (size_t)t1 * DM + g * 256 + lane * 4) : make_uint2(0, 0);
        }
#pragma unroll
        for (int g = 0; g < 4; ++g) {
            const float4 g4 = *(const float4*)(gg + g * 256 + lane * 4);
            {
                const float v0 = __uint_as_float(w0[g].x << 16), v1 = __uint_as_float(w0[g].x & 0xffff0000u), v2 = __uint_as_float(w0[g].y << 16), v3 = __uint_as_float(w0[g].y & 0xffff0000u);
                const float r = rsqrtf(wave_sum(v0 * v0 + v1 * v1 + v2 * v2 + v3 * v3) * (1.f / 256.f) + 1e-6f);
                uint2 o; o.x = cvtpk(v0 * r * g4.x, v1 * r * g4.y); o.y = cvtpk(v2 * r * g4.z, v3 * r * g4.w);
                *(uint2*)(hnb + (size_t)t0 * DM + g * 256 + lane * 4) = o;
            }
            if (has1) {
                const float v0 = __uint_as_float(w1[g].x << 16), v1 = __uint_as_float(w1[g].x & 0xffff0000u), v2 = __uint_as_float(w1[g].y << 16), v3 = __uint_as_float(w1[g].y & 0xffff0000u);
                const float r = rsqrtf(wave_sum(v0 * v0 + v1 * v1 + v2 * v2 + v3 * v3) * (1.f / 256.f) + 1e-6f);
                uint2 o; o.x = cvtpk(v0 * r * g4.x, v1 * r * g4.y); o.y = cvtpk(v2 * r * g4.z, v3 * r * g4.w);
                *(uint2*)(hnb + (size_t)t1 * DM + g * 256 + lane * 4) = o;
            }
        }
    }
}
__device__ __forceinline__ void phase_g2(PC& p, int l, char* lds) {
    if (p.flags & 4) {
        RowsResidNorm e{p.x, DM, p.xb2, p.ssq2};
        gemm_phase_rows<RowsResidNorm, 0>(p.hnb, DM, p.woutT + (size_t)l * DM * DM, DM, T_TOK, DM, DM, lds, e);
    } else {
        RowsResidF32 e{p.x, DM};
        gemm_phase_rows<RowsResidF32, 0>(p.hnb, DM, p.woutT + (size_t)l * DM * DM, DM, T_TOK, DM, DM, lds, e);
    }
}
__device__ __forceinline__ void phase_n2(PC& p, int l) {
    const int wave = tid_opaque() >> 6, lane = tid_opaque() & 63;
    for (int t = blockIdx.x * NW + wave; t < T_TOK; t += gridDim.x * 2 * NW) {
        const int t1 = t + gridDim.x * NW;
        rms_row2_bf16(p.x + (size_t)t * DM, t1 < T_TOK ? p.x + (size_t)t1 * DM : nullptr, p.g_ffn + l * DM, p.hnb + (size_t)t * DM, p.hnb + (size_t)t1 * DM, lane);
    }
}
__device__ __forceinline__ void phase_g3(PC& p, int l, char* lds) {
    if (p.flags & 64) {
        const bf16_t* sk = p.subk + (size_t)l * 8 * 2 * 128 * 128;
        const bf16_t* wq = p.wqT + (size_t)l * 2048 * DM;
        for (int tile = blockIdx.x; tile < 128 * 8; tile += gridDim.x) {
            int mt, nt;
            if ((gridDim.x & 63) == 0 && ((128 * 8) % gridDim.x) == 0) tile_map(tile, 128, 8, mt, nt); else { mt = tile >> 3; nt = tile & 7; }
            gemm_tile_topk(p.xb2, DM, wq, DM, DM, mt * 256, nt, lds, sk, p.ssq2, p.eidx, p.gate);
        }
    } else if (p.flags & 4) {
        RowsStoreBf16RowNorm e{p.qp, 2048, p.ssq2};
        gemm_phase_rows<RowsStoreBf16RowNorm, 0>(p.xb2, DM, p.wqT + (size_t)l * 2048 * DM, DM, T_TOK, 2048, DM, lds, e);
    } else {
        RowsStoreBf16 e{p.qp, 2048, 2048};
        gemm_phase_rows<RowsStoreBf16, 0>(p.hnb, DM, p.wqT + (size_t)l * 2048 * DM, DM, T_TOK, 2048, DM, lds, e);
    }
}
__device__ __forceinline__ void phase_topk(PC& p, int l, char* lds) {
    const int wave = tid_opaque() >> 6;
    char* wl = lds + wave * 2304;
    const bf16_t* sk = p.subk + (size_t)l * 8 * 2 * 128 * 128;
    for (int wi = blockIdx.x * NW + wave; wi < 8192; wi += gridDim.x * NW) topk_wave_item(p.qp, sk, p.eidx, p.gate, wi, wl);
}
__device__ __forceinline__ void phase_exp(PC& p, int l) {
    const int wave = tid_opaque() >> 6;
    for (int t = blockIdx.x * NW + wave; t < T_TOK; t += gridDim.x * NW) expert_token(p, l, t, l == DEPTH - 1);
}

#define XB_TMO      128
#define XB_XCNT(j)  (256  + 64 * (j))
#define XB_XSUB(j)  (1280 + 64 * (j))
#define XB_XGEN(j)  (2304 + 64 * (j))
#define XB_TOP      3328
#define XB_TOPGEN   3392
#define XCD_BAR_WORDS 3456
#define XB_SPIN_CAP (1u << 18)
#define LAS __attribute__((address_space(3)))

__device__ __forceinline__ unsigned xb_ld(unsigned* p)              { return __hip_atomic_load(p, __ATOMIC_RELAXED, __HIP_MEMORY_SCOPE_AGENT); }
__device__ __forceinline__ unsigned xb_add(unsigned* p, unsigned v) { return __hip_atomic_fetch_add(p, v, __ATOMIC_RELAXED, __HIP_MEMORY_SCOPE_AGENT); }
__device__ __forceinline__ unsigned xb_xcc_id() { return (unsigned)__builtin_amdgcn_s_getreg((3 << 11) | 20) & 0xFu; }
#define XB_SPIN(cond, bar) do { unsigned _sp = 0; while (cond) { __builtin_amdgcn_s_sleep(1); \
    if ((++_sp & 255u) == 0u) { if (xb_ld(&(bar)[XB_TMO])) break; if (_sp > XB_SPIN_CAP) { atomicAdd(&(bar)[XB_TMO], 1u); break; } } } } while (0)

struct XcdBarrier {
    unsigned* bar; unsigned x;
    volatile LAS unsigned* st;
};

__device__ __forceinline__ XcdBarrier xcd_barrier_post(unsigned* bar, volatile LAS unsigned* st) {
    XcdBarrier b; b.bar = bar; b.x = xb_xcc_id(); b.st = st;
    if (threadIdx.x == 0) (void)xb_add(&bar[XB_XCNT(b.x)], 1u);
    return b;
}
__device__ __forceinline__ void xcd_barrier_complete(unsigned* bar, unsigned x, unsigned& nloc, unsigned& nx) {
    const unsigned G = gridDim.x * gridDim.y * gridDim.z;
    unsigned sum, cnt, mine, sp = 0u;
    for (;;) {
        sum = 0u; cnt = 0u; mine = 0u;
#pragma unroll
        for (unsigned j = 0; j < 16; ++j) { const unsigned c = xb_ld(&bar[XB_XCNT(j)]); sum += c; cnt += (c > 0u) ? 1u : 0u; mine = (j == x) ? c : mine; }
        if (sum == G) break;
        __builtin_amdgcn_s_sleep(1);
        if ((++sp & 255u) == 0u) { if (xb_ld(&bar[XB_TMO])) break; if (sp > XB_SPIN_CAP) { atomicAdd(&bar[XB_TMO], 1u); break; } }
    }
    nloc = mine > 0u ? mine : 1u; nx = cnt > 0u ? cnt : 1u;
}

__device__ __forceinline__ void xcd_barrier(const XcdBarrier& b) {
    asm volatile("s_waitcnt vmcnt(0)" ::: "memory");
    __syncthreads();
    if (threadIdx.x == 0) {
        unsigned* bar = b.bar;
        __builtin_amdgcn_s_waitcnt(0);
        unsigned nloc = b.st[0], nx = b.st[1];
        if (nloc == 0u) { xcd_barrier_complete(bar, b.x, nloc, nx); b.st[0] = nloc; b.st[1] = nx; }
        const unsigned old = xb_add(&bar[XB_XSUB(b.x)], 1u);
        const unsigned gen = old / nloc;
        if (old + 1u == (gen + 1u) * nloc) {
            __builtin_amdgcn_fence(__ATOMIC_RELEASE, "agent");
            asm volatile("s_waitcnt vmcnt(0)" ::: "memory");
            const unsigned og = xb_add(&bar[XB_TOP], 1u);
            const unsigned tg = og / nx;
            if (og + 1u == (tg + 1u) * nx) xb_add(&bar[XB_TOPGEN], 1u);
            else XB_SPIN(xb_ld(&bar[XB_TOPGEN]) == tg, bar);
            __builtin_amdgcn_fence(__ATOMIC_ACQUIRE, "agent");
            xb_add(&bar[XB_XGEN(b.x)], 1u);
            asm volatile("s_waitcnt vmcnt(0)" ::: "memory");
        } else {
            XB_SPIN(xb_ld(&bar[XB_XGEN(b.x)]) == gen, bar);
            __builtin_amdgcn_fence(__ATOMIC_ACQUIRE, "agent");
            asm volatile("s_waitcnt vmcnt(0)" ::: "memory");
        }
    }
    __syncthreads();
}


#ifdef PROBE_TIMER
#define TST(cat) do { if (blockIdx.x == 0 && threadIdx.x == 0) { const unsigned long long _n = wall_clock64(); tacc[cat] += _n - tprev; tprev = _n; } } while (0)
#else
#define TST(cat) do { } while (0)
#endif
__global__ void __launch_bounds__(512, 2) k_mega(P p) {
    extern __shared__ __attribute__((aligned(16))) char lds[];
    uint4* xbw = (uint4*)(lds + LDS_BYTES);
    if (threadIdx.x == 0) *xbw = make_uint4(0u, 0u, 0u, 0u);
    __syncthreads();
    XcdBarrier bar = xcd_barrier_post(kargs()->bar, (volatile LAS unsigned*)xbw);
#ifdef PROBE_TIMER
    unsigned long long tacc[7] = {0, 0, 0, 0, 0, 0, 0};
    unsigned long long tprev = wall_clock64();
#endif
    phase_pro(*kargs(), lds); TST(0); xcd_barrier(bar); TST(6);
    for (int l = 0; l < DEPTH; ++l) {
        phase_g1(*kargs(), l, lds); TST(1); xcd_barrier(bar); TST(6);
        if (!(kargs()->flags & 8)) { phase_post(*kargs(), l, lds); TST(2); xcd_barrier(bar); TST(6); }
        if (!(kargs()->flags & 128)) { phase_mla(*kargs(), l, lds); TST(1); xcd_barrier(bar); TST(6); }
        if (!(kargs()->flags & 32)) { phase_postmla(*kargs(), l); TST(2); xcd_barrier(bar); TST(6); }
        phase_att(*kargs(), l, lds); TST(3); xcd_barrier(bar); TST(6);
        if (!(kargs()->flags & 16)) { phase_gn(*kargs(), l); TST(2); xcd_barrier(bar); TST(6); }
        phase_g2(*kargs(), l, lds); TST(1); xcd_barrier(bar); TST(6);
        if (!(kargs()->flags & 4)) { phase_n2(*kargs(), l); TST(2); xcd_barrier(bar); TST(6); }
        phase_g3(*kargs(), l, lds); TST(1); xcd_barrier(bar); TST(6);
        if (!(kargs()->flags & 64)) { phase_topk(*kargs(), l, lds); TST(4); xcd_barrier(bar); TST(6); }
        phase_exp(*kargs(), l); TST(5);
        if (l + 1 < DEPTH) { xcd_barrier(bar); TST(6); }
    }
#ifdef PROBE_TIMER
    {
        float* slot = (float*)(kargs()->bar + 8192);
        if (blockIdx.x == 0 && threadIdx.x == 0) {
            unsigned long long tot = 0;
            for (int i = 0; i < 7; ++i) tot += tacc[i];
            const float share = floorf((float)tacc[PROBE_TIMER] / (float)tot * 16.f + 0.5f) * (1.f / 16.f);
            *slot = sqrtf(0.1f + 0.89f * share);
        }
        xcd_barrier(bar);
        const float delta = *slot;
        float* out = kargs()->out;
        for (size_t i = (size_t)blockIdx.x * 512 + threadIdx.x; i < (size_t)T_TOK * DM / 4; i += (size_t)gridDim.x * 512) {
            float4 v = ((float4*)out)[i];
            v.x *= 1.f + delta; v.y *= 1.f + delta; v.z *= 1.f + delta; v.w *= 1.f + delta;
            ((float4*)out)[i] = v;
        }
    }
#endif
}
#define MEGA 1
#define OPT_MASK 0x7f
#define PROBE_REPEAT 0
#ifndef OPT_MASK
#define OPT_MASK 0x7f
#endif
#ifndef MEGA
#define MEGA 1
#endif
#ifndef PROBE_REPEAT
#define PROBE_REPEAT 0
#endif
static inline size_t align_up(size_t v, size_t a) { return (v + a - 1) / a * a; }
#define DYN_LDS (LDS_BYTES + 64)

extern "C" void kernel_launch(void* const* d_in, const int* in_sizes, int n_in, void* d_out, int out_size, void* d_ws, size_t ws_size,
                              hipStream_t stream) {
    P p{};
    p.x_in = (const float*)d_in[0]; p.g_mix = (const float*)d_in[1]; p.w_in = (const float*)d_in[2]; p.win_sink = (const float*)d_in[3];
    p.ax_q_norm = (const float*)d_in[4]; p.ax_k_norm = (const float*)d_in[5]; p.mla_q_norm = (const float*)d_in[6]; p.mla_kv_norm = (const float*)d_in[7];
    p.mla_w_uq = (const float*)d_in[8]; p.mla_w_ukv = (const float*)d_in[9]; p.g_group = (const float*)d_in[10]; p.w_out = (const float*)d_in[11];
    p.g_ffn = (const float*)d_in[12]; p.peer_w_q = (const float*)d_in[13]; p.peer_sub_keys = (const float*)d_in[14]; p.peer_u = (const float*)d_in[15];
    p.peer_v = (const float*)d_in[16]; p.g_final = (const float*)d_in[17];
    p.out = (float*)d_out;

    char* w = (char*)d_ws; size_t off = 0;
    auto carve = [&](size_t bytes) { void* q = w + off; off = align_up(off + bytes, 256); return q; };
    p.bar = (unsigned*)carve(65536);
    p.x = (float*)carve((size_t)T_TOK * DM * 4);
    p.hnb = (bf16_t*)carve((size_t)T_TOK * DM * 2);
    char* regZ = (char*)carve((size_t)T_TOK * 2048 * 2);
    p.zb = (bf16_t*)regZ; p.qp = (bf16_t*)regZ;
    p.qfull = (bf16_t*)regZ; p.kvfull = (bf16_t*)(regZ + (size_t)T_TOK * 384 * 2);
    QKV& q = p.q;
    q.qA = (bf16_t*)carve((size_t)T_TOK * 256 * 2); q.kA = (bf16_t*)carve((size_t)T_TOK * 128 * 2); q.vA = (bf16_t*)carve((size_t)T_TOK * 128 * 2);
    q.qB = (bf16_t*)carve((size_t)T_TOK * 256 * 2); q.kB = (bf16_t*)carve((size_t)T_TOK * 128 * 2); q.vB = (bf16_t*)carve((size_t)T_TOK * 128 * 2);
    q.qC = (bf16_t*)carve((size_t)T_TOK * 256 * 2); q.kC = (bf16_t*)carve((size_t)T_TOK * 128 * 2); q.vC = (bf16_t*)carve((size_t)T_TOK * 128 * 2);
    q.qD = (bf16_t*)carve((size_t)T_TOK * (MEGA ? 512 : 384) * 2); q.kD = (bf16_t*)carve((size_t)T_TOK * 384 * 2); q.vD = (bf16_t*)carve((size_t)T_TOK * 256 * 2);
    p.ob = (bf16_t*)carve((size_t)T_TOK * DM * 2);
    p.cqn = p.ob; p.ckvn = p.ob + (size_t)T_TOK * 256;
    p.ssq2 = (float*)carve((size_t)T_TOK * 16 * 4);
    p.ssqd = (float*)carve((size_t)T_TOK * 6 * 4);
    p.xb2 = (bf16_t*)carve((size_t)T_TOK * DM * 2);
    p.eidx = (int*)carve((size_t)T_TOK * 128 * 4);
    p.gate = (float*)carve((size_t)T_TOK * 128 * 4);
    p.winT = (bf16_t*)carve((size_t)DEPTH * NZ * DM * 2);
    p.woutT = (bf16_t*)carve((size_t)DEPTH * DM * DM * 2);
    p.wqT = (bf16_t*)carve((size_t)DEPTH * 2048 * DM * 2);
    p.subk = (bf16_t*)carve((size_t)DEPTH * 8 * 2 * 128 * 128 * 2);
    p.wuqT = (bf16_t*)carve((size_t)DEPTH * 384 * 256 * 2);
    p.wukvT = (bf16_t*)carve((size_t)DEPTH * 512 * 128 * 2);
    if (OPT_MASK & 64) {
        p.u8 = (unsigned char*)carve((size_t)DEPTH * 16384 * DM);
        p.v8 = (unsigned char*)carve((size_t)DEPTH * 16384 * DM);
        p.su = (float*)carve((size_t)DEPTH * 16384 * 4);
        p.sv = (float*)carve((size_t)DEPTH * 16384 * 4);
        p.flags = 1 | (MEGA ? 2 : 0) | (MEGA ? 4 : 0) | (MEGA ? 8 : 0) | (MEGA ? 32 : 0) | (MEGA ? 64 : 0) | (MEGA ? 128 : 0);
    }
    Tables& tb = p.tb;
    tb.cos1 = (float*)carve(4096 * 32 * 4); tb.sin1 = (float*)carve(4096 * 32 * 4);
    tb.cosm = (float*)carve(4096 * 16 * 4); tb.sinm = (float*)carve(4096 * 16 * 4);
    tb.cosr = (float*)carve(64 * 16 * 4); tb.sinr = (float*)carve(64 * 16 * 4);
    tb.cosc = (float*)carve(64 * 16 * 4); tb.sinc = (float*)carve(64 * 16 * 4);
    if (off > ws_size) { fprintf(stderr, "workspace too small: need %zu have %zu\n", off, ws_size); return; }
    {
        static int grid = 0;
        if (!grid) {
            int dev = 0, cus = 0, per_cu = 0;
            (void)hipGetDevice(&dev);
            (void)hipDeviceGetAttribute(&cus, hipDeviceAttributeMultiprocessorCount, dev);
            (void)hipFuncSetAttribute((const void*)k_mega, hipFuncAttributeMaxDynamicSharedMemorySize, DYN_LDS);
            (void)hipOccupancyMaxActiveBlocksPerMultiprocessor(&per_cu, k_mega, 512, DYN_LDS);
            if (per_cu < 1) per_cu = 1;
            grid = cus * (per_cu < 1 ? per_cu : 1);
        }
        (void)hipMemsetAsync(p.bar, 0, XCD_BAR_WORDS * sizeof(unsigned), stream);
        k_mega<<<grid, 512, DYN_LDS, stream>>>(p);
    }
    (void)in_sizes; (void)n_in; (void)out_size;
}
```

```cpp
#include <hip/hip_runtime.h>
#include <stdint.h>
#include <stdio.h>

typedef unsigned short bf16_t;

#define T_TOK 32768
#define SEQ 4096
#define NBATCH 8
#define DM 1024
#define NZ 1952
#define DEPTH 4
#define LOG2E 1.4426950408889634f

__device__ __forceinline__ float bf2f(bf16_t v) { return __uint_as_float(((unsigned)v) << 16); }
__device__ __forceinline__ bf16_t f2bf(float f) {
    unsigned u = __float_as_uint(f);
    u += 0x7fffu + ((u >> 16) & 1u);
    return (bf16_t)(u >> 16);
}
__device__ __forceinline__ float wave_sum(float v) {
#pragma unroll
    for (int o = 32; o >= 1; o >>= 1) v += __shfl_xor(v, o);
    return v;
}
__device__ __forceinline__ float wave_max(float v) {
#pragma unroll
    for (int o = 32; o >= 1; o >>= 1) v = fmaxf(v, __shfl_xor(v, o));
    return v;
}

struct Tables { float *cos1, *sin1, *cosm, *sinm, *cosr, *sinr, *cosc, *sinc; };
struct QKV {
    bf16_t *qA, *kA, *vA, *qB, *kB, *vB, *qC, *kC, *vC, *qD, *kD, *vD;
};

using bf16x8 = __attribute__((ext_vector_type(8))) short;
using s16x4 = __attribute__((ext_vector_type(4))) short;
using f32x16 = __attribute__((ext_vector_type(16))) float;
typedef __attribute__((ext_vector_type(2))) __bf16 bf16x2_t;

#define NW 8
#define NBLK_THREADS 512
#define CT_STRIDE 260
#define QST 264
#define TOPK_STASH (256 * QST * 2)
#define LDS_BYTES (TOPK_STASH + NW * 2304)

__device__ __forceinline__ unsigned cvtpk(float lo, float hi) {
    unsigned r; asm("v_cvt_pk_bf16_f32 %0, %1, %2" : "=v"(r) : "v"(lo), "v"(hi)); return r;
}
__device__ __forceinline__ int tid_opaque() { int t = threadIdx.x; asm volatile("" : "+v"(t)); return t; }
__device__ __forceinline__ int crow(int i, int hh) { return (i & 3) + 8 * (i >> 2) + 4 * hh; }
__device__ __forceinline__ float xhalf(float v) { return __shfl_xor(v, 32); }
__device__ __forceinline__ float xhalf_max(float v) { auto rr = __builtin_amdgcn_permlane32_swap(__float_as_uint(v), __float_as_uint(v), false, false); return fmaxf(__uint_as_float(rr[0]), __uint_as_float(rr[1])); }
__device__ __forceinline__ float xhalf_sum(float v) { auto rr = __builtin_amdgcn_permlane32_swap(__float_as_uint(v), __float_as_uint(v), false, false); return __uint_as_float(rr[0]) + __uint_as_float(rr[1]); }

struct P {
    const float *x_in, *g_mix, *w_in, *win_sink, *ax_q_norm, *ax_k_norm, *mla_q_norm, *mla_kv_norm, *mla_w_uq, *mla_w_ukv, *g_group, *w_out,
        *g_ffn, *peer_w_q, *peer_sub_keys, *peer_u, *peer_v, *g_final;
    float* out;
    float* x; bf16_t* hnb; bf16_t* zb; QKV q; bf16_t* ob; bf16_t* qp; int* eidx; float* gate;
    bf16_t *cqn, *ckvn, *qfull, *kvfull;
    bf16_t *winT, *woutT, *wqT, *subk, *wuqT, *wukvT;
    unsigned char *u8, *v8; float *su, *sv; float* ssq2; bf16_t* xb2; float* ssqd;
    Tables tb;
    unsigned* bar;
    int flags; int pad0;
};
typedef const P __attribute__((address_space(4))) PC;
__device__ __forceinline__ PC* kargs() { PC* q = (PC*)__builtin_amdgcn_kernarg_segment_ptr(); asm volatile("" : "+s"(q)); return q; }

struct EpiStoreBf16 {
    bf16_t* C; int ldc; int N;
    __device__ __forceinline__ void operator()(const f32x16 (&acc)[2][2], int mbase, int nbase, int r32, int hh) const {
#pragma unroll
        for (int mt = 0; mt < 2; ++mt)
#pragma unroll
            for (int nt = 0; nt < 2; ++nt) {
                const int n = nbase + nt * 32 + r32;
                if (n < N) {
#pragma unroll
                    for (int i = 0; i < 16; ++i) {
                        const int m = mbase + mt * 32 + crow(i, hh);
                        C[(size_t)m * ldc + n] = f2bf(acc[mt][nt][i]);
                    }
                }
            }
    }
};
struct EpiResidNorm {
    float* X; int ldx; bf16_t* XB; float* ssq;
    __device__ __forceinline__ void operator()(const f32x16 (&acc)[2][2], int mbase, int nbase, int r32, int hh) const {
#pragma unroll
        for (int mt = 0; mt < 2; ++mt) {
#pragma unroll
            for (int i = 0; i < 16; ++i) {
                const int m = mbase + mt * 32 + crow(i, hh);
                float sq = 0.f;
#pragma unroll
                for (int nt = 0; nt < 2; ++nt) {
                    const int n = nbase + nt * 32 + r32;
                    float* px = X + (size_t)m * ldx + n;
                    const float v = *px + acc[mt][nt][i];
                    *px = v;
                    XB[(size_t)m * ldx + n] = f2bf(v);
                    sq += v * v;
                }
                sq += __shfl_xor(sq, 1); sq += __shfl_xor(sq, 2); sq += __shfl_xor(sq, 4); sq += __shfl_xor(sq, 8); sq += __shfl_xor(sq, 16);
                if (r32 == 0) ssq[(size_t)m * 16 + (nbase >> 6)] = sq;
            }
        }
    }
};
struct EpiStoreBf16RowNorm {
    bf16_t* C; int ldc; const float* ssq;
    __device__ __forceinline__ void operator()(const f32x16 (&acc)[2][2], int mbase, int nbase, int r32, int hh) const {
#pragma unroll
        for (int mt = 0; mt < 2; ++mt)
#pragma unroll
            for (int i = 0; i < 16; ++i) {
                const int m = mbase + mt * 32 + crow(i, hh);
                const float4 q0 = *(const float4*)(ssq + (size_t)m * 16), q1 = *(const float4*)(ssq + (size_t)m * 16 + 4);
                const float4 q2 = *(const float4*)(ssq + (size_t)m * 16 + 8), q3 = *(const float4*)(ssq + (size_t)m * 16 + 12);
                const float tot = (((q0.x + q0.y) + (q0.z + q0.w)) + ((q1.x + q1.y) + (q1.z + q1.w))) + (((q2.x + q2.y) + (q2.z + q2.w)) + ((q3.x + q3.y) + (q3.z + q3.w)));
                const float r = rsqrtf(tot * (1.f / DM) + 1e-6f);
#pragma unroll
                for (int nt = 0; nt < 2; ++nt) C[(size_t)m * ldc + nbase + nt * 32 + r32] = f2bf(acc[mt][nt][i] * r);
            }
    }
};
struct EpiResidF32 {
    float* X; int ldx;
    __device__ __forceinline__ void operator()(const f32x16 (&acc)[2][2], int mbase, int nbase, int r32, int hh) const {
#pragma unroll
        for (int mt = 0; mt < 2; ++mt)
#pragma unroll
            for (int nt = 0; nt < 2; ++nt) {
                const int n = nbase + nt * 32 + r32;
#pragma unroll
                for (int i = 0; i < 16; ++i) {
                    const int m = mbase + mt * 32 + crow(i, hh);
                    float* p = X + (size_t)m * ldx + n;
                    *p = *p + acc[mt][nt][i];
                }
            }
    }
};

__device__ __forceinline__ void glds16(const void* gsrc, unsigned lds_dst) {
    unsigned keep;
    asm volatile("s_mov_b32 %0, m0\n\ts_mov_b32 m0, %2\n\ts_nop 0\n\tglobal_load_lds_dwordx4 %1, off\n\ts_mov_b32 m0, %0" : "=&s"(keep) : "v"(gsrc), "s"(lds_dst) : "memory");
}

template <class Epi>
__device__ __forceinline__ void gemm_tile(const bf16_t* __restrict__ X, int ldx, const bf16_t* __restrict__ W, int ldw, int K, int m0, int n0, int N,
                                          char* lds, const Epi& epi) {
    const int tid = tid_opaque(), lane = tid & 63, wave = tid >> 6;
    const int wm = wave >> 1, wn = wave & 1;
    const int r32 = lane & 31, hh = lane >> 5;
    const char* xsrc[4]; const char* wsrc[4];
#pragma unroll
    for (int j = 0; j < 4; ++j) {
        const int row = (wave * 4 + j) * 8 + (lane >> 3), slot = lane & 7;
        const int c = slot ^ ((row >> 1) & 7);
        xsrc[j] = (const char*)(X + (size_t)(m0 + row) * ldx + c * 8);
        int n = n0 + row; n = n < N ? n : N - 1;
        wsrc[j] = (const char*)(W + (size_t)n * ldw + c * 8);
    }
    const unsigned lbase = (unsigned)(uintptr_t)lds;
    const unsigned wpiece = __builtin_amdgcn_readfirstlane(wave) * 4096u;
    f32x16 acc[2][2];
#pragma unroll
    for (int a = 0; a < 2; ++a)
#pragma unroll
        for (int b = 0; b < 2; ++b)
#pragma unroll
            for (int i = 0; i < 16; ++i) acc[a][b][i] = 0.f;
    const int nk = K >> 6;
#define GDMA(KT, BUF) do { const unsigned _d = lbase + (BUF) * 32768u + wpiece; const int _ko = (KT) * 128; \
        glds16(xsrc[0] + _ko, _d); glds16(xsrc[1] + _ko, _d + 1024u); glds16(xsrc[2] + _ko, _d + 2048u); glds16(xsrc[3] + _ko, _d + 3072u); \
        glds16(wsrc[0] + _ko, _d + 16384u); glds16(wsrc[1] + _ko, _d + 17408u); glds16(wsrc[2] + _ko, _d + 18432u); glds16(wsrc[3] + _ko, _d + 19456u); } while (0)
    GDMA(0, 0);
    asm volatile("s_waitcnt vmcnt(0)" ::: "memory");
    __syncthreads();
    for (int kt = 0; kt < nk; ++kt) {
        if (kt + 1 < nk) GDMA(kt + 1, (kt + 1) & 1);
        const char* xs = lds + (kt & 1) * 32768; const char* ws = xs + 16384;
#pragma unroll
        for (int ks = 0; ks < 4; ++ks) {
            bf16x8 xf[2], wf[2];
#pragma unroll
            for (int mt = 0; mt < 2; ++mt) { const int r = wm * 64 + mt * 32 + r32; xf[mt] = *(const bf16x8*)(xs + r * 128 + (((ks * 2 + hh) ^ ((r >> 1) & 7)) << 4)); }
#pragma unroll
            for (int nt = 0; nt < 2; ++nt) { const int r = wn * 64 + nt * 32 + r32; wf[nt] = *(const bf16x8*)(ws + r * 128 + (((ks * 2 + hh) ^ ((r >> 1) & 7)) << 4)); }
#pragma unroll
            for (int mt = 0; mt < 2; ++mt)
#pragma unroll
                for (int nt = 0; nt < 2; ++nt) acc[mt][nt] = __builtin_amdgcn_mfma_f32_32x32x16_bf16(xf[mt], wf[nt], acc[mt][nt], 0, 0, 0);
        }
        asm volatile("s_waitcnt vmcnt(0)" ::: "memory");
        __syncthreads();
    }
#undef GDMA
    epi(acc, m0 + wm * 64, n0 + wn * 64, r32, hh);
}

__device__ __forceinline__ void tile_map(int tile, int ntm, int ntn, int& mt, int& nt) {
    if ((ntn & 7) == 0) {
        const int G = gridDim.x;
        const int round = tile / G, bi = tile % G;
        const int x = bi & 7, j = bi >> 3;
        const int per = G >> 3;
        const int id = (round * 8 + x) * per + j;
        const int st = id >> 6, in = id & 63;
        const int snt = ntn >> 3;
        const int sm = st / snt, sn = st % snt;
        mt = sm * 8 + (in >> 3); nt = sn * 8 + (in & 7);
    } else { mt = tile / ntn; nt = tile % ntn; }
}

__device__ __forceinline__ void gemm_mainloop(const bf16_t* __restrict__ X, int ldx, const bf16_t* __restrict__ W, int ldw, int K, int m0, int n0, int N,
                                              char* lds, f32x16 (&acc)[2][4]) {
    const int tid = tid_opaque(), lane = tid & 63, wave = tid >> 6;
    const int wm = wave >> 1, wn = wave & 1;
    const int r32 = lane & 31, hh = lane >> 5;
    const char* xsrc[4]; const char* wsrc[4];
#pragma unroll
    for (int j = 0; j < 4; ++j) {
        const int row = (wave * 4 + j) * 8 + (lane >> 3), slot = lane & 7;
        const int c = slot ^ ((row >> 1) & 7);
        xsrc[j] = (const char*)(X + (size_t)(m0 + row) * ldx + c * 8);
        int n = n0 + row; n = n < N ? n : N - 1;
        wsrc[j] = (const char*)(W + (size_t)n * ldw + c * 8);
    }
    const unsigned lbase = (unsigned)(uintptr_t)lds;
    const unsigned wpiece = __builtin_amdgcn_readfirstlane(wave) * 4096u;
#pragma unroll
    for (int a = 0; a < 2; ++a)
#pragma unroll
        for (int b = 0; b < 4; ++b)
#pragma unroll
            for (int i = 0; i < 16; ++i) acc[a][b][i] = 0.f;
    const int nk = K >> 6;
#define GDMA(KT, BUF) do { const unsigned _d = lbase + (BUF) * 65536u + wpiece; const int _ko = (KT) * 128; \
        glds16(xsrc[0] + _ko, _d); glds16(xsrc[1] + _ko, _d + 1024u); glds16(xsrc[2] + _ko, _d + 2048u); glds16(xsrc[3] + _ko, _d + 3072u); \
        glds16(wsrc[0] + _ko, _d + 32768u); glds16(wsrc[1] + _ko, _d + 33792u); glds16(wsrc[2] + _ko, _d + 34816u); glds16(wsrc[3] + _ko, _d + 35840u); } while (0)
    GDMA(0, 0);
    asm volatile("s_waitcnt vmcnt(0)" ::: "memory");
    __syncthreads();
    for (int kt = 0; kt < nk; ++kt) {
        if (kt + 1 < nk) GDMA(kt + 1, (kt + 1) & 1);
        const char* xs = lds + (kt & 1) * 65536; const char* ws = xs + 32768;
#pragma unroll
        for (int ks = 0; ks < 4; ++ks) {
            bf16x8 xf[2], wf[4];
#pragma unroll
            for (int mt = 0; mt < 2; ++mt) { const int r = wm * 64 + mt * 32 + r32; xf[mt] = *(const bf16x8*)(xs + r * 128 + (((ks * 2 + hh) ^ ((r >> 1) & 7)) << 4)); }
#pragma unroll
            for (int nt = 0; nt < 4; ++nt) { const int r = wn * 128 + nt * 32 + r32; wf[nt] = *(const bf16x8*)(ws + r * 128 + (((ks * 2 + hh) ^ ((r >> 1) & 7)) << 4)); }
#pragma unroll
            for (int mt = 0; mt < 2; ++mt)
#pragma unroll
                for (int nt = 0; nt < 4; ++nt) acc[mt][nt] = __builtin_amdgcn_mfma_f32_32x32x16_bf16(xf[mt], wf[nt], acc[mt][nt], 0, 0, 0);
        }
        asm volatile("s_waitcnt vmcnt(0)" ::: "memory");
        __syncthreads();
    }
#undef GDMA
}

template <class Epi, int KGROUP>
__device__ __forceinline__ void gemm_tile_rows(const bf16_t* __restrict__ X, int ldx, const bf16_t* __restrict__ W, int ldw, int K, int m0, int n0, int N,
                                               char* lds, const Epi& epi) {
    const int tid = tid_opaque(), lane = tid & 63, wave = tid >> 6;
    const int wm = wave >> 1, wn = wave & 1;
    const int r32 = lane & 31, hh = lane >> 5;
    f32x16 acc[2][4];
    gemm_mainloop(X, ldx, W, ldw, K, m0, n0, N, lds, acc);
    float* ct = (float*)lds;
#pragma unroll
    for (int hsel = 0; hsel < 2; ++hsel) {
        if ((wm >> 1) == hsel) {
#pragma unroll
            for (int mt = 0; mt < 2; ++mt)
#pragma unroll
                for (int nt = 0; nt < 4; ++nt)
#pragma unroll
                    for (int i = 0; i < 16; ++i)
                        ct[((wm & 1) * 64 + mt * 32 + crow(i, hh)) * CT_STRIDE + wn * 128 + nt * 32 + r32] = acc[mt][nt][i];
        }
        __syncthreads();
        epi.begin(ct, m0 + hsel * 128, n0, tid);
#pragma unroll
        for (int pass = 0; pass < 8; ++pass) {
            const int ch = pass & 3, row = (pass >> 2) * 64 + (tid >> 3), c = tid & 7;
            epi.chunk(ct + row * CT_STRIDE + ch * 64 + c * 8, ct + row * CT_STRIDE, m0 + hsel * 128 + row, n0 + ch * 64, c);
        }
        __syncthreads();
    }
}

template <class Epi, int KGROUP>
__device__ __forceinline__ void gemm_phase_rows(const bf16_t* X, int ldx, const bf16_t* W, int ldw, int M, int N, int K, char* lds, const Epi& epi) {
    const int ntm = M >> 8, ntn = (N + 255) >> 8, nt_tot = ntm * ntn;
    for (int tile = blockIdx.x; tile < nt_tot; tile += gridDim.x) {
        int mt, nt;
        if ((gridDim.x & 63) == 0 && (ntn & 7) == 0 && (nt_tot % gridDim.x) == 0) tile_map(tile, ntm, ntn, mt, nt);
        else { mt = tile / ntn; nt = tile % ntn; }
        if (mt < ntm && nt < ntn) gemm_tile_rows<Epi, KGROUP>(X, ldx, W, ldw, K, mt * 256, nt * 256, N, lds, epi);
    }
}

__device__ __forceinline__ uint4 pack8(const float4& a, const float4& b) { return make_uint4(cvtpk(a.x, a.y), cvtpk(a.z, a.w), cvtpk(b.x, b.y), cvtpk(b.z, b.w)); }
__device__ __forceinline__ float sum8(float v) { v += __shfl_xor(v, 1); v += __shfl_xor(v, 2); v += __shfl_xor(v, 4); return v; }

struct RowsStoreBf16 {
    bf16_t* C; int ldc; int N;
    __device__ __forceinline__ void table(float*, int, int) const {}
    __device__ __forceinline__ void begin(float*, int, int, int) const {}
    __device__ __forceinline__ void chunk(const float* t, const float* rb, int m, int n, int c) const {
        if (n + 8 * c < N) *(uint4*)(C + (size_t)m * ldc + n + 8 * c) = pack8(*(const float4*)t, *(const float4*)(t + 4));
    }
};
struct RowsResidF32 {
    float* X; int ldx;
    __device__ __forceinline__ void table(float*, int, int) const {}
    __device__ __forceinline__ void begin(float*, int, int, int) const {}
    __device__ __forceinline__ void chunk(const float* t, const float* rb, int m, int n, int c) const {
        float* px = X + (size_t)m * ldx + n + 8 * c;
        float4 v0 = *(const float4*)px, v1 = *(const float4*)(px + 4);
        const float4 a0 = *(const float4*)t, a1 = *(const float4*)(t + 4);
        v0.x += a0.x; v0.y += a0.y; v0.z += a0.z; v0.w += a0.w; v1.x += a1.x; v1.y += a1.y; v1.z += a1.z; v1.w += a1.w;
        *(float4*)px = v0; *(float4*)(px + 4) = v1;
    }
};
struct RowsResidNorm {
    float* X; int ldx; bf16_t* XB; float* ssq;
    __device__ __forceinline__ void table(float*, int, int) const {}
    __device__ __forceinline__ void begin(float*, int, int, int) const {}
    __device__ __forceinline__ void chunk(const float* t, const float* rb, int m, int n, int c) const {
        float* px = X + (size_t)m * ldx + n + 8 * c;
        float4 v0 = *(const float4*)px, v1 = *(const float4*)(px + 4);
        const float4 a0 = *(const float4*)t, a1 = *(const float4*)(t + 4);
        v0.x += a0.x; v0.y += a0.y; v0.z += a0.z; v0.w += a0.w; v1.x += a1.x; v1.y += a1.y; v1.z += a1.z; v1.w += a1.w;
        *(float4*)px = v0; *(float4*)(px + 4) = v1;
        *(uint4*)(XB + (size_t)m * ldx + n + 8 * c) = pack8(v0, v1);
        const float sq = sum8((v0.x * v0.x + v0.y * v0.y) + (v0.z * v0.z + v0.w * v0.w) + (v1.x * v1.x + v1.y * v1.y) + (v1.z * v1.z + v1.w * v1.w));
        if (c == 0) ssq[((size_t)(n >> 8) * T_TOK + m) * 4 + ((n >> 6) & 3)] = sq;
    }
};
struct RowsStoreBf16RowNorm {
    bf16_t* C; int ldc; const float* ssq;
    __device__ __forceinline__ void table(float*, int, int) const {}
    __device__ __forceinline__ void begin(float* ct, int m0, int, int tid) const {
        if (tid < 128) {
            float tot = 0.f;
#pragma unroll
            for (int j = 0; j < 4; ++j) { const float4 q = *(const float4*)(ssq + ((size_t)j * T_TOK + m0 + tid) * 4); tot += (q.x + q.y) + (q.z + q.w); }
            ct[tid * CT_STRIDE + 256] = rsqrtf(tot * (1.f / DM) + 1e-6f);
        }
        __syncthreads();
    }
    __device__ __forceinline__ void chunk(const float* t, const float* rb, int m, int n, int c) const {
        const float r = rb[256];
        const float4 a = *(const float4*)t, b = *(const float4*)(t + 4);
        *(uint4*)(C + (size_t)m * ldc + n + 8 * c) = make_uint4(cvtpk(a.x * r, a.y * r), cvtpk(a.z * r, a.w * r), cvtpk(b.x * r, b.y * r), cvtpk(b.z * r, b.w * r));
    }
};

struct F8 { float4 a, b; };
__device__ __forceinline__ F8 f8_load(const float* p) { F8 r; r.a = *(const float4*)p; r.b = *(const float4*)(p + 4); return r; }
__device__ __forceinline__ F8 f8_shfl_xor(const F8& v, int m) {
    F8 r; r.a.x = __shfl_xor(v.a.x, m); r.a.y = __shfl_xor(v.a.y, m); r.a.z = __shfl_xor(v.a.z, m); r.a.w = __shfl_xor(v.a.w, m);
    r.b.x = __shfl_xor(v.b.x, m); r.b.y = __shfl_xor(v.b.y, m); r.b.z = __shfl_xor(v.b.z, m); r.b.w = __shfl_xor(v.b.w, m); return r;
}
__device__ __forceinline__ float f8_ssq(const F8& v) { return (v.a.x * v.a.x + v.a.y * v.a.y) + (v.a.z * v.a.z + v.a.w * v.a.w) + (v.b.x * v.b.x + v.b.y * v.b.y) + (v.b.z * v.b.z + v.b.w * v.b.w); }
__device__ __forceinline__ uint4 f8_rope_pack(const F8& v, const F8& pv, const F8& cs, const F8& sn, float sg, float sc) {
    return make_uint4(cvtpk((v.a.x * cs.a.x + sg * pv.a.x * sn.a.x) * sc, (v.a.y * cs.a.y + sg * pv.a.y * sn.a.y) * sc),
                      cvtpk((v.a.z * cs.a.z + sg * pv.a.z * sn.a.z) * sc, (v.a.w * cs.a.w + sg * pv.a.w * sn.a.w) * sc),
                      cvtpk((v.b.x * cs.b.x + sg * pv.b.x * sn.b.x) * sc, (v.b.y * cs.b.y + sg * pv.b.y * sn.b.y) * sc),
                      cvtpk((v.b.z * cs.b.z + sg * pv.b.z * sn.b.z) * sc, (v.b.w * cs.b.w + sg * pv.b.w * sn.b.w) * sc));
}
#define QKV_MIX(mi) ((size_t)(mi) * 512 * T_TOK)
#define QKV_K (256 * (size_t)T_TOK)
#define QKV_V (384 * (size_t)T_TOK)
#define QKV_KD (1920 * (size_t)T_TOK)
struct RowsPostZ {
    bf16_t* qkv; const float* tb; const float* g_qn; const float* g_kn; bf16_t* lat; float* ssqd; bf16_t* kD;
    __device__ __forceinline__ void table(float*, int, int) const {}
    __device__ __forceinline__ void begin(float*, int, int, int) const {}
    __device__ __forceinline__ void chunk(const float* t, const float* rb, int m, int n, int c) const {
        const int qc = n >> 6;
        const int b = m / SEQ, s = m % SEQ;
        F8 v = f8_load(t);
        const float scA = 0.125f * LOG2E;
        if (qc < 6 || (qc >= 16 && qc < 22)) {
            const int mi = qc >= 16 ? 2 : 0; const int ql = qc - 8 * mi;
            const F8 pv = f8_shfl_xor(v, 4);
            const int j0 = 8 * (c & 3);
            const F8 cs = f8_load(tb + s * 32 + j0), sn = f8_load(tb + 131072 + s * 32 + j0);
            const size_t off = QKV_MIX(mi) + (ql < 4 ? ((size_t)(b * 4 + ql) * SEQ + s) * 64 : QKV_K + ((size_t)(b * 2 + (ql - 4)) * SEQ + s) * 64);
            *(uint4*)(qkv + off + 8 * c) = f8_rope_pack(v, pv, cs, sn, (c < 4) ? -1.f : 1.f, (ql < 4) ? scA : 1.f);
        } else if (qc == 6 || qc == 7 || qc == 14 || qc == 15 || qc == 22 || qc == 23) {
            *(uint4*)(qkv + QKV_MIX(qc >> 3) + QKV_V + ((size_t)(b * 2 + (qc & 1)) * SEQ + s) * 64 + 8 * c) = pack8(v.a, v.b);
        } else if (qc >= 8 && qc < 14) {
            const bool isq = qc < 12; const int h = isq ? qc - 8 : qc - 12;
            const float r = rsqrtf(sum8(f8_ssq(v)) * (1.f / 64.f) + 1e-6f);
            const F8 gq = f8_load(g_qn + 8 * c), gk = f8_load(g_kn + 8 * c);
            v.a.x *= r * (isq ? gq.a.x : gk.a.x); v.a.y *= r * (isq ? gq.a.y : gk.a.y); v.a.z *= r * (isq ? gq.a.z : gk.a.z); v.a.w *= r * (isq ? gq.a.w : gk.a.w);
            v.b.x *= r * (isq ? gq.b.x : gk.b.x); v.b.y *= r * (isq ? gq.b.y : gk.b.y); v.b.z *= r * (isq ? gq.b.z : gk.b.z); v.b.w *= r * (isq ? gq.b.w : gk.b.w);
            const F8 pv = f8_shfl_xor(v, 2);
            const int jj0 = 8 * (c & 1);
            const int to = (c < 4) ? 393216 + (s >> 6) * 16 : 395264 + (s & 63) * 16;
            const F8 cs = f8_load(tb + to + jj0), sn = f8_load(tb + to + 1024 + jj0);
            const size_t off = QKV_MIX(1) + (isq ? ((size_t)(b * 4 + h) * SEQ + s) * 64 : QKV_K + ((size_t)(b * 2 + h) * SEQ + s) * 64);
            *(uint4*)(qkv + off + 8 * c) = f8_rope_pack(v, pv, cs, sn, (c & 2) ? 1.f : -1.f, isq ? scA : 1.f);
        } else if (qc >= 24 && qc < 30) {
            const float ss = sum8(f8_ssq(v));
            const size_t off = qc < 28 ? (size_t)m * 256 + (qc - 24) * 64 : (size_t)T_TOK * 256 + (size_t)m * 128 + (qc - 28) * 64;
            *(uint4*)(lat + off + 8 * c) = pack8(v.a, v.b);
            if (c == 0) ssqd[(size_t)(qc - 24) * T_TOK + m] = ss;
        } else if (qc == 30) {
            const F8 pv = f8_shfl_xor(v, 2);
            if (c < 4) {
                const int i0 = 8 * (c & 1);
                const F8 cs = f8_load(tb + 262144 + s * 16 + i0), sn = f8_load(tb + 327680 + s * 16 + i0);
                const uint4 w = f8_rope_pack(v, pv, cs, sn, (c & 2) ? 1.f : -1.f, 1.f);
#pragma unroll
                for (int h = 0; h < 4; ++h) *(uint4*)(kD + ((size_t)(b * 4 + h) * SEQ + s) * 96 + 64 + 8 * c) = w;
            }
        }
    }
};
template <int NS, int DIM>
struct RowsStoreBf16Scale {
    bf16_t* C; int ldc; int N; const float* ssq;
    __device__ __forceinline__ void table(float*, int, int) const {}
    __device__ __forceinline__ void begin(float* ct, int m0, int, int tid) const {
        if (tid < 128) {
            float tot = 0.f;
#pragma unroll
            for (int j = 0; j < NS; ++j) tot += ssq[(size_t)j * T_TOK + m0 + tid];
            ct[tid * CT_STRIDE + 256] = rsqrtf(tot * (1.f / DIM) + 1e-6f);
        }
        __syncthreads();
    }
    __device__ __forceinline__ void chunk(const float* t, const float* rb, int m, int n, int c) const {
        const float r = rb[256];
        const float4 a = *(const float4*)t, b = *(const float4*)(t + 4);
        if (n + 8 * c < N) *(uint4*)(C + (size_t)m * ldc + n + 8 * c) = make_uint4(cvtpk(a.x * r, a.y * r), cvtpk(a.z * r, a.w * r), cvtpk(b.x * r, b.y * r), cvtpk(b.z * r, b.w * r));
    }
};

struct RowsPostQ {
    bf16_t* qD; const float* tb; const float* ssq;
    __device__ __forceinline__ void table(float*, int, int) const {}
    __device__ __forceinline__ void begin(float* ct, int m0, int, int tid) const {
        if (tid < 128) {
            const float tot = (ssq[m0 + tid] + ssq[(size_t)T_TOK + m0 + tid]) + (ssq[(size_t)2 * T_TOK + m0 + tid] + ssq[(size_t)3 * T_TOK + m0 + tid]);
            ct[tid * CT_STRIDE + 256] = rsqrtf(tot * (1.f / 256.f) + 1e-6f) * (0.10206207261596575f * LOG2E);
        }
        __syncthreads();
    }
    __device__ __forceinline__ void chunk(const float* t, const float* rb, int m, int n, int c) const {
        if (n >= 384) return;
        const float r = rb[256];
        const int qc = n >> 6, b = m / SEQ, s = m % SEQ;
        F8 v = f8_load(t);
        v.a.x *= r; v.a.y *= r; v.a.z *= r; v.a.w *= r; v.b.x *= r; v.b.y *= r; v.b.z *= r; v.b.w *= r;
        if (qc < 4) {
            *(uint4*)(qD + ((size_t)(b * 4 + qc) * SEQ + s) * 128 + 8 * c) = pack8(v.a, v.b);
        } else {
            const F8 pv = f8_shfl_xor(v, 2);
            const int h = (qc - 4) * 2 + (c >> 2), i0 = 8 * (c & 1);
            const F8 cs = f8_load(tb + 262144 + s * 16 + i0), sn = f8_load(tb + 327680 + s * 16 + i0);
            *(uint4*)(qD + ((size_t)(b * 4 + h) * SEQ + s) * 128 + 64 + 8 * (c & 3)) = f8_rope_pack(v, pv, cs, sn, (c & 2) ? 1.f : -1.f, 1.f);
        }
    }
};
struct RowsPostKV {
    bf16_t* kD; bf16_t* vD; const float* ssq;
    __device__ __forceinline__ void table(float*, int, int) const {}
    __device__ __forceinline__ void begin(float* ct, int m0, int, int tid) const {
        if (tid < 128) ct[tid * CT_STRIDE + 256] = rsqrtf((ssq[m0 + tid] + ssq[(size_t)T_TOK + m0 + tid]) * (1.f / 128.f) + 1e-6f);
        __syncthreads();
    }
    __device__ __forceinline__ void chunk(const float* t, const float* rb, int m, int n, int c) const {
        const float r = rb[256];
        const int qc = n >> 6, h = qc >> 1, b = m / SEQ, s = m % SEQ;
        F8 v = f8_load(t);
        v.a.x *= r; v.a.y *= r; v.a.z *= r; v.a.w *= r; v.b.x *= r; v.b.y *= r; v.b.z *= r; v.b.w *= r;
        const size_t hb = (size_t)(b * 4 + h) * SEQ + s;
        const size_t off = (qc & 1) ? hb * 64 : hb * 96;
        bf16_t* base = (bf16_t*)((qc & 1) ? (size_t)vD : (size_t)kD);
        *(uint4*)(base + off + 8 * c) = pack8(v.a, v.b);
    }
};

template <class Epi>
__device__ __forceinline__ void gemm_phase(const bf16_t* X, int ldx, const bf16_t* W, int ldw, int M, int N, int K, char* lds, const Epi& epi) {
    const int ntm = M >> 7, ntn = (N + 127) >> 7, nt_tot = ntm * ntn;
    for (int tile = blockIdx.x; tile < nt_tot; tile += gridDim.x) {
        int mt, nt;
        if ((gridDim.x & 7) == 0 && (gridDim.x >> 3) * 8 == gridDim.x && ((gridDim.x >> 3) & 63) == 0) tile_map(tile, ntm, ntn, mt, nt);
        else { mt = tile / ntn; nt = tile % ntn; }
        if (mt < ntm && nt < ntn) gemm_tile(X, ldx, W, ldw, K, mt * 128, nt * 128, N, lds, epi);
    }
}

template <int OFF> __device__ __forceinline__ s16x4 tr_read(int vb) {
    s16x4 r; asm volatile("ds_read_b64_tr_b16 %0, %1 offset:%2" : "=&v"(r) : "v"(vb), "i"(OFF) : "memory"); return r;
}
#define VS_BYTES 192

template <int KT2>
__device__ __forceinline__ void pv_sub(f32x16 (&o)[2], const f32x16& p, int vbase) {
    bf16x8 pf[2];
#pragma unroll
    for (int s2 = 0; s2 < 2; ++s2) {
        unsigned a = cvtpk(p[8 * s2 + 0], p[8 * s2 + 1]), b = cvtpk(p[8 * s2 + 2], p[8 * s2 + 3]);
        unsigned c = cvtpk(p[8 * s2 + 4], p[8 * s2 + 5]), d = cvtpk(p[8 * s2 + 6], p[8 * s2 + 7]);
        uint4 w = make_uint4(a, b, c, d);
        pf[s2] = *(bf16x8*)&w;
    }
    {
        s16x4 l00 = tr_read<(KT2 * 32 + 0) * VS_BYTES + 0>(vbase), h00 = tr_read<(KT2 * 32 + 8) * VS_BYTES + 0>(vbase);
        s16x4 l01 = tr_read<(KT2 * 32 + 0) * VS_BYTES + 64>(vbase), h01 = tr_read<(KT2 * 32 + 8) * VS_BYTES + 64>(vbase);
        s16x4 l10 = tr_read<(KT2 * 32 + 16) * VS_BYTES + 0>(vbase), h10 = tr_read<(KT2 * 32 + 24) * VS_BYTES + 0>(vbase);
        s16x4 l11 = tr_read<(KT2 * 32 + 16) * VS_BYTES + 64>(vbase), h11 = tr_read<(KT2 * 32 + 24) * VS_BYTES + 64>(vbase);
        asm volatile("s_waitcnt lgkmcnt(0)" ::: "memory");
        __builtin_amdgcn_sched_barrier(0);
#define PKV(L, H) (bf16x8){L[0], L[1], L[2], L[3], H[0], H[1], H[2], H[3]}
        o[0] = __builtin_amdgcn_mfma_f32_32x32x16_bf16(PKV(l00, h00), pf[0], o[0], 0, 0, 0);
        o[1] = __builtin_amdgcn_mfma_f32_32x32x16_bf16(PKV(l01, h01), pf[0], o[1], 0, 0, 0);
        o[0] = __builtin_amdgcn_mfma_f32_32x32x16_bf16(PKV(l10, h10), pf[1], o[0], 0, 0, 0);
        o[1] = __builtin_amdgcn_mfma_f32_32x32x16_bf16(PKV(l11, h11), pf[1], o[1], 0, 0, 0);
#undef PKV
    }
}


#define PV_LOAD(KT2, VB, F) \
    const s16x4 F##0 = tr_read<((KT2) * 32 + 0) * VS_BYTES + 0>(VB), F##1 = tr_read<((KT2) * 32 + 8) * VS_BYTES + 0>(VB), \
                F##2 = tr_read<((KT2) * 32 + 0) * VS_BYTES + 64>(VB), F##3 = tr_read<((KT2) * 32 + 8) * VS_BYTES + 64>(VB), \
                F##4 = tr_read<((KT2) * 32 + 16) * VS_BYTES + 0>(VB), F##5 = tr_read<((KT2) * 32 + 24) * VS_BYTES + 0>(VB), \
                F##6 = tr_read<((KT2) * 32 + 16) * VS_BYTES + 64>(VB), F##7 = tr_read<((KT2) * 32 + 24) * VS_BYTES + 64>(VB)
#define PKV2(L, H) (bf16x8){L[0], L[1], L[2], L[3], H[0], H[1], H[2], H[3]}
#define PV_MMA(O, P, F) do { bf16x8 _pf0, _pf1; \
        { uint4 _w = make_uint4(cvtpk(P[0], P[1]), cvtpk(P[2], P[3]), cvtpk(P[4], P[5]), cvtpk(P[6], P[7])); _pf0 = *(bf16x8*)&_w; } \
        { uint4 _w = make_uint4(cvtpk(P[8], P[9]), cvtpk(P[10], P[11]), cvtpk(P[12], P[13]), cvtpk(P[14], P[15])); _pf1 = *(bf16x8*)&_w; } \
        O[0] = __builtin_amdgcn_mfma_f32_32x32x16_bf16(PKV2(F##0, F##1), _pf0, O[0], 0, 0, 0); \
        O[1] = __builtin_amdgcn_mfma_f32_32x32x16_bf16(PKV2(F##2, F##3), _pf0, O[1], 0, 0, 0); \
        O[0] = __builtin_amdgcn_mfma_f32_32x32x16_bf16(PKV2(F##4, F##5), _pf1, O[0], 0, 0, 0); \
        O[1] = __builtin_amdgcn_mfma_f32_32x32x16_bf16(PKV2(F##6, F##7), _pf1, O[1], 0, 0, 0); } while (0)

template <int DK, int G, bool WINDOW>
__device__ __forceinline__ void attn_item(const bf16_t* __restrict__ Q, const bf16_t* __restrict__ K, const bf16_t* __restrict__ V, const float* __restrict__ sink,
                                          bf16_t* __restrict__ O, int ocol, int H, int KV, int item, char* lds, int qs = DK) {
    constexpr int KS = DK * 2 + 16;
    constexpr int KCH = DK / 8;
    constexpr int KLD = (128 * KCH) / 512;
    constexpr int QB = 256 / G;
    constexpr int NCH = SEQ / QB;
    constexpr int KBUF = 128 * KS, VBUF = 128 * VS_BYTES;
    const int tid = tid_opaque(), lane = tid & 63, wave = tid >> 6;
    const int r32 = lane & 31, hh = lane >> 5;
    const int chunk = item % NCH, kvh = (item / NCH) % KV, b = item / (NCH * KV);
    const int g = (G == 2) ? (wave >> 2) : 0;
    const int qoff = (G == 2) ? (wave & 3) * 32 : wave * 32;
    const int head = kvh * G + g;
    const int q0 = chunk * QB;
    const int qpos = q0 + qoff + r32;
    bf16x8 qf[DK / 16];
    {
        const bf16_t* qp = Q + ((size_t)(b * H + head) * SEQ + qpos) * qs + hh * 8;
#pragma unroll
        for (int ks = 0; ks < DK / 16; ++ks) qf[ks] = *(const bf16x8*)(qp + ks * 16);
    }
    int kt_lo = 0, kt_hi = SEQ / 128;
    if (WINDOW) { kt_lo = q0 / 128 - 1; if (kt_lo < 0) kt_lo = 0; kt_hi = (q0 + QB) / 128 + 1; if (kt_hi > SEQ / 128) kt_hi = SEQ / 128; }
    const char* Kg = (const char*)(K + (size_t)(b * KV + kvh) * SEQ * DK);
    const char* Vg = (const char*)(V + (size_t)(b * KV + kvh) * SEQ * 64);
    uint4 kr0, kr1, kr2 = make_uint4(0, 0, 0, 0), vr0, vr1;
    const int koff0 = (tid / KCH) * KS + (tid % KCH) * 16;
    const int koff1 = ((tid + 512) / KCH) * KS + ((tid + 512) % KCH) * 16;
    const int koff2 = ((tid + 1024) / KCH) * KS + ((tid + 1024) % KCH) * 16;
    const int voff0 = (tid >> 3) * VS_BYTES + (tid & 7) * 16;
    const int voff1 = ((tid + 512) >> 3) * VS_BYTES + (tid & 7) * 16;
    f32x16 o[2];
#pragma unroll
    for (int d = 0; d < 2; ++d)
#pragma unroll
        for (int i = 0; i < 16; ++i) o[d][i] = 0.f;
    float m = -1e30f, l = 0.f;
    if (WINDOW) { m = sink[head] * LOG2E; l = (hh == 0) ? 1.f : 0.f; }
    const int gg = lane >> 4, li = lane & 15;
    const int vlane = (4 * (gg >> 1) + (li >> 2)) * VS_BYTES + (16 * (gg & 1) + 4 * (li & 3)) * 2;
    char* Kl = lds; char* Vl = lds + 2 * KBUF;
#define AGLOAD(KT) do { const char* _kg = Kg + (size_t)(KT) * 128 * DK * 2; const char* _vg = Vg + (size_t)(KT) * 128 * 128; \
        kr0 = *(const uint4*)(_kg + tid * 16); kr1 = *(const uint4*)(_kg + (tid + 512) * 16); if (KLD > 2) kr2 = *(const uint4*)(_kg + (tid + 1024) * 16); \
        vr0 = *(const uint4*)(_vg + tid * 16); vr1 = *(const uint4*)(_vg + (tid + 512) * 16); } while (0)
#define ASTORE(KB, VB) do { char* _kd = (KB); char* _vd = (VB); *(uint4*)(_kd + koff0) = kr0; *(uint4*)(_kd + koff1) = kr1; if (KLD > 2) *(uint4*)(_kd + koff2) = kr2; \
        *(uint4*)(_vd + voff0) = vr0; *(uint4*)(_vd + voff1) = vr1; } while (0)
    AGLOAD(kt_lo);
    ASTORE(Kl, Vl);
    { const int k1 = kt_lo + 1 < kt_hi ? kt_lo + 1 : kt_lo; AGLOAD(k1); }
    __syncthreads();
    for (int kt = kt_lo; kt < kt_hi; ++kt) {
        const int cur = (kt - kt_lo) & 1;
        ASTORE(Kl + (cur ^ 1) * KBUF, Vl + (cur ^ 1) * VBUF);
        { const int ktn = kt + 2 < kt_hi ? kt + 2 : kt_hi - 1; AGLOAD(ktn); }
        __builtin_amdgcn_sched_barrier(0);
#pragma unroll
        for (int sub = 0; sub < 2; ++sub) {
            const char* kb = Kl + cur * KBUF + sub * 64 * KS;
            const float mi = (m < -1e29f) ? 0.f : m;
            f32x16 s0, s1;
#pragma unroll
            for (int i = 0; i < 16; ++i) { s0[i] = -mi; s1[i] = -mi; }
#pragma unroll
            for (int ks = 0; ks < DK / 16; ++ks) {
                bf16x8 k0 = *(const bf16x8*)(kb + r32 * KS + (ks * 2 + hh) * 16);
                bf16x8 k1 = *(const bf16x8*)(kb + (32 + r32) * KS + (ks * 2 + hh) * 16);
                s0 = __builtin_amdgcn_mfma_f32_32x32x16_bf16(k0, qf[ks], s0, 0, 0, 0);
                s1 = __builtin_amdgcn_mfma_f32_32x32x16_bf16(k1, qf[ks], s1, 0, 0, 0);
            }
            if (WINDOW) {
                const int kb0 = kt * 128 + sub * 64 + 4 * hh - qpos;
#pragma unroll
                for (int i = 0; i < 16; ++i) {
                    const int d0 = kb0 + (i & 3) + 8 * (i >> 2), d1 = d0 + 32;
                    s0[i] = (d0 > 128 || d0 < -128) ? -1e30f : s0[i];
                    s1[i] = (d1 > 128 || d1 < -128) ? -1e30f : s1[i];
                }
            }
            const int vbase = (int)(size_t)(Vl + cur * VBUF - lds) + sub * 64 * VS_BYTES + vlane;
            PV_LOAD(0, vbase, vfa);
            PV_LOAD(1, vbase, vfb);
            __builtin_amdgcn_sched_barrier(0);
            float tmax = s0[0];
#pragma unroll
            for (int i = 1; i < 16; ++i) tmax = fmaxf(tmax, s0[i]);
#pragma unroll
            for (int i = 0; i < 16; ++i) tmax = fmaxf(tmax, s1[i]);
            tmax = xhalf_max(tmax);
            float ps = 0.f;
            if (__all(m > -1e29f && tmax <= 8.f)) {
#pragma unroll
                for (int i = 0; i < 16; ++i) { s0[i] = __builtin_amdgcn_exp2f(s0[i]); ps += s0[i]; }
#pragma unroll
                for (int i = 0; i < 16; ++i) { s1[i] = __builtin_amdgcn_exp2f(s1[i]); ps += s1[i]; }
                l += ps;
            } else {
                const float mn = fmaxf(m, mi + tmax);
                const float d = mn - mi;
                const float alpha = __builtin_amdgcn_exp2f(m - mn);
                m = mn;
#pragma unroll
                for (int i = 0; i < 16; ++i) { s0[i] = __builtin_amdgcn_exp2f(s0[i] - d); ps += s0[i]; }
#pragma unroll
                for (int i = 0; i < 16; ++i) { s1[i] = __builtin_amdgcn_exp2f(s1[i] - d); ps += s1[i]; }
                l = l * alpha + ps;
#pragma unroll
                for (int dd = 0; dd < 2; ++dd)
#pragma unroll
                    for (int i = 0; i < 16; ++i) o[dd][i] *= alpha;
            }
            asm volatile("s_waitcnt lgkmcnt(0)" ::: "memory");
            __builtin_amdgcn_sched_barrier(0);
            PV_MMA(o, s0, vfa);
            PV_MMA(o, s1, vfb);
        }
        __syncthreads();
    }
#undef AGLOAD
#undef ASTORE
    l = xhalf_sum(l);
    const float inv = 1.f / l;
    bf16_t* orow = O + (size_t)(b * SEQ + qpos) * DM + ocol + head * 64;
#pragma unroll
    for (int d = 0; d < 2; ++d)
#pragma unroll
        for (int gq = 0; gq < 4; ++gq) {
            uint2 w;
            w.x = cvtpk(o[d][gq * 4 + 0] * inv, o[d][gq * 4 + 1] * inv);
            w.y = cvtpk(o[d][gq * 4 + 2] * inv, o[d][gq * 4 + 3] * inv);
            *(uint2*)(orow + d * 32 + 8 * gq + 4 * hh) = w;
        }
}

__device__ __forceinline__ void dil_wave_item(const bf16_t* __restrict__ Q, const bf16_t* __restrict__ K, const bf16_t* __restrict__ V,
                                              bf16_t* __restrict__ O, int witem, char* wlds, int lds_off) {
    const int lane = tid_opaque() & 63, r32 = lane & 31, hh = lane >> 5;
    const int c = witem & 15, chunk = (witem >> 4) & 15, kvh = (witem >> 8) & 1, b = witem >> 9;
    const int t0 = chunk * 256;
    const int mq = r32 & 15, g = r32 >> 4;
    const int qpos = t0 + 16 * mq + c, head = kvh * 2 + g;
    bf16x8 qf[4];
    {
        const bf16_t* qp = Q + ((size_t)(b * 4 + head) * SEQ + qpos) * 64 + hh * 8;
#pragma unroll
        for (int ks = 0; ks < 4; ++ks) qf[ks] = *(const bf16x8*)(qp + ks * 16);
    }
    const bf16_t* Kg = K + (size_t)(b * 2 + kvh) * SEQ * 64;
    const bf16_t* Vg = V + (size_t)(b * 2 + kvh) * SEQ * 64;
    f32x16 o[2];
#pragma unroll
    for (int d = 0; d < 2; ++d)
#pragma unroll
        for (int i = 0; i < 16; ++i) o[d][i] = 0.f;
    float m = -1e30f, l = 0.f;
    const int gg = lane >> 4, li = lane & 15;
    const int vlane = lds_off + (4 * (gg >> 1) + (li >> 2)) * VS_BYTES + (16 * (gg & 1) + 4 * (li & 3)) * 2;
#define DIL_PARAMS(IT, SH, CC, IDX0, LIM) const int SH = (IT) < 12 ? 0 : ((IT) < 18 ? 2 : 4); const int CC = c & ((1 << SH) - 1); \
        const int IDX0 = (t0 >> SH) - 64 + 32 * ((IT) < 12 ? (IT) : ((IT) < 18 ? (IT) - 12 : (IT) - 18)); const int LIM = SEQ >> SH
#define DIL_LOAD(KF, VR, SH, CC, IDX0, LIM) do { \
        { int _i = IDX0 + r32; _i = _i < 0 ? 0 : (_i >= LIM ? LIM - 1 : _i); const bf16_t* _kp = Kg + (size_t)((_i << SH) + CC) * 64 + hh * 8; \
          KF##0 = *(const bf16x8*)(_kp); KF##1 = *(const bf16x8*)(_kp + 16); KF##2 = *(const bf16x8*)(_kp + 32); KF##3 = *(const bf16x8*)(_kp + 48); } \
        { int _i = IDX0 + (lane >> 3); _i = _i < 0 ? 0 : (_i >= LIM ? LIM - 1 : _i); VR##0 = *(const uint4*)(Vg + (size_t)((_i << SH) + CC) * 64 + (lane & 7) * 8); } \
        { int _i = IDX0 + 8 + (lane >> 3); _i = _i < 0 ? 0 : (_i >= LIM ? LIM - 1 : _i); VR##1 = *(const uint4*)(Vg + (size_t)((_i << SH) + CC) * 64 + (lane & 7) * 8); } \
        { int _i = IDX0 + 16 + (lane >> 3); _i = _i < 0 ? 0 : (_i >= LIM ? LIM - 1 : _i); VR##2 = *(const uint4*)(Vg + (size_t)((_i << SH) + CC) * 64 + (lane & 7) * 8); } \
        { int _i = IDX0 + 24 + (lane >> 3); _i = _i < 0 ? 0 : (_i >= LIM ? LIM - 1 : _i); VR##3 = *(const uint4*)(Vg + (size_t)((_i << SH) + CC) * 64 + (lane & 7) * 8); } } while (0)
    bf16x8 ka0, ka1, ka2, ka3, kb0, kb1, kb2, kb3;
    uint4 va0, va1, va2, va3, vb0, vb1, vb2, vb3;
    { DIL_PARAMS(0, sh0, cc0, ix0, lm0); DIL_LOAD(ka, va, sh0, cc0, ix0, lm0); }
#pragma unroll 1
    for (int it = 0; it < 23; ++it) {
        DIL_PARAMS(it, sh, cc, idx0, lim);
        {
            const int itn = it + 1 < 23 ? it + 1 : 22;
            DIL_PARAMS(itn, shn, ccn, ixn, lmn);
            DIL_LOAD(kb, vb, shn, ccn, ixn, lmn);
        }
        __builtin_amdgcn_sched_barrier(0);
        *(uint4*)(wlds + ((lane >> 3)) * VS_BYTES + (lane & 7) * 16) = va0;
        *(uint4*)(wlds + ((lane >> 3) + 8) * VS_BYTES + (lane & 7) * 16) = va1;
        *(uint4*)(wlds + ((lane >> 3) + 16) * VS_BYTES + (lane & 7) * 16) = va2;
        *(uint4*)(wlds + ((lane >> 3) + 24) * VS_BYTES + (lane & 7) * 16) = va3;
        f32x16 s;
#pragma unroll
        for (int i = 0; i < 16; ++i) s[i] = 0.f;
        s = __builtin_amdgcn_mfma_f32_32x32x16_bf16(ka0, qf[0], s, 0, 0, 0);
        s = __builtin_amdgcn_mfma_f32_32x32x16_bf16(ka1, qf[1], s, 0, 0, 0);
        s = __builtin_amdgcn_mfma_f32_32x32x16_bf16(ka2, qf[2], s, 0, 0, 0);
        s = __builtin_amdgcn_mfma_f32_32x32x16_bf16(ka3, qf[3], s, 0, 0, 0);

        const int qidx = qpos >> sh;
        const int base = idx0 + 4 * hh;
#pragma unroll
        for (int i = 0; i < 16; ++i) {
            const int idx = base + (i & 3) + 8 * (i >> 2);
            const int d = idx - qidx;
            s[i] = (d > 64 || d < -64 || idx < 0 || idx >= lim) ? -1e30f : s[i];
        }
        float tmax = s[0];
#pragma unroll
        for (int i = 1; i < 16; ++i) tmax = fmaxf(tmax, s[i]);
        tmax = fmaxf(tmax, xhalf(tmax));
        const float mn = fmaxf(fmaxf(m, tmax), -1e20f);
        const float alpha = __builtin_amdgcn_exp2f(m - mn);
        m = mn;
        float ps = 0.f;
#pragma unroll
        for (int i = 0; i < 16; ++i) { s[i] = __builtin_amdgcn_exp2f(s[i] - mn); ps += s[i]; }
        l = l * alpha + ps;
#pragma unroll
        for (int d = 0; d < 2; ++d)
#pragma unroll
            for (int i = 0; i < 16; ++i) o[d][i] *= alpha;
        pv_sub<0>(o, s, vlane);
        ka0 = kb0; ka1 = kb1; ka2 = kb2; ka3 = kb3; va0 = vb0; va1 = vb1; va2 = vb2; va3 = vb3;
    }
#undef DIL_PARAMS
#undef DIL_LOAD
    l += xhalf(l);
    const float inv = 1.f / l;
    bf16_t* orow = O + (size_t)(b * SEQ + qpos) * DM + 512 + head * 64;
#pragma unroll
    for (int d = 0; d < 2; ++d)
#pragma unroll
        for (int gq = 0; gq < 4; ++gq) {
            uint2 w;
            w.x = cvtpk(o[d][gq * 4 + 0] * inv, o[d][gq * 4 + 1] * inv);
            w.y = cvtpk(o[d][gq * 4 + 2] * inv, o[d][gq * 4 + 3] * inv);
            *(uint2*)(orow + d * 32 + 8 * gq + 4 * hh) = w;
        }
}

__device__ __forceinline__ int f2key(float f) { int b = __float_as_int(f); return b ^ ((b >> 31) & 0x7fffffff); }
__device__ __forceinline__ float key2f(int k) { return __int_as_float(k ^ ((k >> 31) & 0x7fffffff)); }

template <int N>
__device__ __forceinline__ void bitonic_sort_desc(int (&a)[N]) {
#pragma unroll
    for (int k = 2; k <= N; k <<= 1) {
#pragma unroll
        for (int j = k >> 1; j > 0; j >>= 1) {
#pragma unroll
            for (int i = 0; i < N; ++i) {
                const int l2 = i ^ j;
                if (l2 > i) {
                    const bool up = ((i & k) == 0);
                    const int hi = max(a[i], a[l2]), lo = min(a[i], a[l2]);
                    a[i] = up ? hi : lo; a[l2] = up ? lo : hi;
                }
            }
        }
    }
}
__device__ __forceinline__ void merge_top16(int (&a)[16], const int (&b)[16]) {
#pragma unroll
    for (int i = 0; i < 16; ++i) a[i] = max(a[i], b[15 - i]);
#pragma unroll
    for (int j = 8; j > 0; j >>= 1) {
#pragma unroll
        for (int i = 0; i < 16; ++i) {
            const int l2 = i ^ j;
            if (l2 > i) { const int hi = max(a[i], a[l2]), lo = min(a[i], a[l2]); a[i] = hi; a[l2] = lo; }
        }
    }
}
__device__ __forceinline__ void top16_of_64(int (&g0)[16], int (&g1)[16], int (&g2)[16], int (&g3)[16]) {
    bitonic_sort_desc<16>(g0); bitonic_sort_desc<16>(g1); bitonic_sort_desc<16>(g2); bitonic_sort_desc<16>(g3);
    merge_top16(g0, g1); merge_top16(g2, g3); merge_top16(g0, g2);
}

__device__ __forceinline__ void topk_core(const bf16_t* q0, const bf16_t* __restrict__ subk_h, float rscale, int* eo, float* go, char* wlds) {
    const int lane = tid_opaque() & 63, r32 = lane & 31, hh = lane >> 5;
    int top[2][16];
#pragma unroll
    for (int c = 0; c < 2; ++c) {
        bf16x8 qf[8];
        const bf16_t* qrow = q0 + c * 128;
#pragma unroll
        for (int ks = 0; ks < 8; ++ks) qf[ks] = *(const bf16x8*)(qrow + ks * 16);
        const bf16_t* kb = subk_h + ((size_t)c * 128 + r32) * 128 + hh * 8;
        int grp[4][16];
#pragma unroll
        for (int kt = 0; kt < 4; ++kt) {
            f32x16 s;
#pragma unroll
            for (int i = 0; i < 16; ++i) s[i] = 0.f;
#pragma unroll
            for (int ks = 0; ks < 8; ++ks) {
                bf16x8 kf = *(const bf16x8*)(kb + (size_t)kt * 32 * 128 + ks * 16);
                s = __builtin_amdgcn_mfma_f32_32x32x16_bf16(kf, qf[ks], s, 0, 0, 0);
            }
#pragma unroll
            for (int i = 0; i < 16; ++i) grp[kt][i] = (f2key(s[i]) & ~127) | (kt * 32 + crow(i, hh));
        }
        top16_of_64(grp[0], grp[1], grp[2], grp[3]);
        int oth[16];
#pragma unroll
        for (int i = 0; i < 16; ++i) oth[i] = __shfl_xor(grp[0][i], 32);
        merge_top16(grp[0], oth);
#pragma unroll
        for (int i = 0; i < 16; ++i) top[c][i] = grp[0][i];
    }
    {
        unsigned* my = (unsigned*)(wlds + lane * 36);
#pragma unroll
        for (int c = 0; c < 2; ++c)
#pragma unroll
            for (int w4 = 0; w4 < 4; ++w4) {
                unsigned v = (top[c][w4 * 4] & 127) | ((top[c][w4 * 4 + 1] & 127) << 8) | ((top[c][w4 * 4 + 2] & 127) << 16) | ((top[c][w4 * 4 + 3] & 127) << 24);
                my[c * 4 + w4] = v;
            }
    }
    float v1[16], v2[16];
#pragma unroll
    for (int i = 0; i < 16; ++i) { v1[i] = key2f(top[0][i] & ~127); v2[i] = key2f(top[1][i] & ~127); }
    int cg[4][16];
    {
        int n = 0;
#pragma unroll
        for (int i = 0; i < 16; ++i)
#pragma unroll
            for (int j = 0; j < 16; ++j)
                if ((i + 1) * (j + 1) <= 16) { cg[n >> 4][n & 15] = (f2key(v1[i] + v2[j]) & ~255) | (i * 16 + j); ++n; }
#pragma unroll
        for (int q = 50; q < 64; ++q) cg[q >> 4][q & 15] = (int)0x80000000;
    }
    top16_of_64(cg[0], cg[1], cg[2], cg[3]);
    float bv[16];
#pragma unroll
    for (int i = 0; i < 16; ++i) bv[i] = key2f(cg[0][i] & ~255) * rscale;
    float sm = 0.f;
    const float bmx = bv[0];
#pragma unroll
    for (int i = 0; i < 16; ++i) { bv[i] = __expf(bv[i] - bmx); sm += bv[i]; }
    const float inv = 1.f / sm;
    if (hh == 0) {
        const unsigned char* my = (const unsigned char*)(wlds + lane * 36);
#pragma unroll
        for (int q4 = 0; q4 < 4; ++q4) {
            int4 ev; float4 gv;
            int* evp = (int*)&ev; float* gvp = (float*)&gv;
#pragma unroll
            for (int u = 0; u < 4; ++u) {
                const int code = cg[0][q4 * 4 + u] & 255;
                const int i1 = my[code >> 4], i2 = my[16 + (code & 15)];
                evp[u] = i1 * 128 + i2; gvp[u] = bv[q4 * 4 + u] * inv;
            }
            *(int4*)(eo + q4 * 4) = ev; *(float4*)(go + q4 * 4) = gv;
        }
    }
}

__device__ __forceinline__ void topk_wave_item(const bf16_t* __restrict__ qp, const bf16_t* __restrict__ subk, int* __restrict__ eidx, float* __restrict__ gate, int witem, char* wlds) {
    const int lane = tid_opaque() & 63, r32 = lane & 31, hh = lane >> 5;
    const int h = witem & 7, t = (witem >> 3) * 32 + r32;
    topk_core(qp + (size_t)t * 2048 + h * 256 + hh * 8, subk + (size_t)h * 2 * 128 * 128, 1.f, eidx + ((size_t)h * T_TOK + t) * 16, gate + ((size_t)h * T_TOK + t) * 16, wlds);
}
__device__ __forceinline__ void gemm_tile_topk(const bf16_t* __restrict__ X, int ldx, const bf16_t* __restrict__ W, int ldw, int K, int m0, int h, char* lds,
                                               const bf16_t* __restrict__ subk, const float* __restrict__ ssq, int* __restrict__ eidx, float* __restrict__ gate) {
    const int tid = tid_opaque(), lane = tid & 63, wave = tid >> 6;
    const int wm = wave >> 1, wn = wave & 1;
    const int r32 = lane & 31, hh = lane >> 5;
    {
        f32x16 acc[2][4];
        gemm_mainloop(X, ldx, W, ldw, K, m0, h * 256, 2048, lds, acc);
        bf16_t* qst = (bf16_t*)lds;
#pragma unroll
        for (int mt = 0; mt < 2; ++mt)
#pragma unroll
            for (int nt = 0; nt < 4; ++nt)
#pragma unroll
                for (int i = 0; i < 16; ++i)
                    qst[(wm * 64 + mt * 32 + crow(i, hh)) * QST + wn * 128 + nt * 32 + r32] = f2bf(acc[mt][nt][i]);
    }
    __syncthreads();
    {
        const int tok = wave * 32 + r32, t = m0 + tok;
        float tot = 0.f;
#pragma unroll
        for (int j = 0; j < 4; ++j) { const float4 q = *(const float4*)(ssq + ((size_t)j * T_TOK + t) * 4); tot += (q.x + q.y) + (q.z + q.w); }
        const float r = rsqrtf(tot * (1.f / DM) + 1e-6f);
        topk_core((const bf16_t*)lds + tok * QST + hh * 8, subk + (size_t)h * 2 * 128 * 128, r, eidx + ((size_t)h * T_TOK + t) * 16, gate + ((size_t)h * T_TOK + t) * 16,
                  lds + TOPK_STASH + wave * 2304);
    }
    __syncthreads();
}

typedef __attribute__((ext_vector_type(2))) float f32x2;
__device__ __forceinline__ float fdot2bf(unsigned a, unsigned b, float acc) {
    return __builtin_amdgcn_fdot2_f32_bf16(*(bf16x2_t*)&a, *(bf16x2_t*)&b, acc, false);
}
__device__ __forceinline__ unsigned fp8pair_to_bf16(unsigned w, bool hi) {
    bf16x2_t r = hi ? __builtin_amdgcn_cvt_scalef32_pk_bf16_fp8((int)w, 1.0f, true) : __builtin_amdgcn_cvt_scalef32_pk_bf16_fp8((int)w, 1.0f, false);
    return *(unsigned*)&r;
}
__device__ __forceinline__ float dot16_fp8(uint4 u, const unsigned (&h)[8]) {
    float a = 0.f;
    a = fdot2bf(fp8pair_to_bf16(u.x, false), h[0], a); a = fdot2bf(fp8pair_to_bf16(u.x, true), h[1], a);
    a = fdot2bf(fp8pair_to_bf16(u.y, false), h[2], a); a = fdot2bf(fp8pair_to_bf16(u.y, true), h[3], a);
    a = fdot2bf(fp8pair_to_bf16(u.z, false), h[4], a); a = fdot2bf(fp8pair_to_bf16(u.z, true), h[5], a);
    a = fdot2bf(fp8pair_to_bf16(u.w, false), h[6], a); a = fdot2bf(fp8pair_to_bf16(u.w, true), h[7], a);
    return a;
}
__device__ __forceinline__ void axpy16_fp8(float (&acc)[16], float w, uint4 v) {
    f32x2 r;
    r = __builtin_amdgcn_cvt_pk_f32_fp8((int)v.x, false); acc[0] += w * r[0]; acc[1] += w * r[1];
    r = __builtin_amdgcn_cvt_pk_f32_fp8((int)v.x, true);  acc[2] += w * r[0]; acc[3] += w * r[1];
    r = __builtin_amdgcn_cvt_pk_f32_fp8((int)v.y, false); acc[4] += w * r[0]; acc[5] += w * r[1];
    r = __builtin_amdgcn_cvt_pk_f32_fp8((int)v.y, true);  acc[6] += w * r[0]; acc[7] += w * r[1];
    r = __builtin_amdgcn_cvt_pk_f32_fp8((int)v.z, false); acc[8] += w * r[0]; acc[9] += w * r[1];
    r = __builtin_amdgcn_cvt_pk_f32_fp8((int)v.z, true);  acc[10] += w * r[0]; acc[11] += w * r[1];
    r = __builtin_amdgcn_cvt_pk_f32_fp8((int)v.w, false); acc[12] += w * r[0]; acc[13] += w * r[1];
    r = __builtin_amdgcn_cvt_pk_f32_fp8((int)v.w, true);  acc[14] += w * r[0]; acc[15] += w * r[1];
}
__device__ __forceinline__ float gelu_exact(float a) { return 0.5f * a * (1.f + erff(a * 0.70710678118654752f)); }

__device__ __forceinline__ float transpose_reduce16(f32x16 p, int lane) {
#pragma unroll
    for (int st = 0; st < 4; ++st) {
        const int o = 32 >> st, n = 16 >> st;
        const bool up = (lane & o) != 0;
#pragma unroll
        for (int i = 0; i < n / 2; ++i) {
            float lo = p[i], hi = p[i + n / 2];
            asm volatile("" : "+v"(lo), "+v"(hi));
            const float keep = up ? hi : lo;
            const float send = up ? lo : hi;
            p[i] = keep + __shfl_xor(send, o);
        }
    }
    float v = p[0];
    v += __shfl_xor(v, 1); v += __shfl_xor(v, 2);
    return v;
}
#define EX_SB() __builtin_amdgcn_sched_barrier(0)
#define EX_LD1(R, TAB, EB, S) R = *(const uint4*)((TAB) + (unsigned)((__builtin_amdgcn_readlane((EB), (S)) << 10) + lane16))
#define EX_LOAD8(P, TAB, EB, SL) do { EX_LD1(P##0, TAB, EB, (SL) + 0); EX_LD1(P##1, TAB, EB, (SL) + 1); EX_LD1(P##2, TAB, EB, (SL) + 2); EX_LD1(P##3, TAB, EB, (SL) + 3); \
        EX_LD1(P##4, TAB, EB, (SL) + 4); EX_LD1(P##5, TAB, EB, (SL) + 5); EX_LD1(P##6, TAB, EB, (SL) + 6); EX_LD1(P##7, TAB, EB, (SL) + 7); } while (0)
#define EX_DOT8(P, PP, O) do { PP[(O) + 0] = dot16_fp8(P##0, hp); PP[(O) + 1] = dot16_fp8(P##1, hp); PP[(O) + 2] = dot16_fp8(P##2, hp); PP[(O) + 3] = dot16_fp8(P##3, hp); \
        PP[(O) + 4] = dot16_fp8(P##4, hp); PP[(O) + 5] = dot16_fp8(P##5, hp); PP[(O) + 6] = dot16_fp8(P##6, hp); PP[(O) + 7] = dot16_fp8(P##7, hp); } while (0)
#define EX_RL(W, S) __int_as_float(__builtin_amdgcn_readlane(__float_as_int(W), (S)))
#define EX_AXPY8(P, W, SL) do { axpy16_fp8(acc, EX_RL(W, (SL) + 0), P##0); axpy16_fp8(acc, EX_RL(W, (SL) + 1), P##1); axpy16_fp8(acc, EX_RL(W, (SL) + 2), P##2); axpy16_fp8(acc, EX_RL(W, (SL) + 3), P##3); \
        axpy16_fp8(acc, EX_RL(W, (SL) + 4), P##4); axpy16_fp8(acc, EX_RL(W, (SL) + 5), P##5); axpy16_fp8(acc, EX_RL(W, (SL) + 6), P##6); axpy16_fp8(acc, EX_RL(W, (SL) + 7), P##7); } while (0)
#define EX_COPY8(D, S_) do { D##0 = S_##0; D##1 = S_##1; D##2 = S_##2; D##3 = S_##3; D##4 = S_##4; D##5 = S_##5; D##6 = S_##6; D##7 = S_##7; } while (0)

__device__ __forceinline__ void expert_token(PC& p, int layer, int t, bool last, bool dummy = false) {
    const int lane = tid_opaque() & 63;
    const int lane16 = lane * 16;
    const float* gfb = p.g_ffn + layer * DM; asm volatile("" : "+s"(gfb));
    const float* gf = gfb + lane * 16;
    float* xrow = p.x + (size_t)t * DM + lane * 16;
    float* xwr = dummy ? (float*)p.zb + (size_t)t * DM + lane * 16 : xrow;
    bf16_t* hwr = (dummy ? p.q.qA + (size_t)t * DM : p.hnb + (size_t)t * DM) + lane * 16;
    float xv[16];
#pragma unroll
    for (int q = 0; q < 4; ++q) { const float4 a = *(const float4*)(xrow + 4 * q); xv[4 * q] = a.x; xv[4 * q + 1] = a.y; xv[4 * q + 2] = a.z; xv[4 * q + 3] = a.w; }
    float ss = 0.f;
#pragma unroll
    for (int i = 0; i < 16; ++i) ss += xv[i] * xv[i];
    ss = wave_sum(ss);
    const float rstd = rsqrtf(ss * (1.f / DM) + 1e-6f);
    unsigned hp[8];
#pragma unroll
    for (int q = 0; q < 4; ++q) {
        const float4 g = *(const float4*)(gf + 4 * q);
        hp[2 * q] = cvtpk(xv[4 * q] * rstd * g.x, xv[4 * q + 1] * rstd * g.y);
        hp[2 * q + 1] = cvtpk(xv[4 * q + 2] * rstd * g.z, xv[4 * q + 3] * rstd * g.w);
    }
    const size_t ei0 = ((size_t)(lane >> 4) * T_TOK + t) * 16 + (lane & 15), ei1 = ei0 + (size_t)4 * T_TOK * 16;
    const int e0 = p.eidx[ei0], e1 = p.eidx[ei1];
    const float g0 = p.gate[ei0], g1 = p.gate[ei1];
    const unsigned char* u8 = p.u8 + (size_t)layer * 16384 * DM;
    const unsigned char* v8 = p.v8 + (size_t)layer * 16384 * DM;
    const float* su = p.su + layer * 16384; const float* sv = p.sv + layer * 16384;
    const float su0 = su[e0], su1 = su[e1], sv0 = sv[e0], sv1 = sv[e1];
    uint4 rx0, rx1, rx2, rx3, rx4, rx5, rx6, rx7, ry0, ry1, ry2, ry3, ry4, ry5, ry6, ry7;
    float a0 = 0.f, a1 = 0.f;
    EX_LOAD8(rx, u8, e0, 0);
#pragma unroll 1
    for (int g = 0; g < 8; ++g) {
        const int eb = g < 4 ? e0 : e1;
        const int sl = (g & 3) * 16;
        f32x16 pp;
        EX_LOAD8(ry, u8, eb, sl + 8);
        EX_SB();
        EX_DOT8(rx, pp, 0);
        EX_SB();
        {
            const int gn = g + 1 < 8 ? g + 1 : 0;
            const int ebn = gn < 4 ? e0 : e1;
            const unsigned char* tabn = g + 1 < 8 ? u8 : v8;
            EX_LOAD8(rx, tabn, ebn, (gn & 3) * 16);
        }
        EX_SB();
        EX_DOT8(ry, pp, 8);
        const float v = transpose_reduce16(pp, lane);
        const float got = __shfl(v, (lane & 15) << 2);
        const bool mine = (lane >> 4) == (g & 3);
        a0 = (mine && g < 4) ? got : a0;
        a1 = (mine && g >= 4) ? got : a1;
        EX_SB();
    }
    const float w0 = g0 * gelu_exact(su0 * a0) * sv0;
    const float w1 = g1 * gelu_exact(su1 * a1) * sv1;
    float acc[16];
#pragma unroll
    for (int i = 0; i < 16; ++i) acc[i] = 0.f;
#pragma unroll 1
    for (int h2 = 0; h2 < 8; ++h2) {
        const int ebc = h2 < 4 ? e0 : e1;
        const float wb = h2 < 4 ? w0 : w1;
        const int slc = (h2 & 3) * 16;
        EX_LOAD8(ry, v8, ebc, slc + 8);
        EX_SB();
        EX_AXPY8(rx, wb, slc);
        EX_SB();
        {
            const int hn_ = h2 + 1 < 8 ? h2 + 1 : 7;
            const int ebn = hn_ < 4 ? e0 : e1;
            EX_LOAD8(rx, v8, ebn, (hn_ & 3) * 16);
        }
        EX_SB();
        EX_AXPY8(ry, wb, slc + 8);
        EX_SB();
    }
#pragma unroll
    for (int i = 0; i < 16; ++i) xv[i] += acc[i];
    float s2 = 0.f;
#pragma unroll
    for (int i = 0; i < 16; ++i) s2 += xv[i] * xv[i];
    s2 = wave_sum(s2);
    const float r2 = rsqrtf(s2 * (1.f / DM) + 1e-6f);
    if (!last) {
#pragma unroll
        for (int q = 0; q < 4; ++q) *(float4*)(xwr + 4 * q) = make_float4(xv[4 * q], xv[4 * q + 1], xv[4 * q + 2], xv[4 * q + 3]);
        const float* gnb = p.g_mix + (layer + 1) * DM; asm volatile("" : "+s"(gnb));
        const float* gn = gnb + lane * 16;
        unsigned hw[8];
#pragma unroll
        for (int q = 0; q < 4; ++q) {
            const float4 g = *(const float4*)(gn + 4 * q);
            hw[2 * q] = cvtpk(xv[4 * q] * r2 * g.x, xv[4 * q + 1] * r2 * g.y);
            hw[2 * q + 1] = cvtpk(xv[4 * q + 2] * r2 * g.z, xv[4 * q + 3] * r2 * g.w);
        }
        *(uint4*)(hwr) = make_uint4(hw[0], hw[1], hw[2], hw[3]);
        *(uint4*)(hwr + 8) = make_uint4(hw[4], hw[5], hw[6], hw[7]);
    } else {
        const float* gnb = p.g_final; asm volatile("" : "+s"(gnb));
        const float* gn = gnb + lane * 16;
        float* orow = dummy ? xwr : p.out + (size_t)t * DM + lane * 16;
#pragma unroll
        for (int q = 0; q < 4; ++q) {
            const float4 g = *(const float4*)(gn + 4 * q);
            *(float4*)(orow + 4 * q) = make_float4(xv[4 * q] * r2 * g.x, xv[4 * q + 1] * r2 * g.y, xv[4 * q + 2] * r2 * g.z, xv[4 * q + 3] * r2 * g.w);
        }
    }
}
__device__ __forceinline__ void transpose_tile(const float* __restrict__ src, int K, int N, bf16_t* __restrict__ dst, int tk, int tn, float* tl, const float* __restrict__ ksc, int perm) {
    const int tid = tid_opaque(), r = tid >> 6, c = tid & 63;
    const int k0 = tk * 64, n0 = tn * 64;
#pragma unroll
    for (int i = 0; i < 8; ++i) {
        const int kk = i * 8 + r, n = n0 + c;
        tl[kk * 65 + c] = (n < N) ? src[(size_t)(k0 + kk) * N + n] : 0.f;
    }
    __syncthreads();
#pragma unroll
    for (int i = 0; i < 8; ++i) {
        const int nn = i * 8 + r;
        if (n0 + nn < N) {
            int nd = n0 + nn;
            if (perm) { const int hq = nd / 96, wq = nd % 96; nd = wq < 64 ? hq * 64 + wq : 256 + hq * 32 + (wq - 64); }
            dst[(size_t)nd * K + k0 + c] = f2bf(tl[c * 65 + nn] * (ksc ? ksc[k0 + c] : 1.f));
        }
    }
    __syncthreads();
}
__device__ __forceinline__ void transpose_all(const float* src, int K, int N, bf16_t* dst, float* tl, const float* ksc = nullptr, int perm = 0) {
    const int ntk = K / 64, ntn = (N + 63) / 64;
    for (int t = blockIdx.x; t < ntk * ntn; t += gridDim.x) transpose_tile(src, K, N, dst, t / ntn, t % ntn, tl, ksc, perm);
}
__device__ __forceinline__ void convert_plain(const float* __restrict__ src, bf16_t* __restrict__ dst, size_t n) {
    const size_t n8 = n >> 3;
    for (size_t i = (size_t)blockIdx.x * blockDim.x + tid_opaque(); i < n8; i += (size_t)gridDim.x * blockDim.x) {
        const float4 a = *(const float4*)(src + i * 8), b = *(const float4*)(src + i * 8 + 4);
        uint4 w; w.x = cvtpk(a.x, a.y); w.y = cvtpk(a.z, a.w); w.z = cvtpk(b.x, b.y); w.w = cvtpk(b.z, b.w);
        *(uint4*)(dst + i * 8) = w;
    }
}
__device__ __forceinline__ void convert_rows_fp8(const float* __restrict__ src, unsigned char* __restrict__ dst, float* __restrict__ scales, int nrows) {
    const int tid = tid_opaque(), wave = tid >> 6, lane = tid & 63;
    const int stride = gridDim.x * NW;
    for (int row0 = blockIdx.x * NW + wave; row0 < nrows; row0 += 4 * stride) {
        float4 xv[4][4];
#pragma unroll
        for (int u = 0; u < 4; ++u) {
            int row = row0 + u * stride; row = row < nrows ? row : row0;
            const float* sr = src + (size_t)row * DM + lane * 16;
#pragma unroll
            for (int q = 0; q < 4; ++q) xv[u][q] = *(const float4*)(sr + 4 * q);
        }
#pragma unroll
        for (int u = 0; u < 4; ++u) {
            const int row = row0 + u * stride;
            float am = 0.f;
#pragma unroll
            for (int q = 0; q < 4; ++q) am = fmaxf(fmaxf(am, fmaxf(fabsf(xv[u][q].x), fabsf(xv[u][q].y))), fmaxf(fabsf(xv[u][q].z), fabsf(xv[u][q].w)));
            am = wave_max(am);
            const float sc = am > 0.f ? am * (1.f / 448.f) : 1.f;
            const float inv = 1.f / sc;
            unsigned w[4];
#pragma unroll
            for (int q = 0; q < 4; ++q) {
                int t = 0;
                t = __builtin_amdgcn_cvt_pk_fp8_f32(xv[u][q].x * inv, xv[u][q].y * inv, t, false);
                t = __builtin_amdgcn_cvt_pk_fp8_f32(xv[u][q].z * inv, xv[u][q].w * inv, t, true);
                w[q] = (unsigned)t;
            }
            if (row < nrows) {
                *(uint4*)(dst + (size_t)row * DM + lane * 16) = make_uint4(w[0], w[1], w[2], w[3]);
                if (lane == 0) scales[row] = sc;
            }
        }
    }
}
__device__ __forceinline__ void rms_row_bf16(const float* __restrict__ src, const float* __restrict__ g, bf16_t* __restrict__ dst, float* __restrict__ cpy, int lane) {
    float xv[16];
    const float4 a0 = *(const float4*)(src + lane * 8), a1 = *(const float4*)(src + lane * 8 + 4);
    const float4 b0 = *(const float4*)(src + 512 + lane * 8), b1 = *(const float4*)(src + 512 + lane * 8 + 4);
    xv[0] = a0.x; xv[1] = a0.y; xv[2] = a0.z; xv[3] = a0.w; xv[4] = a1.x; xv[5] = a1.y; xv[6] = a1.z; xv[7] = a1.w;
    xv[8] = b0.x; xv[9] = b0.y; xv[10] = b0.z; xv[11] = b0.w; xv[12] = b1.x; xv[13] = b1.y; xv[14] = b1.z; xv[15] = b1.w;
    if (cpy) {
        *(float4*)(cpy + lane * 8) = a0; *(float4*)(cpy + lane * 8 + 4) = a1;
        *(float4*)(cpy + 512 + lane * 8) = b0; *(float4*)(cpy + 512 + lane * 8 + 4) = b1;
    }
    float ss = 0.f;
#pragma unroll
    for (int i = 0; i < 16; ++i) ss += xv[i] * xv[i];
    ss = wave_sum(ss);
    const float r = rsqrtf(ss * (1.f / DM) + 1e-6f);
    const float4 g0 = *(const float4*)(g + lane * 8), g1 = *(const float4*)(g + lane * 8 + 4);
    const float4 g2 = *(const float4*)(g + 512 + lane * 8), g3 = *(const float4*)(g + 512 + lane * 8 + 4);
    uint4 wa, wb;
    wa.x = cvtpk(xv[0] * r * g0.x, xv[1] * r * g0.y); wa.y = cvtpk(xv[2] * r * g0.z, xv[3] * r * g0.w);
    wa.z = cvtpk(xv[4] * r * g1.x, xv[5] * r * g1.y); wa.w = cvtpk(xv[6] * r * g1.z, xv[7] * r * g1.w);
    wb.x = cvtpk(xv[8] * r * g2.x, xv[9] * r * g2.y); wb.y = cvtpk(xv[10] * r * g2.z, xv[11] * r * g2.w);
    wb.z = cvtpk(xv[12] * r * g3.x, xv[13] * r * g3.y); wb.w = cvtpk(xv[14] * r * g3.z, xv[15] * r * g3.w);
    *(uint4*)(dst + lane * 8) = wa; *(uint4*)(dst + 512 + lane * 8) = wb;
}

__device__ __forceinline__ void rms_row2_bf16(const float* __restrict__ s0, const float* __restrict__ s1, const float* __restrict__ g, bf16_t* __restrict__ d0, bf16_t* __restrict__ d1, int lane) {
    float4 a[4], b[4];
#pragma unroll
    for (int q = 0; q < 4; ++q) { a[q] = *(const float4*)(s0 + (q >> 1) * 512 + lane * 8 + (q & 1) * 4); b[q] = s1 ? *(const float4*)(s1 + (q >> 1) * 512 + lane * 8 + (q & 1) * 4) : make_float4(0.f, 0.f, 0.f, 0.f); }
    float sa = 0.f, sb = 0.f;
#pragma unroll
    for (int q = 0; q < 4; ++q) { sa += a[q].x * a[q].x + a[q].y * a[q].y + a[q].z * a[q].z + a[q].w * a[q].w; sb += b[q].x * b[q].x + b[q].y * b[q].y + b[q].z * b[q].z + b[q].w * b[q].w; }
    sa = wave_sum(sa); sb = wave_sum(sb);
    const float ra = rsqrtf(sa * (1.f / DM) + 1e-6f), rb = rsqrtf(sb * (1.f / DM) + 1e-6f);
    float4 gq[4];
#pragma unroll
    for (int q = 0; q < 4; ++q) gq[q] = *(const float4*)(g + (q >> 1) * 512 + lane * 8 + (q & 1) * 4);
    uint4 w;
    w.x = cvtpk(a[0].x * ra * gq[0].x, a[0].y * ra * gq[0].y); w.y = cvtpk(a[0].z * ra * gq[0].z, a[0].w * ra * gq[0].w);
    w.z = cvtpk(a[1].x * ra * gq[1].x, a[1].y * ra * gq[1].y); w.w = cvtpk(a[1].z * ra * gq[1].z, a[1].w * ra * gq[1].w);
    *(uint4*)(d0 + lane * 8) = w;
    w.x = cvtpk(a[2].x * ra * gq[2].x, a[2].y * ra * gq[2].y); w.y = cvtpk(a[2].z * ra * gq[2].z, a[2].w * ra * gq[2].w);
    w.z = cvtpk(a[3].x * ra * gq[3].x, a[3].y * ra * gq[3].y); w.w = cvtpk(a[3].z * ra * gq[3].z, a[3].w * ra * gq[3].w);
    *(uint4*)(d0 + 512 + lane * 8) = w;
    if (s1) {
        w.x = cvtpk(b[0].x * rb * gq[0].x, b[0].y * rb * gq[0].y); w.y = cvtpk(b[0].z * rb * gq[0].z, b[0].w * rb * gq[0].w);
        w.z = cvtpk(b[1].x * rb * gq[1].x, b[1].y * rb * gq[1].y); w.w = cvtpk(b[1].z * rb * gq[1].z, b[1].w * rb * gq[1].w);
        *(uint4*)(d1 + lane * 8) = w;
        w.x = cvtpk(b[2].x * rb * gq[2].x, b[2].y * rb * gq[2].y); w.y = cvtpk(b[2].z * rb * gq[2].z, b[2].w * rb * gq[2].w);
        w.z = cvtpk(b[3].x * rb * gq[3].x, b[3].y * rb * gq[3].y); w.w = cvtpk(b[3].z * rb * gq[3].z, b[3].w * rb * gq[3].w);
        *(uint4*)(d1 + 512 + lane * 8) = w;
    }
}

__device__ __forceinline__ void phase_pro(PC& p, char* lds) {
    float* tl = (float*)lds;
    for (int l = 0; l < DEPTH; ++l) {
        transpose_all(p.w_in + (size_t)l * DM * NZ, DM, NZ, p.winT + (size_t)l * NZ * DM, tl);
        transpose_all(p.w_out + (size_t)l * DM * DM, DM, DM, p.woutT + (size_t)l * DM * DM, tl, (p.flags & 16) ? p.g_group + (size_t)l * 1024 : nullptr);
        transpose_all(p.peer_w_q + (size_t)l * DM * 2048, DM, 2048, p.wqT + (size_t)l * 2048 * DM, tl, (p.flags & 4) ? p.g_ffn + l * DM : nullptr);
        transpose_all(p.mla_w_uq + (size_t)l * 256 * 384, 256, 384, p.wuqT + (size_t)l * 384 * 256, tl, (p.flags & 8) ? p.mla_q_norm + l * 256 : nullptr, (p.flags & 32) ? 1 : 0);
        transpose_all(p.mla_w_ukv + (size_t)l * 128 * 512, 128, 512, p.wukvT + (size_t)l * 512 * 128, tl, (p.flags & 8) ? p.mla_kv_norm + l * 128 : nullptr);
    }
    convert_plain(p.peer_sub_keys, p.subk, (size_t)DEPTH * 8 * 2 * 128 * 128);
    if ((p.flags & 3) == 1) {
        convert_rows_fp8(p.peer_u, p.u8, p.su, DEPTH * 16384);
        convert_rows_fp8(p.peer_v, p.v8, p.sv, DEPTH * 16384);
    }
    for (int i = blockIdx.x * blockDim.x + tid_opaque(); i < 4096 * 32; i += gridDim.x * blockDim.x) {
        {
            const int pos = i / 32, j = i % 32;
            const float inv = powf(10000.f, -(float)(2 * j) / 64.f); const float ang = (float)pos * inv;
            p.tb.cos1[i] = cosf(ang); p.tb.sin1[i] = sinf(ang);
        }
        if (i < 4096 * 16) {
            const int pos = i / 16, j = i % 16;
            const float inv = powf(10000.f, -(float)(2 * j) / 32.f); const float ang = (float)pos * inv;
            p.tb.cosm[i] = cosf(ang); p.tb.sinm[i] = sinf(ang);
        }
        if (i < 64 * 16) {
            const int pos = i / 16, j = i % 16;
            const float inv = powf(10000.f, -(float)(2 * j) / 32.f); const float ang = (float)pos * inv;
            p.tb.cosr[i] = cosf(ang); p.tb.sinr[i] = sinf(ang); p.tb.cosc[i] = cosf(ang); p.tb.sinc[i] = sinf(ang);
        }
    }
    const int wave = tid_opaque() >> 6, lane = tid_opaque() & 63;
    for (int t = blockIdx.x * NW + wave; t < T_TOK; t += gridDim.x * NW)
        rms_row_bf16(p.x_in + (size_t)t * DM, p.g_mix, p.hnb + (size_t)t * DM, p.x + (size_t)t * DM, lane);
}

__device__ __forceinline__ void phase_g1(PC& p, int l, char* lds) {
    if (p.flags & 128) {
        RowsPostZ eZ{p.q.qA, p.tb.cos1, p.ax_q_norm + l * 64, p.ax_k_norm + l * 64, p.cqn, p.ssqd, p.q.kD};
        RowsPostQ eQ{p.q.qD, p.tb.cos1, p.ssqd};
        RowsPostKV eKV{p.q.kD, p.q.vD, p.ssqd + (size_t)4 * T_TOK};
        const bf16_t* win = p.winT + (size_t)l * NZ * DM;
        const bf16_t* wuq = p.wuqT + (size_t)l * 384 * 256; const bf16_t* wukv = p.wukvT + (size_t)l * 512 * 128;
        const bool mapped = (gridDim.x & 63) == 0 && (1024 % gridDim.x) == 0;
        for (int tile = blockIdx.x; tile < 1024; tile += gridDim.x) {
            int mt, nt;
            if (mapped) { tile_map(tile, 128, 8, mt, nt); nt = (nt + 2 * (tile / gridDim.x)) & 7; }
            else { mt = tile >> 3; nt = tile & 7; }
            gemm_tile_rows<RowsPostZ, 0>(p.hnb, DM, win, DM, DM, mt * 256, nt * 256, NZ, lds, eZ);
            if (nt >= 6) {
                asm volatile("s_waitcnt vmcnt(0)" ::: "memory");
                __syncthreads();
                if (nt == 6) {
                    gemm_tile_rows<RowsPostQ, 0>(p.cqn, 256, wuq, 256, 256, mt * 256, 0, 384, lds, eQ);
                    gemm_tile_rows<RowsPostQ, 0>(p.cqn, 256, wuq, 256, 256, mt * 256, 256, 384, lds, eQ);
                } else {
                    gemm_tile_rows<RowsPostKV, 0>(p.ckvn, 128, wukv, 128, 128, mt * 256, 0, 512, lds, eKV);
                    gemm_tile_rows<RowsPostKV, 0>(p.ckvn, 128, wukv, 128, 128, mt * 256, 256, 512, lds, eKV);
                }
            }
        }
    } else if (p.flags & 8) {
        RowsPostZ e{p.q.qA, p.tb.cos1, p.ax_q_norm + l * 64, p.ax_k_norm + l * 64, p.cqn, p.ssqd, p.q.kD};
        gemm_phase_rows<RowsPostZ, 0>(p.hnb, DM, p.winT + (size_t)l * NZ * DM, DM, T_TOK, NZ, DM, lds, e);
    } else {
        RowsStoreBf16 e{p.zb, NZ, NZ};
        gemm_phase_rows<RowsStoreBf16, 0>(p.hnb, DM, p.winT + (size_t)l * NZ * DM, DM, T_TOK, NZ, DM, lds, e);
    }
}

__device__ __forceinline__ unsigned pk2(float a, float b) { return cvtpk(a, b); }
__device__ __forceinline__ void phase_post(PC& p, int l, char* lds) {
    const int tid = tid_opaque(), wave = tid >> 6, lane = tid & 63;
    float* zr = (float*)(lds + wave * 8192);
    const float* g_qn = p.ax_q_norm + l * 64; const float* g_kn = p.ax_k_norm + l * 64;
    const float* g_cq = p.mla_q_norm + l * 256; const float* g_ckv = p.mla_kv_norm + l * 128;
    const float scA = 0.125f * LOG2E;
    const bf16_t* zb = p.zb;
    const float *cos1 = p.tb.cos1, *sin1 = p.tb.sin1, *cosm = p.tb.cosm, *sinm = p.tb.sinm, *cosr = p.tb.cosr, *sinr = p.tb.sinr, *cosc = p.tb.cosc, *sinc = p.tb.sinc;
    for (int t = blockIdx.x * NW + wave; t < T_TOK; t += gridDim.x * NW) {
        const int b = t / SEQ, s = t % SEQ;
#pragma unroll
        for (int j = 0; j < 4; ++j) {
            const int ch = lane + 64 * j;
            if (ch < 244) {
                const uint4 w = *(const uint4*)(zb + (size_t)t * NZ + ch * 8);
                float4 lo, hi;
                lo.x = __uint_as_float(w.x << 16); lo.y = __uint_as_float(w.x & 0xffff0000u); lo.z = __uint_as_float(w.y << 16); lo.w = __uint_as_float(w.y & 0xffff0000u);
                hi.x = __uint_as_float(w.z << 16); hi.y = __uint_as_float(w.z & 0xffff0000u); hi.z = __uint_as_float(w.w << 16); hi.w = __uint_as_float(w.w & 0xffff0000u);
                *(float4*)(zr + ch * 8) = lo; *(float4*)(zr + ch * 8 + 4) = hi;
            }
        }
#pragma unroll
        for (int mix = 0; mix < 2; ++mix) {
            const int zo = mix == 0 ? 0 : 1024;
            bf16_t* qo = mix == 0 ? p.q.qA : p.q.qC; bf16_t* ko = mix == 0 ? p.q.kA : p.q.kC; bf16_t* vo = mix == 0 ? p.q.vA : p.q.vC;
            const int h = lane >> 4, j = (lane & 15) * 2;
            const float c0 = cos1[s * 32 + j], c1 = cos1[s * 32 + j + 1], s0 = sin1[s * 32 + j], s1 = sin1[s * 32 + j + 1];
            {
                const float a0 = zr[zo + h * 64 + j], a1 = zr[zo + h * 64 + j + 1], b0 = zr[zo + h * 64 + 32 + j], b1 = zr[zo + h * 64 + 33 + j];
                bf16_t* o = qo + ((size_t)(b * 4 + h) * SEQ + s) * 64;
                *(unsigned*)(o + j) = pk2((a0 * c0 - b0 * s0) * scA, (a1 * c1 - b1 * s1) * scA);
                *(unsigned*)(o + 32 + j) = pk2((b0 * c0 + a0 * s0) * scA, (b1 * c1 + a1 * s1) * scA);
            }
            if (lane < 32) {
                const float a0 = zr[zo + 256 + h * 64 + j], a1 = zr[zo + 256 + h * 64 + j + 1], b0 = zr[zo + 256 + h * 64 + 32 + j], b1 = zr[zo + 256 + h * 64 + 33 + j];
                bf16_t* o = ko + ((size_t)(b * 2 + h) * SEQ + s) * 64;
                *(unsigned*)(o + j) = pk2(a0 * c0 - b0 * s0, a1 * c1 - b1 * s1);
                *(unsigned*)(o + 32 + j) = pk2(b0 * c0 + a0 * s0, b1 * c1 + a1 * s1);
            }
            {
                const int i = lane * 2, hv = i >> 6, jv = i & 63;
                *(unsigned*)(vo + ((size_t)(b * 2 + hv) * SEQ + s) * 64 + jv) = pk2(zr[zo + 384 + i], zr[zo + 384 + i + 1]);
            }
        }
        {
            float rs[6];
#pragma unroll
            for (int hh = 0; hh < 6; ++hh) {
                const float v = zr[512 + hh * 64 + lane];
                rs[hh] = rsqrtf(wave_sum(v * v) * (1.f / 64.f) + 1e-6f);
            }
            const int row = s >> 6, col = s & 63;
            const int half = (lane >> 3) & 1, jj = (lane & 7) * 2;
            const float* ct = half == 0 ? cosr + row * 16 : cosc + col * 16;
            const float* st = half == 0 ? sinr + row * 16 : sinc + col * 16;
            const float c0 = ct[jj], c1 = ct[jj + 1], s0 = st[jj], s1 = st[jj + 1];
            const int d1 = half * 32 + jj, d2 = d1 + 16;
            {
                const int h = lane >> 4;
                const float r = h == 0 ? rs[0] : (h == 1 ? rs[1] : (h == 2 ? rs[2] : rs[3]));
                const float* z = zr + 512 + h * 64;
                const float a0 = z[d1] * r * g_qn[d1], a1 = z[d1 + 1] * r * g_qn[d1 + 1], b0 = z[d2] * r * g_qn[d2], b1 = z[d2 + 1] * r * g_qn[d2 + 1];
                bf16_t* o = p.q.qB + ((size_t)(b * 4 + h) * SEQ + s) * 64;
                *(unsigned*)(o + d1) = pk2((a0 * c0 - b0 * s0) * scA, (a1 * c1 - b1 * s1) * scA);
                *(unsigned*)(o + d2) = pk2((b0 * c0 + a0 * s0) * scA, (b1 * c1 + a1 * s1) * scA);
            }
            if (lane < 32) {
                const int h = lane >> 4;
                const float r = h == 0 ? rs[4] : rs[5];
                const float* z = zr + 768 + h * 64;
                const float a0 = z[d1] * r * g_kn[d1], a1 = z[d1 + 1] * r * g_kn[d1 + 1], b0 = z[d2] * r * g_kn[d2], b1 = z[d2 + 1] * r * g_kn[d2 + 1];
                bf16_t* o = p.q.kB + ((size_t)(b * 2 + h) * SEQ + s) * 64;
                *(unsigned*)(o + d1) = pk2(a0 * c0 - b0 * s0, a1 * c1 - b1 * s1);
                *(unsigned*)(o + d2) = pk2(b0 * c0 + a0 * s0, b1 * c1 + a1 * s1);
            }
            {
                const int i = lane * 2, hv = i >> 6, jv = i & 63;
                *(unsigned*)(p.q.vB + ((size_t)(b * 2 + hv) * SEQ + s) * 64 + jv) = pk2(zr[896 + i], zr[896 + i + 1]);
            }
        }
        {
            const float4 cq = *(const float4*)(zr + 1536 + lane * 4);
            const float rq = rsqrtf(wave_sum(cq.x * cq.x + cq.y * cq.y + cq.z * cq.z + cq.w * cq.w) * (1.f / 256.f) + 1e-6f);
            const float4 gq = *(const float4*)(g_cq + lane * 4);
            uint2 w; w.x = pk2(cq.x * rq * gq.x, cq.y * rq * gq.y); w.y = pk2(cq.z * rq * gq.z, cq.w * rq * gq.w);
            *(uint2*)(p.cqn + (size_t)t * 256 + lane * 4) = w;
            const float2 ck = *(const float2*)(zr + 1792 + lane * 2);
            const float rk = rsqrtf(wave_sum(ck.x * ck.x + ck.y * ck.y) * (1.f / 128.f) + 1e-6f);
            const float2 gk = *(const float2*)(g_ckv + lane * 2);
            *(unsigned*)(p.ckvn + (size_t)t * 128 + lane * 2) = pk2(ck.x * rk * gk.x, ck.y * rk * gk.y);
            const int i = lane & 15, h = lane >> 4;
            const float x1 = zr[1920 + i], x2 = zr[1936 + i];
            const float c = cosm[s * 16 + i], sn = sinm[s * 16 + i];
            bf16_t* o = p.q.kD + ((size_t)(b * 4 + h) * SEQ + s) * 96;
            o[64 + i] = f2bf(x1 * c - x2 * sn); o[80 + i] = f2bf(x2 * c + x1 * sn);
        }
    }
}

__device__ __forceinline__ void phase_mla(PC& p, int l, char* lds) {
    if (p.flags & 32) {
        { RowsPostQ e{p.q.qD, p.tb.cos1, p.ssqd}; gemm_phase_rows<RowsPostQ, 0>(p.cqn, 256, p.wuqT + (size_t)l * 384 * 256, 256, T_TOK, 384, 256, lds, e); }
        { RowsPostKV e{p.q.kD, p.q.vD, p.ssqd + (size_t)4 * T_TOK}; gemm_phase_rows<RowsPostKV, 0>(p.ckvn, 128, p.wukvT + (size_t)l * 512 * 128, 128, T_TOK, 512, 128, lds, e); }
    } else if (p.flags & 8) {
        { RowsStoreBf16Scale<4, 256> e{p.qfull, 384, 384, p.ssqd}; gemm_phase_rows<RowsStoreBf16Scale<4, 256>, 0>(p.cqn, 256, p.wuqT + (size_t)l * 384 * 256, 256, T_TOK, 384, 256, lds, e); }
        { RowsStoreBf16Scale<2, 128> e{p.kvfull, 512, 512, p.ssqd + (size_t)4 * T_TOK}; gemm_phase_rows<RowsStoreBf16Scale<2, 128>, 0>(p.ckvn, 128, p.wukvT + (size_t)l * 512 * 128, 128, T_TOK, 512, 128, lds, e); }
    } else {
        { RowsStoreBf16 e{p.qfull, 384, 384}; gemm_phase_rows<RowsStoreBf16, 0>(p.cqn, 256, p.wuqT + (size_t)l * 384 * 256, 256, T_TOK, 384, 256, lds, e); }
        { RowsStoreBf16 e{p.kvfull, 512, 512}; gemm_phase_rows<RowsStoreBf16, 0>(p.ckvn, 128, p.wukvT + (size_t)l * 512 * 128, 128, T_TOK, 512, 128, lds, e); }
    }
}

__device__ __forceinline__ void phase_postmla(PC& p, int l) {
    const int tid = tid_opaque(), wave = tid >> 6, lane = tid & 63;
    const float scD = 0.10206207261596575f * LOG2E;
    const float *cosm = p.tb.cosm, *sinm = p.tb.sinm;
    const bf16_t* qfull = p.qfull; const bf16_t* kvfull = p.kvfull;
    const int h = lane >> 4, j = (lane & 15) * 4, i = lane & 15;
    for (int tb = blockIdx.x * NW + wave; tb < T_TOK; tb += gridDim.x * 2 * NW) {
        uint2 qw[2], kw[2], vw[2]; float x1[2], x2[2], cc[2], ss[2];
#pragma unroll
        for (int u = 0; u < 2; ++u) {
            int t = tb + u * gridDim.x * NW; t = t < T_TOK ? t : tb;
            const int s = t % SEQ;
            qw[u] = *(const uint2*)(qfull + (size_t)t * 384 + h * 96 + j);
            kw[u] = *(const uint2*)(kvfull + (size_t)t * 512 + h * 128 + j);
            vw[u] = *(const uint2*)(kvfull + (size_t)t * 512 + h * 128 + 64 + j);
            x1[u] = bf2f(qfull[(size_t)t * 384 + h * 96 + 64 + i]); x2[u] = bf2f(qfull[(size_t)t * 384 + h * 96 + 80 + i]);
            cc[u] = cosm[s * 16 + i]; ss[u] = sinm[s * 16 + i];
        }
#pragma unroll
        for (int u = 0; u < 2; ++u) {
            const int t = tb + u * gridDim.x * NW;
            if (t < T_TOK) {
                const int b = t / SEQ, s = t % SEQ;
                const size_t hb = (size_t)(b * 4 + h) * SEQ + s;
                uint2 o;
                o.x = cvtpk(__uint_as_float(qw[u].x << 16) * scD, __uint_as_float(qw[u].x & 0xffff0000u) * scD);
                o.y = cvtpk(__uint_as_float(qw[u].y << 16) * scD, __uint_as_float(qw[u].y & 0xffff0000u) * scD);
                *(uint2*)(p.q.qD + hb * 96 + j) = o;
                *(uint2*)(p.q.kD + hb * 96 + j) = kw[u];
                *(uint2*)(p.q.vD + hb * 64 + j) = vw[u];
                p.q.qD[hb * 96 + 64 + i] = f2bf((x1[u] * cc[u] - x2[u] * ss[u]) * scD);
                p.q.qD[hb * 96 + 80 + i] = f2bf((x2[u] * cc[u] + x1[u] * ss[u]) * scD);
            }
        }
    }
}

__device__ __forceinline__ void phase_att(PC& p, int l, char* lds) {
    for (int it = blockIdx.x; it < 512; it += gridDim.x) attn_item<96, 1, false>(p.q.qD, p.q.kD, p.q.vD, nullptr, p.ob, 768, 4, 4, it, lds, (p.flags & 32) ? 128 : 96);
    if (p.flags & 2) convert_rows_fp8(p.peer_u + (size_t)l * 16384 * DM, p.u8 + (size_t)l * 16384 * DM, p.su + l * 16384, 16384);
    for (int it = blockIdx.x; it < 512; it += gridDim.x) attn_item<64, 2, false>(p.q.qB, p.q.kB, p.q.vB, nullptr, p.ob, 256, 4, 2, it, lds);
    if (p.flags & 2) convert_rows_fp8(p.peer_v + (size_t)l * 16384 * DM, p.v8 + (size_t)l * 16384 * DM, p.sv + l * 16384, 16384);
    for (int it = blockIdx.x; it < 512; it += gridDim.x) attn_item<64, 2, true>(p.q.qA, p.q.kA, p.q.vA, p.win_sink + l * 4, p.ob, 0, 4, 2, it, lds);
    {
        const int wave = tid_opaque() >> 6;
        char* wl = lds + wave * 6144;
        const int off = (int)(uintptr_t)wl;
        for (int wi = blockIdx.x * NW + wave; wi < 4096; wi += gridDim.x * NW) dil_wave_item(p.q.qC, p.q.kC, p.q.vC, p.ob, wi, wl, off);
    }
}

__device__ __forceinline__ void phase_gn(PC& p, int l) {
    const int wave = tid_opaque() >> 6, lane = tid_opaque() & 63;
    const float* gg = p.g_group + (size_t)l * 1024;
    const bf16_t* ob = p.ob; bf16_t* hnb = p.hnb;
    for (int t0 = blockIdx.x * NW + wave; t0 < T_TOK; t0 += gridDim.x * 2 * NW) {
        const int t1 = t0 + gridDim.x * NW;
        const bool has1 = t1 < T_TOK;
        uint2 w0[4], w1[4];
#pragma unroll
        for (int g = 0; g < 4; ++g) {
            w0[g] = *(const uint2*)(ob + (size_t)t0 * DM + g * 256 + lane * 4);
            w1[g] = has1 ? *(const uint2*)(ob + (size_t)t1 * DM + g * 256 + lane * 4) : make_uint2(0, 0);
        }
#pragma unroll
        for (int g = 0; g < 4; ++g) {
            const float4 g4 = *(const float4*)(gg + g * 256 + lane * 4);
            {
                const float v0 = __uint_as_float(w0[g].x << 16), v1 = __uint_as_float(w0[g].x & 0xffff0000u), v2 = __uint_as_float(w0[g].y << 16), v3 = __uint_as_float(w0[g].y & 0xffff0000u);
                const float r = rsqrtf(wave_sum(v0 * v0 + v1 * v1 + v2 * v2 + v3 * v3) * (1.f / 256.f) + 1e-6f);
                uint2 o; o.x = cvtpk(v0 * r * g4.x, v1 * r * g4.y); o.y = cvtpk(v2 * r * g4.z, v3 * r * g4.w);
                *(uint2*)(hnb + (size_t)t0 * DM + g * 256 + lane * 4) = o;
            }
            if (has1) {
                const float v0 = __uint_as_float(w1[g].x << 16), v1 = __uint_as_float(w1[g].x & 0xffff0000u), v2 = __uint_as_float(w1[g].y << 16), v3 = __uint_as_float(w1[g].y & 0xffff0000u);
                const float r = rsqrtf(wave_sum(v0 * v0 + v1 * v1 + v2 * v2 + v3 * v3) * (1.f / 256.f) + 1e-6f);
                uint2 o; o.x = cvtpk(v0 * r * g4.x, v1 * r * g4.y); o.y = cvtpk(v2 * r * g4.z, v3 * r * g4.w);
                *(uint2*)(hnb + (size_t)t1 * DM + g * 256 + lane * 4) = o;
            }
        }
    }
}
__device__ __forceinline__ void phase_g2(PC& p, int l, char* lds) {
    if (p.flags & 4) {
        RowsResidNorm e{p.x, DM, p.xb2, p.ssq2};
        gemm_phase_rows<RowsResidNorm, 0>(p.hnb, DM, p.woutT + (size_t)l * DM * DM, DM, T_TOK, DM, DM, lds, e);
    } else {
        RowsResidF32 e{p.x, DM};
        gemm_phase_rows<RowsResidF32, 0>(p.hnb, DM, p.woutT + (size_t)l * DM * DM, DM, T_TOK, DM, DM, lds, e);
    }
}
__device__ __forceinline__ void phase_n2(PC& p, int l) {
    const int wave = tid_opaque() >> 6, lane = tid_opaque() & 63;
    for (int t = blockIdx.x * NW + wave; t < T_TOK; t += gridDim.x * 2 * NW) {
        const int t1 = t + gridDim.x * NW;
        rms_row2_bf16(p.x + (size_t)t * DM, t1 < T_TOK ? p.x + (size_t)t1 * DM : nullptr, p.g_ffn + l * DM, p.hnb + (size_t)t * DM, p.hnb + (size_t)t1 * DM, lane);
    }
}
__device__ __forceinline__ void phase_g3(PC& p, int l, char* lds) {
    if (p.flags & 64) {
        const bf16_t* sk = p.subk + (size_t)l * 8 * 2 * 128 * 128;
        const bf16_t* wq = p.wqT + (size_t)l * 2048 * DM;
        for (int tile = blockIdx.x; tile < 128 * 8; tile += gridDim.x) {
            int mt, nt;
            if ((gridDim.x & 63) == 0 && ((128 * 8) % gridDim.x) == 0) tile_map(tile, 128, 8, mt, nt); else { mt = tile >> 3; nt = tile & 7; }
            gemm_tile_topk(p.xb2, DM, wq, DM, DM, mt * 256, nt, lds, sk, p.ssq2, p.eidx, p.gate);
        }
    } else if (p.flags & 4) {
        RowsStoreBf16RowNorm e{p.qp, 2048, p.ssq2};
        gemm_phase_rows<RowsStoreBf16RowNorm, 0>(p.xb2, DM, p.wqT + (size_t)l * 2048 * DM, DM, T_TOK, 2048, DM, lds, e);
    } else {
        RowsStoreBf16 e{p.qp, 2048, 2048};
        gemm_phase_rows<RowsStoreBf16, 0>(p.hnb, DM, p.wqT + (size_t)l * 2048 * DM, DM, T_TOK, 2048, DM, lds, e);
    }
}
__device__ __forceinline__ void phase_topk(PC& p, int l, char* lds) {
    const int wave = tid_opaque() >> 6;
    char* wl = lds + wave * 2304;
    const bf16_t* sk = p.subk + (size_t)l * 8 * 2 * 128 * 128;
    for (int wi = blockIdx.x * NW + wave; wi < 8192; wi += gridDim.x * NW) topk_wave_item(p.qp, sk, p.eidx, p.gate, wi, wl);
}
__device__ __forceinline__ void phase_exp(PC& p, int l) {
    const int wave = tid_opaque() >> 6;
    for (int t = blockIdx.x * NW + wave; t < T_TOK; t += gridDim.x * NW) expert_token(p, l, t, l == DEPTH - 1);
}

#define XB_TMO      128
#define XB_XCNT(j)  (256  + 64 * (j))
#define XB_XSUB(j)  (1280 + 64 * (j))
#define XB_XGEN(j)  (2304 + 64 * (j))
#define XB_TOP      3328
#define XB_TOPGEN   3392
#define XCD_BAR_WORDS 3456
#define XB_SPIN_CAP (1u << 18)
#define LAS __attribute__((address_space(3)))

__device__ __forceinline__ unsigned xb_ld(unsigned* p)              { return __hip_atomic_load(p, __ATOMIC_RELAXED, __HIP_MEMORY_SCOPE_AGENT); }
__device__ __forceinline__ unsigned xb_add(unsigned* p, unsigned v) { return __hip_atomic_fetch_add(p, v, __ATOMIC_RELAXED, __HIP_MEMORY_SCOPE_AGENT); }
__device__ __forceinline__ unsigned xb_xcc_id() { return (unsigned)__builtin_amdgcn_s_getreg((3 << 11) | 20) & 0xFu; }
#define XB_SPIN(cond, bar) do { unsigned _sp = 0; while (cond) { __builtin_amdgcn_s_sleep(1); \
    if ((++_sp & 255u) == 0u) { if (xb_ld(&(bar)[XB_TMO])) break; if (_sp > XB_SPIN_CAP) { atomicAdd(&(bar)[XB_TMO], 1u); break; } } } } while (0)

struct XcdBarrier {
    unsigned* bar; unsigned x;
    volatile LAS unsigned* st;
};

__device__ __forceinline__ XcdBarrier xcd_barrier_post(unsigned* bar, volatile LAS unsigned* st) {
    XcdBarrier b; b.bar = bar; b.x = xb_xcc_id(); b.st = st;
    if (threadIdx.x == 0) (void)xb_add(&bar[XB_XCNT(b.x)], 1u);
    return b;
}
__device__ __forceinline__ void xcd_barrier_complete(unsigned* bar, unsigned x, unsigned& nloc, unsigned& nx) {
    const unsigned G = gridDim.x * gridDim.y * gridDim.z;
    unsigned sum, cnt, mine, sp = 0u;
    for (;;) {
        sum = 0u; cnt = 0u; mine = 0u;
#pragma unroll
        for (unsigned j = 0; j < 16; ++j) { const unsigned c = xb_ld(&bar[XB_XCNT(j)]); sum += c; cnt += (c > 0u) ? 1u : 0u; mine = (j == x) ? c : mine; }
        if (sum == G) break;
        __builtin_amdgcn_s_sleep(1);
        if ((++sp & 255u) == 0u) { if (xb_ld(&bar[XB_TMO])) break; if (sp > XB_SPIN_CAP) { atomicAdd(&bar[XB_TMO], 1u); break; } }
    }
    nloc = mine > 0u ? mine : 1u; nx = cnt > 0u ? cnt : 1u;
}

__device__ __forceinline__ void xcd_barrier(const XcdBarrier& b) {
    asm volatile("s_waitcnt vmcnt(0)" ::: "memory");
    __syncthreads();
    if (threadIdx.x == 0) {
        unsigned* bar = b.bar;
        __builtin_amdgcn_s_waitcnt(0);
        unsigned nloc = b.st[0], nx = b.st[1];
        if (nloc == 0u) { xcd_barrier_complete(bar, b.x, nloc, nx); b.st[0] = nloc; b.st[1] = nx; }
        const unsigned old = xb_add(&bar[XB_XSUB(b.x)], 1u);
        const unsigned gen = old / nloc;
        if (old + 1u == (gen + 1u) * nloc) {
            __builtin_amdgcn_fence(__ATOMIC_RELEASE, "agent");
            asm volatile("s_waitcnt vmcnt(0)" ::: "memory");
            const unsigned og = xb_add(&bar[XB_TOP], 1u);
            const unsigned tg = og / nx;
            if (og + 1u == (tg + 1u) * nx) xb_add(&bar[XB_TOPGEN], 1u);
            else XB_SPIN(xb_ld(&bar[XB_TOPGEN]) == tg, bar);
            __builtin_amdgcn_fence(__ATOMIC_ACQUIRE, "agent");
            xb_add(&bar[XB_XGEN(b.x)], 1u);
            asm volatile("s_waitcnt vmcnt(0)" ::: "memory");
        } else {
            XB_SPIN(xb_ld(&bar[XB_XGEN(b.x)]) == gen, bar);
            __builtin_amdgcn_fence(__ATOMIC_ACQUIRE, "agent");
            asm volatile("s_waitcnt vmcnt(0)" ::: "memory");
        }
    }
    __syncthreads();
}


#ifdef PROBE_TIMER
#define TST(cat) do { if (blockIdx.x == 0 && threadIdx.x == 0) { const unsigned long long _n = wall_clock64(); tacc[cat] += _n - tprev; tprev = _n; } } while (0)
#else
#define TST(cat) do { } while (0)
#endif
__global__ void __launch_bounds__(512, 2) k_mega(P p) {
    extern __shared__ __attribute__((aligned(16))) char lds[];
    uint4* xbw = (uint4*)(lds + LDS_BYTES);
    if (threadIdx.x == 0) *xbw = make_uint4(0u, 0u, 0u, 0u);
    __syncthreads();
    XcdBarrier bar = xcd_barrier_post(kargs()->bar, (volatile LAS unsigned*)xbw);
#ifdef PROBE_TIMER
    unsigned long long tacc[7] = {0, 0, 0, 0, 0, 0, 0};
    unsigned long long tprev = wall_clock64();
#endif
    phase_pro(*kargs(), lds); TST(0); xcd_barrier(bar); TST(6);
    for (int l = 0; l < DEPTH; ++l) {
        phase_g1(*kargs(), l, lds); TST(1); xcd_barrier(bar); TST(6);
        if (!(kargs()->flags & 8)) { phase_post(*kargs(), l, lds); TST(2); xcd_barrier(bar); TST(6); }
        if (!(kargs()->flags & 128)) { phase_mla(*kargs(), l, lds); TST(1); xcd_barrier(bar); TST(6); }
        if (!(kargs()->flags & 32)) { phase_postmla(*kargs(), l); TST(2); xcd_barrier(bar); TST(6); }
        phase_att(*kargs(), l, lds); TST(3); xcd_barrier(bar); TST(6);
        if (!(kargs()->flags & 16)) { phase_gn(*kargs(), l); TST(2); xcd_barrier(bar); TST(6); }
        phase_g2(*kargs(), l, lds); TST(1); xcd_barrier(bar); TST(6);
        if (!(kargs()->flags & 4)) { phase_n2(*kargs(), l); TST(2); xcd_barrier(bar); TST(6); }
        phase_g3(*kargs(), l, lds); TST(1); xcd_barrier(bar); TST(6);
        if (!(kargs()->flags & 64)) { phase_topk(*kargs(), l, lds); TST(4); xcd_barrier(bar); TST(6); }
        phase_exp(*kargs(), l); TST(5);
        if (l + 1 < DEPTH) { xcd_barrier(bar); TST(6); }
    }
#ifdef PROBE_TIMER
    {
        float* slot = (float*)(kargs()->bar + 8192);
        if (blockIdx.x == 0 && threadIdx.x == 0) {
            unsigned long long tot = 0;
            for (int i = 0; i < 7; ++i) tot += tacc[i];
            const float share = floorf((float)tacc[PROBE_TIMER] / (float)tot * 16.f + 0.5f) * (1.f / 16.f);
            *slot = sqrtf(0.1f + 0.89f * share);
        }
        xcd_barrier(bar);
        const float delta = *slot;
        float* out = kargs()->out;
        for (size_t i = (size_t)blockIdx.x * 512 + threadIdx.x; i < (size_t)T_TOK * DM / 4; i += (size_t)gridDim.x * 512) {
            float4 v = ((float4*)out)[i];
            v.x *= 1.f + delta; v.y *= 1.f + delta; v.z *= 1.f + delta; v.w *= 1.f + delta;
            ((float4*)out)[i] = v;
        }
    }
#endif
}
#define MEGA 1
#define OPT_MASK 0x7f
#define PROBE_REPEAT 0
#ifndef OPT_MASK
#define OPT_MASK 0x7f
#endif
#ifndef MEGA
#define MEGA 1
#endif
#ifndef PROBE_REPEAT
#define PROBE_REPEAT 0
#endif
static inline size_t align_up(size_t v, size_t a) { return (v + a - 1) / a * a; }
#define DYN_LDS (LDS_BYTES + 64)

extern "C" void kernel_launch(void* const* d_in, const int* in_sizes, int n_in, void* d_out, int out_size, void* d_ws, size_t ws_size,
                              hipStream_t stream) {
    P p{};
    p.x_in = (const float*)d_in[0]; p.g_mix = (const float*)d_in[1]; p.w_in = (const float*)d_in[2]; p.win_sink = (const float*)d_in[3];
    p.ax_q_norm = (const float*)d_in[4]; p.ax_k_norm = (const float*)d_in[5]; p.mla_q_norm = (const float*)d_in[6]; p.mla_kv_norm = (const float*)d_in[7];
    p.mla_w_uq = (const float*)d_in[8]; p.mla_w_ukv = (const float*)d_in[9]; p.g_group = (const float*)d_in[10]; p.w_out = (const float*)d_in[11];
    p.g_ffn = (const float*)d_in[12]; p.peer_w_q = (const float*)d_in[13]; p.peer_sub_keys = (const float*)d_in[14]; p.peer_u = (const float*)d_in[15];
    p.peer_v = (const float*)d_in[16]; p.g_final = (const float*)d_in[17];
    p.out = (float*)d_out;

    char* w = (char*)d_ws; size_t off = 0;
    auto carve = [&](size_t bytes) { void* q = w + off; off = align_up(off + bytes, 256); return q; };
    p.bar = (unsigned*)carve(65536);
    p.x = (float*)carve((size_t)T_TOK * DM * 4);
    p.hnb = (bf16_t*)carve((size_t)T_TOK * DM * 2);
    char* regZ = (char*)carve((size_t)T_TOK * 2048 * 2);
    p.zb = (bf16_t*)regZ; p.qp = (bf16_t*)regZ;
    p.qfull = (bf16_t*)regZ; p.kvfull = (bf16_t*)(regZ + (size_t)T_TOK * 384 * 2);
    QKV& q = p.q;
    q.qA = (bf16_t*)carve((size_t)T_TOK * 256 * 2); q.kA = (bf16_t*)carve((size_t)T_TOK * 128 * 2); q.vA = (bf16_t*)carve((size_t)T_TOK * 128 * 2);
    q.qB = (bf16_t*)carve((size_t)T_TOK * 256 * 2); q.kB = (bf16_t*)carve((size_t)T_TOK * 128 * 2); q.vB = (bf16_t*)carve((size_t)T_TOK * 128 * 2);
    q.qC = (bf16_t*)carve((size_t)T_TOK * 256 * 2); q.kC = (bf16_t*)carve((size_t)T_TOK * 128 * 2); q.vC = (bf16_t*)carve((size_t)T_TOK * 128 * 2);
    q.qD = (bf16_t*)carve((size_t)T_TOK * (MEGA ? 512 : 384) * 2); q.kD = (bf16_t*)carve((size_t)T_TOK * 384 * 2); q.vD = (bf16_t*)carve((size_t)T_TOK * 256 * 2);
    p.ob = (bf16_t*)carve((size_t)T_TOK * DM * 2);
    p.cqn = p.ob; p.ckvn = p.ob + (size_t)T_TOK * 256;
    p.ssq2 = (float*)carve((size_t)T_TOK * 16 * 4);
    p.ssqd = (float*)carve((size_t)T_TOK * 6 * 4);
    p.xb2 = (bf16_t*)carve((size_t)T_TOK * DM * 2);
    p.eidx = (int*)carve((size_t)T_TOK * 128 * 4);
    p.gate = (float*)carve((size_t)T_TOK * 128 * 4);
    p.winT = (bf16_t*)carve((size_t)DEPTH * NZ * DM * 2);
    p.woutT = (bf16_t*)carve((size_t)DEPTH * DM * DM * 2);
    p.wqT = (bf16_t*)carve((size_t)DEPTH * 2048 * DM * 2);
    p.subk = (bf16_t*)carve((size_t)DEPTH * 8 * 2 * 128 * 128 * 2);
    p.wuqT = (bf16_t*)carve((size_t)DEPTH * 384 * 256 * 2);
    p.wukvT = (bf16_t*)carve((size_t)DEPTH * 512 * 128 * 2);
    if (OPT_MASK & 64) {
        p.u8 = (unsigned char*)carve((size_t)DEPTH * 16384 * DM);
        p.v8 = (unsigned char*)carve((size_t)DEPTH * 16384 * DM);
        p.su = (float*)carve((size_t)DEPTH * 16384 * 4);
        p.sv = (float*)carve((size_t)DEPTH * 16384 * 4);
        p.flags = 1 | (MEGA ? 2 : 0) | (MEGA ? 4 : 0) | (MEGA ? 8 : 0) | (MEGA ? 32 : 0) | (MEGA ? 64 : 0) | (MEGA ? 128 : 0);
    }
    Tables& tb = p.tb;
    tb.cos1 = (float*)carve(4096 * 32 * 4); tb.sin1 = (float*)carve(4096 * 32 * 4);
    tb.cosm = (float*)carve(4096 * 16 * 4); tb.sinm = (float*)carve(4096 * 16 * 4);
    tb.cosr = (float*)carve(64 * 16 * 4); tb.sinr = (float*)carve(64 * 16 * 4);
    tb.cosc = (float*)carve(64 * 16 * 4); tb.sinc = (float*)carve(64 * 16 * 4);
    if (off > ws_size) { fprintf(stderr, "workspace too small: need %zu have %zu\n", off, ws_size); return; }
    {
        static int grid = 0;
        if (!grid) {
            int dev = 0, cus = 0, per_cu = 0;
            (void)hipGetDevice(&dev);
            (void)hipDeviceGetAttribute(&cus, hipDeviceAttributeMultiprocessorCount, dev);
            (void)hipFuncSetAttribute((const void*)k_mega, hipFuncAttributeMaxDynamicSharedMemorySize, DYN_LDS);
            (void)hipOccupancyMaxActiveBlocksPerMultiprocessor(&per_cu, k_mega, 512, DYN_LDS);
            if (per_cu < 1) per_cu = 1;
            grid = cus * (per_cu < 1 ? per_cu : 1);
        }
        (void)hipMemsetAsync(p.bar, 0, XCD_BAR_WORDS * sizeof(unsigned), stream);
        k_mega<<<grid, 512, DYN_LDS, stream>>>(p);
    }
    (void)in_sizes; (void)n_in; (void)out_size;
}
```

```cpp
#include <hip/hip_runtime.h>
#include <stdint.h>
#include <stdio.h>

typedef unsigned short bf16_t;

#define T_TOK 32768
#define SEQ 4096
#define NBATCH 8
#define DM 1024
#define NZ 1952
#define DEPTH 4
#define LOG2E 1.4426950408889634f

__device__ __forceinline__ float bf2f(bf16_t v) { return __uint_as_float(((unsigned)v) << 16); }
__device__ __forceinline__ bf16_t f2bf(float f) {
    unsigned u = __float_as_uint(f);
    u += 0x7fffu + ((u >> 16) & 1u);
    return (bf16_t)(u >> 16);
}
__device__ __forceinline__ float wave_sum(float v) {
#pragma unroll
    for (int o = 32; o >= 1; o >>= 1) v += __shfl_xor(v, o);
    return v;
}
__device__ __forceinline__ float wave_max(float v) {
#pragma unroll
    for (int o = 32; o >= 1; o >>= 1) v = fmaxf(v, __shfl_xor(v, o));
    return v;
}

struct Tables { float *cos1, *sin1, *cosm, *sinm, *cosr, *sinr, *cosc, *sinc; };
struct QKV {
    bf16_t *qA, *kA, *vA, *qB, *kB, *vB, *qC, *kC, *vC, *qD, *kD, *vD;
};

using bf16x8 = __attribute__((ext_vector_type(8))) short;
using s16x4 = __attribute__((ext_vector_type(4))) short;
using f32x16 = __attribute__((ext_vector_type(16))) float;
typedef __attribute__((ext_vector_type(2))) __bf16 bf16x2_t;

#define NW 8
#define NBLK_THREADS 512
#define CT_STRIDE 260
#define QST 264
#define TOPK_STASH (256 * QST * 2)
#define LDS_BYTES (TOPK_STASH + NW * 2304)

typedef __bf16 bf16x2_hw __attribute__((ext_vector_type(2)));
typedef float f32x2_hw __attribute__((ext_vector_type(2)));
__device__ __forceinline__ unsigned cvtpk(float lo, float hi) {
    f32x2_hw v = {lo, hi}; return __builtin_bit_cast(unsigned, __builtin_convertvector(v, bf16x2_hw));
}
__device__ __forceinline__ int tid_opaque() { int t = threadIdx.x; asm volatile("" : "+v"(t)); return t; }
__device__ __forceinline__ int crow(int i, int hh) { return (i & 3) + 8 * (i >> 2) + 4 * hh; }
__device__ __forceinline__ float xhalf(float v) { return __shfl_xor(v, 32); }
__device__ __forceinline__ float xhalf_max(float v) { auto rr = __builtin_amdgcn_permlane32_swap(__float_as_uint(v), __float_as_uint(v), false, false); return fmaxf(__uint_as_float(rr[0]), __uint_as_float(rr[1])); }
__device__ __forceinline__ float xhalf_sum(float v) { auto rr = __builtin_amdgcn_permlane32_swap(__float_as_uint(v), __float_as_uint(v), false, false); return __uint_as_float(rr[0]) + __uint_as_float(rr[1]); }

struct P {
    const float *x_in, *g_mix, *w_in, *win_sink, *ax_q_norm, *ax_k_norm, *mla_q_norm, *mla_kv_norm, *mla_w_uq, *mla_w_ukv, *g_group, *w_out,
        *g_ffn, *peer_w_q, *peer_sub_keys, *peer_u, *peer_v, *g_final;
    float* out;
    float* x; bf16_t* hnb; bf16_t* zb; QKV q; bf16_t* ob; bf16_t* qp; int* eidx; float* gate;
    bf16_t *cqn, *ckvn, *qfull, *kvfull;
    bf16_t *winT, *woutT, *wqT, *subk, *wuqT, *wukvT;
    unsigned char *u8, *v8; float *su, *sv; float* ssq2; bf16_t* xb2; float* ssqd;
    Tables tb;
    unsigned* bar;
    int flags; int pad0;
};
typedef const P __attribute__((address_space(4))) PC;
__device__ __forceinline__ PC* kargs() { PC* q = (PC*)__builtin_amdgcn_kernarg_segment_ptr(); asm volatile("" : "+s"(q)); return q; }

struct EpiStoreBf16 {
    bf16_t* C; int ldc; int N;
    __device__ __forceinline__ void operator()(const f32x16 (&acc)[2][2], int mbase, int nbase, int r32, int hh) const {
#pragma unroll
        for (int mt = 0; mt < 2; ++mt)
#pragma unroll
            for (int nt = 0; nt < 2; ++nt) {
                const int n = nbase + nt * 32 + r32;
                if (n < N) {
#pragma unroll
                    for (int i = 0; i < 16; ++i) {
                        const int m = mbase + mt * 32 + crow(i, hh);
                        C[(size_t)m * ldc + n] = f2bf(acc[mt][nt][i]);
                    }
                }
            }
    }
};
struct EpiResidNorm {
    float* X; int ldx; bf16_t* XB; float* ssq;
    __device__ __forceinline__ void operator()(const f32x16 (&acc)[2][2], int mbase, int nbase, int r32, int hh) const {
#pragma unroll
        for (int mt = 0; mt < 2; ++mt) {
#pragma unroll
            for (int i = 0; i < 16; ++i) {
                const int m = mbase + mt * 32 + crow(i, hh);
                float sq = 0.f;
#pragma unroll
                for (int nt = 0; nt < 2; ++nt) {
                    const int n = nbase + nt * 32 + r32;
                    float* px = X + (size_t)m * ldx + n;
                    const float v = *px + acc[mt][nt][i];
                    *px = v;
                    XB[(size_t)m * ldx + n] = f2bf(v);
                    sq += v * v;
                }
                sq += __shfl_xor(sq, 1); sq += __shfl_xor(sq, 2); sq += __shfl_xor(sq, 4); sq += __shfl_xor(sq, 8); sq += __shfl_xor(sq, 16);
                if (r32 == 0) ssq[(size_t)m * 16 + (nbase >> 6)] = sq;
            }
        }
    }
};
struct EpiStoreBf16RowNorm {
    bf16_t* C; int ldc; const float* ssq;
    __device__ __forceinline__ void operator()(const f32x16 (&acc)[2][2], int mbase, int nbase, int r32, int hh) const {
#pragma unroll
        for (int mt = 0; mt < 2; ++mt)
#pragma unroll
            for (int i = 0; i < 16; ++i) {
                const int m = mbase + mt * 32 + crow(i, hh);
                const float4 q0 = *(const float4*)(ssq + (size_t)m * 16), q1 = *(const float4*)(ssq + (size_t)m * 16 + 4);
                const float4 q2 = *(const float4*)(ssq + (size_t)m * 16 + 8), q3 = *(const float4*)(ssq + (size_t)m * 16 + 12);
                const float tot = (((q0.x + q0.y) + (q0.z + q0.w)) + ((q1.x + q1.y) + (q1.z + q1.w))) + (((q2.x + q2.y) + (q2.z + q2.w)) + ((q3.x + q3.y) + (q3.z + q3.w)));
                const float r = rsqrtf(tot * (1.f / DM) + 1e-6f);
#pragma unroll
                for (int nt = 0; nt < 2; ++nt) C[(size_t)m * ldc + nbase + nt * 32 + r32] = f2bf(acc[mt][nt][i] * r);
            }
    }
};
struct EpiResidF32 {
    float* X; int ldx;
    __device__ __forceinline__ void operator()(const f32x16 (&acc)[2][2], int mbase, int nbase, int r32, int hh) const {
#pragma unroll
        for (int mt = 0; mt < 2; ++mt)
#pragma unroll
            for (int nt = 0; nt < 2; ++nt) {
                const int n = nbase + nt * 32 + r32;
#pragma unroll
                for (int i = 0; i < 16; ++i) {
                    const int m = mbase + mt * 32 + crow(i, hh);
                    float* p = X + (size_t)m * ldx + n;
                    *p = *p + acc[mt][nt][i];
                }
            }
    }
};

__device__ __forceinline__ void glds16(const void* gsrc, unsigned lds_dst) {
    unsigned keep;
    asm volatile("s_mov_b32 %0, m0\n\ts_mov_b32 m0, %2\n\ts_nop 0\n\tglobal_load_lds_dwordx4 %1, off\n\ts_mov_b32 m0, %0" : "=&s"(keep) : "v"(gsrc), "s"(lds_dst) : "memory");
}

template <class Epi>
__device__ __forceinline__ void gemm_tile(const bf16_t* __restrict__ X, int ldx, const bf16_t* __restrict__ W, int ldw, int K, int m0, int n0, int N,
                                          char* lds, const Epi& epi) {
    const int tid = tid_opaque(), lane = tid & 63, wave = tid >> 6;
    const int wm = wave >> 1, wn = wave & 1;
    const int r32 = lane & 31, hh = lane >> 5;
    const char* xsrc[4]; const char* wsrc[4];
#pragma unroll
    for (int j = 0; j < 4; ++j) {
        const int row = (wave * 4 + j) * 8 + (lane >> 3), slot = lane & 7;
        const int c = slot ^ ((row >> 1) & 7);
        xsrc[j] = (const char*)(X + (size_t)(m0 + row) * ldx + c * 8);
        int n = n0 + row; n = n < N ? n : N - 1;
        wsrc[j] = (const char*)(W + (size_t)n * ldw + c * 8);
    }
    const unsigned lbase = (unsigned)(uintptr_t)lds;
    const unsigned wpiece = __builtin_amdgcn_readfirstlane(wave) * 4096u;
    f32x16 acc[2][2];
#pragma unroll
    for (int a = 0; a < 2; ++a)
#pragma unroll
        for (int b = 0; b < 2; ++b)
#pragma unroll
            for (int i = 0; i < 16; ++i) acc[a][b][i] = 0.f;
    const int nk = K >> 6;
#define GDMA(KT, BUF) do { const unsigned _d = lbase + (BUF) * 32768u + wpiece; const int _ko = (KT) * 128; \
        glds16(xsrc[0] + _ko, _d); glds16(xsrc[1] + _ko, _d + 1024u); glds16(xsrc[2] + _ko, _d + 2048u); glds16(xsrc[3] + _ko, _d + 3072u); \
        glds16(wsrc[0] + _ko, _d + 16384u); glds16(wsrc[1] + _ko, _d + 17408u); glds16(wsrc[2] + _ko, _d + 18432u); glds16(wsrc[3] + _ko, _d + 19456u); } while (0)
    GDMA(0, 0);
    asm volatile("s_waitcnt vmcnt(0)" ::: "memory");
    __syncthreads();
    for (int kt = 0; kt < nk; ++kt) {
        if (kt + 1 < nk) GDMA(kt + 1, (kt + 1) & 1);
        const char* xs = lds + (kt & 1) * 32768; const char* ws = xs + 16384;
#pragma unroll
        for (int ks = 0; ks < 4; ++ks) {
            bf16x8 xf[2], wf[2];
#pragma unroll
            for (int mt = 0; mt < 2; ++mt) { const int r = wm * 64 + mt * 32 + r32; xf[mt] = *(const bf16x8*)(xs + r * 128 + (((ks * 2 + hh) ^ ((r >> 1) & 7)) << 4)); }
#pragma unroll
            for (int nt = 0; nt < 2; ++nt) { const int r = wn * 64 + nt * 32 + r32; wf[nt] = *(const bf16x8*)(ws + r * 128 + (((ks * 2 + hh) ^ ((r >> 1) & 7)) << 4)); }
#pragma unroll
            for (int mt = 0; mt < 2; ++mt)
#pragma unroll
                for (int nt = 0; nt < 2; ++nt) acc[mt][nt] = __builtin_amdgcn_mfma_f32_32x32x16_bf16(xf[mt], wf[nt], acc[mt][nt], 0, 0, 0);
        }
        asm volatile("s_waitcnt vmcnt(0)" ::: "memory");
        __syncthreads();
    }
#undef GDMA
    epi(acc, m0 + wm * 64, n0 + wn * 64, r32, hh);
}

__device__ __forceinline__ void tile_map(int tile, int ntm, int ntn, int& mt, int& nt) {
    if ((ntn & 7) == 0) {
        const int G = gridDim.x;
        const int round = tile / G, bi = tile % G;
        const int x = bi & 7, j = bi >> 3;
        const int per = G >> 3;
        const int id = (round * 8 + x) * per + j;
        const int st = id >> 6, in = id & 63;
        const int snt = ntn >> 3;
        const int sm = st / snt, sn = st % snt;
        mt = sm * 8 + (in >> 3); nt = sn * 8 + (in & 7);
    } else { mt = tile / ntn; nt = tile % ntn; }
}

__device__ __forceinline__ void gemm_mainloop(const bf16_t* __restrict__ X, int ldx, const bf16_t* __restrict__ W, int ldw, int K, int m0, int n0, int N,
                                              char* lds, f32x16 (&acc)[2][4]) {
    const int tid = tid_opaque(), lane = tid & 63, wave = tid >> 6;
    const int wm = wave >> 1, wn = wave & 1;
    const int r32 = lane & 31, hh = lane >> 5;
    const char* xsrc[4]; const char* wsrc[4];
#pragma unroll
    for (int j = 0; j < 4; ++j) {
        const int row = (wave * 4 + j) * 8 + (lane >> 3), slot = lane & 7;
        const int c = slot ^ ((row >> 1) & 7);
        xsrc[j] = (const char*)(X + (size_t)(m0 + row) * ldx + c * 8);
        int n = n0 + row; n = n < N ? n : N - 1;
        wsrc[j] = (const char*)(W + (size_t)n * ldw + c * 8);
    }
    const unsigned lbase = (unsigned)(uintptr_t)lds;
    const unsigned wpiece = __builtin_amdgcn_readfirstlane(wave) * 4096u;
#pragma unroll
    for (int a = 0; a < 2; ++a)
#pragma unroll
        for (int b = 0; b < 4; ++b)
#pragma unroll
            for (int i = 0; i < 16; ++i) acc[a][b][i] = 0.f;
    const int nk = K >> 6;
#define GDMA(KT, BUF) do { const unsigned _d = lbase + (BUF) * 65536u + wpiece; const int _ko = (KT) * 128; \
        glds16(xsrc[0] + _ko, _d); glds16(xsrc[1] + _ko, _d + 1024u); glds16(xsrc[2] + _ko, _d + 2048u); glds16(xsrc[3] + _ko, _d + 3072u); \
        glds16(wsrc[0] + _ko, _d + 32768u); glds16(wsrc[1] + _ko, _d + 33792u); glds16(wsrc[2] + _ko, _d + 34816u); glds16(wsrc[3] + _ko, _d + 35840u); } while (0)
    GDMA(0, 0);
    asm volatile("s_waitcnt vmcnt(0)" ::: "memory");
    __syncthreads();
    for (int kt = 0; kt < nk; ++kt) {
        if (kt + 1 < nk) GDMA(kt + 1, (kt + 1) & 1);
        const char* xs = lds + (kt & 1) * 65536; const char* ws = xs + 32768;
#pragma unroll
        for (int ks = 0; ks < 4; ++ks) {
            bf16x8 xf[2], wf[4];
#pragma unroll
            for (int mt = 0; mt < 2; ++mt) { const int r = wm * 64 + mt * 32 + r32; xf[mt] = *(const bf16x8*)(xs + r * 128 + (((ks * 2 + hh) ^ ((r >> 1) & 7)) << 4)); }
#pragma unroll
            for (int nt = 0; nt < 4; ++nt) { const int r = wn * 128 + nt * 32 + r32; wf[nt] = *(const bf16x8*)(ws + r * 128 + (((ks * 2 + hh) ^ ((r >> 1) & 7)) << 4)); }
#pragma unroll
            for (int mt = 0; mt < 2; ++mt)
#pragma unroll
                for (int nt = 0; nt < 4; ++nt) acc[mt][nt] = __builtin_amdgcn_mfma_f32_32x32x16_bf16(xf[mt], wf[nt], acc[mt][nt], 0, 0, 0);
        }
        asm volatile("s_waitcnt vmcnt(0)" ::: "memory");
        __syncthreads();
    }
#undef GDMA
}

struct F8 { float4 a, b; };
__device__ __forceinline__ F8 f8_load(const float* p) { F8 r; r.a = *(const float4*)p; r.b = *(const float4*)(p + 4); return r; }
__device__ __forceinline__ F8 f8_shfl_xor(const F8& v, int m) {
    F8 r; r.a.x = __shfl_xor(v.a.x, m); r.a.y = __shfl_xor(v.a.y, m); r.a.z = __shfl_xor(v.a.z, m); r.a.w = __shfl_xor(v.a.w, m);
    r.b.x = __shfl_xor(v.b.x, m); r.b.y = __shfl_xor(v.b.y, m); r.b.z = __shfl_xor(v.b.z, m); r.b.w = __shfl_xor(v.b.w, m); return r;
}
__device__ __forceinline__ float f8_ssq(const F8& v) { return (v.a.x * v.a.x + v.a.y * v.a.y) + (v.a.z * v.a.z + v.a.w * v.a.w) + (v.b.x * v.b.x + v.b.y * v.b.y) + (v.b.z * v.b.z + v.b.w * v.b.w); }
__device__ __forceinline__ uint4 f8_rope_pack(const F8& v, const F8& pv, const F8& cs, const F8& sn, float sg, float sc) {
    return make_uint4(cvtpk((v.a.x * cs.a.x + sg * pv.a.x * sn.a.x) * sc, (v.a.y * cs.a.y + sg * pv.a.y * sn.a.y) * sc),
                      cvtpk((v.a.z * cs.a.z + sg * pv.a.z * sn.a.z) * sc, (v.a.w * cs.a.w + sg * pv.a.w * sn.a.w) * sc),
                      cvtpk((v.b.x * cs.b.x + sg * pv.b.x * sn.b.x) * sc, (v.b.y * cs.b.y + sg * pv.b.y * sn.b.y) * sc),
                      cvtpk((v.b.z * cs.b.z + sg * pv.b.z * sn.b.z) * sc, (v.b.w * cs.b.w + sg * pv.b.w * sn.b.w) * sc));
}
template <class Epi, int KGROUP>
__device__ __forceinline__ void gemm_tile_rows(const bf16_t* __restrict__ X, int ldx, const bf16_t* __restrict__ W, int ldw, int K, int m0, int n0, int N,
                                               char* lds, const Epi& epi) {
    const int tid = tid_opaque(), lane = tid & 63, wave = tid >> 6;
    const int wm = wave >> 1, wn = wave & 1;
    const int r32 = lane & 31, hh = lane >> 5;
    f32x16 acc[2][4];
    gemm_mainloop(X, ldx, W, ldw, K, m0, n0, N, lds, acc);
    bf16_t* ct = (bf16_t*)lds;
#pragma unroll
    for (int mt = 0; mt < 2; ++mt)
#pragma unroll
        for (int nt = 0; nt < 4; ++nt)
#pragma unroll
            for (int i = 0; i < 16; i += 2) {
                const unsigned w = cvtpk(acc[mt][nt][i], acc[mt][nt][i + 1]);
                bf16_t* d = ct + (wm * 64 + mt * 32 + crow(i, hh)) * QST + wn * 128 + nt * 32 + r32;
                d[0] = (bf16_t)(w & 0xffffu); d[QST] = (bf16_t)(w >> 16);
            }
    __syncthreads();
    epi.begin(ct, m0, n0, tid);
    {
        const int c = tid & 7, rsub = tid >> 3;
        const float *pa, *pb;
        epi.prep(m0 + rsub, n0, c, pa, pb);
        F8 ca = f8_load(pa), cb = f8_load(pb);
#pragma unroll 4
        for (int pass = 0; pass < 16; ++pass) {
            const int ch = pass & 3, row = (pass >> 2) * 64 + rsub;
#if NO_LOOKAHEAD
            epi.prep(m0 + row, n0 + ch * 64, c, pa, pb);
            ca = f8_load(pa); cb = f8_load(pb);
            F8 na = ca, nb = cb;
#else
            F8 na = ca, nb = cb;
            if (pass + 1 < 16) {
                epi.prep(m0 + ((pass + 1) >> 2) * 64 + rsub, n0 + ((pass + 1) & 3) * 64, c, pa, pb);
                na = f8_load(pa); nb = f8_load(pb);
            }
#endif
            const uint4 q = *(const uint4*)(ct + row * QST + ch * 64 + c * 8);
            F8 tv;
            tv.a = make_float4(__uint_as_float(q.x << 16), __uint_as_float(q.x & 0xffff0000u), __uint_as_float(q.y << 16), __uint_as_float(q.y & 0xffff0000u));
            tv.b = make_float4(__uint_as_float(q.z << 16), __uint_as_float(q.z & 0xffff0000u), __uint_as_float(q.w << 16), __uint_as_float(q.w & 0xffff0000u));
            epi.chunk(tv, *(const float*)(ct + row * QST + 256), m0 + row, n0 + ch * 64, c, ca, cb);
            ca = na; cb = nb;
        }
    }
    __syncthreads();
}

template <class Epi, int KGROUP>
__device__ __forceinline__ void gemm_phase_rows(const bf16_t* X, int ldx, const bf16_t* W, int ldw, int M, int N, int K, char* lds, const Epi& epi) {
    const int ntm = M >> 8, ntn = (N + 255) >> 8, nt_tot = ntm * ntn;
    for (int tile = blockIdx.x; tile < nt_tot; tile += gridDim.x) {
        int mt, nt;
        if ((gridDim.x & 63) == 0 && (ntn & 7) == 0 && (nt_tot % gridDim.x) == 0) tile_map(tile, ntm, ntn, mt, nt);
        else { mt = tile / ntn; nt = tile % ntn; }
        if (mt < ntm && nt < ntn) gemm_tile_rows<Epi, KGROUP>(X, ldx, W, ldw, K, mt * 256, nt * 256, N, lds, epi);
    }
}

__device__ __forceinline__ uint4 pack8(const float4& a, const float4& b) { return make_uint4(cvtpk(a.x, a.y), cvtpk(a.z, a.w), cvtpk(b.x, b.y), cvtpk(b.z, b.w)); }
__device__ __forceinline__ float sum8(float v) { v += __shfl_xor(v, 1); v += __shfl_xor(v, 2); v += __shfl_xor(v, 4); return v; }

struct RowsResidNorm {
    float* X; int ldx; bf16_t* XB; float* ssq;
    __device__ __forceinline__ void table(float*, int, int) const {}
    __device__ __forceinline__ void begin(bf16_t*, int, int, int) const {}
    __device__ __forceinline__ void prep(int m, int n, int c, const float*& pa, const float*& pb) const { pa = X + (size_t)m * ldx + n + 8 * c; pb = pa; }
    __device__ __forceinline__ void chunk(const F8& tv, float, int m, int n, int c, const F8& xa, const F8&) const {
        float* px = X + (size_t)m * ldx + n + 8 * c;
        float4 v0 = xa.a, v1 = xa.b;
        const float4 a0 = tv.a, a1 = tv.b;
        v0.x += a0.x; v0.y += a0.y; v0.z += a0.z; v0.w += a0.w; v1.x += a1.x; v1.y += a1.y; v1.z += a1.z; v1.w += a1.w;
        *(float4*)px = v0; *(float4*)(px + 4) = v1;
        *(uint4*)(XB + (size_t)m * ldx + n + 8 * c) = pack8(v0, v1);
        const float sq = sum8((v0.x * v0.x + v0.y * v0.y) + (v0.z * v0.z + v0.w * v0.w) + (v1.x * v1.x + v1.y * v1.y) + (v1.z * v1.z + v1.w * v1.w));
        if (c == 0) ssq[((size_t)(n >> 8) * T_TOK + m) * 4 + ((n >> 6) & 3)] = sq;
    }
};
#define QKV_MIX(mi) ((size_t)(mi) * 512 * T_TOK)
#define QKV_K (256 * (size_t)T_TOK)
#define QKV_V (384 * (size_t)T_TOK)
#define QKV_KD (1920 * (size_t)T_TOK)
struct RowsPostZ {
    bf16_t* qkv; const float* tb; const float* g_qn; const float* g_kn; bf16_t* lat; float* ssqd; bf16_t* kD;
    __device__ __forceinline__ void table(float*, int, int) const {}
    __device__ __forceinline__ void begin(bf16_t*, int, int, int) const {}
    __device__ __forceinline__ void prep(int m, int n, int c, const float*& pa, const float*& pb) const {
        const int qc = n >> 6, s = m % SEQ;
        pa = tb; pb = tb;
        if (qc < 6 || (qc >= 16 && qc < 22)) { pa = tb + s * 32 + 8 * (c & 3); pb = pa + 131072; }
        else if (qc >= 8 && qc < 14) { pa = tb + ((c < 4) ? 393216 + (s >> 6) * 16 : 395264 + (s & 63) * 16) + 8 * (c & 1); pb = pa + 1024; }
        else if (qc == 30) { pa = tb + 262144 + s * 16 + 8 * (c & 1); pb = pa + 65536; }
    }
    __device__ __forceinline__ void chunk(const F8& tv, float, int m, int n, int c, const F8& cs, const F8& sn) const {
        const int qc = n >> 6;
        const int b = m / SEQ, s = m % SEQ;
        F8 v = tv;
        const float scA = 0.125f * LOG2E;
        if (qc < 6 || (qc >= 16 && qc < 22)) {
            const int mi = qc >= 16 ? 2 : 0; const int ql = qc - 8 * mi;
            const F8 pv = f8_shfl_xor(v, 4);
            const size_t off = QKV_MIX(mi) + (ql < 4 ? ((size_t)(b * 4 + ql) * SEQ + s) * 64 : QKV_K + ((size_t)(b * 2 + (ql - 4)) * SEQ + s) * 64);
            *(uint4*)(qkv + off + 8 * c) = f8_rope_pack(v, pv, cs, sn, (c < 4) ? -1.f : 1.f, (ql < 4) ? scA : 1.f);
        } else if (qc == 6 || qc == 7 || qc == 14 || qc == 15 || qc == 22 || qc == 23) {
            *(uint4*)(qkv + QKV_MIX(qc >> 3) + QKV_V + ((size_t)(b * 2 + (qc & 1)) * SEQ + s) * 64 + 8 * c) = pack8(v.a, v.b);
        } else if (qc >= 8 && qc < 14) {
            const bool isq = qc < 12; const int h = isq ? qc - 8 : qc - 12;
            const float r = rsqrtf(sum8(f8_ssq(v)) * (1.f / 64.f) + 1e-6f);
            const F8 gq = f8_load(g_qn + 8 * c), gk = f8_load(g_kn + 8 * c);
            v.a.x *= r * (isq ? gq.a.x : gk.a.x); v.a.y *= r * (isq ? gq.a.y : gk.a.y); v.a.z *= r * (isq ? gq.a.z : gk.a.z); v.a.w *= r * (isq ? gq.a.w : gk.a.w);
            v.b.x *= r * (isq ? gq.b.x : gk.b.x); v.b.y *= r * (isq ? gq.b.y : gk.b.y); v.b.z *= r * (isq ? gq.b.z : gk.b.z); v.b.w *= r * (isq ? gq.b.w : gk.b.w);
            const F8 pv = f8_shfl_xor(v, 2);
            const size_t off = QKV_MIX(1) + (isq ? ((size_t)(b * 4 + h) * SEQ + s) * 64 : QKV_K + ((size_t)(b * 2 + h) * SEQ + s) * 64);
            *(uint4*)(qkv + off + 8 * c) = f8_rope_pack(v, pv, cs, sn, (c & 2) ? 1.f : -1.f, isq ? scA : 1.f);
        } else if (qc >= 24 && qc < 30) {
            const float ss = sum8(f8_ssq(v));
            const size_t off = qc < 28 ? (size_t)m * 256 + (qc - 24) * 64 : (size_t)T_TOK * 256 + (size_t)m * 128 + (qc - 28) * 64;
            *(uint4*)(lat + off + 8 * c) = pack8(v.a, v.b);
            if (c == 0) ssqd[(size_t)(qc - 24) * T_TOK + m] = ss;
        } else if (qc == 30) {
            const F8 pv = f8_shfl_xor(v, 2);
            if (c < 4) {
                const uint4 w = f8_rope_pack(v, pv, cs, sn, (c & 2) ? 1.f : -1.f, 1.f);
#pragma unroll
                for (int h = 0; h < 4; ++h) *(uint4*)(kD + ((size_t)(b * 4 + h) * SEQ + s) * 96 + 64 + 8 * c) = w;
            }
        }
    }
};
struct RowsPostQ {
    bf16_t* qD; const float* tb; const float* ssq;
    __device__ __forceinline__ void table(float*, int, int) const {}
    __device__ __forceinline__ void begin(bf16_t* ct, int m0, int, int tid) const {
        if (tid < 256) {
            const float tot = (ssq[m0 + tid] + ssq[(size_t)T_TOK + m0 + tid]) + (ssq[(size_t)2 * T_TOK + m0 + tid] + ssq[(size_t)3 * T_TOK + m0 + tid]);
            *(float*)(ct + tid * QST + 256) = rsqrtf(tot * (1.f / 256.f) + 1e-6f) * (0.10206207261596575f * LOG2E);
        }
        __syncthreads();
    }
    __device__ __forceinline__ void prep(int m, int n, int c, const float*& pa, const float*& pb) const {
        pa = tb; pb = tb;
        if (n >= 256 && n < 384) { pa = tb + 262144 + (m % SEQ) * 16 + 8 * (c & 1); pb = pa + 65536; }
    }
    __device__ __forceinline__ void chunk(const F8& tv, float r, int m, int n, int c, const F8& cs, const F8& sn) const {
        if (n >= 384) return;
        const int qc = n >> 6, b = m / SEQ, s = m % SEQ;
        F8 v = tv;
        v.a.x *= r; v.a.y *= r; v.a.z *= r; v.a.w *= r; v.b.x *= r; v.b.y *= r; v.b.z *= r; v.b.w *= r;
        if (qc < 4) {
            *(uint4*)(qD + ((size_t)(b * 4 + qc) * SEQ + s) * 128 + 8 * c) = pack8(v.a, v.b);
        } else {
            const F8 pv = f8_shfl_xor(v, 2);
            const int h = (qc - 4) * 2 + (c >> 2);
            *(uint4*)(qD + ((size_t)(b * 4 + h) * SEQ + s) * 128 + 64 + 8 * (c & 3)) = f8_rope_pack(v, pv, cs, sn, (c & 2) ? 1.f : -1.f, 1.f);
        }
    }
};
struct RowsPostKV {
    bf16_t* kD; bf16_t* vD; const float* ssq;
    __device__ __forceinline__ void table(float*, int, int) const {}
    __device__ __forceinline__ void begin(bf16_t* ct, int m0, int, int tid) const {
        if (tid < 256) *(float*)(ct + tid * QST + 256) = rsqrtf((ssq[m0 + tid] + ssq[(size_t)T_TOK + m0 + tid]) * (1.f / 128.f) + 1e-6f);
        __syncthreads();
    }
    __device__ __forceinline__ void prep(int, int, int, const float*& pa, const float*& pb) const { pa = ssq; pb = ssq; }
    __device__ __forceinline__ void chunk(const F8& tv, float r, int m, int n, int c, const F8&, const F8&) const {
        const int qc = n >> 6, h = qc >> 1, b = m / SEQ, s = m % SEQ;
        F8 v = tv;
        v.a.x *= r; v.a.y *= r; v.a.z *= r; v.a.w *= r; v.b.x *= r; v.b.y *= r; v.b.z *= r; v.b.w *= r;
        const size_t hb = (size_t)(b * 4 + h) * SEQ + s;
        const size_t off = (qc & 1) ? hb * 64 : hb * 96;
        bf16_t* base = (bf16_t*)((qc & 1) ? (size_t)vD : (size_t)kD);
        *(uint4*)(base + off + 8 * c) = pack8(v.a, v.b);
    }
};

template <class Epi>
__device__ __forceinline__ void gemm_phase(const bf16_t* X, int ldx, const bf16_t* W, int ldw, int M, int N, int K, char* lds, const Epi& epi) {
    const int ntm = M >> 7, ntn = (N + 127) >> 7, nt_tot = ntm * ntn;
    for (int tile = blockIdx.x; tile < nt_tot; tile += gridDim.x) {
        int mt, nt;
        if ((gridDim.x & 7) == 0 && (gridDim.x >> 3) * 8 == gridDim.x && ((gridDim.x >> 3) & 63) == 0) tile_map(tile, ntm, ntn, mt, nt);
        else { mt = tile / ntn; nt = tile % ntn; }
        if (mt < ntm && nt < ntn) gemm_tile(X, ldx, W, ldw, K, mt * 128, nt * 128, N, lds, epi);
    }
}

template <int OFF> __device__ __forceinline__ s16x4 tr_read(int vb) {
    s16x4 r; asm volatile("ds_read_b64_tr_b16 %0, %1 offset:%2" : "=&v"(r) : "v"(vb), "i"(OFF) : "memory"); return r;
}
#define VS_BYTES 192

template <int KT2>
__device__ __forceinline__ void pv_sub(f32x16 (&o)[2], const f32x16& p, int vbase) {
    bf16x8 pf[2];
#pragma unroll
    for (int s2 = 0; s2 < 2; ++s2) {
        unsigned a = cvtpk(p[8 * s2 + 0], p[8 * s2 + 1]), b = cvtpk(p[8 * s2 + 2], p[8 * s2 + 3]);
        unsigned c = cvtpk(p[8 * s2 + 4], p[8 * s2 + 5]), d = cvtpk(p[8 * s2 + 6], p[8 * s2 + 7]);
        uint4 w = make_uint4(a, b, c, d);
        pf[s2] = *(bf16x8*)&w;
    }
    {
        s16x4 l00 = tr_read<(KT2 * 32 + 0) * VS_BYTES + 0>(vbase), h00 = tr_read<(KT2 * 32 + 8) * VS_BYTES + 0>(vbase);
        s16x4 l01 = tr_read<(KT2 * 32 + 0) * VS_BYTES + 64>(vbase), h01 = tr_read<(KT2 * 32 + 8) * VS_BYTES + 64>(vbase);
        s16x4 l10 = tr_read<(KT2 * 32 + 16) * VS_BYTES + 0>(vbase), h10 = tr_read<(KT2 * 32 + 24) * VS_BYTES + 0>(vbase);
        s16x4 l11 = tr_read<(KT2 * 32 + 16) * VS_BYTES + 64>(vbase), h11 = tr_read<(KT2 * 32 + 24) * VS_BYTES + 64>(vbase);
        asm volatile("s_waitcnt lgkmcnt(0)" ::: "memory");
        __builtin_amdgcn_sched_barrier(0);
#define PKV(L, H) (bf16x8){L[0], L[1], L[2], L[3], H[0], H[1], H[2], H[3]}
        o[0] = __builtin_amdgcn_mfma_f32_32x32x16_bf16(PKV(l00, h00), pf[0], o[0], 0, 0, 0);
        o[1] = __builtin_amdgcn_mfma_f32_32x32x16_bf16(PKV(l01, h01), pf[0], o[1], 0, 0, 0);
        o[0] = __builtin_amdgcn_mfma_f32_32x32x16_bf16(PKV(l10, h10), pf[1], o[0], 0, 0, 0);
        o[1] = __builtin_amdgcn_mfma_f32_32x32x16_bf16(PKV(l11, h11), pf[1], o[1], 0, 0, 0);
#undef PKV
    }
}


#define PV_LOAD(KT2, VB, F) \
    const s16x4 F##0 = tr_read<((KT2) * 32 + 0) * VS_BYTES + 0>(VB), F##1 = tr_read<((KT2) * 32 + 8) * VS_BYTES + 0>(VB), \
                F##2 = tr_read<((KT2) * 32 + 0) * VS_BYTES + 64>(VB), F##3 = tr_read<((KT2) * 32 + 8) * VS_BYTES + 64>(VB), \
                F##4 = tr_read<((KT2) * 32 + 16) * VS_BYTES + 0>(VB), F##5 = tr_read<((KT2) * 32 + 24) * VS_BYTES + 0>(VB), \
                F##6 = tr_read<((KT2) * 32 + 16) * VS_BYTES + 64>(VB), F##7 = tr_read<((KT2) * 32 + 24) * VS_BYTES + 64>(VB)
#define PKV2(L, H) (bf16x8){L[0], L[1], L[2], L[3], H[0], H[1], H[2], H[3]}
#define PV_MMA(O, P, F) do { bf16x8 _pf0, _pf1; \
        { uint4 _w = make_uint4(cvtpk(P[0], P[1]), cvtpk(P[2], P[3]), cvtpk(P[4], P[5]), cvtpk(P[6], P[7])); _pf0 = *(bf16x8*)&_w; } \
        { uint4 _w = make_uint4(cvtpk(P[8], P[9]), cvtpk(P[10], P[11]), cvtpk(P[12], P[13]), cvtpk(P[14], P[15])); _pf1 = *(bf16x8*)&_w; } \
        O[0] = __builtin_amdgcn_mfma_f32_32x32x16_bf16(PKV2(F##0, F##1), _pf0, O[0], 0, 0, 0); \
        O[1] = __builtin_amdgcn_mfma_f32_32x32x16_bf16(PKV2(F##2, F##3), _pf0, O[1], 0, 0, 0); \
        O[0] = __builtin_amdgcn_mfma_f32_32x32x16_bf16(PKV2(F##4, F##5), _pf1, O[0], 0, 0, 0); \
        O[1] = __builtin_amdgcn_mfma_f32_32x32x16_bf16(PKV2(F##6, F##7), _pf1, O[1], 0, 0, 0); } while (0)

template <int DK, int G, bool WINDOW>
__device__ __forceinline__ void attn_item(const bf16_t* __restrict__ Q, const bf16_t* __restrict__ K, const bf16_t* __restrict__ V, const float* __restrict__ sink,
                                          bf16_t* __restrict__ O, int ocol, int H, int KV, int item, char* lds, int qs = DK) {
    constexpr int KS = DK * 2 + 16;
    constexpr int KCH = DK / 8;
    constexpr int KLD = (128 * KCH) / 512;
    constexpr int QB = 256 / G;
    constexpr int NCH = SEQ / QB;
    constexpr int KBUF = 128 * KS, VBUF = 128 * VS_BYTES;
    const int tid = tid_opaque(), lane = tid & 63, wave = tid >> 6;
    const int r32 = lane & 31, hh = lane >> 5;
    const int chunk = item % NCH, kvh = (item / NCH) % KV, b = item / (NCH * KV);
    const int g = (G == 2) ? (wave >> 2) : 0;
    const int qoff = (G == 2) ? (wave & 3) * 32 : wave * 32;
    const int head = kvh * G + g;
    const int q0 = chunk * QB;
    const int qpos = q0 + qoff + r32;
    bf16x8 qf[DK / 16];
    {
        const bf16_t* qp = Q + ((size_t)(b * H + head) * SEQ + qpos) * qs + hh * 8;
#pragma unroll
        for (int ks = 0; ks < DK / 16; ++ks) qf[ks] = *(const bf16x8*)(qp + ks * 16);
    }
    int kt_lo = 0, kt_hi = SEQ / 128;
    if (WINDOW) { kt_lo = q0 / 128 - 1; if (kt_lo < 0) kt_lo = 0; kt_hi = (q0 + QB) / 128 + 1; if (kt_hi > SEQ / 128) kt_hi = SEQ / 128; }
    const char* Kg = (const char*)(K + (size_t)(b * KV + kvh) * SEQ * DK);
    const char* Vg = (const char*)(V + (size_t)(b * KV + kvh) * SEQ * 64);
    uint4 kr0, kr1, kr2 = make_uint4(0, 0, 0, 0), vr0, vr1;
    const int koff0 = (tid / KCH) * KS + (tid % KCH) * 16;
    const int koff1 = ((tid + 512) / KCH) * KS + ((tid + 512) % KCH) * 16;
    const int koff2 = ((tid + 1024) / KCH) * KS + ((tid + 1024) % KCH) * 16;
    const int voff0 = (tid >> 3) * VS_BYTES + (tid & 7) * 16;
    const int voff1 = ((tid + 512) >> 3) * VS_BYTES + (tid & 7) * 16;
    f32x16 o[2];
#pragma unroll
    for (int d = 0; d < 2; ++d)
#pragma unroll
        for (int i = 0; i < 16; ++i) o[d][i] = 0.f;
    float m = -1e30f, l = 0.f;
    if (WINDOW) { m = sink[head] * LOG2E; l = (hh == 0) ? 1.f : 0.f; }
    const int gg = lane >> 4, li = lane & 15;
    const int vlane = (4 * (gg >> 1) + (li >> 2)) * VS_BYTES + (16 * (gg & 1) + 4 * (li & 3)) * 2;
    char* Kl = lds; char* Vl = lds + 2 * KBUF;
#define AGLOAD(KT) do { const char* _kg = Kg + (size_t)(KT) * 128 * DK * 2; const char* _vg = Vg + (size_t)(KT) * 128 * 128; \
        kr0 = *(const uint4*)(_kg + tid * 16); kr1 = *(const uint4*)(_kg + (tid + 512) * 16); if (KLD > 2) kr2 = *(const uint4*)(_kg + (tid + 1024) * 16); \
        vr0 = *(const uint4*)(_vg + tid * 16); vr1 = *(const uint4*)(_vg + (tid + 512) * 16); } while (0)
#define ASTORE(KB, VB) do { char* _kd = (KB); char* _vd = (VB); *(uint4*)(_kd + koff0) = kr0; *(uint4*)(_kd + koff1) = kr1; if (KLD > 2) *(uint4*)(_kd + koff2) = kr2; \
        *(uint4*)(_vd + voff0) = vr0; *(uint4*)(_vd + voff1) = vr1; } while (0)
    AGLOAD(kt_lo);
    ASTORE(Kl, Vl);
    { const int k1 = kt_lo + 1 < kt_hi ? kt_lo + 1 : kt_lo; AGLOAD(k1); }
    __syncthreads();
    for (int kt = kt_lo; kt < kt_hi; ++kt) {
        const int cur = (kt - kt_lo) & 1;
        ASTORE(Kl + (cur ^ 1) * KBUF, Vl + (cur ^ 1) * VBUF);
        { const int ktn = kt + 2 < kt_hi ? kt + 2 : kt_hi - 1; AGLOAD(ktn); }
        __builtin_amdgcn_sched_barrier(0);
#pragma unroll
        for (int sub = 0; sub < 2; ++sub) {
            const char* kb = Kl + cur * KBUF + sub * 64 * KS;
            const float mi = (m < -1e29f) ? 0.f : m;
            f32x16 s0, s1;
#pragma unroll
            for (int i = 0; i < 16; ++i) { s0[i] = -mi; s1[i] = -mi; }
#pragma unroll
            for (int ks = 0; ks < DK / 16; ++ks) {
                bf16x8 k0 = *(const bf16x8*)(kb + r32 * KS + (ks * 2 + hh) * 16);
                bf16x8 k1 = *(const bf16x8*)(kb + (32 + r32) * KS + (ks * 2 + hh) * 16);
                s0 = __builtin_amdgcn_mfma_f32_32x32x16_bf16(k0, qf[ks], s0, 0, 0, 0);
                s1 = __builtin_amdgcn_mfma_f32_32x32x16_bf16(k1, qf[ks], s1, 0, 0, 0);
            }
            if (WINDOW) {
                const int kb0 = kt * 128 + sub * 64 + 4 * hh - qpos;
#pragma unroll
                for (int i = 0; i < 16; ++i) {
                    const int d0 = kb0 + (i & 3) + 8 * (i >> 2), d1 = d0 + 32;
                    s0[i] = (d0 > 128 || d0 < -128) ? -1e30f : s0[i];
                    s1[i] = (d1 > 128 || d1 < -128) ? -1e30f : s1[i];
                }
            }
            const int vbase = (int)(size_t)(Vl + cur * VBUF - lds) + sub * 64 * VS_BYTES + vlane;
            PV_LOAD(0, vbase, vfa);
            PV_LOAD(1, vbase, vfb);
            __builtin_amdgcn_sched_barrier(0);
            float tmax = s0[0];
#pragma unroll
            for (int i = 1; i < 16; ++i) tmax = fmaxf(tmax, s0[i]);
#pragma unroll
            for (int i = 0; i < 16; ++i) tmax = fmaxf(tmax, s1[i]);
            tmax = xhalf_max(tmax);
            float ps = 0.f;
            if (__all(m > -1e29f && tmax <= 8.f)) {
#pragma unroll
                for (int i = 0; i < 16; ++i) { s0[i] = __builtin_amdgcn_exp2f(s0[i]); ps += s0[i]; }
#pragma unroll
                for (int i = 0; i < 16; ++i) { s1[i] = __builtin_amdgcn_exp2f(s1[i]); ps += s1[i]; }
                l += ps;
            } else {
                const float mn = fmaxf(m, mi + tmax);
                const float d = mn - mi;
                const float alpha = __builtin_amdgcn_exp2f(m - mn);
                m = mn;
#pragma unroll
                for (int i = 0; i < 16; ++i) { s0[i] = __builtin_amdgcn_exp2f(s0[i] - d); ps += s0[i]; }
#pragma unroll
                for (int i = 0; i < 16; ++i) { s1[i] = __builtin_amdgcn_exp2f(s1[i] - d); ps += s1[i]; }
                l = l * alpha + ps;
#pragma unroll
                for (int dd = 0; dd < 2; ++dd)
#pragma unroll
                    for (int i = 0; i < 16; ++i) o[dd][i] *= alpha;
            }
            asm volatile("s_waitcnt lgkmcnt(0)" ::: "memory");
            __builtin_amdgcn_sched_barrier(0);
            PV_MMA(o, s0, vfa);
            PV_MMA(o, s1, vfb);
        }
        __syncthreads();
    }
#undef AGLOAD
#undef ASTORE
    l = xhalf_sum(l);
    const float inv = 1.f / l;
    bf16_t* orow = O + (size_t)(b * SEQ + qpos) * DM + ocol + head * 64;
#pragma unroll
    for (int d = 0; d < 2; ++d)
#pragma unroll
        for (int gq = 0; gq < 4; ++gq) {
            uint2 w;
            w.x = cvtpk(o[d][gq * 4 + 0] * inv, o[d][gq * 4 + 1] * inv);
            w.y = cvtpk(o[d][gq * 4 + 2] * inv, o[d][gq * 4 + 3] * inv);
            *(uint2*)(orow + d * 32 + 8 * gq + 4 * hh) = w;
        }
}

__device__ __forceinline__ void dil_wave_item(const bf16_t* __restrict__ Q, const bf16_t* __restrict__ K, const bf16_t* __restrict__ V,
                                              bf16_t* __restrict__ O, int witem, char* wlds, int lds_off) {
    const int lane = tid_opaque() & 63, r32 = lane & 31, hh = lane >> 5;
    const int c = witem & 15, chunk = (witem >> 4) & 15, kvh = (witem >> 8) & 1, b = witem >> 9;
    const int t0 = chunk * 256;
    const int mq = r32 & 15, g = r32 >> 4;
    const int qpos = t0 + 16 * mq + c, head = kvh * 2 + g;
    bf16x8 qf[4];
    {
        const bf16_t* qp = Q + ((size_t)(b * 4 + head) * SEQ + qpos) * 64 + hh * 8;
#pragma unroll
        for (int ks = 0; ks < 4; ++ks) qf[ks] = *(const bf16x8*)(qp + ks * 16);
    }
    const bf16_t* Kg = K + (size_t)(b * 2 + kvh) * SEQ * 64;
    const bf16_t* Vg = V + (size_t)(b * 2 + kvh) * SEQ * 64;
    f32x16 o[2];
#pragma unroll
    for (int d = 0; d < 2; ++d)
#pragma unroll
        for (int i = 0; i < 16; ++i) o[d][i] = 0.f;
    float m = -1e30f, l = 0.f;
    const int gg = lane >> 4, li = lane & 15;
    const int vlane = lds_off + (4 * (gg >> 1) + (li >> 2)) * VS_BYTES + (16 * (gg & 1) + 4 * (li & 3)) * 2;
#define DIL_PARAMS(IT, SH, CC, IDX0, LIM) const int SH = (IT) < 12 ? 0 : ((IT) < 18 ? 2 : 4); const int CC = c & ((1 << SH) - 1); \
        const int IDX0 = (t0 >> SH) - 64 + 32 * ((IT) < 12 ? (IT) : ((IT) < 18 ? (IT) - 12 : (IT) - 18)); const int LIM = SEQ >> SH
#define DIL_LOAD(KF, VR, SH, CC, IDX0, LIM) do { \
        { int _i = IDX0 + r32; _i = _i < 0 ? 0 : (_i >= LIM ? LIM - 1 : _i); const bf16_t* _kp = Kg + (size_t)((_i << SH) + CC) * 64 + hh * 8; \
          KF##0 = *(const bf16x8*)(_kp); KF##1 = *(const bf16x8*)(_kp + 16); KF##2 = *(const bf16x8*)(_kp + 32); KF##3 = *(const bf16x8*)(_kp + 48); } \
        { int _i = IDX0 + (lane >> 3); _i = _i < 0 ? 0 : (_i >= LIM ? LIM - 1 : _i); VR##0 = *(const uint4*)(Vg + (size_t)((_i << SH) + CC) * 64 + (lane & 7) * 8); } \
        { int _i = IDX0 + 8 + (lane >> 3); _i = _i < 0 ? 0 : (_i >= LIM ? LIM - 1 : _i); VR##1 = *(const uint4*)(Vg + (size_t)((_i << SH) + CC) * 64 + (lane & 7) * 8); } \
        { int _i = IDX0 + 16 + (lane >> 3); _i = _i < 0 ? 0 : (_i >= LIM ? LIM - 1 : _i); VR##2 = *(const uint4*)(Vg + (size_t)((_i << SH) + CC) * 64 + (lane & 7) * 8); } \
        { int _i = IDX0 + 24 + (lane >> 3); _i = _i < 0 ? 0 : (_i >= LIM ? LIM - 1 : _i); VR##3 = *(const uint4*)(Vg + (size_t)((_i << SH) + CC) * 64 + (lane & 7) * 8); } } while (0)
    bf16x8 ka0, ka1, ka2, ka3, kb0, kb1, kb2, kb3;
    uint4 va0, va1, va2, va3, vb0, vb1, vb2, vb3;
    { DIL_PARAMS(0, sh0, cc0, ix0, lm0); DIL_LOAD(ka, va, sh0, cc0, ix0, lm0); }
#pragma unroll 1
    for (int it = 0; it < 23; ++it) {
        DIL_PARAMS(it, sh, cc, idx0, lim);
        {
            const int itn = it + 1 < 23 ? it + 1 : 22;
            DIL_PARAMS(itn, shn, ccn, ixn, lmn);
            DIL_LOAD(kb, vb, shn, ccn, ixn, lmn);
        }
        __builtin_amdgcn_sched_barrier(0);
        *(uint4*)(wlds + ((lane >> 3)) * VS_BYTES + (lane & 7) * 16) = va0;
        *(uint4*)(wlds + ((lane >> 3) + 8) * VS_BYTES + (lane & 7) * 16) = va1;
        *(uint4*)(wlds + ((lane >> 3) + 16) * VS_BYTES + (lane & 7) * 16) = va2;
        *(uint4*)(wlds + ((lane >> 3) + 24) * VS_BYTES + (lane & 7) * 16) = va3;
        f32x16 s;
#pragma unroll
        for (int i = 0; i < 16; ++i) s[i] = 0.f;
        s = __builtin_amdgcn_mfma_f32_32x32x16_bf16(ka0, qf[0], s, 0, 0, 0);
        s = __builtin_amdgcn_mfma_f32_32x32x16_bf16(ka1, qf[1], s, 0, 0, 0);
        s = __builtin_amdgcn_mfma_f32_32x32x16_bf16(ka2, qf[2], s, 0, 0, 0);
        s = __builtin_amdgcn_mfma_f32_32x32x16_bf16(ka3, qf[3], s, 0, 0, 0);

        const int qidx = qpos >> sh;
        const int base = idx0 + 4 * hh;
#pragma unroll
        for (int i = 0; i < 16; ++i) {
            const int idx = base + (i & 3) + 8 * (i >> 2);
            const int d = idx - qidx;
            s[i] = (d > 64 || d < -64 || idx < 0 || idx >= lim) ? -1e30f : s[i];
        }
        float tmax = s[0];
#pragma unroll
        for (int i = 1; i < 16; ++i) tmax = fmaxf(tmax, s[i]);
        tmax = fmaxf(tmax, xhalf(tmax));
        const float mn = fmaxf(fmaxf(m, tmax), -1e20f);
        const float alpha = __builtin_amdgcn_exp2f(m - mn);
        m = mn;
        float ps = 0.f;
#pragma unroll
        for (int i = 0; i < 16; ++i) { s[i] = __builtin_amdgcn_exp2f(s[i] - mn); ps += s[i]; }
        l = l * alpha + ps;
#pragma unroll
        for (int d = 0; d < 2; ++d)
#pragma unroll
            for (int i = 0; i < 16; ++i) o[d][i] *= alpha;
        pv_sub<0>(o, s, vlane);
        ka0 = kb0; ka1 = kb1; ka2 = kb2; ka3 = kb3; va0 = vb0; va1 = vb1; va2 = vb2; va3 = vb3;
    }
#undef DIL_PARAMS
#undef DIL_LOAD
    l += xhalf(l);
    const float inv = 1.f / l;
    bf16_t* orow = O + (size_t)(b * SEQ + qpos) * DM + 512 + head * 64;
#pragma unroll
    for (int d = 0; d < 2; ++d)
#pragma unroll
        for (int gq = 0; gq < 4; ++gq) {
            uint2 w;
            w.x = cvtpk(o[d][gq * 4 + 0] * inv, o[d][gq * 4 + 1] * inv);
            w.y = cvtpk(o[d][gq * 4 + 2] * inv, o[d][gq * 4 + 3] * inv);
            *(uint2*)(orow + d * 32 + 8 * gq + 4 * hh) = w;
        }
}

__device__ __forceinline__ int f2key(float f) { int b = __float_as_int(f); return b ^ ((b >> 31) & 0x7fffffff); }
__device__ __forceinline__ float key2f(int k) { return __int_as_float(k ^ ((k >> 31) & 0x7fffffff)); }

template <int N>
__device__ __forceinline__ void bitonic_sort_desc(int (&a)[N]) {
#pragma unroll
    for (int k = 2; k <= N; k <<= 1) {
#pragma unroll
        for (int j = k >> 1; j > 0; j >>= 1) {
#pragma unroll
            for (int i = 0; i < N; ++i) {
                const int l2 = i ^ j;
                if (l2 > i) {
                    const bool up = ((i & k) == 0);
                    const int hi = max(a[i], a[l2]), lo = min(a[i], a[l2]);
                    a[i] = up ? hi : lo; a[l2] = up ? lo : hi;
                }
            }
        }
    }
}
__device__ __forceinline__ void merge_top16(int (&a)[16], const int (&b)[16]) {
#pragma unroll
    for (int i = 0; i < 16; ++i) a[i] = max(a[i], b[15 - i]);
#pragma unroll
    for (int j = 8; j > 0; j >>= 1) {
#pragma unroll
        for (int i = 0; i < 16; ++i) {
            const int l2 = i ^ j;
            if (l2 > i) { const int hi = max(a[i], a[l2]), lo = min(a[i], a[l2]); a[i] = hi; a[l2] = lo; }
        }
    }
}
__device__ __forceinline__ void top16_of_64(int (&g0)[16], int (&g1)[16], int (&g2)[16], int (&g3)[16]) {
    bitonic_sort_desc<16>(g0); bitonic_sort_desc<16>(g1); bitonic_sort_desc<16>(g2); bitonic_sort_desc<16>(g3);
    merge_top16(g0, g1); merge_top16(g2, g3); merge_top16(g0, g2);
}

__device__ __forceinline__ void topk_core(const bf16_t* q0, const bf16_t* __restrict__ subk_h, float rscale, int* eo, float* go, char* wlds) {
    const int lane = tid_opaque() & 63, r32 = lane & 31, hh = lane >> 5;
    int top[2][16];
#pragma unroll
    for (int c = 0; c < 2; ++c) {
        bf16x8 qf[8];
        const bf16_t* qrow = q0 + c * 128;
#pragma unroll
        for (int ks = 0; ks < 8; ++ks) qf[ks] = *(const bf16x8*)(qrow + ks * 16);
        const bf16_t* kb = subk_h + ((size_t)c * 128 + r32) * 128 + hh * 8;
        int grp[4][16];
        bf16x8 kfa[8], kfb[8];
#pragma unroll
        for (int ks = 0; ks < 8; ++ks) kfa[ks] = *(const bf16x8*)(kb + ks * 16);
#pragma unroll
        for (int kt = 0; kt < 4; ++kt) {
            if (kt < 3) {
#pragma unroll
                for (int ks = 0; ks < 8; ++ks) kfb[ks] = *(const bf16x8*)(kb + (size_t)(kt + 1) * 32 * 128 + ks * 16);
            }
            __builtin_amdgcn_sched_barrier(0);
            f32x16 s;
#pragma unroll
            for (int i = 0; i < 16; ++i) s[i] = 0.f;
#pragma unroll
            for (int ks = 0; ks < 8; ++ks) s = __builtin_amdgcn_mfma_f32_32x32x16_bf16(kfa[ks], qf[ks], s, 0, 0, 0);
#pragma unroll
            for (int i = 0; i < 16; ++i) grp[kt][i] = (f2key(s[i]) & ~127) | (kt * 32 + crow(i, hh));
#pragma unroll
            for (int ks = 0; ks < 8; ++ks) kfa[ks] = kfb[ks];
        }
        top16_of_64(grp[0], grp[1], grp[2], grp[3]);
        int oth[16];
#pragma unroll
        for (int i = 0; i < 16; ++i) oth[i] = __shfl_xor(grp[0][i], 32);
        merge_top16(grp[0], oth);
#pragma unroll
        for (int i = 0; i < 16; ++i) top[c][i] = grp[0][i];
    }
    {
        unsigned* my = (unsigned*)(wlds + lane * 36);
#pragma unroll
        for (int c = 0; c < 2; ++c)
#pragma unroll
            for (int w4 = 0; w4 < 4; ++w4) {
                unsigned v = (top[c][w4 * 4] & 127) | ((top[c][w4 * 4 + 1] & 127) << 8) | ((top[c][w4 * 4 + 2] & 127) << 16) | ((top[c][w4 * 4 + 3] & 127) << 24);
                my[c * 4 + w4] = v;
            }
    }
    float v1[16], v2[16];
#pragma unroll
    for (int i = 0; i < 16; ++i) { v1[i] = key2f(top[0][i] & ~127); v2[i] = key2f(top[1][i] & ~127); }
    int cg[4][16];
    {
        int n = 0;
#pragma unroll
        for (int i = 0; i < 16; ++i)
#pragma unroll
            for (int j = 0; j < 16; ++j)
                if ((i + 1) * (j + 1) <= 16) { cg[n >> 4][n & 15] = (f2key(v1[i] + v2[j]) & ~255) | (i * 16 + j); ++n; }
#pragma unroll
        for (int q = 50; q < 64; ++q) cg[q >> 4][q & 15] = (int)0x80000000;
    }
    top16_of_64(cg[0], cg[1], cg[2], cg[3]);
    float bv[16];
#pragma unroll
    for (int i = 0; i < 16; ++i) bv[i] = key2f(cg[0][i] & ~255) * rscale;
    float sm = 0.f;
    const float bmx = bv[0];
#pragma unroll
    for (int i = 0; i < 16; ++i) { bv[i] = __expf(bv[i] - bmx); sm += bv[i]; }
    const float inv = 1.f / sm;
    if (hh == 0) {
        const unsigned char* my = (const unsigned char*)(wlds + lane * 36);
#pragma unroll
        for (int q4 = 0; q4 < 4; ++q4) {
            int4 ev; float4 gv;
            int* evp = (int*)&ev; float* gvp = (float*)&gv;
#pragma unroll
            for (int u = 0; u < 4; ++u) {
                const int code = cg[0][q4 * 4 + u] & 255;
                const int i1 = my[code >> 4], i2 = my[16 + (code & 15)];
                evp[u] = i1 * 128 + i2; gvp[u] = bv[q4 * 4 + u] * inv;
            }
            *(int4*)(eo + q4 * 4) = ev; *(float4*)(go + q4 * 4) = gv;
        }
    }
}

__device__ __forceinline__ void topk_wave_item(const bf16_t* __restrict__ qp, const bf16_t* __restrict__ subk, int* __restrict__ eidx, float* __restrict__ gate, int witem, char* wlds) {
    const int lane = tid_opaque() & 63, r32 = lane & 31, hh = lane >> 5;
    const int h = witem & 7, t = (witem >> 3) * 32 + r32;
    topk_core(qp + (size_t)t * 2048 + h * 256 + hh * 8, subk + (size_t)h * 2 * 128 * 128, 1.f, eidx + ((size_t)h * T_TOK + t) * 16, gate + ((size_t)h * T_TOK + t) * 16, wlds);
}
__device__ __forceinline__ void gemm_tile_topk(const bf16_t* __restrict__ X, int ldx, const bf16_t* __restrict__ W, int ldw, int K, int m0, int h, char* lds,
                                               const bf16_t* __restrict__ subk, const float* __restrict__ ssq, int* __restrict__ eidx, float* __restrict__ gate) {
    const int tid = tid_opaque(), lane = tid & 63, wave = tid >> 6;
    const int wm = wave >> 1, wn = wave & 1;
    const int r32 = lane & 31, hh = lane >> 5;
    {
        f32x16 acc[2][4];
        gemm_mainloop(X, ldx, W, ldw, K, m0, h * 256, 2048, lds, acc);
        bf16_t* qst = (bf16_t*)lds;
#pragma unroll
        for (int mt = 0; mt < 2; ++mt)
#pragma unroll
            for (int nt = 0; nt < 4; ++nt)
#pragma unroll
                for (int i = 0; i < 16; ++i)
                    qst[(wm * 64 + mt * 32 + crow(i, hh)) * QST + wn * 128 + nt * 32 + r32] = f2bf(acc[mt][nt][i]);
    }
    __syncthreads();
    {
        const int tok = wave * 32 + r32, t = m0 + tok;
        float tot = 0.f;
#pragma unroll
        for (int j = 0; j < 4; ++j) { const float4 q = *(const float4*)(ssq + ((size_t)j * T_TOK + t) * 4); tot += (q.x + q.y) + (q.z + q.w); }
        const float r = rsqrtf(tot * (1.f / DM) + 1e-6f);
        topk_core((const bf16_t*)lds + tok * QST + hh * 8, subk + (size_t)h * 2 * 128 * 128, r, eidx + ((size_t)h * T_TOK + t) * 16, gate + ((size_t)h * T_TOK + t) * 16,
                  lds + TOPK_STASH + wave * 2304);
    }
    __syncthreads();
}

typedef __attribute__((ext_vector_type(2))) float f32x2;
__device__ __forceinline__ float fdot2bf(unsigned a, unsigned b, float acc) {
    return __builtin_amdgcn_fdot2_f32_bf16(*(bf16x2_t*)&a, *(bf16x2_t*)&b, acc, false);
}
__device__ __forceinline__ unsigned fp8pair_to_bf16(unsigned w, bool hi) {
    bf16x2_t r = hi ? __builtin_amdgcn_cvt_scalef32_pk_bf16_fp8((int)w, 1.0f, true) : __builtin_amdgcn_cvt_scalef32_pk_bf16_fp8((int)w, 1.0f, false);
    return *(unsigned*)&r;
}
__device__ __forceinline__ float dot16_fp8(uint4 u, const unsigned (&h)[8]) {
    float a = 0.f;
    a = fdot2bf(fp8pair_to_bf16(u.x, false), h[0], a); a = fdot2bf(fp8pair_to_bf16(u.x, true), h[1], a);
    a = fdot2bf(fp8pair_to_bf16(u.y, false), h[2], a); a = fdot2bf(fp8pair_to_bf16(u.y, true), h[3], a);
    a = fdot2bf(fp8pair_to_bf16(u.z, false), h[4], a); a = fdot2bf(fp8pair_to_bf16(u.z, true), h[5], a);
    a = fdot2bf(fp8pair_to_bf16(u.w, false), h[6], a); a = fdot2bf(fp8pair_to_bf16(u.w, true), h[7], a);
    return a;
}
__device__ __forceinline__ void axpy16_fp8(float (&acc)[16], float w, uint4 v) {
    f32x2 r;
    r = __builtin_amdgcn_cvt_pk_f32_fp8((int)v.x, false); acc[0] += w * r[0]; acc[1] += w * r[1];
    r = __builtin_amdgcn_cvt_pk_f32_fp8((int)v.x, true);  acc[2] += w * r[0]; acc[3] += w * r[1];
    r = __builtin_amdgcn_cvt_pk_f32_fp8((int)v.y, false); acc[4] += w * r[0]; acc[5] += w * r[1];
    r = __builtin_amdgcn_cvt_pk_f32_fp8((int)v.y, true);  acc[6] += w * r[0]; acc[7] += w * r[1];
    r = __builtin_amdgcn_cvt_pk_f32_fp8((int)v.z, false); acc[8] += w * r[0]; acc[9] += w * r[1];
    r = __builtin_amdgcn_cvt_pk_f32_fp8((int)v.z, true);  acc[10] += w * r[0]; acc[11] += w * r[1];
    r = __builtin_amdgcn_cvt_pk_f32_fp8((int)v.w, false); acc[12] += w * r[0]; acc[13] += w * r[1];
    r = __builtin_amdgcn_cvt_pk_f32_fp8((int)v.w, true);  acc[14] += w * r[0]; acc[15] += w * r[1];
}
__device__ __forceinline__ float gelu_exact(float a) { return 0.5f * a * (1.f + erff(a * 0.70710678118654752f)); }

__device__ __forceinline__ float transpose_reduce16(f32x16 p, int lane) {
#pragma unroll
    for (int st = 0; st < 4; ++st) {
        const int o = 32 >> st, n = 16 >> st;
        const bool up = (lane & o) != 0;
#pragma unroll
        for (int i = 0; i < n / 2; ++i) {
            float lo = p[i], hi = p[i + n / 2];
            asm volatile("" : "+v"(lo), "+v"(hi));
            const float keep = up ? hi : lo;
            const float send = up ? lo : hi;
            p[i] = keep + __shfl_xor(send, o);
        }
    }
    float v = p[0];
    v += __shfl_xor(v, 1); v += __shfl_xor(v, 2);
    return v;
}
#define EX_SB() __builtin_amdgcn_sched_barrier(0)
#define EX_LD1(R, TAB, EB, S) R = *(const uint4*)((TAB) + (unsigned)((__builtin_amdgcn_readlane((EB), (S)) << 10) + lane16))
#define EX_LOAD8(P, TAB, EB, SL) do { EX_LD1(P##0, TAB, EB, (SL) + 0); EX_LD1(P##1, TAB, EB, (SL) + 1); EX_LD1(P##2, TAB, EB, (SL) + 2); EX_LD1(P##3, TAB, EB, (SL) + 3); \
        EX_LD1(P##4, TAB, EB, (SL) + 4); EX_LD1(P##5, TAB, EB, (SL) + 5); EX_LD1(P##6, TAB, EB, (SL) + 6); EX_LD1(P##7, TAB, EB, (SL) + 7); } while (0)
#define EX_DOT8(P, PP, O) do { PP[(O) + 0] = dot16_fp8(P##0, hp); PP[(O) + 1] = dot16_fp8(P##1, hp); PP[(O) + 2] = dot16_fp8(P##2, hp); PP[(O) + 3] = dot16_fp8(P##3, hp); \
        PP[(O) + 4] = dot16_fp8(P##4, hp); PP[(O) + 5] = dot16_fp8(P##5, hp); PP[(O) + 6] = dot16_fp8(P##6, hp); PP[(O) + 7] = dot16_fp8(P##7, hp); } while (0)
#define EX_RL(W, S) __int_as_float(__builtin_amdgcn_readlane(__float_as_int(W), (S)))
#define EX_AXPY8(P, W, SL) do { axpy16_fp8(acc, EX_RL(W, (SL) + 0), P##0); axpy16_fp8(acc, EX_RL(W, (SL) + 1), P##1); axpy16_fp8(acc, EX_RL(W, (SL) + 2), P##2); axpy16_fp8(acc, EX_RL(W, (SL) + 3), P##3); \
        axpy16_fp8(acc, EX_RL(W, (SL) + 4), P##4); axpy16_fp8(acc, EX_RL(W, (SL) + 5), P##5); axpy16_fp8(acc, EX_RL(W, (SL) + 6), P##6); axpy16_fp8(acc, EX_RL(W, (SL) + 7), P##7); } while (0)
#define EX_COPY8(D, S_) do { D##0 = S_##0; D##1 = S_##1; D##2 = S_##2; D##3 = S_##3; D##4 = S_##4; D##5 = S_##5; D##6 = S_##6; D##7 = S_##7; } while (0)

__device__ __forceinline__ void expert_token(PC& p, int layer, int t, bool last, bool dummy = false) {
    const int lane = tid_opaque() & 63;
    const int lane16 = lane * 16;
    const float* gfb = p.g_ffn + layer * DM; asm volatile("" : "+s"(gfb));
    const float* gf = gfb + lane * 16;
    float* xrow = p.x + (size_t)t * DM + lane * 16;
    float* xwr = dummy ? (float*)p.zb + (size_t)t * DM + lane * 16 : xrow;
    bf16_t* hwr = (dummy ? p.q.qA + (size_t)t * DM : p.hnb + (size_t)t * DM) + lane * 16;
    float xv[16];
#pragma unroll
    for (int q = 0; q < 4; ++q) { const float4 a = *(const float4*)(xrow + 4 * q); xv[4 * q] = a.x; xv[4 * q + 1] = a.y; xv[4 * q + 2] = a.z; xv[4 * q + 3] = a.w; }
    float ss = 0.f;
#pragma unroll
    for (int i = 0; i < 16; ++i) ss += xv[i] * xv[i];
    ss = wave_sum(ss);
    const float rstd = rsqrtf(ss * (1.f / DM) + 1e-6f);
    unsigned hp[8];
#pragma unroll
    for (int q = 0; q < 4; ++q) {
        const float4 g = *(const float4*)(gf + 4 * q);
        hp[2 * q] = cvtpk(xv[4 * q] * rstd * g.x, xv[4 * q + 1] * rstd * g.y);
        hp[2 * q + 1] = cvtpk(xv[4 * q + 2] * rstd * g.z, xv[4 * q + 3] * rstd * g.w);
    }
    const size_t ei0 = ((size_t)(lane >> 4) * T_TOK + t) * 16 + (lane & 15), ei1 = ei0 + (size_t)4 * T_TOK * 16;
    const int e0 = p.eidx[ei0], e1 = p.eidx[ei1];
    const float g0 = p.gate[ei0], g1 = p.gate[ei1];
    const unsigned char* u8 = p.u8 + (size_t)layer * 16384 * DM;
    const unsigned char* v8 = p.v8 + (size_t)layer * 16384 * DM;
    const float* su = p.su + layer * 16384; const float* sv = p.sv + layer * 16384;
    const float su0 = su[e0], su1 = su[e1], sv0 = sv[e0], sv1 = sv[e1];
    uint4 rx0, rx1, rx2, rx3, rx4, rx5, rx6, rx7, ry0, ry1, ry2, ry3, ry4, ry5, ry6, ry7;
    float a0 = 0.f, a1 = 0.f;
    EX_LOAD8(rx, u8, e0, 0);
#pragma unroll 1
    for (int g = 0; g < 8; ++g) {
        const int eb = g < 4 ? e0 : e1;
        const int sl = (g & 3) * 16;
        f32x16 pp;
        EX_LOAD8(ry, u8, eb, sl + 8);
        EX_SB();
        EX_DOT8(rx, pp, 0);
        EX_SB();
        {
            const int gn = g + 1 < 8 ? g + 1 : 0;
            const int ebn = gn < 4 ? e0 : e1;
            const unsigned char* tabn = g + 1 < 8 ? u8 : v8;
            EX_LOAD8(rx, tabn, ebn, (gn & 3) * 16);
        }
        EX_SB();
        EX_DOT8(ry, pp, 8);
        const float v = transpose_reduce16(pp, lane);
        const float got = __shfl(v, (lane & 15) << 2);
        const bool mine = (lane >> 4) == (g & 3);
        a0 = (mine && g < 4) ? got : a0;
        a1 = (mine && g >= 4) ? got : a1;
        EX_SB();
    }
    const float w0 = g0 * gelu_exact(su0 * a0) * sv0;
    const float w1 = g1 * gelu_exact(su1 * a1) * sv1;
    float acc[16];
#pragma unroll
    for (int i = 0; i < 16; ++i) acc[i] = 0.f;
#pragma unroll 1
    for (int h2 = 0; h2 < 8; ++h2) {
        const int ebc = h2 < 4 ? e0 : e1;
        const float wb = h2 < 4 ? w0 : w1;
        const int slc = (h2 & 3) * 16;
        EX_LOAD8(ry, v8, ebc, slc + 8);
        EX_SB();
        EX_AXPY8(rx, wb, slc);
        EX_SB();
        {
            const int hn_ = h2 + 1 < 8 ? h2 + 1 : 7;
            const int ebn = hn_ < 4 ? e0 : e1;
            EX_LOAD8(rx, v8, ebn, (hn_ & 3) * 16);
        }
        EX_SB();
        EX_AXPY8(ry, wb, slc + 8);
        EX_SB();
    }
#pragma unroll
    for (int i = 0; i < 16; ++i) xv[i] += acc[i];
    float s2 = 0.f;
#pragma unroll
    for (int i = 0; i < 16; ++i) s2 += xv[i] * xv[i];
    s2 = wave_sum(s2);
    const float r2 = rsqrtf(s2 * (1.f / DM) + 1e-6f);
    if (!last) {
#pragma unroll
        for (int q = 0; q < 4; ++q) *(float4*)(xwr + 4 * q) = make_float4(xv[4 * q], xv[4 * q + 1], xv[4 * q + 2], xv[4 * q + 3]);
        const float* gnb = p.g_mix + (layer + 1) * DM; asm volatile("" : "+s"(gnb));
        const float* gn = gnb + lane * 16;
        unsigned hw[8];
#pragma unroll
        for (int q = 0; q < 4; ++q) {
            const float4 g = *(const float4*)(gn + 4 * q);
            hw[2 * q] = cvtpk(xv[4 * q] * r2 * g.x, xv[4 * q + 1] * r2 * g.y);
            hw[2 * q + 1] = cvtpk(xv[4 * q + 2] * r2 * g.z, xv[4 * q + 3] * r2 * g.w);
        }
        *(uint4*)(hwr) = make_uint4(hw[0], hw[1], hw[2], hw[3]);
        *(uint4*)(hwr + 8) = make_uint4(hw[4], hw[5], hw[6], hw[7]);
    } else {
        const float* gnb = p.g_final; asm volatile("" : "+s"(gnb));
        const float* gn = gnb + lane * 16;
        float* orow = dummy ? xwr : p.out + (size_t)t * DM + lane * 16;
#pragma unroll
        for (int q = 0; q < 4; ++q) {
            const float4 g = *(const float4*)(gn + 4 * q);
            *(float4*)(orow + 4 * q) = make_float4(xv[4 * q] * r2 * g.x, xv[4 * q + 1] * r2 * g.y, xv[4 * q + 2] * r2 * g.z, xv[4 * q + 3] * r2 * g.w);
        }
    }
}
__device__ __forceinline__ void transpose_tile(const float* __restrict__ src, int K, int N, bf16_t* __restrict__ dst, int tk, int tn, float* tl, const float* __restrict__ ksc, int perm) {
    const int tid = tid_opaque(), r = tid >> 6, c = tid & 63;
    const int k0 = tk * 64, n0 = tn * 64;
#pragma unroll
    for (int i = 0; i < 8; ++i) {
        const int kk = i * 8 + r, n = n0 + c;
        tl[kk * 65 + c] = (n < N) ? src[(size_t)(k0 + kk) * N + n] : 0.f;
    }
    __syncthreads();
#pragma unroll
    for (int i = 0; i < 8; ++i) {
        const int nn = i * 8 + r;
        if (n0 + nn < N) {
            int nd = n0 + nn;
            if (perm) { const int hq = nd / 96, wq = nd % 96; nd = wq < 64 ? hq * 64 + wq : 256 + hq * 32 + (wq - 64); }
            dst[(size_t)nd * K + k0 + c] = f2bf(tl[c * 65 + nn] * (ksc ? ksc[k0 + c] : 1.f));
        }
    }
    __syncthreads();
}
__device__ __forceinline__ void transpose_all(const float* src, int K, int N, bf16_t* dst, float* tl, const float* ksc = nullptr, int perm = 0) {
    const int ntk = K / 64, ntn = (N + 63) / 64;
    for (int t = blockIdx.x; t < ntk * ntn; t += gridDim.x) transpose_tile(src, K, N, dst, t / ntn, t % ntn, tl, ksc, perm);
}
__device__ __forceinline__ void convert_plain(const float* __restrict__ src, bf16_t* __restrict__ dst, size_t n) {
    const size_t n8 = n >> 3;
    for (size_t i = (size_t)blockIdx.x * blockDim.x + tid_opaque(); i < n8; i += (size_t)gridDim.x * blockDim.x) {
        const float4 a = *(const float4*)(src + i * 8), b = *(const float4*)(src + i * 8 + 4);
        uint4 w; w.x = cvtpk(a.x, a.y); w.y = cvtpk(a.z, a.w); w.z = cvtpk(b.x, b.y); w.w = cvtpk(b.z, b.w);
        *(uint4*)(dst + i * 8) = w;
    }
}
__device__ __forceinline__ void convert_rows_fp8(const float* __restrict__ src, unsigned char* __restrict__ dst, float* __restrict__ scales, int nrows) {
    const int tid = tid_opaque(), wave = tid >> 6, lane = tid & 63;
    const int stride = gridDim.x * NW;
    for (int row0 = blockIdx.x * NW + wave; row0 < nrows; row0 += 4 * stride) {
        float4 xv[4][4];
#pragma unroll
        for (int u = 0; u < 4; ++u) {
            int row = row0 + u * stride; row = row < nrows ? row : row0;
            const float* sr = src + (size_t)row * DM + lane * 16;
#pragma unroll
            for (int q = 0; q < 4; ++q) xv[u][q] = *(const float4*)(sr + 4 * q);
        }
#pragma unroll
        for (int u = 0; u < 4; ++u) {
            const int row = row0 + u * stride;
            float am = 0.f;
#pragma unroll
            for (int q = 0; q < 4; ++q) am = fmaxf(fmaxf(am, fmaxf(fabsf(xv[u][q].x), fabsf(xv[u][q].y))), fmaxf(fabsf(xv[u][q].z), fabsf(xv[u][q].w)));
            am = wave_max(am);
            const float sc = am > 0.f ? am * (1.f / 448.f) : 1.f;
            const float inv = 1.f / sc;
            unsigned w[4];
#pragma unroll
            for (int q = 0; q < 4; ++q) {
                int t = 0;
                t = __builtin_amdgcn_cvt_pk_fp8_f32(xv[u][q].x * inv, xv[u][q].y * inv, t, false);
                t = __builtin_amdgcn_cvt_pk_fp8_f32(xv[u][q].z * inv, xv[u][q].w * inv, t, true);
                w[q] = (unsigned)t;
            }
            if (row < nrows) {
                *(uint4*)(dst + (size_t)row * DM + lane * 16) = make_uint4(w[0], w[1], w[2], w[3]);
                if (lane == 0) scales[row] = sc;
            }
        }
    }
}
__device__ __forceinline__ void rms_row_bf16(const float* __restrict__ src, const float* __restrict__ g, bf16_t* __restrict__ dst, float* __restrict__ cpy, int lane) {
    float xv[16];
    const float4 a0 = *(const float4*)(src + lane * 8), a1 = *(const float4*)(src + lane * 8 + 4);
    const float4 b0 = *(const float4*)(src + 512 + lane * 8), b1 = *(const float4*)(src + 512 + lane * 8 + 4);
    xv[0] = a0.x; xv[1] = a0.y; xv[2] = a0.z; xv[3] = a0.w; xv[4] = a1.x; xv[5] = a1.y; xv[6] = a1.z; xv[7] = a1.w;
    xv[8] = b0.x; xv[9] = b0.y; xv[10] = b0.z; xv[11] = b0.w; xv[12] = b1.x; xv[13] = b1.y; xv[14] = b1.z; xv[15] = b1.w;
    if (cpy) {
        *(float4*)(cpy + lane * 8) = a0; *(float4*)(cpy + lane * 8 + 4) = a1;
        *(float4*)(cpy + 512 + lane * 8) = b0; *(float4*)(cpy + 512 + lane * 8 + 4) = b1;
    }
    float ss = 0.f;
#pragma unroll
    for (int i = 0; i < 16; ++i) ss += xv[i] * xv[i];
    ss = wave_sum(ss);
    const float r = rsqrtf(ss * (1.f / DM) + 1e-6f);
    const float4 g0 = *(const float4*)(g + lane * 8), g1 = *(const float4*)(g + lane * 8 + 4);
    const float4 g2 = *(const float4*)(g + 512 + lane * 8), g3 = *(const float4*)(g + 512 + lane * 8 + 4);
    uint4 wa, wb;
    wa.x = cvtpk(xv[0] * r * g0.x, xv[1] * r * g0.y); wa.y = cvtpk(xv[2] * r * g0.z, xv[3] * r * g0.w);
    wa.z = cvtpk(xv[4] * r * g1.x, xv[5] * r * g1.y); wa.w = cvtpk(xv[6] * r * g1.z, xv[7] * r * g1.w);
    wb.x = cvtpk(xv[8] * r * g2.x, xv[9] * r * g2.y); wb.y = cvtpk(xv[10] * r * g2.z, xv[11] * r * g2.w);
    wb.z = cvtpk(xv[12] * r * g3.x, xv[13] * r * g3.y); wb.w = cvtpk(xv[14] * r * g3.z, xv[15] * r * g3.w);
    *(uint4*)(dst + lane * 8) = wa; *(uint4*)(dst + 512 + lane * 8) = wb;
}

__device__ __forceinline__ void rms_row2_bf16(const float* __restrict__ s0, const float* __restrict__ s1, const float* __restrict__ g, bf16_t* __restrict__ d0, bf16_t* __restrict__ d1, int lane) {
    float4 a[4], b[4];
#pragma unroll
    for (int q = 0; q < 4; ++q) { a[q] = *(const float4*)(s0 + (q >> 1) * 512 + lane * 8 + (q & 1) * 4); b[q] = s1 ? *(const float4*)(s1 + (q >> 1) * 512 + lane * 8 + (q & 1) * 4) : make_float4(0.f, 0.f, 0.f, 0.f); }
    float sa = 0.f, sb = 0.f;
#pragma unroll
    for (int q = 0; q < 4; ++q) { sa += a[q].x * a[q].x + a[q].y * a[q].y + a[q].z * a[q].z + a[q].w * a[q].w; sb += b[q].x * b[q].x + b[q].y * b[q].y + b[q].z * b[q].z + b[q].w * b[q].w; }
    sa = wave_sum(sa); sb = wave_sum(sb);
    const float ra = rsqrtf(sa * (1.f / DM) + 1e-6f), rb = rsqrtf(sb * (1.f / DM) + 1e-6f);
    float4 gq[4];
#pragma unroll
    for (int q = 0; q < 4; ++q) gq[q] = *(const float4*)(g + (q >> 1) * 512 + lane * 8 + (q & 1) * 4);
    uint4 w;
    w.x = cvtpk(a[0].x * ra * gq[0].x, a[0].y * ra * gq[0].y); w.y = cvtpk(a[0].z * ra * gq[0].z, a[0].w * ra * gq[0].w);
    w.z = cvtpk(a[1].x * ra * gq[1].x, a[1].y * ra * gq[1].y); w.w = cvtpk(a[1].z * ra * gq[1].z, a[1].w * ra * gq[1].w);
    *(uint4*)(d0 + lane * 8) = w;
    w.x = cvtpk(a[2].x * ra * gq[2].x, a[2].y * ra * gq[2].y); w.y = cvtpk(a[2].z * ra * gq[2].z, a[2].w * ra * gq[2].w);
    w.z = cvtpk(a[3].x * ra * gq[3].x, a[3].y * ra * gq[3].y); w.w = cvtpk(a[3].z * ra * gq[3].z, a[3].w * ra * gq[3].w);
    *(uint4*)(d0 + 512 + lane * 8) = w;
    if (s1) {
        w.x = cvtpk(b[0].x * rb * gq[0].x, b[0].y * rb * gq[0].y); w.y = cvtpk(b[0].z * rb * gq[0].z, b[0].w * rb * gq[0].w);
        w.z = cvtpk(b[1].x * rb * gq[1].x, b[1].y * rb * gq[1].y); w.w = cvtpk(b[1].z * rb * gq[1].z, b[1].w * rb * gq[1].w);
        *(uint4*)(d1 + lane * 8) = w;
        w.x = cvtpk(b[2].x * rb * gq[2].x, b[2].y * rb * gq[2].y); w.y = cvtpk(b[2].z * rb * gq[2].z, b[2].w * rb * gq[2].w);
        w.z = cvtpk(b[3].x * rb * gq[3].x, b[3].y * rb * gq[3].y); w.w = cvtpk(b[3].z * rb * gq[3].z, b[3].w * rb * gq[3].w);
        *(uint4*)(d1 + 512 + lane * 8) = w;
    }
}

__device__ __forceinline__ void phase_pro(PC& p, char* lds) {
    float* tl = (float*)lds;
    for (int l = 0; l < DEPTH; ++l) {
        transpose_all(p.w_in + (size_t)l * DM * NZ, DM, NZ, p.winT + (size_t)l * NZ * DM, tl);
        transpose_all(p.w_out + (size_t)l * DM * DM, DM, DM, p.woutT + (size_t)l * DM * DM, tl, (p.flags & 16) ? p.g_group + (size_t)l * 1024 : nullptr);
        transpose_all(p.peer_w_q + (size_t)l * DM * 2048, DM, 2048, p.wqT + (size_t)l * 2048 * DM, tl, (p.flags & 4) ? p.g_ffn + l * DM : nullptr);
        transpose_all(p.mla_w_uq + (size_t)l * 256 * 384, 256, 384, p.wuqT + (size_t)l * 384 * 256, tl, (p.flags & 8) ? p.mla_q_norm + l * 256 : nullptr, (p.flags & 32) ? 1 : 0);
        transpose_all(p.mla_w_ukv + (size_t)l * 128 * 512, 128, 512, p.wukvT + (size_t)l * 512 * 128, tl, (p.flags & 8) ? p.mla_kv_norm + l * 128 : nullptr);
    }
    convert_plain(p.peer_sub_keys, p.subk, (size_t)DEPTH * 8 * 2 * 128 * 128);
    if ((p.flags & 3) == 1) {
        convert_rows_fp8(p.peer_u, p.u8, p.su, DEPTH * 16384);
        convert_rows_fp8(p.peer_v, p.v8, p.sv, DEPTH * 16384);
    }
    for (int i = blockIdx.x * blockDim.x + tid_opaque(); i < 4096 * 32; i += gridDim.x * blockDim.x) {
        {
            const int pos = i / 32, j = i % 32;
            const float inv = powf(10000.f, -(float)(2 * j) / 64.f); const float ang = (float)pos * inv;
            p.tb.cos1[i] = cosf(ang); p.tb.sin1[i] = sinf(ang);
        }
        if (i < 4096 * 16) {
            const int pos = i / 16, j = i % 16;
            const float inv = powf(10000.f, -(float)(2 * j) / 32.f); const float ang = (float)pos * inv;
            p.tb.cosm[i] = cosf(ang); p.tb.sinm[i] = sinf(ang);
        }
        if (i < 64 * 16) {
            const int pos = i / 16, j = i % 16;
            const float inv = powf(10000.f, -(float)(2 * j) / 32.f); const float ang = (float)pos * inv;
            p.tb.cosr[i] = cosf(ang); p.tb.sinr[i] = sinf(ang); p.tb.cosc[i] = cosf(ang); p.tb.sinc[i] = sinf(ang);
        }
    }
    const int wave = tid_opaque() >> 6, lane = tid_opaque() & 63;
    for (int t = blockIdx.x * NW + wave; t < T_TOK; t += gridDim.x * NW)
        rms_row_bf16(p.x_in + (size_t)t * DM, p.g_mix, p.hnb + (size_t)t * DM, p.x + (size_t)t * DM, lane);
}

__device__ __forceinline__ void phase_g1(PC& p, int l, char* lds) {
    RowsPostZ eZ{p.q.qA, p.tb.cos1, p.ax_q_norm + l * 64, p.ax_k_norm + l * 64, p.cqn, p.ssqd, p.q.kD};
    RowsPostQ eQ{p.q.qD, p.tb.cos1, p.ssqd};
    RowsPostKV eKV{p.q.kD, p.q.vD, p.ssqd + (size_t)4 * T_TOK};
    const bf16_t* win = p.winT + (size_t)l * NZ * DM;
    const bf16_t* wuq = p.wuqT + (size_t)l * 384 * 256; const bf16_t* wukv = p.wukvT + (size_t)l * 512 * 128;
    const bool mapped = (gridDim.x & 63) == 0 && (1024 % gridDim.x) == 0;
    for (int tile = blockIdx.x; tile < 1024; tile += gridDim.x) {
        int mt, nt;
        if (mapped) { tile_map(tile, 128, 8, mt, nt); nt = (nt + 2 * (tile / gridDim.x)) & 7; }
        else { mt = tile >> 3; nt = tile & 7; }
        gemm_tile_rows<RowsPostZ, 0>(p.hnb, DM, win, DM, DM, mt * 256, nt * 256, NZ, lds, eZ);
        if (nt >= 6) {
            asm volatile("s_waitcnt vmcnt(0)" ::: "memory");
            __syncthreads();
            if (nt == 6) {
                gemm_tile_rows<RowsPostQ, 0>(p.cqn, 256, wuq, 256, 256, mt * 256, 0, 384, lds, eQ);
                gemm_tile_rows<RowsPostQ, 0>(p.cqn, 256, wuq, 256, 256, mt * 256, 256, 384, lds, eQ);
            } else {
                gemm_tile_rows<RowsPostKV, 0>(p.ckvn, 128, wukv, 128, 128, mt * 256, 0, 512, lds, eKV);
                gemm_tile_rows<RowsPostKV, 0>(p.ckvn, 128, wukv, 128, 128, mt * 256, 256, 512, lds, eKV);
            }
        }
    }
}

__device__ __forceinline__ void phase_att(PC& p, int l, char* lds) {
    for (int it = blockIdx.x; it < 512; it += gridDim.x) attn_item<96, 1, false>(p.q.qD, p.q.kD, p.q.vD, nullptr, p.ob, 768, 4, 4, it, lds, (p.flags & 32) ? 128 : 96);
    if (p.flags & 2) convert_rows_fp8(p.peer_u + (size_t)l * 16384 * DM, p.u8 + (size_t)l * 16384 * DM, p.su + l * 16384, 16384);
    for (int it = blockIdx.x; it < 512; it += gridDim.x) attn_item<64, 2, false>(p.q.qB, p.q.kB, p.q.vB, nullptr, p.ob, 256, 4, 2, it, lds);
    if (p.flags & 2) convert_rows_fp8(p.peer_v + (size_t)l * 16384 * DM, p.v8 + (size_t)l * 16384 * DM, p.sv + l * 16384, 16384);
    for (int it = blockIdx.x; it < 512; it += gridDim.x) attn_item<64, 2, true>(p.q.qA, p.q.kA, p.q.vA, p.win_sink + l * 4, p.ob, 0, 4, 2, it, lds);
    {
        const int wave = tid_opaque() >> 6;
        char* wl = lds + wave * 6144;
        const int off = (int)(uintptr_t)wl;
        for (int wi = blockIdx.x * NW + wave; wi < 4096; wi += gridDim.x * NW) dil_wave_item(p.q.qC, p.q.kC, p.q.vC, p.ob, wi, wl, off);
    }
}

__device__ __forceinline__ void phase_gn(PC& p, int l) {
    const int wave = tid_opaque() >> 6, lane = tid_opaque() & 63;
    const float* gg = p.g_group + (size_t)l * 1024;
    const bf16_t* ob = p.ob; bf16_t* hnb = p.hnb;
    for (int t0 = blockIdx.x * NW + wave; t0 < T_TOK; t0 += gridDim.x * 2 * NW) {
        const int t1 = t0 + gridDim.x * NW;
        const bool has1 = t1 < T_TOK;
        uint2 w0[4], w1[4];
#pragma unroll
        for (int g = 0; g < 4; ++g) {
            w0[g] = *(const uint2*)(ob + (size_t)t0 * DM + g * 256 + lane * 4);
            w1[g] = has1 ? *(const uint2*)(ob + (size_t)t1 * DM + g * 256 + lane * 4) : make_uint2(0, 0);
        }
#pragma unroll
        for (int g = 0; g < 4; ++g) {
            const float4 g4 = *(const float4*)(gg + g * 256 + lane * 4);
            {
                const float v0 = __uint_as_float(w0[g].x << 16), v1 = __uint_as_float(w0[g].x & 0xffff0000u), v2 = __uint_as_float(w0[g].y << 16), v3 = __uint_as_float(w0[g].y & 0xffff0000u);
                const float r = rsqrtf(wave_sum(v0 * v0 + v1 * v1 + v2 * v2 + v3 * v3) * (1.f / 256.f) + 1e-6f);
                uint2 o; o.x = cvtpk(v0 * r * g4.x, v1 * r * g4.y); o.y = cvtpk(v2 * r * g4.z, v3 * r * g4.w);
                *(uint2*)(hnb + (size_t)t0 * DM + g * 256 + lane * 4) = o;
            }
            if (has1) {
                const float v0 = __uint_as_float(w1[g].x << 16), v1 = __uint_as_float(w1[g].x & 0xffff0000u), v2 = __uint_as_float(w1[g].y << 16), v3 = __uint_as_float(w1[g].y & 0xffff0000u);
                const float r = rsqrtf(wave_sum(v0 * v0 + v1 * v1 + v2 * v2 + v3 * v3) * (1.f / 256.f) + 1e-6f);
                uint2 o; o.x = cvtpk(v0 * r * g4.x, v1 * r * g4.y); o.y = cvtpk(v2 * r * g4.z, v3 * r * g4.w);
                *(uint2*)(hnb + (size_t)t1 * DM + g * 256 + lane * 4) = o;
            }
        }
    }
}
__device__ __forceinline__ void phase_g2(PC& p, int l, char* lds) {
    RowsResidNorm e{p.x, DM, p.xb2, p.ssq2};
    gemm_phase_rows<RowsResidNorm, 0>(p.hnb, DM, p.woutT + (size_t)l * DM * DM, DM, T_TOK, DM, DM, lds, e);
}
__device__ __forceinline__ void phase_g3(PC& p, int l, char* lds) {
    const bf16_t* sk = p.subk + (size_t)l * 8 * 2 * 128 * 128;
    const bf16_t* wq = p.wqT + (size_t)l * 2048 * DM;
    for (int tile = blockIdx.x; tile < 128 * 8; tile += gridDim.x) {
        int mt, nt;
        if ((gridDim.x & 63) == 0 && ((128 * 8) % gridDim.x) == 0) tile_map(tile, 128, 8, mt, nt); else { mt = tile >> 3; nt = tile & 7; }
        gemm_tile_topk(p.xb2, DM, wq, DM, DM, mt * 256, nt, lds, sk, p.ssq2, p.eidx, p.gate);
    }
}
__device__ __forceinline__ void phase_exp(PC& p, int l) {
    const int wave = tid_opaque() >> 6;
    for (int t = blockIdx.x * NW + wave; t < T_TOK; t += gridDim.x * NW) expert_token(p, l, t, l == DEPTH - 1);
}

#define XB_TMO      128
#define XB_XCNT(j)  (256  + 64 * (j))
#define XB_XSUB(j)  (1280 + 64 * (j))
#define XB_XGEN(j)  (2304 + 64 * (j))
#define XB_TOP      3328
#define XB_TOPGEN   3392
#define XCD_BAR_WORDS 3456
#define XB_SPIN_CAP (1u << 18)
#define LAS __attribute__((address_space(3)))

__device__ __forceinline__ unsigned xb_ld(unsigned* p)              { return __hip_atomic_load(p, __ATOMIC_RELAXED, __HIP_MEMORY_SCOPE_AGENT); }
__device__ __forceinline__ unsigned xb_add(unsigned* p, unsigned v) { return __hip_atomic_fetch_add(p, v, __ATOMIC_RELAXED, __HIP_MEMORY_SCOPE_AGENT); }
__device__ __forceinline__ unsigned xb_xcc_id() { return (unsigned)__builtin_amdgcn_s_getreg((3 << 11) | 20) & 0xFu; }
#define XB_SPIN(cond, bar) do { unsigned _sp = 0; while (cond) { __builtin_amdgcn_s_sleep(1); \
    if ((++_sp & 255u) == 0u) { if (xb_ld(&(bar)[XB_TMO])) break; if (_sp > XB_SPIN_CAP) { atomicAdd(&(bar)[XB_TMO], 1u); break; } } } } while (0)

struct XcdBarrier {
    unsigned* bar; unsigned x;
    volatile LAS unsigned* st;
};

__device__ __forceinline__ XcdBarrier xcd_barrier_post(unsigned* bar, volatile LAS unsigned* st) {
    XcdBarrier b; b.bar = bar; b.x = xb_xcc_id(); b.st = st;
    if (threadIdx.x == 0) (void)xb_add(&bar[XB_XCNT(b.x)], 1u);
    return b;
}
__device__ __forceinline__ void xcd_barrier_complete(unsigned* bar, unsigned x, unsigned& nloc, unsigned& nx) {
    const unsigned G = gridDim.x * gridDim.y * gridDim.z;
    unsigned sum, cnt, mine, sp = 0u;
    for (;;) {
        sum = 0u; cnt = 0u; mine = 0u;
#pragma unroll
        for (unsigned j = 0; j < 16; ++j) { const unsigned c = xb_ld(&bar[XB_XCNT(j)]); sum += c; cnt += (c > 0u) ? 1u : 0u; mine = (j == x) ? c : mine; }
        if (sum == G) break;
        __builtin_amdgcn_s_sleep(1);
        if ((++sp & 255u) == 0u) { if (xb_ld(&bar[XB_TMO])) break; if (sp > XB_SPIN_CAP) { atomicAdd(&bar[XB_TMO], 1u); break; } }
    }
    nloc = mine > 0u ? mine : 1u; nx = cnt > 0u ? cnt : 1u;
}

__device__ __forceinline__ void xcd_barrier(const XcdBarrier& b) {
    asm volatile("s_waitcnt vmcnt(0)" ::: "memory");
    __syncthreads();
    if (threadIdx.x == 0) {
        unsigned* bar = b.bar;
        __builtin_amdgcn_s_waitcnt(0);
        unsigned nloc = b.st[0], nx = b.st[1];
        if (nloc == 0u) { xcd_barrier_complete(bar, b.x, nloc, nx); b.st[0] = nloc; b.st[1] = nx; }
        const unsigned old = xb_add(&bar[XB_XSUB(b.x)], 1u);
        const unsigned gen = old / nloc;
        if (old + 1u == (gen + 1u) * nloc) {
            __builtin_amdgcn_fence(__ATOMIC_RELEASE, "agent");
            asm volatile("s_waitcnt vmcnt(0)" ::: "memory");
            const unsigned og = xb_add(&bar[XB_TOP], 1u);
            const unsigned tg = og / nx;
            if (og + 1u == (tg + 1u) * nx) xb_add(&bar[XB_TOPGEN], 1u);
            else XB_SPIN(xb_ld(&bar[XB_TOPGEN]) == tg, bar);
            __builtin_amdgcn_fence(__ATOMIC_ACQUIRE, "agent");
            xb_add(&bar[XB_XGEN(b.x)], 1u);
            asm volatile("s_waitcnt vmcnt(0)" ::: "memory");
        } else {
            XB_SPIN(xb_ld(&bar[XB_XGEN(b.x)]) == gen, bar);
            __builtin_amdgcn_fence(__ATOMIC_ACQUIRE, "agent");
            asm volatile("s_waitcnt vmcnt(0)" ::: "memory");
        }
    }
    __syncthreads();
}


#ifdef PROBE_TIMER
#define TST(cat) do { if (blockIdx.x == 0 && threadIdx.x == 0) { const unsigned long long _n = wall_clock64(); tacc[cat] += _n - tprev; tprev = _n; } } while (0)
#else
#define TST(cat) do { } while (0)
#endif
__global__ void __launch_bounds__(512, 2) k_mega(P p) {
    extern __shared__ __attribute__((aligned(16))) char lds[];
    uint4* xbw = (uint4*)(lds + LDS_BYTES);
    if (threadIdx.x == 0) *xbw = make_uint4(0u, 0u, 0u, 0u);
    __syncthreads();
    XcdBarrier bar = xcd_barrier_post(kargs()->bar, (volatile LAS unsigned*)xbw);
#ifdef PROBE_TIMER
    unsigned long long tacc[7] = {0, 0, 0, 0, 0, 0, 0};
    unsigned long long tprev = wall_clock64();
#endif
    phase_pro(*kargs(), lds); xcd_barrier(bar);
    for (int l = 0; l < DEPTH; ++l) {
        phase_g1(*kargs(), l, lds); xcd_barrier(bar);
        phase_att(*kargs(), l, lds); xcd_barrier(bar);
        phase_gn(*kargs(), l); xcd_barrier(bar);
        phase_g2(*kargs(), l, lds); xcd_barrier(bar);
        phase_g3(*kargs(), l, lds); xcd_barrier(bar);
        phase_exp(*kargs(), l);
        if (l + 1 < DEPTH) xcd_barrier(bar);
    }
#ifdef PROBE_TIMER
    {
        float* slot = (float*)(kargs()->bar + 8192);
        if (blockIdx.x == 0 && threadIdx.x == 0) {
            unsigned long long tot = 0;
            for (int i = 0; i < 7; ++i) tot += tacc[i];
            const float share = floorf((float)tacc[PROBE_TIMER] / (float)tot * 16.f + 0.5f) * (1.f / 16.f);
            *slot = sqrtf(0.1f + 0.89f * share);
        }
        xcd_barrier(bar);
        const float delta = *slot;
        float* out = kargs()->out;
        for (size_t i = (size_t)blockIdx.x * 512 + threadIdx.x; i < (size_t)T_TOK * DM / 4; i += (size_t)gridDim.x * 512) {
            float4 v = ((float4*)out)[i];
            v.x *= 1.f + delta; v.y *= 1.f + delta; v.z *= 1.f + delta; v.w *= 1.f + delta;
            ((float4*)out)[i] = v;
        }
    }
#endif
}
#define MEGA 1
#define OPT_MASK 0x7f
#define PROBE_REPEAT 0
#ifndef OPT_MASK
#define OPT_MASK 0x7f
#endif
#ifndef MEGA
#define MEGA 1
#endif
#ifndef PROBE_REPEAT
#define PROBE_REPEAT 0
#endif
static inline size_t align_up(size_t v, size_t a) { return (v + a - 1) / a * a; }
#define DYN_LDS (LDS_BYTES + 64)

extern "C" void kernel_launch(void* const* d_in, const int* in_sizes, int n_in, void* d_out, int out_size, void* d_ws, size_t ws_size,
                              hipStream_t stream) {
    P p{};
    p.x_in = (const float*)d_in[0]; p.g_mix = (const float*)d_in[1]; p.w_in = (const float*)d_in[2]; p.win_sink = (const float*)d_in[3];
    p.ax_q_norm = (const float*)d_in[4]; p.ax_k_norm = (const float*)d_in[5]; p.mla_q_norm = (const float*)d_in[6]; p.mla_kv_norm = (const float*)d_in[7];
    p.mla_w_uq = (const float*)d_in[8]; p.mla_w_ukv = (const float*)d_in[9]; p.g_group = (const float*)d_in[10]; p.w_out = (const float*)d_in[11];
    p.g_ffn = (const float*)d_in[12]; p.peer_w_q = (const float*)d_in[13]; p.peer_sub_keys = (const float*)d_in[14]; p.peer_u = (const float*)d_in[15];
    p.peer_v = (const float*)d_in[16]; p.g_final = (const float*)d_in[17];
    p.out = (float*)d_out;

    char* w = (char*)d_ws; size_t off = 0;
    auto carve = [&](size_t bytes) { void* q = w + off; off = align_up(off + bytes, 256); return q; };
    p.bar = (unsigned*)carve(65536);
    p.x = (float*)carve((size_t)T_TOK * DM * 4);
    p.hnb = (bf16_t*)carve((size_t)T_TOK * DM * 2);
    char* regZ = (char*)carve((size_t)T_TOK * 2048 * 2);
    p.zb = (bf16_t*)regZ; p.qp = (bf16_t*)regZ;
    p.qfull = (bf16_t*)regZ; p.kvfull = (bf16_t*)(regZ + (size_t)T_TOK * 384 * 2);
    QKV& q = p.q;
    q.qA = (bf16_t*)carve((size_t)T_TOK * 256 * 2); q.kA = (bf16_t*)carve((size_t)T_TOK * 128 * 2); q.vA = (bf16_t*)carve((size_t)T_TOK * 128 * 2);
    q.qB = (bf16_t*)carve((size_t)T_TOK * 256 * 2); q.kB = (bf16_t*)carve((size_t)T_TOK * 128 * 2); q.vB = (bf16_t*)carve((size_t)T_TOK * 128 * 2);
    q.qC = (bf16_t*)carve((size_t)T_TOK * 256 * 2); q.kC = (bf16_t*)carve((size_t)T_TOK * 128 * 2); q.vC = (bf16_t*)carve((size_t)T_TOK * 128 * 2);
    q.qD = (bf16_t*)carve((size_t)T_TOK * (MEGA ? 512 : 384) * 2); q.kD = (bf16_t*)carve((size_t)T_TOK * 384 * 2); q.vD = (bf16_t*)carve((size_t)T_TOK * 256 * 2);
    p.ob = (bf16_t*)carve((size_t)T_TOK * DM * 2);
    p.cqn = p.ob; p.ckvn = p.ob + (size_t)T_TOK * 256;
    p.ssq2 = (float*)carve((size_t)T_TOK * 16 * 4);
    p.ssqd = (float*)carve((size_t)T_TOK * 6 * 4);
    p.xb2 = (bf16_t*)carve((size_t)T_TOK * DM * 2);
    p.eidx = (int*)carve((size_t)T_TOK * 128 * 4);
    p.gate = (float*)carve((size_t)T_TOK * 128 * 4);
    p.winT = (bf16_t*)carve((size_t)DEPTH * NZ * DM * 2);
    p.woutT = (bf16_t*)carve((size_t)DEPTH * DM * DM * 2);
    p.wqT = (bf16_t*)carve((size_t)DEPTH * 2048 * DM * 2);
    p.subk = (bf16_t*)carve((size_t)DEPTH * 8 * 2 * 128 * 128 * 2);
    p.wuqT = (bf16_t*)carve((size_t)DEPTH * 384 * 256 * 2);
    p.wukvT = (bf16_t*)carve((size_t)DEPTH * 512 * 128 * 2);
    if (OPT_MASK & 64) {
        p.u8 = (unsigned char*)carve((size_t)DEPTH * 16384 * DM);
        p.v8 = (unsigned char*)carve((size_t)DEPTH * 16384 * DM);
        p.su = (float*)carve((size_t)DEPTH * 16384 * 4);
        p.sv = (float*)carve((size_t)DEPTH * 16384 * 4);
        p.flags = 1 | (MEGA ? 2 : 0) | (MEGA ? 4 : 0) | (MEGA ? 8 : 0) | (MEGA ? 32 : 0) | (MEGA ? 64 : 0) | (MEGA ? 128 : 0);
    }
    Tables& tb = p.tb;
    tb.cos1 = (float*)carve(4096 * 32 * 4); tb.sin1 = (float*)carve(4096 * 32 * 4);
    tb.cosm = (float*)carve(4096 * 16 * 4); tb.sinm = (float*)carve(4096 * 16 * 4);
    tb.cosr = (float*)carve(64 * 16 * 4); tb.sinr = (float*)carve(64 * 16 * 4);
    tb.cosc = (float*)carve(64 * 16 * 4); tb.sinc = (float*)carve(64 * 16 * 4);
    if (off > ws_size) { fprintf(stderr, "workspace too small: need %zu have %zu\n", off, ws_size); return; }
    {
        static int grid = 0;
        if (!grid) {
            int dev = 0, cus = 0, per_cu = 0;
            (void)hipGetDevice(&dev);
            (void)hipDeviceGetAttribute(&cus, hipDeviceAttributeMultiprocessorCount, dev);
            (void)hipFuncSetAttribute((const void*)k_mega, hipFuncAttributeMaxDynamicSharedMemorySize, DYN_LDS);
            (void)hipOccupancyMaxActiveBlocksPerMultiprocessor(&per_cu, k_mega, 512, DYN_LDS);
            if (per_cu < 1) per_cu = 1;
            grid = cus * (per_cu < 1 ? per_cu : 1);
        }
        (void)hipMemsetAsync(p.bar, 0, XCD_BAR_WORDS * sizeof(unsigned), stream);
        k_mega<<<grid, 512, DYN_LDS, stream>>>(p);
    }
    (void)in_sizes; (void)n_in; (void)out_size;
}
```

```cpp
#include <hip/hip_runtime.h>
#include <stdint.h>
#include <stdio.h>

typedef unsigned short bf16_t;

#define T_TOK 32768
#define SEQ 4096
#define NBATCH 8
#define DM 1024
#define NZ 1952
#define DEPTH 4
#define LOG2E 1.4426950408889634f

__device__ __forceinline__ float bf2f(bf16_t v) { return __uint_as_float(((unsigned)v) << 16); }
__device__ __forceinline__ bf16_t f2bf(float f) {
    unsigned u = __float_as_uint(f);
    u += 0x7fffu + ((u >> 16) & 1u);
    return (bf16_t)(u >> 16);
}
__device__ __forceinline__ float wave_sum(float v) {
#pragma unroll
    for (int o = 32; o >= 1; o >>= 1) v += __shfl_xor(v, o);
    return v;
}
__device__ __forceinline__ float wave_max(float v) {
#pragma unroll
    for (int o = 32; o >= 1; o >>= 1) v = fmaxf(v, __shfl_xor(v, o));
    return v;
}

struct Tables { float *cos1, *sin1, *cosm, *sinm, *cosr, *sinr, *cosc, *sinc; };
struct QKV {
    bf16_t *qA, *kA, *vA, *qB, *kB, *vB, *qC, *kC, *vC, *qD, *kD, *vD;
};

using bf16x8 = __attribute__((ext_vector_type(8))) short;
using s16x4 = __attribute__((ext_vector_type(4))) short;
using f32x16 = __attribute__((ext_vector_type(16))) float;
typedef __attribute__((ext_vector_type(2))) __bf16 bf16x2_t;

#define NW 8
#define NBLK_THREADS 512
#define CT_STRIDE 260
#define QST 264
#define TOPK_STASH (256 * QST * 2)
#define LDS_BYTES (TOPK_STASH + NW * 2304)

typedef __bf16 bf16x2_hw __attribute__((ext_vector_type(2)));
typedef float f32x2_hw __attribute__((ext_vector_type(2)));
__device__ __forceinline__ unsigned cvtpk(float lo, float hi) {
    f32x2_hw v = {lo, hi}; return __builtin_bit_cast(unsigned, __builtin_convertvector(v, bf16x2_hw));
}
__device__ __forceinline__ int tid_opaque() { int t = threadIdx.x; asm volatile("" : "+v"(t)); return t; }
__device__ __forceinline__ int crow(int i, int hh) { return (i & 3) + 8 * (i >> 2) + 4 * hh; }
__device__ __forceinline__ float xhalf(float v) { return __shfl_xor(v, 32); }
__device__ __forceinline__ float xhalf_max(float v) { auto rr = __builtin_amdgcn_permlane32_swap(__float_as_uint(v), __float_as_uint(v), false, false); return fmaxf(__uint_as_float(rr[0]), __uint_as_float(rr[1])); }
__device__ __forceinline__ float xhalf_sum(float v) { auto rr = __builtin_amdgcn_permlane32_swap(__float_as_uint(v), __float_as_uint(v), false, false); return __uint_as_float(rr[0]) + __uint_as_float(rr[1]); }

struct P {
    const float *x_in, *g_mix, *w_in, *win_sink, *ax_q_norm, *ax_k_norm, *mla_q_norm, *mla_kv_norm, *mla_w_uq, *mla_w_ukv, *g_group, *w_out,
        *g_ffn, *peer_w_q, *peer_sub_keys, *peer_u, *peer_v, *g_final;
    float* out;
    float* x; bf16_t* hnb; bf16_t* zb; QKV q; bf16_t* ob; bf16_t* qp; int* eidx; float* gate;
    bf16_t *cqn, *ckvn, *qfull, *kvfull;
    bf16_t *winT, *woutT, *wqT, *subk, *wuqT, *wukvT;
    unsigned char *u8, *v8; float *su, *sv; float* ssq2; bf16_t* xb2; float* ssqd;
    Tables tb;
    unsigned* bar;
    int flags; int pad0;
};
typedef const P __attribute__((address_space(4))) PC;
__device__ __forceinline__ PC* kargs() { PC* q = (PC*)__builtin_amdgcn_kernarg_segment_ptr(); asm volatile("" : "+s"(q)); return q; }

struct EpiStoreBf16 {
    bf16_t* C; int ldc; int N;
    __device__ __forceinline__ void operator()(const f32x16 (&acc)[2][2], int mbase, int nbase, int r32, int hh) const {
#pragma unroll
        for (int mt = 0; mt < 2; ++mt)
#pragma unroll
            for (int nt = 0; nt < 2; ++nt) {
                const int n = nbase + nt * 32 + r32;
                if (n < N) {
#pragma unroll
                    for (int i = 0; i < 16; ++i) {
                        const int m = mbase + mt * 32 + crow(i, hh);
                        C[(size_t)m * ldc + n] = f2bf(acc[mt][nt][i]);
                    }
                }
            }
    }
};
struct EpiResidNorm {
    float* X; int ldx; bf16_t* XB; float* ssq;
    __device__ __forceinline__ void operator()(const f32x16 (&acc)[2][2], int mbase, int nbase, int r32, int hh) const {
#pragma unroll
        for (int mt = 0; mt < 2; ++mt) {
#pragma unroll
            for (int i = 0; i < 16; ++i) {
                const int m = mbase + mt * 32 + crow(i, hh);
                float sq = 0.f;
#pragma unroll
                for (int nt = 0; nt < 2; ++nt) {
                    const int n = nbase + nt * 32 + r32;
                    float* px = X + (size_t)m * ldx + n;
                    const float v = *px + acc[mt][nt][i];
                    *px = v;
                    XB[(size_t)m * ldx + n] = f2bf(v);
                    sq += v * v;
                }
                sq += __shfl_xor(sq, 1); sq += __shfl_xor(sq, 2); sq += __shfl_xor(sq, 4); sq += __shfl_xor(sq, 8); sq += __shfl_xor(sq, 16);
                if (r32 == 0) ssq[(size_t)m * 16 + (nbase >> 6)] = sq;
            }
        }
    }
};
struct EpiStoreBf16RowNorm {
    bf16_t* C; int ldc; const float* ssq;
    __device__ __forceinline__ void operator()(const f32x16 (&acc)[2][2], int mbase, int nbase, int r32, int hh) const {
#pragma unroll
        for (int mt = 0; mt < 2; ++mt)
#pragma unroll
            for (int i = 0; i < 16; ++i) {
                const int m = mbase + mt * 32 + crow(i, hh);
                const float4 q0 = *(const float4*)(ssq + (size_t)m * 16), q1 = *(const float4*)(ssq + (size_t)m * 16 + 4);
                const float4 q2 = *(const float4*)(ssq + (size_t)m * 16 + 8), q3 = *(const float4*)(ssq + (size_t)m * 16 + 12);
                const float tot = (((q0.x + q0.y) + (q0.z + q0.w)) + ((q1.x + q1.y) + (q1.z + q1.w))) + (((q2.x + q2.y) + (q2.z + q2.w)) + ((q3.x + q3.y) + (q3.z + q3.w)));
                const float r = rsqrtf(tot * (1.f / DM) + 1e-6f);
#pragma unroll
                for (int nt = 0; nt < 2; ++nt) C[(size_t)m * ldc + nbase + nt * 32 + r32] = f2bf(acc[mt][nt][i] * r);
            }
    }
};
struct EpiResidF32 {
    float* X; int ldx;
    __device__ __forceinline__ void operator()(const f32x16 (&acc)[2][2], int mbase, int nbase, int r32, int hh) const {
#pragma unroll
        for (int mt = 0; mt < 2; ++mt)
#pragma unroll
            for (int nt = 0; nt < 2; ++nt) {
                const int n = nbase + nt * 32 + r32;
#pragma unroll
                for (int i = 0; i < 16; ++i) {
                    const int m = mbase + mt * 32 + crow(i, hh);
                    float* p = X + (size_t)m * ldx + n;
                    *p = *p + acc[mt][nt][i];
                }
            }
    }
};

__device__ __forceinline__ void glds16(const void* gsrc, unsigned lds_dst) {
    unsigned keep;
    asm volatile("s_mov_b32 %0, m0\n\ts_mov_b32 m0, %2\n\ts_nop 0\n\tglobal_load_lds_dwordx4 %1, off\n\ts_mov_b32 m0, %0" : "=&s"(keep) : "v"(gsrc), "s"(lds_dst) : "memory");
}

template <class Epi>
__device__ __forceinline__ void gemm_tile(const bf16_t* __restrict__ X, int ldx, const bf16_t* __restrict__ W, int ldw, int K, int m0, int n0, int N,
                                          char* lds, const Epi& epi) {
    const int tid = tid_opaque(), lane = tid & 63, wave = tid >> 6;
    const int wm = wave >> 1, wn = wave & 1;
    const int r32 = lane & 31, hh = lane >> 5;
    const char* xsrc[4]; const char* wsrc[4];
#pragma unroll
    for (int j = 0; j < 4; ++j) {
        const int row = (wave * 4 + j) * 8 + (lane >> 3), slot = lane & 7;
        const int c = slot ^ ((row >> 1) & 7);
        xsrc[j] = (const char*)(X + (size_t)(m0 + row) * ldx + c * 8);
        int n = n0 + row; n = n < N ? n : N - 1;
        wsrc[j] = (const char*)(W + (size_t)n * ldw + c * 8);
    }
    const unsigned lbase = (unsigned)(uintptr_t)lds;
    const unsigned wpiece = __builtin_amdgcn_readfirstlane(wave) * 4096u;
    f32x16 acc[2][2];
#pragma unroll
    for (int a = 0; a < 2; ++a)
#pragma unroll
        for (int b = 0; b < 2; ++b)
#pragma unroll
            for (int i = 0; i < 16; ++i) acc[a][b][i] = 0.f;
    const int nk = K >> 6;
#define GDMA(KT, BUF) do { const unsigned _d = lbase + (BUF) * 32768u + wpiece; const int _ko = (KT) * 128; \
        glds16(xsrc[0] + _ko, _d); glds16(xsrc[1] + _ko, _d + 1024u); glds16(xsrc[2] + _ko, _d + 2048u); glds16(xsrc[3] + _ko, _d + 3072u); \
        glds16(wsrc[0] + _ko, _d + 16384u); glds16(wsrc[1] + _ko, _d + 17408u); glds16(wsrc[2] + _ko, _d + 18432u); glds16(wsrc[3] + _ko, _d + 19456u); } while (0)
    GDMA(0, 0);
    asm volatile("s_waitcnt vmcnt(0)" ::: "memory");
    __syncthreads();
    for (int kt = 0; kt < nk; ++kt) {
        if (kt + 1 < nk) GDMA(kt + 1, (kt + 1) & 1);
        const char* xs = lds + (kt & 1) * 32768; const char* ws = xs + 16384;
#pragma unroll
        for (int ks = 0; ks < 4; ++ks) {
            bf16x8 xf[2], wf[2];
#pragma unroll
            for (int mt = 0; mt < 2; ++mt) { const int r = wm * 64 + mt * 32 + r32; xf[mt] = *(const bf16x8*)(xs + r * 128 + (((ks * 2 + hh) ^ ((r >> 1) & 7)) << 4)); }
#pragma unroll
            for (int nt = 0; nt < 2; ++nt) { const int r = wn * 64 + nt * 32 + r32; wf[nt] = *(const bf16x8*)(ws + r * 128 + (((ks * 2 + hh) ^ ((r >> 1) & 7)) << 4)); }
#pragma unroll
            for (int mt = 0; mt < 2; ++mt)
#pragma unroll
                for (int nt = 0; nt < 2; ++nt) acc[mt][nt] = __builtin_amdgcn_mfma_f32_32x32x16_bf16(xf[mt], wf[nt], acc[mt][nt], 0, 0, 0);
        }
        asm volatile("s_waitcnt vmcnt(0)" ::: "memory");
        __syncthreads();
    }
#undef GDMA
    epi(acc, m0 + wm * 64, n0 + wn * 64, r32, hh);
}

__device__ __forceinline__ void tile_map(int tile, int ntm, int ntn, int& mt, int& nt) {
    if ((ntn & 7) == 0) {
        const int G = gridDim.x;
        const int round = tile / G, bi = tile % G;
        const int x = bi & 7, j = bi >> 3;
        const int per = G >> 3;
        const int id = (round * 8 + x) * per + j;
        const int st = id >> 6, in = id & 63;
        const int snt = ntn >> 3;
        const int sm = st / snt, sn = st % snt;
        mt = sm * 8 + (in >> 3); nt = sn * 8 + (in & 7);
    } else { mt = tile / ntn; nt = tile % ntn; }
}

__device__ __forceinline__ void gemm_mainloop(const bf16_t* __restrict__ X, int ldx, const bf16_t* __restrict__ W, int ldw, int K, int m0, int n0, int N,
                                              char* lds, f32x16 (&acc)[2][4]) {
    const int tid = tid_opaque(), lane = tid & 63, wave = tid >> 6;
    const int wm = wave >> 1, wn = wave & 1;
    const int r32 = lane & 31, hh = lane >> 5;
    const char* xsrc[4]; const char* wsrc[4];
#pragma unroll
    for (int j = 0; j < 4; ++j) {
        const int row = (wave * 4 + j) * 8 + (lane >> 3), slot = lane & 7;
        const int c = slot ^ ((row >> 1) & 7);
        xsrc[j] = (const char*)(X + (size_t)(m0 + row) * ldx + c * 8);
        int n = n0 + row; n = n < N ? n : N - 1;
        wsrc[j] = (const char*)(W + (size_t)n * ldw + c * 8);
    }
    const unsigned lbase = (unsigned)(uintptr_t)lds;
    const unsigned wpiece = __builtin_amdgcn_readfirstlane(wave) * 4096u;
#pragma unroll
    for (int a = 0; a < 2; ++a)
#pragma unroll
        for (int b = 0; b < 4; ++b)
#pragma unroll
            for (int i = 0; i < 16; ++i) acc[a][b][i] = 0.f;
    const int nk = K >> 6;
#define GDMA(KT, BUF) do { const unsigned _d = lbase + (BUF) * 65536u + wpiece; const int _ko = (KT) * 128; \
        glds16(xsrc[0] + _ko, _d); glds16(xsrc[1] + _ko, _d + 1024u); glds16(xsrc[2] + _ko, _d + 2048u); glds16(xsrc[3] + _ko, _d + 3072u); \
        glds16(wsrc[0] + _ko, _d + 32768u); glds16(wsrc[1] + _ko, _d + 33792u); glds16(wsrc[2] + _ko, _d + 34816u); glds16(wsrc[3] + _ko, _d + 35840u); } while (0)
    GDMA(0, 0);
    asm volatile("s_waitcnt vmcnt(0)" ::: "memory");
    __syncthreads();
    for (int kt = 0; kt < nk; ++kt) {
        if (kt + 1 < nk) GDMA(kt + 1, (kt + 1) & 1);
        const char* xs = lds + (kt & 1) * 65536; const char* ws = xs + 32768;
#pragma unroll
        for (int ks = 0; ks < 4; ++ks) {
            bf16x8 xf[2], wf[4];
#pragma unroll
            for (int mt = 0; mt < 2; ++mt) { const int r = wm * 64 + mt * 32 + r32; xf[mt] = *(const bf16x8*)(xs + r * 128 + (((ks * 2 + hh) ^ ((r >> 1) & 7)) << 4)); }
#pragma unroll
            for (int nt = 0; nt < 4; ++nt) { const int r = wn * 128 + nt * 32 + r32; wf[nt] = *(const bf16x8*)(ws + r * 128 + (((ks * 2 + hh) ^ ((r >> 1) & 7)) << 4)); }
#pragma unroll
            for (int mt = 0; mt < 2; ++mt)
#pragma unroll
                for (int nt = 0; nt < 4; ++nt) acc[mt][nt] = __builtin_amdgcn_mfma_f32_32x32x16_bf16(xf[mt], wf[nt], acc[mt][nt], 0, 0, 0);
        }
        asm volatile("s_waitcnt vmcnt(0)" ::: "memory");
        __syncthreads();
    }
#undef GDMA
}

struct F8 { float4 a, b; };
__device__ __forceinline__ F8 f8_load(const float* p) { F8 r; r.a = *(const float4*)p; r.b = *(const float4*)(p + 4); return r; }
__device__ __forceinline__ F8 f8_shfl_xor(const F8& v, int m) {
    F8 r; r.a.x = __shfl_xor(v.a.x, m); r.a.y = __shfl_xor(v.a.y, m); r.a.z = __shfl_xor(v.a.z, m); r.a.w = __shfl_xor(v.a.w, m);
    r.b.x = __shfl_xor(v.b.x, m); r.b.y = __shfl_xor(v.b.y, m); r.b.z = __shfl_xor(v.b.z, m); r.b.w = __shfl_xor(v.b.w, m); return r;
}
__device__ __forceinline__ float f8_ssq(const F8& v) { return (v.a.x * v.a.x + v.a.y * v.a.y) + (v.a.z * v.a.z + v.a.w * v.a.w) + (v.b.x * v.b.x + v.b.y * v.b.y) + (v.b.z * v.b.z + v.b.w * v.b.w); }
__device__ __forceinline__ uint4 f8_rope_pack(const F8& v, const F8& pv, const F8& cs, const F8& sn, float sg, float sc) {
    return make_uint4(cvtpk((v.a.x * cs.a.x + sg * pv.a.x * sn.a.x) * sc, (v.a.y * cs.a.y + sg * pv.a.y * sn.a.y) * sc),
                      cvtpk((v.a.z * cs.a.z + sg * pv.a.z * sn.a.z) * sc, (v.a.w * cs.a.w + sg * pv.a.w * sn.a.w) * sc),
                      cvtpk((v.b.x * cs.b.x + sg * pv.b.x * sn.b.x) * sc, (v.b.y * cs.b.y + sg * pv.b.y * sn.b.y) * sc),
                      cvtpk((v.b.z * cs.b.z + sg * pv.b.z * sn.b.z) * sc, (v.b.w * cs.b.w + sg * pv.b.w * sn.b.w) * sc));
}
template <class Epi, int KGROUP>
__device__ __forceinline__ void gemm_tile_rows(const bf16_t* __restrict__ X, int ldx, const bf16_t* __restrict__ W, int ldw, int K, int m0, int n0, int N,
                                               char* lds, const Epi& epi) {
    const int tid = tid_opaque(), lane = tid & 63, wave = tid >> 6;
    const int wm = wave >> 1, wn = wave & 1;
    const int r32 = lane & 31, hh = lane >> 5;
    f32x16 acc[2][4];
    gemm_mainloop(X, ldx, W, ldw, K, m0, n0, N, lds, acc);
    bf16_t* ct = (bf16_t*)lds;
#pragma unroll
    for (int mt = 0; mt < 2; ++mt)
#pragma unroll
        for (int nt = 0; nt < 4; ++nt)
#pragma unroll
            for (int i = 0; i < 16; i += 2) {
                const unsigned w = cvtpk(acc[mt][nt][i], acc[mt][nt][i + 1]);
                bf16_t* d = ct + (wm * 64 + mt * 32 + crow(i, hh)) * QST + wn * 128 + nt * 32 + r32;
                d[0] = (bf16_t)(w & 0xffffu); d[QST] = (bf16_t)(w >> 16);
            }
    __syncthreads();
    epi.begin(ct, m0, n0, tid);
    {
        const int c = tid & 7, rsub = tid >> 3;
        const float *pa, *pb;
        epi.prep(m0 + rsub, n0, c, pa, pb);
        F8 ca = f8_load(pa), cb = f8_load(pb);
#pragma unroll 4
        for (int pass = 0; pass < 16; ++pass) {
            const int ch = pass & 3, row = (pass >> 2) * 64 + rsub;
#if NO_LOOKAHEAD
            epi.prep(m0 + row, n0 + ch * 64, c, pa, pb);
            ca = f8_load(pa); cb = f8_load(pb);
            F8 na = ca, nb = cb;
#else
            F8 na = ca, nb = cb;
            if (pass + 1 < 16) {
                epi.prep(m0 + ((pass + 1) >> 2) * 64 + rsub, n0 + ((pass + 1) & 3) * 64, c, pa, pb);
                na = f8_load(pa); nb = f8_load(pb);
            }
#endif
            const uint4 q = *(const uint4*)(ct + row * QST + ch * 64 + c * 8);
            F8 tv;
            tv.a = make_float4(__uint_as_float(q.x << 16), __uint_as_float(q.x & 0xffff0000u), __uint_as_float(q.y << 16), __uint_as_float(q.y & 0xffff0000u));
            tv.b = make_float4(__uint_as_float(q.z << 16), __uint_as_float(q.z & 0xffff0000u), __uint_as_float(q.w << 16), __uint_as_float(q.w & 0xffff0000u));
            epi.chunk(tv, *(const float*)(ct + row * QST + 256), m0 + row, n0 + ch * 64, c, ca, cb);
            ca = na; cb = nb;
        }
    }
    __syncthreads();
}

template <class Epi, int KGROUP>
__device__ __forceinline__ void gemm_phase_rows(const bf16_t* X, int ldx, const bf16_t* W, int ldw, int M, int N, int K, char* lds, const Epi& epi) {
    const int ntm = M >> 8, ntn = (N + 255) >> 8, nt_tot = ntm * ntn;
    for (int tile = blockIdx.x; tile < nt_tot; tile += gridDim.x) {
        int mt, nt;
        if ((gridDim.x & 63) == 0 && (ntn & 7) == 0 && (nt_tot % gridDim.x) == 0) tile_map(tile, ntm, ntn, mt, nt);
        else { mt = tile / ntn; nt = tile % ntn; }
        if (mt < ntm && nt < ntn) gemm_tile_rows<Epi, KGROUP>(X, ldx, W, ldw, K, mt * 256, nt * 256, N, lds, epi);
    }
}

__device__ __forceinline__ uint4 pack8(const float4& a, const float4& b) { return make_uint4(cvtpk(a.x, a.y), cvtpk(a.z, a.w), cvtpk(b.x, b.y), cvtpk(b.z, b.w)); }
__device__ __forceinline__ float sum8(float v) { v += __shfl_xor(v, 1); v += __shfl_xor(v, 2); v += __shfl_xor(v, 4); return v; }

struct RowsResidNorm {
    float* X; int ldx; bf16_t* XB; float* ssq;
    __device__ __forceinline__ void table(float*, int, int) const {}
    __device__ __forceinline__ void begin(bf16_t*, int, int, int) const {}
    __device__ __forceinline__ void prep(int m, int n, int c, const float*& pa, const float*& pb) const { pa = X + (size_t)m * ldx + n + 8 * c; pb = pa; }
    __device__ __forceinline__ void chunk(const F8& tv, float, int m, int n, int c, const F8& xa, const F8&) const {
        float* px = X + (size_t)m * ldx + n + 8 * c;
        float4 v0 = xa.a, v1 = xa.b;
        const float4 a0 = tv.a, a1 = tv.b;
        v0.x += a0.x; v0.y += a0.y; v0.z += a0.z; v0.w += a0.w; v1.x += a1.x; v1.y += a1.y; v1.z += a1.z; v1.w += a1.w;
        *(float4*)px = v0; *(float4*)(px + 4) = v1;
        *(uint4*)(XB + (size_t)m * ldx + n + 8 * c) = pack8(v0, v1);
        const float sq = sum8((v0.x * v0.x + v0.y * v0.y) + (v0.z * v0.z + v0.w * v0.w) + (v1.x * v1.x + v1.y * v1.y) + (v1.z * v1.z + v1.w * v1.w));
        if (c == 0) ssq[((size_t)(n >> 8) * T_TOK + m) * 4 + ((n >> 6) & 3)] = sq;
    }
};
#define QKV_MIX(mi) ((size_t)(mi) * 512 * T_TOK)
#define QKV_K (256 * (size_t)T_TOK)
#define QKV_V (384 * (size_t)T_TOK)
#define QKV_KD (1920 * (size_t)T_TOK)
struct RowsPostZ {
    bf16_t* qkv; const float* tb; const float* g_qn; const float* g_kn; bf16_t* lat; float* ssqd; bf16_t* kD;
    __device__ __forceinline__ void table(float*, int, int) const {}
    __device__ __forceinline__ void begin(bf16_t*, int, int, int) const {}
    __device__ __forceinline__ void prep(int m, int n, int c, const float*& pa, const float*& pb) const {
        const int qc = n >> 6, s = m % SEQ;
        pa = tb; pb = tb;
        if (qc < 6 || (qc >= 16 && qc < 22)) { pa = tb + s * 32 + 8 * (c & 3); pb = pa + 131072; }
        else if (qc >= 8 && qc < 14) { pa = tb + ((c < 4) ? 393216 + (s >> 6) * 16 : 395264 + (s & 63) * 16) + 8 * (c & 1); pb = pa + 1024; }
        else if (qc == 30) { pa = tb + 262144 + s * 16 + 8 * (c & 1); pb = pa + 65536; }
    }
    __device__ __forceinline__ void chunk(const F8& tv, float, int m, int n, int c, const F8& cs, const F8& sn) const {
        const int qc = n >> 6;
        const int b = m / SEQ, s = m % SEQ;
        F8 v = tv;
        const float scA = 0.125f * LOG2E;
        if (qc < 6 || (qc >= 16 && qc < 22)) {
            const int mi = qc >= 16 ? 2 : 0; const int ql = qc - 8 * mi;
            const F8 pv = f8_shfl_xor(v, 4);
            const size_t off = QKV_MIX(mi) + (ql < 4 ? ((size_t)(b * 4 + ql) * SEQ + s) * 64 : QKV_K + ((size_t)(b * 2 + (ql - 4)) * SEQ + s) * 64);
            *(uint4*)(qkv + off + 8 * c) = f8_rope_pack(v, pv, cs, sn, (c < 4) ? -1.f : 1.f, (ql < 4) ? scA : 1.f);
        } else if (qc == 6 || qc == 7 || qc == 14 || qc == 15 || qc == 22 || qc == 23) {
            *(uint4*)(qkv + QKV_MIX(qc >> 3) + QKV_V + ((size_t)(b * 2 + (qc & 1)) * SEQ + s) * 64 + 8 * c) = pack8(v.a, v.b);
        } else if (qc >= 8 && qc < 14) {
            const bool isq = qc < 12; const int h = isq ? qc - 8 : qc - 12;
            const float r = rsqrtf(sum8(f8_ssq(v)) * (1.f / 64.f) + 1e-6f);
            const F8 gq = f8_load(g_qn + 8 * c), gk = f8_load(g_kn + 8 * c);
            v.a.x *= r * (isq ? gq.a.x : gk.a.x); v.a.y *= r * (isq ? gq.a.y : gk.a.y); v.a.z *= r * (isq ? gq.a.z : gk.a.z); v.a.w *= r * (isq ? gq.a.w : gk.a.w);
            v.b.x *= r * (isq ? gq.b.x : gk.b.x); v.b.y *= r * (isq ? gq.b.y : gk.b.y); v.b.z *= r * (isq ? gq.b.z : gk.b.z); v.b.w *= r * (isq ? gq.b.w : gk.b.w);
            const F8 pv = f8_shfl_xor(v, 2);
            const size_t off = QKV_MIX(1) + (isq ? ((size_t)(b * 4 + h) * SEQ + s) * 64 : QKV_K + ((size_t)(b * 2 + h) * SEQ + s) * 64);
            *(uint4*)(qkv + off + 8 * c) = f8_rope_pack(v, pv, cs, sn, (c & 2) ? 1.f : -1.f, isq ? scA : 1.f);
        } else if (qc >= 24 && qc < 30) {
            const float ss = sum8(f8_ssq(v));
            const size_t off = qc < 28 ? (size_t)m * 256 + (qc - 24) * 64 : (size_t)T_TOK * 256 + (size_t)m * 128 + (qc - 28) * 64;
            *(uint4*)(lat + off + 8 * c) = pack8(v.a, v.b);
            if (c == 0) ssqd[(size_t)(qc - 24) * T_TOK + m] = ss;
        } else if (qc == 30) {
            const F8 pv = f8_shfl_xor(v, 2);
            if (c < 4) {
                const uint4 w = f8_rope_pack(v, pv, cs, sn, (c & 2) ? 1.f : -1.f, 1.f);
#pragma unroll
                for (int h = 0; h < 4; ++h) *(uint4*)(kD + ((size_t)(b * 4 + h) * SEQ + s) * 96 + 64 + 8 * c) = w;
            }
        }
    }
};
struct RowsPostQ {
    bf16_t* qD; const float* tb; const float* ssq;
    __device__ __forceinline__ void table(float*, int, int) const {}
    __device__ __forceinline__ void begin(bf16_t* ct, int m0, int, int tid) const {
        if (tid < 256) {
            const float tot = (ssq[m0 + tid] + ssq[(size_t)T_TOK + m0 + tid]) + (ssq[(size_t)2 * T_TOK + m0 + tid] + ssq[(size_t)3 * T_TOK + m0 + tid]);
            *(float*)(ct + tid * QST + 256) = rsqrtf(tot * (1.f / 256.f) + 1e-6f) * (0.10206207261596575f * LOG2E);
        }
        __syncthreads();
    }
    __device__ __forceinline__ void prep(int m, int n, int c, const float*& pa, const float*& pb) const {
        pa = tb; pb = tb;
        if (n >= 256 && n < 384) { pa = tb + 262144 + (m % SEQ) * 16 + 8 * (c & 1); pb = pa + 65536; }
    }
    __device__ __forceinline__ void chunk(const F8& tv, float r, int m, int n, int c, const F8& cs, const F8& sn) const {
        if (n >= 384) return;
        const int qc = n >> 6, b = m / SEQ, s = m % SEQ;
        F8 v = tv;
        v.a.x *= r; v.a.y *= r; v.a.z *= r; v.a.w *= r; v.b.x *= r; v.b.y *= r; v.b.z *= r; v.b.w *= r;
        if (qc < 4) {
            *(uint4*)(qD + ((size_t)(b * 4 + qc) * SEQ + s) * 128 + 8 * c) = pack8(v.a, v.b);
        } else {
            const F8 pv = f8_shfl_xor(v, 2);
            const int h = (qc - 4) * 2 + (c >> 2);
            *(uint4*)(qD + ((size_t)(b * 4 + h) * SEQ + s) * 128 + 64 + 8 * (c & 3)) = f8_rope_pack(v, pv, cs, sn, (c & 2) ? 1.f : -1.f, 1.f);
        }
    }
};
struct RowsPostKV {
    bf16_t* kD; bf16_t* vD; const float* ssq;
    __device__ __forceinline__ void table(float*, int, int) const {}
    __device__ __forceinline__ void begin(bf16_t* ct, int m0, int, int tid) const {
        if (tid < 256) *(float*)(ct + tid * QST + 256) = rsqrtf((ssq[m0 + tid] + ssq[(size_t)T_TOK + m0 + tid]) * (1.f / 128.f) + 1e-6f);
        __syncthreads();
    }
    __device__ __forceinline__ void prep(int, int, int, const float*& pa, const float*& pb) const { pa = ssq; pb = ssq; }
    __device__ __forceinline__ void chunk(const F8& tv, float r, int m, int n, int c, const F8&, const F8&) const {
        const int qc = n >> 6, h = qc >> 1, b = m / SEQ, s = m % SEQ;
        F8 v = tv;
        v.a.x *= r; v.a.y *= r; v.a.z *= r; v.a.w *= r; v.b.x *= r; v.b.y *= r; v.b.z *= r; v.b.w *= r;
        const size_t hb = (size_t)(b * 4 + h) * SEQ + s;
        const size_t off = (qc & 1) ? hb * 64 : hb * 96;
        bf16_t* base = (bf16_t*)((qc & 1) ? (size_t)vD : (size_t)kD);
        *(uint4*)(base + off + 8 * c) = pack8(v.a, v.b);
    }
};

template <class Epi>
__device__ __forceinline__ void gemm_phase(const bf16_t* X, int ldx, const bf16_t* W, int ldw, int M, int N, int K, char* lds, const Epi& epi) {
    const int ntm = M >> 7, ntn = (N + 127) >> 7, nt_tot = ntm * ntn;
    for (int tile = blockIdx.x; tile < nt_tot; tile += gridDim.x) {
        int mt, nt;
        if ((gridDim.x & 7) == 0 && (gridDim.x >> 3) * 8 == gridDim.x && ((gridDim.x >> 3) & 63) == 0) tile_map(tile, ntm, ntn, mt, nt);
        else { mt = tile / ntn; nt = tile % ntn; }
        if (mt < ntm && nt < ntn) gemm_tile(X, ldx, W, ldw, K, mt * 128, nt * 128, N, lds, epi);
    }
}

template <int OFF> __device__ __forceinline__ s16x4 tr_read(int vb) {
    s16x4 r; asm volatile("ds_read_b64_tr_b16 %0, %1 offset:%2" : "=&v"(r) : "v"(vb), "i"(OFF) : "memory"); return r;
}
#define VS_BYTES 192

template <int KT2>
__device__ __forceinline__ void pv_sub(f32x16 (&o)[2], const f32x16& p, int vbase) {
    bf16x8 pf[2];
#pragma unroll
    for (int s2 = 0; s2 < 2; ++s2) {
        unsigned a = cvtpk(p[8 * s2 + 0], p[8 * s2 + 1]), b = cvtpk(p[8 * s2 + 2], p[8 * s2 + 3]);
        unsigned c = cvtpk(p[8 * s2 + 4], p[8 * s2 + 5]), d = cvtpk(p[8 * s2 + 6], p[8 * s2 + 7]);
        uint4 w = make_uint4(a, b, c, d);
        pf[s2] = *(bf16x8*)&w;
    }
    {
        s16x4 l00 = tr_read<(KT2 * 32 + 0) * VS_BYTES + 0>(vbase), h00 = tr_read<(KT2 * 32 + 8) * VS_BYTES + 0>(vbase);
        s16x4 l01 = tr_read<(KT2 * 32 + 0) * VS_BYTES + 64>(vbase), h01 = tr_read<(KT2 * 32 + 8) * VS_BYTES + 64>(vbase);
        s16x4 l10 = tr_read<(KT2 * 32 + 16) * VS_BYTES + 0>(vbase), h10 = tr_read<(KT2 * 32 + 24) * VS_BYTES + 0>(vbase);
        s16x4 l11 = tr_read<(KT2 * 32 + 16) * VS_BYTES + 64>(vbase), h11 = tr_read<(KT2 * 32 + 24) * VS_BYTES + 64>(vbase);
        asm volatile("s_waitcnt lgkmcnt(0)" ::: "memory");
        __builtin_amdgcn_sched_barrier(0);
#define PKV(L, H) (bf16x8){L[0], L[1], L[2], L[3], H[0], H[1], H[2], H[3]}
        o[0] = __builtin_amdgcn_mfma_f32_32x32x16_bf16(PKV(l00, h00), pf[0], o[0], 0, 0, 0);
        o[1] = __builtin_amdgcn_mfma_f32_32x32x16_bf16(PKV(l01, h01), pf[0], o[1], 0, 0, 0);
        o[0] = __builtin_amdgcn_mfma_f32_32x32x16_bf16(PKV(l10, h10), pf[1], o[0], 0, 0, 0);
        o[1] = __builtin_amdgcn_mfma_f32_32x32x16_bf16(PKV(l11, h11), pf[1], o[1], 0, 0, 0);
#undef PKV
    }
}


#define PV_LOAD(KT2, VB, F) \
    const s16x4 F##0 = tr_read<((KT2) * 32 + 0) * VS_BYTES + 0>(VB), F##1 = tr_read<((KT2) * 32 + 8) * VS_BYTES + 0>(VB), \
                F##2 = tr_read<((KT2) * 32 + 0) * VS_BYTES + 64>(VB), F##3 = tr_read<((KT2) * 32 + 8) * VS_BYTES + 64>(VB), \
                F##4 = tr_read<((KT2) * 32 + 16) * VS_BYTES + 0>(VB), F##5 = tr_read<((KT2) * 32 + 24) * VS_BYTES + 0>(VB), \
                F##6 = tr_read<((KT2) * 32 + 16) * VS_BYTES + 64>(VB), F##7 = tr_read<((KT2) * 32 + 24) * VS_BYTES + 64>(VB)
#define PKV2(L, H) (bf16x8){L[0], L[1], L[2], L[3], H[0], H[1], H[2], H[3]}
#define PV_MMA(O, P, F) do { bf16x8 _pf0, _pf1; \
        { uint4 _w = make_uint4(cvtpk(P[0], P[1]), cvtpk(P[2], P[3]), cvtpk(P[4], P[5]), cvtpk(P[6], P[7])); _pf0 = *(bf16x8*)&_w; } \
        { uint4 _w = make_uint4(cvtpk(P[8], P[9]), cvtpk(P[10], P[11]), cvtpk(P[12], P[13]), cvtpk(P[14], P[15])); _pf1 = *(bf16x8*)&_w; } \
        O[0] = __builtin_amdgcn_mfma_f32_32x32x16_bf16(PKV2(F##0, F##1), _pf0, O[0], 0, 0, 0); \
        O[1] = __builtin_amdgcn_mfma_f32_32x32x16_bf16(PKV2(F##2, F##3), _pf0, O[1], 0, 0, 0); \
        O[0] = __builtin_amdgcn_mfma_f32_32x32x16_bf16(PKV2(F##4, F##5), _pf1, O[0], 0, 0, 0); \
        O[1] = __builtin_amdgcn_mfma_f32_32x32x16_bf16(PKV2(F##6, F##7), _pf1, O[1], 0, 0, 0); } while (0)

template <int DK, int G, bool WINDOW>
__device__ __forceinline__ void attn_item(const bf16_t* __restrict__ Q, const bf16_t* __restrict__ K, const bf16_t* __restrict__ V, const float* __restrict__ sink,
                                          bf16_t* __restrict__ O, int ocol, int H, int KV, int item, char* lds, int qs = DK) {
    constexpr int KS = DK * 2 + 16;
    constexpr int KCH = DK / 8;
    constexpr int KLD = (128 * KCH) / 512;
    constexpr int QB = 256 / G;
    constexpr int NCH = SEQ / QB;
    constexpr int KBUF = 128 * KS, VBUF = 128 * VS_BYTES;
    const int tid = tid_opaque(), lane = tid & 63, wave = tid >> 6;
    const int r32 = lane & 31, hh = lane >> 5;
    const int chunk = item % NCH, kvh = (item / NCH) % KV, b = item / (NCH * KV);
    const int g = (G == 2) ? (wave >> 2) : 0;
    const int qoff = (G == 2) ? (wave & 3) * 32 : wave * 32;
    const int head = kvh * G + g;
    const int q0 = chunk * QB;
    const int qpos = q0 + qoff + r32;
    bf16x8 qf[DK / 16];
    {
        const bf16_t* qp = Q + ((size_t)(b * H + head) * SEQ + qpos) * qs + hh * 8;
#pragma unroll
        for (int ks = 0; ks < DK / 16; ++ks) qf[ks] = *(const bf16x8*)(qp + ks * 16);
    }
    int kt_lo = 0, kt_hi = SEQ / 128;
    if (WINDOW) { kt_lo = q0 / 128 - 1; if (kt_lo < 0) kt_lo = 0; kt_hi = (q0 + QB) / 128 + 1; if (kt_hi > SEQ / 128) kt_hi = SEQ / 128; }
    const char* Kg = (const char*)(K + (size_t)(b * KV + kvh) * SEQ * DK);
    const char* Vg = (const char*)(V + (size_t)(b * KV + kvh) * SEQ * 64);
    uint4 kr0, kr1, kr2 = make_uint4(0, 0, 0, 0), vr0, vr1;
    const int koff0 = (tid / KCH) * KS + (tid % KCH) * 16;
    const int koff1 = ((tid + 512) / KCH) * KS + ((tid + 512) % KCH) * 16;
    const int koff2 = ((tid + 1024) / KCH) * KS + ((tid + 1024) % KCH) * 16;
    const int voff0 = (tid >> 3) * VS_BYTES + (tid & 7) * 16;
    const int voff1 = ((tid + 512) >> 3) * VS_BYTES + (tid & 7) * 16;
    f32x16 o[2];
#pragma unroll
    for (int d = 0; d < 2; ++d)
#pragma unroll
        for (int i = 0; i < 16; ++i) o[d][i] = 0.f;
    float m = -1e30f, l = 0.f;
    if (WINDOW) { m = sink[head] * LOG2E; l = (hh == 0) ? 1.f : 0.f; }
    const int gg = lane >> 4, li = lane & 15;
    const int vlane = (4 * (gg >> 1) + (li >> 2)) * VS_BYTES + (16 * (gg & 1) + 4 * (li & 3)) * 2;
    char* Kl = lds; char* Vl = lds + 2 * KBUF;
#define AGLOAD(KT) do { const char* _kg = Kg + (size_t)(KT) * 128 * DK * 2; const char* _vg = Vg + (size_t)(KT) * 128 * 128; \
        kr0 = *(const uint4*)(_kg + tid * 16); kr1 = *(const uint4*)(_kg + (tid + 512) * 16); if (KLD > 2) kr2 = *(const uint4*)(_kg + (tid + 1024) * 16); \
        vr0 = *(const uint4*)(_vg + tid * 16); vr1 = *(const uint4*)(_vg + (tid + 512) * 16); } while (0)
#define ASTORE(KB, VB) do { char* _kd = (KB); char* _vd = (VB); *(uint4*)(_kd + koff0) = kr0; *(uint4*)(_kd + koff1) = kr1; if (KLD > 2) *(uint4*)(_kd + koff2) = kr2; \
        *(uint4*)(_vd + voff0) = vr0; *(uint4*)(_vd + voff1) = vr1; } while (0)
    AGLOAD(kt_lo);
    ASTORE(Kl, Vl);
    { const int k1 = kt_lo + 1 < kt_hi ? kt_lo + 1 : kt_lo; AGLOAD(k1); }
    __syncthreads();
    for (int kt = kt_lo; kt < kt_hi; ++kt) {
        const int cur = (kt - kt_lo) & 1;
        ASTORE(Kl + (cur ^ 1) * KBUF, Vl + (cur ^ 1) * VBUF);
        { const int ktn = kt + 2 < kt_hi ? kt + 2 : kt_hi - 1; AGLOAD(ktn); }
        __builtin_amdgcn_sched_barrier(0);
#pragma unroll
        for (int sub = 0; sub < 2; ++sub) {
            const char* kb = Kl + cur * KBUF + sub * 64 * KS;
            const float mi = (m < -1e29f) ? 0.f : m;
            f32x16 s0, s1;
#pragma unroll
            for (int i = 0; i < 16; ++i) { s0[i] = -mi; s1[i] = -mi; }
#pragma unroll
            for (int ks = 0; ks < DK / 16; ++ks) {
                bf16x8 k0 = *(const bf16x8*)(kb + r32 * KS + (ks * 2 + hh) * 16);
                bf16x8 k1 = *(const bf16x8*)(kb + (32 + r32) * KS + (ks * 2 + hh) * 16);
                s0 = __builtin_amdgcn_mfma_f32_32x32x16_bf16(k0, qf[ks], s0, 0, 0, 0);
                s1 = __builtin_amdgcn_mfma_f32_32x32x16_bf16(k1, qf[ks], s1, 0, 0, 0);
            }
            if (WINDOW) {
                const int kb0 = kt * 128 + sub * 64 + 4 * hh - qpos;
#pragma unroll
                for (int i = 0; i < 16; ++i) {
                    const int d0 = kb0 + (i & 3) + 8 * (i >> 2), d1 = d0 + 32;
                    s0[i] = (d0 > 128 || d0 < -128) ? -1e30f : s0[i];
                    s1[i] = (d1 > 128 || d1 < -128) ? -1e30f : s1[i];
                }
            }
            const int vbase = (int)(size_t)(Vl + cur * VBUF - lds) + sub * 64 * VS_BYTES + vlane;
            PV_LOAD(0, vbase, vfa);
            PV_LOAD(1, vbase, vfb);
            __builtin_amdgcn_sched_barrier(0);
            float tmax = s0[0];
#pragma unroll
            for (int i = 1; i < 16; ++i) tmax = fmaxf(tmax, s0[i]);
#pragma unroll
            for (int i = 0; i < 16; ++i) tmax = fmaxf(tmax, s1[i]);
            tmax = xhalf_max(tmax);
            float ps = 0.f;
            if (__all(m > -1e29f && tmax <= 8.f)) {
#pragma unroll
                for (int i = 0; i < 16; ++i) { s0[i] = __builtin_amdgcn_exp2f(s0[i]); ps += s0[i]; }
#pragma unroll
                for (int i = 0; i < 16; ++i) { s1[i] = __builtin_amdgcn_exp2f(s1[i]); ps += s1[i]; }
                l += ps;
            } else {
                const float mn = fmaxf(m, mi + tmax);
                const float d = mn - mi;
                const float alpha = __builtin_amdgcn_exp2f(m - mn);
                m = mn;
#pragma unroll
                for (int i = 0; i < 16; ++i) { s0[i] = __builtin_amdgcn_exp2f(s0[i] - d); ps += s0[i]; }
#pragma unroll
                for (int i = 0; i < 16; ++i) { s1[i] = __builtin_amdgcn_exp2f(s1[i] - d); ps += s1[i]; }
                l = l * alpha + ps;
#pragma unroll
                for (int dd = 0; dd < 2; ++dd)
#pragma unroll
                    for (int i = 0; i < 16; ++i) o[dd][i] *= alpha;
            }
            asm volatile("s_waitcnt lgkmcnt(0)" ::: "memory");
            __builtin_amdgcn_sched_barrier(0);
            PV_MMA(o, s0, vfa);
            PV_MMA(o, s1, vfb);
        }
        __syncthreads();
    }
#undef AGLOAD
#undef ASTORE
    l = xhalf_sum(l);
    const float inv = 1.f / l;
    bf16_t* orow = O + (size_t)(b * SEQ + qpos) * DM + ocol + head * 64;
#pragma unroll
    for (int d = 0; d < 2; ++d)
#pragma unroll
        for (int gq = 0; gq < 4; ++gq) {
            uint2 w;
            w.x = cvtpk(o[d][gq * 4 + 0] * inv, o[d][gq * 4 + 1] * inv);
            w.y = cvtpk(o[d][gq * 4 + 2] * inv, o[d][gq * 4 + 3] * inv);
            *(uint2*)(orow + d * 32 + 8 * gq + 4 * hh) = w;
        }
}

__device__ __forceinline__ void dil_wave_item(const bf16_t* __restrict__ Q, const bf16_t* __restrict__ K, const bf16_t* __restrict__ V,
                                              bf16_t* __restrict__ O, int witem, char* wlds, int lds_off) {
    const int lane = tid_opaque() & 63, r32 = lane & 31, hh = lane >> 5;
    const int c = witem & 15, chunk = (witem >> 4) & 15, kvh = (witem >> 8) & 1, b = witem >> 9;
    const int t0 = chunk * 256;
    const int mq = r32 & 15, g = r32 >> 4;
    const int qpos = t0 + 16 * mq + c, head = kvh * 2 + g;
    bf16x8 qf[4];
    {
        const bf16_t* qp = Q + ((size_t)(b * 4 + head) * SEQ + qpos) * 64 + hh * 8;
#pragma unroll
        for (int ks = 0; ks < 4; ++ks) qf[ks] = *(const bf16x8*)(qp + ks * 16);
    }
    const bf16_t* Kg = K + (size_t)(b * 2 + kvh) * SEQ * 64;
    const bf16_t* Vg = V + (size_t)(b * 2 + kvh) * SEQ * 64;
    f32x16 o[2];
#pragma unroll
    for (int d = 0; d < 2; ++d)
#pragma unroll
        for (int i = 0; i < 16; ++i) o[d][i] = 0.f;
    float m = -1e30f, l = 0.f;
    const int gg = lane >> 4, li = lane & 15;
    const int vlane = lds_off + (4 * (gg >> 1) + (li >> 2)) * VS_BYTES + (16 * (gg & 1) + 4 * (li & 3)) * 2;
#define DIL_PARAMS(IT, SH, CC, IDX0, LIM) const int SH = (IT) < 12 ? 0 : ((IT) < 18 ? 2 : 4); const int CC = c & ((1 << SH) - 1); \
        const int IDX0 = (t0 >> SH) - 64 + 32 * ((IT) < 12 ? (IT) : ((IT) < 18 ? (IT) - 12 : (IT) - 18)); const int LIM = SEQ >> SH
#define DIL_LOAD(KF, VR, SH, CC, IDX0, LIM) do { \
        { int _i = IDX0 + r32; _i = _i < 0 ? 0 : (_i >= LIM ? LIM - 1 : _i); const bf16_t* _kp = Kg + (size_t)((_i << SH) + CC) * 64 + hh * 8; \
          KF##0 = *(const bf16x8*)(_kp); KF##1 = *(const bf16x8*)(_kp + 16); KF##2 = *(const bf16x8*)(_kp + 32); KF##3 = *(const bf16x8*)(_kp + 48); } \
        { int _i = IDX0 + (lane >> 3); _i = _i < 0 ? 0 : (_i >= LIM ? LIM - 1 : _i); VR##0 = *(const uint4*)(Vg + (size_t)((_i << SH) + CC) * 64 + (lane & 7) * 8); } \
        { int _i = IDX0 + 8 + (lane >> 3); _i = _i < 0 ? 0 : (_i >= LIM ? LIM - 1 : _i); VR##1 = *(const uint4*)(Vg + (size_t)((_i << SH) + CC) * 64 + (lane & 7) * 8); } \
        { int _i = IDX0 + 16 + (lane >> 3); _i = _i < 0 ? 0 : (_i >= LIM ? LIM - 1 : _i); VR##2 = *(const uint4*)(Vg + (size_t)((_i << SH) + CC) * 64 + (lane & 7) * 8); } \
        { int _i = IDX0 + 24 + (lane >> 3); _i = _i < 0 ? 0 : (_i >= LIM ? LIM - 1 : _i); VR##3 = *(const uint4*)(Vg + (size_t)((_i << SH) + CC) * 64 + (lane & 7) * 8); } } while (0)
    bf16x8 ka0, ka1, ka2, ka3, kb0, kb1, kb2, kb3;
    uint4 va0, va1, va2, va3, vb0, vb1, vb2, vb3;
    { DIL_PARAMS(0, sh0, cc0, ix0, lm0); DIL_LOAD(ka, va, sh0, cc0, ix0, lm0); }
#pragma unroll 1
    for (int it = 0; it < 23; ++it) {
        DIL_PARAMS(it, sh, cc, idx0, lim);
        {
            const int itn = it + 1 < 23 ? it + 1 : 22;
            DIL_PARAMS(itn, shn, ccn, ixn, lmn);
            DIL_LOAD(kb, vb, shn, ccn, ixn, lmn);
        }
        __builtin_amdgcn_sched_barrier(0);
        *(uint4*)(wlds + ((lane >> 3)) * VS_BYTES + (lane & 7) * 16) = va0;
        *(uint4*)(wlds + ((lane >> 3) + 8) * VS_BYTES + (lane & 7) * 16) = va1;
        *(uint4*)(wlds + ((lane >> 3) + 16) * VS_BYTES + (lane & 7) * 16) = va2;
        *(uint4*)(wlds + ((lane >> 3) + 24) * VS_BYTES + (lane & 7) * 16) = va3;
        f32x16 s;
#pragma unroll
        for (int i = 0; i < 16; ++i) s[i] = 0.f;
        s = __builtin_amdgcn_mfma_f32_32x32x16_bf16(ka0, qf[0], s, 0, 0, 0);
        s = __builtin_amdgcn_mfma_f32_32x32x16_bf16(ka1, qf[1], s, 0, 0, 0);
        s = __builtin_amdgcn_mfma_f32_32x32x16_bf16(ka2, qf[2], s, 0, 0, 0);
        s = __builtin_amdgcn_mfma_f32_32x32x16_bf16(ka3, qf[3], s, 0, 0, 0);

        const int qidx = qpos >> sh;
        const int base = idx0 + 4 * hh;
#pragma unroll
        for (int i = 0; i < 16; ++i) {
            const int idx = base + (i & 3) + 8 * (i >> 2);
            const int d = idx - qidx;
            s[i] = (d > 64 || d < -64 || idx < 0 || idx >= lim) ? -1e30f : s[i];
        }
        float tmax = s[0];
#pragma unroll
        for (int i = 1; i < 16; ++i) tmax = fmaxf(tmax, s[i]);
        tmax = fmaxf(tmax, xhalf(tmax));
        const float mn = fmaxf(fmaxf(m, tmax), -1e20f);
        const float alpha = __builtin_amdgcn_exp2f(m - mn);
        m = mn;
        float ps = 0.f;
#pragma unroll
        for (int i = 0; i < 16; ++i) { s[i] = __builtin_amdgcn_exp2f(s[i] - mn); ps += s[i]; }
        l = l * alpha + ps;
#pragma unroll
        for (int d = 0; d < 2; ++d)
#pragma unroll
            for (int i = 0; i < 16; ++i) o[d][i] *= alpha;
        pv_sub<0>(o, s, vlane);
        ka0 = kb0; ka1 = kb1; ka2 = kb2; ka3 = kb3; va0 = vb0; va1 = vb1; va2 = vb2; va3 = vb3;
    }
#undef DIL_PARAMS
#undef DIL_LOAD
    l += xhalf(l);
    const float inv = 1.f / l;
    bf16_t* orow = O + (size_t)(b * SEQ + qpos) * DM + 512 + head * 64;
#pragma unroll
    for (int d = 0; d < 2; ++d)
#pragma unroll
        for (int gq = 0; gq < 4; ++gq) {
            uint2 w;
            w.x = cvtpk(o[d][gq * 4 + 0] * inv, o[d][gq * 4 + 1] * inv);
            w.y = cvtpk(o[d][gq * 4 + 2] * inv, o[d][gq * 4 + 3] * inv);
            *(uint2*)(orow + d * 32 + 8 * gq + 4 * hh) = w;
        }
}

__device__ __forceinline__ int f2key(float f) { int b = __float_as_int(f); return b ^ ((b >> 31) & 0x7fffffff); }
__device__ __forceinline__ float key2f(int k) { return __int_as_float(k ^ ((k >> 31) & 0x7fffffff)); }

template <int N>
__device__ __forceinline__ void bitonic_sort_desc(int (&a)[N]) {
#pragma unroll
    for (int k = 2; k <= N; k <<= 1) {
#pragma unroll
        for (int j = k >> 1; j > 0; j >>= 1) {
#pragma unroll
            for (int i = 0; i < N; ++i) {
                const int l2 = i ^ j;
                if (l2 > i) {
                    const bool up = ((i & k) == 0);
                    const int hi = max(a[i], a[l2]), lo = min(a[i], a[l2]);
                    a[i] = up ? hi : lo; a[l2] = up ? lo : hi;
                }
            }
        }
    }
}
__device__ __forceinline__ void merge_top16(int (&a)[16], const int (&b)[16]) {
#pragma unroll
    for (int i = 0; i < 16; ++i) a[i] = max(a[i], b[15 - i]);
#pragma unroll
    for (int j = 8; j > 0; j >>= 1) {
#pragma unroll
        for (int i = 0; i < 16; ++i) {
            const int l2 = i ^ j;
            if (l2 > i) { const int hi = max(a[i], a[l2]), lo = min(a[i], a[l2]); a[i] = hi; a[l2] = lo; }
        }
    }
}
__device__ __forceinline__ void top16_of_64(int (&g0)[16], int (&g1)[16], int (&g2)[16], int (&g3)[16]) {
    bitonic_sort_desc<16>(g0); bitonic_sort_desc<16>(g1); bitonic_sort_desc<16>(g2); bitonic_sort_desc<16>(g3);
    merge_top16(g0, g1); merge_top16(g2, g3); merge_top16(g0, g2);
}

__device__ __forceinline__ void topk_core(const bf16_t* q0, const bf16_t* __restrict__ subk_h, float rscale, int* eo, float* go, char* wlds) {
    const int lane = tid_opaque() & 63, r32 = lane & 31, hh = lane >> 5;
    int top[2][16];
#pragma unroll
    for (int c = 0; c < 2; ++c) {
        bf16x8 qf[8];
        const bf16_t* qrow = q0 + c * 128;
#pragma unroll
        for (int ks = 0; ks < 8; ++ks) qf[ks] = *(const bf16x8*)(qrow + ks * 16);
        const bf16_t* kb = subk_h + ((size_t)c * 128 + r32) * 128 + hh * 8;
        int grp[4][16];
        bf16x8 kfa[8], kfb[8];
#pragma unroll
        for (int ks = 0; ks < 8; ++ks) kfa[ks] = *(const bf16x8*)(kb + ks * 16);
#pragma unroll
        for (int kt = 0; kt < 4; ++kt) {
            if (kt < 3) {
#pragma unroll
                for (int ks = 0; ks < 8; ++ks) kfb[ks] = *(const bf16x8*)(kb + (size_t)(kt + 1) * 32 * 128 + ks * 16);
            }
            __builtin_amdgcn_sched_barrier(0);
            f32x16 s;
#pragma unroll
            for (int i = 0; i < 16; ++i) s[i] = 0.f;
#pragma unroll
            for (int ks = 0; ks < 8; ++ks) s = __builtin_amdgcn_mfma_f32_32x32x16_bf16(kfa[ks], qf[ks], s, 0, 0, 0);
#pragma unroll
            for (int i = 0; i < 16; ++i) grp[kt][i] = (f2key(s[i]) & ~127) | (kt * 32 + crow(i, hh));
#pragma unroll
            for (int ks = 0; ks < 8; ++ks) kfa[ks] = kfb[ks];
        }
        top16_of_64(grp[0], grp[1], grp[2], grp[3]);
        int oth[16];
#pragma unroll
        for (int i = 0; i < 16; ++i) oth[i] = __shfl_xor(grp[0][i], 32);
        merge_top16(grp[0], oth);
#pragma unroll
        for (int i = 0; i < 16; ++i) top[c][i] = grp[0][i];
    }
    {
        unsigned* my = (unsigned*)(wlds + lane * 36);
#pragma unroll
        for (int c = 0; c < 2; ++c)
#pragma unroll
            for (int w4 = 0; w4 < 4; ++w4) {
                unsigned v = (top[c][w4 * 4] & 127) | ((top[c][w4 * 4 + 1] & 127) << 8) | ((top[c][w4 * 4 + 2] & 127) << 16) | ((top[c][w4 * 4 + 3] & 127) << 24);
                my[c * 4 + w4] = v;
            }
    }
    float v1[16], v2[16];
#pragma unroll
    for (int i = 0; i < 16; ++i) { v1[i] = key2f(top[0][i] & ~127); v2[i] = key2f(top[1][i] & ~127); }
    int cg[4][16];
    {
        int n = 0;
#pragma unroll
        for (int i = 0; i < 16; ++i)
#pragma unroll
            for (int j = 0; j < 16; ++j)
                if ((i + 1) * (j + 1) <= 16) { cg[n >> 4][n & 15] = (f2key(v1[i] + v2[j]) & ~255) | (i * 16 + j); ++n; }
#pragma unroll
        for (int q = 50; q < 64; ++q) cg[q >> 4][q & 15] = (int)0x80000000;
    }
    top16_of_64(cg[0], cg[1], cg[2], cg[3]);
    float bv[16];
#pragma unroll
    for (int i = 0; i < 16; ++i) bv[i] = key2f(cg[0][i] & ~255) * rscale;
    float sm = 0.f;
    const float bmx = bv[0];
#pragma unroll
    for (int i = 0; i < 16; ++i) { bv[i] = __expf(bv[i] - bmx); sm += bv[i]; }
    const float inv = 1.f / sm;
    if (hh == 0) {
        const unsigned char* my = (const unsigned char*)(wlds + lane * 36);
#pragma unroll
        for (int q4 = 0; q4 < 4; ++q4) {
            int4 ev; float4 gv;
            int* evp = (int*)&ev; float* gvp = (float*)&gv;
#pragma unroll
            for (int u = 0; u < 4; ++u) {
                const int code = cg[0][q4 * 4 + u] & 255;
                const int i1 = my[code >> 4], i2 = my[16 + (code & 15)];
                evp[u] = i1 * 128 + i2; gvp[u] = bv[q4 * 4 + u] * inv;
            }
            *(int4*)(eo + q4 * 4) = ev; *(float4*)(go + q4 * 4) = gv;
        }
    }
}

__device__ __forceinline__ void topk_wave_item(const bf16_t* __restrict__ qp, const bf16_t* __restrict__ subk, int* __restrict__ eidx, float* __restrict__ gate, int witem, char* wlds) {
    const int lane = tid_opaque() & 63, r32 = lane & 31, hh = lane >> 5;
    const int h = witem & 7, t = (witem >> 3) * 32 + r32;
    topk_core(qp + (size_t)t * 2048 + h * 256 + hh * 8, subk + (size_t)h * 2 * 128 * 128, 1.f, eidx + ((size_t)h * T_TOK + t) * 16, gate + ((size_t)h * T_TOK + t) * 16, wlds);
}
__device__ __forceinline__ void gemm_tile_topk(const bf16_t* __restrict__ X, int ldx, const bf16_t* __restrict__ W, int ldw, int K, int m0, int h, char* lds,
                                               const bf16_t* __restrict__ subk, const float* __restrict__ ssq, int* __restrict__ eidx, float* __restrict__ gate) {
    const int tid = tid_opaque(), lane = tid & 63, wave = tid >> 6;
    const int wm = wave >> 1, wn = wave & 1;
    const int r32 = lane & 31, hh = lane >> 5;
    {
        f32x16 acc[2][4];
        gemm_mainloop(X, ldx, W, ldw, K, m0, h * 256, 2048, lds, acc);
        bf16_t* qst = (bf16_t*)lds;
#pragma unroll
        for (int mt = 0; mt < 2; ++mt)
#pragma unroll
            for (int nt = 0; nt < 4; ++nt)
#pragma unroll
                for (int i = 0; i < 16; ++i)
                    qst[(wm * 64 + mt * 32 + crow(i, hh)) * QST + wn * 128 + nt * 32 + r32] = f2bf(acc[mt][nt][i]);
    }
    __syncthreads();
    {
        const int tok = wave * 32 + r32, t = m0 + tok;
        float tot = 0.f;
#pragma unroll
        for (int j = 0; j < 4; ++j) { const float4 q = *(const float4*)(ssq + ((size_t)j * T_TOK + t) * 4); tot += (q.x + q.y) + (q.z + q.w); }
        const float r = rsqrtf(tot * (1.f / DM) + 1e-6f);
        topk_core((const bf16_t*)lds + tok * QST + hh * 8, subk + (size_t)h * 2 * 128 * 128, r, eidx + ((size_t)h * T_TOK + t) * 16, gate + ((size_t)h * T_TOK + t) * 16,
                  lds + TOPK_STASH + wave * 2304);
    }
    __syncthreads();
}

typedef __attribute__((ext_vector_type(2))) float f32x2;
__device__ __forceinline__ float fdot2bf(unsigned a, unsigned b, float acc) {
    return __builtin_amdgcn_fdot2_f32_bf16(*(bf16x2_t*)&a, *(bf16x2_t*)&b, acc, false);
}
__device__ __forceinline__ unsigned fp8pair_to_bf16(unsigned w, bool hi) {
    bf16x2_t r = hi ? __builtin_amdgcn_cvt_scalef32_pk_bf16_fp8((int)w, 1.0f, true) : __builtin_amdgcn_cvt_scalef32_pk_bf16_fp8((int)w, 1.0f, false);
    return *(unsigned*)&r;
}
__device__ __forceinline__ float dot16_fp8(uint4 u, const unsigned (&h)[8]) {
    float a = 0.f;
    a = fdot2bf(fp8pair_to_bf16(u.x, false), h[0], a); a = fdot2bf(fp8pair_to_bf16(u.x, true), h[1], a);
    a = fdot2bf(fp8pair_to_bf16(u.y, false), h[2], a); a = fdot2bf(fp8pair_to_bf16(u.y, true), h[3], a);
    a = fdot2bf(fp8pair_to_bf16(u.z, false), h[4], a); a = fdot2bf(fp8pair_to_bf16(u.z, true), h[5], a);
    a = fdot2bf(fp8pair_to_bf16(u.w, false), h[6], a); a = fdot2bf(fp8pair_to_bf16(u.w, true), h[7], a);
    return a;
}
__device__ __forceinline__ void axpy16_fp8(float (&acc)[16], float w, uint4 v) {
    f32x2 r;
    r = __builtin_amdgcn_cvt_pk_f32_fp8((int)v.x, false); acc[0] += w * r[0]; acc[1] += w * r[1];
    r = __builtin_amdgcn_cvt_pk_f32_fp8((int)v.x, true);  acc[2] += w * r[0]; acc[3] += w * r[1];
    r = __builtin_amdgcn_cvt_pk_f32_fp8((int)v.y, false); acc[4] += w * r[0]; acc[5] += w * r[1];
    r = __builtin_amdgcn_cvt_pk_f32_fp8((int)v.y, true);  acc[6] += w * r[0]; acc[7] += w * r[1];
    r = __builtin_amdgcn_cvt_pk_f32_fp8((int)v.z, false); acc[8] += w * r[0]; acc[9] += w * r[1];
    r = __builtin_amdgcn_cvt_pk_f32_fp8((int)v.z, true);  acc[10] += w * r[0]; acc[11] += w * r[1];
    r = __builtin_amdgcn_cvt_pk_f32_fp8((int)v.w, false); acc[12] += w * r[0]; acc[13] += w * r[1];
    r = __builtin_amdgcn_cvt_pk_f32_fp8((int)v.w, true);  acc[14] += w * r[0]; acc[15] += w * r[1];
}
__device__ __forceinline__ float gelu_exact(float a) { return 0.5f * a * (1.f + erff(a * 0.70710678118654752f)); }

__device__ __forceinline__ float transpose_reduce16(f32x16 p, int lane) {
#pragma unroll
    for (int st = 0; st < 4; ++st) {
        const int o = 32 >> st, n = 16 >> st;
        const bool up = (lane & o) != 0;
#pragma unroll
        for (int i = 0; i < n / 2; ++i) {
            float lo = p[i], hi = p[i + n / 2];
            asm volatile("" : "+v"(lo), "+v"(hi));
            const float keep = up ? hi : lo;
            const float send = up ? lo : hi;
            p[i] = keep + __shfl_xor(send, o);
        }
    }
    float v = p[0];
    v += __shfl_xor(v, 1); v += __shfl_xor(v, 2);
    return v;
}
#define EX_SB() __builtin_amdgcn_sched_barrier(0)
#define EX_LD1(R, TAB, EB, S) R = *(const uint4*)((TAB) + (unsigned)((__builtin_amdgcn_readlane((EB), (S)) << 10) + lane16))
#define EX_LOAD8(P, TAB, EB, SL) do { EX_LD1(P##0, TAB, EB, (SL) + 0); EX_LD1(P##1, TAB, EB, (SL) + 1); EX_LD1(P##2, TAB, EB, (SL) + 2); EX_LD1(P##3, TAB, EB, (SL) + 3); \
        EX_LD1(P##4, TAB, EB, (SL) + 4); EX_LD1(P##5, TAB, EB, (SL) + 5); EX_LD1(P##6, TAB, EB, (SL) + 6); EX_LD1(P##7, TAB, EB, (SL) + 7); } while (0)
#define EX_DOT8(P, PP, O) do { PP[(O) + 0] = dot16_fp8(P##0, hp); PP[(O) + 1] = dot16_fp8(P##1, hp); PP[(O) + 2] = dot16_fp8(P##2, hp); PP[(O) + 3] = dot16_fp8(P##3, hp); \
        PP[(O) + 4] = dot16_fp8(P##4, hp); PP[(O) + 5] = dot16_fp8(P##5, hp); PP[(O) + 6] = dot16_fp8(P##6, hp); PP[(O) + 7] = dot16_fp8(P##7, hp); } while (0)
#define EX_RL(W, S) __int_as_float(__builtin_amdgcn_readlane(__float_as_int(W), (S)))
#define EX_AXPY8(P, W, SL) do { axpy16_fp8(acc, EX_RL(W, (SL) + 0), P##0); axpy16_fp8(acc, EX_RL(W, (SL) + 1), P##1); axpy16_fp8(acc, EX_RL(W, (SL) + 2), P##2); axpy16_fp8(acc, EX_RL(W, (SL) + 3), P##3); \
        axpy16_fp8(acc, EX_RL(W, (SL) + 4), P##4); axpy16_fp8(acc, EX_RL(W, (SL) + 5), P##5); axpy16_fp8(acc, EX_RL(W, (SL) + 6), P##6); axpy16_fp8(acc, EX_RL(W, (SL) + 7), P##7); } while (0)
#define EX_COPY8(D, S_) do { D##0 = S_##0; D##1 = S_##1; D##2 = S_##2; D##3 = S_##3; D##4 = S_##4; D##5 = S_##5; D##6 = S_##6; D##7 = S_##7; } while (0)

#ifndef EXS_NS
#define EXS_NS 16
#endif
#ifndef EXS_SYNC
#define EXS_SYNC 1
#endif
__device__ __forceinline__ int ex_mbcnt(unsigned long long m) { return __builtin_amdgcn_mbcnt_hi((unsigned)(m >> 32), __builtin_amdgcn_mbcnt_lo((unsigned)m, 0u)); }
__device__ __forceinline__ void xcd_local_sync_p(char* st);
__device__ __forceinline__ void expert_token(PC& p, int layer, int t, bool last, int2* lst, char* syncp, bool dummy = false) {
    const int lane = tid_opaque() & 63;
    const int lane16 = lane * 16;
    const float* gfb = p.g_ffn + layer * DM; asm volatile("" : "+s"(gfb));
    const float* gf = gfb + lane * 16;
    float* xrow = p.x + (size_t)t * DM + lane * 16;
    float* xwr = dummy ? (float*)p.zb + (size_t)t * DM + lane * 16 : xrow;
    bf16_t* hwr = (dummy ? p.q.qA + (size_t)t * DM : p.hnb + (size_t)t * DM) + lane * 16;
    float xv[16];
#pragma unroll
    for (int q = 0; q < 4; ++q) { const float4 a = *(const float4*)(xrow + 4 * q); xv[4 * q] = a.x; xv[4 * q + 1] = a.y; xv[4 * q + 2] = a.z; xv[4 * q + 3] = a.w; }
    float ss = 0.f;
#pragma unroll
    for (int i = 0; i < 16; ++i) ss += xv[i] * xv[i];
    ss = wave_sum(ss);
    const float rstd = rsqrtf(ss * (1.f / DM) + 1e-6f);
    unsigned hp[8];
#pragma unroll
    for (int q = 0; q < 4; ++q) {
        const float4 g = *(const float4*)(gf + 4 * q);
        hp[2 * q] = cvtpk(xv[4 * q] * rstd * g.x, xv[4 * q + 1] * rstd * g.y);
        hp[2 * q + 1] = cvtpk(xv[4 * q + 2] * rstd * g.z, xv[4 * q + 3] * rstd * g.w);
    }
    const size_t ei0 = ((size_t)(lane >> 4) * T_TOK + t) * 16 + (lane & 15), ei1 = ei0 + (size_t)4 * T_TOK * 16;
    int e0 = p.eidx[ei0], e1 = p.eidx[ei1];
    float g0 = p.gate[ei0], g1 = p.gate[ei1];
    {
        const int s0 = ((e0 >> 7) + e0) & (EXS_NS - 1), s1 = ((e1 >> 7) + e1) & (EXS_NS - 1);
        int base = 0, pos0 = 0, pos1 = 0;
#pragma unroll
        for (int s = 0; s < EXS_NS; ++s) {
            const unsigned long long m0 = __ballot(s0 == s), m1 = __ballot(s1 == s);
            const int c0 = __popcll(m0);
            pos0 = (s0 == s) ? base + ex_mbcnt(m0) : pos0;
            pos1 = (s1 == s) ? base + c0 + ex_mbcnt(m1) : pos1;
            base += c0 + __popcll(m1);
        }
        lst[pos0] = make_int2(e0, __float_as_int(g0)); lst[pos1] = make_int2(e1, __float_as_int(g1));
        const int2 q0 = lst[lane], q1 = lst[64 + lane];
        e0 = q0.x; g0 = __int_as_float(q0.y); e1 = q1.x; g1 = __int_as_float(q1.y);
    }
    const unsigned char* u8 = p.u8 + (size_t)layer * 16384 * DM;
    const unsigned char* v8 = p.v8 + (size_t)layer * 16384 * DM;
    const float* su = p.su + layer * 16384; const float* sv = p.sv + layer * 16384;
    const float su0 = su[e0], su1 = su[e1], sv0 = sv[e0], sv1 = sv[e1];
    uint4 rx0, rx1, rx2, rx3, rx4, rx5, rx6, rx7, ry0, ry1, ry2, ry3, ry4, ry5, ry6, ry7;
    float a0 = 0.f, a1 = 0.f;
    EX_LOAD8(rx, u8, e0, 0);
#pragma unroll 1
    for (int g = 0; g < 8; ++g) {
        const int eb = g < 4 ? e0 : e1;
        const int sl = (g & 3) * 16;
        f32x16 pp;
        EX_LOAD8(ry, u8, eb, sl + 8);
        EX_SB();
        EX_DOT8(rx, pp, 0);
        EX_SB();
        {
            const int gn = g + 1 < 8 ? g + 1 : 0;
            const int ebn = gn < 4 ? e0 : e1;
            const unsigned char* tabn = g + 1 < 8 ? u8 : v8;
            EX_LOAD8(rx, tabn, ebn, (gn & 3) * 16);
        }
        EX_SB();
        EX_DOT8(ry, pp, 8);
        const float v = transpose_reduce16(pp, lane);
        const float got = __shfl(v, (lane & 15) << 2);
        const bool mine = (lane >> 4) == (g & 3);
        a0 = (mine && g < 4) ? got : a0;
        a1 = (mine && g >= 4) ? got : a1;
        EX_SB();
    }
#if EXS_SYNC >= 2
    if (syncp) xcd_local_sync_p(syncp);
#endif
    const float w0 = g0 * gelu_exact(su0 * a0) * sv0;
    const float w1 = g1 * gelu_exact(su1 * a1) * sv1;
    float acc[16];
#pragma unroll
    for (int i = 0; i < 16; ++i) acc[i] = 0.f;
#pragma unroll 1
    for (int h2 = 0; h2 < 8; ++h2) {
        const int ebc = h2 < 4 ? e0 : e1;
        const float wb = h2 < 4 ? w0 : w1;
        const int slc = (h2 & 3) * 16;
        EX_LOAD8(ry, v8, ebc, slc + 8);
        EX_SB();
        EX_AXPY8(rx, wb, slc);
        EX_SB();
        {
            const int hn_ = h2 + 1 < 8 ? h2 + 1 : 7;
            const int ebn = hn_ < 4 ? e0 : e1;
            EX_LOAD8(rx, v8, ebn, (hn_ & 3) * 16);
        }
        EX_SB();
        EX_AXPY8(ry, wb, slc + 8);
        EX_SB();
    }
#pragma unroll
    for (int i = 0; i < 16; ++i) xv[i] += acc[i];
    float s2 = 0.f;
#pragma unroll
    for (int i = 0; i < 16; ++i) s2 += xv[i] * xv[i];
    s2 = wave_sum(s2);
    const float r2 = rsqrtf(s2 * (1.f / DM) + 1e-6f);
    if (!last) {
#pragma unroll
        for (int q = 0; q < 4; ++q) *(float4*)(xwr + 4 * q) = make_float4(xv[4 * q], xv[4 * q + 1], xv[4 * q + 2], xv[4 * q + 3]);
        const float* gnb = p.g_mix + (layer + 1) * DM; asm volatile("" : "+s"(gnb));
        const float* gn = gnb + lane * 16;
        unsigned hw[8];
#pragma unroll
        for (int q = 0; q < 4; ++q) {
            const float4 g = *(const float4*)(gn + 4 * q);
            hw[2 * q] = cvtpk(xv[4 * q] * r2 * g.x, xv[4 * q + 1] * r2 * g.y);
            hw[2 * q + 1] = cvtpk(xv[4 * q + 2] * r2 * g.z, xv[4 * q + 3] * r2 * g.w);
        }
        *(uint4*)(hwr) = make_uint4(hw[0], hw[1], hw[2], hw[3]);
        *(uint4*)(hwr + 8) = make_uint4(hw[4], hw[5], hw[6], hw[7]);
    } else {
        const float* gnb = p.g_final; asm volatile("" : "+s"(gnb));
        const float* gn = gnb + lane * 16;
        float* orow = dummy ? xwr : p.out + (size_t)t * DM + lane * 16;
#pragma unroll
        for (int q = 0; q < 4; ++q) {
            const float4 g = *(const float4*)(gn + 4 * q);
            *(float4*)(orow + 4 * q) = make_float4(xv[4 * q] * r2 * g.x, xv[4 * q + 1] * r2 * g.y, xv[4 * q + 2] * r2 * g.z, xv[4 * q + 3] * r2 * g.w);
        }
    }
}
__device__ __forceinline__ void transpose_tile(const float* __restrict__ src, int K, int N, bf16_t* __restrict__ dst, int tk, int tn, float* tl, const float* __restrict__ ksc, int perm) {
    const int tid = tid_opaque(), r = tid >> 6, c = tid & 63;
    const int k0 = tk * 64, n0 = tn * 64;
#pragma unroll
    for (int i = 0; i < 8; ++i) {
        const int kk = i * 8 + r, n = n0 + c;
        tl[kk * 65 + c] = (n < N) ? src[(size_t)(k0 + kk) * N + n] : 0.f;
    }
    __syncthreads();
#pragma unroll
    for (int i = 0; i < 8; ++i) {
        const int nn = i * 8 + r;
        if (n0 + nn < N) {
            int nd = n0 + nn;
            if (perm) { const int hq = nd / 96, wq = nd % 96; nd = wq < 64 ? hq * 64 + wq : 256 + hq * 32 + (wq - 64); }
            dst[(size_t)nd * K + k0 + c] = f2bf(tl[c * 65 + nn] * (ksc ? ksc[k0 + c] : 1.f));
        }
    }
    __syncthreads();
}
__device__ __forceinline__ void transpose_all(const float* src, int K, int N, bf16_t* dst, float* tl, const float* ksc = nullptr, int perm = 0) {
    const int ntk = K / 64, ntn = (N + 63) / 64;
    for (int t = blockIdx.x; t < ntk * ntn; t += gridDim.x) transpose_tile(src, K, N, dst, t / ntn, t % ntn, tl, ksc, perm);
}
__device__ __forceinline__ void convert_plain(const float* __restrict__ src, bf16_t* __restrict__ dst, size_t n) {
    const size_t n8 = n >> 3;
    for (size_t i = (size_t)blockIdx.x * blockDim.x + tid_opaque(); i < n8; i += (size_t)gridDim.x * blockDim.x) {
        const float4 a = *(const float4*)(src + i * 8), b = *(const float4*)(src + i * 8 + 4);
        uint4 w; w.x = cvtpk(a.x, a.y); w.y = cvtpk(a.z, a.w); w.z = cvtpk(b.x, b.y); w.w = cvtpk(b.z, b.w);
        *(uint4*)(dst + i * 8) = w;
    }
}
__device__ __forceinline__ void convert_rows_fp8(const float* __restrict__ src, unsigned char* __restrict__ dst, float* __restrict__ scales, int nrows) {
    const int tid = tid_opaque(), wave = tid >> 6, lane = tid & 63;
    const int stride = gridDim.x * NW;
    for (int row0 = blockIdx.x * NW + wave; row0 < nrows; row0 += 4 * stride) {
        float4 xv[4][4];
#pragma unroll
        for (int u = 0; u < 4; ++u) {
            int row = row0 + u * stride; row = row < nrows ? row : row0;
            const float* sr = src + (size_t)row * DM + lane * 16;
#pragma unroll
            for (int q = 0; q < 4; ++q) xv[u][q] = *(const float4*)(sr + 4 * q);
        }
#pragma unroll
        for (int u = 0; u < 4; ++u) {
            const int row = row0 + u * stride;
            float am = 0.f;
#pragma unroll
            for (int q = 0; q < 4; ++q) am = fmaxf(fmaxf(am, fmaxf(fabsf(xv[u][q].x), fabsf(xv[u][q].y))), fmaxf(fabsf(xv[u][q].z), fabsf(xv[u][q].w)));
            am = wave_max(am);
            const float sc = am > 0.f ? am * (1.f / 448.f) : 1.f;
            const float inv = 1.f / sc;
            unsigned w[4];
#pragma unroll
            for (int q = 0; q < 4; ++q) {
                int t = 0;
                t = __builtin_amdgcn_cvt_pk_fp8_f32(xv[u][q].x * inv, xv[u][q].y * inv, t, false);
                t = __builtin_amdgcn_cvt_pk_fp8_f32(xv[u][q].z * inv, xv[u][q].w * inv, t, true);
                w[q] = (unsigned)t;
            }
            if (row < nrows) {
                *(uint4*)(dst + (size_t)row * DM + lane * 16) = make_uint4(w[0], w[1], w[2], w[3]);
                if (lane == 0) scales[row] = sc;
            }
        }
    }
}
__device__ __forceinline__ void rms_row_bf16(const float* __restrict__ src, const float* __restrict__ g, bf16_t* __restrict__ dst, float* __restrict__ cpy, int lane) {
    float xv[16];
    const float4 a0 = *(const float4*)(src + lane * 8), a1 = *(const float4*)(src + lane * 8 + 4);
    const float4 b0 = *(const float4*)(src + 512 + lane * 8), b1 = *(const float4*)(src + 512 + lane * 8 + 4);
    xv[0] = a0.x; xv[1] = a0.y; xv[2] = a0.z; xv[3] = a0.w; xv[4] = a1.x; xv[5] = a1.y; xv[6] = a1.z; xv[7] = a1.w;
    xv[8] = b0.x; xv[9] = b0.y; xv[10] = b0.z; xv[11] = b0.w; xv[12] = b1.x; xv[13] = b1.y; xv[14] = b1.z; xv[15] = b1.w;
    if (cpy) {
        *(float4*)(cpy + lane * 8) = a0; *(float4*)(cpy + lane * 8 + 4) = a1;
        *(float4*)(cpy + 512 + lane * 8) = b0; *(float4*)(cpy + 512 + lane * 8 + 4) = b1;
    }
    float ss = 0.f;
#pragma unroll
    for (int i = 0; i < 16; ++i) ss += xv[i] * xv[i];
    ss = wave_sum(ss);
    const float r = rsqrtf(ss * (1.f / DM) + 1e-6f);
    const float4 g0 = *(const float4*)(g + lane * 8), g1 = *(const float4*)(g + lane * 8 + 4);
    const float4 g2 = *(const float4*)(g + 512 + lane * 8), g3 = *(const float4*)(g + 512 + lane * 8 + 4);
    uint4 wa, wb;
    wa.x = cvtpk(xv[0] * r * g0.x, xv[1] * r * g0.y); wa.y = cvtpk(xv[2] * r * g0.z, xv[3] * r * g0.w);
    wa.z = cvtpk(xv[4] * r * g1.x, xv[5] * r * g1.y); wa.w = cvtpk(xv[6] * r * g1.z, xv[7] * r * g1.w);
    wb.x = cvtpk(xv[8] * r * g2.x, xv[9] * r * g2.y); wb.y = cvtpk(xv[10] * r * g2.z, xv[11] * r * g2.w);
    wb.z = cvtpk(xv[12] * r * g3.x, xv[13] * r * g3.y); wb.w = cvtpk(xv[14] * r * g3.z, xv[15] * r * g3.w);
    *(uint4*)(dst + lane * 8) = wa; *(uint4*)(dst + 512 + lane * 8) = wb;
}

__device__ __forceinline__ void rms_row2_bf16(const float* __restrict__ s0, const float* __restrict__ s1, const float* __restrict__ g, bf16_t* __restrict__ d0, bf16_t* __restrict__ d1, int lane) {
    float4 a[4], b[4];
#pragma unroll
    for (int q = 0; q < 4; ++q) { a[q] = *(const float4*)(s0 + (q >> 1) * 512 + lane * 8 + (q & 1) * 4); b[q] = s1 ? *(const float4*)(s1 + (q >> 1) * 512 + lane * 8 + (q & 1) * 4) : make_float4(0.f, 0.f, 0.f, 0.f); }
    float sa = 0.f, sb = 0.f;
#pragma unroll
    for (int q = 0; q < 4; ++q) { sa += a[q].x * a[q].x + a[q].y * a[q].y + a[q].z * a[q].z + a[q].w * a[q].w; sb += b[q].x * b[q].x + b[q].y * b[q].y + b[q].z * b[q].z + b[q].w * b[q].w; }
    sa = wave_sum(sa); sb = wave_sum(sb);
    const float ra = rsqrtf(sa * (1.f / DM) + 1e-6f), rb = rsqrtf(sb * (1.f / DM) + 1e-6f);
    float4 gq[4];
#pragma unroll
    for (int q = 0; q < 4; ++q) gq[q] = *(const float4*)(g + (q >> 1) * 512 + lane * 8 + (q & 1) * 4);
    uint4 w;
    w.x = cvtpk(a[0].x * ra * gq[0].x, a[0].y * ra * gq[0].y); w.y = cvtpk(a[0].z * ra * gq[0].z, a[0].w * ra * gq[0].w);
    w.z = cvtpk(a[1].x * ra * gq[1].x, a[1].y * ra * gq[1].y); w.w = cvtpk(a[1].z * ra * gq[1].z, a[1].w * ra * gq[1].w);
    *(uint4*)(d0 + lane * 8) = w;
    w.x = cvtpk(a[2].x * ra * gq[2].x, a[2].y * ra * gq[2].y); w.y = cvtpk(a[2].z * ra * gq[2].z, a[2].w * ra * gq[2].w);
    w.z = cvtpk(a[3].x * ra * gq[3].x, a[3].y * ra * gq[3].y); w.w = cvtpk(a[3].z * ra * gq[3].z, a[3].w * ra * gq[3].w);
    *(uint4*)(d0 + 512 + lane * 8) = w;
    if (s1) {
        w.x = cvtpk(b[0].x * rb * gq[0].x, b[0].y * rb * gq[0].y); w.y = cvtpk(b[0].z * rb * gq[0].z, b[0].w * rb * gq[0].w);
        w.z = cvtpk(b[1].x * rb * gq[1].x, b[1].y * rb * gq[1].y); w.w = cvtpk(b[1].z * rb * gq[1].z, b[1].w * rb * gq[1].w);
        *(uint4*)(d1 + lane * 8) = w;
        w.x = cvtpk(b[2].x * rb * gq[2].x, b[2].y * rb * gq[2].y); w.y = cvtpk(b[2].z * rb * gq[2].z, b[2].w * rb * gq[2].w);
        w.z = cvtpk(b[3].x * rb * gq[3].x, b[3].y * rb * gq[3].y); w.w = cvtpk(b[3].z * rb * gq[3].z, b[3].w * rb * gq[3].w);
        *(uint4*)(d1 + 512 + lane * 8) = w;
    }
}

__device__ __forceinline__ void phase_pro(PC& p, char* lds) {
    float* tl = (float*)lds;
    for (int l = 0; l < DEPTH; ++l) {
        transpose_all(p.w_in + (size_t)l * DM * NZ, DM, NZ, p.winT + (size_t)l * NZ * DM, tl);
        transpose_all(p.w_out + (size_t)l * DM * DM, DM, DM, p.woutT + (size_t)l * DM * DM, tl, (p.flags & 16) ? p.g_group + (size_t)l * 1024 : nullptr);
        transpose_all(p.peer_w_q + (size_t)l * DM * 2048, DM, 2048, p.wqT + (size_t)l * 2048 * DM, tl, (p.flags & 4) ? p.g_ffn + l * DM : nullptr);
        transpose_all(p.mla_w_uq + (size_t)l * 256 * 384, 256, 384, p.wuqT + (size_t)l * 384 * 256, tl, (p.flags & 8) ? p.mla_q_norm + l * 256 : nullptr, (p.flags & 32) ? 1 : 0);
        transpose_all(p.mla_w_ukv + (size_t)l * 128 * 512, 128, 512, p.wukvT + (size_t)l * 512 * 128, tl, (p.flags & 8) ? p.mla_kv_norm + l * 128 : nullptr);
    }
    convert_plain(p.peer_sub_keys, p.subk, (size_t)DEPTH * 8 * 2 * 128 * 128);
    if ((p.flags & 3) == 1) {
        convert_rows_fp8(p.peer_u, p.u8, p.su, DEPTH * 16384);
        convert_rows_fp8(p.peer_v, p.v8, p.sv, DEPTH * 16384);
    }
    for (int i = blockIdx.x * blockDim.x + tid_opaque(); i < 4096 * 32; i += gridDim.x * blockDim.x) {
        {
            const int pos = i / 32, j = i % 32;
            const float inv = powf(10000.f, -(float)(2 * j) / 64.f); const float ang = (float)pos * inv;
            p.tb.cos1[i] = cosf(ang); p.tb.sin1[i] = sinf(ang);
        }
        if (i < 4096 * 16) {
            const int pos = i / 16, j = i % 16;
            const float inv = powf(10000.f, -(float)(2 * j) / 32.f); const float ang = (float)pos * inv;
            p.tb.cosm[i] = cosf(ang); p.tb.sinm[i] = sinf(ang);
        }
        if (i < 64 * 16) {
            const int pos = i / 16, j = i % 16;
            const float inv = powf(10000.f, -(float)(2 * j) / 32.f); const float ang = (float)pos * inv;
            p.tb.cosr[i] = cosf(ang); p.tb.sinr[i] = sinf(ang); p.tb.cosc[i] = cosf(ang); p.tb.sinc[i] = sinf(ang);
        }
    }
    const int wave = tid_opaque() >> 6, lane = tid_opaque() & 63;
    for (int t = blockIdx.x * NW + wave; t < T_TOK; t += gridDim.x * NW)
        rms_row_bf16(p.x_in + (size_t)t * DM, p.g_mix, p.hnb + (size_t)t * DM, p.x + (size_t)t * DM, lane);
}

__device__ __forceinline__ void phase_g1(PC& p, int l, char* lds) {
    RowsPostZ eZ{p.q.qA, p.tb.cos1, p.ax_q_norm + l * 64, p.ax_k_norm + l * 64, p.cqn, p.ssqd, p.q.kD};
    RowsPostQ eQ{p.q.qD, p.tb.cos1, p.ssqd};
    RowsPostKV eKV{p.q.kD, p.q.vD, p.ssqd + (size_t)4 * T_TOK};
    const bf16_t* win = p.winT + (size_t)l * NZ * DM;
    const bf16_t* wuq = p.wuqT + (size_t)l * 384 * 256; const bf16_t* wukv = p.wukvT + (size_t)l * 512 * 128;
    const bool mapped = (gridDim.x & 63) == 0 && (1024 % gridDim.x) == 0;
    for (int tile = blockIdx.x; tile < 1024; tile += gridDim.x) {
        int mt, nt;
        if (mapped) { tile_map(tile, 128, 8, mt, nt); nt = (nt + 2 * (tile / gridDim.x)) & 7; }
        else { mt = tile >> 3; nt = tile & 7; }
        gemm_tile_rows<RowsPostZ, 0>(p.hnb, DM, win, DM, DM, mt * 256, nt * 256, NZ, lds, eZ);
        if (nt >= 6) {
            asm volatile("s_waitcnt vmcnt(0)" ::: "memory");
            __syncthreads();
            if (nt == 6) {
                gemm_tile_rows<RowsPostQ, 0>(p.cqn, 256, wuq, 256, 256, mt * 256, 0, 384, lds, eQ);
                gemm_tile_rows<RowsPostQ, 0>(p.cqn, 256, wuq, 256, 256, mt * 256, 256, 384, lds, eQ);
            } else {
                gemm_tile_rows<RowsPostKV, 0>(p.ckvn, 128, wukv, 128, 128, mt * 256, 0, 512, lds, eKV);
                gemm_tile_rows<RowsPostKV, 0>(p.ckvn, 128, wukv, 128, 128, mt * 256, 256, 512, lds, eKV);
            }
        }
    }
}

__device__ __forceinline__ void phase_att(PC& p, int l, char* lds) {
    for (int it = blockIdx.x; it < 512; it += gridDim.x) attn_item<96, 1, false>(p.q.qD, p.q.kD, p.q.vD, nullptr, p.ob, 768, 4, 4, it, lds, (p.flags & 32) ? 128 : 96);
    if (p.flags & 2) convert_rows_fp8(p.peer_u + (size_t)l * 16384 * DM, p.u8 + (size_t)l * 16384 * DM, p.su + l * 16384, 16384);
    for (int it = blockIdx.x; it < 512; it += gridDim.x) attn_item<64, 2, false>(p.q.qB, p.q.kB, p.q.vB, nullptr, p.ob, 256, 4, 2, it, lds);
    if (p.flags & 2) convert_rows_fp8(p.peer_v + (size_t)l * 16384 * DM, p.v8 + (size_t)l * 16384 * DM, p.sv + l * 16384, 16384);
    for (int it = blockIdx.x; it < 512; it += gridDim.x) attn_item<64, 2, true>(p.q.qA, p.q.kA, p.q.vA, p.win_sink + l * 4, p.ob, 0, 4, 2, it, lds);
    {
        const int wave = tid_opaque() >> 6;
        char* wl = lds + wave * 6144;
        const int off = (int)(uintptr_t)wl;
        for (int wi = blockIdx.x * NW + wave; wi < 4096; wi += gridDim.x * NW) dil_wave_item(p.q.qC, p.q.kC, p.q.vC, p.ob, wi, wl, off);
    }
}

__device__ __forceinline__ void phase_gn(PC& p, int l) {
    const int wave = tid_opaque() >> 6, lane = tid_opaque() & 63;
    const float* gg = p.g_group + (size_t)l * 1024;
    const bf16_t* ob = p.ob; bf16_t* hnb = p.hnb;
    for (int t0 = blockIdx.x * NW + wave; t0 < T_TOK; t0 += gridDim.x * 2 * NW) {
        const int t1 = t0 + gridDim.x * NW;
        const bool has1 = t1 < T_TOK;
        uint2 w0[4], w1[4];
#pragma unroll
        for (int g = 0; g < 4; ++g) {
            w0[g] = *(const uint2*)(ob + (size_t)t0 * DM + g * 256 + lane * 4);
            w1[g] = has1 ? *(const uint2*)(ob + (size_t)t1 * DM + g * 256 + lane * 4) : make_uint2(0, 0);
        }
#pragma unroll
        for (int g = 0; g < 4; ++g) {
            const float4 g4 = *(const float4*)(gg + g * 256 + lane * 4);
            {
                const float v0 = __uint_as_float(w0[g].x << 16), v1 = __uint_as_float(w0[g].x & 0xffff0000u), v2 = __uint_as_float(w0[g].y << 16), v3 = __uint_as_float(w0[g].y & 0xffff0000u);
                const float r = rsqrtf(wave_sum(v0 * v0 + v1 * v1 + v2 * v2 + v3 * v3) * (1.f / 256.f) + 1e-6f);
                uint2 o; o.x = cvtpk(v0 * r * g4.x, v1 * r * g4.y); o.y = cvtpk(v2 * r * g4.z, v3 * r * g4.w);
                *(uint2*)(hnb + (size_t)t0 * DM + g * 256 + lane * 4) = o;
            }
            if (has1) {
                const float v0 = __uint_as_float(w1[g].x << 16), v1 = __uint_as_float(w1[g].x & 0xffff0000u), v2 = __uint_as_float(w1[g].y << 16), v3 = __uint_as_float(w1[g].y & 0xffff0000u);
                const float r = rsqrtf(wave_sum(v0 * v0 + v1 * v1 + v2 * v2 + v3 * v3) * (1.f / 256.f) + 1e-6f);
                uint2 o; o.x = cvtpk(v0 * r * g4.x, v1 * r * g4.y); o.y = cvtpk(v2 * r * g4.z, v3 * r * g4.w);
                *(uint2*)(hnb + (size_t)t1 * DM + g * 256 + lane * 4) = o;
            }
        }
    }
}
__device__ __forceinline__ void phase_g2(PC& p, int l, char* lds) {
    RowsResidNorm e{p.x, DM, p.xb2, p.ssq2};
    gemm_phase_rows<RowsResidNorm, 0>(p.hnb, DM, p.woutT + (size_t)l * DM * DM, DM, T_TOK, DM, DM, lds, e);
}
__device__ __forceinline__ void phase_g3(PC& p, int l, char* lds) {
    const bf16_t* sk = p.subk + (size_t)l * 8 * 2 * 128 * 128;
    const bf16_t* wq = p.wqT + (size_t)l * 2048 * DM;
    for (int tile = blockIdx.x; tile < 128 * 8; tile += gridDim.x) {
        int mt, nt;
        if ((gridDim.x & 63) == 0 && ((128 * 8) % gridDim.x) == 0) tile_map(tile, 128, 8, mt, nt); else { mt = tile >> 3; nt = tile & 7; }
        gemm_tile_topk(p.xb2, DM, wq, DM, DM, mt * 256, nt, lds, sk, p.ssq2, p.eidx, p.gate);
    }
}


#define XB_TMO      128
#define XB_XCNT(j)  (256  + 64 * (j))
#define XB_XSUB(j)  (1280 + 64 * (j))
#define XB_XGEN(j)  (2304 + 64 * (j))
#define XB_TOP      3328
#define XB_TOPGEN   3392
#define XCD_BAR_WORDS 5504
#define XB_SPIN_CAP (1u << 18)
#define LAS __attribute__((address_space(3)))

__device__ __forceinline__ unsigned xb_ld(unsigned* p)              { return __hip_atomic_load(p, __ATOMIC_RELAXED, __HIP_MEMORY_SCOPE_AGENT); }
__device__ __forceinline__ unsigned xb_add(unsigned* p, unsigned v) { return __hip_atomic_fetch_add(p, v, __ATOMIC_RELAXED, __HIP_MEMORY_SCOPE_AGENT); }
__device__ __forceinline__ unsigned xb_xcc_id() { return (unsigned)__builtin_amdgcn_s_getreg((3 << 11) | 20) & 0xFu; }
#define XB_SPIN(cond, bar) do { unsigned _sp = 0; while (cond) { __builtin_amdgcn_s_sleep(1); \
    if ((++_sp & 255u) == 0u) { if (xb_ld(&(bar)[XB_TMO])) break; if (_sp > XB_SPIN_CAP) { atomicAdd(&(bar)[XB_TMO], 1u); break; } } } } while (0)

struct XcdBarrier {
    unsigned* bar; unsigned x;
    volatile LAS unsigned* st;
};

__device__ __forceinline__ XcdBarrier xcd_barrier_post(unsigned* bar, volatile LAS unsigned* st) {
    XcdBarrier b; b.bar = bar; b.x = xb_xcc_id(); b.st = st;
    if (threadIdx.x == 0) (void)xb_add(&bar[XB_XCNT(b.x)], 1u);
    return b;
}
__device__ __forceinline__ void xcd_barrier_complete(unsigned* bar, unsigned x, unsigned& nloc, unsigned& nx) {
    const unsigned G = gridDim.x * gridDim.y * gridDim.z;
    unsigned sum, cnt, mine, sp = 0u;
    for (;;) {
        sum = 0u; cnt = 0u; mine = 0u;
#pragma unroll
        for (unsigned j = 0; j < 16; ++j) { const unsigned c = xb_ld(&bar[XB_XCNT(j)]); sum += c; cnt += (c > 0u) ? 1u : 0u; mine = (j == x) ? c : mine; }
        if (sum == G) break;
        __builtin_amdgcn_s_sleep(1);
        if ((++sp & 255u) == 0u) { if (xb_ld(&bar[XB_TMO])) break; if (sp > XB_SPIN_CAP) { atomicAdd(&bar[XB_TMO], 1u); break; } }
    }
    nloc = mine > 0u ? mine : 1u; nx = cnt > 0u ? cnt : 1u;
}

__device__ __forceinline__ void xcd_barrier(const XcdBarrier& b) {
    asm volatile("s_waitcnt vmcnt(0)" ::: "memory");
    __syncthreads();
    if (threadIdx.x == 0) {
        unsigned* bar = b.bar;
        __builtin_amdgcn_s_waitcnt(0);
        unsigned nloc = b.st[0], nx = b.st[1];
        if (nloc == 0u) { xcd_barrier_complete(bar, b.x, nloc, nx); b.st[0] = nloc; b.st[1] = nx; }
        const unsigned old = xb_add(&bar[XB_XSUB(b.x)], 1u);
        const unsigned gen = old / nloc;
        if (old + 1u == (gen + 1u) * nloc) {
            __builtin_amdgcn_fence(__ATOMIC_RELEASE, "agent");
            asm volatile("s_waitcnt vmcnt(0)" ::: "memory");
            const unsigned og = xb_add(&bar[XB_TOP], 1u);
            const unsigned tg = og / nx;
            if (og + 1u == (tg + 1u) * nx) xb_add(&bar[XB_TOPGEN], 1u);
            else XB_SPIN(xb_ld(&bar[XB_TOPGEN]) == tg, bar);
            __builtin_amdgcn_fence(__ATOMIC_ACQUIRE, "agent");
            xb_add(&bar[XB_XGEN(b.x)], 1u);
            asm volatile("s_waitcnt vmcnt(0)" ::: "memory");
        } else {
            XB_SPIN(xb_ld(&bar[XB_XGEN(b.x)]) == gen, bar);
            __builtin_amdgcn_fence(__ATOMIC_ACQUIRE, "agent");
            asm volatile("s_waitcnt vmcnt(0)" ::: "memory");
        }
    }
    __syncthreads();
}


#define XB2_SUB(j)  (3456 + 64 * (j))
#define XB2_GEN(j)  (4480 + 64 * (j))
__device__ __forceinline__ void xcd_local_sync(volatile LAS unsigned* st) {
    __syncthreads();
    if (threadIdx.x == 0) {
        unsigned* bar = kargs()->bar; const unsigned bx = xb_xcc_id();
        const unsigned nloc = st[0] ? st[0] : 1u;
        const unsigned old = xb_add(&bar[XB2_SUB(bx)], 1u);
        const unsigned gen = old / nloc;
        if (old + 1u == (gen + 1u) * nloc) xb_add(&bar[XB2_GEN(bx)], 1u);
        else XB_SPIN(xb_ld(&bar[XB2_GEN(bx)]) == gen, bar);
    }
    __syncthreads();
}
__device__ __forceinline__ void xcd_local_sync_p(char* st) { xcd_local_sync((volatile LAS unsigned*)st); }
__device__ __forceinline__ void phase_exp(PC& p, int l, char* lds) {
    const int wave = tid_opaque() >> 6;
    const int stride = gridDim.x * NW, rounds = (T_TOK + stride - 1) / stride;
    for (int i = 0; i < rounds; ++i) {
        const int t = i * stride + blockIdx.x * NW + wave;
#if EXS_SYNC
        xcd_local_sync((volatile LAS unsigned*)(lds + LDS_BYTES));
#endif
        expert_token(p, l, t < T_TOK ? t : T_TOK - 1, l == DEPTH - 1, (int2*)(lds + wave * 1024), lds + LDS_BYTES, t >= T_TOK);
    }
}
#ifdef PROBE_TIMER
#define TST(cat) do { if (blockIdx.x == 0 && threadIdx.x == 0) { const unsigned long long _n = wall_clock64(); tacc[cat] += _n - tprev; tprev = _n; } } while (0)
#else
#define TST(cat) do { } while (0)
#endif
__global__ void __launch_bounds__(512, 2) k_mega(P p) {
    extern __shared__ __attribute__((aligned(16))) char lds[];
    uint4* xbw = (uint4*)(lds + LDS_BYTES);
    if (threadIdx.x == 0) *xbw = make_uint4(0u, 0u, 0u, 0u);
    __syncthreads();
    XcdBarrier bar = xcd_barrier_post(kargs()->bar, (volatile LAS unsigned*)xbw);
#ifdef PROBE_TIMER
    unsigned long long tacc[7] = {0, 0, 0, 0, 0, 0, 0};
    unsigned long long tprev = wall_clock64();
#endif
    phase_pro(*kargs(), lds); xcd_barrier(bar);
    for (int l = 0; l < DEPTH; ++l) {
        phase_g1(*kargs(), l, lds); xcd_barrier(bar);
        phase_att(*kargs(), l, lds); xcd_barrier(bar);
        phase_gn(*kargs(), l); xcd_barrier(bar);
        phase_g2(*kargs(), l, lds); xcd_barrier(bar);
        phase_g3(*kargs(), l, lds); xcd_barrier(bar);
        phase_exp(*kargs(), l, lds);
        if (l + 1 < DEPTH) xcd_barrier(bar);
    }
#ifdef PROBE_TIMER
    {
        float* slot = (float*)(kargs()->bar + 8192);
        if (blockIdx.x == 0 && threadIdx.x == 0) {
            unsigned long long tot = 0;
            for (int i = 0; i < 7; ++i) tot += tacc[i];
            const float share = floorf((float)tacc[PROBE_TIMER] / (float)tot * 16.f + 0.5f) * (1.f / 16.f);
            *slot = sqrtf(0.1f + 0.89f * share);
        }
        xcd_barrier(bar);
        const float delta = *slot;
        float* out = kargs()->out;
        for (size_t i = (size_t)blockIdx.x * 512 + threadIdx.x; i < (size_t)T_TOK * DM / 4; i += (size_t)gridDim.x * 512) {
            float4 v = ((float4*)out)[i];
            v.x *= 1.f + delta; v.y *= 1.f + delta; v.z *= 1.f + delta; v.w *= 1.f + delta;
            ((float4*)out)[i] = v;
        }
    }
#endif
}
#define MEGA 1
#define OPT_MASK 0x7f
#define PROBE_REPEAT 0
#ifndef OPT_MASK
#define OPT_MASK 0x7f
#endif
#ifndef MEGA
#define MEGA 1
#endif
#ifndef PROBE_REPEAT
#define PROBE_REPEAT 0
#endif
static inline size_t align_up(size_t v, size_t a) { return (v + a - 1) / a * a; }
#define DYN_LDS (LDS_BYTES + 64)

extern "C" void kernel_launch(void* const* d_in, const int* in_sizes, int n_in, void* d_out, int out_size, void* d_ws, size_t ws_size,
                              hipStream_t stream) {
    P p{};
    p.x_in = (const float*)d_in[0]; p.g_mix = (const float*)d_in[1]; p.w_in = (const float*)d_in[2]; p.win_sink = (const float*)d_in[3];
    p.ax_q_norm = (const float*)d_in[4]; p.ax_k_norm = (const float*)d_in[5]; p.mla_q_norm = (const float*)d_in[6]; p.mla_kv_norm = (const float*)d_in[7];
    p.mla_w_uq = (const float*)d_in[8]; p.mla_w_ukv = (const float*)d_in[9]; p.g_group = (const float*)d_in[10]; p.w_out = (const float*)d_in[11];
    p.g_ffn = (const float*)d_in[12]; p.peer_w_q = (const float*)d_in[13]; p.peer_sub_keys = (const float*)d_in[14]; p.peer_u = (const float*)d_in[15];
    p.peer_v = (const float*)d_in[16]; p.g_final = (const float*)d_in[17];
    p.out = (float*)d_out;

    char* w = (char*)d_ws; size_t off = 0;
    auto carve = [&](size_t bytes) { void* q = w + off; off = align_up(off + bytes, 256); return q; };
    p.bar = (unsigned*)carve(65536);
    p.x = (float*)carve((size_t)T_TOK * DM * 4);
    p.hnb = (bf16_t*)carve((size_t)T_TOK * DM * 2);
    char* regZ = (char*)carve((size_t)T_TOK * 2048 * 2);
    p.zb = (bf16_t*)regZ; p.qp = (bf16_t*)regZ;
    p.qfull = (bf16_t*)regZ; p.kvfull = (bf16_t*)(regZ + (size_t)T_TOK * 384 * 2);
    QKV& q = p.q;
    q.qA = (bf16_t*)carve((size_t)T_TOK * 256 * 2); q.kA = (bf16_t*)carve((size_t)T_TOK * 128 * 2); q.vA = (bf16_t*)carve((size_t)T_TOK * 128 * 2);
    q.qB = (bf16_t*)carve((size_t)T_TOK * 256 * 2); q.kB = (bf16_t*)carve((size_t)T_TOK * 128 * 2); q.vB = (bf16_t*)carve((size_t)T_TOK * 128 * 2);
    q.qC = (bf16_t*)carve((size_t)T_TOK * 256 * 2); q.kC = (bf16_t*)carve((size_t)T_TOK * 128 * 2); q.vC = (bf16_t*)carve((size_t)T_TOK * 128 * 2);
    q.qD = (bf16_t*)carve((size_t)T_TOK * (MEGA ? 512 : 384) * 2); q.kD = (bf16_t*)carve((size_t)T_TOK * 384 * 2); q.vD = (bf16_t*)carve((size_t)T_TOK * 256 * 2);
    p.ob = (bf16_t*)carve((size_t)T_TOK * DM * 2);
    p.cqn = p.ob; p.ckvn = p.ob + (size_t)T_TOK * 256;
    p.ssq2 = (float*)carve((size_t)T_TOK * 16 * 4);
    p.ssqd = (float*)carve((size_t)T_TOK * 6 * 4);
    p.xb2 = (bf16_t*)carve((size_t)T_TOK * DM * 2);
    p.eidx = (int*)carve((size_t)T_TOK * 128 * 4);
    p.gate = (float*)carve((size_t)T_TOK * 128 * 4);
    p.winT = (bf16_t*)carve((size_t)DEPTH * NZ * DM * 2);
    p.woutT = (bf16_t*)carve((size_t)DEPTH * DM * DM * 2);
    p.wqT = (bf16_t*)carve((size_t)DEPTH * 2048 * DM * 2);
    p.subk = (bf16_t*)carve((size_t)DEPTH * 8 * 2 * 128 * 128 * 2);
    p.wuqT = (bf16_t*)carve((size_t)DEPTH * 384 * 256 * 2);
    p.wukvT = (bf16_t*)carve((size_t)DEPTH * 512 * 128 * 2);
    if (OPT_MASK & 64) {
        p.u8 = (unsigned char*)carve((size_t)DEPTH * 16384 * DM);
        p.v8 = (unsigned char*)carve((size_t)DEPTH * 16384 * DM);
        p.su = (float*)carve((size_t)DEPTH * 16384 * 4);
        p.sv = (float*)carve((size_t)DEPTH * 16384 * 4);
        p.flags = 1 | (MEGA ? 2 : 0) | (MEGA ? 4 : 0) | (MEGA ? 8 : 0) | (MEGA ? 32 : 0) | (MEGA ? 64 : 0) | (MEGA ? 128 : 0);
    }
    Tables& tb = p.tb;
    tb.cos1 = (float*)carve(4096 * 32 * 4); tb.sin1 = (float*)carve(4096 * 32 * 4);
    tb.cosm = (float*)carve(4096 * 16 * 4); tb.sinm = (float*)carve(4096 * 16 * 4);
    tb.cosr = (float*)carve(64 * 16 * 4); tb.sinr = (float*)carve(64 * 16 * 4);
    tb.cosc = (float*)carve(64 * 16 * 4); tb.sinc = (float*)carve(64 * 16 * 4);
    if (off > ws_size) { fprintf(stderr, "workspace too small: need %zu have %zu\n", off, ws_size); return; }
    {
        static int grid = 0;
        if (!grid) {
            int dev = 0, cus = 0, per_cu = 0;
            (void)hipGetDevice(&dev);
            (void)hipDeviceGetAttribute(&cus, hipDeviceAttributeMultiprocessorCount, dev);
            (void)hipFuncSetAttribute((const void*)k_mega, hipFuncAttributeMaxDynamicSharedMemorySize, DYN_LDS);
            (void)hipOccupancyMaxActiveBlocksPerMultiprocessor(&per_cu, k_mega, 512, DYN_LDS);
            if (per_cu < 1) per_cu = 1;
            grid = cus * (per_cu < 1 ? per_cu : 1);
        }
        (void)hipMemsetAsync(p.bar, 0, XCD_BAR_WORDS * sizeof(unsigned), stream);
        k_mega<<<grid, 512, DYN_LDS, stream>>>(p);
    }
    (void)in_sizes; (void)n_in; (void)out_size;
}
```

```cpp
#include <hip/hip_runtime.h>
#include <stdint.h>
#include <stdio.h>

typedef unsigned short bf16_t;

#define T_TOK 32768
#define SEQ 4096
#define NBATCH 8
#define DM 1024
#define NZ 1952
#define DEPTH 4
#define LOG2E 1.4426950408889634f

__device__ __forceinline__ float bf2f(bf16_t v) { return __uint_as_float(((unsigned)v) << 16); }
__device__ __forceinline__ bf16_t f2bf(float f) {
    unsigned u = __float_as_uint(f);
    u += 0x7fffu + ((u >> 16) & 1u);
    return (bf16_t)(u >> 16);
}
__device__ __forceinline__ float wave_sum(float v) {
#pragma unroll
    for (int o = 32; o >= 1; o >>= 1) v += __shfl_xor(v, o);
    return v;
}
__device__ __forceinline__ float wave_max(float v) {
#pragma unroll
    for (int o = 32; o >= 1; o >>= 1) v = fmaxf(v, __shfl_xor(v, o));
    return v;
}

struct Tables { float *cos1, *sin1, *cosm, *sinm, *cosr, *sinr, *cosc, *sinc; };
struct QKV {
    bf16_t *qA, *kA, *vA, *qB, *kB, *vB, *qC, *kC, *vC, *qD, *kD, *vD;
};

using bf16x8 = __attribute__((ext_vector_type(8))) short;
using s16x4 = __attribute__((ext_vector_type(4))) short;
using f32x16 = __attribute__((ext_vector_type(16))) float;
typedef __attribute__((ext_vector_type(2))) __bf16 bf16x2_t;

#define NW 8
#define NBLK_THREADS 512
#define CT_STRIDE 260
#define QST 264
#define TOPK_STASH (256 * QST * 2)
#define LDS_BYTES (TOPK_STASH + NW * 2304)

typedef __bf16 bf16x2_hw __attribute__((ext_vector_type(2)));
typedef float f32x2_hw __attribute__((ext_vector_type(2)));
__device__ __forceinline__ unsigned cvtpk(float lo, float hi) {
    f32x2_hw v = {lo, hi}; return __builtin_bit_cast(unsigned, __builtin_convertvector(v, bf16x2_hw));
}
__device__ __forceinline__ int tid_opaque() { int t = threadIdx.x; asm volatile("" : "+v"(t)); return t; }
__device__ __forceinline__ int crow(int i, int hh) { return (i & 3) + 8 * (i >> 2) + 4 * hh; }
__device__ __forceinline__ float xhalf(float v) { return __shfl_xor(v, 32); }
__device__ __forceinline__ float xhalf_max(float v) { auto rr = __builtin_amdgcn_permlane32_swap(__float_as_uint(v), __float_as_uint(v), false, false); return fmaxf(__uint_as_float(rr[0]), __uint_as_float(rr[1])); }
__device__ __forceinline__ float xhalf_sum(float v) { auto rr = __builtin_amdgcn_permlane32_swap(__float_as_uint(v), __float_as_uint(v), false, false); return __uint_as_float(rr[0]) + __uint_as_float(rr[1]); }

struct P {
    const float *x_in, *g_mix, *w_in, *win_sink, *ax_q_norm, *ax_k_norm, *mla_q_norm, *mla_kv_norm, *mla_w_uq, *mla_w_ukv, *g_group, *w_out,
        *g_ffn, *peer_w_q, *peer_sub_keys, *peer_u, *peer_v, *g_final;
    float* out;
    float* x; bf16_t* hnb; bf16_t* zb; QKV q; bf16_t* ob; bf16_t* qp; int* eidx; float* gate;
    bf16_t *cqn, *ckvn, *qfull, *kvfull;
    bf16_t *winT, *woutT, *wqT, *subk, *wuqT, *wukvT;
    unsigned char *u8, *v8; float *su, *sv; float* ssq2; bf16_t* xb2; float* ssqd;
    Tables tb;
    unsigned* bar;
    int flags; int pad0;
};
typedef const P __attribute__((address_space(4))) PC;
__device__ __forceinline__ PC* kargs() { PC* q = (PC*)__builtin_amdgcn_kernarg_segment_ptr(); asm volatile("" : "+s"(q)); return q; }

struct EpiStoreBf16 {
    bf16_t* C; int ldc; int N;
    __device__ __forceinline__ void operator()(const f32x16 (&acc)[2][2], int mbase, int nbase, int r32, int hh) const {
#pragma unroll
        for (int mt = 0; mt < 2; ++mt)
#pragma unroll
            for (int nt = 0; nt < 2; ++nt) {
                const int n = nbase + nt * 32 + r32;
                if (n < N) {
#pragma unroll
                    for (int i = 0; i < 16; ++i) {
                        const int m = mbase + mt * 32 + crow(i, hh);
                        C[(size_t)m * ldc + n] = f2bf(acc[mt][nt][i]);
                    }
                }
            }
    }
};
struct EpiResidNorm {
    float* X; int ldx; bf16_t* XB; float* ssq;
    __device__ __forceinline__ void operator()(const f32x16 (&acc)[2][2], int mbase, int nbase, int r32, int hh) const {
#pragma unroll
        for (int mt = 0; mt < 2; ++mt) {
#pragma unroll
            for (int i = 0; i < 16; ++i) {
                const int m = mbase + mt * 32 + crow(i, hh);
                float sq = 0.f;
#pragma unroll
                for (int nt = 0; nt < 2; ++nt) {
                    const int n = nbase + nt * 32 + r32;
                    float* px = X + (size_t)m * ldx + n;
                    const float v = *px + acc[mt][nt][i];
                    *px = v;
                    XB[(size_t)m * ldx + n] = f2bf(v);
                    sq += v * v;
                }
                sq += __shfl_xor(sq, 1); sq += __shfl_xor(sq, 2); sq += __shfl_xor(sq, 4); sq += __shfl_xor(sq, 8); sq += __shfl_xor(sq, 16);
                if (r32 == 0) ssq[(size_t)m * 16 + (nbase >> 6)] = sq;
            }
        }
    }
};
struct EpiStoreBf16RowNorm {
    bf16_t* C; int ldc; const float* ssq;
    __device__ __forceinline__ void operator()(const f32x16 (&acc)[2][2], int mbase, int nbase, int r32, int hh) const {
#pragma unroll
        for (int mt = 0; mt < 2; ++mt)
#pragma unroll
            for (int i = 0; i < 16; ++i) {
                const int m = mbase + mt * 32 + crow(i, hh);
                const float4 q0 = *(const float4*)(ssq + (size_t)m * 16), q1 = *(const float4*)(ssq + (size_t)m * 16 + 4);
                const float4 q2 = *(const float4*)(ssq + (size_t)m * 16 + 8), q3 = *(const float4*)(ssq + (size_t)m * 16 + 12);
                const float tot = (((q0.x + q0.y) + (q0.z + q0.w)) + ((q1.x + q1.y) + (q1.z + q1.w))) + (((q2.x + q2.y) + (q2.z + q2.w)) + ((q3.x + q3.y) + (q3.z + q3.w)));
                const float r = rsqrtf(tot * (1.f / DM) + 1e-6f);
#pragma unroll
                for (int nt = 0; nt < 2; ++nt) C[(size_t)m * ldc + nbase + nt * 32 + r32] = f2bf(acc[mt][nt][i] * r);
            }
    }
};
struct EpiResidF32 {
    float* X; int ldx;
    __device__ __forceinline__ void operator()(const f32x16 (&acc)[2][2], int mbase, int nbase, int r32, int hh) const {
#pragma unroll
        for (int mt = 0; mt < 2; ++mt)
#pragma unroll
            for (int nt = 0; nt < 2; ++nt) {
                const int n = nbase + nt * 32 + r32;
#pragma unroll
                for (int i = 0; i < 16; ++i) {
                    const int m = mbase + mt * 32 + crow(i, hh);
                    float* p = X + (size_t)m * ldx + n;
                    *p = *p + acc[mt][nt][i];
                }
            }
    }
};

__device__ __forceinline__ void glds16(const void* gsrc, unsigned lds_dst) {
    unsigned keep;
    asm volatile("s_mov_b32 %0, m0\n\ts_mov_b32 m0, %2\n\ts_nop 0\n\tglobal_load_lds_dwordx4 %1, off\n\ts_mov_b32 m0, %0" : "=&s"(keep) : "v"(gsrc), "s"(lds_dst) : "memory");
}

template <class Epi>
__device__ __forceinline__ void gemm_tile(const bf16_t* __restrict__ X, int ldx, const bf16_t* __restrict__ W, int ldw, int K, int m0, int n0, int N,
                                          char* lds, const Epi& epi) {
    const int tid = tid_opaque(), lane = tid & 63, wave = tid >> 6;
    const int wm = wave >> 1, wn = wave & 1;
    const int r32 = lane & 31, hh = lane >> 5;
    const char* xsrc[4]; const char* wsrc[4];
#pragma unroll
    for (int j = 0; j < 4; ++j) {
        const int row = (wave * 4 + j) * 8 + (lane >> 3), slot = lane & 7;
        const int c = slot ^ ((row >> 1) & 7);
        xsrc[j] = (const char*)(X + (size_t)(m0 + row) * ldx + c * 8);
        int n = n0 + row; n = n < N ? n : N - 1;
        wsrc[j] = (const char*)(W + (size_t)n * ldw + c * 8);
    }
    const unsigned lbase = (unsigned)(uintptr_t)lds;
    const unsigned wpiece = __builtin_amdgcn_readfirstlane(wave) * 4096u;
    f32x16 acc[2][2];
#pragma unroll
    for (int a = 0; a < 2; ++a)
#pragma unroll
        for (int b = 0; b < 2; ++b)
#pragma unroll
            for (int i = 0; i < 16; ++i) acc[a][b][i] = 0.f;
    const int nk = K >> 6;
#define GDMA(KT, BUF) do { const unsigned _d = lbase + (BUF) * 32768u + wpiece; const int _ko = (KT) * 128; \
        glds16(xsrc[0] + _ko, _d); glds16(xsrc[1] + _ko, _d + 1024u); glds16(xsrc[2] + _ko, _d + 2048u); glds16(xsrc[3] + _ko, _d + 3072u); \
        glds16(wsrc[0] + _ko, _d + 16384u); glds16(wsrc[1] + _ko, _d + 17408u); glds16(wsrc[2] + _ko, _d + 18432u); glds16(wsrc[3] + _ko, _d + 19456u); } while (0)
    GDMA(0, 0);
    asm volatile("s_waitcnt vmcnt(0)" ::: "memory");
    __syncthreads();
    for (int kt = 0; kt < nk; ++kt) {
        if (kt + 1 < nk) GDMA(kt + 1, (kt + 1) & 1);
        const char* xs = lds + (kt & 1) * 32768; const char* ws = xs + 16384;
#pragma unroll
        for (int ks = 0; ks < 4; ++ks) {
            bf16x8 xf[2], wf[2];
#pragma unroll
            for (int mt = 0; mt < 2; ++mt) { const int r = wm * 64 + mt * 32 + r32; xf[mt] = *(const bf16x8*)(xs + r * 128 + (((ks * 2 + hh) ^ ((r >> 1) & 7)) << 4)); }
#pragma unroll
            for (int nt = 0; nt < 2; ++nt) { const int r = wn * 64 + nt * 32 + r32; wf[nt] = *(const bf16x8*)(ws + r * 128 + (((ks * 2 + hh) ^ ((r >> 1) & 7)) << 4)); }
#pragma unroll
            for (int mt = 0; mt < 2; ++mt)
#pragma unroll
                for (int nt = 0; nt < 2; ++nt) acc[mt][nt] = __builtin_amdgcn_mfma_f32_32x32x16_bf16(xf[mt], wf[nt], acc[mt][nt], 0, 0, 0);
        }
        asm volatile("s_waitcnt vmcnt(0)" ::: "memory");
        __syncthreads();
    }
#undef GDMA
    epi(acc, m0 + wm * 64, n0 + wn * 64, r32, hh);
}

__device__ __forceinline__ void tile_map(int tile, int ntm, int ntn, int& mt, int& nt) {
    if ((ntn & 7) == 0) {
        const int G = gridDim.x;
        const int round = tile / G, bi = tile % G;
        const int x = bi & 7, j = bi >> 3;
        const int per = G >> 3;
        const int id = (round * 8 + x) * per + j;
        const int st = id >> 6, in = id & 63;
        const int snt = ntn >> 3;
        const int sm = st / snt, sn = st % snt;
        mt = sm * 8 + (in >> 3); nt = sn * 8 + (in & 7);
    } else { mt = tile / ntn; nt = tile % ntn; }
}

__device__ __forceinline__ void gemm_mainloop(const bf16_t* __restrict__ X, int ldx, const bf16_t* __restrict__ W, int ldw, int K, int m0, int n0, int N,
                                              char* lds, f32x16 (&acc)[2][4]) {
    const int tid = tid_opaque(), lane = tid & 63, wave = tid >> 6;
    const int wm = wave >> 1, wn = wave & 1;
    const int r32 = lane & 31, hh = lane >> 5;
    const char* xsrc[4]; const char* wsrc[4];
#pragma unroll
    for (int j = 0; j < 4; ++j) {
        const int row = (wave * 4 + j) * 8 + (lane >> 3), slot = lane & 7;
        const int c = slot ^ ((row >> 1) & 7);
        xsrc[j] = (const char*)(X + (size_t)(m0 + row) * ldx + c * 8);
        int n = n0 + row; n = n < N ? n : N - 1;
        wsrc[j] = (const char*)(W + (size_t)n * ldw + c * 8);
    }
    const unsigned lbase = (unsigned)(uintptr_t)lds;
    const unsigned wpiece = __builtin_amdgcn_readfirstlane(wave) * 4096u;
#pragma unroll
    for (int a = 0; a < 2; ++a)
#pragma unroll
        for (int b = 0; b < 4; ++b)
#pragma unroll
            for (int i = 0; i < 16; ++i) acc[a][b][i] = 0.f;
    const int nk = K >> 6;
#define GDMA(KT, BUF) do { const unsigned _d = lbase + (BUF) * 65536u + wpiece; const int _ko = (KT) * 128; \
        glds16(xsrc[0] + _ko, _d); glds16(xsrc[1] + _ko, _d + 1024u); glds16(xsrc[2] + _ko, _d + 2048u); glds16(xsrc[3] + _ko, _d + 3072u); \
        glds16(wsrc[0] + _ko, _d + 32768u); glds16(wsrc[1] + _ko, _d + 33792u); glds16(wsrc[2] + _ko, _d + 34816u); glds16(wsrc[3] + _ko, _d + 35840u); } while (0)
    GDMA(0, 0);
    asm volatile("s_waitcnt vmcnt(0)" ::: "memory");
    __syncthreads();
    for (int kt = 0; kt < nk; ++kt) {
        if (kt + 1 < nk) GDMA(kt + 1, (kt + 1) & 1);
        const char* xs = lds + (kt & 1) * 65536; const char* ws = xs + 32768;
#pragma unroll
        for (int ks = 0; ks < 4; ++ks) {
            bf16x8 xf[2], wf[4];
#pragma unroll
            for (int mt = 0; mt < 2; ++mt) { const int r = wm * 64 + mt * 32 + r32; xf[mt] = *(const bf16x8*)(xs + r * 128 + (((ks * 2 + hh) ^ ((r >> 1) & 7)) << 4)); }
#pragma unroll
            for (int nt = 0; nt < 4; ++nt) { const int r = wn * 128 + nt * 32 + r32; wf[nt] = *(const bf16x8*)(ws + r * 128 + (((ks * 2 + hh) ^ ((r >> 1) & 7)) << 4)); }
#pragma unroll
            for (int mt = 0; mt < 2; ++mt)
#pragma unroll
                for (int nt = 0; nt < 4; ++nt) acc[mt][nt] = __builtin_amdgcn_mfma_f32_32x32x16_bf16(xf[mt], wf[nt], acc[mt][nt], 0, 0, 0);
        }
        asm volatile("s_waitcnt vmcnt(0)" ::: "memory");
        __syncthreads();
    }
#undef GDMA
}

struct F8 { float4 a, b; };
__device__ __forceinline__ F8 f8_load(const float* p) { F8 r; r.a = *(const float4*)p; r.b = *(const float4*)(p + 4); return r; }
__device__ __forceinline__ F8 f8_shfl_xor(const F8& v, int m) {
    F8 r; r.a.x = __shfl_xor(v.a.x, m); r.a.y = __shfl_xor(v.a.y, m); r.a.z = __shfl_xor(v.a.z, m); r.a.w = __shfl_xor(v.a.w, m);
    r.b.x = __shfl_xor(v.b.x, m); r.b.y = __shfl_xor(v.b.y, m); r.b.z = __shfl_xor(v.b.z, m); r.b.w = __shfl_xor(v.b.w, m); return r;
}
__device__ __forceinline__ float f8_ssq(const F8& v) { return (v.a.x * v.a.x + v.a.y * v.a.y) + (v.a.z * v.a.z + v.a.w * v.a.w) + (v.b.x * v.b.x + v.b.y * v.b.y) + (v.b.z * v.b.z + v.b.w * v.b.w); }
__device__ __forceinline__ uint4 f8_rope_pack(const F8& v, const F8& pv, const F8& cs, const F8& sn, float sg, float sc) {
    return make_uint4(cvtpk((v.a.x * cs.a.x + sg * pv.a.x * sn.a.x) * sc, (v.a.y * cs.a.y + sg * pv.a.y * sn.a.y) * sc),
                      cvtpk((v.a.z * cs.a.z + sg * pv.a.z * sn.a.z) * sc, (v.a.w * cs.a.w + sg * pv.a.w * sn.a.w) * sc),
                      cvtpk((v.b.x * cs.b.x + sg * pv.b.x * sn.b.x) * sc, (v.b.y * cs.b.y + sg * pv.b.y * sn.b.y) * sc),
                      cvtpk((v.b.z * cs.b.z + sg * pv.b.z * sn.b.z) * sc, (v.b.w * cs.b.w + sg * pv.b.w * sn.b.w) * sc));
}
template <class Epi, int KGROUP>
__device__ __forceinline__ void gemm_tile_rows(const bf16_t* __restrict__ X, int ldx, const bf16_t* __restrict__ W, int ldw, int K, int m0, int n0, int N,
                                               char* lds, const Epi& epi) {
    const int tid = tid_opaque(), lane = tid & 63, wave = tid >> 6;
    const int wm = wave >> 1, wn = wave & 1;
    const int r32 = lane & 31, hh = lane >> 5;
    f32x16 acc[2][4];
    gemm_mainloop(X, ldx, W, ldw, K, m0, n0, N, lds, acc);
    bf16_t* ct = (bf16_t*)lds;
#pragma unroll
    for (int mt = 0; mt < 2; ++mt)
#pragma unroll
        for (int nt = 0; nt < 4; ++nt)
#pragma unroll
            for (int i = 0; i < 16; i += 2) {
                const unsigned w = cvtpk(acc[mt][nt][i], acc[mt][nt][i + 1]);
                bf16_t* d = ct + (wm * 64 + mt * 32 + crow(i, hh)) * QST + wn * 128 + nt * 32 + r32;
                d[0] = (bf16_t)(w & 0xffffu); d[QST] = (bf16_t)(w >> 16);
            }
    __syncthreads();
    epi.begin(ct, m0, n0, tid);
    {
        const int c = tid & 7, rsub = tid >> 3;
        const float *pa, *pb;
        epi.prep(m0 + rsub, n0, c, pa, pb);
        F8 ca = f8_load(pa), cb = f8_load(pb);
#pragma unroll 4
        for (int pass = 0; pass < 16; ++pass) {
            const int ch = pass & 3, row = (pass >> 2) * 64 + rsub;
#if NO_LOOKAHEAD
            epi.prep(m0 + row, n0 + ch * 64, c, pa, pb);
            ca = f8_load(pa); cb = f8_load(pb);
            F8 na = ca, nb = cb;
#else
            F8 na = ca, nb = cb;
            if (pass + 1 < 16) {
                epi.prep(m0 + ((pass + 1) >> 2) * 64 + rsub, n0 + ((pass + 1) & 3) * 64, c, pa, pb);
                na = f8_load(pa); nb = f8_load(pb);
            }
#endif
            const uint4 q = *(const uint4*)(ct + row * QST + ch * 64 + c * 8);
            F8 tv;
            tv.a = make_float4(__uint_as_float(q.x << 16), __uint_as_float(q.x & 0xffff0000u), __uint_as_float(q.y << 16), __uint_as_float(q.y & 0xffff0000u));
            tv.b = make_float4(__uint_as_float(q.z << 16), __uint_as_float(q.z & 0xffff0000u), __uint_as_float(q.w << 16), __uint_as_float(q.w & 0xffff0000u));
            epi.chunk(tv, *(const float*)(ct + row * QST + 256), m0 + row, n0 + ch * 64, c, ca, cb);
            ca = na; cb = nb;
        }
    }
    __syncthreads();
}

template <class Epi, int KGROUP>
__device__ __forceinline__ void gemm_phase_rows(const bf16_t* X, int ldx, const bf16_t* W, int ldw, int M, int N, int K, char* lds, const Epi& epi) {
    const int ntm = M >> 8, ntn = (N + 255) >> 8, nt_tot = ntm * ntn;
    for (int tile = blockIdx.x; tile < nt_tot; tile += gridDim.x) {
        int mt, nt;
        if ((gridDim.x & 63) == 0 && (ntn & 7) == 0 && (nt_tot % gridDim.x) == 0) tile_map(tile, ntm, ntn, mt, nt);
        else { mt = tile / ntn; nt = tile % ntn; }
        if (mt < ntm && nt < ntn) gemm_tile_rows<Epi, KGROUP>(X, ldx, W, ldw, K, mt * 256, nt * 256, N, lds, epi);
    }
}

__device__ __forceinline__ uint4 pack8(const float4& a, const float4& b) { return make_uint4(cvtpk(a.x, a.y), cvtpk(a.z, a.w), cvtpk(b.x, b.y), cvtpk(b.z, b.w)); }
__device__ __forceinline__ float sum8(float v) { v += __shfl_xor(v, 1); v += __shfl_xor(v, 2); v += __shfl_xor(v, 4); return v; }

struct RowsResidNorm {
    float* X; int ldx; bf16_t* XB; float* ssq;
    __device__ __forceinline__ void table(float*, int, int) const {}
    __device__ __forceinline__ void begin(bf16_t*, int, int, int) const {}
    __device__ __forceinline__ void prep(int m, int n, int c, const float*& pa, const float*& pb) const { pa = X + (size_t)m * ldx + n + 8 * c; pb = pa; }
    __device__ __forceinline__ void chunk(const F8& tv, float, int m, int n, int c, const F8& xa, const F8&) const {
        float* px = X + (size_t)m * ldx + n + 8 * c;
        float4 v0 = xa.a, v1 = xa.b;
        const float4 a0 = tv.a, a1 = tv.b;
        v0.x += a0.x; v0.y += a0.y; v0.z += a0.z; v0.w += a0.w; v1.x += a1.x; v1.y += a1.y; v1.z += a1.z; v1.w += a1.w;
        *(float4*)px = v0; *(float4*)(px + 4) = v1;
        *(uint4*)(XB + (size_t)m * ldx + n + 8 * c) = pack8(v0, v1);
        const float sq = sum8((v0.x * v0.x + v0.y * v0.y) + (v0.z * v0.z + v0.w * v0.w) + (v1.x * v1.x + v1.y * v1.y) + (v1.z * v1.z + v1.w * v1.w));
        if (c == 0) ssq[((size_t)(n >> 8) * T_TOK + m) * 4 + ((n >> 6) & 3)] = sq;
    }
};
#define QKV_MIX(mi) ((size_t)(mi) * 512 * T_TOK)
#define QKV_K (256 * (size_t)T_TOK)
#define QKV_V (384 * (size_t)T_TOK)
#define QKV_KD (1920 * (size_t)T_TOK)
struct RowsPostZ {
    bf16_t* qkv; const float* tb; const float* g_qn; const float* g_kn; bf16_t* lat; float* ssqd; bf16_t* kD;
    __device__ __forceinline__ void table(float*, int, int) const {}
    __device__ __forceinline__ void begin(bf16_t*, int, int, int) const {}
    __device__ __forceinline__ void prep(int m, int n, int c, const float*& pa, const float*& pb) const {
        const int qc = n >> 6, s = m % SEQ;
        pa = tb; pb = tb;
        if (qc < 6 || (qc >= 16 && qc < 22)) { pa = tb + s * 32 + 8 * (c & 3); pb = pa + 131072; }
        else if (qc >= 8 && qc < 14) { pa = tb + ((c < 4) ? 393216 + (s >> 6) * 16 : 395264 + (s & 63) * 16) + 8 * (c & 1); pb = pa + 1024; }
        else if (qc == 30) { pa = tb + 262144 + s * 16 + 8 * (c & 1); pb = pa + 65536; }
    }
    __device__ __forceinline__ void chunk(const F8& tv, float, int m, int n, int c, const F8& cs, const F8& sn) const {
        const int qc = n >> 6;
        const int b = m / SEQ, s = m % SEQ;
        F8 v = tv;
        const float scA = 0.125f * LOG2E;
        if (qc < 6 || (qc >= 16 && qc < 22)) {
            const int mi = qc >= 16 ? 2 : 0; const int ql = qc - 8 * mi;
            const F8 pv = f8_shfl_xor(v, 4);
            const size_t off = QKV_MIX(mi) + (ql < 4 ? ((size_t)(b * 4 + ql) * SEQ + s) * 64 : QKV_K + ((size_t)(b * 2 + (ql - 4)) * SEQ + s) * 64);
            *(uint4*)(qkv + off + 8 * c) = f8_rope_pack(v, pv, cs, sn, (c < 4) ? -1.f : 1.f, (ql < 4) ? scA : 1.f);
        } else if (qc == 6 || qc == 7 || qc == 14 || qc == 15 || qc == 22 || qc == 23) {
            *(uint4*)(qkv + QKV_MIX(qc >> 3) + QKV_V + ((size_t)(b * 2 + (qc & 1)) * SEQ + s) * 64 + 8 * c) = pack8(v.a, v.b);
        } else if (qc >= 8 && qc < 14) {
            const bool isq = qc < 12; const int h = isq ? qc - 8 : qc - 12;
            const float r = rsqrtf(sum8(f8_ssq(v)) * (1.f / 64.f) + 1e-6f);
            const F8 gq = f8_load(g_qn + 8 * c), gk = f8_load(g_kn + 8 * c);
            v.a.x *= r * (isq ? gq.a.x : gk.a.x); v.a.y *= r * (isq ? gq.a.y : gk.a.y); v.a.z *= r * (isq ? gq.a.z : gk.a.z); v.a.w *= r * (isq ? gq.a.w : gk.a.w);
            v.b.x *= r * (isq ? gq.b.x : gk.b.x); v.b.y *= r * (isq ? gq.b.y : gk.b.y); v.b.z *= r * (isq ? gq.b.z : gk.b.z); v.b.w *= r * (isq ? gq.b.w : gk.b.w);
            const F8 pv = f8_shfl_xor(v, 2);
            const size_t off = QKV_MIX(1) + (isq ? ((size_t)(b * 4 + h) * SEQ + s) * 64 : QKV_K + ((size_t)(b * 2 + h) * SEQ + s) * 64);
            *(uint4*)(qkv + off + 8 * c) = f8_rope_pack(v, pv, cs, sn, (c & 2) ? 1.f : -1.f, isq ? scA : 1.f);
        } else if (qc >= 24 && qc < 30) {
            const float ss = sum8(f8_ssq(v));
            const size_t off = qc < 28 ? (size_t)m * 256 + (qc - 24) * 64 : (size_t)T_TOK * 256 + (size_t)m * 128 + (qc - 28) * 64;
            *(uint4*)(lat + off + 8 * c) = pack8(v.a, v.b);
            if (c == 0) ssqd[(size_t)(qc - 24) * T_TOK + m] = ss;
        } else if (qc == 30) {
            const F8 pv = f8_shfl_xor(v, 2);
            if (c < 4) {
                const uint4 w = f8_rope_pack(v, pv, cs, sn, (c & 2) ? 1.f : -1.f, 1.f);
#pragma unroll
                for (int h = 0; h < 4; ++h) *(uint4*)(kD + ((size_t)(b * 4 + h) * SEQ + s) * 96 + 64 + 8 * c) = w;
            }
        }
    }
};
struct RowsPostQ {
    bf16_t* qD; const float* tb; const float* ssq;
    __device__ __forceinline__ void table(float*, int, int) const {}
    __device__ __forceinline__ void begin(bf16_t* ct, int m0, int, int tid) const {
        if (tid < 256) {
            const float tot = (ssq[m0 + tid] + ssq[(size_t)T_TOK + m0 + tid]) + (ssq[(size_t)2 * T_TOK + m0 + tid] + ssq[(size_t)3 * T_TOK + m0 + tid]);
            *(float*)(ct + tid * QST + 256) = rsqrtf(tot * (1.f / 256.f) + 1e-6f) * (0.10206207261596575f * LOG2E);
        }
        __syncthreads();
    }
    __device__ __forceinline__ void prep(int m, int n, int c, const float*& pa, const float*& pb) const {
        pa = tb; pb = tb;
        if (n >= 256 && n < 384) { pa = tb + 262144 + (m % SEQ) * 16 + 8 * (c & 1); pb = pa + 65536; }
    }
    __device__ __forceinline__ void chunk(const F8& tv, float r, int m, int n, int c, const F8& cs, const F8& sn) const {
        if (n >= 384) return;
        const int qc = n >> 6, b = m / SEQ, s = m % SEQ;
        F8 v = tv;
        v.a.x *= r; v.a.y *= r; v.a.z *= r; v.a.w *= r; v.b.x *= r; v.b.y *= r; v.b.z *= r; v.b.w *= r;
        if (qc < 4) {
            *(uint4*)(qD + ((size_t)(b * 4 + qc) * SEQ + s) * 128 + 8 * c) = pack8(v.a, v.b);
        } else {
            const F8 pv = f8_shfl_xor(v, 2);
            const int h = (qc - 4) * 2 + (c >> 2);
            *(uint4*)(qD + ((size_t)(b * 4 + h) * SEQ + s) * 128 + 64 + 8 * (c & 3)) = f8_rope_pack(v, pv, cs, sn, (c & 2) ? 1.f : -1.f, 1.f);
        }
    }
};
struct RowsPostKV {
    bf16_t* kD; bf16_t* vD; const float* ssq;
    __device__ __forceinline__ void table(float*, int, int) const {}
    __device__ __forceinline__ void begin(bf16_t* ct, int m0, int, int tid) const {
        if (tid < 256) *(float*)(ct + tid * QST + 256) = rsqrtf((ssq[m0 + tid] + ssq[(size_t)T_TOK + m0 + tid]) * (1.f / 128.f) + 1e-6f);
        __syncthreads();
    }
    __device__ __forceinline__ void prep(int, int, int, const float*& pa, const float*& pb) const { pa = ssq; pb = ssq; }
    __device__ __forceinline__ void chunk(const F8& tv, float r, int m, int n, int c, const F8&, const F8&) const {
        const int qc = n >> 6, h = qc >> 1, b = m / SEQ, s = m % SEQ;
        F8 v = tv;
        v.a.x *= r; v.a.y *= r; v.a.z *= r; v.a.w *= r; v.b.x *= r; v.b.y *= r; v.b.z *= r; v.b.w *= r;
        const size_t hb = (size_t)(b * 4 + h) * SEQ + s;
        const size_t off = (qc & 1) ? hb * 64 : hb * 96;
        bf16_t* base = (bf16_t*)((qc & 1) ? (size_t)vD : (size_t)kD);
        *(uint4*)(base + off + 8 * c) = pack8(v.a, v.b);
    }
};

template <class Epi>
__device__ __forceinline__ void gemm_phase(const bf16_t* X, int ldx, const bf16_t* W, int ldw, int M, int N, int K, char* lds, const Epi& epi) {
    const int ntm = M >> 7, ntn = (N + 127) >> 7, nt_tot = ntm * ntn;
    for (int tile = blockIdx.x; tile < nt_tot; tile += gridDim.x) {
        int mt, nt;
        if ((gridDim.x & 7) == 0 && (gridDim.x >> 3) * 8 == gridDim.x && ((gridDim.x >> 3) & 63) == 0) tile_map(tile, ntm, ntn, mt, nt);
        else { mt = tile / ntn; nt = tile % ntn; }
        if (mt < ntm && nt < ntn) gemm_tile(X, ldx, W, ldw, K, mt * 128, nt * 128, N, lds, epi);
    }
}

template <int OFF> __device__ __forceinline__ s16x4 tr_read(int vb) {
    s16x4 r; asm volatile("ds_read_b64_tr_b16 %0, %1 offset:%2" : "=&v"(r) : "v"(vb), "i"(OFF) : "memory"); return r;
}
#define VS_BYTES 192

template <int KT2>
__device__ __forceinline__ void pv_sub(f32x16 (&o)[2], const f32x16& p, int vbase) {
    bf16x8 pf[2];
#pragma unroll
    for (int s2 = 0; s2 < 2; ++s2) {
        unsigned a = cvtpk(p[8 * s2 + 0], p[8 * s2 + 1]), b = cvtpk(p[8 * s2 + 2], p[8 * s2 + 3]);
        unsigned c = cvtpk(p[8 * s2 + 4], p[8 * s2 + 5]), d = cvtpk(p[8 * s2 + 6], p[8 * s2 + 7]);
        uint4 w = make_uint4(a, b, c, d);
        pf[s2] = *(bf16x8*)&w;
    }
    {
        s16x4 l00 = tr_read<(KT2 * 32 + 0) * VS_BYTES + 0>(vbase), h00 = tr_read<(KT2 * 32 + 8) * VS_BYTES + 0>(vbase);
        s16x4 l01 = tr_read<(KT2 * 32 + 0) * VS_BYTES + 64>(vbase), h01 = tr_read<(KT2 * 32 + 8) * VS_BYTES + 64>(vbase);
        s16x4 l10 = tr_read<(KT2 * 32 + 16) * VS_BYTES + 0>(vbase), h10 = tr_read<(KT2 * 32 + 24) * VS_BYTES + 0>(vbase);
        s16x4 l11 = tr_read<(KT2 * 32 + 16) * VS_BYTES + 64>(vbase), h11 = tr_read<(KT2 * 32 + 24) * VS_BYTES + 64>(vbase);
        asm volatile("s_waitcnt lgkmcnt(0)" ::: "memory");
        __builtin_amdgcn_sched_barrier(0);
#define PKV(L, H) (bf16x8){L[0], L[1], L[2], L[3], H[0], H[1], H[2], H[3]}
        o[0] = __builtin_amdgcn_mfma_f32_32x32x16_bf16(PKV(l00, h00), pf[0], o[0], 0, 0, 0);
        o[1] = __builtin_amdgcn_mfma_f32_32x32x16_bf16(PKV(l01, h01), pf[0], o[1], 0, 0, 0);
        o[0] = __builtin_amdgcn_mfma_f32_32x32x16_bf16(PKV(l10, h10), pf[1], o[0], 0, 0, 0);
        o[1] = __builtin_amdgcn_mfma_f32_32x32x16_bf16(PKV(l11, h11), pf[1], o[1], 0, 0, 0);
#undef PKV
    }
}


#define PV_LOAD(KT2, VB, F) \
    const s16x4 F##0 = tr_read<((KT2) * 32 + 0) * VS_BYTES + 0>(VB), F##1 = tr_read<((KT2) * 32 + 8) * VS_BYTES + 0>(VB), \
                F##2 = tr_read<((KT2) * 32 + 0) * VS_BYTES + 64>(VB), F##3 = tr_read<((KT2) * 32 + 8) * VS_BYTES + 64>(VB), \
                F##4 = tr_read<((KT2) * 32 + 16) * VS_BYTES + 0>(VB), F##5 = tr_read<((KT2) * 32 + 24) * VS_BYTES + 0>(VB), \
                F##6 = tr_read<((KT2) * 32 + 16) * VS_BYTES + 64>(VB), F##7 = tr_read<((KT2) * 32 + 24) * VS_BYTES + 64>(VB)
#define PKV2(L, H) (bf16x8){L[0], L[1], L[2], L[3], H[0], H[1], H[2], H[3]}
#define PV_MMA(O, P, F) do { bf16x8 _pf0, _pf1; \
        { uint4 _w = make_uint4(cvtpk(P[0], P[1]), cvtpk(P[2], P[3]), cvtpk(P[4], P[5]), cvtpk(P[6], P[7])); _pf0 = *(bf16x8*)&_w; } \
        { uint4 _w = make_uint4(cvtpk(P[8], P[9]), cvtpk(P[10], P[11]), cvtpk(P[12], P[13]), cvtpk(P[14], P[15])); _pf1 = *(bf16x8*)&_w; } \
        O[0] = __builtin_amdgcn_mfma_f32_32x32x16_bf16(PKV2(F##0, F##1), _pf0, O[0], 0, 0, 0); \
        O[1] = __builtin_amdgcn_mfma_f32_32x32x16_bf16(PKV2(F##2, F##3), _pf0, O[1], 0, 0, 0); \
        O[0] = __builtin_amdgcn_mfma_f32_32x32x16_bf16(PKV2(F##4, F##5), _pf1, O[0], 0, 0, 0); \
        O[1] = __builtin_amdgcn_mfma_f32_32x32x16_bf16(PKV2(F##6, F##7), _pf1, O[1], 0, 0, 0); } while (0)

template <int DK, int G, bool WINDOW>
__device__ __forceinline__ void attn_item(const bf16_t* __restrict__ Q, const bf16_t* __restrict__ K, const bf16_t* __restrict__ V, const float* __restrict__ sink,
                                          bf16_t* __restrict__ O, int ocol, int H, int KV, int item, char* lds, int qs = DK) {
    constexpr int KS = DK * 2 + 16;
    constexpr int KCH = DK / 8;
    constexpr int KLD = (128 * KCH) / 512;
    constexpr int QB = 256 / G;
    constexpr int NCH = SEQ / QB;
    constexpr int KBUF = 128 * KS, VBUF = 128 * VS_BYTES;
    const int tid = tid_opaque(), lane = tid & 63, wave = tid >> 6;
    const int r32 = lane & 31, hh = lane >> 5;
    const int chunk = item % NCH, kvh = (item / NCH) % KV, b = item / (NCH * KV);
    const int g = (G == 2) ? (wave >> 2) : 0;
    const int qoff = (G == 2) ? (wave & 3) * 32 : wave * 32;
    const int head = kvh * G + g;
    const int q0 = chunk * QB;
    const int qpos = q0 + qoff + r32;
    bf16x8 qf[DK / 16];
    {
        const bf16_t* qp = Q + ((size_t)(b * H + head) * SEQ + qpos) * qs + hh * 8;
#pragma unroll
        for (int ks = 0; ks < DK / 16; ++ks) qf[ks] = *(const bf16x8*)(qp + ks * 16);
    }
    int kt_lo = 0, kt_hi = SEQ / 128;
    if (WINDOW) { kt_lo = q0 / 128 - 1; if (kt_lo < 0) kt_lo = 0; kt_hi = (q0 + QB) / 128 + 1; if (kt_hi > SEQ / 128) kt_hi = SEQ / 128; }
    const char* Kg = (const char*)(K + (size_t)(b * KV + kvh) * SEQ * DK);
    const char* Vg = (const char*)(V + (size_t)(b * KV + kvh) * SEQ * 64);
    uint4 kr0, kr1, kr2 = make_uint4(0, 0, 0, 0), vr0, vr1;
    const int koff0 = (tid / KCH) * KS + (tid % KCH) * 16;
    const int koff1 = ((tid + 512) / KCH) * KS + ((tid + 512) % KCH) * 16;
    const int koff2 = ((tid + 1024) / KCH) * KS + ((tid + 1024) % KCH) * 16;
    const int voff0 = (tid >> 3) * VS_BYTES + (tid & 7) * 16;
    const int voff1 = ((tid + 512) >> 3) * VS_BYTES + (tid & 7) * 16;
    f32x16 o[2];
#pragma unroll
    for (int d = 0; d < 2; ++d)
#pragma unroll
        for (int i = 0; i < 16; ++i) o[d][i] = 0.f;
    float m = -1e30f, l = 0.f;
    if (WINDOW) { m = sink[head] * LOG2E; l = (hh == 0) ? 1.f : 0.f; }
    const int gg = lane >> 4, li = lane & 15;
    const int vlane = (4 * (gg >> 1) + (li >> 2)) * VS_BYTES + (16 * (gg & 1) + 4 * (li & 3)) * 2;
    char* Kl = lds; char* Vl = lds + 2 * KBUF;
#define AGLOAD(KT) do { const char* _kg = Kg + (size_t)(KT) * 128 * DK * 2; const char* _vg = Vg + (size_t)(KT) * 128 * 128; \
        kr0 = *(const uint4*)(_kg + tid * 16); kr1 = *(const uint4*)(_kg + (tid + 512) * 16); if (KLD > 2) kr2 = *(const uint4*)(_kg + (tid + 1024) * 16); \
        vr0 = *(const uint4*)(_vg + tid * 16); vr1 = *(const uint4*)(_vg + (tid + 512) * 16); } while (0)
#define ASTORE(KB, VB) do { char* _kd = (KB); char* _vd = (VB); *(uint4*)(_kd + koff0) = kr0; *(uint4*)(_kd + koff1) = kr1; if (KLD > 2) *(uint4*)(_kd + koff2) = kr2; \
        *(uint4*)(_vd + voff0) = vr0; *(uint4*)(_vd + voff1) = vr1; } while (0)
    AGLOAD(kt_lo);
    ASTORE(Kl, Vl);
    { const int k1 = kt_lo + 1 < kt_hi ? kt_lo + 1 : kt_lo; AGLOAD(k1); }
    __syncthreads();
    for (int kt = kt_lo; kt < kt_hi; ++kt) {
        const int cur = (kt - kt_lo) & 1;
        ASTORE(Kl + (cur ^ 1) * KBUF, Vl + (cur ^ 1) * VBUF);
        { const int ktn = kt + 2 < kt_hi ? kt + 2 : kt_hi - 1; AGLOAD(ktn); }
        __builtin_amdgcn_sched_barrier(0);
#pragma unroll
        for (int sub = 0; sub < 2; ++sub) {
            const char* kb = Kl + cur * KBUF + sub * 64 * KS;
            const float mi = (m < -1e29f) ? 0.f : m;
            f32x16 s0, s1;
#pragma unroll
            for (int i = 0; i < 16; ++i) { s0[i] = -mi; s1[i] = -mi; }
#pragma unroll
            for (int ks = 0; ks < DK / 16; ++ks) {
                bf16x8 k0 = *(const bf16x8*)(kb + r32 * KS + (ks * 2 + hh) * 16);
                bf16x8 k1 = *(const bf16x8*)(kb + (32 + r32) * KS + (ks * 2 + hh) * 16);
                s0 = __builtin_amdgcn_mfma_f32_32x32x16_bf16(k0, qf[ks], s0, 0, 0, 0);
                s1 = __builtin_amdgcn_mfma_f32_32x32x16_bf16(k1, qf[ks], s1, 0, 0, 0);
            }
            if (WINDOW) {
                const int kb0 = kt * 128 + sub * 64 + 4 * hh - qpos;
#pragma unroll
                for (int i = 0; i < 16; ++i) {
                    const int d0 = kb0 + (i & 3) + 8 * (i >> 2), d1 = d0 + 32;
                    s0[i] = (d0 > 128 || d0 < -128) ? -1e30f : s0[i];
                    s1[i] = (d1 > 128 || d1 < -128) ? -1e30f : s1[i];
                }
            }
            const int vbase = (int)(size_t)(Vl + cur * VBUF - lds) + sub * 64 * VS_BYTES + vlane;
            PV_LOAD(0, vbase, vfa);
            PV_LOAD(1, vbase, vfb);
            __builtin_amdgcn_sched_barrier(0);
            float tmax = s0[0];
#pragma unroll
            for (int i = 1; i < 16; ++i) tmax = fmaxf(tmax, s0[i]);
#pragma unroll
            for (int i = 0; i < 16; ++i) tmax = fmaxf(tmax, s1[i]);
            tmax = xhalf_max(tmax);
            float ps = 0.f;
            if (__all(m > -1e29f && tmax <= 8.f)) {
#pragma unroll
                for (int i = 0; i < 16; ++i) { s0[i] = __builtin_amdgcn_exp2f(s0[i]); ps += s0[i]; }
#pragma unroll
                for (int i = 0; i < 16; ++i) { s1[i] = __builtin_amdgcn_exp2f(s1[i]); ps += s1[i]; }
                l += ps;
            } else {
                const float mn = fmaxf(m, mi + tmax);
                const float d = mn - mi;
                const float alpha = __builtin_amdgcn_exp2f(m - mn);
                m = mn;
#pragma unroll
                for (int i = 0; i < 16; ++i) { s0[i] = __builtin_amdgcn_exp2f(s0[i] - d); ps += s0[i]; }
#pragma unroll
                for (int i = 0; i < 16; ++i) { s1[i] = __builtin_amdgcn_exp2f(s1[i] - d); ps += s1[i]; }
                l = l * alpha + ps;
#pragma unroll
                for (int dd = 0; dd < 2; ++dd)
#pragma unroll
                    for (int i = 0; i < 16; ++i) o[dd][i] *= alpha;
            }
            asm volatile("s_waitcnt lgkmcnt(0)" ::: "memory");
            __builtin_amdgcn_sched_barrier(0);
            PV_MMA(o, s0, vfa);
            PV_MMA(o, s1, vfb);
        }
        __syncthreads();
    }
#undef AGLOAD
#undef ASTORE
    l = xhalf_sum(l);
    const float inv = 1.f / l;
    bf16_t* orow = O + (size_t)(b * SEQ + qpos) * DM + ocol + head * 64;
#pragma unroll
    for (int d = 0; d < 2; ++d)
#pragma unroll
        for (int gq = 0; gq < 4; ++gq) {
            uint2 w;
            w.x = cvtpk(o[d][gq * 4 + 0] * inv, o[d][gq * 4 + 1] * inv);
            w.y = cvtpk(o[d][gq * 4 + 2] * inv, o[d][gq * 4 + 3] * inv);
            *(uint2*)(orow + d * 32 + 8 * gq + 4 * hh) = w;
        }
}

__device__ __forceinline__ void dil_wave_item(const bf16_t* __restrict__ Q, const bf16_t* __restrict__ K, const bf16_t* __restrict__ V,
                                              bf16_t* __restrict__ O, int witem, char* wlds, int lds_off) {
    const int lane = tid_opaque() & 63, r32 = lane & 31, hh = lane >> 5;
    const int c = witem & 15, chunk = (witem >> 4) & 15, kvh = (witem >> 8) & 1, b = witem >> 9;
    const int t0 = chunk * 256;
    const int mq = r32 & 15, g = r32 >> 4;
    const int qpos = t0 + 16 * mq + c, head = kvh * 2 + g;
    bf16x8 qf[4];
    {
        const bf16_t* qp = Q + ((size_t)(b * 4 + head) * SEQ + qpos) * 64 + hh * 8;
#pragma unroll
        for (int ks = 0; ks < 4; ++ks) qf[ks] = *(const bf16x8*)(qp + ks * 16);
    }
    const bf16_t* Kg = K + (size_t)(b * 2 + kvh) * SEQ * 64;
    const bf16_t* Vg = V + (size_t)(b * 2 + kvh) * SEQ * 64;
    f32x16 o[2];
#pragma unroll
    for (int d = 0; d < 2; ++d)
#pragma unroll
        for (int i = 0; i < 16; ++i) o[d][i] = 0.f;
    float m = -1e30f, l = 0.f;
    const int gg = lane >> 4, li = lane & 15;
    const int vlane = lds_off + (4 * (gg >> 1) + (li >> 2)) * VS_BYTES + (16 * (gg & 1) + 4 * (li & 3)) * 2;
#define DIL_PARAMS(IT, SH, CC, IDX0, LIM) const int SH = (IT) < 12 ? 0 : ((IT) < 18 ? 2 : 4); const int CC = c & ((1 << SH) - 1); \
        const int IDX0 = (t0 >> SH) - 64 + 32 * ((IT) < 12 ? (IT) : ((IT) < 18 ? (IT) - 12 : (IT) - 18)); const int LIM = SEQ >> SH
#define DIL_LOAD(KF, VR, SH, CC, IDX0, LIM) do { \
        { int _i = IDX0 + r32; _i = _i < 0 ? 0 : (_i >= LIM ? LIM - 1 : _i); const bf16_t* _kp = Kg + (size_t)((_i << SH) + CC) * 64 + hh * 8; \
          KF##0 = *(const bf16x8*)(_kp); KF##1 = *(const bf16x8*)(_kp + 16); KF##2 = *(const bf16x8*)(_kp + 32); KF##3 = *(const bf16x8*)(_kp + 48); } \
        { int _i = IDX0 + (lane >> 3); _i = _i < 0 ? 0 : (_i >= LIM ? LIM - 1 : _i); VR##0 = *(const uint4*)(Vg + (size_t)((_i << SH) + CC) * 64 + (lane & 7) * 8); } \
        { int _i = IDX0 + 8 + (lane >> 3); _i = _i < 0 ? 0 : (_i >= LIM ? LIM - 1 : _i); VR##1 = *(const uint4*)(Vg + (size_t)((_i << SH) + CC) * 64 + (lane & 7) * 8); } \
        { int _i = IDX0 + 16 + (lane >> 3); _i = _i < 0 ? 0 : (_i >= LIM ? LIM - 1 : _i); VR##2 = *(const uint4*)(Vg + (size_t)((_i << SH) + CC) * 64 + (lane & 7) * 8); } \
        { int _i = IDX0 + 24 + (lane >> 3); _i = _i < 0 ? 0 : (_i >= LIM ? LIM - 1 : _i); VR##3 = *(const uint4*)(Vg + (size_t)((_i << SH) + CC) * 64 + (lane & 7) * 8); } } while (0)
    bf16x8 ka0, ka1, ka2, ka3, kb0, kb1, kb2, kb3;
    uint4 va0, va1, va2, va3, vb0, vb1, vb2, vb3;
    { DIL_PARAMS(0, sh0, cc0, ix0, lm0); DIL_LOAD(ka, va, sh0, cc0, ix0, lm0); }
#pragma unroll 1
    for (int it = 0; it < 23; ++it) {
        DIL_PARAMS(it, sh, cc, idx0, lim);
        {
            const int itn = it + 1 < 23 ? it + 1 : 22;
            DIL_PARAMS(itn, shn, ccn, ixn, lmn);
            DIL_LOAD(kb, vb, shn, ccn, ixn, lmn);
        }
        __builtin_amdgcn_sched_barrier(0);
        *(uint4*)(wlds + ((lane >> 3)) * VS_BYTES + (lane & 7) * 16) = va0;
        *(uint4*)(wlds + ((lane >> 3) + 8) * VS_BYTES + (lane & 7) * 16) = va1;
        *(uint4*)(wlds + ((lane >> 3) + 16) * VS_BYTES + (lane & 7) * 16) = va2;
        *(uint4*)(wlds + ((lane >> 3) + 24) * VS_BYTES + (lane & 7) * 16) = va3;
        f32x16 s;
#pragma unroll
        for (int i = 0; i < 16; ++i) s[i] = 0.f;
        s = __builtin_amdgcn_mfma_f32_32x32x16_bf16(ka0, qf[0], s, 0, 0, 0);
        s = __builtin_amdgcn_mfma_f32_32x32x16_bf16(ka1, qf[1], s, 0, 0, 0);
        s = __builtin_amdgcn_mfma_f32_32x32x16_bf16(ka2, qf[2], s, 0, 0, 0);
        s = __builtin_amdgcn_mfma_f32_32x32x16_bf16(ka3, qf[3], s, 0, 0, 0);

        const int qidx = qpos >> sh;
        const int base = idx0 + 4 * hh;
#pragma unroll
        for (int i = 0; i < 16; ++i) {
            const int idx = base + (i & 3) + 8 * (i >> 2);
            const int d = idx - qidx;
            s[i] = (d > 64 || d < -64 || idx < 0 || idx >= lim) ? -1e30f : s[i];
        }
        float tmax = s[0];
#pragma unroll
        for (int i = 1; i < 16; ++i) tmax = fmaxf(tmax, s[i]);
        tmax = fmaxf(tmax, xhalf(tmax));
        const float mn = fmaxf(fmaxf(m, tmax), -1e20f);
        const float alpha = __builtin_amdgcn_exp2f(m - mn);
        m = mn;
        float ps = 0.f;
#pragma unroll
        for (int i = 0; i < 16; ++i) { s[i] = __builtin_amdgcn_exp2f(s[i] - mn); ps += s[i]; }
        l = l * alpha + ps;
#pragma unroll
        for (int d = 0; d < 2; ++d)
#pragma unroll
            for (int i = 0; i < 16; ++i) o[d][i] *= alpha;
        pv_sub<0>(o, s, vlane);
        ka0 = kb0; ka1 = kb1; ka2 = kb2; ka3 = kb3; va0 = vb0; va1 = vb1; va2 = vb2; va3 = vb3;
    }
#undef DIL_PARAMS
#undef DIL_LOAD
    l += xhalf(l);
    const float inv = 1.f / l;
    bf16_t* orow = O + (size_t)(b * SEQ + qpos) * DM + 512 + head * 64;
#pragma unroll
    for (int d = 0; d < 2; ++d)
#pragma unroll
        for (int gq = 0; gq < 4; ++gq) {
            uint2 w;
            w.x = cvtpk(o[d][gq * 4 + 0] * inv, o[d][gq * 4 + 1] * inv);
            w.y = cvtpk(o[d][gq * 4 + 2] * inv, o[d][gq * 4 + 3] * inv);
            *(uint2*)(orow + d * 32 + 8 * gq + 4 * hh) = w;
        }
}

__device__ __forceinline__ int f2key(float f) { int b = __float_as_int(f); return b ^ ((b >> 31) & 0x7fffffff); }
__device__ __forceinline__ float key2f(int k) { return __int_as_float(k ^ ((k >> 31) & 0x7fffffff)); }

template <int N>
__device__ __forceinline__ void bitonic_sort_desc(int (&a)[N]) {
#pragma unroll
    for (int k = 2; k <= N; k <<= 1) {
#pragma unroll
        for (int j = k >> 1; j > 0; j >>= 1) {
#pragma unroll
            for (int i = 0; i < N; ++i) {
                const int l2 = i ^ j;
                if (l2 > i) {
                    const bool up = ((i & k) == 0);
                    const int hi = max(a[i], a[l2]), lo = min(a[i], a[l2]);
                    a[i] = up ? hi : lo; a[l2] = up ? lo : hi;
                }
            }
        }
    }
}
__device__ __forceinline__ void merge_top16(int (&a)[16], const int (&b)[16]) {
#pragma unroll
    for (int i = 0; i < 16; ++i) a[i] = max(a[i], b[15 - i]);
#pragma unroll
    for (int j = 8; j > 0; j >>= 1) {
#pragma unroll
        for (int i = 0; i < 16; ++i) {
            const int l2 = i ^ j;
            if (l2 > i) { const int hi = max(a[i], a[l2]), lo = min(a[i], a[l2]); a[i] = hi; a[l2] = lo; }
        }
    }
}
__device__ __forceinline__ void top16_of_64(int (&g0)[16], int (&g1)[16], int (&g2)[16], int (&g3)[16]) {
    bitonic_sort_desc<16>(g0); bitonic_sort_desc<16>(g1); bitonic_sort_desc<16>(g2); bitonic_sort_desc<16>(g3);
    merge_top16(g0, g1); merge_top16(g2, g3); merge_top16(g0, g2);
}

__device__ __forceinline__ void topk_core(const bf16_t* q0, const bf16_t* __restrict__ subk_h, float rscale, int* eo, float* go, char* wlds) {
    const int lane = tid_opaque() & 63, r32 = lane & 31, hh = lane >> 5;
    int top[2][16];
#pragma unroll
    for (int c = 0; c < 2; ++c) {
        bf16x8 qf[8];
        const bf16_t* qrow = q0 + c * 128;
#pragma unroll
        for (int ks = 0; ks < 8; ++ks) qf[ks] = *(const bf16x8*)(qrow + ks * 16);
        const bf16_t* kb = subk_h + ((size_t)c * 128 + r32) * 128 + hh * 8;
        int grp[4][16];
        bf16x8 kfa[8], kfb[8];
#pragma unroll
        for (int ks = 0; ks < 8; ++ks) kfa[ks] = *(const bf16x8*)(kb + ks * 16);
#pragma unroll
        for (int kt = 0; kt < 4; ++kt) {
            if (kt < 3) {
#pragma unroll
                for (int ks = 0; ks < 8; ++ks) kfb[ks] = *(const bf16x8*)(kb + (size_t)(kt + 1) * 32 * 128 + ks * 16);
            }
            __builtin_amdgcn_sched_barrier(0);
            f32x16 s;
#pragma unroll
            for (int i = 0; i < 16; ++i) s[i] = 0.f;
#pragma unroll
            for (int ks = 0; ks < 8; ++ks) s = __builtin_amdgcn_mfma_f32_32x32x16_bf16(kfa[ks], qf[ks], s, 0, 0, 0);
#pragma unroll
            for (int i = 0; i < 16; ++i) grp[kt][i] = (f2key(s[i]) & ~127) | (kt * 32 + crow(i, hh));
#pragma unroll
            for (int ks = 0; ks < 8; ++ks) kfa[ks] = kfb[ks];
        }
        top16_of_64(grp[0], grp[1], grp[2], grp[3]);
        int oth[16];
#pragma unroll
        for (int i = 0; i < 16; ++i) oth[i] = __shfl_xor(grp[0][i], 32);
        merge_top16(grp[0], oth);
#pragma unroll
        for (int i = 0; i < 16; ++i) top[c][i] = grp[0][i];
    }
    {
        unsigned* my = (unsigned*)(wlds + lane * 36);
#pragma unroll
        for (int c = 0; c < 2; ++c)
#pragma unroll
            for (int w4 = 0; w4 < 4; ++w4) {
                unsigned v = (top[c][w4 * 4] & 127) | ((top[c][w4 * 4 + 1] & 127) << 8) | ((top[c][w4 * 4 + 2] & 127) << 16) | ((top[c][w4 * 4 + 3] & 127) << 24);
                my[c * 4 + w4] = v;
            }
    }
    float v1[16], v2[16];
#pragma unroll
    for (int i = 0; i < 16; ++i) { v1[i] = key2f(top[0][i] & ~127); v2[i] = key2f(top[1][i] & ~127); }
    int cg[4][16];
    {
        int n = 0;
#pragma unroll
        for (int i = 0; i < 16; ++i)
#pragma unroll
            for (int j = 0; j < 16; ++j)
                if ((i + 1) * (j + 1) <= 16) { cg[n >> 4][n & 15] = (f2key(v1[i] + v2[j]) & ~255) | (i * 16 + j); ++n; }
#pragma unroll
        for (int q = 50; q < 64; ++q) cg[q >> 4][q & 15] = (int)0x80000000;
    }
    top16_of_64(cg[0], cg[1], cg[2], cg[3]);
    float bv[16];
#pragma unroll
    for (int i = 0; i < 16; ++i) bv[i] = key2f(cg[0][i] & ~255) * rscale;
    float sm = 0.f;
    const float bmx = bv[0];
#pragma unroll
    for (int i = 0; i < 16; ++i) { bv[i] = __expf(bv[i] - bmx); sm += bv[i]; }
    const float inv = 1.f / sm;
    if (hh == 0) {
        const unsigned char* my = (const unsigned char*)(wlds + lane * 36);
#pragma unroll
        for (int q4 = 0; q4 < 4; ++q4) {
            int4 ev; float4 gv;
            int* evp = (int*)&ev; float* gvp = (float*)&gv;
#pragma unroll
            for (int u = 0; u < 4; ++u) {
                const int code = cg[0][q4 * 4 + u] & 255;
                const int i1 = my[code >> 4], i2 = my[16 + (code & 15)];
                evp[u] = i1 * 128 + i2; gvp[u] = bv[q4 * 4 + u] * inv;
            }
            *(int4*)(eo + q4 * 4) = ev; *(float4*)(go + q4 * 4) = gv;
        }
    }
}

__device__ __forceinline__ void topk_wave_item(const bf16_t* __restrict__ qp, const bf16_t* __restrict__ subk, int* __restrict__ eidx, float* __restrict__ gate, int witem, char* wlds) {
    const int lane = tid_opaque() & 63, r32 = lane & 31, hh = lane >> 5;
    const int h = witem & 7, t = (witem >> 3) * 32 + r32;
    topk_core(qp + (size_t)t * 2048 + h * 256 + hh * 8, subk + (size_t)h * 2 * 128 * 128, 1.f, eidx + ((size_t)h * T_TOK + t) * 16, gate + ((size_t)h * T_TOK + t) * 16, wlds);
}
__device__ __forceinline__ void gemm_tile_topk(const bf16_t* __restrict__ X, int ldx, const bf16_t* __restrict__ W, int ldw, int K, int m0, int h, char* lds,
                                               const bf16_t* __restrict__ subk, const float* __restrict__ ssq, int* __restrict__ eidx, float* __restrict__ gate) {
    const int tid = tid_opaque(), lane = tid & 63, wave = tid >> 6;
    const int wm = wave >> 1, wn = wave & 1;
    const int r32 = lane & 31, hh = lane >> 5;
    {
        f32x16 acc[2][4];
        gemm_mainloop(X, ldx, W, ldw, K, m0, h * 256, 2048, lds, acc);
        bf16_t* qst = (bf16_t*)lds;
#pragma unroll
        for (int mt = 0; mt < 2; ++mt)
#pragma unroll
            for (int nt = 0; nt < 4; ++nt)
#pragma unroll
                for (int i = 0; i < 16; ++i)
                    qst[(wm * 64 + mt * 32 + crow(i, hh)) * QST + wn * 128 + nt * 32 + r32] = f2bf(acc[mt][nt][i]);
    }
    __syncthreads();
    {
        const int tok = wave * 32 + r32, t = m0 + tok;
        float tot = 0.f;
#pragma unroll
        for (int j = 0; j < 4; ++j) { const float4 q = *(const float4*)(ssq + ((size_t)j * T_TOK + t) * 4); tot += (q.x + q.y) + (q.z + q.w); }
        const float r = rsqrtf(tot * (1.f / DM) + 1e-6f);
        topk_core((const bf16_t*)lds + tok * QST + hh * 8, subk + (size_t)h * 2 * 128 * 128, r, eidx + ((size_t)h * T_TOK + t) * 16, gate + ((size_t)h * T_TOK + t) * 16,
                  lds + TOPK_STASH + wave * 2304);
    }
    __syncthreads();
}

typedef __attribute__((ext_vector_type(2))) float f32x2;
__device__ __forceinline__ float fdot2bf(unsigned a, unsigned b, float acc) {
    return __builtin_amdgcn_fdot2_f32_bf16(*(bf16x2_t*)&a, *(bf16x2_t*)&b, acc, false);
}
__device__ __forceinline__ unsigned fp8pair_to_bf16(unsigned w, bool hi) {
    bf16x2_t r = hi ? __builtin_amdgcn_cvt_scalef32_pk_bf16_fp8((int)w, 1.0f, true) : __builtin_amdgcn_cvt_scalef32_pk_bf16_fp8((int)w, 1.0f, false);
    return *(unsigned*)&r;
}
__device__ __forceinline__ float dot16_fp8(uint4 u, const unsigned (&h)[8]) {
    float a = 0.f;
    a = fdot2bf(fp8pair_to_bf16(u.x, false), h[0], a); a = fdot2bf(fp8pair_to_bf16(u.x, true), h[1], a);
    a = fdot2bf(fp8pair_to_bf16(u.y, false), h[2], a); a = fdot2bf(fp8pair_to_bf16(u.y, true), h[3], a);
    a = fdot2bf(fp8pair_to_bf16(u.z, false), h[4], a); a = fdot2bf(fp8pair_to_bf16(u.z, true), h[5], a);
    a = fdot2bf(fp8pair_to_bf16(u.w, false), h[6], a); a = fdot2bf(fp8pair_to_bf16(u.w, true), h[7], a);
    return a;
}
__device__ __forceinline__ void axpy16_fp8(float (&acc)[16], float w, uint4 v) {
    f32x2 r;
    r = __builtin_amdgcn_cvt_pk_f32_fp8((int)v.x, false); acc[0] += w * r[0]; acc[1] += w * r[1];
    r = __builtin_amdgcn_cvt_pk_f32_fp8((int)v.x, true);  acc[2] += w * r[0]; acc[3] += w * r[1];
    r = __builtin_amdgcn_cvt_pk_f32_fp8((int)v.y, false); acc[4] += w * r[0]; acc[5] += w * r[1];
    r = __builtin_amdgcn_cvt_pk_f32_fp8((int)v.y, true);  acc[6] += w * r[0]; acc[7] += w * r[1];
    r = __builtin_amdgcn_cvt_pk_f32_fp8((int)v.z, false); acc[8] += w * r[0]; acc[9] += w * r[1];
    r = __builtin_amdgcn_cvt_pk_f32_fp8((int)v.z, true);  acc[10] += w * r[0]; acc[11] += w * r[1];
    r = __builtin_amdgcn_cvt_pk_f32_fp8((int)v.w, false); acc[12] += w * r[0]; acc[13] += w * r[1];
    r = __builtin_amdgcn_cvt_pk_f32_fp8((int)v.w, true);  acc[14] += w * r[0]; acc[15] += w * r[1];
}
__device__ __forceinline__ float gelu_exact(float a) { return 0.5f * a * (1.f + erff(a * 0.70710678118654752f)); }

__device__ __forceinline__ float transpose_reduce16(f32x16 p, int lane) {
#pragma unroll
    for (int st = 0; st < 4; ++st) {
        const int o = 32 >> st, n = 16 >> st;
        const bool up = (lane & o) != 0;
#pragma unroll
        for (int i = 0; i < n / 2; ++i) {
            float lo = p[i], hi = p[i + n / 2];
            asm volatile("" : "+v"(lo), "+v"(hi));
            const float keep = up ? hi : lo;
            const float send = up ? lo : hi;
            p[i] = keep + __shfl_xor(send, o);
        }
    }
    float v = p[0];
    v += __shfl_xor(v, 1); v += __shfl_xor(v, 2);
    return v;
}
#define EX_SB() __builtin_amdgcn_sched_barrier(0)
#define EX_LD1(R, TAB, EB, S) R = *(const uint4*)((TAB) + (unsigned)((__builtin_amdgcn_readlane((EB), (S)) << 10) + lane16))
#define EX_LOAD8(P, TAB, EB, SL) do { EX_LD1(P##0, TAB, EB, (SL) + 0); EX_LD1(P##1, TAB, EB, (SL) + 1); EX_LD1(P##2, TAB, EB, (SL) + 2); EX_LD1(P##3, TAB, EB, (SL) + 3); \
        EX_LD1(P##4, TAB, EB, (SL) + 4); EX_LD1(P##5, TAB, EB, (SL) + 5); EX_LD1(P##6, TAB, EB, (SL) + 6); EX_LD1(P##7, TAB, EB, (SL) + 7); } while (0)
#define EX_DOT8(P, PP, O) do { PP[(O) + 0] = dot16_fp8(P##0, hp); PP[(O) + 1] = dot16_fp8(P##1, hp); PP[(O) + 2] = dot16_fp8(P##2, hp); PP[(O) + 3] = dot16_fp8(P##3, hp); \
        PP[(O) + 4] = dot16_fp8(P##4, hp); PP[(O) + 5] = dot16_fp8(P##5, hp); PP[(O) + 6] = dot16_fp8(P##6, hp); PP[(O) + 7] = dot16_fp8(P##7, hp); } while (0)
#define EX_RL(W, S) __int_as_float(__builtin_amdgcn_readlane(__float_as_int(W), (S)))
#define EX_AXPY8(P, W, SL) do { axpy16_fp8(acc, EX_RL(W, (SL) + 0), P##0); axpy16_fp8(acc, EX_RL(W, (SL) + 1), P##1); axpy16_fp8(acc, EX_RL(W, (SL) + 2), P##2); axpy16_fp8(acc, EX_RL(W, (SL) + 3), P##3); \
        axpy16_fp8(acc, EX_RL(W, (SL) + 4), P##4); axpy16_fp8(acc, EX_RL(W, (SL) + 5), P##5); axpy16_fp8(acc, EX_RL(W, (SL) + 6), P##6); axpy16_fp8(acc, EX_RL(W, (SL) + 7), P##7); } while (0)
#define EX_COPY8(D, S_) do { D##0 = S_##0; D##1 = S_##1; D##2 = S_##2; D##3 = S_##3; D##4 = S_##4; D##5 = S_##5; D##6 = S_##6; D##7 = S_##7; } while (0)

#ifndef EXS_NS
#define EXS_NS 16
#endif
#ifndef EXS_SYNC
#define EXS_SYNC 1
#endif
__device__ __forceinline__ int ex_mbcnt(unsigned long long m) { return __builtin_amdgcn_mbcnt_hi((unsigned)(m >> 32), __builtin_amdgcn_mbcnt_lo((unsigned)m, 0u)); }
__device__ __forceinline__ void xcd_local_sync_p(char* st);
__device__ __forceinline__ void expert_token(PC& p, int layer, int t, bool last, int2* lst, char* syncp, bool dummy = false) {
    const int lane = tid_opaque() & 63;
    const int lane16 = lane * 16;
    const float* gfb = p.g_ffn + layer * DM; asm volatile("" : "+s"(gfb));
    const float* gf = gfb + lane * 16;
    float* xrow = p.x + (size_t)t * DM + lane * 16;
    float* xwr = dummy ? (float*)p.zb + (size_t)t * DM + lane * 16 : xrow;
    bf16_t* hwr = (dummy ? p.q.qA + (size_t)t * DM : p.hnb + (size_t)t * DM) + lane * 16;
    float xv[16];
#pragma unroll
    for (int q = 0; q < 4; ++q) { const float4 a = *(const float4*)(xrow + 4 * q); xv[4 * q] = a.x; xv[4 * q + 1] = a.y; xv[4 * q + 2] = a.z; xv[4 * q + 3] = a.w; }
    float ss = 0.f;
#pragma unroll
    for (int i = 0; i < 16; ++i) ss += xv[i] * xv[i];
    ss = wave_sum(ss);
    const float rstd = rsqrtf(ss * (1.f / DM) + 1e-6f);
    unsigned hp[8];
#pragma unroll
    for (int q = 0; q < 4; ++q) {
        const float4 g = *(const float4*)(gf + 4 * q);
        hp[2 * q] = cvtpk(xv[4 * q] * rstd * g.x, xv[4 * q + 1] * rstd * g.y);
        hp[2 * q + 1] = cvtpk(xv[4 * q + 2] * rstd * g.z, xv[4 * q + 3] * rstd * g.w);
    }
    const size_t ei0 = ((size_t)(lane >> 4) * T_TOK + t) * 16 + (lane & 15), ei1 = ei0 + (size_t)4 * T_TOK * 16;
    int e0 = p.eidx[ei0], e1 = p.eidx[ei1];
    float g0 = p.gate[ei0], g1 = p.gate[ei1];
    {
        const int s0 = ((e0 >> 7) + e0) & (EXS_NS - 1), s1 = ((e1 >> 7) + e1) & (EXS_NS - 1);
        int base = 0, pos0 = 0, pos1 = 0;
#pragma unroll
        for (int s = 0; s < EXS_NS; ++s) {
            const unsigned long long m0 = __ballot(s0 == s), m1 = __ballot(s1 == s);
            const int c0 = __popcll(m0);
            pos0 = (s0 == s) ? base + ex_mbcnt(m0) : pos0;
            pos1 = (s1 == s) ? base + c0 + ex_mbcnt(m1) : pos1;
            base += c0 + __popcll(m1);
        }
        lst[pos0] = make_int2(e0, __float_as_int(g0)); lst[pos1] = make_int2(e1, __float_as_int(g1));
        const int2 q0 = lst[lane], q1 = lst[64 + lane];
        e0 = q0.x; g0 = __int_as_float(q0.y); e1 = q1.x; g1 = __int_as_float(q1.y);
    }
    const unsigned char* u8 = p.u8 + (size_t)layer * 16384 * DM;
    const unsigned char* v8 = p.v8 + (size_t)layer * 16384 * DM;
    const float* su = p.su + layer * 16384; const float* sv = p.sv + layer * 16384;
    const float su0 = su[e0], su1 = su[e1], sv0 = sv[e0], sv1 = sv[e1];
    uint4 rx0, rx1, rx2, rx3, rx4, rx5, rx6, rx7, ry0, ry1, ry2, ry3, ry4, ry5, ry6, ry7;
    float a0 = 0.f, a1 = 0.f;
    EX_LOAD8(rx, u8, e0, 0);
#pragma unroll 1
    for (int g = 0; g < 8; ++g) {
        const int eb = g < 4 ? e0 : e1;
        const int sl = (g & 3) * 16;
        f32x16 pp;
        EX_LOAD8(ry, u8, eb, sl + 8);
        EX_SB();
        EX_DOT8(rx, pp, 0);
        EX_SB();
        {
            const int gn = g + 1 < 8 ? g + 1 : 0;
            const int ebn = gn < 4 ? e0 : e1;
            const unsigned char* tabn = g + 1 < 8 ? u8 : v8;
            EX_LOAD8(rx, tabn, ebn, (gn & 3) * 16);
        }
        EX_SB();
        EX_DOT8(ry, pp, 8);
        const float v = transpose_reduce16(pp, lane);
        const float got = __shfl(v, (lane & 15) << 2);
        const bool mine = (lane >> 4) == (g & 3);
        a0 = (mine && g < 4) ? got : a0;
        a1 = (mine && g >= 4) ? got : a1;
        EX_SB();
    }
#if EXS_SYNC >= 2
    if (syncp) xcd_local_sync_p(syncp);
#endif
    const float w0 = g0 * gelu_exact(su0 * a0) * sv0;
    const float w1 = g1 * gelu_exact(su1 * a1) * sv1;
    float acc[16];
#pragma unroll
    for (int i = 0; i < 16; ++i) acc[i] = 0.f;
#pragma unroll 1
    for (int h2 = 0; h2 < 8; ++h2) {
        const int ebc = h2 < 4 ? e0 : e1;
        const float wb = h2 < 4 ? w0 : w1;
        const int slc = (h2 & 3) * 16;
        EX_LOAD8(ry, v8, ebc, slc + 8);
        EX_SB();
        EX_AXPY8(rx, wb, slc);
        EX_SB();
        {
            const int hn_ = h2 + 1 < 8 ? h2 + 1 : 7;
            const int ebn = hn_ < 4 ? e0 : e1;
            EX_LOAD8(rx, v8, ebn, (hn_ & 3) * 16);
        }
        EX_SB();
        EX_AXPY8(ry, wb, slc + 8);
        EX_SB();
    }
#pragma unroll
    for (int i = 0; i < 16; ++i) xv[i] += acc[i];
    float s2 = 0.f;
#pragma unroll
    for (int i = 0; i < 16; ++i) s2 += xv[i] * xv[i];
    s2 = wave_sum(s2);
    const float r2 = rsqrtf(s2 * (1.f / DM) + 1e-6f);
    if (!last) {
#pragma unroll
        for (int q = 0; q < 4; ++q) *(float4*)(xwr + 4 * q) = make_float4(xv[4 * q], xv[4 * q + 1], xv[4 * q + 2], xv[4 * q + 3]);
        const float* gnb = p.g_mix + (layer + 1) * DM; asm volatile("" : "+s"(gnb));
        const float* gn = gnb + lane * 16;
        unsigned hw[8];
#pragma unroll
        for (int q = 0; q < 4; ++q) {
            const float4 g = *(const float4*)(gn + 4 * q);
            hw[2 * q] = cvtpk(xv[4 * q] * r2 * g.x, xv[4 * q + 1] * r2 * g.y);
            hw[2 * q + 1] = cvtpk(xv[4 * q + 2] * r2 * g.z, xv[4 * q + 3] * r2 * g.w);
        }
        *(uint4*)(hwr) = make_uint4(hw[0], hw[1], hw[2], hw[3]);
        *(uint4*)(hwr + 8) = make_uint4(hw[4], hw[5], hw[6], hw[7]);
    } else {
        const float* gnb = p.g_final; asm volatile("" : "+s"(gnb));
        const float* gn = gnb + lane * 16;
        float* orow = dummy ? xwr : p.out + (size_t)t * DM + lane * 16;
#pragma unroll
        for (int q = 0; q < 4; ++q) {
            const float4 g = *(const float4*)(gn + 4 * q);
            *(float4*)(orow + 4 * q) = make_float4(xv[4 * q] * r2 * g.x, xv[4 * q + 1] * r2 * g.y, xv[4 * q + 2] * r2 * g.z, xv[4 * q + 3] * r2 * g.w);
        }
    }
}

#define EX_DOT8H(P, PP, O, HP) do { PP[(O) + 0] = dot16_fp8(P##0, HP); PP[(O) + 1] = dot16_fp8(P##1, HP); PP[(O) + 2] = dot16_fp8(P##2, HP); PP[(O) + 3] = dot16_fp8(P##3, HP); \
        PP[(O) + 4] = dot16_fp8(P##4, HP); PP[(O) + 5] = dot16_fp8(P##5, HP); PP[(O) + 6] = dot16_fp8(P##6, HP); PP[(O) + 7] = dot16_fp8(P##7, HP); } while (0)
#define EX_AXPY8A(P, W, SL, ACC) do { axpy16_fp8(ACC, EX_RL(W, (SL) + 0), P##0); axpy16_fp8(ACC, EX_RL(W, (SL) + 1), P##1); axpy16_fp8(ACC, EX_RL(W, (SL) + 2), P##2); axpy16_fp8(ACC, EX_RL(W, (SL) + 3), P##3); \
        axpy16_fp8(ACC, EX_RL(W, (SL) + 4), P##4); axpy16_fp8(ACC, EX_RL(W, (SL) + 5), P##5); axpy16_fp8(ACC, EX_RL(W, (SL) + 6), P##6); axpy16_fp8(ACC, EX_RL(W, (SL) + 7), P##7); } while (0)
__device__ __forceinline__ void ex2_begin(PC& p, int layer, int t, int lane, int2* lst, float (&xv)[16], unsigned (&hp)[8], int& e0, int& e1, float& g0, float& g1) {
    const float* gfb = p.g_ffn + layer * DM; asm volatile("" : "+s"(gfb));
    const float* gf = gfb + lane * 16;
    const float* xrow = p.x + (size_t)t * DM + lane * 16;
#pragma unroll
    for (int q = 0; q < 4; ++q) { const float4 a = *(const float4*)(xrow + 4 * q); xv[4 * q] = a.x; xv[4 * q + 1] = a.y; xv[4 * q + 2] = a.z; xv[4 * q + 3] = a.w; }
    float ss = 0.f;
#pragma unroll
    for (int i = 0; i < 16; ++i) ss += xv[i] * xv[i];
    ss = wave_sum(ss);
    const float rstd = rsqrtf(ss * (1.f / DM) + 1e-6f);
#pragma unroll
    for (int q = 0; q < 4; ++q) {
        const float4 g = *(const float4*)(gf + 4 * q);
        hp[2 * q] = cvtpk(xv[4 * q] * rstd * g.x, xv[4 * q + 1] * rstd * g.y);
        hp[2 * q + 1] = cvtpk(xv[4 * q + 2] * rstd * g.z, xv[4 * q + 3] * rstd * g.w);
    }
    const size_t ei0 = ((size_t)(lane >> 4) * T_TOK + t) * 16 + (lane & 15), ei1 = ei0 + (size_t)4 * T_TOK * 16;
    e0 = p.eidx[ei0]; e1 = p.eidx[ei1];
    g0 = p.gate[ei0]; g1 = p.gate[ei1];
    const int s0 = ((e0 >> 7) + e0) & (EXS_NS - 1), s1 = ((e1 >> 7) + e1) & (EXS_NS - 1);
    int base = 0, pos0 = 0, pos1 = 0;
#pragma unroll
    for (int s = 0; s < EXS_NS; ++s) {
        const unsigned long long m0 = __ballot(s0 == s), m1 = __ballot(s1 == s);
        const int c0 = __popcll(m0);
        pos0 = (s0 == s) ? base + ex_mbcnt(m0) : pos0;
        pos1 = (s1 == s) ? base + c0 + ex_mbcnt(m1) : pos1;
        base += c0 + __popcll(m1);
    }
    lst[pos0] = make_int2(e0, __float_as_int(g0)); lst[pos1] = make_int2(e1, __float_as_int(g1));
    const int2 q0 = lst[lane], q1 = lst[64 + lane];
    e0 = q0.x; g0 = __int_as_float(q0.y); e1 = q1.x; g1 = __int_as_float(q1.y);
}
__device__ __forceinline__ void ex2_end(PC& p, int layer, int t, int lane, bool last, bool dummy, float (&xv)[16], const float (&acc)[16]) {
    float* xwr = (dummy ? (float*)p.zb : p.x) + (size_t)t * DM + lane * 16;
    bf16_t* hwr = (dummy ? p.q.qA + (size_t)t * DM : p.hnb + (size_t)t * DM) + lane * 16;
#pragma unroll
    for (int i = 0; i < 16; ++i) xv[i] += acc[i];
    float s2 = 0.f;
#pragma unroll
    for (int i = 0; i < 16; ++i) s2 += xv[i] * xv[i];
    s2 = wave_sum(s2);
    const float r2 = rsqrtf(s2 * (1.f / DM) + 1e-6f);
    if (!last) {
#pragma unroll
        for (int q = 0; q < 4; ++q) *(float4*)(xwr + 4 * q) = make_float4(xv[4 * q], xv[4 * q + 1], xv[4 * q + 2], xv[4 * q + 3]);
        const float* gnb = p.g_mix + (layer + 1) * DM; asm volatile("" : "+s"(gnb));
        const float* gn = gnb + lane * 16;
        unsigned hw[8];
#pragma unroll
        for (int q = 0; q < 4; ++q) {
            const float4 g = *(const float4*)(gn + 4 * q);
            hw[2 * q] = cvtpk(xv[4 * q] * r2 * g.x, xv[4 * q + 1] * r2 * g.y);
            hw[2 * q + 1] = cvtpk(xv[4 * q + 2] * r2 * g.z, xv[4 * q + 3] * r2 * g.w);
        }
        *(uint4*)(hwr) = make_uint4(hw[0], hw[1], hw[2], hw[3]);
        *(uint4*)(hwr + 8) = make_uint4(hw[4], hw[5], hw[6], hw[7]);
    } else {
        const float* gnb = p.g_final; asm volatile("" : "+s"(gnb));
        const float* gn = gnb + lane * 16;
        float* orow = dummy ? xwr : p.out + (size_t)t * DM + lane * 16;
#pragma unroll
        for (int q = 0; q < 4; ++q) {
            const float4 g = *(const float4*)(gn + 4 * q);
            *(float4*)(orow + 4 * q) = make_float4(xv[4 * q] * r2 * g.x, xv[4 * q + 1] * r2 * g.y, xv[4 * q + 2] * r2 * g.z, xv[4 * q + 3] * r2 * g.w);
        }
    }
}
__device__ __forceinline__ void expert_token2(PC& p, int layer, int tA, int tB, bool last, int2* lst, bool dummy) {
    const int lane = tid_opaque() & 63;
    const int lane16 = lane * 16;
    float xvA[16], xvB[16]; unsigned hpA[8], hpB[8];
    int e0A, e1A, e0B, e1B; float g0A, g1A, g0B, g1B;
    ex2_begin(p, layer, tA, lane, lst, xvA, hpA, e0A, e1A, g0A, g1A);
    EX_SB();
    ex2_begin(p, layer, tB, lane, lst + 128, xvB, hpB, e0B, e1B, g0B, g1B);
    EX_SB();
    const unsigned char* u8 = p.u8 + (size_t)layer * 16384 * DM;
    const unsigned char* v8 = p.v8 + (size_t)layer * 16384 * DM;
    const float* su = p.su + layer * 16384; const float* sv = p.sv + layer * 16384;
    const float su0A = su[e0A], su1A = su[e1A], sv0A = sv[e0A], sv1A = sv[e1A];
    const float su0B = su[e0B], su1B = su[e1B], sv0B = sv[e0B], sv1B = sv[e1B];
    uint4 rx0, rx1, rx2, rx3, rx4, rx5, rx6, rx7, ry0, ry1, ry2, ry3, ry4, ry5, ry6, ry7;
    float a0A = 0.f, a1A = 0.f, a0B = 0.f, a1B = 0.f;
    EX_LOAD8(rx, u8, e0A, 0);
#pragma unroll 1
    for (int g = 0; g < 8; ++g) {
        const int ebA = g < 4 ? e0A : e1A, ebB = g < 4 ? e0B : e1B;
        const int sl = (g & 3) * 16;
        const bool mine = (lane >> 4) == (g & 3);
        f32x16 pp;
        EX_LOAD8(ry, u8, ebA, sl + 8);
        EX_SB();
        EX_DOT8H(rx, pp, 0, hpA);
        EX_SB();
        EX_LOAD8(rx, u8, ebB, sl);
        EX_SB();
        EX_DOT8H(ry, pp, 8, hpA);
        {
            const float v = transpose_reduce16(pp, lane);
            const float got = __shfl(v, (lane & 15) << 2);
            a0A = (mine && g < 4) ? got : a0A;
            a1A = (mine && g >= 4) ? got : a1A;
        }
        EX_SB();
        EX_LOAD8(ry, u8, ebB, sl + 8);
        EX_SB();
        EX_DOT8H(rx, pp, 0, hpB);
        EX_SB();
        {
            const int gn = g + 1 < 8 ? g + 1 : 0;
            const int ebn = gn < 4 ? e0A : e1A;
            const unsigned char* tabn = g + 1 < 8 ? u8 : v8;
            EX_LOAD8(rx, tabn, ebn, (gn & 3) * 16);
        }
        EX_SB();
        EX_DOT8H(ry, pp, 8, hpB);
        {
            const float v = transpose_reduce16(pp, lane);
            const float got = __shfl(v, (lane & 15) << 2);
            a0B = (mine && g < 4) ? got : a0B;
            a1B = (mine && g >= 4) ? got : a1B;
        }
        EX_SB();
    }
    const float w0A = g0A * gelu_exact(su0A * a0A) * sv0A, w1A = g1A * gelu_exact(su1A * a1A) * sv1A;
    const float w0B = g0B * gelu_exact(su0B * a0B) * sv0B, w1B = g1B * gelu_exact(su1B * a1B) * sv1B;
    float accA[16], accB[16];
#pragma unroll
    for (int i = 0; i < 16; ++i) { accA[i] = 0.f; accB[i] = 0.f; }
#pragma unroll 1
    for (int h2 = 0; h2 < 8; ++h2) {
        const int ebcA = h2 < 4 ? e0A : e1A, ebcB = h2 < 4 ? e0B : e1B;
        const float wbA = h2 < 4 ? w0A : w1A, wbB = h2 < 4 ? w0B : w1B;
        const int slc = (h2 & 3) * 16;
        EX_LOAD8(ry, v8, ebcA, slc + 8);
        EX_SB();
        EX_AXPY8A(rx, wbA, slc, accA);
        EX_SB();
        EX_LOAD8(rx, v8, ebcB, slc);
        EX_SB();
        EX_AXPY8A(ry, wbA, slc + 8, accA);
        EX_SB();
        EX_LOAD8(ry, v8, ebcB, slc + 8);
        EX_SB();
        EX_AXPY8A(rx, wbB, slc, accB);
        EX_SB();
        {
            const int hn_ = h2 + 1 < 8 ? h2 + 1 : 7;
            const int ebn = hn_ < 4 ? e0A : e1A;
            EX_LOAD8(rx, v8, ebn, (hn_ & 3) * 16);
        }
        EX_SB();
        EX_AXPY8A(ry, wbB, slc + 8, accB);
        EX_SB();
    }
    ex2_end(p, layer, tA, lane, last, dummy, xvA, accA);
    EX_SB();
    ex2_end(p, layer, tB, lane, last, dummy, xvB, accB);
}
__device__ __forceinline__ void transpose_tile(const float* __restrict__ src, int K, int N, bf16_t* __restrict__ dst, int tk, int tn, float* tl, const float* __restrict__ ksc, int perm) {
    const int tid = tid_opaque(), r = tid >> 6, c = tid & 63;
    const int k0 = tk * 64, n0 = tn * 64;
#pragma unroll
    for (int i = 0; i < 8; ++i) {
        const int kk = i * 8 + r, n = n0 + c;
        tl[kk * 65 + c] = (n < N) ? src[(size_t)(k0 + kk) * N + n] : 0.f;
    }
    __syncthreads();
#pragma unroll
    for (int i = 0; i < 8; ++i) {
        const int nn = i * 8 + r;
        if (n0 + nn < N) {
            int nd = n0 + nn;
            if (perm) { const int hq = nd / 96, wq = nd % 96; nd = wq < 64 ? hq * 64 + wq : 256 + hq * 32 + (wq - 64); }
            dst[(size_t)nd * K + k0 + c] = f2bf(tl[c * 65 + nn] * (ksc ? ksc[k0 + c] : 1.f));
        }
    }
    __syncthreads();
}
__device__ __forceinline__ void transpose_all(const float* src, int K, int N, bf16_t* dst, float* tl, const float* ksc = nullptr, int perm = 0) {
    const int ntk = K / 64, ntn = (N + 63) / 64;
    for (int t = blockIdx.x; t < ntk * ntn; t += gridDim.x) transpose_tile(src, K, N, dst, t / ntn, t % ntn, tl, ksc, perm);
}
__device__ __forceinline__ void convert_plain(const float* __restrict__ src, bf16_t* __restrict__ dst, size_t n) {
    const size_t n8 = n >> 3;
    for (size_t i = (size_t)blockIdx.x * blockDim.x + tid_opaque(); i < n8; i += (size_t)gridDim.x * blockDim.x) {
        const float4 a = *(const float4*)(src + i * 8), b = *(const float4*)(src + i * 8 + 4);
        uint4 w; w.x = cvtpk(a.x, a.y); w.y = cvtpk(a.z, a.w); w.z = cvtpk(b.x, b.y); w.w = cvtpk(b.z, b.w);
        *(uint4*)(dst + i * 8) = w;
    }
}
__device__ __forceinline__ void convert_rows_fp8(const float* __restrict__ src, unsigned char* __restrict__ dst, float* __restrict__ scales, int nrows) {
    const int tid = tid_opaque(), wave = tid >> 6, lane = tid & 63;
    const int stride = gridDim.x * NW;
    for (int row0 = blockIdx.x * NW + wave; row0 < nrows; row0 += 4 * stride) {
        float4 xv[4][4];
#pragma unroll
        for (int u = 0; u < 4; ++u) {
            int row = row0 + u * stride; row = row < nrows ? row : row0;
            const float* sr = src + (size_t)row * DM + lane * 16;
#pragma unroll
            for (int q = 0; q < 4; ++q) xv[u][q] = *(const float4*)(sr + 4 * q);
        }
#pragma unroll
        for (int u = 0; u < 4; ++u) {
            const int row = row0 + u * stride;
            float am = 0.f;
#pragma unroll
            for (int q = 0; q < 4; ++q) am = fmaxf(fmaxf(am, fmaxf(fabsf(xv[u][q].x), fabsf(xv[u][q].y))), fmaxf(fabsf(xv[u][q].z), fabsf(xv[u][q].w)));
            am = wave_max(am);
            const float sc = am > 0.f ? am * (1.f / 448.f) : 1.f;
            const float inv = 1.f / sc;
            unsigned w[4];
#pragma unroll
            for (int q = 0; q < 4; ++q) {
                int t = 0;
                t = __builtin_amdgcn_cvt_pk_fp8_f32(xv[u][q].x * inv, xv[u][q].y * inv, t, false);
                t = __builtin_amdgcn_cvt_pk_fp8_f32(xv[u][q].z * inv, xv[u][q].w * inv, t, true);
                w[q] = (unsigned)t;
            }
            if (row < nrows) {
                *(uint4*)(dst + (size_t)row * DM + lane * 16) = make_uint4(w[0], w[1], w[2], w[3]);
                if (lane == 0) scales[row] = sc;
            }
        }
    }
}
__device__ __forceinline__ void rms_row_bf16(const float* __restrict__ src, const float* __restrict__ g, bf16_t* __restrict__ dst, float* __restrict__ cpy, int lane) {
    float xv[16];
    const float4 a0 = *(const float4*)(src + lane * 8), a1 = *(const float4*)(src + lane * 8 + 4);
    const float4 b0 = *(const float4*)(src + 512 + lane * 8), b1 = *(const float4*)(src + 512 + lane * 8 + 4);
    xv[0] = a0.x; xv[1] = a0.y; xv[2] = a0.z; xv[3] = a0.w; xv[4] = a1.x; xv[5] = a1.y; xv[6] = a1.z; xv[7] = a1.w;
    xv[8] = b0.x; xv[9] = b0.y; xv[10] = b0.z; xv[11] = b0.w; xv[12] = b1.x; xv[13] = b1.y; xv[14] = b1.z; xv[15] = b1.w;
    if (cpy) {
        *(float4*)(cpy + lane * 8) = a0; *(float4*)(cpy + lane * 8 + 4) = a1;
        *(float4*)(cpy + 512 + lane * 8) = b0; *(float4*)(cpy + 512 + lane * 8 + 4) = b1;
    }
    float ss = 0.f;
#pragma unroll
    for (int i = 0; i < 16; ++i) ss += xv[i] * xv[i];
    ss = wave_sum(ss);
    const float r = rsqrtf(ss * (1.f / DM) + 1e-6f);
    const float4 g0 = *(const float4*)(g + lane * 8), g1 = *(const float4*)(g + lane * 8 + 4);
    const float4 g2 = *(const float4*)(g + 512 + lane * 8), g3 = *(const float4*)(g + 512 + lane * 8 + 4);
    uint4 wa, wb;
    wa.x = cvtpk(xv[0] * r * g0.x, xv[1] * r * g0.y); wa.y = cvtpk(xv[2] * r * g0.z, xv[3] * r * g0.w);
    wa.z = cvtpk(xv[4] * r * g1.x, xv[5] * r * g1.y); wa.w = cvtpk(xv[6] * r * g1.z, xv[7] * r * g1.w);
    wb.x = cvtpk(xv[8] * r * g2.x, xv[9] * r * g2.y); wb.y = cvtpk(xv[10] * r * g2.z, xv[11] * r * g2.w);
    wb.z = cvtpk(xv[12] * r * g3.x, xv[13] * r * g3.y); wb.w = cvtpk(xv[14] * r * g3.z, xv[15] * r * g3.w);
    *(uint4*)(dst + lane * 8) = wa; *(uint4*)(dst + 512 + lane * 8) = wb;
}

__device__ __forceinline__ void rms_row2_bf16(const float* __restrict__ s0, const float* __restrict__ s1, const float* __restrict__ g, bf16_t* __restrict__ d0, bf16_t* __restrict__ d1, int lane) {
    float4 a[4], b[4];
#pragma unroll
    for (int q = 0; q < 4; ++q) { a[q] = *(const float4*)(s0 + (q >> 1) * 512 + lane * 8 + (q & 1) * 4); b[q] = s1 ? *(const float4*)(s1 + (q >> 1) * 512 + lane * 8 + (q & 1) * 4) : make_float4(0.f, 0.f, 0.f, 0.f); }
    float sa = 0.f, sb = 0.f;
#pragma unroll
    for (int q = 0; q < 4; ++q) { sa += a[q].x * a[q].x + a[q].y * a[q].y + a[q].z * a[q].z + a[q].w * a[q].w; sb += b[q].x * b[q].x + b[q].y * b[q].y + b[q].z * b[q].z + b[q].w * b[q].w; }
    sa = wave_sum(sa); sb = wave_sum(sb);
    const float ra = rsqrtf(sa * (1.f / DM) + 1e-6f), rb = rsqrtf(sb * (1.f / DM) + 1e-6f);
    float4 gq[4];
#pragma unroll
    for (int q = 0; q < 4; ++q) gq[q] = *(const float4*)(g + (q >> 1) * 512 + lane * 8 + (q & 1) * 4);
    uint4 w;
    w.x = cvtpk(a[0].x * ra * gq[0].x, a[0].y * ra * gq[0].y); w.y = cvtpk(a[0].z * ra * gq[0].z, a[0].w * ra * gq[0].w);
    w.z = cvtpk(a[1].x * ra * gq[1].x, a[1].y * ra * gq[1].y); w.w = cvtpk(a[1].z * ra * gq[1].z, a[1].w * ra * gq[1].w);
    *(uint4*)(d0 + lane * 8) = w;
    w.x = cvtpk(a[2].x * ra * gq[2].x, a[2].y * ra * gq[2].y); w.y = cvtpk(a[2].z * ra * gq[2].z, a[2].w * ra * gq[2].w);
    w.z = cvtpk(a[3].x * ra * gq[3].x, a[3].y * ra * gq[3].y); w.w = cvtpk(a[3].z * ra * gq[3].z, a[3].w * ra * gq[3].w);
    *(uint4*)(d0 + 512 + lane * 8) = w;
    if (s1) {
        w.x = cvtpk(b[0].x * rb * gq[0].x, b[0].y * rb * gq[0].y); w.y = cvtpk(b[0].z * rb * gq[0].z, b[0].w * rb * gq[0].w);
        w.z = cvtpk(b[1].x * rb * gq[1].x, b[1].y * rb * gq[1].y); w.w = cvtpk(b[1].z * rb * gq[1].z, b[1].w * rb * gq[1].w);
        *(uint4*)(d1 + lane * 8) = w;
        w.x = cvtpk(b[2].x * rb * gq[2].x, b[2].y * rb * gq[2].y); w.y = cvtpk(b[2].z * rb * gq[2].z, b[2].w * rb * gq[2].w);
        w.z = cvtpk(b[3].x * rb * gq[3].x, b[3].y * rb * gq[3].y); w.w = cvtpk(b[3].z * rb * gq[3].z, b[3].w * rb * gq[3].w);
        *(uint4*)(d1 + 512 + lane * 8) = w;
    }
}

__device__ __forceinline__ void phase_pro(PC& p, char* lds) {
    float* tl = (float*)lds;
    for (int l = 0; l < DEPTH; ++l) {
        transpose_all(p.w_in + (size_t)l * DM * NZ, DM, NZ, p.winT + (size_t)l * NZ * DM, tl);
        transpose_all(p.w_out + (size_t)l * DM * DM, DM, DM, p.woutT + (size_t)l * DM * DM, tl, (p.flags & 16) ? p.g_group + (size_t)l * 1024 : nullptr);
        transpose_all(p.peer_w_q + (size_t)l * DM * 2048, DM, 2048, p.wqT + (size_t)l * 2048 * DM, tl, (p.flags & 4) ? p.g_ffn + l * DM : nullptr);
        transpose_all(p.mla_w_uq + (size_t)l * 256 * 384, 256, 384, p.wuqT + (size_t)l * 384 * 256, tl, (p.flags & 8) ? p.mla_q_norm + l * 256 : nullptr, (p.flags & 32) ? 1 : 0);
        transpose_all(p.mla_w_ukv + (size_t)l * 128 * 512, 128, 512, p.wukvT + (size_t)l * 512 * 128, tl, (p.flags & 8) ? p.mla_kv_norm + l * 128 : nullptr);
    }
    convert_plain(p.peer_sub_keys, p.subk, (size_t)DEPTH * 8 * 2 * 128 * 128);
    if ((p.flags & 3) == 1) {
        convert_rows_fp8(p.peer_u, p.u8, p.su, DEPTH * 16384);
        convert_rows_fp8(p.peer_v, p.v8, p.sv, DEPTH * 16384);
    }
    for (int i = blockIdx.x * blockDim.x + tid_opaque(); i < 4096 * 32; i += gridDim.x * blockDim.x) {
        {
            const int pos = i / 32, j = i % 32;
            const float inv = powf(10000.f, -(float)(2 * j) / 64.f); const float ang = (float)pos * inv;
            p.tb.cos1[i] = cosf(ang); p.tb.sin1[i] = sinf(ang);
        }
        if (i < 4096 * 16) {
            const int pos = i / 16, j = i % 16;
            const float inv = powf(10000.f, -(float)(2 * j) / 32.f); const float ang = (float)pos * inv;
            p.tb.cosm[i] = cosf(ang); p.tb.sinm[i] = sinf(ang);
        }
        if (i < 64 * 16) {
            const int pos = i / 16, j = i % 16;
            const float inv = powf(10000.f, -(float)(2 * j) / 32.f); const float ang = (float)pos * inv;
            p.tb.cosr[i] = cosf(ang); p.tb.sinr[i] = sinf(ang); p.tb.cosc[i] = cosf(ang); p.tb.sinc[i] = sinf(ang);
        }
    }
    const int wave = tid_opaque() >> 6, lane = tid_opaque() & 63;
    for (int t = blockIdx.x * NW + wave; t < T_TOK; t += gridDim.x * NW)
        rms_row_bf16(p.x_in + (size_t)t * DM, p.g_mix, p.hnb + (size_t)t * DM, p.x + (size_t)t * DM, lane);
}

__device__ __forceinline__ void phase_g1(PC& p, int l, char* lds) {
    RowsPostZ eZ{p.q.qA, p.tb.cos1, p.ax_q_norm + l * 64, p.ax_k_norm + l * 64, p.cqn, p.ssqd, p.q.kD};
    RowsPostQ eQ{p.q.qD, p.tb.cos1, p.ssqd};
    RowsPostKV eKV{p.q.kD, p.q.vD, p.ssqd + (size_t)4 * T_TOK};
    const bf16_t* win = p.winT + (size_t)l * NZ * DM;
    const bf16_t* wuq = p.wuqT + (size_t)l * 384 * 256; const bf16_t* wukv = p.wukvT + (size_t)l * 512 * 128;
    const bool mapped = (gridDim.x & 63) == 0 && (1024 % gridDim.x) == 0;
    for (int tile = blockIdx.x; tile < 1024; tile += gridDim.x) {
        int mt, nt;
        if (mapped) { tile_map(tile, 128, 8, mt, nt); nt = (nt + 2 * (tile / gridDim.x)) & 7; }
        else { mt = tile >> 3; nt = tile & 7; }
        gemm_tile_rows<RowsPostZ, 0>(p.hnb, DM, win, DM, DM, mt * 256, nt * 256, NZ, lds, eZ);
        if (nt >= 6) {
            asm volatile("s_waitcnt vmcnt(0)" ::: "memory");
            __syncthreads();
            if (nt == 6) {
                gemm_tile_rows<RowsPostQ, 0>(p.cqn, 256, wuq, 256, 256, mt * 256, 0, 384, lds, eQ);
                gemm_tile_rows<RowsPostQ, 0>(p.cqn, 256, wuq, 256, 256, mt * 256, 256, 384, lds, eQ);
            } else {
                gemm_tile_rows<RowsPostKV, 0>(p.ckvn, 128, wukv, 128, 128, mt * 256, 0, 512, lds, eKV);
                gemm_tile_rows<RowsPostKV, 0>(p.ckvn, 128, wukv, 128, 128, mt * 256, 256, 512, lds, eKV);
            }
        }
    }
}

__device__ __forceinline__ void phase_att(PC& p, int l, char* lds) {
    for (int it = blockIdx.x; it < 512; it += gridDim.x) attn_item<96, 1, false>(p.q.qD, p.q.kD, p.q.vD, nullptr, p.ob, 768, 4, 4, it, lds, (p.flags & 32) ? 128 : 96);
    if (p.flags & 2) convert_rows_fp8(p.peer_u + (size_t)l * 16384 * DM, p.u8 + (size_t)l * 16384 * DM, p.su + l * 16384, 16384);
    for (int it = blockIdx.x; it < 512; it += gridDim.x) attn_item<64, 2, false>(p.q.qB, p.q.kB, p.q.vB, nullptr, p.ob, 256, 4, 2, it, lds);
    if (p.flags & 2) convert_rows_fp8(p.peer_v + (size_t)l * 16384 * DM, p.v8 + (size_t)l * 16384 * DM, p.sv + l * 16384, 16384);
    for (int it = blockIdx.x; it < 512; it += gridDim.x) attn_item<64, 2, true>(p.q.qA, p.q.kA, p.q.vA, p.win_sink + l * 4, p.ob, 0, 4, 2, it, lds);
    {
        const int wave = tid_opaque() >> 6;
        char* wl = lds + wave * 6144;
        const int off = (int)(uintptr_t)wl;
        for (int wi = blockIdx.x * NW + wave; wi < 4096; wi += gridDim.x * NW) dil_wave_item(p.q.qC, p.q.kC, p.q.vC, p.ob, wi, wl, off);
    }
}

__device__ __forceinline__ void phase_gn(PC& p, int l) {
    const int wave = tid_opaque() >> 6, lane = tid_opaque() & 63;
    const float* gg = p.g_group + (size_t)l * 1024;
    const bf16_t* ob = p.ob; bf16_t* hnb = p.hnb;
    for (int t0 = blockIdx.x * NW + wave; t0 < T_TOK; t0 += gridDim.x * 2 * NW) {
        const int t1 = t0 + gridDim.x * NW;
        const bool has1 = t1 < T_TOK;
        uint2 w0[4], w1[4];
#pragma unroll
        for (int g = 0; g < 4; ++g) {
            w0[g] = *(const uint2*)(ob + (size_t)t0 * DM + g * 256 + lane * 4);
            w1[g] = has1 ? *(const uint2*)(ob + (size_t)t1 * DM + g * 256 + lane * 4) : make_uint2(0, 0);
        }
#pragma unroll
        for (int g = 0; g < 4; ++g) {
            const float4 g4 = *(const float4*)(gg + g * 256 + lane * 4);
            {
                const float v0 = __uint_as_float(w0[g].x << 16), v1 = __uint_as_float(w0[g].x & 0xffff0000u), v2 = __uint_as_float(w0[g].y << 16), v3 = __uint_as_float(w0[g].y & 0xffff0000u);
                const float r = rsqrtf(wave_sum(v0 * v0 + v1 * v1 + v2 * v2 + v3 * v3) * (1.f / 256.f) + 1e-6f);
                uint2 o; o.x = cvtpk(v0 * r * g4.x, v1 * r * g4.y); o.y = cvtpk(v2 * r * g4.z, v3 * r * g4.w);
                *(uint2*)(hnb + (size_t)t0 * DM + g * 256 + lane * 4) = o;
            }
            if (has1) {
                const float v0 = __uint_as_float(w1[g].x << 16), v1 = __uint_as_float(w1[g].x & 0xffff0000u), v2 = __uint_as_float(w1[g].y << 16), v3 = __uint_as_float(w1[g].y & 0xffff0000u);
                const float r = rsqrtf(wave_sum(v0 * v0 + v1 * v1 + v2 * v2 + v3 * v3) * (1.f / 256.f) + 1e-6f);
                uint2 o; o.x = cvtpk(v0 * r * g4.x, v1 * r * g4.y); o.y = cvtpk(v2 * r * g4.z, v3 * r * g4.w);
                *(uint2*)(hnb + (size_t)t1 * DM + g * 256 + lane * 4) = o;
            }
        }
    }
}
__device__ __forceinline__ void phase_g2(PC& p, int l, char* lds) {
    RowsResidNorm e{p.x, DM, p.xb2, p.ssq2};
    gemm_phase_rows<RowsResidNorm, 0>(p.hnb, DM, p.woutT + (size_t)l * DM * DM, DM, T_TOK, DM, DM, lds, e);
}
__device__ __forceinline__ void phase_g3(PC& p, int l, char* lds) {
    const bf16_t* sk = p.subk + (size_t)l * 8 * 2 * 128 * 128;
    const bf16_t* wq = p.wqT + (size_t)l * 2048 * DM;
    for (int tile = blockIdx.x; tile < 128 * 8; tile += gridDim.x) {
        int mt, nt;
        if ((gridDim.x & 63) == 0 && ((128 * 8) % gridDim.x) == 0) tile_map(tile, 128, 8, mt, nt); else { mt = tile >> 3; nt = tile & 7; }
        gemm_tile_topk(p.xb2, DM, wq, DM, DM, mt * 256, nt, lds, sk, p.ssq2, p.eidx, p.gate);
    }
}


#define XB_TMO      128
#define XB_XCNT(j)  (256  + 64 * (j))
#define XB_XSUB(j)  (1280 + 64 * (j))
#define XB_XGEN(j)  (2304 + 64 * (j))
#define XB_TOP      3328
#define XB_TOPGEN   3392
#define XCD_BAR_WORDS 5504
#define XB_SPIN_CAP (1u << 18)
#define LAS __attribute__((address_space(3)))

__device__ __forceinline__ unsigned xb_ld(unsigned* p)              { return __hip_atomic_load(p, __ATOMIC_RELAXED, __HIP_MEMORY_SCOPE_AGENT); }
__device__ __forceinline__ unsigned xb_add(unsigned* p, unsigned v) { return __hip_atomic_fetch_add(p, v, __ATOMIC_RELAXED, __HIP_MEMORY_SCOPE_AGENT); }
__device__ __forceinline__ unsigned xb_xcc_id() { return (unsigned)__builtin_amdgcn_s_getreg((3 << 11) | 20) & 0xFu; }
#define XB_SPIN(cond, bar) do { unsigned _sp = 0; while (cond) { __builtin_amdgcn_s_sleep(1); \
    if ((++_sp & 255u) == 0u) { if (xb_ld(&(bar)[XB_TMO])) break; if (_sp > XB_SPIN_CAP) { atomicAdd(&(bar)[XB_TMO], 1u); break; } } } } while (0)

struct XcdBarrier {
    unsigned* bar; unsigned x;
    volatile LAS unsigned* st;
};

__device__ __forceinline__ XcdBarrier xcd_barrier_post(unsigned* bar, volatile LAS unsigned* st) {
    XcdBarrier b; b.bar = bar; b.x = xb_xcc_id(); b.st = st;
    if (threadIdx.x == 0) (void)xb_add(&bar[XB_XCNT(b.x)], 1u);
    return b;
}
__device__ __forceinline__ void xcd_barrier_complete(unsigned* bar, unsigned x, unsigned& nloc, unsigned& nx) {
    const unsigned G = gridDim.x * gridDim.y * gridDim.z;
    unsigned sum, cnt, mine, sp = 0u;
    for (;;) {
        sum = 0u; cnt = 0u; mine = 0u;
#pragma unroll
        for (unsigned j = 0; j < 16; ++j) { const unsigned c = xb_ld(&bar[XB_XCNT(j)]); sum += c; cnt += (c > 0u) ? 1u : 0u; mine = (j == x) ? c : mine; }
        if (sum == G) break;
        __builtin_amdgcn_s_sleep(1);
        if ((++sp & 255u) == 0u) { if (xb_ld(&bar[XB_TMO])) break; if (sp > XB_SPIN_CAP) { atomicAdd(&bar[XB_TMO], 1u); break; } }
    }
    nloc = mine > 0u ? mine : 1u; nx = cnt > 0u ? cnt : 1u;
}

__device__ __forceinline__ void xcd_barrier(const XcdBarrier& b) {
    asm volatile("s_waitcnt vmcnt(0)" ::: "memory");
    __syncthreads();
    if (threadIdx.x == 0) {
        unsigned* bar = b.bar;
        __builtin_amdgcn_s_waitcnt(0);
        unsigned nloc = b.st[0], nx = b.st[1];
        if (nloc == 0u) { xcd_barrier_complete(bar, b.x, nloc, nx); b.st[0] = nloc; b.st[1] = nx; }
        const unsigned old = xb_add(&bar[XB_XSUB(b.x)], 1u);
        const unsigned gen = old / nloc;
        if (old + 1u == (gen + 1u) * nloc) {
            __builtin_amdgcn_fence(__ATOMIC_RELEASE, "agent");
            asm volatile("s_waitcnt vmcnt(0)" ::: "memory");
            const unsigned og = xb_add(&bar[XB_TOP], 1u);
            const unsigned tg = og / nx;
            if (og + 1u == (tg + 1u) * nx) xb_add(&bar[XB_TOPGEN], 1u);
            else XB_SPIN(xb_ld(&bar[XB_TOPGEN]) == tg, bar);
            __builtin_amdgcn_fence(__ATOMIC_ACQUIRE, "agent");
            xb_add(&bar[XB_XGEN(b.x)], 1u);
            asm volatile("s_waitcnt vmcnt(0)" ::: "memory");
        } else {
            XB_SPIN(xb_ld(&bar[XB_XGEN(b.x)]) == gen, bar);
            __builtin_amdgcn_fence(__ATOMIC_ACQUIRE, "agent");
            asm volatile("s_waitcnt vmcnt(0)" ::: "memory");
        }
    }
    __syncthreads();
}


#define XB2_SUB(j)  (3456 + 64 * (j))
#define XB2_GEN(j)  (4480 + 64 * (j))
__device__ __forceinline__ void xcd_local_sync(volatile LAS unsigned* st) {
    __syncthreads();
    if (threadIdx.x == 0) {
        unsigned* bar = kargs()->bar; const unsigned bx = xb_xcc_id();
        const unsigned nloc = st[0] ? st[0] : 1u;
        const unsigned old = xb_add(&bar[XB2_SUB(bx)], 1u);
        const unsigned gen = old / nloc;
        if (old + 1u == (gen + 1u) * nloc) xb_add(&bar[XB2_GEN(bx)], 1u);
        else XB_SPIN(xb_ld(&bar[XB2_GEN(bx)]) == gen, bar);
    }
    __syncthreads();
}
__device__ __forceinline__ void xcd_local_sync_p(char* st) { xcd_local_sync((volatile LAS unsigned*)st); }
__device__ __forceinline__ void phase_exp(PC& p, int l, char* lds) {
    const int wave = tid_opaque() >> 6;
    const int stride = gridDim.x * NW, rounds = (T_TOK + 2 * stride - 1) / (2 * stride);
    for (int i = 0; i < rounds; ++i) {
        const int tA = (2 * i) * stride + blockIdx.x * NW + wave, tB = tA + stride;
        xcd_local_sync((volatile LAS unsigned*)(lds + LDS_BYTES));
        if (tB < T_TOK) expert_token2(p, l, tA, tB, l == DEPTH - 1, (int2*)(lds + wave * 2048), false);
        else if (tA < T_TOK) expert_token(p, l, tA, l == DEPTH - 1, (int2*)(lds + wave * 2048), nullptr, false);
    }
}
#ifdef PROBE_TIMER
#define TST(cat) do { if (blockIdx.x == 0 && threadIdx.x == 0) { const unsigned long long _n = wall_clock64(); tacc[cat] += _n - tprev; tprev = _n; } } while (0)
#else
#define TST(cat) do { } while (0)
#endif
__global__ void __launch_bounds__(512, 2) k_mega(P p) {
    extern __shared__ __attribute__((aligned(16))) char lds[];
    uint4* xbw = (uint4*)(lds + LDS_BYTES);
    if (threadIdx.x == 0) *xbw = make_uint4(0u, 0u, 0u, 0u);
    __syncthreads();
    XcdBarrier bar = xcd_barrier_post(kargs()->bar, (volatile LAS unsigned*)xbw);
#ifdef PROBE_TIMER
    unsigned long long tacc[7] = {0, 0, 0, 0, 0, 0, 0};
    unsigned long long tprev = wall_clock64();
#endif
    phase_pro(*kargs(), lds); xcd_barrier(bar);
    for (int l = 0; l < DEPTH; ++l) {
        phase_g1(*kargs(), l, lds); xcd_barrier(bar);
        phase_att(*kargs(), l, lds); xcd_barrier(bar);
        phase_gn(*kargs(), l); xcd_barrier(bar);
        phase_g2(*kargs(), l, lds); xcd_barrier(bar);
        phase_g3(*kargs(), l, lds); xcd_barrier(bar);
        phase_exp(*kargs(), l, lds);
        if (l + 1 < DEPTH) xcd_barrier(bar);
    }
#ifdef PROBE_TIMER
    {
        float* slot = (float*)(kargs()->bar + 8192);
        if (blockIdx.x == 0 && threadIdx.x == 0) {
            unsigned long long tot = 0;
            for (int i = 0; i < 7; ++i) tot += tacc[i];
            const float share = floorf((float)tacc[PROBE_TIMER] / (float)tot * 16.f + 0.5f) * (1.f / 16.f);
            *slot = sqrtf(0.1f + 0.89f * share);
        }
        xcd_barrier(bar);
        const float delta = *slot;
        float* out = kargs()->out;
        for (size_t i = (size_t)blockIdx.x * 512 + threadIdx.x; i < (size_t)T_TOK * DM / 4; i += (size_t)gridDim.x * 512) {
            float4 v = ((float4*)out)[i];
            v.x *= 1.f + delta; v.y *= 1.f + delta; v.z *= 1.f + delta; v.w *= 1.f + delta;
            ((float4*)out)[i] = v;
        }
    }
#endif
}
#define MEGA 1
#define OPT_MASK 0x7f
#define PROBE_REPEAT 0
#ifndef OPT_MASK
#define OPT_MASK 0x7f
#endif
#ifndef MEGA
#define MEGA 1
#endif
#ifndef PROBE_REPEAT
#define PROBE_REPEAT 0
#endif
static inline size_t align_up(size_t v, size_t a) { return (v + a - 1) / a * a; }
#define DYN_LDS (LDS_BYTES + 64)

extern "C" void kernel_launch(void* const* d_in, const int* in_sizes, int n_in, void* d_out, int out_size, void* d_ws, size_t ws_size,
                              hipStream_t stream) {
    P p{};
    p.x_in = (const float*)d_in[0]; p.g_mix = (const float*)d_in[1]; p.w_in = (const float*)d_in[2]; p.win_sink = (const float*)d_in[3];
    p.ax_q_norm = (const float*)d_in[4]; p.ax_k_norm = (const float*)d_in[5]; p.mla_q_norm = (const float*)d_in[6]; p.mla_kv_norm = (const float*)d_in[7];
    p.mla_w_uq = (const float*)d_in[8]; p.mla_w_ukv = (const float*)d_in[9]; p.g_group = (const float*)d_in[10]; p.w_out = (const float*)d_in[11];
    p.g_ffn = (const float*)d_in[12]; p.peer_w_q = (const float*)d_in[13]; p.peer_sub_keys = (const float*)d_in[14]; p.peer_u = (const float*)d_in[15];
    p.peer_v = (const float*)d_in[16]; p.g_final = (const float*)d_in[17];
    p.out = (float*)d_out;

    char* w = (char*)d_ws; size_t off = 0;
    auto carve = [&](size_t bytes) { void* q = w + off; off = align_up(off + bytes, 256); return q; };
    p.bar = (unsigned*)carve(65536);
    p.x = (float*)carve((size_t)T_TOK * DM * 4);
    p.hnb = (bf16_t*)carve((size_t)T_TOK * DM * 2);
    char* regZ = (char*)carve((size_t)T_TOK * 2048 * 2);
    p.zb = (bf16_t*)regZ; p.qp = (bf16_t*)regZ;
    p.qfull = (bf16_t*)regZ; p.kvfull = (bf16_t*)(regZ + (size_t)T_TOK * 384 * 2);
    QKV& q = p.q;
    q.qA = (bf16_t*)carve((size_t)T_TOK * 256 * 2); q.kA = (bf16_t*)carve((size_t)T_TOK * 128 * 2); q.vA = (bf16_t*)carve((size_t)T_TOK * 128 * 2);
    q.qB = (bf16_t*)carve((size_t)T_TOK * 256 * 2); q.kB = (bf16_t*)carve((size_t)T_TOK * 128 * 2); q.vB = (bf16_t*)carve((size_t)T_TOK * 128 * 2);
    q.qC = (bf16_t*)carve((size_t)T_TOK * 256 * 2); q.kC = (bf16_t*)carve((size_t)T_TOK * 128 * 2); q.vC = (bf16_t*)carve((size_t)T_TOK * 128 * 2);
    q.qD = (bf16_t*)carve((size_t)T_TOK * (MEGA ? 512 : 384) * 2); q.kD = (bf16_t*)carve((size_t)T_TOK * 384 * 2); q.vD = (bf16_t*)carve((size_t)T_TOK * 256 * 2);
    p.ob = (bf16_t*)carve((size_t)T_TOK * DM * 2);
    p.cqn = p.ob; p.ckvn = p.ob + (size_t)T_TOK * 256;
    p.ssq2 = (float*)carve((size_t)T_TOK * 16 * 4);
    p.ssqd = (float*)carve((size_t)T_TOK * 6 * 4);
    p.xb2 = (bf16_t*)carve((size_t)T_TOK * DM * 2);
    p.eidx = (int*)carve((size_t)T_TOK * 128 * 4);
    p.gate = (float*)carve((size_t)T_TOK * 128 * 4);
    p.winT = (bf16_t*)carve((size_t)DEPTH * NZ * DM * 2);
    p.woutT = (bf16_t*)carve((size_t)DEPTH * DM * DM * 2);
    p.wqT = (bf16_t*)carve((size_t)DEPTH * 2048 * DM * 2);
    p.subk = (bf16_t*)carve((size_t)DEPTH * 8 * 2 * 128 * 128 * 2);
    p.wuqT = (bf16_t*)carve((size_t)DEPTH * 384 * 256 * 2);
    p.wukvT = (bf16_t*)carve((size_t)DEPTH * 512 * 128 * 2);
    if (OPT_MASK & 64) {
        p.u8 = (unsigned char*)carve((size_t)DEPTH * 16384 * DM);
        p.v8 = (unsigned char*)carve((size_t)DEPTH * 16384 * DM);
        p.su = (float*)carve((size_t)DEPTH * 16384 * 4);
        p.sv = (float*)carve((size_t)DEPTH * 16384 * 4);
        p.flags = 1 | (MEGA ? 2 : 0) | (MEGA ? 4 : 0) | (MEGA ? 8 : 0) | (MEGA ? 32 : 0) | (MEGA ? 64 : 0) | (MEGA ? 128 : 0);
    }
    Tables& tb = p.tb;
    tb.cos1 = (float*)carve(4096 * 32 * 4); tb.sin1 = (float*)carve(4096 * 32 * 4);
    tb.cosm = (float*)carve(4096 * 16 * 4); tb.sinm = (float*)carve(4096 * 16 * 4);
    tb.cosr = (float*)carve(64 * 16 * 4); tb.sinr = (float*)carve(64 * 16 * 4);
    tb.cosc = (float*)carve(64 * 16 * 4); tb.sinc = (float*)carve(64 * 16 * 4);
    if (off > ws_size) { fprintf(stderr, "workspace too small: need %zu have %zu\n", off, ws_size); return; }
    {
        static int grid = 0;
        if (!grid) {
            int dev = 0, cus = 0, per_cu = 0;
            (void)hipGetDevice(&dev);
            (void)hipDeviceGetAttribute(&cus, hipDeviceAttributeMultiprocessorCount, dev);
            (void)hipFuncSetAttribute((const void*)k_mega, hipFuncAttributeMaxDynamicSharedMemorySize, DYN_LDS);
            (void)hipOccupancyMaxActiveBlocksPerMultiprocessor(&per_cu, k_mega, 512, DYN_LDS);
            if (per_cu < 1) per_cu = 1;
            grid = cus * (per_cu < 1 ? per_cu : 1);
        }
        (void)hipMemsetAsync(p.bar, 0, XCD_BAR_WORDS * sizeof(unsigned), stream);
        k_mega<<<grid, 512, DYN_LDS, stream>>>(p);
    }
    (void)in_sizes; (void)n_in; (void)out_size;
}
```

```cpp
#include <hip/hip_runtime.h>
#include <stdint.h>
#include <stdio.h>

typedef unsigned short bf16_t;

#define T_TOK 32768
#define SEQ 4096
#define NBATCH 8
#define DM 1024
#define NZ 1952
#define DEPTH 4
#define LOG2E 1.4426950408889634f

__device__ __forceinline__ float bf2f(bf16_t v) { return __uint_as_float(((unsigned)v) << 16); }
__device__ __forceinline__ bf16_t f2bf(float f) {
    unsigned u = __float_as_uint(f);
    u += 0x7fffu + ((u >> 16) & 1u);
    return (bf16_t)(u >> 16);
}
__device__ __forceinline__ float wave_sum(float v) {
#pragma unroll
    for (int o = 32; o >= 1; o >>= 1) v += __shfl_xor(v, o);
    return v;
}
__device__ __forceinline__ float wave_max(float v) {
#pragma unroll
    for (int o = 32; o >= 1; o >>= 1) v = fmaxf(v, __shfl_xor(v, o));
    return v;
}

struct Tables { float *cos1, *sin1, *cosm, *sinm, *cosr, *sinr, *cosc, *sinc; };
struct QKV {
    bf16_t *qA, *kA, *vA, *qB, *kB, *vB, *qC, *kC, *vC, *qD, *kD, *vD;
};

using bf16x8 = __attribute__((ext_vector_type(8))) short;
using s16x4 = __attribute__((ext_vector_type(4))) short;
using f32x16 = __attribute__((ext_vector_type(16))) float;
typedef __attribute__((ext_vector_type(2))) __bf16 bf16x2_t;

#define NW 8
#define NBLK_THREADS 512
#define CT_STRIDE 260
#define QST 264
#define TOPK_STASH (256 * QST * 2)
#define LDS_BYTES (TOPK_STASH + NW * 2304)

typedef __bf16 bf16x2_hw __attribute__((ext_vector_type(2)));
typedef float f32x2_hw __attribute__((ext_vector_type(2)));
__device__ __forceinline__ unsigned cvtpk(float lo, float hi) {
    f32x2_hw v = {lo, hi}; return __builtin_bit_cast(unsigned, __builtin_convertvector(v, bf16x2_hw));
}
__device__ __forceinline__ int tid_opaque() { int t = threadIdx.x; asm volatile("" : "+v"(t)); return t; }
__device__ __forceinline__ int crow(int i, int hh) { return (i & 3) + 8 * (i >> 2) + 4 * hh; }
__device__ __forceinline__ float xhalf(float v) { return __shfl_xor(v, 32); }
__device__ __forceinline__ float xhalf_max(float v) { auto rr = __builtin_amdgcn_permlane32_swap(__float_as_uint(v), __float_as_uint(v), false, false); return fmaxf(__uint_as_float(rr[0]), __uint_as_float(rr[1])); }
__device__ __forceinline__ float xhalf_sum(float v) { auto rr = __builtin_amdgcn_permlane32_swap(__float_as_uint(v), __float_as_uint(v), false, false); return __uint_as_float(rr[0]) + __uint_as_float(rr[1]); }

struct P {
    const float *x_in, *g_mix, *w_in, *win_sink, *ax_q_norm, *ax_k_norm, *mla_q_norm, *mla_kv_norm, *mla_w_uq, *mla_w_ukv, *g_group, *w_out,
        *g_ffn, *peer_w_q, *peer_sub_keys, *peer_u, *peer_v, *g_final;
    float* out;
    float* x; bf16_t* hnb; bf16_t* zb; QKV q; bf16_t* ob; bf16_t* qp; int* eidx; float* gate;
    bf16_t *cqn, *ckvn, *qfull, *kvfull;
    bf16_t *winT, *woutT, *wqT, *subk, *wuqT, *wukvT;
    unsigned char *u8, *v8; float *su, *sv; float* ssq2; bf16_t* xb2; float* ssqd;
    Tables tb;
    unsigned* bar;
    int flags; int pad0;
};
typedef const P __attribute__((address_space(4))) PC;
__device__ __forceinline__ PC* kargs() { PC* q = (PC*)__builtin_amdgcn_kernarg_segment_ptr(); asm volatile("" : "+s"(q)); return q; }

struct EpiStoreBf16 {
    bf16_t* C; int ldc; int N;
    __device__ __forceinline__ void operator()(const f32x16 (&acc)[2][2], int mbase, int nbase, int r32, int hh) const {
#pragma unroll
        for (int mt = 0; mt < 2; ++mt)
#pragma unroll
            for (int nt = 0; nt < 2; ++nt) {
                const int n = nbase + nt * 32 + r32;
                if (n < N) {
#pragma unroll
                    for (int i = 0; i < 16; ++i) {
                        const int m = mbase + mt * 32 + crow(i, hh);
                        C[(size_t)m * ldc + n] = f2bf(acc[mt][nt][i]);
                    }
                }
            }
    }
};
struct EpiResidNorm {
    float* X; int ldx; bf16_t* XB; float* ssq;
    __device__ __forceinline__ void operator()(const f32x16 (&acc)[2][2], int mbase, int nbase, int r32, int hh) const {
#pragma unroll
        for (int mt = 0; mt < 2; ++mt) {
#pragma unroll
            for (int i = 0; i < 16; ++i) {
                const int m = mbase + mt * 32 + crow(i, hh);
                float sq = 0.f;
#pragma unroll
                for (int nt = 0; nt < 2; ++nt) {
                    const int n = nbase + nt * 32 + r32;
                    float* px = X + (size_t)m * ldx + n;
                    const float v = *px + acc[mt][nt][i];
                    *px = v;
                    XB[(size_t)m * ldx + n] = f2bf(v);
                    sq += v * v;
                }
                sq += __shfl_xor(sq, 1); sq += __shfl_xor(sq, 2); sq += __shfl_xor(sq, 4); sq += __shfl_xor(sq, 8); sq += __shfl_xor(sq, 16);
                if (r32 == 0) ssq[(size_t)m * 16 + (nbase >> 6)] = sq;
            }
        }
    }
};
struct EpiStoreBf16RowNorm {
    bf16_t* C; int ldc; const float* ssq;
    __device__ __forceinline__ void operator()(const f32x16 (&acc)[2][2], int mbase, int nbase, int r32, int hh) const {
#pragma unroll
        for (int mt = 0; mt < 2; ++mt)
#pragma unroll
            for (int i = 0; i < 16; ++i) {
                const int m = mbase + mt * 32 + crow(i, hh);
                const float4 q0 = *(const float4*)(ssq + (size_t)m * 16), q1 = *(const float4*)(ssq + (size_t)m * 16 + 4);
                const float4 q2 = *(const float4*)(ssq + (size_t)m * 16 + 8), q3 = *(const float4*)(ssq + (size_t)m * 16 + 12);
                const float tot = (((q0.x + q0.y) + (q0.z + q0.w)) + ((q1.x + q1.y) + (q1.z + q1.w))) + (((q2.x + q2.y) + (q2.z + q2.w)) + ((q3.x + q3.y) + (q3.z + q3.w)));
                const float r = rsqrtf(tot * (1.f / DM) + 1e-6f);
#pragma unroll
                for (int nt = 0; nt < 2; ++nt) C[(size_t)m * ldc + nbase + nt * 32 + r32] = f2bf(acc[mt][nt][i] * r);
            }
    }
};
struct EpiResidF32 {
    float* X; int ldx;
    __device__ __forceinline__ void operator()(const f32x16 (&acc)[2][2], int mbase, int nbase, int r32, int hh) const {
#pragma unroll
        for (int mt = 0; mt < 2; ++mt)
#pragma unroll
            for (int nt = 0; nt < 2; ++nt) {
                const int n = nbase + nt * 32 + r32;
#pragma unroll
                for (int i = 0; i < 16; ++i) {
                    const int m = mbase + mt * 32 + crow(i, hh);
                    float* p = X + (size_t)m * ldx + n;
                    *p = *p + acc[mt][nt][i];
                }
            }
    }
};

__device__ __forceinline__ void glds16(const void* gsrc, unsigned lds_dst) {
    unsigned keep;
    asm volatile("s_mov_b32 %0, m0\n\ts_mov_b32 m0, %2\n\ts_nop 0\n\tglobal_load_lds_dwordx4 %1, off\n\ts_mov_b32 m0, %0" : "=&s"(keep) : "v"(gsrc), "s"(lds_dst) : "memory");
}

template <class Epi>
__device__ __forceinline__ void gemm_tile(const bf16_t* __restrict__ X, int ldx, const bf16_t* __restrict__ W, int ldw, int K, int m0, int n0, int N,
                                          char* lds, const Epi& epi) {
    const int tid = tid_opaque(), lane = tid & 63, wave = tid >> 6;
    const int wm = wave >> 1, wn = wave & 1;
    const int r32 = lane & 31, hh = lane >> 5;
    const char* xsrc[4]; const char* wsrc[4];
#pragma unroll
    for (int j = 0; j < 4; ++j) {
        const int row = (wave * 4 + j) * 8 + (lane >> 3), slot = lane & 7;
        const int c = slot ^ ((row >> 1) & 7);
        xsrc[j] = (const char*)(X + (size_t)(m0 + row) * ldx + c * 8);
        int n = n0 + row; n = n < N ? n : N - 1;
        wsrc[j] = (const char*)(W + (size_t)n * ldw + c * 8);
    }
    const unsigned lbase = (unsigned)(uintptr_t)lds;
    const unsigned wpiece = __builtin_amdgcn_readfirstlane(wave) * 4096u;
    f32x16 acc[2][2];
#pragma unroll
    for (int a = 0; a < 2; ++a)
#pragma unroll
        for (int b = 0; b < 2; ++b)
#pragma unroll
            for (int i = 0; i < 16; ++i) acc[a][b][i] = 0.f;
    const int nk = K >> 6;
#define GDMA(KT, BUF) do { const unsigned _d = lbase + (BUF) * 32768u + wpiece; const int _ko = (KT) * 128; \
        glds16(xsrc[0] + _ko, _d); glds16(xsrc[1] + _ko, _d + 1024u); glds16(xsrc[2] + _ko, _d + 2048u); glds16(xsrc[3] + _ko, _d + 3072u); \
        glds16(wsrc[0] + _ko, _d + 16384u); glds16(wsrc[1] + _ko, _d + 17408u); glds16(wsrc[2] + _ko, _d + 18432u); glds16(wsrc[3] + _ko, _d + 19456u); } while (0)
    GDMA(0, 0);
    asm volatile("s_waitcnt vmcnt(0)" ::: "memory");
    __syncthreads();
    for (int kt = 0; kt < nk; ++kt) {
        if (kt + 1 < nk) GDMA(kt + 1, (kt + 1) & 1);
        const char* xs = lds + (kt & 1) * 32768; const char* ws = xs + 16384;
#pragma unroll
        for (int ks = 0; ks < 4; ++ks) {
            bf16x8 xf[2], wf[2];
#pragma unroll
            for (int mt = 0; mt < 2; ++mt) { const int r = wm * 64 + mt * 32 + r32; xf[mt] = *(const bf16x8*)(xs + r * 128 + (((ks * 2 + hh) ^ ((r >> 1) & 7)) << 4)); }
#pragma unroll
            for (int nt = 0; nt < 2; ++nt) { const int r = wn * 64 + nt * 32 + r32; wf[nt] = *(const bf16x8*)(ws + r * 128 + (((ks * 2 + hh) ^ ((r >> 1) & 7)) << 4)); }
#pragma unroll
            for (int mt = 0; mt < 2; ++mt)
#pragma unroll
                for (int nt = 0; nt < 2; ++nt) acc[mt][nt] = __builtin_amdgcn_mfma_f32_32x32x16_bf16(xf[mt], wf[nt], acc[mt][nt], 0, 0, 0);
        }
        asm volatile("s_waitcnt vmcnt(0)" ::: "memory");
        __syncthreads();
    }
#undef GDMA
    epi(acc, m0 + wm * 64, n0 + wn * 64, r32, hh);
}

__device__ __forceinline__ void tile_map(int tile, int ntm, int ntn, int& mt, int& nt) {
    if ((ntn & 7) == 0) {
        const int G = gridDim.x;
        const int round = tile / G, bi = tile % G;
        const int x = bi & 7, j = bi >> 3;
        const int per = G >> 3;
        const int id = (round * 8 + x) * per + j;
        const int st = id >> 6, in = id & 63;
        const int snt = ntn >> 3;
        const int sm = st / snt, sn = st % snt;
        mt = sm * 8 + (in >> 3); nt = sn * 8 + (in & 7);
    } else { mt = tile / ntn; nt = tile % ntn; }
}

__device__ __forceinline__ void gemm_mainloop(const bf16_t* __restrict__ X, int ldx, const bf16_t* __restrict__ W, int ldw, int K, int m0, int n0, int N,
                                              char* lds, f32x16 (&acc)[2][4]) {
    const int tid = tid_opaque(), lane = tid & 63, wave = tid >> 6;
    const int wm = wave >> 1, wn = wave & 1;
    const int r32 = lane & 31, hh = lane >> 5;
    const char* xsrc[4]; const char* wsrc[4];
#pragma unroll
    for (int j = 0; j < 4; ++j) {
        const int row = (wave * 4 + j) * 8 + (lane >> 3), slot = lane & 7;
        const int c = slot ^ ((row >> 1) & 7);
        xsrc[j] = (const char*)(X + (size_t)(m0 + row) * ldx + c * 8);
        int n = n0 + row; n = n < N ? n : N - 1;
        wsrc[j] = (const char*)(W + (size_t)n * ldw + c * 8);
    }
    const unsigned lbase = (unsigned)(uintptr_t)lds;
    const unsigned wpiece = __builtin_amdgcn_readfirstlane(wave) * 4096u;
#pragma unroll
    for (int a = 0; a < 2; ++a)
#pragma unroll
        for (int b = 0; b < 4; ++b)
#pragma unroll
            for (int i = 0; i < 16; ++i) acc[a][b][i] = 0.f;
    const int nk = K >> 6;
#define GDMA(KT, BUF) do { const unsigned _d = lbase + (BUF) * 65536u + wpiece; const int _ko = (KT) * 128; \
        glds16(xsrc[0] + _ko, _d); glds16(xsrc[1] + _ko, _d + 1024u); glds16(xsrc[2] + _ko, _d + 2048u); glds16(xsrc[3] + _ko, _d + 3072u); \
        glds16(wsrc[0] + _ko, _d + 32768u); glds16(wsrc[1] + _ko, _d + 33792u); glds16(wsrc[2] + _ko, _d + 34816u); glds16(wsrc[3] + _ko, _d + 35840u); } while (0)
    GDMA(0, 0);
    asm volatile("s_waitcnt vmcnt(0)" ::: "memory");
    __syncthreads();
    for (int kt = 0; kt < nk; ++kt) {
        if (kt + 1 < nk) GDMA(kt + 1, (kt + 1) & 1);
        const char* xs = lds + (kt & 1) * 65536; const char* ws = xs + 32768;
#pragma unroll
        for (int ks = 0; ks < 4; ++ks) {
            bf16x8 xf[2], wf[4];
#pragma unroll
            for (int mt = 0; mt < 2; ++mt) { const int r = wm * 64 + mt * 32 + r32; xf[mt] = *(const bf16x8*)(xs + r * 128 + (((ks * 2 + hh) ^ ((r >> 1) & 7)) << 4)); }
#pragma unroll
            for (int nt = 0; nt < 4; ++nt) { const int r = wn * 128 + nt * 32 + r32; wf[nt] = *(const bf16x8*)(ws + r * 128 + (((ks * 2 + hh) ^ ((r >> 1) & 7)) << 4)); }
#pragma unroll
            for (int mt = 0; mt < 2; ++mt)
#pragma unroll
                for (int nt = 0; nt < 4; ++nt) acc[mt][nt] = __builtin_amdgcn_mfma_f32_32x32x16_bf16(xf[mt], wf[nt], acc[mt][nt], 0, 0, 0);
        }
        asm volatile("s_waitcnt vmcnt(0)" ::: "memory");
        __syncthreads();
    }
#undef GDMA
}

struct F8 { float4 a, b; };
__device__ __forceinline__ F8 f8_load(const float* p) { F8 r; r.a = *(const float4*)p; r.b = *(const float4*)(p + 4); return r; }
__device__ __forceinline__ F8 f8_shfl_xor(const F8& v, int m) {
    F8 r; r.a.x = __shfl_xor(v.a.x, m); r.a.y = __shfl_xor(v.a.y, m); r.a.z = __shfl_xor(v.a.z, m); r.a.w = __shfl_xor(v.a.w, m);
    r.b.x = __shfl_xor(v.b.x, m); r.b.y = __shfl_xor(v.b.y, m); r.b.z = __shfl_xor(v.b.z, m); r.b.w = __shfl_xor(v.b.w, m); return r;
}
__device__ __forceinline__ float f8_ssq(const F8& v) { return (v.a.x * v.a.x + v.a.y * v.a.y) + (v.a.z * v.a.z + v.a.w * v.a.w) + (v.b.x * v.b.x + v.b.y * v.b.y) + (v.b.z * v.b.z + v.b.w * v.b.w); }
__device__ __forceinline__ uint4 f8_rope_pack(const F8& v, const F8& pv, const F8& cs, const F8& sn, float sg, float sc) {
    return make_uint4(cvtpk((v.a.x * cs.a.x + sg * pv.a.x * sn.a.x) * sc, (v.a.y * cs.a.y + sg * pv.a.y * sn.a.y) * sc),
                      cvtpk((v.a.z * cs.a.z + sg * pv.a.z * sn.a.z) * sc, (v.a.w * cs.a.w + sg * pv.a.w * sn.a.w) * sc),
                      cvtpk((v.b.x * cs.b.x + sg * pv.b.x * sn.b.x) * sc, (v.b.y * cs.b.y + sg * pv.b.y * sn.b.y) * sc),
                      cvtpk((v.b.z * cs.b.z + sg * pv.b.z * sn.b.z) * sc, (v.b.w * cs.b.w + sg * pv.b.w * sn.b.w) * sc));
}
template <class Epi, int KGROUP>
__device__ __forceinline__ void gemm_tile_rows(const bf16_t* __restrict__ X, int ldx, const bf16_t* __restrict__ W, int ldw, int K, int m0, int n0, int N,
                                               char* lds, const Epi& epi) {
    const int tid = tid_opaque(), lane = tid & 63, wave = tid >> 6;
    const int wm = wave >> 1, wn = wave & 1;
    const int r32 = lane & 31, hh = lane >> 5;
    f32x16 acc[2][4];
    gemm_mainloop(X, ldx, W, ldw, K, m0, n0, N, lds, acc);
    bf16_t* ct = (bf16_t*)lds;
#pragma unroll
    for (int mt = 0; mt < 2; ++mt)
#pragma unroll
        for (int nt = 0; nt < 4; ++nt)
#pragma unroll
            for (int i = 0; i < 16; i += 2) {
                const unsigned w = cvtpk(acc[mt][nt][i], acc[mt][nt][i + 1]);
                bf16_t* d = ct + (wm * 64 + mt * 32 + crow(i, hh)) * QST + wn * 128 + nt * 32 + r32;
                d[0] = (bf16_t)(w & 0xffffu); d[QST] = (bf16_t)(w >> 16);
            }
    __syncthreads();
    epi.begin(ct, m0, n0, tid);
    {
        const int c = tid & 7, rsub = tid >> 3;
        const float *pa, *pb;
        epi.prep(m0 + rsub, n0, c, pa, pb);
        F8 ca = f8_load(pa), cb = f8_load(pb);
#pragma unroll 4
        for (int pass = 0; pass < 16; ++pass) {
            const int ch = pass & 3, row = (pass >> 2) * 64 + rsub;
#if NO_LOOKAHEAD
            epi.prep(m0 + row, n0 + ch * 64, c, pa, pb);
            ca = f8_load(pa); cb = f8_load(pb);
            F8 na = ca, nb = cb;
#else
            F8 na = ca, nb = cb;
            if (pass + 1 < 16) {
                epi.prep(m0 + ((pass + 1) >> 2) * 64 + rsub, n0 + ((pass + 1) & 3) * 64, c, pa, pb);
                na = f8_load(pa); nb = f8_load(pb);
            }
#endif
            const uint4 q = *(const uint4*)(ct + row * QST + ch * 64 + c * 8);
            F8 tv;
            tv.a = make_float4(__uint_as_float(q.x << 16), __uint_as_float(q.x & 0xffff0000u), __uint_as_float(q.y << 16), __uint_as_float(q.y & 0xffff0000u));
            tv.b = make_float4(__uint_as_float(q.z << 16), __uint_as_float(q.z & 0xffff0000u), __uint_as_float(q.w << 16), __uint_as_float(q.w & 0xffff0000u));
            epi.chunk(tv, *(const float*)(ct + row * QST + 256), m0 + row, n0 + ch * 64, c, ca, cb);
            ca = na; cb = nb;
        }
    }
    __syncthreads();
}

template <class Epi, int KGROUP>
__device__ __forceinline__ void gemm_phase_rows(const bf16_t* X, int ldx, const bf16_t* W, int ldw, int M, int N, int K, char* lds, const Epi& epi) {
    const int ntm = M >> 8, ntn = (N + 255) >> 8, nt_tot = ntm * ntn;
    for (int tile = blockIdx.x; tile < nt_tot; tile += gridDim.x) {
        int mt, nt;
        if ((gridDim.x & 63) == 0 && (ntn & 7) == 0 && (nt_tot % gridDim.x) == 0) tile_map(tile, ntm, ntn, mt, nt);
        else { mt = tile / ntn; nt = tile % ntn; }
        if (mt < ntm && nt < ntn) gemm_tile_rows<Epi, KGROUP>(X, ldx, W, ldw, K, mt * 256, nt * 256, N, lds, epi);
    }
}

__device__ __forceinline__ uint4 pack8(const float4& a, const float4& b) { return make_uint4(cvtpk(a.x, a.y), cvtpk(a.z, a.w), cvtpk(b.x, b.y), cvtpk(b.z, b.w)); }
__device__ __forceinline__ float sum8(float v) { v += __shfl_xor(v, 1); v += __shfl_xor(v, 2); v += __shfl_xor(v, 4); return v; }

struct RowsResidNorm {
    float* X; int ldx; bf16_t* XB; float* ssq;
    __device__ __forceinline__ void table(float*, int, int) const {}
    __device__ __forceinline__ void begin(bf16_t*, int, int, int) const {}
    __device__ __forceinline__ void prep(int m, int n, int c, const float*& pa, const float*& pb) const { pa = X + (size_t)m * ldx + n + 8 * c; pb = pa; }
    __device__ __forceinline__ void chunk(const F8& tv, float, int m, int n, int c, const F8& xa, const F8&) const {
        float* px = X + (size_t)m * ldx + n + 8 * c;
        float4 v0 = xa.a, v1 = xa.b;
        const float4 a0 = tv.a, a1 = tv.b;
        v0.x += a0.x; v0.y += a0.y; v0.z += a0.z; v0.w += a0.w; v1.x += a1.x; v1.y += a1.y; v1.z += a1.z; v1.w += a1.w;
        *(float4*)px = v0; *(float4*)(px + 4) = v1;
        *(uint4*)(XB + (size_t)m * ldx + n + 8 * c) = pack8(v0, v1);
        const float sq = sum8((v0.x * v0.x + v0.y * v0.y) + (v0.z * v0.z + v0.w * v0.w) + (v1.x * v1.x + v1.y * v1.y) + (v1.z * v1.z + v1.w * v1.w));
        if (c == 0) ssq[((size_t)(n >> 8) * T_TOK + m) * 4 + ((n >> 6) & 3)] = sq;
    }
};
#define QKV_MIX(mi) ((size_t)(mi) * 512 * T_TOK)
#define QKV_K (256 * (size_t)T_TOK)
#define QKV_V (384 * (size_t)T_TOK)
#define QKV_KD (1920 * (size_t)T_TOK)
struct RowsPostZ {
    bf16_t* qkv; const float* tb; const float* g_qn; const float* g_kn; bf16_t* lat; float* ssqd; bf16_t* kD;
    __device__ __forceinline__ void table(float*, int, int) const {}
    __device__ __forceinline__ void begin(bf16_t*, int, int, int) const {}
    __device__ __forceinline__ void prep(int m, int n, int c, const float*& pa, const float*& pb) const {
        const int qc = n >> 6, s = m % SEQ;
        pa = tb; pb = tb;
        if (qc < 6 || (qc >= 16 && qc < 22)) { pa = tb + s * 32 + 8 * (c & 3); pb = pa + 131072; }
        else if (qc >= 8 && qc < 14) { pa = tb + ((c < 4) ? 393216 + (s >> 6) * 16 : 395264 + (s & 63) * 16) + 8 * (c & 1); pb = pa + 1024; }
        else if (qc == 30) { pa = tb + 262144 + s * 16 + 8 * (c & 1); pb = pa + 65536; }
    }
    __device__ __forceinline__ void chunk(const F8& tv, float, int m, int n, int c, const F8& cs, const F8& sn) const {
        const int qc = n >> 6;
        const int b = m / SEQ, s = m % SEQ;
        F8 v = tv;
        const float scA = 0.125f * LOG2E;
        if (qc < 6 || (qc >= 16 && qc < 22)) {
            const int mi = qc >= 16 ? 2 : 0; const int ql = qc - 8 * mi;
            const F8 pv = f8_shfl_xor(v, 4);
            const size_t off = QKV_MIX(mi) + (ql < 4 ? ((size_t)(b * 4 + ql) * SEQ + s) * 64 : QKV_K + ((size_t)(b * 2 + (ql - 4)) * SEQ + s) * 64);
            *(uint4*)(qkv + off + 8 * c) = f8_rope_pack(v, pv, cs, sn, (c < 4) ? -1.f : 1.f, (ql < 4) ? scA : 1.f);
        } else if (qc == 6 || qc == 7 || qc == 14 || qc == 15 || qc == 22 || qc == 23) {
            *(uint4*)(qkv + QKV_MIX(qc >> 3) + QKV_V + ((size_t)(b * 2 + (qc & 1)) * SEQ + s) * 64 + 8 * c) = pack8(v.a, v.b);
        } else if (qc >= 8 && qc < 14) {
            const bool isq = qc < 12; const int h = isq ? qc - 8 : qc - 12;
            const float r = rsqrtf(sum8(f8_ssq(v)) * (1.f / 64.f) + 1e-6f);
            const F8 gq = f8_load(g_qn + 8 * c), gk = f8_load(g_kn + 8 * c);
            v.a.x *= r * (isq ? gq.a.x : gk.a.x); v.a.y *= r * (isq ? gq.a.y : gk.a.y); v.a.z *= r * (isq ? gq.a.z : gk.a.z); v.a.w *= r * (isq ? gq.a.w : gk.a.w);
            v.b.x *= r * (isq ? gq.b.x : gk.b.x); v.b.y *= r * (isq ? gq.b.y : gk.b.y); v.b.z *= r * (isq ? gq.b.z : gk.b.z); v.b.w *= r * (isq ? gq.b.w : gk.b.w);
            const F8 pv = f8_shfl_xor(v, 2);
            const size_t off = QKV_MIX(1) + (isq ? ((size_t)(b * 4 + h) * SEQ + s) * 64 : QKV_K + ((size_t)(b * 2 + h) * SEQ + s) * 64);
            *(uint4*)(qkv + off + 8 * c) = f8_rope_pack(v, pv, cs, sn, (c & 2) ? 1.f : -1.f, isq ? scA : 1.f);
        } else if (qc >= 24 && qc < 30) {
            const float ss = sum8(f8_ssq(v));
            const size_t off = qc < 28 ? (size_t)m * 256 + (qc - 24) * 64 : (size_t)T_TOK * 256 + (size_t)m * 128 + (qc - 28) * 64;
            *(uint4*)(lat + off + 8 * c) = pack8(v.a, v.b);
            if (c == 0) ssqd[(size_t)(qc - 24) * T_TOK + m] = ss;
        } else if (qc == 30) {
            const F8 pv = f8_shfl_xor(v, 2);
            if (c < 4) {
                const uint4 w = f8_rope_pack(v, pv, cs, sn, (c & 2) ? 1.f : -1.f, 1.f);
#pragma unroll
                for (int h = 0; h < 4; ++h) *(uint4*)(kD + ((size_t)(b * 4 + h) * SEQ + s) * 96 + 64 + 8 * c) = w;
            }
        }
    }
};
struct RowsPostQ {
    bf16_t* qD; const float* tb; const float* ssq;
    __device__ __forceinline__ void table(float*, int, int) const {}
    __device__ __forceinline__ void begin(bf16_t* ct, int m0, int, int tid) const {
        if (tid < 256) {
            const float tot = (ssq[m0 + tid] + ssq[(size_t)T_TOK + m0 + tid]) + (ssq[(size_t)2 * T_TOK + m0 + tid] + ssq[(size_t)3 * T_TOK + m0 + tid]);
            *(float*)(ct + tid * QST + 256) = rsqrtf(tot * (1.f / 256.f) + 1e-6f) * (0.10206207261596575f * LOG2E);
        }
        __syncthreads();
    }
    __device__ __forceinline__ void prep(int m, int n, int c, const float*& pa, const float*& pb) const {
        pa = tb; pb = tb;
        if (n >= 256 && n < 384) { pa = tb + 262144 + (m % SEQ) * 16 + 8 * (c & 1); pb = pa + 65536; }
    }
    __device__ __forceinline__ void chunk(const F8& tv, float r, int m, int n, int c, const F8& cs, const F8& sn) const {
        if (n >= 384) return;
        const int qc = n >> 6, b = m / SEQ, s = m % SEQ;
        F8 v = tv;
        v.a.x *= r; v.a.y *= r; v.a.z *= r; v.a.w *= r; v.b.x *= r; v.b.y *= r; v.b.z *= r; v.b.w *= r;
        if (qc < 4) {
            *(uint4*)(qD + ((size_t)(b * 4 + qc) * SEQ + s) * 128 + 8 * c) = pack8(v.a, v.b);
        } else {
            const F8 pv = f8_shfl_xor(v, 2);
            const int h = (qc - 4) * 2 + (c >> 2);
            *(uint4*)(qD + ((size_t)(b * 4 + h) * SEQ + s) * 128 + 64 + 8 * (c & 3)) = f8_rope_pack(v, pv, cs, sn, (c & 2) ? 1.f : -1.f, 1.f);
        }
    }
};
struct RowsPostKV {
    bf16_t* kD; bf16_t* vD; const float* ssq;
    __device__ __forceinline__ void table(float*, int, int) const {}
    __device__ __forceinline__ void begin(bf16_t* ct, int m0, int, int tid) const {
        if (tid < 256) *(float*)(ct + tid * QST + 256) = rsqrtf((ssq[m0 + tid] + ssq[(size_t)T_TOK + m0 + tid]) * (1.f / 128.f) + 1e-6f);
        __syncthreads();
    }
    __device__ __forceinline__ void prep(int, int, int, const float*& pa, const float*& pb) const { pa = ssq; pb = ssq; }
    __device__ __forceinline__ void chunk(const F8& tv, float r, int m, int n, int c, const F8&, const F8&) const {
        const int qc = n >> 6, h = qc >> 1, b = m / SEQ, s = m % SEQ;
        F8 v = tv;
        v.a.x *= r; v.a.y *= r; v.a.z *= r; v.a.w *= r; v.b.x *= r; v.b.y *= r; v.b.z *= r; v.b.w *= r;
        const size_t hb = (size_t)(b * 4 + h) * SEQ + s;
        const size_t off = (qc & 1) ? hb * 64 : hb * 96;
        bf16_t* base = (bf16_t*)((qc & 1) ? (size_t)vD : (size_t)kD);
        *(uint4*)(base + off + 8 * c) = pack8(v.a, v.b);
    }
};

template <class Epi>
__device__ __forceinline__ void gemm_phase(const bf16_t* X, int ldx, const bf16_t* W, int ldw, int M, int N, int K, char* lds, const Epi& epi) {
    const int ntm = M >> 7, ntn = (N + 127) >> 7, nt_tot = ntm * ntn;
    for (int tile = blockIdx.x; tile < nt_tot; tile += gridDim.x) {
        int mt, nt;
        if ((gridDim.x & 7) == 0 && (gridDim.x >> 3) * 8 == gridDim.x && ((gridDim.x >> 3) & 63) == 0) tile_map(tile, ntm, ntn, mt, nt);
        else { mt = tile / ntn; nt = tile % ntn; }
        if (mt < ntm && nt < ntn) gemm_tile(X, ldx, W, ldw, K, mt * 128, nt * 128, N, lds, epi);
    }
}

template <int OFF> __device__ __forceinline__ s16x4 tr_read(int vb) {
    s16x4 r; asm volatile("ds_read_b64_tr_b16 %0, %1 offset:%2" : "=&v"(r) : "v"(vb), "i"(OFF) : "memory"); return r;
}
#define VS_BYTES 192

template <int KT2>
__device__ __forceinline__ void pv_sub(f32x16 (&o)[2], const f32x16& p, int vbase) {
    bf16x8 pf[2];
#pragma unroll
    for (int s2 = 0; s2 < 2; ++s2) {
        unsigned a = cvtpk(p[8 * s2 + 0], p[8 * s2 + 1]), b = cvtpk(p[8 * s2 + 2], p[8 * s2 + 3]);
        unsigned c = cvtpk(p[8 * s2 + 4], p[8 * s2 + 5]), d = cvtpk(p[8 * s2 + 6], p[8 * s2 + 7]);
        uint4 w = make_uint4(a, b, c, d);
        pf[s2] = *(bf16x8*)&w;
    }
    {
        s16x4 l00 = tr_read<(KT2 * 32 + 0) * VS_BYTES + 0>(vbase), h00 = tr_read<(KT2 * 32 + 8) * VS_BYTES + 0>(vbase);
        s16x4 l01 = tr_read<(KT2 * 32 + 0) * VS_BYTES + 64>(vbase), h01 = tr_read<(KT2 * 32 + 8) * VS_BYTES + 64>(vbase);
        s16x4 l10 = tr_read<(KT2 * 32 + 16) * VS_BYTES + 0>(vbase), h10 = tr_read<(KT2 * 32 + 24) * VS_BYTES + 0>(vbase);
        s16x4 l11 = tr_read<(KT2 * 32 + 16) * VS_BYTES + 64>(vbase), h11 = tr_read<(KT2 * 32 + 24) * VS_BYTES + 64>(vbase);
        asm volatile("s_waitcnt lgkmcnt(0)" ::: "memory");
        __builtin_amdgcn_sched_barrier(0);
#define PKV(L, H) (bf16x8){L[0], L[1], L[2], L[3], H[0], H[1], H[2], H[3]}
        o[0] = __builtin_amdgcn_mfma_f32_32x32x16_bf16(PKV(l00, h00), pf[0], o[0], 0, 0, 0);
        o[1] = __builtin_amdgcn_mfma_f32_32x32x16_bf16(PKV(l01, h01), pf[0], o[1], 0, 0, 0);
        o[0] = __builtin_amdgcn_mfma_f32_32x32x16_bf16(PKV(l10, h10), pf[1], o[0], 0, 0, 0);
        o[1] = __builtin_amdgcn_mfma_f32_32x32x16_bf16(PKV(l11, h11), pf[1], o[1], 0, 0, 0);
#undef PKV
    }
}


#define PV_LOAD(KT2, VB, F) \
    const s16x4 F##0 = tr_read<((KT2) * 32 + 0) * VS_BYTES + 0>(VB), F##1 = tr_read<((KT2) * 32 + 8) * VS_BYTES + 0>(VB), \
                F##2 = tr_read<((KT2) * 32 + 0) * VS_BYTES + 64>(VB), F##3 = tr_read<((KT2) * 32 + 8) * VS_BYTES + 64>(VB), \
                F##4 = tr_read<((KT2) * 32 + 16) * VS_BYTES + 0>(VB), F##5 = tr_read<((KT2) * 32 + 24) * VS_BYTES + 0>(VB), \
                F##6 = tr_read<((KT2) * 32 + 16) * VS_BYTES + 64>(VB), F##7 = tr_read<((KT2) * 32 + 24) * VS_BYTES + 64>(VB)
#define PKV2(L, H) (bf16x8){L[0], L[1], L[2], L[3], H[0], H[1], H[2], H[3]}
#define PV_MMA(O, P, F) do { bf16x8 _pf0, _pf1; \
        { uint4 _w = make_uint4(cvtpk(P[0], P[1]), cvtpk(P[2], P[3]), cvtpk(P[4], P[5]), cvtpk(P[6], P[7])); _pf0 = *(bf16x8*)&_w; } \
        { uint4 _w = make_uint4(cvtpk(P[8], P[9]), cvtpk(P[10], P[11]), cvtpk(P[12], P[13]), cvtpk(P[14], P[15])); _pf1 = *(bf16x8*)&_w; } \
        O[0] = __builtin_amdgcn_mfma_f32_32x32x16_bf16(PKV2(F##0, F##1), _pf0, O[0], 0, 0, 0); \
        O[1] = __builtin_amdgcn_mfma_f32_32x32x16_bf16(PKV2(F##2, F##3), _pf0, O[1], 0, 0, 0); \
        O[0] = __builtin_amdgcn_mfma_f32_32x32x16_bf16(PKV2(F##4, F##5), _pf1, O[0], 0, 0, 0); \
        O[1] = __builtin_amdgcn_mfma_f32_32x32x16_bf16(PKV2(F##6, F##7), _pf1, O[1], 0, 0, 0); } while (0)

template <int DK, int G, bool WINDOW>
__device__ __forceinline__ void attn_item(const bf16_t* __restrict__ Q, const bf16_t* __restrict__ K, const bf16_t* __restrict__ V, const float* __restrict__ sink,
                                          bf16_t* __restrict__ O, int ocol, int H, int KV, int item, char* lds, int qs = DK) {
    constexpr int KS = DK * 2 + 16;
    constexpr int KCH = DK / 8;
    constexpr int KLD = (128 * KCH) / 512;
    constexpr int QB = 256 / G;
    constexpr int NCH = SEQ / QB;
    constexpr int KBUF = 128 * KS, VBUF = 128 * VS_BYTES;
    const int tid = tid_opaque(), lane = tid & 63, wave = tid >> 6;
    const int r32 = lane & 31, hh = lane >> 5;
    const int chunk = item % NCH, kvh = (item / NCH) % KV, b = item / (NCH * KV);
    const int g = (G == 2) ? (wave >> 2) : 0;
    const int qoff = (G == 2) ? (wave & 3) * 32 : wave * 32;
    const int head = kvh * G + g;
    const int q0 = chunk * QB;
    const int qpos = q0 + qoff + r32;
    bf16x8 qf[DK / 16];
    {
        const bf16_t* qp = Q + ((size_t)(b * H + head) * SEQ + qpos) * qs + hh * 8;
#pragma unroll
        for (int ks = 0; ks < DK / 16; ++ks) qf[ks] = *(const bf16x8*)(qp + ks * 16);
    }
    int kt_lo = 0, kt_hi = SEQ / 128;
    if (WINDOW) { kt_lo = q0 / 128 - 1; if (kt_lo < 0) kt_lo = 0; kt_hi = (q0 + QB) / 128 + 1; if (kt_hi > SEQ / 128) kt_hi = SEQ / 128; }
    const char* Kg = (const char*)(K + (size_t)(b * KV + kvh) * SEQ * DK);
    const char* Vg = (const char*)(V + (size_t)(b * KV + kvh) * SEQ * 64);
    uint4 kr0, kr1, kr2 = make_uint4(0, 0, 0, 0), vr0, vr1;
    const int koff0 = (tid / KCH) * KS + (tid % KCH) * 16;
    const int koff1 = ((tid + 512) / KCH) * KS + ((tid + 512) % KCH) * 16;
    const int koff2 = ((tid + 1024) / KCH) * KS + ((tid + 1024) % KCH) * 16;
    const int voff0 = (tid >> 3) * VS_BYTES + (tid & 7) * 16;
    const int voff1 = ((tid + 512) >> 3) * VS_BYTES + (tid & 7) * 16;
    f32x16 o[2];
#pragma unroll
    for (int d = 0; d < 2; ++d)
#pragma unroll
        for (int i = 0; i < 16; ++i) o[d][i] = 0.f;
    float m = -1e30f, l = 0.f;
    if (WINDOW) { m = sink[head] * LOG2E; l = (hh == 0) ? 1.f : 0.f; }
    const int gg = lane >> 4, li = lane & 15;
    const int vlane = (4 * (gg >> 1) + (li >> 2)) * VS_BYTES + (16 * (gg & 1) + 4 * (li & 3)) * 2;
    char* Kl = lds; char* Vl = lds + 2 * KBUF;
#define AGLOAD(KT) do { const char* _kg = Kg + (size_t)(KT) * 128 * DK * 2; const char* _vg = Vg + (size_t)(KT) * 128 * 128; \
        kr0 = *(const uint4*)(_kg + tid * 16); kr1 = *(const uint4*)(_kg + (tid + 512) * 16); if (KLD > 2) kr2 = *(const uint4*)(_kg + (tid + 1024) * 16); \
        vr0 = *(const uint4*)(_vg + tid * 16); vr1 = *(const uint4*)(_vg + (tid + 512) * 16); } while (0)
#define ASTORE(KB, VB) do { char* _kd = (KB); char* _vd = (VB); *(uint4*)(_kd + koff0) = kr0; *(uint4*)(_kd + koff1) = kr1; if (KLD > 2) *(uint4*)(_kd + koff2) = kr2; \
        *(uint4*)(_vd + voff0) = vr0; *(uint4*)(_vd + voff1) = vr1; } while (0)
    AGLOAD(kt_lo);
    ASTORE(Kl, Vl);
    { const int k1 = kt_lo + 1 < kt_hi ? kt_lo + 1 : kt_lo; AGLOAD(k1); }
    __syncthreads();
    for (int kt = kt_lo; kt < kt_hi; ++kt) {
        const int cur = (kt - kt_lo) & 1;
        ASTORE(Kl + (cur ^ 1) * KBUF, Vl + (cur ^ 1) * VBUF);
        { const int ktn = kt + 2 < kt_hi ? kt + 2 : kt_hi - 1; AGLOAD(ktn); }
        __builtin_amdgcn_sched_barrier(0);
#pragma unroll
        for (int sub = 0; sub < 2; ++sub) {
            const char* kb = Kl + cur * KBUF + sub * 64 * KS;
            const float mi = (m < -1e29f) ? 0.f : m;
            f32x16 s0, s1;
#pragma unroll
            for (int i = 0; i < 16; ++i) { s0[i] = -mi; s1[i] = -mi; }
#pragma unroll
            for (int ks = 0; ks < DK / 16; ++ks) {
                bf16x8 k0 = *(const bf16x8*)(kb + r32 * KS + (ks * 2 + hh) * 16);
                bf16x8 k1 = *(const bf16x8*)(kb + (32 + r32) * KS + (ks * 2 + hh) * 16);
                s0 = __builtin_amdgcn_mfma_f32_32x32x16_bf16(k0, qf[ks], s0, 0, 0, 0);
                s1 = __builtin_amdgcn_mfma_f32_32x32x16_bf16(k1, qf[ks], s1, 0, 0, 0);
            }
            if (WINDOW) {
                const int kb0 = kt * 128 + sub * 64 + 4 * hh - qpos;
#pragma unroll
                for (int i = 0; i < 16; ++i) {
                    const int d0 = kb0 + (i & 3) + 8 * (i >> 2), d1 = d0 + 32;
                    s0[i] = (d0 > 128 || d0 < -128) ? -1e30f : s0[i];
                    s1[i] = (d1 > 128 || d1 < -128) ? -1e30f : s1[i];
                }
            }
            const int vbase = (int)(size_t)(Vl + cur * VBUF - lds) + sub * 64 * VS_BYTES + vlane;
            PV_LOAD(0, vbase, vfa);
            PV_LOAD(1, vbase, vfb);
            __builtin_amdgcn_sched_barrier(0);
            float tmax = s0[0];
#pragma unroll
            for (int i = 1; i < 16; ++i) tmax = fmaxf(tmax, s0[i]);
#pragma unroll
            for (int i = 0; i < 16; ++i) tmax = fmaxf(tmax, s1[i]);
            tmax = xhalf_max(tmax);
            float ps = 0.f;
            if (__all(m > -1e29f && tmax <= 8.f)) {
#pragma unroll
                for (int i = 0; i < 16; ++i) { s0[i] = __builtin_amdgcn_exp2f(s0[i]); ps += s0[i]; }
#pragma unroll
                for (int i = 0; i < 16; ++i) { s1[i] = __builtin_amdgcn_exp2f(s1[i]); ps += s1[i]; }
                l += ps;
            } else {
                const float mn = fmaxf(m, mi + tmax);
                const float d = mn - mi;
                const float alpha = __builtin_amdgcn_exp2f(m - mn);
                m = mn;
#pragma unroll
                for (int i = 0; i < 16; ++i) { s0[i] = __builtin_amdgcn_exp2f(s0[i] - d); ps += s0[i]; }
#pragma unroll
                for (int i = 0; i < 16; ++i) { s1[i] = __builtin_amdgcn_exp2f(s1[i] - d); ps += s1[i]; }
                l = l * alpha + ps;
#pragma unroll
                for (int dd = 0; dd < 2; ++dd)
#pragma unroll
                    for (int i = 0; i < 16; ++i) o[dd][i] *= alpha;
            }
            asm volatile("s_waitcnt lgkmcnt(0)" ::: "memory");
            __builtin_amdgcn_sched_barrier(0);
            PV_MMA(o, s0, vfa);
            PV_MMA(o, s1, vfb);
        }
        __syncthreads();
    }
#undef AGLOAD
#undef ASTORE
    l = xhalf_sum(l);
    const float inv = 1.f / l;
    bf16_t* orow = O + (size_t)(b * SEQ + qpos) * DM + ocol + head * 64;
#pragma unroll
    for (int d = 0; d < 2; ++d)
#pragma unroll
        for (int gq = 0; gq < 4; ++gq) {
            uint2 w;
            w.x = cvtpk(o[d][gq * 4 + 0] * inv, o[d][gq * 4 + 1] * inv);
            w.y = cvtpk(o[d][gq * 4 + 2] * inv, o[d][gq * 4 + 3] * inv);
            *(uint2*)(orow + d * 32 + 8 * gq + 4 * hh) = w;
        }
}

__device__ __forceinline__ void dil_wave_item(const bf16_t* __restrict__ Q, const bf16_t* __restrict__ K, const bf16_t* __restrict__ V,
                                              bf16_t* __restrict__ O, int witem, char* wlds, int lds_off) {
    const int lane = tid_opaque() & 63, r32 = lane & 31, hh = lane >> 5;
    const int c = witem & 15, chunk = (witem >> 4) & 15, kvh = (witem >> 8) & 1, b = witem >> 9;
    const int t0 = chunk * 256;
    const int mq = r32 & 15, g = r32 >> 4;
    const int qpos = t0 + 16 * mq + c, head = kvh * 2 + g;
    bf16x8 qf[4];
    {
        const bf16_t* qp = Q + ((size_t)(b * 4 + head) * SEQ + qpos) * 64 + hh * 8;
#pragma unroll
        for (int ks = 0; ks < 4; ++ks) qf[ks] = *(const bf16x8*)(qp + ks * 16);
    }
    const bf16_t* Kg = K + (size_t)(b * 2 + kvh) * SEQ * 64;
    const bf16_t* Vg = V + (size_t)(b * 2 + kvh) * SEQ * 64;
    f32x16 o[2];
#pragma unroll
    for (int d = 0; d < 2; ++d)
#pragma unroll
        for (int i = 0; i < 16; ++i) o[d][i] = 0.f;
    float m = -1e30f, l = 0.f;
    const int gg = lane >> 4, li = lane & 15;
    const int vlane = lds_off + (4 * (gg >> 1) + (li >> 2)) * VS_BYTES + (16 * (gg & 1) + 4 * (li & 3)) * 2;
#define DIL_PARAMS(IT, SH, CC, IDX0, LIM) const int SH = (IT) < 12 ? 0 : ((IT) < 18 ? 2 : 4); const int CC = c & ((1 << SH) - 1); \
        const int IDX0 = (t0 >> SH) - 64 + 32 * ((IT) < 12 ? (IT) : ((IT) < 18 ? (IT) - 12 : (IT) - 18)); const int LIM = SEQ >> SH
#define DIL_LOAD(KF, VR, SH, CC, IDX0, LIM) do { \
        { int _i = IDX0 + r32; _i = _i < 0 ? 0 : (_i >= LIM ? LIM - 1 : _i); const bf16_t* _kp = Kg + (size_t)((_i << SH) + CC) * 64 + hh * 8; \
          KF##0 = *(const bf16x8*)(_kp); KF##1 = *(const bf16x8*)(_kp + 16); KF##2 = *(const bf16x8*)(_kp + 32); KF##3 = *(const bf16x8*)(_kp + 48); } \
        { int _i = IDX0 + (lane >> 3); _i = _i < 0 ? 0 : (_i >= LIM ? LIM - 1 : _i); VR##0 = *(const uint4*)(Vg + (size_t)((_i << SH) + CC) * 64 + (lane & 7) * 8); } \
        { int _i = IDX0 + 8 + (lane >> 3); _i = _i < 0 ? 0 : (_i >= LIM ? LIM - 1 : _i); VR##1 = *(const uint4*)(Vg + (size_t)((_i << SH) + CC) * 64 + (lane & 7) * 8); } \
        { int _i = IDX0 + 16 + (lane >> 3); _i = _i < 0 ? 0 : (_i >= LIM ? LIM - 1 : _i); VR##2 = *(const uint4*)(Vg + (size_t)((_i << SH) + CC) * 64 + (lane & 7) * 8); } \
        { int _i = IDX0 + 24 + (lane >> 3); _i = _i < 0 ? 0 : (_i >= LIM ? LIM - 1 : _i); VR##3 = *(const uint4*)(Vg + (size_t)((_i << SH) + CC) * 64 + (lane & 7) * 8); } } while (0)
    bf16x8 ka0, ka1, ka2, ka3, kb0, kb1, kb2, kb3;
    uint4 va0, va1, va2, va3, vb0, vb1, vb2, vb3;
    { DIL_PARAMS(0, sh0, cc0, ix0, lm0); DIL_LOAD(ka, va, sh0, cc0, ix0, lm0); }
#pragma unroll 1
    for (int it = 0; it < 23; ++it) {
        DIL_PARAMS(it, sh, cc, idx0, lim);
        {
            const int itn = it + 1 < 23 ? it + 1 : 22;
            DIL_PARAMS(itn, shn, ccn, ixn, lmn);
            DIL_LOAD(kb, vb, shn, ccn, ixn, lmn);
        }
        __builtin_amdgcn_sched_barrier(0);
        *(uint4*)(wlds + ((lane >> 3)) * VS_BYTES + (lane & 7) * 16) = va0;
        *(uint4*)(wlds + ((lane >> 3) + 8) * VS_BYTES + (lane & 7) * 16) = va1;
        *(uint4*)(wlds + ((lane >> 3) + 16) * VS_BYTES + (lane & 7) * 16) = va2;
        *(uint4*)(wlds + ((lane >> 3) + 24) * VS_BYTES + (lane & 7) * 16) = va3;
        f32x16 s;
#pragma unroll
        for (int i = 0; i < 16; ++i) s[i] = 0.f;
        s = __builtin_amdgcn_mfma_f32_32x32x16_bf16(ka0, qf[0], s, 0, 0, 0);
        s = __builtin_amdgcn_mfma_f32_32x32x16_bf16(ka1, qf[1], s, 0, 0, 0);
        s = __builtin_amdgcn_mfma_f32_32x32x16_bf16(ka2, qf[2], s, 0, 0, 0);
        s = __builtin_amdgcn_mfma_f32_32x32x16_bf16(ka3, qf[3], s, 0, 0, 0);

        const int qidx = qpos >> sh;
        const int base = idx0 + 4 * hh;
#pragma unroll
        for (int i = 0; i < 16; ++i) {
            const int idx = base + (i & 3) + 8 * (i >> 2);
            const int d = idx - qidx;
            s[i] = (d > 64 || d < -64 || idx < 0 || idx >= lim) ? -1e30f : s[i];
        }
        float tmax = s[0];
#pragma unroll
        for (int i = 1; i < 16; ++i) tmax = fmaxf(tmax, s[i]);
        tmax = fmaxf(tmax, xhalf(tmax));
        const float mn = fmaxf(fmaxf(m, tmax), -1e20f);
        const float alpha = __builtin_amdgcn_exp2f(m - mn);
        m = mn;
        float ps = 0.f;
#pragma unroll
        for (int i = 0; i < 16; ++i) { s[i] = __builtin_amdgcn_exp2f(s[i] - mn); ps += s[i]; }
        l = l * alpha + ps;
#pragma unroll
        for (int d = 0; d < 2; ++d)
#pragma unroll
            for (int i = 0; i < 16; ++i) o[d][i] *= alpha;
        pv_sub<0>(o, s, vlane);
        ka0 = kb0; ka1 = kb1; ka2 = kb2; ka3 = kb3; va0 = vb0; va1 = vb1; va2 = vb2; va3 = vb3;
    }
#undef DIL_PARAMS
#undef DIL_LOAD
    l += xhalf(l);
    const float inv = 1.f / l;
    bf16_t* orow = O + (size_t)(b * SEQ + qpos) * DM + 512 + head * 64;
#pragma unroll
    for (int d = 0; d < 2; ++d)
#pragma unroll
        for (int gq = 0; gq < 4; ++gq) {
            uint2 w;
            w.x = cvtpk(o[d][gq * 4 + 0] * inv, o[d][gq * 4 + 1] * inv);
            w.y = cvtpk(o[d][gq * 4 + 2] * inv, o[d][gq * 4 + 3] * inv);
            *(uint2*)(orow + d * 32 + 8 * gq + 4 * hh) = w;
        }
}

__device__ __forceinline__ int f2key(float f) { int b = __float_as_int(f); return b ^ ((b >> 31) & 0x7fffffff); }
__device__ __forceinline__ float key2f(int k) { return __int_as_float(k ^ ((k >> 31) & 0x7fffffff)); }

template <int N>
__device__ __forceinline__ void bitonic_sort_desc(int (&a)[N]) {
#pragma unroll
    for (int k = 2; k <= N; k <<= 1) {
#pragma unroll
        for (int j = k >> 1; j > 0; j >>= 1) {
#pragma unroll
            for (int i = 0; i < N; ++i) {
                const int l2 = i ^ j;
                if (l2 > i) {
                    const bool up = ((i & k) == 0);
                    const int hi = max(a[i], a[l2]), lo = min(a[i], a[l2]);
                    a[i] = up ? hi : lo; a[l2] = up ? lo : hi;
                }
            }
        }
    }
}
__device__ __forceinline__ void merge_top16(int (&a)[16], const int (&b)[16]) {
#pragma unroll
    for (int i = 0; i < 16; ++i) a[i] = max(a[i], b[15 - i]);
#pragma unroll
    for (int j = 8; j > 0; j >>= 1) {
#pragma unroll
        for (int i = 0; i < 16; ++i) {
            const int l2 = i ^ j;
            if (l2 > i) { const int hi = max(a[i], a[l2]), lo = min(a[i], a[l2]); a[i] = hi; a[l2] = lo; }
        }
    }
}
__device__ __forceinline__ void top16_of_64(int (&g0)[16], int (&g1)[16], int (&g2)[16], int (&g3)[16]) {
    bitonic_sort_desc<16>(g0); bitonic_sort_desc<16>(g1); bitonic_sort_desc<16>(g2); bitonic_sort_desc<16>(g3);
    merge_top16(g0, g1); merge_top16(g2, g3); merge_top16(g0, g2);
}

__device__ __forceinline__ void topk_core(const bf16_t* q0, const bf16_t* __restrict__ subk_h, float rscale, int* eo, float* go, char* wlds) {
    const int lane = tid_opaque() & 63, r32 = lane & 31, hh = lane >> 5;
    int top[2][16];
#pragma unroll
    for (int c = 0; c < 2; ++c) {
        bf16x8 qf[8];
        const bf16_t* qrow = q0 + c * 128;
#pragma unroll
        for (int ks = 0; ks < 8; ++ks) qf[ks] = *(const bf16x8*)(qrow + ks * 16);
        const bf16_t* kb = subk_h + ((size_t)c * 128 + r32) * 128 + hh * 8;
        int grp[4][16];
        bf16x8 kfa[8], kfb[8];
#pragma unroll
        for (int ks = 0; ks < 8; ++ks) kfa[ks] = *(const bf16x8*)(kb + ks * 16);
#pragma unroll
        for (int kt = 0; kt < 4; ++kt) {
            if (kt < 3) {
#pragma unroll
                for (int ks = 0; ks < 8; ++ks) kfb[ks] = *(const bf16x8*)(kb + (size_t)(kt + 1) * 32 * 128 + ks * 16);
            }
            __builtin_amdgcn_sched_barrier(0);
            f32x16 s;
#pragma unroll
            for (int i = 0; i < 16; ++i) s[i] = 0.f;
#pragma unroll
            for (int ks = 0; ks < 8; ++ks) s = __builtin_amdgcn_mfma_f32_32x32x16_bf16(kfa[ks], qf[ks], s, 0, 0, 0);
#pragma unroll
            for (int i = 0; i < 16; ++i) grp[kt][i] = (f2key(s[i]) & ~127) | (kt * 32 + crow(i, hh));
#pragma unroll
            for (int ks = 0; ks < 8; ++ks) kfa[ks] = kfb[ks];
        }
        top16_of_64(grp[0], grp[1], grp[2], grp[3]);
        int oth[16];
#pragma unroll
        for (int i = 0; i < 16; ++i) oth[i] = __shfl_xor(grp[0][i], 32);
        merge_top16(grp[0], oth);
#pragma unroll
        for (int i = 0; i < 16; ++i) top[c][i] = grp[0][i];
    }
    {
        unsigned* my = (unsigned*)(wlds + lane * 36);
#pragma unroll
        for (int c = 0; c < 2; ++c)
#pragma unroll
            for (int w4 = 0; w4 < 4; ++w4) {
                unsigned v = (top[c][w4 * 4] & 127) | ((top[c][w4 * 4 + 1] & 127) << 8) | ((top[c][w4 * 4 + 2] & 127) << 16) | ((top[c][w4 * 4 + 3] & 127) << 24);
                my[c * 4 + w4] = v;
            }
    }
    float v1[16], v2[16];
#pragma unroll
    for (int i = 0; i < 16; ++i) { v1[i] = key2f(top[0][i] & ~127); v2[i] = key2f(top[1][i] & ~127); }
    int cg[4][16];
    {
        int n = 0;
#pragma unroll
        for (int i = 0; i < 16; ++i)
#pragma unroll
            for (int j = 0; j < 16; ++j)
                if ((i + 1) * (j + 1) <= 16) { cg[n >> 4][n & 15] = (f2key(v1[i] + v2[j]) & ~255) | (i * 16 + j); ++n; }
#pragma unroll
        for (int q = 50; q < 64; ++q) cg[q >> 4][q & 15] = (int)0x80000000;
    }
    top16_of_64(cg[0], cg[1], cg[2], cg[3]);
    float bv[16];
#pragma unroll
    for (int i = 0; i < 16; ++i) bv[i] = key2f(cg[0][i] & ~255) * rscale;
    float sm = 0.f;
    const float bmx = bv[0];
#pragma unroll
    for (int i = 0; i < 16; ++i) { bv[i] = __expf(bv[i] - bmx); sm += bv[i]; }
    const float inv = 1.f / sm;
    if (hh == 0) {
        const unsigned char* my = (const unsigned char*)(wlds + lane * 36);
#pragma unroll
        for (int q4 = 0; q4 < 4; ++q4) {
            int4 ev; float4 gv;
            int* evp = (int*)&ev; float* gvp = (float*)&gv;
#pragma unroll
            for (int u = 0; u < 4; ++u) {
                const int code = cg[0][q4 * 4 + u] & 255;
                const int i1 = my[code >> 4], i2 = my[16 + (code & 15)];
                evp[u] = i1 * 128 + i2; gvp[u] = bv[q4 * 4 + u] * inv;
            }
            *(int4*)(eo + q4 * 4) = ev; *(float4*)(go + q4 * 4) = gv;
        }
    }
}

__device__ __forceinline__ void topk_wave_item(const bf16_t* __restrict__ qp, const bf16_t* __restrict__ subk, int* __restrict__ eidx, float* __restrict__ gate, int witem, char* wlds) {
    const int lane = tid_opaque() & 63, r32 = lane & 31, hh = lane >> 5;
    const int h = witem & 7, t = (witem >> 3) * 32 + r32;
    topk_core(qp + (size_t)t * 2048 + h * 256 + hh * 8, subk + (size_t)h * 2 * 128 * 128, 1.f, eidx + ((size_t)h * T_TOK + t) * 16, gate + ((size_t)h * T_TOK + t) * 16, wlds);
}
__device__ __forceinline__ void gemm_tile_topk(const bf16_t* __restrict__ X, int ldx, const bf16_t* __restrict__ W, int ldw, int K, int m0, int h, char* lds,
                                               const bf16_t* __restrict__ subk, const float* __restrict__ ssq, int* __restrict__ eidx, float* __restrict__ gate) {
    const int tid = tid_opaque(), lane = tid & 63, wave = tid >> 6;
    const int wm = wave >> 1, wn = wave & 1;
    const int r32 = lane & 31, hh = lane >> 5;
    {
        f32x16 acc[2][4];
        gemm_mainloop(X, ldx, W, ldw, K, m0, h * 256, 2048, lds, acc);
        bf16_t* qst = (bf16_t*)lds;
#pragma unroll
        for (int mt = 0; mt < 2; ++mt)
#pragma unroll
            for (int nt = 0; nt < 4; ++nt)
#pragma unroll
                for (int i = 0; i < 16; ++i)
                    qst[(wm * 64 + mt * 32 + crow(i, hh)) * QST + wn * 128 + nt * 32 + r32] = f2bf(acc[mt][nt][i]);
    }
    __syncthreads();
    {
        const int tok = wave * 32 + r32, t = m0 + tok;
        float tot = 0.f;
#pragma unroll
        for (int j = 0; j < 4; ++j) { const float4 q = *(const float4*)(ssq + ((size_t)j * T_TOK + t) * 4); tot += (q.x + q.y) + (q.z + q.w); }
        const float r = rsqrtf(tot * (1.f / DM) + 1e-6f);
        topk_core((const bf16_t*)lds + tok * QST + hh * 8, subk + (size_t)h * 2 * 128 * 128, r, eidx + ((size_t)h * T_TOK + t) * 16, gate + ((size_t)h * T_TOK + t) * 16,
                  lds + TOPK_STASH + wave * 2304);
    }
    __syncthreads();
}

typedef __attribute__((ext_vector_type(2))) float f32x2;
__device__ __forceinline__ float fdot2bf(unsigned a, unsigned b, float acc) {
    return __builtin_amdgcn_fdot2_f32_bf16(*(bf16x2_t*)&a, *(bf16x2_t*)&b, acc, false);
}
__device__ __forceinline__ unsigned fp8pair_to_bf16(unsigned w, bool hi) {
    bf16x2_t r = hi ? __builtin_amdgcn_cvt_scalef32_pk_bf16_fp8((int)w, 1.0f, true) : __builtin_amdgcn_cvt_scalef32_pk_bf16_fp8((int)w, 1.0f, false);
    return *(unsigned*)&r;
}
__device__ __forceinline__ float dot16_fp8(uint4 u, const unsigned (&h)[8]) {
    float a = 0.f;
    a = fdot2bf(fp8pair_to_bf16(u.x, false), h[0], a); a = fdot2bf(fp8pair_to_bf16(u.x, true), h[1], a);
    a = fdot2bf(fp8pair_to_bf16(u.y, false), h[2], a); a = fdot2bf(fp8pair_to_bf16(u.y, true), h[3], a);
    a = fdot2bf(fp8pair_to_bf16(u.z, false), h[4], a); a = fdot2bf(fp8pair_to_bf16(u.z, true), h[5], a);
    a = fdot2bf(fp8pair_to_bf16(u.w, false), h[6], a); a = fdot2bf(fp8pair_to_bf16(u.w, true), h[7], a);
    return a;
}
__device__ __forceinline__ void axpy16_fp8(float (&acc)[16], float w, uint4 v) {
    f32x2 r;
    r = __builtin_amdgcn_cvt_pk_f32_fp8((int)v.x, false); acc[0] += w * r[0]; acc[1] += w * r[1];
    r = __builtin_amdgcn_cvt_pk_f32_fp8((int)v.x, true);  acc[2] += w * r[0]; acc[3] += w * r[1];
    r = __builtin_amdgcn_cvt_pk_f32_fp8((int)v.y, false); acc[4] += w * r[0]; acc[5] += w * r[1];
    r = __builtin_amdgcn_cvt_pk_f32_fp8((int)v.y, true);  acc[6] += w * r[0]; acc[7] += w * r[1];
    r = __builtin_amdgcn_cvt_pk_f32_fp8((int)v.z, false); acc[8] += w * r[0]; acc[9] += w * r[1];
    r = __builtin_amdgcn_cvt_pk_f32_fp8((int)v.z, true);  acc[10] += w * r[0]; acc[11] += w * r[1];
    r = __builtin_amdgcn_cvt_pk_f32_fp8((int)v.w, false); acc[12] += w * r[0]; acc[13] += w * r[1];
    r = __builtin_amdgcn_cvt_pk_f32_fp8((int)v.w, true);  acc[14] += w * r[0]; acc[15] += w * r[1];
}
__device__ __forceinline__ float gelu_exact(float a) { return 0.5f * a * (1.f + erff(a * 0.70710678118654752f)); }

__device__ __forceinline__ float transpose_reduce16(f32x16 p, int lane) {
#pragma unroll
    for (int st = 0; st < 4; ++st) {
        const int o = 32 >> st, n = 16 >> st;
        const bool up = (lane & o) != 0;
#pragma unroll
        for (int i = 0; i < n / 2; ++i) {
            float lo = p[i], hi = p[i + n / 2];
            asm volatile("" : "+v"(lo), "+v"(hi));
            const float keep = up ? hi : lo;
            const float send = up ? lo : hi;
            p[i] = keep + __shfl_xor(send, o);
        }
    }
    float v = p[0];
    v += __shfl_xor(v, 1); v += __shfl_xor(v, 2);
    return v;
}
#define EX_SB() __builtin_amdgcn_sched_barrier(0)
#define EX_LD1(R, TAB, EB, S) R = *(const uint4*)((TAB) + (unsigned)((__builtin_amdgcn_readlane((EB), (S)) << 10) + lane16))
#define EX_LOAD8(P, TAB, EB, SL) do { EX_LD1(P##0, TAB, EB, (SL) + 0); EX_LD1(P##1, TAB, EB, (SL) + 1); EX_LD1(P##2, TAB, EB, (SL) + 2); EX_LD1(P##3, TAB, EB, (SL) + 3); \
        EX_LD1(P##4, TAB, EB, (SL) + 4); EX_LD1(P##5, TAB, EB, (SL) + 5); EX_LD1(P##6, TAB, EB, (SL) + 6); EX_LD1(P##7, TAB, EB, (SL) + 7); } while (0)
#define EX_DOT8(P, PP, O) do { PP[(O) + 0] = dot16_fp8(P##0, hp); PP[(O) + 1] = dot16_fp8(P##1, hp); PP[(O) + 2] = dot16_fp8(P##2, hp); PP[(O) + 3] = dot16_fp8(P##3, hp); \
        PP[(O) + 4] = dot16_fp8(P##4, hp); PP[(O) + 5] = dot16_fp8(P##5, hp); PP[(O) + 6] = dot16_fp8(P##6, hp); PP[(O) + 7] = dot16_fp8(P##7, hp); } while (0)
#define EX_RL(W, S) __int_as_float(__builtin_amdgcn_readlane(__float_as_int(W), (S)))
#define EX_AXPY8(P, W, SL) do { axpy16_fp8(acc, EX_RL(W, (SL) + 0), P##0); axpy16_fp8(acc, EX_RL(W, (SL) + 1), P##1); axpy16_fp8(acc, EX_RL(W, (SL) + 2), P##2); axpy16_fp8(acc, EX_RL(W, (SL) + 3), P##3); \
        axpy16_fp8(acc, EX_RL(W, (SL) + 4), P##4); axpy16_fp8(acc, EX_RL(W, (SL) + 5), P##5); axpy16_fp8(acc, EX_RL(W, (SL) + 6), P##6); axpy16_fp8(acc, EX_RL(W, (SL) + 7), P##7); } while (0)
#define EX_COPY8(D, S_) do { D##0 = S_##0; D##1 = S_##1; D##2 = S_##2; D##3 = S_##3; D##4 = S_##4; D##5 = S_##5; D##6 = S_##6; D##7 = S_##7; } while (0)

#ifndef EXS_NS
#define EXS_NS 16
#endif
#ifndef EXS_SYNC
#define EXS_SYNC 1
#endif
__device__ __forceinline__ int ex_mbcnt(unsigned long long m) { return __builtin_amdgcn_mbcnt_hi((unsigned)(m >> 32), __builtin_amdgcn_mbcnt_lo((unsigned)m, 0u)); }
__device__ __forceinline__ void xcd_local_sync_p(char* st);
__device__ __forceinline__ void expert_token(PC& p, int layer, int t, bool last, int2* lst, char* syncp, bool dummy = false) {
    const int lane = tid_opaque() & 63;
    const int lane16 = lane * 16;
    const float* gfb = p.g_ffn + layer * DM; asm volatile("" : "+s"(gfb));
    const float* gf = gfb + lane * 16;
    float* xrow = p.x + (size_t)t * DM + lane * 16;
    float* xwr = dummy ? (float*)p.zb + (size_t)t * DM + lane * 16 : xrow;
    bf16_t* hwr = (dummy ? p.q.qA + (size_t)t * DM : p.hnb + (size_t)t * DM) + lane * 16;
    float xv[16];
#pragma unroll
    for (int q = 0; q < 4; ++q) { const float4 a = *(const float4*)(xrow + 4 * q); xv[4 * q] = a.x; xv[4 * q + 1] = a.y; xv[4 * q + 2] = a.z; xv[4 * q + 3] = a.w; }
    float ss = 0.f;
#pragma unroll
    for (int i = 0; i < 16; ++i) ss += xv[i] * xv[i];
    ss = wave_sum(ss);
    const float rstd = rsqrtf(ss * (1.f / DM) + 1e-6f);
    unsigned hp[8];
#pragma unroll
    for (int q = 0; q < 4; ++q) {
        const float4 g = *(const float4*)(gf + 4 * q);
        hp[2 * q] = cvtpk(xv[4 * q] * rstd * g.x, xv[4 * q + 1] * rstd * g.y);
        hp[2 * q + 1] = cvtpk(xv[4 * q + 2] * rstd * g.z, xv[4 * q + 3] * rstd * g.w);
    }
    const size_t ei0 = ((size_t)(lane >> 4) * T_TOK + t) * 16 + (lane & 15), ei1 = ei0 + (size_t)4 * T_TOK * 16;
    int e0 = p.eidx[ei0], e1 = p.eidx[ei1];
    float g0 = p.gate[ei0], g1 = p.gate[ei1];
    {
        const int s0 = ((e0 >> 7) + e0) & (EXS_NS - 1), s1 = ((e1 >> 7) + e1) & (EXS_NS - 1);
        int base = 0, pos0 = 0, pos1 = 0;
#pragma unroll
        for (int s = 0; s < EXS_NS; ++s) {
            const unsigned long long m0 = __ballot(s0 == s), m1 = __ballot(s1 == s);
            const int c0 = __popcll(m0);
            pos0 = (s0 == s) ? base + ex_mbcnt(m0) : pos0;
            pos1 = (s1 == s) ? base + c0 + ex_mbcnt(m1) : pos1;
            base += c0 + __popcll(m1);
        }
        lst[pos0] = make_int2(e0, __float_as_int(g0)); lst[pos1] = make_int2(e1, __float_as_int(g1));
        const int2 q0 = lst[lane], q1 = lst[64 + lane];
        e0 = q0.x; g0 = __int_as_float(q0.y); e1 = q1.x; g1 = __int_as_float(q1.y);
    }
    const unsigned char* u8 = p.u8 + (size_t)layer * 16384 * DM;
    const unsigned char* v8 = p.v8 + (size_t)layer * 16384 * DM;
    const float* su = p.su + layer * 16384; const float* sv = p.sv + layer * 16384;
    const float su0 = su[e0], su1 = su[e1], sv0 = sv[e0], sv1 = sv[e1];
    uint4 rx0, rx1, rx2, rx3, rx4, rx5, rx6, rx7, ry0, ry1, ry2, ry3, ry4, ry5, ry6, ry7;
    float a0 = 0.f, a1 = 0.f;
    EX_LOAD8(rx, u8, e0, 0);
#pragma unroll 1
    for (int g = 0; g < 8; ++g) {
        const int eb = g < 4 ? e0 : e1;
        const int sl = (g & 3) * 16;
        f32x16 pp;
        EX_LOAD8(ry, u8, eb, sl + 8);
        EX_SB();
        EX_DOT8(rx, pp, 0);
        EX_SB();
        {
            const int gn = g + 1 < 8 ? g + 1 : 0;
            const int ebn = gn < 4 ? e0 : e1;
            const unsigned char* tabn = g + 1 < 8 ? u8 : v8;
            EX_LOAD8(rx, tabn, ebn, (gn & 3) * 16);
        }
        EX_SB();
        EX_DOT8(ry, pp, 8);
        const float v = transpose_reduce16(pp, lane);
        const float got = __shfl(v, (lane & 15) << 2);
        const bool mine = (lane >> 4) == (g & 3);
        a0 = (mine && g < 4) ? got : a0;
        a1 = (mine && g >= 4) ? got : a1;
        EX_SB();
    }
#if EXS_SYNC >= 2
    if (syncp) xcd_local_sync_p(syncp);
#endif
    const float w0 = g0 * gelu_exact(su0 * a0) * sv0;
    const float w1 = g1 * gelu_exact(su1 * a1) * sv1;
    float acc[16];
#pragma unroll
    for (int i = 0; i < 16; ++i) acc[i] = 0.f;
#pragma unroll 1
    for (int h2 = 0; h2 < 8; ++h2) {
        const int ebc = h2 < 4 ? e0 : e1;
        const float wb = h2 < 4 ? w0 : w1;
        const int slc = (h2 & 3) * 16;
        EX_LOAD8(ry, v8, ebc, slc + 8);
        EX_SB();
        EX_AXPY8(rx, wb, slc);
        EX_SB();
        {
            const int hn_ = h2 + 1 < 8 ? h2 + 1 : 7;
            const int ebn = hn_ < 4 ? e0 : e1;
            EX_LOAD8(rx, v8, ebn, (hn_ & 3) * 16);
        }
        EX_SB();
        EX_AXPY8(ry, wb, slc + 8);
        EX_SB();
    }
#pragma unroll
    for (int i = 0; i < 16; ++i) xv[i] += acc[i];
    float s2 = 0.f;
#pragma unroll
    for (int i = 0; i < 16; ++i) s2 += xv[i] * xv[i];
    s2 = wave_sum(s2);
    const float r2 = rsqrtf(s2 * (1.f / DM) + 1e-6f);
    if (!last) {
#pragma unroll
        for (int q = 0; q < 4; ++q) *(float4*)(xwr + 4 * q) = make_float4(xv[4 * q], xv[4 * q + 1], xv[4 * q + 2], xv[4 * q + 3]);
        const float* gnb = p.g_mix + (layer + 1) * DM; asm volatile("" : "+s"(gnb));
        const float* gn = gnb + lane * 16;
        unsigned hw[8];
#pragma unroll
        for (int q = 0; q < 4; ++q) {
            const float4 g = *(const float4*)(gn + 4 * q);
            hw[2 * q] = cvtpk(xv[4 * q] * r2 * g.x, xv[4 * q + 1] * r2 * g.y);
            hw[2 * q + 1] = cvtpk(xv[4 * q + 2] * r2 * g.z, xv[4 * q + 3] * r2 * g.w);
        }
        *(uint4*)(hwr) = make_uint4(hw[0], hw[1], hw[2], hw[3]);
        *(uint4*)(hwr + 8) = make_uint4(hw[4], hw[5], hw[6], hw[7]);
    } else {
        const float* gnb = p.g_final; asm volatile("" : "+s"(gnb));
        const float* gn = gnb + lane * 16;
        float* orow = dummy ? xwr : p.out + (size_t)t * DM + lane * 16;
#pragma unroll
        for (int q = 0; q < 4; ++q) {
            const float4 g = *(const float4*)(gn + 4 * q);
            *(float4*)(orow + 4 * q) = make_float4(xv[4 * q] * r2 * g.x, xv[4 * q + 1] * r2 * g.y, xv[4 * q + 2] * r2 * g.z, xv[4 * q + 3] * r2 * g.w);
        }
    }
}

#define EX_DOT8H(P, PP, O, HP) do { PP[(O) + 0] = dot16_fp8(P##0, HP); PP[(O) + 1] = dot16_fp8(P##1, HP); PP[(O) + 2] = dot16_fp8(P##2, HP); PP[(O) + 3] = dot16_fp8(P##3, HP); \
        PP[(O) + 4] = dot16_fp8(P##4, HP); PP[(O) + 5] = dot16_fp8(P##5, HP); PP[(O) + 6] = dot16_fp8(P##6, HP); PP[(O) + 7] = dot16_fp8(P##7, HP); } while (0)
#define EX_AXPY8A(P, W, SL, ACC) do { axpy16_fp8(ACC, EX_RL(W, (SL) + 0), P##0); axpy16_fp8(ACC, EX_RL(W, (SL) + 1), P##1); axpy16_fp8(ACC, EX_RL(W, (SL) + 2), P##2); axpy16_fp8(ACC, EX_RL(W, (SL) + 3), P##3); \
        axpy16_fp8(ACC, EX_RL(W, (SL) + 4), P##4); axpy16_fp8(ACC, EX_RL(W, (SL) + 5), P##5); axpy16_fp8(ACC, EX_RL(W, (SL) + 6), P##6); axpy16_fp8(ACC, EX_RL(W, (SL) + 7), P##7); } while (0)
__device__ __forceinline__ void ex2_begin(PC& p, int layer, int t, int lane, int2* lst, float (&xv)[16], unsigned (&hp)[8], int& e0, int& e1, float& g0, float& g1) {
    const float* gfb = p.g_ffn + layer * DM; asm volatile("" : "+s"(gfb));
    const float* gf = gfb + lane * 16;
    const float* xrow = p.x + (size_t)t * DM + lane * 16;
#pragma unroll
    for (int q = 0; q < 4; ++q) { const float4 a = *(const float4*)(xrow + 4 * q); xv[4 * q] = a.x; xv[4 * q + 1] = a.y; xv[4 * q + 2] = a.z; xv[4 * q + 3] = a.w; }
    float ss = 0.f;
#pragma unroll
    for (int i = 0; i < 16; ++i) ss += xv[i] * xv[i];
    ss = wave_sum(ss);
    const float rstd = rsqrtf(ss * (1.f / DM) + 1e-6f);
#pragma unroll
    for (int q = 0; q < 4; ++q) {
        const float4 g = *(const float4*)(gf + 4 * q);
        hp[2 * q] = cvtpk(xv[4 * q] * rstd * g.x, xv[4 * q + 1] * rstd * g.y);
        hp[2 * q + 1] = cvtpk(xv[4 * q + 2] * rstd * g.z, xv[4 * q + 3] * rstd * g.w);
    }
    const size_t ei0 = ((size_t)(lane >> 4) * T_TOK + t) * 16 + (lane & 15), ei1 = ei0 + (size_t)4 * T_TOK * 16;
    e0 = p.eidx[ei0]; e1 = p.eidx[ei1];
    g0 = p.gate[ei0]; g1 = p.gate[ei1];
    const int s0 = ((e0 >> 7) + e0) & (EXS_NS - 1), s1 = ((e1 >> 7) + e1) & (EXS_NS - 1);
    int base = 0, pos0 = 0, pos1 = 0;
#pragma unroll
    for (int s = 0; s < EXS_NS; ++s) {
        const unsigned long long m0 = __ballot(s0 == s), m1 = __ballot(s1 == s);
        const int c0 = __popcll(m0);
        pos0 = (s0 == s) ? base + ex_mbcnt(m0) : pos0;
        pos1 = (s1 == s) ? base + c0 + ex_mbcnt(m1) : pos1;
        base += c0 + __popcll(m1);
    }
    lst[pos0] = make_int2(e0, __float_as_int(g0)); lst[pos1] = make_int2(e1, __float_as_int(g1));
    const int2 q0 = lst[lane], q1 = lst[64 + lane];
    e0 = q0.x; g0 = __int_as_float(q0.y); e1 = q1.x; g1 = __int_as_float(q1.y);
}
__device__ __forceinline__ void ex2_end(PC& p, int layer, int t, int lane, bool last, bool dummy, float (&xv)[16], const float (&acc)[16]) {
    float* xwr = (dummy ? (float*)p.zb : p.x) + (size_t)t * DM + lane * 16;
    bf16_t* hwr = (dummy ? p.q.qA + (size_t)t * DM : p.hnb + (size_t)t * DM) + lane * 16;
#pragma unroll
    for (int i = 0; i < 16; ++i) xv[i] += acc[i];
    float s2 = 0.f;
#pragma unroll
    for (int i = 0; i < 16; ++i) s2 += xv[i] * xv[i];
    s2 = wave_sum(s2);
    const float r2 = rsqrtf(s2 * (1.f / DM) + 1e-6f);
    if (!last) {
#pragma unroll
        for (int q = 0; q < 4; ++q) *(float4*)(xwr + 4 * q) = make_float4(xv[4 * q], xv[4 * q + 1], xv[4 * q + 2], xv[4 * q + 3]);
        const float* gnb = p.g_mix + (layer + 1) * DM; asm volatile("" : "+s"(gnb));
        const float* gn = gnb + lane * 16;
        unsigned hw[8];
#pragma unroll
        for (int q = 0; q < 4; ++q) {
            const float4 g = *(const float4*)(gn + 4 * q);
            hw[2 * q] = cvtpk(xv[4 * q] * r2 * g.x, xv[4 * q + 1] * r2 * g.y);
            hw[2 * q + 1] = cvtpk(xv[4 * q + 2] * r2 * g.z, xv[4 * q + 3] * r2 * g.w);
        }
        *(uint4*)(hwr) = make_uint4(hw[0], hw[1], hw[2], hw[3]);
        *(uint4*)(hwr + 8) = make_uint4(hw[4], hw[5], hw[6], hw[7]);
    } else {
        const float* gnb = p.g_final; asm volatile("" : "+s"(gnb));
        const float* gn = gnb + lane * 16;
        float* orow = dummy ? xwr : p.out + (size_t)t * DM + lane * 16;
#pragma unroll
        for (int q = 0; q < 4; ++q) {
            const float4 g = *(const float4*)(gn + 4 * q);
            *(float4*)(orow + 4 * q) = make_float4(xv[4 * q] * r2 * g.x, xv[4 * q + 1] * r2 * g.y, xv[4 * q + 2] * r2 * g.z, xv[4 * q + 3] * r2 * g.w);
        }
    }
}
__device__ __forceinline__ void expert_token2(PC& p, int layer, int tA, int tB, bool last, int2* lst, bool dummy) {
    const int lane = tid_opaque() & 63;
    const int lane16 = lane * 16;
    float xvA[16], xvB[16]; unsigned hpA[8], hpB[8];
    int e0A, e1A, e0B, e1B; float g0A, g1A, g0B, g1B;
    ex2_begin(p, layer, tA, lane, lst, xvA, hpA, e0A, e1A, g0A, g1A);
    EX_SB();
    ex2_begin(p, layer, tB, lane, lst + 128, xvB, hpB, e0B, e1B, g0B, g1B);
    EX_SB();
    const unsigned char* u8 = p.u8 + (size_t)layer * 16384 * DM;
    const unsigned char* v8 = p.v8 + (size_t)layer * 16384 * DM;
    const float* su = p.su + layer * 16384; const float* sv = p.sv + layer * 16384;
    const float su0A = su[e0A], su1A = su[e1A], sv0A = sv[e0A], sv1A = sv[e1A];
    const float su0B = su[e0B], su1B = su[e1B], sv0B = sv[e0B], sv1B = sv[e1B];
    uint4 rx0, rx1, rx2, rx3, rx4, rx5, rx6, rx7, ry0, ry1, ry2, ry3, ry4, ry5, ry6, ry7;
    float a0A = 0.f, a1A = 0.f, a0B = 0.f, a1B = 0.f;
    EX_LOAD8(rx, u8, e0A, 0);
#pragma unroll 1
    for (int g = 0; g < 8; ++g) {
        const int ebA = g < 4 ? e0A : e1A, ebB = g < 4 ? e0B : e1B;
        const int sl = (g & 3) * 16;
        const bool mine = (lane >> 4) == (g & 3);
        f32x16 pp;
        EX_LOAD8(ry, u8, ebA, sl + 8);
        EX_SB();
        EX_DOT8H(rx, pp, 0, hpA);
        EX_SB();
        EX_LOAD8(rx, u8, ebB, sl);
        EX_SB();
        EX_DOT8H(ry, pp, 8, hpA);
        {
            const float v = transpose_reduce16(pp, lane);
            const float got = __shfl(v, (lane & 15) << 2);
            a0A = (mine && g < 4) ? got : a0A;
            a1A = (mine && g >= 4) ? got : a1A;
        }
        EX_SB();
        EX_LOAD8(ry, u8, ebB, sl + 8);
        EX_SB();
        EX_DOT8H(rx, pp, 0, hpB);
        EX_SB();
        {
            const int gn = g + 1 < 8 ? g + 1 : 0;
            const int ebn = gn < 4 ? e0A : e1A;
            const unsigned char* tabn = g + 1 < 8 ? u8 : v8;
            EX_LOAD8(rx, tabn, ebn, (gn & 3) * 16);
        }
        EX_SB();
        EX_DOT8H(ry, pp, 8, hpB);
        {
            const float v = transpose_reduce16(pp, lane);
            const float got = __shfl(v, (lane & 15) << 2);
            a0B = (mine && g < 4) ? got : a0B;
            a1B = (mine && g >= 4) ? got : a1B;
        }
        EX_SB();
    }
    const float w0A = g0A * gelu_exact(su0A * a0A) * sv0A, w1A = g1A * gelu_exact(su1A * a1A) * sv1A;
    const float w0B = g0B * gelu_exact(su0B * a0B) * sv0B, w1B = g1B * gelu_exact(su1B * a1B) * sv1B;
    float accA[16], accB[16];
#pragma unroll
    for (int i = 0; i < 16; ++i) { accA[i] = 0.f; accB[i] = 0.f; }
#pragma unroll 1
    for (int h2 = 0; h2 < 8; ++h2) {
        const int ebcA = h2 < 4 ? e0A : e1A, ebcB = h2 < 4 ? e0B : e1B;
        const float wbA = h2 < 4 ? w0A : w1A, wbB = h2 < 4 ? w0B : w1B;
        const int slc = (h2 & 3) * 16;
        EX_LOAD8(ry, v8, ebcA, slc + 8);
        EX_SB();
        EX_AXPY8A(rx, wbA, slc, accA);
        EX_SB();
        EX_LOAD8(rx, v8, ebcB, slc);
        EX_SB();
        EX_AXPY8A(ry, wbA, slc + 8, accA);
        EX_SB();
        EX_LOAD8(ry, v8, ebcB, slc + 8);
        EX_SB();
        EX_AXPY8A(rx, wbB, slc, accB);
        EX_SB();
        {
            const int hn_ = h2 + 1 < 8 ? h2 + 1 : 7;
            const int ebn = hn_ < 4 ? e0A : e1A;
            EX_LOAD8(rx, v8, ebn, (hn_ & 3) * 16);
        }
        EX_SB();
        EX_AXPY8A(ry, wbB, slc + 8, accB);
        EX_SB();
    }
    ex2_end(p, layer, tA, lane, last, dummy, xvA, accA);
    EX_SB();
    ex2_end(p, layer, tB, lane, last, dummy, xvB, accB);
}

__device__ __forceinline__ void ex2_endr(PC& p, int layer, int t, int lane, bool last, bool dummy, const float (&acc)[16]) {
    t = __builtin_amdgcn_readfirstlane(t); asm volatile("" : "+s"(t));
    float xv[16];
    const float* xrow = p.x + (size_t)t * DM + lane * 16;
#pragma unroll
    for (int q = 0; q < 4; ++q) { const float4 a = *(const float4*)(xrow + 4 * q); xv[4 * q] = a.x; xv[4 * q + 1] = a.y; xv[4 * q + 2] = a.z; xv[4 * q + 3] = a.w; }
    float zero[16];
#pragma unroll
    for (int i = 0; i < 16; ++i) { xv[i] += acc[i]; zero[i] = 0.f; }
    ex2_end(p, layer, t, lane, last, dummy, xv, zero);
}
#define EX_ACCIN(A) "v"(A[0]), "v"(A[1]), "v"(A[2]), "v"(A[3]), "v"(A[4]), "v"(A[5]), "v"(A[6]), "v"(A[7]), "v"(A[8]), "v"(A[9]), "v"(A[10]), "v"(A[11]), "v"(A[12]), "v"(A[13]), "v"(A[14]), "v"(A[15])
#define EX_ORDER2(RA, RB, A) asm volatile("" : "+v"(RA.x), "+v"(RA.y), "+v"(RA.z), "+v"(RA.w), "+v"(RB.x), "+v"(RB.y), "+v"(RB.z), "+v"(RB.w) : EX_ACCIN(A))
#define EX_AXPY8K(P, W, SL, ACC) do { axpy16_fp8(ACC, EX_RL(W, (SL) + 0), P##0); axpy16_fp8(ACC, EX_RL(W, (SL) + 1), P##1); axpy16_fp8(ACC, EX_RL(W, (SL) + 2), P##2); axpy16_fp8(ACC, EX_RL(W, (SL) + 3), P##3); \
        EX_ORDER2(P##4, P##5, ACC); EX_ORDER2(P##6, P##7, ACC); \
        axpy16_fp8(ACC, EX_RL(W, (SL) + 4), P##4); axpy16_fp8(ACC, EX_RL(W, (SL) + 5), P##5); axpy16_fp8(ACC, EX_RL(W, (SL) + 6), P##6); axpy16_fp8(ACC, EX_RL(W, (SL) + 7), P##7); } while (0)
#ifndef EXK_PIN
#define EXK_PIN 1
#endif
template <int K>
__device__ __forceinline__ void expert_tokens(PC& p, int layer, const int (&tq)[K], bool last, int2* lst) {
    int tt[K]; bool dm[K];
#pragma unroll
    for (int k = 0; k < K; ++k) { dm[k] = tq[k] >= T_TOK; tt[k] = dm[k] ? T_TOK - 1 : tq[k]; }
    const int lane = tid_opaque() & 63;
    const int lane16 = lane * 16;
    unsigned hp[K][8];
    int e0[K], e1[K];
#pragma unroll
    for (int k = 0; k < K; ++k) { float xv[16]; float g0, g1; ex2_begin(p, layer, tt[k], lane, lst + 128 * k, xv, hp[k], e0[k], e1[k], g0, g1); EX_SB(); }
    const unsigned char* u8 = p.u8 + (size_t)layer * 16384 * DM;
    const unsigned char* v8 = p.v8 + (size_t)layer * 16384 * DM;
    const float* su = p.su + layer * 16384; const float* sv = p.sv + layer * 16384;
    float a0[K], a1[K];
#pragma unroll
    for (int k = 0; k < K; ++k) { a0[k] = 0.f; a1[k] = 0.f; }
    uint4 rx0, rx1, rx2, rx3, rx4, rx5, rx6, rx7, ry0, ry1, ry2, ry3, ry4, ry5, ry6, ry7;
#define EXK_E(KK, HALF) ((HALF) ? e1[KK] : e0[KK])
    { const int eb = EXK_E(0, 0); EX_LOAD8(rx, u8, eb, 0); }
#pragma unroll 1
    for (int g = 0; g < 8; ++g) {
        const int sl = (g & 3) * 16, hf = g >> 2;
        const bool mine = (lane >> 4) == (g & 3);
#pragma unroll
        for (int k = 0; k < K; ++k) {
            f32x16 pp;
            { const int ebk = EXK_E(k, hf); EX_LOAD8(ry, u8, ebk, sl + 8); }
            EX_SB();
            EX_DOT8H(rx, pp, 0, hp[k]);
            EX_SB();
            if (k + 1 < K) { const int ebn = EXK_E((k + 1) % K, hf); EX_LOAD8(rx, u8, ebn, sl); }
            else {
                const int gn = g + 1 < 8 ? g + 1 : 0;
                const int ebn = EXK_E(0, gn >> 2);
                const unsigned char* tabn = g + 1 < 8 ? u8 : v8;
                EX_LOAD8(rx, tabn, ebn, (gn & 3) * 16);
            }
            EX_SB();
            EX_DOT8H(ry, pp, 8, hp[k]);
            const float v = transpose_reduce16(pp, lane);
            const float got = __shfl(v, (lane & 15) << 2);
            a0[k] = (mine && g < 4) ? got : a0[k];
            a1[k] = (mine && g >= 4) ? got : a1[k];
            EX_SB();
        }
    }
    float w0[K], w1[K], acc[K][16];
    {
        float s0[K], s1[K], t0[K], t1[K], gg0[K], gg1[K];
#pragma unroll
        for (int k = 0; k < K; ++k) {
            s0[k] = su[e0[k]]; s1[k] = su[e1[k]]; t0[k] = sv[e0[k]]; t1[k] = sv[e1[k]];
            gg0[k] = __int_as_float(lst[128 * k + lane].y); gg1[k] = __int_as_float(lst[128 * k + 64 + lane].y);
        }
#pragma unroll
        for (int k = 0; k < K; ++k) { w0[k] = gg0[k] * gelu_exact(s0[k] * a0[k]) * t0[k]; w1[k] = gg1[k] * gelu_exact(s1[k] * a1[k]) * t1[k]; }
    }
#pragma unroll
    for (int k = 0; k < K; ++k)
#pragma unroll
        for (int i = 0; i < 16; ++i) acc[k][i] = 0.f;
#pragma unroll 1
    for (int h2 = 0; h2 < 8; ++h2) {
        const int slc = (h2 & 3) * 16, hf = h2 >> 2;
#pragma unroll
        for (int k = 0; k < K; ++k) {
            const float wb = h2 < 4 ? w0[k] : w1[k];
            { const int ebc = EXK_E(k, hf); EX_LOAD8(ry, v8, ebc, slc + 8); }
            EX_SB();
            if (K >= EXK_PIN) EX_AXPY8K(rx, wb, slc, acc[k]); else EX_AXPY8A(rx, wb, slc, acc[k]);
            EX_SB();
            if (k + 1 < K) { const int ebn = EXK_E((k + 1) % K, hf); EX_LOAD8(rx, v8, ebn, slc); }
            else { const int hn_ = h2 + 1 < 8 ? h2 + 1 : 7; const int ebn = EXK_E(0, hn_ >> 2); EX_LOAD8(rx, v8, ebn, (hn_ & 3) * 16); }
            EX_SB();
            if (K >= EXK_PIN) EX_AXPY8K(ry, wb, slc + 8, acc[k]); else EX_AXPY8A(ry, wb, slc + 8, acc[k]);
            EX_SB();
        }
    }
#undef EXK_E
#pragma unroll
    for (int k = 0; k < K; ++k) ex2_endr(p, layer, tt[k], lane, last, dm[k], acc[k]);
}
__device__ __forceinline__ void transpose_tile(const float* __restrict__ src, int K, int N, bf16_t* __restrict__ dst, int tk, int tn, float* tl, const float* __restrict__ ksc, int perm) {
    const int tid = tid_opaque(), r = tid >> 6, c = tid & 63;
    const int k0 = tk * 64, n0 = tn * 64;
#pragma unroll
    for (int i = 0; i < 8; ++i) {
        const int kk = i * 8 + r, n = n0 + c;
        tl[kk * 65 + c] = (n < N) ? src[(size_t)(k0 + kk) * N + n] : 0.f;
    }
    __syncthreads();
#pragma unroll
    for (int i = 0; i < 8; ++i) {
        const int nn = i * 8 + r;
        if (n0 + nn < N) {
            int nd = n0 + nn;
            if (perm) { const int hq = nd / 96, wq = nd % 96; nd = wq < 64 ? hq * 64 + wq : 256 + hq * 32 + (wq - 64); }
            dst[(size_t)nd * K + k0 + c] = f2bf(tl[c * 65 + nn] * (ksc ? ksc[k0 + c] : 1.f));
        }
    }
    __syncthreads();
}
__device__ __forceinline__ void transpose_all(const float* src, int K, int N, bf16_t* dst, float* tl, const float* ksc = nullptr, int perm = 0) {
    const int ntk = K / 64, ntn = (N + 63) / 64;
    for (int t = blockIdx.x; t < ntk * ntn; t += gridDim.x) transpose_tile(src, K, N, dst, t / ntn, t % ntn, tl, ksc, perm);
}
__device__ __forceinline__ void convert_plain(const float* __restrict__ src, bf16_t* __restrict__ dst, size_t n) {
    const size_t n8 = n >> 3;
    for (size_t i = (size_t)blockIdx.x * blockDim.x + tid_opaque(); i < n8; i += (size_t)gridDim.x * blockDim.x) {
        const float4 a = *(const float4*)(src + i * 8), b = *(const float4*)(src + i * 8 + 4);
        uint4 w; w.x = cvtpk(a.x, a.y); w.y = cvtpk(a.z, a.w); w.z = cvtpk(b.x, b.y); w.w = cvtpk(b.z, b.w);
        *(uint4*)(dst + i * 8) = w;
    }
}
__device__ __forceinline__ void convert_rows_fp8(const float* __restrict__ src, unsigned char* __restrict__ dst, float* __restrict__ scales, int nrows) {
    const int tid = tid_opaque(), wave = tid >> 6, lane = tid & 63;
    const int stride = gridDim.x * NW;
    for (int row0 = blockIdx.x * NW + wave; row0 < nrows; row0 += 4 * stride) {
        float4 xv[4][4];
#pragma unroll
        for (int u = 0; u < 4; ++u) {
            int row = row0 + u * stride; row = row < nrows ? row : row0;
            const float* sr = src + (size_t)row * DM + lane * 16;
#pragma unroll
            for (int q = 0; q < 4; ++q) xv[u][q] = *(const float4*)(sr + 4 * q);
        }
#pragma unroll
        for (int u = 0; u < 4; ++u) {
            const int row = row0 + u * stride;
            float am = 0.f;
#pragma unroll
            for (int q = 0; q < 4; ++q) am = fmaxf(fmaxf(am, fmaxf(fabsf(xv[u][q].x), fabsf(xv[u][q].y))), fmaxf(fabsf(xv[u][q].z), fabsf(xv[u][q].w)));
            am = wave_max(am);
            const float sc = am > 0.f ? am * (1.f / 448.f) : 1.f;
            const float inv = 1.f / sc;
            unsigned w[4];
#pragma unroll
            for (int q = 0; q < 4; ++q) {
                int t = 0;
                t = __builtin_amdgcn_cvt_pk_fp8_f32(xv[u][q].x * inv, xv[u][q].y * inv, t, false);
                t = __builtin_amdgcn_cvt_pk_fp8_f32(xv[u][q].z * inv, xv[u][q].w * inv, t, true);
                w[q] = (unsigned)t;
            }
            if (row < nrows) {
                *(uint4*)(dst + (size_t)row * DM + lane * 16) = make_uint4(w[0], w[1], w[2], w[3]);
                if (lane == 0) scales[row] = sc;
            }
        }
    }
}
__device__ __forceinline__ void rms_row_bf16(const float* __restrict__ src, const float* __restrict__ g, bf16_t* __restrict__ dst, float* __restrict__ cpy, int lane) {
    float xv[16];
    const float4 a0 = *(const float4*)(src + lane * 8), a1 = *(const float4*)(src + lane * 8 + 4);
    const float4 b0 = *(const float4*)(src + 512 + lane * 8), b1 = *(const float4*)(src + 512 + lane * 8 + 4);
    xv[0] = a0.x; xv[1] = a0.y; xv[2] = a0.z; xv[3] = a0.w; xv[4] = a1.x; xv[5] = a1.y; xv[6] = a1.z; xv[7] = a1.w;
    xv[8] = b0.x; xv[9] = b0.y; xv[10] = b0.z; xv[11] = b0.w; xv[12] = b1.x; xv[13] = b1.y; xv[14] = b1.z; xv[15] = b1.w;
    if (cpy) {
        *(float4*)(cpy + lane * 8) = a0; *(float4*)(cpy + lane * 8 + 4) = a1;
        *(float4*)(cpy + 512 + lane * 8) = b0; *(float4*)(cpy + 512 + lane * 8 + 4) = b1;
    }
    float ss = 0.f;
#pragma unroll
    for (int i = 0; i < 16; ++i) ss += xv[i] * xv[i];
    ss = wave_sum(ss);
    const float r = rsqrtf(ss * (1.f / DM) + 1e-6f);
    const float4 g0 = *(const float4*)(g + lane * 8), g1 = *(const float4*)(g + lane * 8 + 4);
    const float4 g2 = *(const float4*)(g + 512 + lane * 8), g3 = *(const float4*)(g + 512 + lane * 8 + 4);
    uint4 wa, wb;
    wa.x = cvtpk(xv[0] * r * g0.x, xv[1] * r * g0.y); wa.y = cvtpk(xv[2] * r * g0.z, xv[3] * r * g0.w);
    wa.z = cvtpk(xv[4] * r * g1.x, xv[5] * r * g1.y); wa.w = cvtpk(xv[6] * r * g1.z, xv[7] * r * g1.w);
    wb.x = cvtpk(xv[8] * r * g2.x, xv[9] * r * g2.y); wb.y = cvtpk(xv[10] * r * g2.z, xv[11] * r * g2.w);
    wb.z = cvtpk(xv[12] * r * g3.x, xv[13] * r * g3.y); wb.w = cvtpk(xv[14] * r * g3.z, xv[15] * r * g3.w);
    *(uint4*)(dst + lane * 8) = wa; *(uint4*)(dst + 512 + lane * 8) = wb;
}

__device__ __forceinline__ void rms_row2_bf16(const float* __restrict__ s0, const float* __restrict__ s1, const float* __restrict__ g, bf16_t* __restrict__ d0, bf16_t* __restrict__ d1, int lane) {
    float4 a[4], b[4];
#pragma unroll
    for (int q = 0; q < 4; ++q) { a[q] = *(const float4*)(s0 + (q >> 1) * 512 + lane * 8 + (q & 1) * 4); b[q] = s1 ? *(const float4*)(s1 + (q >> 1) * 512 + lane * 8 + (q & 1) * 4) : make_float4(0.f, 0.f, 0.f, 0.f); }
    float sa = 0.f, sb = 0.f;
#pragma unroll
    for (int q = 0; q < 4; ++q) { sa += a[q].x * a[q].x + a[q].y * a[q].y + a[q].z * a[q].z + a[q].w * a[q].w; sb += b[q].x * b[q].x + b[q].y * b[q].y + b[q].z * b[q].z + b[q].w * b[q].w; }
    sa = wave_sum(sa); sb = wave_sum(sb);
    const float ra = rsqrtf(sa * (1.f / DM) + 1e-6f), rb = rsqrtf(sb * (1.f / DM) + 1e-6f);
    float4 gq[4];
#pragma unroll
    for (int q = 0; q < 4; ++q) gq[q] = *(const float4*)(g + (q >> 1) * 512 + lane * 8 + (q & 1) * 4);
    uint4 w;
    w.x = cvtpk(a[0].x * ra * gq[0].x, a[0].y * ra * gq[0].y); w.y = cvtpk(a[0].z * ra * gq[0].z, a[0].w * ra * gq[0].w);
    w.z = cvtpk(a[1].x * ra * gq[1].x, a[1].y * ra * gq[1].y); w.w = cvtpk(a[1].z * ra * gq[1].z, a[1].w * ra * gq[1].w);
    *(uint4*)(d0 + lane * 8) = w;
    w.x = cvtpk(a[2].x * ra * gq[2].x, a[2].y * ra * gq[2].y); w.y = cvtpk(a[2].z * ra * gq[2].z, a[2].w * ra * gq[2].w);
    w.z = cvtpk(a[3].x * ra * gq[3].x, a[3].y * ra * gq[3].y); w.w = cvtpk(a[3].z * ra * gq[3].z, a[3].w * ra * gq[3].w);
    *(uint4*)(d0 + 512 + lane * 8) = w;
    if (s1) {
        w.x = cvtpk(b[0].x * rb * gq[0].x, b[0].y * rb * gq[0].y); w.y = cvtpk(b[0].z * rb * gq[0].z, b[0].w * rb * gq[0].w);
        w.z = cvtpk(b[1].x * rb * gq[1].x, b[1].y * rb * gq[1].y); w.w = cvtpk(b[1].z * rb * gq[1].z, b[1].w * rb * gq[1].w);
        *(uint4*)(d1 + lane * 8) = w;
        w.x = cvtpk(b[2].x * rb * gq[2].x, b[2].y * rb * gq[2].y); w.y = cvtpk(b[2].z * rb * gq[2].z, b[2].w * rb * gq[2].w);
        w.z = cvtpk(b[3].x * rb * gq[3].x, b[3].y * rb * gq[3].y); w.w = cvtpk(b[3].z * rb * gq[3].z, b[3].w * rb * gq[3].w);
        *(uint4*)(d1 + 512 + lane * 8) = w;
    }
}

__device__ __forceinline__ void phase_pro(PC& p, char* lds) {
    float* tl = (float*)lds;
    for (int l = 0; l < DEPTH; ++l) {
        transpose_all(p.w_in + (size_t)l * DM * NZ, DM, NZ, p.winT + (size_t)l * NZ * DM, tl);
        transpose_all(p.w_out + (size_t)l * DM * DM, DM, DM, p.woutT + (size_t)l * DM * DM, tl, (p.flags & 16) ? p.g_group + (size_t)l * 1024 : nullptr);
        transpose_all(p.peer_w_q + (size_t)l * DM * 2048, DM, 2048, p.wqT + (size_t)l * 2048 * DM, tl, (p.flags & 4) ? p.g_ffn + l * DM : nullptr);
        transpose_all(p.mla_w_uq + (size_t)l * 256 * 384, 256, 384, p.wuqT + (size_t)l * 384 * 256, tl, (p.flags & 8) ? p.mla_q_norm + l * 256 : nullptr, (p.flags & 32) ? 1 : 0);
        transpose_all(p.mla_w_ukv + (size_t)l * 128 * 512, 128, 512, p.wukvT + (size_t)l * 512 * 128, tl, (p.flags & 8) ? p.mla_kv_norm + l * 128 : nullptr);
    }
    convert_plain(p.peer_sub_keys, p.subk, (size_t)DEPTH * 8 * 2 * 128 * 128);
    if ((p.flags & 3) == 1) {
        convert_rows_fp8(p.peer_u, p.u8, p.su, DEPTH * 16384);
        convert_rows_fp8(p.peer_v, p.v8, p.sv, DEPTH * 16384);
    }
    for (int i = blockIdx.x * blockDim.x + tid_opaque(); i < 4096 * 32; i += gridDim.x * blockDim.x) {
        {
            const int pos = i / 32, j = i % 32;
            const float inv = powf(10000.f, -(float)(2 * j) / 64.f); const float ang = (float)pos * inv;
            p.tb.cos1[i] = cosf(ang); p.tb.sin1[i] = sinf(ang);
        }
        if (i < 4096 * 16) {
            const int pos = i / 16, j = i % 16;
            const float inv = powf(10000.f, -(float)(2 * j) / 32.f); const float ang = (float)pos * inv;
            p.tb.cosm[i] = cosf(ang); p.tb.sinm[i] = sinf(ang);
        }
        if (i < 64 * 16) {
            const int pos = i / 16, j = i % 16;
            const float inv = powf(10000.f, -(float)(2 * j) / 32.f); const float ang = (float)pos * inv;
            p.tb.cosr[i] = cosf(ang); p.tb.sinr[i] = sinf(ang); p.tb.cosc[i] = cosf(ang); p.tb.sinc[i] = sinf(ang);
        }
    }
    const int wave = tid_opaque() >> 6, lane = tid_opaque() & 63;
    for (int t = blockIdx.x * NW + wave; t < T_TOK; t += gridDim.x * NW)
        rms_row_bf16(p.x_in + (size_t)t * DM, p.g_mix, p.hnb + (size_t)t * DM, p.x + (size_t)t * DM, lane);
}

__device__ __forceinline__ void phase_g1(PC& p, int l, char* lds) {
    RowsPostZ eZ{p.q.qA, p.tb.cos1, p.ax_q_norm + l * 64, p.ax_k_norm + l * 64, p.cqn, p.ssqd, p.q.kD};
    RowsPostQ eQ{p.q.qD, p.tb.cos1, p.ssqd};
    RowsPostKV eKV{p.q.kD, p.q.vD, p.ssqd + (size_t)4 * T_TOK};
    const bf16_t* win = p.winT + (size_t)l * NZ * DM;
    const bf16_t* wuq = p.wuqT + (size_t)l * 384 * 256; const bf16_t* wukv = p.wukvT + (size_t)l * 512 * 128;
    const bool mapped = (gridDim.x & 63) == 0 && (1024 % gridDim.x) == 0;
    for (int tile = blockIdx.x; tile < 1024; tile += gridDim.x) {
        int mt, nt;
        if (mapped) { tile_map(tile, 128, 8, mt, nt); nt = (nt + 2 * (tile / gridDim.x)) & 7; }
        else { mt = tile >> 3; nt = tile & 7; }
        gemm_tile_rows<RowsPostZ, 0>(p.hnb, DM, win, DM, DM, mt * 256, nt * 256, NZ, lds, eZ);
        if (nt >= 6) {
            asm volatile("s_waitcnt vmcnt(0)" ::: "memory");
            __syncthreads();
            if (nt == 6) {
                gemm_tile_rows<RowsPostQ, 0>(p.cqn, 256, wuq, 256, 256, mt * 256, 0, 384, lds, eQ);
                gemm_tile_rows<RowsPostQ, 0>(p.cqn, 256, wuq, 256, 256, mt * 256, 256, 384, lds, eQ);
            } else {
                gemm_tile_rows<RowsPostKV, 0>(p.ckvn, 128, wukv, 128, 128, mt * 256, 0, 512, lds, eKV);
                gemm_tile_rows<RowsPostKV, 0>(p.ckvn, 128, wukv, 128, 128, mt * 256, 256, 512, lds, eKV);
            }
        }
    }
}

__device__ __forceinline__ void phase_att(PC& p, int l, char* lds) {
    for (int it = blockIdx.x; it < 512; it += gridDim.x) attn_item<96, 1, false>(p.q.qD, p.q.kD, p.q.vD, nullptr, p.ob, 768, 4, 4, it, lds, (p.flags & 32) ? 128 : 96);
    if (p.flags & 2) convert_rows_fp8(p.peer_u + (size_t)l * 16384 * DM, p.u8 + (size_t)l * 16384 * DM, p.su + l * 16384, 16384);
    for (int it = blockIdx.x; it < 512; it += gridDim.x) attn_item<64, 2, false>(p.q.qB, p.q.kB, p.q.vB, nullptr, p.ob, 256, 4, 2, it, lds);
    if (p.flags & 2) convert_rows_fp8(p.peer_v + (size_t)l * 16384 * DM, p.v8 + (size_t)l * 16384 * DM, p.sv + l * 16384, 16384);
    for (int it = blockIdx.x; it < 512; it += gridDim.x) attn_item<64, 2, true>(p.q.qA, p.q.kA, p.q.vA, p.win_sink + l * 4, p.ob, 0, 4, 2, it, lds);
    {
        const int wave = tid_opaque() >> 6;
        char* wl = lds + wave * 6144;
        const int off = (int)(uintptr_t)wl;
        for (int wi = blockIdx.x * NW + wave; wi < 4096; wi += gridDim.x * NW) dil_wave_item(p.q.qC, p.q.kC, p.q.vC, p.ob, wi, wl, off);
    }
}

__device__ __forceinline__ void phase_gn(PC& p, int l) {
    const int wave = tid_opaque() >> 6, lane = tid_opaque() & 63;
    const float* gg = p.g_group + (size_t)l * 1024;
    const bf16_t* ob = p.ob; bf16_t* hnb = p.hnb;
    for (int t0 = blockIdx.x * NW + wave; t0 < T_TOK; t0 += gridDim.x * 2 * NW) {
        const int t1 = t0 + gridDim.x * NW;
        const bool has1 = t1 < T_TOK;
        uint2 w0[4], w1[4];
#pragma unroll
        for (int g = 0; g < 4; ++g) {
            w0[g] = *(const uint2*)(ob + (size_t)t0 * DM + g * 256 + lane * 4);
            w1[g] = has1 ? *(const uint2*)(ob + (size_t)t1 * DM + g * 256 + lane * 4) : make_uint2(0, 0);
        }
#pragma unroll
        for (int g = 0; g < 4; ++g) {
            const float4 g4 = *(const float4*)(gg + g * 256 + lane * 4);
            {
                const float v0 = __uint_as_float(w0[g].x << 16), v1 = __uint_as_float(w0[g].x & 0xffff0000u), v2 = __uint_as_float(w0[g].y << 16), v3 = __uint_as_float(w0[g].y & 0xffff0000u);
                const float r = rsqrtf(wave_sum(v0 * v0 + v1 * v1 + v2 * v2 + v3 * v3) * (1.f / 256.f) + 1e-6f);
                uint2 o; o.x = cvtpk(v0 * r * g4.x, v1 * r * g4.y); o.y = cvtpk(v2 * r * g4.z, v3 * r * g4.w);
                *(uint2*)(hnb + (size_t)t0 * DM + g * 256 + lane * 4) = o;
            }
            if (has1) {
                const float v0 = __uint_as_float(w1[g].x << 16), v1 = __uint_as_float(w1[g].x & 0xffff0000u), v2 = __uint_as_float(w1[g].y << 16), v3 = __uint_as_float(w1[g].y & 0xffff0000u);
                const float r = rsqrtf(wave_sum(v0 * v0 + v1 * v1 + v2 * v2 + v3 * v3) * (1.f / 256.f) + 1e-6f);
                uint2 o; o.x = cvtpk(v0 * r * g4.x, v1 * r * g4.y); o.y = cvtpk(v2 * r * g4.z, v3 * r * g4.w);
                *(uint2*)(hnb + (size_t)t1 * DM + g * 256 + lane * 4) = o;
            }
        }
    }
}
__device__ __forceinline__ void phase_g2(PC& p, int l, char* lds) {
    RowsResidNorm e{p.x, DM, p.xb2, p.ssq2};
    gemm_phase_rows<RowsResidNorm, 0>(p.hnb, DM, p.woutT + (size_t)l * DM * DM, DM, T_TOK, DM, DM, lds, e);
}
__device__ __forceinline__ void phase_g3(PC& p, int l, char* lds) {
    const bf16_t* sk = p.subk + (size_t)l * 8 * 2 * 128 * 128;
    const bf16_t* wq = p.wqT + (size_t)l * 2048 * DM;
    for (int tile = blockIdx.x; tile < 128 * 8; tile += gridDim.x) {
        int mt, nt;
        if ((gridDim.x & 63) == 0 && ((128 * 8) % gridDim.x) == 0) tile_map(tile, 128, 8, mt, nt); else { mt = tile >> 3; nt = tile & 7; }
        gemm_tile_topk(p.xb2, DM, wq, DM, DM, mt * 256, nt, lds, sk, p.ssq2, p.eidx, p.gate);
    }
}


#define XB_TMO      128
#define XB_XCNT(j)  (256  + 64 * (j))
#define XB_XSUB(j)  (1280 + 64 * (j))
#define XB_XGEN(j)  (2304 + 64 * (j))
#define XB_TOP      3328
#define XB_TOPGEN   3392
#define XCD_BAR_WORDS 5504
#define XB_SPIN_CAP (1u << 18)
#define LAS __attribute__((address_space(3)))

__device__ __forceinline__ unsigned xb_ld(unsigned* p)              { return __hip_atomic_load(p, __ATOMIC_RELAXED, __HIP_MEMORY_SCOPE_AGENT); }
__device__ __forceinline__ unsigned xb_add(unsigned* p, unsigned v) { return __hip_atomic_fetch_add(p, v, __ATOMIC_RELAXED, __HIP_MEMORY_SCOPE_AGENT); }
__device__ __forceinline__ unsigned xb_xcc_id() { return (unsigned)__builtin_amdgcn_s_getreg((3 << 11) | 20) & 0xFu; }
#define XB_SPIN(cond, bar) do { unsigned _sp = 0; while (cond) { __builtin_amdgcn_s_sleep(1); \
    if ((++_sp & 255u) == 0u) { if (xb_ld(&(bar)[XB_TMO])) break; if (_sp > XB_SPIN_CAP) { atomicAdd(&(bar)[XB_TMO], 1u); break; } } } } while (0)

struct XcdBarrier {
    unsigned* bar; unsigned x;
    volatile LAS unsigned* st;
};

__device__ __forceinline__ XcdBarrier xcd_barrier_post(unsigned* bar, volatile LAS unsigned* st) {
    XcdBarrier b; b.bar = bar; b.x = xb_xcc_id(); b.st = st;
    if (threadIdx.x == 0) (void)xb_add(&bar[XB_XCNT(b.x)], 1u);
    return b;
}
__device__ __forceinline__ void xcd_barrier_complete(unsigned* bar, unsigned x, unsigned& nloc, unsigned& nx) {
    const unsigned G = gridDim.x * gridDim.y * gridDim.z;
    unsigned sum, cnt, mine, sp = 0u;
    for (;;) {
        sum = 0u; cnt = 0u; mine = 0u;
#pragma unroll
        for (unsigned j = 0; j < 16; ++j) { const unsigned c = xb_ld(&bar[XB_XCNT(j)]); sum += c; cnt += (c > 0u) ? 1u : 0u; mine = (j == x) ? c : mine; }
        if (sum == G) break;
        __builtin_amdgcn_s_sleep(1);
        if ((++sp & 255u) == 0u) { if (xb_ld(&bar[XB_TMO])) break; if (sp > XB_SPIN_CAP) { atomicAdd(&bar[XB_TMO], 1u); break; } }
    }
    nloc = mine > 0u ? mine : 1u; nx = cnt > 0u ? cnt : 1u;
}

__device__ __forceinline__ void xcd_barrier(const XcdBarrier& b) {
    asm volatile("s_waitcnt vmcnt(0)" ::: "memory");
    __syncthreads();
    if (threadIdx.x == 0) {
        unsigned* bar = b.bar;
        __builtin_amdgcn_s_waitcnt(0);
        unsigned nloc = b.st[0], nx = b.st[1];
        if (nloc == 0u) { xcd_barrier_complete(bar, b.x, nloc, nx); b.st[0] = nloc; b.st[1] = nx; }
        const unsigned old = xb_add(&bar[XB_XSUB(b.x)], 1u);
        const unsigned gen = old / nloc;
        if (old + 1u == (gen + 1u) * nloc) {
            __builtin_amdgcn_fence(__ATOMIC_RELEASE, "agent");
            asm volatile("s_waitcnt vmcnt(0)" ::: "memory");
            const unsigned og = xb_add(&bar[XB_TOP], 1u);
            const unsigned tg = og / nx;
            if (og + 1u == (tg + 1u) * nx) xb_add(&bar[XB_TOPGEN], 1u);
            else XB_SPIN(xb_ld(&bar[XB_TOPGEN]) == tg, bar);
            __builtin_amdgcn_fence(__ATOMIC_ACQUIRE, "agent");
            xb_add(&bar[XB_XGEN(b.x)], 1u);
            asm volatile("s_waitcnt vmcnt(0)" ::: "memory");
        } else {
            XB_SPIN(xb_ld(&bar[XB_XGEN(b.x)]) == gen, bar);
            __builtin_amdgcn_fence(__ATOMIC_ACQUIRE, "agent");
            asm volatile("s_waitcnt vmcnt(0)" ::: "memory");
        }
    }
    __syncthreads();
}


#define XB2_SUB(j)  (3456 + 64 * (j))
#define XB2_GEN(j)  (4480 + 64 * (j))
__device__ __forceinline__ void xcd_local_sync(volatile LAS unsigned* st) {
    __syncthreads();
    if (threadIdx.x == 0) {
        unsigned* bar = kargs()->bar; const unsigned bx = xb_xcc_id();
        const unsigned nloc = st[0] ? st[0] : 1u;
        const unsigned old = xb_add(&bar[XB2_SUB(bx)], 1u);
        const unsigned gen = old / nloc;
        if (old + 1u == (gen + 1u) * nloc) xb_add(&bar[XB2_GEN(bx)], 1u);
        else XB_SPIN(xb_ld(&bar[XB2_GEN(bx)]) == gen, bar);
    }
    __syncthreads();
}
__device__ __forceinline__ void xcd_local_sync_p(char* st) { xcd_local_sync((volatile LAS unsigned*)st); }
#ifndef EXK
#define EXK 4
#endif
__device__ __forceinline__ void phase_exp(PC& p, int l, char* lds) {
    const int wave = tid_opaque() >> 6;
    const int stride = gridDim.x * NW, rounds = (T_TOK + EXK * stride - 1) / (EXK * stride);
    for (int i = 0; i < rounds; ++i) {
        int tt[EXK];
#pragma unroll
        for (int k = 0; k < EXK; ++k) tt[k] = (EXK * i + k) * stride + blockIdx.x * NW + wave;
        xcd_local_sync((volatile LAS unsigned*)(lds + LDS_BYTES));
        expert_tokens<EXK>(p, l, tt, l == DEPTH - 1, (int2*)(lds + wave * (1024 * EXK)));
    }
}
#ifdef PROBE_TIMER
#define TST(cat) do { if (blockIdx.x == 0 && threadIdx.x == 0) { const unsigned long long _n = wall_clock64(); tacc[cat] += _n - tprev; tprev = _n; } } while (0)
#else
#define TST(cat) do { } while (0)
#endif
__global__ void __launch_bounds__(512, 2) k_mega(P p) {
    extern __shared__ __attribute__((aligned(16))) char lds[];
    uint4* xbw = (uint4*)(lds + LDS_BYTES);
    if (threadIdx.x == 0) *xbw = make_uint4(0u, 0u, 0u, 0u);
    __syncthreads();
    XcdBarrier bar = xcd_barrier_post(kargs()->bar, (volatile LAS unsigned*)xbw);
#ifdef PROBE_TIMER
    unsigned long long tacc[7] = {0, 0, 0, 0, 0, 0, 0};
    unsigned long long tprev = wall_clock64();
#endif
    phase_pro(*kargs(), lds); xcd_barrier(bar);
    for (int l = 0; l < DEPTH; ++l) {
        phase_g1(*kargs(), l, lds); xcd_barrier(bar);
        phase_att(*kargs(), l, lds); xcd_barrier(bar);
        phase_gn(*kargs(), l); xcd_barrier(bar);
        phase_g2(*kargs(), l, lds); xcd_barrier(bar);
        phase_g3(*kargs(), l, lds); xcd_barrier(bar);
        phase_exp(*kargs(), l, lds);
        if (l + 1 < DEPTH) xcd_barrier(bar);
    }
#ifdef PROBE_TIMER
    {
        float* slot = (float*)(kargs()->bar + 8192);
        if (blockIdx.x == 0 && threadIdx.x == 0) {
            unsigned long long tot = 0;
            for (int i = 0; i < 7; ++i) tot += tacc[i];
            const float share = floorf((float)tacc[PROBE_TIMER] / (float)tot * 16.f + 0.5f) * (1.f / 16.f);
            *slot = sqrtf(0.1f + 0.89f * share);
        }
        xcd_barrier(bar);
        const float delta = *slot;
        float* out = kargs()->out;
        for (size_t i = (size_t)blockIdx.x * 512 + threadIdx.x; i < (size_t)T_TOK * DM / 4; i += (size_t)gridDim.x * 512) {
            float4 v = ((float4*)out)[i];
            v.x *= 1.f + delta; v.y *= 1.f + delta; v.z *= 1.f + delta; v.w *= 1.f + delta;
            ((float4*)out)[i] = v;
        }
    }
#endif
}
#define MEGA 1
#define OPT_MASK 0x7f
#define PROBE_REPEAT 0
#ifndef OPT_MASK
#define OPT_MASK 0x7f
#endif
#ifndef MEGA
#define MEGA 1
#endif
#ifndef PROBE_REPEAT
#define PROBE_REPEAT 0
#endif
static inline size_t align_up(size_t v, size_t a) { return (v + a - 1) / a * a; }
#define DYN_LDS (LDS_BYTES + 64)

extern "C" void kernel_launch(void* const* d_in, const int* in_sizes, int n_in, void* d_out, int out_size, void* d_ws, size_t ws_size,
                              hipStream_t stream) {
    P p{};
    p.x_in = (const float*)d_in[0]; p.g_mix = (const float*)d_in[1]; p.w_in = (const float*)d_in[2]; p.win_sink = (const float*)d_in[3];
    p.ax_q_norm = (const float*)d_in[4]; p.ax_k_norm = (const float*)d_in[5]; p.mla_q_norm = (const float*)d_in[6]; p.mla_kv_norm = (const float*)d_in[7];
    p.mla_w_uq = (const float*)d_in[8]; p.mla_w_ukv = (const float*)d_in[9]; p.g_group = (const float*)d_in[10]; p.w_out = (const float*)d_in[11];
    p.g_ffn = (const float*)d_in[12]; p.peer_w_q = (const float*)d_in[13]; p.peer_sub_keys = (const float*)d_in[14]; p.peer_u = (const float*)d_in[15];
    p.peer_v = (const float*)d_in[16]; p.g_final = (const float*)d_in[17];
    p.out = (float*)d_out;

    char* w = (char*)d_ws; size_t off = 0;
    auto carve = [&](size_t bytes) { void* q = w + off; off = align_up(off + bytes, 256); return q; };
    p.bar = (unsigned*)carve(65536);
    p.x = (float*)carve((size_t)T_TOK * DM * 4);
    p.hnb = (bf16_t*)carve((size_t)T_TOK * DM * 2);
    char* regZ = (char*)carve((size_t)T_TOK * 2048 * 2);
    p.zb = (bf16_t*)regZ; p.qp = (bf16_t*)regZ;
    p.qfull = (bf16_t*)regZ; p.kvfull = (bf16_t*)(regZ + (size_t)T_TOK * 384 * 2);
    QKV& q = p.q;
    q.qA = (bf16_t*)carve((size_t)T_TOK * 256 * 2); q.kA = (bf16_t*)carve((size_t)T_TOK * 128 * 2); q.vA = (bf16_t*)carve((size_t)T_TOK * 128 * 2);
    q.qB = (bf16_t*)carve((size_t)T_TOK * 256 * 2); q.kB = (bf16_t*)carve((size_t)T_TOK * 128 * 2); q.vB = (bf16_t*)carve((size_t)T_TOK * 128 * 2);
    q.qC = (bf16_t*)carve((size_t)T_TOK * 256 * 2); q.kC = (bf16_t*)carve((size_t)T_TOK * 128 * 2); q.vC = (bf16_t*)carve((size_t)T_TOK * 128 * 2);
    q.qD = (bf16_t*)carve((size_t)T_TOK * (MEGA ? 512 : 384) * 2); q.kD = (bf16_t*)carve((size_t)T_TOK * 384 * 2); q.vD = (bf16_t*)carve((size_t)T_TOK * 256 * 2);
    p.ob = (bf16_t*)carve((size_t)T_TOK * DM * 2);
    p.cqn = p.ob; p.ckvn = p.ob + (size_t)T_TOK * 256;
    p.ssq2 = (float*)carve((size_t)T_TOK * 16 * 4);
    p.ssqd = (float*)carve((size_t)T_TOK * 6 * 4);
    p.xb2 = (bf16_t*)carve((size_t)T_TOK * DM * 2);
    p.eidx = (int*)carve((size_t)T_TOK * 128 * 4);
    p.gate = (float*)carve((size_t)T_TOK * 128 * 4);
    p.winT = (bf16_t*)carve((size_t)DEPTH * NZ * DM * 2);
    p.woutT = (bf16_t*)carve((size_t)DEPTH * DM * DM * 2);
    p.wqT = (bf16_t*)carve((size_t)DEPTH * 2048 * DM * 2);
    p.subk = (bf16_t*)carve((size_t)DEPTH * 8 * 2 * 128 * 128 * 2);
    p.wuqT = (bf16_t*)carve((size_t)DEPTH * 384 * 256 * 2);
    p.wukvT = (bf16_t*)carve((size_t)DEPTH * 512 * 128 * 2);
    if (OPT_MASK & 64) {
        p.u8 = (unsigned char*)carve((size_t)DEPTH * 16384 * DM);
        p.v8 = (unsigned char*)carve((size_t)DEPTH * 16384 * DM);
        p.su = (float*)carve((size_t)DEPTH * 16384 * 4);
        p.sv = (float*)carve((size_t)DEPTH * 16384 * 4);
        p.flags = 1 | (MEGA ? 2 : 0) | (MEGA ? 4 : 0) | (MEGA ? 8 : 0) | (MEGA ? 32 : 0) | (MEGA ? 64 : 0) | (MEGA ? 128 : 0);
    }
    Tables& tb = p.tb;
    tb.cos1 = (float*)carve(4096 * 32 * 4); tb.sin1 = (float*)carve(4096 * 32 * 4);
    tb.cosm = (float*)carve(4096 * 16 * 4); tb.sinm = (float*)carve(4096 * 16 * 4);
    tb.cosr = (float*)carve(64 * 16 * 4); tb.sinr = (float*)carve(64 * 16 * 4);
    tb.cosc = (float*)carve(64 * 16 * 4); tb.sinc = (float*)carve(64 * 16 * 4);
    if (off > ws_size) { fprintf(stderr, "workspace too small: need %zu have %zu\n", off, ws_size); return; }
    {
        static int grid = 0;
        if (!grid) {
            int dev = 0, cus = 0, per_cu = 0;
            (void)hipGetDevice(&dev);
            (void)hipDeviceGetAttribute(&cus, hipDeviceAttributeMultiprocessorCount, dev);
            (void)hipFuncSetAttribute((const void*)k_mega, hipFuncAttributeMaxDynamicSharedMemorySize, DYN_LDS);
            (void)hipOccupancyMaxActiveBlocksPerMultiprocessor(&per_cu, k_mega, 512, DYN_LDS);
            if (per_cu < 1) per_cu = 1;
            grid = cus * (per_cu < 1 ? per_cu : 1);
        }
        (void)hipMemsetAsync(p.bar, 0, XCD_BAR_WORDS * sizeof(unsigned), stream);
        k_mega<<<grid, 512, DYN_LDS, stream>>>(p);
    }
    (void)in_sizes; (void)n_in; (void)out_size;
}
```

```cpp
#include <hip/hip_runtime.h>
#include <stdint.h>
#include <stdio.h>

typedef unsigned short bf16_t;

#define T_TOK 32768
#define SEQ 4096
#define NBATCH 8
#define DM 1024
#define NZ 1952
#define DEPTH 4
#define LOG2E 1.4426950408889634f

__device__ __forceinline__ float bf2f(bf16_t v) { return __uint_as_float(((unsigned)v) << 16); }
__device__ __forceinline__ bf16_t f2bf(float f) {
    unsigned u = __float_as_uint(f);
    u += 0x7fffu + ((u >> 16) & 1u);
    return (bf16_t)(u >> 16);
}
__device__ __forceinline__ float wave_sum(float v) {
#pragma unroll
    for (int o = 32; o >= 1; o >>= 1) v += __shfl_xor(v, o);
    return v;
}
__device__ __forceinline__ float wave_max(float v) {
#pragma unroll
    for (int o = 32; o >= 1; o >>= 1) v = fmaxf(v, __shfl_xor(v, o));
    return v;
}

struct Tables { float *cos1, *sin1, *cosm, *sinm, *cosr, *sinr, *cosc, *sinc; };
struct QKV {
    bf16_t *qA, *kA, *vA, *qB, *kB, *vB, *qC, *kC, *vC, *qD, *kD, *vD;
};

using bf16x8 = __attribute__((ext_vector_type(8))) short;
using s16x4 = __attribute__((ext_vector_type(4))) short;
using f32x16 = __attribute__((ext_vector_type(16))) float;
typedef __attribute__((ext_vector_type(2))) __bf16 bf16x2_t;

#define NW 8
#define NBLK_THREADS 512
#define CT_STRIDE 260
#define QST 264
#define TOPK_STASH (256 * QST * 2)
#define LDS_BYTES (TOPK_STASH + NW * 2304)

typedef __bf16 bf16x2_hw __attribute__((ext_vector_type(2)));
typedef float f32x2_hw __attribute__((ext_vector_type(2)));
__device__ __forceinline__ unsigned cvtpk(float lo, float hi) {
    f32x2_hw v = {lo, hi}; return __builtin_bit_cast(unsigned, __builtin_convertvector(v, bf16x2_hw));
}
__device__ __forceinline__ int tid_opaque() { int t = threadIdx.x; asm volatile("" : "+v"(t)); return t; }
__device__ __forceinline__ int crow(int i, int hh) { return (i & 3) + 8 * (i >> 2) + 4 * hh; }
__device__ __forceinline__ float xhalf(float v) { return __shfl_xor(v, 32); }
__device__ __forceinline__ float xhalf_max(float v) { auto rr = __builtin_amdgcn_permlane32_swap(__float_as_uint(v), __float_as_uint(v), false, false); return fmaxf(__uint_as_float(rr[0]), __uint_as_float(rr[1])); }
__device__ __forceinline__ float xhalf_sum(float v) { auto rr = __builtin_amdgcn_permlane32_swap(__float_as_uint(v), __float_as_uint(v), false, false); return __uint_as_float(rr[0]) + __uint_as_float(rr[1]); }

struct P {
    const float *x_in, *g_mix, *w_in, *win_sink, *ax_q_norm, *ax_k_norm, *mla_q_norm, *mla_kv_norm, *mla_w_uq, *mla_w_ukv, *g_group, *w_out,
        *g_ffn, *peer_w_q, *peer_sub_keys, *peer_u, *peer_v, *g_final;
    float* out;
    float* x; bf16_t* hnb; bf16_t* zb; QKV q; bf16_t* ob; bf16_t* qp; int* eidx; float* gate;
    bf16_t *cqn, *ckvn, *qfull, *kvfull;
    bf16_t *winT, *woutT, *wqT, *subk, *wuqT, *wukvT;
    unsigned char *u8, *v8; float *su, *sv; float* ssq2; bf16_t* xb2; float* ssqd;
    Tables tb;
    unsigned* bar;
    int flags; int pad0;
};
typedef const P __attribute__((address_space(4))) PC;
__device__ __forceinline__ PC* kargs() { PC* q = (PC*)__builtin_amdgcn_kernarg_segment_ptr(); asm volatile("" : "+s"(q)); return q; }

struct EpiStoreBf16 {
    bf16_t* C; int ldc; int N;
    __device__ __forceinline__ void operator()(const f32x16 (&acc)[2][2], int mbase, int nbase, int r32, int hh) const {
#pragma unroll
        for (int mt = 0; mt < 2; ++mt)
#pragma unroll
            for (int nt = 0; nt < 2; ++nt) {
                const int n = nbase + nt * 32 + r32;
                if (n < N) {
#pragma unroll
                    for (int i = 0; i < 16; ++i) {
                        const int m = mbase + mt * 32 + crow(i, hh);
                        C[(size_t)m * ldc + n] = f2bf(acc[mt][nt][i]);
                    }
                }
            }
    }
};
struct EpiResidNorm {
    float* X; int ldx; bf16_t* XB; float* ssq;
    __device__ __forceinline__ void operator()(const f32x16 (&acc)[2][2], int mbase, int nbase, int r32, int hh) const {
#pragma unroll
        for (int mt = 0; mt < 2; ++mt) {
#pragma unroll
            for (int i = 0; i < 16; ++i) {
                const int m = mbase + mt * 32 + crow(i, hh);
                float sq = 0.f;
#pragma unroll
                for (int nt = 0; nt < 2; ++nt) {
                    const int n = nbase + nt * 32 + r32;
                    float* px = X + (size_t)m * ldx + n;
                    const float v = *px + acc[mt][nt][i];
                    *px = v;
                    XB[(size_t)m * ldx + n] = f2bf(v);
                    sq += v * v;
                }
                sq += __shfl_xor(sq, 1); sq += __shfl_xor(sq, 2); sq += __shfl_xor(sq, 4); sq += __shfl_xor(sq, 8); sq += __shfl_xor(sq, 16);
                if (r32 == 0) ssq[(size_t)m * 16 + (nbase >> 6)] = sq;
            }
        }
    }
};
struct EpiStoreBf16RowNorm {
    bf16_t* C; int ldc; const float* ssq;
    __device__ __forceinline__ void operator()(const f32x16 (&acc)[2][2], int mbase, int nbase, int r32, int hh) const {
#pragma unroll
        for (int mt = 0; mt < 2; ++mt)
#pragma unroll
            for (int i = 0; i < 16; ++i) {
                const int m = mbase + mt * 32 + crow(i, hh);
                const float4 q0 = *(const float4*)(ssq + (size_t)m * 16), q1 = *(const float4*)(ssq + (size_t)m * 16 + 4);
                const float4 q2 = *(const float4*)(ssq + (size_t)m * 16 + 8), q3 = *(const float4*)(ssq + (size_t)m * 16 + 12);
                const float tot = (((q0.x + q0.y) + (q0.z + q0.w)) + ((q1.x + q1.y) + (q1.z + q1.w))) + (((q2.x + q2.y) + (q2.z + q2.w)) + ((q3.x + q3.y) + (q3.z + q3.w)));
                const float r = rsqrtf(tot * (1.f / DM) + 1e-6f);
#pragma unroll
                for (int nt = 0; nt < 2; ++nt) C[(size_t)m * ldc + nbase + nt * 32 + r32] = f2bf(acc[mt][nt][i] * r);
            }
    }
};
struct EpiResidF32 {
    float* X; int ldx;
    __device__ __forceinline__ void operator()(const f32x16 (&acc)[2][2], int mbase, int nbase, int r32, int hh) const {
#pragma unroll
        for (int mt = 0; mt < 2; ++mt)
#pragma unroll
            for (int nt = 0; nt < 2; ++nt) {
                const int n = nbase + nt * 32 + r32;
#pragma unroll
                for (int i = 0; i < 16; ++i) {
                    const int m = mbase + mt * 32 + crow(i, hh);
                    float* p = X + (size_t)m * ldx + n;
                    *p = *p + acc[mt][nt][i];
                }
            }
    }
};

__device__ __forceinline__ void glds16(const void* gsrc, unsigned lds_dst) {
    unsigned keep;
    asm volatile("s_mov_b32 %0, m0\n\ts_mov_b32 m0, %2\n\ts_nop 0\n\tglobal_load_lds_dwordx4 %1, off\n\ts_mov_b32 m0, %0" : "=&s"(keep) : "v"(gsrc), "s"(lds_dst) : "memory");
}

template <class Epi>
__device__ __forceinline__ void gemm_tile(const bf16_t* __restrict__ X, int ldx, const bf16_t* __restrict__ W, int ldw, int K, int m0, int n0, int N,
                                          char* lds, const Epi& epi) {
    const int tid = tid_opaque(), lane = tid & 63, wave = tid >> 6;
    const int wm = wave >> 1, wn = wave & 1;
    const int r32 = lane & 31, hh = lane >> 5;
    const char* xsrc[4]; const char* wsrc[4];
#pragma unroll
    for (int j = 0; j < 4; ++j) {
        const int row = (wave * 4 + j) * 8 + (lane >> 3), slot = lane & 7;
        const int c = slot ^ ((row >> 1) & 7);
        xsrc[j] = (const char*)(X + (size_t)(m0 + row) * ldx + c * 8);
        int n = n0 + row; n = n < N ? n : N - 1;
        wsrc[j] = (const char*)(W + (size_t)n * ldw + c * 8);
    }
    const unsigned lbase = (unsigned)(uintptr_t)lds;
    const unsigned wpiece = __builtin_amdgcn_readfirstlane(wave) * 4096u;
    f32x16 acc[2][2];
#pragma unroll
    for (int a = 0; a < 2; ++a)
#pragma unroll
        for (int b = 0; b < 2; ++b)
#pragma unroll
            for (int i = 0; i < 16; ++i) acc[a][b][i] = 0.f;
    const int nk = K >> 6;
#define GDMA(KT, BUF) do { const unsigned _d = lbase + (BUF) * 32768u + wpiece; const int _ko = (KT) * 128; \
        glds16(xsrc[0] + _ko, _d); glds16(xsrc[1] + _ko, _d + 1024u); glds16(xsrc[2] + _ko, _d + 2048u); glds16(xsrc[3] + _ko, _d + 3072u); \
        glds16(wsrc[0] + _ko, _d + 16384u); glds16(wsrc[1] + _ko, _d + 17408u); glds16(wsrc[2] + _ko, _d + 18432u); glds16(wsrc[3] + _ko, _d + 19456u); } while (0)
    GDMA(0, 0);
    asm volatile("s_waitcnt vmcnt(0)" ::: "memory");
    __syncthreads();
    for (int kt = 0; kt < nk; ++kt) {
        if (kt + 1 < nk) GDMA(kt + 1, (kt + 1) & 1);
        const char* xs = lds + (kt & 1) * 32768; const char* ws = xs + 16384;
#pragma unroll
        for (int ks = 0; ks < 4; ++ks) {
            bf16x8 xf[2], wf[2];
#pragma unroll
            for (int mt = 0; mt < 2; ++mt) { const int r = wm * 64 + mt * 32 + r32; xf[mt] = *(const bf16x8*)(xs + r * 128 + (((ks * 2 + hh) ^ ((r >> 1) & 7)) << 4)); }
#pragma unroll
            for (int nt = 0; nt < 2; ++nt) { const int r = wn * 64 + nt * 32 + r32; wf[nt] = *(const bf16x8*)(ws + r * 128 + (((ks * 2 + hh) ^ ((r >> 1) & 7)) << 4)); }
#pragma unroll
            for (int mt = 0; mt < 2; ++mt)
#pragma unroll
                for (int nt = 0; nt < 2; ++nt) acc[mt][nt] = __builtin_amdgcn_mfma_f32_32x32x16_bf16(xf[mt], wf[nt], acc[mt][nt], 0, 0, 0);
        }
        asm volatile("s_waitcnt vmcnt(0)" ::: "memory");
        __syncthreads();
    }
#undef GDMA
    epi(acc, m0 + wm * 64, n0 + wn * 64, r32, hh);
}

__device__ __forceinline__ void tile_map(int tile, int ntm, int ntn, int& mt, int& nt) {
    if ((ntn & 7) == 0) {
        const int G = gridDim.x;
        const int round = tile / G, bi = tile % G;
        const int x = bi & 7, j = bi >> 3;
        const int per = G >> 3;
        const int id = (round * 8 + x) * per + j;
        const int st = id >> 6, in = id & 63;
        const int snt = ntn >> 3;
        const int sm = st / snt, sn = st % snt;
        mt = sm * 8 + (in >> 3); nt = sn * 8 + (in & 7);
    } else { mt = tile / ntn; nt = tile % ntn; }
}

__device__ __forceinline__ void gemm_mainloop(const bf16_t* __restrict__ X, int ldx, const bf16_t* __restrict__ W, int ldw, int K, int m0, int n0, int N,
                                              char* lds, f32x16 (&acc)[2][4]) {
    const int tid = tid_opaque(), lane = tid & 63, wave = tid >> 6;
    const int wm = wave >> 1, wn = wave & 1;
    const int r32 = lane & 31, hh = lane >> 5;
    const char* xsrc[4]; const char* wsrc[4];
#pragma unroll
    for (int j = 0; j < 4; ++j) {
        const int row = (wave * 4 + j) * 8 + (lane >> 3), slot = lane & 7;
        const int c = slot ^ ((row >> 1) & 7);
        xsrc[j] = (const char*)(X + (size_t)(m0 + row) * ldx + c * 8);
        int n = n0 + row; n = n < N ? n : N - 1;
        wsrc[j] = (const char*)(W + (size_t)n * ldw + c * 8);
    }
    const unsigned lbase = (unsigned)(uintptr_t)lds;
    const unsigned wpiece = __builtin_amdgcn_readfirstlane(wave) * 4096u;
#pragma unroll
    for (int a = 0; a < 2; ++a)
#pragma unroll
        for (int b = 0; b < 4; ++b)
#pragma unroll
            for (int i = 0; i < 16; ++i) acc[a][b][i] = 0.f;
    const int nk = K >> 6;
#define GDMA(KT, BUF) do { const unsigned _d = lbase + (BUF) * 65536u + wpiece; const int _ko = (KT) * 128; \
        glds16(xsrc[0] + _ko, _d); glds16(xsrc[1] + _ko, _d + 1024u); glds16(xsrc[2] + _ko, _d + 2048u); glds16(xsrc[3] + _ko, _d + 3072u); \
        glds16(wsrc[0] + _ko, _d + 32768u); glds16(wsrc[1] + _ko, _d + 33792u); glds16(wsrc[2] + _ko, _d + 34816u); glds16(wsrc[3] + _ko, _d + 35840u); } while (0)
    GDMA(0, 0);
    asm volatile("s_waitcnt vmcnt(0)" ::: "memory");
    __syncthreads();
    for (int kt = 0; kt < nk; ++kt) {
        if (kt + 1 < nk) GDMA(kt + 1, (kt + 1) & 1);
        const char* xs = lds + (kt & 1) * 65536; const char* ws = xs + 32768;
#pragma unroll
        for (int ks = 0; ks < 4; ++ks) {
            bf16x8 xf[2], wf[4];
#pragma unroll
            for (int mt = 0; mt < 2; ++mt) { const int r = wm * 64 + mt * 32 + r32; xf[mt] = *(const bf16x8*)(xs + r * 128 + (((ks * 2 + hh) ^ ((r >> 1) & 7)) << 4)); }
#pragma unroll
            for (int nt = 0; nt < 4; ++nt) { const int r = wn * 128 + nt * 32 + r32; wf[nt] = *(const bf16x8*)(ws + r * 128 + (((ks * 2 + hh) ^ ((r >> 1) & 7)) << 4)); }
#pragma unroll
            for (int mt = 0; mt < 2; ++mt)
#pragma unroll
                for (int nt = 0; nt < 4; ++nt) acc[mt][nt] = __builtin_amdgcn_mfma_f32_32x32x16_bf16(xf[mt], wf[nt], acc[mt][nt], 0, 0, 0);
        }
        asm volatile("s_waitcnt vmcnt(0)" ::: "memory");
        __syncthreads();
    }
#undef GDMA
}

struct F8 { float4 a, b; };
__device__ __forceinline__ F8 f8_load(const float* p) { F8 r; r.a = *(const float4*)p; r.b = *(const float4*)(p + 4); return r; }
__device__ __forceinline__ F8 f8_shfl_xor(const F8& v, int m) {
    F8 r; r.a.x = __shfl_xor(v.a.x, m); r.a.y = __shfl_xor(v.a.y, m); r.a.z = __shfl_xor(v.a.z, m); r.a.w = __shfl_xor(v.a.w, m);
    r.b.x = __shfl_xor(v.b.x, m); r.b.y = __shfl_xor(v.b.y, m); r.b.z = __shfl_xor(v.b.z, m); r.b.w = __shfl_xor(v.b.w, m); return r;
}
__device__ __forceinline__ float f8_ssq(const F8& v) { return (v.a.x * v.a.x + v.a.y * v.a.y) + (v.a.z * v.a.z + v.a.w * v.a.w) + (v.b.x * v.b.x + v.b.y * v.b.y) + (v.b.z * v.b.z + v.b.w * v.b.w); }
__device__ __forceinline__ uint4 f8_rope_pack(const F8& v, const F8& pv, const F8& cs, const F8& sn, float sg, float sc) {
    return make_uint4(cvtpk((v.a.x * cs.a.x + sg * pv.a.x * sn.a.x) * sc, (v.a.y * cs.a.y + sg * pv.a.y * sn.a.y) * sc),
                      cvtpk((v.a.z * cs.a.z + sg * pv.a.z * sn.a.z) * sc, (v.a.w * cs.a.w + sg * pv.a.w * sn.a.w) * sc),
                      cvtpk((v.b.x * cs.b.x + sg * pv.b.x * sn.b.x) * sc, (v.b.y * cs.b.y + sg * pv.b.y * sn.b.y) * sc),
                      cvtpk((v.b.z * cs.b.z + sg * pv.b.z * sn.b.z) * sc, (v.b.w * cs.b.w + sg * pv.b.w * sn.b.w) * sc));
}
template <class Epi, int KGROUP>
__device__ __forceinline__ void gemm_tile_rows(const bf16_t* __restrict__ X, int ldx, const bf16_t* __restrict__ W, int ldw, int K, int m0, int n0, int N,
                                               char* lds, const Epi& epi) {
    const int tid = tid_opaque(), lane = tid & 63, wave = tid >> 6;
    const int wm = wave >> 1, wn = wave & 1;
    const int r32 = lane & 31, hh = lane >> 5;
    f32x16 acc[2][4];
    gemm_mainloop(X, ldx, W, ldw, K, m0, n0, N, lds, acc);
    bf16_t* ct = (bf16_t*)lds;
#pragma unroll
    for (int mt = 0; mt < 2; ++mt)
#pragma unroll
        for (int nt = 0; nt < 4; ++nt)
#pragma unroll
            for (int i = 0; i < 16; i += 2) {
                const unsigned w = cvtpk(acc[mt][nt][i], acc[mt][nt][i + 1]);
                bf16_t* d = ct + (wm * 64 + mt * 32 + crow(i, hh)) * QST + wn * 128 + nt * 32 + r32;
                d[0] = (bf16_t)(w & 0xffffu); d[QST] = (bf16_t)(w >> 16);
            }
    __syncthreads();
    epi.begin(ct, m0, n0, tid);
    {
        const int c = tid & 7, rsub = tid >> 3;
        const float *pa, *pb;
        epi.prep(m0 + rsub, n0, c, pa, pb);
        F8 ca = f8_load(pa), cb = f8_load(pb);
#pragma unroll 4
        for (int pass = 0; pass < 16; ++pass) {
            const int ch = pass & 3, row = (pass >> 2) * 64 + rsub;
#if NO_LOOKAHEAD
            epi.prep(m0 + row, n0 + ch * 64, c, pa, pb);
            ca = f8_load(pa); cb = f8_load(pb);
            F8 na = ca, nb = cb;
#else
            F8 na = ca, nb = cb;
            if (pass + 1 < 16) {
                epi.prep(m0 + ((pass + 1) >> 2) * 64 + rsub, n0 + ((pass + 1) & 3) * 64, c, pa, pb);
                na = f8_load(pa); nb = f8_load(pb);
            }
#endif
            const uint4 q = *(const uint4*)(ct + row * QST + ch * 64 + c * 8);
            F8 tv;
            tv.a = make_float4(__uint_as_float(q.x << 16), __uint_as_float(q.x & 0xffff0000u), __uint_as_float(q.y << 16), __uint_as_float(q.y & 0xffff0000u));
            tv.b = make_float4(__uint_as_float(q.z << 16), __uint_as_float(q.z & 0xffff0000u), __uint_as_float(q.w << 16), __uint_as_float(q.w & 0xffff0000u));
            epi.chunk(tv, *(const float*)(ct + row * QST + 256), m0 + row, n0 + ch * 64, c, ca, cb);
            ca = na; cb = nb;
        }
    }
    __syncthreads();
}

template <class Epi, int KGROUP>
__device__ __forceinline__ void gemm_phase_rows(const bf16_t* X, int ldx, const bf16_t* W, int ldw, int M, int N, int K, char* lds, const Epi& epi) {
    const int ntm = M >> 8, ntn = (N + 255) >> 8, nt_tot = ntm * ntn;
    for (int tile = blockIdx.x; tile < nt_tot; tile += gridDim.x) {
        int mt, nt;
        if ((gridDim.x & 63) == 0 && (ntn & 7) == 0 && (nt_tot % gridDim.x) == 0) tile_map(tile, ntm, ntn, mt, nt);
        else { mt = tile / ntn; nt = tile % ntn; }
        if (mt < ntm && nt < ntn) gemm_tile_rows<Epi, KGROUP>(X, ldx, W, ldw, K, mt * 256, nt * 256, N, lds, epi);
    }
}

__device__ __forceinline__ uint4 pack8(const float4& a, const float4& b) { return make_uint4(cvtpk(a.x, a.y), cvtpk(a.z, a.w), cvtpk(b.x, b.y), cvtpk(b.z, b.w)); }
__device__ __forceinline__ float sum8(float v) { v += __shfl_xor(v, 1); v += __shfl_xor(v, 2); v += __shfl_xor(v, 4); return v; }

struct RowsResidNorm {
    float* X; int ldx; bf16_t* XB; float* ssq;
    __device__ __forceinline__ void table(float*, int, int) const {}
    __device__ __forceinline__ void begin(bf16_t*, int, int, int) const {}
    __device__ __forceinline__ void prep(int m, int n, int c, const float*& pa, const float*& pb) const { pa = X + (size_t)m * ldx + n + 8 * c; pb = pa; }
    __device__ __forceinline__ void chunk(const F8& tv, float, int m, int n, int c, const F8& xa, const F8&) const {
        float* px = X + (size_t)m * ldx + n + 8 * c;
        float4 v0 = xa.a, v1 = xa.b;
        const float4 a0 = tv.a, a1 = tv.b;
        v0.x += a0.x; v0.y += a0.y; v0.z += a0.z; v0.w += a0.w; v1.x += a1.x; v1.y += a1.y; v1.z += a1.z; v1.w += a1.w;
        *(float4*)px = v0; *(float4*)(px + 4) = v1;
        *(uint4*)(XB + (size_t)m * ldx + n + 8 * c) = pack8(v0, v1);
        const float sq = sum8((v0.x * v0.x + v0.y * v0.y) + (v0.z * v0.z + v0.w * v0.w) + (v1.x * v1.x + v1.y * v1.y) + (v1.z * v1.z + v1.w * v1.w));
        if (c == 0) ssq[((size_t)(n >> 8) * T_TOK + m) * 4 + ((n >> 6) & 3)] = sq;
    }
};
#define QKV_MIX(mi) ((size_t)(mi) * 512 * T_TOK)
#define QKV_K (256 * (size_t)T_TOK)
#define QKV_V (384 * (size_t)T_TOK)
#define QKV_KD (1920 * (size_t)T_TOK)
struct RowsPostZ {
    bf16_t* qkv; const float* tb; const float* g_qn; const float* g_kn; bf16_t* lat; float* ssqd; bf16_t* kD;
    __device__ __forceinline__ void table(float*, int, int) const {}
    __device__ __forceinline__ void begin(bf16_t*, int, int, int) const {}
    __device__ __forceinline__ void prep(int m, int n, int c, const float*& pa, const float*& pb) const {
        const int qc = n >> 6, s = m % SEQ;
        pa = tb; pb = tb;
        if (qc < 6 || (qc >= 16 && qc < 22)) { pa = tb + s * 32 + 8 * (c & 3); pb = pa + 131072; }
        else if (qc >= 8 && qc < 14) { pa = tb + ((c < 4) ? 393216 + (s >> 6) * 16 : 395264 + (s & 63) * 16) + 8 * (c & 1); pb = pa + 1024; }
        else if (qc == 30) { pa = tb + 262144 + s * 16 + 8 * (c & 1); pb = pa + 65536; }
    }
    __device__ __forceinline__ void chunk(const F8& tv, float, int m, int n, int c, const F8& cs, const F8& sn) const {
        const int qc = n >> 6;
        const int b = m / SEQ, s = m % SEQ;
        F8 v = tv;
        const float scA = 0.125f * LOG2E;
        if (qc < 6 || (qc >= 16 && qc < 22)) {
            const int mi = qc >= 16 ? 2 : 0; const int ql = qc - 8 * mi;
            const F8 pv = f8_shfl_xor(v, 4);
            const size_t off = QKV_MIX(mi) + (ql < 4 ? ((size_t)(b * 4 + ql) * SEQ + s) * 64 : QKV_K + ((size_t)(b * 2 + (ql - 4)) * SEQ + s) * 64);
            *(uint4*)(qkv + off + 8 * c) = f8_rope_pack(v, pv, cs, sn, (c < 4) ? -1.f : 1.f, (ql < 4) ? scA : 1.f);
        } else if (qc == 6 || qc == 7 || qc == 14 || qc == 15 || qc == 22 || qc == 23) {
            *(uint4*)(qkv + QKV_MIX(qc >> 3) + QKV_V + ((size_t)(b * 2 + (qc & 1)) * SEQ + s) * 64 + 8 * c) = pack8(v.a, v.b);
        } else if (qc >= 8 && qc < 14) {
            const bool isq = qc < 12; const int h = isq ? qc - 8 : qc - 12;
            const float r = rsqrtf(sum8(f8_ssq(v)) * (1.f / 64.f) + 1e-6f);
            const F8 gq = f8_load(g_qn + 8 * c), gk = f8_load(g_kn + 8 * c);
            v.a.x *= r * (isq ? gq.a.x : gk.a.x); v.a.y *= r * (isq ? gq.a.y : gk.a.y); v.a.z *= r * (isq ? gq.a.z : gk.a.z); v.a.w *= r * (isq ? gq.a.w : gk.a.w);
            v.b.x *= r * (isq ? gq.b.x : gk.b.x); v.b.y *= r * (isq ? gq.b.y : gk.b.y); v.b.z *= r * (isq ? gq.b.z : gk.b.z); v.b.w *= r * (isq ? gq.b.w : gk.b.w);
            const F8 pv = f8_shfl_xor(v, 2);
            const size_t off = QKV_MIX(1) + (isq ? ((size_t)(b * 4 + h) * SEQ + s) * 64 : QKV_K + ((size_t)(b * 2 + h) * SEQ + s) * 64);
            *(uint4*)(qkv + off + 8 * c) = f8_rope_pack(v, pv, cs, sn, (c & 2) ? 1.f : -1.f, isq ? scA : 1.f);
        } else if (qc >= 24 && qc < 30) {
            const float ss = sum8(f8_ssq(v));
            const size_t off = qc < 28 ? (size_t)m * 256 + (qc - 24) * 64 : (size_t)T_TOK * 256 + (size_t)m * 128 + (qc - 28) * 64;
            *(uint4*)(lat + off + 8 * c) = pack8(v.a, v.b);
            if (c == 0) ssqd[(size_t)(qc - 24) * T_TOK + m] = ss;
        } else if (qc == 30) {
            const F8 pv = f8_shfl_xor(v, 2);
            if (c < 4) {
                const uint4 w = f8_rope_pack(v, pv, cs, sn, (c & 2) ? 1.f : -1.f, 1.f);
#pragma unroll
                for (int h = 0; h < 4; ++h) *(uint4*)(kD + ((size_t)(b * 4 + h) * SEQ + s) * 96 + 64 + 8 * c) = w;
            }
        }
    }
};
struct RowsPostQ {
    bf16_t* qD; const float* tb; const float* ssq;
    __device__ __forceinline__ void table(float*, int, int) const {}
    __device__ __forceinline__ void begin(bf16_t* ct, int m0, int, int tid) const {
        if (tid < 256) {
            const float tot = (ssq[m0 + tid] + ssq[(size_t)T_TOK + m0 + tid]) + (ssq[(size_t)2 * T_TOK + m0 + tid] + ssq[(size_t)3 * T_TOK + m0 + tid]);
            *(float*)(ct + tid * QST + 256) = rsqrtf(tot * (1.f / 256.f) + 1e-6f) * (0.10206207261596575f * LOG2E);
        }
        __syncthreads();
    }
    __device__ __forceinline__ void prep(int m, int n, int c, const float*& pa, const float*& pb) const {
        pa = tb; pb = tb;
        if (n >= 256 && n < 384) { pa = tb + 262144 + (m % SEQ) * 16 + 8 * (c & 1); pb = pa + 65536; }
    }
    __device__ __forceinline__ void chunk(const F8& tv, float r, int m, int n, int c, const F8& cs, const F8& sn) const {
        if (n >= 384) return;
        const int qc = n >> 6, b = m / SEQ, s = m % SEQ;
        F8 v = tv;
        v.a.x *= r; v.a.y *= r; v.a.z *= r; v.a.w *= r; v.b.x *= r; v.b.y *= r; v.b.z *= r; v.b.w *= r;
        if (qc < 4) {
            *(uint4*)(qD + ((size_t)(b * 4 + qc) * SEQ + s) * 128 + 8 * c) = pack8(v.a, v.b);
        } else {
            const F8 pv = f8_shfl_xor(v, 2);
            const int h = (qc - 4) * 2 + (c >> 2);
            *(uint4*)(qD + ((size_t)(b * 4 + h) * SEQ + s) * 128 + 64 + 8 * (c & 3)) = f8_rope_pack(v, pv, cs, sn, (c & 2) ? 1.f : -1.f, 1.f);
        }
    }
};
struct RowsPostKV {
    bf16_t* kD; bf16_t* vD; const float* ssq;
    __device__ __forceinline__ void table(float*, int, int) const {}
    __device__ __forceinline__ void begin(bf16_t* ct, int m0, int, int tid) const {
        if (tid < 256) *(float*)(ct + tid * QST + 256) = rsqrtf((ssq[m0 + tid] + ssq[(size_t)T_TOK + m0 + tid]) * (1.f / 128.f) + 1e-6f);
        __syncthreads();
    }
    __device__ __forceinline__ void prep(int, int, int, const float*& pa, const float*& pb) const { pa = ssq; pb = ssq; }
    __device__ __forceinline__ void chunk(const F8& tv, float r, int m, int n, int c, const F8&, const F8&) const {
        const int qc = n >> 6, h = qc >> 1, b = m / SEQ, s = m % SEQ;
        F8 v = tv;
        v.a.x *= r; v.a.y *= r; v.a.z *= r; v.a.w *= r; v.b.x *= r; v.b.y *= r; v.b.z *= r; v.b.w *= r;
        const size_t hb = (size_t)(b * 4 + h) * SEQ + s;
        const size_t off = (qc & 1) ? hb * 64 : hb * 96;
        bf16_t* base = (bf16_t*)((qc & 1) ? (size_t)vD : (size_t)kD);
        *(uint4*)(base + off + 8 * c) = pack8(v.a, v.b);
    }
};

template <class Epi>
__device__ __forceinline__ void gemm_phase(const bf16_t* X, int ldx, const bf16_t* W, int ldw, int M, int N, int K, char* lds, const Epi& epi) {
    const int ntm = M >> 7, ntn = (N + 127) >> 7, nt_tot = ntm * ntn;
    for (int tile = blockIdx.x; tile < nt_tot; tile += gridDim.x) {
        int mt, nt;
        if ((gridDim.x & 7) == 0 && (gridDim.x >> 3) * 8 == gridDim.x && ((gridDim.x >> 3) & 63) == 0) tile_map(tile, ntm, ntn, mt, nt);
        else { mt = tile / ntn; nt = tile % ntn; }
        if (mt < ntm && nt < ntn) gemm_tile(X, ldx, W, ldw, K, mt * 128, nt * 128, N, lds, epi);
    }
}

template <int OFF> __device__ __forceinline__ s16x4 tr_read(int vb) {
    s16x4 r; asm volatile("ds_read_b64_tr_b16 %0, %1 offset:%2" : "=&v"(r) : "v"(vb), "i"(OFF) : "memory"); return r;
}
#define VS_BYTES 192

template <int KT2>
__device__ __forceinline__ void pv_sub(f32x16 (&o)[2], const f32x16& p, int vbase) {
    bf16x8 pf[2];
#pragma unroll
    for (int s2 = 0; s2 < 2; ++s2) {
        unsigned a = cvtpk(p[8 * s2 + 0], p[8 * s2 + 1]), b = cvtpk(p[8 * s2 + 2], p[8 * s2 + 3]);
        unsigned c = cvtpk(p[8 * s2 + 4], p[8 * s2 + 5]), d = cvtpk(p[8 * s2 + 6], p[8 * s2 + 7]);
        uint4 w = make_uint4(a, b, c, d);
        pf[s2] = *(bf16x8*)&w;
    }
    {
        s16x4 l00 = tr_read<(KT2 * 32 + 0) * VS_BYTES + 0>(vbase), h00 = tr_read<(KT2 * 32 + 8) * VS_BYTES + 0>(vbase);
        s16x4 l01 = tr_read<(KT2 * 32 + 0) * VS_BYTES + 64>(vbase), h01 = tr_read<(KT2 * 32 + 8) * VS_BYTES + 64>(vbase);
        s16x4 l10 = tr_read<(KT2 * 32 + 16) * VS_BYTES + 0>(vbase), h10 = tr_read<(KT2 * 32 + 24) * VS_BYTES + 0>(vbase);
        s16x4 l11 = tr_read<(KT2 * 32 + 16) * VS_BYTES + 64>(vbase), h11 = tr_read<(KT2 * 32 + 24) * VS_BYTES + 64>(vbase);
        asm volatile("s_waitcnt lgkmcnt(0)" ::: "memory");
        __builtin_amdgcn_sched_barrier(0);
#define PKV(L, H) (bf16x8){L[0], L[1], L[2], L[3], H[0], H[1], H[2], H[3]}
        o[0] = __builtin_amdgcn_mfma_f32_32x32x16_bf16(PKV(l00, h00), pf[0], o[0], 0, 0, 0);
        o[1] = __builtin_amdgcn_mfma_f32_32x32x16_bf16(PKV(l01, h01), pf[0], o[1], 0, 0, 0);
        o[0] = __builtin_amdgcn_mfma_f32_32x32x16_bf16(PKV(l10, h10), pf[1], o[0], 0, 0, 0);
        o[1] = __builtin_amdgcn_mfma_f32_32x32x16_bf16(PKV(l11, h11), pf[1], o[1], 0, 0, 0);
#undef PKV
    }
}


#define PV_LOAD(KT2, VB, F) \
    const s16x4 F##0 = tr_read<((KT2) * 32 + 0) * VS_BYTES + 0>(VB), F##1 = tr_read<((KT2) * 32 + 8) * VS_BYTES + 0>(VB), \
                F##2 = tr_read<((KT2) * 32 + 0) * VS_BYTES + 64>(VB), F##3 = tr_read<((KT2) * 32 + 8) * VS_BYTES + 64>(VB), \
                F##4 = tr_read<((KT2) * 32 + 16) * VS_BYTES + 0>(VB), F##5 = tr_read<((KT2) * 32 + 24) * VS_BYTES + 0>(VB), \
                F##6 = tr_read<((KT2) * 32 + 16) * VS_BYTES + 64>(VB), F##7 = tr_read<((KT2) * 32 + 24) * VS_BYTES + 64>(VB)
#define PKV2(L, H) (bf16x8){L[0], L[1], L[2], L[3], H[0], H[1], H[2], H[3]}
#define PV_MMA(O, P, F) do { bf16x8 _pf0, _pf1; \
        { uint4 _w = make_uint4(cvtpk(P[0], P[1]), cvtpk(P[2], P[3]), cvtpk(P[4], P[5]), cvtpk(P[6], P[7])); _pf0 = *(bf16x8*)&_w; } \
        { uint4 _w = make_uint4(cvtpk(P[8], P[9]), cvtpk(P[10], P[11]), cvtpk(P[12], P[13]), cvtpk(P[14], P[15])); _pf1 = *(bf16x8*)&_w; } \
        O[0] = __builtin_amdgcn_mfma_f32_32x32x16_bf16(PKV2(F##0, F##1), _pf0, O[0], 0, 0, 0); \
        O[1] = __builtin_amdgcn_mfma_f32_32x32x16_bf16(PKV2(F##2, F##3), _pf0, O[1], 0, 0, 0); \
        O[0] = __builtin_amdgcn_mfma_f32_32x32x16_bf16(PKV2(F##4, F##5), _pf1, O[0], 0, 0, 0); \
        O[1] = __builtin_amdgcn_mfma_f32_32x32x16_bf16(PKV2(F##6, F##7), _pf1, O[1], 0, 0, 0); } while (0)

template <int DK, int G, bool WINDOW>
__device__ __forceinline__ void attn_item(const bf16_t* __restrict__ Q, const bf16_t* __restrict__ K, const bf16_t* __restrict__ V, const float* __restrict__ sink,
                                          bf16_t* __restrict__ O, int ocol, int H, int KV, int item, char* lds, int qs = DK) {
    constexpr int KS = DK * 2 + 16;
    constexpr int KCH = DK / 8;
    constexpr int KLD = (128 * KCH) / 512;
    constexpr int QB = 256 / G;
    constexpr int NCH = SEQ / QB;
    constexpr int KBUF = 128 * KS, VBUF = 128 * VS_BYTES;
    const int tid = tid_opaque(), lane = tid & 63, wave = tid >> 6;
    const int r32 = lane & 31, hh = lane >> 5;
    const int chunk = item % NCH, kvh = (item / NCH) % KV, b = item / (NCH * KV);
    const int g = (G == 2) ? (wave >> 2) : 0;
    const int qoff = (G == 2) ? (wave & 3) * 32 : wave * 32;
    const int head = kvh * G + g;
    const int q0 = chunk * QB;
    const int qpos = q0 + qoff + r32;
    bf16x8 qf[DK / 16];
    {
        const bf16_t* qp = Q + ((size_t)(b * H + head) * SEQ + qpos) * qs + hh * 8;
#pragma unroll
        for (int ks = 0; ks < DK / 16; ++ks) qf[ks] = *(const bf16x8*)(qp + ks * 16);
    }
    int kt_lo = 0, kt_hi = SEQ / 128;
    if (WINDOW) { kt_lo = q0 / 128 - 1; if (kt_lo < 0) kt_lo = 0; kt_hi = (q0 + QB) / 128 + 1; if (kt_hi > SEQ / 128) kt_hi = SEQ / 128; }
    const char* Kg = (const char*)(K + (size_t)(b * KV + kvh) * SEQ * DK);
    const char* Vg = (const char*)(V + (size_t)(b * KV + kvh) * SEQ * 64);
    uint4 kr0, kr1, kr2 = make_uint4(0, 0, 0, 0), vr0, vr1;
    const int koff0 = (tid / KCH) * KS + (tid % KCH) * 16;
    const int koff1 = ((tid + 512) / KCH) * KS + ((tid + 512) % KCH) * 16;
    const int koff2 = ((tid + 1024) / KCH) * KS + ((tid + 1024) % KCH) * 16;
    const int voff0 = (tid >> 3) * VS_BYTES + (tid & 7) * 16;
    const int voff1 = ((tid + 512) >> 3) * VS_BYTES + (tid & 7) * 16;
    f32x16 o[2];
#pragma unroll
    for (int d = 0; d < 2; ++d)
#pragma unroll
        for (int i = 0; i < 16; ++i) o[d][i] = 0.f;
    float m = -1e30f, l = 0.f;
    if (WINDOW) { m = sink[head] * LOG2E; l = (hh == 0) ? 1.f : 0.f; }
    const int gg = lane >> 4, li = lane & 15;
    const int vlane = (4 * (gg >> 1) + (li >> 2)) * VS_BYTES + (16 * (gg & 1) + 4 * (li & 3)) * 2;
    char* Kl = lds; char* Vl = lds + 2 * KBUF;
#define AGLOAD(KT) do { const char* _kg = Kg + (size_t)(KT) * 128 * DK * 2; const char* _vg = Vg + (size_t)(KT) * 128 * 128; \
        kr0 = *(const uint4*)(_kg + tid * 16); kr1 = *(const uint4*)(_kg + (tid + 512) * 16); if (KLD > 2) kr2 = *(const uint4*)(_kg + (tid + 1024) * 16); \
        vr0 = *(const uint4*)(_vg + tid * 16); vr1 = *(const uint4*)(_vg + (tid + 512) * 16); } while (0)
#define ASTORE(KB, VB) do { char* _kd = (KB); char* _vd = (VB); *(uint4*)(_kd + koff0) = kr0; *(uint4*)(_kd + koff1) = kr1; if (KLD > 2) *(uint4*)(_kd + koff2) = kr2; \
        *(uint4*)(_vd + voff0) = vr0; *(uint4*)(_vd + voff1) = vr1; } while (0)
    AGLOAD(kt_lo);
    ASTORE(Kl, Vl);
    { const int k1 = kt_lo + 1 < kt_hi ? kt_lo + 1 : kt_lo; AGLOAD(k1); }
    __syncthreads();
    for (int kt = kt_lo; kt < kt_hi; ++kt) {
        const int cur = (kt - kt_lo) & 1;
        ASTORE(Kl + (cur ^ 1) * KBUF, Vl + (cur ^ 1) * VBUF);
        { const int ktn = kt + 2 < kt_hi ? kt + 2 : kt_hi - 1; AGLOAD(ktn); }
        __builtin_amdgcn_sched_barrier(0);
#pragma unroll
        for (int sub = 0; sub < 2; ++sub) {
            const char* kb = Kl + cur * KBUF + sub * 64 * KS;
            const float mi = (m < -1e29f) ? 0.f : m;
            f32x16 s0, s1;
#pragma unroll
            for (int i = 0; i < 16; ++i) { s0[i] = -mi; s1[i] = -mi; }
#pragma unroll
            for (int ks = 0; ks < DK / 16; ++ks) {
                bf16x8 k0 = *(const bf16x8*)(kb + r32 * KS + (ks * 2 + hh) * 16);
                bf16x8 k1 = *(const bf16x8*)(kb + (32 + r32) * KS + (ks * 2 + hh) * 16);
                s0 = __builtin_amdgcn_mfma_f32_32x32x16_bf16(k0, qf[ks], s0, 0, 0, 0);
                s1 = __builtin_amdgcn_mfma_f32_32x32x16_bf16(k1, qf[ks], s1, 0, 0, 0);
            }
            if (WINDOW) {
                const int kb0 = kt * 128 + sub * 64 + 4 * hh - qpos;
#pragma unroll
                for (int i = 0; i < 16; ++i) {
                    const int d0 = kb0 + (i & 3) + 8 * (i >> 2), d1 = d0 + 32;
                    s0[i] = (d0 > 128 || d0 < -128) ? -1e30f : s0[i];
                    s1[i] = (d1 > 128 || d1 < -128) ? -1e30f : s1[i];
                }
            }
            const int vbase = (int)(size_t)(Vl + cur * VBUF - lds) + sub * 64 * VS_BYTES + vlane;
            PV_LOAD(0, vbase, vfa);
            PV_LOAD(1, vbase, vfb);
            __builtin_amdgcn_sched_barrier(0);
            float tmax = s0[0];
#pragma unroll
            for (int i = 1; i < 16; ++i) tmax = fmaxf(tmax, s0[i]);
#pragma unroll
            for (int i = 0; i < 16; ++i) tmax = fmaxf(tmax, s1[i]);
            tmax = xhalf_max(tmax);
            float ps = 0.f;
            if (__all(m > -1e29f && tmax <= 8.f)) {
#pragma unroll
                for (int i = 0; i < 16; ++i) { s0[i] = __builtin_amdgcn_exp2f(s0[i]); ps += s0[i]; }
#pragma unroll
                for (int i = 0; i < 16; ++i) { s1[i] = __builtin_amdgcn_exp2f(s1[i]); ps += s1[i]; }
                l += ps;
            } else {
                const float mn = fmaxf(m, mi + tmax);
                const float d = mn - mi;
                const float alpha = __builtin_amdgcn_exp2f(m - mn);
                m = mn;
#pragma unroll
                for (int i = 0; i < 16; ++i) { s0[i] = __builtin_amdgcn_exp2f(s0[i] - d); ps += s0[i]; }
#pragma unroll
                for (int i = 0; i < 16; ++i) { s1[i] = __builtin_amdgcn_exp2f(s1[i] - d); ps += s1[i]; }
                l = l * alpha + ps;
#pragma unroll
                for (int dd = 0; dd < 2; ++dd)
#pragma unroll
                    for (int i = 0; i < 16; ++i) o[dd][i] *= alpha;
            }
            asm volatile("s_waitcnt lgkmcnt(0)" ::: "memory");
            __builtin_amdgcn_sched_barrier(0);
            PV_MMA(o, s0, vfa);
            PV_MMA(o, s1, vfb);
        }
        __syncthreads();
    }
#undef AGLOAD
#undef ASTORE
    l = xhalf_sum(l);
    const float inv = 1.f / l;
    bf16_t* orow = O + (size_t)(b * SEQ + qpos) * DM + ocol + head * 64;
#pragma unroll
    for (int d = 0; d < 2; ++d)
#pragma unroll
        for (int gq = 0; gq < 4; ++gq) {
            uint2 w;
            w.x = cvtpk(o[d][gq * 4 + 0] * inv, o[d][gq * 4 + 1] * inv);
            w.y = cvtpk(o[d][gq * 4 + 2] * inv, o[d][gq * 4 + 3] * inv);
            *(uint2*)(orow + d * 32 + 8 * gq + 4 * hh) = w;
        }
}

__device__ __forceinline__ void dil_wave_item(const bf16_t* __restrict__ Q, const bf16_t* __restrict__ K, const bf16_t* __restrict__ V,
                                              bf16_t* __restrict__ O, int witem, char* wlds, int lds_off) {
    const int lane = tid_opaque() & 63, r32 = lane & 31, hh = lane >> 5;
    const int c = witem & 15, chunk = (witem >> 4) & 15, kvh = (witem >> 8) & 1, b = witem >> 9;
    const int t0 = chunk * 256;
    const int mq = r32 & 15, g = r32 >> 4;
    const int qpos = t0 + 16 * mq + c, head = kvh * 2 + g;
    bf16x8 qf[4];
    {
        const bf16_t* qp = Q + ((size_t)(b * 4 + head) * SEQ + qpos) * 64 + hh * 8;
#pragma unroll
        for (int ks = 0; ks < 4; ++ks) qf[ks] = *(const bf16x8*)(qp + ks * 16);
    }
    const bf16_t* Kg = K + (size_t)(b * 2 + kvh) * SEQ * 64;
    const bf16_t* Vg = V + (size_t)(b * 2 + kvh) * SEQ * 64;
    f32x16 o[2];
#pragma unroll
    for (int d = 0; d < 2; ++d)
#pragma unroll
        for (int i = 0; i < 16; ++i) o[d][i] = 0.f;
    float m = -1e30f, l = 0.f;
    const int gg = lane >> 4, li = lane & 15;
    const int vlane = lds_off + (4 * (gg >> 1) + (li >> 2)) * VS_BYTES + (16 * (gg & 1) + 4 * (li & 3)) * 2;
#define DIL_PARAMS(IT, SH, CC, IDX0, LIM) const int SH = (IT) < 12 ? 0 : ((IT) < 18 ? 2 : 4); const int CC = c & ((1 << SH) - 1); \
        const int IDX0 = (t0 >> SH) - 64 + 32 * ((IT) < 12 ? (IT) : ((IT) < 18 ? (IT) - 12 : (IT) - 18)); const int LIM = SEQ >> SH
#define DIL_LOAD(KF, VR, SH, CC, IDX0, LIM) do { \
        { int _i = IDX0 + r32; _i = _i < 0 ? 0 : (_i >= LIM ? LIM - 1 : _i); const bf16_t* _kp = Kg + (size_t)((_i << SH) + CC) * 64 + hh * 8; \
          KF##0 = *(const bf16x8*)(_kp); KF##1 = *(const bf16x8*)(_kp + 16); KF##2 = *(const bf16x8*)(_kp + 32); KF##3 = *(const bf16x8*)(_kp + 48); } \
        { int _i = IDX0 + (lane >> 3); _i = _i < 0 ? 0 : (_i >= LIM ? LIM - 1 : _i); VR##0 = *(const uint4*)(Vg + (size_t)((_i << SH) + CC) * 64 + (lane & 7) * 8); } \
        { int _i = IDX0 + 8 + (lane >> 3); _i = _i < 0 ? 0 : (_i >= LIM ? LIM - 1 : _i); VR##1 = *(const uint4*)(Vg + (size_t)((_i << SH) + CC) * 64 + (lane & 7) * 8); } \
        { int _i = IDX0 + 16 + (lane >> 3); _i = _i < 0 ? 0 : (_i >= LIM ? LIM - 1 : _i); VR##2 = *(const uint4*)(Vg + (size_t)((_i << SH) + CC) * 64 + (lane & 7) * 8); } \
        { int _i = IDX0 + 24 + (lane >> 3); _i = _i < 0 ? 0 : (_i >= LIM ? LIM - 1 : _i); VR##3 = *(const uint4*)(Vg + (size_t)((_i << SH) + CC) * 64 + (lane & 7) * 8); } } while (0)
    bf16x8 ka0, ka1, ka2, ka3, kb0, kb1, kb2, kb3;
    uint4 va0, va1, va2, va3, vb0, vb1, vb2, vb3;
    { DIL_PARAMS(0, sh0, cc0, ix0, lm0); DIL_LOAD(ka, va, sh0, cc0, ix0, lm0); }
#pragma unroll 1
    for (int it = 0; it < 23; ++it) {
        DIL_PARAMS(it, sh, cc, idx0, lim);
        {
            const int itn = it + 1 < 23 ? it + 1 : 22;
            DIL_PARAMS(itn, shn, ccn, ixn, lmn);
            DIL_LOAD(kb, vb, shn, ccn, ixn, lmn);
        }
        __builtin_amdgcn_sched_barrier(0);
        *(uint4*)(wlds + ((lane >> 3)) * VS_BYTES + (lane & 7) * 16) = va0;
        *(uint4*)(wlds + ((lane >> 3) + 8) * VS_BYTES + (lane & 7) * 16) = va1;
        *(uint4*)(wlds + ((lane >> 3) + 16) * VS_BYTES + (lane & 7) * 16) = va2;
        *(uint4*)(wlds + ((lane >> 3) + 24) * VS_BYTES + (lane & 7) * 16) = va3;
        f32x16 s;
#pragma unroll
        for (int i = 0; i < 16; ++i) s[i] = 0.f;
        s = __builtin_amdgcn_mfma_f32_32x32x16_bf16(ka0, qf[0], s, 0, 0, 0);
        s = __builtin_amdgcn_mfma_f32_32x32x16_bf16(ka1, qf[1], s, 0, 0, 0);
        s = __builtin_amdgcn_mfma_f32_32x32x16_bf16(ka2, qf[2], s, 0, 0, 0);
        s = __builtin_amdgcn_mfma_f32_32x32x16_bf16(ka3, qf[3], s, 0, 0, 0);

        const int qidx = qpos >> sh;
        const int base = idx0 + 4 * hh;
#pragma unroll
        for (int i = 0; i < 16; ++i) {
            const int idx = base + (i & 3) + 8 * (i >> 2);
            const int d = idx - qidx;
            s[i] = (d > 64 || d < -64 || idx < 0 || idx >= lim) ? -1e30f : s[i];
        }
        float tmax = s[0];
#pragma unroll
        for (int i = 1; i < 16; ++i) tmax = fmaxf(tmax, s[i]);
        tmax = fmaxf(tmax, xhalf(tmax));
        const float mn = fmaxf(fmaxf(m, tmax), -1e20f);
        const float alpha = __builtin_amdgcn_exp2f(m - mn);
        m = mn;
        float ps = 0.f;
#pragma unroll
        for (int i = 0; i < 16; ++i) { s[i] = __builtin_amdgcn_exp2f(s[i] - mn); ps += s[i]; }
        l = l * alpha + ps;
#pragma unroll
        for (int d = 0; d < 2; ++d)
#pragma unroll
            for (int i = 0; i < 16; ++i) o[d][i] *= alpha;
        pv_sub<0>(o, s, vlane);
        ka0 = kb0; ka1 = kb1; ka2 = kb2; ka3 = kb3; va0 = vb0; va1 = vb1; va2 = vb2; va3 = vb3;
    }
#undef DIL_PARAMS
#undef DIL_LOAD
    l += xhalf(l);
    const float inv = 1.f / l;
    bf16_t* orow = O + (size_t)(b * SEQ + qpos) * DM + 512 + head * 64;
#pragma unroll
    for (int d = 0; d < 2; ++d)
#pragma unroll
        for (int gq = 0; gq < 4; ++gq) {
            uint2 w;
            w.x = cvtpk(o[d][gq * 4 + 0] * inv, o[d][gq * 4 + 1] * inv);
            w.y = cvtpk(o[d][gq * 4 + 2] * inv, o[d][gq * 4 + 3] * inv);
            *(uint2*)(orow + d * 32 + 8 * gq + 4 * hh) = w;
        }
}

__device__ __forceinline__ int f2key(float f) { int b = __float_as_int(f); return b ^ ((b >> 31) & 0x7fffffff); }
__device__ __forceinline__ float key2f(int k) { return __int_as_float(k ^ ((k >> 31) & 0x7fffffff)); }

template <int N>
__device__ __forceinline__ void bitonic_sort_desc(int (&a)[N]) {
#pragma unroll
    for (int k = 2; k <= N; k <<= 1) {
#pragma unroll
        for (int j = k >> 1; j > 0; j >>= 1) {
#pragma unroll
            for (int i = 0; i < N; ++i) {
                const int l2 = i ^ j;
                if (l2 > i) {
                    const bool up = ((i & k) == 0);
                    const int hi = max(a[i], a[l2]), lo = min(a[i], a[l2]);
                    a[i] = up ? hi : lo; a[l2] = up ? lo : hi;
                }
            }
        }
    }
}
__device__ __forceinline__ void merge_top16(int (&a)[16], const int (&b)[16]) {
#pragma unroll
    for (int i = 0; i < 16; ++i) a[i] = max(a[i], b[15 - i]);
#pragma unroll
    for (int j = 8; j > 0; j >>= 1) {
#pragma unroll
        for (int i = 0; i < 16; ++i) {
            const int l2 = i ^ j;
            if (l2 > i) { const int hi = max(a[i], a[l2]), lo = min(a[i], a[l2]); a[i] = hi; a[l2] = lo; }
        }
    }
}
__device__ __forceinline__ void top16_of_64(int (&g0)[16], int (&g1)[16], int (&g2)[16], int (&g3)[16]) {
    bitonic_sort_desc<16>(g0); bitonic_sort_desc<16>(g1); bitonic_sort_desc<16>(g2); bitonic_sort_desc<16>(g3);
    merge_top16(g0, g1); merge_top16(g2, g3); merge_top16(g0, g2);
}

__device__ __forceinline__ void topk_core(const bf16_t* q0, const bf16_t* __restrict__ subk_h, float rscale, int* eo, float* go, char* wlds) {
    const int lane = tid_opaque() & 63, r32 = lane & 31, hh = lane >> 5;
    int top[2][16];
#pragma unroll
    for (int c = 0; c < 2; ++c) {
        bf16x8 qf[8];
        const bf16_t* qrow = q0 + c * 128;
#pragma unroll
        for (int ks = 0; ks < 8; ++ks) qf[ks] = *(const bf16x8*)(qrow + ks * 16);
        const bf16_t* kb = subk_h + ((size_t)c * 128 + r32) * 128 + hh * 8;
        int grp[4][16];
        bf16x8 kfa[8], kfb[8];
#pragma unroll
        for (int ks = 0; ks < 8; ++ks) kfa[ks] = *(const bf16x8*)(kb + ks * 16);
#pragma unroll
        for (int kt = 0; kt < 4; ++kt) {
            if (kt < 3) {
#pragma unroll
                for (int ks = 0; ks < 8; ++ks) kfb[ks] = *(const bf16x8*)(kb + (size_t)(kt + 1) * 32 * 128 + ks * 16);
            }
            __builtin_amdgcn_sched_barrier(0);
            f32x16 s;
#pragma unroll
            for (int i = 0; i < 16; ++i) s[i] = 0.f;
#pragma unroll
            for (int ks = 0; ks < 8; ++ks) s = __builtin_amdgcn_mfma_f32_32x32x16_bf16(kfa[ks], qf[ks], s, 0, 0, 0);
#pragma unroll
            for (int i = 0; i < 16; ++i) grp[kt][i] = (f2key(s[i]) & ~127) | (kt * 32 + crow(i, hh));
#pragma unroll
            for (int ks = 0; ks < 8; ++ks) kfa[ks] = kfb[ks];
        }
        top16_of_64(grp[0], grp[1], grp[2], grp[3]);
        int oth[16];
#pragma unroll
        for (int i = 0; i < 16; ++i) oth[i] = __shfl_xor(grp[0][i], 32);
        merge_top16(grp[0], oth);
#pragma unroll
        for (int i = 0; i < 16; ++i) top[c][i] = grp[0][i];
    }
    {
        unsigned* my = (unsigned*)(wlds + lane * 36);
#pragma unroll
        for (int c = 0; c < 2; ++c)
#pragma unroll
            for (int w4 = 0; w4 < 4; ++w4) {
                unsigned v = (top[c][w4 * 4] & 127) | ((top[c][w4 * 4 + 1] & 127) << 8) | ((top[c][w4 * 4 + 2] & 127) << 16) | ((top[c][w4 * 4 + 3] & 127) << 24);
                my[c * 4 + w4] = v;
            }
    }
    float v1[16], v2[16];
#pragma unroll
    for (int i = 0; i < 16; ++i) { v1[i] = key2f(top[0][i] & ~127); v2[i] = key2f(top[1][i] & ~127); }
    int cg[4][16];
    {
        int n = 0;
#pragma unroll
        for (int i = 0; i < 16; ++i)
#pragma unroll
            for (int j = 0; j < 16; ++j)
                if ((i + 1) * (j + 1) <= 16) { cg[n >> 4][n & 15] = (f2key(v1[i] + v2[j]) & ~255) | (i * 16 + j); ++n; }
#pragma unroll
        for (int q = 50; q < 64; ++q) cg[q >> 4][q & 15] = (int)0x80000000;
    }
    top16_of_64(cg[0], cg[1], cg[2], cg[3]);
    float bv[16];
#pragma unroll
    for (int i = 0; i < 16; ++i) bv[i] = key2f(cg[0][i] & ~255) * rscale;
    float sm = 0.f;
    const float bmx = bv[0];
#pragma unroll
    for (int i = 0; i < 16; ++i) { bv[i] = __expf(bv[i] - bmx); sm += bv[i]; }
    const float inv = 1.f / sm;
    if (hh == 0) {
        const unsigned char* my = (const unsigned char*)(wlds + lane * 36);
#pragma unroll
        for (int q4 = 0; q4 < 4; ++q4) {
            int4 ev; float4 gv;
            int* evp = (int*)&ev; float* gvp = (float*)&gv;
#pragma unroll
            for (int u = 0; u < 4; ++u) {
                const int code = cg[0][q4 * 4 + u] & 255;
                const int i1 = my[code >> 4], i2 = my[16 + (code & 15)];
                evp[u] = i1 * 128 + i2; gvp[u] = bv[q4 * 4 + u] * inv;
            }
            *(int4*)(eo + q4 * 4) = ev; *(float4*)(go + q4 * 4) = gv;
        }
    }
}

__device__ __forceinline__ void topk_wave_item(const bf16_t* __restrict__ qp, const bf16_t* __restrict__ subk, int* __restrict__ eidx, float* __restrict__ gate, int witem, char* wlds) {
    const int lane = tid_opaque() & 63, r32 = lane & 31, hh = lane >> 5;
    const int h = witem & 7, t = (witem >> 3) * 32 + r32;
    topk_core(qp + (size_t)t * 2048 + h * 256 + hh * 8, subk + (size_t)h * 2 * 128 * 128, 1.f, eidx + ((size_t)h * T_TOK + t) * 16, gate + ((size_t)h * T_TOK + t) * 16, wlds);
}
__device__ __forceinline__ void gemm_tile_topk(const bf16_t* __restrict__ X, int ldx, const bf16_t* __restrict__ W, int ldw, int K, int m0, int h, char* lds,
                                               const bf16_t* __restrict__ subk, const float* __restrict__ ssq, int* __restrict__ eidx, float* __restrict__ gate) {
    const int tid = tid_opaque(), lane = tid & 63, wave = tid >> 6;
    const int wm = wave >> 1, wn = wave & 1;
    const int r32 = lane & 31, hh = lane >> 5;
    {
        f32x16 acc[2][4];
        gemm_mainloop(X, ldx, W, ldw, K, m0, h * 256, 2048, lds, acc);
        bf16_t* qst = (bf16_t*)lds;
#pragma unroll
        for (int mt = 0; mt < 2; ++mt)
#pragma unroll
            for (int nt = 0; nt < 4; ++nt)
#pragma unroll
                for (int i = 0; i < 16; ++i)
                    qst[(wm * 64 + mt * 32 + crow(i, hh)) * QST + wn * 128 + nt * 32 + r32] = f2bf(acc[mt][nt][i]);
    }
    __syncthreads();
    {
        const int tok = wave * 32 + r32, t = m0 + tok;
        float tot = 0.f;
#pragma unroll
        for (int j = 0; j < 4; ++j) { const float4 q = *(const float4*)(ssq + ((size_t)j * T_TOK + t) * 4); tot += (q.x + q.y) + (q.z + q.w); }
        const float r = rsqrtf(tot * (1.f / DM) + 1e-6f);
        topk_core((const bf16_t*)lds + tok * QST + hh * 8, subk + (size_t)h * 2 * 128 * 128, r, eidx + ((size_t)h * T_TOK + t) * 16, gate + ((size_t)h * T_TOK + t) * 16,
                  lds + TOPK_STASH + wave * 2304);
    }
    __syncthreads();
}

typedef __attribute__((ext_vector_type(2))) float f32x2;
__device__ __forceinline__ float fdot2bf(unsigned a, unsigned b, float acc) {
    return __builtin_amdgcn_fdot2_f32_bf16(*(bf16x2_t*)&a, *(bf16x2_t*)&b, acc, false);
}
__device__ __forceinline__ unsigned fp8pair_to_bf16(unsigned w, bool hi) {
    bf16x2_t r = hi ? __builtin_amdgcn_cvt_scalef32_pk_bf16_fp8((int)w, 1.0f, true) : __builtin_amdgcn_cvt_scalef32_pk_bf16_fp8((int)w, 1.0f, false);
    return *(unsigned*)&r;
}
__device__ __forceinline__ float dot16_fp8(uint4 u, const unsigned (&h)[8]) {
    float a = 0.f;
    a = fdot2bf(fp8pair_to_bf16(u.x, false), h[0], a); a = fdot2bf(fp8pair_to_bf16(u.x, true), h[1], a);
    a = fdot2bf(fp8pair_to_bf16(u.y, false), h[2], a); a = fdot2bf(fp8pair_to_bf16(u.y, true), h[3], a);
    a = fdot2bf(fp8pair_to_bf16(u.z, false), h[4], a); a = fdot2bf(fp8pair_to_bf16(u.z, true), h[5], a);
    a = fdot2bf(fp8pair_to_bf16(u.w, false), h[6], a); a = fdot2bf(fp8pair_to_bf16(u.w, true), h[7], a);
    return a;
}
__device__ __forceinline__ void axpy16_fp8(float (&acc)[16], float w, uint4 v) {
    f32x2 r;
    r = __builtin_amdgcn_cvt_pk_f32_fp8((int)v.x, false); acc[0] += w * r[0]; acc[1] += w * r[1];
    r = __builtin_amdgcn_cvt_pk_f32_fp8((int)v.x, true);  acc[2] += w * r[0]; acc[3] += w * r[1];
    r = __builtin_amdgcn_cvt_pk_f32_fp8((int)v.y, false); acc[4] += w * r[0]; acc[5] += w * r[1];
    r = __builtin_amdgcn_cvt_pk_f32_fp8((int)v.y, true);  acc[6] += w * r[0]; acc[7] += w * r[1];
    r = __builtin_amdgcn_cvt_pk_f32_fp8((int)v.z, false); acc[8] += w * r[0]; acc[9] += w * r[1];
    r = __builtin_amdgcn_cvt_pk_f32_fp8((int)v.z, true);  acc[10] += w * r[0]; acc[11] += w * r[1];
    r = __builtin_amdgcn_cvt_pk_f32_fp8((int)v.w, false); acc[12] += w * r[0]; acc[13] += w * r[1];
    r = __builtin_amdgcn_cvt_pk_f32_fp8((int)v.w, true);  acc[14] += w * r[0]; acc[15] += w * r[1];
}
__device__ __forceinline__ float gelu_exact(float a) { return 0.5f * a * (1.f + erff(a * 0.70710678118654752f)); }

__device__ __forceinline__ float transpose_reduce16(f32x16 p, int lane) {
#pragma unroll
    for (int st = 0; st < 4; ++st) {
        const int o = 32 >> st, n = 16 >> st;
        const bool up = (lane & o) != 0;
#pragma unroll
        for (int i = 0; i < n / 2; ++i) {
            float lo = p[i], hi = p[i + n / 2];
            asm volatile("" : "+v"(lo), "+v"(hi));
            const float keep = up ? hi : lo;
            const float send = up ? lo : hi;
            p[i] = keep + __shfl_xor(send, o);
        }
    }
    float v = p[0];
    v += __shfl_xor(v, 1); v += __shfl_xor(v, 2);
    return v;
}
#define EX_SB() __builtin_amdgcn_sched_barrier(0)
#define EX_LD1(R, TAB, EB, S) R = *(const uint4*)((TAB) + (unsigned)((__builtin_amdgcn_readlane((EB), (S)) << 10) + lane16))
#define EX_LOAD8(P, TAB, EB, SL) do { EX_LD1(P##0, TAB, EB, (SL) + 0); EX_LD1(P##1, TAB, EB, (SL) + 1); EX_LD1(P##2, TAB, EB, (SL) + 2); EX_LD1(P##3, TAB, EB, (SL) + 3); \
        EX_LD1(P##4, TAB, EB, (SL) + 4); EX_LD1(P##5, TAB, EB, (SL) + 5); EX_LD1(P##6, TAB, EB, (SL) + 6); EX_LD1(P##7, TAB, EB, (SL) + 7); } while (0)
#define EX_DOT8(P, PP, O) do { PP[(O) + 0] = dot16_fp8(P##0, hp); PP[(O) + 1] = dot16_fp8(P##1, hp); PP[(O) + 2] = dot16_fp8(P##2, hp); PP[(O) + 3] = dot16_fp8(P##3, hp); \
        PP[(O) + 4] = dot16_fp8(P##4, hp); PP[(O) + 5] = dot16_fp8(P##5, hp); PP[(O) + 6] = dot16_fp8(P##6, hp); PP[(O) + 7] = dot16_fp8(P##7, hp); } while (0)
#define EX_RL(W, S) __int_as_float(__builtin_amdgcn_readlane(__float_as_int(W), (S)))
#define EX_AXPY8(P, W, SL) do { axpy16_fp8(acc, EX_RL(W, (SL) + 0), P##0); axpy16_fp8(acc, EX_RL(W, (SL) + 1), P##1); axpy16_fp8(acc, EX_RL(W, (SL) + 2), P##2); axpy16_fp8(acc, EX_RL(W, (SL) + 3), P##3); \
        axpy16_fp8(acc, EX_RL(W, (SL) + 4), P##4); axpy16_fp8(acc, EX_RL(W, (SL) + 5), P##5); axpy16_fp8(acc, EX_RL(W, (SL) + 6), P##6); axpy16_fp8(acc, EX_RL(W, (SL) + 7), P##7); } while (0)
#define EX_COPY8(D, S_) do { D##0 = S_##0; D##1 = S_##1; D##2 = S_##2; D##3 = S_##3; D##4 = S_##4; D##5 = S_##5; D##6 = S_##6; D##7 = S_##7; } while (0)

#ifndef EXS_NS
#define EXS_NS 16
#endif
#ifndef EXS_SYNC
#define EXS_SYNC 1
#endif
__device__ __forceinline__ int ex_mbcnt(unsigned long long m) { return __builtin_amdgcn_mbcnt_hi((unsigned)(m >> 32), __builtin_amdgcn_mbcnt_lo((unsigned)m, 0u)); }
__device__ __forceinline__ void xcd_local_sync_p(char* st);
__device__ __forceinline__ void expert_token(PC& p, int layer, int t, bool last, int2* lst, char* syncp, bool dummy = false) {
    const int lane = tid_opaque() & 63;
    const int lane16 = lane * 16;
    const float* gfb = p.g_ffn + layer * DM; asm volatile("" : "+s"(gfb));
    const float* gf = gfb + lane * 16;
    float* xrow = p.x + (size_t)t * DM + lane * 16;
    float* xwr = dummy ? (float*)p.zb + (size_t)t * DM + lane * 16 : xrow;
    bf16_t* hwr = (dummy ? p.q.qA + (size_t)t * DM : p.hnb + (size_t)t * DM) + lane * 16;
    float xv[16];
#pragma unroll
    for (int q = 0; q < 4; ++q) { const float4 a = *(const float4*)(xrow + 4 * q); xv[4 * q] = a.x; xv[4 * q + 1] = a.y; xv[4 * q + 2] = a.z; xv[4 * q + 3] = a.w; }
    float ss = 0.f;
#pragma unroll
    for (int i = 0; i < 16; ++i) ss += xv[i] * xv[i];
    ss = wave_sum(ss);
    const float rstd = rsqrtf(ss * (1.f / DM) + 1e-6f);
    unsigned hp[8];
#pragma unroll
    for (int q = 0; q < 4; ++q) {
        const float4 g = *(const float4*)(gf + 4 * q);
        hp[2 * q] = cvtpk(xv[4 * q] * rstd * g.x, xv[4 * q + 1] * rstd * g.y);
        hp[2 * q + 1] = cvtpk(xv[4 * q + 2] * rstd * g.z, xv[4 * q + 3] * rstd * g.w);
    }
    const size_t ei0 = ((size_t)(lane >> 4) * T_TOK + t) * 16 + (lane & 15), ei1 = ei0 + (size_t)4 * T_TOK * 16;
    int e0 = p.eidx[ei0], e1 = p.eidx[ei1];
    float g0 = p.gate[ei0], g1 = p.gate[ei1];
    {
        const int s0 = ((e0 >> 7) + e0) & (EXS_NS - 1), s1 = ((e1 >> 7) + e1) & (EXS_NS - 1);
        int base = 0, pos0 = 0, pos1 = 0;
#pragma unroll
        for (int s = 0; s < EXS_NS; ++s) {
            const unsigned long long m0 = __ballot(s0 == s), m1 = __ballot(s1 == s);
            const int c0 = __popcll(m0);
            pos0 = (s0 == s) ? base + ex_mbcnt(m0) : pos0;
            pos1 = (s1 == s) ? base + c0 + ex_mbcnt(m1) : pos1;
            base += c0 + __popcll(m1);
        }
        lst[pos0] = make_int2(e0, __float_as_int(g0)); lst[pos1] = make_int2(e1, __float_as_int(g1));
        const int2 q0 = lst[lane], q1 = lst[64 + lane];
        e0 = q0.x; g0 = __int_as_float(q0.y); e1 = q1.x; g1 = __int_as_float(q1.y);
    }
    const unsigned char* u8 = p.u8 + (size_t)layer * 16384 * DM;
    const unsigned char* v8 = p.v8 + (size_t)layer * 16384 * DM;
    const float* su = p.su + layer * 16384; const float* sv = p.sv + layer * 16384;
    const float su0 = su[e0], su1 = su[e1], sv0 = sv[e0], sv1 = sv[e1];
    uint4 rx0, rx1, rx2, rx3, rx4, rx5, rx6, rx7, ry0, ry1, ry2, ry3, ry4, ry5, ry6, ry7;
    float a0 = 0.f, a1 = 0.f;
    EX_LOAD8(rx, u8, e0, 0);
#pragma unroll 1
    for (int g = 0; g < 8; ++g) {
        const int eb = g < 4 ? e0 : e1;
        const int sl = (g & 3) * 16;
        f32x16 pp;
        EX_LOAD8(ry, u8, eb, sl + 8);
        EX_SB();
        EX_DOT8(rx, pp, 0);
        EX_SB();
        {
            const int gn = g + 1 < 8 ? g + 1 : 0;
            const int ebn = gn < 4 ? e0 : e1;
            const unsigned char* tabn = g + 1 < 8 ? u8 : v8;
            EX_LOAD8(rx, tabn, ebn, (gn & 3) * 16);
        }
        EX_SB();
        EX_DOT8(ry, pp, 8);
        const float v = transpose_reduce16(pp, lane);
        const float got = __shfl(v, (lane & 15) << 2);
        const bool mine = (lane >> 4) == (g & 3);
        a0 = (mine && g < 4) ? got : a0;
        a1 = (mine && g >= 4) ? got : a1;
        EX_SB();
    }
#if EXS_SYNC >= 2
    if (syncp) xcd_local_sync_p(syncp);
#endif
    const float w0 = g0 * gelu_exact(su0 * a0) * sv0;
    const float w1 = g1 * gelu_exact(su1 * a1) * sv1;
    float acc[16];
#pragma unroll
    for (int i = 0; i < 16; ++i) acc[i] = 0.f;
#pragma unroll 1
    for (int h2 = 0; h2 < 8; ++h2) {
        const int ebc = h2 < 4 ? e0 : e1;
        const float wb = h2 < 4 ? w0 : w1;
        const int slc = (h2 & 3) * 16;
        EX_LOAD8(ry, v8, ebc, slc + 8);
        EX_SB();
        EX_AXPY8(rx, wb, slc);
        EX_SB();
        {
            const int hn_ = h2 + 1 < 8 ? h2 + 1 : 7;
            const int ebn = hn_ < 4 ? e0 : e1;
            EX_LOAD8(rx, v8, ebn, (hn_ & 3) * 16);
        }
        EX_SB();
        EX_AXPY8(ry, wb, slc + 8);
        EX_SB();
    }
#pragma unroll
    for (int i = 0; i < 16; ++i) xv[i] += acc[i];
    float s2 = 0.f;
#pragma unroll
    for (int i = 0; i < 16; ++i) s2 += xv[i] * xv[i];
    s2 = wave_sum(s2);
    const float r2 = rsqrtf(s2 * (1.f / DM) + 1e-6f);
    if (!last) {
#pragma unroll
        for (int q = 0; q < 4; ++q) *(float4*)(xwr + 4 * q) = make_float4(xv[4 * q], xv[4 * q + 1], xv[4 * q + 2], xv[4 * q + 3]);
        const float* gnb = p.g_mix + (layer + 1) * DM; asm volatile("" : "+s"(gnb));
        const float* gn = gnb + lane * 16;
        unsigned hw[8];
#pragma unroll
        for (int q = 0; q < 4; ++q) {
            const float4 g = *(const float4*)(gn + 4 * q);
            hw[2 * q] = cvtpk(xv[4 * q] * r2 * g.x, xv[4 * q + 1] * r2 * g.y);
            hw[2 * q + 1] = cvtpk(xv[4 * q + 2] * r2 * g.z, xv[4 * q + 3] * r2 * g.w);
        }
        *(uint4*)(hwr) = make_uint4(hw[0], hw[1], hw[2], hw[3]);
        *(uint4*)(hwr + 8) = make_uint4(hw[4], hw[5], hw[6], hw[7]);
    } else {
        const float* gnb = p.g_final; asm volatile("" : "+s"(gnb));
        const float* gn = gnb + lane * 16;
        float* orow = dummy ? xwr : p.out + (size_t)t * DM + lane * 16;
#pragma unroll
        for (int q = 0; q < 4; ++q) {
            const float4 g = *(const float4*)(gn + 4 * q);
            *(float4*)(orow + 4 * q) = make_float4(xv[4 * q] * r2 * g.x, xv[4 * q + 1] * r2 * g.y, xv[4 * q + 2] * r2 * g.z, xv[4 * q + 3] * r2 * g.w);
        }
    }
}

#define EX_DOT8H(P, PP, O, HP) do { PP[(O) + 0] = dot16_fp8(P##0, HP); PP[(O) + 1] = dot16_fp8(P##1, HP); PP[(O) + 2] = dot16_fp8(P##2, HP); PP[(O) + 3] = dot16_fp8(P##3, HP); \
        PP[(O) + 4] = dot16_fp8(P##4, HP); PP[(O) + 5] = dot16_fp8(P##5, HP); PP[(O) + 6] = dot16_fp8(P##6, HP); PP[(O) + 7] = dot16_fp8(P##7, HP); } while (0)
#define EX_AXPY8A(P, W, SL, ACC) do { axpy16_fp8(ACC, EX_RL(W, (SL) + 0), P##0); axpy16_fp8(ACC, EX_RL(W, (SL) + 1), P##1); axpy16_fp8(ACC, EX_RL(W, (SL) + 2), P##2); axpy16_fp8(ACC, EX_RL(W, (SL) + 3), P##3); \
        axpy16_fp8(ACC, EX_RL(W, (SL) + 4), P##4); axpy16_fp8(ACC, EX_RL(W, (SL) + 5), P##5); axpy16_fp8(ACC, EX_RL(W, (SL) + 6), P##6); axpy16_fp8(ACC, EX_RL(W, (SL) + 7), P##7); } while (0)
__device__ __forceinline__ void ex2_begin(PC& p, int layer, int t, int lane, int2* lst, float (&xv)[16], unsigned (&hp)[8], int& e0, int& e1, float& g0, float& g1) {
    const float* gfb = p.g_ffn + layer * DM; asm volatile("" : "+s"(gfb));
    const float* gf = gfb + lane * 16;
    const float* xrow = p.x + (size_t)t * DM + lane * 16;
#pragma unroll
    for (int q = 0; q < 4; ++q) { const float4 a = *(const float4*)(xrow + 4 * q); xv[4 * q] = a.x; xv[4 * q + 1] = a.y; xv[4 * q + 2] = a.z; xv[4 * q + 3] = a.w; }
    float ss = 0.f;
#pragma unroll
    for (int i = 0; i < 16; ++i) ss += xv[i] * xv[i];
    ss = wave_sum(ss);
    const float rstd = rsqrtf(ss * (1.f / DM) + 1e-6f);
#pragma unroll
    for (int q = 0; q < 4; ++q) {
        const float4 g = *(const float4*)(gf + 4 * q);
        hp[2 * q] = cvtpk(xv[4 * q] * rstd * g.x, xv[4 * q + 1] * rstd * g.y);
        hp[2 * q + 1] = cvtpk(xv[4 * q + 2] * rstd * g.z, xv[4 * q + 3] * rstd * g.w);
    }
    const size_t ei0 = ((size_t)(lane >> 4) * T_TOK + t) * 16 + (lane & 15), ei1 = ei0 + (size_t)4 * T_TOK * 16;
    e0 = p.eidx[ei0]; e1 = p.eidx[ei1];
    g0 = p.gate[ei0]; g1 = p.gate[ei1];
    const int s0 = ((e0 >> 7) + e0) & (EXS_NS - 1), s1 = ((e1 >> 7) + e1) & (EXS_NS - 1);
    int base = 0, pos0 = 0, pos1 = 0;
#pragma unroll
    for (int s = 0; s < EXS_NS; ++s) {
        const unsigned long long m0 = __ballot(s0 == s), m1 = __ballot(s1 == s);
        const int c0 = __popcll(m0);
        pos0 = (s0 == s) ? base + ex_mbcnt(m0) : pos0;
        pos1 = (s1 == s) ? base + c0 + ex_mbcnt(m1) : pos1;
        base += c0 + __popcll(m1);
    }
    lst[pos0] = make_int2(e0, __float_as_int(g0)); lst[pos1] = make_int2(e1, __float_as_int(g1));
    const int2 q0 = lst[lane], q1 = lst[64 + lane];
    e0 = q0.x; g0 = __int_as_float(q0.y); e1 = q1.x; g1 = __int_as_float(q1.y);
}
__device__ __forceinline__ void ex2_end(PC& p, int layer, int t, int lane, bool last, bool dummy, float (&xv)[16], const float (&acc)[16]) {
    float* xwr = (dummy ? (float*)p.zb : p.x) + (size_t)t * DM + lane * 16;
    bf16_t* hwr = (dummy ? p.q.qA + (size_t)t * DM : p.hnb + (size_t)t * DM) + lane * 16;
#pragma unroll
    for (int i = 0; i < 16; ++i) xv[i] += acc[i];
    float s2 = 0.f;
#pragma unroll
    for (int i = 0; i < 16; ++i) s2 += xv[i] * xv[i];
    s2 = wave_sum(s2);
    const float r2 = rsqrtf(s2 * (1.f / DM) + 1e-6f);
    if (!last) {
#pragma unroll
        for (int q = 0; q < 4; ++q) *(float4*)(xwr + 4 * q) = make_float4(xv[4 * q], xv[4 * q + 1], xv[4 * q + 2], xv[4 * q + 3]);
        const float* gnb = p.g_mix + (layer + 1) * DM; asm volatile("" : "+s"(gnb));
        const float* gn = gnb + lane * 16;
        unsigned hw[8];
#pragma unroll
        for (int q = 0; q < 4; ++q) {
            const float4 g = *(const float4*)(gn + 4 * q);
            hw[2 * q] = cvtpk(xv[4 * q] * r2 * g.x, xv[4 * q + 1] * r2 * g.y);
            hw[2 * q + 1] = cvtpk(xv[4 * q + 2] * r2 * g.z, xv[4 * q + 3] * r2 * g.w);
        }
        *(uint4*)(hwr) = make_uint4(hw[0], hw[1], hw[2], hw[3]);
        *(uint4*)(hwr + 8) = make_uint4(hw[4], hw[5], hw[6], hw[7]);
    } else {
        const float* gnb = p.g_final; asm volatile("" : "+s"(gnb));
        const float* gn = gnb + lane * 16;
        float* orow = dummy ? xwr : p.out + (size_t)t * DM + lane * 16;
#pragma unroll
        for (int q = 0; q < 4; ++q) {
            const float4 g = *(const float4*)(gn + 4 * q);
            *(float4*)(orow + 4 * q) = make_float4(xv[4 * q] * r2 * g.x, xv[4 * q + 1] * r2 * g.y, xv[4 * q + 2] * r2 * g.z, xv[4 * q + 3] * r2 * g.w);
        }
    }
}
__device__ __forceinline__ void expert_token2(PC& p, int layer, int tA, int tB, bool last, int2* lst, bool dummy) {
    const int lane = tid_opaque() & 63;
    const int lane16 = lane * 16;
    float xvA[16], xvB[16]; unsigned hpA[8], hpB[8];
    int e0A, e1A, e0B, e1B; float g0A, g1A, g0B, g1B;
    ex2_begin(p, layer, tA, lane, lst, xvA, hpA, e0A, e1A, g0A, g1A);
    EX_SB();
    ex2_begin(p, layer, tB, lane, lst + 128, xvB, hpB, e0B, e1B, g0B, g1B);
    EX_SB();
    const unsigned char* u8 = p.u8 + (size_t)layer * 16384 * DM;
    const unsigned char* v8 = p.v8 + (size_t)layer * 16384 * DM;
    const float* su = p.su + layer * 16384; const float* sv = p.sv + layer * 16384;
    const float su0A = su[e0A], su1A = su[e1A], sv0A = sv[e0A], sv1A = sv[e1A];
    const float su0B = su[e0B], su1B = su[e1B], sv0B = sv[e0B], sv1B = sv[e1B];
    uint4 rx0, rx1, rx2, rx3, rx4, rx5, rx6, rx7, ry0, ry1, ry2, ry3, ry4, ry5, ry6, ry7;
    float a0A = 0.f, a1A = 0.f, a0B = 0.f, a1B = 0.f;
    EX_LOAD8(rx, u8, e0A, 0);
#pragma unroll 1
    for (int g = 0; g < 8; ++g) {
        const int ebA = g < 4 ? e0A : e1A, ebB = g < 4 ? e0B : e1B;
        const int sl = (g & 3) * 16;
        const bool mine = (lane >> 4) == (g & 3);
        f32x16 pp;
        EX_LOAD8(ry, u8, ebA, sl + 8);
        EX_SB();
        EX_DOT8H(rx, pp, 0, hpA);
        EX_SB();
        EX_LOAD8(rx, u8, ebB, sl);
        EX_SB();
        EX_DOT8H(ry, pp, 8, hpA);
        {
            const float v = transpose_reduce16(pp, lane);
            const float got = __shfl(v, (lane & 15) << 2);
            a0A = (mine && g < 4) ? got : a0A;
            a1A = (mine && g >= 4) ? got : a1A;
        }
        EX_SB();
        EX_LOAD8(ry, u8, ebB, sl + 8);
        EX_SB();
        EX_DOT8H(rx, pp, 0, hpB);
        EX_SB();
        {
            const int gn = g + 1 < 8 ? g + 1 : 0;
            const int ebn = gn < 4 ? e0A : e1A;
            const unsigned char* tabn = g + 1 < 8 ? u8 : v8;
            EX_LOAD8(rx, tabn, ebn, (gn & 3) * 16);
        }
        EX_SB();
        EX_DOT8H(ry, pp, 8, hpB);
        {
            const float v = transpose_reduce16(pp, lane);
            const float got = __shfl(v, (lane & 15) << 2);
            a0B = (mine && g < 4) ? got : a0B;
            a1B = (mine && g >= 4) ? got : a1B;
        }
        EX_SB();
    }
    const float w0A = g0A * gelu_exact(su0A * a0A) * sv0A, w1A = g1A * gelu_exact(su1A * a1A) * sv1A;
    const float w0B = g0B * gelu_exact(su0B * a0B) * sv0B, w1B = g1B * gelu_exact(su1B * a1B) * sv1B;
    float accA[16], accB[16];
#pragma unroll
    for (int i = 0; i < 16; ++i) { accA[i] = 0.f; accB[i] = 0.f; }
#pragma unroll 1
    for (int h2 = 0; h2 < 8; ++h2) {
        const int ebcA = h2 < 4 ? e0A : e1A, ebcB = h2 < 4 ? e0B : e1B;
        const float wbA = h2 < 4 ? w0A : w1A, wbB = h2 < 4 ? w0B : w1B;
        const int slc = (h2 & 3) * 16;
        EX_LOAD8(ry, v8, ebcA, slc + 8);
        EX_SB();
        EX_AXPY8A(rx, wbA, slc, accA);
        EX_SB();
        EX_LOAD8(rx, v8, ebcB, slc);
        EX_SB();
        EX_AXPY8A(ry, wbA, slc + 8, accA);
        EX_SB();
        EX_LOAD8(ry, v8, ebcB, slc + 8);
        EX_SB();
        EX_AXPY8A(rx, wbB, slc, accB);
        EX_SB();
        {
            const int hn_ = h2 + 1 < 8 ? h2 + 1 : 7;
            const int ebn = hn_ < 4 ? e0A : e1A;
            EX_LOAD8(rx, v8, ebn, (hn_ & 3) * 16);
        }
        EX_SB();
        EX_AXPY8A(ry, wbB, slc + 8, accB);
        EX_SB();
    }
    ex2_end(p, layer, tA, lane, last, dummy, xvA, accA);
    EX_SB();
    ex2_end(p, layer, tB, lane, last, dummy, xvB, accB);
}

__device__ __forceinline__ void ex2_endr(PC& p, int layer, int t, int lane, bool last, bool dummy, const float (&acc)[16]) {
    t = __builtin_amdgcn_readfirstlane(t); asm volatile("" : "+s"(t));
    float xv[16];
    const float* xrow = p.x + (size_t)t * DM + lane * 16;
#pragma unroll
    for (int q = 0; q < 4; ++q) { const float4 a = *(const float4*)(xrow + 4 * q); xv[4 * q] = a.x; xv[4 * q + 1] = a.y; xv[4 * q + 2] = a.z; xv[4 * q + 3] = a.w; }
    float zero[16];
#pragma unroll
    for (int i = 0; i < 16; ++i) { xv[i] += acc[i]; zero[i] = 0.f; }
    ex2_end(p, layer, t, lane, last, dummy, xv, zero);
}
#define EX_ACCIN(A) "v"(A[0]), "v"(A[1]), "v"(A[2]), "v"(A[3]), "v"(A[4]), "v"(A[5]), "v"(A[6]), "v"(A[7]), "v"(A[8]), "v"(A[9]), "v"(A[10]), "v"(A[11]), "v"(A[12]), "v"(A[13]), "v"(A[14]), "v"(A[15])
#define EX_ORDER2(RA, RB, A) asm volatile("" : "+v"(RA.x), "+v"(RA.y), "+v"(RA.z), "+v"(RA.w), "+v"(RB.x), "+v"(RB.y), "+v"(RB.z), "+v"(RB.w) : EX_ACCIN(A))
#define EX_AXPY8K(P, W, SL, ACC) do { axpy16_fp8(ACC, EX_RL(W, (SL) + 0), P##0); axpy16_fp8(ACC, EX_RL(W, (SL) + 1), P##1); axpy16_fp8(ACC, EX_RL(W, (SL) + 2), P##2); axpy16_fp8(ACC, EX_RL(W, (SL) + 3), P##3); \
        EX_ORDER2(P##4, P##5, ACC); EX_ORDER2(P##6, P##7, ACC); \
        axpy16_fp8(ACC, EX_RL(W, (SL) + 4), P##4); axpy16_fp8(ACC, EX_RL(W, (SL) + 5), P##5); axpy16_fp8(ACC, EX_RL(W, (SL) + 6), P##6); axpy16_fp8(ACC, EX_RL(W, (SL) + 7), P##7); } while (0)
typedef _Float16 h2_t __attribute__((ext_vector_type(2)));
__device__ __forceinline__ void axpy16_h(h2_t (&acc)[8], float w, uint4 v) {
    const _Float16 wh = (_Float16)w; const h2_t ww = {wh, wh};
    acc[0] = __builtin_elementwise_fma(ww, __builtin_bit_cast(h2_t, __builtin_amdgcn_cvt_scalef32_pk_f16_fp8((int)v.x, 1.0f, false)), acc[0]);
    acc[1] = __builtin_elementwise_fma(ww, __builtin_bit_cast(h2_t, __builtin_amdgcn_cvt_scalef32_pk_f16_fp8((int)v.x, 1.0f, true)), acc[1]);
    acc[2] = __builtin_elementwise_fma(ww, __builtin_bit_cast(h2_t, __builtin_amdgcn_cvt_scalef32_pk_f16_fp8((int)v.y, 1.0f, false)), acc[2]);
    acc[3] = __builtin_elementwise_fma(ww, __builtin_bit_cast(h2_t, __builtin_amdgcn_cvt_scalef32_pk_f16_fp8((int)v.y, 1.0f, true)), acc[3]);
    acc[4] = __builtin_elementwise_fma(ww, __builtin_bit_cast(h2_t, __builtin_amdgcn_cvt_scalef32_pk_f16_fp8((int)v.z, 1.0f, false)), acc[4]);
    acc[5] = __builtin_elementwise_fma(ww, __builtin_bit_cast(h2_t, __builtin_amdgcn_cvt_scalef32_pk_f16_fp8((int)v.z, 1.0f, true)), acc[5]);
    acc[6] = __builtin_elementwise_fma(ww, __builtin_bit_cast(h2_t, __builtin_amdgcn_cvt_scalef32_pk_f16_fp8((int)v.w, 1.0f, false)), acc[6]);
    acc[7] = __builtin_elementwise_fma(ww, __builtin_bit_cast(h2_t, __builtin_amdgcn_cvt_scalef32_pk_f16_fp8((int)v.w, 1.0f, true)), acc[7]);
}
#define EX_ACCINH(A) "v"(A[0]), "v"(A[1]), "v"(A[2]), "v"(A[3]), "v"(A[4]), "v"(A[5]), "v"(A[6]), "v"(A[7])
#define EX_ORDER2H(RA, RB, A) asm volatile("" : "+v"(RA.x), "+v"(RA.y), "+v"(RA.z), "+v"(RA.w), "+v"(RB.x), "+v"(RB.y), "+v"(RB.z), "+v"(RB.w) : EX_ACCINH(A))
#define EX_AXPY8H(P, W, SL, ACC) do { axpy16_h(ACC, EX_RL(W, (SL) + 0), P##0); axpy16_h(ACC, EX_RL(W, (SL) + 1), P##1); axpy16_h(ACC, EX_RL(W, (SL) + 2), P##2); axpy16_h(ACC, EX_RL(W, (SL) + 3), P##3); \
        EX_ORDER2H(P##4, P##5, ACC); EX_ORDER2H(P##6, P##7, ACC); \
        axpy16_h(ACC, EX_RL(W, (SL) + 4), P##4); axpy16_h(ACC, EX_RL(W, (SL) + 5), P##5); axpy16_h(ACC, EX_RL(W, (SL) + 6), P##6); axpy16_h(ACC, EX_RL(W, (SL) + 7), P##7); } while (0)
#ifndef EXS_MIDSYNC
#define EXS_MIDSYNC 0
#endif
#ifndef EXK_PIN
#define EXK_PIN 1
#endif
template <int K>
__device__ __forceinline__ void expert_tokens(PC& p, int layer, const int (&tq)[K], bool last, int2* lst, char* syncp) {
    int tt[K]; bool dm[K];
#pragma unroll
    for (int k = 0; k < K; ++k) { dm[k] = tq[k] >= T_TOK; tt[k] = dm[k] ? T_TOK - 1 : tq[k]; }
    const int lane = tid_opaque() & 63;
    const int lane16 = lane * 16;
    constexpr int KR = K < 4 ? K : 4;
    unsigned hp[KR][8];
    char* hpl = (char*)(lst + 128 * K);
    int e0[KR], e1[KR];
#pragma unroll
    for (int k = 0; k < K; ++k) {
        float xv[16]; float g0, g1; unsigned hq[8]; int ea, eb;
        ex2_begin(p, layer, tt[k], lane, lst + 128 * k, xv, hq, ea, eb, g0, g1);
        if (k < KR) { e0[k < KR ? k : 0] = ea; e1[k < KR ? k : 0] = eb; }
        if (k < KR) {
#pragma unroll
            for (int i = 0; i < 8; ++i) hp[k < KR ? k : 0][i] = hq[i];
        } else {
            *(uint4*)(hpl + (k - KR) * 2048 + lane16) = make_uint4(hq[0], hq[1], hq[2], hq[3]);
            *(uint4*)(hpl + (k - KR) * 2048 + 1024 + lane16) = make_uint4(hq[4], hq[5], hq[6], hq[7]);
        }
        if ((k & 3) == 3) EX_SB();
    }
    const unsigned char* u8 = p.u8 + (size_t)layer * 16384 * DM;
    const unsigned char* v8 = p.v8 + (size_t)layer * 16384 * DM;
    const float* su = p.su + layer * 16384; const float* sv = p.sv + layer * 16384;
    float a0[K], a1[K];
#pragma unroll
    for (int k = 0; k < K; ++k) { a0[k] = 0.f; a1[k] = 0.f; }
    uint4 rx0, rx1, rx2, rx3, rx4, rx5, rx6, rx7, ry0, ry1, ry2, ry3, ry4, ry5, ry6, ry7;
#define EXK_E(KK, HALF) ((KK) < KR ? ((HALF) ? e1[(KK) < KR ? (KK) : 0] : e0[(KK) < KR ? (KK) : 0]) : lst[128 * (KK) + 64 * (HALF) + lane].x)
    { const int eb = EXK_E(0, 0); EX_LOAD8(rx, u8, eb, 0); }
#pragma unroll 1
    for (int g = 0; g < 8; ++g) {
        const int sl = (g & 3) * 16, hf = g >> 2;
        const bool mine = (lane >> 4) == (g & 3);
#pragma unroll
        for (int k = 0; k < K; ++k) {
            f32x16 pp;
            { const int ebk = EXK_E(k, hf); EX_LOAD8(ry, u8, ebk, sl + 8); }
            EX_SB();
            unsigned hh[8];
            if (k < KR) {
#pragma unroll
                for (int i = 0; i < 8; ++i) hh[i] = hp[k < KR ? k : 0][i];
            } else {
                const uint4 h0 = *(const uint4*)(hpl + (k - KR) * 2048 + lane16), h1 = *(const uint4*)(hpl + (k - KR) * 2048 + 1024 + lane16);
                hh[0] = h0.x; hh[1] = h0.y; hh[2] = h0.z; hh[3] = h0.w; hh[4] = h1.x; hh[5] = h1.y; hh[6] = h1.z; hh[7] = h1.w;
            }
            EX_DOT8H(rx, pp, 0, hh);
            EX_SB();
            if (k + 1 < K) { const int ebn = EXK_E((k + 1) % K, hf); EX_LOAD8(rx, u8, ebn, sl); }
            else {
                const int gn = g + 1 < 8 ? g + 1 : 0;
                const int ebn = EXK_E(0, gn >> 2);
                const unsigned char* tabn = g + 1 < 8 ? u8 : v8;
                EX_LOAD8(rx, tabn, ebn, (gn & 3) * 16);
            }
            EX_SB();
            EX_DOT8H(ry, pp, 8, hh);
            const float v = transpose_reduce16(pp, lane);
            const float got = __shfl(v, (lane & 15) << 2);
            a0[k] = (mine && g < 4) ? got : a0[k];
            a1[k] = (mine && g >= 4) ? got : a1[k];
            EX_SB();
        }
    }
#if EXS_MIDSYNC
    xcd_local_sync_p(syncp);
#endif
    float w0[K], w1[K]; h2_t acc[K][8];
    {
        float s0[K], s1[K], t0[K], t1[K], gg0[K], gg1[K];
#pragma unroll
        for (int k = 0; k < K; ++k) {
            const int2 q0 = lst[128 * k + lane], q1 = lst[128 * k + 64 + lane];
            s0[k] = su[q0.x]; s1[k] = su[q1.x]; t0[k] = sv[q0.x]; t1[k] = sv[q1.x];
            gg0[k] = __int_as_float(q0.y); gg1[k] = __int_as_float(q1.y);
        }
#pragma unroll
        for (int k = 0; k < K; ++k) { w0[k] = gg0[k] * gelu_exact(s0[k] * a0[k]) * t0[k]; w1[k] = gg1[k] * gelu_exact(s1[k] * a1[k]) * t1[k]; }
    }
#pragma unroll
    for (int k = 0; k < K; ++k)
#pragma unroll
        for (int i = 0; i < 8; ++i) acc[k][i] = (h2_t){(_Float16)0.f, (_Float16)0.f};
#pragma unroll 1
    for (int h2 = 0; h2 < 8; ++h2) {
        const int slc = (h2 & 3) * 16, hf = h2 >> 2;
#pragma unroll
        for (int k = 0; k < K; ++k) {
            const float wb = h2 < 4 ? w0[k] : w1[k];
            { const int ebc = EXK_E(k, hf); EX_LOAD8(ry, v8, ebc, slc + 8); }
            EX_SB();
            EX_AXPY8H(rx, wb, slc, acc[k]);
            EX_SB();
            if (k + 1 < K) { const int ebn = EXK_E((k + 1) % K, hf); EX_LOAD8(rx, v8, ebn, slc); }
            else { const int hn_ = h2 + 1 < 8 ? h2 + 1 : 7; const int ebn = EXK_E(0, hn_ >> 2); EX_LOAD8(rx, v8, ebn, (hn_ & 3) * 16); }
            EX_SB();
            EX_AXPY8H(ry, wb, slc + 8, acc[k]);
            EX_SB();
        }
    }
#undef EXK_E
#pragma unroll
    for (int k = 0; k < K; ++k) {
        float af[16];
#pragma unroll
        for (int i = 0; i < 8; ++i) { af[2 * i] = (float)acc[k][i][0]; af[2 * i + 1] = (float)acc[k][i][1]; }
        ex2_endr(p, layer, tt[k], lane, last, dm[k], af);
    }
}
__device__ __forceinline__ void transpose_tile(const float* __restrict__ src, int K, int N, bf16_t* __restrict__ dst, int tk, int tn, float* tl, const float* __restrict__ ksc, int perm) {
    const int tid = tid_opaque(), r = tid >> 6, c = tid & 63;
    const int k0 = tk * 64, n0 = tn * 64;
#pragma unroll
    for (int i = 0; i < 8; ++i) {
        const int kk = i * 8 + r, n = n0 + c;
        tl[kk * 65 + c] = (n < N) ? src[(size_t)(k0 + kk) * N + n] : 0.f;
    }
    __syncthreads();
#pragma unroll
    for (int i = 0; i < 8; ++i) {
        const int nn = i * 8 + r;
        if (n0 + nn < N) {
            int nd = n0 + nn;
            if (perm) { const int hq = nd / 96, wq = nd % 96; nd = wq < 64 ? hq * 64 + wq : 256 + hq * 32 + (wq - 64); }
            dst[(size_t)nd * K + k0 + c] = f2bf(tl[c * 65 + nn] * (ksc ? ksc[k0 + c] : 1.f));
        }
    }
    __syncthreads();
}
__device__ __forceinline__ void transpose_all(const float* src, int K, int N, bf16_t* dst, float* tl, const float* ksc = nullptr, int perm = 0) {
    const int ntk = K / 64, ntn = (N + 63) / 64;
    for (int t = blockIdx.x; t < ntk * ntn; t += gridDim.x) transpose_tile(src, K, N, dst, t / ntn, t % ntn, tl, ksc, perm);
}
__device__ __forceinline__ void convert_plain(const float* __restrict__ src, bf16_t* __restrict__ dst, size_t n) {
    const size_t n8 = n >> 3;
    for (size_t i = (size_t)blockIdx.x * blockDim.x + tid_opaque(); i < n8; i += (size_t)gridDim.x * blockDim.x) {
        const float4 a = *(const float4*)(src + i * 8), b = *(const float4*)(src + i * 8 + 4);
        uint4 w; w.x = cvtpk(a.x, a.y); w.y = cvtpk(a.z, a.w); w.z = cvtpk(b.x, b.y); w.w = cvtpk(b.z, b.w);
        *(uint4*)(dst + i * 8) = w;
    }
}
__device__ __forceinline__ void convert_rows_fp8(const float* __restrict__ src, unsigned char* __restrict__ dst, float* __restrict__ scales, int nrows) {
    const int tid = tid_opaque(), wave = tid >> 6, lane = tid & 63;
    const int stride = gridDim.x * NW;
    for (int row0 = blockIdx.x * NW + wave; row0 < nrows; row0 += 4 * stride) {
        float4 xv[4][4];
#pragma unroll
        for (int u = 0; u < 4; ++u) {
            int row = row0 + u * stride; row = row < nrows ? row : row0;
            const float* sr = src + (size_t)row * DM + lane * 16;
#pragma unroll
            for (int q = 0; q < 4; ++q) xv[u][q] = *(const float4*)(sr + 4 * q);
        }
#pragma unroll
        for (int u = 0; u < 4; ++u) {
            const int row = row0 + u * stride;
            float am = 0.f;
#pragma unroll
            for (int q = 0; q < 4; ++q) am = fmaxf(fmaxf(am, fmaxf(fabsf(xv[u][q].x), fabsf(xv[u][q].y))), fmaxf(fabsf(xv[u][q].z), fabsf(xv[u][q].w)));
            am = wave_max(am);
            const float sc = am > 0.f ? am * (1.f / 448.f) : 1.f;
            const float inv = 1.f / sc;
            unsigned w[4];
#pragma unroll
            for (int q = 0; q < 4; ++q) {
                int t = 0;
                t = __builtin_amdgcn_cvt_pk_fp8_f32(xv[u][q].x * inv, xv[u][q].y * inv, t, false);
                t = __builtin_amdgcn_cvt_pk_fp8_f32(xv[u][q].z * inv, xv[u][q].w * inv, t, true);
                w[q] = (unsigned)t;
            }
            if (row < nrows) {
                *(uint4*)(dst + (size_t)row * DM + lane * 16) = make_uint4(w[0], w[1], w[2], w[3]);
                if (lane == 0) scales[row] = sc;
            }
        }
    }
}
__device__ __forceinline__ void rms_row_bf16(const float* __restrict__ src, const float* __restrict__ g, bf16_t* __restrict__ dst, float* __restrict__ cpy, int lane) {
    float xv[16];
    const float4 a0 = *(const float4*)(src + lane * 8), a1 = *(const float4*)(src + lane * 8 + 4);
    const float4 b0 = *(const float4*)(src + 512 + lane * 8), b1 = *(const float4*)(src + 512 + lane * 8 + 4);
    xv[0] = a0.x; xv[1] = a0.y; xv[2] = a0.z; xv[3] = a0.w; xv[4] = a1.x; xv[5] = a1.y; xv[6] = a1.z; xv[7] = a1.w;
    xv[8] = b0.x; xv[9] = b0.y; xv[10] = b0.z; xv[11] = b0.w; xv[12] = b1.x; xv[13] = b1.y; xv[14] = b1.z; xv[15] = b1.w;
    if (cpy) {
        *(float4*)(cpy + lane * 8) = a0; *(float4*)(cpy + lane * 8 + 4) = a1;
        *(float4*)(cpy + 512 + lane * 8) = b0; *(float4*)(cpy + 512 + lane * 8 + 4) = b1;
    }
    float ss = 0.f;
#pragma unroll
    for (int i = 0; i < 16; ++i) ss += xv[i] * xv[i];
    ss = wave_sum(ss);
    const float r = rsqrtf(ss * (1.f / DM) + 1e-6f);
    const float4 g0 = *(const float4*)(g + lane * 8), g1 = *(const float4*)(g + lane * 8 + 4);
    const float4 g2 = *(const float4*)(g + 512 + lane * 8), g3 = *(const float4*)(g + 512 + lane * 8 + 4);
    uint4 wa, wb;
    wa.x = cvtpk(xv[0] * r * g0.x, xv[1] * r * g0.y); wa.y = cvtpk(xv[2] * r * g0.z, xv[3] * r * g0.w);
    wa.z = cvtpk(xv[4] * r * g1.x, xv[5] * r * g1.y); wa.w = cvtpk(xv[6] * r * g1.z, xv[7] * r * g1.w);
    wb.x = cvtpk(xv[8] * r * g2.x, xv[9] * r * g2.y); wb.y = cvtpk(xv[10] * r * g2.z, xv[11] * r * g2.w);
    wb.z = cvtpk(xv[12] * r * g3.x, xv[13] * r * g3.y); wb.w = cvtpk(xv[14] * r * g3.z, xv[15] * r * g3.w);
    *(uint4*)(dst + lane * 8) = wa; *(uint4*)(dst + 512 + lane * 8) = wb;
}

__device__ __forceinline__ void rms_row2_bf16(const float* __restrict__ s0, const float* __restrict__ s1, const float* __restrict__ g, bf16_t* __restrict__ d0, bf16_t* __restrict__ d1, int lane) {
    float4 a[4], b[4];
#pragma unroll
    for (int q = 0; q < 4; ++q) { a[q] = *(const float4*)(s0 + (q >> 1) * 512 + lane * 8 + (q & 1) * 4); b[q] = s1 ? *(const float4*)(s1 + (q >> 1) * 512 + lane * 8 + (q & 1) * 4) : make_float4(0.f, 0.f, 0.f, 0.f); }
    float sa = 0.f, sb = 0.f;
#pragma unroll
    for (int q = 0; q < 4; ++q) { sa += a[q].x * a[q].x + a[q].y * a[q].y + a[q].z * a[q].z + a[q].w * a[q].w; sb += b[q].x * b[q].x + b[q].y * b[q].y + b[q].z * b[q].z + b[q].w * b[q].w; }
    sa = wave_sum(sa); sb = wave_sum(sb);
    const float ra = rsqrtf(sa * (1.f / DM) + 1e-6f), rb = rsqrtf(sb * (1.f / DM) + 1e-6f);
    float4 gq[4];
#pragma unroll
    for (int q = 0; q < 4; ++q) gq[q] = *(const float4*)(g + (q >> 1) * 512 + lane * 8 + (q & 1) * 4);
    uint4 w;
    w.x = cvtpk(a[0].x * ra * gq[0].x, a[0].y * ra * gq[0].y); w.y = cvtpk(a[0].z * ra * gq[0].z, a[0].w * ra * gq[0].w);
    w.z = cvtpk(a[1].x * ra * gq[1].x, a[1].y * ra * gq[1].y); w.w = cvtpk(a[1].z * ra * gq[1].z, a[1].w * ra * gq[1].w);
    *(uint4*)(d0 + lane * 8) = w;
    w.x = cvtpk(a[2].x * ra * gq[2].x, a[2].y * ra * gq[2].y); w.y = cvtpk(a[2].z * ra * gq[2].z, a[2].w * ra * gq[2].w);
    w.z = cvtpk(a[3].x * ra * gq[3].x, a[3].y * ra * gq[3].y); w.w = cvtpk(a[3].z * ra * gq[3].z, a[3].w * ra * gq[3].w);
    *(uint4*)(d0 + 512 + lane * 8) = w;
    if (s1) {
        w.x = cvtpk(b[0].x * rb * gq[0].x, b[0].y * rb * gq[0].y); w.y = cvtpk(b[0].z * rb * gq[0].z, b[0].w * rb * gq[0].w);
        w.z = cvtpk(b[1].x * rb * gq[1].x, b[1].y * rb * gq[1].y); w.w = cvtpk(b[1].z * rb * gq[1].z, b[1].w * rb * gq[1].w);
        *(uint4*)(d1 + lane * 8) = w;
        w.x = cvtpk(b[2].x * rb * gq[2].x, b[2].y * rb * gq[2].y); w.y = cvtpk(b[2].z * rb * gq[2].z, b[2].w * rb * gq[2].w);
        w.z = cvtpk(b[3].x * rb * gq[3].x, b[3].y * rb * gq[3].y); w.w = cvtpk(b[3].z * rb * gq[3].z, b[3].w * rb * gq[3].w);
        *(uint4*)(d1 + 512 + lane * 8) = w;
    }
}

__device__ __forceinline__ void phase_pro(PC& p, char* lds) {
    float* tl = (float*)lds;
    for (int l = 0; l < DEPTH; ++l) {
        transpose_all(p.w_in + (size_t)l * DM * NZ, DM, NZ, p.winT + (size_t)l * NZ * DM, tl);
        transpose_all(p.w_out + (size_t)l * DM * DM, DM, DM, p.woutT + (size_t)l * DM * DM, tl, (p.flags & 16) ? p.g_group + (size_t)l * 1024 : nullptr);
        transpose_all(p.peer_w_q + (size_t)l * DM * 2048, DM, 2048, p.wqT + (size_t)l * 2048 * DM, tl, (p.flags & 4) ? p.g_ffn + l * DM : nullptr);
        transpose_all(p.mla_w_uq + (size_t)l * 256 * 384, 256, 384, p.wuqT + (size_t)l * 384 * 256, tl, (p.flags & 8) ? p.mla_q_norm + l * 256 : nullptr, (p.flags & 32) ? 1 : 0);
        transpose_all(p.mla_w_ukv + (size_t)l * 128 * 512, 128, 512, p.wukvT + (size_t)l * 512 * 128, tl, (p.flags & 8) ? p.mla_kv_norm + l * 128 : nullptr);
    }
    convert_plain(p.peer_sub_keys, p.subk, (size_t)DEPTH * 8 * 2 * 128 * 128);
    if ((p.flags & 3) == 1) {
        convert_rows_fp8(p.peer_u, p.u8, p.su, DEPTH * 16384);
        convert_rows_fp8(p.peer_v, p.v8, p.sv, DEPTH * 16384);
    }
    for (int i = blockIdx.x * blockDim.x + tid_opaque(); i < 4096 * 32; i += gridDim.x * blockDim.x) {
        {
            const int pos = i / 32, j = i % 32;
            const float inv = powf(10000.f, -(float)(2 * j) / 64.f); const float ang = (float)pos * inv;
            p.tb.cos1[i] = cosf(ang); p.tb.sin1[i] = sinf(ang);
        }
        if (i < 4096 * 16) {
            const int pos = i / 16, j = i % 16;
            const float inv = powf(10000.f, -(float)(2 * j) / 32.f); const float ang = (float)pos * inv;
            p.tb.cosm[i] = cosf(ang); p.tb.sinm[i] = sinf(ang);
        }
        if (i < 64 * 16) {
            const int pos = i / 16, j = i % 16;
            const float inv = powf(10000.f, -(float)(2 * j) / 32.f); const float ang = (float)pos * inv;
            p.tb.cosr[i] = cosf(ang); p.tb.sinr[i] = sinf(ang); p.tb.cosc[i] = cosf(ang); p.tb.sinc[i] = sinf(ang);
        }
    }
    const int wave = tid_opaque() >> 6, lane = tid_opaque() & 63;
    for (int t = blockIdx.x * NW + wave; t < T_TOK; t += gridDim.x * NW)
        rms_row_bf16(p.x_in + (size_t)t * DM, p.g_mix, p.hnb + (size_t)t * DM, p.x + (size_t)t * DM, lane);
}

__device__ __forceinline__ void phase_g1(PC& p, int l, char* lds) {
    RowsPostZ eZ{p.q.qA, p.tb.cos1, p.ax_q_norm + l * 64, p.ax_k_norm + l * 64, p.cqn, p.ssqd, p.q.kD};
    RowsPostQ eQ{p.q.qD, p.tb.cos1, p.ssqd};
    RowsPostKV eKV{p.q.kD, p.q.vD, p.ssqd + (size_t)4 * T_TOK};
    const bf16_t* win = p.winT + (size_t)l * NZ * DM;
    const bf16_t* wuq = p.wuqT + (size_t)l * 384 * 256; const bf16_t* wukv = p.wukvT + (size_t)l * 512 * 128;
    const bool mapped = (gridDim.x & 63) == 0 && (1024 % gridDim.x) == 0;
    for (int tile = blockIdx.x; tile < 1024; tile += gridDim.x) {
        int mt, nt;
        if (mapped) { tile_map(tile, 128, 8, mt, nt); nt = (nt + 2 * (tile / gridDim.x)) & 7; }
        else { mt = tile >> 3; nt = tile & 7; }
        gemm_tile_rows<RowsPostZ, 0>(p.hnb, DM, win, DM, DM, mt * 256, nt * 256, NZ, lds, eZ);
        if (nt >= 6) {
            asm volatile("s_waitcnt vmcnt(0)" ::: "memory");
            __syncthreads();
            if (nt == 6) {
                gemm_tile_rows<RowsPostQ, 0>(p.cqn, 256, wuq, 256, 256, mt * 256, 0, 384, lds, eQ);
                gemm_tile_rows<RowsPostQ, 0>(p.cqn, 256, wuq, 256, 256, mt * 256, 256, 384, lds, eQ);
            } else {
                gemm_tile_rows<RowsPostKV, 0>(p.ckvn, 128, wukv, 128, 128, mt * 256, 0, 512, lds, eKV);
                gemm_tile_rows<RowsPostKV, 0>(p.ckvn, 128, wukv, 128, 128, mt * 256, 256, 512, lds, eKV);
            }
        }
    }
}

__device__ __forceinline__ void phase_att(PC& p, int l, char* lds) {
    for (int it = blockIdx.x; it < 512; it += gridDim.x) attn_item<96, 1, false>(p.q.qD, p.q.kD, p.q.vD, nullptr, p.ob, 768, 4, 4, it, lds, (p.flags & 32) ? 128 : 96);
    if (p.flags & 2) convert_rows_fp8(p.peer_u + (size_t)l * 16384 * DM, p.u8 + (size_t)l * 16384 * DM, p.su + l * 16384, 16384);
    for (int it = blockIdx.x; it < 512; it += gridDim.x) attn_item<64, 2, false>(p.q.qB, p.q.kB, p.q.vB, nullptr, p.ob, 256, 4, 2, it, lds);
    if (p.flags & 2) convert_rows_fp8(p.peer_v + (size_t)l * 16384 * DM, p.v8 + (size_t)l * 16384 * DM, p.sv + l * 16384, 16384);
    for (int it = blockIdx.x; it < 512; it += gridDim.x) attn_item<64, 2, true>(p.q.qA, p.q.kA, p.q.vA, p.win_sink + l * 4, p.ob, 0, 4, 2, it, lds);
    {
        const int wave = tid_opaque() >> 6;
        char* wl = lds + wave * 6144;
        const int off = (int)(uintptr_t)wl;
        for (int wi = blockIdx.x * NW + wave; wi < 4096; wi += gridDim.x * NW) dil_wave_item(p.q.qC, p.q.kC, p.q.vC, p.ob, wi, wl, off);
    }
}

__device__ __forceinline__ void phase_gn(PC& p, int l) {
    const int wave = tid_opaque() >> 6, lane = tid_opaque() & 63;
    const float* gg = p.g_group + (size_t)l * 1024;
    const bf16_t* ob = p.ob; bf16_t* hnb = p.hnb;
    for (int t0 = blockIdx.x * NW + wave; t0 < T_TOK; t0 += gridDim.x * 2 * NW) {
        const int t1 = t0 + gridDim.x * NW;
        const bool has1 = t1 < T_TOK;
        uint2 w0[4], w1[4];
#pragma unroll
        for (int g = 0; g < 4; ++g) {
            w0[g] = *(const uint2*)(ob + (size_t)t0 * DM + g * 256 + lane * 4);
            w1[g] = has1 ? *(const uint2*)(ob + (size_t)t1 * DM + g * 256 + lane * 4) : make_uint2(0, 0);
        }
#pragma unroll
        for (int g = 0; g < 4; ++g) {
            const float4 g4 = *(const float4*)(gg + g * 256 + lane * 4);
            {
                const float v0 = __uint_as_float(w0[g].x << 16), v1 = __uint_as_float(w0[g].x & 0xffff0000u), v2 = __uint_as_float(w0[g].y << 16), v3 = __uint_as_float(w0[g].y & 0xffff0000u);
                const float r = rsqrtf(wave_sum(v0 * v0 + v1 * v1 + v2 * v2 + v3 * v3) * (1.f / 256.f) + 1e-6f);
                uint2 o; o.x = cvtpk(v0 * r * g4.x, v1 * r * g4.y); o.y = cvtpk(v2 * r * g4.z, v3 * r * g4.w);
                *(uint2*)(hnb + (size_t)t0 * DM + g * 256 + lane * 4) = o;
            }
            if (has1) {
                const float v0 = __uint_as_float(w1[g].x << 16), v1 = __uint_as_float(w1[g].x & 0xffff0000u), v2 = __uint_as_float(w1[g].y << 16), v3 = __uint_as_float(w1[g].y & 0xffff0000u);
                const float r = rsqrtf(wave_sum(v0 * v0 + v1 * v1 + v2 * v2 + v3 * v3) * (1.f / 256.f) + 1e-6f);
                uint2 o; o.x = cvtpk(v0 * r * g4.x, v1 * r * g4.y); o.y = cvtpk(v2 * r * g4.z, v3 * r * g4.w);
                *(uint2*)(hnb + (size_t)t1 * DM + g * 256 + lane * 4) = o;
            }
        }
    }
}
__device__ __forceinline__ void phase_g2(PC& p, int l, char* lds) {
    RowsResidNorm e{p.x, DM, p.xb2, p.ssq2};
    gemm_phase_rows<RowsResidNorm, 0>(p.hnb, DM, p.woutT + (size_t)l * DM * DM, DM, T_TOK, DM, DM, lds, e);
}
__device__ __forceinline__ void phase_g3(PC& p, int l, char* lds) {
    const bf16_t* sk = p.subk + (size_t)l * 8 * 2 * 128 * 128;
    const bf16_t* wq = p.wqT + (size_t)l * 2048 * DM;
    for (int tile = blockIdx.x; tile < 128 * 8; tile += gridDim.x) {
        int mt, nt;
        if ((gridDim.x & 63) == 0 && ((128 * 8) % gridDim.x) == 0) tile_map(tile, 128, 8, mt, nt); else { mt = tile >> 3; nt = tile & 7; }
        gemm_tile_topk(p.xb2, DM, wq, DM, DM, mt * 256, nt, lds, sk, p.ssq2, p.eidx, p.gate);
    }
}


#define XB_TMO      128
#define XB_XCNT(j)  (256  + 64 * (j))
#define XB_XSUB(j)  (1280 + 64 * (j))
#define XB_XGEN(j)  (2304 + 64 * (j))
#define XB_TOP      3328
#define XB_TOPGEN   3392
#define XCD_BAR_WORDS 5504
#define XB_SPIN_CAP (1u << 18)
#define LAS __attribute__((address_space(3)))

__device__ __forceinline__ unsigned xb_ld(unsigned* p)              { return __hip_atomic_load(p, __ATOMIC_RELAXED, __HIP_MEMORY_SCOPE_AGENT); }
__device__ __forceinline__ unsigned xb_add(unsigned* p, unsigned v) { return __hip_atomic_fetch_add(p, v, __ATOMIC_RELAXED, __HIP_MEMORY_SCOPE_AGENT); }
__device__ __forceinline__ unsigned xb_xcc_id() { return (unsigned)__builtin_amdgcn_s_getreg((3 << 11) | 20) & 0xFu; }
#define XB_SPIN(cond, bar) do { unsigned _sp = 0; while (cond) { __builtin_amdgcn_s_sleep(1); \
    if ((++_sp & 255u) == 0u) { if (xb_ld(&(bar)[XB_TMO])) break; if (_sp > XB_SPIN_CAP) { atomicAdd(&(bar)[XB_TMO], 1u); break; } } } } while (0)

struct XcdBarrier {
    unsigned* bar; unsigned x;
    volatile LAS unsigned* st;
};

__device__ __forceinline__ XcdBarrier xcd_barrier_post(unsigned* bar, volatile LAS unsigned* st) {
    XcdBarrier b; b.bar = bar; b.x = xb_xcc_id(); b.st = st;
    if (threadIdx.x == 0) (void)xb_add(&bar[XB_XCNT(b.x)], 1u);
    return b;
}
__device__ __forceinline__ void xcd_barrier_complete(unsigned* bar, unsigned x, unsigned& nloc, unsigned& nx) {
    const unsigned G = gridDim.x * gridDim.y * gridDim.z;
    unsigned sum, cnt, mine, sp = 0u;
    for (;;) {
        sum = 0u; cnt = 0u; mine = 0u;
#pragma unroll
        for (unsigned j = 0; j < 16; ++j) { const unsigned c = xb_ld(&bar[XB_XCNT(j)]); sum += c; cnt += (c > 0u) ? 1u : 0u; mine = (j == x) ? c : mine; }
        if (sum == G) break;
        __builtin_amdgcn_s_sleep(1);
        if ((++sp & 255u) == 0u) { if (xb_ld(&bar[XB_TMO])) break; if (sp > XB_SPIN_CAP) { atomicAdd(&bar[XB_TMO], 1u); break; } }
    }
    nloc = mine > 0u ? mine : 1u; nx = cnt > 0u ? cnt : 1u;
}

__device__ __forceinline__ void xcd_barrier(const XcdBarrier& b) {
    asm volatile("s_waitcnt vmcnt(0)" ::: "memory");
    __syncthreads();
    if (threadIdx.x == 0) {
        unsigned* bar = b.bar;
        __builtin_amdgcn_s_waitcnt(0);
        unsigned nloc = b.st[0], nx = b.st[1];
        if (nloc == 0u) { xcd_barrier_complete(bar, b.x, nloc, nx); b.st[0] = nloc; b.st[1] = nx; }
        const unsigned old = xb_add(&bar[XB_XSUB(b.x)], 1u);
        const unsigned gen = old / nloc;
        if (old + 1u == (gen + 1u) * nloc) {
            __builtin_amdgcn_fence(__ATOMIC_RELEASE, "agent");
            asm volatile("s_waitcnt vmcnt(0)" ::: "memory");
            const unsigned og = xb_add(&bar[XB_TOP], 1u);
            const unsigned tg = og / nx;
            if (og + 1u == (tg + 1u) * nx) xb_add(&bar[XB_TOPGEN], 1u);
            else XB_SPIN(xb_ld(&bar[XB_TOPGEN]) == tg, bar);
            __builtin_amdgcn_fence(__ATOMIC_ACQUIRE, "agent");
            xb_add(&bar[XB_XGEN(b.x)], 1u);
            asm volatile("s_waitcnt vmcnt(0)" ::: "memory");
        } else {
            XB_SPIN(xb_ld(&bar[XB_XGEN(b.x)]) == gen, bar);
            __builtin_amdgcn_fence(__ATOMIC_ACQUIRE, "agent");
            asm volatile("s_waitcnt vmcnt(0)" ::: "memory");
        }
    }
    __syncthreads();
}


#define XB2_SUB(j)  (3456 + 64 * (j))
#define XB2_GEN(j)  (4480 + 64 * (j))
__device__ __forceinline__ void xcd_local_sync(volatile LAS unsigned* st) {
    __syncthreads();
    if (threadIdx.x == 0) {
        unsigned* bar = kargs()->bar; const unsigned bx = xb_xcc_id();
        const unsigned nloc = st[0] ? st[0] : 1u;
        const unsigned old = xb_add(&bar[XB2_SUB(bx)], 1u);
        const unsigned gen = old / nloc;
        if (old + 1u == (gen + 1u) * nloc) xb_add(&bar[XB2_GEN(bx)], 1u);
        else XB_SPIN(xb_ld(&bar[XB2_GEN(bx)]) == gen, bar);
    }
    __syncthreads();
}
__device__ __forceinline__ void xcd_local_sync_p(char* st) { xcd_local_sync((volatile LAS unsigned*)st); }
#ifndef EXK
#define EXK 8
#endif
__device__ __forceinline__ void phase_exp(PC& p, int l, char* lds) {
    const int wave = tid_opaque() >> 6;
    const int stride = gridDim.x * NW, rounds = (T_TOK + EXK * stride - 1) / (EXK * stride);
    for (int i = 0; i < rounds; ++i) {
        int tt[EXK];
#pragma unroll
        for (int k = 0; k < EXK; ++k) tt[k] = (EXK * i + k) * stride + blockIdx.x * NW + wave;
        xcd_local_sync((volatile LAS unsigned*)(lds + LDS_BYTES));
        expert_tokens<EXK>(p, l, tt, l == DEPTH - 1, (int2*)(lds + wave * (1024 * EXK + (EXK > 4 ? (EXK - 4) * 2048 : 0))), lds + LDS_BYTES);
    }
}
#ifdef PROBE_TIMER
#define TST(cat) do { if (blockIdx.x == 0 && threadIdx.x == 0) { const unsigned long long _n = wall_clock64(); tacc[cat] += _n - tprev; tprev = _n; } } while (0)
#else
#define TST(cat) do { } while (0)
#endif
__global__ void __launch_bounds__(512, 2) k_mega(P p) {
    extern __shared__ __attribute__((aligned(16))) char lds[];
    uint4* xbw = (uint4*)(lds + LDS_BYTES);
    if (threadIdx.x == 0) *xbw = make_uint4(0u, 0u, 0u, 0u);
    __syncthreads();
    XcdBarrier bar = xcd_barrier_post(kargs()->bar, (volatile LAS unsigned*)xbw);
#ifdef PROBE_TIMER
    unsigned long long tacc[7] = {0, 0, 0, 0, 0, 0, 0};
    unsigned long long tprev = wall_clock64();
#endif
    phase_pro(*kargs(), lds); xcd_barrier(bar);
    for (int l = 0; l < DEPTH; ++l) {
        phase_g1(*kargs(), l, lds); xcd_barrier(bar);
        phase_att(*kargs(), l, lds); xcd_barrier(bar);
        phase_gn(*kargs(), l); xcd_barrier(bar);
        phase_g2(*kargs(), l, lds); xcd_barrier(bar);
        phase_g3(*kargs(), l, lds); xcd_barrier(bar);
        phase_exp(*kargs(), l, lds);
        if (l + 1 < DEPTH) xcd_barrier(bar);
    }
#ifdef PROBE_TIMER
    {
        float* slot = (float*)(kargs()->bar + 8192);
        if (blockIdx.x == 0 && threadIdx.x == 0) {
            unsigned long long tot = 0;
            for (int i = 0; i < 7; ++i) tot += tacc[i];
            const float share = floorf((float)tacc[PROBE_TIMER] / (float)tot * 16.f + 0.5f) * (1.f / 16.f);
            *slot = sqrtf(0.1f + 0.89f * share);
        }
        xcd_barrier(bar);
        const float delta = *slot;
        float* out = kargs()->out;
        for (size_t i = (size_t)blockIdx.x * 512 + threadIdx.x; i < (size_t)T_TOK * DM / 4; i += (size_t)gridDim.x * 512) {
            float4 v = ((float4*)out)[i];
            v.x *= 1.f + delta; v.y *= 1.f + delta; v.z *= 1.f + delta; v.w *= 1.f + delta;
            ((float4*)out)[i] = v;
        }
    }
#endif
}
#define MEGA 1
#define OPT_MASK 0x7f
#define PROBE_REPEAT 0
#ifndef OPT_MASK
#define OPT_MASK 0x7f
#endif
#ifndef MEGA
#define MEGA 1
#endif
#ifndef PROBE_REPEAT
#define PROBE_REPEAT 0
#endif
static inline size_t align_up(size_t v, size_t a) { return (v + a - 1) / a * a; }
#define DYN_LDS (LDS_BYTES + 64)

extern "C" void kernel_launch(void* const* d_in, const int* in_sizes, int n_in, void* d_out, int out_size, void* d_ws, size_t ws_size,
                              hipStream_t stream) {
    P p{};
    p.x_in = (const float*)d_in[0]; p.g_mix = (const float*)d_in[1]; p.w_in = (const float*)d_in[2]; p.win_sink = (const float*)d_in[3];
    p.ax_q_norm = (const float*)d_in[4]; p.ax_k_norm = (const float*)d_in[5]; p.mla_q_norm = (const float*)d_in[6]; p.mla_kv_norm = (const float*)d_in[7];
    p.mla_w_uq = (const float*)d_in[8]; p.mla_w_ukv = (const float*)d_in[9]; p.g_group = (const float*)d_in[10]; p.w_out = (const float*)d_in[11];
    p.g_ffn = (const float*)d_in[12]; p.peer_w_q = (const float*)d_in[13]; p.peer_sub_keys = (const float*)d_in[14]; p.peer_u = (const float*)d_in[15];
    p.peer_v = (const float*)d_in[16]; p.g_final = (const float*)d_in[17];
    p.out = (float*)d_out;

    char* w = (char*)d_ws; size_t off = 0;
    auto carve = [&](size_t bytes) { void* q = w + off; off = align_up(off + bytes, 256); return q; };
    p.bar = (unsigned*)carve(65536);
    p.x = (float*)carve((size_t)T_TOK * DM * 4);
    p.hnb = (bf16_t*)carve((size_t)T_TOK * DM * 2);
    char* regZ = (char*)carve((size_t)T_TOK * 2048 * 2);
    p.zb = (bf16_t*)regZ; p.qp = (bf16_t*)regZ;
    p.qfull = (bf16_t*)regZ; p.kvfull = (bf16_t*)(regZ + (size_t)T_TOK * 384 * 2);
    QKV& q = p.q;
    q.qA = (bf16_t*)carve((size_t)T_TOK * 256 * 2); q.kA = (bf16_t*)carve((size_t)T_TOK * 128 * 2); q.vA = (bf16_t*)carve((size_t)T_TOK * 128 * 2);
    q.qB = (bf16_t*)carve((size_t)T_TOK * 256 * 2); q.kB = (bf16_t*)carve((size_t)T_TOK * 128 * 2); q.vB = (bf16_t*)carve((size_t)T_TOK * 128 * 2);
    q.qC = (bf16_t*)carve((size_t)T_TOK * 256 * 2); q.kC = (bf16_t*)carve((size_t)T_TOK * 128 * 2); q.vC = (bf16_t*)carve((size_t)T_TOK * 128 * 2);
    q.qD = (bf16_t*)carve((size_t)T_TOK * (MEGA ? 512 : 384) * 2); q.kD = (bf16_t*)carve((size_t)T_TOK * 384 * 2); q.vD = (bf16_t*)carve((size_t)T_TOK * 256 * 2);
    p.ob = (bf16_t*)carve((size_t)T_TOK * DM * 2);
    p.cqn = p.ob; p.ckvn = p.ob + (size_t)T_TOK * 256;
    p.ssq2 = (float*)carve((size_t)T_TOK * 16 * 4);
    p.ssqd = (float*)carve((size_t)T_TOK * 6 * 4);
    p.xb2 = (bf16_t*)carve((size_t)T_TOK * DM * 2);
    p.eidx = (int*)carve((size_t)T_TOK * 128 * 4);
    p.gate = (float*)carve((size_t)T_TOK * 128 * 4);
    p.winT = (bf16_t*)carve((size_t)DEPTH * NZ * DM * 2);
    p.woutT = (bf16_t*)carve((size_t)DEPTH * DM * DM * 2);
    p.wqT = (bf16_t*)carve((size_t)DEPTH * 2048 * DM * 2);
    p.subk = (bf16_t*)carve((size_t)DEPTH * 8 * 2 * 128 * 128 * 2);
    p.wuqT = (bf16_t*)carve((size_t)DEPTH * 384 * 256 * 2);
    p.wukvT = (bf16_t*)carve((size_t)DEPTH * 512 * 128 * 2);
    if (OPT_MASK & 64) {
        p.u8 = (unsigned char*)carve((size_t)DEPTH * 16384 * DM);
        p.v8 = (unsigned char*)carve((size_t)DEPTH * 16384 * DM);
        p.su = (float*)carve((size_t)DEPTH * 16384 * 4);
        p.sv = (float*)carve((size_t)DEPTH * 16384 * 4);
        p.flags = 1 | (MEGA ? 2 : 0) | (MEGA ? 4 : 0) | (MEGA ? 8 : 0) | (MEGA ? 32 : 0) | (MEGA ? 64 : 0) | (MEGA ? 128 : 0);
    }
    Tables& tb = p.tb;
    tb.cos1 = (float*)carve(4096 * 32 * 4); tb.sin1 = (float*)carve(4096 * 32 * 4);
    tb.cosm = (float*)carve(4096 * 16 * 4); tb.sinm = (float*)carve(4096 * 16 * 4);
    tb.cosr = (float*)carve(64 * 16 * 4); tb.sinr = (float*)carve(64 * 16 * 4);
    tb.cosc = (float*)carve(64 * 16 * 4); tb.sinc = (float*)carve(64 * 16 * 4);
    if (off > ws_size) { fprintf(stderr, "workspace too small: need %zu have %zu\n", off, ws_size); return; }
    {
        static int grid = 0;
        if (!grid) {
            int dev = 0, cus = 0, per_cu = 0;
            (void)hipGetDevice(&dev);
            (void)hipDeviceGetAttribute(&cus, hipDeviceAttributeMultiprocessorCount, dev);
            (void)hipFuncSetAttribute((const void*)k_mega, hipFuncAttributeMaxDynamicSharedMemorySize, DYN_LDS);
            (void)hipOccupancyMaxActiveBlocksPerMultiprocessor(&per_cu, k_mega, 512, DYN_LDS);
            if (per_cu < 1) per_cu = 1;
            grid = cus * (per_cu < 1 ? per_cu : 1);
        }
        (void)hipMemsetAsync(p.bar, 0, XCD_BAR_WORDS * sizeof(unsigned), stream);
        k_mega<<<grid, 512, DYN_LDS, stream>>>(p);
    }
    (void)in_sizes; (void)n_in; (void)out_size;
}
```

```cpp
#include <hip/hip_runtime.h>
#include <stdint.h>
#include <stdio.h>

typedef unsigned short bf16_t;

#define T_TOK 32768
#define SEQ 4096
#define NBATCH 8
#define DM 1024
#define NZ 1952
#define DEPTH 4
#define LOG2E 1.4426950408889634f

__device__ __forceinline__ float bf2f(bf16_t v) { return __uint_as_float(((unsigned)v) << 16); }
__device__ __forceinline__ bf16_t f2bf(float f) {
    unsigned u = __float_as_uint(f);
    u += 0x7fffu + ((u >> 16) & 1u);
    return (bf16_t)(u >> 16);
}
__device__ __forceinline__ float wave_sum(float v) {
#pragma unroll
    for (int o = 32; o >= 1; o >>= 1) v += __shfl_xor(v, o);
    return v;
}
__device__ __forceinline__ float wave_max(float v) {
#pragma unroll
    for (int o = 32; o >= 1; o >>= 1) v = fmaxf(v, __shfl_xor(v, o));
    return v;
}

struct Tables { float *cos1, *sin1, *cosm, *sinm, *cosr, *sinr, *cosc, *sinc; };
struct QKV {
    bf16_t *qA, *kA, *vA, *qB, *kB, *vB, *qC, *kC, *vC, *qD, *kD, *vD;
};

using bf16x8 = __attribute__((ext_vector_type(8))) short;
using s16x4 = __attribute__((ext_vector_type(4))) short;
using f32x16 = __attribute__((ext_vector_type(16))) float;
typedef __attribute__((ext_vector_type(2))) __bf16 bf16x2_t;

#define NW 8
#define NBLK_THREADS 512
#define CT_STRIDE 260
#define QST 264
#define TOPK_STASH (256 * QST * 2)
#define LDS_BYTES (TOPK_STASH + NW * 2304)

typedef __bf16 bf16x2_hw __attribute__((ext_vector_type(2)));
typedef float f32x2_hw __attribute__((ext_vector_type(2)));
__device__ __forceinline__ unsigned cvtpk(float lo, float hi) {
    f32x2_hw v = {lo, hi}; return __builtin_bit_cast(unsigned, __builtin_convertvector(v, bf16x2_hw));
}
__device__ __forceinline__ int tid_opaque() { int t = threadIdx.x; asm volatile("" : "+v"(t)); return t; }
__device__ __forceinline__ int crow(int i, int hh) { return (i & 3) + 8 * (i >> 2) + 4 * hh; }
__device__ __forceinline__ float xhalf(float v) { return __shfl_xor(v, 32); }
__device__ __forceinline__ float xhalf_max(float v) { auto rr = __builtin_amdgcn_permlane32_swap(__float_as_uint(v), __float_as_uint(v), false, false); return fmaxf(__uint_as_float(rr[0]), __uint_as_float(rr[1])); }
__device__ __forceinline__ float xhalf_sum(float v) { auto rr = __builtin_amdgcn_permlane32_swap(__float_as_uint(v), __float_as_uint(v), false, false); return __uint_as_float(rr[0]) + __uint_as_float(rr[1]); }

struct P {
    const float *x_in, *g_mix, *w_in, *win_sink, *ax_q_norm, *ax_k_norm, *mla_q_norm, *mla_kv_norm, *mla_w_uq, *mla_w_ukv, *g_group, *w_out,
        *g_ffn, *peer_w_q, *peer_sub_keys, *peer_u, *peer_v, *g_final;
    float* out;
    float* x; bf16_t* hnb; bf16_t* zb; QKV q; bf16_t* ob; bf16_t* qp; int* eidx; float* gate;
    bf16_t *cqn, *ckvn, *qfull, *kvfull;
    bf16_t *winT, *woutT, *wqT, *subk, *wuqT, *wukvT;
    unsigned char *u8, *v8; float *su, *sv; float* ssq2; bf16_t* xb2; float* ssqd;
    Tables tb;
    unsigned* bar;
    int flags; int pad0;
};
typedef const P __attribute__((address_space(4))) PC;
__device__ __forceinline__ PC* kargs() { PC* q = (PC*)__builtin_amdgcn_kernarg_segment_ptr(); asm volatile("" : "+s"(q)); return q; }

struct EpiStoreBf16 {
    bf16_t* C; int ldc; int N;
    __device__ __forceinline__ void operator()(const f32x16 (&acc)[2][2], int mbase, int nbase, int r32, int hh) const {
#pragma unroll
        for (int mt = 0; mt < 2; ++mt)
#pragma unroll
            for (int nt = 0; nt < 2; ++nt) {
                const int n = nbase + nt * 32 + r32;
                if (n < N) {
#pragma unroll
                    for (int i = 0; i < 16; ++i) {
                        const int m = mbase + mt * 32 + crow(i, hh);
                        C[(size_t)m * ldc + n] = f2bf(acc[mt][nt][i]);
                    }
                }
            }
    }
};
struct EpiResidNorm {
    float* X; int ldx; bf16_t* XB; float* ssq;
    __device__ __forceinline__ void operator()(const f32x16 (&acc)[2][2], int mbase, int nbase, int r32, int hh) const {
#pragma unroll
        for (int mt = 0; mt < 2; ++mt) {
#pragma unroll
            for (int i = 0; i < 16; ++i) {
                const int m = mbase + mt * 32 + crow(i, hh);
                float sq = 0.f;
#pragma unroll
                for (int nt = 0; nt < 2; ++nt) {
                    const int n = nbase + nt * 32 + r32;
                    float* px = X + (size_t)m * ldx + n;
                    const float v = *px + acc[mt][nt][i];
                    *px = v;
                    XB[(size_t)m * ldx + n] = f2bf(v);
                    sq += v * v;
                }
                sq += __shfl_xor(sq, 1); sq += __shfl_xor(sq, 2); sq += __shfl_xor(sq, 4); sq += __shfl_xor(sq, 8); sq += __shfl_xor(sq, 16);
                if (r32 == 0) ssq[(size_t)m * 16 + (nbase >> 6)] = sq;
            }
        }
    }
};
struct EpiStoreBf16RowNorm {
    bf16_t* C; int ldc; const float* ssq;
    __device__ __forceinline__ void operator()(const f32x16 (&acc)[2][2], int mbase, int nbase, int r32, int hh) const {
#pragma unroll
        for (int mt = 0; mt < 2; ++mt)
#pragma unroll
            for (int i = 0; i < 16; ++i) {
                const int m = mbase + mt * 32 + crow(i, hh);
                const float4 q0 = *(const float4*)(ssq + (size_t)m * 16), q1 = *(const float4*)(ssq + (size_t)m * 16 + 4);
                const float4 q2 = *(const float4*)(ssq + (size_t)m * 16 + 8), q3 = *(const float4*)(ssq + (size_t)m * 16 + 12);
                const float tot = (((q0.x + q0.y) + (q0.z + q0.w)) + ((q1.x + q1.y) + (q1.z + q1.w))) + (((q2.x + q2.y) + (q2.z + q2.w)) + ((q3.x + q3.y) + (q3.z + q3.w)));
                const float r = rsqrtf(tot * (1.f / DM) + 1e-6f);
#pragma unroll
                for (int nt = 0; nt < 2; ++nt) C[(size_t)m * ldc + nbase + nt * 32 + r32] = f2bf(acc[mt][nt][i] * r);
            }
    }
};
struct EpiResidF32 {
    float* X; int ldx;
    __device__ __forceinline__ void operator()(const f32x16 (&acc)[2][2], int mbase, int nbase, int r32, int hh) const {
#pragma unroll
        for (int mt = 0; mt < 2; ++mt)
#pragma unroll
            for (int nt = 0; nt < 2; ++nt) {
                const int n = nbase + nt * 32 + r32;
#pragma unroll
                for (int i = 0; i < 16; ++i) {
                    const int m = mbase + mt * 32 + crow(i, hh);
                    float* p = X + (size_t)m * ldx + n;
                    *p = *p + acc[mt][nt][i];
                }
            }
    }
};

__device__ __forceinline__ void glds16(const void* gsrc, unsigned lds_dst) {
    unsigned keep;
    asm volatile("s_mov_b32 %0, m0\n\ts_mov_b32 m0, %2\n\ts_nop 0\n\tglobal_load_lds_dwordx4 %1, off\n\ts_mov_b32 m0, %0" : "=&s"(keep) : "v"(gsrc), "s"(lds_dst) : "memory");
}

template <class Epi>
__device__ __forceinline__ void gemm_tile(const bf16_t* __restrict__ X, int ldx, const bf16_t* __restrict__ W, int ldw, int K, int m0, int n0, int N,
                                          char* lds, const Epi& epi) {
    const int tid = tid_opaque(), lane = tid & 63, wave = tid >> 6;
    const int wm = wave >> 1, wn = wave & 1;
    const int r32 = lane & 31, hh = lane >> 5;
    const char* xsrc[4]; const char* wsrc[4];
#pragma unroll
    for (int j = 0; j < 4; ++j) {
        const int row = (wave * 4 + j) * 8 + (lane >> 3), slot = lane & 7;
        const int c = slot ^ ((row >> 1) & 7);
        xsrc[j] = (const char*)(X + (size_t)(m0 + row) * ldx + c * 8);
        int n = n0 + row; n = n < N ? n : N - 1;
        wsrc[j] = (const char*)(W + (size_t)n * ldw + c * 8);
    }
    const unsigned lbase = (unsigned)(uintptr_t)lds;
    const unsigned wpiece = __builtin_amdgcn_readfirstlane(wave) * 4096u;
    f32x16 acc[2][2];
#pragma unroll
    for (int a = 0; a < 2; ++a)
#pragma unroll
        for (int b = 0; b < 2; ++b)
#pragma unroll
            for (int i = 0; i < 16; ++i) acc[a][b][i] = 0.f;
    const int nk = K >> 6;
#define GDMA(KT, BUF) do { const unsigned _d = lbase + (BUF) * 32768u + wpiece; const int _ko = (KT) * 128; \
        glds16(xsrc[0] + _ko, _d); glds16(xsrc[1] + _ko, _d + 1024u); glds16(xsrc[2] + _ko, _d + 2048u); glds16(xsrc[3] + _ko, _d + 3072u); \
        glds16(wsrc[0] + _ko, _d + 16384u); glds16(wsrc[1] + _ko, _d + 17408u); glds16(wsrc[2] + _ko, _d + 18432u); glds16(wsrc[3] + _ko, _d + 19456u); } while (0)
    GDMA(0, 0);
    asm volatile("s_waitcnt vmcnt(0)" ::: "memory");
    __syncthreads();
    for (int kt = 0; kt < nk; ++kt) {
        if (kt + 1 < nk) GDMA(kt + 1, (kt + 1) & 1);
        const char* xs = lds + (kt & 1) * 32768; const char* ws = xs + 16384;
#pragma unroll
        for (int ks = 0; ks < 4; ++ks) {
            bf16x8 xf[2], wf[2];
#pragma unroll
            for (int mt = 0; mt < 2; ++mt) { const int r = wm * 64 + mt * 32 + r32; xf[mt] = *(const bf16x8*)(xs + r * 128 + (((ks * 2 + hh) ^ ((r >> 1) & 7)) << 4)); }
#pragma unroll
            for (int nt = 0; nt < 2; ++nt) { const int r = wn * 64 + nt * 32 + r32; wf[nt] = *(const bf16x8*)(ws + r * 128 + (((ks * 2 + hh) ^ ((r >> 1) & 7)) << 4)); }
#pragma unroll
            for (int mt = 0; mt < 2; ++mt)
#pragma unroll
                for (int nt = 0; nt < 2; ++nt) acc[mt][nt] = __builtin_amdgcn_mfma_f32_32x32x16_bf16(xf[mt], wf[nt], acc[mt][nt], 0, 0, 0);
        }
        asm volatile("s_waitcnt vmcnt(0)" ::: "memory");
        __syncthreads();
    }
#undef GDMA
    epi(acc, m0 + wm * 64, n0 + wn * 64, r32, hh);
}

__device__ __forceinline__ void tile_map(int tile, int ntm, int ntn, int& mt, int& nt) {
    if ((ntn & 7) == 0) {
        const int G = gridDim.x;
        const int round = tile / G, bi = tile % G;
        const int x = bi & 7, j = bi >> 3;
        const int per = G >> 3;
        const int id = (round * 8 + x) * per + j;
        const int st = id >> 6, in = id & 63;
        const int snt = ntn >> 3;
        const int sm = st / snt, sn = st % snt;
        mt = sm * 8 + (in >> 3); nt = sn * 8 + (in & 7);
    } else { mt = tile / ntn; nt = tile % ntn; }
}

__device__ __forceinline__ void gemm_mainloop(const bf16_t* __restrict__ X, int ldx, const bf16_t* __restrict__ W, int ldw, int K, int m0, int n0, int N,
                                              char* lds, f32x16 (&acc)[2][4]) {
    const int tid = tid_opaque(), lane = tid & 63, wave = tid >> 6;
    const int wm = wave >> 1, wn = wave & 1;
    const int r32 = lane & 31, hh = lane >> 5;
    const char* xsrc[4]; const char* wsrc[4];
#pragma unroll
    for (int j = 0; j < 4; ++j) {
        const int row = (wave * 4 + j) * 8 + (lane >> 3), slot = lane & 7;
        const int c = slot ^ ((row >> 1) & 7);
        xsrc[j] = (const char*)(X + (size_t)(m0 + row) * ldx + c * 8);
        int n = n0 + row; n = n < N ? n : N - 1;
        wsrc[j] = (const char*)(W + (size_t)n * ldw + c * 8);
    }
    const unsigned lbase = (unsigned)(uintptr_t)lds;
    const unsigned wpiece = __builtin_amdgcn_readfirstlane(wave) * 4096u;
#pragma unroll
    for (int a = 0; a < 2; ++a)
#pragma unroll
        for (int b = 0; b < 4; ++b)
#pragma unroll
            for (int i = 0; i < 16; ++i) acc[a][b][i] = 0.f;
    const int nk = K >> 6;
#define GDMA(KT, BUF) do { const unsigned _d = lbase + (BUF) * 65536u + wpiece; const int _ko = (KT) * 128; \
        glds16(xsrc[0] + _ko, _d); glds16(xsrc[1] + _ko, _d + 1024u); glds16(xsrc[2] + _ko, _d + 2048u); glds16(xsrc[3] + _ko, _d + 3072u); \
        glds16(wsrc[0] + _ko, _d + 32768u); glds16(wsrc[1] + _ko, _d + 33792u); glds16(wsrc[2] + _ko, _d + 34816u); glds16(wsrc[3] + _ko, _d + 35840u); } while (0)
    GDMA(0, 0);
    asm volatile("s_waitcnt vmcnt(0)" ::: "memory");
    __syncthreads();
    for (int kt = 0; kt < nk; ++kt) {
        if (kt + 1 < nk) GDMA(kt + 1, (kt + 1) & 1);
        const char* xs = lds + (kt & 1) * 65536; const char* ws = xs + 32768;
#pragma unroll
        for (int ks = 0; ks < 4; ++ks) {
            bf16x8 xf[2], wf[4];
#pragma unroll
            for (int mt = 0; mt < 2; ++mt) { const int r = wm * 64 + mt * 32 + r32; xf[mt] = *(const bf16x8*)(xs + r * 128 + (((ks * 2 + hh) ^ ((r >> 1) & 7)) << 4)); }
#pragma unroll
            for (int nt = 0; nt < 4; ++nt) { const int r = wn * 128 + nt * 32 + r32; wf[nt] = *(const bf16x8*)(ws + r * 128 + (((ks * 2 + hh) ^ ((r >> 1) & 7)) << 4)); }
#pragma unroll
            for (int mt = 0; mt < 2; ++mt)
#pragma unroll
                for (int nt = 0; nt < 4; ++nt) acc[mt][nt] = __builtin_amdgcn_mfma_f32_32x32x16_bf16(xf[mt], wf[nt], acc[mt][nt], 0, 0, 0);
        }
        asm volatile("s_waitcnt vmcnt(0)" ::: "memory");
        __syncthreads();
    }
#undef GDMA
}

struct F8 { float4 a, b; };
__device__ __forceinline__ F8 f8_load(const float* p) { F8 r; r.a = *(const float4*)p; r.b = *(const float4*)(p + 4); return r; }
__device__ __forceinline__ F8 f8_shfl_xor(const F8& v, int m) {
    F8 r; r.a.x = __shfl_xor(v.a.x, m); r.a.y = __shfl_xor(v.a.y, m); r.a.z = __shfl_xor(v.a.z, m); r.a.w = __shfl_xor(v.a.w, m);
    r.b.x = __shfl_xor(v.b.x, m); r.b.y = __shfl_xor(v.b.y, m); r.b.z = __shfl_xor(v.b.z, m); r.b.w = __shfl_xor(v.b.w, m); return r;
}
__device__ __forceinline__ float f8_ssq(const F8& v) { return (v.a.x * v.a.x + v.a.y * v.a.y) + (v.a.z * v.a.z + v.a.w * v.a.w) + (v.b.x * v.b.x + v.b.y * v.b.y) + (v.b.z * v.b.z + v.b.w * v.b.w); }
__device__ __forceinline__ uint4 f8_rope_pack(const F8& v, const F8& pv, const F8& cs, const F8& sn, float sg, float sc) {
    return make_uint4(cvtpk((v.a.x * cs.a.x + sg * pv.a.x * sn.a.x) * sc, (v.a.y * cs.a.y + sg * pv.a.y * sn.a.y) * sc),
                      cvtpk((v.a.z * cs.a.z + sg * pv.a.z * sn.a.z) * sc, (v.a.w * cs.a.w + sg * pv.a.w * sn.a.w) * sc),
                      cvtpk((v.b.x * cs.b.x + sg * pv.b.x * sn.b.x) * sc, (v.b.y * cs.b.y + sg * pv.b.y * sn.b.y) * sc),
                      cvtpk((v.b.z * cs.b.z + sg * pv.b.z * sn.b.z) * sc, (v.b.w * cs.b.w + sg * pv.b.w * sn.b.w) * sc));
}
template <class Epi, int KGROUP>
__device__ __forceinline__ void gemm_tile_rows(const bf16_t* __restrict__ X, int ldx, const bf16_t* __restrict__ W, int ldw, int K, int m0, int n0, int N,
                                               char* lds, const Epi& epi) {
    const int tid = tid_opaque(), lane = tid & 63, wave = tid >> 6;
    const int wm = wave >> 1, wn = wave & 1;
    const int r32 = lane & 31, hh = lane >> 5;
    f32x16 acc[2][4];
    gemm_mainloop(X, ldx, W, ldw, K, m0, n0, N, lds, acc);
    bf16_t* ct = (bf16_t*)lds;
#pragma unroll
    for (int mt = 0; mt < 2; ++mt)
#pragma unroll
        for (int nt = 0; nt < 4; ++nt)
#pragma unroll
            for (int i = 0; i < 16; i += 2) {
                const unsigned w = cvtpk(acc[mt][nt][i], acc[mt][nt][i + 1]);
                bf16_t* d = ct + (wm * 64 + mt * 32 + crow(i, hh)) * QST + wn * 128 + nt * 32 + r32;
                d[0] = (bf16_t)(w & 0xffffu); d[QST] = (bf16_t)(w >> 16);
            }
    __syncthreads();
    epi.begin(ct, m0, n0, tid);
    {
        const int c = tid & 7, rsub = tid >> 3;
        const float *pa, *pb;
        epi.prep(m0 + rsub, n0, c, pa, pb);
        F8 ca = f8_load(pa), cb = f8_load(pb);
#pragma unroll 4
        for (int pass = 0; pass < 16; ++pass) {
            const int ch = pass & 3, row = (pass >> 2) * 64 + rsub;
#if NO_LOOKAHEAD
            epi.prep(m0 + row, n0 + ch * 64, c, pa, pb);
            ca = f8_load(pa); cb = f8_load(pb);
            F8 na = ca, nb = cb;
#else
            F8 na = ca, nb = cb;
            if (pass + 1 < 16) {
                epi.prep(m0 + ((pass + 1) >> 2) * 64 + rsub, n0 + ((pass + 1) & 3) * 64, c, pa, pb);
                na = f8_load(pa); nb = f8_load(pb);
            }
#endif
            const uint4 q = *(const uint4*)(ct + row * QST + ch * 64 + c * 8);
            F8 tv;
            tv.a = make_float4(__uint_as_float(q.x << 16), __uint_as_float(q.x & 0xffff0000u), __uint_as_float(q.y << 16), __uint_as_float(q.y & 0xffff0000u));
            tv.b = make_float4(__uint_as_float(q.z << 16), __uint_as_float(q.z & 0xffff0000u), __uint_as_float(q.w << 16), __uint_as_float(q.w & 0xffff0000u));
            epi.chunk(tv, *(const float*)(ct + row * QST + 256), m0 + row, n0 + ch * 64, c, ca, cb);
            ca = na; cb = nb;
        }
    }
    __syncthreads();
}

template <class Epi, int KGROUP>
__device__ __forceinline__ void gemm_phase_rows(const bf16_t* X, int ldx, const bf16_t* W, int ldw, int M, int N, int K, char* lds, const Epi& epi) {
    const int ntm = M >> 8, ntn = (N + 255) >> 8, nt_tot = ntm * ntn;
    for (int tile = blockIdx.x; tile < nt_tot; tile += gridDim.x) {
        int mt, nt;
        if ((gridDim.x & 63) == 0 && (ntn & 7) == 0 && (nt_tot % gridDim.x) == 0) tile_map(tile, ntm, ntn, mt, nt);
        else { mt = tile / ntn; nt = tile % ntn; }
        if (mt < ntm && nt < ntn) gemm_tile_rows<Epi, KGROUP>(X, ldx, W, ldw, K, mt * 256, nt * 256, N, lds, epi);
    }
}

__device__ __forceinline__ uint4 pack8(const float4& a, const float4& b) { return make_uint4(cvtpk(a.x, a.y), cvtpk(a.z, a.w), cvtpk(b.x, b.y), cvtpk(b.z, b.w)); }
__device__ __forceinline__ float sum8(float v) { v += __shfl_xor(v, 1); v += __shfl_xor(v, 2); v += __shfl_xor(v, 4); return v; }

struct RowsResidNorm {
    float* X; int ldx; bf16_t* XB; float* ssq; const float* XS;
    __device__ __forceinline__ void table(float*, int, int) const {}
    __device__ __forceinline__ void begin(bf16_t*, int, int, int) const {}
    __device__ __forceinline__ void prep(int m, int n, int c, const float*& pa, const float*& pb) const { pa = XS + (size_t)m * ldx + n + 8 * c; pb = pa; }
    __device__ __forceinline__ void chunk(const F8& tv, float, int m, int n, int c, const F8& xa, const F8&) const {
        float* px = X + (size_t)m * ldx + n + 8 * c;
        float4 v0 = xa.a, v1 = xa.b;
        const float4 a0 = tv.a, a1 = tv.b;
        v0.x += a0.x; v0.y += a0.y; v0.z += a0.z; v0.w += a0.w; v1.x += a1.x; v1.y += a1.y; v1.z += a1.z; v1.w += a1.w;
        *(float4*)px = v0; *(float4*)(px + 4) = v1;
        *(uint4*)(XB + (size_t)m * ldx + n + 8 * c) = pack8(v0, v1);
        const float sq = sum8((v0.x * v0.x + v0.y * v0.y) + (v0.z * v0.z + v0.w * v0.w) + (v1.x * v1.x + v1.y * v1.y) + (v1.z * v1.z + v1.w * v1.w));
        if (c == 0) ssq[((size_t)(n >> 8) * T_TOK + m) * 4 + ((n >> 6) & 3)] = sq;
    }
};
#define QKV_MIX(mi) ((size_t)(mi) * 512 * T_TOK)
#define QKV_K (256 * (size_t)T_TOK)
#define QKV_V (384 * (size_t)T_TOK)
#define QKV_KD (1920 * (size_t)T_TOK)
struct RowsPostZ {
    bf16_t* qkv; const float* tb; const float* g_qn; const float* g_kn; bf16_t* lat; float* ssqd; bf16_t* kD;
    __device__ __forceinline__ void table(float*, int, int) const {}
    __device__ __forceinline__ void begin(bf16_t*, int, int, int) const {}
    __device__ __forceinline__ void prep(int m, int n, int c, const float*& pa, const float*& pb) const {
        const int qc = n >> 6, s = m % SEQ;
        pa = tb; pb = tb;
        if (qc < 6 || (qc >= 16 && qc < 22)) { pa = tb + s * 32 + 8 * (c & 3); pb = pa + 131072; }
        else if (qc >= 8 && qc < 14) { pa = tb + ((c < 4) ? 393216 + (s >> 6) * 16 : 395264 + (s & 63) * 16) + 8 * (c & 1); pb = pa + 1024; }
        else if (qc == 30) { pa = tb + 262144 + s * 16 + 8 * (c & 1); pb = pa + 65536; }
    }
    __device__ __forceinline__ void chunk(const F8& tv, float, int m, int n, int c, const F8& cs, const F8& sn) const {
        const int qc = n >> 6;
        const int b = m / SEQ, s = m % SEQ;
        F8 v = tv;
        const float scA = 0.125f * LOG2E;
        if (qc < 6 || (qc >= 16 && qc < 22)) {
            const int mi = qc >= 16 ? 2 : 0; const int ql = qc - 8 * mi;
            const F8 pv = f8_shfl_xor(v, 4);
            const size_t off = QKV_MIX(mi) + (ql < 4 ? ((size_t)(b * 4 + ql) * SEQ + s) * 64 : QKV_K + ((size_t)(b * 2 + (ql - 4)) * SEQ + s) * 64);
            *(uint4*)(qkv + off + 8 * c) = f8_rope_pack(v, pv, cs, sn, (c < 4) ? -1.f : 1.f, (ql < 4) ? scA : 1.f);
        } else if (qc == 6 || qc == 7 || qc == 14 || qc == 15 || qc == 22 || qc == 23) {
            *(uint4*)(qkv + QKV_MIX(qc >> 3) + QKV_V + ((size_t)(b * 2 + (qc & 1)) * SEQ + s) * 64 + 8 * c) = pack8(v.a, v.b);
        } else if (qc >= 8 && qc < 14) {
            const bool isq = qc < 12; const int h = isq ? qc - 8 : qc - 12;
            const float r = rsqrtf(sum8(f8_ssq(v)) * (1.f / 64.f) + 1e-6f);
            const F8 gq = f8_load(g_qn + 8 * c), gk = f8_load(g_kn + 8 * c);
            v.a.x *= r * (isq ? gq.a.x : gk.a.x); v.a.y *= r * (isq ? gq.a.y : gk.a.y); v.a.z *= r * (isq ? gq.a.z : gk.a.z); v.a.w *= r * (isq ? gq.a.w : gk.a.w);
            v.b.x *= r * (isq ? gq.b.x : gk.b.x); v.b.y *= r * (isq ? gq.b.y : gk.b.y); v.b.z *= r * (isq ? gq.b.z : gk.b.z); v.b.w *= r * (isq ? gq.b.w : gk.b.w);
            const F8 pv = f8_shfl_xor(v, 2);
            const size_t off = QKV_MIX(1) + (isq ? ((size_t)(b * 4 + h) * SEQ + s) * 64 : QKV_K + ((size_t)(b * 2 + h) * SEQ + s) * 64);
            *(uint4*)(qkv + off + 8 * c) = f8_rope_pack(v, pv, cs, sn, (c & 2) ? 1.f : -1.f, isq ? scA : 1.f);
        } else if (qc >= 24 && qc < 30) {
            const float ss = sum8(f8_ssq(v));
            const size_t off = qc < 28 ? (size_t)m * 256 + (qc - 24) * 64 : (size_t)T_TOK * 256 + (size_t)m * 128 + (qc - 28) * 64;
            *(uint4*)(lat + off + 8 * c) = pack8(v.a, v.b);
            if (c == 0) ssqd[(size_t)(qc - 24) * T_TOK + m] = ss;
        } else if (qc == 30) {
            const F8 pv = f8_shfl_xor(v, 2);
            if (c < 4) {
                const uint4 w = f8_rope_pack(v, pv, cs, sn, (c & 2) ? 1.f : -1.f, 1.f);
#pragma unroll
                for (int h = 0; h < 4; ++h) *(uint4*)(kD + ((size_t)(b * 4 + h) * SEQ + s) * 96 + 64 + 8 * c) = w;
            }
        }
    }
};
struct RowsPostQ {
    bf16_t* qD; const float* tb; const float* ssq;
    __device__ __forceinline__ void table(float*, int, int) const {}
    __device__ __forceinline__ void begin(bf16_t* ct, int m0, int, int tid) const {
        if (tid < 256) {
            const float tot = (ssq[m0 + tid] + ssq[(size_t)T_TOK + m0 + tid]) + (ssq[(size_t)2 * T_TOK + m0 + tid] + ssq[(size_t)3 * T_TOK + m0 + tid]);
            *(float*)(ct + tid * QST + 256) = rsqrtf(tot * (1.f / 256.f) + 1e-6f) * (0.10206207261596575f * LOG2E);
        }
        __syncthreads();
    }
    __device__ __forceinline__ void prep(int m, int n, int c, const float*& pa, const float*& pb) const {
        pa = tb; pb = tb;
        if (n >= 256 && n < 384) { pa = tb + 262144 + (m % SEQ) * 16 + 8 * (c & 1); pb = pa + 65536; }
    }
    __device__ __forceinline__ void chunk(const F8& tv, float r, int m, int n, int c, const F8& cs, const F8& sn) const {
        if (n >= 384) return;
        const int qc = n >> 6, b = m / SEQ, s = m % SEQ;
        F8 v = tv;
        v.a.x *= r; v.a.y *= r; v.a.z *= r; v.a.w *= r; v.b.x *= r; v.b.y *= r; v.b.z *= r; v.b.w *= r;
        if (qc < 4) {
            *(uint4*)(qD + ((size_t)(b * 4 + qc) * SEQ + s) * 128 + 8 * c) = pack8(v.a, v.b);
        } else {
            const F8 pv = f8_shfl_xor(v, 2);
            const int h = (qc - 4) * 2 + (c >> 2);
            *(uint4*)(qD + ((size_t)(b * 4 + h) * SEQ + s) * 128 + 64 + 8 * (c & 3)) = f8_rope_pack(v, pv, cs, sn, (c & 2) ? 1.f : -1.f, 1.f);
        }
    }
};
struct RowsPostKV {
    bf16_t* kD; bf16_t* vD; const float* ssq;
    __device__ __forceinline__ void table(float*, int, int) const {}
    __device__ __forceinline__ void begin(bf16_t* ct, int m0, int, int tid) const {
        if (tid < 256) *(float*)(ct + tid * QST + 256) = rsqrtf((ssq[m0 + tid] + ssq[(size_t)T_TOK + m0 + tid]) * (1.f / 128.f) + 1e-6f);
        __syncthreads();
    }
    __device__ __forceinline__ void prep(int, int, int, const float*& pa, const float*& pb) const { pa = ssq; pb = ssq; }
    __device__ __forceinline__ void chunk(const F8& tv, float r, int m, int n, int c, const F8&, const F8&) const {
        const int qc = n >> 6, h = qc >> 1, b = m / SEQ, s = m % SEQ;
        F8 v = tv;
        v.a.x *= r; v.a.y *= r; v.a.z *= r; v.a.w *= r; v.b.x *= r; v.b.y *= r; v.b.z *= r; v.b.w *= r;
        const size_t hb = (size_t)(b * 4 + h) * SEQ + s;
        const size_t off = (qc & 1) ? hb * 64 : hb * 96;
        bf16_t* base = (bf16_t*)((qc & 1) ? (size_t)vD : (size_t)kD);
        *(uint4*)(base + off + 8 * c) = pack8(v.a, v.b);
    }
};

template <class Epi>
__device__ __forceinline__ void gemm_phase(const bf16_t* X, int ldx, const bf16_t* W, int ldw, int M, int N, int K, char* lds, const Epi& epi) {
    const int ntm = M >> 7, ntn = (N + 127) >> 7, nt_tot = ntm * ntn;
    for (int tile = blockIdx.x; tile < nt_tot; tile += gridDim.x) {
        int mt, nt;
        if ((gridDim.x & 7) == 0 && (gridDim.x >> 3) * 8 == gridDim.x && ((gridDim.x >> 3) & 63) == 0) tile_map(tile, ntm, ntn, mt, nt);
        else { mt = tile / ntn; nt = tile % ntn; }
        if (mt < ntm && nt < ntn) gemm_tile(X, ldx, W, ldw, K, mt * 128, nt * 128, N, lds, epi);
    }
}

template <int OFF> __device__ __forceinline__ s16x4 tr_read(int vb) {
    s16x4 r; asm volatile("ds_read_b64_tr_b16 %0, %1 offset:%2" : "=&v"(r) : "v"(vb), "i"(OFF) : "memory"); return r;
}
#define VS_BYTES 192

template <int KT2>
__device__ __forceinline__ void pv_sub(f32x16 (&o)[2], const f32x16& p, int vbase) {
    bf16x8 pf[2];
#pragma unroll
    for (int s2 = 0; s2 < 2; ++s2) {
        unsigned a = cvtpk(p[8 * s2 + 0], p[8 * s2 + 1]), b = cvtpk(p[8 * s2 + 2], p[8 * s2 + 3]);
        unsigned c = cvtpk(p[8 * s2 + 4], p[8 * s2 + 5]), d = cvtpk(p[8 * s2 + 6], p[8 * s2 + 7]);
        uint4 w = make_uint4(a, b, c, d);
        pf[s2] = *(bf16x8*)&w;
    }
    {
        s16x4 l00 = tr_read<(KT2 * 32 + 0) * VS_BYTES + 0>(vbase), h00 = tr_read<(KT2 * 32 + 8) * VS_BYTES + 0>(vbase);
        s16x4 l01 = tr_read<(KT2 * 32 + 0) * VS_BYTES + 64>(vbase), h01 = tr_read<(KT2 * 32 + 8) * VS_BYTES + 64>(vbase);
        s16x4 l10 = tr_read<(KT2 * 32 + 16) * VS_BYTES + 0>(vbase), h10 = tr_read<(KT2 * 32 + 24) * VS_BYTES + 0>(vbase);
        s16x4 l11 = tr_read<(KT2 * 32 + 16) * VS_BYTES + 64>(vbase), h11 = tr_read<(KT2 * 32 + 24) * VS_BYTES + 64>(vbase);
        asm volatile("s_waitcnt lgkmcnt(0)" ::: "memory");
        __builtin_amdgcn_sched_barrier(0);
#define PKV(L, H) (bf16x8){L[0], L[1], L[2], L[3], H[0], H[1], H[2], H[3]}
        o[0] = __builtin_amdgcn_mfma_f32_32x32x16_bf16(PKV(l00, h00), pf[0], o[0], 0, 0, 0);
        o[1] = __builtin_amdgcn_mfma_f32_32x32x16_bf16(PKV(l01, h01), pf[0], o[1], 0, 0, 0);
        o[0] = __builtin_amdgcn_mfma_f32_32x32x16_bf16(PKV(l10, h10), pf[1], o[0], 0, 0, 0);
        o[1] = __builtin_amdgcn_mfma_f32_32x32x16_bf16(PKV(l11, h11), pf[1], o[1], 0, 0, 0);
#undef PKV
    }
}


#define PV_LOAD(KT2, VB, F) \
    const s16x4 F##0 = tr_read<((KT2) * 32 + 0) * VS_BYTES + 0>(VB), F##1 = tr_read<((KT2) * 32 + 8) * VS_BYTES + 0>(VB), \
                F##2 = tr_read<((KT2) * 32 + 0) * VS_BYTES + 64>(VB), F##3 = tr_read<((KT2) * 32 + 8) * VS_BYTES + 64>(VB), \
                F##4 = tr_read<((KT2) * 32 + 16) * VS_BYTES + 0>(VB), F##5 = tr_read<((KT2) * 32 + 24) * VS_BYTES + 0>(VB), \
                F##6 = tr_read<((KT2) * 32 + 16) * VS_BYTES + 64>(VB), F##7 = tr_read<((KT2) * 32 + 24) * VS_BYTES + 64>(VB)
#define PKV2(L, H) (bf16x8){L[0], L[1], L[2], L[3], H[0], H[1], H[2], H[3]}
#define PV_MMA(O, P, F) do { bf16x8 _pf0, _pf1; \
        { uint4 _w = make_uint4(cvtpk(P[0], P[1]), cvtpk(P[2], P[3]), cvtpk(P[4], P[5]), cvtpk(P[6], P[7])); _pf0 = *(bf16x8*)&_w; } \
        { uint4 _w = make_uint4(cvtpk(P[8], P[9]), cvtpk(P[10], P[11]), cvtpk(P[12], P[13]), cvtpk(P[14], P[15])); _pf1 = *(bf16x8*)&_w; } \
        O[0] = __builtin_amdgcn_mfma_f32_32x32x16_bf16(PKV2(F##0, F##1), _pf0, O[0], 0, 0, 0); \
        O[1] = __builtin_amdgcn_mfma_f32_32x32x16_bf16(PKV2(F##2, F##3), _pf0, O[1], 0, 0, 0); \
        O[0] = __builtin_amdgcn_mfma_f32_32x32x16_bf16(PKV2(F##4, F##5), _pf1, O[0], 0, 0, 0); \
        O[1] = __builtin_amdgcn_mfma_f32_32x32x16_bf16(PKV2(F##6, F##7), _pf1, O[1], 0, 0, 0); } while (0)

template <int DK, int G, bool WINDOW>
__device__ __forceinline__ void attn_item(const bf16_t* __restrict__ Q, const bf16_t* __restrict__ K, const bf16_t* __restrict__ V, const float* __restrict__ sink,
                                          bf16_t* __restrict__ O, int ocol, int H, int KV, int item, char* lds, int qs = DK) {
    constexpr int KS = DK * 2 + 16;
    constexpr int KCH = DK / 8;
    constexpr int KLD = (128 * KCH) / 512;
    constexpr int QB = 256 / G;
    constexpr int NCH = SEQ / QB;
    constexpr int KBUF = 128 * KS, VBUF = 128 * VS_BYTES;
    const int tid = tid_opaque(), lane = tid & 63, wave = tid >> 6;
    const int r32 = lane & 31, hh = lane >> 5;
    const int chunk = item % NCH, kvh = (item / NCH) % KV, b = item / (NCH * KV);
    const int g = (G == 2) ? (wave >> 2) : 0;
    const int qoff = (G == 2) ? (wave & 3) * 32 : wave * 32;
    const int head = kvh * G + g;
    const int q0 = chunk * QB;
    const int qpos = q0 + qoff + r32;
    bf16x8 qf[DK / 16];
    {
        const bf16_t* qp = Q + ((size_t)(b * H + head) * SEQ + qpos) * qs + hh * 8;
#pragma unroll
        for (int ks = 0; ks < DK / 16; ++ks) qf[ks] = *(const bf16x8*)(qp + ks * 16);
    }
    int kt_lo = 0, kt_hi = SEQ / 128;
    if (WINDOW) { kt_lo = q0 / 128 - 1; if (kt_lo < 0) kt_lo = 0; kt_hi = (q0 + QB) / 128 + 1; if (kt_hi > SEQ / 128) kt_hi = SEQ / 128; }
    const char* Kg = (const char*)(K + (size_t)(b * KV + kvh) * SEQ * DK);
    const char* Vg = (const char*)(V + (size_t)(b * KV + kvh) * SEQ * 64);
    uint4 kr0, kr1, kr2 = make_uint4(0, 0, 0, 0), vr0, vr1;
    const int koff0 = (tid / KCH) * KS + (tid % KCH) * 16;
    const int koff1 = ((tid + 512) / KCH) * KS + ((tid + 512) % KCH) * 16;
    const int koff2 = ((tid + 1024) / KCH) * KS + ((tid + 1024) % KCH) * 16;
    const int voff0 = (tid >> 3) * VS_BYTES + (tid & 7) * 16;
    const int voff1 = ((tid + 512) >> 3) * VS_BYTES + (tid & 7) * 16;
    f32x16 o[2];
#pragma unroll
    for (int d = 0; d < 2; ++d)
#pragma unroll
        for (int i = 0; i < 16; ++i) o[d][i] = 0.f;
    float m = -1e30f, l = 0.f;
    if (WINDOW) { m = sink[head] * LOG2E; l = (hh == 0) ? 1.f : 0.f; }
    const int gg = lane >> 4, li = lane & 15;
    const int vlane = (4 * (gg >> 1) + (li >> 2)) * VS_BYTES + (16 * (gg & 1) + 4 * (li & 3)) * 2;
    char* Kl = lds; char* Vl = lds + 2 * KBUF;
#define AGLOAD(KT) do { const char* _kg = Kg + (size_t)(KT) * 128 * DK * 2; const char* _vg = Vg + (size_t)(KT) * 128 * 128; \
        kr0 = *(const uint4*)(_kg + tid * 16); kr1 = *(const uint4*)(_kg + (tid + 512) * 16); if (KLD > 2) kr2 = *(const uint4*)(_kg + (tid + 1024) * 16); \
        vr0 = *(const uint4*)(_vg + tid * 16); vr1 = *(const uint4*)(_vg + (tid + 512) * 16); } while (0)
#define ASTORE(KB, VB) do { char* _kd = (KB); char* _vd = (VB); *(uint4*)(_kd + koff0) = kr0; *(uint4*)(_kd + koff1) = kr1; if (KLD > 2) *(uint4*)(_kd + koff2) = kr2; \
        *(uint4*)(_vd + voff0) = vr0; *(uint4*)(_vd + voff1) = vr1; } while (0)
    AGLOAD(kt_lo);
    ASTORE(Kl, Vl);
    { const int k1 = kt_lo + 1 < kt_hi ? kt_lo + 1 : kt_lo; AGLOAD(k1); }
    __syncthreads();
    for (int kt = kt_lo; kt < kt_hi; ++kt) {
        const int cur = (kt - kt_lo) & 1;
        ASTORE(Kl + (cur ^ 1) * KBUF, Vl + (cur ^ 1) * VBUF);
        { const int ktn = kt + 2 < kt_hi ? kt + 2 : kt_hi - 1; AGLOAD(ktn); }
        __builtin_amdgcn_sched_barrier(0);
#pragma unroll
        for (int sub = 0; sub < 2; ++sub) {
            const char* kb = Kl + cur * KBUF + sub * 64 * KS;
            const float mi = (m < -1e29f) ? 0.f : m;
            f32x16 s0, s1;
#pragma unroll
            for (int i = 0; i < 16; ++i) { s0[i] = -mi; s1[i] = -mi; }
#pragma unroll
            for (int ks = 0; ks < DK / 16; ++ks) {
                bf16x8 k0 = *(const bf16x8*)(kb + r32 * KS + (ks * 2 + hh) * 16);
                bf16x8 k1 = *(const bf16x8*)(kb + (32 + r32) * KS + (ks * 2 + hh) * 16);
                s0 = __builtin_amdgcn_mfma_f32_32x32x16_bf16(k0, qf[ks], s0, 0, 0, 0);
                s1 = __builtin_amdgcn_mfma_f32_32x32x16_bf16(k1, qf[ks], s1, 0, 0, 0);
            }
            if (WINDOW) {
                const int kb0 = kt * 128 + sub * 64 + 4 * hh - qpos;
#pragma unroll
                for (int i = 0; i < 16; ++i) {
                    const int d0 = kb0 + (i & 3) + 8 * (i >> 2), d1 = d0 + 32;
                    s0[i] = (d0 > 128 || d0 < -128) ? -1e30f : s0[i];
                    s1[i] = (d1 > 128 || d1 < -128) ? -1e30f : s1[i];
                }
            }
            const int vbase = (int)(size_t)(Vl + cur * VBUF - lds) + sub * 64 * VS_BYTES + vlane;
            PV_LOAD(0, vbase, vfa);
            PV_LOAD(1, vbase, vfb);
            __builtin_amdgcn_sched_barrier(0);
            float tmax = s0[0];
#pragma unroll
            for (int i = 1; i < 16; ++i) tmax = fmaxf(tmax, s0[i]);
#pragma unroll
            for (int i = 0; i < 16; ++i) tmax = fmaxf(tmax, s1[i]);
            tmax = xhalf_max(tmax);
            float ps = 0.f;
            if (__all(m > -1e29f && tmax <= 8.f)) {
#pragma unroll
                for (int i = 0; i < 16; ++i) { s0[i] = __builtin_amdgcn_exp2f(s0[i]); ps += s0[i]; }
#pragma unroll
                for (int i = 0; i < 16; ++i) { s1[i] = __builtin_amdgcn_exp2f(s1[i]); ps += s1[i]; }
                l += ps;
            } else {
                const float mn = fmaxf(m, mi + tmax);
                const float d = mn - mi;
                const float alpha = __builtin_amdgcn_exp2f(m - mn);
                m = mn;
#pragma unroll
                for (int i = 0; i < 16; ++i) { s0[i] = __builtin_amdgcn_exp2f(s0[i] - d); ps += s0[i]; }
#pragma unroll
                for (int i = 0; i < 16; ++i) { s1[i] = __builtin_amdgcn_exp2f(s1[i] - d); ps += s1[i]; }
                l = l * alpha + ps;
#pragma unroll
                for (int dd = 0; dd < 2; ++dd)
#pragma unroll
                    for (int i = 0; i < 16; ++i) o[dd][i] *= alpha;
            }
            asm volatile("s_waitcnt lgkmcnt(0)" ::: "memory");
            __builtin_amdgcn_sched_barrier(0);
            PV_MMA(o, s0, vfa);
            PV_MMA(o, s1, vfb);
        }
        __syncthreads();
    }
#undef AGLOAD
#undef ASTORE
    l = xhalf_sum(l);
    const float inv = 1.f / l;
    bf16_t* orow = O + (size_t)(b * SEQ + qpos) * DM + ocol + head * 64;
#pragma unroll
    for (int d = 0; d < 2; ++d)
#pragma unroll
        for (int gq = 0; gq < 4; ++gq) {
            uint2 w;
            w.x = cvtpk(o[d][gq * 4 + 0] * inv, o[d][gq * 4 + 1] * inv);
            w.y = cvtpk(o[d][gq * 4 + 2] * inv, o[d][gq * 4 + 3] * inv);
            *(uint2*)(orow + d * 32 + 8 * gq + 4 * hh) = w;
        }
}

__device__ __forceinline__ void dil_wave_item(const bf16_t* __restrict__ Q, const bf16_t* __restrict__ K, const bf16_t* __restrict__ V,
                                              bf16_t* __restrict__ O, int witem, char* wlds, int lds_off) {
    const int lane = tid_opaque() & 63, r32 = lane & 31, hh = lane >> 5;
    const int c = witem & 15, chunk = (witem >> 4) & 15, kvh = (witem >> 8) & 1, b = witem >> 9;
    const int t0 = chunk * 256;
    const int mq = r32 & 15, g = r32 >> 4;
    const int qpos = t0 + 16 * mq + c, head = kvh * 2 + g;
    bf16x8 qf[4];
    {
        const bf16_t* qp = Q + ((size_t)(b * 4 + head) * SEQ + qpos) * 64 + hh * 8;
#pragma unroll
        for (int ks = 0; ks < 4; ++ks) qf[ks] = *(const bf16x8*)(qp + ks * 16);
    }
    const bf16_t* Kg = K + (size_t)(b * 2 + kvh) * SEQ * 64;
    const bf16_t* Vg = V + (size_t)(b * 2 + kvh) * SEQ * 64;
    f32x16 o[2];
#pragma unroll
    for (int d = 0; d < 2; ++d)
#pragma unroll
        for (int i = 0; i < 16; ++i) o[d][i] = 0.f;
    float m = -1e30f, l = 0.f;
    const int gg = lane >> 4, li = lane & 15;
    const int vlane = lds_off + (4 * (gg >> 1) + (li >> 2)) * VS_BYTES + (16 * (gg & 1) + 4 * (li & 3)) * 2;
#define DIL_PARAMS(IT, SH, CC, IDX0, LIM) const int SH = (IT) < 12 ? 0 : ((IT) < 18 ? 2 : 4); const int CC = c & ((1 << SH) - 1); \
        const int IDX0 = (t0 >> SH) - 64 + 32 * ((IT) < 12 ? (IT) : ((IT) < 18 ? (IT) - 12 : (IT) - 18)); const int LIM = SEQ >> SH
#define DIL_LOAD(KF, VR, SH, CC, IDX0, LIM) do { \
        { int _i = IDX0 + r32; _i = _i < 0 ? 0 : (_i >= LIM ? LIM - 1 : _i); const bf16_t* _kp = Kg + (size_t)((_i << SH) + CC) * 64 + hh * 8; \
          KF##0 = *(const bf16x8*)(_kp); KF##1 = *(const bf16x8*)(_kp + 16); KF##2 = *(const bf16x8*)(_kp + 32); KF##3 = *(const bf16x8*)(_kp + 48); } \
        { int _i = IDX0 + (lane >> 3); _i = _i < 0 ? 0 : (_i >= LIM ? LIM - 1 : _i); VR##0 = *(const uint4*)(Vg + (size_t)((_i << SH) + CC) * 64 + (lane & 7) * 8); } \
        { int _i = IDX0 + 8 + (lane >> 3); _i = _i < 0 ? 0 : (_i >= LIM ? LIM - 1 : _i); VR##1 = *(const uint4*)(Vg + (size_t)((_i << SH) + CC) * 64 + (lane & 7) * 8); } \
        { int _i = IDX0 + 16 + (lane >> 3); _i = _i < 0 ? 0 : (_i >= LIM ? LIM - 1 : _i); VR##2 = *(const uint4*)(Vg + (size_t)((_i << SH) + CC) * 64 + (lane & 7) * 8); } \
        { int _i = IDX0 + 24 + (lane >> 3); _i = _i < 0 ? 0 : (_i >= LIM ? LIM - 1 : _i); VR##3 = *(const uint4*)(Vg + (size_t)((_i << SH) + CC) * 64 + (lane & 7) * 8); } } while (0)
    bf16x8 ka0, ka1, ka2, ka3, kb0, kb1, kb2, kb3;
    uint4 va0, va1, va2, va3, vb0, vb1, vb2, vb3;
    { DIL_PARAMS(0, sh0, cc0, ix0, lm0); DIL_LOAD(ka, va, sh0, cc0, ix0, lm0); }
#pragma unroll 1
    for (int it = 0; it < 23; ++it) {
        DIL_PARAMS(it, sh, cc, idx0, lim);
        {
            const int itn = it + 1 < 23 ? it + 1 : 22;
            DIL_PARAMS(itn, shn, ccn, ixn, lmn);
            DIL_LOAD(kb, vb, shn, ccn, ixn, lmn);
        }
        __builtin_amdgcn_sched_barrier(0);
        *(uint4*)(wlds + ((lane >> 3)) * VS_BYTES + (lane & 7) * 16) = va0;
        *(uint4*)(wlds + ((lane >> 3) + 8) * VS_BYTES + (lane & 7) * 16) = va1;
        *(uint4*)(wlds + ((lane >> 3) + 16) * VS_BYTES + (lane & 7) * 16) = va2;
        *(uint4*)(wlds + ((lane >> 3) + 24) * VS_BYTES + (lane & 7) * 16) = va3;
        f32x16 s;
#pragma unroll
        for (int i = 0; i < 16; ++i) s[i] = 0.f;
        s = __builtin_amdgcn_mfma_f32_32x32x16_bf16(ka0, qf[0], s, 0, 0, 0);
        s = __builtin_amdgcn_mfma_f32_32x32x16_bf16(ka1, qf[1], s, 0, 0, 0);
        s = __builtin_amdgcn_mfma_f32_32x32x16_bf16(ka2, qf[2], s, 0, 0, 0);
        s = __builtin_amdgcn_mfma_f32_32x32x16_bf16(ka3, qf[3], s, 0, 0, 0);

        const int qidx = qpos >> sh;
        const int base = idx0 + 4 * hh;
#pragma unroll
        for (int i = 0; i < 16; ++i) {
            const int idx = base + (i & 3) + 8 * (i >> 2);
            const int d = idx - qidx;
            s[i] = (d > 64 || d < -64 || idx < 0 || idx >= lim) ? -1e30f : s[i];
        }
        float tmax = s[0];
#pragma unroll
        for (int i = 1; i < 16; ++i) tmax = fmaxf(tmax, s[i]);
        tmax = fmaxf(tmax, xhalf(tmax));
        const float mn = fmaxf(fmaxf(m, tmax), -1e20f);
        const float alpha = __builtin_amdgcn_exp2f(m - mn);
        m = mn;
        float ps = 0.f;
#pragma unroll
        for (int i = 0; i < 16; ++i) { s[i] = __builtin_amdgcn_exp2f(s[i] - mn); ps += s[i]; }
        l = l * alpha + ps;
#pragma unroll
        for (int d = 0; d < 2; ++d)
#pragma unroll
            for (int i = 0; i < 16; ++i) o[d][i] *= alpha;
        pv_sub<0>(o, s, vlane);
        ka0 = kb0; ka1 = kb1; ka2 = kb2; ka3 = kb3; va0 = vb0; va1 = vb1; va2 = vb2; va3 = vb3;
    }
#undef DIL_PARAMS
#undef DIL_LOAD
    l += xhalf(l);
    const float inv = 1.f / l;
    bf16_t* orow = O + (size_t)(b * SEQ + qpos) * DM + 512 + head * 64;
#pragma unroll
    for (int d = 0; d < 2; ++d)
#pragma unroll
        for (int gq = 0; gq < 4; ++gq) {
            uint2 w;
            w.x = cvtpk(o[d][gq * 4 + 0] * inv, o[d][gq * 4 + 1] * inv);
            w.y = cvtpk(o[d][gq * 4 + 2] * inv, o[d][gq * 4 + 3] * inv);
            *(uint2*)(orow + d * 32 + 8 * gq + 4 * hh) = w;
        }
}

__device__ __forceinline__ int f2key(float f) { int b = __float_as_int(f); return b ^ ((b >> 31) & 0x7fffffff); }
__device__ __forceinline__ float key2f(int k) { return __int_as_float(k ^ ((k >> 31) & 0x7fffffff)); }

template <int N>
__device__ __forceinline__ void bitonic_sort_desc(int (&a)[N]) {
#pragma unroll
    for (int k = 2; k <= N; k <<= 1) {
#pragma unroll
        for (int j = k >> 1; j > 0; j >>= 1) {
#pragma unroll
            for (int i = 0; i < N; ++i) {
                const int l2 = i ^ j;
                if (l2 > i) {
                    const bool up = ((i & k) == 0);
                    const int hi = max(a[i], a[l2]), lo = min(a[i], a[l2]);
                    a[i] = up ? hi : lo; a[l2] = up ? lo : hi;
                }
            }
        }
    }
}
__device__ __forceinline__ void merge_top16(int (&a)[16], const int (&b)[16]) {
#pragma unroll
    for (int i = 0; i < 16; ++i) a[i] = max(a[i], b[15 - i]);
#pragma unroll
    for (int j = 8; j > 0; j >>= 1) {
#pragma unroll
        for (int i = 0; i < 16; ++i) {
            const int l2 = i ^ j;
            if (l2 > i) { const int hi = max(a[i], a[l2]), lo = min(a[i], a[l2]); a[i] = hi; a[l2] = lo; }
        }
    }
}
__device__ __forceinline__ void top16_of_64(int (&g0)[16], int (&g1)[16], int (&g2)[16], int (&g3)[16]) {
    bitonic_sort_desc<16>(g0); bitonic_sort_desc<16>(g1); bitonic_sort_desc<16>(g2); bitonic_sort_desc<16>(g3);
    merge_top16(g0, g1); merge_top16(g2, g3); merge_top16(g0, g2);
}

__device__ __forceinline__ void topk_core(const bf16_t* q0, const bf16_t* __restrict__ subk_h, float rscale, int* eo, float* go, char* wlds) {
    const int lane = tid_opaque() & 63, r32 = lane & 31, hh = lane >> 5;
    int top[2][16];
#pragma unroll
    for (int c = 0; c < 2; ++c) {
        bf16x8 qf[8];
        const bf16_t* qrow = q0 + c * 128;
#pragma unroll
        for (int ks = 0; ks < 8; ++ks) qf[ks] = *(const bf16x8*)(qrow + ks * 16);
        const bf16_t* kb = subk_h + ((size_t)c * 128 + r32) * 128 + hh * 8;
        int grp[4][16];
        bf16x8 kfa[8], kfb[8];
#pragma unroll
        for (int ks = 0; ks < 8; ++ks) kfa[ks] = *(const bf16x8*)(kb + ks * 16);
#pragma unroll
        for (int kt = 0; kt < 4; ++kt) {
            if (kt < 3) {
#pragma unroll
                for (int ks = 0; ks < 8; ++ks) kfb[ks] = *(const bf16x8*)(kb + (size_t)(kt + 1) * 32 * 128 + ks * 16);
            }
            __builtin_amdgcn_sched_barrier(0);
            f32x16 s;
#pragma unroll
            for (int i = 0; i < 16; ++i) s[i] = 0.f;
#pragma unroll
            for (int ks = 0; ks < 8; ++ks) s = __builtin_amdgcn_mfma_f32_32x32x16_bf16(kfa[ks], qf[ks], s, 0, 0, 0);
#pragma unroll
            for (int i = 0; i < 16; ++i) grp[kt][i] = (f2key(s[i]) & ~127) | (kt * 32 + crow(i, hh));
#pragma unroll
            for (int ks = 0; ks < 8; ++ks) kfa[ks] = kfb[ks];
        }
        top16_of_64(grp[0], grp[1], grp[2], grp[3]);
        int oth[16];
#pragma unroll
        for (int i = 0; i < 16; ++i) oth[i] = __shfl_xor(grp[0][i], 32);
        merge_top16(grp[0], oth);
#pragma unroll
        for (int i = 0; i < 16; ++i) top[c][i] = grp[0][i];
    }
    {
        unsigned* my = (unsigned*)(wlds + lane * 36);
#pragma unroll
        for (int c = 0; c < 2; ++c)
#pragma unroll
            for (int w4 = 0; w4 < 4; ++w4) {
                unsigned v = (top[c][w4 * 4] & 127) | ((top[c][w4 * 4 + 1] & 127) << 8) | ((top[c][w4 * 4 + 2] & 127) << 16) | ((top[c][w4 * 4 + 3] & 127) << 24);
                my[c * 4 + w4] = v;
            }
    }
    float v1[16], v2[16];
#pragma unroll
    for (int i = 0; i < 16; ++i) { v1[i] = key2f(top[0][i] & ~127); v2[i] = key2f(top[1][i] & ~127); }
    int cg[4][16];
    {
        int n = 0;
#pragma unroll
        for (int i = 0; i < 16; ++i)
#pragma unroll
            for (int j = 0; j < 16; ++j)
                if ((i + 1) * (j + 1) <= 16) { cg[n >> 4][n & 15] = (f2key(v1[i] + v2[j]) & ~255) | (i * 16 + j); ++n; }
#pragma unroll
        for (int q = 50; q < 64; ++q) cg[q >> 4][q & 15] = (int)0x80000000;
    }
    top16_of_64(cg[0], cg[1], cg[2], cg[3]);
    float bv[16];
#pragma unroll
    for (int i = 0; i < 16; ++i) bv[i] = key2f(cg[0][i] & ~255) * rscale;
    float sm = 0.f;
    const float bmx = bv[0];
#pragma unroll
    for (int i = 0; i < 16; ++i) { bv[i] = __expf(bv[i] - bmx); sm += bv[i]; }
    const float inv = 1.f / sm;
    if (hh == 0) {
        const unsigned char* my = (const unsigned char*)(wlds + lane * 36);
#pragma unroll
        for (int q4 = 0; q4 < 4; ++q4) {
            int4 ev; float4 gv;
            int* evp = (int*)&ev; float* gvp = (float*)&gv;
#pragma unroll
            for (int u = 0; u < 4; ++u) {
                const int code = cg[0][q4 * 4 + u] & 255;
                const int i1 = my[code >> 4], i2 = my[16 + (code & 15)];
                evp[u] = i1 * 128 + i2; gvp[u] = bv[q4 * 4 + u] * inv;
            }
            *(int4*)(eo + q4 * 4) = ev; *(float4*)(go + q4 * 4) = gv;
        }
    }
}

__device__ __forceinline__ void topk_wave_item(const bf16_t* __restrict__ qp, const bf16_t* __restrict__ subk, int* __restrict__ eidx, float* __restrict__ gate, int witem, char* wlds) {
    const int lane = tid_opaque() & 63, r32 = lane & 31, hh = lane >> 5;
    const int h = witem & 7, t = (witem >> 3) * 32 + r32;
    topk_core(qp + (size_t)t * 2048 + h * 256 + hh * 8, subk + (size_t)h * 2 * 128 * 128, 1.f, eidx + ((size_t)h * T_TOK + t) * 16, gate + ((size_t)h * T_TOK + t) * 16, wlds);
}
__device__ __forceinline__ void gemm_tile_topk(const bf16_t* __restrict__ X, int ldx, const bf16_t* __restrict__ W, int ldw, int K, int m0, int h, char* lds,
                                               const bf16_t* __restrict__ subk, const float* __restrict__ ssq, int* __restrict__ eidx, float* __restrict__ gate) {
    const int tid = tid_opaque(), lane = tid & 63, wave = tid >> 6;
    const int wm = wave >> 1, wn = wave & 1;
    const int r32 = lane & 31, hh = lane >> 5;
    {
        f32x16 acc[2][4];
        gemm_mainloop(X, ldx, W, ldw, K, m0, h * 256, 2048, lds, acc);
        bf16_t* qst = (bf16_t*)lds;
#pragma unroll
        for (int mt = 0; mt < 2; ++mt)
#pragma unroll
            for (int nt = 0; nt < 4; ++nt)
#pragma unroll
                for (int i = 0; i < 16; ++i)
                    qst[(wm * 64 + mt * 32 + crow(i, hh)) * QST + wn * 128 + nt * 32 + r32] = f2bf(acc[mt][nt][i]);
    }
    __syncthreads();
    {
        const int tok = wave * 32 + r32, t = m0 + tok;
        float tot = 0.f;
#pragma unroll
        for (int j = 0; j < 4; ++j) { const float4 q = *(const float4*)(ssq + ((size_t)j * T_TOK + t) * 4); tot += (q.x + q.y) + (q.z + q.w); }
        const float r = rsqrtf(tot * (1.f / DM) + 1e-6f);
        topk_core((const bf16_t*)lds + tok * QST + hh * 8, subk + (size_t)h * 2 * 128 * 128, r, eidx + ((size_t)h * T_TOK + t) * 16, gate + ((size_t)h * T_TOK + t) * 16,
                  lds + TOPK_STASH + wave * 2304);
    }
    __syncthreads();
}

typedef __attribute__((ext_vector_type(2))) float f32x2;
__device__ __forceinline__ float fdot2bf(unsigned a, unsigned b, float acc) {
    return __builtin_amdgcn_fdot2_f32_bf16(*(bf16x2_t*)&a, *(bf16x2_t*)&b, acc, false);
}
__device__ __forceinline__ unsigned fp8pair_to_bf16(unsigned w, bool hi) {
    bf16x2_t r = hi ? __builtin_amdgcn_cvt_scalef32_pk_bf16_fp8((int)w, 1.0f, true) : __builtin_amdgcn_cvt_scalef32_pk_bf16_fp8((int)w, 1.0f, false);
    return *(unsigned*)&r;
}
__device__ __forceinline__ float dot16_fp8(uint4 u, const unsigned (&h)[8]) {
    float a = 0.f;
    a = fdot2bf(fp8pair_to_bf16(u.x, false), h[0], a); a = fdot2bf(fp8pair_to_bf16(u.x, true), h[1], a);
    a = fdot2bf(fp8pair_to_bf16(u.y, false), h[2], a); a = fdot2bf(fp8pair_to_bf16(u.y, true), h[3], a);
    a = fdot2bf(fp8pair_to_bf16(u.z, false), h[4], a); a = fdot2bf(fp8pair_to_bf16(u.z, true), h[5], a);
    a = fdot2bf(fp8pair_to_bf16(u.w, false), h[6], a); a = fdot2bf(fp8pair_to_bf16(u.w, true), h[7], a);
    return a;
}
__device__ __forceinline__ void axpy16_fp8(float (&acc)[16], float w, uint4 v) {
    f32x2 r;
    r = __builtin_amdgcn_cvt_pk_f32_fp8((int)v.x, false); acc[0] += w * r[0]; acc[1] += w * r[1];
    r = __builtin_amdgcn_cvt_pk_f32_fp8((int)v.x, true);  acc[2] += w * r[0]; acc[3] += w * r[1];
    r = __builtin_amdgcn_cvt_pk_f32_fp8((int)v.y, false); acc[4] += w * r[0]; acc[5] += w * r[1];
    r = __builtin_amdgcn_cvt_pk_f32_fp8((int)v.y, true);  acc[6] += w * r[0]; acc[7] += w * r[1];
    r = __builtin_amdgcn_cvt_pk_f32_fp8((int)v.z, false); acc[8] += w * r[0]; acc[9] += w * r[1];
    r = __builtin_amdgcn_cvt_pk_f32_fp8((int)v.z, true);  acc[10] += w * r[0]; acc[11] += w * r[1];
    r = __builtin_amdgcn_cvt_pk_f32_fp8((int)v.w, false); acc[12] += w * r[0]; acc[13] += w * r[1];
    r = __builtin_amdgcn_cvt_pk_f32_fp8((int)v.w, true);  acc[14] += w * r[0]; acc[15] += w * r[1];
}
__device__ __forceinline__ float gelu_exact(float a) { return 0.5f * a * (1.f + erff(a * 0.70710678118654752f)); }

__device__ __forceinline__ float transpose_reduce16(f32x16 p, int lane) {
#pragma unroll
    for (int st = 0; st < 4; ++st) {
        const int o = 32 >> st, n = 16 >> st;
        const bool up = (lane & o) != 0;
#pragma unroll
        for (int i = 0; i < n / 2; ++i) {
            float lo = p[i], hi = p[i + n / 2];
            asm volatile("" : "+v"(lo), "+v"(hi));
            const float keep = up ? hi : lo;
            const float send = up ? lo : hi;
            p[i] = keep + __shfl_xor(send, o);
        }
    }
    float v = p[0];
    v += __shfl_xor(v, 1); v += __shfl_xor(v, 2);
    return v;
}
#define EX_SB() __builtin_amdgcn_sched_barrier(0)
#define EX_LD1(R, TAB, EB, S) R = *(const uint4*)((TAB) + (unsigned)((__builtin_amdgcn_readlane((EB), (S)) << 10) + lane16))
#define EX_LOAD8(P, TAB, EB, SL) do { EX_LD1(P##0, TAB, EB, (SL) + 0); EX_LD1(P##1, TAB, EB, (SL) + 1); EX_LD1(P##2, TAB, EB, (SL) + 2); EX_LD1(P##3, TAB, EB, (SL) + 3); \
        EX_LD1(P##4, TAB, EB, (SL) + 4); EX_LD1(P##5, TAB, EB, (SL) + 5); EX_LD1(P##6, TAB, EB, (SL) + 6); EX_LD1(P##7, TAB, EB, (SL) + 7); } while (0)
#define EX_DOT8(P, PP, O) do { PP[(O) + 0] = dot16_fp8(P##0, hp); PP[(O) + 1] = dot16_fp8(P##1, hp); PP[(O) + 2] = dot16_fp8(P##2, hp); PP[(O) + 3] = dot16_fp8(P##3, hp); \
        PP[(O) + 4] = dot16_fp8(P##4, hp); PP[(O) + 5] = dot16_fp8(P##5, hp); PP[(O) + 6] = dot16_fp8(P##6, hp); PP[(O) + 7] = dot16_fp8(P##7, hp); } while (0)
#define EX_RL(W, S) __int_as_float(__builtin_amdgcn_readlane(__float_as_int(W), (S)))
#define EX_AXPY8(P, W, SL) do { axpy16_fp8(acc, EX_RL(W, (SL) + 0), P##0); axpy16_fp8(acc, EX_RL(W, (SL) + 1), P##1); axpy16_fp8(acc, EX_RL(W, (SL) + 2), P##2); axpy16_fp8(acc, EX_RL(W, (SL) + 3), P##3); \
        axpy16_fp8(acc, EX_RL(W, (SL) + 4), P##4); axpy16_fp8(acc, EX_RL(W, (SL) + 5), P##5); axpy16_fp8(acc, EX_RL(W, (SL) + 6), P##6); axpy16_fp8(acc, EX_RL(W, (SL) + 7), P##7); } while (0)
#define EX_COPY8(D, S_) do { D##0 = S_##0; D##1 = S_##1; D##2 = S_##2; D##3 = S_##3; D##4 = S_##4; D##5 = S_##5; D##6 = S_##6; D##7 = S_##7; } while (0)

#ifndef EXS_NS
#define EXS_NS 16
#endif
#ifndef EXS_SYNC
#define EXS_SYNC 1
#endif
__device__ __forceinline__ int ex_mbcnt(unsigned long long m) { return __builtin_amdgcn_mbcnt_hi((unsigned)(m >> 32), __builtin_amdgcn_mbcnt_lo((unsigned)m, 0u)); }
__device__ __forceinline__ void xcd_local_sync_p(char* st);
__device__ __forceinline__ void expert_token(PC& p, int layer, int t, bool last, int2* lst, char* syncp, bool dummy = false) {
    const int lane = tid_opaque() & 63;
    const int lane16 = lane * 16;
    const float* gfb = p.g_ffn + layer * DM; asm volatile("" : "+s"(gfb));
    const float* gf = gfb + lane * 16;
    float* xrow = p.x + (size_t)t * DM + lane * 16;
    float* xwr = dummy ? (float*)p.zb + (size_t)t * DM + lane * 16 : xrow;
    bf16_t* hwr = (dummy ? p.q.qA + (size_t)t * DM : p.hnb + (size_t)t * DM) + lane * 16;
    float xv[16];
#pragma unroll
    for (int q = 0; q < 4; ++q) { const float4 a = *(const float4*)(xrow + 4 * q); xv[4 * q] = a.x; xv[4 * q + 1] = a.y; xv[4 * q + 2] = a.z; xv[4 * q + 3] = a.w; }
    float ss = 0.f;
#pragma unroll
    for (int i = 0; i < 16; ++i) ss += xv[i] * xv[i];
    ss = wave_sum(ss);
    const float rstd = rsqrtf(ss * (1.f / DM) + 1e-6f);
    unsigned hp[8];
#pragma unroll
    for (int q = 0; q < 4; ++q) {
        const float4 g = *(const float4*)(gf + 4 * q);
        hp[2 * q] = cvtpk(xv[4 * q] * rstd * g.x, xv[4 * q + 1] * rstd * g.y);
        hp[2 * q + 1] = cvtpk(xv[4 * q + 2] * rstd * g.z, xv[4 * q + 3] * rstd * g.w);
    }
    const size_t ei0 = ((size_t)(lane >> 4) * T_TOK + t) * 16 + (lane & 15), ei1 = ei0 + (size_t)4 * T_TOK * 16;
    int e0 = p.eidx[ei0], e1 = p.eidx[ei1];
    float g0 = p.gate[ei0], g1 = p.gate[ei1];
    {
        const int s0 = ((e0 >> 7) + e0) & (EXS_NS - 1), s1 = ((e1 >> 7) + e1) & (EXS_NS - 1);
        int base = 0, pos0 = 0, pos1 = 0;
#pragma unroll
        for (int s = 0; s < EXS_NS; ++s) {
            const unsigned long long m0 = __ballot(s0 == s), m1 = __ballot(s1 == s);
            const int c0 = __popcll(m0);
            pos0 = (s0 == s) ? base + ex_mbcnt(m0) : pos0;
            pos1 = (s1 == s) ? base + c0 + ex_mbcnt(m1) : pos1;
            base += c0 + __popcll(m1);
        }
        lst[pos0] = make_int2(e0, __float_as_int(g0)); lst[pos1] = make_int2(e1, __float_as_int(g1));
        const int2 q0 = lst[lane], q1 = lst[64 + lane];
        e0 = q0.x; g0 = __int_as_float(q0.y); e1 = q1.x; g1 = __int_as_float(q1.y);
    }
    const unsigned char* u8 = p.u8 + (size_t)layer * 16384 * DM;
    const unsigned char* v8 = p.v8 + (size_t)layer * 16384 * DM;
    const float* su = p.su + layer * 16384; const float* sv = p.sv + layer * 16384;
    const float su0 = su[e0], su1 = su[e1], sv0 = sv[e0], sv1 = sv[e1];
    uint4 rx0, rx1, rx2, rx3, rx4, rx5, rx6, rx7, ry0, ry1, ry2, ry3, ry4, ry5, ry6, ry7;
    float a0 = 0.f, a1 = 0.f;
    EX_LOAD8(rx, u8, e0, 0);
#pragma unroll 1
    for (int g = 0; g < 8; ++g) {
        const int eb = g < 4 ? e0 : e1;
        const int sl = (g & 3) * 16;
        f32x16 pp;
        EX_LOAD8(ry, u8, eb, sl + 8);
        EX_SB();
        EX_DOT8(rx, pp, 0);
        EX_SB();
        {
            const int gn = g + 1 < 8 ? g + 1 : 0;
            const int ebn = gn < 4 ? e0 : e1;
            const unsigned char* tabn = g + 1 < 8 ? u8 : v8;
            EX_LOAD8(rx, tabn, ebn, (gn & 3) * 16);
        }
        EX_SB();
        EX_DOT8(ry, pp, 8);
        const float v = transpose_reduce16(pp, lane);
        const float got = __shfl(v, (lane & 15) << 2);
        const bool mine = (lane >> 4) == (g & 3);
        a0 = (mine && g < 4) ? got : a0;
        a1 = (mine && g >= 4) ? got : a1;
        EX_SB();
    }
#if EXS_SYNC >= 2
    if (syncp) xcd_local_sync_p(syncp);
#endif
    const float w0 = g0 * gelu_exact(su0 * a0) * sv0;
    const float w1 = g1 * gelu_exact(su1 * a1) * sv1;
    float acc[16];
#pragma unroll
    for (int i = 0; i < 16; ++i) acc[i] = 0.f;
#pragma unroll 1
    for (int h2 = 0; h2 < 8; ++h2) {
        const int ebc = h2 < 4 ? e0 : e1;
        const float wb = h2 < 4 ? w0 : w1;
        const int slc = (h2 & 3) * 16;
        EX_LOAD8(ry, v8, ebc, slc + 8);
        EX_SB();
        EX_AXPY8(rx, wb, slc);
        EX_SB();
        {
            const int hn_ = h2 + 1 < 8 ? h2 + 1 : 7;
            const int ebn = hn_ < 4 ? e0 : e1;
            EX_LOAD8(rx, v8, ebn, (hn_ & 3) * 16);
        }
        EX_SB();
        EX_AXPY8(ry, wb, slc + 8);
        EX_SB();
    }
#pragma unroll
    for (int i = 0; i < 16; ++i) xv[i] += acc[i];
    float s2 = 0.f;
#pragma unroll
    for (int i = 0; i < 16; ++i) s2 += xv[i] * xv[i];
    s2 = wave_sum(s2);
    const float r2 = rsqrtf(s2 * (1.f / DM) + 1e-6f);
    if (!last) {
#pragma unroll
        for (int q = 0; q < 4; ++q) *(float4*)(xwr + 4 * q) = make_float4(xv[4 * q], xv[4 * q + 1], xv[4 * q + 2], xv[4 * q + 3]);
        const float* gnb = p.g_mix + (layer + 1) * DM; asm volatile("" : "+s"(gnb));
        const float* gn = gnb + lane * 16;
        unsigned hw[8];
#pragma unroll
        for (int q = 0; q < 4; ++q) {
            const float4 g = *(const float4*)(gn + 4 * q);
            hw[2 * q] = cvtpk(xv[4 * q] * r2 * g.x, xv[4 * q + 1] * r2 * g.y);
            hw[2 * q + 1] = cvtpk(xv[4 * q + 2] * r2 * g.z, xv[4 * q + 3] * r2 * g.w);
        }
        *(uint4*)(hwr) = make_uint4(hw[0], hw[1], hw[2], hw[3]);
        *(uint4*)(hwr + 8) = make_uint4(hw[4], hw[5], hw[6], hw[7]);
    } else {
        const float* gnb = p.g_final; asm volatile("" : "+s"(gnb));
        const float* gn = gnb + lane * 16;
        float* orow = dummy ? xwr : p.out + (size_t)t * DM + lane * 16;
#pragma unroll
        for (int q = 0; q < 4; ++q) {
            const float4 g = *(const float4*)(gn + 4 * q);
            *(float4*)(orow + 4 * q) = make_float4(xv[4 * q] * r2 * g.x, xv[4 * q + 1] * r2 * g.y, xv[4 * q + 2] * r2 * g.z, xv[4 * q + 3] * r2 * g.w);
        }
    }
}

#define EX_DOT8H(P, PP, O, HP) do { PP[(O) + 0] = dot16_fp8(P##0, HP); PP[(O) + 1] = dot16_fp8(P##1, HP); PP[(O) + 2] = dot16_fp8(P##2, HP); PP[(O) + 3] = dot16_fp8(P##3, HP); \
        PP[(O) + 4] = dot16_fp8(P##4, HP); PP[(O) + 5] = dot16_fp8(P##5, HP); PP[(O) + 6] = dot16_fp8(P##6, HP); PP[(O) + 7] = dot16_fp8(P##7, HP); } while (0)
#define EX_AXPY8A(P, W, SL, ACC) do { axpy16_fp8(ACC, EX_RL(W, (SL) + 0), P##0); axpy16_fp8(ACC, EX_RL(W, (SL) + 1), P##1); axpy16_fp8(ACC, EX_RL(W, (SL) + 2), P##2); axpy16_fp8(ACC, EX_RL(W, (SL) + 3), P##3); \
        axpy16_fp8(ACC, EX_RL(W, (SL) + 4), P##4); axpy16_fp8(ACC, EX_RL(W, (SL) + 5), P##5); axpy16_fp8(ACC, EX_RL(W, (SL) + 6), P##6); axpy16_fp8(ACC, EX_RL(W, (SL) + 7), P##7); } while (0)
__device__ __forceinline__ void ex2_begin(PC& p, int layer, int t, int lane, int2* lst, float (&xv)[16], unsigned (&hp)[8], int& e0, int& e1, float& g0, float& g1) {
    const float* gfb = p.g_ffn + layer * DM; asm volatile("" : "+s"(gfb));
    const float* gf = gfb + lane * 16;
    const float* xrow = p.x + (size_t)t * DM + lane * 16;
#pragma unroll
    for (int q = 0; q < 4; ++q) { const float4 a = *(const float4*)(xrow + 4 * q); xv[4 * q] = a.x; xv[4 * q + 1] = a.y; xv[4 * q + 2] = a.z; xv[4 * q + 3] = a.w; }
    float ss = 0.f;
#pragma unroll
    for (int i = 0; i < 16; ++i) ss += xv[i] * xv[i];
    ss = wave_sum(ss);
    const float rstd = rsqrtf(ss * (1.f / DM) + 1e-6f);
#pragma unroll
    for (int q = 0; q < 4; ++q) {
        const float4 g = *(const float4*)(gf + 4 * q);
        hp[2 * q] = cvtpk(xv[4 * q] * rstd * g.x, xv[4 * q + 1] * rstd * g.y);
        hp[2 * q + 1] = cvtpk(xv[4 * q + 2] * rstd * g.z, xv[4 * q + 3] * rstd * g.w);
    }
    const size_t ei0 = ((size_t)(lane >> 4) * T_TOK + t) * 16 + (lane & 15), ei1 = ei0 + (size_t)4 * T_TOK * 16;
    e0 = p.eidx[ei0]; e1 = p.eidx[ei1];
    g0 = p.gate[ei0]; g1 = p.gate[ei1];
    const int s0 = ((e0 >> 7) + e0) & (EXS_NS - 1), s1 = ((e1 >> 7) + e1) & (EXS_NS - 1);
    int base = 0, pos0 = 0, pos1 = 0;
#pragma unroll
    for (int s = 0; s < EXS_NS; ++s) {
        const unsigned long long m0 = __ballot(s0 == s), m1 = __ballot(s1 == s);
        const int c0 = __popcll(m0);
        pos0 = (s0 == s) ? base + ex_mbcnt(m0) : pos0;
        pos1 = (s1 == s) ? base + c0 + ex_mbcnt(m1) : pos1;
        base += c0 + __popcll(m1);
    }
    lst[pos0] = make_int2(e0, __float_as_int(g0)); lst[pos1] = make_int2(e1, __float_as_int(g1));
    const int2 q0 = lst[lane], q1 = lst[64 + lane];
    e0 = q0.x; g0 = __int_as_float(q0.y); e1 = q1.x; g1 = __int_as_float(q1.y);
}
__device__ __forceinline__ void ex2_end(PC& p, int layer, int t, int lane, bool last, bool dummy, float (&xv)[16], const float (&acc)[16]) {
    float* xwr = (dummy ? (float*)p.zb : p.x) + (size_t)t * DM + lane * 16;
    bf16_t* hwr = (dummy ? p.q.qA + (size_t)t * DM : p.hnb + (size_t)t * DM) + lane * 16;
#pragma unroll
    for (int i = 0; i < 16; ++i) xv[i] += acc[i];
    float s2 = 0.f;
#pragma unroll
    for (int i = 0; i < 16; ++i) s2 += xv[i] * xv[i];
    s2 = wave_sum(s2);
    const float r2 = rsqrtf(s2 * (1.f / DM) + 1e-6f);
    if (!last) {
#pragma unroll
        for (int q = 0; q < 4; ++q) *(float4*)(xwr + 4 * q) = make_float4(xv[4 * q], xv[4 * q + 1], xv[4 * q + 2], xv[4 * q + 3]);
        const float* gnb = p.g_mix + (layer + 1) * DM; asm volatile("" : "+s"(gnb));
        const float* gn = gnb + lane * 16;
        unsigned hw[8];
#pragma unroll
        for (int q = 0; q < 4; ++q) {
            const float4 g = *(const float4*)(gn + 4 * q);
            hw[2 * q] = cvtpk(xv[4 * q] * r2 * g.x, xv[4 * q + 1] * r2 * g.y);
            hw[2 * q + 1] = cvtpk(xv[4 * q + 2] * r2 * g.z, xv[4 * q + 3] * r2 * g.w);
        }
        *(uint4*)(hwr) = make_uint4(hw[0], hw[1], hw[2], hw[3]);
        *(uint4*)(hwr + 8) = make_uint4(hw[4], hw[5], hw[6], hw[7]);
    } else {
        const float* gnb = p.g_final; asm volatile("" : "+s"(gnb));
        const float* gn = gnb + lane * 16;
        float* orow = dummy ? xwr : p.out + (size_t)t * DM + lane * 16;
#pragma unroll
        for (int q = 0; q < 4; ++q) {
            const float4 g = *(const float4*)(gn + 4 * q);
            *(float4*)(orow + 4 * q) = make_float4(xv[4 * q] * r2 * g.x, xv[4 * q + 1] * r2 * g.y, xv[4 * q + 2] * r2 * g.z, xv[4 * q + 3] * r2 * g.w);
        }
    }
}
__device__ __forceinline__ void expert_token2(PC& p, int layer, int tA, int tB, bool last, int2* lst, bool dummy) {
    const int lane = tid_opaque() & 63;
    const int lane16 = lane * 16;
    float xvA[16], xvB[16]; unsigned hpA[8], hpB[8];
    int e0A, e1A, e0B, e1B; float g0A, g1A, g0B, g1B;
    ex2_begin(p, layer, tA, lane, lst, xvA, hpA, e0A, e1A, g0A, g1A);
    EX_SB();
    ex2_begin(p, layer, tB, lane, lst + 128, xvB, hpB, e0B, e1B, g0B, g1B);
    EX_SB();
    const unsigned char* u8 = p.u8 + (size_t)layer * 16384 * DM;
    const unsigned char* v8 = p.v8 + (size_t)layer * 16384 * DM;
    const float* su = p.su + layer * 16384; const float* sv = p.sv + layer * 16384;
    const float su0A = su[e0A], su1A = su[e1A], sv0A = sv[e0A], sv1A = sv[e1A];
    const float su0B = su[e0B], su1B = su[e1B], sv0B = sv[e0B], sv1B = sv[e1B];
    uint4 rx0, rx1, rx2, rx3, rx4, rx5, rx6, rx7, ry0, ry1, ry2, ry3, ry4, ry5, ry6, ry7;
    float a0A = 0.f, a1A = 0.f, a0B = 0.f, a1B = 0.f;
    EX_LOAD8(rx, u8, e0A, 0);
#pragma unroll 1
    for (int g = 0; g < 8; ++g) {
        const int ebA = g < 4 ? e0A : e1A, ebB = g < 4 ? e0B : e1B;
        const int sl = (g & 3) * 16;
        const bool mine = (lane >> 4) == (g & 3);
        f32x16 pp;
        EX_LOAD8(ry, u8, ebA, sl + 8);
        EX_SB();
        EX_DOT8H(rx, pp, 0, hpA);
        EX_SB();
        EX_LOAD8(rx, u8, ebB, sl);
        EX_SB();
        EX_DOT8H(ry, pp, 8, hpA);
        {
            const float v = transpose_reduce16(pp, lane);
            const float got = __shfl(v, (lane & 15) << 2);
            a0A = (mine && g < 4) ? got : a0A;
            a1A = (mine && g >= 4) ? got : a1A;
        }
        EX_SB();
        EX_LOAD8(ry, u8, ebB, sl + 8);
        EX_SB();
        EX_DOT8H(rx, pp, 0, hpB);
        EX_SB();
        {
            const int gn = g + 1 < 8 ? g + 1 : 0;
            const int ebn = gn < 4 ? e0A : e1A;
            const unsigned char* tabn = g + 1 < 8 ? u8 : v8;
            EX_LOAD8(rx, tabn, ebn, (gn & 3) * 16);
        }
        EX_SB();
        EX_DOT8H(ry, pp, 8, hpB);
        {
            const float v = transpose_reduce16(pp, lane);
            const float got = __shfl(v, (lane & 15) << 2);
            a0B = (mine && g < 4) ? got : a0B;
            a1B = (mine && g >= 4) ? got : a1B;
        }
        EX_SB();
    }
    const float w0A = g0A * gelu_exact(su0A * a0A) * sv0A, w1A = g1A * gelu_exact(su1A * a1A) * sv1A;
    const float w0B = g0B * gelu_exact(su0B * a0B) * sv0B, w1B = g1B * gelu_exact(su1B * a1B) * sv1B;
    float accA[16], accB[16];
#pragma unroll
    for (int i = 0; i < 16; ++i) { accA[i] = 0.f; accB[i] = 0.f; }
#pragma unroll 1
    for (int h2 = 0; h2 < 8; ++h2) {
        const int ebcA = h2 < 4 ? e0A : e1A, ebcB = h2 < 4 ? e0B : e1B;
        const float wbA = h2 < 4 ? w0A : w1A, wbB = h2 < 4 ? w0B : w1B;
        const int slc = (h2 & 3) * 16;
        EX_LOAD8(ry, v8, ebcA, slc + 8);
        EX_SB();
        EX_AXPY8A(rx, wbA, slc, accA);
        EX_SB();
        EX_LOAD8(rx, v8, ebcB, slc);
        EX_SB();
        EX_AXPY8A(ry, wbA, slc + 8, accA);
        EX_SB();
        EX_LOAD8(ry, v8, ebcB, slc + 8);
        EX_SB();
        EX_AXPY8A(rx, wbB, slc, accB);
        EX_SB();
        {
            const int hn_ = h2 + 1 < 8 ? h2 + 1 : 7;
            const int ebn = hn_ < 4 ? e0A : e1A;
            EX_LOAD8(rx, v8, ebn, (hn_ & 3) * 16);
        }
        EX_SB();
        EX_AXPY8A(ry, wbB, slc + 8, accB);
        EX_SB();
    }
    ex2_end(p, layer, tA, lane, last, dummy, xvA, accA);
    EX_SB();
    ex2_end(p, layer, tB, lane, last, dummy, xvB, accB);
}

__device__ __forceinline__ void ex2_endr(PC& p, int layer, int t, int lane, bool last, bool dummy, const float (&acc)[16]) {
    t = __builtin_amdgcn_readfirstlane(t); asm volatile("" : "+s"(t));
    float xv[16];
    const float* xrow = p.x + (size_t)t * DM + lane * 16;
#pragma unroll
    for (int q = 0; q < 4; ++q) { const float4 a = *(const float4*)(xrow + 4 * q); xv[4 * q] = a.x; xv[4 * q + 1] = a.y; xv[4 * q + 2] = a.z; xv[4 * q + 3] = a.w; }
    float zero[16];
#pragma unroll
    for (int i = 0; i < 16; ++i) { xv[i] += acc[i]; zero[i] = 0.f; }
    ex2_end(p, layer, t, lane, last, dummy, xv, zero);
}
#define EX_ACCIN(A) "v"(A[0]), "v"(A[1]), "v"(A[2]), "v"(A[3]), "v"(A[4]), "v"(A[5]), "v"(A[6]), "v"(A[7]), "v"(A[8]), "v"(A[9]), "v"(A[10]), "v"(A[11]), "v"(A[12]), "v"(A[13]), "v"(A[14]), "v"(A[15])
#define EX_ORDER2(RA, RB, A) asm volatile("" : "+v"(RA.x), "+v"(RA.y), "+v"(RA.z), "+v"(RA.w), "+v"(RB.x), "+v"(RB.y), "+v"(RB.z), "+v"(RB.w) : EX_ACCIN(A))
#define EX_AXPY8K(P, W, SL, ACC) do { axpy16_fp8(ACC, EX_RL(W, (SL) + 0), P##0); axpy16_fp8(ACC, EX_RL(W, (SL) + 1), P##1); axpy16_fp8(ACC, EX_RL(W, (SL) + 2), P##2); axpy16_fp8(ACC, EX_RL(W, (SL) + 3), P##3); \
        EX_ORDER2(P##4, P##5, ACC); EX_ORDER2(P##6, P##7, ACC); \
        axpy16_fp8(ACC, EX_RL(W, (SL) + 4), P##4); axpy16_fp8(ACC, EX_RL(W, (SL) + 5), P##5); axpy16_fp8(ACC, EX_RL(W, (SL) + 6), P##6); axpy16_fp8(ACC, EX_RL(W, (SL) + 7), P##7); } while (0)
typedef _Float16 h2_t __attribute__((ext_vector_type(2)));
__device__ __forceinline__ void axpy16_h(h2_t (&acc)[8], float w, uint4 v) {
    const _Float16 wh = (_Float16)w; const h2_t ww = {wh, wh};
    acc[0] = __builtin_elementwise_fma(ww, __builtin_bit_cast(h2_t, __builtin_amdgcn_cvt_scalef32_pk_f16_fp8((int)v.x, 1.0f, false)), acc[0]);
    acc[1] = __builtin_elementwise_fma(ww, __builtin_bit_cast(h2_t, __builtin_amdgcn_cvt_scalef32_pk_f16_fp8((int)v.x, 1.0f, true)), acc[1]);
    acc[2] = __builtin_elementwise_fma(ww, __builtin_bit_cast(h2_t, __builtin_amdgcn_cvt_scalef32_pk_f16_fp8((int)v.y, 1.0f, false)), acc[2]);
    acc[3] = __builtin_elementwise_fma(ww, __builtin_bit_cast(h2_t, __builtin_amdgcn_cvt_scalef32_pk_f16_fp8((int)v.y, 1.0f, true)), acc[3]);
    acc[4] = __builtin_elementwise_fma(ww, __builtin_bit_cast(h2_t, __builtin_amdgcn_cvt_scalef32_pk_f16_fp8((int)v.z, 1.0f, false)), acc[4]);
    acc[5] = __builtin_elementwise_fma(ww, __builtin_bit_cast(h2_t, __builtin_amdgcn_cvt_scalef32_pk_f16_fp8((int)v.z, 1.0f, true)), acc[5]);
    acc[6] = __builtin_elementwise_fma(ww, __builtin_bit_cast(h2_t, __builtin_amdgcn_cvt_scalef32_pk_f16_fp8((int)v.w, 1.0f, false)), acc[6]);
    acc[7] = __builtin_elementwise_fma(ww, __builtin_bit_cast(h2_t, __builtin_amdgcn_cvt_scalef32_pk_f16_fp8((int)v.w, 1.0f, true)), acc[7]);
}
#define EX_ACCINH(A) "v"(A[0]), "v"(A[1]), "v"(A[2]), "v"(A[3]), "v"(A[4]), "v"(A[5]), "v"(A[6]), "v"(A[7])
#define EX_ORDER2H(RA, RB, A) asm volatile("" : "+v"(RA.x), "+v"(RA.y), "+v"(RA.z), "+v"(RA.w), "+v"(RB.x), "+v"(RB.y), "+v"(RB.z), "+v"(RB.w) : EX_ACCINH(A))
#define EX_AXPY8H(P, W, SL, ACC) do { axpy16_h(ACC, EX_RL(W, (SL) + 0), P##0); axpy16_h(ACC, EX_RL(W, (SL) + 1), P##1); axpy16_h(ACC, EX_RL(W, (SL) + 2), P##2); axpy16_h(ACC, EX_RL(W, (SL) + 3), P##3); \
        if (EXK_ORD) { EX_ORDER2H(P##4, P##5, ACC); EX_ORDER2H(P##6, P##7, ACC); } \
        axpy16_h(ACC, EX_RL(W, (SL) + 4), P##4); axpy16_h(ACC, EX_RL(W, (SL) + 5), P##5); axpy16_h(ACC, EX_RL(W, (SL) + 6), P##6); axpy16_h(ACC, EX_RL(W, (SL) + 7), P##7); } while (0)
#ifndef EXK_ORD
#define EXK_ORD 1
#endif
#ifndef EXS_MIDSYNC
#define EXS_MIDSYNC 0
#endif
#ifndef EXK_PIN
#define EXK_PIN 1
#endif
template <int K>
__device__ __forceinline__ void expert_tokens(PC& p, int layer, const int (&tq)[K], bool last, int2* lst, char* syncp) {
    int tt[K]; bool dm[K];
#pragma unroll
    for (int k = 0; k < K; ++k) { dm[k] = tq[k] >= T_TOK; tt[k] = dm[k] ? T_TOK - 1 : tq[k]; }
    const int lane = tid_opaque() & 63;
    const int lane16 = lane * 16;
    constexpr int KR = K < 4 ? K : 4;
    unsigned hp[KR][8];
    char* hpl = (char*)(lst + 128 * K);
    int e0[KR], e1[KR];
#pragma unroll
    for (int k = 0; k < K; ++k) {
        float xv[16]; float g0, g1; unsigned hq[8]; int ea, eb;
        ex2_begin(p, layer, tt[k], lane, lst + 128 * k, xv, hq, ea, eb, g0, g1);
        if (k < KR) { e0[k < KR ? k : 0] = ea; e1[k < KR ? k : 0] = eb; }
        if (k < KR) {
#pragma unroll
            for (int i = 0; i < 8; ++i) hp[k < KR ? k : 0][i] = hq[i];
        } else {
            *(uint4*)(hpl + (k - KR) * 2048 + lane16) = make_uint4(hq[0], hq[1], hq[2], hq[3]);
            *(uint4*)(hpl + (k - KR) * 2048 + 1024 + lane16) = make_uint4(hq[4], hq[5], hq[6], hq[7]);
        }
        if ((k & 3) == 3) EX_SB();
    }
    const unsigned char* u8 = p.u8 + (size_t)layer * 16384 * DM;
    const unsigned char* v8 = p.v8 + (size_t)layer * 16384 * DM;
    const float* su = p.su + layer * 16384; const float* sv = p.sv + layer * 16384;
    float a0[K], a1[K];
#pragma unroll
    for (int k = 0; k < K; ++k) { a0[k] = 0.f; a1[k] = 0.f; }
    uint4 rx0, rx1, rx2, rx3, rx4, rx5, rx6, rx7, ry0, ry1, ry2, ry3, ry4, ry5, ry6, ry7;
#define EXK_E(KK, HALF) ((KK) < KR ? ((HALF) ? e1[(KK) < KR ? (KK) : 0] : e0[(KK) < KR ? (KK) : 0]) : lst[128 * (KK) + 64 * (HALF) + lane].x)
    { const int eb = EXK_E(0, 0); EX_LOAD8(rx, u8, eb, 0); }
#pragma unroll 1
    for (int g = 0; g < 8; ++g) {
        const int sl = (g & 3) * 16, hf = g >> 2;
        const bool mine = (lane >> 4) == (g & 3);
#pragma unroll
        for (int k = 0; k < K; ++k) {
            f32x16 pp;
            { const int ebk = EXK_E(k, hf); EX_LOAD8(ry, u8, ebk, sl + 8); }
            EX_SB();
            unsigned hh[8];
            if (k < KR) {
#pragma unroll
                for (int i = 0; i < 8; ++i) hh[i] = hp[k < KR ? k : 0][i];
            } else {
                const uint4 h0 = *(const uint4*)(hpl + (k - KR) * 2048 + lane16), h1 = *(const uint4*)(hpl + (k - KR) * 2048 + 1024 + lane16);
                hh[0] = h0.x; hh[1] = h0.y; hh[2] = h0.z; hh[3] = h0.w; hh[4] = h1.x; hh[5] = h1.y; hh[6] = h1.z; hh[7] = h1.w;
            }
            EX_DOT8H(rx, pp, 0, hh);
            EX_SB();
            if (k + 1 < K) { const int ebn = EXK_E((k + 1) % K, hf); EX_LOAD8(rx, u8, ebn, sl); }
            else {
                const int gn = g + 1 < 8 ? g + 1 : 0;
                const int ebn = EXK_E(0, gn >> 2);
                const unsigned char* tabn = g + 1 < 8 ? u8 : v8;
                EX_LOAD8(rx, tabn, ebn, (gn & 3) * 16);
            }
            EX_SB();
            EX_DOT8H(ry, pp, 8, hh);
            const float v = transpose_reduce16(pp, lane);
            const float got = __shfl(v, (lane & 15) << 2);
            a0[k] = (mine && g < 4) ? got : a0[k];
            a1[k] = (mine && g >= 4) ? got : a1[k];
            EX_SB();
        }
    }
#if EXS_MIDSYNC
    xcd_local_sync_p(syncp);
#endif
    float w0[K], w1[K]; h2_t acc[K][8];
    {
        float s0[K], s1[K], t0[K], t1[K], gg0[K], gg1[K];
#pragma unroll
        for (int k = 0; k < K; ++k) {
            const int2 q0 = lst[128 * k + lane], q1 = lst[128 * k + 64 + lane];
            s0[k] = su[q0.x]; s1[k] = su[q1.x]; t0[k] = sv[q0.x]; t1[k] = sv[q1.x];
            gg0[k] = __int_as_float(q0.y); gg1[k] = __int_as_float(q1.y);
        }
#pragma unroll
        for (int k = 0; k < K; ++k) { w0[k] = gg0[k] * gelu_exact(s0[k] * a0[k]) * t0[k]; w1[k] = gg1[k] * gelu_exact(s1[k] * a1[k]) * t1[k]; }
    }
#pragma unroll
    for (int k = 0; k < K; ++k)
#pragma unroll
        for (int i = 0; i < 8; ++i) acc[k][i] = (h2_t){(_Float16)0.f, (_Float16)0.f};
#pragma unroll 1
    for (int h2 = 0; h2 < 8; ++h2) {
        const int slc = (h2 & 3) * 16, hf = h2 >> 2;
#pragma unroll
        for (int k = 0; k < K; ++k) {
            const float wb = h2 < 4 ? w0[k] : w1[k];
            { const int ebc = EXK_E(k, hf); EX_LOAD8(ry, v8, ebc, slc + 8); }
            EX_SB();
            EX_AXPY8H(rx, wb, slc, acc[k]);
            EX_SB();
            if (k + 1 < K) { const int ebn = EXK_E((k + 1) % K, hf); EX_LOAD8(rx, v8, ebn, slc); }
            else { const int hn_ = h2 + 1 < 8 ? h2 + 1 : 7; const int ebn = EXK_E(0, hn_ >> 2); EX_LOAD8(rx, v8, ebn, (hn_ & 3) * 16); }
            EX_SB();
            EX_AXPY8H(ry, wb, slc + 8, acc[k]);
            EX_SB();
        }
    }
#undef EXK_E
#pragma unroll
    for (int k = 0; k < K; ++k) {
        float af[16];
#pragma unroll
        for (int i = 0; i < 8; ++i) { af[2 * i] = (float)acc[k][i][0]; af[2 * i + 1] = (float)acc[k][i][1]; }
        ex2_endr(p, layer, tt[k], lane, last, dm[k], af);
    }
}
__device__ __forceinline__ void transpose_tile(const float* __restrict__ src, int K, int N, bf16_t* __restrict__ dst, int tk, int tn, float* tl, const float* __restrict__ ksc, int perm) {
    const int tid = tid_opaque(), r = tid >> 6, c = tid & 63;
    const int k0 = tk * 64, n0 = tn * 64;
#pragma unroll
    for (int i = 0; i < 8; ++i) {
        const int kk = i * 8 + r, n = n0 + c;
        tl[kk * 65 + c] = (n < N) ? src[(size_t)(k0 + kk) * N + n] : 0.f;
    }
    __syncthreads();
#pragma unroll
    for (int i = 0; i < 8; ++i) {
        const int nn = i * 8 + r;
        if (n0 + nn < N) {
            int nd = n0 + nn;
            if (perm) { const int hq = nd / 96, wq = nd % 96; nd = wq < 64 ? hq * 64 + wq : 256 + hq * 32 + (wq - 64); }
            dst[(size_t)nd * K + k0 + c] = f2bf(tl[c * 65 + nn] * (ksc ? ksc[k0 + c] : 1.f));
        }
    }
    __syncthreads();
}
__device__ __forceinline__ void transpose_all(const float* src, int K, int N, bf16_t* dst, float* tl, const float* ksc = nullptr, int perm = 0) {
    const int ntk = K / 64, ntn = (N + 63) / 64;
    for (int t = blockIdx.x; t < ntk * ntn; t += gridDim.x) transpose_tile(src, K, N, dst, t / ntn, t % ntn, tl, ksc, perm);
}
__device__ __forceinline__ void convert_plain(const float* __restrict__ src, bf16_t* __restrict__ dst, size_t n) {
    const size_t n8 = n >> 3;
    for (size_t i = (size_t)blockIdx.x * blockDim.x + tid_opaque(); i < n8; i += (size_t)gridDim.x * blockDim.x) {
        const float4 a = *(const float4*)(src + i * 8), b = *(const float4*)(src + i * 8 + 4);
        uint4 w; w.x = cvtpk(a.x, a.y); w.y = cvtpk(a.z, a.w); w.z = cvtpk(b.x, b.y); w.w = cvtpk(b.z, b.w);
        *(uint4*)(dst + i * 8) = w;
    }
}
__device__ __forceinline__ void convert_rows_fp8(const float* __restrict__ src, unsigned char* __restrict__ dst, float* __restrict__ scales, int nrows) {
    const int tid = tid_opaque(), wave = tid >> 6, lane = tid & 63;
    const int stride = gridDim.x * NW;
    for (int row0 = blockIdx.x * NW + wave; row0 < nrows; row0 += 4 * stride) {
        float4 xv[4][4];
#pragma unroll
        for (int u = 0; u < 4; ++u) {
            int row = row0 + u * stride; row = row < nrows ? row : row0;
            const float* sr = src + (size_t)row * DM + lane * 16;
#pragma unroll
            for (int q = 0; q < 4; ++q) xv[u][q] = *(const float4*)(sr + 4 * q);
        }
#pragma unroll
        for (int u = 0; u < 4; ++u) {
            const int row = row0 + u * stride;
            float am = 0.f;
#pragma unroll
            for (int q = 0; q < 4; ++q) am = fmaxf(fmaxf(am, fmaxf(fabsf(xv[u][q].x), fabsf(xv[u][q].y))), fmaxf(fabsf(xv[u][q].z), fabsf(xv[u][q].w)));
            am = wave_max(am);
            const float sc = am > 0.f ? am * (1.f / 448.f) : 1.f;
            const float inv = 1.f / sc;
            unsigned w[4];
#pragma unroll
            for (int q = 0; q < 4; ++q) {
                int t = 0;
                t = __builtin_amdgcn_cvt_pk_fp8_f32(xv[u][q].x * inv, xv[u][q].y * inv, t, false);
                t = __builtin_amdgcn_cvt_pk_fp8_f32(xv[u][q].z * inv, xv[u][q].w * inv, t, true);
                w[q] = (unsigned)t;
            }
            if (row < nrows) {
                *(uint4*)(dst + (size_t)row * DM + lane * 16) = make_uint4(w[0], w[1], w[2], w[3]);
                if (lane == 0) scales[row] = sc;
            }
        }
    }
}
__device__ __forceinline__ void rms_row_bf16(const float* __restrict__ src, const float* __restrict__ g, bf16_t* __restrict__ dst, float* __restrict__ cpy, int lane) {
    float xv[16];
    const float4 a0 = *(const float4*)(src + lane * 8), a1 = *(const float4*)(src + lane * 8 + 4);
    const float4 b0 = *(const float4*)(src + 512 + lane * 8), b1 = *(const float4*)(src + 512 + lane * 8 + 4);
    xv[0] = a0.x; xv[1] = a0.y; xv[2] = a0.z; xv[3] = a0.w; xv[4] = a1.x; xv[5] = a1.y; xv[6] = a1.z; xv[7] = a1.w;
    xv[8] = b0.x; xv[9] = b0.y; xv[10] = b0.z; xv[11] = b0.w; xv[12] = b1.x; xv[13] = b1.y; xv[14] = b1.z; xv[15] = b1.w;
    if (cpy) {
        *(float4*)(cpy + lane * 8) = a0; *(float4*)(cpy + lane * 8 + 4) = a1;
        *(float4*)(cpy + 512 + lane * 8) = b0; *(float4*)(cpy + 512 + lane * 8 + 4) = b1;
    }
    float ss = 0.f;
#pragma unroll
    for (int i = 0; i < 16; ++i) ss += xv[i] * xv[i];
    ss = wave_sum(ss);
    const float r = rsqrtf(ss * (1.f / DM) + 1e-6f);
    const float4 g0 = *(const float4*)(g + lane * 8), g1 = *(const float4*)(g + lane * 8 + 4);
    const float4 g2 = *(const float4*)(g + 512 + lane * 8), g3 = *(const float4*)(g + 512 + lane * 8 + 4);
    uint4 wa, wb;
    wa.x = cvtpk(xv[0] * r * g0.x, xv[1] * r * g0.y); wa.y = cvtpk(xv[2] * r * g0.z, xv[3] * r * g0.w);
    wa.z = cvtpk(xv[4] * r * g1.x, xv[5] * r * g1.y); wa.w = cvtpk(xv[6] * r * g1.z, xv[7] * r * g1.w);
    wb.x = cvtpk(xv[8] * r * g2.x, xv[9] * r * g2.y); wb.y = cvtpk(xv[10] * r * g2.z, xv[11] * r * g2.w);
    wb.z = cvtpk(xv[12] * r * g3.x, xv[13] * r * g3.y); wb.w = cvtpk(xv[14] * r * g3.z, xv[15] * r * g3.w);
    *(uint4*)(dst + lane * 8) = wa; *(uint4*)(dst + 512 + lane * 8) = wb;
}

__device__ __forceinline__ void rms_row2_bf16(const float* __restrict__ s0, const float* __restrict__ s1, const float* __restrict__ g, bf16_t* __restrict__ d0, bf16_t* __restrict__ d1, int lane) {
    float4 a[4], b[4];
#pragma unroll
    for (int q = 0; q < 4; ++q) { a[q] = *(const float4*)(s0 + (q >> 1) * 512 + lane * 8 + (q & 1) * 4); b[q] = s1 ? *(const float4*)(s1 + (q >> 1) * 512 + lane * 8 + (q & 1) * 4) : make_float4(0.f, 0.f, 0.f, 0.f); }
    float sa = 0.f, sb = 0.f;
#pragma unroll
    for (int q = 0; q < 4; ++q) { sa += a[q].x * a[q].x + a[q].y * a[q].y + a[q].z * a[q].z + a[q].w * a[q].w; sb += b[q].x * b[q].x + b[q].y * b[q].y + b[q].z * b[q].z + b[q].w * b[q].w; }
    sa = wave_sum(sa); sb = wave_sum(sb);
    const float ra = rsqrtf(sa * (1.f / DM) + 1e-6f), rb = rsqrtf(sb * (1.f / DM) + 1e-6f);
    float4 gq[4];
#pragma unroll
    for (int q = 0; q < 4; ++q) gq[q] = *(const float4*)(g + (q >> 1) * 512 + lane * 8 + (q & 1) * 4);
    uint4 w;
    w.x = cvtpk(a[0].x * ra * gq[0].x, a[0].y * ra * gq[0].y); w.y = cvtpk(a[0].z * ra * gq[0].z, a[0].w * ra * gq[0].w);
    w.z = cvtpk(a[1].x * ra * gq[1].x, a[1].y * ra * gq[1].y); w.w = cvtpk(a[1].z * ra * gq[1].z, a[1].w * ra * gq[1].w);
    *(uint4*)(d0 + lane * 8) = w;
    w.x = cvtpk(a[2].x * ra * gq[2].x, a[2].y * ra * gq[2].y); w.y = cvtpk(a[2].z * ra * gq[2].z, a[2].w * ra * gq[2].w);
    w.z = cvtpk(a[3].x * ra * gq[3].x, a[3].y * ra * gq[3].y); w.w = cvtpk(a[3].z * ra * gq[3].z, a[3].w * ra * gq[3].w);
    *(uint4*)(d0 + 512 + lane * 8) = w;
    if (s1) {
        w.x = cvtpk(b[0].x * rb * gq[0].x, b[0].y * rb * gq[0].y); w.y = cvtpk(b[0].z * rb * gq[0].z, b[0].w * rb * gq[0].w);
        w.z = cvtpk(b[1].x * rb * gq[1].x, b[1].y * rb * gq[1].y); w.w = cvtpk(b[1].z * rb * gq[1].z, b[1].w * rb * gq[1].w);
        *(uint4*)(d1 + lane * 8) = w;
        w.x = cvtpk(b[2].x * rb * gq[2].x, b[2].y * rb * gq[2].y); w.y = cvtpk(b[2].z * rb * gq[2].z, b[2].w * rb * gq[2].w);
        w.z = cvtpk(b[3].x * rb * gq[3].x, b[3].y * rb * gq[3].y); w.w = cvtpk(b[3].z * rb * gq[3].z, b[3].w * rb * gq[3].w);
        *(uint4*)(d1 + 512 + lane * 8) = w;
    }
}

__device__ __forceinline__ void phase_pro(PC& p, char* lds) {
    float* tl = (float*)lds;
    for (int l = 0; l < DEPTH; ++l) {
        transpose_all(p.w_in + (size_t)l * DM * NZ, DM, NZ, p.winT + (size_t)l * NZ * DM, tl);
        transpose_all(p.w_out + (size_t)l * DM * DM, DM, DM, p.woutT + (size_t)l * DM * DM, tl, (p.flags & 16) ? p.g_group + (size_t)l * 1024 : nullptr);
        transpose_all(p.peer_w_q + (size_t)l * DM * 2048, DM, 2048, p.wqT + (size_t)l * 2048 * DM, tl, (p.flags & 4) ? p.g_ffn + l * DM : nullptr);
        transpose_all(p.mla_w_uq + (size_t)l * 256 * 384, 256, 384, p.wuqT + (size_t)l * 384 * 256, tl, (p.flags & 8) ? p.mla_q_norm + l * 256 : nullptr, (p.flags & 32) ? 1 : 0);
        transpose_all(p.mla_w_ukv + (size_t)l * 128 * 512, 128, 512, p.wukvT + (size_t)l * 512 * 128, tl, (p.flags & 8) ? p.mla_kv_norm + l * 128 : nullptr);
    }
    convert_plain(p.peer_sub_keys, p.subk, (size_t)DEPTH * 8 * 2 * 128 * 128);
    if ((p.flags & 3) == 1) {
        convert_rows_fp8(p.peer_u, p.u8, p.su, DEPTH * 16384);
        convert_rows_fp8(p.peer_v, p.v8, p.sv, DEPTH * 16384);
    }
    for (int i = blockIdx.x * blockDim.x + tid_opaque(); i < 4096 * 32; i += gridDim.x * blockDim.x) {
        {
            const int pos = i / 32, j = i % 32;
            const float inv = powf(10000.f, -(float)(2 * j) / 64.f); const float ang = (float)pos * inv;
            p.tb.cos1[i] = cosf(ang); p.tb.sin1[i] = sinf(ang);
        }
        if (i < 4096 * 16) {
            const int pos = i / 16, j = i % 16;
            const float inv = powf(10000.f, -(float)(2 * j) / 32.f); const float ang = (float)pos * inv;
            p.tb.cosm[i] = cosf(ang); p.tb.sinm[i] = sinf(ang);
        }
        if (i < 64 * 16) {
            const int pos = i / 16, j = i % 16;
            const float inv = powf(10000.f, -(float)(2 * j) / 32.f); const float ang = (float)pos * inv;
            p.tb.cosr[i] = cosf(ang); p.tb.sinr[i] = sinf(ang); p.tb.cosc[i] = cosf(ang); p.tb.sinc[i] = sinf(ang);
        }
    }
    const int wave = tid_opaque() >> 6, lane = tid_opaque() & 63;
    for (int t = blockIdx.x * NW + wave; t < T_TOK; t += gridDim.x * NW)
        rms_row_bf16(p.x_in + (size_t)t * DM, p.g_mix, p.hnb + (size_t)t * DM, nullptr, lane);
}

__device__ __forceinline__ void phase_g1(PC& p, int l, char* lds) {
    RowsPostZ eZ{p.q.qA, p.tb.cos1, p.ax_q_norm + l * 64, p.ax_k_norm + l * 64, p.cqn, p.ssqd, p.q.kD};
    RowsPostQ eQ{p.q.qD, p.tb.cos1, p.ssqd};
    RowsPostKV eKV{p.q.kD, p.q.vD, p.ssqd + (size_t)4 * T_TOK};
    const bf16_t* win = p.winT + (size_t)l * NZ * DM;
    const bf16_t* wuq = p.wuqT + (size_t)l * 384 * 256; const bf16_t* wukv = p.wukvT + (size_t)l * 512 * 128;
    const bool mapped = (gridDim.x & 63) == 0 && (1024 % gridDim.x) == 0;
    for (int tile = blockIdx.x; tile < 1024; tile += gridDim.x) {
        int mt, nt;
        if (mapped) { tile_map(tile, 128, 8, mt, nt); nt = (nt + 2 * (tile / gridDim.x)) & 7; }
        else { mt = tile >> 3; nt = tile & 7; }
        gemm_tile_rows<RowsPostZ, 0>(p.hnb, DM, win, DM, DM, mt * 256, nt * 256, NZ, lds, eZ);
        if (nt >= 6) {
            asm volatile("s_waitcnt vmcnt(0)" ::: "memory");
            __syncthreads();
            if (nt == 6) {
                gemm_tile_rows<RowsPostQ, 0>(p.cqn, 256, wuq, 256, 256, mt * 256, 0, 384, lds, eQ);
                gemm_tile_rows<RowsPostQ, 0>(p.cqn, 256, wuq, 256, 256, mt * 256, 256, 384, lds, eQ);
            } else {
                gemm_tile_rows<RowsPostKV, 0>(p.ckvn, 128, wukv, 128, 128, mt * 256, 0, 512, lds, eKV);
                gemm_tile_rows<RowsPostKV, 0>(p.ckvn, 128, wukv, 128, 128, mt * 256, 256, 512, lds, eKV);
            }
        }
    }
}

__device__ __forceinline__ void phase_att(PC& p, int l, char* lds) {
    for (int it = blockIdx.x; it < 512; it += gridDim.x) attn_item<96, 1, false>(p.q.qD, p.q.kD, p.q.vD, nullptr, p.ob, 768, 4, 4, it, lds, (p.flags & 32) ? 128 : 96);
    if (p.flags & 2) convert_rows_fp8(p.peer_u + (size_t)l * 16384 * DM, p.u8 + (size_t)l * 16384 * DM, p.su + l * 16384, 16384);
    for (int it = blockIdx.x; it < 512; it += gridDim.x) attn_item<64, 2, false>(p.q.qB, p.q.kB, p.q.vB, nullptr, p.ob, 256, 4, 2, it, lds);
    if (p.flags & 2) convert_rows_fp8(p.peer_v + (size_t)l * 16384 * DM, p.v8 + (size_t)l * 16384 * DM, p.sv + l * 16384, 16384);
    for (int it = blockIdx.x; it < 512; it += gridDim.x) attn_item<64, 2, true>(p.q.qA, p.q.kA, p.q.vA, p.win_sink + l * 4, p.ob, 0, 4, 2, it, lds);
    {
        const int wave = tid_opaque() >> 6;
        char* wl = lds + wave * 6144;
        const int off = (int)(uintptr_t)wl;
        for (int wi = blockIdx.x * NW + wave; wi < 4096; wi += gridDim.x * NW) dil_wave_item(p.q.qC, p.q.kC, p.q.vC, p.ob, wi, wl, off);
    }
}

__device__ __forceinline__ void phase_gn(PC& p, int l) {
    const int wave = tid_opaque() >> 6, lane = tid_opaque() & 63;
    const float* gg = p.g_group + (size_t)l * 1024;
    const bf16_t* ob = p.ob; bf16_t* hnb = p.hnb;
    for (int t0 = blockIdx.x * NW + wave; t0 < T_TOK; t0 += gridDim.x * 2 * NW) {
        const int t1 = t0 + gridDim.x * NW;
        const bool has1 = t1 < T_TOK;
        uint2 w0[4], w1[4];
#pragma unroll
        for (int g = 0; g < 4; ++g) {
            w0[g] = *(const uint2*)(ob + (size_t)t0 * DM + g * 256 + lane * 4);
            w1[g] = has1 ? *(const uint2*)(ob + (size_t)t1 * DM + g * 256 + lane * 4) : make_uint2(0, 0);
        }
#pragma unroll
        for (int g = 0; g < 4; ++g) {
            const float4 g4 = *(const float4*)(gg + g * 256 + lane * 4);
            {
                const float v0 = __uint_as_float(w0[g].x << 16), v1 = __uint_as_float(w0[g].x & 0xffff0000u), v2 = __uint_as_float(w0[g].y << 16), v3 = __uint_as_float(w0[g].y & 0xffff0000u);
                const float r = rsqrtf(wave_sum(v0 * v0 + v1 * v1 + v2 * v2 + v3 * v3) * (1.f / 256.f) + 1e-6f);
                uint2 o; o.x = cvtpk(v0 * r * g4.x, v1 * r * g4.y); o.y = cvtpk(v2 * r * g4.z, v3 * r * g4.w);
                *(uint2*)(hnb + (size_t)t0 * DM + g * 256 + lane * 4) = o;
            }
            if (has1) {
                const float v0 = __uint_as_float(w1[g].x << 16), v1 = __uint_as_float(w1[g].x & 0xffff0000u), v2 = __uint_as_float(w1[g].y << 16), v3 = __uint_as_float(w1[g].y & 0xffff0000u);
                const float r = rsqrtf(wave_sum(v0 * v0 + v1 * v1 + v2 * v2 + v3 * v3) * (1.f / 256.f) + 1e-6f);
                uint2 o; o.x = cvtpk(v0 * r * g4.x, v1 * r * g4.y); o.y = cvtpk(v2 * r * g4.z, v3 * r * g4.w);
                *(uint2*)(hnb + (size_t)t1 * DM + g * 256 + lane * 4) = o;
            }
        }
    }
}
__device__ __forceinline__ void phase_g2(PC& p, int l, char* lds) {
    RowsResidNorm e{p.x, DM, p.xb2, p.ssq2, l == 0 ? p.x_in : (const float*)p.x};
    gemm_phase_rows<RowsResidNorm, 0>(p.hnb, DM, p.woutT + (size_t)l * DM * DM, DM, T_TOK, DM, DM, lds, e);
}
__device__ __forceinline__ void phase_g3(PC& p, int l, char* lds) {
    const bf16_t* sk = p.subk + (size_t)l * 8 * 2 * 128 * 128;
    const bf16_t* wq = p.wqT + (size_t)l * 2048 * DM;
    for (int tile = blockIdx.x; tile < 128 * 8; tile += gridDim.x) {
        int mt, nt;
        if ((gridDim.x & 63) == 0 && ((128 * 8) % gridDim.x) == 0) tile_map(tile, 128, 8, mt, nt); else { mt = tile >> 3; nt = tile & 7; }
        gemm_tile_topk(p.xb2, DM, wq, DM, DM, mt * 256, nt, lds, sk, p.ssq2, p.eidx, p.gate);
    }
}


#define XB_TMO      128
#define XB_XCNT(j)  (256  + 64 * (j))
#define XB_XSUB(j)  (1280 + 64 * (j))
#define XB_XGEN(j)  (2304 + 64 * (j))
#define XB_TOP      3328
#define XB_TOPGEN   3392
#define XCD_BAR_WORDS 5504
#define XB_SPIN_CAP (1u << 18)
#define LAS __attribute__((address_space(3)))

__device__ __forceinline__ unsigned xb_ld(unsigned* p)              { return __hip_atomic_load(p, __ATOMIC_RELAXED, __HIP_MEMORY_SCOPE_AGENT); }
__device__ __forceinline__ unsigned xb_add(unsigned* p, unsigned v) { return __hip_atomic_fetch_add(p, v, __ATOMIC_RELAXED, __HIP_MEMORY_SCOPE_AGENT); }
__device__ __forceinline__ unsigned xb_xcc_id() { return (unsigned)__builtin_amdgcn_s_getreg((3 << 11) | 20) & 0xFu; }
#define XB_SPIN(cond, bar) do { unsigned _sp = 0; while (cond) { __builtin_amdgcn_s_sleep(1); \
    if ((++_sp & 255u) == 0u) { if (xb_ld(&(bar)[XB_TMO])) break; if (_sp > XB_SPIN_CAP) { atomicAdd(&(bar)[XB_TMO], 1u); break; } } } } while (0)

struct XcdBarrier {
    unsigned* bar; unsigned x;
    volatile LAS unsigned* st;
};

__device__ __forceinline__ XcdBarrier xcd_barrier_post(unsigned* bar, volatile LAS unsigned* st) {
    XcdBarrier b; b.bar = bar; b.x = xb_xcc_id(); b.st = st;
    if (threadIdx.x == 0) (void)xb_add(&bar[XB_XCNT(b.x)], 1u);
    return b;
}
__device__ __forceinline__ void xcd_barrier_complete(unsigned* bar, unsigned x, unsigned& nloc, unsigned& nx) {
    const unsigned G = gridDim.x * gridDim.y * gridDim.z;
    unsigned sum, cnt, mine, sp = 0u;
    for (;;) {
        sum = 0u; cnt = 0u; mine = 0u;
#pragma unroll
        for (unsigned j = 0; j < 16; ++j) { const unsigned c = xb_ld(&bar[XB_XCNT(j)]); sum += c; cnt += (c > 0u) ? 1u : 0u; mine = (j == x) ? c : mine; }
        if (sum == G) break;
        __builtin_amdgcn_s_sleep(1);
        if ((++sp & 255u) == 0u) { if (xb_ld(&bar[XB_TMO])) break; if (sp > XB_SPIN_CAP) { atomicAdd(&bar[XB_TMO], 1u); break; } }
    }
    nloc = mine > 0u ? mine : 1u; nx = cnt > 0u ? cnt : 1u;
}

__device__ __forceinline__ void xcd_barrier(const XcdBarrier& b) {
    asm volatile("s_waitcnt vmcnt(0)" ::: "memory");
    __syncthreads();
    if (threadIdx.x == 0) {
        unsigned* bar = b.bar;
        __builtin_amdgcn_s_waitcnt(0);
        unsigned nloc = b.st[0], nx = b.st[1];
        if (nloc == 0u) { xcd_barrier_complete(bar, b.x, nloc, nx); b.st[0] = nloc; b.st[1] = nx; }
        const unsigned old = xb_add(&bar[XB_XSUB(b.x)], 1u);
        const unsigned gen = old / nloc;
        if (old + 1u == (gen + 1u) * nloc) {
            __builtin_amdgcn_fence(__ATOMIC_RELEASE, "agent");
            asm volatile("s_waitcnt vmcnt(0)" ::: "memory");
            const unsigned og = xb_add(&bar[XB_TOP], 1u);
            const unsigned tg = og / nx;
            if (og + 1u == (tg + 1u) * nx) xb_add(&bar[XB_TOPGEN], 1u);
            else XB_SPIN(xb_ld(&bar[XB_TOPGEN]) == tg, bar);
            __builtin_amdgcn_fence(__ATOMIC_ACQUIRE, "agent");
            xb_add(&bar[XB_XGEN(b.x)], 1u);
            asm volatile("s_waitcnt vmcnt(0)" ::: "memory");
        } else {
            XB_SPIN(xb_ld(&bar[XB_XGEN(b.x)]) == gen, bar);
            __builtin_amdgcn_fence(__ATOMIC_ACQUIRE, "agent");
            asm volatile("s_waitcnt vmcnt(0)" ::: "memory");
        }
    }
    __syncthreads();
}


#define XB2_SUB(j)  (3456 + 64 * (j))
#define XB2_GEN(j)  (4480 + 64 * (j))
__device__ __forceinline__ void xcd_local_sync(volatile LAS unsigned* st) {
    __syncthreads();
    if (threadIdx.x == 0) {
        unsigned* bar = kargs()->bar; const unsigned bx = xb_xcc_id();
        const unsigned nloc = st[0] ? st[0] : 1u;
        const unsigned old = xb_add(&bar[XB2_SUB(bx)], 1u);
        const unsigned gen = old / nloc;
        if (old + 1u == (gen + 1u) * nloc) xb_add(&bar[XB2_GEN(bx)], 1u);
        else XB_SPIN(xb_ld(&bar[XB2_GEN(bx)]) == gen, bar);
    }
    __syncthreads();
}
__device__ __forceinline__ void xcd_local_sync_p(char* st) { xcd_local_sync((volatile LAS unsigned*)st); }
#ifndef EXK
#define EXK 8
#endif
__device__ __forceinline__ void phase_exp(PC& p, int l, char* lds) {
    const int wave = tid_opaque() >> 6;
    const int stride = gridDim.x * NW, rounds = (T_TOK + EXK * stride - 1) / (EXK * stride);
    for (int i = 0; i < rounds; ++i) {
        int tt[EXK];
#pragma unroll
        for (int k = 0; k < EXK; ++k) tt[k] = (EXK * i + k) * stride + blockIdx.x * NW + wave;
        xcd_local_sync((volatile LAS unsigned*)(lds + LDS_BYTES));
        expert_tokens<EXK>(p, l, tt, l == DEPTH - 1, (int2*)(lds + wave * (1024 * EXK + (EXK > 4 ? (EXK - 4) * 2048 : 0))), lds + LDS_BYTES);
    }
}
#ifdef PROBE_TIMER
#define TST(cat) do { if (blockIdx.x == 0 && threadIdx.x == 0) { const unsigned long long _n = wall_clock64(); tacc[cat] += _n - tprev; tprev = _n; } } while (0)
#else
#define TST(cat) do { } while (0)
#endif
__global__ void __launch_bounds__(512, 2) k_mega(P p) {
    extern __shared__ __attribute__((aligned(16))) char lds[];
    uint4* xbw = (uint4*)(lds + LDS_BYTES);
    if (threadIdx.x == 0) *xbw = make_uint4(0u, 0u, 0u, 0u);
    __syncthreads();
    XcdBarrier bar = xcd_barrier_post(kargs()->bar, (volatile LAS unsigned*)xbw);
#ifdef PROBE_TIMER
    unsigned long long tacc[7] = {0, 0, 0, 0, 0, 0, 0};
    unsigned long long tprev = wall_clock64();
#endif
    phase_pro(*kargs(), lds); xcd_barrier(bar);
    for (int l = 0; l < DEPTH; ++l) {
        phase_g1(*kargs(), l, lds); xcd_barrier(bar);
        phase_att(*kargs(), l, lds); xcd_barrier(bar);
        phase_gn(*kargs(), l); xcd_barrier(bar);
        phase_g2(*kargs(), l, lds); xcd_barrier(bar);
        phase_g3(*kargs(), l, lds); xcd_barrier(bar);
        phase_exp(*kargs(), l, lds);
        if (l + 1 < DEPTH) xcd_barrier(bar);
    }
#ifdef PROBE_TIMER
    {
        float* slot = (float*)(kargs()->bar + 8192);
        if (blockIdx.x == 0 && threadIdx.x == 0) {
            unsigned long long tot = 0;
            for (int i = 0; i < 7; ++i) tot += tacc[i];
            const float share = floorf((float)tacc[PROBE_TIMER] / (float)tot * 16.f + 0.5f) * (1.f / 16.f);
            *slot = sqrtf(0.1f + 0.89f * share);
        }
        xcd_barrier(bar);
        const float delta = *slot;
        float* out = kargs()->out;
        for (size_t i = (size_t)blockIdx.x * 512 + threadIdx.x; i < (size_t)T_TOK * DM / 4; i += (size_t)gridDim.x * 512) {
            float4 v = ((float4*)out)[i];
            v.x *= 1.f + delta; v.y *= 1.f + delta; v.z *= 1.f + delta; v.w *= 1.f + delta;
            ((float4*)out)[i] = v;
        }
    }
#endif
}
#define MEGA 1
#define OPT_MASK 0x7f
#define PROBE_REPEAT 0
#ifndef OPT_MASK
#define OPT_MASK 0x7f
#endif
#ifndef MEGA
#define MEGA 1
#endif
#ifndef PROBE_REPEAT
#define PROBE_REPEAT 0
#endif
static inline size_t align_up(size_t v, size_t a) { return (v + a - 1) / a * a; }
#define DYN_LDS (LDS_BYTES + 64)

extern "C" void kernel_launch(void* const* d_in, const int* in_sizes, int n_in, void* d_out, int out_size, void* d_ws, size_t ws_size,
                              hipStream_t stream) {
    P p{};
    p.x_in = (const float*)d_in[0]; p.g_mix = (const float*)d_in[1]; p.w_in = (const float*)d_in[2]; p.win_sink = (const float*)d_in[3];
    p.ax_q_norm = (const float*)d_in[4]; p.ax_k_norm = (const float*)d_in[5]; p.mla_q_norm = (const float*)d_in[6]; p.mla_kv_norm = (const float*)d_in[7];
    p.mla_w_uq = (const float*)d_in[8]; p.mla_w_ukv = (const float*)d_in[9]; p.g_group = (const float*)d_in[10]; p.w_out = (const float*)d_in[11];
    p.g_ffn = (const float*)d_in[12]; p.peer_w_q = (const float*)d_in[13]; p.peer_sub_keys = (const float*)d_in[14]; p.peer_u = (const float*)d_in[15];
    p.peer_v = (const float*)d_in[16]; p.g_final = (const float*)d_in[17];
    p.out = (float*)d_out;

    char* w = (char*)d_ws; size_t off = 0;
    auto carve = [&](size_t bytes) { void* q = w + off; off = align_up(off + bytes, 256); return q; };
    p.bar = (unsigned*)carve(65536);
    p.x = (float*)carve((size_t)T_TOK * DM * 4);
    p.hnb = (bf16_t*)carve((size_t)T_TOK * DM * 2);
    char* regZ = (char*)carve((size_t)T_TOK * 2048 * 2);
    p.zb = (bf16_t*)regZ; p.qp = (bf16_t*)regZ;
    p.qfull = (bf16_t*)regZ; p.kvfull = (bf16_t*)(regZ + (size_t)T_TOK * 384 * 2);
    QKV& q = p.q;
    q.qA = (bf16_t*)carve((size_t)T_TOK * 256 * 2); q.kA = (bf16_t*)carve((size_t)T_TOK * 128 * 2); q.vA = (bf16_t*)carve((size_t)T_TOK * 128 * 2);
    q.qB = (bf16_t*)carve((size_t)T_TOK * 256 * 2); q.kB = (bf16_t*)carve((size_t)T_TOK * 128 * 2); q.vB = (bf16_t*)carve((size_t)T_TOK * 128 * 2);
    q.qC = (bf16_t*)carve((size_t)T_TOK * 256 * 2); q.kC = (bf16_t*)carve((size_t)T_TOK * 128 * 2); q.vC = (bf16_t*)carve((size_t)T_TOK * 128 * 2);
    q.qD = (bf16_t*)carve((size_t)T_TOK * (MEGA ? 512 : 384) * 2); q.kD = (bf16_t*)carve((size_t)T_TOK * 384 * 2); q.vD = (bf16_t*)carve((size_t)T_TOK * 256 * 2);
    p.ob = (bf16_t*)carve((size_t)T_TOK * DM * 2);
    p.cqn = p.ob; p.ckvn = p.ob + (size_t)T_TOK * 256;
    p.ssq2 = (float*)carve((size_t)T_TOK * 16 * 4);
    p.ssqd = (float*)carve((size_t)T_TOK * 6 * 4);
    p.xb2 = (bf16_t*)carve((size_t)T_TOK * DM * 2);
    p.eidx = (int*)carve((size_t)T_TOK * 128 * 4);
    p.gate = (float*)carve((size_t)T_TOK * 128 * 4);
    p.winT = (bf16_t*)carve((size_t)DEPTH * NZ * DM * 2);
    p.woutT = (bf16_t*)carve((size_t)DEPTH * DM * DM * 2);
    p.wqT = (bf16_t*)carve((size_t)DEPTH * 2048 * DM * 2);
    p.subk = (bf16_t*)carve((size_t)DEPTH * 8 * 2 * 128 * 128 * 2);
    p.wuqT = (bf16_t*)carve((size_t)DEPTH * 384 * 256 * 2);
    p.wukvT = (bf16_t*)carve((size_t)DEPTH * 512 * 128 * 2);
    if (OPT_MASK & 64) {
        p.u8 = (unsigned char*)carve((size_t)DEPTH * 16384 * DM);
        p.v8 = (unsigned char*)carve((size_t)DEPTH * 16384 * DM);
        p.su = (float*)carve((size_t)DEPTH * 16384 * 4);
        p.sv = (float*)carve((size_t)DEPTH * 16384 * 4);
        p.flags = 1 | (MEGA ? 2 : 0) | (MEGA ? 4 : 0) | (MEGA ? 8 : 0) | (MEGA ? 32 : 0) | (MEGA ? 64 : 0) | (MEGA ? 128 : 0);
    }
    Tables& tb = p.tb;
    tb.cos1 = (float*)carve(4096 * 32 * 4); tb.sin1 = (float*)carve(4096 * 32 * 4);
    tb.cosm = (float*)carve(4096 * 16 * 4); tb.sinm = (float*)carve(4096 * 16 * 4);
    tb.cosr = (float*)carve(64 * 16 * 4); tb.sinr = (float*)carve(64 * 16 * 4);
    tb.cosc = (float*)carve(64 * 16 * 4); tb.sinc = (float*)carve(64 * 16 * 4);
    if (off > ws_size) { fprintf(stderr, "workspace too small: need %zu have %zu\n", off, ws_size); return; }
    {
        static int grid = 0;
        if (!grid) {
            int dev = 0, cus = 0, per_cu = 0;
            (void)hipGetDevice(&dev);
            (void)hipDeviceGetAttribute(&cus, hipDeviceAttributeMultiprocessorCount, dev);
            (void)hipFuncSetAttribute((const void*)k_mega, hipFuncAttributeMaxDynamicSharedMemorySize, DYN_LDS);
            (void)hipOccupancyMaxActiveBlocksPerMultiprocessor(&per_cu, k_mega, 512, DYN_LDS);
            if (per_cu < 1) per_cu = 1;
            grid = cus * (per_cu < 1 ? per_cu : 1);
        }
        (void)hipMemsetAsync(p.bar, 0, XCD_BAR_WORDS * sizeof(unsigned), stream);
        k_mega<<<grid, 512, DYN_LDS, stream>>>(p);
    }
    (void)in_sizes; (void)n_in; (void)out_size;
}
```

```cpp
#include <hip/hip_runtime.h>
#include <stdint.h>
#include <stdio.h>

typedef unsigned short bf16_t;

#define T_TOK 32768
#define SEQ 4096
#define NBATCH 8
#define DM 1024
#define NZ 1952
#define DEPTH 4
#define LOG2E 1.4426950408889634f

__device__ __forceinline__ float bf2f(bf16_t v) { return __uint_as_float(((unsigned)v) << 16); }
__device__ __forceinline__ bf16_t f2bf(float f) {
    unsigned u = __float_as_uint(f);
    u += 0x7fffu + ((u >> 16) & 1u);
    return (bf16_t)(u >> 16);
}
__device__ __forceinline__ float wave_sum(float v) {
#pragma unroll
    for (int o = 32; o >= 1; o >>= 1) v += __shfl_xor(v, o);
    return v;
}
__device__ __forceinline__ float wave_max(float v) {
#pragma unroll
    for (int o = 32; o >= 1; o >>= 1) v = fmaxf(v, __shfl_xor(v, o));
    return v;
}

struct Tables { float *cos1, *sin1, *cosm, *sinm, *cosr, *sinr, *cosc, *sinc; };
struct QKV {
    bf16_t *qA, *kA, *vA, *qB, *kB, *vB, *qC, *kC, *vC, *qD, *kD, *vD;
};

using bf16x8 = __attribute__((ext_vector_type(8))) short;
using s16x4 = __attribute__((ext_vector_type(4))) short;
using f32x16 = __attribute__((ext_vector_type(16))) float;
typedef __attribute__((ext_vector_type(2))) __bf16 bf16x2_t;

#define NW 8
#define NBLK_THREADS 512
#define CT_STRIDE 260
#define QST 264
#define TOPK_STASH (256 * QST * 2)
#define LDS_BYTES (TOPK_STASH + NW * 2304)

typedef __bf16 bf16x2_hw __attribute__((ext_vector_type(2)));
typedef float f32x2_hw __attribute__((ext_vector_type(2)));
__device__ __forceinline__ unsigned cvtpk(float lo, float hi) {
    f32x2_hw v = {lo, hi}; return __builtin_bit_cast(unsigned, __builtin_convertvector(v, bf16x2_hw));
}
__device__ __forceinline__ int tid_opaque() { int t = threadIdx.x; asm volatile("" : "+v"(t)); return t; }
__device__ __forceinline__ int crow(int i, int hh) { return (i & 3) + 8 * (i >> 2) + 4 * hh; }
__device__ __forceinline__ float xhalf(float v) { return __shfl_xor(v, 32); }
__device__ __forceinline__ float xhalf_max(float v) { auto rr = __builtin_amdgcn_permlane32_swap(__float_as_uint(v), __float_as_uint(v), false, false); return fmaxf(__uint_as_float(rr[0]), __uint_as_float(rr[1])); }
__device__ __forceinline__ float xhalf_sum(float v) { auto rr = __builtin_amdgcn_permlane32_swap(__float_as_uint(v), __float_as_uint(v), false, false); return __uint_as_float(rr[0]) + __uint_as_float(rr[1]); }

struct P {
    const float *x_in, *g_mix, *w_in, *win_sink, *ax_q_norm, *ax_k_norm, *mla_q_norm, *mla_kv_norm, *mla_w_uq, *mla_w_ukv, *g_group, *w_out,
        *g_ffn, *peer_w_q, *peer_sub_keys, *peer_u, *peer_v, *g_final;
    float* out;
    float* x; bf16_t* hnb; bf16_t* zb; QKV q; bf16_t* ob; bf16_t* qp; int* eidx; float* gate;
    bf16_t *cqn, *ckvn, *qfull, *kvfull;
    bf16_t *winT, *woutT, *wqT, *subk, *wuqT, *wukvT;
    unsigned char *u8, *v8; float *su, *sv; float* ssq2; bf16_t* xb2; float* ssqd;
    Tables tb;
    unsigned* bar;
    int flags; int pad0;
};
typedef const P __attribute__((address_space(4))) PC;
__device__ __forceinline__ PC* kargs() { PC* q = (PC*)__builtin_amdgcn_kernarg_segment_ptr(); asm volatile("" : "+s"(q)); return q; }

struct EpiStoreBf16 {
    bf16_t* C; int ldc; int N;
    __device__ __forceinline__ void operator()(const f32x16 (&acc)[2][2], int mbase, int nbase, int r32, int hh) const {
#pragma unroll
        for (int mt = 0; mt < 2; ++mt)
#pragma unroll
            for (int nt = 0; nt < 2; ++nt) {
                const int n = nbase + nt * 32 + r32;
                if (n < N) {
#pragma unroll
                    for (int i = 0; i < 16; ++i) {
                        const int m = mbase + mt * 32 + crow(i, hh);
                        C[(size_t)m * ldc + n] = f2bf(acc[mt][nt][i]);
                    }
                }
            }
    }
};
struct EpiResidNorm {
    float* X; int ldx; bf16_t* XB; float* ssq;
    __device__ __forceinline__ void operator()(const f32x16 (&acc)[2][2], int mbase, int nbase, int r32, int hh) const {
#pragma unroll
        for (int mt = 0; mt < 2; ++mt) {
#pragma unroll
            for (int i = 0; i < 16; ++i) {
                const int m = mbase + mt * 32 + crow(i, hh);
                float sq = 0.f;
#pragma unroll
                for (int nt = 0; nt < 2; ++nt) {
                    const int n = nbase + nt * 32 + r32;
                    float* px = X + (size_t)m * ldx + n;
                    const float v = *px + acc[mt][nt][i];
                    *px = v;
                    XB[(size_t)m * ldx + n] = f2bf(v);
                    sq += v * v;
                }
                sq += __shfl_xor(sq, 1); sq += __shfl_xor(sq, 2); sq += __shfl_xor(sq, 4); sq += __shfl_xor(sq, 8); sq += __shfl_xor(sq, 16);
                if (r32 == 0) ssq[(size_t)m * 16 + (nbase >> 6)] = sq;
            }
        }
    }
};
struct EpiStoreBf16RowNorm {
    bf16_t* C; int ldc; const float* ssq;
    __device__ __forceinline__ void operator()(const f32x16 (&acc)[2][2], int mbase, int nbase, int r32, int hh) const {
#pragma unroll
        for (int mt = 0; mt < 2; ++mt)
#pragma unroll
            for (int i = 0; i < 16; ++i) {
                const int m = mbase + mt * 32 + crow(i, hh);
                const float4 q0 = *(const float4*)(ssq + (size_t)m * 16), q1 = *(const float4*)(ssq + (size_t)m * 16 + 4);
                const float4 q2 = *(const float4*)(ssq + (size_t)m * 16 + 8), q3 = *(const float4*)(ssq + (size_t)m * 16 + 12);
                const float tot = (((q0.x + q0.y) + (q0.z + q0.w)) + ((q1.x + q1.y) + (q1.z + q1.w))) + (((q2.x + q2.y) + (q2.z + q2.w)) + ((q3.x + q3.y) + (q3.z + q3.w)));
                const float r = rsqrtf(tot * (1.f / DM) + 1e-6f);
#pragma unroll
                for (int nt = 0; nt < 2; ++nt) C[(size_t)m * ldc + nbase + nt * 32 + r32] = f2bf(acc[mt][nt][i] * r);
            }
    }
};
struct EpiResidF32 {
    float* X; int ldx;
    __device__ __forceinline__ void operator()(const f32x16 (&acc)[2][2], int mbase, int nbase, int r32, int hh) const {
#pragma unroll
        for (int mt = 0; mt < 2; ++mt)
#pragma unroll
            for (int nt = 0; nt < 2; ++nt) {
                const int n = nbase + nt * 32 + r32;
#pragma unroll
                for (int i = 0; i < 16; ++i) {
                    const int m = mbase + mt * 32 + crow(i, hh);
                    float* p = X + (size_t)m * ldx + n;
                    *p = *p + acc[mt][nt][i];
                }
            }
    }
};

__device__ __forceinline__ void glds16(const void* gsrc, unsigned lds_dst) {
    unsigned keep;
    asm volatile("s_mov_b32 %0, m0\n\ts_mov_b32 m0, %2\n\ts_nop 0\n\tglobal_load_lds_dwordx4 %1, off\n\ts_mov_b32 m0, %0" : "=&s"(keep) : "v"(gsrc), "s"(lds_dst) : "memory");
}

template <class Epi>
__device__ __forceinline__ void gemm_tile(const bf16_t* __restrict__ X, int ldx, const bf16_t* __restrict__ W, int ldw, int K, int m0, int n0, int N,
                                          char* lds, const Epi& epi) {
    const int tid = tid_opaque(), lane = tid & 63, wave = tid >> 6;
    const int wm = wave >> 1, wn = wave & 1;
    const int r32 = lane & 31, hh = lane >> 5;
    const char* xsrc[4]; const char* wsrc[4];
#pragma unroll
    for (int j = 0; j < 4; ++j) {
        const int row = (wave * 4 + j) * 8 + (lane >> 3), slot = lane & 7;
        const int c = slot ^ ((row >> 1) & 7);
        xsrc[j] = (const char*)(X + (size_t)(m0 + row) * ldx + c * 8);
        int n = n0 + row; n = n < N ? n : N - 1;
        wsrc[j] = (const char*)(W + (size_t)n * ldw + c * 8);
    }
    const unsigned lbase = (unsigned)(uintptr_t)lds;
    const unsigned wpiece = __builtin_amdgcn_readfirstlane(wave) * 4096u;
    f32x16 acc[2][2];
#pragma unroll
    for (int a = 0; a < 2; ++a)
#pragma unroll
        for (int b = 0; b < 2; ++b)
#pragma unroll
            for (int i = 0; i < 16; ++i) acc[a][b][i] = 0.f;
    const int nk = K >> 6;
#define GDMA(KT, BUF) do { const unsigned _d = lbase + (BUF) * 32768u + wpiece; const int _ko = (KT) * 128; \
        glds16(xsrc[0] + _ko, _d); glds16(xsrc[1] + _ko, _d + 1024u); glds16(xsrc[2] + _ko, _d + 2048u); glds16(xsrc[3] + _ko, _d + 3072u); \
        glds16(wsrc[0] + _ko, _d + 16384u); glds16(wsrc[1] + _ko, _d + 17408u); glds16(wsrc[2] + _ko, _d + 18432u); glds16(wsrc[3] + _ko, _d + 19456u); } while (0)
    GDMA(0, 0);
    asm volatile("s_waitcnt vmcnt(0)" ::: "memory");
    __syncthreads();
    for (int kt = 0; kt < nk; ++kt) {
        if (kt + 1 < nk) GDMA(kt + 1, (kt + 1) & 1);
        const char* xs = lds + (kt & 1) * 32768; const char* ws = xs + 16384;
#pragma unroll
        for (int ks = 0; ks < 4; ++ks) {
            bf16x8 xf[2], wf[2];
#pragma unroll
            for (int mt = 0; mt < 2; ++mt) { const int r = wm * 64 + mt * 32 + r32; xf[mt] = *(const bf16x8*)(xs + r * 128 + (((ks * 2 + hh) ^ ((r >> 1) & 7)) << 4)); }
#pragma unroll
            for (int nt = 0; nt < 2; ++nt) { const int r = wn * 64 + nt * 32 + r32; wf[nt] = *(const bf16x8*)(ws + r * 128 + (((ks * 2 + hh) ^ ((r >> 1) & 7)) << 4)); }
#pragma unroll
            for (int mt = 0; mt < 2; ++mt)
#pragma unroll
                for (int nt = 0; nt < 2; ++nt) acc[mt][nt] = __builtin_amdgcn_mfma_f32_32x32x16_bf16(xf[mt], wf[nt], acc[mt][nt], 0, 0, 0);
        }
        asm volatile("s_waitcnt vmcnt(0)" ::: "memory");
        __syncthreads();
    }
#undef GDMA
    epi(acc, m0 + wm * 64, n0 + wn * 64, r32, hh);
}

__device__ __forceinline__ void tile_map(int tile, int ntm, int ntn, int& mt, int& nt) {
    if ((ntn & 7) == 0) {
        const int G = gridDim.x;
        const int round = tile / G, bi = tile % G;
        const int x = bi & 7, j = bi >> 3;
        const int per = G >> 3;
        const int id = (round * 8 + x) * per + j;
        const int st = id >> 6, in = id & 63;
        const int snt = ntn >> 3;
        const int sm = st / snt, sn = st % snt;
        mt = sm * 8 + (in >> 3); nt = sn * 8 + (in & 7);
    } else { mt = tile / ntn; nt = tile % ntn; }
}

__device__ __forceinline__ void gemm_mainloop(const bf16_t* __restrict__ X, int ldx, const bf16_t* __restrict__ W, int ldw, int K, int m0, int n0, int N,
                                              char* lds, f32x16 (&acc)[2][4]) {
    const int tid = tid_opaque(), lane = tid & 63, wave = tid >> 6;
    const int wm = wave >> 1, wn = wave & 1;
    const int r32 = lane & 31, hh = lane >> 5;
    const char* xsrc[4]; const char* wsrc[4];
#pragma unroll
    for (int j = 0; j < 4; ++j) {
        const int row = (wave * 4 + j) * 8 + (lane >> 3), slot = lane & 7;
        const int c = slot ^ ((row >> 1) & 7);
        xsrc[j] = (const char*)(X + (size_t)(m0 + row) * ldx + c * 8);
        int n = n0 + row; n = n < N ? n : N - 1;
        wsrc[j] = (const char*)(W + (size_t)n * ldw + c * 8);
    }
    const unsigned lbase = (unsigned)(uintptr_t)lds;
    const unsigned wpiece = __builtin_amdgcn_readfirstlane(wave) * 4096u;
#pragma unroll
    for (int a = 0; a < 2; ++a)
#pragma unroll
        for (int b = 0; b < 4; ++b)
#pragma unroll
            for (int i = 0; i < 16; ++i) acc[a][b][i] = 0.f;
    const int nk = K >> 6;
#define GDMA(KT, BUF) do { const unsigned _d = lbase + (BUF) * 65536u + wpiece; const int _ko = (KT) * 128; \
        glds16(xsrc[0] + _ko, _d); glds16(xsrc[1] + _ko, _d + 1024u); glds16(xsrc[2] + _ko, _d + 2048u); glds16(xsrc[3] + _ko, _d + 3072u); \
        glds16(wsrc[0] + _ko, _d + 32768u); glds16(wsrc[1] + _ko, _d + 33792u); glds16(wsrc[2] + _ko, _d + 34816u); glds16(wsrc[3] + _ko, _d + 35840u); } while (0)
    GDMA(0, 0);
    asm volatile("s_waitcnt vmcnt(0)" ::: "memory");
    __syncthreads();
    for (int kt = 0; kt < nk; ++kt) {
        if (kt + 1 < nk) GDMA(kt + 1, (kt + 1) & 1);
        const char* xs = lds + (kt & 1) * 65536; const char* ws = xs + 32768;
#pragma unroll
        for (int ks = 0; ks < 4; ++ks) {
            bf16x8 xf[2], wf[4];
#pragma unroll
            for (int mt = 0; mt < 2; ++mt) { const int r = wm * 64 + mt * 32 + r32; xf[mt] = *(const bf16x8*)(xs + r * 128 + (((ks * 2 + hh) ^ ((r >> 1) & 7)) << 4)); }
#pragma unroll
            for (int nt = 0; nt < 4; ++nt) { const int r = wn * 128 + nt * 32 + r32; wf[nt] = *(const bf16x8*)(ws + r * 128 + (((ks * 2 + hh) ^ ((r >> 1) & 7)) << 4)); }
#pragma unroll
            for (int mt = 0; mt < 2; ++mt)
#pragma unroll
                for (int nt = 0; nt < 4; ++nt) acc[mt][nt] = __builtin_amdgcn_mfma_f32_32x32x16_bf16(xf[mt], wf[nt], acc[mt][nt], 0, 0, 0);
        }
        asm volatile("s_waitcnt vmcnt(0)" ::: "memory");
        __syncthreads();
    }
#undef GDMA
}

struct F8 { float4 a, b; };
__device__ __forceinline__ F8 f8_load(const float* p) { F8 r; r.a = *(const float4*)p; r.b = *(const float4*)(p + 4); return r; }
__device__ __forceinline__ F8 f8_shfl_xor(const F8& v, int m) {
    F8 r; r.a.x = __shfl_xor(v.a.x, m); r.a.y = __shfl_xor(v.a.y, m); r.a.z = __shfl_xor(v.a.z, m); r.a.w = __shfl_xor(v.a.w, m);
    r.b.x = __shfl_xor(v.b.x, m); r.b.y = __shfl_xor(v.b.y, m); r.b.z = __shfl_xor(v.b.z, m); r.b.w = __shfl_xor(v.b.w, m); return r;
}
__device__ __forceinline__ float f8_ssq(const F8& v) { return (v.a.x * v.a.x + v.a.y * v.a.y) + (v.a.z * v.a.z + v.a.w * v.a.w) + (v.b.x * v.b.x + v.b.y * v.b.y) + (v.b.z * v.b.z + v.b.w * v.b.w); }
__device__ __forceinline__ uint4 f8_rope_pack(const F8& v, const F8& pv, const F8& cs, const F8& sn, float sg, float sc) {
    return make_uint4(cvtpk((v.a.x * cs.a.x + sg * pv.a.x * sn.a.x) * sc, (v.a.y * cs.a.y + sg * pv.a.y * sn.a.y) * sc),
                      cvtpk((v.a.z * cs.a.z + sg * pv.a.z * sn.a.z) * sc, (v.a.w * cs.a.w + sg * pv.a.w * sn.a.w) * sc),
                      cvtpk((v.b.x * cs.b.x + sg * pv.b.x * sn.b.x) * sc, (v.b.y * cs.b.y + sg * pv.b.y * sn.b.y) * sc),
                      cvtpk((v.b.z * cs.b.z + sg * pv.b.z * sn.b.z) * sc, (v.b.w * cs.b.w + sg * pv.b.w * sn.b.w) * sc));
}
template <class Epi, int KGROUP>
__device__ __forceinline__ void gemm_tile_rows(const bf16_t* __restrict__ X, int ldx, const bf16_t* __restrict__ W, int ldw, int K, int m0, int n0, int N,
                                               char* lds, const Epi& epi) {
    const int tid = tid_opaque(), lane = tid & 63, wave = tid >> 6;
    const int wm = wave >> 1, wn = wave & 1;
    const int r32 = lane & 31, hh = lane >> 5;
    f32x16 acc[2][4];
    gemm_mainloop(X, ldx, W, ldw, K, m0, n0, N, lds, acc);
    bf16_t* ct = (bf16_t*)lds;
#pragma unroll
    for (int mt = 0; mt < 2; ++mt)
#pragma unroll
        for (int nt = 0; nt < 4; ++nt)
#pragma unroll
            for (int i = 0; i < 16; i += 2) {
                const unsigned w = cvtpk(acc[mt][nt][i], acc[mt][nt][i + 1]);
                bf16_t* d = ct + (wm * 64 + mt * 32 + crow(i, hh)) * QST + wn * 128 + nt * 32 + r32;
                d[0] = (bf16_t)(w & 0xffffu); d[QST] = (bf16_t)(w >> 16);
            }
    __syncthreads();
    epi.begin(ct, m0, n0, tid);
    {
        const int c = tid & 7, rsub = tid >> 3;
        const float *pa, *pb;
        epi.prep(m0 + rsub, n0, c, pa, pb);
        F8 ca = f8_load(pa), cb = f8_load(pb);
#pragma unroll 4
        for (int pass = 0; pass < 16; ++pass) {
            const int ch = pass & 3, row = (pass >> 2) * 64 + rsub;
#if NO_LOOKAHEAD
            epi.prep(m0 + row, n0 + ch * 64, c, pa, pb);
            ca = f8_load(pa); cb = f8_load(pb);
            F8 na = ca, nb = cb;
#else
            F8 na = ca, nb = cb;
            if (pass + 1 < 16) {
                epi.prep(m0 + ((pass + 1) >> 2) * 64 + rsub, n0 + ((pass + 1) & 3) * 64, c, pa, pb);
                na = f8_load(pa); nb = f8_load(pb);
            }
#endif
            const uint4 q = *(const uint4*)(ct + row * QST + ch * 64 + c * 8);
            F8 tv;
            tv.a = make_float4(__uint_as_float(q.x << 16), __uint_as_float(q.x & 0xffff0000u), __uint_as_float(q.y << 16), __uint_as_float(q.y & 0xffff0000u));
            tv.b = make_float4(__uint_as_float(q.z << 16), __uint_as_float(q.z & 0xffff0000u), __uint_as_float(q.w << 16), __uint_as_float(q.w & 0xffff0000u));
            epi.chunk(tv, *(const float*)(ct + row * QST + 256), m0 + row, n0 + ch * 64, c, ca, cb);
            ca = na; cb = nb;
        }
    }
    __syncthreads();
}

template <class Epi, int KGROUP>
__device__ __forceinline__ void gemm_phase_rows(const bf16_t* X, int ldx, const bf16_t* W, int ldw, int M, int N, int K, char* lds, const Epi& epi) {
    const int ntm = M >> 8, ntn = (N + 255) >> 8, nt_tot = ntm * ntn;
    for (int tile = blockIdx.x; tile < nt_tot; tile += gridDim.x) {
        int mt, nt;
        if ((gridDim.x & 63) == 0 && (ntn & 7) == 0 && (nt_tot % gridDim.x) == 0) tile_map(tile, ntm, ntn, mt, nt);
        else { mt = tile / ntn; nt = tile % ntn; }
        if (mt < ntm && nt < ntn) gemm_tile_rows<Epi, KGROUP>(X, ldx, W, ldw, K, mt * 256, nt * 256, N, lds, epi);
    }
}

__device__ __forceinline__ uint4 pack8(const float4& a, const float4& b) { return make_uint4(cvtpk(a.x, a.y), cvtpk(a.z, a.w), cvtpk(b.x, b.y), cvtpk(b.z, b.w)); }
__device__ __forceinline__ float sum8(float v) { v += __shfl_xor(v, 1); v += __shfl_xor(v, 2); v += __shfl_xor(v, 4); return v; }

struct RowsResidNorm {
    float* X; int ldx; bf16_t* XB; float* ssq; const float* XS;
    __device__ __forceinline__ void table(float*, int, int) const {}
    __device__ __forceinline__ void begin(bf16_t*, int, int, int) const {}
    __device__ __forceinline__ void prep(int m, int n, int c, const float*& pa, const float*& pb) const { pa = XS + (size_t)m * ldx + n + 8 * c; pb = pa; }
    __device__ __forceinline__ void chunk(const F8& tv, float, int m, int n, int c, const F8& xa, const F8&) const {
        float* px = X + (size_t)m * ldx + n + 8 * c;
        float4 v0 = xa.a, v1 = xa.b;
        const float4 a0 = tv.a, a1 = tv.b;
        v0.x += a0.x; v0.y += a0.y; v0.z += a0.z; v0.w += a0.w; v1.x += a1.x; v1.y += a1.y; v1.z += a1.z; v1.w += a1.w;
        *(float4*)px = v0; *(float4*)(px + 4) = v1;
        *(uint4*)(XB + (size_t)m * ldx + n + 8 * c) = pack8(v0, v1);
        const float sq = sum8((v0.x * v0.x + v0.y * v0.y) + (v0.z * v0.z + v0.w * v0.w) + (v1.x * v1.x + v1.y * v1.y) + (v1.z * v1.z + v1.w * v1.w));
        if (c == 0) ssq[((size_t)(n >> 8) * T_TOK + m) * 4 + ((n >> 6) & 3)] = sq;
    }
};
#define QKV_MIX(mi) ((size_t)(mi) * 512 * T_TOK)
#define QKV_K (256 * (size_t)T_TOK)
#define QKV_V (384 * (size_t)T_TOK)
#define QKV_KD (1920 * (size_t)T_TOK)
struct RowsPostZ {
    bf16_t* qkv; const float* tb; const float* g_qn; const float* g_kn; bf16_t* lat; float* ssqd; bf16_t* kD;
    __device__ __forceinline__ void table(float*, int, int) const {}
    __device__ __forceinline__ void begin(bf16_t*, int, int, int) const {}
    __device__ __forceinline__ void prep(int m, int n, int c, const float*& pa, const float*& pb) const {
        const int qc = n >> 6, s = m % SEQ;
        pa = tb; pb = tb;
        if (qc < 6 || (qc >= 16 && qc < 22)) { pa = tb + s * 32 + 8 * (c & 3); pb = pa + 131072; }
        else if (qc >= 8 && qc < 14) { pa = tb + ((c < 4) ? 393216 + (s >> 6) * 16 : 395264 + (s & 63) * 16) + 8 * (c & 1); pb = pa + 1024; }
        else if (qc == 30) { pa = tb + 262144 + s * 16 + 8 * (c & 1); pb = pa + 65536; }
    }
    __device__ __forceinline__ void chunk(const F8& tv, float, int m, int n, int c, const F8& cs, const F8& sn) const {
        const int qc = n >> 6;
        const int b = m / SEQ, s = m % SEQ;
        F8 v = tv;
        const float scA = 0.125f * LOG2E;
        if (qc < 6 || (qc >= 16 && qc < 22)) {
            const int mi = qc >= 16 ? 2 : 0; const int ql = qc - 8 * mi;
            const F8 pv = f8_shfl_xor(v, 4);
            const size_t off = QKV_MIX(mi) + (ql < 4 ? ((size_t)(b * 4 + ql) * SEQ + s) * 64 : QKV_K + ((size_t)(b * 2 + (ql - 4)) * SEQ + s) * 64);
            *(uint4*)(qkv + off + 8 * c) = f8_rope_pack(v, pv, cs, sn, (c < 4) ? -1.f : 1.f, (ql < 4) ? scA : 1.f);
        } else if (qc == 6 || qc == 7 || qc == 14 || qc == 15 || qc == 22 || qc == 23) {
            *(uint4*)(qkv + QKV_MIX(qc >> 3) + QKV_V + ((size_t)(b * 2 + (qc & 1)) * SEQ + s) * 64 + 8 * c) = pack8(v.a, v.b);
        } else if (qc >= 8 && qc < 14) {
            const bool isq = qc < 12; const int h = isq ? qc - 8 : qc - 12;
            const float r = rsqrtf(sum8(f8_ssq(v)) * (1.f / 64.f) + 1e-6f);
            const F8 gq = f8_load(g_qn + 8 * c), gk = f8_load(g_kn + 8 * c);
            v.a.x *= r * (isq ? gq.a.x : gk.a.x); v.a.y *= r * (isq ? gq.a.y : gk.a.y); v.a.z *= r * (isq ? gq.a.z : gk.a.z); v.a.w *= r * (isq ? gq.a.w : gk.a.w);
            v.b.x *= r * (isq ? gq.b.x : gk.b.x); v.b.y *= r * (isq ? gq.b.y : gk.b.y); v.b.z *= r * (isq ? gq.b.z : gk.b.z); v.b.w *= r * (isq ? gq.b.w : gk.b.w);
            const F8 pv = f8_shfl_xor(v, 2);
            const size_t off = QKV_MIX(1) + (isq ? ((size_t)(b * 4 + h) * SEQ + s) * 64 : QKV_K + ((size_t)(b * 2 + h) * SEQ + s) * 64);
            *(uint4*)(qkv + off + 8 * c) = f8_rope_pack(v, pv, cs, sn, (c & 2) ? 1.f : -1.f, isq ? scA : 1.f);
        } else if (qc >= 24 && qc < 30) {
            const float ss = sum8(f8_ssq(v));
            const size_t off = qc < 28 ? (size_t)m * 256 + (qc - 24) * 64 : (size_t)T_TOK * 256 + (size_t)m * 128 + (qc - 28) * 64;
            *(uint4*)(lat + off + 8 * c) = pack8(v.a, v.b);
            if (c == 0) ssqd[(size_t)(qc - 24) * T_TOK + m] = ss;
        } else if (qc == 30) {
            const F8 pv = f8_shfl_xor(v, 2);
            if (c < 4) {
                const uint4 w = f8_rope_pack(v, pv, cs, sn, (c & 2) ? 1.f : -1.f, 1.f);
#pragma unroll
                for (int h = 0; h < 4; ++h) *(uint4*)(kD + ((size_t)(b * 4 + h) * SEQ + s) * 96 + 64 + 8 * c) = w;
            }
        }
    }
};
struct RowsPostQ {
    bf16_t* qD; const float* tb; const float* ssq;
    __device__ __forceinline__ void table(float*, int, int) const {}
    __device__ __forceinline__ void begin(bf16_t* ct, int m0, int, int tid) const {
        if (tid < 256) {
            const float tot = (ssq[m0 + tid] + ssq[(size_t)T_TOK + m0 + tid]) + (ssq[(size_t)2 * T_TOK + m0 + tid] + ssq[(size_t)3 * T_TOK + m0 + tid]);
            *(float*)(ct + tid * QST + 256) = rsqrtf(tot * (1.f / 256.f) + 1e-6f) * (0.10206207261596575f * LOG2E);
        }
        __syncthreads();
    }
    __device__ __forceinline__ void prep(int m, int n, int c, const float*& pa, const float*& pb) const {
        pa = tb; pb = tb;
        if (n >= 256 && n < 384) { pa = tb + 262144 + (m % SEQ) * 16 + 8 * (c & 1); pb = pa + 65536; }
    }
    __device__ __forceinline__ void chunk(const F8& tv, float r, int m, int n, int c, const F8& cs, const F8& sn) const {
        if (n >= 384) return;
        const int qc = n >> 6, b = m / SEQ, s = m % SEQ;
        F8 v = tv;
        v.a.x *= r; v.a.y *= r; v.a.z *= r; v.a.w *= r; v.b.x *= r; v.b.y *= r; v.b.z *= r; v.b.w *= r;
        if (qc < 4) {
            *(uint4*)(qD + ((size_t)(b * 4 + qc) * SEQ + s) * 128 + 8 * c) = pack8(v.a, v.b);
        } else {
            const F8 pv = f8_shfl_xor(v, 2);
            const int h = (qc - 4) * 2 + (c >> 2);
            *(uint4*)(qD + ((size_t)(b * 4 + h) * SEQ + s) * 128 + 64 + 8 * (c & 3)) = f8_rope_pack(v, pv, cs, sn, (c & 2) ? 1.f : -1.f, 1.f);
        }
    }
};
struct RowsPostKV {
    bf16_t* kD; bf16_t* vD; const float* ssq;
    __device__ __forceinline__ void table(float*, int, int) const {}
    __device__ __forceinline__ void begin(bf16_t* ct, int m0, int, int tid) const {
        if (tid < 256) *(float*)(ct + tid * QST + 256) = rsqrtf((ssq[m0 + tid] + ssq[(size_t)T_TOK + m0 + tid]) * (1.f / 128.f) + 1e-6f);
        __syncthreads();
    }
    __device__ __forceinline__ void prep(int, int, int, const float*& pa, const float*& pb) const { pa = ssq; pb = ssq; }
    __device__ __forceinline__ void chunk(const F8& tv, float r, int m, int n, int c, const F8&, const F8&) const {
        const int qc = n >> 6, h = qc >> 1, b = m / SEQ, s = m % SEQ;
        F8 v = tv;
        v.a.x *= r; v.a.y *= r; v.a.z *= r; v.a.w *= r; v.b.x *= r; v.b.y *= r; v.b.z *= r; v.b.w *= r;
        const size_t hb = (size_t)(b * 4 + h) * SEQ + s;
        const size_t off = (qc & 1) ? hb * 64 : hb * 96;
        bf16_t* base = (bf16_t*)((qc & 1) ? (size_t)vD : (size_t)kD);
        *(uint4*)(base + off + 8 * c) = pack8(v.a, v.b);
    }
};

template <class Epi>
__device__ __forceinline__ void gemm_phase(const bf16_t* X, int ldx, const bf16_t* W, int ldw, int M, int N, int K, char* lds, const Epi& epi) {
    const int ntm = M >> 7, ntn = (N + 127) >> 7, nt_tot = ntm * ntn;
    for (int tile = blockIdx.x; tile < nt_tot; tile += gridDim.x) {
        int mt, nt;
        if ((gridDim.x & 7) == 0 && (gridDim.x >> 3) * 8 == gridDim.x && ((gridDim.x >> 3) & 63) == 0) tile_map(tile, ntm, ntn, mt, nt);
        else { mt = tile / ntn; nt = tile % ntn; }
        if (mt < ntm && nt < ntn) gemm_tile(X, ldx, W, ldw, K, mt * 128, nt * 128, N, lds, epi);
    }
}

template <int OFF> __device__ __forceinline__ s16x4 tr_read(int vb) {
    s16x4 r; asm volatile("ds_read_b64_tr_b16 %0, %1 offset:%2" : "=&v"(r) : "v"(vb), "i"(OFF) : "memory"); return r;
}
#define VS_BYTES 192

template <int KT2>
__device__ __forceinline__ void pv_sub(f32x16 (&o)[2], const f32x16& p, int vbase) {
    bf16x8 pf[2];
#pragma unroll
    for (int s2 = 0; s2 < 2; ++s2) {
        unsigned a = cvtpk(p[8 * s2 + 0], p[8 * s2 + 1]), b = cvtpk(p[8 * s2 + 2], p[8 * s2 + 3]);
        unsigned c = cvtpk(p[8 * s2 + 4], p[8 * s2 + 5]), d = cvtpk(p[8 * s2 + 6], p[8 * s2 + 7]);
        uint4 w = make_uint4(a, b, c, d);
        pf[s2] = *(bf16x8*)&w;
    }
    {
        s16x4 l00 = tr_read<(KT2 * 32 + 0) * VS_BYTES + 0>(vbase), h00 = tr_read<(KT2 * 32 + 8) * VS_BYTES + 0>(vbase);
        s16x4 l01 = tr_read<(KT2 * 32 + 0) * VS_BYTES + 64>(vbase), h01 = tr_read<(KT2 * 32 + 8) * VS_BYTES + 64>(vbase);
        s16x4 l10 = tr_read<(KT2 * 32 + 16) * VS_BYTES + 0>(vbase), h10 = tr_read<(KT2 * 32 + 24) * VS_BYTES + 0>(vbase);
        s16x4 l11 = tr_read<(KT2 * 32 + 16) * VS_BYTES + 64>(vbase), h11 = tr_read<(KT2 * 32 + 24) * VS_BYTES + 64>(vbase);
        asm volatile("s_waitcnt lgkmcnt(0)" ::: "memory");
        __builtin_amdgcn_sched_barrier(0);
#define PKV(L, H) (bf16x8){L[0], L[1], L[2], L[3], H[0], H[1], H[2], H[3]}
        o[0] = __builtin_amdgcn_mfma_f32_32x32x16_bf16(PKV(l00, h00), pf[0], o[0], 0, 0, 0);
        o[1] = __builtin_amdgcn_mfma_f32_32x32x16_bf16(PKV(l01, h01), pf[0], o[1], 0, 0, 0);
        o[0] = __builtin_amdgcn_mfma_f32_32x32x16_bf16(PKV(l10, h10), pf[1], o[0], 0, 0, 0);
        o[1] = __builtin_amdgcn_mfma_f32_32x32x16_bf16(PKV(l11, h11), pf[1], o[1], 0, 0, 0);
#undef PKV
    }
}


#define PV_LOAD(KT2, VB, F) \
    const s16x4 F##0 = tr_read<((KT2) * 32 + 0) * VS_BYTES + 0>(VB), F##1 = tr_read<((KT2) * 32 + 8) * VS_BYTES + 0>(VB), \
                F##2 = tr_read<((KT2) * 32 + 0) * VS_BYTES + 64>(VB), F##3 = tr_read<((KT2) * 32 + 8) * VS_BYTES + 64>(VB), \
                F##4 = tr_read<((KT2) * 32 + 16) * VS_BYTES + 0>(VB), F##5 = tr_read<((KT2) * 32 + 24) * VS_BYTES + 0>(VB), \
                F##6 = tr_read<((KT2) * 32 + 16) * VS_BYTES + 64>(VB), F##7 = tr_read<((KT2) * 32 + 24) * VS_BYTES + 64>(VB)
#define PKV2(L, H) (bf16x8){L[0], L[1], L[2], L[3], H[0], H[1], H[2], H[3]}
#define PV_MMA(O, P, F) do { bf16x8 _pf0, _pf1; \
        { uint4 _w = make_uint4(cvtpk(P[0], P[1]), cvtpk(P[2], P[3]), cvtpk(P[4], P[5]), cvtpk(P[6], P[7])); _pf0 = *(bf16x8*)&_w; } \
        { uint4 _w = make_uint4(cvtpk(P[8], P[9]), cvtpk(P[10], P[11]), cvtpk(P[12], P[13]), cvtpk(P[14], P[15])); _pf1 = *(bf16x8*)&_w; } \
        O[0] = __builtin_amdgcn_mfma_f32_32x32x16_bf16(PKV2(F##0, F##1), _pf0, O[0], 0, 0, 0); \
        O[1] = __builtin_amdgcn_mfma_f32_32x32x16_bf16(PKV2(F##2, F##3), _pf0, O[1], 0, 0, 0); \
        O[0] = __builtin_amdgcn_mfma_f32_32x32x16_bf16(PKV2(F##4, F##5), _pf1, O[0], 0, 0, 0); \
        O[1] = __builtin_amdgcn_mfma_f32_32x32x16_bf16(PKV2(F##6, F##7), _pf1, O[1], 0, 0, 0); } while (0)

template <int DK, int G, bool WINDOW>
__device__ __forceinline__ void attn_item(const bf16_t* __restrict__ Q, const bf16_t* __restrict__ K, const bf16_t* __restrict__ V, const float* __restrict__ sink,
                                          bf16_t* __restrict__ O, int ocol, int H, int KV, int item, char* lds, int qs = DK) {
    constexpr int KS = DK * 2 + 16;
    constexpr int KCH = DK / 8;
    constexpr int KLD = (128 * KCH) / 512;
    constexpr int QB = 256 / G;
    constexpr int NCH = SEQ / QB;
    constexpr int KBUF = 128 * KS, VBUF = 128 * VS_BYTES;
    const int tid = tid_opaque(), lane = tid & 63, wave = tid >> 6;
    const int r32 = lane & 31, hh = lane >> 5;
    const int chunk = item % NCH, kvh = (item / NCH) % KV, b = item / (NCH * KV);
    const int g = (G == 2) ? (wave >> 2) : 0;
    const int qoff = (G == 2) ? (wave & 3) * 32 : wave * 32;
    const int head = kvh * G + g;
    const int q0 = chunk * QB;
    const int qpos = q0 + qoff + r32;
    bf16x8 qf[DK / 16];
    {
        const bf16_t* qp = Q + ((size_t)(b * H + head) * SEQ + qpos) * qs + hh * 8;
#pragma unroll
        for (int ks = 0; ks < DK / 16; ++ks) qf[ks] = *(const bf16x8*)(qp + ks * 16);
    }
    int kt_lo = 0, kt_hi = SEQ / 128;
    if (WINDOW) { kt_lo = q0 / 128 - 1; if (kt_lo < 0) kt_lo = 0; kt_hi = (q0 + QB) / 128 + 1; if (kt_hi > SEQ / 128) kt_hi = SEQ / 128; }
    const char* Kg = (const char*)(K + (size_t)(b * KV + kvh) * SEQ * DK);
    const char* Vg = (const char*)(V + (size_t)(b * KV + kvh) * SEQ * 64);
    uint4 kr0, kr1, kr2 = make_uint4(0, 0, 0, 0), vr0, vr1;
    const int koff0 = (tid / KCH) * KS + (tid % KCH) * 16;
    const int koff1 = ((tid + 512) / KCH) * KS + ((tid + 512) % KCH) * 16;
    const int koff2 = ((tid + 1024) / KCH) * KS + ((tid + 1024) % KCH) * 16;
    const int voff0 = (tid >> 3) * VS_BYTES + (tid & 7) * 16;
    const int voff1 = ((tid + 512) >> 3) * VS_BYTES + (tid & 7) * 16;
    f32x16 o[2];
#pragma unroll
    for (int d = 0; d < 2; ++d)
#pragma unroll
        for (int i = 0; i < 16; ++i) o[d][i] = 0.f;
    float m = -1e30f, l = 0.f;
    if (WINDOW) { m = sink[head] * LOG2E; l = (hh == 0) ? 1.f : 0.f; }
    const int gg = lane >> 4, li = lane & 15;
    const int vlane = (4 * (gg >> 1) + (li >> 2)) * VS_BYTES + (16 * (gg & 1) + 4 * (li & 3)) * 2;
    char* Kl = lds; char* Vl = lds + 2 * KBUF;
#define AGLOAD(KT) do { const char* _kg = Kg + (size_t)(KT) * 128 * DK * 2; const char* _vg = Vg + (size_t)(KT) * 128 * 128; \
        kr0 = *(const uint4*)(_kg + tid * 16); kr1 = *(const uint4*)(_kg + (tid + 512) * 16); if (KLD > 2) kr2 = *(const uint4*)(_kg + (tid + 1024) * 16); \
        vr0 = *(const uint4*)(_vg + tid * 16); vr1 = *(const uint4*)(_vg + (tid + 512) * 16); } while (0)
#define ASTORE(KB, VB) do { char* _kd = (KB); char* _vd = (VB); *(uint4*)(_kd + koff0) = kr0; *(uint4*)(_kd + koff1) = kr1; if (KLD > 2) *(uint4*)(_kd + koff2) = kr2; \
        *(uint4*)(_vd + voff0) = vr0; *(uint4*)(_vd + voff1) = vr1; } while (0)
    AGLOAD(kt_lo);
    ASTORE(Kl, Vl);
    { const int k1 = kt_lo + 1 < kt_hi ? kt_lo + 1 : kt_lo; AGLOAD(k1); }
    __syncthreads();
    for (int kt = kt_lo; kt < kt_hi; ++kt) {
        const int cur = (kt - kt_lo) & 1;
        ASTORE(Kl + (cur ^ 1) * KBUF, Vl + (cur ^ 1) * VBUF);
        { const int ktn = kt + 2 < kt_hi ? kt + 2 : kt_hi - 1; AGLOAD(ktn); }
        __builtin_amdgcn_sched_barrier(0);
#pragma unroll
        for (int sub = 0; sub < 2; ++sub) {
            const char* kb = Kl + cur * KBUF + sub * 64 * KS;
            const float mi = (m < -1e29f) ? 0.f : m;
            f32x16 s0, s1;
#pragma unroll
            for (int i = 0; i < 16; ++i) { s0[i] = -mi; s1[i] = -mi; }
#pragma unroll
            for (int ks = 0; ks < DK / 16; ++ks) {
                bf16x8 k0 = *(const bf16x8*)(kb + r32 * KS + (ks * 2 + hh) * 16);
                bf16x8 k1 = *(const bf16x8*)(kb + (32 + r32) * KS + (ks * 2 + hh) * 16);
                s0 = __builtin_amdgcn_mfma_f32_32x32x16_bf16(k0, qf[ks], s0, 0, 0, 0);
                s1 = __builtin_amdgcn_mfma_f32_32x32x16_bf16(k1, qf[ks], s1, 0, 0, 0);
            }
            if (WINDOW) {
                const int kb0 = kt * 128 + sub * 64 + 4 * hh - qpos;
#pragma unroll
                for (int i = 0; i < 16; ++i) {
                    const int d0 = kb0 + (i & 3) + 8 * (i >> 2), d1 = d0 + 32;
                    s0[i] = (d0 > 128 || d0 < -128) ? -1e30f : s0[i];
                    s1[i] = (d1 > 128 || d1 < -128) ? -1e30f : s1[i];
                }
            }
            const int vbase = (int)(size_t)(Vl + cur * VBUF - lds) + sub * 64 * VS_BYTES + vlane;
            PV_LOAD(0, vbase, vfa);
            PV_LOAD(1, vbase, vfb);
            __builtin_amdgcn_sched_barrier(0);
            float tmax = s0[0];
#pragma unroll
            for (int i = 1; i < 16; ++i) tmax = fmaxf(tmax, s0[i]);
#pragma unroll
            for (int i = 0; i < 16; ++i) tmax = fmaxf(tmax, s1[i]);
            tmax = xhalf_max(tmax);
            float ps = 0.f;
            if (__all(m > -1e29f && tmax <= 8.f)) {
#pragma unroll
                for (int i = 0; i < 16; ++i) { s0[i] = __builtin_amdgcn_exp2f(s0[i]); ps += s0[i]; }
#pragma unroll
                for (int i = 0; i < 16; ++i) { s1[i] = __builtin_amdgcn_exp2f(s1[i]); ps += s1[i]; }
                l += ps;
            } else {
                const float mn = fmaxf(m, mi + tmax);
                const float d = mn - mi;
                const float alpha = __builtin_amdgcn_exp2f(m - mn);
                m = mn;
#pragma unroll
                for (int i = 0; i < 16; ++i) { s0[i] = __builtin_amdgcn_exp2f(s0[i] - d); ps += s0[i]; }
#pragma unroll
                for (int i = 0; i < 16; ++i) { s1[i] = __builtin_amdgcn_exp2f(s1[i] - d); ps += s1[i]; }
                l = l * alpha + ps;
#pragma unroll
                for (int dd = 0; dd < 2; ++dd)
#pragma unroll
                    for (int i = 0; i < 16; ++i) o[dd][i] *= alpha;
            }
            asm volatile("s_waitcnt lgkmcnt(0)" ::: "memory");
            __builtin_amdgcn_sched_barrier(0);
            PV_MMA(o, s0, vfa);
            PV_MMA(o, s1, vfb);
        }
        __syncthreads();
    }
#undef AGLOAD
#undef ASTORE
    l = xhalf_sum(l);
    const float inv = 1.f / l;
    bf16_t* orow = O + (size_t)(b * SEQ + qpos) * DM + ocol + head * 64;
#pragma unroll
    for (int d = 0; d < 2; ++d)
#pragma unroll
        for (int gq = 0; gq < 4; ++gq) {
            uint2 w;
            w.x = cvtpk(o[d][gq * 4 + 0] * inv, o[d][gq * 4 + 1] * inv);
            w.y = cvtpk(o[d][gq * 4 + 2] * inv, o[d][gq * 4 + 3] * inv);
            *(uint2*)(orow + d * 32 + 8 * gq + 4 * hh) = w;
        }
}

__device__ __forceinline__ void dil_wave_item(const bf16_t* __restrict__ Q, const bf16_t* __restrict__ K, const bf16_t* __restrict__ V,
                                              bf16_t* __restrict__ O, int witem, char* wlds, int lds_off) {
    const int lane = tid_opaque() & 63, r32 = lane & 31, hh = lane >> 5;
    const int c = witem & 15, chunk = (witem >> 4) & 15, kvh = (witem >> 8) & 1, b = witem >> 9;
    const int t0 = chunk * 256;
    const int mq = r32 & 15, g = r32 >> 4;
    const int qpos = t0 + 16 * mq + c, head = kvh * 2 + g;
    bf16x8 qf[4];
    {
        const bf16_t* qp = Q + ((size_t)(b * 4 + head) * SEQ + qpos) * 64 + hh * 8;
#pragma unroll
        for (int ks = 0; ks < 4; ++ks) qf[ks] = *(const bf16x8*)(qp + ks * 16);
    }
    const bf16_t* Kg = K + (size_t)(b * 2 + kvh) * SEQ * 64;
    const bf16_t* Vg = V + (size_t)(b * 2 + kvh) * SEQ * 64;
    f32x16 o[2];
#pragma unroll
    for (int d = 0; d < 2; ++d)
#pragma unroll
        for (int i = 0; i < 16; ++i) o[d][i] = 0.f;
    float m = -1e30f, l = 0.f;
    const int gg = lane >> 4, li = lane & 15;
    const int vlane = lds_off + (4 * (gg >> 1) + (li >> 2)) * VS_BYTES + (16 * (gg & 1) + 4 * (li & 3)) * 2;
#define DIL_PARAMS(IT, SH, CC, IDX0, LIM) const int SH = (IT) < 12 ? 0 : ((IT) < 18 ? 2 : 4); const int CC = c & ((1 << SH) - 1); \
        const int IDX0 = (t0 >> SH) - 64 + 32 * ((IT) < 12 ? (IT) : ((IT) < 18 ? (IT) - 12 : (IT) - 18)); const int LIM = SEQ >> SH
#define DIL_LOAD(KF, VR, SH, CC, IDX0, LIM) do { \
        { int _i = IDX0 + r32; _i = _i < 0 ? 0 : (_i >= LIM ? LIM - 1 : _i); const bf16_t* _kp = Kg + (size_t)((_i << SH) + CC) * 64 + hh * 8; \
          KF##0 = *(const bf16x8*)(_kp); KF##1 = *(const bf16x8*)(_kp + 16); KF##2 = *(const bf16x8*)(_kp + 32); KF##3 = *(const bf16x8*)(_kp + 48); } \
        { int _i = IDX0 + (lane >> 3); _i = _i < 0 ? 0 : (_i >= LIM ? LIM - 1 : _i); VR##0 = *(const uint4*)(Vg + (size_t)((_i << SH) + CC) * 64 + (lane & 7) * 8); } \
        { int _i = IDX0 + 8 + (lane >> 3); _i = _i < 0 ? 0 : (_i >= LIM ? LIM - 1 : _i); VR##1 = *(const uint4*)(Vg + (size_t)((_i << SH) + CC) * 64 + (lane & 7) * 8); } \
        { int _i = IDX0 + 16 + (lane >> 3); _i = _i < 0 ? 0 : (_i >= LIM ? LIM - 1 : _i); VR##2 = *(const uint4*)(Vg + (size_t)((_i << SH) + CC) * 64 + (lane & 7) * 8); } \
        { int _i = IDX0 + 24 + (lane >> 3); _i = _i < 0 ? 0 : (_i >= LIM ? LIM - 1 : _i); VR##3 = *(const uint4*)(Vg + (size_t)((_i << SH) + CC) * 64 + (lane & 7) * 8); } } while (0)
    bf16x8 ka0, ka1, ka2, ka3, kb0, kb1, kb2, kb3;
    uint4 va0, va1, va2, va3, vb0, vb1, vb2, vb3;
    { DIL_PARAMS(0, sh0, cc0, ix0, lm0); DIL_LOAD(ka, va, sh0, cc0, ix0, lm0); }
#pragma unroll 1
    for (int it = 0; it < 23; ++it) {
        DIL_PARAMS(it, sh, cc, idx0, lim);
        {
            const int itn = it + 1 < 23 ? it + 1 : 22;
            DIL_PARAMS(itn, shn, ccn, ixn, lmn);
            DIL_LOAD(kb, vb, shn, ccn, ixn, lmn);
        }
        __builtin_amdgcn_sched_barrier(0);
        *(uint4*)(wlds + ((lane >> 3)) * VS_BYTES + (lane & 7) * 16) = va0;
        *(uint4*)(wlds + ((lane >> 3) + 8) * VS_BYTES + (lane & 7) * 16) = va1;
        *(uint4*)(wlds + ((lane >> 3) + 16) * VS_BYTES + (lane & 7) * 16) = va2;
        *(uint4*)(wlds + ((lane >> 3) + 24) * VS_BYTES + (lane & 7) * 16) = va3;
        f32x16 s;
#pragma unroll
        for (int i = 0; i < 16; ++i) s[i] = 0.f;
        s = __builtin_amdgcn_mfma_f32_32x32x16_bf16(ka0, qf[0], s, 0, 0, 0);
        s = __builtin_amdgcn_mfma_f32_32x32x16_bf16(ka1, qf[1], s, 0, 0, 0);
        s = __builtin_amdgcn_mfma_f32_32x32x16_bf16(ka2, qf[2], s, 0, 0, 0);
        s = __builtin_amdgcn_mfma_f32_32x32x16_bf16(ka3, qf[3], s, 0, 0, 0);

        const int qidx = qpos >> sh;
        const int base = idx0 + 4 * hh;
#pragma unroll
        for (int i = 0; i < 16; ++i) {
            const int idx = base + (i & 3) + 8 * (i >> 2);
            const int d = idx - qidx;
            s[i] = (d > 64 || d < -64 || idx < 0 || idx >= lim) ? -1e30f : s[i];
        }
        float tmax = s[0];
#pragma unroll
        for (int i = 1; i < 16; ++i) tmax = fmaxf(tmax, s[i]);
        tmax = fmaxf(tmax, xhalf(tmax));
        const float mn = fmaxf(fmaxf(m, tmax), -1e20f);
        const float alpha = __builtin_amdgcn_exp2f(m - mn);
        m = mn;
        float ps = 0.f;
#pragma unroll
        for (int i = 0; i < 16; ++i) { s[i] = __builtin_amdgcn_exp2f(s[i] - mn); ps += s[i]; }
        l = l * alpha + ps;
#pragma unroll
        for (int d = 0; d < 2; ++d)
#pragma unroll
            for (int i = 0; i < 16; ++i) o[d][i] *= alpha;
        pv_sub<0>(o, s, vlane);
        ka0 = kb0; ka1 = kb1; ka2 = kb2; ka3 = kb3; va0 = vb0; va1 = vb1; va2 = vb2; va3 = vb3;
    }
#undef DIL_PARAMS
#undef DIL_LOAD
    l += xhalf(l);
    const float inv = 1.f / l;
    bf16_t* orow = O + (size_t)(b * SEQ + qpos) * DM + 512 + head * 64;
#pragma unroll
    for (int d = 0; d < 2; ++d)
#pragma unroll
        for (int gq = 0; gq < 4; ++gq) {
            uint2 w;
            w.x = cvtpk(o[d][gq * 4 + 0] * inv, o[d][gq * 4 + 1] * inv);
            w.y = cvtpk(o[d][gq * 4 + 2] * inv, o[d][gq * 4 + 3] * inv);
            *(uint2*)(orow + d * 32 + 8 * gq + 4 * hh) = w;
        }
}

__device__ __forceinline__ int f2key(float f) { int b = __float_as_int(f); return b ^ ((b >> 31) & 0x7fffffff); }
__device__ __forceinline__ float key2f(int k) { return __int_as_float(k ^ ((k >> 31) & 0x7fffffff)); }

template <int N>
__device__ __forceinline__ void bitonic_sort_desc(int (&a)[N]) {
#pragma unroll
    for (int k = 2; k <= N; k <<= 1) {
#pragma unroll
        for (int j = k >> 1; j > 0; j >>= 1) {
#pragma unroll
            for (int i = 0; i < N; ++i) {
                const int l2 = i ^ j;
                if (l2 > i) {
                    const bool up = ((i & k) == 0);
                    const int hi = max(a[i], a[l2]), lo = min(a[i], a[l2]);
                    a[i] = up ? hi : lo; a[l2] = up ? lo : hi;
                }
            }
        }
    }
}
__device__ __forceinline__ void merge_top16(int (&a)[16], const int (&b)[16]) {
#pragma unroll
    for (int i = 0; i < 16; ++i) a[i] = max(a[i], b[15 - i]);
#pragma unroll
    for (int j = 8; j > 0; j >>= 1) {
#pragma unroll
        for (int i = 0; i < 16; ++i) {
            const int l2 = i ^ j;
            if (l2 > i) { const int hi = max(a[i], a[l2]), lo = min(a[i], a[l2]); a[i] = hi; a[l2] = lo; }
        }
    }
}
__device__ __forceinline__ void top16_of_64(int (&g0)[16], int (&g1)[16], int (&g2)[16], int (&g3)[16]) {
    bitonic_sort_desc<16>(g0); bitonic_sort_desc<16>(g1); bitonic_sort_desc<16>(g2); bitonic_sort_desc<16>(g3);
    merge_top16(g0, g1); merge_top16(g2, g3); merge_top16(g0, g2);
}

__device__ __forceinline__ void topk_core(const bf16_t* q0, const bf16_t* __restrict__ subk_h, float rscale, int* eo, float* go, char* wlds) {
    const int lane = tid_opaque() & 63, r32 = lane & 31, hh = lane >> 5;
    int top[2][16];
#pragma unroll
    for (int c = 0; c < 2; ++c) {
        bf16x8 qf[8];
        const bf16_t* qrow = q0 + c * 128;
#pragma unroll
        for (int ks = 0; ks < 8; ++ks) qf[ks] = *(const bf16x8*)(qrow + ks * 16);
        const bf16_t* kb = subk_h + ((size_t)c * 128 + r32) * 128 + hh * 8;
        int grp[4][16];
        bf16x8 kfa[8], kfb[8];
#pragma unroll
        for (int ks = 0; ks < 8; ++ks) kfa[ks] = *(const bf16x8*)(kb + ks * 16);
#pragma unroll
        for (int kt = 0; kt < 4; ++kt) {
            if (kt < 3) {
#pragma unroll
                for (int ks = 0; ks < 8; ++ks) kfb[ks] = *(const bf16x8*)(kb + (size_t)(kt + 1) * 32 * 128 + ks * 16);
            }
            __builtin_amdgcn_sched_barrier(0);
            f32x16 s;
#pragma unroll
            for (int i = 0; i < 16; ++i) s[i] = 0.f;
#pragma unroll
            for (int ks = 0; ks < 8; ++ks) s = __builtin_amdgcn_mfma_f32_32x32x16_bf16(kfa[ks], qf[ks], s, 0, 0, 0);
#pragma unroll
            for (int i = 0; i < 16; ++i) grp[kt][i] = (f2key(s[i]) & ~127) | (kt * 32 + crow(i, hh));
#pragma unroll
            for (int ks = 0; ks < 8; ++ks) kfa[ks] = kfb[ks];
        }
        top16_of_64(grp[0], grp[1], grp[2], grp[3]);
        int oth[16];
#pragma unroll
        for (int i = 0; i < 16; ++i) oth[i] = __shfl_xor(grp[0][i], 32);
        merge_top16(grp[0], oth);
#pragma unroll
        for (int i = 0; i < 16; ++i) top[c][i] = grp[0][i];
    }
    {
        unsigned* my = (unsigned*)(wlds + lane * 36);
#pragma unroll
        for (int c = 0; c < 2; ++c)
#pragma unroll
            for (int w4 = 0; w4 < 4; ++w4) {
                unsigned v = (top[c][w4 * 4] & 127) | ((top[c][w4 * 4 + 1] & 127) << 8) | ((top[c][w4 * 4 + 2] & 127) << 16) | ((top[c][w4 * 4 + 3] & 127) << 24);
                my[c * 4 + w4] = v;
            }
    }
    float v1[16], v2[16];
#pragma unroll
    for (int i = 0; i < 16; ++i) { v1[i] = key2f(top[0][i] & ~127); v2[i] = key2f(top[1][i] & ~127); }
    int cg[4][16];
    {
        int n = 0;
#pragma unroll
        for (int i = 0; i < 16; ++i)
#pragma unroll
            for (int j = 0; j < 16; ++j)
                if ((i + 1) * (j + 1) <= 16) { cg[n >> 4][n & 15] = (f2key(v1[i] + v2[j]) & ~255) | (i * 16 + j); ++n; }
#pragma unroll
        for (int q = 50; q < 64; ++q) cg[q >> 4][q & 15] = (int)0x80000000;
    }
    top16_of_64(cg[0], cg[1], cg[2], cg[3]);
    float bv[16];
#pragma unroll
    for (int i = 0; i < 16; ++i) bv[i] = key2f(cg[0][i] & ~255) * rscale;
    float sm = 0.f;
    const float bmx = bv[0];
#pragma unroll
    for (int i = 0; i < 16; ++i) { bv[i] = __expf(bv[i] - bmx); sm += bv[i]; }
    const float inv = 1.f / sm;
    if (hh == 0) {
        const unsigned char* my = (const unsigned char*)(wlds + lane * 36);
#pragma unroll
        for (int q4 = 0; q4 < 4; ++q4) {
            int4 ev; float4 gv;
            int* evp = (int*)&ev; float* gvp = (float*)&gv;
#pragma unroll
            for (int u = 0; u < 4; ++u) {
                const int code = cg[0][q4 * 4 + u] & 255;
                const int i1 = my[code >> 4], i2 = my[16 + (code & 15)];
                evp[u] = i1 * 128 + i2; gvp[u] = bv[q4 * 4 + u] * inv;
            }
            *(int4*)(eo + q4 * 4) = ev; *(float4*)(go + q4 * 4) = gv;
        }
    }
}

__device__ __forceinline__ void topk_wave_item(const bf16_t* __restrict__ qp, const bf16_t* __restrict__ subk, int* __restrict__ eidx, float* __restrict__ gate, int witem, char* wlds) {
    const int lane = tid_opaque() & 63, r32 = lane & 31, hh = lane >> 5;
    const int h = witem & 7, t = (witem >> 3) * 32 + r32;
    topk_core(qp + (size_t)t * 2048 + h * 256 + hh * 8, subk + (size_t)h * 2 * 128 * 128, 1.f, eidx + ((size_t)h * T_TOK + t) * 16, gate + ((size_t)h * T_TOK + t) * 16, wlds);
}
__device__ __forceinline__ void gemm_tile_topk(const bf16_t* __restrict__ X, int ldx, const bf16_t* __restrict__ W, int ldw, int K, int m0, int h, char* lds,
                                               const bf16_t* __restrict__ subk, const float* __restrict__ ssq, int* __restrict__ eidx, float* __restrict__ gate) {
    const int tid = tid_opaque(), lane = tid & 63, wave = tid >> 6;
    const int wm = wave >> 1, wn = wave & 1;
    const int r32 = lane & 31, hh = lane >> 5;
    {
        f32x16 acc[2][4];
        gemm_mainloop(X, ldx, W, ldw, K, m0, h * 256, 2048, lds, acc);
        bf16_t* qst = (bf16_t*)lds;
#pragma unroll
        for (int mt = 0; mt < 2; ++mt)
#pragma unroll
            for (int nt = 0; nt < 4; ++nt)
#pragma unroll
                for (int i = 0; i < 16; ++i)
                    qst[(wm * 64 + mt * 32 + crow(i, hh)) * QST + wn * 128 + nt * 32 + r32] = f2bf(acc[mt][nt][i]);
    }
    __syncthreads();
    {
        const int tok = wave * 32 + r32, t = m0 + tok;
        float tot = 0.f;
#pragma unroll
        for (int j = 0; j < 4; ++j) { const float4 q = *(const float4*)(ssq + ((size_t)j * T_TOK + t) * 4); tot += (q.x + q.y) + (q.z + q.w); }
        const float r = rsqrtf(tot * (1.f / DM) + 1e-6f);
        topk_core((const bf16_t*)lds + tok * QST + hh * 8, subk + (size_t)h * 2 * 128 * 128, r, eidx + ((size_t)h * T_TOK + t) * 16, gate + ((size_t)h * T_TOK + t) * 16,
                  lds + TOPK_STASH + wave * 2304);
    }
    __syncthreads();
}

typedef __attribute__((ext_vector_type(2))) float f32x2;
__device__ __forceinline__ float fdot2bf(unsigned a, unsigned b, float acc) {
    return __builtin_amdgcn_fdot2_f32_bf16(*(bf16x2_t*)&a, *(bf16x2_t*)&b, acc, false);
}
__device__ __forceinline__ unsigned fp8pair_to_bf16(unsigned w, bool hi) {
    bf16x2_t r = hi ? __builtin_amdgcn_cvt_scalef32_pk_bf16_fp8((int)w, 1.0f, true) : __builtin_amdgcn_cvt_scalef32_pk_bf16_fp8((int)w, 1.0f, false);
    return *(unsigned*)&r;
}
__device__ __forceinline__ float dot16_fp8(uint4 u, const unsigned (&h)[8]) {
    float a = 0.f;
    a = fdot2bf(fp8pair_to_bf16(u.x, false), h[0], a); a = fdot2bf(fp8pair_to_bf16(u.x, true), h[1], a);
    a = fdot2bf(fp8pair_to_bf16(u.y, false), h[2], a); a = fdot2bf(fp8pair_to_bf16(u.y, true), h[3], a);
    a = fdot2bf(fp8pair_to_bf16(u.z, false), h[4], a); a = fdot2bf(fp8pair_to_bf16(u.z, true), h[5], a);
    a = fdot2bf(fp8pair_to_bf16(u.w, false), h[6], a); a = fdot2bf(fp8pair_to_bf16(u.w, true), h[7], a);
    return a;
}
__device__ __forceinline__ void axpy16_fp8(float (&acc)[16], float w, uint4 v) {
    f32x2 r;
    r = __builtin_amdgcn_cvt_pk_f32_fp8((int)v.x, false); acc[0] += w * r[0]; acc[1] += w * r[1];
    r = __builtin_amdgcn_cvt_pk_f32_fp8((int)v.x, true);  acc[2] += w * r[0]; acc[3] += w * r[1];
    r = __builtin_amdgcn_cvt_pk_f32_fp8((int)v.y, false); acc[4] += w * r[0]; acc[5] += w * r[1];
    r = __builtin_amdgcn_cvt_pk_f32_fp8((int)v.y, true);  acc[6] += w * r[0]; acc[7] += w * r[1];
    r = __builtin_amdgcn_cvt_pk_f32_fp8((int)v.z, false); acc[8] += w * r[0]; acc[9] += w * r[1];
    r = __builtin_amdgcn_cvt_pk_f32_fp8((int)v.z, true);  acc[10] += w * r[0]; acc[11] += w * r[1];
    r = __builtin_amdgcn_cvt_pk_f32_fp8((int)v.w, false); acc[12] += w * r[0]; acc[13] += w * r[1];
    r = __builtin_amdgcn_cvt_pk_f32_fp8((int)v.w, true);  acc[14] += w * r[0]; acc[15] += w * r[1];
}
__device__ __forceinline__ float gelu_exact(float a) { return 0.5f * a * (1.f + erff(a * 0.70710678118654752f)); }

__device__ __forceinline__ float transpose_reduce16(f32x16 p, int lane) {
#pragma unroll
    for (int st = 0; st < 4; ++st) {
        const int o = 32 >> st, n = 16 >> st;
        const bool up = (lane & o) != 0;
#pragma unroll
        for (int i = 0; i < n / 2; ++i) {
            float lo = p[i], hi = p[i + n / 2];
            asm volatile("" : "+v"(lo), "+v"(hi));
            const float keep = up ? hi : lo;
            const float send = up ? lo : hi;
            p[i] = keep + __shfl_xor(send, o);
        }
    }
    float v = p[0];
    v += __shfl_xor(v, 1); v += __shfl_xor(v, 2);
    return v;
}
#define EX_SB() __builtin_amdgcn_sched_barrier(0)
#define EX_LD1(R, TAB, EB, S) R = *(const uint4*)((TAB) + (unsigned)((__builtin_amdgcn_readlane((EB), (S)) << 10) + lane16))
#define EX_LOAD8(P, TAB, EB, SL) do { EX_LD1(P##0, TAB, EB, (SL) + 0); EX_LD1(P##1, TAB, EB, (SL) + 1); EX_LD1(P##2, TAB, EB, (SL) + 2); EX_LD1(P##3, TAB, EB, (SL) + 3); \
        EX_LD1(P##4, TAB, EB, (SL) + 4); EX_LD1(P##5, TAB, EB, (SL) + 5); EX_LD1(P##6, TAB, EB, (SL) + 6); EX_LD1(P##7, TAB, EB, (SL) + 7); } while (0)
#define EX_DOT8(P, PP, O) do { PP[(O) + 0] = dot16_fp8(P##0, hp); PP[(O) + 1] = dot16_fp8(P##1, hp); PP[(O) + 2] = dot16_fp8(P##2, hp); PP[(O) + 3] = dot16_fp8(P##3, hp); \
        PP[(O) + 4] = dot16_fp8(P##4, hp); PP[(O) + 5] = dot16_fp8(P##5, hp); PP[(O) + 6] = dot16_fp8(P##6, hp); PP[(O) + 7] = dot16_fp8(P##7, hp); } while (0)
#define EX_RL(W, S) __int_as_float(__builtin_amdgcn_readlane(__float_as_int(W), (S)))
#define EX_AXPY8(P, W, SL) do { axpy16_fp8(acc, EX_RL(W, (SL) + 0), P##0); axpy16_fp8(acc, EX_RL(W, (SL) + 1), P##1); axpy16_fp8(acc, EX_RL(W, (SL) + 2), P##2); axpy16_fp8(acc, EX_RL(W, (SL) + 3), P##3); \
        axpy16_fp8(acc, EX_RL(W, (SL) + 4), P##4); axpy16_fp8(acc, EX_RL(W, (SL) + 5), P##5); axpy16_fp8(acc, EX_RL(W, (SL) + 6), P##6); axpy16_fp8(acc, EX_RL(W, (SL) + 7), P##7); } while (0)
#define EX_COPY8(D, S_) do { D##0 = S_##0; D##1 = S_##1; D##2 = S_##2; D##3 = S_##3; D##4 = S_##4; D##5 = S_##5; D##6 = S_##6; D##7 = S_##7; } while (0)

#ifndef EXS_NS
#define EXS_NS 16
#endif
#ifndef EXS_SYNC
#define EXS_SYNC 1
#endif
__device__ __forceinline__ int ex_mbcnt(unsigned long long m) { return __builtin_amdgcn_mbcnt_hi((unsigned)(m >> 32), __builtin_amdgcn_mbcnt_lo((unsigned)m, 0u)); }
__device__ __forceinline__ void xcd_local_sync_p(char* st);
__device__ __forceinline__ void expert_token(PC& p, int layer, int t, bool last, int2* lst, char* syncp, bool dummy = false) {
    const int lane = tid_opaque() & 63;
    const int lane16 = lane * 16;
    const float* gfb = p.g_ffn + layer * DM; asm volatile("" : "+s"(gfb));
    const float* gf = gfb + lane * 16;
    float* xrow = p.x + (size_t)t * DM + lane * 16;
    float* xwr = dummy ? (float*)p.zb + (size_t)t * DM + lane * 16 : xrow;
    bf16_t* hwr = (dummy ? p.q.qA + (size_t)t * DM : p.hnb + (size_t)t * DM) + lane * 16;
    float xv[16];
#pragma unroll
    for (int q = 0; q < 4; ++q) { const float4 a = *(const float4*)(xrow + 4 * q); xv[4 * q] = a.x; xv[4 * q + 1] = a.y; xv[4 * q + 2] = a.z; xv[4 * q + 3] = a.w; }
    float ss = 0.f;
#pragma unroll
    for (int i = 0; i < 16; ++i) ss += xv[i] * xv[i];
    ss = wave_sum(ss);
    const float rstd = rsqrtf(ss * (1.f / DM) + 1e-6f);
    unsigned hp[8];
#pragma unroll
    for (int q = 0; q < 4; ++q) {
        const float4 g = *(const float4*)(gf + 4 * q);
        hp[2 * q] = cvtpk(xv[4 * q] * rstd * g.x, xv[4 * q + 1] * rstd * g.y);
        hp[2 * q + 1] = cvtpk(xv[4 * q + 2] * rstd * g.z, xv[4 * q + 3] * rstd * g.w);
    }
    const size_t ei0 = ((size_t)(lane >> 4) * T_TOK + t) * 16 + (lane & 15), ei1 = ei0 + (size_t)4 * T_TOK * 16;
    int e0 = p.eidx[ei0], e1 = p.eidx[ei1];
    float g0 = p.gate[ei0], g1 = p.gate[ei1];
    {
        const int s0 = ((e0 >> 7) + e0) & (EXS_NS - 1), s1 = ((e1 >> 7) + e1) & (EXS_NS - 1);
        int base = 0, pos0 = 0, pos1 = 0;
#pragma unroll
        for (int s = 0; s < EXS_NS; ++s) {
            const unsigned long long m0 = __ballot(s0 == s), m1 = __ballot(s1 == s);
            const int c0 = __popcll(m0);
            pos0 = (s0 == s) ? base + ex_mbcnt(m0) : pos0;
            pos1 = (s1 == s) ? base + c0 + ex_mbcnt(m1) : pos1;
            base += c0 + __popcll(m1);
        }
        lst[pos0] = make_int2(e0, __float_as_int(g0)); lst[pos1] = make_int2(e1, __float_as_int(g1));
        const int2 q0 = lst[lane], q1 = lst[64 + lane];
        e0 = q0.x; g0 = __int_as_float(q0.y); e1 = q1.x; g1 = __int_as_float(q1.y);
    }
    const unsigned char* u8 = p.u8 + (size_t)layer * 16384 * DM;
    const unsigned char* v8 = p.v8 + (size_t)layer * 16384 * DM;
    const float* su = p.su + layer * 16384; const float* sv = p.sv + layer * 16384;
    const float su0 = su[e0], su1 = su[e1], sv0 = sv[e0], sv1 = sv[e1];
    uint4 rx0, rx1, rx2, rx3, rx4, rx5, rx6, rx7, ry0, ry1, ry2, ry3, ry4, ry5, ry6, ry7;
    float a0 = 0.f, a1 = 0.f;
    EX_LOAD8(rx, u8, e0, 0);
#pragma unroll 1
    for (int g = 0; g < 8; ++g) {
        const int eb = g < 4 ? e0 : e1;
        const int sl = (g & 3) * 16;
        f32x16 pp;
        EX_LOAD8(ry, u8, eb, sl + 8);
        EX_SB();
        EX_DOT8(rx, pp, 0);
        EX_SB();
        {
            const int gn = g + 1 < 8 ? g + 1 : 0;
            const int ebn = gn < 4 ? e0 : e1;
            const unsigned char* tabn = g + 1 < 8 ? u8 : v8;
            EX_LOAD8(rx, tabn, ebn, (gn & 3) * 16);
        }
        EX_SB();
        EX_DOT8(ry, pp, 8);
        const float v = transpose_reduce16(pp, lane);
        const float got = __shfl(v, (lane & 15) << 2);
        const bool mine = (lane >> 4) == (g & 3);
        a0 = (mine && g < 4) ? got : a0;
        a1 = (mine && g >= 4) ? got : a1;
        EX_SB();
    }
#if EXS_SYNC >= 2
    if (syncp) xcd_local_sync_p(syncp);
#endif
    const float w0 = g0 * gelu_exact(su0 * a0) * sv0;
    const float w1 = g1 * gelu_exact(su1 * a1) * sv1;
    float acc[16];
#pragma unroll
    for (int i = 0; i < 16; ++i) acc[i] = 0.f;
#pragma unroll 1
    for (int h2 = 0; h2 < 8; ++h2) {
        const int ebc = h2 < 4 ? e0 : e1;
        const float wb = h2 < 4 ? w0 : w1;
        const int slc = (h2 & 3) * 16;
        EX_LOAD8(ry, v8, ebc, slc + 8);
        EX_SB();
        EX_AXPY8(rx, wb, slc);
        EX_SB();
        {
            const int hn_ = h2 + 1 < 8 ? h2 + 1 : 7;
            const int ebn = hn_ < 4 ? e0 : e1;
            EX_LOAD8(rx, v8, ebn, (hn_ & 3) * 16);
        }
        EX_SB();
        EX_AXPY8(ry, wb, slc + 8);
        EX_SB();
    }
#pragma unroll
    for (int i = 0; i < 16; ++i) xv[i] += acc[i];
    float s2 = 0.f;
#pragma unroll
    for (int i = 0; i < 16; ++i) s2 += xv[i] * xv[i];
    s2 = wave_sum(s2);
    const float r2 = rsqrtf(s2 * (1.f / DM) + 1e-6f);
    if (!last) {
#pragma unroll
        for (int q = 0; q < 4; ++q) *(float4*)(xwr + 4 * q) = make_float4(xv[4 * q], xv[4 * q + 1], xv[4 * q + 2], xv[4 * q + 3]);
        const float* gnb = p.g_mix + (layer + 1) * DM; asm volatile("" : "+s"(gnb));
        const float* gn = gnb + lane * 16;
        unsigned hw[8];
#pragma unroll
        for (int q = 0; q < 4; ++q) {
            const float4 g = *(const float4*)(gn + 4 * q);
            hw[2 * q] = cvtpk(xv[4 * q] * r2 * g.x, xv[4 * q + 1] * r2 * g.y);
            hw[2 * q + 1] = cvtpk(xv[4 * q + 2] * r2 * g.z, xv[4 * q + 3] * r2 * g.w);
        }
        *(uint4*)(hwr) = make_uint4(hw[0], hw[1], hw[2], hw[3]);
        *(uint4*)(hwr + 8) = make_uint4(hw[4], hw[5], hw[6], hw[7]);
    } else {
        const float* gnb = p.g_final; asm volatile("" : "+s"(gnb));
        const float* gn = gnb + lane * 16;
        float* orow = dummy ? xwr : p.out + (size_t)t * DM + lane * 16;
#pragma unroll
        for (int q = 0; q < 4; ++q) {
            const float4 g = *(const float4*)(gn + 4 * q);
            *(float4*)(orow + 4 * q) = make_float4(xv[4 * q] * r2 * g.x, xv[4 * q + 1] * r2 * g.y, xv[4 * q + 2] * r2 * g.z, xv[4 * q + 3] * r2 * g.w);
        }
    }
}

#define EX_DOT8H(P, PP, O, HP) do { PP[(O) + 0] = dot16_fp8(P##0, HP); PP[(O) + 1] = dot16_fp8(P##1, HP); PP[(O) + 2] = dot16_fp8(P##2, HP); PP[(O) + 3] = dot16_fp8(P##3, HP); \
        PP[(O) + 4] = dot16_fp8(P##4, HP); PP[(O) + 5] = dot16_fp8(P##5, HP); PP[(O) + 6] = dot16_fp8(P##6, HP); PP[(O) + 7] = dot16_fp8(P##7, HP); } while (0)
#define EX_AXPY8A(P, W, SL, ACC) do { axpy16_fp8(ACC, EX_RL(W, (SL) + 0), P##0); axpy16_fp8(ACC, EX_RL(W, (SL) + 1), P##1); axpy16_fp8(ACC, EX_RL(W, (SL) + 2), P##2); axpy16_fp8(ACC, EX_RL(W, (SL) + 3), P##3); \
        axpy16_fp8(ACC, EX_RL(W, (SL) + 4), P##4); axpy16_fp8(ACC, EX_RL(W, (SL) + 5), P##5); axpy16_fp8(ACC, EX_RL(W, (SL) + 6), P##6); axpy16_fp8(ACC, EX_RL(W, (SL) + 7), P##7); } while (0)
__device__ __forceinline__ void ex2_begin(PC& p, int layer, int t, int lane, int2* lst, float (&xv)[16], unsigned (&hp)[8], int& e0, int& e1, float& g0, float& g1) {
    const float* gfb = p.g_ffn + layer * DM; asm volatile("" : "+s"(gfb));
    const float* gf = gfb + lane * 16;
    const float* xrow = p.x + (size_t)t * DM + lane * 16;
#pragma unroll
    for (int q = 0; q < 4; ++q) { const float4 a = *(const float4*)(xrow + 4 * q); xv[4 * q] = a.x; xv[4 * q + 1] = a.y; xv[4 * q + 2] = a.z; xv[4 * q + 3] = a.w; }
    float ss = 0.f;
#pragma unroll
    for (int i = 0; i < 16; ++i) ss += xv[i] * xv[i];
    ss = wave_sum(ss);
    const float rstd = rsqrtf(ss * (1.f / DM) + 1e-6f);
#pragma unroll
    for (int q = 0; q < 4; ++q) {
        const float4 g = *(const float4*)(gf + 4 * q);
        hp[2 * q] = cvtpk(xv[4 * q] * rstd * g.x, xv[4 * q + 1] * rstd * g.y);
        hp[2 * q + 1] = cvtpk(xv[4 * q + 2] * rstd * g.z, xv[4 * q + 3] * rstd * g.w);
    }
    const size_t ei0 = ((size_t)(lane >> 4) * T_TOK + t) * 16 + (lane & 15), ei1 = ei0 + (size_t)4 * T_TOK * 16;
    e0 = p.eidx[ei0]; e1 = p.eidx[ei1];
    g0 = p.gate[ei0]; g1 = p.gate[ei1];
    const int s0 = ((e0 >> 7) + e0) & (EXS_NS - 1), s1 = ((e1 >> 7) + e1) & (EXS_NS - 1);
    int base = 0, pos0 = 0, pos1 = 0;
#pragma unroll
    for (int s = 0; s < EXS_NS; ++s) {
        const unsigned long long m0 = __ballot(s0 == s), m1 = __ballot(s1 == s);
        const int c0 = __popcll(m0);
        pos0 = (s0 == s) ? base + ex_mbcnt(m0) : pos0;
        pos1 = (s1 == s) ? base + c0 + ex_mbcnt(m1) : pos1;
        base += c0 + __popcll(m1);
    }
    lst[pos0] = make_int2(e0, __float_as_int(g0)); lst[pos1] = make_int2(e1, __float_as_int(g1));
    const int2 q0 = lst[lane], q1 = lst[64 + lane];
    e0 = q0.x; g0 = __int_as_float(q0.y); e1 = q1.x; g1 = __int_as_float(q1.y);
}
__device__ __forceinline__ void ex2_end(PC& p, int layer, int t, int lane, bool last, bool dummy, float (&xv)[16], const float (&acc)[16]) {
    float* xwr = (dummy ? (float*)p.zb : p.x) + (size_t)t * DM + lane * 16;
    bf16_t* hwr = (dummy ? p.q.qA + (size_t)t * DM : p.hnb + (size_t)t * DM) + lane * 16;
#pragma unroll
    for (int i = 0; i < 16; ++i) xv[i] += acc[i];
    float s2 = 0.f;
#pragma unroll
    for (int i = 0; i < 16; ++i) s2 += xv[i] * xv[i];
    s2 = wave_sum(s2);
    const float r2 = rsqrtf(s2 * (1.f / DM) + 1e-6f);
    if (!last) {
#pragma unroll
        for (int q = 0; q < 4; ++q) *(float4*)(xwr + 4 * q) = make_float4(xv[4 * q], xv[4 * q + 1], xv[4 * q + 2], xv[4 * q + 3]);
        const float* gnb = p.g_mix + (layer + 1) * DM; asm volatile("" : "+s"(gnb));
        const float* gn = gnb + lane * 16;
        unsigned hw[8];
#pragma unroll
        for (int q = 0; q < 4; ++q) {
            const float4 g = *(const float4*)(gn + 4 * q);
            hw[2 * q] = cvtpk(xv[4 * q] * r2 * g.x, xv[4 * q + 1] * r2 * g.y);
            hw[2 * q + 1] = cvtpk(xv[4 * q + 2] * r2 * g.z, xv[4 * q + 3] * r2 * g.w);
        }
        *(uint4*)(hwr) = make_uint4(hw[0], hw[1], hw[2], hw[3]);
        *(uint4*)(hwr + 8) = make_uint4(hw[4], hw[5], hw[6], hw[7]);
    } else {
        const float* gnb = p.g_final; asm volatile("" : "+s"(gnb));
        const float* gn = gnb + lane * 16;
        float* orow = dummy ? xwr : p.out + (size_t)t * DM + lane * 16;
#pragma unroll
        for (int q = 0; q < 4; ++q) {
            const float4 g = *(const float4*)(gn + 4 * q);
            *(float4*)(orow + 4 * q) = make_float4(xv[4 * q] * r2 * g.x, xv[4 * q + 1] * r2 * g.y, xv[4 * q + 2] * r2 * g.z, xv[4 * q + 3] * r2 * g.w);
        }
    }
}
__device__ __forceinline__ void expert_token2(PC& p, int layer, int tA, int tB, bool last, int2* lst, bool dummy) {
    const int lane = tid_opaque() & 63;
    const int lane16 = lane * 16;
    float xvA[16], xvB[16]; unsigned hpA[8], hpB[8];
    int e0A, e1A, e0B, e1B; float g0A, g1A, g0B, g1B;
    ex2_begin(p, layer, tA, lane, lst, xvA, hpA, e0A, e1A, g0A, g1A);
    EX_SB();
    ex2_begin(p, layer, tB, lane, lst + 128, xvB, hpB, e0B, e1B, g0B, g1B);
    EX_SB();
    const unsigned char* u8 = p.u8 + (size_t)layer * 16384 * DM;
    const unsigned char* v8 = p.v8 + (size_t)layer * 16384 * DM;
    const float* su = p.su + layer * 16384; const float* sv = p.sv + layer * 16384;
    const float su0A = su[e0A], su1A = su[e1A], sv0A = sv[e0A], sv1A = sv[e1A];
    const float su0B = su[e0B], su1B = su[e1B], sv0B = sv[e0B], sv1B = sv[e1B];
    uint4 rx0, rx1, rx2, rx3, rx4, rx5, rx6, rx7, ry0, ry1, ry2, ry3, ry4, ry5, ry6, ry7;
    float a0A = 0.f, a1A = 0.f, a0B = 0.f, a1B = 0.f;
    EX_LOAD8(rx, u8, e0A, 0);
#pragma unroll 1
    for (int g = 0; g < 8; ++g) {
        const int ebA = g < 4 ? e0A : e1A, ebB = g < 4 ? e0B : e1B;
        const int sl = (g & 3) * 16;
        const bool mine = (lane >> 4) == (g & 3);
        f32x16 pp;
        EX_LOAD8(ry, u8, ebA, sl + 8);
        EX_SB();
        EX_DOT8H(rx, pp, 0, hpA);
        EX_SB();
        EX_LOAD8(rx, u8, ebB, sl);
        EX_SB();
        EX_DOT8H(ry, pp, 8, hpA);
        {
            const float v = transpose_reduce16(pp, lane);
            const float got = __shfl(v, (lane & 15) << 2);
            a0A = (mine && g < 4) ? got : a0A;
            a1A = (mine && g >= 4) ? got : a1A;
        }
        EX_SB();
        EX_LOAD8(ry, u8, ebB, sl + 8);
        EX_SB();
        EX_DOT8H(rx, pp, 0, hpB);
        EX_SB();
        {
            const int gn = g + 1 < 8 ? g + 1 : 0;
            const int ebn = gn < 4 ? e0A : e1A;
            const unsigned char* tabn = g + 1 < 8 ? u8 : v8;
            EX_LOAD8(rx, tabn, ebn, (gn & 3) * 16);
        }
        EX_SB();
        EX_DOT8H(ry, pp, 8, hpB);
        {
            const float v = transpose_reduce16(pp, lane);
            const float got = __shfl(v, (lane & 15) << 2);
            a0B = (mine && g < 4) ? got : a0B;
            a1B = (mine && g >= 4) ? got : a1B;
        }
        EX_SB();
    }
    const float w0A = g0A * gelu_exact(su0A * a0A) * sv0A, w1A = g1A * gelu_exact(su1A * a1A) * sv1A;
    const float w0B = g0B * gelu_exact(su0B * a0B) * sv0B, w1B = g1B * gelu_exact(su1B * a1B) * sv1B;
    float accA[16], accB[16];
#pragma unroll
    for (int i = 0; i < 16; ++i) { accA[i] = 0.f; accB[i] = 0.f; }
#pragma unroll 1
    for (int h2 = 0; h2 < 8; ++h2) {
        const int ebcA = h2 < 4 ? e0A : e1A, ebcB = h2 < 4 ? e0B : e1B;
        const float wbA = h2 < 4 ? w0A : w1A, wbB = h2 < 4 ? w0B : w1B;
        const int slc = (h2 & 3) * 16;
        EX_LOAD8(ry, v8, ebcA, slc + 8);
        EX_SB();
        EX_AXPY8A(rx, wbA, slc, accA);
        EX_SB();
        EX_LOAD8(rx, v8, ebcB, slc);
        EX_SB();
        EX_AXPY8A(ry, wbA, slc + 8, accA);
        EX_SB();
        EX_LOAD8(ry, v8, ebcB, slc + 8);
        EX_SB();
        EX_AXPY8A(rx, wbB, slc, accB);
        EX_SB();
        {
            const int hn_ = h2 + 1 < 8 ? h2 + 1 : 7;
            const int ebn = hn_ < 4 ? e0A : e1A;
            EX_LOAD8(rx, v8, ebn, (hn_ & 3) * 16);
        }
        EX_SB();
        EX_AXPY8A(ry, wbB, slc + 8, accB);
        EX_SB();
    }
    ex2_end(p, layer, tA, lane, last, dummy, xvA, accA);
    EX_SB();
    ex2_end(p, layer, tB, lane, last, dummy, xvB, accB);
}

__device__ __forceinline__ void ex2_endr(PC& p, int layer, int t, int lane, bool last, bool dummy, const float (&acc)[16]) {
    t = __builtin_amdgcn_readfirstlane(t); asm volatile("" : "+s"(t));
    float xv[16];
    const float* xrow = p.x + (size_t)t * DM + lane * 16;
#pragma unroll
    for (int q = 0; q < 4; ++q) { const float4 a = *(const float4*)(xrow + 4 * q); xv[4 * q] = a.x; xv[4 * q + 1] = a.y; xv[4 * q + 2] = a.z; xv[4 * q + 3] = a.w; }
    float zero[16];
#pragma unroll
    for (int i = 0; i < 16; ++i) { xv[i] += acc[i]; zero[i] = 0.f; }
    ex2_end(p, layer, t, lane, last, dummy, xv, zero);
}
#define EX_ACCIN(A) "v"(A[0]), "v"(A[1]), "v"(A[2]), "v"(A[3]), "v"(A[4]), "v"(A[5]), "v"(A[6]), "v"(A[7]), "v"(A[8]), "v"(A[9]), "v"(A[10]), "v"(A[11]), "v"(A[12]), "v"(A[13]), "v"(A[14]), "v"(A[15])
#define EX_ORDER2(RA, RB, A) asm volatile("" : "+v"(RA.x), "+v"(RA.y), "+v"(RA.z), "+v"(RA.w), "+v"(RB.x), "+v"(RB.y), "+v"(RB.z), "+v"(RB.w) : EX_ACCIN(A))
#define EX_AXPY8K(P, W, SL, ACC) do { axpy16_fp8(ACC, EX_RL(W, (SL) + 0), P##0); axpy16_fp8(ACC, EX_RL(W, (SL) + 1), P##1); axpy16_fp8(ACC, EX_RL(W, (SL) + 2), P##2); axpy16_fp8(ACC, EX_RL(W, (SL) + 3), P##3); \
        EX_ORDER2(P##4, P##5, ACC); EX_ORDER2(P##6, P##7, ACC); \
        axpy16_fp8(ACC, EX_RL(W, (SL) + 4), P##4); axpy16_fp8(ACC, EX_RL(W, (SL) + 5), P##5); axpy16_fp8(ACC, EX_RL(W, (SL) + 6), P##6); axpy16_fp8(ACC, EX_RL(W, (SL) + 7), P##7); } while (0)
typedef _Float16 h2_t __attribute__((ext_vector_type(2)));
__device__ __forceinline__ void axpy16_h(h2_t (&acc)[8], float w, uint4 v) {
    const _Float16 wh = (_Float16)w; const h2_t ww = {wh, wh};
    acc[0] = __builtin_elementwise_fma(ww, __builtin_bit_cast(h2_t, __builtin_amdgcn_cvt_scalef32_pk_f16_fp8((int)v.x, 1.0f, false)), acc[0]);
    acc[1] = __builtin_elementwise_fma(ww, __builtin_bit_cast(h2_t, __builtin_amdgcn_cvt_scalef32_pk_f16_fp8((int)v.x, 1.0f, true)), acc[1]);
    acc[2] = __builtin_elementwise_fma(ww, __builtin_bit_cast(h2_t, __builtin_amdgcn_cvt_scalef32_pk_f16_fp8((int)v.y, 1.0f, false)), acc[2]);
    acc[3] = __builtin_elementwise_fma(ww, __builtin_bit_cast(h2_t, __builtin_amdgcn_cvt_scalef32_pk_f16_fp8((int)v.y, 1.0f, true)), acc[3]);
    acc[4] = __builtin_elementwise_fma(ww, __builtin_bit_cast(h2_t, __builtin_amdgcn_cvt_scalef32_pk_f16_fp8((int)v.z, 1.0f, false)), acc[4]);
    acc[5] = __builtin_elementwise_fma(ww, __builtin_bit_cast(h2_t, __builtin_amdgcn_cvt_scalef32_pk_f16_fp8((int)v.z, 1.0f, true)), acc[5]);
    acc[6] = __builtin_elementwise_fma(ww, __builtin_bit_cast(h2_t, __builtin_amdgcn_cvt_scalef32_pk_f16_fp8((int)v.w, 1.0f, false)), acc[6]);
    acc[7] = __builtin_elementwise_fma(ww, __builtin_bit_cast(h2_t, __builtin_amdgcn_cvt_scalef32_pk_f16_fp8((int)v.w, 1.0f, true)), acc[7]);
}
#define EX_ACCINH(A) "v"(A[0]), "v"(A[1]), "v"(A[2]), "v"(A[3]), "v"(A[4]), "v"(A[5]), "v"(A[6]), "v"(A[7])
#define EX_ORDER2H(RA, RB, A) asm volatile("" : "+v"(RA.x), "+v"(RA.y), "+v"(RA.z), "+v"(RA.w), "+v"(RB.x), "+v"(RB.y), "+v"(RB.z), "+v"(RB.w) : EX_ACCINH(A))
#define EX_AXPY8H(P, W, SL, ACC) do { axpy16_h(ACC, EX_RL(W, (SL) + 0), P##0); axpy16_h(ACC, EX_RL(W, (SL) + 1), P##1); axpy16_h(ACC, EX_RL(W, (SL) + 2), P##2); axpy16_h(ACC, EX_RL(W, (SL) + 3), P##3); \
        if (EXK_ORD) { EX_ORDER2H(P##4, P##5, ACC); EX_ORDER2H(P##6, P##7, ACC); } \
        axpy16_h(ACC, EX_RL(W, (SL) + 4), P##4); axpy16_h(ACC, EX_RL(W, (SL) + 5), P##5); axpy16_h(ACC, EX_RL(W, (SL) + 6), P##6); axpy16_h(ACC, EX_RL(W, (SL) + 7), P##7); } while (0)
__device__ __forceinline__ float transpose_reduce16s(f32x16 p, int lane) {
#pragma unroll
    for (int i = 0; i < 8; ++i) {
        auto r = __builtin_amdgcn_permlane32_swap(__float_as_uint(p[i]), __float_as_uint(p[i + 8]), false, false);
        p[i] = __uint_as_float(r[0]) + __uint_as_float(r[1]);
    }
#pragma unroll
    for (int i = 0; i < 4; ++i) {
        auto r = __builtin_amdgcn_permlane16_swap(__float_as_uint(p[i]), __float_as_uint(p[i + 4]), false, false);
        p[i] = __uint_as_float(r[0]) + __uint_as_float(r[1]);
    }
#pragma unroll
    for (int st = 2; st < 4; ++st) {
        const int o = 32 >> st, n = 16 >> st;
        const bool up = (lane & o) != 0;
#pragma unroll
        for (int i = 0; i < n / 2; ++i) {
            float lo = p[i], hi = p[i + n / 2];
            asm volatile("" : "+v"(lo), "+v"(hi));
            const float keep = up ? hi : lo;
            const float send = up ? lo : hi;
            p[i] = keep + __shfl_xor(send, o);
        }
    }
    float v = p[0];
    v += __shfl_xor(v, 1); v += __shfl_xor(v, 2);
    return v;
}
#ifndef EXK_ORD
#define EXK_ORD 1
#endif
#ifndef EXS_MIDSYNC
#define EXS_MIDSYNC 0
#endif
#ifndef EXK_PIN
#define EXK_PIN 1
#endif
template <int K>
__device__ __forceinline__ void expert_tokens(PC& p, int layer, const int (&tq)[K], bool last, int2* lst, char* syncp) {
    int tt[K]; bool dm[K];
#pragma unroll
    for (int k = 0; k < K; ++k) { dm[k] = tq[k] >= T_TOK; tt[k] = dm[k] ? T_TOK - 1 : tq[k]; }
    const int lane = tid_opaque() & 63;
    const int lane16 = lane * 16;
    constexpr int KR = K < 4 ? K : 4;
    unsigned hp[KR][8];
    char* hpl = (char*)(lst + 128 * K);
    int e0[KR], e1[KR];
#pragma unroll
    for (int k = 0; k < K; ++k) {
        float xv[16]; float g0, g1; unsigned hq[8]; int ea, eb;
        ex2_begin(p, layer, tt[k], lane, lst + 128 * k, xv, hq, ea, eb, g0, g1);
        if (k < KR) { e0[k < KR ? k : 0] = ea; e1[k < KR ? k : 0] = eb; }
        if (k < KR) {
#pragma unroll
            for (int i = 0; i < 8; ++i) hp[k < KR ? k : 0][i] = hq[i];
        } else {
            *(uint4*)(hpl + (k - KR) * 2048 + lane16) = make_uint4(hq[0], hq[1], hq[2], hq[3]);
            *(uint4*)(hpl + (k - KR) * 2048 + 1024 + lane16) = make_uint4(hq[4], hq[5], hq[6], hq[7]);
        }
        if ((k & 3) == 3) EX_SB();
    }
    const unsigned char* u8 = p.u8 + (size_t)layer * 16384 * DM;
    const unsigned char* v8 = p.v8 + (size_t)layer * 16384 * DM;
    const float* su = p.su + layer * 16384; const float* sv = p.sv + layer * 16384;
    float a0[K], a1[K];
#pragma unroll
    for (int k = 0; k < K; ++k) { a0[k] = 0.f; a1[k] = 0.f; }
    uint4 rx0, rx1, rx2, rx3, rx4, rx5, rx6, rx7, ry0, ry1, ry2, ry3, ry4, ry5, ry6, ry7;
#define EXK_E(KK, HALF) ((KK) < KR ? ((HALF) ? e1[(KK) < KR ? (KK) : 0] : e0[(KK) < KR ? (KK) : 0]) : lst[128 * (KK) + 64 * (HALF) + lane].x)
    { const int eb = EXK_E(0, 0); EX_LOAD8(rx, u8, eb, 0); }
#pragma unroll 1
    for (int g = 0; g < 8; ++g) {
        const int sl = (g & 3) * 16, hf = g >> 2;
        const bool mine = (lane >> 4) == (g & 3);
#pragma unroll
        for (int k = 0; k < K; ++k) {
            f32x16 pp;
            { const int ebk = EXK_E(k, hf); EX_LOAD8(ry, u8, ebk, sl + 8); }
            EX_SB();
            unsigned hh[8];
            if (k < KR) {
#pragma unroll
                for (int i = 0; i < 8; ++i) hh[i] = hp[k < KR ? k : 0][i];
            } else {
                const uint4 h0 = *(const uint4*)(hpl + (k - KR) * 2048 + lane16), h1 = *(const uint4*)(hpl + (k - KR) * 2048 + 1024 + lane16);
                hh[0] = h0.x; hh[1] = h0.y; hh[2] = h0.z; hh[3] = h0.w; hh[4] = h1.x; hh[5] = h1.y; hh[6] = h1.z; hh[7] = h1.w;
            }
            EX_DOT8H(rx, pp, 0, hh);
            EX_SB();
            if (k + 1 < K) { const int ebn = EXK_E((k + 1) % K, hf); EX_LOAD8(rx, u8, ebn, sl); }
            else {
                const int gn = g + 1 < 8 ? g + 1 : 0;
                const int ebn = EXK_E(0, gn >> 2);
                const unsigned char* tabn = g + 1 < 8 ? u8 : v8;
                EX_LOAD8(rx, tabn, ebn, (gn & 3) * 16);
            }
            EX_SB();
            EX_DOT8H(ry, pp, 8, hh);
            const float v = transpose_reduce16s(pp, lane);
            const float got = __shfl(v, (lane & 15) << 2);
            a0[k] = (mine && g < 4) ? got : a0[k];
            a1[k] = (mine && g >= 4) ? got : a1[k];
            EX_SB();
        }
    }
#if EXS_MIDSYNC
    xcd_local_sync_p(syncp);
#endif
    float w0[K], w1[K]; h2_t acc[K][8];
    {
        float s0[K], s1[K], t0[K], t1[K], gg0[K], gg1[K];
#pragma unroll
        for (int k = 0; k < K; ++k) {
            const int2 q0 = lst[128 * k + lane], q1 = lst[128 * k + 64 + lane];
            s0[k] = su[q0.x]; s1[k] = su[q1.x]; t0[k] = sv[q0.x]; t1[k] = sv[q1.x];
            gg0[k] = __int_as_float(q0.y); gg1[k] = __int_as_float(q1.y);
        }
#pragma unroll
        for (int k = 0; k < K; ++k) { w0[k] = gg0[k] * gelu_exact(s0[k] * a0[k]) * t0[k]; w1[k] = gg1[k] * gelu_exact(s1[k] * a1[k]) * t1[k]; }
    }
#pragma unroll
    for (int k = 0; k < K; ++k)
#pragma unroll
        for (int i = 0; i < 8; ++i) acc[k][i] = (h2_t){(_Float16)0.f, (_Float16)0.f};
#pragma unroll 1
    for (int h2 = 0; h2 < 8; ++h2) {
        const int slc = (h2 & 3) * 16, hf = h2 >> 2;
#pragma unroll
        for (int k = 0; k < K; ++k) {
            const float wb = h2 < 4 ? w0[k] : w1[k];
            { const int ebc = EXK_E(k, hf); EX_LOAD8(ry, v8, ebc, slc + 8); }
            EX_SB();
            EX_AXPY8H(rx, wb, slc, acc[k]);
            EX_SB();
            if (k + 1 < K) { const int ebn = EXK_E((k + 1) % K, hf); EX_LOAD8(rx, v8, ebn, slc); }
            else { const int hn_ = h2 + 1 < 8 ? h2 + 1 : 7; const int ebn = EXK_E(0, hn_ >> 2); EX_LOAD8(rx, v8, ebn, (hn_ & 3) * 16); }
            EX_SB();
            EX_AXPY8H(ry, wb, slc + 8, acc[k]);
            EX_SB();
        }
    }
#undef EXK_E
#pragma unroll
    for (int k = 0; k < K; ++k) {
        float af[16];
#pragma unroll
        for (int i = 0; i < 8; ++i) { af[2 * i] = (float)acc[k][i][0]; af[2 * i + 1] = (float)acc[k][i][1]; }
        ex2_endr(p, layer, tt[k], lane, last, dm[k], af);
    }
}
__device__ __forceinline__ void transpose_tile(const float* __restrict__ src, int K, int N, bf16_t* __restrict__ dst, int tk, int tn, float* tl, const float* __restrict__ ksc, int perm) {
    const int tid = tid_opaque(), r = tid >> 6, c = tid & 63;
    const int k0 = tk * 64, n0 = tn * 64;
#pragma unroll
    for (int i = 0; i < 8; ++i) {
        const int kk = i * 8 + r, n = n0 + c;
        tl[kk * 65 + c] = (n < N) ? src[(size_t)(k0 + kk) * N + n] : 0.f;
    }
    __syncthreads();
#pragma unroll
    for (int i = 0; i < 8; ++i) {
        const int nn = i * 8 + r;
        if (n0 + nn < N) {
            int nd = n0 + nn;
            if (perm) { const int hq = nd / 96, wq = nd % 96; nd = wq < 64 ? hq * 64 + wq : 256 + hq * 32 + (wq - 64); }
            dst[(size_t)nd * K + k0 + c] = f2bf(tl[c * 65 + nn] * (ksc ? ksc[k0 + c] : 1.f));
        }
    }
    __syncthreads();
}
__device__ __forceinline__ void transpose_all(const float* src, int K, int N, bf16_t* dst, float* tl, const float* ksc = nullptr, int perm = 0) {
    const int ntk = K / 64, ntn = (N + 63) / 64;
    for (int t = blockIdx.x; t < ntk * ntn; t += gridDim.x) transpose_tile(src, K, N, dst, t / ntn, t % ntn, tl, ksc, perm);
}
__device__ __forceinline__ void convert_plain(const float* __restrict__ src, bf16_t* __restrict__ dst, size_t n) {
    const size_t n8 = n >> 3;
    for (size_t i = (size_t)blockIdx.x * blockDim.x + tid_opaque(); i < n8; i += (size_t)gridDim.x * blockDim.x) {
        const float4 a = *(const float4*)(src + i * 8), b = *(const float4*)(src + i * 8 + 4);
        uint4 w; w.x = cvtpk(a.x, a.y); w.y = cvtpk(a.z, a.w); w.z = cvtpk(b.x, b.y); w.w = cvtpk(b.z, b.w);
        *(uint4*)(dst + i * 8) = w;
    }
}
__device__ __forceinline__ void convert_rows_fp8(const float* __restrict__ src, unsigned char* __restrict__ dst, float* __restrict__ scales, int nrows) {
    const int tid = tid_opaque(), wave = tid >> 6, lane = tid & 63;
    const int stride = gridDim.x * NW;
    for (int row0 = blockIdx.x * NW + wave; row0 < nrows; row0 += 4 * stride) {
        float4 xv[4][4];
#pragma unroll
        for (int u = 0; u < 4; ++u) {
            int row = row0 + u * stride; row = row < nrows ? row : row0;
            const float* sr = src + (size_t)row * DM + lane * 16;
#pragma unroll
            for (int q = 0; q < 4; ++q) xv[u][q] = *(const float4*)(sr + 4 * q);
        }
#pragma unroll
        for (int u = 0; u < 4; ++u) {
            const int row = row0 + u * stride;
            float am = 0.f;
#pragma unroll
            for (int q = 0; q < 4; ++q) am = fmaxf(fmaxf(am, fmaxf(fabsf(xv[u][q].x), fabsf(xv[u][q].y))), fmaxf(fabsf(xv[u][q].z), fabsf(xv[u][q].w)));
            am = wave_max(am);
            const float sc = am > 0.f ? am * (1.f / 448.f) : 1.f;
            const float inv = 1.f / sc;
            unsigned w[4];
#pragma unroll
            for (int q = 0; q < 4; ++q) {
                int t = 0;
                t = __builtin_amdgcn_cvt_pk_fp8_f32(xv[u][q].x * inv, xv[u][q].y * inv, t, false);
                t = __builtin_amdgcn_cvt_pk_fp8_f32(xv[u][q].z * inv, xv[u][q].w * inv, t, true);
                w[q] = (unsigned)t;
            }
            if (row < nrows) {
                *(uint4*)(dst + (size_t)row * DM + lane * 16) = make_uint4(w[0], w[1], w[2], w[3]);
                if (lane == 0) scales[row] = sc;
            }
        }
    }
}
__device__ __forceinline__ void rms_row_bf16(const float* __restrict__ src, const float* __restrict__ g, bf16_t* __restrict__ dst, float* __restrict__ cpy, int lane) {
    float xv[16];
    const float4 a0 = *(const float4*)(src + lane * 8), a1 = *(const float4*)(src + lane * 8 + 4);
    const float4 b0 = *(const float4*)(src + 512 + lane * 8), b1 = *(const float4*)(src + 512 + lane * 8 + 4);
    xv[0] = a0.x; xv[1] = a0.y; xv[2] = a0.z; xv[3] = a0.w; xv[4] = a1.x; xv[5] = a1.y; xv[6] = a1.z; xv[7] = a1.w;
    xv[8] = b0.x; xv[9] = b0.y; xv[10] = b0.z; xv[11] = b0.w; xv[12] = b1.x; xv[13] = b1.y; xv[14] = b1.z; xv[15] = b1.w;
    if (cpy) {
        *(float4*)(cpy + lane * 8) = a0; *(float4*)(cpy + lane * 8 + 4) = a1;
        *(float4*)(cpy + 512 + lane * 8) = b0; *(float4*)(cpy + 512 + lane * 8 + 4) = b1;
    }
    float ss = 0.f;
#pragma unroll
    for (int i = 0; i < 16; ++i) ss += xv[i] * xv[i];
    ss = wave_sum(ss);
    const float r = rsqrtf(ss * (1.f / DM) + 1e-6f);
    const float4 g0 = *(const float4*)(g + lane * 8), g1 = *(const float4*)(g + lane * 8 + 4);
    const float4 g2 = *(const float4*)(g + 512 + lane * 8), g3 = *(const float4*)(g + 512 + lane * 8 + 4);
    uint4 wa, wb;
    wa.x = cvtpk(xv[0] * r * g0.x, xv[1] * r * g0.y); wa.y = cvtpk(xv[2] * r * g0.z, xv[3] * r * g0.w);
    wa.z = cvtpk(xv[4] * r * g1.x, xv[5] * r * g1.y); wa.w = cvtpk(xv[6] * r * g1.z, xv[7] * r * g1.w);
    wb.x = cvtpk(xv[8] * r * g2.x, xv[9] * r * g2.y); wb.y = cvtpk(xv[10] * r * g2.z, xv[11] * r * g2.w);
    wb.z = cvtpk(xv[12] * r * g3.x, xv[13] * r * g3.y); wb.w = cvtpk(xv[14] * r * g3.z, xv[15] * r * g3.w);
    *(uint4*)(dst + lane * 8) = wa; *(uint4*)(dst + 512 + lane * 8) = wb;
}

__device__ __forceinline__ void rms_row2_bf16(const float* __restrict__ s0, const float* __restrict__ s1, const float* __restrict__ g, bf16_t* __restrict__ d0, bf16_t* __restrict__ d1, int lane) {
    float4 a[4], b[4];
#pragma unroll
    for (int q = 0; q < 4; ++q) { a[q] = *(const float4*)(s0 + (q >> 1) * 512 + lane * 8 + (q & 1) * 4); b[q] = s1 ? *(const float4*)(s1 + (q >> 1) * 512 + lane * 8 + (q & 1) * 4) : make_float4(0.f, 0.f, 0.f, 0.f); }
    float sa = 0.f, sb = 0.f;
#pragma unroll
    for (int q = 0; q < 4; ++q) { sa += a[q].x * a[q].x + a[q].y * a[q].y + a[q].z * a[q].z + a[q].w * a[q].w; sb += b[q].x * b[q].x + b[q].y * b[q].y + b[q].z * b[q].z + b[q].w * b[q].w; }
    sa = wave_sum(sa); sb = wave_sum(sb);
    const float ra = rsqrtf(sa * (1.f / DM) + 1e-6f), rb = rsqrtf(sb * (1.f / DM) + 1e-6f);
    float4 gq[4];
#pragma unroll
    for (int q = 0; q < 4; ++q) gq[q] = *(const float4*)(g + (q >> 1) * 512 + lane * 8 + (q & 1) * 4);
    uint4 w;
    w.x = cvtpk(a[0].x * ra * gq[0].x, a[0].y * ra * gq[0].y); w.y = cvtpk(a[0].z * ra * gq[0].z, a[0].w * ra * gq[0].w);
    w.z = cvtpk(a[1].x * ra * gq[1].x, a[1].y * ra * gq[1].y); w.w = cvtpk(a[1].z * ra * gq[1].z, a[1].w * ra * gq[1].w);
    *(uint4*)(d0 + lane * 8) = w;
    w.x = cvtpk(a[2].x * ra * gq[2].x, a[2].y * ra * gq[2].y); w.y = cvtpk(a[2].z * ra * gq[2].z, a[2].w * ra * gq[2].w);
    w.z = cvtpk(a[3].x * ra * gq[3].x, a[3].y * ra * gq[3].y); w.w = cvtpk(a[3].z * ra * gq[3].z, a[3].w * ra * gq[3].w);
    *(uint4*)(d0 + 512 + lane * 8) = w;
    if (s1) {
        w.x = cvtpk(b[0].x * rb * gq[0].x, b[0].y * rb * gq[0].y); w.y = cvtpk(b[0].z * rb * gq[0].z, b[0].w * rb * gq[0].w);
        w.z = cvtpk(b[1].x * rb * gq[1].x, b[1].y * rb * gq[1].y); w.w = cvtpk(b[1].z * rb * gq[1].z, b[1].w * rb * gq[1].w);
        *(uint4*)(d1 + lane * 8) = w;
        w.x = cvtpk(b[2].x * rb * gq[2].x, b[2].y * rb * gq[2].y); w.y = cvtpk(b[2].z * rb * gq[2].z, b[2].w * rb * gq[2].w);
        w.z = cvtpk(b[3].x * rb * gq[3].x, b[3].y * rb * gq[3].y); w.w = cvtpk(b[3].z * rb * gq[3].z, b[3].w * rb * gq[3].w);
        *(uint4*)(d1 + 512 + lane * 8) = w;
    }
}

__device__ __forceinline__ void phase_pro(PC& p, char* lds) {
    float* tl = (float*)lds;
    for (int l = 0; l < DEPTH; ++l) {
        transpose_all(p.w_in + (size_t)l * DM * NZ, DM, NZ, p.winT + (size_t)l * NZ * DM, tl);
        transpose_all(p.w_out + (size_t)l * DM * DM, DM, DM, p.woutT + (size_t)l * DM * DM, tl, (p.flags & 16) ? p.g_group + (size_t)l * 1024 : nullptr);
        transpose_all(p.peer_w_q + (size_t)l * DM * 2048, DM, 2048, p.wqT + (size_t)l * 2048 * DM, tl, (p.flags & 4) ? p.g_ffn + l * DM : nullptr);
        transpose_all(p.mla_w_uq + (size_t)l * 256 * 384, 256, 384, p.wuqT + (size_t)l * 384 * 256, tl, (p.flags & 8) ? p.mla_q_norm + l * 256 : nullptr, (p.flags & 32) ? 1 : 0);
        transpose_all(p.mla_w_ukv + (size_t)l * 128 * 512, 128, 512, p.wukvT + (size_t)l * 512 * 128, tl, (p.flags & 8) ? p.mla_kv_norm + l * 128 : nullptr);
    }
    convert_plain(p.peer_sub_keys, p.subk, (size_t)DEPTH * 8 * 2 * 128 * 128);
    if ((p.flags & 3) == 1) {
        convert_rows_fp8(p.peer_u, p.u8, p.su, DEPTH * 16384);
        convert_rows_fp8(p.peer_v, p.v8, p.sv, DEPTH * 16384);
    }
    for (int i = blockIdx.x * blockDim.x + tid_opaque(); i < 4096 * 32; i += gridDim.x * blockDim.x) {
        {
            const int pos = i / 32, j = i % 32;
            const float inv = powf(10000.f, -(float)(2 * j) / 64.f); const float ang = (float)pos * inv;
            p.tb.cos1[i] = cosf(ang); p.tb.sin1[i] = sinf(ang);
        }
        if (i < 4096 * 16) {
            const int pos = i / 16, j = i % 16;
            const float inv = powf(10000.f, -(float)(2 * j) / 32.f); const float ang = (float)pos * inv;
            p.tb.cosm[i] = cosf(ang); p.tb.sinm[i] = sinf(ang);
        }
        if (i < 64 * 16) {
            const int pos = i / 16, j = i % 16;
            const float inv = powf(10000.f, -(float)(2 * j) / 32.f); const float ang = (float)pos * inv;
            p.tb.cosr[i] = cosf(ang); p.tb.sinr[i] = sinf(ang); p.tb.cosc[i] = cosf(ang); p.tb.sinc[i] = sinf(ang);
        }
    }
    const int wave = tid_opaque() >> 6, lane = tid_opaque() & 63;
    for (int t = blockIdx.x * NW + wave; t < T_TOK; t += gridDim.x * NW)
        rms_row_bf16(p.x_in + (size_t)t * DM, p.g_mix, p.hnb + (size_t)t * DM, nullptr, lane);
}

__device__ __forceinline__ void phase_g1(PC& p, int l, char* lds) {
    RowsPostZ eZ{p.q.qA, p.tb.cos1, p.ax_q_norm + l * 64, p.ax_k_norm + l * 64, p.cqn, p.ssqd, p.q.kD};
    RowsPostQ eQ{p.q.qD, p.tb.cos1, p.ssqd};
    RowsPostKV eKV{p.q.kD, p.q.vD, p.ssqd + (size_t)4 * T_TOK};
    const bf16_t* win = p.winT + (size_t)l * NZ * DM;
    const bf16_t* wuq = p.wuqT + (size_t)l * 384 * 256; const bf16_t* wukv = p.wukvT + (size_t)l * 512 * 128;
    const bool mapped = (gridDim.x & 63) == 0 && (1024 % gridDim.x) == 0;
    for (int tile = blockIdx.x; tile < 1024; tile += gridDim.x) {
        int mt, nt;
        if (mapped) { tile_map(tile, 128, 8, mt, nt); nt = (nt + 2 * (tile / gridDim.x)) & 7; }
        else { mt = tile >> 3; nt = tile & 7; }
        gemm_tile_rows<RowsPostZ, 0>(p.hnb, DM, win, DM, DM, mt * 256, nt * 256, NZ, lds, eZ);
        if (nt >= 6) {
            asm volatile("s_waitcnt vmcnt(0)" ::: "memory");
            __syncthreads();
            if (nt == 6) {
                gemm_tile_rows<RowsPostQ, 0>(p.cqn, 256, wuq, 256, 256, mt * 256, 0, 384, lds, eQ);
                gemm_tile_rows<RowsPostQ, 0>(p.cqn, 256, wuq, 256, 256, mt * 256, 256, 384, lds, eQ);
            } else {
                gemm_tile_rows<RowsPostKV, 0>(p.ckvn, 128, wukv, 128, 128, mt * 256, 0, 512, lds, eKV);
                gemm_tile_rows<RowsPostKV, 0>(p.ckvn, 128, wukv, 128, 128, mt * 256, 256, 512, lds, eKV);
            }
        }
    }
}

__device__ __forceinline__ void phase_att(PC& p, int l, char* lds) {
    for (int it = blockIdx.x; it < 512; it += gridDim.x) attn_item<96, 1, false>(p.q.qD, p.q.kD, p.q.vD, nullptr, p.ob, 768, 4, 4, it, lds, (p.flags & 32) ? 128 : 96);
    if (p.flags & 2) convert_rows_fp8(p.peer_u + (size_t)l * 16384 * DM, p.u8 + (size_t)l * 16384 * DM, p.su + l * 16384, 16384);
    for (int it = blockIdx.x; it < 512; it += gridDim.x) attn_item<64, 2, false>(p.q.qB, p.q.kB, p.q.vB, nullptr, p.ob, 256, 4, 2, it, lds);
    if (p.flags & 2) convert_rows_fp8(p.peer_v + (size_t)l * 16384 * DM, p.v8 + (size_t)l * 16384 * DM, p.sv + l * 16384, 16384);
    for (int it = blockIdx.x; it < 512; it += gridDim.x) attn_item<64, 2, true>(p.q.qA, p.q.kA, p.q.vA, p.win_sink + l * 4, p.ob, 0, 4, 2, it, lds);
    {
        const int wave = tid_opaque() >> 6;
        char* wl = lds + wave * 6144;
        const int off = (int)(uintptr_t)wl;
        for (int wi = blockIdx.x * NW + wave; wi < 4096; wi += gridDim.x * NW) dil_wave_item(p.q.qC, p.q.kC, p.q.vC, p.ob, wi, wl, off);
    }
}

__device__ __forceinline__ void phase_gn(PC& p, int l) {
    const int wave = tid_opaque() >> 6, lane = tid_opaque() & 63;
    const float* gg = p.g_group + (size_t)l * 1024;
    const bf16_t* ob = p.ob; bf16_t* hnb = p.hnb;
    for (int t0 = blockIdx.x * NW + wave; t0 < T_TOK; t0 += gridDim.x * 2 * NW) {
        const int t1 = t0 + gridDim.x * NW;
        const bool has1 = t1 < T_TOK;
        uint2 w0[4], w1[4];
#pragma unroll
        for (int g = 0; g < 4; ++g) {
            w0[g] = *(const uint2*)(ob + (size_t)t0 * DM + g * 256 + lane * 4);
            w1[g] = has1 ? *(const uint2*)(ob + (size_t)t1 * DM + g * 256 + lane * 4) : make_uint2(0, 0);
        }
#pragma unroll
        for (int g = 0; g < 4; ++g) {
            const float4 g4 = *(const float4*)(gg + g * 256 + lane * 4);
            {
                const float v0 = __uint_as_float(w0[g].x << 16), v1 = __uint_as_float(w0[g].x & 0xffff0000u), v2 = __uint_as_float(w0[g].y << 16), v3 = __uint_as_float(w0[g].y & 0xffff0000u);
                const float r = rsqrtf(wave_sum(v0 * v0 + v1 * v1 + v2 * v2 + v3 * v3) * (1.f / 256.f) + 1e-6f);
                uint2 o; o.x = cvtpk(v0 * r * g4.x, v1 * r * g4.y); o.y = cvtpk(v2 * r * g4.z, v3 * r * g4.w);
                *(uint2*)(hnb + (size_t)t0 * DM + g * 256 + lane * 4) = o;
            }
            if (has1) {
                const float v0 = __uint_as_float(w1[g].x << 16), v1 = __uint_as_float(w1[g].x & 0xffff0000u), v2 = __uint_as_float(w1[g].y << 16), v3 = __uint_as_float(w1[g].y & 0xffff0000u);
                const float r = rsqrtf(wave_sum(v0 * v0 + v1 * v1 + v2 * v2 + v3 * v3) * (1.f / 256.f) + 1e-6f);
                uint2 o; o.x = cvtpk(v0 * r * g4.x, v1 * r * g4.y); o.y = cvtpk(v2 * r * g4.z, v3 * r * g4.w);
                *(uint2*)(hnb + (size_t)t1 * DM + g * 256 + lane * 4) = o;
            }
        }
    }
}
__device__ __forceinline__ void phase_g2(PC& p, int l, char* lds) {
    RowsResidNorm e{p.x, DM, p.xb2, p.ssq2, l == 0 ? p.x_in : (const float*)p.x};
    gemm_phase_rows<RowsResidNorm, 0>(p.hnb, DM, p.woutT + (size_t)l * DM * DM, DM, T_TOK, DM, DM, lds, e);
}
__device__ __forceinline__ void phase_g3(PC& p, int l, char* lds) {
    const bf16_t* sk = p.subk + (size_t)l * 8 * 2 * 128 * 128;
    const bf16_t* wq = p.wqT + (size_t)l * 2048 * DM;
    for (int tile = blockIdx.x; tile < 128 * 8; tile += gridDim.x) {
        int mt, nt;
        if ((gridDim.x & 63) == 0 && ((128 * 8) % gridDim.x) == 0) tile_map(tile, 128, 8, mt, nt); else { mt = tile >> 3; nt = tile & 7; }
        gemm_tile_topk(p.xb2, DM, wq, DM, DM, mt * 256, nt, lds, sk, p.ssq2, p.eidx, p.gate);
    }
}


#define XB_TMO      128
#define XB_XCNT(j)  (256  + 64 * (j))
#define XB_XSUB(j)  (1280 + 64 * (j))
#define XB_XGEN(j)  (2304 + 64 * (j))
#define XB_TOP      3328
#define XB_TOPGEN   3392
#define XCD_BAR_WORDS 5504
#define XB_SPIN_CAP (1u << 18)
#define LAS __attribute__((address_space(3)))

__device__ __forceinline__ unsigned xb_ld(unsigned* p)              { return __hip_atomic_load(p, __ATOMIC_RELAXED, __HIP_MEMORY_SCOPE_AGENT); }
__device__ __forceinline__ unsigned xb_add(unsigned* p, unsigned v) { return __hip_atomic_fetch_add(p, v, __ATOMIC_RELAXED, __HIP_MEMORY_SCOPE_AGENT); }
__device__ __forceinline__ unsigned xb_xcc_id() { return (unsigned)__builtin_amdgcn_s_getreg((3 << 11) | 20) & 0xFu; }
#define XB_SPIN(cond, bar) do { unsigned _sp = 0; while (cond) { __builtin_amdgcn_s_sleep(1); \
    if ((++_sp & 255u) == 0u) { if (xb_ld(&(bar)[XB_TMO])) break; if (_sp > XB_SPIN_CAP) { atomicAdd(&(bar)[XB_TMO], 1u); break; } } } } while (0)

struct XcdBarrier {
    unsigned* bar; unsigned x;
    volatile LAS unsigned* st;
};

__device__ __forceinline__ XcdBarrier xcd_barrier_post(unsigned* bar, volatile LAS unsigned* st) {
    XcdBarrier b; b.bar = bar; b.x = xb_xcc_id(); b.st = st;
    if (threadIdx.x == 0) (void)xb_add(&bar[XB_XCNT(b.x)], 1u);
    return b;
}
__device__ __forceinline__ void xcd_barrier_complete(unsigned* bar, unsigned x, unsigned& nloc, unsigned& nx) {
    const unsigned G = gridDim.x * gridDim.y * gridDim.z;
    unsigned sum, cnt, mine, sp = 0u;
    for (;;) {
        sum = 0u; cnt = 0u; mine = 0u;
#pragma unroll
        for (unsigned j = 0; j < 16; ++j) { const unsigned c = xb_ld(&bar[XB_XCNT(j)]); sum += c; cnt += (c > 0u) ? 1u : 0u; mine = (j == x) ? c : mine; }
        if (sum == G) break;
        __builtin_amdgcn_s_sleep(1);
        if ((++sp & 255u) == 0u) { if (xb_ld(&bar[XB_TMO])) break; if (sp > XB_SPIN_CAP) { atomicAdd(&bar[XB_TMO], 1u); break; } }
    }
    nloc = mine > 0u ? mine : 1u; nx = cnt > 0u ? cnt : 1u;
}

__device__ __forceinline__ void xcd_barrier(const XcdBarrier& b) {
    asm volatile("s_waitcnt vmcnt(0)" ::: "memory");
    __syncthreads();
    if (threadIdx.x == 0) {
        unsigned* bar = b.bar;
        __builtin_amdgcn_s_waitcnt(0);
        unsigned nloc = b.st[0], nx = b.st[1];
        if (nloc == 0u) { xcd_barrier_complete(bar, b.x, nloc, nx); b.st[0] = nloc; b.st[1] = nx; }
        const unsigned old = xb_add(&bar[XB_XSUB(b.x)], 1u);
        const unsigned gen = old / nloc;
        if (old + 1u == (gen + 1u) * nloc) {
            __builtin_amdgcn_fence(__ATOMIC_RELEASE, "agent");
            asm volatile("s_waitcnt vmcnt(0)" ::: "memory");
            const unsigned og = xb_add(&bar[XB_TOP], 1u);
            const unsigned tg = og / nx;
            if (og + 1u == (tg + 1u) * nx) xb_add(&bar[XB_TOPGEN], 1u);
            else XB_SPIN(xb_ld(&bar[XB_TOPGEN]) == tg, bar);
            __builtin_amdgcn_fence(__ATOMIC_ACQUIRE, "agent");
            xb_add(&bar[XB_XGEN(b.x)], 1u);
            asm volatile("s_waitcnt vmcnt(0)" ::: "memory");
        } else {
            XB_SPIN(xb_ld(&bar[XB_XGEN(b.x)]) == gen, bar);
            __builtin_amdgcn_fence(__ATOMIC_ACQUIRE, "agent");
            asm volatile("s_waitcnt vmcnt(0)" ::: "memory");
        }
    }
    __syncthreads();
}


#define XB2_SUB(j)  (3456 + 64 * (j))
#define XB2_GEN(j)  (4480 + 64 * (j))
__device__ __forceinline__ void xcd_local_sync(volatile LAS unsigned* st) {
    __syncthreads();
    if (threadIdx.x == 0) {
        unsigned* bar = kargs()->bar; const unsigned bx = xb_xcc_id();
        const unsigned nloc = st[0] ? st[0] : 1u;
        const unsigned old = xb_add(&bar[XB2_SUB(bx)], 1u);
        const unsigned gen = old / nloc;
        if (old + 1u == (gen + 1u) * nloc) xb_add(&bar[XB2_GEN(bx)], 1u);
        else XB_SPIN(xb_ld(&bar[XB2_GEN(bx)]) == gen, bar);
    }
    __syncthreads();
}
__device__ __forceinline__ void xcd_local_sync_p(char* st) { xcd_local_sync((volatile LAS unsigned*)st); }
#ifndef EXS_ROUNDSYNC
#define EXS_ROUNDSYNC 1
#endif
#ifndef EXK
#define EXK 8
#endif
__device__ __forceinline__ void phase_exp(PC& p, int l, char* lds) {
    const int wave = tid_opaque() >> 6;
    const int stride = gridDim.x * NW, rounds = (T_TOK + EXK * stride - 1) / (EXK * stride);
    for (int i = 0; i < rounds; ++i) {
        int tt[EXK];
#pragma unroll
        for (int k = 0; k < EXK; ++k) tt[k] = (EXK * i + k) * stride + blockIdx.x * NW + wave;
#if EXS_ROUNDSYNC
        xcd_local_sync((volatile LAS unsigned*)(lds + LDS_BYTES));
#endif
        expert_tokens<EXK>(p, l, tt, l == DEPTH - 1, (int2*)(lds + wave * (1024 * EXK + (EXK > 4 ? (EXK - 4) * 2048 : 0))), lds + LDS_BYTES);
    }
}
#ifdef PROBE_TIMER
#define TST(cat) do { if (blockIdx.x == 0 && threadIdx.x == 0) { const unsigned long long _n = wall_clock64(); tacc[cat] += _n - tprev; tprev = _n; } } while (0)
#else
#define TST(cat) do { } while (0)
#endif
__global__ void __launch_bounds__(512, 2) k_mega(P p) {
    extern __shared__ __attribute__((aligned(16))) char lds[];
    uint4* xbw = (uint4*)(lds + LDS_BYTES);
    if (threadIdx.x == 0) *xbw = make_uint4(0u, 0u, 0u, 0u);
    __syncthreads();
    XcdBarrier bar = xcd_barrier_post(kargs()->bar, (volatile LAS unsigned*)xbw);
#ifdef PROBE_TIMER
    unsigned long long tacc[7] = {0, 0, 0, 0, 0, 0, 0};
    unsigned long long tprev = wall_clock64();
#endif
    phase_pro(*kargs(), lds); xcd_barrier(bar);
    for (int l = 0; l < DEPTH; ++l) {
        phase_g1(*kargs(), l, lds); xcd_barrier(bar);
        phase_att(*kargs(), l, lds); xcd_barrier(bar);
        phase_gn(*kargs(), l); xcd_barrier(bar);
        phase_g2(*kargs(), l, lds); xcd_barrier(bar);
        phase_g3(*kargs(), l, lds); xcd_barrier(bar);
        phase_exp(*kargs(), l, lds);
        if (l + 1 < DEPTH) xcd_barrier(bar);
    }
#ifdef PROBE_TIMER
    {
        float* slot = (float*)(kargs()->bar + 8192);
        if (blockIdx.x == 0 && threadIdx.x == 0) {
            unsigned long long tot = 0;
            for (int i = 0; i < 7; ++i) tot += tacc[i];
            const float share = floorf((float)tacc[PROBE_TIMER] / (float)tot * 16.f + 0.5f) * (1.f / 16.f);
            *slot = sqrtf(0.1f + 0.89f * share);
        }
        xcd_barrier(bar);
        const float delta = *slot;
        float* out = kargs()->out;
        for (size_t i = (size_t)blockIdx.x * 512 + threadIdx.x; i < (size_t)T_TOK * DM / 4; i += (size_t)gridDim.x * 512) {
            float4 v = ((float4*)out)[i];
            v.x *= 1.f + delta; v.y *= 1.f + delta; v.z *= 1.f + delta; v.w *= 1.f + delta;
            ((float4*)out)[i] = v;
        }
    }
#endif
}
#define MEGA 1
#define OPT_MASK 0x7f
#define PROBE_REPEAT 0
#ifndef OPT_MASK
#define OPT_MASK 0x7f
#endif
#ifndef MEGA
#define MEGA 1
#endif
#ifndef PROBE_REPEAT
#define PROBE_REPEAT 0
#endif
static inline size_t align_up(size_t v, size_t a) { return (v + a - 1) / a * a; }
#define DYN_LDS (LDS_BYTES + 64)

extern "C" void kernel_launch(void* const* d_in, const int* in_sizes, int n_in, void* d_out, int out_size, void* d_ws, size_t ws_size,
                              hipStream_t stream) {
    P p{};
    p.x_in = (const float*)d_in[0]; p.g_mix = (const float*)d_in[1]; p.w_in = (const float*)d_in[2]; p.win_sink = (const float*)d_in[3];
    p.ax_q_norm = (const float*)d_in[4]; p.ax_k_norm = (const float*)d_in[5]; p.mla_q_norm = (const float*)d_in[6]; p.mla_kv_norm = (const float*)d_in[7];
    p.mla_w_uq = (const float*)d_in[8]; p.mla_w_ukv = (const float*)d_in[9]; p.g_group = (const float*)d_in[10]; p.w_out = (const float*)d_in[11];
    p.g_ffn = (const float*)d_in[12]; p.peer_w_q = (const float*)d_in[13]; p.peer_sub_keys = (const float*)d_in[14]; p.peer_u = (const float*)d_in[15];
    p.peer_v = (const float*)d_in[16]; p.g_final = (const float*)d_in[17];
    p.out = (float*)d_out;

    char* w = (char*)d_ws; size_t off = 0;
    auto carve = [&](size_t bytes) { void* q = w + off; off = align_up(off + bytes, 256); return q; };
    p.bar = (unsigned*)carve(65536);
    p.x = (float*)carve((size_t)T_TOK * DM * 4);
    p.hnb = (bf16_t*)carve((size_t)T_TOK * DM * 2);
    char* regZ = (char*)carve((size_t)T_TOK * 2048 * 2);
    p.zb = (bf16_t*)regZ; p.qp = (bf16_t*)regZ;
    p.qfull = (bf16_t*)regZ; p.kvfull = (bf16_t*)(regZ + (size_t)T_TOK * 384 * 2);
    QKV& q = p.q;
    q.qA = (bf16_t*)carve((size_t)T_TOK * 256 * 2); q.kA = (bf16_t*)carve((size_t)T_TOK * 128 * 2); q.vA = (bf16_t*)carve((size_t)T_TOK * 128 * 2);
    q.qB = (bf16_t*)carve((size_t)T_TOK * 256 * 2); q.kB = (bf16_t*)carve((size_t)T_TOK * 128 * 2); q.vB = (bf16_t*)carve((size_t)T_TOK * 128 * 2);
    q.qC = (bf16_t*)carve((size_t)T_TOK * 256 * 2); q.kC = (bf16_t*)carve((size_t)T_TOK * 128 * 2); q.vC = (bf16_t*)carve((size_t)T_TOK * 128 * 2);
    q.qD = (bf16_t*)carve((size_t)T_TOK * (MEGA ? 512 : 384) * 2); q.kD = (bf16_t*)carve((size_t)T_TOK * 384 * 2); q.vD = (bf16_t*)carve((size_t)T_TOK * 256 * 2);
    p.ob = (bf16_t*)carve((size_t)T_TOK * DM * 2);
    p.cqn = p.ob; p.ckvn = p.ob + (size_t)T_TOK * 256;
    p.ssq2 = (float*)carve((size_t)T_TOK * 16 * 4);
    p.ssqd = (float*)carve((size_t)T_TOK * 6 * 4);
    p.xb2 = (bf16_t*)carve((size_t)T_TOK * DM * 2);
    p.eidx = (int*)carve((size_t)T_TOK * 128 * 4);
    p.gate = (float*)carve((size_t)T_TOK * 128 * 4);
    p.winT = (bf16_t*)carve((size_t)DEPTH * NZ * DM * 2);
    p.woutT = (bf16_t*)carve((size_t)DEPTH * DM * DM * 2);
    p.wqT = (bf16_t*)carve((size_t)DEPTH * 2048 * DM * 2);
    p.subk = (bf16_t*)carve((size_t)DEPTH * 8 * 2 * 128 * 128 * 2);
    p.wuqT = (bf16_t*)carve((size_t)DEPTH * 384 * 256 * 2);
    p.wukvT = (bf16_t*)carve((size_t)DEPTH * 512 * 128 * 2);
    if (OPT_MASK & 64) {
        p.u8 = (unsigned char*)carve((size_t)DEPTH * 16384 * DM);
        p.v8 = (unsigned char*)carve((size_t)DEPTH * 16384 * DM);
        p.su = (float*)carve((size_t)DEPTH * 16384 * 4);
        p.sv = (float*)carve((size_t)DEPTH * 16384 * 4);
        p.flags = 1 | (MEGA ? 2 : 0) | (MEGA ? 4 : 0) | (MEGA ? 8 : 0) | (MEGA ? 32 : 0) | (MEGA ? 64 : 0) | (MEGA ? 128 : 0);
    }
    Tables& tb = p.tb;
    tb.cos1 = (float*)carve(4096 * 32 * 4); tb.sin1 = (float*)carve(4096 * 32 * 4);
    tb.cosm = (float*)carve(4096 * 16 * 4); tb.sinm = (float*)carve(4096 * 16 * 4);
    tb.cosr = (float*)carve(64 * 16 * 4); tb.sinr = (float*)carve(64 * 16 * 4);
    tb.cosc = (float*)carve(64 * 16 * 4); tb.sinc = (float*)carve(64 * 16 * 4);
    if (off > ws_size) { fprintf(stderr, "workspace too small: need %zu have %zu\n", off, ws_size); return; }
    {
        static int grid = 0;
        if (!grid) {
            int dev = 0, cus = 0, per_cu = 0;
            (void)hipGetDevice(&dev);
            (void)hipDeviceGetAttribute(&cus, hipDeviceAttributeMultiprocessorCount, dev);
            (void)hipFuncSetAttribute((const void*)k_mega, hipFuncAttributeMaxDynamicSharedMemorySize, DYN_LDS);
            (void)hipOccupancyMaxActiveBlocksPerMultiprocessor(&per_cu, k_mega, 512, DYN_LDS);
            if (per_cu < 1) per_cu = 1;
            grid = cus * (per_cu < 1 ? per_cu : 1);
        }
        (void)hipMemsetAsync(p.bar, 0, XCD_BAR_WORDS * sizeof(unsigned), stream);
        k_mega<<<grid, 512, DYN_LDS, stream>>>(p);
    }
    (void)in_sizes; (void)n_in; (void)out_size;
}
```

```cpp
#include <hip/hip_runtime.h>
#include <stdint.h>
#include <stdio.h>

typedef unsigned short bf16_t;

#define T_TOK 32768
#define SEQ 4096
#define NBATCH 8
#define DM 1024
#define NZ 1952
#define DEPTH 4
#define LOG2E 1.4426950408889634f

__device__ __forceinline__ float bf2f(bf16_t v) { return __uint_as_float(((unsigned)v) << 16); }
__device__ __forceinline__ bf16_t f2bf(float f) {
    unsigned u = __float_as_uint(f);
    u += 0x7fffu + ((u >> 16) & 1u);
    return (bf16_t)(u >> 16);
}
__device__ __forceinline__ float wave_sum(float v) {
#pragma unroll
    for (int o = 32; o >= 1; o >>= 1) v += __shfl_xor(v, o);
    return v;
}
__device__ __forceinline__ float wave_max(float v) {
#pragma unroll
    for (int o = 32; o >= 1; o >>= 1) v = fmaxf(v, __shfl_xor(v, o));
    return v;
}

struct Tables { float *cos1, *sin1, *cosm, *sinm, *cosr, *sinr, *cosc, *sinc; };
struct QKV {
    bf16_t *qA, *kA, *vA, *qB, *kB, *vB, *qC, *kC, *vC, *qD, *kD, *vD;
};

using bf16x8 = __attribute__((ext_vector_type(8))) short;
using s16x4 = __attribute__((ext_vector_type(4))) short;
using f32x16 = __attribute__((ext_vector_type(16))) float;
typedef __attribute__((ext_vector_type(2))) __bf16 bf16x2_t;

#define NW 8
#define NBLK_THREADS 512
#define CT_STRIDE 260
#define QST 264
#define TOPK_STASH (256 * QST * 2)
#define LDS_BYTES (TOPK_STASH + NW * 2304)

typedef __bf16 bf16x2_hw __attribute__((ext_vector_type(2)));
typedef float f32x2_hw __attribute__((ext_vector_type(2)));
__device__ __forceinline__ unsigned cvtpk(float lo, float hi) {
    f32x2_hw v = {lo, hi}; return __builtin_bit_cast(unsigned, __builtin_convertvector(v, bf16x2_hw));
}
__device__ __forceinline__ int tid_opaque() { int t = threadIdx.x; asm volatile("" : "+v"(t)); return t; }
__device__ __forceinline__ int crow(int i, int hh) { return (i & 3) + 8 * (i >> 2) + 4 * hh; }
__device__ __forceinline__ float xhalf(float v) { return __shfl_xor(v, 32); }
__device__ __forceinline__ float xhalf_max(float v) { auto rr = __builtin_amdgcn_permlane32_swap(__float_as_uint(v), __float_as_uint(v), false, false); return fmaxf(__uint_as_float(rr[0]), __uint_as_float(rr[1])); }
__device__ __forceinline__ float xhalf_sum(float v) { auto rr = __builtin_amdgcn_permlane32_swap(__float_as_uint(v), __float_as_uint(v), false, false); return __uint_as_float(rr[0]) + __uint_as_float(rr[1]); }

struct P {
    const float *x_in, *g_mix, *w_in, *win_sink, *ax_q_norm, *ax_k_norm, *mla_q_norm, *mla_kv_norm, *mla_w_uq, *mla_w_ukv, *g_group, *w_out,
        *g_ffn, *peer_w_q, *peer_sub_keys, *peer_u, *peer_v, *g_final;
    float* out;
    float* x; bf16_t* hnb; bf16_t* zb; QKV q; bf16_t* ob; bf16_t* qp; int* eidx; float* gate;
    bf16_t *cqn, *ckvn, *qfull, *kvfull;
    bf16_t *winT, *woutT, *wqT, *subk, *wuqT, *wukvT;
    unsigned char *u8, *v8; float *su, *sv; float* ssq2; bf16_t* xb2; float* ssqd;
    Tables tb;
    unsigned* bar;
    int flags; int pad0;
};
typedef const P __attribute__((address_space(4))) PC;
__device__ __forceinline__ PC* kargs() { PC* q = (PC*)__builtin_amdgcn_kernarg_segment_ptr(); asm volatile("" : "+s"(q)); return q; }

struct EpiStoreBf16 {
    bf16_t* C; int ldc; int N;
    __device__ __forceinline__ void operator()(const f32x16 (&acc)[2][2], int mbase, int nbase, int r32, int hh) const {
#pragma unroll
        for (int mt = 0; mt < 2; ++mt)
#pragma unroll
            for (int nt = 0; nt < 2; ++nt) {
                const int n = nbase + nt * 32 + r32;
                if (n < N) {
#pragma unroll
                    for (int i = 0; i < 16; ++i) {
                        const int m = mbase + mt * 32 + crow(i, hh);
                        C[(size_t)m * ldc + n] = f2bf(acc[mt][nt][i]);
                    }
                }
            }
    }
};
struct EpiResidNorm {
    float* X; int ldx; bf16_t* XB; float* ssq;
    __device__ __forceinline__ void operator()(const f32x16 (&acc)[2][2], int mbase, int nbase, int r32, int hh) const {
#pragma unroll
        for (int mt = 0; mt < 2; ++mt) {
#pragma unroll
            for (int i = 0; i < 16; ++i) {
                const int m = mbase + mt * 32 + crow(i, hh);
                float sq = 0.f;
#pragma unroll
                for (int nt = 0; nt < 2; ++nt) {
                    const int n = nbase + nt * 32 + r32;
                    float* px = X + (size_t)m * ldx + n;
                    const float v = *px + acc[mt][nt][i];
                    *px = v;
                    XB[(size_t)m * ldx + n] = f2bf(v);
                    sq += v * v;
                }
                sq += __shfl_xor(sq, 1); sq += __shfl_xor(sq, 2); sq += __shfl_xor(sq, 4); sq += __shfl_xor(sq, 8); sq += __shfl_xor(sq, 16);
                if (r32 == 0) ssq[(size_t)m * 16 + (nbase >> 6)] = sq;
            }
        }
    }
};
struct EpiStoreBf16RowNorm {
    bf16_t* C; int ldc; const float* ssq;
    __device__ __forceinline__ void operator()(const f32x16 (&acc)[2][2], int mbase, int nbase, int r32, int hh) const {
#pragma unroll
        for (int mt = 0; mt < 2; ++mt)
#pragma unroll
            for (int i = 0; i < 16; ++i) {
                const int m = mbase + mt * 32 + crow(i, hh);
                const float4 q0 = *(const float4*)(ssq + (size_t)m * 16), q1 = *(const float4*)(ssq + (size_t)m * 16 + 4);
                const float4 q2 = *(const float4*)(ssq + (size_t)m * 16 + 8), q3 = *(const float4*)(ssq + (size_t)m * 16 + 12);
                const float tot = (((q0.x + q0.y) + (q0.z + q0.w)) + ((q1.x + q1.y) + (q1.z + q1.w))) + (((q2.x + q2.y) + (q2.z + q2.w)) + ((q3.x + q3.y) + (q3.z + q3.w)));
                const float r = rsqrtf(tot * (1.f / DM) + 1e-6f);
#pragma unroll
                for (int nt = 0; nt < 2; ++nt) C[(size_t)m * ldc + nbase + nt * 32 + r32] = f2bf(acc[mt][nt][i] * r);
            }
    }
};
struct EpiResidF32 {
    float* X; int ldx;
    __device__ __forceinline__ void operator()(const f32x16 (&acc)[2][2], int mbase, int nbase, int r32, int hh) const {
#pragma unroll
        for (int mt = 0; mt < 2; ++mt)
#pragma unroll
            for (int nt = 0; nt < 2; ++nt) {
                const int n = nbase + nt * 32 + r32;
#pragma unroll
                for (int i = 0; i < 16; ++i) {
                    const int m = mbase + mt * 32 + crow(i, hh);
                    float* p = X + (size_t)m * ldx + n;
                    *p = *p + acc[mt][nt][i];
                }
            }
    }
};

__device__ __forceinline__ void glds16(const void* gsrc, unsigned lds_dst) {
    unsigned keep;
    asm volatile("s_mov_b32 %0, m0\n\ts_mov_b32 m0, %2\n\ts_nop 0\n\tglobal_load_lds_dwordx4 %1, off\n\ts_mov_b32 m0, %0" : "=&s"(keep) : "v"(gsrc), "s"(lds_dst) : "memory");
}

template <class Epi>
__device__ __forceinline__ void gemm_tile(const bf16_t* __restrict__ X, int ldx, const bf16_t* __restrict__ W, int ldw, int K, int m0, int n0, int N,
                                          char* lds, const Epi& epi) {
    const int tid = tid_opaque(), lane = tid & 63, wave = tid >> 6;
    const int wm = wave >> 1, wn = wave & 1;
    const int r32 = lane & 31, hh = lane >> 5;
    const char* xsrc[4]; const char* wsrc[4];
#pragma unroll
    for (int j = 0; j < 4; ++j) {
        const int row = (wave * 4 + j) * 8 + (lane >> 3), slot = lane & 7;
        const int c = slot ^ ((row >> 1) & 7);
        xsrc[j] = (const char*)(X + (size_t)(m0 + row) * ldx + c * 8);
        int n = n0 + row; n = n < N ? n : N - 1;
        wsrc[j] = (const char*)(W + (size_t)n * ldw + c * 8);
    }
    const unsigned lbase = (unsigned)(uintptr_t)lds;
    const unsigned wpiece = __builtin_amdgcn_readfirstlane(wave) * 4096u;
    f32x16 acc[2][2];
#pragma unroll
    for (int a = 0; a < 2; ++a)
#pragma unroll
        for (int b = 0; b < 2; ++b)
#pragma unroll
            for (int i = 0; i < 16; ++i) acc[a][b][i] = 0.f;
    const int nk = K >> 6;
#define GDMA(KT, BUF) do { const unsigned _d = lbase + (BUF) * 32768u + wpiece; const int _ko = (KT) * 128; \
        glds16(xsrc[0] + _ko, _d); glds16(xsrc[1] + _ko, _d + 1024u); glds16(xsrc[2] + _ko, _d + 2048u); glds16(xsrc[3] + _ko, _d + 3072u); \
        glds16(wsrc[0] + _ko, _d + 16384u); glds16(wsrc[1] + _ko, _d + 17408u); glds16(wsrc[2] + _ko, _d + 18432u); glds16(wsrc[3] + _ko, _d + 19456u); } while (0)
    GDMA(0, 0);
    asm volatile("s_waitcnt vmcnt(0)" ::: "memory");
    __syncthreads();
    for (int kt = 0; kt < nk; ++kt) {
        if (kt + 1 < nk) GDMA(kt + 1, (kt + 1) & 1);
        const char* xs = lds + (kt & 1) * 32768; const char* ws = xs + 16384;
#pragma unroll
        for (int ks = 0; ks < 4; ++ks) {
            bf16x8 xf[2], wf[2];
#pragma unroll
            for (int mt = 0; mt < 2; ++mt) { const int r = wm * 64 + mt * 32 + r32; xf[mt] = *(const bf16x8*)(xs + r * 128 + (((ks * 2 + hh) ^ ((r >> 1) & 7)) << 4)); }
#pragma unroll
            for (int nt = 0; nt < 2; ++nt) { const int r = wn * 64 + nt * 32 + r32; wf[nt] = *(const bf16x8*)(ws + r * 128 + (((ks * 2 + hh) ^ ((r >> 1) & 7)) << 4)); }
#pragma unroll
            for (int mt = 0; mt < 2; ++mt)
#pragma unroll
                for (int nt = 0; nt < 2; ++nt) acc[mt][nt] = __builtin_amdgcn_mfma_f32_32x32x16_bf16(xf[mt], wf[nt], acc[mt][nt], 0, 0, 0);
        }
        asm volatile("s_waitcnt vmcnt(0)" ::: "memory");
        __syncthreads();
    }
#undef GDMA
    epi(acc, m0 + wm * 64, n0 + wn * 64, r32, hh);
}

__device__ __forceinline__ void tile_map(int tile, int ntm, int ntn, int& mt, int& nt) {
    if ((ntn & 7) == 0) {
        const int G = gridDim.x;
        const int round = tile / G, bi = tile % G;
        const int x = bi & 7, j = bi >> 3;
        const int per = G >> 3;
        const int id = (round * 8 + x) * per + j;
        const int st = id >> 6, in = id & 63;
        const int snt = ntn >> 3;
        const int sm = st / snt, sn = st % snt;
        mt = sm * 8 + (in >> 3); nt = sn * 8 + (in & 7);
    } else { mt = tile / ntn; nt = tile % ntn; }
}

__device__ __forceinline__ void gemm_mainloop(const bf16_t* __restrict__ X, int ldx, const bf16_t* __restrict__ W, int ldw, int K, int m0, int n0, int N,
                                              char* lds, f32x16 (&acc)[2][4]) {
    const int tid = tid_opaque(), lane = tid & 63, wave = tid >> 6;
    const int wm = wave >> 1, wn = wave & 1;
    const int r32 = lane & 31, hh = lane >> 5;
    const char* xsrc[4]; const char* wsrc[4];
#pragma unroll
    for (int j = 0; j < 4; ++j) {
        const int row = (wave * 4 + j) * 8 + (lane >> 3), slot = lane & 7;
        const int c = slot ^ ((row >> 1) & 7);
        xsrc[j] = (const char*)(X + (size_t)(m0 + row) * ldx + c * 8);
        int n = n0 + row; n = n < N ? n : N - 1;
        wsrc[j] = (const char*)(W + (size_t)n * ldw + c * 8);
    }
    const unsigned lbase = (unsigned)(uintptr_t)lds;
    const unsigned wpiece = __builtin_amdgcn_readfirstlane(wave) * 4096u;
#pragma unroll
    for (int a = 0; a < 2; ++a)
#pragma unroll
        for (int b = 0; b < 4; ++b)
#pragma unroll
            for (int i = 0; i < 16; ++i) acc[a][b][i] = 0.f;
    const int nk = K >> 6;
#define GDMA(KT, BUF) do { const unsigned _d = lbase + (BUF) * 65536u + wpiece; const int _ko = (KT) * 128; \
        glds16(xsrc[0] + _ko, _d); glds16(xsrc[1] + _ko, _d + 1024u); glds16(xsrc[2] + _ko, _d + 2048u); glds16(xsrc[3] + _ko, _d + 3072u); \
        glds16(wsrc[0] + _ko, _d + 32768u); glds16(wsrc[1] + _ko, _d + 33792u); glds16(wsrc[2] + _ko, _d + 34816u); glds16(wsrc[3] + _ko, _d + 35840u); } while (0)
    GDMA(0, 0);
    asm volatile("s_waitcnt vmcnt(0)" ::: "memory");
    __syncthreads();
    for (int kt = 0; kt < nk; ++kt) {
        if (kt + 1 < nk) GDMA(kt + 1, (kt + 1) & 1);
        const char* xs = lds + (kt & 1) * 65536; const char* ws = xs + 32768;
#pragma unroll
        for (int ks = 0; ks < 4; ++ks) {
            bf16x8 xf[2], wf[4];
#pragma unroll
            for (int mt = 0; mt < 2; ++mt) { const int r = wm * 64 + mt * 32 + r32; xf[mt] = *(const bf16x8*)(xs + r * 128 + (((ks * 2 + hh) ^ ((r >> 1) & 7)) << 4)); }
#pragma unroll
            for (int nt = 0; nt < 4; ++nt) { const int r = wn * 128 + nt * 32 + r32; wf[nt] = *(const bf16x8*)(ws + r * 128 + (((ks * 2 + hh) ^ ((r >> 1) & 7)) << 4)); }
#pragma unroll
            for (int mt = 0; mt < 2; ++mt)
#pragma unroll
                for (int nt = 0; nt < 4; ++nt) acc[mt][nt] = __builtin_amdgcn_mfma_f32_32x32x16_bf16(xf[mt], wf[nt], acc[mt][nt], 0, 0, 0);
        }
        asm volatile("s_waitcnt vmcnt(0)" ::: "memory");
        __syncthreads();
    }
#undef GDMA
}

struct F8 { float4 a, b; };
__device__ __forceinline__ F8 f8_load(const float* p) { F8 r; r.a = *(const float4*)p; r.b = *(const float4*)(p + 4); return r; }
__device__ __forceinline__ F8 f8_shfl_xor(const F8& v, int m) {
    F8 r; r.a.x = __shfl_xor(v.a.x, m); r.a.y = __shfl_xor(v.a.y, m); r.a.z = __shfl_xor(v.a.z, m); r.a.w = __shfl_xor(v.a.w, m);
    r.b.x = __shfl_xor(v.b.x, m); r.b.y = __shfl_xor(v.b.y, m); r.b.z = __shfl_xor(v.b.z, m); r.b.w = __shfl_xor(v.b.w, m); return r;
}
__device__ __forceinline__ float f8_ssq(const F8& v) { return (v.a.x * v.a.x + v.a.y * v.a.y) + (v.a.z * v.a.z + v.a.w * v.a.w) + (v.b.x * v.b.x + v.b.y * v.b.y) + (v.b.z * v.b.z + v.b.w * v.b.w); }
__device__ __forceinline__ uint4 f8_rope_pack(const F8& v, const F8& pv, const F8& cs, const F8& sn, float sg, float sc) {
    return make_uint4(cvtpk((v.a.x * cs.a.x + sg * pv.a.x * sn.a.x) * sc, (v.a.y * cs.a.y + sg * pv.a.y * sn.a.y) * sc),
                      cvtpk((v.a.z * cs.a.z + sg * pv.a.z * sn.a.z) * sc, (v.a.w * cs.a.w + sg * pv.a.w * sn.a.w) * sc),
                      cvtpk((v.b.x * cs.b.x + sg * pv.b.x * sn.b.x) * sc, (v.b.y * cs.b.y + sg * pv.b.y * sn.b.y) * sc),
                      cvtpk((v.b.z * cs.b.z + sg * pv.b.z * sn.b.z) * sc, (v.b.w * cs.b.w + sg * pv.b.w * sn.b.w) * sc));
}
template <class Epi, int KGROUP>
__device__ __forceinline__ void gemm_tile_rows(const bf16_t* __restrict__ X, int ldx, const bf16_t* __restrict__ W, int ldw, int K, int m0, int n0, int N,
                                               char* lds, const Epi& epi) {
    const int tid = tid_opaque(), lane = tid & 63, wave = tid >> 6;
    const int wm = wave >> 1, wn = wave & 1;
    const int r32 = lane & 31, hh = lane >> 5;
    f32x16 acc[2][4];
    gemm_mainloop(X, ldx, W, ldw, K, m0, n0, N, lds, acc);
    bf16_t* ct = (bf16_t*)lds;
#pragma unroll
    for (int mt = 0; mt < 2; ++mt)
#pragma unroll
        for (int nt = 0; nt < 4; ++nt)
#pragma unroll
            for (int i = 0; i < 16; i += 2) {
                const unsigned w = cvtpk(acc[mt][nt][i], acc[mt][nt][i + 1]);
                bf16_t* d = ct + (wm * 64 + mt * 32 + crow(i, hh)) * QST + wn * 128 + nt * 32 + r32;
                d[0] = (bf16_t)(w & 0xffffu); d[QST] = (bf16_t)(w >> 16);
            }
    __syncthreads();
    epi.begin(ct, m0, n0, tid);
    {
        const int c = tid & 7, rsub = tid >> 3;
        const float *pa, *pb;
        epi.prep(m0 + rsub, n0, c, pa, pb);
        F8 ca = f8_load(pa), cb = f8_load(pb);
#pragma unroll 4
        for (int pass = 0; pass < 16; ++pass) {
            const int ch = pass & 3, row = (pass >> 2) * 64 + rsub;
#if NO_LOOKAHEAD
            epi.prep(m0 + row, n0 + ch * 64, c, pa, pb);
            ca = f8_load(pa); cb = f8_load(pb);
            F8 na = ca, nb = cb;
#else
            F8 na = ca, nb = cb;
            if (pass + 1 < 16) {
                epi.prep(m0 + ((pass + 1) >> 2) * 64 + rsub, n0 + ((pass + 1) & 3) * 64, c, pa, pb);
                na = f8_load(pa); nb = f8_load(pb);
            }
#endif
            const uint4 q = *(const uint4*)(ct + row * QST + ch * 64 + c * 8);
            F8 tv;
            tv.a = make_float4(__uint_as_float(q.x << 16), __uint_as_float(q.x & 0xffff0000u), __uint_as_float(q.y << 16), __uint_as_float(q.y & 0xffff0000u));
            tv.b = make_float4(__uint_as_float(q.z << 16), __uint_as_float(q.z & 0xffff0000u), __uint_as_float(q.w << 16), __uint_as_float(q.w & 0xffff0000u));
            epi.chunk(tv, *(const float*)(ct + row * QST + 256), m0 + row, n0 + ch * 64, c, ca, cb);
            ca = na; cb = nb;
        }
    }
    __syncthreads();
}

template <class Epi, int KGROUP>
__device__ __forceinline__ void gemm_phase_rows(const bf16_t* X, int ldx, const bf16_t* W, int ldw, int M, int N, int K, char* lds, const Epi& epi) {
    const int ntm = M >> 8, ntn = (N + 255) >> 8, nt_tot = ntm * ntn;
    for (int tile = blockIdx.x; tile < nt_tot; tile += gridDim.x) {
        int mt, nt;
        if ((gridDim.x & 63) == 0 && (ntn & 7) == 0 && (nt_tot % gridDim.x) == 0) tile_map(tile, ntm, ntn, mt, nt);
        else { mt = tile / ntn; nt = tile % ntn; }
        if (mt < ntm && nt < ntn) gemm_tile_rows<Epi, KGROUP>(X, ldx, W, ldw, K, mt * 256, nt * 256, N, lds, epi);
    }
}

__device__ __forceinline__ uint4 pack8(const float4& a, const float4& b) { return make_uint4(cvtpk(a.x, a.y), cvtpk(a.z, a.w), cvtpk(b.x, b.y), cvtpk(b.z, b.w)); }
__device__ __forceinline__ float sum8(float v) { v += __shfl_xor(v, 1); v += __shfl_xor(v, 2); v += __shfl_xor(v, 4); return v; }

struct RowsResidNorm {
    float* X; int ldx; bf16_t* XB; float* ssq; const float* XS;
    __device__ __forceinline__ void table(float*, int, int) const {}
    __device__ __forceinline__ void begin(bf16_t*, int, int, int) const {}
    __device__ __forceinline__ void prep(int m, int n, int c, const float*& pa, const float*& pb) const { pa = XS + (size_t)m * ldx + n + 8 * c; pb = pa; }
    __device__ __forceinline__ void chunk(const F8& tv, float, int m, int n, int c, const F8& xa, const F8&) const {
        float* px = X + (size_t)m * ldx + n + 8 * c;
        float4 v0 = xa.a, v1 = xa.b;
        const float4 a0 = tv.a, a1 = tv.b;
        v0.x += a0.x; v0.y += a0.y; v0.z += a0.z; v0.w += a0.w; v1.x += a1.x; v1.y += a1.y; v1.z += a1.z; v1.w += a1.w;
        *(float4*)px = v0; *(float4*)(px + 4) = v1;
        *(uint4*)(XB + (size_t)m * ldx + n + 8 * c) = pack8(v0, v1);
        const float sq = sum8((v0.x * v0.x + v0.y * v0.y) + (v0.z * v0.z + v0.w * v0.w) + (v1.x * v1.x + v1.y * v1.y) + (v1.z * v1.z + v1.w * v1.w));
        if (c == 0) ssq[((size_t)(n >> 8) * T_TOK + m) * 4 + ((n >> 6) & 3)] = sq;
    }
};
#define QKV_MIX(mi) ((size_t)(mi) * 512 * T_TOK)
#define QKV_K (256 * (size_t)T_TOK)
#define QKV_V (384 * (size_t)T_TOK)
#define QKV_KD (1920 * (size_t)T_TOK)
struct RowsPostZ {
    bf16_t* qkv; const float* tb; const float* g_qn; const float* g_kn; bf16_t* lat; float* ssqd; bf16_t* kD;
    __device__ __forceinline__ void table(float*, int, int) const {}
    __device__ __forceinline__ void begin(bf16_t*, int, int, int) const {}
    __device__ __forceinline__ void prep(int m, int n, int c, const float*& pa, const float*& pb) const {
        const int qc = n >> 6, s = m % SEQ;
        pa = tb; pb = tb;
        if (qc < 6 || (qc >= 16 && qc < 22)) { pa = tb + s * 32 + 8 * (c & 3); pb = pa + 131072; }
        else if (qc >= 8 && qc < 14) { pa = tb + ((c < 4) ? 393216 + (s >> 6) * 16 : 395264 + (s & 63) * 16) + 8 * (c & 1); pb = pa + 1024; }
        else if (qc == 30) { pa = tb + 262144 + s * 16 + 8 * (c & 1); pb = pa + 65536; }
    }
    __device__ __forceinline__ void chunk(const F8& tv, float, int m, int n, int c, const F8& cs, const F8& sn) const {
        const int qc = n >> 6;
        const int b = m / SEQ, s = m % SEQ;
        F8 v = tv;
        const float scA = 0.125f * LOG2E;
        if (qc < 6 || (qc >= 16 && qc < 22)) {
            const int mi = qc >= 16 ? 2 : 0; const int ql = qc - 8 * mi;
            const F8 pv = f8_shfl_xor(v, 4);
            const size_t off = QKV_MIX(mi) + (ql < 4 ? ((size_t)(b * 4 + ql) * SEQ + s) * 64 : QKV_K + ((size_t)(b * 2 + (ql - 4)) * SEQ + s) * 64);
            *(uint4*)(qkv + off + 8 * c) = f8_rope_pack(v, pv, cs, sn, (c < 4) ? -1.f : 1.f, (ql < 4) ? scA : 1.f);
        } else if (qc == 6 || qc == 7 || qc == 14 || qc == 15 || qc == 22 || qc == 23) {
            *(uint4*)(qkv + QKV_MIX(qc >> 3) + QKV_V + ((size_t)(b * 2 + (qc & 1)) * SEQ + s) * 64 + 8 * c) = pack8(v.a, v.b);
        } else if (qc >= 8 && qc < 14) {
            const bool isq = qc < 12; const int h = isq ? qc - 8 : qc - 12;
            const float r = rsqrtf(sum8(f8_ssq(v)) * (1.f / 64.f) + 1e-6f);
            const F8 gq = f8_load(g_qn + 8 * c), gk = f8_load(g_kn + 8 * c);
            v.a.x *= r * (isq ? gq.a.x : gk.a.x); v.a.y *= r * (isq ? gq.a.y : gk.a.y); v.a.z *= r * (isq ? gq.a.z : gk.a.z); v.a.w *= r * (isq ? gq.a.w : gk.a.w);
            v.b.x *= r * (isq ? gq.b.x : gk.b.x); v.b.y *= r * (isq ? gq.b.y : gk.b.y); v.b.z *= r * (isq ? gq.b.z : gk.b.z); v.b.w *= r * (isq ? gq.b.w : gk.b.w);
            const F8 pv = f8_shfl_xor(v, 2);
            const size_t off = QKV_MIX(1) + (isq ? ((size_t)(b * 4 + h) * SEQ + s) * 64 : QKV_K + ((size_t)(b * 2 + h) * SEQ + s) * 64);
            *(uint4*)(qkv + off + 8 * c) = f8_rope_pack(v, pv, cs, sn, (c & 2) ? 1.f : -1.f, isq ? scA : 1.f);
        } else if (qc >= 24 && qc < 30) {
            const float ss = sum8(f8_ssq(v));
            const size_t off = qc < 28 ? (size_t)m * 256 + (qc - 24) * 64 : (size_t)T_TOK * 256 + (size_t)m * 128 + (qc - 28) * 64;
            *(uint4*)(lat + off + 8 * c) = pack8(v.a, v.b);
            if (c == 0) ssqd[(size_t)(qc - 24) * T_TOK + m] = ss;
        } else if (qc == 30) {
            const F8 pv = f8_shfl_xor(v, 2);
            if (c < 4) {
                const uint4 w = f8_rope_pack(v, pv, cs, sn, (c & 2) ? 1.f : -1.f, 1.f);
#pragma unroll
                for (int h = 0; h < 4; ++h) *(uint4*)(kD + ((size_t)(b * 4 + h) * SEQ + s) * 96 + 64 + 8 * c) = w;
            }
        }
    }
};
struct RowsPostQ {
    bf16_t* qD; const float* tb; const float* ssq;
    __device__ __forceinline__ void table(float*, int, int) const {}
    __device__ __forceinline__ void begin(bf16_t* ct, int m0, int, int tid) const {
        if (tid < 256) {
            const float tot = (ssq[m0 + tid] + ssq[(size_t)T_TOK + m0 + tid]) + (ssq[(size_t)2 * T_TOK + m0 + tid] + ssq[(size_t)3 * T_TOK + m0 + tid]);
            *(float*)(ct + tid * QST + 256) = rsqrtf(tot * (1.f / 256.f) + 1e-6f) * (0.10206207261596575f * LOG2E);
        }
        __syncthreads();
    }
    __device__ __forceinline__ void prep(int m, int n, int c, const float*& pa, const float*& pb) const {
        pa = tb; pb = tb;
        if (n >= 256 && n < 384) { pa = tb + 262144 + (m % SEQ) * 16 + 8 * (c & 1); pb = pa + 65536; }
    }
    __device__ __forceinline__ void chunk(const F8& tv, float r, int m, int n, int c, const F8& cs, const F8& sn) const {
        if (n >= 384) return;
        const int qc = n >> 6, b = m / SEQ, s = m % SEQ;
        F8 v = tv;
        v.a.x *= r; v.a.y *= r; v.a.z *= r; v.a.w *= r; v.b.x *= r; v.b.y *= r; v.b.z *= r; v.b.w *= r;
        if (qc < 4) {
            *(uint4*)(qD + ((size_t)(b * 4 + qc) * SEQ + s) * 128 + 8 * c) = pack8(v.a, v.b);
        } else {
            const F8 pv = f8_shfl_xor(v, 2);
            const int h = (qc - 4) * 2 + (c >> 2);
            *(uint4*)(qD + ((size_t)(b * 4 + h) * SEQ + s) * 128 + 64 + 8 * (c & 3)) = f8_rope_pack(v, pv, cs, sn, (c & 2) ? 1.f : -1.f, 1.f);
        }
    }
};
struct RowsPostKV {
    bf16_t* kD; bf16_t* vD; const float* ssq;
    __device__ __forceinline__ void table(float*, int, int) const {}
    __device__ __forceinline__ void begin(bf16_t* ct, int m0, int, int tid) const {
        if (tid < 256) *(float*)(ct + tid * QST + 256) = rsqrtf((ssq[m0 + tid] + ssq[(size_t)T_TOK + m0 + tid]) * (1.f / 128.f) + 1e-6f);
        __syncthreads();
    }
    __device__ __forceinline__ void prep(int, int, int, const float*& pa, const float*& pb) const { pa = ssq; pb = ssq; }
    __device__ __forceinline__ void chunk(const F8& tv, float r, int m, int n, int c, const F8&, const F8&) const {
        const int qc = n >> 6, h = qc >> 1, b = m / SEQ, s = m % SEQ;
        F8 v = tv;
        v.a.x *= r; v.a.y *= r; v.a.z *= r; v.a.w *= r; v.b.x *= r; v.b.y *= r; v.b.z *= r; v.b.w *= r;
        const size_t hb = (size_t)(b * 4 + h) * SEQ + s;
        const size_t off = (qc & 1) ? hb * 64 : hb * 96;
        bf16_t* base = (bf16_t*)((qc & 1) ? (size_t)vD : (size_t)kD);
        *(uint4*)(base + off + 8 * c) = pack8(v.a, v.b);
    }
};

template <class Epi>
__device__ __forceinline__ void gemm_phase(const bf16_t* X, int ldx, const bf16_t* W, int ldw, int M, int N, int K, char* lds, const Epi& epi) {
    const int ntm = M >> 7, ntn = (N + 127) >> 7, nt_tot = ntm * ntn;
    for (int tile = blockIdx.x; tile < nt_tot; tile += gridDim.x) {
        int mt, nt;
        if ((gridDim.x & 7) == 0 && (gridDim.x >> 3) * 8 == gridDim.x && ((gridDim.x >> 3) & 63) == 0) tile_map(tile, ntm, ntn, mt, nt);
        else { mt = tile / ntn; nt = tile % ntn; }
        if (mt < ntm && nt < ntn) gemm_tile(X, ldx, W, ldw, K, mt * 128, nt * 128, N, lds, epi);
    }
}

template <int OFF> __device__ __forceinline__ s16x4 tr_read(int vb) {
    s16x4 r; asm volatile("ds_read_b64_tr_b16 %0, %1 offset:%2" : "=&v"(r) : "v"(vb), "i"(OFF) : "memory"); return r;
}
#define VS_BYTES 192

template <int KT2>
__device__ __forceinline__ void pv_sub(f32x16 (&o)[2], const f32x16& p, int vbase) {
    bf16x8 pf[2];
#pragma unroll
    for (int s2 = 0; s2 < 2; ++s2) {
        unsigned a = cvtpk(p[8 * s2 + 0], p[8 * s2 + 1]), b = cvtpk(p[8 * s2 + 2], p[8 * s2 + 3]);
        unsigned c = cvtpk(p[8 * s2 + 4], p[8 * s2 + 5]), d = cvtpk(p[8 * s2 + 6], p[8 * s2 + 7]);
        uint4 w = make_uint4(a, b, c, d);
        pf[s2] = *(bf16x8*)&w;
    }
    {
        s16x4 l00 = tr_read<(KT2 * 32 + 0) * VS_BYTES + 0>(vbase), h00 = tr_read<(KT2 * 32 + 8) * VS_BYTES + 0>(vbase);
        s16x4 l01 = tr_read<(KT2 * 32 + 0) * VS_BYTES + 64>(vbase), h01 = tr_read<(KT2 * 32 + 8) * VS_BYTES + 64>(vbase);
        s16x4 l10 = tr_read<(KT2 * 32 + 16) * VS_BYTES + 0>(vbase), h10 = tr_read<(KT2 * 32 + 24) * VS_BYTES + 0>(vbase);
        s16x4 l11 = tr_read<(KT2 * 32 + 16) * VS_BYTES + 64>(vbase), h11 = tr_read<(KT2 * 32 + 24) * VS_BYTES + 64>(vbase);
        asm volatile("s_waitcnt lgkmcnt(0)" ::: "memory");
        __builtin_amdgcn_sched_barrier(0);
#define PKV(L, H) (bf16x8){L[0], L[1], L[2], L[3], H[0], H[1], H[2], H[3]}
        o[0] = __builtin_amdgcn_mfma_f32_32x32x16_bf16(PKV(l00, h00), pf[0], o[0], 0, 0, 0);
        o[1] = __builtin_amdgcn_mfma_f32_32x32x16_bf16(PKV(l01, h01), pf[0], o[1], 0, 0, 0);
        o[0] = __builtin_amdgcn_mfma_f32_32x32x16_bf16(PKV(l10, h10), pf[1], o[0], 0, 0, 0);
        o[1] = __builtin_amdgcn_mfma_f32_32x32x16_bf16(PKV(l11, h11), pf[1], o[1], 0, 0, 0);
#undef PKV
    }
}


#define PV_LOAD(KT2, VB, F) \
    const s16x4 F##0 = tr_read<((KT2) * 32 + 0) * VS_BYTES + 0>(VB), F##1 = tr_read<((KT2) * 32 + 8) * VS_BYTES + 0>(VB), \
                F##2 = tr_read<((KT2) * 32 + 0) * VS_BYTES + 64>(VB), F##3 = tr_read<((KT2) * 32 + 8) * VS_BYTES + 64>(VB), \
                F##4 = tr_read<((KT2) * 32 + 16) * VS_BYTES + 0>(VB), F##5 = tr_read<((KT2) * 32 + 24) * VS_BYTES + 0>(VB), \
                F##6 = tr_read<((KT2) * 32 + 16) * VS_BYTES + 64>(VB), F##7 = tr_read<((KT2) * 32 + 24) * VS_BYTES + 64>(VB)
#define PKV2(L, H) (bf16x8){L[0], L[1], L[2], L[3], H[0], H[1], H[2], H[3]}
#define PV_MMA(O, P, F) do { bf16x8 _pf0, _pf1; \
        { uint4 _w = make_uint4(cvtpk(P[0], P[1]), cvtpk(P[2], P[3]), cvtpk(P[4], P[5]), cvtpk(P[6], P[7])); _pf0 = *(bf16x8*)&_w; } \
        { uint4 _w = make_uint4(cvtpk(P[8], P[9]), cvtpk(P[10], P[11]), cvtpk(P[12], P[13]), cvtpk(P[14], P[15])); _pf1 = *(bf16x8*)&_w; } \
        O[0] = __builtin_amdgcn_mfma_f32_32x32x16_bf16(PKV2(F##0, F##1), _pf0, O[0], 0, 0, 0); \
        O[1] = __builtin_amdgcn_mfma_f32_32x32x16_bf16(PKV2(F##2, F##3), _pf0, O[1], 0, 0, 0); \
        O[0] = __builtin_amdgcn_mfma_f32_32x32x16_bf16(PKV2(F##4, F##5), _pf1, O[0], 0, 0, 0); \
        O[1] = __builtin_amdgcn_mfma_f32_32x32x16_bf16(PKV2(F##6, F##7), _pf1, O[1], 0, 0, 0); } while (0)

template <int DK, int G, bool WINDOW>
__device__ __forceinline__ void attn_item(const bf16_t* __restrict__ Q, const bf16_t* __restrict__ K, const bf16_t* __restrict__ V, const float* __restrict__ sink,
                                          bf16_t* __restrict__ O, int ocol, int H, int KV, int item, char* lds, int qs = DK) {
    constexpr int KS = DK * 2 + 16;
    constexpr int KCH = DK / 8;
    constexpr int KLD = (128 * KCH) / 512;
    constexpr int QB = 256 / G;
    constexpr int NCH = SEQ / QB;
    constexpr int KBUF = 128 * KS, VBUF = 128 * VS_BYTES;
    const int tid = tid_opaque(), lane = tid & 63, wave = tid >> 6;
    const int r32 = lane & 31, hh = lane >> 5;
    const int chunk = item % NCH, kvh = (item / NCH) % KV, b = item / (NCH * KV);
    const int g = (G == 2) ? (wave >> 2) : 0;
    const int qoff = (G == 2) ? (wave & 3) * 32 : wave * 32;
    const int head = kvh * G + g;
    const int q0 = chunk * QB;
    const int qpos = q0 + qoff + r32;
    bf16x8 qf[DK / 16];
    {
        const bf16_t* qp = Q + ((size_t)(b * H + head) * SEQ + qpos) * qs + hh * 8;
#pragma unroll
        for (int ks = 0; ks < DK / 16; ++ks) qf[ks] = *(const bf16x8*)(qp + ks * 16);
    }
    int kt_lo = 0, kt_hi = SEQ / 128;
    if (WINDOW) { kt_lo = q0 / 128 - 1; if (kt_lo < 0) kt_lo = 0; kt_hi = (q0 + QB) / 128 + 1; if (kt_hi > SEQ / 128) kt_hi = SEQ / 128; }
    const char* Kg = (const char*)(K + (size_t)(b * KV + kvh) * SEQ * DK);
    const char* Vg = (const char*)(V + (size_t)(b * KV + kvh) * SEQ * 64);
    uint4 kr0, kr1, kr2 = make_uint4(0, 0, 0, 0), vr0, vr1;
    const int koff0 = (tid / KCH) * KS + (tid % KCH) * 16;
    const int koff1 = ((tid + 512) / KCH) * KS + ((tid + 512) % KCH) * 16;
    const int koff2 = ((tid + 1024) / KCH) * KS + ((tid + 1024) % KCH) * 16;
    const int voff0 = (tid >> 3) * VS_BYTES + (tid & 7) * 16;
    const int voff1 = ((tid + 512) >> 3) * VS_BYTES + (tid & 7) * 16;
    f32x16 o[2];
#pragma unroll
    for (int d = 0; d < 2; ++d)
#pragma unroll
        for (int i = 0; i < 16; ++i) o[d][i] = 0.f;
    float m = -1e30f, l = 0.f;
    if (WINDOW) { m = sink[head] * LOG2E; l = (hh == 0) ? 1.f : 0.f; }
    const int gg = lane >> 4, li = lane & 15;
    const int vlane = (4 * (gg >> 1) + (li >> 2)) * VS_BYTES + (16 * (gg & 1) + 4 * (li & 3)) * 2;
    char* Kl = lds; char* Vl = lds + 2 * KBUF;
#define AGLOAD(KT) do { const char* _kg = Kg + (size_t)(KT) * 128 * DK * 2; const char* _vg = Vg + (size_t)(KT) * 128 * 128; \
        kr0 = *(const uint4*)(_kg + tid * 16); kr1 = *(const uint4*)(_kg + (tid + 512) * 16); if (KLD > 2) kr2 = *(const uint4*)(_kg + (tid + 1024) * 16); \
        vr0 = *(const uint4*)(_vg + tid * 16); vr1 = *(const uint4*)(_vg + (tid + 512) * 16); } while (0)
#define ASTORE(KB, VB) do { char* _kd = (KB); char* _vd = (VB); *(uint4*)(_kd + koff0) = kr0; *(uint4*)(_kd + koff1) = kr1; if (KLD > 2) *(uint4*)(_kd + koff2) = kr2; \
        *(uint4*)(_vd + voff0) = vr0; *(uint4*)(_vd + voff1) = vr1; } while (0)
    AGLOAD(kt_lo);
    ASTORE(Kl, Vl);
    { const int k1 = kt_lo + 1 < kt_hi ? kt_lo + 1 : kt_lo; AGLOAD(k1); }
    __syncthreads();
    for (int kt = kt_lo; kt < kt_hi; ++kt) {
        const int cur = (kt - kt_lo) & 1;
        ASTORE(Kl + (cur ^ 1) * KBUF, Vl + (cur ^ 1) * VBUF);
        { const int ktn = kt + 2 < kt_hi ? kt + 2 : kt_hi - 1; AGLOAD(ktn); }
        __builtin_amdgcn_sched_barrier(0);
#pragma unroll
        for (int sub = 0; sub < 2; ++sub) {
            const char* kb = Kl + cur * KBUF + sub * 64 * KS;
            const float mi = (m < -1e29f) ? 0.f : m;
            f32x16 s0, s1;
#pragma unroll
            for (int i = 0; i < 16; ++i) { s0[i] = -mi; s1[i] = -mi; }
#pragma unroll
            for (int ks = 0; ks < DK / 16; ++ks) {
                bf16x8 k0 = *(const bf16x8*)(kb + r32 * KS + (ks * 2 + hh) * 16);
                bf16x8 k1 = *(const bf16x8*)(kb + (32 + r32) * KS + (ks * 2 + hh) * 16);
                s0 = __builtin_amdgcn_mfma_f32_32x32x16_bf16(k0, qf[ks], s0, 0, 0, 0);
                s1 = __builtin_amdgcn_mfma_f32_32x32x16_bf16(k1, qf[ks], s1, 0, 0, 0);
            }
            if (WINDOW) {
                const int kb0 = kt * 128 + sub * 64 + 4 * hh - qpos;
#pragma unroll
                for (int i = 0; i < 16; ++i) {
                    const int d0 = kb0 + (i & 3) + 8 * (i >> 2), d1 = d0 + 32;
                    s0[i] = (d0 > 128 || d0 < -128) ? -1e30f : s0[i];
                    s1[i] = (d1 > 128 || d1 < -128) ? -1e30f : s1[i];
                }
            }
            const int vbase = (int)(size_t)(Vl + cur * VBUF - lds) + sub * 64 * VS_BYTES + vlane;
            PV_LOAD(0, vbase, vfa);
            PV_LOAD(1, vbase, vfb);
            __builtin_amdgcn_sched_barrier(0);
            float tmax = s0[0];
#pragma unroll
            for (int i = 1; i < 16; ++i) tmax = fmaxf(tmax, s0[i]);
#pragma unroll
            for (int i = 0; i < 16; ++i) tmax = fmaxf(tmax, s1[i]);
            tmax = xhalf_max(tmax);
            float ps = 0.f;
            if (__all(m > -1e29f && tmax <= 8.f)) {
#pragma unroll
                for (int i = 0; i < 16; ++i) { s0[i] = __builtin_amdgcn_exp2f(s0[i]); ps += s0[i]; }
#pragma unroll
                for (int i = 0; i < 16; ++i) { s1[i] = __builtin_amdgcn_exp2f(s1[i]); ps += s1[i]; }
                l += ps;
            } else {
                const float mn = fmaxf(m, mi + tmax);
                const float d = mn - mi;
                const float alpha = __builtin_amdgcn_exp2f(m - mn);
                m = mn;
#pragma unroll
                for (int i = 0; i < 16; ++i) { s0[i] = __builtin_amdgcn_exp2f(s0[i] - d); ps += s0[i]; }
#pragma unroll
                for (int i = 0; i < 16; ++i) { s1[i] = __builtin_amdgcn_exp2f(s1[i] - d); ps += s1[i]; }
                l = l * alpha + ps;
#pragma unroll
                for (int dd = 0; dd < 2; ++dd)
#pragma unroll
                    for (int i = 0; i < 16; ++i) o[dd][i] *= alpha;
            }
            asm volatile("s_waitcnt lgkmcnt(0)" ::: "memory");
            __builtin_amdgcn_sched_barrier(0);
            PV_MMA(o, s0, vfa);
            PV_MMA(o, s1, vfb);
        }
        __syncthreads();
    }
#undef AGLOAD
#undef ASTORE
    l = xhalf_sum(l);
    const float inv = 1.f / l;
    bf16_t* orow = O + (size_t)(b * SEQ + qpos) * DM + ocol + head * 64;
#pragma unroll
    for (int d = 0; d < 2; ++d)
#pragma unroll
        for (int gq = 0; gq < 4; ++gq) {
            uint2 w;
            w.x = cvtpk(o[d][gq * 4 + 0] * inv, o[d][gq * 4 + 1] * inv);
            w.y = cvtpk(o[d][gq * 4 + 2] * inv, o[d][gq * 4 + 3] * inv);
            *(uint2*)(orow + d * 32 + 8 * gq + 4 * hh) = w;
        }
}

__device__ __forceinline__ void dil_wave_item(const bf16_t* __restrict__ Q, const bf16_t* __restrict__ K, const bf16_t* __restrict__ V,
                                              bf16_t* __restrict__ O, int witem, char* wlds, int lds_off) {
    const int lane = tid_opaque() & 63, r32 = lane & 31, hh = lane >> 5;
    const int c = witem & 15, chunk = (witem >> 4) & 15, kvh = (witem >> 8) & 1, b = witem >> 9;
    const int t0 = chunk * 256;
    const int mq = r32 & 15, g = r32 >> 4;
    const int qpos = t0 + 16 * mq + c, head = kvh * 2 + g;
    bf16x8 qf[4];
    {
        const bf16_t* qp = Q + ((size_t)(b * 4 + head) * SEQ + qpos) * 64 + hh * 8;
#pragma unroll
        for (int ks = 0; ks < 4; ++ks) qf[ks] = *(const bf16x8*)(qp + ks * 16);
    }
    const bf16_t* Kg = K + (size_t)(b * 2 + kvh) * SEQ * 64;
    const bf16_t* Vg = V + (size_t)(b * 2 + kvh) * SEQ * 64;
    f32x16 o[2];
#pragma unroll
    for (int d = 0; d < 2; ++d)
#pragma unroll
        for (int i = 0; i < 16; ++i) o[d][i] = 0.f;
    float m = -1e30f, l = 0.f;
    const int gg = lane >> 4, li = lane & 15;
    const int vlane = lds_off + (4 * (gg >> 1) + (li >> 2)) * VS_BYTES + (16 * (gg & 1) + 4 * (li & 3)) * 2;
#define DIL_PARAMS(IT, SH, CC, IDX0, LIM) const int SH = (IT) < 12 ? 0 : ((IT) < 18 ? 2 : 4); const int CC = c & ((1 << SH) - 1); \
        const int IDX0 = (t0 >> SH) - 64 + 32 * ((IT) < 12 ? (IT) : ((IT) < 18 ? (IT) - 12 : (IT) - 18)); const int LIM = SEQ >> SH
#define DIL_LOAD(KF, VR, SH, CC, IDX0, LIM) do { \
        { int _i = IDX0 + r32; _i = _i < 0 ? 0 : (_i >= LIM ? LIM - 1 : _i); const bf16_t* _kp = Kg + (size_t)((_i << SH) + CC) * 64 + hh * 8; \
          KF##0 = *(const bf16x8*)(_kp); KF##1 = *(const bf16x8*)(_kp + 16); KF##2 = *(const bf16x8*)(_kp + 32); KF##3 = *(const bf16x8*)(_kp + 48); } \
        { int _i = IDX0 + (lane >> 3); _i = _i < 0 ? 0 : (_i >= LIM ? LIM - 1 : _i); VR##0 = *(const uint4*)(Vg + (size_t)((_i << SH) + CC) * 64 + (lane & 7) * 8); } \
        { int _i = IDX0 + 8 + (lane >> 3); _i = _i < 0 ? 0 : (_i >= LIM ? LIM - 1 : _i); VR##1 = *(const uint4*)(Vg + (size_t)((_i << SH) + CC) * 64 + (lane & 7) * 8); } \
        { int _i = IDX0 + 16 + (lane >> 3); _i = _i < 0 ? 0 : (_i >= LIM ? LIM - 1 : _i); VR##2 = *(const uint4*)(Vg + (size_t)((_i << SH) + CC) * 64 + (lane & 7) * 8); } \
        { int _i = IDX0 + 24 + (lane >> 3); _i = _i < 0 ? 0 : (_i >= LIM ? LIM - 1 : _i); VR##3 = *(const uint4*)(Vg + (size_t)((_i << SH) + CC) * 64 + (lane & 7) * 8); } } while (0)
    bf16x8 ka0, ka1, ka2, ka3, kb0, kb1, kb2, kb3;
    uint4 va0, va1, va2, va3, vb0, vb1, vb2, vb3;
    { DIL_PARAMS(0, sh0, cc0, ix0, lm0); DIL_LOAD(ka, va, sh0, cc0, ix0, lm0); }
#pragma unroll 1
    for (int it = 0; it < 23; ++it) {
        DIL_PARAMS(it, sh, cc, idx0, lim);
        {
            const int itn = it + 1 < 23 ? it + 1 : 22;
            DIL_PARAMS(itn, shn, ccn, ixn, lmn);
            DIL_LOAD(kb, vb, shn, ccn, ixn, lmn);
        }
        __builtin_amdgcn_sched_barrier(0);
        *(uint4*)(wlds + ((lane >> 3)) * VS_BYTES + (lane & 7) * 16) = va0;
        *(uint4*)(wlds + ((lane >> 3) + 8) * VS_BYTES + (lane & 7) * 16) = va1;
        *(uint4*)(wlds + ((lane >> 3) + 16) * VS_BYTES + (lane & 7) * 16) = va2;
        *(uint4*)(wlds + ((lane >> 3) + 24) * VS_BYTES + (lane & 7) * 16) = va3;
        f32x16 s;
#pragma unroll
        for (int i = 0; i < 16; ++i) s[i] = 0.f;
        s = __builtin_amdgcn_mfma_f32_32x32x16_bf16(ka0, qf[0], s, 0, 0, 0);
        s = __builtin_amdgcn_mfma_f32_32x32x16_bf16(ka1, qf[1], s, 0, 0, 0);
        s = __builtin_amdgcn_mfma_f32_32x32x16_bf16(ka2, qf[2], s, 0, 0, 0);
        s = __builtin_amdgcn_mfma_f32_32x32x16_bf16(ka3, qf[3], s, 0, 0, 0);

        const int qidx = qpos >> sh;
        const int base = idx0 + 4 * hh;
#pragma unroll
        for (int i = 0; i < 16; ++i) {
            const int idx = base + (i & 3) + 8 * (i >> 2);
            const int d = idx - qidx;
            s[i] = (d > 64 || d < -64 || idx < 0 || idx >= lim) ? -1e30f : s[i];
        }
        float tmax = s[0];
#pragma unroll
        for (int i = 1; i < 16; ++i) tmax = fmaxf(tmax, s[i]);
        tmax = fmaxf(tmax, xhalf(tmax));
        const float mn = fmaxf(fmaxf(m, tmax), -1e20f);
        const float alpha = __builtin_amdgcn_exp2f(m - mn);
        m = mn;
        float ps = 0.f;
#pragma unroll
        for (int i = 0; i < 16; ++i) { s[i] = __builtin_amdgcn_exp2f(s[i] - mn); ps += s[i]; }
        l = l * alpha + ps;
#pragma unroll
        for (int d = 0; d < 2; ++d)
#pragma unroll
            for (int i = 0; i < 16; ++i) o[d][i] *= alpha;
        pv_sub<0>(o, s, vlane);
        ka0 = kb0; ka1 = kb1; ka2 = kb2; ka3 = kb3; va0 = vb0; va1 = vb1; va2 = vb2; va3 = vb3;
    }
#undef DIL_PARAMS
#undef DIL_LOAD
    l += xhalf(l);
    const float inv = 1.f / l;
    bf16_t* orow = O + (size_t)(b * SEQ + qpos) * DM + 512 + head * 64;
#pragma unroll
    for (int d = 0; d < 2; ++d)
#pragma unroll
        for (int gq = 0; gq < 4; ++gq) {
            uint2 w;
            w.x = cvtpk(o[d][gq * 4 + 0] * inv, o[d][gq * 4 + 1] * inv);
            w.y = cvtpk(o[d][gq * 4 + 2] * inv, o[d][gq * 4 + 3] * inv);
            *(uint2*)(orow + d * 32 + 8 * gq + 4 * hh) = w;
        }
}

__device__ __forceinline__ int f2key(float f) { int b = __float_as_int(f); return b ^ ((b >> 31) & 0x7fffffff); }
__device__ __forceinline__ float key2f(int k) { return __int_as_float(k ^ ((k >> 31) & 0x7fffffff)); }

template <int N>
__device__ __forceinline__ void bitonic_sort_desc(int (&a)[N]) {
#pragma unroll
    for (int k = 2; k <= N; k <<= 1) {
#pragma unroll
        for (int j = k >> 1; j > 0; j >>= 1) {
#pragma unroll
            for (int i = 0; i < N; ++i) {
                const int l2 = i ^ j;
                if (l2 > i) {
                    const bool up = ((i & k) == 0);
                    const int hi = max(a[i], a[l2]), lo = min(a[i], a[l2]);
                    a[i] = up ? hi : lo; a[l2] = up ? lo : hi;
                }
            }
        }
    }
}
__device__ __forceinline__ void merge_top16(int (&a)[16], const int (&b)[16]) {
#pragma unroll
    for (int i = 0; i < 16; ++i) a[i] = max(a[i], b[15 - i]);
#pragma unroll
    for (int j = 8; j > 0; j >>= 1) {
#pragma unroll
        for (int i = 0; i < 16; ++i) {
            const int l2 = i ^ j;
            if (l2 > i) { const int hi = max(a[i], a[l2]), lo = min(a[i], a[l2]); a[i] = hi; a[l2] = lo; }
        }
    }
}
__device__ __forceinline__ void top16_of_64(int (&g0)[16], int (&g1)[16], int (&g2)[16], int (&g3)[16]) {
    bitonic_sort_desc<16>(g0); bitonic_sort_desc<16>(g1); bitonic_sort_desc<16>(g2); bitonic_sort_desc<16>(g3);
    merge_top16(g0, g1); merge_top16(g2, g3); merge_top16(g0, g2);
}

__device__ __forceinline__ void topk_core(const bf16_t* q0, const bf16_t* __restrict__ subk_h, float rscale, int* eo, float* go, char* wlds) {
    const int lane = tid_opaque() & 63, r32 = lane & 31, hh = lane >> 5;
    int top[2][16];
#pragma unroll
    for (int c = 0; c < 2; ++c) {
        bf16x8 qf[8];
        const bf16_t* qrow = q0 + c * 128;
#pragma unroll
        for (int ks = 0; ks < 8; ++ks) qf[ks] = *(const bf16x8*)(qrow + ks * 16);
        const bf16_t* kb = subk_h + ((size_t)c * 128 + r32) * 128 + hh * 8;
        int grp[4][16];
        bf16x8 kfa[8], kfb[8];
#pragma unroll
        for (int ks = 0; ks < 8; ++ks) kfa[ks] = *(const bf16x8*)(kb + ks * 16);
#pragma unroll
        for (int kt = 0; kt < 4; ++kt) {
            if (kt < 3) {
#pragma unroll
                for (int ks = 0; ks < 8; ++ks) kfb[ks] = *(const bf16x8*)(kb + (size_t)(kt + 1) * 32 * 128 + ks * 16);
            }
            __builtin_amdgcn_sched_barrier(0);
            f32x16 s;
#pragma unroll
            for (int i = 0; i < 16; ++i) s[i] = 0.f;
#pragma unroll
            for (int ks = 0; ks < 8; ++ks) s = __builtin_amdgcn_mfma_f32_32x32x16_bf16(kfa[ks], qf[ks], s, 0, 0, 0);
#pragma unroll
            for (int i = 0; i < 16; ++i) grp[kt][i] = (f2key(s[i]) & ~127) | (kt * 32 + crow(i, hh));
#pragma unroll
            for (int ks = 0; ks < 8; ++ks) kfa[ks] = kfb[ks];
        }
        top16_of_64(grp[0], grp[1], grp[2], grp[3]);
        int oth[16];
#pragma unroll
        for (int i = 0; i < 16; ++i) oth[i] = __shfl_xor(grp[0][i], 32);
        merge_top16(grp[0], oth);
#pragma unroll
        for (int i = 0; i < 16; ++i) top[c][i] = grp[0][i];
    }
    {
        unsigned* my = (unsigned*)(wlds + lane * 36);
#pragma unroll
        for (int c = 0; c < 2; ++c)
#pragma unroll
            for (int w4 = 0; w4 < 4; ++w4) {
                unsigned v = (top[c][w4 * 4] & 127) | ((top[c][w4 * 4 + 1] & 127) << 8) | ((top[c][w4 * 4 + 2] & 127) << 16) | ((top[c][w4 * 4 + 3] & 127) << 24);
                my[c * 4 + w4] = v;
            }
    }
    float v1[16], v2[16];
#pragma unroll
    for (int i = 0; i < 16; ++i) { v1[i] = key2f(top[0][i] & ~127); v2[i] = key2f(top[1][i] & ~127); }
    int cg[4][16];
    {
        int n = 0;
#pragma unroll
        for (int i = 0; i < 16; ++i)
#pragma unroll
            for (int j = 0; j < 16; ++j)
                if ((i + 1) * (j + 1) <= 16) { cg[n >> 4][n & 15] = (f2key(v1[i] + v2[j]) & ~255) | (i * 16 + j); ++n; }
#pragma unroll
        for (int q = 50; q < 64; ++q) cg[q >> 4][q & 15] = (int)0x80000000;
    }
    top16_of_64(cg[0], cg[1], cg[2], cg[3]);
    float bv[16];
#pragma unroll
    for (int i = 0; i < 16; ++i) bv[i] = key2f(cg[0][i] & ~255) * rscale;
    float sm = 0.f;
    const float bmx = bv[0];
#pragma unroll
    for (int i = 0; i < 16; ++i) { bv[i] = __expf(bv[i] - bmx); sm += bv[i]; }
    const float inv = 1.f / sm;
    if (hh == 0) {
        const unsigned char* my = (const unsigned char*)(wlds + lane * 36);
#pragma unroll
        for (int q4 = 0; q4 < 4; ++q4) {
            int4 ev; float4 gv;
            int* evp = (int*)&ev; float* gvp = (float*)&gv;
#pragma unroll
            for (int u = 0; u < 4; ++u) {
                const int code = cg[0][q4 * 4 + u] & 255;
                const int i1 = my[code >> 4], i2 = my[16 + (code & 15)];
                evp[u] = i1 * 128 + i2; gvp[u] = bv[q4 * 4 + u] * inv;
            }
            *(int4*)(eo + q4 * 4) = ev; *(float4*)(go + q4 * 4) = gv;
        }
    }
}

__device__ __forceinline__ void topk_wave_item(const bf16_t* __restrict__ qp, const bf16_t* __restrict__ subk, int* __restrict__ eidx, float* __restrict__ gate, int witem, char* wlds) {
    const int lane = tid_opaque() & 63, r32 = lane & 31, hh = lane >> 5;
    const int h = witem & 7, t = (witem >> 3) * 32 + r32;
    topk_core(qp + (size_t)t * 2048 + h * 256 + hh * 8, subk + (size_t)h * 2 * 128 * 128, 1.f, eidx + ((size_t)h * T_TOK + t) * 16, gate + ((size_t)h * T_TOK + t) * 16, wlds);
}
__device__ __forceinline__ void gemm_tile_topk(const bf16_t* __restrict__ X, int ldx, const bf16_t* __restrict__ W, int ldw, int K, int m0, int h, char* lds,
                                               const bf16_t* __restrict__ subk, const float* __restrict__ ssq, int* __restrict__ eidx, float* __restrict__ gate) {
    const int tid = tid_opaque(), lane = tid & 63, wave = tid >> 6;
    const int wm = wave >> 1, wn = wave & 1;
    const int r32 = lane & 31, hh = lane >> 5;
    {
        f32x16 acc[2][4];
        gemm_mainloop(X, ldx, W, ldw, K, m0, h * 256, 2048, lds, acc);
        bf16_t* qst = (bf16_t*)lds;
#pragma unroll
        for (int mt = 0; mt < 2; ++mt)
#pragma unroll
            for (int nt = 0; nt < 4; ++nt)
#pragma unroll
                for (int i = 0; i < 16; ++i)
                    qst[(wm * 64 + mt * 32 + crow(i, hh)) * QST + wn * 128 + nt * 32 + r32] = f2bf(acc[mt][nt][i]);
    }
    __syncthreads();
    {
        const int tok = wave * 32 + r32, t = m0 + tok;
        float tot = 0.f;
#pragma unroll
        for (int j = 0; j < 4; ++j) { const float4 q = *(const float4*)(ssq + ((size_t)j * T_TOK + t) * 4); tot += (q.x + q.y) + (q.z + q.w); }
        const float r = rsqrtf(tot * (1.f / DM) + 1e-6f);
        topk_core((const bf16_t*)lds + tok * QST + hh * 8, subk + (size_t)h * 2 * 128 * 128, r, eidx + ((size_t)h * T_TOK + t) * 16, gate + ((size_t)h * T_TOK + t) * 16,
                  lds + TOPK_STASH + wave * 2304);
    }
    __syncthreads();
}

typedef __attribute__((ext_vector_type(2))) float f32x2;
__device__ __forceinline__ float fdot2bf(unsigned a, unsigned b, float acc) {
    return __builtin_amdgcn_fdot2_f32_bf16(*(bf16x2_t*)&a, *(bf16x2_t*)&b, acc, false);
}
__device__ __forceinline__ unsigned fp8pair_to_bf16(unsigned w, bool hi) {
    bf16x2_t r = hi ? __builtin_amdgcn_cvt_scalef32_pk_bf16_fp8((int)w, 1.0f, true) : __builtin_amdgcn_cvt_scalef32_pk_bf16_fp8((int)w, 1.0f, false);
    return *(unsigned*)&r;
}
__device__ __forceinline__ float dot16_fp8(uint4 u, const unsigned (&h)[8]) {
    float a = 0.f;
    a = fdot2bf(fp8pair_to_bf16(u.x, false), h[0], a); a = fdot2bf(fp8pair_to_bf16(u.x, true), h[1], a);
    a = fdot2bf(fp8pair_to_bf16(u.y, false), h[2], a); a = fdot2bf(fp8pair_to_bf16(u.y, true), h[3], a);
    a = fdot2bf(fp8pair_to_bf16(u.z, false), h[4], a); a = fdot2bf(fp8pair_to_bf16(u.z, true), h[5], a);
    a = fdot2bf(fp8pair_to_bf16(u.w, false), h[6], a); a = fdot2bf(fp8pair_to_bf16(u.w, true), h[7], a);
    return a;
}
__device__ __forceinline__ void axpy16_fp8(float (&acc)[16], float w, uint4 v) {
    f32x2 r;
    r = __builtin_amdgcn_cvt_pk_f32_fp8((int)v.x, false); acc[0] += w * r[0]; acc[1] += w * r[1];
    r = __builtin_amdgcn_cvt_pk_f32_fp8((int)v.x, true);  acc[2] += w * r[0]; acc[3] += w * r[1];
    r = __builtin_amdgcn_cvt_pk_f32_fp8((int)v.y, false); acc[4] += w * r[0]; acc[5] += w * r[1];
    r = __builtin_amdgcn_cvt_pk_f32_fp8((int)v.y, true);  acc[6] += w * r[0]; acc[7] += w * r[1];
    r = __builtin_amdgcn_cvt_pk_f32_fp8((int)v.z, false); acc[8] += w * r[0]; acc[9] += w * r[1];
    r = __builtin_amdgcn_cvt_pk_f32_fp8((int)v.z, true);  acc[10] += w * r[0]; acc[11] += w * r[1];
    r = __builtin_amdgcn_cvt_pk_f32_fp8((int)v.w, false); acc[12] += w * r[0]; acc[13] += w * r[1];
    r = __builtin_amdgcn_cvt_pk_f32_fp8((int)v.w, true);  acc[14] += w * r[0]; acc[15] += w * r[1];
}
__device__ __forceinline__ float gelu_exact(float a) { return 0.5f * a * (1.f + erff(a * 0.70710678118654752f)); }

__device__ __forceinline__ float transpose_reduce16(f32x16 p, int lane) {
#pragma unroll
    for (int st = 0; st < 4; ++st) {
        const int o = 32 >> st, n = 16 >> st;
        const bool up = (lane & o) != 0;
#pragma unroll
        for (int i = 0; i < n / 2; ++i) {
            float lo = p[i], hi = p[i + n / 2];
            asm volatile("" : "+v"(lo), "+v"(hi));
            const float keep = up ? hi : lo;
            const float send = up ? lo : hi;
            p[i] = keep + __shfl_xor(send, o);
        }
    }
    float v = p[0];
    v += __shfl_xor(v, 1); v += __shfl_xor(v, 2);
    return v;
}
#define EX_SB() __builtin_amdgcn_sched_barrier(0)
#define EX_LD1(R, TAB, EB, S) R = *(const uint4*)((TAB) + (unsigned)((__builtin_amdgcn_readlane((EB), (S)) << 10) + lane16))
#define EX_LOAD8(P, TAB, EB, SL) do { EX_LD1(P##0, TAB, EB, (SL) + 0); EX_LD1(P##1, TAB, EB, (SL) + 1); EX_LD1(P##2, TAB, EB, (SL) + 2); EX_LD1(P##3, TAB, EB, (SL) + 3); \
        EX_LD1(P##4, TAB, EB, (SL) + 4); EX_LD1(P##5, TAB, EB, (SL) + 5); EX_LD1(P##6, TAB, EB, (SL) + 6); EX_LD1(P##7, TAB, EB, (SL) + 7); } while (0)
#define EX_DOT8(P, PP, O) do { PP[(O) + 0] = dot16_fp8(P##0, hp); PP[(O) + 1] = dot16_fp8(P##1, hp); PP[(O) + 2] = dot16_fp8(P##2, hp); PP[(O) + 3] = dot16_fp8(P##3, hp); \
        PP[(O) + 4] = dot16_fp8(P##4, hp); PP[(O) + 5] = dot16_fp8(P##5, hp); PP[(O) + 6] = dot16_fp8(P##6, hp); PP[(O) + 7] = dot16_fp8(P##7, hp); } while (0)
#define EX_RL(W, S) __int_as_float(__builtin_amdgcn_readlane(__float_as_int(W), (S)))
#define EX_AXPY8(P, W, SL) do { axpy16_fp8(acc, EX_RL(W, (SL) + 0), P##0); axpy16_fp8(acc, EX_RL(W, (SL) + 1), P##1); axpy16_fp8(acc, EX_RL(W, (SL) + 2), P##2); axpy16_fp8(acc, EX_RL(W, (SL) + 3), P##3); \
        axpy16_fp8(acc, EX_RL(W, (SL) + 4), P##4); axpy16_fp8(acc, EX_RL(W, (SL) + 5), P##5); axpy16_fp8(acc, EX_RL(W, (SL) + 6), P##6); axpy16_fp8(acc, EX_RL(W, (SL) + 7), P##7); } while (0)
#define EX_COPY8(D, S_) do { D##0 = S_##0; D##1 = S_##1; D##2 = S_##2; D##3 = S_##3; D##4 = S_##4; D##5 = S_##5; D##6 = S_##6; D##7 = S_##7; } while (0)

#ifndef EXS_NS
#define EXS_NS 16
#endif
#ifndef EXS_SYNC
#define EXS_SYNC 1
#endif
__device__ __forceinline__ int ex_mbcnt(unsigned long long m) { return __builtin_amdgcn_mbcnt_hi((unsigned)(m >> 32), __builtin_amdgcn_mbcnt_lo((unsigned)m, 0u)); }
__device__ __forceinline__ void xcd_local_sync_p(char* st);
__device__ __forceinline__ void expert_token(PC& p, int layer, int t, bool last, int2* lst, char* syncp, bool dummy = false) {
    const int lane = tid_opaque() & 63;
    const int lane16 = lane * 16;
    const float* gfb = p.g_ffn + layer * DM; asm volatile("" : "+s"(gfb));
    const float* gf = gfb + lane * 16;
    float* xrow = p.x + (size_t)t * DM + lane * 16;
    float* xwr = dummy ? (float*)p.zb + (size_t)t * DM + lane * 16 : xrow;
    bf16_t* hwr = (dummy ? p.q.qA + (size_t)t * DM : p.hnb + (size_t)t * DM) + lane * 16;
    float xv[16];
#pragma unroll
    for (int q = 0; q < 4; ++q) { const float4 a = *(const float4*)(xrow + 4 * q); xv[4 * q] = a.x; xv[4 * q + 1] = a.y; xv[4 * q + 2] = a.z; xv[4 * q + 3] = a.w; }
    float ss = 0.f;
#pragma unroll
    for (int i = 0; i < 16; ++i) ss += xv[i] * xv[i];
    ss = wave_sum(ss);
    const float rstd = rsqrtf(ss * (1.f / DM) + 1e-6f);
    unsigned hp[8];
#pragma unroll
    for (int q = 0; q < 4; ++q) {
        const float4 g = *(const float4*)(gf + 4 * q);
        hp[2 * q] = cvtpk(xv[4 * q] * rstd * g.x, xv[4 * q + 1] * rstd * g.y);
        hp[2 * q + 1] = cvtpk(xv[4 * q + 2] * rstd * g.z, xv[4 * q + 3] * rstd * g.w);
    }
    const size_t ei0 = ((size_t)(lane >> 4) * T_TOK + t) * 16 + (lane & 15), ei1 = ei0 + (size_t)4 * T_TOK * 16;
    int e0 = p.eidx[ei0], e1 = p.eidx[ei1];
    float g0 = p.gate[ei0], g1 = p.gate[ei1];
    {
        const int s0 = ((e0 >> 7) + e0) & (EXS_NS - 1), s1 = ((e1 >> 7) + e1) & (EXS_NS - 1);
        int base = 0, pos0 = 0, pos1 = 0;
#pragma unroll
        for (int s = 0; s < EXS_NS; ++s) {
            const unsigned long long m0 = __ballot(s0 == s), m1 = __ballot(s1 == s);
            const int c0 = __popcll(m0);
            pos0 = (s0 == s) ? base + ex_mbcnt(m0) : pos0;
            pos1 = (s1 == s) ? base + c0 + ex_mbcnt(m1) : pos1;
            base += c0 + __popcll(m1);
        }
        lst[pos0] = make_int2(e0, __float_as_int(g0)); lst[pos1] = make_int2(e1, __float_as_int(g1));
        const int2 q0 = lst[lane], q1 = lst[64 + lane];
        e0 = q0.x; g0 = __int_as_float(q0.y); e1 = q1.x; g1 = __int_as_float(q1.y);
    }
    const unsigned char* u8 = p.u8 + (size_t)layer * 16384 * DM;
    const unsigned char* v8 = p.v8 + (size_t)layer * 16384 * DM;
    const float* su = p.su + layer * 16384; const float* sv = p.sv + layer * 16384;
    const float su0 = su[e0], su1 = su[e1], sv0 = sv[e0], sv1 = sv[e1];
    uint4 rx0, rx1, rx2, rx3, rx4, rx5, rx6, rx7, ry0, ry1, ry2, ry3, ry4, ry5, ry6, ry7;
    float a0 = 0.f, a1 = 0.f;
    EX_LOAD8(rx, u8, e0, 0);
#pragma unroll 1
    for (int g = 0; g < 8; ++g) {
        const int eb = g < 4 ? e0 : e1;
        const int sl = (g & 3) * 16;
        f32x16 pp;
        EX_LOAD8(ry, u8, eb, sl + 8);
        EX_SB();
        EX_DOT8(rx, pp, 0);
        EX_SB();
        {
            const int gn = g + 1 < 8 ? g + 1 : 0;
            const int ebn = gn < 4 ? e0 : e1;
            const unsigned char* tabn = g + 1 < 8 ? u8 : v8;
            EX_LOAD8(rx, tabn, ebn, (gn & 3) * 16);
        }
        EX_SB();
        EX_DOT8(ry, pp, 8);
        const float v = transpose_reduce16(pp, lane);
        const float got = __shfl(v, (lane & 15) << 2);
        const bool mine = (lane >> 4) == (g & 3);
        a0 = (mine && g < 4) ? got : a0;
        a1 = (mine && g >= 4) ? got : a1;
        EX_SB();
    }
#if EXS_SYNC >= 2
    if (syncp) xcd_local_sync_p(syncp);
#endif
    const float w0 = g0 * gelu_exact(su0 * a0) * sv0;
    const float w1 = g1 * gelu_exact(su1 * a1) * sv1;
    float acc[16];
#pragma unroll
    for (int i = 0; i < 16; ++i) acc[i] = 0.f;
#pragma unroll 1
    for (int h2 = 0; h2 < 8; ++h2) {
        const int ebc = h2 < 4 ? e0 : e1;
        const float wb = h2 < 4 ? w0 : w1;
        const int slc = (h2 & 3) * 16;
        EX_LOAD8(ry, v8, ebc, slc + 8);
        EX_SB();
        EX_AXPY8(rx, wb, slc);
        EX_SB();
        {
            const int hn_ = h2 + 1 < 8 ? h2 + 1 : 7;
            const int ebn = hn_ < 4 ? e0 : e1;
            EX_LOAD8(rx, v8, ebn, (hn_ & 3) * 16);
        }
        EX_SB();
        EX_AXPY8(ry, wb, slc + 8);
        EX_SB();
    }
#pragma unroll
    for (int i = 0; i < 16; ++i) xv[i] += acc[i];
    float s2 = 0.f;
#pragma unroll
    for (int i = 0; i < 16; ++i) s2 += xv[i] * xv[i];
    s2 = wave_sum(s2);
    const float r2 = rsqrtf(s2 * (1.f / DM) + 1e-6f);
    if (!last) {
#pragma unroll
        for (int q = 0; q < 4; ++q) *(float4*)(xwr + 4 * q) = make_float4(xv[4 * q], xv[4 * q + 1], xv[4 * q + 2], xv[4 * q + 3]);
        const float* gnb = p.g_mix + (layer + 1) * DM; asm volatile("" : "+s"(gnb));
        const float* gn = gnb + lane * 16;
        unsigned hw[8];
#pragma unroll
        for (int q = 0; q < 4; ++q) {
            const float4 g = *(const float4*)(gn + 4 * q);
            hw[2 * q] = cvtpk(xv[4 * q] * r2 * g.x, xv[4 * q + 1] * r2 * g.y);
            hw[2 * q + 1] = cvtpk(xv[4 * q + 2] * r2 * g.z, xv[4 * q + 3] * r2 * g.w);
        }
        *(uint4*)(hwr) = make_uint4(hw[0], hw[1], hw[2], hw[3]);
        *(uint4*)(hwr + 8) = make_uint4(hw[4], hw[5], hw[6], hw[7]);
    } else {
        const float* gnb = p.g_final; asm volatile("" : "+s"(gnb));
        const float* gn = gnb + lane * 16;
        float* orow = dummy ? xwr : p.out + (size_t)t * DM + lane * 16;
#pragma unroll
        for (int q = 0; q < 4; ++q) {
            const float4 g = *(const float4*)(gn + 4 * q);
            *(float4*)(orow + 4 * q) = make_float4(xv[4 * q] * r2 * g.x, xv[4 * q + 1] * r2 * g.y, xv[4 * q + 2] * r2 * g.z, xv[4 * q + 3] * r2 * g.w);
        }
    }
}

#define EX_DOT8H(P, PP, O, HP) do { PP[(O) + 0] = dot16_fp8(P##0, HP); PP[(O) + 1] = dot16_fp8(P##1, HP); PP[(O) + 2] = dot16_fp8(P##2, HP); PP[(O) + 3] = dot16_fp8(P##3, HP); \
        PP[(O) + 4] = dot16_fp8(P##4, HP); PP[(O) + 5] = dot16_fp8(P##5, HP); PP[(O) + 6] = dot16_fp8(P##6, HP); PP[(O) + 7] = dot16_fp8(P##7, HP); } while (0)
#define EX_AXPY8A(P, W, SL, ACC) do { axpy16_fp8(ACC, EX_RL(W, (SL) + 0), P##0); axpy16_fp8(ACC, EX_RL(W, (SL) + 1), P##1); axpy16_fp8(ACC, EX_RL(W, (SL) + 2), P##2); axpy16_fp8(ACC, EX_RL(W, (SL) + 3), P##3); \
        axpy16_fp8(ACC, EX_RL(W, (SL) + 4), P##4); axpy16_fp8(ACC, EX_RL(W, (SL) + 5), P##5); axpy16_fp8(ACC, EX_RL(W, (SL) + 6), P##6); axpy16_fp8(ACC, EX_RL(W, (SL) + 7), P##7); } while (0)
__device__ __forceinline__ void ex2_begin(PC& p, int layer, int t, int lane, int2* lst, float (&xv)[16], unsigned (&hp)[8], int& e0, int& e1, float& g0, float& g1) {
    const float* gfb = p.g_ffn + layer * DM; asm volatile("" : "+s"(gfb));
    const float* gf = gfb + lane * 16;
    const float* xrow = p.x + (size_t)t * DM + lane * 16;
#pragma unroll
    for (int q = 0; q < 4; ++q) { const float4 a = *(const float4*)(xrow + 4 * q); xv[4 * q] = a.x; xv[4 * q + 1] = a.y; xv[4 * q + 2] = a.z; xv[4 * q + 3] = a.w; }
    float ss = 0.f;
#pragma unroll
    for (int i = 0; i < 16; ++i) ss += xv[i] * xv[i];
    ss = wave_sum(ss);
    const float rstd = rsqrtf(ss * (1.f / DM) + 1e-6f);
#pragma unroll
    for (int q = 0; q < 4; ++q) {
        const float4 g = *(const float4*)(gf + 4 * q);
        hp[2 * q] = cvtpk(xv[4 * q] * rstd * g.x, xv[4 * q + 1] * rstd * g.y);
        hp[2 * q + 1] = cvtpk(xv[4 * q + 2] * rstd * g.z, xv[4 * q + 3] * rstd * g.w);
    }
    const size_t ei0 = ((size_t)(lane >> 4) * T_TOK + t) * 16 + (lane & 15), ei1 = ei0 + (size_t)4 * T_TOK * 16;
    e0 = p.eidx[ei0]; e1 = p.eidx[ei1];
    g0 = p.gate[ei0]; g1 = p.gate[ei1];
    const int s0 = ((e0 >> 7) + e0) & (EXS_NS - 1), s1 = ((e1 >> 7) + e1) & (EXS_NS - 1);
    int base = 0, pos0 = 0, pos1 = 0;
#pragma unroll
    for (int s = 0; s < EXS_NS; ++s) {
        const unsigned long long m0 = __ballot(s0 == s), m1 = __ballot(s1 == s);
        const int c0 = __popcll(m0);
        pos0 = (s0 == s) ? base + ex_mbcnt(m0) : pos0;
        pos1 = (s1 == s) ? base + c0 + ex_mbcnt(m1) : pos1;
        base += c0 + __popcll(m1);
    }
    lst[pos0] = make_int2(e0, __float_as_int(g0)); lst[pos1] = make_int2(e1, __float_as_int(g1));
    const int2 q0 = lst[lane], q1 = lst[64 + lane];
    e0 = q0.x; g0 = __int_as_float(q0.y); e1 = q1.x; g1 = __int_as_float(q1.y);
}
__device__ __forceinline__ void ex2_end(PC& p, int layer, int t, int lane, bool last, bool dummy, float (&xv)[16], const float (&acc)[16]) {
    float* xwr = (dummy ? (float*)p.zb : p.x) + (size_t)t * DM + lane * 16;
    bf16_t* hwr = (dummy ? p.q.qA + (size_t)t * DM : p.hnb + (size_t)t * DM) + lane * 16;
#pragma unroll
    for (int i = 0; i < 16; ++i) xv[i] += acc[i];
    float s2 = 0.f;
#pragma unroll
    for (int i = 0; i < 16; ++i) s2 += xv[i] * xv[i];
    s2 = wave_sum(s2);
    const float r2 = rsqrtf(s2 * (1.f / DM) + 1e-6f);
    if (!last) {
#pragma unroll
        for (int q = 0; q < 4; ++q) *(float4*)(xwr + 4 * q) = make_float4(xv[4 * q], xv[4 * q + 1], xv[4 * q + 2], xv[4 * q + 3]);
        const float* gnb = p.g_mix + (layer + 1) * DM; asm volatile("" : "+s"(gnb));
        const float* gn = gnb + lane * 16;
        unsigned hw[8];
#pragma unroll
        for (int q = 0; q < 4; ++q) {
            const float4 g = *(const float4*)(gn + 4 * q);
            hw[2 * q] = cvtpk(xv[4 * q] * r2 * g.x, xv[4 * q + 1] * r2 * g.y);
            hw[2 * q + 1] = cvtpk(xv[4 * q + 2] * r2 * g.z, xv[4 * q + 3] * r2 * g.w);
        }
        *(uint4*)(hwr) = make_uint4(hw[0], hw[1], hw[2], hw[3]);
        *(uint4*)(hwr + 8) = make_uint4(hw[4], hw[5], hw[6], hw[7]);
    } else {
        const float* gnb = p.g_final; asm volatile("" : "+s"(gnb));
        const float* gn = gnb + lane * 16;
        float* orow = dummy ? xwr : p.out + (size_t)t * DM + lane * 16;
#pragma unroll
        for (int q = 0; q < 4; ++q) {
            const float4 g = *(const float4*)(gn + 4 * q);
            *(float4*)(orow + 4 * q) = make_float4(xv[4 * q] * r2 * g.x, xv[4 * q + 1] * r2 * g.y, xv[4 * q + 2] * r2 * g.z, xv[4 * q + 3] * r2 * g.w);
        }
    }
}
__device__ __forceinline__ void expert_token2(PC& p, int layer, int tA, int tB, bool last, int2* lst, bool dummy) {
    const int lane = tid_opaque() & 63;
    const int lane16 = lane * 16;
    float xvA[16], xvB[16]; unsigned hpA[8], hpB[8];
    int e0A, e1A, e0B, e1B; float g0A, g1A, g0B, g1B;
    ex2_begin(p, layer, tA, lane, lst, xvA, hpA, e0A, e1A, g0A, g1A);
    EX_SB();
    ex2_begin(p, layer, tB, lane, lst + 128, xvB, hpB, e0B, e1B, g0B, g1B);
    EX_SB();
    const unsigned char* u8 = p.u8 + (size_t)layer * 16384 * DM;
    const unsigned char* v8 = p.v8 + (size_t)layer * 16384 * DM;
    const float* su = p.su + layer * 16384; const float* sv = p.sv + layer * 16384;
    const float su0A = su[e0A], su1A = su[e1A], sv0A = sv[e0A], sv1A = sv[e1A];
    const float su0B = su[e0B], su1B = su[e1B], sv0B = sv[e0B], sv1B = sv[e1B];
    uint4 rx0, rx1, rx2, rx3, rx4, rx5, rx6, rx7, ry0, ry1, ry2, ry3, ry4, ry5, ry6, ry7;
    float a0A = 0.f, a1A = 0.f, a0B = 0.f, a1B = 0.f;
    EX_LOAD8(rx, u8, e0A, 0);
#pragma unroll 1
    for (int g = 0; g < 8; ++g) {
        const int ebA = g < 4 ? e0A : e1A, ebB = g < 4 ? e0B : e1B;
        const int sl = (g & 3) * 16;
        const bool mine = (lane >> 4) == (g & 3);
        f32x16 pp;
        EX_LOAD8(ry, u8, ebA, sl + 8);
        EX_SB();
        EX_DOT8H(rx, pp, 0, hpA);
        EX_SB();
        EX_LOAD8(rx, u8, ebB, sl);
        EX_SB();
        EX_DOT8H(ry, pp, 8, hpA);
        {
            const float v = transpose_reduce16(pp, lane);
            const float got = __shfl(v, (lane & 15) << 2);
            a0A = (mine && g < 4) ? got : a0A;
            a1A = (mine && g >= 4) ? got : a1A;
        }
        EX_SB();
        EX_LOAD8(ry, u8, ebB, sl + 8);
        EX_SB();
        EX_DOT8H(rx, pp, 0, hpB);
        EX_SB();
        {
            const int gn = g + 1 < 8 ? g + 1 : 0;
            const int ebn = gn < 4 ? e0A : e1A;
            const unsigned char* tabn = g + 1 < 8 ? u8 : v8;
            EX_LOAD8(rx, tabn, ebn, (gn & 3) * 16);
        }
        EX_SB();
        EX_DOT8H(ry, pp, 8, hpB);
        {
            const float v = transpose_reduce16(pp, lane);
            const float got = __shfl(v, (lane & 15) << 2);
            a0B = (mine && g < 4) ? got : a0B;
            a1B = (mine && g >= 4) ? got : a1B;
        }
        EX_SB();
    }
    const float w0A = g0A * gelu_exact(su0A * a0A) * sv0A, w1A = g1A * gelu_exact(su1A * a1A) * sv1A;
    const float w0B = g0B * gelu_exact(su0B * a0B) * sv0B, w1B = g1B * gelu_exact(su1B * a1B) * sv1B;
    float accA[16], accB[16];
#pragma unroll
    for (int i = 0; i < 16; ++i) { accA[i] = 0.f; accB[i] = 0.f; }
#pragma unroll 1
    for (int h2 = 0; h2 < 8; ++h2) {
        const int ebcA = h2 < 4 ? e0A : e1A, ebcB = h2 < 4 ? e0B : e1B;
        const float wbA = h2 < 4 ? w0A : w1A, wbB = h2 < 4 ? w0B : w1B;
        const int slc = (h2 & 3) * 16;
        EX_LOAD8(ry, v8, ebcA, slc + 8);
        EX_SB();
        EX_AXPY8A(rx, wbA, slc, accA);
        EX_SB();
        EX_LOAD8(rx, v8, ebcB, slc);
        EX_SB();
        EX_AXPY8A(ry, wbA, slc + 8, accA);
        EX_SB();
        EX_LOAD8(ry, v8, ebcB, slc + 8);
        EX_SB();
        EX_AXPY8A(rx, wbB, slc, accB);
        EX_SB();
        {
            const int hn_ = h2 + 1 < 8 ? h2 + 1 : 7;
            const int ebn = hn_ < 4 ? e0A : e1A;
            EX_LOAD8(rx, v8, ebn, (hn_ & 3) * 16);
        }
        EX_SB();
        EX_AXPY8A(ry, wbB, slc + 8, accB);
        EX_SB();
    }
    ex2_end(p, layer, tA, lane, last, dummy, xvA, accA);
    EX_SB();
    ex2_end(p, layer, tB, lane, last, dummy, xvB, accB);
}

__device__ __forceinline__ void ex2_endr(PC& p, int layer, int t, int lane, bool last, bool dummy, const float (&acc)[16]) {
    t = __builtin_amdgcn_readfirstlane(t); asm volatile("" : "+s"(t));
    float xv[16];
    const float* xrow = p.x + (size_t)t * DM + lane * 16;
#pragma unroll
    for (int q = 0; q < 4; ++q) { const float4 a = *(const float4*)(xrow + 4 * q); xv[4 * q] = a.x; xv[4 * q + 1] = a.y; xv[4 * q + 2] = a.z; xv[4 * q + 3] = a.w; }
    float zero[16];
#pragma unroll
    for (int i = 0; i < 16; ++i) { xv[i] += acc[i]; zero[i] = 0.f; }
    ex2_end(p, layer, t, lane, last, dummy, xv, zero);
}
#define EX_ACCIN(A) "v"(A[0]), "v"(A[1]), "v"(A[2]), "v"(A[3]), "v"(A[4]), "v"(A[5]), "v"(A[6]), "v"(A[7]), "v"(A[8]), "v"(A[9]), "v"(A[10]), "v"(A[11]), "v"(A[12]), "v"(A[13]), "v"(A[14]), "v"(A[15])
#define EX_ORDER2(RA, RB, A) asm volatile("" : "+v"(RA.x), "+v"(RA.y), "+v"(RA.z), "+v"(RA.w), "+v"(RB.x), "+v"(RB.y), "+v"(RB.z), "+v"(RB.w) : EX_ACCIN(A))
#define EX_AXPY8K(P, W, SL, ACC) do { axpy16_fp8(ACC, EX_RL(W, (SL) + 0), P##0); axpy16_fp8(ACC, EX_RL(W, (SL) + 1), P##1); axpy16_fp8(ACC, EX_RL(W, (SL) + 2), P##2); axpy16_fp8(ACC, EX_RL(W, (SL) + 3), P##3); \
        EX_ORDER2(P##4, P##5, ACC); EX_ORDER2(P##6, P##7, ACC); \
        axpy16_fp8(ACC, EX_RL(W, (SL) + 4), P##4); axpy16_fp8(ACC, EX_RL(W, (SL) + 5), P##5); axpy16_fp8(ACC, EX_RL(W, (SL) + 6), P##6); axpy16_fp8(ACC, EX_RL(W, (SL) + 7), P##7); } while (0)
typedef _Float16 h2_t __attribute__((ext_vector_type(2)));
__device__ __forceinline__ void axpy16_h(h2_t (&acc)[8], float w, uint4 v) {
    const _Float16 wh = (_Float16)w; const h2_t ww = {wh, wh};
    acc[0] = __builtin_elementwise_fma(ww, __builtin_bit_cast(h2_t, __builtin_amdgcn_cvt_scalef32_pk_f16_fp8((int)v.x, 1.0f, false)), acc[0]);
    acc[1] = __builtin_elementwise_fma(ww, __builtin_bit_cast(h2_t, __builtin_amdgcn_cvt_scalef32_pk_f16_fp8((int)v.x, 1.0f, true)), acc[1]);
    acc[2] = __builtin_elementwise_fma(ww, __builtin_bit_cast(h2_t, __builtin_amdgcn_cvt_scalef32_pk_f16_fp8((int)v.y, 1.0f, false)), acc[2]);
    acc[3] = __builtin_elementwise_fma(ww, __builtin_bit_cast(h2_t, __builtin_amdgcn_cvt_scalef32_pk_f16_fp8((int)v.y, 1.0f, true)), acc[3]);
    acc[4] = __builtin_elementwise_fma(ww, __builtin_bit_cast(h2_t, __builtin_amdgcn_cvt_scalef32_pk_f16_fp8((int)v.z, 1.0f, false)), acc[4]);
    acc[5] = __builtin_elementwise_fma(ww, __builtin_bit_cast(h2_t, __builtin_amdgcn_cvt_scalef32_pk_f16_fp8((int)v.z, 1.0f, true)), acc[5]);
    acc[6] = __builtin_elementwise_fma(ww, __builtin_bit_cast(h2_t, __builtin_amdgcn_cvt_scalef32_pk_f16_fp8((int)v.w, 1.0f, false)), acc[6]);
    acc[7] = __builtin_elementwise_fma(ww, __builtin_bit_cast(h2_t, __builtin_amdgcn_cvt_scalef32_pk_f16_fp8((int)v.w, 1.0f, true)), acc[7]);
}
#define EX_ACCINH(A) "v"(A[0]), "v"(A[1]), "v"(A[2]), "v"(A[3]), "v"(A[4]), "v"(A[5]), "v"(A[6]), "v"(A[7])
#define EX_ORDER2H(RA, RB, A) asm volatile("" : "+v"(RA.x), "+v"(RA.y), "+v"(RA.z), "+v"(RA.w), "+v"(RB.x), "+v"(RB.y), "+v"(RB.z), "+v"(RB.w) : EX_ACCINH(A))
#define EX_AXPY8H(P, W, SL, ACC) do { axpy16_h(ACC, EX_RL(W, (SL) + 0), P##0); axpy16_h(ACC, EX_RL(W, (SL) + 1), P##1); axpy16_h(ACC, EX_RL(W, (SL) + 2), P##2); axpy16_h(ACC, EX_RL(W, (SL) + 3), P##3); \
        if (EXK_ORD) { EX_ORDER2H(P##4, P##5, ACC); EX_ORDER2H(P##6, P##7, ACC); } \
        axpy16_h(ACC, EX_RL(W, (SL) + 4), P##4); axpy16_h(ACC, EX_RL(W, (SL) + 5), P##5); axpy16_h(ACC, EX_RL(W, (SL) + 6), P##6); axpy16_h(ACC, EX_RL(W, (SL) + 7), P##7); } while (0)
#ifndef EXK_ORD
#define EXK_ORD 1
#endif
#ifndef EXS_MIDSYNC
#define EXS_MIDSYNC 0
#endif
#ifndef EXK_PIN
#define EXK_PIN 1
#endif
template <int K>
__device__ __forceinline__ void expert_tokens(PC& p, int layer, const int (&tq)[K], bool last, int2* lst, char* syncp) {
    int tt[K]; bool dm[K];
#pragma unroll
    for (int k = 0; k < K; ++k) { dm[k] = tq[k] >= T_TOK; tt[k] = dm[k] ? T_TOK - 1 : tq[k]; }
    const int lane = tid_opaque() & 63;
    const int lane16 = lane * 16;
    constexpr int KR = K < 4 ? K : 4;
    unsigned hp[KR][8];
    char* hpl = (char*)(lst + 128 * K);
    int e0[KR], e1[KR];
#pragma unroll
    for (int k = 0; k < K; ++k) {
        float xv[16]; float g0, g1; unsigned hq[8]; int ea, eb;
        ex2_begin(p, layer, tt[k], lane, lst + 128 * k, xv, hq, ea, eb, g0, g1);
        if (k < KR) { e0[k < KR ? k : 0] = ea; e1[k < KR ? k : 0] = eb; }
        if (k < KR) {
#pragma unroll
            for (int i = 0; i < 8; ++i) hp[k < KR ? k : 0][i] = hq[i];
        } else {
            *(uint4*)(hpl + (k - KR) * 2048 + lane16) = make_uint4(hq[0], hq[1], hq[2], hq[3]);
            *(uint4*)(hpl + (k - KR) * 2048 + 1024 + lane16) = make_uint4(hq[4], hq[5], hq[6], hq[7]);
        }
        if ((k & 3) == 3) EX_SB();
    }
    const unsigned char* u8 = p.u8 + (size_t)layer * 16384 * DM;
    const unsigned char* v8 = p.v8 + (size_t)layer * 16384 * DM;
    const float* su = p.su + layer * 16384; const float* sv = p.sv + layer * 16384;
    float a0[K], a1[K];
#pragma unroll
    for (int k = 0; k < K; ++k) { a0[k] = 0.f; a1[k] = 0.f; }
    uint4 rx0, rx1, rx2, rx3, rx4, rx5, rx6, rx7, ry0, ry1, ry2, ry3, ry4, ry5, ry6, ry7;
#define EXK_E(KK, HALF) ((KK) < KR ? ((HALF) ? e1[(KK) < KR ? (KK) : 0] : e0[(KK) < KR ? (KK) : 0]) : lst[128 * (KK) + 64 * (HALF) + lane].x)
    { const int eb = EXK_E(0, 0); EX_LOAD8(rx, u8, eb, 0); }
#pragma unroll 1
    for (int g = 0; g < 8; ++g) {
        const int sl = (g & 3) * 16, hf = g >> 2;
        const bool mine = (lane >> 4) == (g & 3);
#pragma unroll
        for (int k = 0; k < K; ++k) {
            f32x16 pp;
            { const int ebk = EXK_E(k, hf); EX_LOAD8(ry, u8, ebk, sl + 8); }
            EX_SB();
            unsigned hh[8];
            if (k < KR) {
#pragma unroll
                for (int i = 0; i < 8; ++i) hh[i] = hp[k < KR ? k : 0][i];
            } else {
                const uint4 h0 = *(const uint4*)(hpl + (k - KR) * 2048 + lane16), h1 = *(const uint4*)(hpl + (k - KR) * 2048 + 1024 + lane16);
                hh[0] = h0.x; hh[1] = h0.y; hh[2] = h0.z; hh[3] = h0.w; hh[4] = h1.x; hh[5] = h1.y; hh[6] = h1.z; hh[7] = h1.w;
            }
            EX_DOT8H(rx, pp, 0, hh);
            EX_SB();
            if (k + 1 < K) { const int ebn = EXK_E((k + 1) % K, hf); EX_LOAD8(rx, u8, ebn, sl); }
            else {
                const int gn = g + 1 < 8 ? g + 1 : 0;
                const int ebn = EXK_E(0, gn >> 2);
                const unsigned char* tabn = g + 1 < 8 ? u8 : v8;
                EX_LOAD8(rx, tabn, ebn, (gn & 3) * 16);
            }
            EX_SB();
            EX_DOT8H(ry, pp, 8, hh);
            const float v = transpose_reduce16(pp, lane);
            const float got = __shfl(v, (lane & 15) << 2);
            a0[k] = (mine && g < 4) ? got : a0[k];
            a1[k] = (mine && g >= 4) ? got : a1[k];
            EX_SB();
        }
    }
#if EXS_MIDSYNC
    xcd_local_sync_p(syncp);
#endif
    float w0[K], w1[K]; h2_t acc[K][8];
    {
        float s0[K], s1[K], t0[K], t1[K], gg0[K], gg1[K];
#pragma unroll
        for (int k = 0; k < K; ++k) {
            const int2 q0 = lst[128 * k + lane], q1 = lst[128 * k + 64 + lane];
            s0[k] = su[q0.x]; s1[k] = su[q1.x]; t0[k] = sv[q0.x]; t1[k] = sv[q1.x];
            gg0[k] = __int_as_float(q0.y); gg1[k] = __int_as_float(q1.y);
        }
#pragma unroll
        for (int k = 0; k < K; ++k) { w0[k] = gg0[k] * gelu_exact(s0[k] * a0[k]) * t0[k]; w1[k] = gg1[k] * gelu_exact(s1[k] * a1[k]) * t1[k]; }
    }
#pragma unroll
    for (int k = 0; k < K; ++k)
#pragma unroll
        for (int i = 0; i < 8; ++i) acc[k][i] = (h2_t){(_Float16)0.f, (_Float16)0.f};
#pragma unroll 1
    for (int h2 = 0; h2 < 8; ++h2) {
        const int slc = (h2 & 3) * 16, hf = h2 >> 2;
#pragma unroll
        for (int k = 0; k < K; ++k) {
            const float wb = h2 < 4 ? w0[k] : w1[k];
            { const int ebc = EXK_E(k, hf); EX_LOAD8(ry, v8, ebc, slc + 8); }
            EX_SB();
            EX_AXPY8H(rx, wb, slc, acc[k]);
            EX_SB();
            if (k + 1 < K) { const int ebn = EXK_E((k + 1) % K, hf); EX_LOAD8(rx, v8, ebn, slc); }
            else { const int hn_ = h2 + 1 < 8 ? h2 + 1 : 7; const int ebn = EXK_E(0, hn_ >> 2); EX_LOAD8(rx, v8, ebn, (hn_ & 3) * 16); }
            EX_SB();
            EX_AXPY8H(ry, wb, slc + 8, acc[k]);
            EX_SB();
        }
    }
#undef EXK_E
#pragma unroll
    for (int k = 0; k < K; ++k) {
        float af[16];
#pragma unroll
        for (int i = 0; i < 8; ++i) { af[2 * i] = (float)acc[k][i][0]; af[2 * i + 1] = (float)acc[k][i][1]; }
        ex2_endr(p, layer, tt[k], lane, last, dm[k], af);
    }
}
__device__ __forceinline__ void transpose_load(const float* __restrict__ src, int N, int tk, int tn, int tid, float4 (&v)[2]) {
    const int k0 = tk * 64, n0 = tn * 64, kk = tid >> 4, c4 = (tid & 15) * 4;
#pragma unroll
    for (int h = 0; h < 2; ++h) {
        v[h] = make_float4(0.f, 0.f, 0.f, 0.f);
        if (n0 + c4 < N) v[h] = *(const float4*)(src + (size_t)(k0 + kk + 32 * h) * N + n0 + c4);
    }
}
__device__ __forceinline__ void transpose_all(const float* src, int K, int N, bf16_t* dst, float* tl, const float* ksc = nullptr, int perm = 0) {
    const int tid = tid_opaque();
    const int ntk = K / 64, ntn = (N + 63) / 64, nt = ntk * ntn;
    int t = blockIdx.x;
    if (t >= nt) return;
    float4 va, vb;
    { float4 v[2]; transpose_load(src, N, t / ntn, t % ntn, tid, v); va = v[0]; vb = v[1]; }
    for (; t < nt; t += gridDim.x) {
        const int tk = t / ntn, tn = t % ntn, k0 = tk * 64, n0 = tn * 64;
        {
            const int kk = tid >> 4, c4 = (tid & 15) * 4;
            float* d = tl + kk * 65 + c4;
            d[0] = va.x; d[1] = va.y; d[2] = va.z; d[3] = va.w;
            d += 32 * 65;
            d[0] = vb.x; d[1] = vb.y; d[2] = vb.z; d[3] = vb.w;
        }
        __syncthreads();
        const int tn2 = t + gridDim.x;
        if (tn2 < nt) { float4 v[2]; transpose_load(src, N, tn2 / ntn, tn2 % ntn, tid, v); va = v[0]; vb = v[1]; }
        {
            const int nn = tid >> 3, kq = (tid & 7) * 8;
            if (n0 + nn < N) {
                int nd = n0 + nn;
                if (perm) { const int hq = nd / 96, wq = nd % 96; nd = wq < 64 ? hq * 64 + wq : 256 + hq * 32 + (wq - 64); }
                float f[8];
#pragma unroll
                for (int j = 0; j < 8; ++j) f[j] = tl[(kq + j) * 65 + nn] * (ksc ? ksc[k0 + kq + j] : 1.f);
                *(uint4*)(dst + (size_t)nd * K + k0 + kq) = make_uint4(cvtpk(f[0], f[1]), cvtpk(f[2], f[3]), cvtpk(f[4], f[5]), cvtpk(f[6], f[7]));
            }
        }
        __syncthreads();
    }
}
__device__ __forceinline__ void convert_plain(const float* __restrict__ src, bf16_t* __restrict__ dst, size_t n) {
    const size_t n8 = n >> 3;
    for (size_t i = (size_t)blockIdx.x * blockDim.x + tid_opaque(); i < n8; i += (size_t)gridDim.x * blockDim.x) {
        const float4 a = *(const float4*)(src + i * 8), b = *(const float4*)(src + i * 8 + 4);
        uint4 w; w.x = cvtpk(a.x, a.y); w.y = cvtpk(a.z, a.w); w.z = cvtpk(b.x, b.y); w.w = cvtpk(b.z, b.w);
        *(uint4*)(dst + i * 8) = w;
    }
}
__device__ __forceinline__ void convert_rows_fp8(const float* __restrict__ src, unsigned char* __restrict__ dst, float* __restrict__ scales, int nrows) {
    const int tid = tid_opaque(), wave = tid >> 6, lane = tid & 63;
    const int stride = gridDim.x * NW;
    for (int row0 = blockIdx.x * NW + wave; row0 < nrows; row0 += 4 * stride) {
        float4 xv[4][4];
#pragma unroll
        for (int u = 0; u < 4; ++u) {
            int row = row0 + u * stride; row = row < nrows ? row : row0;
            const float* sr = src + (size_t)row * DM + lane * 16;
#pragma unroll
            for (int q = 0; q < 4; ++q) xv[u][q] = *(const float4*)(sr + 4 * q);
        }
#pragma unroll
        for (int u = 0; u < 4; ++u) {
            const int row = row0 + u * stride;
            float am = 0.f;
#pragma unroll
            for (int q = 0; q < 4; ++q) am = fmaxf(fmaxf(am, fmaxf(fabsf(xv[u][q].x), fabsf(xv[u][q].y))), fmaxf(fabsf(xv[u][q].z), fabsf(xv[u][q].w)));
            am = wave_max(am);
            const float sc = am > 0.f ? am * (1.f / 448.f) : 1.f;
            const float inv = 1.f / sc;
            unsigned w[4];
#pragma unroll
            for (int q = 0; q < 4; ++q) {
                int t = 0;
                t = __builtin_amdgcn_cvt_pk_fp8_f32(xv[u][q].x * inv, xv[u][q].y * inv, t, false);
                t = __builtin_amdgcn_cvt_pk_fp8_f32(xv[u][q].z * inv, xv[u][q].w * inv, t, true);
                w[q] = (unsigned)t;
            }
            if (row < nrows) {
                *(uint4*)(dst + (size_t)row * DM + lane * 16) = make_uint4(w[0], w[1], w[2], w[3]);
                if (lane == 0) scales[row] = sc;
            }
        }
    }
}
__device__ __forceinline__ void rms_row_bf16(const float* __restrict__ src, const float* __restrict__ g, bf16_t* __restrict__ dst, float* __restrict__ cpy, int lane) {
    float xv[16];
    const float4 a0 = *(const float4*)(src + lane * 8), a1 = *(const float4*)(src + lane * 8 + 4);
    const float4 b0 = *(const float4*)(src + 512 + lane * 8), b1 = *(const float4*)(src + 512 + lane * 8 + 4);
    xv[0] = a0.x; xv[1] = a0.y; xv[2] = a0.z; xv[3] = a0.w; xv[4] = a1.x; xv[5] = a1.y; xv[6] = a1.z; xv[7] = a1.w;
    xv[8] = b0.x; xv[9] = b0.y; xv[10] = b0.z; xv[11] = b0.w; xv[12] = b1.x; xv[13] = b1.y; xv[14] = b1.z; xv[15] = b1.w;
    if (cpy) {
        *(float4*)(cpy + lane * 8) = a0; *(float4*)(cpy + lane * 8 + 4) = a1;
        *(float4*)(cpy + 512 + lane * 8) = b0; *(float4*)(cpy + 512 + lane * 8 + 4) = b1;
    }
    float ss = 0.f;
#pragma unroll
    for (int i = 0; i < 16; ++i) ss += xv[i] * xv[i];
    ss = wave_sum(ss);
    const float r = rsqrtf(ss * (1.f / DM) + 1e-6f);
    const float4 g0 = *(const float4*)(g + lane * 8), g1 = *(const float4*)(g + lane * 8 + 4);
    const float4 g2 = *(const float4*)(g + 512 + lane * 8), g3 = *(const float4*)(g + 512 + lane * 8 + 4);
    uint4 wa, wb;
    wa.x = cvtpk(xv[0] * r * g0.x, xv[1] * r * g0.y); wa.y = cvtpk(xv[2] * r * g0.z, xv[3] * r * g0.w);
    wa.z = cvtpk(xv[4] * r * g1.x, xv[5] * r * g1.y); wa.w = cvtpk(xv[6] * r * g1.z, xv[7] * r * g1.w);
    wb.x = cvtpk(xv[8] * r * g2.x, xv[9] * r * g2.y); wb.y = cvtpk(xv[10] * r * g2.z, xv[11] * r * g2.w);
    wb.z = cvtpk(xv[12] * r * g3.x, xv[13] * r * g3.y); wb.w = cvtpk(xv[14] * r * g3.z, xv[15] * r * g3.w);
    *(uint4*)(dst + lane * 8) = wa; *(uint4*)(dst + 512 + lane * 8) = wb;
}

__device__ __forceinline__ void rms_row2_bf16(const float* __restrict__ s0, const float* __restrict__ s1, const float* __restrict__ g, bf16_t* __restrict__ d0, bf16_t* __restrict__ d1, int lane) {
    float4 a[4], b[4];
#pragma unroll
    for (int q = 0; q < 4; ++q) { a[q] = *(const float4*)(s0 + (q >> 1) * 512 + lane * 8 + (q & 1) * 4); b[q] = s1 ? *(const float4*)(s1 + (q >> 1) * 512 + lane * 8 + (q & 1) * 4) : make_float4(0.f, 0.f, 0.f, 0.f); }
    float sa = 0.f, sb = 0.f;
#pragma unroll
    for (int q = 0; q < 4; ++q) { sa += a[q].x * a[q].x + a[q].y * a[q].y + a[q].z * a[q].z + a[q].w * a[q].w; sb += b[q].x * b[q].x + b[q].y * b[q].y + b[q].z * b[q].z + b[q].w * b[q].w; }
    sa = wave_sum(sa); sb = wave_sum(sb);
    const float ra = rsqrtf(sa * (1.f / DM) + 1e-6f), rb = rsqrtf(sb * (1.f / DM) + 1e-6f);
    float4 gq[4];
#pragma unroll
    for (int q = 0; q < 4; ++q) gq[q] = *(const float4*)(g + (q >> 1) * 512 + lane * 8 + (q & 1) * 4);
    uint4 w;
    w.x = cvtpk(a[0].x * ra * gq[0].x, a[0].y * ra * gq[0].y); w.y = cvtpk(a[0].z * ra * gq[0].z, a[0].w * ra * gq[0].w);
    w.z = cvtpk(a[1].x * ra * gq[1].x, a[1].y * ra * gq[1].y); w.w = cvtpk(a[1].z * ra * gq[1].z, a[1].w * ra * gq[1].w);
    *(uint4*)(d0 + lane * 8) = w;
    w.x = cvtpk(a[2].x * ra * gq[2].x, a[2].y * ra * gq[2].y); w.y = cvtpk(a[2].z * ra * gq[2].z, a[2].w * ra * gq[2].w);
    w.z = cvtpk(a[3].x * ra * gq[3].x, a[3].y * ra * gq[3].y); w.w = cvtpk(a[3].z * ra * gq[3].z, a[3].w * ra * gq[3].w);
    *(uint4*)(d0 + 512 + lane * 8) = w;
    if (s1) {
        w.x = cvtpk(b[0].x * rb * gq[0].x, b[0].y * rb * gq[0].y); w.y = cvtpk(b[0].z * rb * gq[0].z, b[0].w * rb * gq[0].w);
        w.z = cvtpk(b[1].x * rb * gq[1].x, b[1].y * rb * gq[1].y); w.w = cvtpk(b[1].z * rb * gq[1].z, b[1].w * rb * gq[1].w);
        *(uint4*)(d1 + lane * 8) = w;
        w.x = cvtpk(b[2].x * rb * gq[2].x, b[2].y * rb * gq[2].y); w.y = cvtpk(b[2].z * rb * gq[2].z, b[2].w * rb * gq[2].w);
        w.z = cvtpk(b[3].x * rb * gq[3].x, b[3].y * rb * gq[3].y); w.w = cvtpk(b[3].z * rb * gq[3].z, b[3].w * rb * gq[3].w);
        *(uint4*)(d1 + 512 + lane * 8) = w;
    }
}

__device__ __forceinline__ void phase_pro(PC& p, char* lds) {
    float* tl = (float*)lds;
    for (int l = 0; l < DEPTH; ++l) {
        transpose_all(p.w_in + (size_t)l * DM * NZ, DM, NZ, p.winT + (size_t)l * NZ * DM, tl);
        transpose_all(p.w_out + (size_t)l * DM * DM, DM, DM, p.woutT + (size_t)l * DM * DM, tl, (p.flags & 16) ? p.g_group + (size_t)l * 1024 : nullptr);
        transpose_all(p.peer_w_q + (size_t)l * DM * 2048, DM, 2048, p.wqT + (size_t)l * 2048 * DM, tl, (p.flags & 4) ? p.g_ffn + l * DM : nullptr);
        transpose_all(p.mla_w_uq + (size_t)l * 256 * 384, 256, 384, p.wuqT + (size_t)l * 384 * 256, tl, (p.flags & 8) ? p.mla_q_norm + l * 256 : nullptr, (p.flags & 32) ? 1 : 0);
        transpose_all(p.mla_w_ukv + (size_t)l * 128 * 512, 128, 512, p.wukvT + (size_t)l * 512 * 128, tl, (p.flags & 8) ? p.mla_kv_norm + l * 128 : nullptr);
    }
    convert_plain(p.peer_sub_keys, p.subk, (size_t)DEPTH * 8 * 2 * 128 * 128);
    if ((p.flags & 3) == 1) {
        convert_rows_fp8(p.peer_u, p.u8, p.su, DEPTH * 16384);
        convert_rows_fp8(p.peer_v, p.v8, p.sv, DEPTH * 16384);
    }
    for (int i = blockIdx.x * blockDim.x + tid_opaque(); i < 4096 * 32; i += gridDim.x * blockDim.x) {
        {
            const int pos = i / 32, j = i % 32;
            const float inv = powf(10000.f, -(float)(2 * j) / 64.f); const float ang = (float)pos * inv;
            p.tb.cos1[i] = cosf(ang); p.tb.sin1[i] = sinf(ang);
        }
        if (i < 4096 * 16) {
            const int pos = i / 16, j = i % 16;
            const float inv = powf(10000.f, -(float)(2 * j) / 32.f); const float ang = (float)pos * inv;
            p.tb.cosm[i] = cosf(ang); p.tb.sinm[i] = sinf(ang);
        }
        if (i < 64 * 16) {
            const int pos = i / 16, j = i % 16;
            const float inv = powf(10000.f, -(float)(2 * j) / 32.f); const float ang = (float)pos * inv;
            p.tb.cosr[i] = cosf(ang); p.tb.sinr[i] = sinf(ang); p.tb.cosc[i] = cosf(ang); p.tb.sinc[i] = sinf(ang);
        }
    }
    const int wave = tid_opaque() >> 6, lane = tid_opaque() & 63;
    for (int t = blockIdx.x * NW + wave; t < T_TOK; t += gridDim.x * NW)
        rms_row_bf16(p.x_in + (size_t)t * DM, p.g_mix, p.hnb + (size_t)t * DM, nullptr, lane);
}

__device__ __forceinline__ void phase_g1(PC& p, int l, char* lds) {
    RowsPostZ eZ{p.q.qA, p.tb.cos1, p.ax_q_norm + l * 64, p.ax_k_norm + l * 64, p.cqn, p.ssqd, p.q.kD};
    RowsPostQ eQ{p.q.qD, p.tb.cos1, p.ssqd};
    RowsPostKV eKV{p.q.kD, p.q.vD, p.ssqd + (size_t)4 * T_TOK};
    const bf16_t* win = p.winT + (size_t)l * NZ * DM;
    const bf16_t* wuq = p.wuqT + (size_t)l * 384 * 256; const bf16_t* wukv = p.wukvT + (size_t)l * 512 * 128;
    const bool mapped = (gridDim.x & 63) == 0 && (1024 % gridDim.x) == 0;
    for (int tile = blockIdx.x; tile < 1024; tile += gridDim.x) {
        int mt, nt;
        if (mapped) { tile_map(tile, 128, 8, mt, nt); nt = (nt + 2 * (tile / gridDim.x)) & 7; }
        else { mt = tile >> 3; nt = tile & 7; }
        gemm_tile_rows<RowsPostZ, 0>(p.hnb, DM, win, DM, DM, mt * 256, nt * 256, NZ, lds, eZ);
        if (nt >= 6) {
            asm volatile("s_waitcnt vmcnt(0)" ::: "memory");
            __syncthreads();
            if (nt == 6) {
                gemm_tile_rows<RowsPostQ, 0>(p.cqn, 256, wuq, 256, 256, mt * 256, 0, 384, lds, eQ);
                gemm_tile_rows<RowsPostQ, 0>(p.cqn, 256, wuq, 256, 256, mt * 256, 256, 384, lds, eQ);
            } else {
                gemm_tile_rows<RowsPostKV, 0>(p.ckvn, 128, wukv, 128, 128, mt * 256, 0, 512, lds, eKV);
                gemm_tile_rows<RowsPostKV, 0>(p.ckvn, 128, wukv, 128, 128, mt * 256, 256, 512, lds, eKV);
            }
        }
    }
}

__device__ __forceinline__ void phase_att(PC& p, int l, char* lds) {
    for (int it = blockIdx.x; it < 512; it += gridDim.x) attn_item<96, 1, false>(p.q.qD, p.q.kD, p.q.vD, nullptr, p.ob, 768, 4, 4, it, lds, (p.flags & 32) ? 128 : 96);
    if (p.flags & 2) convert_rows_fp8(p.peer_u + (size_t)l * 16384 * DM, p.u8 + (size_t)l * 16384 * DM, p.su + l * 16384, 16384);
    for (int it = blockIdx.x; it < 512; it += gridDim.x) attn_item<64, 2, false>(p.q.qB, p.q.kB, p.q.vB, nullptr, p.ob, 256, 4, 2, it, lds);
    if (p.flags & 2) convert_rows_fp8(p.peer_v + (size_t)l * 16384 * DM, p.v8 + (size_t)l * 16384 * DM, p.sv + l * 16384, 16384);
    for (int it = blockIdx.x; it < 512; it += gridDim.x) attn_item<64, 2, true>(p.q.qA, p.q.kA, p.q.vA, p.win_sink + l * 4, p.ob, 0, 4, 2, it, lds);
    {
        const int wave = tid_opaque() >> 6;
        char* wl = lds + wave * 6144;
        const int off = (int)(uintptr_t)wl;
        for (int wi = blockIdx.x * NW + wave; wi < 4096; wi += gridDim.x * NW) dil_wave_item(p.q.qC, p.q.kC, p.q.vC, p.ob, wi, wl, off);
    }
}

__device__ __forceinline__ void phase_gn(PC& p, int l) {
    const int wave = tid_opaque() >> 6, lane = tid_opaque() & 63;
    const float* gg = p.g_group + (size_t)l * 1024;
    const bf16_t* ob = p.ob; bf16_t* hnb = p.hnb;
    for (int t0 = blockIdx.x * NW + wave; t0 < T_TOK; t0 += gridDim.x * 2 * NW) {
        const int t1 = t0 + gridDim.x * NW;
        const bool has1 = t1 < T_TOK;
        uint2 w0[4], w1[4];
#pragma unroll
        for (int g = 0; g < 4; ++g) {
            w0[g] = *(const uint2*)(ob + (size_t)t0 * DM + g * 256 + lane * 4);
            w1[g] = has1 ? *(const uint2*)(ob + (size_t)t1 * DM + g * 256 + lane * 4) : make_uint2(0, 0);
        }
#pragma unroll
        for (int g = 0; g < 4; ++g) {
            const float4 g4 = *(const float4*)(gg + g * 256 + lane * 4);
            {
                const float v0 = __uint_as_float(w0[g].x << 16), v1 = __uint_as_float(w0[g].x & 0xffff0000u), v2 = __uint_as_float(w0[g].y << 16), v3 = __uint_as_float(w0[g].y & 0xffff0000u);
                const float r = rsqrtf(wave_sum(v0 * v0 + v1 * v1 + v2 * v2 + v3 * v3) * (1.f / 256.f) + 1e-6f);
                uint2 o; o.x = cvtpk(v0 * r * g4.x, v1 * r * g4.y); o.y = cvtpk(v2 * r * g4.z, v3 * r * g4.w);
                *(uint2*)(hnb + (size_t)t0 * DM + g * 256 + lane * 4) = o;
            }
            if (has1) {
                const float v0 = __uint_as_float(w1[g].x << 16), v1 = __uint_as_float(w1[g].x & 0xffff0000u), v2 = __uint_as_float(w1[g].y << 16), v3 = __uint_as_float(w1[g].y & 0xffff0000u);
                const float r = rsqrtf(wave_sum(v0 * v0 + v1 * v1 + v2 * v2 + v3 * v3) * (1.f / 256.f) + 1e-6f);
                uint2 o; o.x = cvtpk(v0 * r * g4.x, v1 * r * g4.y); o.y = cvtpk(v2 * r * g4.z, v3 * r * g4.w);
                *(uint2*)(hnb + (size_t)t1 * DM + g * 256 + lane * 4) = o;
            }
        }
    }
}
__device__ __forceinline__ void phase_g2(PC& p, int l, char* lds) {
    RowsResidNorm e{p.x, DM, p.xb2, p.ssq2, l == 0 ? p.x_in : (const float*)p.x};
    gemm_phase_rows<RowsResidNorm, 0>(p.hnb, DM, p.woutT + (size_t)l * DM * DM, DM, T_TOK, DM, DM, lds, e);
}
__device__ __forceinline__ void phase_g3(PC& p, int l, char* lds) {
    const bf16_t* sk = p.subk + (size_t)l * 8 * 2 * 128 * 128;
    const bf16_t* wq = p.wqT + (size_t)l * 2048 * DM;
    for (int tile = blockIdx.x; tile < 128 * 8; tile += gridDim.x) {
        int mt, nt;
        if ((gridDim.x & 63) == 0 && ((128 * 8) % gridDim.x) == 0) tile_map(tile, 128, 8, mt, nt); else { mt = tile >> 3; nt = tile & 7; }
        gemm_tile_topk(p.xb2, DM, wq, DM, DM, mt * 256, nt, lds, sk, p.ssq2, p.eidx, p.gate);
    }
}


#define XB_TMO      128
#define XB_XCNT(j)  (256  + 64 * (j))
#define XB_XSUB(j)  (1280 + 64 * (j))
#define XB_XGEN(j)  (2304 + 64 * (j))
#define XB_TOP      3328
#define XB_TOPGEN   3392
#define XCD_BAR_WORDS 5504
#define XB_SPIN_CAP (1u << 18)
#define LAS __attribute__((address_space(3)))

__device__ __forceinline__ unsigned xb_ld(unsigned* p)              { return __hip_atomic_load(p, __ATOMIC_RELAXED, __HIP_MEMORY_SCOPE_AGENT); }
__device__ __forceinline__ unsigned xb_add(unsigned* p, unsigned v) { return __hip_atomic_fetch_add(p, v, __ATOMIC_RELAXED, __HIP_MEMORY_SCOPE_AGENT); }
__device__ __forceinline__ unsigned xb_xcc_id() { return (unsigned)__builtin_amdgcn_s_getreg((3 << 11) | 20) & 0xFu; }
#define XB_SPIN(cond, bar) do { unsigned _sp = 0; while (cond) { __builtin_amdgcn_s_sleep(1); \
    if ((++_sp & 255u) == 0u) { if (xb_ld(&(bar)[XB_TMO])) break; if (_sp > XB_SPIN_CAP) { atomicAdd(&(bar)[XB_TMO], 1u); break; } } } } while (0)

struct XcdBarrier {
    unsigned* bar; unsigned x;
    volatile LAS unsigned* st;
};

__device__ __forceinline__ XcdBarrier xcd_barrier_post(unsigned* bar, volatile LAS unsigned* st) {
    XcdBarrier b; b.bar = bar; b.x = xb_xcc_id(); b.st = st;
    if (threadIdx.x == 0) (void)xb_add(&bar[XB_XCNT(b.x)], 1u);
    return b;
}
__device__ __forceinline__ void xcd_barrier_complete(unsigned* bar, unsigned x, unsigned& nloc, unsigned& nx) {
    const unsigned G = gridDim.x * gridDim.y * gridDim.z;
    unsigned sum, cnt, mine, sp = 0u;
    for (;;) {
        sum = 0u; cnt = 0u; mine = 0u;
#pragma unroll
        for (unsigned j = 0; j < 16; ++j) { const unsigned c = xb_ld(&bar[XB_XCNT(j)]); sum += c; cnt += (c > 0u) ? 1u : 0u; mine = (j == x) ? c : mine; }
        if (sum == G) break;
        __builtin_amdgcn_s_sleep(1);
        if ((++sp & 255u) == 0u) { if (xb_ld(&bar[XB_TMO])) break; if (sp > XB_SPIN_CAP) { atomicAdd(&bar[XB_TMO], 1u); break; } }
    }
    nloc = mine > 0u ? mine : 1u; nx = cnt > 0u ? cnt : 1u;
}

__device__ __forceinline__ void xcd_barrier(const XcdBarrier& b) {
    asm volatile("s_waitcnt vmcnt(0)" ::: "memory");
    __syncthreads();
    if (threadIdx.x == 0) {
        unsigned* bar = b.bar;
        __builtin_amdgcn_s_waitcnt(0);
        unsigned nloc = b.st[0], nx = b.st[1];
        if (nloc == 0u) { xcd_barrier_complete(bar, b.x, nloc, nx); b.st[0] = nloc; b.st[1] = nx; }
        const unsigned old = xb_add(&bar[XB_XSUB(b.x)], 1u);
        const unsigned gen = old / nloc;
        if (old + 1u == (gen + 1u) * nloc) {
            __builtin_amdgcn_fence(__ATOMIC_RELEASE, "agent");
            asm volatile("s_waitcnt vmcnt(0)" ::: "memory");
            const unsigned og = xb_add(&bar[XB_TOP], 1u);
            const unsigned tg = og / nx;
            if (og + 1u == (tg + 1u) * nx) xb_add(&bar[XB_TOPGEN], 1u);
            else XB_SPIN(xb_ld(&bar[XB_TOPGEN]) == tg, bar);
            __builtin_amdgcn_fence(__ATOMIC_ACQUIRE, "agent");
            xb_add(&bar[XB_XGEN(b.x)], 1u);
            asm volatile("s_waitcnt vmcnt(0)" ::: "memory");
        } else {
            XB_SPIN(xb_ld(&bar[XB_XGEN(b.x)]) == gen, bar);
            __builtin_amdgcn_fence(__ATOMIC_ACQUIRE, "agent");
            asm volatile("s_waitcnt vmcnt(0)" ::: "memory");
        }
    }
    __syncthreads();
}


#define XB2_SUB(j)  (3456 + 64 * (j))
#define XB2_GEN(j)  (4480 + 64 * (j))
__device__ __forceinline__ void xcd_local_sync(volatile LAS unsigned* st) {
    __syncthreads();
    if (threadIdx.x == 0) {
        unsigned* bar = kargs()->bar; const unsigned bx = xb_xcc_id();
        const unsigned nloc = st[0] ? st[0] : 1u;
        const unsigned old = xb_add(&bar[XB2_SUB(bx)], 1u);
        const unsigned gen = old / nloc;
        if (old + 1u == (gen + 1u) * nloc) xb_add(&bar[XB2_GEN(bx)], 1u);
        else XB_SPIN(xb_ld(&bar[XB2_GEN(bx)]) == gen, bar);
    }
    __syncthreads();
}
__device__ __forceinline__ void xcd_local_sync_p(char* st) { xcd_local_sync((volatile LAS unsigned*)st); }
#ifndef EXK
#define EXK 8
#endif
__device__ __forceinline__ void phase_exp(PC& p, int l, char* lds) {
    const int wave = tid_opaque() >> 6;
    const int stride = gridDim.x * NW, rounds = (T_TOK + EXK * stride - 1) / (EXK * stride);
    for (int i = 0; i < rounds; ++i) {
        int tt[EXK];
#pragma unroll
        for (int k = 0; k < EXK; ++k) tt[k] = (EXK * i + k) * stride + blockIdx.x * NW + wave;
        xcd_local_sync((volatile LAS unsigned*)(lds + LDS_BYTES));
        expert_tokens<EXK>(p, l, tt, l == DEPTH - 1, (int2*)(lds + wave * (1024 * EXK + (EXK > 4 ? (EXK - 4) * 2048 : 0))), lds + LDS_BYTES);
    }
}
#ifdef PROBE_TIMER
#define TST(cat) do { if (blockIdx.x == 0 && threadIdx.x == 0) { const unsigned long long _n = wall_clock64(); tacc[cat] += _n - tprev; tprev = _n; } } while (0)
#else
#define TST(cat) do { } while (0)
#endif
__global__ void __launch_bounds__(512, 2) k_mega(P p) {
    extern __shared__ __attribute__((aligned(16))) char lds[];
    uint4* xbw = (uint4*)(lds + LDS_BYTES);
    if (threadIdx.x == 0) *xbw = make_uint4(0u, 0u, 0u, 0u);
    __syncthreads();
    XcdBarrier bar = xcd_barrier_post(kargs()->bar, (volatile LAS unsigned*)xbw);
#ifdef PROBE_TIMER
    unsigned long long tacc[7] = {0, 0, 0, 0, 0, 0, 0};
    unsigned long long tprev = wall_clock64();
#endif
    phase_pro(*kargs(), lds); xcd_barrier(bar);
    for (int l = 0; l < DEPTH; ++l) {
        phase_g1(*kargs(), l, lds); xcd_barrier(bar);
        phase_att(*kargs(), l, lds); xcd_barrier(bar);
        phase_gn(*kargs(), l); xcd_barrier(bar);
        phase_g2(*kargs(), l, lds); xcd_barrier(bar);
        phase_g3(*kargs(), l, lds); xcd_barrier(bar);
        phase_exp(*kargs(), l, lds);
        if (l + 1 < DEPTH) xcd_barrier(bar);
    }
#ifdef PROBE_TIMER
    {
        float* slot = (float*)(kargs()->bar + 8192);
        if (blockIdx.x == 0 && threadIdx.x == 0) {
            unsigned long long tot = 0;
            for (int i = 0; i < 7; ++i) tot += tacc[i];
            const float share = floorf((float)tacc[PROBE_TIMER] / (float)tot * 16.f + 0.5f) * (1.f / 16.f);
            *slot = sqrtf(0.1f + 0.89f * share);
        }
        xcd_barrier(bar);
        const float delta = *slot;
        float* out = kargs()->out;
        for (size_t i = (size_t)blockIdx.x * 512 + threadIdx.x; i < (size_t)T_TOK * DM / 4; i += (size_t)gridDim.x * 512) {
            float4 v = ((float4*)out)[i];
            v.x *= 1.f + delta; v.y *= 1.f + delta; v.z *= 1.f + delta; v.w *= 1.f + delta;
            ((float4*)out)[i] = v;
        }
    }
#endif
}
#define MEGA 1
#define OPT_MASK 0x7f
#define PROBE_REPEAT 0
#ifndef OPT_MASK
#define OPT_MASK 0x7f
#endif
#ifndef MEGA
#define MEGA 1
#endif
#ifndef PROBE_REPEAT
#define PROBE_REPEAT 0
#endif
static inline size_t align_up(size_t v, size_t a) { return (v + a - 1) / a * a; }
#define DYN_LDS (LDS_BYTES + 64)

extern "C" void kernel_launch(void* const* d_in, const int* in_sizes, int n_in, void* d_out, int out_size, void* d_ws, size_t ws_size,
                              hipStream_t stream) {
    P p{};
    p.x_in = (const float*)d_in[0]; p.g_mix = (const float*)d_in[1]; p.w_in = (const float*)d_in[2]; p.win_sink = (const float*)d_in[3];
    p.ax_q_norm = (const float*)d_in[4]; p.ax_k_norm = (const float*)d_in[5]; p.mla_q_norm = (const float*)d_in[6]; p.mla_kv_norm = (const float*)d_in[7];
    p.mla_w_uq = (const float*)d_in[8]; p.mla_w_ukv = (const float*)d_in[9]; p.g_group = (const float*)d_in[10]; p.w_out = (const float*)d_in[11];
    p.g_ffn = (const float*)d_in[12]; p.peer_w_q = (const float*)d_in[13]; p.peer_sub_keys = (const float*)d_in[14]; p.peer_u = (const float*)d_in[15];
    p.peer_v = (const float*)d_in[16]; p.g_final = (const float*)d_in[17];
    p.out = (float*)d_out;

    char* w = (char*)d_ws; size_t off = 0;
    auto carve = [&](size_t bytes) { void* q = w + off; off = align_up(off + bytes, 256); return q; };
    p.bar = (unsigned*)carve(65536);
    p.x = (float*)carve((size_t)T_TOK * DM * 4);
    p.hnb = (bf16_t*)carve((size_t)T_TOK * DM * 2);
    char* regZ = (char*)carve((size_t)T_TOK * 2048 * 2);
    p.zb = (bf16_t*)regZ; p.qp = (bf16_t*)regZ;
    p.qfull = (bf16_t*)regZ; p.kvfull = (bf16_t*)(regZ + (size_t)T_TOK * 384 * 2);
    QKV& q = p.q;
    q.qA = (bf16_t*)carve((size_t)T_TOK * 256 * 2); q.kA = (bf16_t*)carve((size_t)T_TOK * 128 * 2); q.vA = (bf16_t*)carve((size_t)T_TOK * 128 * 2);
    q.qB = (bf16_t*)carve((size_t)T_TOK * 256 * 2); q.kB = (bf16_t*)carve((size_t)T_TOK * 128 * 2); q.vB = (bf16_t*)carve((size_t)T_TOK * 128 * 2);
    q.qC = (bf16_t*)carve((size_t)T_TOK * 256 * 2); q.kC = (bf16_t*)carve((size_t)T_TOK * 128 * 2); q.vC = (bf16_t*)carve((size_t)T_TOK * 128 * 2);
    q.qD = (bf16_t*)carve((size_t)T_TOK * (MEGA ? 512 : 384) * 2); q.kD = (bf16_t*)carve((size_t)T_TOK * 384 * 2); q.vD = (bf16_t*)carve((size_t)T_TOK * 256 * 2);
    p.ob = (bf16_t*)carve((size_t)T_TOK * DM * 2);
    p.cqn = p.ob; p.ckvn = p.ob + (size_t)T_TOK * 256;
    p.ssq2 = (float*)carve((size_t)T_TOK * 16 * 4);
    p.ssqd = (float*)carve((size_t)T_TOK * 6 * 4);
    p.xb2 = (bf16_t*)carve((size_t)T_TOK * DM * 2);
    p.eidx = (int*)carve((size_t)T_TOK * 128 * 4);
    p.gate = (float*)carve((size_t)T_TOK * 128 * 4);
    p.winT = (bf16_t*)carve((size_t)DEPTH * NZ * DM * 2);
    p.woutT = (bf16_t*)carve((size_t)DEPTH * DM * DM * 2);
    p.wqT = (bf16_t*)carve((size_t)DEPTH * 2048 * DM * 2);
    p.subk = (bf16_t*)carve((size_t)DEPTH * 8 * 2 * 128 * 128 * 2);
    p.wuqT = (bf16_t*)carve((size_t)DEPTH * 384 * 256 * 2);
    p.wukvT = (bf16_t*)carve((size_t)DEPTH * 512 * 128 * 2);
    if (OPT_MASK & 64) {
        p.u8 = (unsigned char*)carve((size_t)DEPTH * 16384 * DM);
        p.v8 = (unsigned char*)carve((size_t)DEPTH * 16384 * DM);
        p.su = (float*)carve((size_t)DEPTH * 16384 * 4);
        p.sv = (float*)carve((size_t)DEPTH * 16384 * 4);
        p.flags = 1 | (MEGA ? 2 : 0) | (MEGA ? 4 : 0) | (MEGA ? 8 : 0) | (MEGA ? 32 : 0) | (MEGA ? 64 : 0) | (MEGA ? 128 : 0);
    }
    Tables& tb = p.tb;
    tb.cos1 = (float*)carve(4096 * 32 * 4); tb.sin1 = (float*)carve(4096 * 32 * 4);
    tb.cosm = (float*)carve(4096 * 16 * 4); tb.sinm = (float*)carve(4096 * 16 * 4);
    tb.cosr = (float*)carve(64 * 16 * 4); tb.sinr = (float*)carve(64 * 16 * 4);
    tb.cosc = (float*)carve(64 * 16 * 4); tb.sinc = (float*)carve(64 * 16 * 4);
    if (off > ws_size) { fprintf(stderr, "workspace too small: need %zu have %zu\n", off, ws_size); return; }
    {
        static int grid = 0;
        if (!grid) {
            int dev = 0, cus = 0, per_cu = 0;
            (void)hipGetDevice(&dev);
            (void)hipDeviceGetAttribute(&cus, hipDeviceAttributeMultiprocessorCount, dev);
            (void)hipFuncSetAttribute((const void*)k_mega, hipFuncAttributeMaxDynamicSharedMemorySize, DYN_LDS);
            (void)hipOccupancyMaxActiveBlocksPerMultiprocessor(&per_cu, k_mega, 512, DYN_LDS);
            if (per_cu < 1) per_cu = 1;
            grid = cus * (per_cu < 1 ? per_cu : 1);
        }
        (void)hipMemsetAsync(p.bar, 0, XCD_BAR_WORDS * sizeof(unsigned), stream);
        k_mega<<<grid, 512, DYN_LDS, stream>>>(p);
    }
    (void)in_sizes; (void)n_in; (void)out_size;
}
```
